# Optimizing an MI355X kernel written in HIP

```python
import jax
import jax.numpy as jnp
from jax import lax
import numpy as np

D_MODEL = 1024
BATCH = 8
SEQ = 2048
DEPTH = 2

CTX_LEN = 256
GRID_W = 64
HEAD_DIM = 64
ATTN_SCALE = HEAD_DIM ** -0.5
A_HEADS = 4
D_A = A_HEADS * HEAD_DIM
LORA_W = 64
LORA_A = 64
LORA_G = 160
A_IN = 3 * D_A + 2 * LORA_W + 2 * LORA_A + LORA_G
GN_EPS = 64e-5
B_QHEADS = 6
B_KVHEADS = 2
B_GROUP = B_QHEADS // B_KVHEADS
D_B = B_QHEADS * HEAD_DIM
D_BKV = B_KVHEADS * HEAD_DIM
B_IN = D_B + 2 * D_BKV
WINDOW = 128
BAND_BLK = 128
C_HEADS = 6
D_C = C_HEADS * HEAD_DIM
C_IN = 3 * D_C
NA_KH = 8
NA_KW = 16
D_MIX = D_A + D_B + D_C
N_IN = A_IN + B_IN + C_IN
ROPE_BASE = 10000.0
ROPE_NF = HEAD_DIM // 4
N_GROUPS = 4
EXP_PER_GROUP = 8
N_EXPERTS = N_GROUPS * EXP_PER_GROUP
TOP_K = 2
D_EXPERT = 512
MOE_BLK = 128
N_MOD = 6
LN_EPS = 1e-6
F32 = jnp.float32

kernel_name = 'hybrid_rwkv7_swa_natten_hmoe_dit'


def _layer_norm(x, gain=None, bias=None):
    xf = x.astype(F32)
    mu = xf.mean(-1, keepdims=True)
    var = jnp.square(xf - mu).mean(-1, keepdims=True)
    y = (xf - mu) * lax.rsqrt(var + LN_EPS)
    if gain is not None:
        y = y * gain.astype(F32) + bias.astype(F32)
    return y.astype(x.dtype)


def _modulate(h, shift, scale):
    return h * (1 + scale) + shift


def _split(z, sizes):
    return jnp.split(z, np.cumsum(sizes)[:-1].tolist(), axis=-1)


def _centred_shift(z, w):
    zp = jnp.pad(z, ((0, 0), (1, 1), (0, 0)))
    return w[0] * zp[:, :-2] + w[1] * zp[:, 1:-1] + w[2] * zp[:, 2:]


def _axial_rope(x):
    T = x.shape[1]
    t = jnp.arange(T)
    pos = jnp.stack([t // GRID_W, t % GRID_W], -1).astype(F32)
    inv = ROPE_BASE ** (-jnp.arange(ROPE_NF, dtype=F32) / ROPE_NF)
    ang = pos[:, :, None] * inv
    cos = jnp.cos(ang)[None, :, None]
    sin = jnp.sin(ang)[None, :, None]
    xr = x.astype(F32).reshape(*x.shape[:-1], 2, 2, ROPE_NF)
    x0, x1 = xr[..., 0, :], xr[..., 1, :]
    out = jnp.stack([x0 * cos - x1 * sin, x1 * cos + x0 * sin], -2)
    return out.reshape(x.shape).astype(x.dtype)


def _rwkv7_streams(z, lp):
    Bn, T, _ = z.shape
    r, k, v, wd, ad, gd = _split(z, [D_A, D_A, D_A, 2 * LORA_W, 2 * LORA_A, LORA_G])
    wd = jnp.tanh(wd.reshape(Bn, T, 2, LORA_W))
    ad = ad.reshape(Bn, T, 2, LORA_A)
    w_log = -jax.nn.softplus(-(lp['a_w0'] + jnp.einsum('btdr,drc->btdc', wd, lp['a_w_up']))) - 0.5
    decay = jnp.exp(-jnp.exp(w_log.astype(F32)))
    a = jax.nn.sigmoid(lp['a_a0'] + jnp.einsum('btdr,drc->btdc', ad, lp['a_a_up']))
    g = jax.nn.sigmoid(gd) @ lp['a_g_up']
    heads = lambda t: t.reshape(*t.shape[:-1], A_HEADS, HEAD_DIM).astype(F32)
    kk = heads(k * lp['a_k_k'])
    kk = kk * lax.rsqrt(jnp.sum(kk * kk, -1, keepdims=True) + 1e-12)
    k_dir = k[:, :, None, :] * (1 + (a - 1) * lp['a_k_a'])
    return {'r': heads(r), 'k': heads(k_dir), 'v': heads(v), 'kk': kk,
            'w': heads(decay), 'a': heads(a), 'g': g}


def _dir_sequence(qc, ql):
    fwd = jnp.concatenate([qc[:, :, 0], ql[:, :, 0]], 1)
    bwd = jnp.concatenate([qc[:, ::-1, 1], ql[:, ::-1, 1]], 1)
    return jnp.stack([fwd, bwd], 0).transpose(2, 0, 1, 3, 4)


def _rwkv7_step(state, inp):
    r, w, k, v, kk, a = inp
    sk = jnp.einsum('dbhvk,dbhk->dbhv', state, kk)
    state = state * w[..., None, :] - sk[..., :, None] * (kk * a)[..., None, :] + v[..., :, None] * k[..., None, :]
    return state, jnp.einsum('dbhvk,dbhk->dbhv', state, r)


def _rwkv7_output(y, s, lp, dtype):
    Bn, T = y.shape[:2]
    mu = y.mean(-1, keepdims=True)
    var = jnp.square(y - mu).mean(-1, keepdims=True)
    yn = ((y - mu) * lax.rsqrt(var + GN_EPS)).reshape(Bn, T, D_A) * lp['a_lnx_g'] + lp['a_lnx_b']
    r_k = lp['a_r_k'].reshape(A_HEADS, HEAD_DIM).astype(F32)
    bonus = jnp.einsum('bthn,btdhn,hn->bth', s['r'], s['k'], r_k)[..., None] * s['v']
    return ((yn + bonus.reshape(Bn, T, D_A)) * s['g']).astype(dtype)


def _rwkv7_mixer(za, za_c, lp, with_ctx):
    Bn = za.shape[0]
    L = za_c.shape[1]
    sl = _rwkv7_streams(_centred_shift(za, lp['a_shift']), lp)
    sc = _rwkv7_streams(_centred_shift(za_c, lp['a_shift']), lp)
    both = lambda t: jnp.stack([t, t], 2)
    shared = lambda n: _dir_sequence(both(sc[n]), both(sl[n]))
    per_dir = lambda n: _dir_sequence(sc[n], sl[n])
    xs = (shared('r'), per_dir('w'), per_dir('k'), shared('v'), shared('kk'), per_dir('a'))
    s0 = jnp.zeros((2, Bn, A_HEADS, HEAD_DIM, HEAD_DIM), F32)
    _, ys = lax.scan(_rwkv7_step, s0, xs)
    ys = ys.transpose(2, 0, 1, 3, 4)
    y_lat = ys[:, L:, 0] + ys[:, L:, 1][:, ::-1]
    out = _rwkv7_output(y_lat, sl, lp, za.dtype)
    if not with_ctx:
        return out, None
    y_ctx = ys[:, :L, 0] + ys[:, :L, 1][:, ::-1]
    return out, _rwkv7_output(y_ctx, sc, lp, za.dtype)


def _window_attention(q, k, v, kc, vc, sink):
    Bn, S = q.shape[:2]
    L = kc.shape[1]
    nb = S // BAND_BLK
    qb = q.reshape(Bn, nb, BAND_BLK, B_KVHEADS, B_GROUP, HEAD_DIM)

    def band(t):
        tp = jnp.pad(t, ((0, 0), (WINDOW, WINDOW), (0, 0), (0, 0))).reshape(Bn, nb + 2, BAND_BLK, B_KVHEADS, HEAD_DIM)
        return jnp.concatenate([tp[:, :-2], tp[:, 1:-1], tp[:, 2:]], axis=2)

    kb, vb = band(k), band(v)
    s_loc = jnp.einsum('bnqhgd,bnkhd->bnhgqk', qb, kb).astype(F32) * ATTN_SCALE
    qi = jnp.arange(BAND_BLK)
    kj = jnp.arange(3 * BAND_BLK)
    rel = kj[None, :] - BAND_BLK - qi[:, None]
    kpos = jnp.arange(nb)[:, None] * BAND_BLK - BAND_BLK + kj[None, :]
    valid = (jnp.abs(rel) <= WINDOW)[None] & ((kpos >= 0) & (kpos < S))[:, None, :]
    s_loc = jnp.where(valid[None, :, None, None], s_loc, -jnp.inf)
    s_ctx = jnp.einsum('bnqhgd,bmhd->bnhgqm', qb, kc).astype(F32) * ATTN_SCALE
    sink_col = jnp.broadcast_to(sink.astype(F32)[None, None, :, :, None, None], s_loc.shape[:-1] + (1,))
    p = jax.nn.softmax(jnp.concatenate([s_loc, s_ctx, sink_col], -1), -1).astype(v.dtype)
    nk = 3 * BAND_BLK
    o = (jnp.einsum('bnhgqk,bnkhd->bnqhgd', p[..., :nk], vb)
         + jnp.einsum('bnhgqm,bmhd->bnqhgd', p[..., nk:nk + L], vc))
    return o.reshape(Bn, S, D_B)


def _context_attention(q, k, v, sink):
    Bn, L, KV, G, dh = q.shape
    s = jnp.einsum('blhgd,bmhd->bhglm', q, k).astype(F32) * ATTN_SCALE
    if sink is not None:
        s = jnp.concatenate([s, jnp.broadcast_to(sink.astype(F32)[None, :, :, None, None], s.shape[:-1] + (1,))], -1)
    p = jax.nn.softmax(s, -1)[..., :L].astype(v.dtype)
    return jnp.einsum('bhglm,bmhd->blhgd', p, v).reshape(Bn, L, KV * G * dh)


def _neighbourhood_attention(q, k, v, kc, vc, rpb):
    Bn, S, H, dh = q.shape
    rows = S // GRID_W
    kh = min(NA_KH, rows)
    qg = q.reshape(Bn, rows, GRID_W, H, dh)
    r = jnp.arange(rows)
    row_idx = jnp.clip(r - kh // 2, 0, rows - kh)[:, None] + jnp.arange(kh)[None, :]
    kband = k.reshape(Bn, rows, GRID_W, H, dh)[:, row_idx]
    vband = v.reshape(Bn, rows, GRID_W, H, dh)[:, row_idx]
    col = jnp.arange(GRID_W)
    col_start = jnp.clip(col - NA_KW // 2, 0, GRID_W - NA_KW)
    col_valid = (col[None, :] >= col_start[:, None]) & (col[None, :] < col_start[:, None] + NA_KW)
    row_off = row_idx - r[:, None] + (NA_KH - 1)
    col_off = jnp.clip(col[None, :] - col[:, None], -(NA_KW - 1), NA_KW - 1) + (NA_KW - 1)
    bias = rpb.astype(F32)[:, row_off[:, None, :, None], col_off[None, :, None, :]]
    bias = jnp.where(col_valid[None, None, :, None, :], bias, -jnp.inf).transpose(1, 0, 2, 3, 4)
    s_loc = jnp.einsum('brqhd,brakhd->brhqak', qg, kband).astype(F32) * ATTN_SCALE + bias[None]
    s_ctx = jnp.einsum('brqhd,bmhd->brhqm', qg, kc).astype(F32) * ATTN_SCALE
    n_loc = kh * GRID_W
    p = jax.nn.softmax(jnp.concatenate([s_loc.reshape(Bn, rows, H, GRID_W, n_loc), s_ctx], -1), -1).astype(v.dtype)
    o = (jnp.einsum('brhqak,brakhd->brqhd', p[..., :n_loc].reshape(Bn, rows, H, GRID_W, kh, GRID_W), vband)
         + jnp.einsum('brhqm,bmhd->brqhd', p[..., n_loc:], vc))
    return o.reshape(Bn, S, H * dh)


def _token_mixer(h, hc, lp, with_ctx):
    Bn, S, _ = h.shape
    L = hc.shape[1]
    za, zb, zn = _split(h @ lp['w_in'], [A_IN, B_IN, C_IN])
    za_c, zb_c, zn_c = _split(hc @ lp['w_in'], [A_IN, B_IN, C_IN])
    oa, oa_c = _rwkv7_mixer(za, za_c, lp, with_ctx)
    qb, kb, vb = _split(zb, [D_B, D_BKV, D_BKV])
    qb = _axial_rope(qb.reshape(Bn, S, B_QHEADS, HEAD_DIM)).reshape(Bn, S, B_KVHEADS, B_GROUP, HEAD_DIM)
    kb = _axial_rope(kb.reshape(Bn, S, B_KVHEADS, HEAD_DIM))
    vb = vb.reshape(Bn, S, B_KVHEADS, HEAD_DIM)
    qb_c, kb_c, vb_c = _split(zb_c, [D_B, D_BKV, D_BKV])
    kb_c = kb_c.reshape(Bn, L, B_KVHEADS, HEAD_DIM)
    vb_c = vb_c.reshape(Bn, L, B_KVHEADS, HEAD_DIM)
    sink = lp['b_sink'].reshape(B_KVHEADS, B_GROUP)
    ob = _window_attention(qb, kb, vb, kb_c, vb_c, sink)
    qn, kn, vn = [t.reshape(Bn, S, C_HEADS, HEAD_DIM) for t in _split(zn, [D_C, D_C, D_C])]
    qn_c, kn_c, vn_c = [t.reshape(Bn, L, C_HEADS, HEAD_DIM) for t in _split(zn_c, [D_C, D_C, D_C])]
    on = _neighbourhood_attention(qn, kn, vn, kn_c, vn_c, lp['c_rpb'])
    out = jnp.concatenate([oa, ob, on], -1) @ lp['w_out']
    if not with_ctx:
        return out, None
    ob_c = _context_attention(qb_c.reshape(Bn, L, B_KVHEADS, B_GROUP, HEAD_DIM), kb_c, vb_c, sink)
    on_c = _context_attention(qn_c[:, :, :, None], kn_c, vn_c, None)
    out_c = jnp.concatenate([oa_c, ob_c, on_c], -1) @ lp['w_out']
    return out, out_c


def _hier_moe(h, lp):
    T, D = h.shape
    gl = (h @ lp['w_rg'] + lp['b_rg']).astype(F32)
    gsel = jnp.argmax(gl, -1)
    p_grp = jnp.take_along_axis(jax.nn.softmax(gl, -1), gsel[:, None], 1)
    el = (h @ lp['w_re'] + lp['b_re']).astype(F32).reshape(T, N_GROUPS, EXP_PER_GROUP)
    el = jnp.take_along_axis(el, gsel[:, None, None], 1)[:, 0]
    top_v, top_i = lax.top_k(el, TOP_K)
    wts = jax.nn.softmax(top_v, -1) * p_grp
    eid = gsel[:, None] * EXP_PER_GROUP + top_i
    A = T * TOP_K
    flat_e = eid.reshape(-1)
    order = jnp.argsort(flat_e)
    se = flat_e[order]
    st = jnp.repeat(jnp.arange(T), TOP_K)[order]
    sw = wts.reshape(-1)[order]
    counts = jnp.bincount(flat_e, length=N_EXPERTS)
    starts = jnp.cumsum(counts) - counts
    pcounts = (counts + MOE_BLK - 1) // MOE_BLK * MOE_BLK
    pends = jnp.cumsum(pcounts)
    pstarts = pends - pcounts
    dest = pstarts[se] + jnp.arange(A) - starts[se]
    n_blk = (A + MOE_BLK - 1) // MOE_BLK + N_EXPERTS
    rows = jnp.full((n_blk * MOE_BLK,), T, jnp.int32).at[dest].set(st)
    hp = jnp.concatenate([h, jnp.zeros((1, D), h.dtype)], 0)
    xb = hp[rows].reshape(n_blk, MOE_BLK, D)
    blk_e = jnp.minimum(jnp.searchsorted(pends, jnp.arange(n_blk) * MOE_BLK, side='right'), N_EXPERTS - 1)
    w_gate, w_up, w_down = lp['w_gate'], lp['w_up'], lp['w_down']

    def expert_block(args):
        xk, e = args
        return (jax.nn.silu(xk @ w_gate[e]) * (xk @ w_up[e])) @ w_down[e]

    yb = lax.map(expert_block, (xb, blk_e)).reshape(n_blk * MOE_BLK, D)
    return jnp.zeros((T, D), h.dtype).at[st].add(yb[dest] * sw[:, None].astype(yb.dtype))


def setup_inputs(seed: int = 0) -> dict:
    key = jax.random.key(seed)
    ks = iter(jax.random.split(key, 40))
    nrm = lambda shape, scale: jax.random.normal(next(ks), shape, F32) * scale
    beta = (8.0 * DEPTH) ** -0.25
    Ld = DEPTH
    frac = jnp.linspace(0.0, 1.0, D_A)
    return {
        'x': nrm((BATCH, SEQ, D_MODEL), 1.0),
        'c': nrm((BATCH, D_MODEL), 1.0),
        'ctx': nrm((BATCH, CTX_LEN, D_MODEL), 1.0),
        'c_ctx': nrm((D_MODEL,), 1.0),
        'w_mod': nrm((Ld, D_MODEL, N_MOD * D_MODEL), 0.5 * D_MODEL ** -0.5),
        'b_mod': nrm((Ld, N_MOD * D_MODEL), 0.02),
        'w_in': nrm((Ld, D_MODEL, N_IN), D_MODEL ** -0.5),
        'w_out': nrm((Ld, D_MIX, D_MODEL), beta * D_MIX ** -0.5),
        'a_shift': jnp.array([0.0, 1.0, 0.0], F32)[None, :, None] + nrm((Ld, 3, A_IN), 0.1),
        'a_w0': (-6.0 + 5.0 * frac ** 1.5) + nrm((Ld, 2, D_A), 0.1),
        'a_w_up': nrm((Ld, 2, LORA_W, D_A), 0.1 * LORA_W ** -0.5),
        'a_a0': nrm((Ld, 2, D_A), 0.1),
        'a_a_up': nrm((Ld, 2, LORA_A, D_A), LORA_A ** -0.5),
        'a_g_up': nrm((Ld, LORA_G, D_A), LORA_G ** -0.5),
        'a_k_k': 0.85 + nrm((Ld, D_A), 0.02),
        'a_k_a': 1.0 + nrm((Ld, D_A), 0.02),
        'a_r_k': nrm((Ld, D_A), 0.1),
        'a_lnx_g': 1.0 + nrm((Ld, D_A), 0.05),
        'a_lnx_b': nrm((Ld, D_A), 0.02),
        'b_sink': nrm((Ld, B_QHEADS), 0.5),
        'c_rpb': nrm((Ld, C_HEADS, 2 * NA_KH - 1, 2 * NA_KW - 1), 0.1),
        'ln1_g': 1.0 + nrm((Ld, D_MODEL), 0.05),
        'ln1_b': nrm((Ld, D_MODEL), 0.02),
        'ln2_g': 1.0 + nrm((Ld, D_MODEL), 0.05),
        'ln2_b': nrm((Ld, D_MODEL), 0.02),
        'w_rg': nrm((Ld, D_MODEL, N_GROUPS), D_MODEL ** -0.5),
        'b_rg': nrm((Ld, N_GROUPS), 0.01),
        'w_re': nrm((Ld, D_MODEL, N_EXPERTS), D_MODEL ** -0.5),
        'b_re': nrm((Ld, N_EXPERTS), 0.01),
        'w_gate': nrm((Ld, N_EXPERTS, D_MODEL, D_EXPERT), D_MODEL ** -0.5),
        'w_up': nrm((Ld, N_EXPERTS, D_MODEL, D_EXPERT), D_MODEL ** -0.5),
        'w_down': nrm((Ld, N_EXPERTS, D_EXPERT, D_MODEL), beta * D_EXPERT ** -0.5),
    }


def reference(x, c, ctx, c_ctx, w_mod, b_mod, w_in, w_out, a_shift, a_w0, a_w_up, a_a0, a_a_up, a_g_up,
              a_k_k, a_k_a, a_r_k, a_lnx_g, a_lnx_b, b_sink, c_rpb, ln1_g, ln1_b, ln2_g, ln2_b,
              w_rg, b_rg, w_re, b_re, w_gate, w_up, w_down):
    alpha = (2.0 * DEPTH) ** 0.25
    Bn, S, D = x.shape
    L = ctx.shape[1]
    xc = ctx
    c_act = jax.nn.silu(c)
    cc_act = jax.nn.silu(c_ctx)
    for l in range(DEPTH):
        lp = {'w_in': w_in[l], 'w_out': w_out[l], 'a_shift': a_shift[l], 'a_w0': a_w0[l], 'a_w_up': a_w_up[l],
              'a_a0': a_a0[l], 'a_a_up': a_a_up[l], 'a_g_up': a_g_up[l], 'a_k_k': a_k_k[l], 'a_k_a': a_k_a[l],
              'a_r_k': a_r_k[l], 'a_lnx_g': a_lnx_g[l], 'a_lnx_b': a_lnx_b[l], 'b_sink': b_sink[l],
              'c_rpb': c_rpb[l], 'w_rg': w_rg[l], 'b_rg': b_rg[l], 'w_re': w_re[l], 'b_re': b_re[l],
              'w_gate': w_gate[l], 'w_up': w_up[l], 'w_down': w_down[l]}
        with_ctx = l < DEPTH - 1
        mod = (c_act @ w_mod[l] + b_mod[l]).reshape(Bn, N_MOD, 1, D)
        mod_c = (cc_act @ w_mod[l] + b_mod[l]).reshape(N_MOD, D)
        h = _modulate(_layer_norm(x), mod[:, 0], mod[:, 1])
        hc = _modulate(_layer_norm(xc), mod_c[0], mod_c[1])
        o, o_c = _token_mixer(h, hc, lp, with_ctx)
        x = _layer_norm(alpha * x + mod[:, 2] * o, ln1_g[l], ln1_b[l])
        h = _modulate(_layer_norm(x), mod[:, 3], mod[:, 4])
        if with_ctx:
            xc = _layer_norm(alpha * xc + mod_c[2] * o_c, ln1_g[l], ln1_b[l])
            hc = _modulate(_layer_norm(xc), mod_c[3], mod_c[4])
            f = _hier_moe(jnp.concatenate([h.reshape(-1, D), hc.reshape(-1, D)], 0), lp)
            f_lat = f[:Bn * S].reshape(Bn, S, D)
            xc = _layer_norm(alpha * xc + mod_c[5] * f[Bn * S:].reshape(Bn, L, D), ln2_g[l], ln2_b[l])
        else:
            f_lat = _hier_moe(h.reshape(-1, D), lp).reshape(Bn, S, D)
        x = _layer_norm(alpha * x + mod[:, 5] * f_lat, ln2_g[l], ln2_b[l])
    return x
```

```cpp
#ifdef HOST_EMU
#include <cmath>
#include <cstdio>
#include <cstring>
#include <cstdint>
#include <cstdlib>
#define __device__
#define __global__
#define __host__
#define __forceinline__ inline
#else
#include <hip/hip_runtime.h>
#include <cstdio>
#include <cstdint>
#endif

#ifndef CFG_D
#define CFG_D 1024
#define CFG_B 8
#define CFG_S 2048
#define CFG_L 256
#define CFG_DE 512
#endif
constexpr int D = CFG_D, NB = CFG_B, S = CFG_S, L = CFG_L, DE = CFG_DE;
constexpr int TL = NB * S, TC = NB * L, T = TL + TC;
constexpr int GRID_W = 64, HD = 64;
constexpr int DA = 256, A_IN = 1184, N_IN = 2976, NINP = 3072, DMIX = 1024;
constexpr int NEXP = 32, NSLOT = 2 * T + NEXP * 128;
constexpr int ZQB = 0, ZKB = 384, ZVB = 512, ZQN = 640, ZKN = 1024, ZVN = 1408, ZA = 1792, ZP = 2976;
constexpr float LN_EPS = 1e-6f, GN_EPS = 64e-5f, ATT_SCALE = 0.125f;
constexpr float ALPHA = 1.41421356237309515f;

typedef unsigned short bf16_t;

__device__ __forceinline__ float bf2f(bf16_t v) {
    unsigned u = ((unsigned)v) << 16; float f;
#ifdef HOST_EMU
    memcpy(&f, &u, 4);
#else
    f = __uint_as_float(u);
#endif
    return f;
}
__device__ __forceinline__ bf16_t f2bf(float f) {
    unsigned u;
#ifdef HOST_EMU
    memcpy(&u, &f, 4);
#else
    u = __float_as_uint(f);
#endif
    return (bf16_t)((u + 0x7fffu + ((u >> 16) & 1u)) >> 16);
}
__device__ __forceinline__ float sigmoidf_(float x) { return 1.0f / (1.0f + expf(-x)); }
__device__ __forceinline__ float siluf_(float x) { return x / (1.0f + expf(-x)); }
__device__ __forceinline__ int atomic_inc_int(int* p) {
#ifdef HOST_EMU
    int o = *p; *p = o + 1; return o;
#else
    return atomicAdd(p, 1);
#endif
}

struct Params {
    const float *x, *c, *ctx, *c_ctx, *w_mod, *b_mod, *w_in, *w_out, *a_shift, *a_w0, *a_w_up, *a_a0, *a_a_up, *a_g_up,
        *a_k_k, *a_k_a, *a_r_k, *a_lnx_g, *a_lnx_b, *b_sink, *c_rpb, *ln1_g, *ln1_b, *ln2_g, *ln2_b, *w_rg, *b_rg, *w_re,
        *b_re, *w_gate, *w_up, *w_down;
    float* out;
    int* cnt;
    float* mod;
    float* rope;
    bf16_t *win_t, *wout_t, *wgu_t, *wd_t;
    bf16_t* H;
    bf16_t* Z;
    float *sR, *sV, *sKK, *sG, *sW, *sKD, *sB;
    float* Y;
    bf16_t* MIX;
    float* XC;
    float* O;
    int *rE, *rPos, *rSlot; float* rW;
    int* slotTok;
    bf16_t* ACT;
    float* YS;
};

constexpr size_t al256(size_t v) { return (v + 255) & ~(size_t)255; }
constexpr size_t OFF_CNT = 0;
constexpr size_t OFF_MOD = 4096;
constexpr size_t OFF_ROPE = al256(OFF_MOD + (size_t)(NB + 1) * 6 * D * 4);
constexpr size_t OFF_WIN = al256(OFF_ROPE + 64 * 16 * 2 * 4);
constexpr size_t OFF_WOUT = al256(OFF_WIN + (size_t)NINP * D * 2);
constexpr size_t OFF_WGU = al256(OFF_WOUT + (size_t)D * DMIX * 2);
constexpr size_t OFF_WD = al256(OFF_WGU + (size_t)NEXP * 2 * DE * D * 2);
constexpr size_t OFF_H = al256(OFF_WD + (size_t)NEXP * D * DE * 2);
constexpr size_t OFF_Z = al256(OFF_H + (size_t)(T + 1) * D * 2);
constexpr size_t OFF_S = al256(OFF_Z + (size_t)T * ZP * 2);
constexpr size_t S1 = (size_t)T * 256 * 4;
constexpr size_t OFF_Y = al256(OFF_S + 10 * S1);
constexpr size_t OFF_MIX = al256(OFF_Y + 2 * S1);
constexpr size_t OFF_XC = al256(OFF_MIX + (size_t)T * 1024 * 2);
constexpr size_t OFF_ROUTE = al256(OFF_XC + (size_t)TC * D * 4);
constexpr size_t OFF_SLOTTOK = al256(OFF_ROUTE + (size_t)T * 2 * 4 * 4);
constexpr size_t WS_NEED = al256(OFF_SLOTTOK + (size_t)NSLOT * 4);
static_assert((size_t)NSLOT * DE * 2 <= (size_t)T * ZP * 2, "ACT overlays Z");
static_assert((size_t)NSLOT * D * 4 <= 10 * S1 && (size_t)T * D * 4 <= 10 * S1, "YS / O overlay the stream buffers");

static Params make_params(void* const* d_in, void* d_out, void* d_ws) {
    Params p;
    const float** f = (const float**)&p.x;
    for (int i = 0; i < 32; ++i) f[i] = (const float*)d_in[i];
    p.out = (float*)d_out;
    char* w = (char*)d_ws;
    p.cnt = (int*)(w + OFF_CNT); p.mod = (float*)(w + OFF_MOD); p.rope = (float*)(w + OFF_ROPE);
    p.win_t = (bf16_t*)(w + OFF_WIN); p.wout_t = (bf16_t*)(w + OFF_WOUT); p.wgu_t = (bf16_t*)(w + OFF_WGU); p.wd_t = (bf16_t*)(w + OFF_WD);
    p.H = (bf16_t*)(w + OFF_H); p.Z = (bf16_t*)(w + OFF_Z);
    float* s = (float*)(w + OFF_S); const size_t n1 = (size_t)T * 256;
    p.sR = s; p.sV = s + n1; p.sKK = s + 2 * n1; p.sG = s + 3 * n1; p.sW = s + 4 * n1; p.sKD = s + 6 * n1; p.sB = s + 8 * n1;
    p.Y = (float*)(w + OFF_Y); p.MIX = (bf16_t*)(w + OFF_MIX); p.XC = (float*)(w + OFF_XC);
    p.O = (float*)(w + OFF_S);
    int* r = (int*)(w + OFF_ROUTE); p.rE = r; p.rPos = r + 2 * T; p.rSlot = r + 4 * T; p.rW = (float*)(r + 6 * T);
    p.slotTok = (int*)(w + OFF_SLOTTOK);
    p.ACT = (bf16_t*)(w + OFF_Z); p.YS = (float*)(w + OFF_S);
    return p;
}

__device__ void ph_prep(const Params& p, int l, long gtid, long gsz) {
    for (long i = gtid; i < (long)D * NINP; i += gsz) {
        const int k = (int)(i / NINP), n = (int)(i % NINP);
        float v = 0.f;
        if (n < N_IN) { const int oc = (n < ZA) ? n + A_IN : n - ZA; v = p.w_in[((size_t)l * D + k) * N_IN + oc]; }
        p.win_t[(size_t)n * D + k] = f2bf(v);
    }
    for (long i = gtid; i < (long)DMIX * D; i += gsz) {
        const int k = (int)(i / D), n = (int)(i % D);
        p.wout_t[(size_t)n * DMIX + k] = f2bf(p.w_out[((size_t)l * DMIX + k) * D + n]);
    }
    for (long i = gtid; i < (long)NEXP * D * 2 * DE; i += gsz) {
        const int rho = (int)(i % (2 * DE)); const long t = i / (2 * DE); const int k = (int)(t % D), e = (int)(t / D);
        const int q = rho >> 5, half = (rho >> 4) & 1, ii = rho & 15, cc = 16 * q + ii;
        const float* src = half ? p.w_up : p.w_gate;
        p.wgu_t[((size_t)e * 2 * DE + rho) * D + k] = f2bf(src[(((size_t)l * NEXP + e) * D + k) * DE + cc]);
    }
    for (long i = gtid; i < (long)NEXP * DE * D; i += gsz) {
        const int n = (int)(i % D); const long t = i / D; const int k = (int)(t % DE), e = (int)(t / DE);
        p.wd_t[((size_t)e * D + n) * DE + k] = f2bf(p.w_down[(((size_t)l * NEXP + e) * DE + k) * D + n]);
    }
    for (long i = gtid; i < (long)(NB + 1) * 6 * D; i += gsz) {
        const int j = (int)(i % (6 * D)), b = (int)(i / (6 * D));
        const float* cv = (b < NB) ? p.c + (size_t)b * D : p.c_ctx;
        float acc = 0.f;
        for (int k = 0; k < D; ++k) acc += siluf_(cv[k]) * p.w_mod[((size_t)l * D + k) * 6 * D + j];
        p.mod[(size_t)b * 6 * D + j] = acc + p.b_mod[(size_t)l * 6 * D + j];
    }
    for (long i = gtid; i < 64 * 16; i += gsz) {
        const int pos = (int)(i / 16), fi = (int)(i % 16);
        const float inv = powf(10000.0f, -(float)fi / 16.0f), ang = (float)pos * inv;
        p.rope[i] = cosf(ang); p.rope[1024 + i] = sinf(ang);
    }
    for (long i = gtid; i < NEXP; i += gsz) p.cnt[l * NEXP + i] = 0;
    for (long i = gtid; i < NSLOT; i += gsz) p.slotTok[i] = T;
    for (long i = gtid; i < D; i += gsz) p.H[(size_t)T * D + i] = 0;
}

__device__ __forceinline__ const float* xrow_in(const Params& p, int l, int m) {
    if (m < TL) return (l == 0 ? p.x : p.out) + (size_t)m * D;
    return (l == 0 ? p.ctx : p.XC) + (size_t)(m - TL) * D;
}
__device__ __forceinline__ const float* modrow(const Params& p, int m) { return p.mod + (size_t)(m < TL ? m / S : NB) * 6 * D; }

__device__ void ph_lnmod(const Params& p, int l, long gtid, long gsz) {
    for (long m = gtid; m < T; m += gsz) {
        const float* xr = xrow_in(p, l, (int)m); const float* md = modrow(p, (int)m);
        float s = 0.f; for (int j = 0; j < D; ++j) s += xr[j];
        const float mu = s / D; float q = 0.f;
        for (int j = 0; j < D; ++j) { const float d = xr[j] - mu; q += d * d; }
        const float rstd = 1.0f / sqrtf(q / D + LN_EPS);
        for (int j = 0; j < D; ++j) p.H[(size_t)m * D + j] = f2bf((xr[j] - mu) * rstd * (1.0f + md[D + j]) + md[j]);
    }
}

__device__ __forceinline__ float zshift(const Params& p, int l, int m, int col) {
    int t, len;
    if (m < TL) { t = m % S; len = S; } else { t = (m - TL) % L; len = L; }
    const float* sh = p.a_shift + (size_t)l * 3 * A_IN;
    const bf16_t* z = p.Z + (size_t)m * ZP + ZA + col;
    float v = sh[A_IN + col] * bf2f(z[0]);
    if (t > 0) v += sh[col] * bf2f(z[-ZP]);
    if (t < len - 1) v += sh[2 * A_IN + col] * bf2f(z[ZP]);
    return v;
}

__device__ void ph_streams(const Params& p, int l, long gtid, long gsz) {
    for (long i = gtid; i < (long)T * DA; i += gsz) {
        const int m = (int)(i / DA), c = (int)(i % DA), h0 = c & ~63;
        const float r = zshift(p, l, m, c), k = zshift(p, l, m, 256 + c), v = zshift(p, l, m, 512 + c);
        float nrm = 0.f;
        for (int j = 0; j < 64; ++j) { const float t = zshift(p, l, m, 256 + h0 + j) * p.a_k_k[l * DA + h0 + j]; nrm += t * t; }
        const float kk = k * p.a_k_k[l * DA + c] / sqrtf(nrm + 1e-12f);
        float g = 0.f;
        for (int j = 0; j < 160; ++j) g += sigmoidf_(zshift(p, l, m, 1024 + j)) * p.a_g_up[((size_t)l * 160 + j) * DA + c];
        const size_t o = (size_t)m * DA + c;
        p.sR[o] = r; p.sV[o] = v; p.sKK[o] = kk; p.sG[o] = g;
        for (int d = 0; d < 2; ++d) {
            float aw = 0.f, aa = 0.f;
            for (int j = 0; j < 64; ++j) {
                aw += tanhf(zshift(p, l, m, 768 + d * 64 + j)) * p.a_w_up[(((size_t)l * 2 + d) * 64 + j) * DA + c];
                aa += zshift(p, l, m, 896 + d * 64 + j) * p.a_a_up[(((size_t)l * 2 + d) * 64 + j) * DA + c];
            }
            const float u = -(p.a_w0[(l * 2 + d) * DA + c] + aw);
            const float sp = (u > 20.f) ? u : log1pf(expf(u));
            const float w = expf(-expf(-sp - 0.5f));
            const float a = sigmoidf_(p.a_a0[(l * 2 + d) * DA + c] + aa);
            const size_t od = ((size_t)d * T + m) * DA + c;
            p.sW[od] = w; p.sKD[od] = k * (1.0f + (a - 1.0f) * p.a_k_a[l * DA + c]); p.sB[od] = kk * a;
        }
    }
}

__device__ void ph_rope(const Params& p, long gtid, long gsz) {
    for (long i = gtid; i < (long)TL * 8 * 32; i += gsz) {
        const int pr = (int)(i & 31), hs = (int)((i >> 5) & 7), m = (int)(i >> 8);
        const int t = m % S, axis = pr >> 4, fi = pr & 15, pos = axis ? (t % GRID_W) : (t / GRID_W);
        bf16_t* z = p.Z + (size_t)m * ZP + hs * 64 + axis * 32 + fi;
        const float cs = p.rope[pos * 16 + fi], sn = p.rope[1024 + pos * 16 + fi];
        const float x0 = bf2f(z[0]), x1 = bf2f(z[16]);
        z[0] = f2bf(x0 * cs - x1 * sn); z[16] = f2bf(x1 * cs + x0 * sn);
    }
}

__device__ void ph_scan(const Params& p, long gtid, long gsz) {
    for (long i = gtid; i < (long)2 * NB * 4 * 64; i += gsz) {
        const int v = (int)(i & 63), h = (int)((i >> 6) & 3), b = (int)((i >> 8) % NB), d = (int)((i >> 8) / NB);
        float st[64];
#pragma unroll
        for (int k = 0; k < 64; ++k) st[k] = 0.f;
        for (int pos = 0; pos < L + S; ++pos) {
            int m;
            if (pos < L) m = TL + b * L + (d ? L - 1 - pos : pos);
            else m = b * S + (d ? S - 1 - (pos - L) : pos - L);
            const size_t o = (size_t)m * DA + h * 64, od = ((size_t)d * T + m) * DA + h * 64;
            const float* kk = p.sKK + o; const float* r = p.sR + o;
            const float* w = p.sW + od; const float* bb = p.sB + od; const float* kd = p.sKD + od;
            const float vv = p.sV[o + v];
            float sk = 0.f;
#pragma unroll
            for (int k = 0; k < 64; ++k) sk += st[k] * kk[k];
            float y = 0.f;
#pragma unroll
            for (int k = 0; k < 64; ++k) { st[k] = st[k] * w[k] - sk * bb[k] + vv * kd[k]; y += st[k] * r[k]; }
            p.Y[od + v] = y;
        }
    }
}

__device__ void ph_rwkv_out(const Params& p, int l, int nrows, long gtid, long gsz) {
    for (long i = gtid; i < (long)nrows * 4; i += gsz) {
        const int m = (int)(i >> 2), h = (int)(i & 3);
        const size_t o = (size_t)m * DA + h * 64;
        const float* y0 = p.Y + o; const float* y1 = p.Y + (size_t)T * DA + o;
        float s = 0.f, bon = 0.f;
        for (int n = 0; n < 64; ++n) {
            s += y0[n] + y1[n];
            bon += p.sR[o + n] * (p.sKD[o + n] + p.sKD[(size_t)T * DA + o + n]) * p.a_r_k[l * DA + h * 64 + n];
        }
        const float mu = s / 64.f; float q = 0.f;
        for (int n = 0; n < 64; ++n) { const float dd = y0[n] + y1[n] - mu; q += dd * dd; }
        const float rstd = 1.0f / sqrtf(q / 64.f + GN_EPS);
        for (int n = 0; n < 64; ++n) {
            const int c = h * 64 + n;
            const float yn = (y0[n] + y1[n] - mu) * rstd * p.a_lnx_g[l * DA + c] + p.a_lnx_b[l * DA + c];
            p.MIX[(size_t)m * DMIX + c] = f2bf((yn + bon * p.sV[o + n]) * p.sG[o + n]);
        }
    }
}

__device__ __forceinline__ void att_key(const float (&q)[64], const bf16_t* kr, const bf16_t* vr, float bias, float& mx, float& ls, float (&acc)[64]) {
    float s = 0.f;
#pragma unroll
    for (int d = 0; d < 64; ++d) s += q[d] * bf2f(kr[d]);
    s = s * ATT_SCALE + bias;
    const float mn = fmaxf(mx, s), f = expf(mx - mn), pe = expf(s - mn);
    ls = ls * f + pe;
#pragma unroll
    for (int d = 0; d < 64; ++d) acc[d] = acc[d] * f + pe * bf2f(vr[d]);
    mx = mn;
}

__device__ void ph_attn(const Params& p, int l, int nrows, long gtid, long gsz) {
    for (long i = gtid; i < (long)nrows * 12; i += gsz) {
        const int m = (int)(i / 12), u = (int)(i % 12);
        const bool isB = u < 6; const int hq = isB ? u : u - 6;
        const int b = (m < TL) ? m / S : (m - TL) / L;
        const int qcol = isB ? ZQB + hq * 64 : ZQN + hq * 64;
        const int kcol = isB ? ZKB + (hq / 3) * 64 : ZKN + hq * 64;
        const int vcol = isB ? ZVB + (hq / 3) * 64 : ZVN + hq * 64;
        float q[64], acc[64];
        const bf16_t* qr = p.Z + (size_t)m * ZP + qcol;
#pragma unroll
        for (int d = 0; d < 64; ++d) { q[d] = bf2f(qr[d]); acc[d] = 0.f; }
        float mx, ls;
        if (isB) { mx = p.b_sink[l * 6 + hq]; ls = 1.0f; } else { mx = -1e30f; ls = 0.f; }
        for (int j = 0; j < L; ++j) { const bf16_t* zr = p.Z + (size_t)(TL + b * L + j) * ZP; att_key(q, zr + kcol, zr + vcol, 0.f, mx, ls, acc); }
        if (m < TL) {
            const int t = m % S;
            if (isB) {
                const int j0 = t - 128 < 0 ? 0 : t - 128, j1 = t + 128 > S - 1 ? S - 1 : t + 128;
                for (int j = j0; j <= j1; ++j) { const bf16_t* zr = p.Z + (size_t)(b * S + j) * ZP; att_key(q, zr + kcol, zr + vcol, 0.f, mx, ls, acc); }
            } else {
                const int rows = S / GRID_W, r = t / GRID_W, c = t % GRID_W;
                int r0 = r - 4; r0 = r0 < 0 ? 0 : (r0 > rows - 8 ? rows - 8 : r0);
                int c0 = c - 8; c0 = c0 < 0 ? 0 : (c0 > GRID_W - 16 ? GRID_W - 16 : c0);
                for (int a = 0; a < 8; ++a)
                    for (int e = 0; e < 16; ++e) {
                        const int kr = r0 + a, kc = c0 + e;
                        const float bias = p.c_rpb[(((size_t)l * 6 + hq) * 15 + (kr - r + 7)) * 31 + (kc - c + 15)];
                        const bf16_t* zr = p.Z + (size_t)(b * S + kr * GRID_W + kc) * ZP;
                        att_key(q, zr + kcol, zr + vcol, bias, mx, ls, acc);
                    }
            }
        }
        const float inv = 1.0f / ls;
        bf16_t* o = p.MIX + (size_t)m * DMIX + (isB ? 256 : 640) + hq * 64;
#pragma unroll
        for (int d = 0; d < 64; ++d) o[d] = f2bf(acc[d] * inv);
    }
}

__device__ void ph_post_mixer(const Params& p, int l, int nrows, long gtid, long gsz) {
    for (long mm = gtid; mm < nrows; mm += gsz) {
        const int m = (int)mm;
        const float* xr = xrow_in(p, l, m); const float* md = modrow(p, m); const float* orow = p.O + (size_t)m * D;
        float* x1 = (m < TL) ? p.out + (size_t)m * D : p.XC + (size_t)(m - TL) * D;
        const float* g1 = p.ln1_g + (size_t)l * D; const float* b1 = p.ln1_b + (size_t)l * D;
        float s = 0.f; for (int j = 0; j < D; ++j) s += ALPHA * xr[j] + md[2 * D + j] * orow[j];
        float mu = s / D, q = 0.f;
        for (int j = 0; j < D; ++j) { const float d = ALPHA * xr[j] + md[2 * D + j] * orow[j] - mu; q += d * d; }
        float rstd = 1.0f / sqrtf(q / D + LN_EPS);
        s = 0.f;
        for (int j = 0; j < D; ++j) { const float v = (ALPHA * xr[j] + md[2 * D + j] * orow[j] - mu) * rstd * g1[j] + b1[j]; x1[j] = v; s += v; }
        mu = s / D; q = 0.f;
        for (int j = 0; j < D; ++j) { const float d = x1[j] - mu; q += d * d; }
        rstd = 1.0f / sqrtf(q / D + LN_EPS);
        float gl[4], el[32];
#pragma unroll
        for (int g = 0; g < 4; ++g) gl[g] = p.b_rg[l * 4 + g];
#pragma unroll
        for (int e = 0; e < 32; ++e) el[e] = p.b_re[l * 32 + e];
        for (int j = 0; j < D; ++j) {
            const float hv = (x1[j] - mu) * rstd * (1.0f + md[4 * D + j]) + md[3 * D + j];
            p.H[(size_t)m * D + j] = f2bf(hv);
            const float* wg = p.w_rg + ((size_t)l * D + j) * 4; const float* we = p.w_re + ((size_t)l * D + j) * 32;
#pragma unroll
            for (int g = 0; g < 4; ++g) gl[g] += hv * wg[g];
#pragma unroll
            for (int e = 0; e < 32; ++e) el[e] += hv * we[e];
        }
        int gs = 0; float gm = gl[0];
#pragma unroll
        for (int g = 1; g < 4; ++g) if (gl[g] > gm) { gm = gl[g]; gs = g; }
        float den = 0.f;
#pragma unroll
        for (int g = 0; g < 4; ++g) den += expf(gl[g] - gm);
        const float pg = 1.0f / den;
        float v1 = -3e38f, v2 = -3e38f; int i1 = 0, i2 = 0;
#pragma unroll
        for (int j = 0; j < 8; ++j) {
            const float v = gs == 0 ? el[j] : gs == 1 ? el[8 + j] : gs == 2 ? el[16 + j] : el[24 + j];
            if (v > v1) { v2 = v1; i2 = i1; v1 = v; i1 = j; } else if (v > v2) { v2 = v; i2 = j; }
        }
        const float e2 = expf(v2 - v1), w1 = pg / (1.0f + e2), w2 = pg * e2 / (1.0f + e2);
        const int ea = gs * 8 + i1, eb = gs * 8 + i2;
        p.rE[2 * m] = ea; p.rE[2 * m + 1] = eb; p.rW[2 * m] = w1; p.rW[2 * m + 1] = w2;
        p.rPos[2 * m] = atomic_inc_int(p.cnt + l * NEXP + ea); p.rPos[2 * m + 1] = atomic_inc_int(p.cnt + l * NEXP + eb);
    }
}

__device__ __forceinline__ int pstart_of(const int* cnt, int e) {
    int s = 0;
    for (int j = 0; j < NEXP; ++j) if (j < e) s += (cnt[j] + 127) & ~127;
    return s;
}
__device__ void ph_dispatch(const Params& p, int l, int nrows, long gtid, long gsz) {
    for (long i = gtid; i < (long)nrows * 2; i += gsz) {
        const int slot = pstart_of(p.cnt + l * NEXP, p.rE[i]) + p.rPos[i];
        p.rSlot[i] = slot; p.slotTok[slot] = (int)(i >> 1);
    }
}

__device__ void ph_final(const Params& p, int l, int nrows, long gtid, long gsz) {
    for (long mm = gtid; mm < nrows; mm += gsz) {
        const int m = (int)mm;
        float* x1 = (m < TL) ? p.out + (size_t)m * D : p.XC + (size_t)(m - TL) * D;
        const float* md = modrow(p, m);
        const float* ya = p.YS + (size_t)p.rSlot[2 * m] * D; const float* yb = p.YS + (size_t)p.rSlot[2 * m + 1] * D;
        const float wa = p.rW[2 * m], wb = p.rW[2 * m + 1];
        const float* g2 = p.ln2_g + (size_t)l * D; const float* b2 = p.ln2_b + (size_t)l * D;
        float s = 0.f; for (int j = 0; j < D; ++j) s += ALPHA * x1[j] + md[5 * D + j] * (wa * ya[j] + wb * yb[j]);
        const float mu = s / D; float q = 0.f;
        for (int j = 0; j < D; ++j) { const float d = ALPHA * x1[j] + md[5 * D + j] * (wa * ya[j] + wb * yb[j]) - mu; q += d * d; }
        const float rstd = 1.0f / sqrtf(q / D + LN_EPS);
        for (int j = 0; j < D; ++j) x1[j] = (ALPHA * x1[j] + md[5 * D + j] * (wa * ya[j] + wb * yb[j]) - mu) * rstd * g2[j] + b2[j];
    }
}

__device__ __forceinline__ int moe_blocks(const int* cnt) { int s = 0; for (int j = 0; j < NEXP; ++j) s += (cnt[j] + 127) >> 7; return s; }
__device__ __forceinline__ int moe_block_expert(const int* cnt, int rb) {
    int s = 0, e = 0;
    for (int j = 0; j < NEXP; ++j) { const int nb = (cnt[j] + 127) >> 7; if (rb >= s && rb < s + nb) e = j; s += nb; }
    return e;
}

#ifdef HOST_EMU
static void host_gemm_in(const Params& p) {
    for (int m = 0; m < T; ++m) for (int n = 0; n < ZP; ++n) { float a = 0.f; for (int k = 0; k < D; ++k) a += bf2f(p.H[(size_t)m * D + k]) * bf2f(p.win_t[(size_t)n * D + k]); p.Z[(size_t)m * ZP + n] = f2bf(a); }
}
static void host_gemm_out(const Params& p, int nrows) {
    for (int m = 0; m < nrows; ++m) for (int n = 0; n < D; ++n) { float a = 0.f; for (int k = 0; k < DMIX; ++k) a += bf2f(p.MIX[(size_t)m * DMIX + k]) * bf2f(p.wout_t[(size_t)n * DMIX + k]); p.O[(size_t)m * D + n] = a; }
}
static void host_moe1(const Params& p, int l) {
    const int* cnt = p.cnt + l * NEXP; const int nrb = moe_blocks(cnt);
    for (int rb = 0; rb < nrb; ++rb) { const int e = moe_block_expert(cnt, rb);
        for (int r = 0; r < 128; ++r) { const int slot = rb * 128 + r; const bf16_t* a = p.H + (size_t)p.slotTok[slot] * D;
            for (int c = 0; c < DE; ++c) { const int q = c >> 4, ii = c & 15; float g = 0.f, u = 0.f;
                const bf16_t* wg = p.wgu_t + ((size_t)e * 2 * DE + 32 * q + ii) * D; const bf16_t* wu = wg + (size_t)16 * D;
                for (int k = 0; k < D; ++k) { g += bf2f(a[k]) * bf2f(wg[k]); u += bf2f(a[k]) * bf2f(wu[k]); }
                p.ACT[(size_t)slot * DE + c] = f2bf(siluf_(g) * u); } } }
}
static void host_moe2(const Params& p, int l) {
    const int* cnt = p.cnt + l * NEXP; const int nrb = moe_blocks(cnt);
    for (int rb = 0; rb < nrb; ++rb) { const int e = moe_block_expert(cnt, rb);
        for (int r = 0; r < 128; ++r) { const int slot = rb * 128 + r;
            for (int n = 0; n < D; ++n) { float a = 0.f; const bf16_t* w = p.wd_t + ((size_t)e * D + n) * DE;
                for (int k = 0; k < DE; ++k) a += bf2f(p.ACT[(size_t)slot * DE + k]) * bf2f(w[k]);
                p.YS[(size_t)slot * D + n] = a; } } }
}
#else
typedef short bf16x8 __attribute__((ext_vector_type(8)));
typedef float f32x4 __attribute__((ext_vector_type(4)));
template <class Epi>
__device__ __forceinline__ void gemm_tile(const bf16_t* a0, const bf16_t* a1, const bf16_t* b0, const bf16_t* b1, int K, char* lds, const Epi& epi) {
    const int tid = threadIdx.x, wid = tid >> 6, lane = tid & 63, wr = wid >> 1, wc = wid & 1, fr = lane & 15, fq = lane >> 4;
    char* SA = lds; char* SB = lds + 8192;
    f32x4 acc[4][4];
#pragma unroll
    for (int m = 0; m < 4; ++m)
#pragma unroll
        for (int n = 0; n < 4; ++n) acc[m][n] = (f32x4){0.f, 0.f, 0.f, 0.f};
    for (int kt = 0; kt < K; kt += 32) {
        __builtin_amdgcn_global_load_lds((const unsigned*)(a0 + kt), (__attribute__((address_space(3))) unsigned*)(SA + tid * 16), 16, 0, 0);
        __builtin_amdgcn_global_load_lds((const unsigned*)(a1 + kt), (__attribute__((address_space(3))) unsigned*)(SA + tid * 16 + 4096), 16, 0, 0);
        __builtin_amdgcn_global_load_lds((const unsigned*)(b0 + kt), (__attribute__((address_space(3))) unsigned*)(SB + tid * 16), 16, 0, 0);
        __builtin_amdgcn_global_load_lds((const unsigned*)(b1 + kt), (__attribute__((address_space(3))) unsigned*)(SB + tid * 16 + 4096), 16, 0, 0);
        asm volatile("s_waitcnt vmcnt(0)" ::: "memory");
        __syncthreads();
        bf16x8 At[4], Bt[4];
#pragma unroll
        for (int m = 0; m < 4; ++m) At[m] = *(const bf16x8*)(SA + (wr * 64 + m * 16 + fr) * 64 + fq * 16);
#pragma unroll
        for (int n = 0; n < 4; ++n) Bt[n] = *(const bf16x8*)(SB + (wc * 64 + n * 16 + fr) * 64 + fq * 16);
#pragma unroll
        for (int m = 0; m < 4; ++m)
#pragma unroll
            for (int n = 0; n < 4; ++n) acc[m][n] = __builtin_amdgcn_mfma_f32_16x16x32_bf16(At[m], Bt[n], acc[m][n], 0, 0, 0);
        __syncthreads();
    }
    epi(acc, wr, wc, fr, fq);
}
#define STG_ROW(i) ((threadIdx.x + (i) * 256) >> 2)
#define STG_K ((threadIdx.x & 3) * 8)

__global__ void __launch_bounds__(256) k_gemm_in(Params p) {
    __shared__ __attribute__((aligned(16))) char lds[16384];
    constexpr int NT = NINP / 128, MT = T / 128;
    for (int tile = blockIdx.x; tile < NT * MT; tile += gridDim.x) {
        const int tm = tile / NT, tn = tile % NT;
        const bf16_t* a0 = p.H + (size_t)(tm * 128 + STG_ROW(0)) * D + STG_K; const bf16_t* a1 = p.H + (size_t)(tm * 128 + STG_ROW(1)) * D + STG_K;
        const bf16_t* b0 = p.win_t + (size_t)(tn * 128 + STG_ROW(0)) * D + STG_K; const bf16_t* b1 = p.win_t + (size_t)(tn * 128 + STG_ROW(1)) * D + STG_K;
        gemm_tile(a0, a1, b0, b1, D, lds, [&](const f32x4 (&acc)[4][4], int wr, int wc, int fr, int fq) {
#pragma unroll
            for (int m = 0; m < 4; ++m)
#pragma unroll
                for (int n = 0; n < 4; ++n) { const int col = tn * 128 + wc * 64 + n * 16 + fr;
                    if (col < ZP) {
#pragma unroll
                        for (int j = 0; j < 4; ++j) p.Z[(size_t)(tm * 128 + wr * 64 + m * 16 + fq * 4 + j) * ZP + col] = f2bf(acc[m][n][j]); } }
        });
    }
}
__global__ void __launch_bounds__(256) k_gemm_out(Params p, int nrows) {
    __shared__ __attribute__((aligned(16))) char lds[16384];
    constexpr int NT = D / 128; const int MT = nrows / 128;
    for (int tile = blockIdx.x; tile < NT * MT; tile += gridDim.x) {
        const int tm = tile / NT, tn = tile % NT;
        const bf16_t* a0 = p.MIX + (size_t)(tm * 128 + STG_ROW(0)) * DMIX + STG_K; const bf16_t* a1 = p.MIX + (size_t)(tm * 128 + STG_ROW(1)) * DMIX + STG_K;
        const bf16_t* b0 = p.wout_t + (size_t)(tn * 128 + STG_ROW(0)) * DMIX + STG_K; const bf16_t* b1 = p.wout_t + (size_t)(tn * 128 + STG_ROW(1)) * DMIX + STG_K;
        gemm_tile(a0, a1, b0, b1, DMIX, lds, [&](const f32x4 (&acc)[4][4], int wr, int wc, int fr, int fq) {
#pragma unroll
            for (int m = 0; m < 4; ++m)
#pragma unroll
                for (int n = 0; n < 4; ++n)
#pragma unroll
                    for (int j = 0; j < 4; ++j) p.O[(size_t)(tm * 128 + wr * 64 + m * 16 + fq * 4 + j) * D + tn * 128 + wc * 64 + n * 16 + fr] = acc[m][n][j];
        });
    }
}
__global__ void __launch_bounds__(256) k_moe1(Params p, int l) {
    __shared__ __attribute__((aligned(16))) char lds[16384];
    const int* cnt = p.cnt + l * NEXP; const int nrb = moe_blocks(cnt); constexpr int NT = 2 * DE / 128;
    for (int tile = blockIdx.x; tile < nrb * NT; tile += gridDim.x) {
        const int rb = tile / NT, tn = tile % NT, e = moe_block_expert(cnt, rb);
        const bf16_t* a0 = p.H + (size_t)p.slotTok[rb * 128 + STG_ROW(0)] * D + STG_K; const bf16_t* a1 = p.H + (size_t)p.slotTok[rb * 128 + STG_ROW(1)] * D + STG_K;
        const bf16_t* bw = p.wgu_t + (size_t)e * 2 * DE * D;
        const bf16_t* b0 = bw + (size_t)(tn * 128 + STG_ROW(0)) * D + STG_K; const bf16_t* b1 = bw + (size_t)(tn * 128 + STG_ROW(1)) * D + STG_K;
        gemm_tile(a0, a1, b0, b1, D, lds, [&](const f32x4 (&acc)[4][4], int wr, int wc, int fr, int fq) {
#pragma unroll
            for (int m = 0; m < 4; ++m)
#pragma unroll
                for (int n2 = 0; n2 < 2; ++n2) { const int col = tn * 64 + wc * 32 + n2 * 16 + fr;
#pragma unroll
                    for (int j = 0; j < 4; ++j) { const float g = acc[m][2 * n2][j], u = acc[m][2 * n2 + 1][j];
                        p.ACT[(size_t)(rb * 128 + wr * 64 + m * 16 + fq * 4 + j) * DE + col] = f2bf(g / (1.0f + __expf(-g)) * u); } }
        });
    }
}
__global__ void __launch_bounds__(256) k_moe2(Params p, int l) {
    __shared__ __attribute__((aligned(16))) char lds[16384];
    const int* cnt = p.cnt + l * NEXP; const int nrb = moe_blocks(cnt); constexpr int NT = D / 128;
    for (int tile = blockIdx.x; tile < nrb * NT; tile += gridDim.x) {
        const int rb = tile / NT, tn = tile % NT, e = moe_block_expert(cnt, rb);
        const bf16_t* a0 = p.ACT + (size_t)(rb * 128 + STG_ROW(0)) * DE + STG_K; const bf16_t* a1 = p.ACT + (size_t)(rb * 128 + STG_ROW(1)) * DE + STG_K;
        const bf16_t* bw = p.wd_t + (size_t)e * D * DE;
        const bf16_t* b0 = bw + (size_t)(tn * 128 + STG_ROW(0)) * DE + STG_K; const bf16_t* b1 = bw + (size_t)(tn * 128 + STG_ROW(1)) * DE + STG_K;
        gemm_tile(a0, a1, b0, b1, DE, lds, [&](const f32x4 (&acc)[4][4], int wr, int wc, int fr, int fq) {
#pragma unroll
            for (int m = 0; m < 4; ++m)
#pragma unroll
                for (int n = 0; n < 4; ++n)
#pragma unroll
                    for (int j = 0; j < 4; ++j) p.YS[(size_t)(rb * 128 + wr * 64 + m * 16 + fq * 4 + j) * D + tn * 128 + wc * 64 + n * 16 + fr] = acc[m][n][j];
        });
    }
}

#define GT ((long)blockIdx.x * blockDim.x + threadIdx.x)
#define GS ((long)gridDim.x * blockDim.x)
__global__ void __launch_bounds__(256) k_prep(Params p, int l) { ph_prep(p, l, GT, GS); }
__global__ void __launch_bounds__(256) k_lnmod(Params p, int l) { ph_lnmod(p, l, GT, GS); }
__global__ void __launch_bounds__(256) k_streams(Params p, int l) { ph_streams(p, l, GT, GS); }
__global__ void __launch_bounds__(256) k_rope(Params p) { ph_rope(p, GT, GS); }
__global__ void __launch_bounds__(256) k_scan(Params p) { ph_scan(p, GT, GS); }
__global__ void __launch_bounds__(256) k_rwkv_out(Params p, int l, int nrows) { ph_rwkv_out(p, l, nrows, GT, GS); }
__global__ void __launch_bounds__(256) k_attn(Params p, int l, int nrows) { ph_attn(p, l, nrows, GT, GS); }
__global__ void __launch_bounds__(256) k_post_mixer(Params p, int l, int nrows) { ph_post_mixer(p, l, nrows, GT, GS); }
__global__ void __launch_bounds__(256) k_dispatch(Params p, int l, int nrows) { ph_dispatch(p, l, nrows, GT, GS); }
__global__ void __launch_bounds__(256) k_final(Params p, int l, int nrows) { ph_final(p, l, nrows, GT, GS); }

extern "C" void kernel_launch(void* const* d_in, const int* in_sizes, int n_in, void* d_out, int out_size, void* d_ws, size_t ws_size, hipStream_t stream) {
    if (n_in != 32 || out_size != TL * D || ws_size < WS_NEED) { fprintf(stderr, "kernel_launch: unexpected shapes / workspace (n_in %d out %d ws %zu need %zu)\n", n_in, out_size, ws_size, (size_t)WS_NEED); return; }
    const Params p = make_params(d_in, d_out, d_ws);
    const int G = 2048;
    for (int l = 0; l < 2; ++l) {
        const int nrows = (l == 0) ? T : TL;
        k_prep<<<G, 256, 0, stream>>>(p, l);
        k_lnmod<<<(T + 255) / 256, 256, 0, stream>>>(p, l);
        k_gemm_in<<<1024, 256, 0, stream>>>(p);
        k_streams<<<G, 256, 0, stream>>>(p, l);
        k_rope<<<G, 256, 0, stream>>>(p);
        k_scan<<<2 * NB * 4 * 64 / 256, 256, 0, stream>>>(p);
        k_attn<<<G, 256, 0, stream>>>(p, l, nrows);
        k_rwkv_out<<<(nrows * 4 + 255) / 256, 256, 0, stream>>>(p, l, nrows);
        k_gemm_out<<<1024, 256, 0, stream>>>(p, nrows);
        k_post_mixer<<<(nrows + 255) / 256, 256, 0, stream>>>(p, l, nrows);
        k_dispatch<<<(nrows * 2 + 255) / 256, 256, 0, stream>>>(p, l, nrows);
        k_moe1<<<1024, 256, 0, stream>>>(p, l);
        k_moe2<<<1024, 256, 0, stream>>>(p, l);
        k_final<<<(nrows + 255) / 256, 256, 0, stream>>>(p, l, nrows);
    }
}
#endif

#ifdef HOST_EMU
static void host_forward(void* const* d_in, void* d_out, void* d_ws) {
    const Params p = make_params(d_in, d_out, d_ws);
    for (int l = 0; l < 2; ++l) {
        const int nrows = (l == 0) ? T : TL;
        ph_prep(p, l, 0, 1); ph_lnmod(p, l, 0, 1); host_gemm_in(p); ph_streams(p, l, 0, 1); ph_rope(p, 0, 1); ph_scan(p, 0, 1);
        ph_attn(p, l, nrows, 0, 1); ph_rwkv_out(p, l, nrows, 0, 1); host_gemm_out(p, nrows); ph_post_mixer(p, l, nrows, 0, 1);
        ph_dispatch(p, l, nrows, 0, 1); host_moe1(p, l); host_moe2(p, l); ph_final(p, l, nrows, 0, 1);
    }
}
#endif
```

```cpp
#ifdef HOST_EMU
#include <cmath>
#include <cstdio>
#include <cstring>
#include <cstdint>
#include <cstdlib>
#define __device__
#define __global__
#define __host__
#define __forceinline__ inline
#else
#include <hip/hip_runtime.h>
#include <hip/hip_cooperative_groups.h>
#include <cstdio>
#include <cstdint>
namespace cg = cooperative_groups;
#endif

#ifndef CFG_D
#define CFG_D 1024
#define CFG_B 8
#define CFG_S 2048
#define CFG_L 256
#define CFG_DE 512
#endif
constexpr int D = CFG_D, NB = CFG_B, S = CFG_S, L = CFG_L, DE = CFG_DE;
constexpr int TL = NB * S, TC = NB * L, T = TL + TC;
constexpr int GRID_W = 64, HD = 64;
constexpr int DA = 256, A_IN = 1184, N_IN = 2976, NINP = 3072, DMIX = 1024;
constexpr int NEXP = 32, NSLOT = 2 * T + NEXP * 128;
constexpr int ZQB = 0, ZKB = 384, ZVB = 512, ZQN = 640, ZKN = 1024, ZVN = 1408, ZA = 1792, ZP = 2976;
constexpr float LN_EPS = 1e-6f, GN_EPS = 64e-5f, ATT_SCALE = 0.125f;
constexpr float ALPHA = 1.41421356237309515f;

typedef unsigned short bf16_t;

__device__ __forceinline__ float bf2f(bf16_t v) {
    unsigned u = ((unsigned)v) << 16; float f;
#ifdef HOST_EMU
    memcpy(&f, &u, 4);
#else
    f = __uint_as_float(u);
#endif
    return f;
}
__device__ __forceinline__ bf16_t f2bf(float f) {
    unsigned u;
#ifdef HOST_EMU
    memcpy(&u, &f, 4);
#else
    u = __float_as_uint(f);
#endif
    return (bf16_t)((u + 0x7fffu + ((u >> 16) & 1u)) >> 16);
}
__device__ __forceinline__ float sigmoidf_(float x) { return 1.0f / (1.0f + expf(-x)); }
__device__ __forceinline__ float siluf_(float x) { return x / (1.0f + expf(-x)); }
__device__ __forceinline__ int atomic_inc_int(int* p) {
#ifdef HOST_EMU
    int o = *p; *p = o + 1; return o;
#else
    return atomicAdd(p, 1);
#endif
}

struct Params {
    const float *x, *c, *ctx, *c_ctx, *w_mod, *b_mod, *w_in, *w_out, *a_shift, *a_w0, *a_w_up, *a_a0, *a_a_up, *a_g_up,
        *a_k_k, *a_k_a, *a_r_k, *a_lnx_g, *a_lnx_b, *b_sink, *c_rpb, *ln1_g, *ln1_b, *ln2_g, *ln2_b, *w_rg, *b_rg, *w_re,
        *b_re, *w_gate, *w_up, *w_down;
    float* out;
    int* cnt;
    float* mod;
    float* rope;
    bf16_t *win_t, *wout_t, *wgu_t, *wd_t;
    bf16_t* H;
    bf16_t* Z;
    float *sR, *sV, *sKK, *sG, *sW, *sKD, *sB;
    float* Y;
    bf16_t* MIX;
    float* XC;
    float* O;
    int *rE, *rPos, *rSlot; float* rW;
    int* slotTok;
    bf16_t* ACT;
    float* YS;
};

constexpr size_t al256(size_t v) { return (v + 255) & ~(size_t)255; }
constexpr size_t OFF_CNT = 0;
constexpr size_t OFF_MOD = 4096;
constexpr size_t OFF_ROPE = al256(OFF_MOD + (size_t)2 * (NB + 1) * 6 * D * 4);
constexpr size_t OFF_WIN = al256(OFF_ROPE + 64 * 16 * 2 * 4);
constexpr size_t OFF_WOUT = al256(OFF_WIN + (size_t)NINP * D * 2);
constexpr size_t OFF_WGU = al256(OFF_WOUT + (size_t)D * DMIX * 2);
constexpr size_t OFF_WD = al256(OFF_WGU + (size_t)NEXP * 2 * DE * D * 2);
constexpr size_t OFF_H = al256(OFF_WD + (size_t)NEXP * D * DE * 2);
constexpr size_t OFF_Z = al256(OFF_H + (size_t)(T + 1) * D * 2);
constexpr size_t OFF_S = al256(OFF_Z + (size_t)T * ZP * 2);
constexpr size_t S1 = (size_t)T * 256 * 4;
constexpr size_t OFF_Y = al256(OFF_S + 10 * S1);
constexpr size_t OFF_MIX = al256(OFF_Y + 2 * S1);
constexpr size_t OFF_XC = al256(OFF_MIX + (size_t)T * 1024 * 2);
constexpr size_t OFF_ROUTE = al256(OFF_XC + (size_t)TC * D * 4);
constexpr size_t OFF_SLOTTOK = al256(OFF_ROUTE + (size_t)T * 2 * 4 * 4);
constexpr size_t WS_NEED = al256(OFF_SLOTTOK + (size_t)NSLOT * 4);
static_assert((size_t)NSLOT * DE * 2 <= (size_t)T * ZP * 2, "ACT overlays Z");
static_assert((size_t)NSLOT * D * 4 <= 10 * S1 && (size_t)T * D * 4 <= 10 * S1, "YS / O overlay the stream buffers");

static Params make_params(void* const* d_in, void* d_out, void* d_ws) {
    Params p{};
    const float** f = (const float**)&p.x;
    for (int i = 0; i < 32; ++i) f[i] = (const float*)d_in[i];
    p.out = (float*)d_out;
    char* w = (char*)d_ws;
    p.cnt = (int*)(w + OFF_CNT); p.mod = (float*)(w + OFF_MOD); p.rope = (float*)(w + OFF_ROPE);
    p.win_t = (bf16_t*)(w + OFF_WIN); p.wout_t = (bf16_t*)(w + OFF_WOUT); p.wgu_t = (bf16_t*)(w + OFF_WGU); p.wd_t = (bf16_t*)(w + OFF_WD);
    p.H = (bf16_t*)(w + OFF_H); p.Z = (bf16_t*)(w + OFF_Z);
    float* s = (float*)(w + OFF_S); const size_t n1 = (size_t)T * 256;
    p.sR = s; p.sV = s + n1; p.sKK = s + 2 * n1; p.sG = s + 3 * n1; p.sW = s + 4 * n1; p.sKD = s + 6 * n1; p.sB = s + 8 * n1;
    p.Y = (float*)(w + OFF_Y); p.MIX = (bf16_t*)(w + OFF_MIX); p.XC = (float*)(w + OFF_XC);
    p.O = (float*)(w + OFF_S);
    int* r = (int*)(w + OFF_ROUTE); p.rE = r; p.rPos = r + 2 * T; p.rSlot = r + 4 * T; p.rW = (float*)(r + 6 * T);
    p.slotTok = (int*)(w + OFF_SLOTTOK);
    p.ACT = (bf16_t*)(w + OFF_Z); p.YS = (float*)(w + OFF_S);
    return p;
}

__device__ void ph_prep(const Params& p, int l, long gtid, long gsz) {
    for (long i = gtid; i < (long)D * NINP; i += gsz) {
        const int k = (int)(i / NINP), n = (int)(i % NINP);
        float v = 0.f;
        if (n < N_IN) { const int oc = (n < ZA) ? n + A_IN : n - ZA; v = p.w_in[((size_t)l * D + k) * N_IN + oc]; }
        p.win_t[(size_t)n * D + k] = f2bf(v);
    }
    for (long i = gtid; i < (long)DMIX * D; i += gsz) {
        const int k = (int)(i / D), n = (int)(i % D);
        p.wout_t[(size_t)n * DMIX + k] = f2bf(p.w_out[((size_t)l * DMIX + k) * D + n]);
    }
    for (long i = gtid; i < (long)NEXP * D * 2 * DE; i += gsz) {
        const int rho = (int)(i % (2 * DE)); const long t = i / (2 * DE); const int k = (int)(t % D), e = (int)(t / D);
        const int q = rho >> 5, half = (rho >> 4) & 1, ii = rho & 15, cc = 16 * q + ii;
        const float* src = half ? p.w_up : p.w_gate;
        p.wgu_t[((size_t)e * 2 * DE + rho) * D + k] = f2bf(src[(((size_t)l * NEXP + e) * D + k) * DE + cc]);
    }
    for (long i = gtid; i < (long)NEXP * DE * D; i += gsz) {
        const int n = (int)(i % D); const long t = i / D; const int k = (int)(t % DE), e = (int)(t / DE);
        p.wd_t[((size_t)e * D + n) * DE + k] = f2bf(p.w_down[(((size_t)l * NEXP + e) * DE + k) * D + n]);
    }
    if (l == 0) for (long i = gtid; i < (long)2 * (NB + 1) * 6 * D; i += gsz) {
        const int j = (int)(i % (6 * D)), b = (int)((i / (6 * D)) % (NB + 1)), ll = (int)(i / ((long)6 * D * (NB + 1)));
        const float* cv = (b < NB) ? p.c + (size_t)b * D : p.c_ctx;
        float acc = 0.f;
        for (int k = 0; k < D; ++k) acc += siluf_(cv[k]) * p.w_mod[((size_t)ll * D + k) * 6 * D + j];
        p.mod[((size_t)ll * (NB + 1) + b) * 6 * D + j] = acc + p.b_mod[(size_t)ll * 6 * D + j];
    }
    if (l == 0) for (long i = gtid; i < 64 * 16; i += gsz) {
        const int pos = (int)(i / 16), fi = (int)(i % 16);
        const float inv = powf(10000.0f, -(float)fi / 16.0f), ang = (float)pos * inv;
        p.rope[i] = cosf(ang); p.rope[1024 + i] = sinf(ang);
    }
    for (long i = gtid; i < NEXP; i += gsz) p.cnt[l * NEXP + i] = 0;
    for (long i = gtid; i < NSLOT; i += gsz) p.slotTok[i] = T;
    for (long i = gtid; i < D; i += gsz) p.H[(size_t)T * D + i] = 0;
}

__device__ __forceinline__ const float* xrow_in(const Params& p, int l, int m) {
    if (m < TL) return (l == 0 ? p.x : p.out) + (size_t)m * D;
    return (l == 0 ? p.ctx : p.XC) + (size_t)(m - TL) * D;
}
__device__ __forceinline__ const float* modrow(const Params& p, int l, int m) { return p.mod + ((size_t)l * (NB + 1) + (m < TL ? m / S : NB)) * 6 * D; }

__device__ void ph_lnmod(const Params& p, int l, long gtid, long gsz) {
    for (long m = gtid; m < T; m += gsz) {
        const float* xr = xrow_in(p, l, (int)m); const float* md = modrow(p, l, (int)m);
        float s = 0.f; for (int j = 0; j < D; ++j) s += xr[j];
        const float mu = s / D; float q = 0.f;
        for (int j = 0; j < D; ++j) { const float d = xr[j] - mu; q += d * d; }
        const float rstd = 1.0f / sqrtf(q / D + LN_EPS);
        for (int j = 0; j < D; ++j) p.H[(size_t)m * D + j] = f2bf((xr[j] - mu) * rstd * (1.0f + md[D + j]) + md[j]);
    }
}

__device__ __forceinline__ float zshift(const Params& p, int l, int m, int col) {
    int t, len;
    if (m < TL) { t = m % S; len = S; } else { t = (m - TL) % L; len = L; }
    const float* sh = p.a_shift + (size_t)l * 3 * A_IN;
    const bf16_t* z = p.Z + (size_t)m * ZP + ZA + col;
    float v = sh[A_IN + col] * bf2f(z[0]);
    if (t > 0) v += sh[col] * bf2f(z[-ZP]);
    if (t < len - 1) v += sh[2 * A_IN + col] * bf2f(z[ZP]);
    return v;
}

__device__ void ph_streams(const Params& p, int l, long gtid, long gsz) {
    for (long i = gtid; i < (long)T * DA; i += gsz) {
        const int m = (int)(i / DA), c = (int)(i % DA), h0 = c & ~63;
        const float r = zshift(p, l, m, c), k = zshift(p, l, m, 256 + c), v = zshift(p, l, m, 512 + c);
        float nrm = 0.f;
        for (int j = 0; j < 64; ++j) { const float t = zshift(p, l, m, 256 + h0 + j) * p.a_k_k[l * DA + h0 + j]; nrm += t * t; }
        const float kk = k * p.a_k_k[l * DA + c] / sqrtf(nrm + 1e-12f);
        float g = 0.f;
        for (int j = 0; j < 160; ++j) g += sigmoidf_(zshift(p, l, m, 1024 + j)) * p.a_g_up[((size_t)l * 160 + j) * DA + c];
        const size_t o = (size_t)m * DA + c;
        p.sR[o] = r; p.sV[o] = v; p.sKK[o] = kk; p.sG[o] = g;
        for (int d = 0; d < 2; ++d) {
            float aw = 0.f, aa = 0.f;
            for (int j = 0; j < 64; ++j) {
                aw += tanhf(zshift(p, l, m, 768 + d * 64 + j)) * p.a_w_up[(((size_t)l * 2 + d) * 64 + j) * DA + c];
                aa += zshift(p, l, m, 896 + d * 64 + j) * p.a_a_up[(((size_t)l * 2 + d) * 64 + j) * DA + c];
            }
            const float u = -(p.a_w0[(l * 2 + d) * DA + c] + aw);
            const float sp = (u > 20.f) ? u : log1pf(expf(u));
            const float w = expf(-expf(-sp - 0.5f));
            const float a = sigmoidf_(p.a_a0[(l * 2 + d) * DA + c] + aa);
            const size_t od = ((size_t)d * T + m) * DA + c;
            p.sW[od] = w; p.sKD[od] = k * (1.0f + (a - 1.0f) * p.a_k_a[l * DA + c]); p.sB[od] = kk * a;
        }
    }
}

__device__ void ph_rope(const Params& p, long gtid, long gsz) {
    for (long i = gtid; i < (long)TL * 8 * 32; i += gsz) {
        const int pr = (int)(i & 31), hs = (int)((i >> 5) & 7), m = (int)(i >> 8);
        const int t = m % S, axis = pr >> 4, fi = pr & 15, pos = axis ? (t % GRID_W) : (t / GRID_W);
        bf16_t* z = p.Z + (size_t)m * ZP + hs * 64 + axis * 32 + fi;
        const float cs = p.rope[pos * 16 + fi], sn = p.rope[1024 + pos * 16 + fi];
        const float x0 = bf2f(z[0]), x1 = bf2f(z[16]);
        z[0] = f2bf(x0 * cs - x1 * sn); z[16] = f2bf(x1 * cs + x0 * sn);
    }
}

__device__ void ph_scan(const Params& p, long gtid, long gsz) {
    for (long i = gtid; i < (long)2 * NB * 4 * 64; i += gsz) {
        const int v = (int)(i & 63), h = (int)((i >> 6) & 3), b = (int)((i >> 8) % NB), d = (int)((i >> 8) / NB);
        float st[64];
#pragma unroll
        for (int k = 0; k < 64; ++k) st[k] = 0.f;
        for (int pos = 0; pos < L + S; ++pos) {
            int m;
            if (pos < L) m = TL + b * L + (d ? L - 1 - pos : pos);
            else m = b * S + (d ? S - 1 - (pos - L) : pos - L);
            const size_t o = (size_t)m * DA + h * 64, od = ((size_t)d * T + m) * DA + h * 64;
            const float* kk = p.sKK + o; const float* r = p.sR + o;
            const float* w = p.sW + od; const float* bb = p.sB + od; const float* kd = p.sKD + od;
            const float vv = p.sV[o + v];
            float sk = 0.f;
#pragma unroll
            for (int k = 0; k < 64; ++k) sk += st[k] * kk[k];
            float y = 0.f;
#pragma unroll
            for (int k = 0; k < 64; ++k) { st[k] = st[k] * w[k] - sk * bb[k] + vv * kd[k]; y += st[k] * r[k]; }
            p.Y[od + v] = y;
        }
    }
}

__device__ void ph_rwkv_out(const Params& p, int l, int nrows, long gtid, long gsz) {
    for (long i = gtid; i < (long)nrows * 4; i += gsz) {
        const int m = (int)(i >> 2), h = (int)(i & 3);
        const size_t o = (size_t)m * DA + h * 64;
        const float* y0 = p.Y + o; const float* y1 = p.Y + (size_t)T * DA + o;
        float s = 0.f, bon = 0.f;
        for (int n = 0; n < 64; ++n) {
            s += y0[n] + y1[n];
            bon += p.sR[o + n] * (p.sKD[o + n] + p.sKD[(size_t)T * DA + o + n]) * p.a_r_k[l * DA + h * 64 + n];
        }
        const float mu = s / 64.f; float q = 0.f;
        for (int n = 0; n < 64; ++n) { const float dd = y0[n] + y1[n] - mu; q += dd * dd; }
        const float rstd = 1.0f / sqrtf(q / 64.f + GN_EPS);
        for (int n = 0; n < 64; ++n) {
            const int c = h * 64 + n;
            const float yn = (y0[n] + y1[n] - mu) * rstd * p.a_lnx_g[l * DA + c] + p.a_lnx_b[l * DA + c];
            p.MIX[(size_t)m * DMIX + c] = f2bf((yn + bon * p.sV[o + n]) * p.sG[o + n]);
        }
    }
}

__device__ __forceinline__ void att_key(const float (&q)[64], const bf16_t* kr, const bf16_t* vr, float bias, float& mx, float& ls, float (&acc)[64]) {
    float s = 0.f;
#pragma unroll
    for (int d = 0; d < 64; ++d) s += q[d] * bf2f(kr[d]);
    s = s * ATT_SCALE + bias;
    const float mn = fmaxf(mx, s), f = expf(mx - mn), pe = expf(s - mn);
    ls = ls * f + pe;
#pragma unroll
    for (int d = 0; d < 64; ++d) acc[d] = acc[d] * f + pe * bf2f(vr[d]);
    mx = mn;
}

__device__ void ph_attn(const Params& p, int l, int nrows, long gtid, long gsz) {
    for (long i = gtid; i < (long)nrows * 12; i += gsz) {
        const int m = (int)(i / 12), u = (int)(i % 12);
        const bool isB = u < 6; const int hq = isB ? u : u - 6;
        const int b = (m < TL) ? m / S : (m - TL) / L;
        const int qcol = isB ? ZQB + hq * 64 : ZQN + hq * 64;
        const int kcol = isB ? ZKB + (hq / 3) * 64 : ZKN + hq * 64;
        const int vcol = isB ? ZVB + (hq / 3) * 64 : ZVN + hq * 64;
        float q[64], acc[64];
        const bf16_t* qr = p.Z + (size_t)m * ZP + qcol;
#pragma unroll
        for (int d = 0; d < 64; ++d) { q[d] = bf2f(qr[d]); acc[d] = 0.f; }
        float mx, ls;
        if (isB) { mx = p.b_sink[l * 6 + hq]; ls = 1.0f; } else { mx = -1e30f; ls = 0.f; }
        for (int j = 0; j < L; ++j) { const bf16_t* zr = p.Z + (size_t)(TL + b * L + j) * ZP; att_key(q, zr + kcol, zr + vcol, 0.f, mx, ls, acc); }
        if (m < TL) {
            const int t = m % S;
            if (isB) {
                const int j0 = t - 128 < 0 ? 0 : t - 128, j1 = t + 128 > S - 1 ? S - 1 : t + 128;
                for (int j = j0; j <= j1; ++j) { const bf16_t* zr = p.Z + (size_t)(b * S + j) * ZP; att_key(q, zr + kcol, zr + vcol, 0.f, mx, ls, acc); }
            } else {
                const int rows = S / GRID_W, r = t / GRID_W, c = t % GRID_W;
                int r0 = r - 4; r0 = r0 < 0 ? 0 : (r0 > rows - 8 ? rows - 8 : r0);
                int c0 = c - 8; c0 = c0 < 0 ? 0 : (c0 > GRID_W - 16 ? GRID_W - 16 : c0);
                for (int a = 0; a < 8; ++a)
                    for (int e = 0; e < 16; ++e) {
                        const int kr = r0 + a, kc = c0 + e;
                        const float bias = p.c_rpb[(((size_t)l * 6 + hq) * 15 + (kr - r + 7)) * 31 + (kc - c + 15)];
                        const bf16_t* zr = p.Z + (size_t)(b * S + kr * GRID_W + kc) * ZP;
                        att_key(q, zr + kcol, zr + vcol, bias, mx, ls, acc);
                    }
            }
        }
        const float inv = 1.0f / ls;
        bf16_t* o = p.MIX + (size_t)m * DMIX + (isB ? 256 : 640) + hq * 64;
#pragma unroll
        for (int d = 0; d < 64; ++d) o[d] = f2bf(acc[d] * inv);
    }
}

__device__ void ph_post_mixer(const Params& p, int l, int nrows, long gtid, long gsz) {
    for (long mm = gtid; mm < nrows; mm += gsz) {
        const int m = (int)mm;
        const float* xr = xrow_in(p, l, m); const float* md = modrow(p, l, m); const float* orow = p.O + (size_t)m * D;
        float* x1 = (m < TL) ? p.out + (size_t)m * D : p.XC + (size_t)(m - TL) * D;
        const float* g1 = p.ln1_g + (size_t)l * D; const float* b1 = p.ln1_b + (size_t)l * D;
        float s = 0.f; for (int j = 0; j < D; ++j) s += ALPHA * xr[j] + md[2 * D + j] * orow[j];
        float mu = s / D, q = 0.f;
        for (int j = 0; j < D; ++j) { const float d = ALPHA * xr[j] + md[2 * D + j] * orow[j] - mu; q += d * d; }
        float rstd = 1.0f / sqrtf(q / D + LN_EPS);
        s = 0.f;
        for (int j = 0; j < D; ++j) { const float v = (ALPHA * xr[j] + md[2 * D + j] * orow[j] - mu) * rstd * g1[j] + b1[j]; x1[j] = v; s += v; }
        mu = s / D; q = 0.f;
        for (int j = 0; j < D; ++j) { const float d = x1[j] - mu; q += d * d; }
        rstd = 1.0f / sqrtf(q / D + LN_EPS);
        float gl[4], el[32];
#pragma unroll
        for (int g = 0; g < 4; ++g) gl[g] = p.b_rg[l * 4 + g];
#pragma unroll
        for (int e = 0; e < 32; ++e) el[e] = p.b_re[l * 32 + e];
        for (int j = 0; j < D; ++j) {
            const float hv = (x1[j] - mu) * rstd * (1.0f + md[4 * D + j]) + md[3 * D + j];
            p.H[(size_t)m * D + j] = f2bf(hv);
            const float* wg = p.w_rg + ((size_t)l * D + j) * 4; const float* we = p.w_re + ((size_t)l * D + j) * 32;
#pragma unroll
            for (int g = 0; g < 4; ++g) gl[g] += hv * wg[g];
#pragma unroll
            for (int e = 0; e < 32; ++e) el[e] += hv * we[e];
        }
        int gs = 0; float gm = gl[0];
#pragma unroll
        for (int g = 1; g < 4; ++g) if (gl[g] > gm) { gm = gl[g]; gs = g; }
        float den = 0.f;
#pragma unroll
        for (int g = 0; g < 4; ++g) den += expf(gl[g] - gm);
        const float pg = 1.0f / den;
        float v1 = -3e38f, v2 = -3e38f; int i1 = 0, i2 = 0;
#pragma unroll
        for (int j = 0; j < 8; ++j) {
            const float v = gs == 0 ? el[j] : gs == 1 ? el[8 + j] : gs == 2 ? el[16 + j] : el[24 + j];
            if (v > v1) { v2 = v1; i2 = i1; v1 = v; i1 = j; } else if (v > v2) { v2 = v; i2 = j; }
        }
        const float e2 = expf(v2 - v1), w1 = pg / (1.0f + e2), w2 = pg * e2 / (1.0f + e2);
        const int ea = gs * 8 + i1, eb = gs * 8 + i2;
        p.rE[2 * m] = ea; p.rE[2 * m + 1] = eb; p.rW[2 * m] = w1; p.rW[2 * m + 1] = w2;
        p.rPos[2 * m] = atomic_inc_int(p.cnt + l * NEXP + ea); p.rPos[2 * m + 1] = atomic_inc_int(p.cnt + l * NEXP + eb);
    }
}

__device__ __forceinline__ int pstart_of(const int* cnt, int e) {
    int s = 0;
    for (int j = 0; j < NEXP; ++j) if (j < e) s += (cnt[j] + 127) & ~127;
    return s;
}
__device__ void ph_dispatch(const Params& p, int l, int nrows, long gtid, long gsz) {
    for (long i = gtid; i < (long)nrows * 2; i += gsz) {
        const int slot = pstart_of(p.cnt + l * NEXP, p.rE[i]) + p.rPos[i];
        p.rSlot[i] = slot; p.slotTok[slot] = (int)(i >> 1);
    }
}

__device__ void ph_final(const Params& p, int l, int nrows, long gtid, long gsz) {
    for (long mm = gtid; mm < nrows; mm += gsz) {
        const int m = (int)mm;
        float* x1 = (m < TL) ? p.out + (size_t)m * D : p.XC + (size_t)(m - TL) * D;
        const float* md = modrow(p, l, m);
        const float* ya = p.YS + (size_t)p.rSlot[2 * m] * D; const float* yb = p.YS + (size_t)p.rSlot[2 * m + 1] * D;
        const float wa = p.rW[2 * m], wb = p.rW[2 * m + 1];
        const float* g2 = p.ln2_g + (size_t)l * D; const float* b2 = p.ln2_b + (size_t)l * D;
        float s = 0.f; for (int j = 0; j < D; ++j) s += ALPHA * x1[j] + md[5 * D + j] * (wa * ya[j] + wb * yb[j]);
        const float mu = s / D; float q = 0.f;
        for (int j = 0; j < D; ++j) { const float d = ALPHA * x1[j] + md[5 * D + j] * (wa * ya[j] + wb * yb[j]) - mu; q += d * d; }
        const float rstd = 1.0f / sqrtf(q / D + LN_EPS);
        for (int j = 0; j < D; ++j) x1[j] = (ALPHA * x1[j] + md[5 * D + j] * (wa * ya[j] + wb * yb[j]) - mu) * rstd * g2[j] + b2[j];
    }
}

__device__ __forceinline__ int moe_blocks(const int* cnt) { int s = 0; for (int j = 0; j < NEXP; ++j) s += (cnt[j] + 127) >> 7; return s; }
__device__ __forceinline__ int moe_block_expert(const int* cnt, int rb) {
    int s = 0, e = 0;
    for (int j = 0; j < NEXP; ++j) { const int nb = (cnt[j] + 127) >> 7; if (rb >= s && rb < s + nb) e = j; s += nb; }
    return e;
}

#ifdef HOST_EMU
static void host_gemm_in(const Params& p) {
    for (int m = 0; m < T; ++m) for (int n = 0; n < ZP; ++n) { float a = 0.f; for (int k = 0; k < D; ++k) a += bf2f(p.H[(size_t)m * D + k]) * bf2f(p.win_t[(size_t)n * D + k]); p.Z[(size_t)m * ZP + n] = f2bf(a); }
}
static void host_gemm_out(const Params& p, int nrows) {
    for (int m = 0; m < nrows; ++m) for (int n = 0; n < D; ++n) { float a = 0.f; for (int k = 0; k < DMIX; ++k) a += bf2f(p.MIX[(size_t)m * DMIX + k]) * bf2f(p.wout_t[(size_t)n * DMIX + k]); p.O[(size_t)m * D + n] = a; }
}
static void host_moe1(const Params& p, int l) {
    const int* cnt = p.cnt + l * NEXP; const int nrb = moe_blocks(cnt);
    for (int rb = 0; rb < nrb; ++rb) { const int e = moe_block_expert(cnt, rb);
        for (int r = 0; r < 128; ++r) { const int slot = rb * 128 + r; const bf16_t* a = p.H + (size_t)p.slotTok[slot] * D;
            for (int c = 0; c < DE; ++c) { const int q = c >> 4, ii = c & 15; float g = 0.f, u = 0.f;
                const bf16_t* wg = p.wgu_t + ((size_t)e * 2 * DE + 32 * q + ii) * D; const bf16_t* wu = wg + (size_t)16 * D;
                for (int k = 0; k < D; ++k) { g += bf2f(a[k]) * bf2f(wg[k]); u += bf2f(a[k]) * bf2f(wu[k]); }
                p.ACT[(size_t)slot * DE + c] = f2bf(siluf_(g) * u); } } }
}
static void host_moe2(const Params& p, int l) {
    const int* cnt = p.cnt + l * NEXP; const int nrb = moe_blocks(cnt);
    for (int rb = 0; rb < nrb; ++rb) { const int e = moe_block_expert(cnt, rb);
        for (int r = 0; r < 128; ++r) { const int slot = rb * 128 + r;
            for (int n = 0; n < D; ++n) { float a = 0.f; const bf16_t* w = p.wd_t + ((size_t)e * D + n) * DE;
                for (int k = 0; k < DE; ++k) a += bf2f(p.ACT[(size_t)slot * DE + k]) * bf2f(w[k]);
                p.YS[(size_t)slot * D + n] = a; } } }
}
#else
typedef short bf16x8 __attribute__((ext_vector_type(8)));
typedef float f32x4 __attribute__((ext_vector_type(4)));
template <class Epi>
__device__ __forceinline__ void gemm_tile(const bf16_t* a0, const bf16_t* a1, const bf16_t* b0, const bf16_t* b1, int K, char* lds, const Epi& epi) {
    const int tid = threadIdx.x, wid = tid >> 6, lane = tid & 63, wr = wid >> 1, wc = wid & 1, fr = lane & 15, fq = lane >> 4;
    char* SA = lds; char* SB = lds + 8192;
    f32x4 acc[4][4];
#pragma unroll
    for (int m = 0; m < 4; ++m)
#pragma unroll
        for (int n = 0; n < 4; ++n) acc[m][n] = (f32x4){0.f, 0.f, 0.f, 0.f};
    for (int kt = 0; kt < K; kt += 32) {
        __builtin_amdgcn_global_load_lds((const unsigned*)(a0 + kt), (__attribute__((address_space(3))) unsigned*)(SA + tid * 16), 16, 0, 0);
        __builtin_amdgcn_global_load_lds((const unsigned*)(a1 + kt), (__attribute__((address_space(3))) unsigned*)(SA + tid * 16 + 4096), 16, 0, 0);
        __builtin_amdgcn_global_load_lds((const unsigned*)(b0 + kt), (__attribute__((address_space(3))) unsigned*)(SB + tid * 16), 16, 0, 0);
        __builtin_amdgcn_global_load_lds((const unsigned*)(b1 + kt), (__attribute__((address_space(3))) unsigned*)(SB + tid * 16 + 4096), 16, 0, 0);
        asm volatile("s_waitcnt vmcnt(0)" ::: "memory");
        __syncthreads();
        bf16x8 At[4], Bt[4];
#pragma unroll
        for (int m = 0; m < 4; ++m) At[m] = *(const bf16x8*)(SA + (wr * 64 + m * 16 + fr) * 64 + fq * 16);
#pragma unroll
        for (int n = 0; n < 4; ++n) Bt[n] = *(const bf16x8*)(SB + (wc * 64 + n * 16 + fr) * 64 + fq * 16);
#pragma unroll
        for (int m = 0; m < 4; ++m)
#pragma unroll
            for (int n = 0; n < 4; ++n) acc[m][n] = __builtin_amdgcn_mfma_f32_16x16x32_bf16(At[m], Bt[n], acc[m][n], 0, 0, 0);
        __syncthreads();
    }
    epi(acc, wr, wc, fr, fq);
}
#define STG_ROW(i) ((threadIdx.x + (i) * 256) >> 2)
#define STG_K ((threadIdx.x & 3) * 8)

__device__ __forceinline__ void g_gemm_in(const Params& p, char* lds) {
    constexpr int NT = NINP / 128, MT = T / 128;
    for (int tile = blockIdx.x; tile < NT * MT; tile += gridDim.x) {
        const int tm = tile / NT, tn = tile % NT;
        const bf16_t* a0 = p.H + (size_t)(tm * 128 + STG_ROW(0)) * D + STG_K; const bf16_t* a1 = p.H + (size_t)(tm * 128 + STG_ROW(1)) * D + STG_K;
        const bf16_t* b0 = p.win_t + (size_t)(tn * 128 + STG_ROW(0)) * D + STG_K; const bf16_t* b1 = p.win_t + (size_t)(tn * 128 + STG_ROW(1)) * D + STG_K;
        gemm_tile(a0, a1, b0, b1, D, lds, [&](const f32x4 (&acc)[4][4], int wr, int wc, int fr, int fq) {
#pragma unroll
            for (int m = 0; m < 4; ++m)
#pragma unroll
                for (int n = 0; n < 4; ++n) { const int col = tn * 128 + wc * 64 + n * 16 + fr;
                    if (col < ZP) {
#pragma unroll
                        for (int j = 0; j < 4; ++j) p.Z[(size_t)(tm * 128 + wr * 64 + m * 16 + fq * 4 + j) * ZP + col] = f2bf(acc[m][n][j]); } }
        });
    }
}
__device__ __forceinline__ void g_gemm_out(const Params& p, int nrows, char* lds) {
    constexpr int NT = D / 128; const int MT = nrows / 128;
    for (int tile = blockIdx.x; tile < NT * MT; tile += gridDim.x) {
        const int tm = tile / NT, tn = tile % NT;
        const bf16_t* a0 = p.MIX + (size_t)(tm * 128 + STG_ROW(0)) * DMIX + STG_K; const bf16_t* a1 = p.MIX + (size_t)(tm * 128 + STG_ROW(1)) * DMIX + STG_K;
        const bf16_t* b0 = p.wout_t + (size_t)(tn * 128 + STG_ROW(0)) * DMIX + STG_K; const bf16_t* b1 = p.wout_t + (size_t)(tn * 128 + STG_ROW(1)) * DMIX + STG_K;
        gemm_tile(a0, a1, b0, b1, DMIX, lds, [&](const f32x4 (&acc)[4][4], int wr, int wc, int fr, int fq) {
#pragma unroll
            for (int m = 0; m < 4; ++m)
#pragma unroll
                for (int n = 0; n < 4; ++n)
#pragma unroll
                    for (int j = 0; j < 4; ++j) p.O[(size_t)(tm * 128 + wr * 64 + m * 16 + fq * 4 + j) * D + tn * 128 + wc * 64 + n * 16 + fr] = acc[m][n][j];
        });
    }
}
__device__ __forceinline__ void g_moe1(const Params& p, int l, char* lds) {
    const int* cnt = p.cnt + l * NEXP; const int nrb = moe_blocks(cnt); constexpr int NT = 2 * DE / 128;
    for (int tile = blockIdx.x; tile < nrb * NT; tile += gridDim.x) {
        const int rb = tile / NT, tn = tile % NT, e = moe_block_expert(cnt, rb);
        const bf16_t* a0 = p.H + (size_t)p.slotTok[rb * 128 + STG_ROW(0)] * D + STG_K; const bf16_t* a1 = p.H + (size_t)p.slotTok[rb * 128 + STG_ROW(1)] * D + STG_K;
        const bf16_t* bw = p.wgu_t + (size_t)e * 2 * DE * D;
        const bf16_t* b0 = bw + (size_t)(tn * 128 + STG_ROW(0)) * D + STG_K; const bf16_t* b1 = bw + (size_t)(tn * 128 + STG_ROW(1)) * D + STG_K;
        gemm_tile(a0, a1, b0, b1, D, lds, [&](const f32x4 (&acc)[4][4], int wr, int wc, int fr, int fq) {
#pragma unroll
            for (int m = 0; m < 4; ++m)
#pragma unroll
                for (int n2 = 0; n2 < 2; ++n2) { const int col = tn * 64 + wc * 32 + n2 * 16 + fr;
#pragma unroll
                    for (int j = 0; j < 4; ++j) { const float g = acc[m][2 * n2][j], u = acc[m][2 * n2 + 1][j];
                        p.ACT[(size_t)(rb * 128 + wr * 64 + m * 16 + fq * 4 + j) * DE + col] = f2bf(g / (1.0f + __expf(-g)) * u); } }
        });
    }
}
__device__ __forceinline__ void g_moe2(const Params& p, int l, char* lds) {
    const int* cnt = p.cnt + l * NEXP; const int nrb = moe_blocks(cnt); constexpr int NT = D / 128;
    for (int tile = blockIdx.x; tile < nrb * NT; tile += gridDim.x) {
        const int rb = tile / NT, tn = tile % NT, e = moe_block_expert(cnt, rb);
        const bf16_t* a0 = p.ACT + (size_t)(rb * 128 + STG_ROW(0)) * DE + STG_K; const bf16_t* a1 = p.ACT + (size_t)(rb * 128 + STG_ROW(1)) * DE + STG_K;
        const bf16_t* bw = p.wd_t + (size_t)e * D * DE;
        const bf16_t* b0 = bw + (size_t)(tn * 128 + STG_ROW(0)) * DE + STG_K; const bf16_t* b1 = bw + (size_t)(tn * 128 + STG_ROW(1)) * DE + STG_K;
        gemm_tile(a0, a1, b0, b1, DE, lds, [&](const f32x4 (&acc)[4][4], int wr, int wc, int fr, int fq) {
#pragma unroll
            for (int m = 0; m < 4; ++m)
#pragma unroll
                for (int n = 0; n < 4; ++n)
#pragma unroll
                    for (int j = 0; j < 4; ++j) p.YS[(size_t)(rb * 128 + wr * 64 + m * 16 + fq * 4 + j) * D + tn * 128 + wc * 64 + n * 16 + fr] = acc[m][n][j];
        });
    }
}

#define GT ((long)blockIdx.x * blockDim.x + threadIdx.x)
#define GS ((long)gridDim.x * blockDim.x)
__global__ void __launch_bounds__(256) mega_fwd(Params p) {
    __shared__ __attribute__((aligned(16))) char lds[16384];
    cg::grid_group grid = cg::this_grid();
    const long gt = GT, gs = GS;
    ph_prep(p, 0, gt, gs);
    grid.sync();
    for (int l = 0; l < 2; ++l) {
        const int nrows = (l == 0) ? T : TL;
        ph_lnmod(p, l, gt, gs);
        grid.sync();
        g_gemm_in(p, lds);
        grid.sync();
        ph_streams(p, l, gt, gs); ph_rope(p, gt, gs);
        grid.sync();
        ph_scan(p, gt, gs); ph_attn(p, l, nrows, gt, gs);
        grid.sync();
        ph_rwkv_out(p, l, nrows, gt, gs);
        grid.sync();
        g_gemm_out(p, nrows, lds);
        grid.sync();
        ph_post_mixer(p, l, nrows, gt, gs);
        grid.sync();
        ph_dispatch(p, l, nrows, gt, gs);
        grid.sync();
        g_moe1(p, l, lds);
        grid.sync();
        g_moe2(p, l, lds);
        grid.sync();
        ph_final(p, l, nrows, gt, gs);
        if (l == 0) ph_prep(p, 1, gt, gs);
        grid.sync();
    }
}

extern "C" void kernel_launch(void* const* d_in, const int* in_sizes, int n_in, void* d_out, int out_size, void* d_ws, size_t ws_size, hipStream_t stream) {
    if (n_in != 32 || out_size != TL * D || ws_size < WS_NEED) { fprintf(stderr, "kernel_launch: unexpected shapes / workspace (n_in %d out %d ws %zu need %zu)\n", n_in, out_size, ws_size, (size_t)WS_NEED); return; }
    static int grid_blocks = 0;
    if (!grid_blocks) {
        int dev = 0, cus = 0, per_cu = 0;
        (void)hipGetDevice(&dev);
        (void)hipDeviceGetAttribute(&cus, hipDeviceAttributeMultiprocessorCount, dev);
        (void)hipOccupancyMaxActiveBlocksPerMultiprocessor(&per_cu, mega_fwd, 256, 0);
        if (per_cu < 1) per_cu = 1;
        if (per_cu > 4) per_cu = 4;
        grid_blocks = cus * per_cu;
        fprintf(stderr, "kernel_launch: %d CUs x %d blocks\n", cus, per_cu);
    }
    Params p = make_params(d_in, d_out, d_ws);
    void* args[] = {&p};
    hipError_t e = hipLaunchCooperativeKernel((void*)mega_fwd, dim3(grid_blocks), dim3(256), args, 0, stream);
    if (e != hipSuccess) fprintf(stderr, "cooperative launch failed: %s (grid %d)\n", hipGetErrorString(e), grid_blocks);
}
#endif

#ifdef HOST_EMU
static void host_forward(void* const* d_in, void* d_out, void* d_ws) {
    const Params p = make_params(d_in, d_out, d_ws);
    for (int l = 0; l < 2; ++l) {
        const int nrows = (l == 0) ? T : TL;
        ph_prep(p, l, 0, 1); ph_lnmod(p, l, 0, 1); host_gemm_in(p); ph_streams(p, l, 0, 1); ph_rope(p, 0, 1); ph_scan(p, 0, 1);
        ph_attn(p, l, nrows, 0, 1); ph_rwkv_out(p, l, nrows, 0, 1); host_gemm_out(p, nrows); ph_post_mixer(p, l, nrows, 0, 1);
        ph_dispatch(p, l, nrows, 0, 1); host_moe1(p, l); host_moe2(p, l); ph_final(p, l, nrows, 0, 1);
    }
}
#endif
```

```cpp
#ifdef HOST_EMU
#include <cmath>
#include <cstdio>
#include <cstring>
#include <cstdint>
#include <cstdlib>
#define __device__
#define __global__
#define __host__
#define __forceinline__ inline
#else
#include <hip/hip_runtime.h>
#include <hip/hip_cooperative_groups.h>
#include <cstdio>
#include <cstdint>
namespace cg = cooperative_groups;
#endif

#ifndef CFG_D
#define CFG_D 1024
#define CFG_B 8
#define CFG_S 2048
#define CFG_L 256
#define CFG_DE 512
#endif
constexpr int D = CFG_D, NB = CFG_B, S = CFG_S, L = CFG_L, DE = CFG_DE;
constexpr int TL = NB * S, TC = NB * L, T = TL + TC;
constexpr int GRID_W = 64, HD = 64;
constexpr int DA = 256, A_IN = 1184, N_IN = 2976, NINP = 3072, DMIX = 1024;
constexpr int NEXP = 32, NSLOT = 2 * T + NEXP * 128;
constexpr int ZQB = 0, ZKB = 384, ZVB = 512, ZQN = 640, ZKN = 1024, ZVN = 1408, ZA = 1792, ZP = 2976;
constexpr float LN_EPS = 1e-6f, GN_EPS = 64e-5f, ATT_SCALE = 0.125f;
constexpr float ALPHA = 1.41421356237309515f;

typedef unsigned short bf16_t;

__device__ __forceinline__ float bf2f(bf16_t v) {
    unsigned u = ((unsigned)v) << 16; float f;
#ifdef HOST_EMU
    memcpy(&f, &u, 4);
#else
    f = __uint_as_float(u);
#endif
    return f;
}
__device__ __forceinline__ bf16_t f2bf(float f) {
    unsigned u;
#ifdef HOST_EMU
    memcpy(&u, &f, 4);
#else
    u = __float_as_uint(f);
#endif
    return (bf16_t)((u + 0x7fffu + ((u >> 16) & 1u)) >> 16);
}
__device__ __forceinline__ float sigmoidf_(float x) { return 1.0f / (1.0f + expf(-x)); }
__device__ __forceinline__ float siluf_(float x) { return x / (1.0f + expf(-x)); }
__device__ __forceinline__ int atomic_inc_int(int* p) {
#ifdef HOST_EMU
    int o = *p; *p = o + 1; return o;
#else
    return atomicAdd(p, 1);
#endif
}

struct Params {
    const float *x, *c, *ctx, *c_ctx, *w_mod, *b_mod, *w_in, *w_out, *a_shift, *a_w0, *a_w_up, *a_a0, *a_a_up, *a_g_up,
        *a_k_k, *a_k_a, *a_r_k, *a_lnx_g, *a_lnx_b, *b_sink, *c_rpb, *ln1_g, *ln1_b, *ln2_g, *ln2_b, *w_rg, *b_rg, *w_re,
        *b_re, *w_gate, *w_up, *w_down;
    float* out;
    int* cnt;
    float* mod;
    float* rope;
    bf16_t *win_t, *wout_t, *wgu_t, *wd_t;
    bf16_t *wupT, *aupT, *gupT;
    bf16_t* LA;
    float *kT, *kN;
    bf16_t* H;
    bf16_t* Z;
    float *sR, *sV, *sKK, *sG, *sW, *sKD, *sB;
    float* Y;
    bf16_t* MIX;
    float* XC;
    float* O;
    int *rE, *rPos, *rSlot; float* rW;
    int* slotTok;
    bf16_t* ACT;
    float* YS;
};

constexpr size_t al256(size_t v) { return (v + 255) & ~(size_t)255; }
constexpr size_t OFF_CNT = 0;
constexpr size_t OFF_MOD = 4096;
constexpr size_t OFF_ROPE = al256(OFF_MOD + (size_t)2 * (NB + 1) * 6 * D * 4);
constexpr size_t OFF_LORA = al256(OFF_ROPE + 64 * 16 * 2 * 4);
constexpr size_t OFF_WIN = al256(OFF_LORA + (size_t)(2 * 256 * 64 * 2 + 256 * 160) * 2);
constexpr size_t OFF_WOUT = al256(OFF_WIN + (size_t)NINP * D * 2);
constexpr size_t OFF_WGU = al256(OFF_WOUT + (size_t)D * DMIX * 2);
constexpr size_t OFF_WD = al256(OFF_WGU + (size_t)NEXP * 2 * DE * D * 2);
constexpr size_t OFF_H = al256(OFF_WD + (size_t)NEXP * D * DE * 2);
constexpr size_t OFF_Z = al256(OFF_H + (size_t)(T + 1) * D * 2);
constexpr size_t OFF_S = al256(OFF_Z + (size_t)T * ZP * 2);
constexpr size_t S1 = (size_t)T * 256 * 4;
constexpr size_t OFF_Y = al256(OFF_S + 10 * S1);
constexpr size_t OFF_MIX = al256(OFF_Y + 2 * S1);
constexpr size_t OFF_XC = al256(OFF_MIX + (size_t)T * 1024 * 2);
constexpr size_t OFF_ROUTE = al256(OFF_XC + (size_t)TC * D * 4);
constexpr size_t OFF_SLOTTOK = al256(OFF_ROUTE + (size_t)T * 2 * 4 * 4);
constexpr size_t WS_NEED = al256(OFF_SLOTTOK + (size_t)NSLOT * 4);
static_assert((size_t)NSLOT * DE * 2 <= (size_t)T * ZP * 2, "ACT overlays Z");
static_assert((size_t)T * 4 * 4 + (size_t)T * 416 * 2 <= S1, "kN + LA overlay Y[1]");
static_assert((size_t)NSLOT * D * 4 <= 10 * S1 && (size_t)T * D * 4 <= 10 * S1, "YS / O overlay the stream buffers");

static Params make_params(void* const* d_in, void* d_out, void* d_ws) {
    Params p{};
    const float** f = (const float**)&p.x;
    for (int i = 0; i < 32; ++i) f[i] = (const float*)d_in[i];
    p.out = (float*)d_out;
    char* w = (char*)d_ws;
    p.cnt = (int*)(w + OFF_CNT); p.mod = (float*)(w + OFF_MOD); p.rope = (float*)(w + OFF_ROPE);
    p.win_t = (bf16_t*)(w + OFF_WIN); p.wout_t = (bf16_t*)(w + OFF_WOUT); p.wgu_t = (bf16_t*)(w + OFF_WGU); p.wd_t = (bf16_t*)(w + OFF_WD);
    p.wupT = (bf16_t*)(w + OFF_LORA); p.aupT = p.wupT + 2 * 256 * 64; p.gupT = p.aupT + 2 * 256 * 64;
    p.H = (bf16_t*)(w + OFF_H); p.Z = (bf16_t*)(w + OFF_Z);
    float* s = (float*)(w + OFF_S); const size_t n1 = (size_t)T * 256;
    p.sR = s; p.sV = s + n1; p.sKK = s + 2 * n1; p.sG = s + 3 * n1; p.sW = s + 4 * n1; p.sKD = s + 6 * n1; p.sB = s + 8 * n1;
    p.Y = (float*)(w + OFF_Y); p.MIX = (bf16_t*)(w + OFF_MIX); p.XC = (float*)(w + OFF_XC);
    p.O = (float*)(w + OFF_S);
    p.kT = p.Y; p.kN = p.Y + (size_t)T * 256; p.LA = (bf16_t*)(p.Y + (size_t)T * 256 + (size_t)T * 4);
    int* r = (int*)(w + OFF_ROUTE); p.rE = r; p.rPos = r + 2 * T; p.rSlot = r + 4 * T; p.rW = (float*)(r + 6 * T);
    p.slotTok = (int*)(w + OFF_SLOTTOK);
    p.ACT = (bf16_t*)(w + OFF_Z); p.YS = (float*)(w + OFF_S);
    return p;
}

__device__ void ph_prep_w(const Params& p, int l, long gtid, long gsz) {
    for (long i = gtid; i < (long)D * NINP; i += gsz) {
        const int k = (int)(i / NINP), n = (int)(i % NINP);
        float v = 0.f;
        if (n < N_IN) { const int oc = (n < ZA) ? n + A_IN : n - ZA; v = p.w_in[((size_t)l * D + k) * N_IN + oc]; }
        p.win_t[(size_t)n * D + k] = f2bf(v);
    }
    for (long i = gtid; i < (long)DMIX * D; i += gsz) {
        const int k = (int)(i / D), n = (int)(i % D);
        p.wout_t[(size_t)n * DMIX + k] = f2bf(p.w_out[((size_t)l * DMIX + k) * D + n]);
    }
    for (long i = gtid; i < (long)NEXP * D * 2 * DE; i += gsz) {
        const int rho = (int)(i % (2 * DE)); const long t = i / (2 * DE); const int k = (int)(t % D), e = (int)(t / D);
        const int q = rho >> 5, half = (rho >> 4) & 1, ii = rho & 15, cc = 16 * q + ii;
        const float* src = half ? p.w_up : p.w_gate;
        p.wgu_t[((size_t)e * 2 * DE + rho) * D + k] = f2bf(src[(((size_t)l * NEXP + e) * D + k) * DE + cc]);
    }
    for (long i = gtid; i < (long)NEXP * DE * D; i += gsz) {
        const int n = (int)(i % D); const long t = i / D; const int k = (int)(t % DE), e = (int)(t / DE);
        p.wd_t[((size_t)e * D + n) * DE + k] = f2bf(p.w_down[(((size_t)l * NEXP + e) * DE + k) * D + n]);
    }
}
__device__ void ph_prep_misc(const Params& p, int l, long gtid, long gsz) {
    if (l == 0) for (long i = gtid; i < (long)2 * (NB + 1) * 6 * D; i += gsz) {
        const int j = (int)(i % (6 * D)), b = (int)((i / (6 * D)) % (NB + 1)), ll = (int)(i / ((long)6 * D * (NB + 1)));
        const float* cv = (b < NB) ? p.c + (size_t)b * D : p.c_ctx;
        float acc = 0.f;
        for (int k = 0; k < D; ++k) acc += siluf_(cv[k]) * p.w_mod[((size_t)ll * D + k) * 6 * D + j];
        p.mod[((size_t)ll * (NB + 1) + b) * 6 * D + j] = acc + p.b_mod[(size_t)ll * 6 * D + j];
    }
    if (l == 0) for (long i = gtid; i < 64 * 16; i += gsz) {
        const int pos = (int)(i / 16), fi = (int)(i % 16);
        const float inv = powf(10000.0f, -(float)fi / 16.0f), ang = (float)pos * inv;
        p.rope[i] = cosf(ang); p.rope[1024 + i] = sinf(ang);
    }
    for (long i = gtid; i < NEXP; i += gsz) p.cnt[l * NEXP + i] = 0;
    for (long i = gtid; i < NSLOT; i += gsz) p.slotTok[i] = T;
    for (long i = gtid; i < D; i += gsz) p.H[(size_t)T * D + i] = 0;
}

__device__ __forceinline__ const float* xrow_in(const Params& p, int l, int m) {
    if (m < TL) return (l == 0 ? p.x : p.out) + (size_t)m * D;
    return (l == 0 ? p.ctx : p.XC) + (size_t)(m - TL) * D;
}
__device__ __forceinline__ const float* modrow(const Params& p, int l, int m) { return p.mod + ((size_t)l * (NB + 1) + (m < TL ? m / S : NB)) * 6 * D; }

__device__ void ph_lnmod(const Params& p, int l, long gtid, long gsz) {
    for (long m = gtid; m < T; m += gsz) {
        const float* xr = xrow_in(p, l, (int)m); const float* md = modrow(p, l, (int)m);
        float s = 0.f; for (int j = 0; j < D; ++j) s += xr[j];
        const float mu = s / D; float q = 0.f;
        for (int j = 0; j < D; ++j) { const float d = xr[j] - mu; q += d * d; }
        const float rstd = 1.0f / sqrtf(q / D + LN_EPS);
        for (int j = 0; j < D; ++j) p.H[(size_t)m * D + j] = f2bf((xr[j] - mu) * rstd * (1.0f + md[D + j]) + md[j]);
    }
}

__device__ __forceinline__ float zshift(const Params& p, int l, int m, int col) {
    int t, len;
    if (m < TL) { t = m % S; len = S; } else { t = (m - TL) % L; len = L; }
    const float* sh = p.a_shift + (size_t)l * 3 * A_IN;
    const bf16_t* z = p.Z + (size_t)m * ZP + ZA + col;
    float v = sh[A_IN + col] * bf2f(z[0]);
    if (t > 0) v += sh[col] * bf2f(z[-ZP]);
    if (t < len - 1) v += sh[2 * A_IN + col] * bf2f(z[ZP]);
    return v;
}

__device__ void ph_streams(const Params& p, int l, long gtid, long gsz) {
    for (long i = gtid; i < (long)T * DA; i += gsz) {
        const int m = (int)(i / DA), c = (int)(i % DA), h0 = c & ~63;
        const float r = zshift(p, l, m, c), k = zshift(p, l, m, 256 + c), v = zshift(p, l, m, 512 + c);
        float nrm = 0.f;
        for (int j = 0; j < 64; ++j) { const float t = zshift(p, l, m, 256 + h0 + j) * p.a_k_k[l * DA + h0 + j]; nrm += t * t; }
        const float kk = k * p.a_k_k[l * DA + c] / sqrtf(nrm + 1e-12f);
        float g = 0.f;
        for (int j = 0; j < 160; ++j) g += sigmoidf_(zshift(p, l, m, 1024 + j)) * p.a_g_up[((size_t)l * 160 + j) * DA + c];
        const size_t o = (size_t)m * DA + c;
        p.sR[o] = r; p.sV[o] = v; p.sKK[o] = kk; p.sG[o] = g;
        for (int d = 0; d < 2; ++d) {
            float aw = 0.f, aa = 0.f;
            for (int j = 0; j < 64; ++j) {
                aw += tanhf(zshift(p, l, m, 768 + d * 64 + j)) * p.a_w_up[(((size_t)l * 2 + d) * 64 + j) * DA + c];
                aa += zshift(p, l, m, 896 + d * 64 + j) * p.a_a_up[(((size_t)l * 2 + d) * 64 + j) * DA + c];
            }
            const float u = -(p.a_w0[(l * 2 + d) * DA + c] + aw);
            const float sp = (u > 20.f) ? u : log1pf(expf(u));
            const float w = expf(-expf(-sp - 0.5f));
            const float a = sigmoidf_(p.a_a0[(l * 2 + d) * DA + c] + aa);
            const size_t od = ((size_t)d * T + m) * DA + c;
            p.sW[od] = w; p.sKD[od] = k * (1.0f + (a - 1.0f) * p.a_k_a[l * DA + c]); p.sB[od] = kk * a;
        }
    }
}

__device__ void ph_rope(const Params& p, long gtid, long gsz) {
    for (long i = gtid; i < (long)TL * 8 * 32; i += gsz) {
        const int pr = (int)(i & 31), hs = (int)((i >> 5) & 7), m = (int)(i >> 8);
        const int t = m % S, axis = pr >> 4, fi = pr & 15, pos = axis ? (t % GRID_W) : (t / GRID_W);
        bf16_t* z = p.Z + (size_t)m * ZP + hs * 64 + axis * 32 + fi;
        const float cs = p.rope[pos * 16 + fi], sn = p.rope[1024 + pos * 16 + fi];
        const float x0 = bf2f(z[0]), x1 = bf2f(z[16]);
        z[0] = f2bf(x0 * cs - x1 * sn); z[16] = f2bf(x1 * cs + x0 * sn);
    }
}

__device__ void ph_scan(const Params& p, long gtid, long gsz) {
    for (long i = gtid; i < (long)2 * NB * 4 * 64; i += gsz) {
        const int v = (int)(i & 63), h = (int)((i >> 6) & 3), b = (int)((i >> 8) % NB), d = (int)((i >> 8) / NB);
        float st[64];
#pragma unroll
        for (int k = 0; k < 64; ++k) st[k] = 0.f;
        for (int pos = 0; pos < L + S; ++pos) {
            int m;
            if (pos < L) m = TL + b * L + (d ? L - 1 - pos : pos);
            else m = b * S + (d ? S - 1 - (pos - L) : pos - L);
            const size_t o = (size_t)m * DA + h * 64, od = ((size_t)d * T + m) * DA + h * 64;
            const float* kk = p.sKK + o; const float* r = p.sR + o;
            const float* w = p.sW + od; const float* bb = p.sB + od; const float* kd = p.sKD + od;
            const float vv = p.sV[o + v];
            float sk = 0.f;
#pragma unroll
            for (int k = 0; k < 64; ++k) sk += st[k] * kk[k];
            float y = 0.f;
#pragma unroll
            for (int k = 0; k < 64; ++k) { st[k] = st[k] * w[k] - sk * bb[k] + vv * kd[k]; y += st[k] * r[k]; }
            p.Y[od + v] = y;
        }
    }
}

__device__ void ph_rwkv_out(const Params& p, int l, int nrows, long gtid, long gsz) {
    for (long i = gtid; i < (long)nrows * 4; i += gsz) {
        const int m = (int)(i >> 2), h = (int)(i & 3);
        const size_t o = (size_t)m * DA + h * 64;
        const float* y0 = p.Y + o; const float* y1 = p.Y + (size_t)T * DA + o;
        float s = 0.f, bon = 0.f;
        for (int n = 0; n < 64; ++n) {
            s += y0[n] + y1[n];
            bon += p.sR[o + n] * (p.sKD[o + n] + p.sKD[(size_t)T * DA + o + n]) * p.a_r_k[l * DA + h * 64 + n];
        }
        const float mu = s / 64.f; float q = 0.f;
        for (int n = 0; n < 64; ++n) { const float dd = y0[n] + y1[n] - mu; q += dd * dd; }
        const float rstd = 1.0f / sqrtf(q / 64.f + GN_EPS);
        for (int n = 0; n < 64; ++n) {
            const int c = h * 64 + n;
            const float yn = (y0[n] + y1[n] - mu) * rstd * p.a_lnx_g[l * DA + c] + p.a_lnx_b[l * DA + c];
            p.MIX[(size_t)m * DMIX + c] = f2bf((yn + bon * p.sV[o + n]) * p.sG[o + n]);
        }
    }
}

__device__ __forceinline__ void att_key(const float (&q)[64], const bf16_t* kr, const bf16_t* vr, float bias, float& mx, float& ls, float (&acc)[64]) {
    float s = 0.f;
#pragma unroll
    for (int d = 0; d < 64; ++d) s += q[d] * bf2f(kr[d]);
    s = s * ATT_SCALE + bias;
    const float mn = fmaxf(mx, s), f = expf(mx - mn), pe = expf(s - mn);
    ls = ls * f + pe;
#pragma unroll
    for (int d = 0; d < 64; ++d) acc[d] = acc[d] * f + pe * bf2f(vr[d]);
    mx = mn;
}

__device__ void ph_attn(const Params& p, int l, int nrows, long gtid, long gsz) {
    for (long i = gtid; i < (long)nrows * 12; i += gsz) {
        const int m = (int)(i / 12), u = (int)(i % 12);
        const bool isB = u < 6; const int hq = isB ? u : u - 6;
        const int b = (m < TL) ? m / S : (m - TL) / L;
        const int qcol = isB ? ZQB + hq * 64 : ZQN + hq * 64;
        const int kcol = isB ? ZKB + (hq / 3) * 64 : ZKN + hq * 64;
        const int vcol = isB ? ZVB + (hq / 3) * 64 : ZVN + hq * 64;
        float q[64], acc[64];
        const bf16_t* qr = p.Z + (size_t)m * ZP + qcol;
#pragma unroll
        for (int d = 0; d < 64; ++d) { q[d] = bf2f(qr[d]); acc[d] = 0.f; }
        float mx, ls;
        if (isB) { mx = p.b_sink[l * 6 + hq]; ls = 1.0f; } else { mx = -1e30f; ls = 0.f; }
        for (int j = 0; j < L; ++j) { const bf16_t* zr = p.Z + (size_t)(TL + b * L + j) * ZP; att_key(q, zr + kcol, zr + vcol, 0.f, mx, ls, acc); }
        if (m < TL) {
            const int t = m % S;
            if (isB) {
                const int j0 = t - 128 < 0 ? 0 : t - 128, j1 = t + 128 > S - 1 ? S - 1 : t + 128;
                for (int j = j0; j <= j1; ++j) { const bf16_t* zr = p.Z + (size_t)(b * S + j) * ZP; att_key(q, zr + kcol, zr + vcol, 0.f, mx, ls, acc); }
            } else {
                const int rows = S / GRID_W, r = t / GRID_W, c = t % GRID_W;
                int r0 = r - 4; r0 = r0 < 0 ? 0 : (r0 > rows - 8 ? rows - 8 : r0);
                int c0 = c - 8; c0 = c0 < 0 ? 0 : (c0 > GRID_W - 16 ? GRID_W - 16 : c0);
                for (int a = 0; a < 8; ++a)
                    for (int e = 0; e < 16; ++e) {
                        const int kr = r0 + a, kc = c0 + e;
                        const float bias = p.c_rpb[(((size_t)l * 6 + hq) * 15 + (kr - r + 7)) * 31 + (kc - c + 15)];
                        const bf16_t* zr = p.Z + (size_t)(b * S + kr * GRID_W + kc) * ZP;
                        att_key(q, zr + kcol, zr + vcol, bias, mx, ls, acc);
                    }
            }
        }
        const float inv = 1.0f / ls;
        bf16_t* o = p.MIX + (size_t)m * DMIX + (isB ? 256 : 640) + hq * 64;
#pragma unroll
        for (int d = 0; d < 64; ++d) o[d] = f2bf(acc[d] * inv);
    }
}

__device__ void ph_post_mixer(const Params& p, int l, int nrows, long gtid, long gsz) {
    for (long mm = gtid; mm < nrows; mm += gsz) {
        const int m = (int)mm;
        const float* xr = xrow_in(p, l, m); const float* md = modrow(p, l, m); const float* orow = p.O + (size_t)m * D;
        float* x1 = (m < TL) ? p.out + (size_t)m * D : p.XC + (size_t)(m - TL) * D;
        const float* g1 = p.ln1_g + (size_t)l * D; const float* b1 = p.ln1_b + (size_t)l * D;
        float s = 0.f; for (int j = 0; j < D; ++j) s += ALPHA * xr[j] + md[2 * D + j] * orow[j];
        float mu = s / D, q = 0.f;
        for (int j = 0; j < D; ++j) { const float d = ALPHA * xr[j] + md[2 * D + j] * orow[j] - mu; q += d * d; }
        float rstd = 1.0f / sqrtf(q / D + LN_EPS);
        s = 0.f;
        for (int j = 0; j < D; ++j) { const float v = (ALPHA * xr[j] + md[2 * D + j] * orow[j] - mu) * rstd * g1[j] + b1[j]; x1[j] = v; s += v; }
        mu = s / D; q = 0.f;
        for (int j = 0; j < D; ++j) { const float d = x1[j] - mu; q += d * d; }
        rstd = 1.0f / sqrtf(q / D + LN_EPS);
        float gl[4], el[32];
#pragma unroll
        for (int g = 0; g < 4; ++g) gl[g] = p.b_rg[l * 4 + g];
#pragma unroll
        for (int e = 0; e < 32; ++e) el[e] = p.b_re[l * 32 + e];
        for (int j = 0; j < D; ++j) {
            const float hv = (x1[j] - mu) * rstd * (1.0f + md[4 * D + j]) + md[3 * D + j];
            p.H[(size_t)m * D + j] = f2bf(hv);
            const float* wg = p.w_rg + ((size_t)l * D + j) * 4; const float* we = p.w_re + ((size_t)l * D + j) * 32;
#pragma unroll
            for (int g = 0; g < 4; ++g) gl[g] += hv * wg[g];
#pragma unroll
            for (int e = 0; e < 32; ++e) el[e] += hv * we[e];
        }
        int gs = 0; float gm = gl[0];
#pragma unroll
        for (int g = 1; g < 4; ++g) if (gl[g] > gm) { gm = gl[g]; gs = g; }
        float den = 0.f;
#pragma unroll
        for (int g = 0; g < 4; ++g) den += expf(gl[g] - gm);
        const float pg = 1.0f / den;
        float v1 = -3e38f, v2 = -3e38f; int i1 = 0, i2 = 0;
#pragma unroll
        for (int j = 0; j < 8; ++j) {
            const float v = gs == 0 ? el[j] : gs == 1 ? el[8 + j] : gs == 2 ? el[16 + j] : el[24 + j];
            if (v > v1) { v2 = v1; i2 = i1; v1 = v; i1 = j; } else if (v > v2) { v2 = v; i2 = j; }
        }
        const float e2 = expf(v2 - v1), w1 = pg / (1.0f + e2), w2 = pg * e2 / (1.0f + e2);
        const int ea = gs * 8 + i1, eb = gs * 8 + i2;
        p.rE[2 * m] = ea; p.rE[2 * m + 1] = eb; p.rW[2 * m] = w1; p.rW[2 * m + 1] = w2;
        p.rPos[2 * m] = atomic_inc_int(p.cnt + l * NEXP + ea); p.rPos[2 * m + 1] = atomic_inc_int(p.cnt + l * NEXP + eb);
    }
}

__device__ __forceinline__ int pstart_of(const int* cnt, int e) {
    int s = 0;
    for (int j = 0; j < NEXP; ++j) if (j < e) s += (cnt[j] + 127) & ~127;
    return s;
}
__device__ void ph_dispatch(const Params& p, int l, int nrows, long gtid, long gsz) {
    for (long i = gtid; i < (long)nrows * 2; i += gsz) {
        const int slot = pstart_of(p.cnt + l * NEXP, p.rE[i]) + p.rPos[i];
        p.rSlot[i] = slot; p.slotTok[slot] = (int)(i >> 1);
    }
}

__device__ void ph_final(const Params& p, int l, int nrows, long gtid, long gsz) {
    for (long mm = gtid; mm < nrows; mm += gsz) {
        const int m = (int)mm;
        float* x1 = (m < TL) ? p.out + (size_t)m * D : p.XC + (size_t)(m - TL) * D;
        const float* md = modrow(p, l, m);
        const float* ya = p.YS + (size_t)p.rSlot[2 * m] * D; const float* yb = p.YS + (size_t)p.rSlot[2 * m + 1] * D;
        const float wa = p.rW[2 * m], wb = p.rW[2 * m + 1];
        const float* g2 = p.ln2_g + (size_t)l * D; const float* b2 = p.ln2_b + (size_t)l * D;
        float s = 0.f; for (int j = 0; j < D; ++j) s += ALPHA * x1[j] + md[5 * D + j] * (wa * ya[j] + wb * yb[j]);
        const float mu = s / D; float q = 0.f;
        for (int j = 0; j < D; ++j) { const float d = ALPHA * x1[j] + md[5 * D + j] * (wa * ya[j] + wb * yb[j]) - mu; q += d * d; }
        const float rstd = 1.0f / sqrtf(q / D + LN_EPS);
        for (int j = 0; j < D; ++j) x1[j] = (ALPHA * x1[j] + md[5 * D + j] * (wa * ya[j] + wb * yb[j]) - mu) * rstd * g2[j] + b2[j];
    }
}

__device__ __forceinline__ int moe_blocks(const int* cnt) { int s = 0; for (int j = 0; j < NEXP; ++j) s += (cnt[j] + 127) >> 7; return s; }
__device__ __forceinline__ int moe_block_expert(const int* cnt, int rb) {
    int s = 0, e = 0;
    for (int j = 0; j < NEXP; ++j) { const int nb = (cnt[j] + 127) >> 7; if (rb >= s && rb < s + nb) e = j; s += nb; }
    return e;
}

#ifdef HOST_EMU
static void host_gemm_in(const Params& p) {
    for (int m = 0; m < T; ++m) for (int n = 0; n < ZP; ++n) { float a = 0.f; for (int k = 0; k < D; ++k) a += bf2f(p.H[(size_t)m * D + k]) * bf2f(p.win_t[(size_t)n * D + k]); p.Z[(size_t)m * ZP + n] = f2bf(a); }
}
static void host_gemm_out(const Params& p, int nrows) {
    for (int m = 0; m < nrows; ++m) for (int n = 0; n < D; ++n) { float a = 0.f; for (int k = 0; k < DMIX; ++k) a += bf2f(p.MIX[(size_t)m * DMIX + k]) * bf2f(p.wout_t[(size_t)n * DMIX + k]); p.O[(size_t)m * D + n] = a; }
}
static void host_moe1(const Params& p, int l) {
    const int* cnt = p.cnt + l * NEXP; const int nrb = moe_blocks(cnt);
    for (int rb = 0; rb < nrb; ++rb) { const int e = moe_block_expert(cnt, rb);
        for (int r = 0; r < 128; ++r) { const int slot = rb * 128 + r; const bf16_t* a = p.H + (size_t)p.slotTok[slot] * D;
            for (int c = 0; c < DE; ++c) { const int q = c >> 4, ii = c & 15; float g = 0.f, u = 0.f;
                const bf16_t* wg = p.wgu_t + ((size_t)e * 2 * DE + 32 * q + ii) * D; const bf16_t* wu = wg + (size_t)16 * D;
                for (int k = 0; k < D; ++k) { g += bf2f(a[k]) * bf2f(wg[k]); u += bf2f(a[k]) * bf2f(wu[k]); }
                p.ACT[(size_t)slot * DE + c] = f2bf(siluf_(g) * u); } } }
}
static void host_moe2(const Params& p, int l) {
    const int* cnt = p.cnt + l * NEXP; const int nrb = moe_blocks(cnt);
    for (int rb = 0; rb < nrb; ++rb) { const int e = moe_block_expert(cnt, rb);
        for (int r = 0; r < 128; ++r) { const int slot = rb * 128 + r;
            for (int n = 0; n < D; ++n) { float a = 0.f; const bf16_t* w = p.wd_t + ((size_t)e * D + n) * DE;
                for (int k = 0; k < DE; ++k) a += bf2f(p.ACT[(size_t)slot * DE + k]) * bf2f(w[k]);
                p.YS[(size_t)slot * D + n] = a; } } }
}
#else
typedef short bf16x8 __attribute__((ext_vector_type(8)));
typedef float f32x4 __attribute__((ext_vector_type(4)));
template <class Epi>
__device__ __forceinline__ void gemm_tile(const bf16_t* a0, const bf16_t* a1, const bf16_t* b0, const bf16_t* b1, int K, char* lds, const Epi& epi) {
    const int tid = threadIdx.x, wid = tid >> 6, lane = tid & 63, wr = wid >> 1, wc = wid & 1, fr = lane & 15, fq = lane >> 4;
    char* SA = lds; char* SB = lds + 8192;
    f32x4 acc[4][4];
#pragma unroll
    for (int m = 0; m < 4; ++m)
#pragma unroll
        for (int n = 0; n < 4; ++n) acc[m][n] = (f32x4){0.f, 0.f, 0.f, 0.f};
    for (int kt = 0; kt < K; kt += 32) {
        __builtin_amdgcn_global_load_lds((const unsigned*)(a0 + kt), (__attribute__((address_space(3))) unsigned*)(SA + tid * 16), 16, 0, 0);
        __builtin_amdgcn_global_load_lds((const unsigned*)(a1 + kt), (__attribute__((address_space(3))) unsigned*)(SA + tid * 16 + 4096), 16, 0, 0);
        __builtin_amdgcn_global_load_lds((const unsigned*)(b0 + kt), (__attribute__((address_space(3))) unsigned*)(SB + tid * 16), 16, 0, 0);
        __builtin_amdgcn_global_load_lds((const unsigned*)(b1 + kt), (__attribute__((address_space(3))) unsigned*)(SB + tid * 16 + 4096), 16, 0, 0);
        asm volatile("s_waitcnt vmcnt(0)" ::: "memory");
        __syncthreads();
        bf16x8 At[4], Bt[4];
#pragma unroll
        for (int m = 0; m < 4; ++m) At[m] = *(const bf16x8*)(SA + (wr * 64 + m * 16 + fr) * 64 + fq * 16);
#pragma unroll
        for (int n = 0; n < 4; ++n) Bt[n] = *(const bf16x8*)(SB + (wc * 64 + n * 16 + fr) * 64 + fq * 16);
#pragma unroll
        for (int m = 0; m < 4; ++m)
#pragma unroll
            for (int n = 0; n < 4; ++n) acc[m][n] = __builtin_amdgcn_mfma_f32_16x16x32_bf16(At[m], Bt[n], acc[m][n], 0, 0, 0);
        __syncthreads();
    }
    epi(acc, wr, wc, fr, fq);
}
#define STG_ROW(i) ((threadIdx.x + (i) * 256) >> 2)
#define STG_K ((threadIdx.x & 3) * 8)

__device__ __forceinline__ void g_gemm_in(const Params& p, char* lds) {
    constexpr int NT = NINP / 128, MT = T / 128;
    for (int tile = blockIdx.x; tile < NT * MT; tile += gridDim.x) {
        const int tm = tile / NT, tn = tile % NT;
        const bf16_t* a0 = p.H + (size_t)(tm * 128 + STG_ROW(0)) * D + STG_K; const bf16_t* a1 = p.H + (size_t)(tm * 128 + STG_ROW(1)) * D + STG_K;
        const bf16_t* b0 = p.win_t + (size_t)(tn * 128 + STG_ROW(0)) * D + STG_K; const bf16_t* b1 = p.win_t + (size_t)(tn * 128 + STG_ROW(1)) * D + STG_K;
        gemm_tile(a0, a1, b0, b1, D, lds, [&](const f32x4 (&acc)[4][4], int wr, int wc, int fr, int fq) {
#pragma unroll
            for (int m = 0; m < 4; ++m)
#pragma unroll
                for (int n = 0; n < 4; ++n) { const int col = tn * 128 + wc * 64 + n * 16 + fr;
                    if (col < ZP) {
#pragma unroll
                        for (int j = 0; j < 4; ++j) p.Z[(size_t)(tm * 128 + wr * 64 + m * 16 + fq * 4 + j) * ZP + col] = f2bf(acc[m][n][j]); } }
        });
    }
}
__device__ __forceinline__ void g_gemm_out(const Params& p, int nrows, char* lds) {
    constexpr int NT = D / 128; const int MT = nrows / 128;
    for (int tile = blockIdx.x; tile < NT * MT; tile += gridDim.x) {
        const int tm = tile / NT, tn = tile % NT;
        const bf16_t* a0 = p.MIX + (size_t)(tm * 128 + STG_ROW(0)) * DMIX + STG_K; const bf16_t* a1 = p.MIX + (size_t)(tm * 128 + STG_ROW(1)) * DMIX + STG_K;
        const bf16_t* b0 = p.wout_t + (size_t)(tn * 128 + STG_ROW(0)) * DMIX + STG_K; const bf16_t* b1 = p.wout_t + (size_t)(tn * 128 + STG_ROW(1)) * DMIX + STG_K;
        gemm_tile(a0, a1, b0, b1, DMIX, lds, [&](const f32x4 (&acc)[4][4], int wr, int wc, int fr, int fq) {
#pragma unroll
            for (int m = 0; m < 4; ++m)
#pragma unroll
                for (int n = 0; n < 4; ++n)
#pragma unroll
                    for (int j = 0; j < 4; ++j) p.O[(size_t)(tm * 128 + wr * 64 + m * 16 + fq * 4 + j) * D + tn * 128 + wc * 64 + n * 16 + fr] = acc[m][n][j];
        });
    }
}
__device__ __forceinline__ void g_moe1(const Params& p, int l, char* lds) {
    const int* cnt = p.cnt + l * NEXP; const int nrb = moe_blocks(cnt); constexpr int NT = 2 * DE / 128;
    for (int tile = blockIdx.x; tile < nrb * NT; tile += gridDim.x) {
        const int rb = tile / NT, tn = tile % NT, e = moe_block_expert(cnt, rb);
        const bf16_t* a0 = p.H + (size_t)p.slotTok[rb * 128 + STG_ROW(0)] * D + STG_K; const bf16_t* a1 = p.H + (size_t)p.slotTok[rb * 128 + STG_ROW(1)] * D + STG_K;
        const bf16_t* bw = p.wgu_t + (size_t)e * 2 * DE * D;
        const bf16_t* b0 = bw + (size_t)(tn * 128 + STG_ROW(0)) * D + STG_K; const bf16_t* b1 = bw + (size_t)(tn * 128 + STG_ROW(1)) * D + STG_K;
        gemm_tile(a0, a1, b0, b1, D, lds, [&](const f32x4 (&acc)[4][4], int wr, int wc, int fr, int fq) {
#pragma unroll
            for (int m = 0; m < 4; ++m)
#pragma unroll
                for (int n2 = 0; n2 < 2; ++n2) { const int col = tn * 64 + wc * 32 + n2 * 16 + fr;
#pragma unroll
                    for (int j = 0; j < 4; ++j) { const float g = acc[m][2 * n2][j], u = acc[m][2 * n2 + 1][j];
                        p.ACT[(size_t)(rb * 128 + wr * 64 + m * 16 + fq * 4 + j) * DE + col] = f2bf(g / (1.0f + __expf(-g)) * u); } }
        });
    }
}
__device__ __forceinline__ void g_moe2(const Params& p, int l, char* lds) {
    const int* cnt = p.cnt + l * NEXP; const int nrb = moe_blocks(cnt); constexpr int NT = D / 128;
    for (int tile = blockIdx.x; tile < nrb * NT; tile += gridDim.x) {
        const int rb = tile / NT, tn = tile % NT, e = moe_block_expert(cnt, rb);
        const bf16_t* a0 = p.ACT + (size_t)(rb * 128 + STG_ROW(0)) * DE + STG_K; const bf16_t* a1 = p.ACT + (size_t)(rb * 128 + STG_ROW(1)) * DE + STG_K;
        const bf16_t* bw = p.wd_t + (size_t)e * D * DE;
        const bf16_t* b0 = bw + (size_t)(tn * 128 + STG_ROW(0)) * DE + STG_K; const bf16_t* b1 = bw + (size_t)(tn * 128 + STG_ROW(1)) * DE + STG_K;
        gemm_tile(a0, a1, b0, b1, DE, lds, [&](const f32x4 (&acc)[4][4], int wr, int wc, int fr, int fq) {
#pragma unroll
            for (int m = 0; m < 4; ++m)
#pragma unroll
                for (int n = 0; n < 4; ++n)
#pragma unroll
                    for (int j = 0; j < 4; ++j) p.YS[(size_t)(rb * 128 + wr * 64 + m * 16 + fq * 4 + j) * D + tn * 128 + wc * 64 + n * 16 + fr] = acc[m][n][j];
        });
    }
}


constexpr int DV = D / 256;
static_assert(D % 256 == 0, "row phases hold a row as DV float4 per lane");
__device__ __forceinline__ float wave_sum(float v) {
#pragma unroll
    for (int o = 1; o < 64; o <<= 1) v += __shfl_xor(v, o);
    return v;
}
__device__ __forceinline__ float sum4(f32x4 a) { return (a[0] + a[1]) + (a[2] + a[3]); }
__device__ __forceinline__ unsigned pk2(float lo, float hi) { return (unsigned)f2bf(lo) | ((unsigned)f2bf(hi) << 16); }
struct u32x2_t { unsigned x, y; };
__device__ __forceinline__ void st_bf16x4(bf16_t* dst, f32x4 v) { u32x2_t o; o.x = pk2(v[0], v[1]); o.y = pk2(v[2], v[3]); *(u32x2_t*)dst = o; }
#define LDS_WAIT() asm volatile("s_waitcnt lgkmcnt(0)" ::: "memory")

__device__ __forceinline__ void row_stats(const f32x4 (&v)[DV], float& mu, float& rstd) {
    float s = 0.f;
#pragma unroll
    for (int j = 0; j < DV; ++j) s += sum4(v[j]);
    mu = wave_sum(s) * (1.0f / D);
    float q = 0.f;
#pragma unroll
    for (int j = 0; j < DV; ++j) { const f32x4 d = v[j] - mu; q += sum4(d * d); }
    rstd = 1.0f / sqrtf(wave_sum(q) * (1.0f / D) + LN_EPS);
}

__device__ void ph_lnmod_fast(const Params& p, int l) {
    const int lane = threadIdx.x & 63, gw = blockIdx.x * 4 + (threadIdx.x >> 6), nw = gridDim.x * 4;
    for (int m = gw; m < T; m += nw) {
        const f32x4* xr = (const f32x4*)xrow_in(p, l, m) + lane; const f32x4* md = (const f32x4*)modrow(p, l, m) + lane;
        f32x4 v[DV];
#pragma unroll
        for (int j = 0; j < DV; ++j) v[j] = xr[64 * j];
        float mu, rstd; row_stats(v, mu, rstd);
#pragma unroll
        for (int j = 0; j < DV; ++j) { const f32x4 sh = md[64 * j], sc = md[D / 4 + 64 * j];
            st_bf16x4(p.H + (size_t)m * D + 4 * (lane + 64 * j), (v[j] - mu) * rstd * (sc + 1.0f) + sh); }
    }
}

__device__ void ph_post_mixer_fast(const Params& p, int l, int nrows) {
    const int lane = threadIdx.x & 63, gw = blockIdx.x * 4 + (threadIdx.x >> 6), nw = gridDim.x * 4;
    for (int m = gw; m < nrows; m += nw) {
        const f32x4* xr = (const f32x4*)xrow_in(p, l, m) + lane; const f32x4* md = (const f32x4*)modrow(p, l, m) + lane;
        const f32x4* orow = (const f32x4*)(p.O + (size_t)m * D) + lane;
        f32x4* x1 = (f32x4*)((m < TL) ? p.out + (size_t)m * D : p.XC + (size_t)(m - TL) * D) + lane;
        const f32x4* g1 = (const f32x4*)(p.ln1_g + (size_t)l * D) + lane; const f32x4* b1 = (const f32x4*)(p.ln1_b + (size_t)l * D) + lane;
        f32x4 v[DV];
#pragma unroll
        for (int j = 0; j < DV; ++j) v[j] = xr[64 * j] * ALPHA + md[2 * (D / 4) + 64 * j] * orow[64 * j];
        float mu, rstd; row_stats(v, mu, rstd);
#pragma unroll
        for (int j = 0; j < DV; ++j) { v[j] = (v[j] - mu) * rstd * g1[64 * j] + b1[64 * j]; x1[64 * j] = v[j]; }
        row_stats(v, mu, rstd);
        float gl[4], el[32];
#pragma unroll
        for (int g = 0; g < 4; ++g) gl[g] = 0.f;
#pragma unroll
        for (int e = 0; e < 32; ++e) el[e] = 0.f;
#pragma unroll
        for (int j = 0; j < DV; ++j) {
            const f32x4 hv = (v[j] - mu) * rstd * (md[4 * (D / 4) + 64 * j] + 1.0f) + md[3 * (D / 4) + 64 * j];
            st_bf16x4(p.H + (size_t)m * D + 4 * (lane + 64 * j), hv);
#pragma unroll
            for (int i = 0; i < 4; ++i) {
                const int k = 4 * (lane + 64 * j) + i;
                const f32x4 wg = *(const f32x4*)(p.w_rg + ((size_t)l * D + k) * 4);
#pragma unroll
                for (int g = 0; g < 4; ++g) gl[g] += hv[i] * wg[g];
                const f32x4* we = (const f32x4*)(p.w_re + ((size_t)l * D + k) * 32);
#pragma unroll
                for (int e4 = 0; e4 < 8; ++e4) { const f32x4 w = we[e4];
#pragma unroll
                    for (int g = 0; g < 4; ++g) el[4 * e4 + g] += hv[i] * w[g]; }
            }
        }
#pragma unroll
        for (int g = 0; g < 4; ++g) gl[g] = wave_sum(gl[g]) + p.b_rg[l * 4 + g];
#pragma unroll
        for (int e = 0; e < 32; ++e) el[e] = wave_sum(el[e]) + p.b_re[l * 32 + e];
        int gs = 0; float gm = gl[0];
#pragma unroll
        for (int g = 1; g < 4; ++g) if (gl[g] > gm) { gm = gl[g]; gs = g; }
        float den = 0.f;
#pragma unroll
        for (int g = 0; g < 4; ++g) den += expf(gl[g] - gm);
        const float pg = 1.0f / den;
        float v1 = -3e38f, v2 = -3e38f; int i1 = 0, i2 = 0;
#pragma unroll
        for (int j = 0; j < 8; ++j) {
            const float vv = gs == 0 ? el[j] : gs == 1 ? el[8 + j] : gs == 2 ? el[16 + j] : el[24 + j];
            if (vv > v1) { v2 = v1; i2 = i1; v1 = vv; i1 = j; } else if (vv > v2) { v2 = vv; i2 = j; }
        }
        if (lane == 0) {
            const float e2 = expf(v2 - v1), w1 = pg / (1.0f + e2), w2 = pg * e2 / (1.0f + e2);
            const int ea = gs * 8 + i1, eb = gs * 8 + i2;
            p.rE[2 * m] = ea; p.rE[2 * m + 1] = eb; p.rW[2 * m] = w1; p.rW[2 * m + 1] = w2;
            p.rPos[2 * m] = atomicAdd(p.cnt + l * NEXP + ea, 1); p.rPos[2 * m + 1] = atomicAdd(p.cnt + l * NEXP + eb, 1);
        }
    }
}

__device__ void ph_final_fast(const Params& p, int l, int nrows) {
    const int lane = threadIdx.x & 63, gw = blockIdx.x * 4 + (threadIdx.x >> 6), nw = gridDim.x * 4;
    for (int m = gw; m < nrows; m += nw) {
        f32x4* x1 = (f32x4*)((m < TL) ? p.out + (size_t)m * D : p.XC + (size_t)(m - TL) * D) + lane;
        const f32x4* md = (const f32x4*)modrow(p, l, m) + lane;
        const f32x4* ya = (const f32x4*)(p.YS + (size_t)p.rSlot[2 * m] * D) + lane; const f32x4* yb = (const f32x4*)(p.YS + (size_t)p.rSlot[2 * m + 1] * D) + lane;
        const float wa = p.rW[2 * m], wb = p.rW[2 * m + 1];
        const f32x4* g2 = (const f32x4*)(p.ln2_g + (size_t)l * D) + lane; const f32x4* b2 = (const f32x4*)(p.ln2_b + (size_t)l * D) + lane;
        f32x4 v[DV];
#pragma unroll
        for (int j = 0; j < DV; ++j) v[j] = x1[64 * j] * ALPHA + md[5 * (D / 4) + 64 * j] * (ya[64 * j] * wa + yb[64 * j] * wb);
        float mu, rstd; row_stats(v, mu, rstd);
#pragma unroll
        for (int j = 0; j < DV; ++j) x1[64 * j] = (v[j] - mu) * rstd * g2[64 * j] + b2[64 * j];
    }
}

__device__ __forceinline__ void tr_item(const float* srcl, size_t ldw, bf16_t* dst, size_t ldd, float* scr, int lane) {
#pragma unroll 8
    for (int i = 0; i < 32; ++i) { const int kk = 2 * i + (lane >> 5); scr[kk * 33 + (lane & 31)] = srcl ? srcl[(size_t)kk * ldw] : 0.f; }
    LDS_WAIT();
    const int c = lane & 7;
#pragma unroll
    for (int j = 0; j < 4; ++j) { const int n = (lane >> 3) + 8 * j; const float* s = scr + (8 * c) * 33 + n;
        uint4 o; o.x = pk2(s[0], s[33]); o.y = pk2(s[2 * 33], s[3 * 33]); o.z = pk2(s[4 * 33], s[5 * 33]); o.w = pk2(s[6 * 33], s[7 * 33]);
        *(uint4*)(dst + (size_t)n * ldd + 8 * c) = o; }
    LDS_WAIT();
}
__device__ void ph_prep_w_fast(const Params& p, int l, char* lds) {
    const int lane = threadIdx.x & 63, wid = threadIdx.x >> 6, gw = blockIdx.x * 4 + wid, nw = gridDim.x * 4;
    float* scr = (float*)(lds + wid * 8448);
    constexpr int I_IN = (D / 64) * (NINP / 32), I_OUT = (DMIX / 64) * (D / 32), I_GU1 = (D / 64) * (2 * DE / 32), I_D1 = (DE / 64) * (D / 32);
    constexpr int NITEMS = I_IN + I_OUT + NEXP * (I_GU1 + I_D1);
    for (int it = gw; it < NITEMS; it += nw) {
        int r = it;
        if (r < I_IN) { const int kb = r / (NINP / 32), n0 = 32 * (r % (NINP / 32));
            const float* s = nullptr;
            if (n0 < N_IN) { const int oc = (n0 < ZA) ? n0 + A_IN : n0 - ZA; s = p.w_in + ((size_t)l * D + 64 * kb) * N_IN + oc + (lane & 31); }
            tr_item(s, N_IN, p.win_t + (size_t)n0 * D + 64 * kb, D, scr, lane); continue; }
        r -= I_IN;
        if (r < I_OUT) { const int kb = r / (D / 32), n0 = 32 * (r % (D / 32));
            tr_item(p.w_out + ((size_t)l * DMIX + 64 * kb) * D + n0 + (lane & 31), D, p.wout_t + (size_t)n0 * DMIX + 64 * kb, DMIX, scr, lane); continue; }
        r -= I_OUT;
        const int e = r / (I_GU1 + I_D1); r %= (I_GU1 + I_D1);
        if (r < I_GU1) { const int kb = r / (2 * DE / 32), q = r % (2 * DE / 32);
            const float* s = (((lane & 31) >> 4) ? p.w_up : p.w_gate) + (((size_t)l * NEXP + e) * D + 64 * kb) * DE + 16 * q + (lane & 15);
            tr_item(s, DE, p.wgu_t + ((size_t)e * 2 * DE + 32 * q) * D + 64 * kb, D, scr, lane); continue; }
        r -= I_GU1;
        { const int kb = r / (D / 32), n0 = 32 * (r % (D / 32));
            tr_item(p.w_down + (((size_t)l * NEXP + e) * DE + 64 * kb) * D + n0 + (lane & 31), D, p.wd_t + ((size_t)e * D + n0) * DE + 64 * kb, DE, scr, lane); }
    }
    const long gt = (long)blockIdx.x * blockDim.x + threadIdx.x, gs = (long)gridDim.x * blockDim.x;
    for (long i = gt; i < 2 * 256 * 64; i += gs) { const int k = (int)(i & 63), n = (int)((i >> 6) & 255), d = (int)(i >> 14);
        p.wupT[i] = f2bf(p.a_w_up[(((size_t)l * 2 + d) * 64 + k) * DA + n]); p.aupT[i] = f2bf(p.a_a_up[(((size_t)l * 2 + d) * 64 + k) * DA + n]); }
    for (long i = gt; i < 256 * 160; i += gs) { const int k = (int)(i % 160), n = (int)(i / 160); p.gupT[i] = f2bf(p.a_g_up[((size_t)l * 160 + k) * DA + n]); }
}

__device__ void ph_streams_s1(const Params& p, int l) {
    const int lane = threadIdx.x & 63, gw = blockIdx.x * 4 + (threadIdx.x >> 6), nw = gridDim.x * 4;
    const float* sh = p.a_shift + (size_t)l * 3 * A_IN;
    for (int m = gw; m < T; m += nw) {
        int t, len;
        if (m < TL) { t = m % S; len = S; } else { t = (m - TL) % L; len = L; }
        const bool hp = t > 0, hn = t < len - 1;
        const bf16_t* z = p.Z + (size_t)m * ZP + ZA;
#pragma unroll 1
        for (int i = 0; i < (A_IN + 63) / 64; ++i) {
            const int c = 64 * i + lane; float v = 0.f;
            if (c < A_IN) {
                v = sh[A_IN + c] * bf2f(z[c]);
                if (hp) v += sh[c] * bf2f(z[c - ZP]);
                if (hn) v += sh[2 * A_IN + c] * bf2f(z[c + ZP]);
                if (c < 256) p.sR[(size_t)m * DA + c] = v;
                else if (c < 512) p.kT[(size_t)m * DA + c - 256] = v;
                else if (c < 768) p.sV[(size_t)m * DA + c - 512] = v;
                else if (c < 896) p.LA[(size_t)m * 416 + c - 768] = f2bf(tanhf(v));
                else if (c < 1024) p.LA[(size_t)m * 416 + c - 768] = f2bf(v);
                else p.LA[(size_t)m * 416 + c - 768] = f2bf(sigmoidf_(v));
            }
            if (i >= 4 && i < 8) {
                const float t2 = v * p.a_k_k[l * DA + c - 256]; const float nrm = wave_sum(t2 * t2);
                if (lane == 0) p.kN[(size_t)m * 4 + i - 4] = 1.0f / sqrtf(nrm + 1e-12f);
            }
        }
    }
}
__device__ void g_streams_s2(const Params& p, int l, char* lds) {
    constexpr int MT = T / 128;
    for (int job = blockIdx.x; job < 5 * MT * 2; job += gridDim.x) {
        const int type = job / (MT * 2), r = job % (MT * 2), tm = r >> 1, tn = r & 1;
        const int coff = type < 2 ? type * 64 : type < 4 ? 128 + (type - 2) * 64 : 256, K = type < 4 ? 64 : 160, d = type & 1;
        const bf16_t* Bt = type < 2 ? p.wupT + type * 256 * 64 : type < 4 ? p.aupT + (type - 2) * 256 * 64 : p.gupT;
        const bf16_t* a0 = p.LA + (size_t)(tm * 128 + STG_ROW(0)) * 416 + coff + STG_K; const bf16_t* a1 = p.LA + (size_t)(tm * 128 + STG_ROW(1)) * 416 + coff + STG_K;
        const bf16_t* b0 = Bt + (size_t)(tn * 128 + STG_ROW(0)) * K + STG_K; const bf16_t* b1 = Bt + (size_t)(tn * 128 + STG_ROW(1)) * K + STG_K;
        gemm_tile(a0, a1, b0, b1, K, lds, [&](const f32x4 (&acc)[4][4], int wr, int wc, int fr, int fq) {
#pragma unroll
            for (int mi = 0; mi < 4; ++mi)
#pragma unroll
                for (int n = 0; n < 4; ++n) { const int c = tn * 128 + wc * 64 + n * 16 + fr;
#pragma unroll
                    for (int j = 0; j < 4; ++j) { const int row = tm * 128 + wr * 64 + mi * 16 + fq * 4 + j; const float a = acc[mi][n][j];
                        const size_t o = (size_t)row * DA + c, od = ((size_t)d * T + row) * DA + c;
                        if (type < 2) { const float u = -(p.a_w0[(l * 2 + d) * DA + c] + a); const float sp = (u > 20.f) ? u : log1pf(expf(u)); p.sW[od] = expf(-expf(-sp - 0.5f)); }
                        else if (type < 4) { const float av = sigmoidf_(p.a_a0[(l * 2 + d) * DA + c] + a); const float k = p.kT[o];
                            const float kk = k * p.a_k_k[l * DA + c] * p.kN[(size_t)row * 4 + (c >> 6)];
                            p.sKD[od] = k * (1.0f + (av - 1.0f) * p.a_k_a[l * DA + c]); p.sB[od] = kk * av; if (d == 0) p.sKK[o] = kk; }
                        else p.sG[o] = a; } }
        });
    }
}

#define GT ((long)blockIdx.x * blockDim.x + threadIdx.x)
#define GS ((long)gridDim.x * blockDim.x)
__global__ void __launch_bounds__(256) mega_fwd(Params p) {
    __shared__ __attribute__((aligned(16))) char lds[34816];
    cg::grid_group grid = cg::this_grid();
    const long gt = GT, gs = GS;
    ph_prep_w_fast(p, 0, lds); ph_prep_misc(p, 0, gt, gs);
    grid.sync();
    for (int l = 0; l < 2; ++l) {
        const int nrows = (l == 0) ? T : TL;
        ph_lnmod_fast(p, l);
        grid.sync();
        g_gemm_in(p, lds);
        grid.sync();
        ph_streams_s1(p, l); ph_rope(p, gt, gs);
        grid.sync();
        g_streams_s2(p, l, lds);
        grid.sync();
        ph_scan(p, gt, gs); ph_attn(p, l, nrows, gt, gs);
        grid.sync();
        ph_rwkv_out(p, l, nrows, gt, gs);
        grid.sync();
        g_gemm_out(p, nrows, lds);
        grid.sync();
        ph_post_mixer_fast(p, l, nrows);
        grid.sync();
        ph_dispatch(p, l, nrows, gt, gs);
        grid.sync();
        g_moe1(p, l, lds);
        grid.sync();
        g_moe2(p, l, lds);
        grid.sync();
        ph_final_fast(p, l, nrows);
        if (l == 0) { ph_prep_w_fast(p, 1, lds); ph_prep_misc(p, 1, gt, gs); }
        grid.sync();
    }
}

extern "C" void kernel_launch(void* const* d_in, const int* in_sizes, int n_in, void* d_out, int out_size, void* d_ws, size_t ws_size, hipStream_t stream) {
    if (n_in != 32 || out_size != TL * D || ws_size < WS_NEED) { fprintf(stderr, "kernel_launch: unexpected shapes / workspace (n_in %d out %d ws %zu need %zu)\n", n_in, out_size, ws_size, (size_t)WS_NEED); return; }
    static int grid_blocks = 0;
    if (!grid_blocks) {
        int dev = 0, cus = 0, per_cu = 0;
        (void)hipGetDevice(&dev);
        (void)hipDeviceGetAttribute(&cus, hipDeviceAttributeMultiprocessorCount, dev);
        (void)hipOccupancyMaxActiveBlocksPerMultiprocessor(&per_cu, mega_fwd, 256, 0);
        if (per_cu < 1) per_cu = 1;
        if (per_cu > 4) per_cu = 4;
        grid_blocks = cus * per_cu;
        fprintf(stderr, "kernel_launch: %d CUs x %d blocks\n", cus, per_cu);
    }
    Params p = make_params(d_in, d_out, d_ws);
    void* args[] = {&p};
    hipError_t e = hipLaunchCooperativeKernel((void*)mega_fwd, dim3(grid_blocks), dim3(256), args, 0, stream);
    if (e != hipSuccess) fprintf(stderr, "cooperative launch failed: %s (grid %d)\n", hipGetErrorString(e), grid_blocks);
}
#endif

#ifdef HOST_EMU
static void host_forward(void* const* d_in, void* d_out, void* d_ws) {
    const Params p = make_params(d_in, d_out, d_ws);
    for (int l = 0; l < 2; ++l) {
        const int nrows = (l == 0) ? T : TL;
        ph_prep_w(p, l, 0, 1); ph_prep_misc(p, l, 0, 1); ph_lnmod(p, l, 0, 1); host_gemm_in(p); ph_streams(p, l, 0, 1); ph_rope(p, 0, 1); ph_scan(p, 0, 1);
        ph_attn(p, l, nrows, 0, 1); ph_rwkv_out(p, l, nrows, 0, 1); host_gemm_out(p, nrows); ph_post_mixer(p, l, nrows, 0, 1);
        ph_dispatch(p, l, nrows, 0, 1); host_moe1(p, l); host_moe2(p, l); ph_final(p, l, nrows, 0, 1);
    }
}
#endif
```

```cpp
#ifdef HOST_EMU
#include <cmath>
#include <cstdio>
#include <cstring>
#include <cstdint>
#include <cstdlib>
#define __device__
#define __global__
#define __host__
#define __forceinline__ inline
#else
#include <hip/hip_runtime.h>
#include <hip/hip_cooperative_groups.h>
#include <cstdio>
#include <cstdint>
namespace cg = cooperative_groups;
#endif

#ifndef CFG_D
#define CFG_D 1024
#define CFG_B 8
#define CFG_S 2048
#define CFG_L 256
#define CFG_DE 512
#endif
constexpr int D = CFG_D, NB = CFG_B, S = CFG_S, L = CFG_L, DE = CFG_DE;
constexpr int TL = NB * S, TC = NB * L, T = TL + TC;
constexpr int GRID_W = 64, HD = 64;
constexpr int DA = 256, A_IN = 1184, N_IN = 2976, NINP = 3072, DMIX = 1024;
constexpr int NEXP = 32, NSLOT = 2 * T + NEXP * 128;
constexpr int ZQB = 0, ZKB = 384, ZVB = 512, ZQN = 640, ZKN = 1024, ZVN = 1408, ZA = 1792, ZP = 2976;
constexpr float LN_EPS = 1e-6f, GN_EPS = 64e-5f, ATT_SCALE = 0.125f;
constexpr float ALPHA = 1.41421356237309515f;

typedef unsigned short bf16_t;

__device__ __forceinline__ float bf2f(bf16_t v) {
    unsigned u = ((unsigned)v) << 16; float f;
#ifdef HOST_EMU
    memcpy(&f, &u, 4);
#else
    f = __uint_as_float(u);
#endif
    return f;
}
__device__ __forceinline__ bf16_t f2bf(float f) {
    unsigned u;
#ifdef HOST_EMU
    memcpy(&u, &f, 4);
#else
    u = __float_as_uint(f);
#endif
    return (bf16_t)((u + 0x7fffu + ((u >> 16) & 1u)) >> 16);
}
__device__ __forceinline__ float sigmoidf_(float x) { return 1.0f / (1.0f + expf(-x)); }
__device__ __forceinline__ float siluf_(float x) { return x / (1.0f + expf(-x)); }
__device__ __forceinline__ int atomic_inc_int(int* p) {
#ifdef HOST_EMU
    int o = *p; *p = o + 1; return o;
#else
    return atomicAdd(p, 1);
#endif
}

struct Params {
    const float *x, *c, *ctx, *c_ctx, *w_mod, *b_mod, *w_in, *w_out, *a_shift, *a_w0, *a_w_up, *a_a0, *a_a_up, *a_g_up,
        *a_k_k, *a_k_a, *a_r_k, *a_lnx_g, *a_lnx_b, *b_sink, *c_rpb, *ln1_g, *ln1_b, *ln2_g, *ln2_b, *w_rg, *b_rg, *w_re,
        *b_re, *w_gate, *w_up, *w_down;
    float* out;
    int* cnt;
    float* mod;
    float* rope;
    bf16_t *win_t, *wout_t, *wgu_t, *wd_t;
    bf16_t *wupT, *aupT, *gupT;
    bf16_t* LA;
    float *kT, *kN;
    bf16_t* H;
    bf16_t* Z;
    bf16_t* VT;
    float *sR, *sV, *sKK, *sG, *sW, *sKD, *sB;
    float* Y;
    bf16_t* MIX;
    float* XC;
    float* O;
    int *rE, *rPos, *rSlot; float* rW;
    int* slotTok;
    bf16_t* ACT;
    float* YS;
};

constexpr size_t al256(size_t v) { return (v + 255) & ~(size_t)255; }
constexpr size_t OFF_CNT = 0;
constexpr size_t OFF_MOD = 4096;
constexpr size_t OFF_ROPE = al256(OFF_MOD + (size_t)2 * (NB + 1) * 6 * D * 4);
constexpr size_t OFF_LORA = al256(OFF_ROPE + 64 * 16 * 2 * 4);
constexpr size_t OFF_WIN = al256(OFF_LORA + (size_t)(2 * 256 * 64 * 2 + 256 * 160) * 2);
constexpr size_t OFF_WOUT = al256(OFF_WIN + (size_t)NINP * D * 2);
constexpr size_t OFF_WGU = al256(OFF_WOUT + (size_t)D * DMIX * 2);
constexpr size_t OFF_WD = al256(OFF_WGU + (size_t)NEXP * 2 * DE * D * 2);
constexpr size_t OFF_H = al256(OFF_WD + (size_t)NEXP * D * DE * 2);
constexpr size_t OFF_Z = al256(OFF_H + (size_t)(T + 1) * D * 2);
constexpr int PU = L + S;
constexpr size_t OFF_VT = al256(OFF_Z + (size_t)T * ZP * 2);
constexpr size_t OFF_S = al256(OFF_VT + (size_t)NB * 8 * 64 * PU * 2);
constexpr size_t S1 = (size_t)T * 256 * 4;
constexpr size_t OFF_Y = al256(OFF_S + 10 * S1);
constexpr size_t OFF_MIX = al256(OFF_Y + 2 * S1);
constexpr size_t OFF_XC = al256(OFF_MIX + (size_t)T * 1024 * 2);
constexpr size_t OFF_ROUTE = al256(OFF_XC + (size_t)TC * D * 4);
constexpr size_t OFF_SLOTTOK = al256(OFF_ROUTE + (size_t)T * 2 * 4 * 4);
constexpr size_t WS_NEED = al256(OFF_SLOTTOK + (size_t)NSLOT * 4);
static_assert((size_t)NSLOT * DE * 2 <= (size_t)T * ZP * 2, "ACT overlays Z");
static_assert((size_t)T * 4 * 4 + (size_t)T * 416 * 2 <= S1, "kN + LA overlay Y[1]");
static_assert((size_t)NSLOT * D * 4 <= 10 * S1 && (size_t)T * D * 4 <= 10 * S1, "YS / O overlay the stream buffers");

static Params make_params(void* const* d_in, void* d_out, void* d_ws) {
    Params p{};
    const float** f = (const float**)&p.x;
    for (int i = 0; i < 32; ++i) f[i] = (const float*)d_in[i];
    p.out = (float*)d_out;
    char* w = (char*)d_ws;
    p.cnt = (int*)(w + OFF_CNT); p.mod = (float*)(w + OFF_MOD); p.rope = (float*)(w + OFF_ROPE);
    p.win_t = (bf16_t*)(w + OFF_WIN); p.wout_t = (bf16_t*)(w + OFF_WOUT); p.wgu_t = (bf16_t*)(w + OFF_WGU); p.wd_t = (bf16_t*)(w + OFF_WD);
    p.wupT = (bf16_t*)(w + OFF_LORA); p.aupT = p.wupT + 2 * 256 * 64; p.gupT = p.aupT + 2 * 256 * 64;
    p.H = (bf16_t*)(w + OFF_H); p.Z = (bf16_t*)(w + OFF_Z); p.VT = (bf16_t*)(w + OFF_VT);
    float* s = (float*)(w + OFF_S); const size_t n1 = (size_t)T * 256;
    p.sR = s; p.sV = s + n1; p.sKK = s + 2 * n1; p.sG = s + 3 * n1; p.sW = s + 4 * n1; p.sKD = s + 6 * n1; p.sB = s + 8 * n1;
    p.Y = (float*)(w + OFF_Y); p.MIX = (bf16_t*)(w + OFF_MIX); p.XC = (float*)(w + OFF_XC);
    p.O = (float*)(w + OFF_S);
    p.kT = p.Y; p.kN = p.Y + (size_t)T * 256; p.LA = (bf16_t*)(p.Y + (size_t)T * 256 + (size_t)T * 4);
    int* r = (int*)(w + OFF_ROUTE); p.rE = r; p.rPos = r + 2 * T; p.rSlot = r + 4 * T; p.rW = (float*)(r + 6 * T);
    p.slotTok = (int*)(w + OFF_SLOTTOK);
    p.ACT = (bf16_t*)(w + OFF_Z); p.YS = (float*)(w + OFF_S);
    return p;
}

__device__ void ph_prep_w(const Params& p, int l, long gtid, long gsz) {
    for (long i = gtid; i < (long)D * NINP; i += gsz) {
        const int k = (int)(i / NINP), n = (int)(i % NINP);
        float v = 0.f;
        if (n < N_IN) { const int oc = (n < ZA) ? n + A_IN : n - ZA; v = p.w_in[((size_t)l * D + k) * N_IN + oc]; }
        p.win_t[(size_t)n * D + k] = f2bf(v);
    }
    for (long i = gtid; i < (long)DMIX * D; i += gsz) {
        const int k = (int)(i / D), n = (int)(i % D);
        p.wout_t[(size_t)n * DMIX + k] = f2bf(p.w_out[((size_t)l * DMIX + k) * D + n]);
    }
    for (long i = gtid; i < (long)NEXP * D * 2 * DE; i += gsz) {
        const int rho = (int)(i % (2 * DE)); const long t = i / (2 * DE); const int k = (int)(t % D), e = (int)(t / D);
        const int q = rho >> 5, half = (rho >> 4) & 1, ii = rho & 15, cc = 16 * q + ii;
        const float* src = half ? p.w_up : p.w_gate;
        p.wgu_t[((size_t)e * 2 * DE + rho) * D + k] = f2bf(src[(((size_t)l * NEXP + e) * D + k) * DE + cc]);
    }
    for (long i = gtid; i < (long)NEXP * DE * D; i += gsz) {
        const int n = (int)(i % D); const long t = i / D; const int k = (int)(t % DE), e = (int)(t / DE);
        p.wd_t[((size_t)e * D + n) * DE + k] = f2bf(p.w_down[(((size_t)l * NEXP + e) * DE + k) * D + n]);
    }
}
__device__ void ph_prep_misc(const Params& p, int l, long gtid, long gsz) {
    if (l == 0) for (long i = gtid; i < (long)2 * (NB + 1) * 6 * D; i += gsz) {
        const int j = (int)(i % (6 * D)), b = (int)((i / (6 * D)) % (NB + 1)), ll = (int)(i / ((long)6 * D * (NB + 1)));
        const float* cv = (b < NB) ? p.c + (size_t)b * D : p.c_ctx;
        float acc = 0.f;
        for (int k = 0; k < D; ++k) acc += siluf_(cv[k]) * p.w_mod[((size_t)ll * D + k) * 6 * D + j];
        p.mod[((size_t)ll * (NB + 1) + b) * 6 * D + j] = acc + p.b_mod[(size_t)ll * 6 * D + j];
    }
    if (l == 0) for (long i = gtid; i < 64 * 16; i += gsz) {
        const int pos = (int)(i / 16), fi = (int)(i % 16);
        const float inv = powf(10000.0f, -(float)fi / 16.0f), ang = (float)pos * inv;
        p.rope[i] = cosf(ang); p.rope[1024 + i] = sinf(ang);
    }
    for (long i = gtid; i < NEXP; i += gsz) p.cnt[l * NEXP + i] = 0;
    for (long i = gtid; i < NSLOT; i += gsz) p.slotTok[i] = T;
    for (long i = gtid; i < D; i += gsz) p.H[(size_t)T * D + i] = 0;
}

__device__ __forceinline__ const float* xrow_in(const Params& p, int l, int m) {
    if (m < TL) return (l == 0 ? p.x : p.out) + (size_t)m * D;
    return (l == 0 ? p.ctx : p.XC) + (size_t)(m - TL) * D;
}
__device__ __forceinline__ const float* modrow(const Params& p, int l, int m) { return p.mod + ((size_t)l * (NB + 1) + (m < TL ? m / S : NB)) * 6 * D; }

__device__ void ph_lnmod(const Params& p, int l, long gtid, long gsz) {
    for (long m = gtid; m < T; m += gsz) {
        const float* xr = xrow_in(p, l, (int)m); const float* md = modrow(p, l, (int)m);
        float s = 0.f; for (int j = 0; j < D; ++j) s += xr[j];
        const float mu = s / D; float q = 0.f;
        for (int j = 0; j < D; ++j) { const float d = xr[j] - mu; q += d * d; }
        const float rstd = 1.0f / sqrtf(q / D + LN_EPS);
        for (int j = 0; j < D; ++j) p.H[(size_t)m * D + j] = f2bf((xr[j] - mu) * rstd * (1.0f + md[D + j]) + md[j]);
    }
}

__device__ __forceinline__ float zshift(const Params& p, int l, int m, int col) {
    int t, len;
    if (m < TL) { t = m % S; len = S; } else { t = (m - TL) % L; len = L; }
    const float* sh = p.a_shift + (size_t)l * 3 * A_IN;
    const bf16_t* z = p.Z + (size_t)m * ZP + ZA + col;
    float v = sh[A_IN + col] * bf2f(z[0]);
    if (t > 0) v += sh[col] * bf2f(z[-ZP]);
    if (t < len - 1) v += sh[2 * A_IN + col] * bf2f(z[ZP]);
    return v;
}

__device__ void ph_streams(const Params& p, int l, long gtid, long gsz) {
    for (long i = gtid; i < (long)T * DA; i += gsz) {
        const int m = (int)(i / DA), c = (int)(i % DA), h0 = c & ~63;
        const float r = zshift(p, l, m, c), k = zshift(p, l, m, 256 + c), v = zshift(p, l, m, 512 + c);
        float nrm = 0.f;
        for (int j = 0; j < 64; ++j) { const float t = zshift(p, l, m, 256 + h0 + j) * p.a_k_k[l * DA + h0 + j]; nrm += t * t; }
        const float kk = k * p.a_k_k[l * DA + c] / sqrtf(nrm + 1e-12f);
        float g = 0.f;
        for (int j = 0; j < 160; ++j) g += sigmoidf_(zshift(p, l, m, 1024 + j)) * p.a_g_up[((size_t)l * 160 + j) * DA + c];
        const size_t o = (size_t)m * DA + c;
        p.sR[o] = r; p.sV[o] = v; p.sKK[o] = kk; p.sG[o] = g;
        for (int d = 0; d < 2; ++d) {
            float aw = 0.f, aa = 0.f;
            for (int j = 0; j < 64; ++j) {
                aw += tanhf(zshift(p, l, m, 768 + d * 64 + j)) * p.a_w_up[(((size_t)l * 2 + d) * 64 + j) * DA + c];
                aa += zshift(p, l, m, 896 + d * 64 + j) * p.a_a_up[(((size_t)l * 2 + d) * 64 + j) * DA + c];
            }
            const float u = -(p.a_w0[(l * 2 + d) * DA + c] + aw);
            const float sp = (u > 20.f) ? u : log1pf(expf(u));
            const float w = expf(-expf(-sp - 0.5f));
            const float a = sigmoidf_(p.a_a0[(l * 2 + d) * DA + c] + aa);
            const size_t od = ((size_t)d * T + m) * DA + c;
            p.sW[od] = w; p.sKD[od] = k * (1.0f + (a - 1.0f) * p.a_k_a[l * DA + c]); p.sB[od] = kk * a;
        }
    }
}

__device__ void ph_rope(const Params& p, long gtid, long gsz) {
    for (long i = gtid; i < (long)TL * 8 * 32; i += gsz) {
        const int pr = (int)(i & 31), hs = (int)((i >> 5) & 7), m = (int)(i >> 8);
        const int t = m % S, axis = pr >> 4, fi = pr & 15, pos = axis ? (t % GRID_W) : (t / GRID_W);
        bf16_t* z = p.Z + (size_t)m * ZP + hs * 64 + axis * 32 + fi;
        const float cs = p.rope[pos * 16 + fi], sn = p.rope[1024 + pos * 16 + fi];
        const float x0 = bf2f(z[0]), x1 = bf2f(z[16]);
        z[0] = f2bf(x0 * cs - x1 * sn); z[16] = f2bf(x1 * cs + x0 * sn);
    }
}

__device__ void ph_scan(const Params& p, long gtid, long gsz) {
    for (long i = gtid; i < (long)2 * NB * 4 * 64; i += gsz) {
        const int v = (int)(i & 63), h = (int)((i >> 6) & 3), b = (int)((i >> 8) % NB), d = (int)((i >> 8) / NB);
        float st[64];
#pragma unroll
        for (int k = 0; k < 64; ++k) st[k] = 0.f;
        for (int pos = 0; pos < L + S; ++pos) {
            int m;
            if (pos < L) m = TL + b * L + (d ? L - 1 - pos : pos);
            else m = b * S + (d ? S - 1 - (pos - L) : pos - L);
            const size_t o = (size_t)m * DA + h * 64, od = ((size_t)d * T + m) * DA + h * 64;
            const float* kk = p.sKK + o; const float* r = p.sR + o;
            const float* w = p.sW + od; const float* bb = p.sB + od; const float* kd = p.sKD + od;
            const float vv = p.sV[o + v];
            float sk = 0.f;
#pragma unroll
            for (int k = 0; k < 64; ++k) sk += st[k] * kk[k];
            float y = 0.f;
#pragma unroll
            for (int k = 0; k < 64; ++k) { st[k] = st[k] * w[k] - sk * bb[k] + vv * kd[k]; y += st[k] * r[k]; }
            p.Y[od + v] = y;
        }
    }
}

__device__ void ph_rwkv_out(const Params& p, int l, int nrows, long gtid, long gsz) {
    for (long i = gtid; i < (long)nrows * 4; i += gsz) {
        const int m = (int)(i >> 2), h = (int)(i & 3);
        const size_t o = (size_t)m * DA + h * 64;
        const float* y0 = p.Y + o; const float* y1 = p.Y + (size_t)T * DA + o;
        float s = 0.f, bon = 0.f;
        for (int n = 0; n < 64; ++n) {
            s += y0[n] + y1[n];
            bon += p.sR[o + n] * (p.sKD[o + n] + p.sKD[(size_t)T * DA + o + n]) * p.a_r_k[l * DA + h * 64 + n];
        }
        const float mu = s / 64.f; float q = 0.f;
        for (int n = 0; n < 64; ++n) { const float dd = y0[n] + y1[n] - mu; q += dd * dd; }
        const float rstd = 1.0f / sqrtf(q / 64.f + GN_EPS);
        for (int n = 0; n < 64; ++n) {
            const int c = h * 64 + n;
            const float yn = (y0[n] + y1[n] - mu) * rstd * p.a_lnx_g[l * DA + c] + p.a_lnx_b[l * DA + c];
            p.MIX[(size_t)m * DMIX + c] = f2bf((yn + bon * p.sV[o + n]) * p.sG[o + n]);
        }
    }
}

__device__ __forceinline__ void att_key(const float (&q)[64], const bf16_t* kr, const bf16_t* vr, float bias, float& mx, float& ls, float (&acc)[64]) {
    float s = 0.f;
#pragma unroll
    for (int d = 0; d < 64; ++d) s += q[d] * bf2f(kr[d]);
    s = s * ATT_SCALE + bias;
    const float mn = fmaxf(mx, s), f = expf(mx - mn), pe = expf(s - mn);
    ls = ls * f + pe;
#pragma unroll
    for (int d = 0; d < 64; ++d) acc[d] = acc[d] * f + pe * bf2f(vr[d]);
    mx = mn;
}

__device__ void ph_attn(const Params& p, int l, int nrows, long gtid, long gsz) {
    for (long i = gtid; i < (long)nrows * 12; i += gsz) {
        const int m = (int)(i / 12), u = (int)(i % 12);
        const bool isB = u < 6; const int hq = isB ? u : u - 6;
        const int b = (m < TL) ? m / S : (m - TL) / L;
        const int qcol = isB ? ZQB + hq * 64 : ZQN + hq * 64;
        const int kcol = isB ? ZKB + (hq / 3) * 64 : ZKN + hq * 64;
        const int vcol = isB ? ZVB + (hq / 3) * 64 : ZVN + hq * 64;
        float q[64], acc[64];
        const bf16_t* qr = p.Z + (size_t)m * ZP + qcol;
#pragma unroll
        for (int d = 0; d < 64; ++d) { q[d] = bf2f(qr[d]); acc[d] = 0.f; }
        float mx, ls;
        if (isB) { mx = p.b_sink[l * 6 + hq]; ls = 1.0f; } else { mx = -1e30f; ls = 0.f; }
        for (int j = 0; j < L; ++j) { const bf16_t* zr = p.Z + (size_t)(TL + b * L + j) * ZP; att_key(q, zr + kcol, zr + vcol, 0.f, mx, ls, acc); }
        if (m < TL) {
            const int t = m % S;
            if (isB) {
                const int j0 = t - 128 < 0 ? 0 : t - 128, j1 = t + 128 > S - 1 ? S - 1 : t + 128;
                for (int j = j0; j <= j1; ++j) { const bf16_t* zr = p.Z + (size_t)(b * S + j) * ZP; att_key(q, zr + kcol, zr + vcol, 0.f, mx, ls, acc); }
            } else {
                const int rows = S / GRID_W, r = t / GRID_W, c = t % GRID_W;
                int r0 = r - 4; r0 = r0 < 0 ? 0 : (r0 > rows - 8 ? rows - 8 : r0);
                int c0 = c - 8; c0 = c0 < 0 ? 0 : (c0 > GRID_W - 16 ? GRID_W - 16 : c0);
                for (int a = 0; a < 8; ++a)
                    for (int e = 0; e < 16; ++e) {
                        const int kr = r0 + a, kc = c0 + e;
                        const float bias = p.c_rpb[(((size_t)l * 6 + hq) * 15 + (kr - r + 7)) * 31 + (kc - c + 15)];
                        const bf16_t* zr = p.Z + (size_t)(b * S + kr * GRID_W + kc) * ZP;
                        att_key(q, zr + kcol, zr + vcol, bias, mx, ls, acc);
                    }
            }
        }
        const float inv = 1.0f / ls;
        bf16_t* o = p.MIX + (size_t)m * DMIX + (isB ? 256 : 640) + hq * 64;
#pragma unroll
        for (int d = 0; d < 64; ++d) o[d] = f2bf(acc[d] * inv);
    }
}

__device__ void ph_post_mixer(const Params& p, int l, int nrows, long gtid, long gsz) {
    for (long mm = gtid; mm < nrows; mm += gsz) {
        const int m = (int)mm;
        const float* xr = xrow_in(p, l, m); const float* md = modrow(p, l, m); const float* orow = p.O + (size_t)m * D;
        float* x1 = (m < TL) ? p.out + (size_t)m * D : p.XC + (size_t)(m - TL) * D;
        const float* g1 = p.ln1_g + (size_t)l * D; const float* b1 = p.ln1_b + (size_t)l * D;
        float s = 0.f; for (int j = 0; j < D; ++j) s += ALPHA * xr[j] + md[2 * D + j] * orow[j];
        float mu = s / D, q = 0.f;
        for (int j = 0; j < D; ++j) { const float d = ALPHA * xr[j] + md[2 * D + j] * orow[j] - mu; q += d * d; }
        float rstd = 1.0f / sqrtf(q / D + LN_EPS);
        s = 0.f;
        for (int j = 0; j < D; ++j) { const float v = (ALPHA * xr[j] + md[2 * D + j] * orow[j] - mu) * rstd * g1[j] + b1[j]; x1[j] = v; s += v; }
        mu = s / D; q = 0.f;
        for (int j = 0; j < D; ++j) { const float d = x1[j] - mu; q += d * d; }
        rstd = 1.0f / sqrtf(q / D + LN_EPS);
        float gl[4], el[32];
#pragma unroll
        for (int g = 0; g < 4; ++g) gl[g] = p.b_rg[l * 4 + g];
#pragma unroll
        for (int e = 0; e < 32; ++e) el[e] = p.b_re[l * 32 + e];
        for (int j = 0; j < D; ++j) {
            const float hv = (x1[j] - mu) * rstd * (1.0f + md[4 * D + j]) + md[3 * D + j];
            p.H[(size_t)m * D + j] = f2bf(hv);
            const float* wg = p.w_rg + ((size_t)l * D + j) * 4; const float* we = p.w_re + ((size_t)l * D + j) * 32;
#pragma unroll
            for (int g = 0; g < 4; ++g) gl[g] += hv * wg[g];
#pragma unroll
            for (int e = 0; e < 32; ++e) el[e] += hv * we[e];
        }
        int gs = 0; float gm = gl[0];
#pragma unroll
        for (int g = 1; g < 4; ++g) if (gl[g] > gm) { gm = gl[g]; gs = g; }
        float den = 0.f;
#pragma unroll
        for (int g = 0; g < 4; ++g) den += expf(gl[g] - gm);
        const float pg = 1.0f / den;
        float v1 = -3e38f, v2 = -3e38f; int i1 = 0, i2 = 0;
#pragma unroll
        for (int j = 0; j < 8; ++j) {
            const float v = gs == 0 ? el[j] : gs == 1 ? el[8 + j] : gs == 2 ? el[16 + j] : el[24 + j];
            if (v > v1) { v2 = v1; i2 = i1; v1 = v; i1 = j; } else if (v > v2) { v2 = v; i2 = j; }
        }
        const float e2 = expf(v2 - v1), w1 = pg / (1.0f + e2), w2 = pg * e2 / (1.0f + e2);
        const int ea = gs * 8 + i1, eb = gs * 8 + i2;
        p.rE[2 * m] = ea; p.rE[2 * m + 1] = eb; p.rW[2 * m] = w1; p.rW[2 * m + 1] = w2;
        p.rPos[2 * m] = atomic_inc_int(p.cnt + l * NEXP + ea); p.rPos[2 * m + 1] = atomic_inc_int(p.cnt + l * NEXP + eb);
    }
}

__device__ __forceinline__ int pstart_of(const int* cnt, int e) {
    int s = 0;
    for (int j = 0; j < NEXP; ++j) if (j < e) s += (cnt[j] + 127) & ~127;
    return s;
}
__device__ void ph_dispatch(const Params& p, int l, int nrows, long gtid, long gsz) {
    for (long i = gtid; i < (long)nrows * 2; i += gsz) {
        const int slot = pstart_of(p.cnt + l * NEXP, p.rE[i]) + p.rPos[i];
        p.rSlot[i] = slot; p.slotTok[slot] = (int)(i >> 1);
    }
}

__device__ void ph_final(const Params& p, int l, int nrows, long gtid, long gsz) {
    for (long mm = gtid; mm < nrows; mm += gsz) {
        const int m = (int)mm;
        float* x1 = (m < TL) ? p.out + (size_t)m * D : p.XC + (size_t)(m - TL) * D;
        const float* md = modrow(p, l, m);
        const float* ya = p.YS + (size_t)p.rSlot[2 * m] * D; const float* yb = p.YS + (size_t)p.rSlot[2 * m + 1] * D;
        const float wa = p.rW[2 * m], wb = p.rW[2 * m + 1];
        const float* g2 = p.ln2_g + (size_t)l * D; const float* b2 = p.ln2_b + (size_t)l * D;
        float s = 0.f; for (int j = 0; j < D; ++j) s += ALPHA * x1[j] + md[5 * D + j] * (wa * ya[j] + wb * yb[j]);
        const float mu = s / D; float q = 0.f;
        for (int j = 0; j < D; ++j) { const float d = ALPHA * x1[j] + md[5 * D + j] * (wa * ya[j] + wb * yb[j]) - mu; q += d * d; }
        const float rstd = 1.0f / sqrtf(q / D + LN_EPS);
        for (int j = 0; j < D; ++j) x1[j] = (ALPHA * x1[j] + md[5 * D + j] * (wa * ya[j] + wb * yb[j]) - mu) * rstd * g2[j] + b2[j];
    }
}

__device__ __forceinline__ int moe_blocks(const int* cnt) { int s = 0; for (int j = 0; j < NEXP; ++j) s += (cnt[j] + 127) >> 7; return s; }
__device__ __forceinline__ int moe_block_expert(const int* cnt, int rb) {
    int s = 0, e = 0;
    for (int j = 0; j < NEXP; ++j) { const int nb = (cnt[j] + 127) >> 7; if (rb >= s && rb < s + nb) e = j; s += nb; }
    return e;
}

#ifdef HOST_EMU
static void host_gemm_in(const Params& p) {
    for (int m = 0; m < T; ++m) for (int n = 0; n < ZP; ++n) { float a = 0.f; for (int k = 0; k < D; ++k) a += bf2f(p.H[(size_t)m * D + k]) * bf2f(p.win_t[(size_t)n * D + k]); p.Z[(size_t)m * ZP + n] = f2bf(a); }
}
static void host_gemm_out(const Params& p, int nrows) {
    for (int m = 0; m < nrows; ++m) for (int n = 0; n < D; ++n) { float a = 0.f; for (int k = 0; k < DMIX; ++k) a += bf2f(p.MIX[(size_t)m * DMIX + k]) * bf2f(p.wout_t[(size_t)n * DMIX + k]); p.O[(size_t)m * D + n] = a; }
}
static void host_moe1(const Params& p, int l) {
    const int* cnt = p.cnt + l * NEXP; const int nrb = moe_blocks(cnt);
    for (int rb = 0; rb < nrb; ++rb) { const int e = moe_block_expert(cnt, rb);
        for (int r = 0; r < 128; ++r) { const int slot = rb * 128 + r; const bf16_t* a = p.H + (size_t)p.slotTok[slot] * D;
            for (int c = 0; c < DE; ++c) { const int q = c >> 4, ii = c & 15; float g = 0.f, u = 0.f;
                const bf16_t* wg = p.wgu_t + ((size_t)e * 2 * DE + 32 * q + ii) * D; const bf16_t* wu = wg + (size_t)16 * D;
                for (int k = 0; k < D; ++k) { g += bf2f(a[k]) * bf2f(wg[k]); u += bf2f(a[k]) * bf2f(wu[k]); }
                p.ACT[(size_t)slot * DE + c] = f2bf(siluf_(g) * u); } } }
}
static void host_moe2(const Params& p, int l) {
    const int* cnt = p.cnt + l * NEXP; const int nrb = moe_blocks(cnt);
    for (int rb = 0; rb < nrb; ++rb) { const int e = moe_block_expert(cnt, rb);
        for (int r = 0; r < 128; ++r) { const int slot = rb * 128 + r;
            for (int n = 0; n < D; ++n) { float a = 0.f; const bf16_t* w = p.wd_t + ((size_t)e * D + n) * DE;
                for (int k = 0; k < DE; ++k) a += bf2f(p.ACT[(size_t)slot * DE + k]) * bf2f(w[k]);
                p.YS[(size_t)slot * D + n] = a; } } }
}
#else
typedef short bf16x8 __attribute__((ext_vector_type(8)));
typedef float f32x4 __attribute__((ext_vector_type(4)));
__device__ __forceinline__ unsigned pk2(float lo, float hi) { return (unsigned)f2bf(lo) | ((unsigned)f2bf(hi) << 16); }
struct u32x2_t { unsigned x, y; };
__device__ __forceinline__ void st_bf16x4(bf16_t* dst, f32x4 v) { u32x2_t o; o.x = pk2(v[0], v[1]); o.y = pk2(v[2], v[3]); *(u32x2_t*)dst = o; }
template <class Epi>
__device__ __forceinline__ void gemm_tile(const bf16_t* a0, const bf16_t* a1, const bf16_t* b0, const bf16_t* b1, int K, char* lds, const Epi& epi) {
    const int tid = threadIdx.x, wid = tid >> 6, lane = tid & 63, wr = wid >> 1, wc = wid & 1, fr = lane & 15, fq = lane >> 4;
    char* SA = lds; char* SB = lds + 8192;
    f32x4 acc[4][4];
#pragma unroll
    for (int m = 0; m < 4; ++m)
#pragma unroll
        for (int n = 0; n < 4; ++n) acc[m][n] = (f32x4){0.f, 0.f, 0.f, 0.f};
    for (int kt = 0; kt < K; kt += 32) {
        __builtin_amdgcn_global_load_lds((const unsigned*)(a0 + kt), (__attribute__((address_space(3))) unsigned*)(SA + tid * 16), 16, 0, 0);
        __builtin_amdgcn_global_load_lds((const unsigned*)(a1 + kt), (__attribute__((address_space(3))) unsigned*)(SA + tid * 16 + 4096), 16, 0, 0);
        __builtin_amdgcn_global_load_lds((const unsigned*)(b0 + kt), (__attribute__((address_space(3))) unsigned*)(SB + tid * 16), 16, 0, 0);
        __builtin_amdgcn_global_load_lds((const unsigned*)(b1 + kt), (__attribute__((address_space(3))) unsigned*)(SB + tid * 16 + 4096), 16, 0, 0);
        asm volatile("s_waitcnt vmcnt(0)" ::: "memory");
        __syncthreads();
        bf16x8 At[4], Bt[4];
#pragma unroll
        for (int m = 0; m < 4; ++m) At[m] = *(const bf16x8*)(SA + (wr * 64 + m * 16 + fr) * 64 + fq * 16);
#pragma unroll
        for (int n = 0; n < 4; ++n) Bt[n] = *(const bf16x8*)(SB + (wc * 64 + n * 16 + fr) * 64 + fq * 16);
#pragma unroll
        for (int m = 0; m < 4; ++m)
#pragma unroll
            for (int n = 0; n < 4; ++n) acc[m][n] = __builtin_amdgcn_mfma_f32_16x16x32_bf16(At[m], Bt[n], acc[m][n], 0, 0, 0);
        __syncthreads();
    }
    epi(acc, wr, wc, fr, fq);
}
#define STG_ROW(i) ((threadIdx.x + (i) * 256) >> 2)
#define STG_K ((threadIdx.x & 3) * 8)

__device__ __forceinline__ void g_gemm_in(const Params& p, char* lds) {
    constexpr int NT = NINP / 128, MT = T / 128;
    for (int tile = blockIdx.x; tile < NT * MT; tile += gridDim.x) {
        const int tm = tile / NT, tn = tile % NT;
        const bf16_t* a0 = p.H + (size_t)(tm * 128 + STG_ROW(0)) * D + STG_K; const bf16_t* a1 = p.H + (size_t)(tm * 128 + STG_ROW(1)) * D + STG_K;
        const bf16_t* b0 = p.win_t + (size_t)(tn * 128 + STG_ROW(0)) * D + STG_K; const bf16_t* b1 = p.win_t + (size_t)(tn * 128 + STG_ROW(1)) * D + STG_K;
        gemm_tile(a0, a1, b0, b1, D, lds, [&](const f32x4 (&acc)[4][4], int wr, int wc, int fr, int fq) {
#pragma unroll
            for (int m = 0; m < 4; ++m)
#pragma unroll
                for (int n = 0; n < 4; ++n) { const int col = tn * 128 + wc * 64 + n * 16 + fr;
                    if (col < ZP) {
#pragma unroll
                        for (int j = 0; j < 4; ++j) p.Z[(size_t)(tm * 128 + wr * 64 + m * 16 + fq * 4 + j) * ZP + col] = f2bf(acc[m][n][j]); } }
            if (tn == ZVB / 128 || (tn >= ZVN / 128 && tn < ZA / 128)) {
#pragma unroll
                for (int m = 0; m < 4; ++m) { const int m0 = tm * 128 + wr * 64 + m * 16 + fq * 4; int b, u;
                    if (m0 < TL) { b = m0 / S; u = L + m0 % S; } else { b = (m0 - TL) / L; u = (m0 - TL) % L; }
#pragma unroll
                    for (int n = 0; n < 4; ++n) { const int col = tn * 128 + wc * 64 + n * 16 + fr;
                        const int hv = col < ZVN ? (col - ZVB) >> 6 : 2 + ((col - ZVN) >> 6), d = col < ZVN ? (col - ZVB) & 63 : (col - ZVN) & 63;
                        st_bf16x4(p.VT + ((size_t)(b * 8 + hv) * 64 + d) * PU + u, acc[m][n]); } }
            }
        });
    }
}
__device__ __forceinline__ void g_gemm_out(const Params& p, int nrows, char* lds) {
    constexpr int NT = D / 128; const int MT = nrows / 128;
    for (int tile = blockIdx.x; tile < NT * MT; tile += gridDim.x) {
        const int tm = tile / NT, tn = tile % NT;
        const bf16_t* a0 = p.MIX + (size_t)(tm * 128 + STG_ROW(0)) * DMIX + STG_K; const bf16_t* a1 = p.MIX + (size_t)(tm * 128 + STG_ROW(1)) * DMIX + STG_K;
        const bf16_t* b0 = p.wout_t + (size_t)(tn * 128 + STG_ROW(0)) * DMIX + STG_K; const bf16_t* b1 = p.wout_t + (size_t)(tn * 128 + STG_ROW(1)) * DMIX + STG_K;
        gemm_tile(a0, a1, b0, b1, DMIX, lds, [&](const f32x4 (&acc)[4][4], int wr, int wc, int fr, int fq) {
#pragma unroll
            for (int m = 0; m < 4; ++m)
#pragma unroll
                for (int n = 0; n < 4; ++n)
#pragma unroll
                    for (int j = 0; j < 4; ++j) p.O[(size_t)(tm * 128 + wr * 64 + m * 16 + fq * 4 + j) * D + tn * 128 + wc * 64 + n * 16 + fr] = acc[m][n][j];
        });
    }
}
__device__ __forceinline__ void g_moe1(const Params& p, int l, char* lds) {
    const int* cnt = p.cnt + l * NEXP; const int nrb = moe_blocks(cnt); constexpr int NT = 2 * DE / 128;
    for (int tile = blockIdx.x; tile < nrb * NT; tile += gridDim.x) {
        const int rb = tile / NT, tn = tile % NT, e = moe_block_expert(cnt, rb);
        const bf16_t* a0 = p.H + (size_t)p.slotTok[rb * 128 + STG_ROW(0)] * D + STG_K; const bf16_t* a1 = p.H + (size_t)p.slotTok[rb * 128 + STG_ROW(1)] * D + STG_K;
        const bf16_t* bw = p.wgu_t + (size_t)e * 2 * DE * D;
        const bf16_t* b0 = bw + (size_t)(tn * 128 + STG_ROW(0)) * D + STG_K; const bf16_t* b1 = bw + (size_t)(tn * 128 + STG_ROW(1)) * D + STG_K;
        gemm_tile(a0, a1, b0, b1, D, lds, [&](const f32x4 (&acc)[4][4], int wr, int wc, int fr, int fq) {
#pragma unroll
            for (int m = 0; m < 4; ++m)
#pragma unroll
                for (int n2 = 0; n2 < 2; ++n2) { const int col = tn * 64 + wc * 32 + n2 * 16 + fr;
#pragma unroll
                    for (int j = 0; j < 4; ++j) { const float g = acc[m][2 * n2][j], u = acc[m][2 * n2 + 1][j];
                        p.ACT[(size_t)(rb * 128 + wr * 64 + m * 16 + fq * 4 + j) * DE + col] = f2bf(g / (1.0f + __expf(-g)) * u); } }
        });
    }
}
__device__ __forceinline__ void g_moe2(const Params& p, int l, char* lds) {
    const int* cnt = p.cnt + l * NEXP; const int nrb = moe_blocks(cnt); constexpr int NT = D / 128;
    for (int tile = blockIdx.x; tile < nrb * NT; tile += gridDim.x) {
        const int rb = tile / NT, tn = tile % NT, e = moe_block_expert(cnt, rb);
        const bf16_t* a0 = p.ACT + (size_t)(rb * 128 + STG_ROW(0)) * DE + STG_K; const bf16_t* a1 = p.ACT + (size_t)(rb * 128 + STG_ROW(1)) * DE + STG_K;
        const bf16_t* bw = p.wd_t + (size_t)e * D * DE;
        const bf16_t* b0 = bw + (size_t)(tn * 128 + STG_ROW(0)) * DE + STG_K; const bf16_t* b1 = bw + (size_t)(tn * 128 + STG_ROW(1)) * DE + STG_K;
        gemm_tile(a0, a1, b0, b1, DE, lds, [&](const f32x4 (&acc)[4][4], int wr, int wc, int fr, int fq) {
#pragma unroll
            for (int m = 0; m < 4; ++m)
#pragma unroll
                for (int n = 0; n < 4; ++n)
#pragma unroll
                    for (int j = 0; j < 4; ++j) p.YS[(size_t)(rb * 128 + wr * 64 + m * 16 + fq * 4 + j) * D + tn * 128 + wc * 64 + n * 16 + fr] = acc[m][n][j];
        });
    }
}


constexpr int DV = D / 256;
static_assert(D % 256 == 0, "row phases hold a row as DV float4 per lane");
__device__ __forceinline__ float wave_sum(float v) {
#pragma unroll
    for (int o = 1; o < 64; o <<= 1) v += __shfl_xor(v, o);
    return v;
}
__device__ __forceinline__ float sum4(f32x4 a) { return (a[0] + a[1]) + (a[2] + a[3]); }
#define LDS_WAIT() asm volatile("s_waitcnt lgkmcnt(0)" ::: "memory")

__device__ __forceinline__ void row_stats(const f32x4 (&v)[DV], float& mu, float& rstd) {
    float s = 0.f;
#pragma unroll
    for (int j = 0; j < DV; ++j) s += sum4(v[j]);
    mu = wave_sum(s) * (1.0f / D);
    float q = 0.f;
#pragma unroll
    for (int j = 0; j < DV; ++j) { const f32x4 d = v[j] - mu; q += sum4(d * d); }
    rstd = 1.0f / sqrtf(wave_sum(q) * (1.0f / D) + LN_EPS);
}

__device__ void ph_lnmod_fast(const Params& p, int l) {
    const int lane = threadIdx.x & 63, gw = blockIdx.x * 4 + (threadIdx.x >> 6), nw = gridDim.x * 4;
    for (int m = gw; m < T; m += nw) {
        const f32x4* xr = (const f32x4*)xrow_in(p, l, m) + lane; const f32x4* md = (const f32x4*)modrow(p, l, m) + lane;
        f32x4 v[DV];
#pragma unroll
        for (int j = 0; j < DV; ++j) v[j] = xr[64 * j];
        float mu, rstd; row_stats(v, mu, rstd);
#pragma unroll
        for (int j = 0; j < DV; ++j) { const f32x4 sh = md[64 * j], sc = md[D / 4 + 64 * j];
            st_bf16x4(p.H + (size_t)m * D + 4 * (lane + 64 * j), (v[j] - mu) * rstd * (sc + 1.0f) + sh); }
    }
}

__device__ void ph_post_mixer_fast(const Params& p, int l, int nrows) {
    const int lane = threadIdx.x & 63, gw = blockIdx.x * 4 + (threadIdx.x >> 6), nw = gridDim.x * 4;
    for (int m = gw; m < nrows; m += nw) {
        const f32x4* xr = (const f32x4*)xrow_in(p, l, m) + lane; const f32x4* md = (const f32x4*)modrow(p, l, m) + lane;
        const f32x4* orow = (const f32x4*)(p.O + (size_t)m * D) + lane;
        f32x4* x1 = (f32x4*)((m < TL) ? p.out + (size_t)m * D : p.XC + (size_t)(m - TL) * D) + lane;
        const f32x4* g1 = (const f32x4*)(p.ln1_g + (size_t)l * D) + lane; const f32x4* b1 = (const f32x4*)(p.ln1_b + (size_t)l * D) + lane;
        f32x4 v[DV];
#pragma unroll
        for (int j = 0; j < DV; ++j) v[j] = xr[64 * j] * ALPHA + md[2 * (D / 4) + 64 * j] * orow[64 * j];
        float mu, rstd; row_stats(v, mu, rstd);
#pragma unroll
        for (int j = 0; j < DV; ++j) { v[j] = (v[j] - mu) * rstd * g1[64 * j] + b1[64 * j]; x1[64 * j] = v[j]; }
        row_stats(v, mu, rstd);
        float gl[4], el[32];
#pragma unroll
        for (int g = 0; g < 4; ++g) gl[g] = 0.f;
#pragma unroll
        for (int e = 0; e < 32; ++e) el[e] = 0.f;
#pragma unroll
        for (int j = 0; j < DV; ++j) {
            const f32x4 hv = (v[j] - mu) * rstd * (md[4 * (D / 4) + 64 * j] + 1.0f) + md[3 * (D / 4) + 64 * j];
            st_bf16x4(p.H + (size_t)m * D + 4 * (lane + 64 * j), hv);
#pragma unroll
            for (int i = 0; i < 4; ++i) {
                const int k = 4 * (lane + 64 * j) + i;
                const f32x4 wg = *(const f32x4*)(p.w_rg + ((size_t)l * D + k) * 4);
#pragma unroll
                for (int g = 0; g < 4; ++g) gl[g] += hv[i] * wg[g];
                const f32x4* we = (const f32x4*)(p.w_re + ((size_t)l * D + k) * 32);
#pragma unroll
                for (int e4 = 0; e4 < 8; ++e4) { const f32x4 w = we[e4];
#pragma unroll
                    for (int g = 0; g < 4; ++g) el[4 * e4 + g] += hv[i] * w[g]; }
            }
        }
#pragma unroll
        for (int g = 0; g < 4; ++g) gl[g] = wave_sum(gl[g]) + p.b_rg[l * 4 + g];
#pragma unroll
        for (int e = 0; e < 32; ++e) el[e] = wave_sum(el[e]) + p.b_re[l * 32 + e];
        int gs = 0; float gm = gl[0];
#pragma unroll
        for (int g = 1; g < 4; ++g) if (gl[g] > gm) { gm = gl[g]; gs = g; }
        float den = 0.f;
#pragma unroll
        for (int g = 0; g < 4; ++g) den += expf(gl[g] - gm);
        const float pg = 1.0f / den;
        float v1 = -3e38f, v2 = -3e38f; int i1 = 0, i2 = 0;
#pragma unroll
        for (int j = 0; j < 8; ++j) {
            const float vv = gs == 0 ? el[j] : gs == 1 ? el[8 + j] : gs == 2 ? el[16 + j] : el[24 + j];
            if (vv > v1) { v2 = v1; i2 = i1; v1 = vv; i1 = j; } else if (vv > v2) { v2 = vv; i2 = j; }
        }
        if (lane == 0) {
            const float e2 = expf(v2 - v1), w1 = pg / (1.0f + e2), w2 = pg * e2 / (1.0f + e2);
            const int ea = gs * 8 + i1, eb = gs * 8 + i2;
            p.rE[2 * m] = ea; p.rE[2 * m + 1] = eb; p.rW[2 * m] = w1; p.rW[2 * m + 1] = w2;
            p.rPos[2 * m] = atomicAdd(p.cnt + l * NEXP + ea, 1); p.rPos[2 * m + 1] = atomicAdd(p.cnt + l * NEXP + eb, 1);
        }
    }
}

__device__ void ph_final_fast(const Params& p, int l, int nrows) {
    const int lane = threadIdx.x & 63, gw = blockIdx.x * 4 + (threadIdx.x >> 6), nw = gridDim.x * 4;
    for (int m = gw; m < nrows; m += nw) {
        f32x4* x1 = (f32x4*)((m < TL) ? p.out + (size_t)m * D : p.XC + (size_t)(m - TL) * D) + lane;
        const f32x4* md = (const f32x4*)modrow(p, l, m) + lane;
        const f32x4* ya = (const f32x4*)(p.YS + (size_t)p.rSlot[2 * m] * D) + lane; const f32x4* yb = (const f32x4*)(p.YS + (size_t)p.rSlot[2 * m + 1] * D) + lane;
        const float wa = p.rW[2 * m], wb = p.rW[2 * m + 1];
        const f32x4* g2 = (const f32x4*)(p.ln2_g + (size_t)l * D) + lane; const f32x4* b2 = (const f32x4*)(p.ln2_b + (size_t)l * D) + lane;
        f32x4 v[DV];
#pragma unroll
        for (int j = 0; j < DV; ++j) v[j] = x1[64 * j] * ALPHA + md[5 * (D / 4) + 64 * j] * (ya[64 * j] * wa + yb[64 * j] * wb);
        float mu, rstd; row_stats(v, mu, rstd);
#pragma unroll
        for (int j = 0; j < DV; ++j) x1[64 * j] = (v[j] - mu) * rstd * g2[64 * j] + b2[64 * j];
    }
}

__device__ __forceinline__ void tr_item(const float* srcl, size_t ldw, bf16_t* dst, size_t ldd, float* scr, int lane) {
#pragma unroll 8
    for (int i = 0; i < 32; ++i) { const int kk = 2 * i + (lane >> 5); scr[kk * 33 + (lane & 31)] = srcl ? srcl[(size_t)kk * ldw] : 0.f; }
    LDS_WAIT();
    const int c = lane & 7;
#pragma unroll
    for (int j = 0; j < 4; ++j) { const int n = (lane >> 3) + 8 * j; const float* s = scr + (8 * c) * 33 + n;
        uint4 o; o.x = pk2(s[0], s[33]); o.y = pk2(s[2 * 33], s[3 * 33]); o.z = pk2(s[4 * 33], s[5 * 33]); o.w = pk2(s[6 * 33], s[7 * 33]);
        *(uint4*)(dst + (size_t)n * ldd + 8 * c) = o; }
    LDS_WAIT();
}
__device__ void ph_prep_w_fast(const Params& p, int l, char* lds) {
    const int lane = threadIdx.x & 63, wid = threadIdx.x >> 6, gw = blockIdx.x * 4 + wid, nw = gridDim.x * 4;
    float* scr = (float*)(lds + wid * 8448);
    constexpr int I_IN = (D / 64) * (NINP / 32), I_OUT = (DMIX / 64) * (D / 32), I_GU1 = (D / 64) * (2 * DE / 32), I_D1 = (DE / 64) * (D / 32);
    constexpr int NITEMS = I_IN + I_OUT + NEXP * (I_GU1 + I_D1);
    for (int it = gw; it < NITEMS; it += nw) {
        int r = it;
        if (r < I_IN) { const int kb = r / (NINP / 32), n0 = 32 * (r % (NINP / 32));
            const float* s = nullptr;
            if (n0 < N_IN) { const int oc = (n0 < ZA) ? n0 + A_IN : n0 - ZA; s = p.w_in + ((size_t)l * D + 64 * kb) * N_IN + oc + (lane & 31); }
            tr_item(s, N_IN, p.win_t + (size_t)n0 * D + 64 * kb, D, scr, lane); continue; }
        r -= I_IN;
        if (r < I_OUT) { const int kb = r / (D / 32), n0 = 32 * (r % (D / 32));
            tr_item(p.w_out + ((size_t)l * DMIX + 64 * kb) * D + n0 + (lane & 31), D, p.wout_t + (size_t)n0 * DMIX + 64 * kb, DMIX, scr, lane); continue; }
        r -= I_OUT;
        const int e = r / (I_GU1 + I_D1); r %= (I_GU1 + I_D1);
        if (r < I_GU1) { const int kb = r / (2 * DE / 32), q = r % (2 * DE / 32);
            const float* s = (((lane & 31) >> 4) ? p.w_up : p.w_gate) + (((size_t)l * NEXP + e) * D + 64 * kb) * DE + 16 * q + (lane & 15);
            tr_item(s, DE, p.wgu_t + ((size_t)e * 2 * DE + 32 * q) * D + 64 * kb, D, scr, lane); continue; }
        r -= I_GU1;
        { const int kb = r / (D / 32), n0 = 32 * (r % (D / 32));
            tr_item(p.w_down + (((size_t)l * NEXP + e) * DE + 64 * kb) * D + n0 + (lane & 31), D, p.wd_t + ((size_t)e * D + n0) * DE + 64 * kb, DE, scr, lane); }
    }
    const long gt = (long)blockIdx.x * blockDim.x + threadIdx.x, gs = (long)gridDim.x * blockDim.x;
    for (long i = gt; i < 2 * 256 * 64; i += gs) { const int k = (int)(i & 63), n = (int)((i >> 6) & 255), d = (int)(i >> 14);
        p.wupT[i] = f2bf(p.a_w_up[(((size_t)l * 2 + d) * 64 + k) * DA + n]); p.aupT[i] = f2bf(p.a_a_up[(((size_t)l * 2 + d) * 64 + k) * DA + n]); }
    for (long i = gt; i < 256 * 160; i += gs) { const int k = (int)(i % 160), n = (int)(i / 160); p.gupT[i] = f2bf(p.a_g_up[((size_t)l * 160 + k) * DA + n]); }
}

__device__ void ph_streams_s1(const Params& p, int l) {
    const int lane = threadIdx.x & 63, gw = blockIdx.x * 4 + (threadIdx.x >> 6), nw = gridDim.x * 4;
    const float* sh = p.a_shift + (size_t)l * 3 * A_IN;
    for (int m = gw; m < T; m += nw) {
        int t, len;
        if (m < TL) { t = m % S; len = S; } else { t = (m - TL) % L; len = L; }
        const bool hp = t > 0, hn = t < len - 1;
        const bf16_t* z = p.Z + (size_t)m * ZP + ZA;
#pragma unroll 1
        for (int i = 0; i < (A_IN + 63) / 64; ++i) {
            const int c = 64 * i + lane; float v = 0.f;
            if (c < A_IN) {
                v = sh[A_IN + c] * bf2f(z[c]);
                if (hp) v += sh[c] * bf2f(z[c - ZP]);
                if (hn) v += sh[2 * A_IN + c] * bf2f(z[c + ZP]);
                if (c < 256) p.sR[(size_t)m * DA + c] = v;
                else if (c < 512) p.kT[(size_t)m * DA + c - 256] = v;
                else if (c < 768) p.sV[(size_t)m * DA + c - 512] = v;
                else if (c < 896) p.LA[(size_t)m * 416 + c - 768] = f2bf(tanhf(v));
                else if (c < 1024) p.LA[(size_t)m * 416 + c - 768] = f2bf(v);
                else p.LA[(size_t)m * 416 + c - 768] = f2bf(sigmoidf_(v));
            }
            if (i >= 4 && i < 8) {
                const float t2 = v * p.a_k_k[l * DA + c - 256]; const float nrm = wave_sum(t2 * t2);
                if (lane == 0) p.kN[(size_t)m * 4 + i - 4] = 1.0f / sqrtf(nrm + 1e-12f);
            }
        }
    }
}
__device__ void g_streams_s2(const Params& p, int l, char* lds) {
    constexpr int MT = T / 128;
    for (int job = blockIdx.x; job < 5 * MT * 2; job += gridDim.x) {
        const int type = job / (MT * 2), r = job % (MT * 2), tm = r >> 1, tn = r & 1;
        const int coff = type < 2 ? type * 64 : type < 4 ? 128 + (type - 2) * 64 : 256, K = type < 4 ? 64 : 160, d = type & 1;
        const bf16_t* Bt = type < 2 ? p.wupT + type * 256 * 64 : type < 4 ? p.aupT + (type - 2) * 256 * 64 : p.gupT;
        const bf16_t* a0 = p.LA + (size_t)(tm * 128 + STG_ROW(0)) * 416 + coff + STG_K; const bf16_t* a1 = p.LA + (size_t)(tm * 128 + STG_ROW(1)) * 416 + coff + STG_K;
        const bf16_t* b0 = Bt + (size_t)(tn * 128 + STG_ROW(0)) * K + STG_K; const bf16_t* b1 = Bt + (size_t)(tn * 128 + STG_ROW(1)) * K + STG_K;
        if (type < 2) gemm_tile(a0, a1, b0, b1, K, lds, [&](const f32x4 (&acc)[4][4], int wr, int wc, int fr, int fq) {
#pragma unroll
            for (int mi = 0; mi < 4; ++mi) {
#pragma unroll
                for (int n = 0; n < 4; ++n) { const int c = tn * 128 + wc * 64 + n * 16 + fr; const float w0 = p.a_w0[(l * 2 + d) * DA + c];
#pragma unroll
                    for (int j = 0; j < 4; ++j) { const int row = tm * 128 + wr * 64 + mi * 16 + fq * 4 + j;
                        const float e = __expf(-(w0 + acc[mi][n][j]));
                        p.sW[((size_t)d * T + row) * DA + c] = __expf(-0.60653065971f / (1.0f + e)); } }
                asm volatile("" ::: "memory"); }
        });
        else if (type < 4) gemm_tile(a0, a1, b0, b1, K, lds, [&](const f32x4 (&acc)[4][4], int wr, int wc, int fr, int fq) {
#pragma unroll
            for (int mi = 0; mi < 4; ++mi) {
#pragma unroll
                for (int n = 0; n < 4; ++n) { const int c = tn * 128 + wc * 64 + n * 16 + fr;
                    const float a0v = p.a_a0[(l * 2 + d) * DA + c], kkc = p.a_k_k[l * DA + c], kac = p.a_k_a[l * DA + c];
#pragma unroll
                    for (int j = 0; j < 4; ++j) { const int row = tm * 128 + wr * 64 + mi * 16 + fq * 4 + j;
                        const size_t o = (size_t)row * DA + c, od = ((size_t)d * T + row) * DA + c;
                        const float av = 1.0f / (1.0f + __expf(-(a0v + acc[mi][n][j]))); const float k = p.kT[o];
                        const float kk = k * kkc * p.kN[(size_t)row * 4 + (c >> 6)];
                        p.sKD[od] = k * (1.0f + (av - 1.0f) * kac); p.sB[od] = kk * av; if (d == 0) p.sKK[o] = kk; } }
                asm volatile("" ::: "memory"); }
        });
        else gemm_tile(a0, a1, b0, b1, K, lds, [&](const f32x4 (&acc)[4][4], int wr, int wc, int fr, int fq) {
#pragma unroll
            for (int mi = 0; mi < 4; ++mi)
#pragma unroll
                for (int n = 0; n < 4; ++n) { const int c = tn * 128 + wc * 64 + n * 16 + fr;
#pragma unroll
                    for (int j = 0; j < 4; ++j) p.sG[(size_t)(tm * 128 + wr * 64 + mi * 16 + fq * 4 + j) * DA + c] = acc[mi][n][j]; }
        });
    }
}


typedef float f32x16 __attribute__((ext_vector_type(16)));
typedef short s16x4 __attribute__((ext_vector_type(4)));
typedef unsigned u32x4_t __attribute__((ext_vector_type(4)));
typedef float f32x2_t __attribute__((ext_vector_type(2)));
typedef __bf16 bf16x2_t __attribute__((ext_vector_type(2)));
__device__ __forceinline__ unsigned cvtpk(float lo, float hi) { f32x2_t v = {lo, hi}; bf16x2_t b = __builtin_convertvector(v, bf16x2_t); return __builtin_bit_cast(unsigned, b); }
__device__ __forceinline__ int crow(int r, int hi) { return (r & 3) + 8 * (r >> 2) + 4 * hi; }

template <class MaskF>
__device__ __forceinline__ void attn_tile(const bf16x8 (&qf)[4], const bf16_t* krow, const bf16_t* vt0, const bf16_t* vt1, const MaskF& mask,
                                          float& m_run, float& l_run, f32x16& o0, f32x16& o1, int hi) {
    f32x16 s;
#pragma unroll
    for (int r = 0; r < 16; ++r) s[r] = 0.f;
#pragma unroll
    for (int ks = 0; ks < 4; ++ks) { const bf16x8 kf = *(const bf16x8*)(krow + 16 * ks); s = __builtin_amdgcn_mfma_f32_32x32x16_bf16(kf, qf[ks], s, 0, 0, 0); }
    float mx = -INFINITY;
#pragma unroll
    for (int r = 0; r < 16; ++r) { s[r] = mask(crow(r, hi), s[r] * ATT_SCALE); mx = fmaxf(mx, s[r]); }
    mx = fmaxf(mx, __shfl_xor(mx, 32));
    const float mn = fmaxf(m_run, mx), alpha = __expf(m_run - mn);
    m_run = mn;
    float ps = 0.f;
#pragma unroll
    for (int r = 0; r < 16; ++r) { s[r] = __expf(s[r] - mn); ps += s[r]; }
    l_run = l_run * alpha + ps;
#pragma unroll
    for (int r = 0; r < 16; ++r) { o0[r] *= alpha; o1[r] *= alpha; }
#pragma unroll
    for (int s2 = 0; s2 < 2; ++s2) {
        u32x4_t pw; pw[0] = cvtpk(s[8 * s2], s[8 * s2 + 1]); pw[1] = cvtpk(s[8 * s2 + 2], s[8 * s2 + 3]); pw[2] = cvtpk(s[8 * s2 + 4], s[8 * s2 + 5]); pw[3] = cvtpk(s[8 * s2 + 6], s[8 * s2 + 7]);
        const bf16x8 pb = __builtin_bit_cast(bf16x8, pw);
        const s16x4 a0 = *(const s16x4*)(vt0 + 16 * s2), a1 = *(const s16x4*)(vt0 + 16 * s2 + 8);
        const s16x4 c0 = *(const s16x4*)(vt1 + 16 * s2), c1 = *(const s16x4*)(vt1 + 16 * s2 + 8);
        o0 = __builtin_amdgcn_mfma_f32_32x32x16_bf16(__builtin_shufflevector(a0, a1, 0, 1, 2, 3, 4, 5, 6, 7), pb, o0, 0, 0, 0);
        o1 = __builtin_amdgcn_mfma_f32_32x32x16_bf16(__builtin_shufflevector(c0, c1, 0, 1, 2, 3, 4, 5, 6, 7), pb, o1, 0, 0, 0);
    }
}
struct NoMask { __device__ __forceinline__ float operator()(int, float v) const { return v; } };

__device__ void ph_attn_mfma(const Params& p, int l, bool with_ctx) {
    const int lane = threadIdx.x & 63, hi = lane >> 5, ql = lane & 31;
    const int gw = blockIdx.x * 4 + (threadIdx.x >> 6), nw = gridDim.x * 4;
    constexpr int NQT = S / 32, NCT = L / 32, N_LAT = NB * 6 * NQT, N_CTX = NB * 6 * NCT;
    const int ntask = 2 * N_LAT + (with_ctx ? 2 * N_CTX : 0);
    for (int task = gw; task < ntask; task += nw) {
        bool isC, isCtx; int r;
        if (task < N_LAT) { isC = true; isCtx = false; r = task; }
        else if (task < 2 * N_LAT) { isC = false; isCtx = false; r = task - N_LAT; }
        else { r = task - 2 * N_LAT; isCtx = true; isC = r >= N_CTX; if (isC) r -= N_CTX; }
        const int nqt = isCtx ? NCT : NQT, qt = r % nqt, h = (r / nqt) % 6, b = r / (nqt * 6);
        const int m = isCtx ? TL + b * L + 32 * qt + ql : b * S + 32 * qt + ql;
        const int qcol = isC ? ZQN + h * 64 : ZQB + h * 64, kcol = isC ? ZKN + h * 64 : ZKB + (h / 3) * 64, hv = isC ? 2 + h : h / 3;
        bf16x8 qf[4];
        { const bf16_t* qp = p.Z + (size_t)m * ZP + qcol + 8 * hi;
#pragma unroll
          for (int ks = 0; ks < 4; ++ks) qf[ks] = *(const bf16x8*)(qp + 16 * ks); }
        const bf16_t* kc0 = p.Z + (size_t)(TL + b * L + ql) * ZP + kcol + 8 * hi;
        const bf16_t* kl0 = p.Z + (size_t)(b * S + ql) * ZP + kcol + 8 * hi;
        const bf16_t* vt0 = p.VT + ((size_t)(b * 8 + hv) * 64 + ql) * PU + 4 * hi; const bf16_t* vt1 = vt0 + (size_t)32 * PU;
        f32x16 o0, o1;
#pragma unroll
        for (int rr = 0; rr < 16; ++rr) { o0[rr] = 0.f; o1[rr] = 0.f; }
        float m_run, l_run;
        if (isC) { m_run = -1e30f; l_run = 0.f; } else { m_run = p.b_sink[l * 6 + h]; l_run = hi == 0 ? 1.0f : 0.f; }
        for (int i = 0; i < NCT; ++i) attn_tile(qf, kc0 + (size_t)(32 * i) * ZP, vt0 + 32 * i, vt1 + 32 * i, NoMask(), m_run, l_run, o0, o1, hi);
        if (!isCtx) {
            if (!isC) {
                for (int jt = qt - 4; jt <= qt + 4; ++jt) {
                    if (jt < 0 || jt >= NQT) continue;
                    const bf16_t* kr = kl0 + (size_t)(32 * jt) * ZP; const bf16_t* v0 = vt0 + L + 32 * jt; const bf16_t* v1 = vt1 + L + 32 * jt;
                    if (jt == qt - 4 || jt == qt + 4) { const int base = 32 * (jt - qt) - ql;
                        attn_tile(qf, kr, v0, v1, [&](int ko, float v) { const int rel = base + ko; return (rel >= -128 && rel <= 128) ? v : -INFINITY; }, m_run, l_run, o0, o1, hi); }
                    else attn_tile(qf, kr, v0, v1, NoMask(), m_run, l_run, o0, o1, hi);
                }
            } else {
                constexpr int ROWS = S / GRID_W;
                const int gr = qt >> 1, c = 32 * (qt & 1) + ql;
                int r0 = gr - 4; r0 = r0 < 0 ? 0 : (r0 > ROWS - 8 ? ROWS - 8 : r0);
                int c0 = c - 8; c0 = c0 < 0 ? 0 : (c0 > GRID_W - 16 ? GRID_W - 16 : c0);
                const float* rpb = p.c_rpb + ((size_t)l * 6 + h) * 15 * 31;
                for (int a = 0; a < 8; ++a) {
                    const int kr_ = r0 + a; const float* rp = rpb + (kr_ - gr + 7) * 31 + 15 - c;
#pragma unroll
                    for (int ct = 0; ct < 2; ++ct) {
                        const int t0 = kr_ * GRID_W + 32 * ct;
                        attn_tile(qf, kl0 + (size_t)t0 * ZP, vt0 + L + t0, vt1 + L + t0,
                                  [&](int ko, float v) { const int kc = 32 * ct + ko; return (kc >= c0 && kc < c0 + 16) ? v + rp[kc] : -INFINITY; }, m_run, l_run, o0, o1, hi);
                    }
                }
            }
        }
        const float lt = l_run + __shfl_xor(l_run, 32), inv = 1.0f / lt;
        bf16_t* op = p.MIX + (size_t)m * DMIX + (isC ? 640 : 256) + h * 64 + 4 * hi;
#pragma unroll
        for (int g = 0; g < 4; ++g) {
            st_bf16x4(op + 8 * g, (f32x4){o0[4 * g] * inv, o0[4 * g + 1] * inv, o0[4 * g + 2] * inv, o0[4 * g + 3] * inv});
            st_bf16x4(op + 32 + 8 * g, (f32x4){o1[4 * g] * inv, o1[4 * g + 1] * inv, o1[4 * g + 2] * inv, o1[4 * g + 3] * inv});
        }
    }
}

#define GT ((long)blockIdx.x * blockDim.x + threadIdx.x)
#define GS ((long)gridDim.x * blockDim.x)
__global__ void __launch_bounds__(256) mega_fwd(Params p) {
    __shared__ __attribute__((aligned(16))) char lds[34816];
    cg::grid_group grid = cg::this_grid();
    const long gt = GT, gs = GS;
    ph_prep_w_fast(p, 0, lds); ph_prep_misc(p, 0, gt, gs);
    grid.sync();
    for (int l = 0; l < 2; ++l) {
        const int nrows = (l == 0) ? T : TL;
        ph_lnmod_fast(p, l);
        grid.sync();
        g_gemm_in(p, lds);
        grid.sync();
        ph_streams_s1(p, l); ph_rope(p, gt, gs);
        grid.sync();
        g_streams_s2(p, l, lds);
        grid.sync();
        ph_scan(p, gt, gs); ph_attn_mfma(p, l, l == 0);
        grid.sync();
        ph_rwkv_out(p, l, nrows, gt, gs);
        grid.sync();
        g_gemm_out(p, nrows, lds);
        grid.sync();
        ph_post_mixer_fast(p, l, nrows);
        grid.sync();
        ph_dispatch(p, l, nrows, gt, gs);
        grid.sync();
        g_moe1(p, l, lds);
        grid.sync();
        g_moe2(p, l, lds);
        grid.sync();
        ph_final_fast(p, l, nrows);
        if (l == 0) { ph_prep_w_fast(p, 1, lds); ph_prep_misc(p, 1, gt, gs); }
        grid.sync();
    }
}

extern "C" void kernel_launch(void* const* d_in, const int* in_sizes, int n_in, void* d_out, int out_size, void* d_ws, size_t ws_size, hipStream_t stream) {
    if (n_in != 32 || out_size != TL * D || ws_size < WS_NEED) { fprintf(stderr, "kernel_launch: unexpected shapes / workspace (n_in %d out %d ws %zu need %zu)\n", n_in, out_size, ws_size, (size_t)WS_NEED); return; }
    static int grid_blocks = 0;
    if (!grid_blocks) {
        int dev = 0, cus = 0, per_cu = 0;
        (void)hipGetDevice(&dev);
        (void)hipDeviceGetAttribute(&cus, hipDeviceAttributeMultiprocessorCount, dev);
        (void)hipOccupancyMaxActiveBlocksPerMultiprocessor(&per_cu, mega_fwd, 256, 0);
        if (per_cu < 1) per_cu = 1;
        if (per_cu > 4) per_cu = 4;
        grid_blocks = cus * per_cu;
        fprintf(stderr, "kernel_launch: %d CUs x %d blocks\n", cus, per_cu);
    }
    Params p = make_params(d_in, d_out, d_ws);
    void* args[] = {&p};
    hipError_t e = hipLaunchCooperativeKernel((void*)mega_fwd, dim3(grid_blocks), dim3(256), args, 0, stream);
    if (e != hipSuccess) fprintf(stderr, "cooperative launch failed: %s (grid %d)\n", hipGetErrorString(e), grid_blocks);
}
#endif

#ifdef HOST_EMU
static void host_forward(void* const* d_in, void* d_out, void* d_ws) {
    const Params p = make_params(d_in, d_out, d_ws);
    for (int l = 0; l < 2; ++l) {
        const int nrows = (l == 0) ? T : TL;
        ph_prep_w(p, l, 0, 1); ph_prep_misc(p, l, 0, 1); ph_lnmod(p, l, 0, 1); host_gemm_in(p); ph_streams(p, l, 0, 1); ph_rope(p, 0, 1); ph_scan(p, 0, 1);
        ph_attn(p, l, nrows, 0, 1); ph_rwkv_out(p, l, nrows, 0, 1); host_gemm_out(p, nrows); ph_post_mixer(p, l, nrows, 0, 1);
        ph_dispatch(p, l, nrows, 0, 1); host_moe1(p, l); host_moe2(p, l); ph_final(p, l, nrows, 0, 1);
    }
}
#endif
```

```cpp
#ifdef HOST_EMU
#include <cmath>
#include <cstdio>
#include <cstring>
#include <cstdint>
#include <cstdlib>
#define __device__
#define __global__
#define __host__
#define __forceinline__ inline
#else
#include <hip/hip_runtime.h>
#include <hip/hip_cooperative_groups.h>
#include <cstdio>
#include <cstdint>
namespace cg = cooperative_groups;
#endif

#ifndef CFG_D
#define CFG_D 1024
#define CFG_B 8
#define CFG_S 2048
#define CFG_L 256
#define CFG_DE 512
#endif
constexpr int D = CFG_D, NB = CFG_B, S = CFG_S, L = CFG_L, DE = CFG_DE;
constexpr int TL = NB * S, TC = NB * L, T = TL + TC;
constexpr int GRID_W = 64, HD = 64;
constexpr int DA = 256, A_IN = 1184, N_IN = 2976, NINP = 3072, DMIX = 1024;
constexpr int NEXP = 32, NSLOT = 2 * T + NEXP * 128;
constexpr int ZQB = 0, ZKB = 384, ZVB = 512, ZQN = 640, ZKN = 1024, ZVN = 1408, ZA = 1792, ZP = 2976;
constexpr float LN_EPS = 1e-6f, GN_EPS = 64e-5f, ATT_SCALE = 0.125f;
constexpr float ALPHA = 1.41421356237309515f;

typedef unsigned short bf16_t;

__device__ __forceinline__ float bf2f(bf16_t v) {
    unsigned u = ((unsigned)v) << 16; float f;
#ifdef HOST_EMU
    memcpy(&f, &u, 4);
#else
    f = __uint_as_float(u);
#endif
    return f;
}
__device__ __forceinline__ bf16_t f2bf(float f) {
    unsigned u;
#ifdef HOST_EMU
    memcpy(&u, &f, 4);
#else
    u = __float_as_uint(f);
#endif
    return (bf16_t)((u + 0x7fffu + ((u >> 16) & 1u)) >> 16);
}
__device__ __forceinline__ float sigmoidf_(float x) { return 1.0f / (1.0f + expf(-x)); }
__device__ __forceinline__ float siluf_(float x) { return x / (1.0f + expf(-x)); }
__device__ __forceinline__ int atomic_inc_int(int* p) {
#ifdef HOST_EMU
    int o = *p; *p = o + 1; return o;
#else
    return atomicAdd(p, 1);
#endif
}

struct Params {
    const float *x, *c, *ctx, *c_ctx, *w_mod, *b_mod, *w_in, *w_out, *a_shift, *a_w0, *a_w_up, *a_a0, *a_a_up, *a_g_up,
        *a_k_k, *a_k_a, *a_r_k, *a_lnx_g, *a_lnx_b, *b_sink, *c_rpb, *ln1_g, *ln1_b, *ln2_g, *ln2_b, *w_rg, *b_rg, *w_re,
        *b_re, *w_gate, *w_up, *w_down;
    float* out;
    int* cnt;
    float* mod;
    float* rope;
    bf16_t *win_t, *wout_t, *wgu_t, *wd_t;
    bf16_t *wupT, *aupT, *gupT;
    bf16_t* LA;
    float *kT, *kN;
    bf16_t* H;
    bf16_t* Z;
    bf16_t* VT;
    float *sR, *sV, *sKK, *sG, *sW, *sKD, *sB;
    float* Y;
    bf16_t* MIX;
    float *PV, *QS, *PS, *SS;
    float* XC;
    float* O;
    int *rE, *rPos, *rSlot; float* rW;
    int* slotTok;
    bf16_t* ACT;
    float* YS;
};

constexpr size_t al256(size_t v) { return (v + 255) & ~(size_t)255; }
constexpr size_t OFF_CNT = 0;
constexpr size_t OFF_MOD = 4096;
constexpr size_t OFF_ROPE = al256(OFF_MOD + (size_t)2 * (NB + 1) * 6 * D * 4);
constexpr size_t OFF_LORA = al256(OFF_ROPE + 64 * 16 * 2 * 4);
constexpr size_t OFF_WIN = al256(OFF_LORA + (size_t)(2 * 256 * 64 * 2 + 256 * 160) * 2);
constexpr size_t OFF_WOUT = al256(OFF_WIN + (size_t)NINP * D * 2);
constexpr size_t OFF_WGU = al256(OFF_WOUT + (size_t)D * DMIX * 2);
constexpr size_t OFF_WD = al256(OFF_WGU + (size_t)NEXP * 2 * DE * D * 2);
constexpr size_t OFF_H = al256(OFF_WD + (size_t)NEXP * D * DE * 2);
constexpr size_t OFF_Z = al256(OFF_H + (size_t)(T + 1) * D * 2);
constexpr int PU = L + S;
constexpr int NSG = (L + S) / 128;
static_assert((size_t)3 * 64 * ((L + S) / 128) * 4096 * 4 <= (size_t)NEXP * 2 * DE * D * 2 || (L % 128) != 0, "scan segment states overlay wgu_t");
constexpr size_t OFF_VT = al256(OFF_Z + (size_t)T * ZP * 2);
constexpr size_t OFF_S = al256(OFF_VT + (size_t)NB * 8 * 64 * PU * 2);
constexpr size_t S1 = (size_t)T * 256 * 4;
constexpr size_t OFF_Y = al256(OFF_S + 10 * S1);
constexpr size_t OFF_MIX = al256(OFF_Y + 2 * S1);
constexpr size_t OFF_XC = al256(OFF_MIX + (size_t)T * 1024 * 2);
constexpr size_t OFF_ROUTE = al256(OFF_XC + (size_t)TC * D * 4);
constexpr size_t OFF_SLOTTOK = al256(OFF_ROUTE + (size_t)T * 2 * 4 * 4);
constexpr size_t WS_NEED = al256(OFF_SLOTTOK + (size_t)NSLOT * 4);
static_assert((size_t)NSLOT * DE * 2 <= (size_t)T * ZP * 2, "ACT overlays Z");
static_assert((size_t)T * 4 * 4 + (size_t)T * 416 * 2 <= S1, "kN + LA overlay Y[1]");
static_assert((size_t)NSLOT * D * 4 <= 10 * S1 && (size_t)T * D * 4 <= 10 * S1, "YS / O overlay the stream buffers");

static Params make_params(void* const* d_in, void* d_out, void* d_ws) {
    Params p{};
    const float** f = (const float**)&p.x;
    for (int i = 0; i < 32; ++i) f[i] = (const float*)d_in[i];
    p.out = (float*)d_out;
    char* w = (char*)d_ws;
    p.cnt = (int*)(w + OFF_CNT); p.mod = (float*)(w + OFF_MOD); p.rope = (float*)(w + OFF_ROPE);
    p.win_t = (bf16_t*)(w + OFF_WIN); p.wout_t = (bf16_t*)(w + OFF_WOUT); p.wgu_t = (bf16_t*)(w + OFF_WGU); p.wd_t = (bf16_t*)(w + OFF_WD);
    p.wupT = (bf16_t*)(w + OFF_LORA); p.aupT = p.wupT + 2 * 256 * 64; p.gupT = p.aupT + 2 * 256 * 64;
    p.H = (bf16_t*)(w + OFF_H); p.Z = (bf16_t*)(w + OFF_Z); p.VT = (bf16_t*)(w + OFF_VT);
    float* s = (float*)(w + OFF_S); const size_t n1 = (size_t)T * 256;
    p.sR = s; p.sV = s + n1; p.sKK = s + 2 * n1; p.sG = s + 3 * n1; p.sW = s + 4 * n1; p.sKD = s + 6 * n1; p.sB = s + 8 * n1;
    p.Y = (float*)(w + OFF_Y); p.MIX = (bf16_t*)(w + OFF_MIX); p.XC = (float*)(w + OFF_XC);
    p.O = (float*)(w + OFF_S);
    p.PV = (float*)(w + OFF_H); p.QS = (float*)(w + OFF_WGU); p.PS = p.QS + (size_t)64 * NSG * 4096; p.SS = p.PS + (size_t)64 * NSG * 4096;
    p.kT = p.Y; p.kN = p.Y + (size_t)T * 256; p.LA = (bf16_t*)(p.Y + (size_t)T * 256 + (size_t)T * 4);
    int* r = (int*)(w + OFF_ROUTE); p.rE = r; p.rPos = r + 2 * T; p.rSlot = r + 4 * T; p.rW = (float*)(r + 6 * T);
    p.slotTok = (int*)(w + OFF_SLOTTOK);
    p.ACT = (bf16_t*)(w + OFF_Z); p.YS = (float*)(w + OFF_S);
    return p;
}

__device__ void ph_prep_w(const Params& p, int l, long gtid, long gsz) {
    for (long i = gtid; i < (long)D * NINP; i += gsz) {
        const int k = (int)(i / NINP), n = (int)(i % NINP);
        float v = 0.f;
        if (n < N_IN) { const int oc = (n < ZA) ? n + A_IN : n - ZA; v = p.w_in[((size_t)l * D + k) * N_IN + oc]; }
        p.win_t[(size_t)n * D + k] = f2bf(v);
    }
    for (long i = gtid; i < (long)DMIX * D; i += gsz) {
        const int k = (int)(i / D), n = (int)(i % D);
        p.wout_t[(size_t)n * DMIX + k] = f2bf(p.w_out[((size_t)l * DMIX + k) * D + n]);
    }
    for (long i = gtid; i < (long)NEXP * D * 2 * DE; i += gsz) {
        const int rho = (int)(i % (2 * DE)); const long t = i / (2 * DE); const int k = (int)(t % D), e = (int)(t / D);
        const int q = rho >> 5, half = (rho >> 4) & 1, ii = rho & 15, cc = 16 * q + ii;
        const float* src = half ? p.w_up : p.w_gate;
        p.wgu_t[((size_t)e * 2 * DE + rho) * D + k] = f2bf(src[(((size_t)l * NEXP + e) * D + k) * DE + cc]);
    }
    for (long i = gtid; i < (long)NEXP * DE * D; i += gsz) {
        const int n = (int)(i % D); const long t = i / D; const int k = (int)(t % DE), e = (int)(t / DE);
        p.wd_t[((size_t)e * D + n) * DE + k] = f2bf(p.w_down[(((size_t)l * NEXP + e) * DE + k) * D + n]);
    }
}
__device__ void ph_prep_misc(const Params& p, int l, long gtid, long gsz) {
    if (l == 0) for (long i = gtid; i < (long)2 * (NB + 1) * 6 * D; i += gsz) {
        const int j = (int)(i % (6 * D)), b = (int)((i / (6 * D)) % (NB + 1)), ll = (int)(i / ((long)6 * D * (NB + 1)));
        const float* cv = (b < NB) ? p.c + (size_t)b * D : p.c_ctx;
        float acc = 0.f;
        for (int k = 0; k < D; ++k) acc += siluf_(cv[k]) * p.w_mod[((size_t)ll * D + k) * 6 * D + j];
        p.mod[((size_t)ll * (NB + 1) + b) * 6 * D + j] = acc + p.b_mod[(size_t)ll * 6 * D + j];
    }
    if (l == 0) for (long i = gtid; i < 64 * 16; i += gsz) {
        const int pos = (int)(i / 16), fi = (int)(i % 16);
        const float inv = powf(10000.0f, -(float)fi / 16.0f), ang = (float)pos * inv;
        p.rope[i] = cosf(ang); p.rope[1024 + i] = sinf(ang);
    }
    for (long i = gtid; i < NEXP; i += gsz) p.cnt[l * NEXP + i] = 0;
    for (long i = gtid; i < NSLOT; i += gsz) p.slotTok[i] = T;
    for (long i = gtid; i < D; i += gsz) p.H[(size_t)T * D + i] = 0;
}

__device__ __forceinline__ const float* xrow_in(const Params& p, int l, int m) {
    if (m < TL) return (l == 0 ? p.x : p.out) + (size_t)m * D;
    return (l == 0 ? p.ctx : p.XC) + (size_t)(m - TL) * D;
}
__device__ __forceinline__ const float* modrow(const Params& p, int l, int m) { return p.mod + ((size_t)l * (NB + 1) + (m < TL ? m / S : NB)) * 6 * D; }

__device__ void ph_lnmod(const Params& p, int l, long gtid, long gsz) {
    for (long m = gtid; m < T; m += gsz) {
        const float* xr = xrow_in(p, l, (int)m); const float* md = modrow(p, l, (int)m);
        float s = 0.f; for (int j = 0; j < D; ++j) s += xr[j];
        const float mu = s / D; float q = 0.f;
        for (int j = 0; j < D; ++j) { const float d = xr[j] - mu; q += d * d; }
        const float rstd = 1.0f / sqrtf(q / D + LN_EPS);
        for (int j = 0; j < D; ++j) p.H[(size_t)m * D + j] = f2bf((xr[j] - mu) * rstd * (1.0f + md[D + j]) + md[j]);
    }
}

__device__ __forceinline__ float zshift(const Params& p, int l, int m, int col) {
    int t, len;
    if (m < TL) { t = m % S; len = S; } else { t = (m - TL) % L; len = L; }
    const float* sh = p.a_shift + (size_t)l * 3 * A_IN;
    const bf16_t* z = p.Z + (size_t)m * ZP + ZA + col;
    float v = sh[A_IN + col] * bf2f(z[0]);
    if (t > 0) v += sh[col] * bf2f(z[-ZP]);
    if (t < len - 1) v += sh[2 * A_IN + col] * bf2f(z[ZP]);
    return v;
}

__device__ void ph_streams(const Params& p, int l, long gtid, long gsz) {
    for (long i = gtid; i < (long)T * DA; i += gsz) {
        const int m = (int)(i / DA), c = (int)(i % DA), h0 = c & ~63;
        const float r = zshift(p, l, m, c), k = zshift(p, l, m, 256 + c), v = zshift(p, l, m, 512 + c);
        float nrm = 0.f;
        for (int j = 0; j < 64; ++j) { const float t = zshift(p, l, m, 256 + h0 + j) * p.a_k_k[l * DA + h0 + j]; nrm += t * t; }
        const float kk = k * p.a_k_k[l * DA + c] / sqrtf(nrm + 1e-12f);
        float g = 0.f;
        for (int j = 0; j < 160; ++j) g += sigmoidf_(zshift(p, l, m, 1024 + j)) * p.a_g_up[((size_t)l * 160 + j) * DA + c];
        const size_t o = (size_t)m * DA + c;
        p.sR[o] = r; p.sV[o] = v; p.sKK[o] = kk; p.sG[o] = g;
        for (int d = 0; d < 2; ++d) {
            float aw = 0.f, aa = 0.f;
            for (int j = 0; j < 64; ++j) {
                aw += tanhf(zshift(p, l, m, 768 + d * 64 + j)) * p.a_w_up[(((size_t)l * 2 + d) * 64 + j) * DA + c];
                aa += zshift(p, l, m, 896 + d * 64 + j) * p.a_a_up[(((size_t)l * 2 + d) * 64 + j) * DA + c];
            }
            const float u = -(p.a_w0[(l * 2 + d) * DA + c] + aw);
            const float sp = (u > 20.f) ? u : log1pf(expf(u));
            const float w = expf(-expf(-sp - 0.5f));
            const float a = sigmoidf_(p.a_a0[(l * 2 + d) * DA + c] + aa);
            const size_t od = ((size_t)d * T + m) * DA + c;
            p.sW[od] = w; p.sKD[od] = k * (1.0f + (a - 1.0f) * p.a_k_a[l * DA + c]); p.sB[od] = kk * a;
        }
    }
}

__device__ void ph_rope(const Params& p, long gtid, long gsz) {
    for (long i = gtid; i < (long)TL * 8 * 32; i += gsz) {
        const int pr = (int)(i & 31), hs = (int)((i >> 5) & 7), m = (int)(i >> 8);
        const int t = m % S, axis = pr >> 4, fi = pr & 15, pos = axis ? (t % GRID_W) : (t / GRID_W);
        bf16_t* z = p.Z + (size_t)m * ZP + hs * 64 + axis * 32 + fi;
        const float cs = p.rope[pos * 16 + fi], sn = p.rope[1024 + pos * 16 + fi];
        const float x0 = bf2f(z[0]), x1 = bf2f(z[16]);
        z[0] = f2bf(x0 * cs - x1 * sn); z[16] = f2bf(x1 * cs + x0 * sn);
    }
}

__device__ void ph_scan(const Params& p, long gtid, long gsz) {
    for (long i = gtid; i < (long)2 * NB * 4 * 64; i += gsz) {
        const int v = (int)(i & 63), h = (int)((i >> 6) & 3), b = (int)((i >> 8) % NB), d = (int)((i >> 8) / NB);
        float st[64];
#pragma unroll
        for (int k = 0; k < 64; ++k) st[k] = 0.f;
        for (int pos = 0; pos < L + S; ++pos) {
            int m;
            if (pos < L) m = TL + b * L + (d ? L - 1 - pos : pos);
            else m = b * S + (d ? S - 1 - (pos - L) : pos - L);
            const size_t o = (size_t)m * DA + h * 64, od = ((size_t)d * T + m) * DA + h * 64;
            const float* kk = p.sKK + o; const float* r = p.sR + o;
            const float* w = p.sW + od; const float* bb = p.sB + od; const float* kd = p.sKD + od;
            const float vv = p.sV[o + v];
            float sk = 0.f;
#pragma unroll
            for (int k = 0; k < 64; ++k) sk += st[k] * kk[k];
            float y = 0.f;
#pragma unroll
            for (int k = 0; k < 64; ++k) { st[k] = st[k] * w[k] - sk * bb[k] + vv * kd[k]; y += st[k] * r[k]; }
            p.Y[od + v] = y;
        }
    }
}

__device__ void ph_rwkv_out(const Params& p, int l, int nrows, long gtid, long gsz) {
    for (long i = gtid; i < (long)nrows * 4; i += gsz) {
        const int m = (int)(i >> 2), h = (int)(i & 3);
        const size_t o = (size_t)m * DA + h * 64;
        const float* y0 = p.Y + o; const float* y1 = p.Y + (size_t)T * DA + o;
        float s = 0.f, bon = 0.f;
        for (int n = 0; n < 64; ++n) {
            s += y0[n] + y1[n];
            bon += p.sR[o + n] * (p.sKD[o + n] + p.sKD[(size_t)T * DA + o + n]) * p.a_r_k[l * DA + h * 64 + n];
        }
        const float mu = s / 64.f; float q = 0.f;
        for (int n = 0; n < 64; ++n) { const float dd = y0[n] + y1[n] - mu; q += dd * dd; }
        const float rstd = 1.0f / sqrtf(q / 64.f + GN_EPS);
        for (int n = 0; n < 64; ++n) {
            const int c = h * 64 + n;
            const float yn = (y0[n] + y1[n] - mu) * rstd * p.a_lnx_g[l * DA + c] + p.a_lnx_b[l * DA + c];
            p.MIX[(size_t)m * DMIX + c] = f2bf((yn + bon * p.sV[o + n]) * p.sG[o + n]);
        }
    }
}

__device__ __forceinline__ void att_key(const float (&q)[64], const bf16_t* kr, const bf16_t* vr, float bias, float& mx, float& ls, float (&acc)[64]) {
    float s = 0.f;
#pragma unroll
    for (int d = 0; d < 64; ++d) s += q[d] * bf2f(kr[d]);
    s = s * ATT_SCALE + bias;
    const float mn = fmaxf(mx, s), f = expf(mx - mn), pe = expf(s - mn);
    ls = ls * f + pe;
#pragma unroll
    for (int d = 0; d < 64; ++d) acc[d] = acc[d] * f + pe * bf2f(vr[d]);
    mx = mn;
}

__device__ void ph_attn(const Params& p, int l, int nrows, long gtid, long gsz) {
    for (long i = gtid; i < (long)nrows * 12; i += gsz) {
        const int m = (int)(i / 12), u = (int)(i % 12);
        const bool isB = u < 6; const int hq = isB ? u : u - 6;
        const int b = (m < TL) ? m / S : (m - TL) / L;
        const int qcol = isB ? ZQB + hq * 64 : ZQN + hq * 64;
        const int kcol = isB ? ZKB + (hq / 3) * 64 : ZKN + hq * 64;
        const int vcol = isB ? ZVB + (hq / 3) * 64 : ZVN + hq * 64;
        float q[64], acc[64];
        const bf16_t* qr = p.Z + (size_t)m * ZP + qcol;
#pragma unroll
        for (int d = 0; d < 64; ++d) { q[d] = bf2f(qr[d]); acc[d] = 0.f; }
        float mx, ls;
        if (isB) { mx = p.b_sink[l * 6 + hq]; ls = 1.0f; } else { mx = -1e30f; ls = 0.f; }
        for (int j = 0; j < L; ++j) { const bf16_t* zr = p.Z + (size_t)(TL + b * L + j) * ZP; att_key(q, zr + kcol, zr + vcol, 0.f, mx, ls, acc); }
        if (m < TL) {
            const int t = m % S;
            if (isB) {
                const int j0 = t - 128 < 0 ? 0 : t - 128, j1 = t + 128 > S - 1 ? S - 1 : t + 128;
                for (int j = j0; j <= j1; ++j) { const bf16_t* zr = p.Z + (size_t)(b * S + j) * ZP; att_key(q, zr + kcol, zr + vcol, 0.f, mx, ls, acc); }
            } else {
                const int rows = S / GRID_W, r = t / GRID_W, c = t % GRID_W;
                int r0 = r - 4; r0 = r0 < 0 ? 0 : (r0 > rows - 8 ? rows - 8 : r0);
                int c0 = c - 8; c0 = c0 < 0 ? 0 : (c0 > GRID_W - 16 ? GRID_W - 16 : c0);
                for (int a = 0; a < 8; ++a)
                    for (int e = 0; e < 16; ++e) {
                        const int kr = r0 + a, kc = c0 + e;
                        const float bias = p.c_rpb[(((size_t)l * 6 + hq) * 15 + (kr - r + 7)) * 31 + (kc - c + 15)];
                        const bf16_t* zr = p.Z + (size_t)(b * S + kr * GRID_W + kc) * ZP;
                        att_key(q, zr + kcol, zr + vcol, bias, mx, ls, acc);
                    }
            }
        }
        const float inv = 1.0f / ls;
        bf16_t* o = p.MIX + (size_t)m * DMIX + (isB ? 256 : 640) + hq * 64;
#pragma unroll
        for (int d = 0; d < 64; ++d) o[d] = f2bf(acc[d] * inv);
    }
}

__device__ void ph_post_mixer(const Params& p, int l, int nrows, long gtid, long gsz) {
    for (long mm = gtid; mm < nrows; mm += gsz) {
        const int m = (int)mm;
        const float* xr = xrow_in(p, l, m); const float* md = modrow(p, l, m); const float* orow = p.O + (size_t)m * D;
        float* x1 = (m < TL) ? p.out + (size_t)m * D : p.XC + (size_t)(m - TL) * D;
        const float* g1 = p.ln1_g + (size_t)l * D; const float* b1 = p.ln1_b + (size_t)l * D;
        float s = 0.f; for (int j = 0; j < D; ++j) s += ALPHA * xr[j] + md[2 * D + j] * orow[j];
        float mu = s / D, q = 0.f;
        for (int j = 0; j < D; ++j) { const float d = ALPHA * xr[j] + md[2 * D + j] * orow[j] - mu; q += d * d; }
        float rstd = 1.0f / sqrtf(q / D + LN_EPS);
        s = 0.f;
        for (int j = 0; j < D; ++j) { const float v = (ALPHA * xr[j] + md[2 * D + j] * orow[j] - mu) * rstd * g1[j] + b1[j]; x1[j] = v; s += v; }
        mu = s / D; q = 0.f;
        for (int j = 0; j < D; ++j) { const float d = x1[j] - mu; q += d * d; }
        rstd = 1.0f / sqrtf(q / D + LN_EPS);
        float gl[4], el[32];
#pragma unroll
        for (int g = 0; g < 4; ++g) gl[g] = p.b_rg[l * 4 + g];
#pragma unroll
        for (int e = 0; e < 32; ++e) el[e] = p.b_re[l * 32 + e];
        for (int j = 0; j < D; ++j) {
            const float hv = (x1[j] - mu) * rstd * (1.0f + md[4 * D + j]) + md[3 * D + j];
            p.H[(size_t)m * D + j] = f2bf(hv);
            const float* wg = p.w_rg + ((size_t)l * D + j) * 4; const float* we = p.w_re + ((size_t)l * D + j) * 32;
#pragma unroll
            for (int g = 0; g < 4; ++g) gl[g] += hv * wg[g];
#pragma unroll
            for (int e = 0; e < 32; ++e) el[e] += hv * we[e];
        }
        int gs = 0; float gm = gl[0];
#pragma unroll
        for (int g = 1; g < 4; ++g) if (gl[g] > gm) { gm = gl[g]; gs = g; }
        float den = 0.f;
#pragma unroll
        for (int g = 0; g < 4; ++g) den += expf(gl[g] - gm);
        const float pg = 1.0f / den;
        float v1 = -3e38f, v2 = -3e38f; int i1 = 0, i2 = 0;
#pragma unroll
        for (int j = 0; j < 8; ++j) {
            const float v = gs == 0 ? el[j] : gs == 1 ? el[8 + j] : gs == 2 ? el[16 + j] : el[24 + j];
            if (v > v1) { v2 = v1; i2 = i1; v1 = v; i1 = j; } else if (v > v2) { v2 = v; i2 = j; }
        }
        const float e2 = expf(v2 - v1), w1 = pg / (1.0f + e2), w2 = pg * e2 / (1.0f + e2);
        const int ea = gs * 8 + i1, eb = gs * 8 + i2;
        p.rE[2 * m] = ea; p.rE[2 * m + 1] = eb; p.rW[2 * m] = w1; p.rW[2 * m + 1] = w2;
        p.rPos[2 * m] = atomic_inc_int(p.cnt + l * NEXP + ea); p.rPos[2 * m + 1] = atomic_inc_int(p.cnt + l * NEXP + eb);
    }
}

__device__ __forceinline__ int pstart_of(const int* cnt, int e) {
    int s = 0;
    for (int j = 0; j < NEXP; ++j) if (j < e) s += (cnt[j] + 127) & ~127;
    return s;
}
__device__ void ph_dispatch(const Params& p, int l, int nrows, long gtid, long gsz) {
    for (long i = gtid; i < (long)nrows * 2; i += gsz) {
        const int slot = pstart_of(p.cnt + l * NEXP, p.rE[i]) + p.rPos[i];
        p.rSlot[i] = slot; p.slotTok[slot] = (int)(i >> 1);
    }
}

__device__ void ph_final(const Params& p, int l, int nrows, long gtid, long gsz) {
    for (long mm = gtid; mm < nrows; mm += gsz) {
        const int m = (int)mm;
        float* x1 = (m < TL) ? p.out + (size_t)m * D : p.XC + (size_t)(m - TL) * D;
        const float* md = modrow(p, l, m);
        const float* ya = p.YS + (size_t)p.rSlot[2 * m] * D; const float* yb = p.YS + (size_t)p.rSlot[2 * m + 1] * D;
        const float wa = p.rW[2 * m], wb = p.rW[2 * m + 1];
        const float* g2 = p.ln2_g + (size_t)l * D; const float* b2 = p.ln2_b + (size_t)l * D;
        float s = 0.f; for (int j = 0; j < D; ++j) s += ALPHA * x1[j] + md[5 * D + j] * (wa * ya[j] + wb * yb[j]);
        const float mu = s / D; float q = 0.f;
        for (int j = 0; j < D; ++j) { const float d = ALPHA * x1[j] + md[5 * D + j] * (wa * ya[j] + wb * yb[j]) - mu; q += d * d; }
        const float rstd = 1.0f / sqrtf(q / D + LN_EPS);
        for (int j = 0; j < D; ++j) x1[j] = (ALPHA * x1[j] + md[5 * D + j] * (wa * ya[j] + wb * yb[j]) - mu) * rstd * g2[j] + b2[j];
    }
}

__device__ __forceinline__ int moe_blocks(const int* cnt) { int s = 0; for (int j = 0; j < NEXP; ++j) s += (cnt[j] + 127) >> 7; return s; }
__device__ __forceinline__ int moe_block_expert(const int* cnt, int rb) {
    int s = 0, e = 0;
    for (int j = 0; j < NEXP; ++j) { const int nb = (cnt[j] + 127) >> 7; if (rb >= s && rb < s + nb) e = j; s += nb; }
    return e;
}

#ifdef HOST_EMU
static void host_gemm_in(const Params& p) {
    for (int m = 0; m < T; ++m) for (int n = 0; n < ZP; ++n) { float a = 0.f; for (int k = 0; k < D; ++k) a += bf2f(p.H[(size_t)m * D + k]) * bf2f(p.win_t[(size_t)n * D + k]); p.Z[(size_t)m * ZP + n] = f2bf(a); }
}
static void host_gemm_out(const Params& p, int nrows) {
    for (int m = 0; m < nrows; ++m) for (int n = 0; n < D; ++n) { float a = 0.f; for (int k = 0; k < DMIX; ++k) a += bf2f(p.MIX[(size_t)m * DMIX + k]) * bf2f(p.wout_t[(size_t)n * DMIX + k]); p.O[(size_t)m * D + n] = a; }
}
static void host_moe1(const Params& p, int l) {
    const int* cnt = p.cnt + l * NEXP; const int nrb = moe_blocks(cnt);
    for (int rb = 0; rb < nrb; ++rb) { const int e = moe_block_expert(cnt, rb);
        for (int r = 0; r < 128; ++r) { const int slot = rb * 128 + r; const bf16_t* a = p.H + (size_t)p.slotTok[slot] * D;
            for (int c = 0; c < DE; ++c) { const int q = c >> 4, ii = c & 15; float g = 0.f, u = 0.f;
                const bf16_t* wg = p.wgu_t + ((size_t)e * 2 * DE + 32 * q + ii) * D; const bf16_t* wu = wg + (size_t)16 * D;
                for (int k = 0; k < D; ++k) { g += bf2f(a[k]) * bf2f(wg[k]); u += bf2f(a[k]) * bf2f(wu[k]); }
                p.ACT[(size_t)slot * DE + c] = f2bf(siluf_(g) * u); } } }
}
static void host_moe2(const Params& p, int l) {
    const int* cnt = p.cnt + l * NEXP; const int nrb = moe_blocks(cnt);
    for (int rb = 0; rb < nrb; ++rb) { const int e = moe_block_expert(cnt, rb);
        for (int r = 0; r < 128; ++r) { const int slot = rb * 128 + r;
            for (int n = 0; n < D; ++n) { float a = 0.f; const bf16_t* w = p.wd_t + ((size_t)e * D + n) * DE;
                for (int k = 0; k < DE; ++k) a += bf2f(p.ACT[(size_t)slot * DE + k]) * bf2f(w[k]);
                p.YS[(size_t)slot * D + n] = a; } } }
}
#else
typedef short bf16x8 __attribute__((ext_vector_type(8)));
typedef float f32x4 __attribute__((ext_vector_type(4)));
__device__ __forceinline__ int opq_tid() { int t = threadIdx.x; asm volatile("" : "+v"(t)); return t; }
__device__ __forceinline__ int opq_bid() { int b = blockIdx.x; asm volatile("" : "+s"(b)); return b; }
__device__ __forceinline__ unsigned pk2(float lo, float hi) { return (unsigned)f2bf(lo) | ((unsigned)f2bf(hi) << 16); }
struct u32x2_t { unsigned x, y; };
__device__ __forceinline__ void st_bf16x4(bf16_t* dst, f32x4 v) { u32x2_t o; o.x = pk2(v[0], v[1]); o.y = pk2(v[2], v[3]); *(u32x2_t*)dst = o; }
template <class Epi>
__device__ __forceinline__ void gemm_tile(const bf16_t* a0, const bf16_t* a1, const bf16_t* b0, const bf16_t* b1, int K, char* lds, const Epi& epi) {
    const int tid = opq_tid(), wid = tid >> 6, lane = tid & 63, wr = wid >> 1, wc = wid & 1, fr = lane & 15, fq = lane >> 4;
    char* SA = lds; char* SB = lds + 8192;
    f32x4 acc[4][4];
#pragma unroll
    for (int m = 0; m < 4; ++m)
#pragma unroll
        for (int n = 0; n < 4; ++n) acc[m][n] = (f32x4){0.f, 0.f, 0.f, 0.f};
    for (int kt = 0; kt < K; kt += 32) {
        __builtin_amdgcn_global_load_lds((const unsigned*)(a0 + kt), (__attribute__((address_space(3))) unsigned*)(SA + tid * 16), 16, 0, 0);
        __builtin_amdgcn_global_load_lds((const unsigned*)(a1 + kt), (__attribute__((address_space(3))) unsigned*)(SA + tid * 16 + 4096), 16, 0, 0);
        __builtin_amdgcn_global_load_lds((const unsigned*)(b0 + kt), (__attribute__((address_space(3))) unsigned*)(SB + tid * 16), 16, 0, 0);
        __builtin_amdgcn_global_load_lds((const unsigned*)(b1 + kt), (__attribute__((address_space(3))) unsigned*)(SB + tid * 16 + 4096), 16, 0, 0);
        asm volatile("s_waitcnt vmcnt(0)" ::: "memory");
        __syncthreads();
        bf16x8 At[4], Bt[4];
#pragma unroll
        for (int m = 0; m < 4; ++m) At[m] = *(const bf16x8*)(SA + (wr * 64 + m * 16 + fr) * 64 + fq * 16);
#pragma unroll
        for (int n = 0; n < 4; ++n) Bt[n] = *(const bf16x8*)(SB + (wc * 64 + n * 16 + fr) * 64 + fq * 16);
#pragma unroll
        for (int m = 0; m < 4; ++m)
#pragma unroll
            for (int n = 0; n < 4; ++n) acc[m][n] = __builtin_amdgcn_mfma_f32_16x16x32_bf16(At[m], Bt[n], acc[m][n], 0, 0, 0);
        __syncthreads();
    }
    epi(acc, wr, wc, fr, fq);
}
#define STG_ROW(i) ((tid_ + (i) * 256) >> 2)
#define STG_K ((tid_ & 3) * 8)

__device__ __forceinline__ void g_gemm_in(const Params& p, char* lds) {
    const int tid_ = opq_tid(), bid_ = opq_bid(); (void)tid_; (void)bid_;
    constexpr int NT = NINP / 128, MT = T / 128;
    for (int tile = bid_; tile < NT * MT; tile += gridDim.x) {
        const int tm = tile / NT, tn = tile % NT;
        const bf16_t* a0 = p.H + (size_t)(tm * 128 + STG_ROW(0)) * D + STG_K; const bf16_t* a1 = p.H + (size_t)(tm * 128 + STG_ROW(1)) * D + STG_K;
        const bf16_t* b0 = p.win_t + (size_t)(tn * 128 + STG_ROW(0)) * D + STG_K; const bf16_t* b1 = p.win_t + (size_t)(tn * 128 + STG_ROW(1)) * D + STG_K;
        gemm_tile(a0, a1, b0, b1, D, lds, [&](const f32x4 (&acc)[4][4], int wr, int wc, int fr, int fq) {
#pragma unroll
            for (int m = 0; m < 4; ++m)
#pragma unroll
                for (int n = 0; n < 4; ++n) { const int col = tn * 128 + wc * 64 + n * 16 + fr;
                    if (col < ZP) {
#pragma unroll
                        for (int j = 0; j < 4; ++j) p.Z[(size_t)(tm * 128 + wr * 64 + m * 16 + fq * 4 + j) * ZP + col] = f2bf(acc[m][n][j]); } }
            if (tn == ZVB / 128 || (tn >= ZVN / 128 && tn < ZA / 128)) {
#pragma unroll
                for (int m = 0; m < 4; ++m) { const int m0 = tm * 128 + wr * 64 + m * 16 + fq * 4; int b, u;
                    if (m0 < TL) { b = m0 / S; u = L + m0 % S; } else { b = (m0 - TL) / L; u = (m0 - TL) % L; }
#pragma unroll
                    for (int n = 0; n < 4; ++n) { const int col = tn * 128 + wc * 64 + n * 16 + fr;
                        const int hv = col < ZVN ? (col - ZVB) >> 6 : 2 + ((col - ZVN) >> 6), d = col < ZVN ? (col - ZVB) & 63 : (col - ZVN) & 63;
                        st_bf16x4(p.VT + ((size_t)(b * 8 + hv) * 64 + d) * PU + u, acc[m][n]); } }
            }
        });
    }
}
__device__ __forceinline__ void g_gemm_out(const Params& p, int nrows, char* lds) {
    const int tid_ = opq_tid(), bid_ = opq_bid(); (void)tid_; (void)bid_;
    constexpr int NT = D / 128; const int MT = nrows / 128;
    for (int tile = bid_; tile < NT * MT; tile += gridDim.x) {
        const int tm = tile / NT, tn = tile % NT;
        const bf16_t* a0 = p.MIX + (size_t)(tm * 128 + STG_ROW(0)) * DMIX + STG_K; const bf16_t* a1 = p.MIX + (size_t)(tm * 128 + STG_ROW(1)) * DMIX + STG_K;
        const bf16_t* b0 = p.wout_t + (size_t)(tn * 128 + STG_ROW(0)) * DMIX + STG_K; const bf16_t* b1 = p.wout_t + (size_t)(tn * 128 + STG_ROW(1)) * DMIX + STG_K;
        gemm_tile(a0, a1, b0, b1, DMIX, lds, [&](const f32x4 (&acc)[4][4], int wr, int wc, int fr, int fq) {
#pragma unroll
            for (int m = 0; m < 4; ++m)
#pragma unroll
                for (int n = 0; n < 4; ++n)
#pragma unroll
                    for (int j = 0; j < 4; ++j) p.O[(size_t)(tm * 128 + wr * 64 + m * 16 + fq * 4 + j) * D + tn * 128 + wc * 64 + n * 16 + fr] = acc[m][n][j];
        });
    }
}
__device__ __forceinline__ void g_moe1(const Params& p, int l, char* lds) {
    const int tid_ = opq_tid(), bid_ = opq_bid(); (void)tid_; (void)bid_;
    const int* cnt = p.cnt + l * NEXP; const int nrb = moe_blocks(cnt); constexpr int NT = 2 * DE / 128;
    for (int tile = bid_; tile < nrb * NT; tile += gridDim.x) {
        const int rb = tile / NT, tn = tile % NT, e = moe_block_expert(cnt, rb);
        const bf16_t* a0 = p.H + (size_t)p.slotTok[rb * 128 + STG_ROW(0)] * D + STG_K; const bf16_t* a1 = p.H + (size_t)p.slotTok[rb * 128 + STG_ROW(1)] * D + STG_K;
        const bf16_t* bw = p.wgu_t + (size_t)e * 2 * DE * D;
        const bf16_t* b0 = bw + (size_t)(tn * 128 + STG_ROW(0)) * D + STG_K; const bf16_t* b1 = bw + (size_t)(tn * 128 + STG_ROW(1)) * D + STG_K;
        gemm_tile(a0, a1, b0, b1, D, lds, [&](const f32x4 (&acc)[4][4], int wr, int wc, int fr, int fq) {
#pragma unroll
            for (int m = 0; m < 4; ++m)
#pragma unroll
                for (int n2 = 0; n2 < 2; ++n2) { const int col = tn * 64 + wc * 32 + n2 * 16 + fr;
#pragma unroll
                    for (int j = 0; j < 4; ++j) { const float g = acc[m][2 * n2][j], u = acc[m][2 * n2 + 1][j];
                        p.ACT[(size_t)(rb * 128 + wr * 64 + m * 16 + fq * 4 + j) * DE + col] = f2bf(g / (1.0f + __expf(-g)) * u); } }
        });
    }
}
__device__ __forceinline__ void g_moe2(const Params& p, int l, char* lds) {
    const int tid_ = opq_tid(), bid_ = opq_bid(); (void)tid_; (void)bid_;
    const int* cnt = p.cnt + l * NEXP; const int nrb = moe_blocks(cnt); constexpr int NT = D / 128;
    for (int tile = bid_; tile < nrb * NT; tile += gridDim.x) {
        const int rb = tile / NT, tn = tile % NT, e = moe_block_expert(cnt, rb);
        const bf16_t* a0 = p.ACT + (size_t)(rb * 128 + STG_ROW(0)) * DE + STG_K; const bf16_t* a1 = p.ACT + (size_t)(rb * 128 + STG_ROW(1)) * DE + STG_K;
        const bf16_t* bw = p.wd_t + (size_t)e * D * DE;
        const bf16_t* b0 = bw + (size_t)(tn * 128 + STG_ROW(0)) * DE + STG_K; const bf16_t* b1 = bw + (size_t)(tn * 128 + STG_ROW(1)) * DE + STG_K;
        gemm_tile(a0, a1, b0, b1, DE, lds, [&](const f32x4 (&acc)[4][4], int wr, int wc, int fr, int fq) {
#pragma unroll
            for (int m = 0; m < 4; ++m)
#pragma unroll
                for (int n = 0; n < 4; ++n)
#pragma unroll
                    for (int j = 0; j < 4; ++j) p.YS[(size_t)(rb * 128 + wr * 64 + m * 16 + fq * 4 + j) * D + tn * 128 + wc * 64 + n * 16 + fr] = acc[m][n][j];
        });
    }
}


constexpr int DV = D / 256;
static_assert(D % 256 == 0, "row phases hold a row as DV float4 per lane");
__device__ __forceinline__ float wave_sum(float v) {
#pragma unroll
    for (int o = 1; o < 64; o <<= 1) v += __shfl_xor(v, o);
    return v;
}
__device__ __forceinline__ float sum4(f32x4 a) { return (a[0] + a[1]) + (a[2] + a[3]); }
#define LDS_WAIT() asm volatile("s_waitcnt lgkmcnt(0)" ::: "memory")

__device__ __forceinline__ void row_stats(const f32x4 (&v)[DV], float& mu, float& rstd) {
    float s = 0.f;
#pragma unroll
    for (int j = 0; j < DV; ++j) s += sum4(v[j]);
    mu = wave_sum(s) * (1.0f / D);
    float q = 0.f;
#pragma unroll
    for (int j = 0; j < DV; ++j) { const f32x4 d = v[j] - mu; q += sum4(d * d); }
    rstd = 1.0f / sqrtf(wave_sum(q) * (1.0f / D) + LN_EPS);
}

__device__ void ph_lnmod_fast(const Params& p, int l) {
    const int tid_ = opq_tid(), bid_ = opq_bid(); (void)tid_; (void)bid_;
    const int lane = tid_ & 63, gw = bid_ * 4 + (tid_ >> 6), nw = gridDim.x * 4;
    for (int m = gw; m < T; m += nw) {
        const f32x4* xr = (const f32x4*)xrow_in(p, l, m) + lane; const f32x4* md = (const f32x4*)modrow(p, l, m) + lane;
        f32x4 v[DV];
#pragma unroll
        for (int j = 0; j < DV; ++j) v[j] = xr[64 * j];
        float mu, rstd; row_stats(v, mu, rstd);
#pragma unroll
        for (int j = 0; j < DV; ++j) { const f32x4 sh = md[64 * j], sc = md[D / 4 + 64 * j];
            st_bf16x4(p.H + (size_t)m * D + 4 * (lane + 64 * j), (v[j] - mu) * rstd * (sc + 1.0f) + sh); }
    }
}

__device__ void ph_post_mixer_fast(const Params& p, int l, int nrows) {
    const int tid_ = opq_tid(), bid_ = opq_bid(); (void)tid_; (void)bid_;
    const int lane = tid_ & 63, gw = bid_ * 4 + (tid_ >> 6), nw = gridDim.x * 4;
    for (int m = gw; m < nrows; m += nw) {
        const f32x4* xr = (const f32x4*)xrow_in(p, l, m) + lane; const f32x4* md = (const f32x4*)modrow(p, l, m) + lane;
        const f32x4* orow = (const f32x4*)(p.O + (size_t)m * D) + lane;
        f32x4* x1 = (f32x4*)((m < TL) ? p.out + (size_t)m * D : p.XC + (size_t)(m - TL) * D) + lane;
        const f32x4* g1 = (const f32x4*)(p.ln1_g + (size_t)l * D) + lane; const f32x4* b1 = (const f32x4*)(p.ln1_b + (size_t)l * D) + lane;
        f32x4 v[DV];
#pragma unroll
        for (int j = 0; j < DV; ++j) v[j] = xr[64 * j] * ALPHA + md[2 * (D / 4) + 64 * j] * orow[64 * j];
        float mu, rstd; row_stats(v, mu, rstd);
#pragma unroll
        for (int j = 0; j < DV; ++j) { v[j] = (v[j] - mu) * rstd * g1[64 * j] + b1[64 * j]; x1[64 * j] = v[j]; }
        row_stats(v, mu, rstd);
        float gl[4], el[32];
#pragma unroll
        for (int g = 0; g < 4; ++g) gl[g] = 0.f;
#pragma unroll
        for (int e = 0; e < 32; ++e) el[e] = 0.f;
#pragma unroll
        for (int j = 0; j < DV; ++j) {
            const f32x4 hv = (v[j] - mu) * rstd * (md[4 * (D / 4) + 64 * j] + 1.0f) + md[3 * (D / 4) + 64 * j];
            st_bf16x4(p.H + (size_t)m * D + 4 * (lane + 64 * j), hv);
#pragma unroll
            for (int i = 0; i < 4; ++i) {
                const int k = 4 * (lane + 64 * j) + i;
                const f32x4 wg = *(const f32x4*)(p.w_rg + ((size_t)l * D + k) * 4);
#pragma unroll
                for (int g = 0; g < 4; ++g) gl[g] += hv[i] * wg[g];
                const f32x4* we = (const f32x4*)(p.w_re + ((size_t)l * D + k) * 32);
#pragma unroll
                for (int e4 = 0; e4 < 8; ++e4) { const f32x4 w = we[e4];
#pragma unroll
                    for (int g = 0; g < 4; ++g) el[4 * e4 + g] += hv[i] * w[g]; }
            }
        }
#pragma unroll
        for (int g = 0; g < 4; ++g) gl[g] = wave_sum(gl[g]) + p.b_rg[l * 4 + g];
#pragma unroll
        for (int e = 0; e < 32; ++e) el[e] = wave_sum(el[e]) + p.b_re[l * 32 + e];
        int gs = 0; float gm = gl[0];
#pragma unroll
        for (int g = 1; g < 4; ++g) if (gl[g] > gm) { gm = gl[g]; gs = g; }
        float den = 0.f;
#pragma unroll
        for (int g = 0; g < 4; ++g) den += expf(gl[g] - gm);
        const float pg = 1.0f / den;
        float v1 = -3e38f, v2 = -3e38f; int i1 = 0, i2 = 0;
#pragma unroll
        for (int j = 0; j < 8; ++j) {
            const float vv = gs == 0 ? el[j] : gs == 1 ? el[8 + j] : gs == 2 ? el[16 + j] : el[24 + j];
            if (vv > v1) { v2 = v1; i2 = i1; v1 = vv; i1 = j; } else if (vv > v2) { v2 = vv; i2 = j; }
        }
        if (lane == 0) {
            const float e2 = expf(v2 - v1), w1 = pg / (1.0f + e2), w2 = pg * e2 / (1.0f + e2);
            const int ea = gs * 8 + i1, eb = gs * 8 + i2;
            p.rE[2 * m] = ea; p.rE[2 * m + 1] = eb; p.rW[2 * m] = w1; p.rW[2 * m + 1] = w2;
            p.rPos[2 * m] = atomicAdd(p.cnt + l * NEXP + ea, 1); p.rPos[2 * m + 1] = atomicAdd(p.cnt + l * NEXP + eb, 1);
        }
    }
}

__device__ void ph_final_fast(const Params& p, int l, int nrows) {
    const int tid_ = opq_tid(), bid_ = opq_bid(); (void)tid_; (void)bid_;
    const int lane = tid_ & 63, gw = bid_ * 4 + (tid_ >> 6), nw = gridDim.x * 4;
    for (int m = gw; m < nrows; m += nw) {
        f32x4* x1 = (f32x4*)((m < TL) ? p.out + (size_t)m * D : p.XC + (size_t)(m - TL) * D) + lane;
        const f32x4* md = (const f32x4*)modrow(p, l, m) + lane;
        const f32x4* ya = (const f32x4*)(p.YS + (size_t)p.rSlot[2 * m] * D) + lane; const f32x4* yb = (const f32x4*)(p.YS + (size_t)p.rSlot[2 * m + 1] * D) + lane;
        const float wa = p.rW[2 * m], wb = p.rW[2 * m + 1];
        const f32x4* g2 = (const f32x4*)(p.ln2_g + (size_t)l * D) + lane; const f32x4* b2 = (const f32x4*)(p.ln2_b + (size_t)l * D) + lane;
        f32x4 v[DV];
#pragma unroll
        for (int j = 0; j < DV; ++j) v[j] = x1[64 * j] * ALPHA + md[5 * (D / 4) + 64 * j] * (ya[64 * j] * wa + yb[64 * j] * wb);
        float mu, rstd; row_stats(v, mu, rstd);
#pragma unroll
        for (int j = 0; j < DV; ++j) x1[64 * j] = (v[j] - mu) * rstd * g2[64 * j] + b2[64 * j];
    }
}

__device__ __forceinline__ void tr_item(const float* srcl, size_t ldw, bf16_t* dst, size_t ldd, float* scr, int lane) {
#pragma unroll 8
    for (int i = 0; i < 32; ++i) { const int kk = 2 * i + (lane >> 5); scr[kk * 33 + (lane & 31)] = srcl ? srcl[(size_t)kk * ldw] : 0.f; }
    LDS_WAIT();
    const int c = lane & 7;
#pragma unroll
    for (int j = 0; j < 4; ++j) { const int n = (lane >> 3) + 8 * j; const float* s = scr + (8 * c) * 33 + n;
        uint4 o; o.x = pk2(s[0], s[33]); o.y = pk2(s[2 * 33], s[3 * 33]); o.z = pk2(s[4 * 33], s[5 * 33]); o.w = pk2(s[6 * 33], s[7 * 33]);
        *(uint4*)(dst + (size_t)n * ldd + 8 * c) = o; }
    LDS_WAIT();
}
__device__ void ph_prep_w_fast(const Params& p, int l, int part, char* lds) {
    const int tid_ = opq_tid(), bid_ = opq_bid(); (void)tid_; (void)bid_;
    const int lane = tid_ & 63, wid = tid_ >> 6, gw = bid_ * 4 + wid, nw = gridDim.x * 4;
    float* scr = (float*)(lds + wid * 8448);
    constexpr int I_IN = (D / 64) * (NINP / 32), I_OUT = (DMIX / 64) * (D / 32), I_GU1 = (D / 64) * (2 * DE / 32), I_D1 = (DE / 64) * (D / 32);
    constexpr int NITEMS = I_IN + I_OUT + NEXP * (I_GU1 + I_D1);
    const int it0 = part == 0 ? 0 : I_IN + I_OUT, it1 = part == 0 ? I_IN + I_OUT : NITEMS;
    for (int it = it0 + gw; it < it1; it += nw) {
        int r = it;
        if (r < I_IN) { const int kb = r / (NINP / 32), n0 = 32 * (r % (NINP / 32));
            const float* s = nullptr;
            if (n0 < N_IN) { const int oc = (n0 < ZA) ? n0 + A_IN : n0 - ZA; s = p.w_in + ((size_t)l * D + 64 * kb) * N_IN + oc + (lane & 31); }
            tr_item(s, N_IN, p.win_t + (size_t)n0 * D + 64 * kb, D, scr, lane); continue; }
        r -= I_IN;
        if (r < I_OUT) { const int kb = r / (D / 32), n0 = 32 * (r % (D / 32));
            tr_item(p.w_out + ((size_t)l * DMIX + 64 * kb) * D + n0 + (lane & 31), D, p.wout_t + (size_t)n0 * DMIX + 64 * kb, DMIX, scr, lane); continue; }
        r -= I_OUT;
        const int e = r / (I_GU1 + I_D1); r %= (I_GU1 + I_D1);
        if (r < I_GU1) { const int kb = r / (2 * DE / 32), q = r % (2 * DE / 32);
            const float* s = (((lane & 31) >> 4) ? p.w_up : p.w_gate) + (((size_t)l * NEXP + e) * D + 64 * kb) * DE + 16 * q + (lane & 15);
            tr_item(s, DE, p.wgu_t + ((size_t)e * 2 * DE + 32 * q) * D + 64 * kb, D, scr, lane); continue; }
        r -= I_GU1;
        { const int kb = r / (D / 32), n0 = 32 * (r % (D / 32));
            tr_item(p.w_down + (((size_t)l * NEXP + e) * DE + 64 * kb) * D + n0 + (lane & 31), D, p.wd_t + ((size_t)e * D + n0) * DE + 64 * kb, DE, scr, lane); }
    }
    if (part != 0) return;
    const long gt = (long)bid_ * blockDim.x + tid_, gs = (long)gridDim.x * blockDim.x;
    for (long i = gt; i < 2 * 256 * 64; i += gs) { const int k = (int)(i & 63), n = (int)((i >> 6) & 255), d = (int)(i >> 14);
        p.wupT[i] = f2bf(p.a_w_up[(((size_t)l * 2 + d) * 64 + k) * DA + n]); p.aupT[i] = f2bf(p.a_a_up[(((size_t)l * 2 + d) * 64 + k) * DA + n]); }
    for (long i = gt; i < 256 * 160; i += gs) { const int k = (int)(i % 160), n = (int)(i / 160); p.gupT[i] = f2bf(p.a_g_up[((size_t)l * 160 + k) * DA + n]); }
}

__device__ void ph_streams_s1(const Params& p, int l) {
    const int tid_ = opq_tid(), bid_ = opq_bid(); (void)tid_; (void)bid_;
    const int lane = tid_ & 63, gw = bid_ * 4 + (tid_ >> 6), nw = gridDim.x * 4;
    const float* sh = p.a_shift + (size_t)l * 3 * A_IN;
    for (int m = gw; m < T; m += nw) {
        int t, len;
        if (m < TL) { t = m % S; len = S; } else { t = (m - TL) % L; len = L; }
        const bool hp = t > 0, hn = t < len - 1;
        const bf16_t* z = p.Z + (size_t)m * ZP + ZA;
#pragma unroll 1
        for (int i = 0; i < (A_IN + 63) / 64; ++i) {
            const int c = 64 * i + lane; float v = 0.f;
            if (c < A_IN) {
                v = sh[A_IN + c] * bf2f(z[c]);
                if (hp) v += sh[c] * bf2f(z[c - ZP]);
                if (hn) v += sh[2 * A_IN + c] * bf2f(z[c + ZP]);
                if (c < 256) p.sR[(size_t)m * DA + c] = v;
                else if (c < 512) p.kT[(size_t)m * DA + c - 256] = v;
                else if (c < 768) p.sV[(size_t)m * DA + c - 512] = v;
                else if (c < 896) p.LA[(size_t)m * 416 + c - 768] = f2bf(tanhf(v));
                else if (c < 1024) p.LA[(size_t)m * 416 + c - 768] = f2bf(v);
                else p.LA[(size_t)m * 416 + c - 768] = f2bf(sigmoidf_(v));
            }
            if (i >= 4 && i < 8) {
                const float t2 = v * p.a_k_k[l * DA + c - 256]; const float nrm = wave_sum(t2 * t2);
                if (lane == 0) p.kN[(size_t)m * 4 + i - 4] = 1.0f / sqrtf(nrm + 1e-12f);
            }
        }
    }
}
__device__ void g_streams_s2(const Params& p, int l, char* lds) {
    const int tid_ = opq_tid(), bid_ = opq_bid(); (void)tid_; (void)bid_;
    constexpr int MT = T / 128;
    for (int job = bid_; job < 5 * MT * 2; job += gridDim.x) {
        const int type = job / (MT * 2), r = job % (MT * 2), tm = r >> 1, tn = r & 1;
        const int coff = type < 2 ? type * 64 : type < 4 ? 128 + (type - 2) * 64 : 256, K = type < 4 ? 64 : 160, d = type & 1;
        const bf16_t* Bt = type < 2 ? p.wupT + type * 256 * 64 : type < 4 ? p.aupT + (type - 2) * 256 * 64 : p.gupT;
        const bf16_t* a0 = p.LA + (size_t)(tm * 128 + STG_ROW(0)) * 416 + coff + STG_K; const bf16_t* a1 = p.LA + (size_t)(tm * 128 + STG_ROW(1)) * 416 + coff + STG_K;
        const bf16_t* b0 = Bt + (size_t)(tn * 128 + STG_ROW(0)) * K + STG_K; const bf16_t* b1 = Bt + (size_t)(tn * 128 + STG_ROW(1)) * K + STG_K;
        if (type < 2) gemm_tile(a0, a1, b0, b1, K, lds, [&](const f32x4 (&acc)[4][4], int wr, int wc, int fr, int fq) {
#pragma unroll
            for (int mi = 0; mi < 4; ++mi) {
#pragma unroll
                for (int n = 0; n < 4; ++n) { const int c = tn * 128 + wc * 64 + n * 16 + fr; const float w0 = p.a_w0[(l * 2 + d) * DA + c];
#pragma unroll
                    for (int j = 0; j < 4; ++j) { const int row = tm * 128 + wr * 64 + mi * 16 + fq * 4 + j;
                        const float e = __expf(-(w0 + acc[mi][n][j]));
                        p.sW[((size_t)d * T + row) * DA + c] = __expf(-0.60653065971f / (1.0f + e)); } }
                asm volatile("" ::: "memory"); }
        });
        else if (type < 4) gemm_tile(a0, a1, b0, b1, K, lds, [&](const f32x4 (&acc)[4][4], int wr, int wc, int fr, int fq) {
#pragma unroll
            for (int mi = 0; mi < 4; ++mi) {
#pragma unroll
                for (int n = 0; n < 4; ++n) { const int c = tn * 128 + wc * 64 + n * 16 + fr;
                    const float a0v = p.a_a0[(l * 2 + d) * DA + c], kkc = p.a_k_k[l * DA + c], kac = p.a_k_a[l * DA + c];
#pragma unroll
                    for (int j = 0; j < 4; ++j) { const int row = tm * 128 + wr * 64 + mi * 16 + fq * 4 + j;
                        const size_t o = (size_t)row * DA + c, od = ((size_t)d * T + row) * DA + c;
                        const float av = 1.0f / (1.0f + __expf(-(a0v + acc[mi][n][j]))); const float k = p.kT[o];
                        const float kk = k * kkc * p.kN[(size_t)row * 4 + (c >> 6)];
                        p.sKD[od] = k * (1.0f + (av - 1.0f) * kac); p.sB[od] = kk * av; if (d == 0) p.sKK[o] = kk; } }
                asm volatile("" ::: "memory"); }
        });
        else gemm_tile(a0, a1, b0, b1, K, lds, [&](const f32x4 (&acc)[4][4], int wr, int wc, int fr, int fq) {
#pragma unroll
            for (int mi = 0; mi < 4; ++mi)
#pragma unroll
                for (int n = 0; n < 4; ++n) { const int c = tn * 128 + wc * 64 + n * 16 + fr;
#pragma unroll
                    for (int j = 0; j < 4; ++j) p.sG[(size_t)(tm * 128 + wr * 64 + mi * 16 + fq * 4 + j) * DA + c] = acc[mi][n][j]; }
        });
    }
}


typedef float f32x16 __attribute__((ext_vector_type(16)));
typedef short s16x4 __attribute__((ext_vector_type(4)));
typedef unsigned u32x4_t __attribute__((ext_vector_type(4)));
typedef float f32x2_t __attribute__((ext_vector_type(2)));
typedef __bf16 bf16x2_t __attribute__((ext_vector_type(2)));
__device__ __forceinline__ unsigned cvtpk(float lo, float hi) { f32x2_t v = {lo, hi}; bf16x2_t b = __builtin_convertvector(v, bf16x2_t); return __builtin_bit_cast(unsigned, b); }
__device__ __forceinline__ int crow(int r, int hi) { return (r & 3) + 8 * (r >> 2) + 4 * hi; }

template <class MaskF>
__device__ __forceinline__ void attn_tile(const bf16x8 (&qf)[4], const bf16_t* krow, const bf16_t* vt0, const bf16_t* vt1, const MaskF& mask,
                                          float& m_run, float& l_run, f32x16& o0, f32x16& o1, int hi) {
    f32x16 s;
#pragma unroll
    for (int r = 0; r < 16; ++r) s[r] = 0.f;
#pragma unroll
    for (int ks = 0; ks < 4; ++ks) { const bf16x8 kf = *(const bf16x8*)(krow + 16 * ks); s = __builtin_amdgcn_mfma_f32_32x32x16_bf16(kf, qf[ks], s, 0, 0, 0); }
    float mx = -INFINITY;
#pragma unroll
    for (int r = 0; r < 16; ++r) { s[r] = mask(crow(r, hi), s[r] * ATT_SCALE); mx = fmaxf(mx, s[r]); }
    mx = fmaxf(mx, __shfl_xor(mx, 32));
    const float mn = fmaxf(m_run, mx), alpha = __expf(m_run - mn);
    m_run = mn;
    float ps = 0.f;
#pragma unroll
    for (int r = 0; r < 16; ++r) { s[r] = __expf(s[r] - mn); ps += s[r]; }
    l_run = l_run * alpha + ps;
#pragma unroll
    for (int r = 0; r < 16; ++r) { o0[r] *= alpha; o1[r] *= alpha; }
#pragma unroll
    for (int s2 = 0; s2 < 2; ++s2) {
        u32x4_t pw; pw[0] = cvtpk(s[8 * s2], s[8 * s2 + 1]); pw[1] = cvtpk(s[8 * s2 + 2], s[8 * s2 + 3]); pw[2] = cvtpk(s[8 * s2 + 4], s[8 * s2 + 5]); pw[3] = cvtpk(s[8 * s2 + 6], s[8 * s2 + 7]);
        const bf16x8 pb = __builtin_bit_cast(bf16x8, pw);
        const s16x4 a0 = *(const s16x4*)(vt0 + 16 * s2), a1 = *(const s16x4*)(vt0 + 16 * s2 + 8);
        const s16x4 c0 = *(const s16x4*)(vt1 + 16 * s2), c1 = *(const s16x4*)(vt1 + 16 * s2 + 8);
        o0 = __builtin_amdgcn_mfma_f32_32x32x16_bf16(__builtin_shufflevector(a0, a1, 0, 1, 2, 3, 4, 5, 6, 7), pb, o0, 0, 0, 0);
        o1 = __builtin_amdgcn_mfma_f32_32x32x16_bf16(__builtin_shufflevector(c0, c1, 0, 1, 2, 3, 4, 5, 6, 7), pb, o1, 0, 0, 0);
    }
}
struct NoMask { __device__ __forceinline__ float operator()(int, float v) const { return v; } };

__device__ void ph_attn_mfma(const Params& p, int l, bool with_ctx) {
    const int tid_ = opq_tid(), bid_ = opq_bid(); (void)tid_; (void)bid_;
    const int lane = tid_ & 63, hi = lane >> 5, ql = lane & 31;
    const int gw = bid_ * 4 + (tid_ >> 6), nw = gridDim.x * 4;
    constexpr int NQT = S / 32, NCT = L / 32, N_LAT = NB * 6 * NQT, N_CTX = NB * 6 * NCT;
    const int ntask = 2 * N_LAT + (with_ctx ? 2 * N_CTX : 0);
    for (int task = gw; task < ntask; task += nw) {
        bool isC, isCtx; int r;
        if (task < N_LAT) { isC = true; isCtx = false; r = task; }
        else if (task < 2 * N_LAT) { isC = false; isCtx = false; r = task - N_LAT; }
        else { r = task - 2 * N_LAT; isCtx = true; isC = r >= N_CTX; if (isC) r -= N_CTX; }
        const int nqt = isCtx ? NCT : NQT, qt = r % nqt, h = (r / nqt) % 6, b = r / (nqt * 6);
        const int m = isCtx ? TL + b * L + 32 * qt + ql : b * S + 32 * qt + ql;
        const int qcol = isC ? ZQN + h * 64 : ZQB + h * 64, kcol = isC ? ZKN + h * 64 : ZKB + (h / 3) * 64, hv = isC ? 2 + h : h / 3;
        bf16x8 qf[4];
        { const bf16_t* qp = p.Z + (size_t)m * ZP + qcol + 8 * hi;
#pragma unroll
          for (int ks = 0; ks < 4; ++ks) qf[ks] = *(const bf16x8*)(qp + 16 * ks); }
        const bf16_t* kc0 = p.Z + (size_t)(TL + b * L + ql) * ZP + kcol + 8 * hi;
        const bf16_t* kl0 = p.Z + (size_t)(b * S + ql) * ZP + kcol + 8 * hi;
        const bf16_t* vt0 = p.VT + ((size_t)(b * 8 + hv) * 64 + ql) * PU + 4 * hi; const bf16_t* vt1 = vt0 + (size_t)32 * PU;
        f32x16 o0, o1;
#pragma unroll
        for (int rr = 0; rr < 16; ++rr) { o0[rr] = 0.f; o1[rr] = 0.f; }
        float m_run, l_run;
        if (isC) { m_run = -1e30f; l_run = 0.f; } else { m_run = p.b_sink[l * 6 + h]; l_run = hi == 0 ? 1.0f : 0.f; }
        for (int i = 0; i < NCT; ++i) attn_tile(qf, kc0 + (size_t)(32 * i) * ZP, vt0 + 32 * i, vt1 + 32 * i, NoMask(), m_run, l_run, o0, o1, hi);
        if (!isCtx) {
            if (!isC) {
                for (int jt = qt - 4; jt <= qt + 4; ++jt) {
                    if (jt < 0 || jt >= NQT) continue;
                    const bf16_t* kr = kl0 + (size_t)(32 * jt) * ZP; const bf16_t* v0 = vt0 + L + 32 * jt; const bf16_t* v1 = vt1 + L + 32 * jt;
                    if (jt == qt - 4 || jt == qt + 4) { const int base = 32 * (jt - qt) - ql;
                        attn_tile(qf, kr, v0, v1, [&](int ko, float v) { const int rel = base + ko; return (rel >= -128 && rel <= 128) ? v : -INFINITY; }, m_run, l_run, o0, o1, hi); }
                    else attn_tile(qf, kr, v0, v1, NoMask(), m_run, l_run, o0, o1, hi);
                }
            } else {
                constexpr int ROWS = S / GRID_W;
                const int gr = qt >> 1, c = 32 * (qt & 1) + ql;
                int r0 = gr - 4; r0 = r0 < 0 ? 0 : (r0 > ROWS - 8 ? ROWS - 8 : r0);
                int c0 = c - 8; c0 = c0 < 0 ? 0 : (c0 > GRID_W - 16 ? GRID_W - 16 : c0);
                const float* rpb = p.c_rpb + ((size_t)l * 6 + h) * 15 * 31;
                for (int a = 0; a < 8; ++a) {
                    const int kr_ = r0 + a; const float* rp = rpb + (kr_ - gr + 7) * 31 + 15 - c;
#pragma unroll
                    for (int ct = 0; ct < 2; ++ct) {
                        const int t0 = kr_ * GRID_W + 32 * ct;
                        attn_tile(qf, kl0 + (size_t)t0 * ZP, vt0 + L + t0, vt1 + L + t0,
                                  [&](int ko, float v) { const int kc = 32 * ct + ko; return (kc >= c0 && kc < c0 + 16) ? v + rp[kc] : -INFINITY; }, m_run, l_run, o0, o1, hi);
                    }
                }
            }
        }
        const float lt = l_run + __shfl_xor(l_run, 32), inv = 1.0f / lt;
        bf16_t* op = p.MIX + (size_t)m * DMIX + (isC ? 640 : 256) + h * 64 + 4 * hi;
#pragma unroll
        for (int g = 0; g < 4; ++g) {
            st_bf16x4(op + 8 * g, (f32x4){o0[4 * g] * inv, o0[4 * g + 1] * inv, o0[4 * g + 2] * inv, o0[4 * g + 3] * inv});
            st_bf16x4(op + 32 + 8 * g, (f32x4){o1[4 * g] * inv, o1[4 * g + 1] * inv, o1[4 * g + 2] * inv, o1[4 * g + 3] * inv});
        }
    }
}


#define RNB " row_newbcast:%c[n] row_mask:0xf bank_mask:0xf\n\t"
template <int N, bool FIRST>
__device__ __forceinline__ void dpp_dot4(float& a0, float& a1, float& a2, float& a3, const f32x4& v, float s0, float s1, float s2, float s3) {
    if (FIRST) asm volatile("s_nop 1");
    asm("v_fmac_f32_dpp %0, %4, %8" RNB "v_fmac_f32_dpp %1, %5, %9" RNB "v_fmac_f32_dpp %2, %6, %10" RNB "v_fmac_f32_dpp %3, %7, %11" RNB
        : "+v"(a0), "+v"(a1), "+v"(a2), "+v"(a3) : "v"(v[0]), "v"(v[1]), "v"(v[2]), "v"(v[3]), "v"(s0), "v"(s1), "v"(s2), "v"(s3), [n] "i"(N));
}
template <int N, bool FIRST>
__device__ __forceinline__ void dpp_upd4s(float& s0, float& s1, float& s2, float& s3, float& y0, float& y1, float& y2, float& y3,
                                          const f32x4& w, const f32x4& b, const f32x4& kd, const f32x4& r, float nsk, float vv) {
    if (FIRST) asm volatile("s_nop 1");
    asm("v_mul_f32_dpp %0, %8, %0" RNB "v_mul_f32_dpp %1, %9, %1" RNB "v_mul_f32_dpp %2, %10, %2" RNB "v_mul_f32_dpp %3, %11, %3" RNB
        "v_fmac_f32_dpp %0, %12, %24" RNB "v_fmac_f32_dpp %1, %13, %24" RNB "v_fmac_f32_dpp %2, %14, %24" RNB "v_fmac_f32_dpp %3, %15, %24" RNB
        "v_fmac_f32_dpp %0, %16, %25" RNB "v_fmac_f32_dpp %1, %17, %25" RNB "v_fmac_f32_dpp %2, %18, %25" RNB "v_fmac_f32_dpp %3, %19, %25" RNB
        "v_fmac_f32_dpp %4, %20, %0" RNB "v_fmac_f32_dpp %5, %21, %1" RNB "v_fmac_f32_dpp %6, %22, %2" RNB "v_fmac_f32_dpp %7, %23, %3" RNB
        : "+v"(s0), "+v"(s1), "+v"(s2), "+v"(s3), "+v"(y0), "+v"(y1), "+v"(y2), "+v"(y3)
        : "v"(w[0]), "v"(w[1]), "v"(w[2]), "v"(w[3]), "v"(b[0]), "v"(b[1]), "v"(b[2]), "v"(b[3]), "v"(kd[0]), "v"(kd[1]), "v"(kd[2]), "v"(kd[3]),
          "v"(r[0]), "v"(r[1]), "v"(r[2]), "v"(r[3]), "v"(nsk), "v"(vv), [n] "i"(N));
}
template <int N, bool FIRST>
__device__ __forceinline__ void dpp_upd4p(float& s0, float& s1, float& s2, float& s3, float& y0, float& y1, float& y2, float& y3,
                                          const f32x4& w, const f32x4& b, const f32x4& r, float nsk) {
    if (FIRST) asm volatile("s_nop 1");
    asm("v_mul_f32_dpp %0, %8, %0" RNB "v_mul_f32_dpp %1, %9, %1" RNB "v_mul_f32_dpp %2, %10, %2" RNB "v_mul_f32_dpp %3, %11, %3" RNB
        "v_fmac_f32_dpp %0, %12, %20" RNB "v_fmac_f32_dpp %1, %13, %20" RNB "v_fmac_f32_dpp %2, %14, %20" RNB "v_fmac_f32_dpp %3, %15, %20" RNB
        "v_fmac_f32_dpp %4, %16, %0" RNB "v_fmac_f32_dpp %5, %17, %1" RNB "v_fmac_f32_dpp %6, %18, %2" RNB "v_fmac_f32_dpp %7, %19, %3" RNB
        : "+v"(s0), "+v"(s1), "+v"(s2), "+v"(s3), "+v"(y0), "+v"(y1), "+v"(y2), "+v"(y3)
        : "v"(w[0]), "v"(w[1]), "v"(w[2]), "v"(w[3]), "v"(b[0]), "v"(b[1]), "v"(b[2]), "v"(b[3]), "v"(r[0]), "v"(r[1]), "v"(r[2]), "v"(r[3]), "v"(nsk), [n] "i"(N));
}
template <int N> struct ScanRep {
    static __device__ __forceinline__ void dot(float& a0, float& a1, float& a2, float& a3, const f32x4& v, const float (&st)[64]) {
        dpp_dot4<N, N == 0>(a0, a1, a2, a3, v, st[4 * N], st[4 * N + 1], st[4 * N + 2], st[4 * N + 3]);
        if constexpr (N < 15) ScanRep<N + 1>::dot(a0, a1, a2, a3, v, st);
    }
    static __device__ __forceinline__ void upds(float (&st)[64], float& y0, float& y1, float& y2, float& y3, const f32x4& w, const f32x4& b, const f32x4& kd, const f32x4& r, float nsk, float vv) {
        dpp_upd4s<N, N == 0>(st[4 * N], st[4 * N + 1], st[4 * N + 2], st[4 * N + 3], y0, y1, y2, y3, w, b, kd, r, nsk, vv);
        if constexpr (N < 15) ScanRep<N + 1>::upds(st, y0, y1, y2, y3, w, b, kd, r, nsk, vv);
    }
    static __device__ __forceinline__ void updp(float (&st)[64], float& y0, float& y1, float& y2, float& y3, const f32x4& w, const f32x4& b, const f32x4& r, float nsk) {
        dpp_upd4p<N, N == 0>(st[4 * N], st[4 * N + 1], st[4 * N + 2], st[4 * N + 3], y0, y1, y2, y3, w, b, r, nsk);
        if constexpr (N < 15) ScanRep<N + 1>::updp(st, y0, y1, y2, y3, w, b, r, nsk);
    }
};
__device__ __forceinline__ int seg_row0(int b, int d, int s) { const int pos0 = 128 * s; return pos0 < L ? TL + b * L + (d ? L - 1 - pos0 : pos0) : b * S + (d ? S - 1 - (pos0 - L) : pos0 - L); }

template <bool ISP>
__device__ __forceinline__ void scan_task(const Params& p, int c, int s, int lane) {
    const int h = c & 3, b = (c >> 2) % NB, d = (c >> 2) / NB;
    const int m0 = seg_row0(b, d, s); const long step = d ? -(long)DA : (long)DA;
    const size_t o = (size_t)m0 * DA + h * 64, od = ((size_t)d * T + m0) * DA + h * 64; const int q = 4 * (lane & 15);
    const float* pkk = p.sKK + o + q; const float* pr = p.sR + o + q; const float* pw = p.sW + od + q; const float* pb = p.sB + od + q;
    const float* pkd = p.sKD + od + q; const float* pv = p.sV + o + lane;
    float* py = (ISP ? p.PV : p.Y) + od + lane;
    float st[64];
#pragma unroll
    for (int k = 0; k < 64; ++k) st[k] = (ISP && k == lane) ? 1.0f : 0.f;
    f32x4 kk = *(const f32x4*)pkk, w = *(const f32x4*)pw, bb = *(const f32x4*)pb, r = *(const f32x4*)pr, kd = w; float vv = 0.f;
    if (!ISP) { kd = *(const f32x4*)pkd; vv = *pv; }
#pragma unroll 1
    for (int i = 0; i < 128; ++i) {
        const long nx = (i < 127) ? step : 0;
        pkk += nx; pw += nx; pb += nx; pr += nx; pkd += nx; pv += nx;
        const f32x4 nkk = *(const f32x4*)pkk, nw = *(const f32x4*)pw, nb = *(const f32x4*)pb, nr = *(const f32x4*)pr;
        f32x4 nkd = nw; float nv = 0.f;
        if (!ISP) { nkd = *(const f32x4*)pkd; nv = *pv; }
        float a0 = 0.f, a1 = 0.f, a2 = 0.f, a3 = 0.f;
        ScanRep<0>::dot(a0, a1, a2, a3, kk, st);
        const float nsk = -((a0 + a1) + (a2 + a3));
        float y0 = 0.f, y1 = 0.f, y2 = 0.f, y3 = 0.f;
        if (ISP) ScanRep<0>::updp(st, y0, y1, y2, y3, w, bb, r, nsk); else ScanRep<0>::upds(st, y0, y1, y2, y3, w, bb, kd, r, nsk, vv);
        *py = (y0 + y1) + (y2 + y3); py += step;
        kk = nkk; w = nw; bb = nb; r = nr; kd = nkd; vv = nv;
    }
    if (s < NSG - 1) {
        float* dst = (ISP ? p.PS : p.QS) + (((size_t)c * NSG + s) * 64 + lane) * 64;
#pragma unroll
        for (int k4 = 0; k4 < 16; ++k4) *(f32x4*)(dst + 4 * k4) = (f32x4){st[4 * k4], st[4 * k4 + 1], st[4 * k4 + 2], st[4 * k4 + 3]};
    }
}
__device__ void ph_scan_fast(const Params& p) {
    const int tid_ = opq_tid(), bid_ = opq_bid(); (void)tid_; (void)bid_;
    const int lane = tid_ & 63, gw = bid_ * 4 + (tid_ >> 6), nw = gridDim.x * 4;
    constexpr int NS_T = 64 * NSG, NP_T = 64 * (NSG - 1);
    for (int tsk = gw; tsk < NS_T + NP_T; tsk += nw) {
        const int t2 = __builtin_amdgcn_readfirstlane(tsk);
        if (t2 < NS_T) scan_task<false>(p, t2 & 63, t2 >> 6, lane);
        else scan_task<true>(p, (t2 - NS_T) & 63, 1 + ((t2 - NS_T) >> 6), lane);
    }
}
__device__ void ph_combine(const Params& p, char* lds) {
    const int tid_ = opq_tid(), bid_ = opq_bid(); (void)tid_; (void)bid_;
    if (bid_ >= 64) return;
    const int c = bid_, tid = tid_, v = tid >> 2, jq = tid & 3;
    float* SSc = (float*)lds; float* Pm = (float*)(lds + 64 * 65 * 4 + 16);
    const float* QSc = p.QS + (size_t)c * NSG * 4096; const float* PSc = p.PS + (size_t)c * NSG * 4096; float* SSg = p.SS + (size_t)c * NSG * 4096;
    f32x4 acc[4];
#pragma unroll
    for (int i = 0; i < 4; ++i) { acc[i] = *(const f32x4*)(QSc + v * 64 + 16 * jq + 4 * i); *(f32x4*)(SSg + 4096 + v * 64 + 16 * jq + 4 * i) = acc[i];
#pragma unroll
        for (int e = 0; e < 4; ++e) SSc[v * 65 + 16 * jq + 4 * i + e] = acc[i][e]; }
    for (int s = 1; s < NSG - 1; ++s) {
#pragma unroll
        for (int qq = 0; qq < 4; ++qq) ((f32x4*)Pm)[tid + 256 * qq] = ((const f32x4*)(PSc + (size_t)s * 4096))[tid + 256 * qq];
#pragma unroll
        for (int i = 0; i < 4; ++i) acc[i] = *(const f32x4*)(QSc + (size_t)s * 4096 + v * 64 + 16 * jq + 4 * i);
        __syncthreads();
#pragma unroll 8
        for (int k = 0; k < 64; ++k) { const float a = SSc[v * 65 + k];
#pragma unroll
            for (int i = 0; i < 4; ++i) acc[i] += ((const f32x4*)Pm)[k * 16 + 4 * jq + i] * a; }
        __syncthreads();
#pragma unroll
        for (int i = 0; i < 4; ++i) { *(f32x4*)(SSg + (size_t)(s + 1) * 4096 + v * 64 + 16 * jq + 4 * i) = acc[i];
#pragma unroll
            for (int e = 0; e < 4; ++e) SSc[v * 65 + 16 * jq + 4 * i + e] = acc[i][e]; }
        __syncthreads();
    }
}
__device__ void ph_rwkv_out_fast(const Params& p, int l, bool with_ctx) {
    const int tid_ = opq_tid(), bid_ = opq_bid(); (void)tid_; (void)bid_;
    const int lane = tid_ & 63, gw = bid_ * 4 + (tid_ >> 6), nw = gridDim.x * 4;
    constexpr int NLT = NB * (S / 32) * 4, NCTK = NB * (L / 32) * 4;
    const int ntask = NLT + (with_ctx ? NCTK : 0);
    for (int tsk = gw; tsk < ntask; tsk += nw) {
        const bool isCtx = tsk >= NLT; const int r = isCtx ? tsk - NLT : tsk;
        const int h = r & 3, npt = isCtx ? L / 32 : S / 32, tt = (r >> 2) % npt, b = (r >> 2) / npt;
        const int seg0 = isCtx ? (tt >> 2) : 2 + (tt >> 2), seg1 = isCtx ? (L / 128 - 1) - (tt >> 2) : 2 + (S / 128 - 1) - (tt >> 2);
        const int mbase = isCtx ? TL + b * L + 32 * tt : b * S + 32 * tt;
        float ss0[64], ss1[64];
        { const float* s0p = p.SS + ((((size_t)(0 * NB + b) * 4 + h) * NSG + seg0) * 64 + lane) * 64; const float* s1p = p.SS + ((((size_t)(1 * NB + b) * 4 + h) * NSG + seg1) * 64 + lane) * 64;
#pragma unroll
          for (int k4 = 0; k4 < 16; ++k4) { f32x4 a = {0.f, 0.f, 0.f, 0.f}, c2 = a; if (seg0 > 0) a = *(const f32x4*)(s0p + 4 * k4); if (seg1 > 0) c2 = *(const f32x4*)(s1p + 4 * k4);
#pragma unroll
              for (int e = 0; e < 4; ++e) { ss0[4 * k4 + e] = a[e]; ss1[4 * k4 + e] = c2[e]; } } }
        const float rk = p.a_r_k[l * DA + h * 64 + lane], gln = p.a_lnx_g[l * DA + h * 64 + lane], bln = p.a_lnx_b[l * DA + h * 64 + lane];
#pragma unroll 1
        for (int i = 0; i < 32; ++i) {
            const size_t o = (size_t)(mbase + i) * DA + h * 64, o1 = o + (size_t)T * DA;
            f32x4 pv0 = {0.f, 0.f, 0.f, 0.f}, pv1 = pv0;
            if (seg0 > 0) pv0 = *(const f32x4*)(p.PV + o + 4 * (lane & 15));
            if (seg1 > 0) pv1 = *(const f32x4*)(p.PV + o1 + 4 * (lane & 15));
            float a0 = p.Y[o + lane], a1 = p.Y[o1 + lane], a2 = 0.f, a3 = 0.f;
            const float rr = p.sR[o + lane], kds = p.sKD[o + lane] + p.sKD[o1 + lane], vv = p.sV[o + lane], gg = p.sG[o + lane];
            ScanRep<0>::dot(a0, a1, a2, a3, pv0, ss0);
            ScanRep<0>::dot(a0, a1, a2, a3, pv1, ss1);
            const float y = (a0 + a1) + (a2 + a3);
            const float mu = wave_sum(y) * (1.0f / 64.f), dy = y - mu;
            const float rstd = 1.0f / sqrtf(wave_sum(dy * dy) * (1.0f / 64.f) + GN_EPS);
            const float bon = wave_sum(rr * kds * rk);
            p.MIX[(size_t)(mbase + i) * DMIX + h * 64 + lane] = f2bf((dy * rstd * gln + bln + bon * vv) * gg);
        }
    }
}

#define GT ((long)blockIdx.x * blockDim.x + threadIdx.x)
#define GS ((long)gridDim.x * blockDim.x)
__global__ void __launch_bounds__(256) mega_fwd(Params p) {
    __shared__ __attribute__((aligned(16))) char lds[40960];
    cg::grid_group grid = cg::this_grid();
    const long gt = GT, gs = GS;
    ph_prep_w_fast(p, 0, 0, lds); ph_prep_misc(p, 0, gt, gs);
    grid.sync();
    for (int l = 0; l < 2; ++l) {
        const int nrows = (l == 0) ? T : TL;
        ph_lnmod_fast(p, l);
        grid.sync();
        g_gemm_in(p, lds);
        grid.sync();
        ph_streams_s1(p, l); ph_rope(p, gt, gs);
        grid.sync();
        g_streams_s2(p, l, lds);
        grid.sync();
        ph_scan_fast(p);
        grid.sync();
        ph_combine(p, lds); ph_attn_mfma(p, l, l == 0);
        grid.sync();
        ph_rwkv_out_fast(p, l, l == 0);
        grid.sync();
        g_gemm_out(p, nrows, lds); ph_prep_w_fast(p, l, 1, lds);
        grid.sync();
        ph_post_mixer_fast(p, l, nrows);
        grid.sync();
        ph_dispatch(p, l, nrows, gt, gs);
        grid.sync();
        g_moe1(p, l, lds);
        grid.sync();
        g_moe2(p, l, lds);
        grid.sync();
        ph_final_fast(p, l, nrows);
        if (l == 0) { ph_prep_w_fast(p, 1, 0, lds); ph_prep_misc(p, 1, gt, gs); }
        grid.sync();
    }
}

extern "C" void kernel_launch(void* const* d_in, const int* in_sizes, int n_in, void* d_out, int out_size, void* d_ws, size_t ws_size, hipStream_t stream) {
    if (n_in != 32 || out_size != TL * D || ws_size < WS_NEED) { fprintf(stderr, "kernel_launch: unexpected shapes / workspace (n_in %d out %d ws %zu need %zu)\n", n_in, out_size, ws_size, (size_t)WS_NEED); return; }
    static int grid_blocks = 0;
    if (!grid_blocks) {
        int dev = 0, cus = 0, per_cu = 0;
        (void)hipGetDevice(&dev);
        (void)hipDeviceGetAttribute(&cus, hipDeviceAttributeMultiprocessorCount, dev);
        (void)hipOccupancyMaxActiveBlocksPerMultiprocessor(&per_cu, mega_fwd, 256, 0);
        if (per_cu < 1) per_cu = 1;
        if (per_cu > 4) per_cu = 4;
        grid_blocks = cus * per_cu;
        fprintf(stderr, "kernel_launch: %d CUs x %d blocks\n", cus, per_cu);
    }
    Params p = make_params(d_in, d_out, d_ws);
    void* args[] = {&p};
    hipError_t e = hipLaunchCooperativeKernel((void*)mega_fwd, dim3(grid_blocks), dim3(256), args, 0, stream);
    if (e != hipSuccess) fprintf(stderr, "cooperative launch failed: %s (grid %d)\n", hipGetErrorString(e), grid_blocks);
}
#endif

#ifdef HOST_EMU
static void host_forward(void* const* d_in, void* d_out, void* d_ws) {
    const Params p = make_params(d_in, d_out, d_ws);
    for (int l = 0; l < 2; ++l) {
        const int nrows = (l == 0) ? T : TL;
        ph_prep_w(p, l, 0, 1); ph_prep_misc(p, l, 0, 1); ph_lnmod(p, l, 0, 1); host_gemm_in(p); ph_streams(p, l, 0, 1); ph_rope(p, 0, 1); ph_scan(p, 0, 1);
        ph_attn(p, l, nrows, 0, 1); ph_rwkv_out(p, l, nrows, 0, 1); host_gemm_out(p, nrows); ph_post_mixer(p, l, nrows, 0, 1);
        ph_dispatch(p, l, nrows, 0, 1); host_moe1(p, l); host_moe2(p, l); ph_final(p, l, nrows, 0, 1);
    }
}
#endif
```

```cpp
#ifdef HOST_EMU
#include <cmath>
#include <cstdio>
#include <cstring>
#include <cstdint>
#include <cstdlib>
#define __device__
#define __global__
#define __host__
#define __forceinline__ inline
#else
#include <hip/hip_runtime.h>
#include <hip/hip_cooperative_groups.h>
#include <cstdio>
#include <cstdint>
namespace cg = cooperative_groups;
#endif

#ifndef CFG_D
#define CFG_D 1024
#define CFG_B 8
#define CFG_S 2048
#define CFG_L 256
#define CFG_DE 512
#endif
constexpr int D = CFG_D, NB = CFG_B, S = CFG_S, L = CFG_L, DE = CFG_DE;
constexpr int TL = NB * S, TC = NB * L, T = TL + TC;
constexpr int GRID_W = 64, HD = 64;
constexpr int DA = 256, A_IN = 1184, N_IN = 2976, NINP = 3072, DMIX = 1024;
constexpr int NEXP = 32, NSLOT = 2 * T + NEXP * 128;
constexpr int ZQB = 0, ZKB = 384, ZVB = 512, ZQN = 640, ZKN = 1024, ZVN = 1408, ZA = 1792, ZP = 2976;
constexpr float LN_EPS = 1e-6f, GN_EPS = 64e-5f, ATT_SCALE = 0.125f;
constexpr float ALPHA = 1.41421356237309515f;

typedef unsigned short bf16_t;

__device__ __forceinline__ float bf2f(bf16_t v) {
    unsigned u = ((unsigned)v) << 16; float f;
#ifdef HOST_EMU
    memcpy(&f, &u, 4);
#else
    f = __uint_as_float(u);
#endif
    return f;
}
__device__ __forceinline__ bf16_t f2bf(float f) {
    unsigned u;
#ifdef HOST_EMU
    memcpy(&u, &f, 4);
#else
    u = __float_as_uint(f);
#endif
    return (bf16_t)((u + 0x7fffu + ((u >> 16) & 1u)) >> 16);
}
__device__ __forceinline__ float sigmoidf_(float x) { return 1.0f / (1.0f + expf(-x)); }
__device__ __forceinline__ float siluf_(float x) { return x / (1.0f + expf(-x)); }
__device__ __forceinline__ int atomic_inc_int(int* p) {
#ifdef HOST_EMU
    int o = *p; *p = o + 1; return o;
#else
    return atomicAdd(p, 1);
#endif
}

struct Params {
    const float *x, *c, *ctx, *c_ctx, *w_mod, *b_mod, *w_in, *w_out, *a_shift, *a_w0, *a_w_up, *a_a0, *a_a_up, *a_g_up,
        *a_k_k, *a_k_a, *a_r_k, *a_lnx_g, *a_lnx_b, *b_sink, *c_rpb, *ln1_g, *ln1_b, *ln2_g, *ln2_b, *w_rg, *b_rg, *w_re,
        *b_re, *w_gate, *w_up, *w_down;
    float* out;
    int* cnt;
    unsigned* bar;
    float* mod;
    float* rope;
    bf16_t *win_t, *wout_t, *wgu_t, *wd_t;
    bf16_t *wupT, *aupT, *gupT;
    bf16_t* LA;
    float *kT, *kN;
    bf16_t* H;
    bf16_t* Z;
    bf16_t* VT;
    float *sR, *sV, *sKK, *sG, *sW, *sKD, *sB;
    float* Y;
    bf16_t* MIX;
    float *PV, *QS, *PS, *SS;
    float* XC;
    float* O;
    int *rE, *rPos, *rSlot; float* rW;
    int* slotTok;
    bf16_t* ACT;
    float* YS;
};

constexpr size_t al256(size_t v) { return (v + 255) & ~(size_t)255; }
constexpr size_t OFF_CNT = 0;
constexpr size_t OFF_BAR = 4096, CTL_BYTES = 4096 + 16384;
constexpr size_t OFF_MOD = CTL_BYTES;
constexpr size_t OFF_ROPE = al256(OFF_MOD + (size_t)2 * (NB + 1) * 6 * D * 4);
constexpr size_t OFF_LORA = al256(OFF_ROPE + 64 * 16 * 2 * 4);
constexpr size_t OFF_WIN = al256(OFF_LORA + (size_t)(2 * 256 * 64 * 2 + 256 * 160) * 2);
constexpr size_t OFF_WOUT = al256(OFF_WIN + (size_t)NINP * D * 2);
constexpr size_t OFF_WGU = al256(OFF_WOUT + (size_t)D * DMIX * 2);
constexpr size_t OFF_WD = al256(OFF_WGU + (size_t)NEXP * 2 * DE * D * 2);
constexpr size_t OFF_H = al256(OFF_WD + (size_t)NEXP * D * DE * 2);
constexpr size_t OFF_Z = al256(OFF_H + (size_t)(T + 1) * D * 2);
constexpr int PU = L + S;
constexpr int NSG = (L + S) / 128;
static_assert((size_t)3 * 64 * ((L + S) / 128) * 4096 * 4 <= (size_t)NEXP * 2 * DE * D * 2 || (L % 128) != 0, "scan segment states overlay wgu_t");
constexpr size_t OFF_VT = al256(OFF_Z + (size_t)T * ZP * 2);
constexpr size_t OFF_S = al256(OFF_VT + (size_t)NB * 8 * 64 * PU * 2);
constexpr size_t S1 = (size_t)T * 256 * 4;
constexpr size_t OFF_Y = al256(OFF_S + 10 * S1);
constexpr size_t OFF_MIX = al256(OFF_Y + 2 * S1);
constexpr size_t OFF_XC = al256(OFF_MIX + (size_t)T * 1024 * 2);
constexpr size_t OFF_ROUTE = al256(OFF_XC + (size_t)TC * D * 4);
constexpr size_t OFF_SLOTTOK = al256(OFF_ROUTE + (size_t)T * 2 * 4 * 4);
constexpr size_t WS_NEED = al256(OFF_SLOTTOK + (size_t)NSLOT * 4);
static_assert((size_t)NSLOT * DE * 2 <= (size_t)T * ZP * 2, "ACT overlays Z");
static_assert((size_t)T * 4 * 4 + (size_t)T * 416 * 2 <= S1, "kN + LA overlay Y[1]");
static_assert((size_t)NSLOT * D * 4 <= 10 * S1 && (size_t)T * D * 4 <= 10 * S1, "YS / O overlay the stream buffers");

static Params make_params(void* const* d_in, void* d_out, void* d_ws) {
    Params p{};
    const float** f = (const float**)&p.x;
    for (int i = 0; i < 32; ++i) f[i] = (const float*)d_in[i];
    p.out = (float*)d_out;
    char* w = (char*)d_ws;
    p.cnt = (int*)(w + OFF_CNT); p.bar = (unsigned*)(w + OFF_BAR); p.mod = (float*)(w + OFF_MOD); p.rope = (float*)(w + OFF_ROPE);
    p.win_t = (bf16_t*)(w + OFF_WIN); p.wout_t = (bf16_t*)(w + OFF_WOUT); p.wgu_t = (bf16_t*)(w + OFF_WGU); p.wd_t = (bf16_t*)(w + OFF_WD);
    p.wupT = (bf16_t*)(w + OFF_LORA); p.aupT = p.wupT + 2 * 256 * 64; p.gupT = p.aupT + 2 * 256 * 64;
    p.H = (bf16_t*)(w + OFF_H); p.Z = (bf16_t*)(w + OFF_Z); p.VT = (bf16_t*)(w + OFF_VT);
    float* s = (float*)(w + OFF_S); const size_t n1 = (size_t)T * 256;
    p.sR = s; p.sV = s + n1; p.sKK = s + 2 * n1; p.sG = s + 3 * n1; p.sW = s + 4 * n1; p.sKD = s + 6 * n1; p.sB = s + 8 * n1;
    p.Y = (float*)(w + OFF_Y); p.MIX = (bf16_t*)(w + OFF_MIX); p.XC = (float*)(w + OFF_XC);
    p.O = (float*)(w + OFF_S);
    p.PV = (float*)(w + OFF_H); p.QS = (float*)(w + OFF_WGU); p.PS = p.QS + (size_t)64 * NSG * 4096; p.SS = p.PS + (size_t)64 * NSG * 4096;
    p.kT = p.Y; p.kN = p.Y + (size_t)T * 256; p.LA = (bf16_t*)(p.Y + (size_t)T * 256 + (size_t)T * 4);
    int* r = (int*)(w + OFF_ROUTE); p.rE = r; p.rPos = r + 2 * T; p.rSlot = r + 4 * T; p.rW = (float*)(r + 6 * T);
    p.slotTok = (int*)(w + OFF_SLOTTOK);
    p.ACT = (bf16_t*)(w + OFF_Z); p.YS = (float*)(w + OFF_S);
    return p;
}

__device__ void ph_prep_w(const Params& p, int l, long gtid, long gsz) {
    for (long i = gtid; i < (long)D * NINP; i += gsz) {
        const int k = (int)(i / NINP), n = (int)(i % NINP);
        float v = 0.f;
        if (n < N_IN) { const int oc = (n < ZA) ? n + A_IN : n - ZA; v = p.w_in[((size_t)l * D + k) * N_IN + oc]; }
        p.win_t[(size_t)n * D + k] = f2bf(v);
    }
    for (long i = gtid; i < (long)DMIX * D; i += gsz) {
        const int k = (int)(i / D), n = (int)(i % D);
        p.wout_t[(size_t)n * DMIX + k] = f2bf(p.w_out[((size_t)l * DMIX + k) * D + n]);
    }
    for (long i = gtid; i < (long)NEXP * D * 2 * DE; i += gsz) {
        const int rho = (int)(i % (2 * DE)); const long t = i / (2 * DE); const int k = (int)(t % D), e = (int)(t / D);
        const int q = rho >> 5, half = (rho >> 4) & 1, ii = rho & 15, cc = 16 * q + ii;
        const float* src = half ? p.w_up : p.w_gate;
        p.wgu_t[((size_t)e * 2 * DE + rho) * D + k] = f2bf(src[(((size_t)l * NEXP + e) * D + k) * DE + cc]);
    }
    for (long i = gtid; i < (long)NEXP * DE * D; i += gsz) {
        const int n = (int)(i % D); const long t = i / D; const int k = (int)(t % DE), e = (int)(t / DE);
        p.wd_t[((size_t)e * D + n) * DE + k] = f2bf(p.w_down[(((size_t)l * NEXP + e) * DE + k) * D + n]);
    }
}
__device__ __forceinline__ void ph_prep_misc(const Params& p, int l, long gtid, long gsz) {
    if (l == 0) for (long i = gtid; i < (long)2 * (NB + 1) * 6 * D; i += gsz) {
        const int j = (int)(i % (6 * D)), b = (int)((i / (6 * D)) % (NB + 1)), ll = (int)(i / ((long)6 * D * (NB + 1)));
        const float* cv = (b < NB) ? p.c + (size_t)b * D : p.c_ctx;
        float acc = 0.f;
        for (int k = 0; k < D; ++k) acc += siluf_(cv[k]) * p.w_mod[((size_t)ll * D + k) * 6 * D + j];
        p.mod[((size_t)ll * (NB + 1) + b) * 6 * D + j] = acc + p.b_mod[(size_t)ll * 6 * D + j];
    }
    if (l == 0) for (long i = gtid; i < 64 * 16; i += gsz) {
        const int pos = (int)(i / 16), fi = (int)(i % 16);
        const float inv = powf(10000.0f, -(float)fi / 16.0f), ang = (float)pos * inv;
        p.rope[i] = cosf(ang); p.rope[1024 + i] = sinf(ang);
    }
    for (long i = gtid; i < NEXP; i += gsz) p.cnt[l * NEXP + i] = 0;
    for (long i = gtid; i < NSLOT; i += gsz) p.slotTok[i] = T;
    for (long i = gtid; i < D; i += gsz) p.H[(size_t)T * D + i] = 0;
}

__device__ __forceinline__ const float* xrow_in(const Params& p, int l, int m) {
    if (m < TL) return (l == 0 ? p.x : p.out) + (size_t)m * D;
    return (l == 0 ? p.ctx : p.XC) + (size_t)(m - TL) * D;
}
__device__ __forceinline__ const float* modrow(const Params& p, int l, int m) { return p.mod + ((size_t)l * (NB + 1) + (m < TL ? m / S : NB)) * 6 * D; }

__device__ void ph_lnmod(const Params& p, int l, long gtid, long gsz) {
    for (long m = gtid; m < T; m += gsz) {
        const float* xr = xrow_in(p, l, (int)m); const float* md = modrow(p, l, (int)m);
        float s = 0.f; for (int j = 0; j < D; ++j) s += xr[j];
        const float mu = s / D; float q = 0.f;
        for (int j = 0; j < D; ++j) { const float d = xr[j] - mu; q += d * d; }
        const float rstd = 1.0f / sqrtf(q / D + LN_EPS);
        for (int j = 0; j < D; ++j) p.H[(size_t)m * D + j] = f2bf((xr[j] - mu) * rstd * (1.0f + md[D + j]) + md[j]);
    }
}

__device__ __forceinline__ float zshift(const Params& p, int l, int m, int col) {
    int t, len;
    if (m < TL) { t = m % S; len = S; } else { t = (m - TL) % L; len = L; }
    const float* sh = p.a_shift + (size_t)l * 3 * A_IN;
    const bf16_t* z = p.Z + (size_t)m * ZP + ZA + col;
    float v = sh[A_IN + col] * bf2f(z[0]);
    if (t > 0) v += sh[col] * bf2f(z[-ZP]);
    if (t < len - 1) v += sh[2 * A_IN + col] * bf2f(z[ZP]);
    return v;
}

__device__ void ph_streams(const Params& p, int l, long gtid, long gsz) {
    for (long i = gtid; i < (long)T * DA; i += gsz) {
        const int m = (int)(i / DA), c = (int)(i % DA), h0 = c & ~63;
        const float r = zshift(p, l, m, c), k = zshift(p, l, m, 256 + c), v = zshift(p, l, m, 512 + c);
        float nrm = 0.f;
        for (int j = 0; j < 64; ++j) { const float t = zshift(p, l, m, 256 + h0 + j) * p.a_k_k[l * DA + h0 + j]; nrm += t * t; }
        const float kk = k * p.a_k_k[l * DA + c] / sqrtf(nrm + 1e-12f);
        float g = 0.f;
        for (int j = 0; j < 160; ++j) g += sigmoidf_(zshift(p, l, m, 1024 + j)) * p.a_g_up[((size_t)l * 160 + j) * DA + c];
        const size_t o = (size_t)m * DA + c;
        p.sR[o] = r; p.sV[o] = v; p.sKK[o] = kk; p.sG[o] = g;
        for (int d = 0; d < 2; ++d) {
            float aw = 0.f, aa = 0.f;
            for (int j = 0; j < 64; ++j) {
                aw += tanhf(zshift(p, l, m, 768 + d * 64 + j)) * p.a_w_up[(((size_t)l * 2 + d) * 64 + j) * DA + c];
                aa += zshift(p, l, m, 896 + d * 64 + j) * p.a_a_up[(((size_t)l * 2 + d) * 64 + j) * DA + c];
            }
            const float u = -(p.a_w0[(l * 2 + d) * DA + c] + aw);
            const float sp = (u > 20.f) ? u : log1pf(expf(u));
            const float w = expf(-expf(-sp - 0.5f));
            const float a = sigmoidf_(p.a_a0[(l * 2 + d) * DA + c] + aa);
            const size_t od = ((size_t)d * T + m) * DA + c;
            p.sW[od] = w; p.sKD[od] = k * (1.0f + (a - 1.0f) * p.a_k_a[l * DA + c]); p.sB[od] = kk * a;
        }
    }
}

__device__ __forceinline__ void ph_rope(const Params& p, long gtid, long gsz) {
    for (long i = gtid; i < (long)TL * 8 * 32; i += gsz) {
        const int pr = (int)(i & 31), hs = (int)((i >> 5) & 7), m = (int)(i >> 8);
        const int t = m % S, axis = pr >> 4, fi = pr & 15, pos = axis ? (t % GRID_W) : (t / GRID_W);
        bf16_t* z = p.Z + (size_t)m * ZP + hs * 64 + axis * 32 + fi;
        const float cs = p.rope[pos * 16 + fi], sn = p.rope[1024 + pos * 16 + fi];
        const float x0 = bf2f(z[0]), x1 = bf2f(z[16]);
        z[0] = f2bf(x0 * cs - x1 * sn); z[16] = f2bf(x1 * cs + x0 * sn);
    }
}

__device__ void ph_scan(const Params& p, long gtid, long gsz) {
    for (long i = gtid; i < (long)2 * NB * 4 * 64; i += gsz) {
        const int v = (int)(i & 63), h = (int)((i >> 6) & 3), b = (int)((i >> 8) % NB), d = (int)((i >> 8) / NB);
        float st[64];
#pragma unroll
        for (int k = 0; k < 64; ++k) st[k] = 0.f;
        for (int pos = 0; pos < L + S; ++pos) {
            int m;
            if (pos < L) m = TL + b * L + (d ? L - 1 - pos : pos);
            else m = b * S + (d ? S - 1 - (pos - L) : pos - L);
            const size_t o = (size_t)m * DA + h * 64, od = ((size_t)d * T + m) * DA + h * 64;
            const float* kk = p.sKK + o; const float* r = p.sR + o;
            const float* w = p.sW + od; const float* bb = p.sB + od; const float* kd = p.sKD + od;
            const float vv = p.sV[o + v];
            float sk = 0.f;
#pragma unroll
            for (int k = 0; k < 64; ++k) sk += st[k] * kk[k];
            float y = 0.f;
#pragma unroll
            for (int k = 0; k < 64; ++k) { st[k] = st[k] * w[k] - sk * bb[k] + vv * kd[k]; y += st[k] * r[k]; }
            p.Y[od + v] = y;
        }
    }
}

__device__ void ph_rwkv_out(const Params& p, int l, int nrows, long gtid, long gsz) {
    for (long i = gtid; i < (long)nrows * 4; i += gsz) {
        const int m = (int)(i >> 2), h = (int)(i & 3);
        const size_t o = (size_t)m * DA + h * 64;
        const float* y0 = p.Y + o; const float* y1 = p.Y + (size_t)T * DA + o;
        float s = 0.f, bon = 0.f;
        for (int n = 0; n < 64; ++n) {
            s += y0[n] + y1[n];
            bon += p.sR[o + n] * (p.sKD[o + n] + p.sKD[(size_t)T * DA + o + n]) * p.a_r_k[l * DA + h * 64 + n];
        }
        const float mu = s / 64.f; float q = 0.f;
        for (int n = 0; n < 64; ++n) { const float dd = y0[n] + y1[n] - mu; q += dd * dd; }
        const float rstd = 1.0f / sqrtf(q / 64.f + GN_EPS);
        for (int n = 0; n < 64; ++n) {
            const int c = h * 64 + n;
            const float yn = (y0[n] + y1[n] - mu) * rstd * p.a_lnx_g[l * DA + c] + p.a_lnx_b[l * DA + c];
            p.MIX[(size_t)m * DMIX + c] = f2bf((yn + bon * p.sV[o + n]) * p.sG[o + n]);
        }
    }
}

__device__ __forceinline__ void att_key(const float (&q)[64], const bf16_t* kr, const bf16_t* vr, float bias, float& mx, float& ls, float (&acc)[64]) {
    float s = 0.f;
#pragma unroll
    for (int d = 0; d < 64; ++d) s += q[d] * bf2f(kr[d]);
    s = s * ATT_SCALE + bias;
    const float mn = fmaxf(mx, s), f = expf(mx - mn), pe = expf(s - mn);
    ls = ls * f + pe;
#pragma unroll
    for (int d = 0; d < 64; ++d) acc[d] = acc[d] * f + pe * bf2f(vr[d]);
    mx = mn;
}

__device__ void ph_attn(const Params& p, int l, int nrows, long gtid, long gsz) {
    for (long i = gtid; i < (long)nrows * 12; i += gsz) {
        const int m = (int)(i / 12), u = (int)(i % 12);
        const bool isB = u < 6; const int hq = isB ? u : u - 6;
        const int b = (m < TL) ? m / S : (m - TL) / L;
        const int qcol = isB ? ZQB + hq * 64 : ZQN + hq * 64;
        const int kcol = isB ? ZKB + (hq / 3) * 64 : ZKN + hq * 64;
        const int vcol = isB ? ZVB + (hq / 3) * 64 : ZVN + hq * 64;
        float q[64], acc[64];
        const bf16_t* qr = p.Z + (size_t)m * ZP + qcol;
#pragma unroll
        for (int d = 0; d < 64; ++d) { q[d] = bf2f(qr[d]); acc[d] = 0.f; }
        float mx, ls;
        if (isB) { mx = p.b_sink[l * 6 + hq]; ls = 1.0f; } else { mx = -1e30f; ls = 0.f; }
        for (int j = 0; j < L; ++j) { const bf16_t* zr = p.Z + (size_t)(TL + b * L + j) * ZP; att_key(q, zr + kcol, zr + vcol, 0.f, mx, ls, acc); }
        if (m < TL) {
            const int t = m % S;
            if (isB) {
                const int j0 = t - 128 < 0 ? 0 : t - 128, j1 = t + 128 > S - 1 ? S - 1 : t + 128;
                for (int j = j0; j <= j1; ++j) { const bf16_t* zr = p.Z + (size_t)(b * S + j) * ZP; att_key(q, zr + kcol, zr + vcol, 0.f, mx, ls, acc); }
            } else {
                const int rows = S / GRID_W, r = t / GRID_W, c = t % GRID_W;
                int r0 = r - 4; r0 = r0 < 0 ? 0 : (r0 > rows - 8 ? rows - 8 : r0);
                int c0 = c - 8; c0 = c0 < 0 ? 0 : (c0 > GRID_W - 16 ? GRID_W - 16 : c0);
                for (int a = 0; a < 8; ++a)
                    for (int e = 0; e < 16; ++e) {
                        const int kr = r0 + a, kc = c0 + e;
                        const float bias = p.c_rpb[(((size_t)l * 6 + hq) * 15 + (kr - r + 7)) * 31 + (kc - c + 15)];
                        const bf16_t* zr = p.Z + (size_t)(b * S + kr * GRID_W + kc) * ZP;
                        att_key(q, zr + kcol, zr + vcol, bias, mx, ls, acc);
                    }
            }
        }
        const float inv = 1.0f / ls;
        bf16_t* o = p.MIX + (size_t)m * DMIX + (isB ? 256 : 640) + hq * 64;
#pragma unroll
        for (int d = 0; d < 64; ++d) o[d] = f2bf(acc[d] * inv);
    }
}

__device__ void ph_post_mixer(const Params& p, int l, int nrows, long gtid, long gsz) {
    for (long mm = gtid; mm < nrows; mm += gsz) {
        const int m = (int)mm;
        const float* xr = xrow_in(p, l, m); const float* md = modrow(p, l, m); const float* orow = p.O + (size_t)m * D;
        float* x1 = (m < TL) ? p.out + (size_t)m * D : p.XC + (size_t)(m - TL) * D;
        const float* g1 = p.ln1_g + (size_t)l * D; const float* b1 = p.ln1_b + (size_t)l * D;
        float s = 0.f; for (int j = 0; j < D; ++j) s += ALPHA * xr[j] + md[2 * D + j] * orow[j];
        float mu = s / D, q = 0.f;
        for (int j = 0; j < D; ++j) { const float d = ALPHA * xr[j] + md[2 * D + j] * orow[j] - mu; q += d * d; }
        float rstd = 1.0f / sqrtf(q / D + LN_EPS);
        s = 0.f;
        for (int j = 0; j < D; ++j) { const float v = (ALPHA * xr[j] + md[2 * D + j] * orow[j] - mu) * rstd * g1[j] + b1[j]; x1[j] = v; s += v; }
        mu = s / D; q = 0.f;
        for (int j = 0; j < D; ++j) { const float d = x1[j] - mu; q += d * d; }
        rstd = 1.0f / sqrtf(q / D + LN_EPS);
        float gl[4], el[32];
#pragma unroll
        for (int g = 0; g < 4; ++g) gl[g] = p.b_rg[l * 4 + g];
#pragma unroll
        for (int e = 0; e < 32; ++e) el[e] = p.b_re[l * 32 + e];
        for (int j = 0; j < D; ++j) {
            const float hv = (x1[j] - mu) * rstd * (1.0f + md[4 * D + j]) + md[3 * D + j];
            p.H[(size_t)m * D + j] = f2bf(hv);
            const float* wg = p.w_rg + ((size_t)l * D + j) * 4; const float* we = p.w_re + ((size_t)l * D + j) * 32;
#pragma unroll
            for (int g = 0; g < 4; ++g) gl[g] += hv * wg[g];
#pragma unroll
            for (int e = 0; e < 32; ++e) el[e] += hv * we[e];
        }
        int gs = 0; float gm = gl[0];
#pragma unroll
        for (int g = 1; g < 4; ++g) if (gl[g] > gm) { gm = gl[g]; gs = g; }
        float den = 0.f;
#pragma unroll
        for (int g = 0; g < 4; ++g) den += expf(gl[g] - gm);
        const float pg = 1.0f / den;
        float v1 = -3e38f, v2 = -3e38f; int i1 = 0, i2 = 0;
#pragma unroll
        for (int j = 0; j < 8; ++j) {
            const float v = gs == 0 ? el[j] : gs == 1 ? el[8 + j] : gs == 2 ? el[16 + j] : el[24 + j];
            if (v > v1) { v2 = v1; i2 = i1; v1 = v; i1 = j; } else if (v > v2) { v2 = v; i2 = j; }
        }
        const float e2 = expf(v2 - v1), w1 = pg / (1.0f + e2), w2 = pg * e2 / (1.0f + e2);
        const int ea = gs * 8 + i1, eb = gs * 8 + i2;
        p.rE[2 * m] = ea; p.rE[2 * m + 1] = eb; p.rW[2 * m] = w1; p.rW[2 * m + 1] = w2;
        p.rPos[2 * m] = atomic_inc_int(p.cnt + l * NEXP + ea); p.rPos[2 * m + 1] = atomic_inc_int(p.cnt + l * NEXP + eb);
    }
}

__device__ __forceinline__ int pstart_of(const int* cnt, int e) {
    int s = 0;
    for (int j = 0; j < NEXP; ++j) if (j < e) s += (cnt[j] + 127) & ~127;
    return s;
}
__device__ __forceinline__ void ph_dispatch(const Params& p, int l, int nrows, long gtid, long gsz) {
    for (long i = gtid; i < (long)nrows * 2; i += gsz) {
        const int slot = pstart_of(p.cnt + l * NEXP, p.rE[i]) + p.rPos[i];
        p.rSlot[i] = slot; p.slotTok[slot] = (int)(i >> 1);
    }
}

__device__ void ph_final(const Params& p, int l, int nrows, long gtid, long gsz) {
    for (long mm = gtid; mm < nrows; mm += gsz) {
        const int m = (int)mm;
        float* x1 = (m < TL) ? p.out + (size_t)m * D : p.XC + (size_t)(m - TL) * D;
        const float* md = modrow(p, l, m);
        const float* ya = p.YS + (size_t)p.rSlot[2 * m] * D; const float* yb = p.YS + (size_t)p.rSlot[2 * m + 1] * D;
        const float wa = p.rW[2 * m], wb = p.rW[2 * m + 1];
        const float* g2 = p.ln2_g + (size_t)l * D; const float* b2 = p.ln2_b + (size_t)l * D;
        float s = 0.f; for (int j = 0; j < D; ++j) s += ALPHA * x1[j] + md[5 * D + j] * (wa * ya[j] + wb * yb[j]);
        const float mu = s / D; float q = 0.f;
        for (int j = 0; j < D; ++j) { const float d = ALPHA * x1[j] + md[5 * D + j] * (wa * ya[j] + wb * yb[j]) - mu; q += d * d; }
        const float rstd = 1.0f / sqrtf(q / D + LN_EPS);
        for (int j = 0; j < D; ++j) x1[j] = (ALPHA * x1[j] + md[5 * D + j] * (wa * ya[j] + wb * yb[j]) - mu) * rstd * g2[j] + b2[j];
    }
}

__device__ __forceinline__ int moe_blocks(const int* cnt) { int s = 0; for (int j = 0; j < NEXP; ++j) s += (cnt[j] + 127) >> 7; return s; }
__device__ __forceinline__ int moe_block_expert(const int* cnt, int rb) {
    int s = 0, e = 0;
    for (int j = 0; j < NEXP; ++j) { const int nb = (cnt[j] + 127) >> 7; if (rb >= s && rb < s + nb) e = j; s += nb; }
    return e;
}

#ifdef HOST_EMU
static void host_gemm_in(const Params& p) {
    for (int m = 0; m < T; ++m) for (int n = 0; n < ZP; ++n) { float a = 0.f; for (int k = 0; k < D; ++k) a += bf2f(p.H[(size_t)m * D + k]) * bf2f(p.win_t[(size_t)n * D + k]); p.Z[(size_t)m * ZP + n] = f2bf(a); }
}
static void host_gemm_out(const Params& p, int nrows) {
    for (int m = 0; m < nrows; ++m) for (int n = 0; n < D; ++n) { float a = 0.f; for (int k = 0; k < DMIX; ++k) a += bf2f(p.MIX[(size_t)m * DMIX + k]) * bf2f(p.wout_t[(size_t)n * DMIX + k]); p.O[(size_t)m * D + n] = a; }
}
static void host_moe1(const Params& p, int l) {
    const int* cnt = p.cnt + l * NEXP; const int nrb = moe_blocks(cnt);
    for (int rb = 0; rb < nrb; ++rb) { const int e = moe_block_expert(cnt, rb);
        for (int r = 0; r < 128; ++r) { const int slot = rb * 128 + r; const bf16_t* a = p.H + (size_t)p.slotTok[slot] * D;
            for (int c = 0; c < DE; ++c) { const int q = c >> 4, ii = c & 15; float g = 0.f, u = 0.f;
                const bf16_t* wg = p.wgu_t + ((size_t)e * 2 * DE + 32 * q + ii) * D; const bf16_t* wu = wg + (size_t)16 * D;
                for (int k = 0; k < D; ++k) { g += bf2f(a[k]) * bf2f(wg[k]); u += bf2f(a[k]) * bf2f(wu[k]); }
                p.ACT[(size_t)slot * DE + c] = f2bf(siluf_(g) * u); } } }
}
static void host_moe2(const Params& p, int l) {
    const int* cnt = p.cnt + l * NEXP; const int nrb = moe_blocks(cnt);
    for (int rb = 0; rb < nrb; ++rb) { const int e = moe_block_expert(cnt, rb);
        for (int r = 0; r < 128; ++r) { const int slot = rb * 128 + r;
            for (int n = 0; n < D; ++n) { float a = 0.f; const bf16_t* w = p.wd_t + ((size_t)e * D + n) * DE;
                for (int k = 0; k < DE; ++k) a += bf2f(p.ACT[(size_t)slot * DE + k]) * bf2f(w[k]);
                p.YS[(size_t)slot * D + n] = a; } } }
}
#else
typedef short bf16x8 __attribute__((ext_vector_type(8)));
typedef float f32x4 __attribute__((ext_vector_type(4)));
__device__ __forceinline__ int opq_tid() { int t = threadIdx.x; asm volatile("" : "+v"(t)); return t; }
__device__ __forceinline__ int opq_bid() { int b = blockIdx.x; asm volatile("" : "+s"(b)); return b; }
__device__ __forceinline__ unsigned pk2(float lo, float hi) { return (unsigned)f2bf(lo) | ((unsigned)f2bf(hi) << 16); }
struct u32x2_t { unsigned x, y; };
__device__ __forceinline__ void st_bf16x4(bf16_t* dst, f32x4 v) { u32x2_t o; o.x = pk2(v[0], v[1]); o.y = pk2(v[2], v[3]); *(u32x2_t*)dst = o; }
template <class Epi>
__device__ __forceinline__ void gemm_tile(const bf16_t* a0, const bf16_t* a1, const bf16_t* b0, const bf16_t* b1, int K, char* lds, const Epi& epi) {
    const int tid = opq_tid(), wid = tid >> 6, lane = tid & 63, wr = wid >> 1, wc = wid & 1, fr = lane & 15, fq = lane >> 4;
    char* SA = lds; char* SB = lds + 8192;
    f32x4 acc[4][4];
#pragma unroll
    for (int m = 0; m < 4; ++m)
#pragma unroll
        for (int n = 0; n < 4; ++n) acc[m][n] = (f32x4){0.f, 0.f, 0.f, 0.f};
    for (int kt = 0; kt < K; kt += 32) {
        __builtin_amdgcn_global_load_lds((const unsigned*)(a0 + kt), (__attribute__((address_space(3))) unsigned*)(SA + tid * 16), 16, 0, 0);
        __builtin_amdgcn_global_load_lds((const unsigned*)(a1 + kt), (__attribute__((address_space(3))) unsigned*)(SA + tid * 16 + 4096), 16, 0, 0);
        __builtin_amdgcn_global_load_lds((const unsigned*)(b0 + kt), (__attribute__((address_space(3))) unsigned*)(SB + tid * 16), 16, 0, 0);
        __builtin_amdgcn_global_load_lds((const unsigned*)(b1 + kt), (__attribute__((address_space(3))) unsigned*)(SB + tid * 16 + 4096), 16, 0, 0);
        asm volatile("s_waitcnt vmcnt(0)" ::: "memory");
        __syncthreads();
        bf16x8 At[4], Bt[4];
#pragma unroll
        for (int m = 0; m < 4; ++m) At[m] = *(const bf16x8*)(SA + (wr * 64 + m * 16 + fr) * 64 + fq * 16);
#pragma unroll
        for (int n = 0; n < 4; ++n) Bt[n] = *(const bf16x8*)(SB + (wc * 64 + n * 16 + fr) * 64 + fq * 16);
#pragma unroll
        for (int m = 0; m < 4; ++m)
#pragma unroll
            for (int n = 0; n < 4; ++n) acc[m][n] = __builtin_amdgcn_mfma_f32_16x16x32_bf16(At[m], Bt[n], acc[m][n], 0, 0, 0);
        __syncthreads();
    }
    epi(acc, wr, wc, fr, fq);
}
#define STG_ROW(i) ((tid_ + (i) * 256) >> 2)
#define STG_K ((tid_ & 3) * 8)

__device__ __forceinline__ void g_gemm_in(const Params& p, char* lds) {
    const int tid_ = opq_tid(), bid_ = opq_bid(); (void)tid_; (void)bid_;
    constexpr int NT = NINP / 128, MT = T / 128;
    for (int tile = bid_; tile < NT * MT; tile += gridDim.x) {
        const int tm = tile / NT, tn = tile % NT;
        const bf16_t* a0 = p.H + (size_t)(tm * 128 + STG_ROW(0)) * D + STG_K; const bf16_t* a1 = p.H + (size_t)(tm * 128 + STG_ROW(1)) * D + STG_K;
        const bf16_t* b0 = p.win_t + (size_t)(tn * 128 + STG_ROW(0)) * D + STG_K; const bf16_t* b1 = p.win_t + (size_t)(tn * 128 + STG_ROW(1)) * D + STG_K;
        gemm_tile(a0, a1, b0, b1, D, lds, [&](const f32x4 (&acc)[4][4], int wr, int wc, int fr, int fq) {
#pragma unroll
            for (int m = 0; m < 4; ++m)
#pragma unroll
                for (int n = 0; n < 4; ++n) { const int col = tn * 128 + wc * 64 + n * 16 + fr;
                    if (col < ZP) {
#pragma unroll
                        for (int j = 0; j < 4; ++j) p.Z[(size_t)(tm * 128 + wr * 64 + m * 16 + fq * 4 + j) * ZP + col] = f2bf(acc[m][n][j]); } }
            if (tn == ZVB / 128 || (tn >= ZVN / 128 && tn < ZA / 128)) {
#pragma unroll
                for (int m = 0; m < 4; ++m) { const int m0 = tm * 128 + wr * 64 + m * 16 + fq * 4; int b, u;
                    if (m0 < TL) { b = m0 / S; u = L + m0 % S; } else { b = (m0 - TL) / L; u = (m0 - TL) % L; }
#pragma unroll
                    for (int n = 0; n < 4; ++n) { const int col = tn * 128 + wc * 64 + n * 16 + fr;
                        const int hv = col < ZVN ? (col - ZVB) >> 6 : 2 + ((col - ZVN) >> 6), d = col < ZVN ? (col - ZVB) & 63 : (col - ZVN) & 63;
                        st_bf16x4(p.VT + ((size_t)(b * 8 + hv) * 64 + d) * PU + u, acc[m][n]); } }
            }
        });
    }
}
__device__ __forceinline__ void g_gemm_out(const Params& p, int nrows, char* lds) {
    const int tid_ = opq_tid(), bid_ = opq_bid(); (void)tid_; (void)bid_;
    constexpr int NT = D / 128; const int MT = nrows / 128;
    for (int tile = bid_; tile < NT * MT; tile += gridDim.x) {
        const int tm = tile / NT, tn = tile % NT;
        const bf16_t* a0 = p.MIX + (size_t)(tm * 128 + STG_ROW(0)) * DMIX + STG_K; const bf16_t* a1 = p.MIX + (size_t)(tm * 128 + STG_ROW(1)) * DMIX + STG_K;
        const bf16_t* b0 = p.wout_t + (size_t)(tn * 128 + STG_ROW(0)) * DMIX + STG_K; const bf16_t* b1 = p.wout_t + (size_t)(tn * 128 + STG_ROW(1)) * DMIX + STG_K;
        gemm_tile(a0, a1, b0, b1, DMIX, lds, [&](const f32x4 (&acc)[4][4], int wr, int wc, int fr, int fq) {
#pragma unroll
            for (int m = 0; m < 4; ++m)
#pragma unroll
                for (int n = 0; n < 4; ++n)
#pragma unroll
                    for (int j = 0; j < 4; ++j) p.O[(size_t)(tm * 128 + wr * 64 + m * 16 + fq * 4 + j) * D + tn * 128 + wc * 64 + n * 16 + fr] = acc[m][n][j];
        });
    }
}
__device__ __forceinline__ void g_moe1(const Params& p, int l, char* lds) {
    const int tid_ = opq_tid(), bid_ = opq_bid(); (void)tid_; (void)bid_;
    const int* cnt = p.cnt + l * NEXP; const int nrb = moe_blocks(cnt); constexpr int NT = 2 * DE / 128;
    for (int tile = bid_; tile < nrb * NT; tile += gridDim.x) {
        const int rb = tile / NT, tn = tile % NT, e = moe_block_expert(cnt, rb);
        const bf16_t* a0 = p.H + (size_t)p.slotTok[rb * 128 + STG_ROW(0)] * D + STG_K; const bf16_t* a1 = p.H + (size_t)p.slotTok[rb * 128 + STG_ROW(1)] * D + STG_K;
        const bf16_t* bw = p.wgu_t + (size_t)e * 2 * DE * D;
        const bf16_t* b0 = bw + (size_t)(tn * 128 + STG_ROW(0)) * D + STG_K; const bf16_t* b1 = bw + (size_t)(tn * 128 + STG_ROW(1)) * D + STG_K;
        gemm_tile(a0, a1, b0, b1, D, lds, [&](const f32x4 (&acc)[4][4], int wr, int wc, int fr, int fq) {
#pragma unroll
            for (int m = 0; m < 4; ++m)
#pragma unroll
                for (int n2 = 0; n2 < 2; ++n2) { const int col = tn * 64 + wc * 32 + n2 * 16 + fr;
#pragma unroll
                    for (int j = 0; j < 4; ++j) { const float g = acc[m][2 * n2][j], u = acc[m][2 * n2 + 1][j];
                        p.ACT[(size_t)(rb * 128 + wr * 64 + m * 16 + fq * 4 + j) * DE + col] = f2bf(g / (1.0f + __expf(-g)) * u); } }
        });
    }
}
__device__ __forceinline__ void g_moe2(const Params& p, int l, char* lds) {
    const int tid_ = opq_tid(), bid_ = opq_bid(); (void)tid_; (void)bid_;
    const int* cnt = p.cnt + l * NEXP; const int nrb = moe_blocks(cnt); constexpr int NT = D / 128;
    for (int tile = bid_; tile < nrb * NT; tile += gridDim.x) {
        const int rb = tile / NT, tn = tile % NT, e = moe_block_expert(cnt, rb);
        const bf16_t* a0 = p.ACT + (size_t)(rb * 128 + STG_ROW(0)) * DE + STG_K; const bf16_t* a1 = p.ACT + (size_t)(rb * 128 + STG_ROW(1)) * DE + STG_K;
        const bf16_t* bw = p.wd_t + (size_t)e * D * DE;
        const bf16_t* b0 = bw + (size_t)(tn * 128 + STG_ROW(0)) * DE + STG_K; const bf16_t* b1 = bw + (size_t)(tn * 128 + STG_ROW(1)) * DE + STG_K;
        gemm_tile(a0, a1, b0, b1, DE, lds, [&](const f32x4 (&acc)[4][4], int wr, int wc, int fr, int fq) {
#pragma unroll
            for (int m = 0; m < 4; ++m)
#pragma unroll
                for (int n = 0; n < 4; ++n)
#pragma unroll
                    for (int j = 0; j < 4; ++j) p.YS[(size_t)(rb * 128 + wr * 64 + m * 16 + fq * 4 + j) * D + tn * 128 + wc * 64 + n * 16 + fr] = acc[m][n][j];
        });
    }
}


constexpr int DV = D / 256;
static_assert(D % 256 == 0, "row phases hold a row as DV float4 per lane");
__device__ __forceinline__ float wave_sum(float v) {
#pragma unroll
    for (int o = 1; o < 64; o <<= 1) v += __shfl_xor(v, o);
    return v;
}
__device__ __forceinline__ float sum4(f32x4 a) { return (a[0] + a[1]) + (a[2] + a[3]); }
#define LDS_WAIT() asm volatile("s_waitcnt lgkmcnt(0)" ::: "memory")

__device__ __forceinline__ void row_stats(const f32x4 (&v)[DV], float& mu, float& rstd) {
    float s = 0.f;
#pragma unroll
    for (int j = 0; j < DV; ++j) s += sum4(v[j]);
    mu = wave_sum(s) * (1.0f / D);
    float q = 0.f;
#pragma unroll
    for (int j = 0; j < DV; ++j) { const f32x4 d = v[j] - mu; q += sum4(d * d); }
    rstd = 1.0f / sqrtf(wave_sum(q) * (1.0f / D) + LN_EPS);
}

__device__ __forceinline__ void ph_lnmod_fast(const Params& p, int l) {
    const int tid_ = opq_tid(), bid_ = opq_bid(); (void)tid_; (void)bid_;
    const int lane = tid_ & 63, gw = bid_ * 4 + (tid_ >> 6), nw = gridDim.x * 4;
    for (int m = gw; m < T; m += nw) {
        const f32x4* xr = (const f32x4*)xrow_in(p, l, m) + lane; const f32x4* md = (const f32x4*)modrow(p, l, m) + lane;
        f32x4 v[DV];
#pragma unroll
        for (int j = 0; j < DV; ++j) v[j] = xr[64 * j];
        float mu, rstd; row_stats(v, mu, rstd);
#pragma unroll
        for (int j = 0; j < DV; ++j) { const f32x4 sh = md[64 * j], sc = md[D / 4 + 64 * j];
            st_bf16x4(p.H + (size_t)m * D + 4 * (lane + 64 * j), (v[j] - mu) * rstd * (sc + 1.0f) + sh); }
    }
}

__device__ __forceinline__ void ph_post_mixer_fast(const Params& p, int l, int nrows) {
    const int tid_ = opq_tid(), bid_ = opq_bid(); (void)tid_; (void)bid_;
    const int lane = tid_ & 63, gw = bid_ * 4 + (tid_ >> 6), nw = gridDim.x * 4;
    for (int m = gw; m < nrows; m += nw) {
        const f32x4* xr = (const f32x4*)xrow_in(p, l, m) + lane; const f32x4* md = (const f32x4*)modrow(p, l, m) + lane;
        const f32x4* orow = (const f32x4*)(p.O + (size_t)m * D) + lane;
        f32x4* x1 = (f32x4*)((m < TL) ? p.out + (size_t)m * D : p.XC + (size_t)(m - TL) * D) + lane;
        const f32x4* g1 = (const f32x4*)(p.ln1_g + (size_t)l * D) + lane; const f32x4* b1 = (const f32x4*)(p.ln1_b + (size_t)l * D) + lane;
        f32x4 v[DV];
#pragma unroll
        for (int j = 0; j < DV; ++j) v[j] = xr[64 * j] * ALPHA + md[2 * (D / 4) + 64 * j] * orow[64 * j];
        float mu, rstd; row_stats(v, mu, rstd);
#pragma unroll
        for (int j = 0; j < DV; ++j) { v[j] = (v[j] - mu) * rstd * g1[64 * j] + b1[64 * j]; x1[64 * j] = v[j]; }
        row_stats(v, mu, rstd);
        float gl[4], el[32];
#pragma unroll
        for (int g = 0; g < 4; ++g) gl[g] = 0.f;
#pragma unroll
        for (int e = 0; e < 32; ++e) el[e] = 0.f;
#pragma unroll
        for (int j = 0; j < DV; ++j) {
            const f32x4 hv = (v[j] - mu) * rstd * (md[4 * (D / 4) + 64 * j] + 1.0f) + md[3 * (D / 4) + 64 * j];
            st_bf16x4(p.H + (size_t)m * D + 4 * (lane + 64 * j), hv);
#pragma unroll
            for (int i = 0; i < 4; ++i) {
                const int k = 4 * (lane + 64 * j) + i;
                const f32x4 wg = *(const f32x4*)(p.w_rg + ((size_t)l * D + k) * 4);
#pragma unroll
                for (int g = 0; g < 4; ++g) gl[g] += hv[i] * wg[g];
                const f32x4* we = (const f32x4*)(p.w_re + ((size_t)l * D + k) * 32);
#pragma unroll
                for (int e4 = 0; e4 < 8; ++e4) { const f32x4 w = we[e4];
#pragma unroll
                    for (int g = 0; g < 4; ++g) el[4 * e4 + g] += hv[i] * w[g]; }
            }
        }
#pragma unroll
        for (int g = 0; g < 4; ++g) gl[g] = wave_sum(gl[g]) + p.b_rg[l * 4 + g];
#pragma unroll
        for (int e = 0; e < 32; ++e) el[e] = wave_sum(el[e]) + p.b_re[l * 32 + e];
        int gs = 0; float gm = gl[0];
#pragma unroll
        for (int g = 1; g < 4; ++g) if (gl[g] > gm) { gm = gl[g]; gs = g; }
        float den = 0.f;
#pragma unroll
        for (int g = 0; g < 4; ++g) den += expf(gl[g] - gm);
        const float pg = 1.0f / den;
        float v1 = -3e38f, v2 = -3e38f; int i1 = 0, i2 = 0;
#pragma unroll
        for (int j = 0; j < 8; ++j) {
            const float vv = gs == 0 ? el[j] : gs == 1 ? el[8 + j] : gs == 2 ? el[16 + j] : el[24 + j];
            if (vv > v1) { v2 = v1; i2 = i1; v1 = vv; i1 = j; } else if (vv > v2) { v2 = vv; i2 = j; }
        }
        if (lane == 0) {
            const float e2 = expf(v2 - v1), w1 = pg / (1.0f + e2), w2 = pg * e2 / (1.0f + e2);
            const int ea = gs * 8 + i1, eb = gs * 8 + i2;
            p.rE[2 * m] = ea; p.rE[2 * m + 1] = eb; p.rW[2 * m] = w1; p.rW[2 * m + 1] = w2;
            p.rPos[2 * m] = atomicAdd(p.cnt + l * NEXP + ea, 1); p.rPos[2 * m + 1] = atomicAdd(p.cnt + l * NEXP + eb, 1);
        }
    }
}

__device__ __forceinline__ void ph_final_fast(const Params& p, int l, int nrows) {
    const int tid_ = opq_tid(), bid_ = opq_bid(); (void)tid_; (void)bid_;
    const int lane = tid_ & 63, gw = bid_ * 4 + (tid_ >> 6), nw = gridDim.x * 4;
    for (int m = gw; m < nrows; m += nw) {
        f32x4* x1 = (f32x4*)((m < TL) ? p.out + (size_t)m * D : p.XC + (size_t)(m - TL) * D) + lane;
        const f32x4* md = (const f32x4*)modrow(p, l, m) + lane;
        const f32x4* ya = (const f32x4*)(p.YS + (size_t)p.rSlot[2 * m] * D) + lane; const f32x4* yb = (const f32x4*)(p.YS + (size_t)p.rSlot[2 * m + 1] * D) + lane;
        const float wa = p.rW[2 * m], wb = p.rW[2 * m + 1];
        const f32x4* g2 = (const f32x4*)(p.ln2_g + (size_t)l * D) + lane; const f32x4* b2 = (const f32x4*)(p.ln2_b + (size_t)l * D) + lane;
        f32x4 v[DV];
#pragma unroll
        for (int j = 0; j < DV; ++j) v[j] = x1[64 * j] * ALPHA + md[5 * (D / 4) + 64 * j] * (ya[64 * j] * wa + yb[64 * j] * wb);
        float mu, rstd; row_stats(v, mu, rstd);
#pragma unroll
        for (int j = 0; j < DV; ++j) x1[64 * j] = (v[j] - mu) * rstd * g2[64 * j] + b2[64 * j];
    }
}

__device__ __forceinline__ void tr_item(const float* srcl, size_t ldw, bf16_t* dst, size_t ldd, float* scr, int lane) {
#pragma unroll 8
    for (int i = 0; i < 32; ++i) { const int kk = 2 * i + (lane >> 5); scr[kk * 33 + (lane & 31)] = srcl ? srcl[(size_t)kk * ldw] : 0.f; }
    LDS_WAIT();
    const int c = lane & 7;
#pragma unroll
    for (int j = 0; j < 4; ++j) { const int n = (lane >> 3) + 8 * j; const float* s = scr + (8 * c) * 33 + n;
        uint4 o; o.x = pk2(s[0], s[33]); o.y = pk2(s[2 * 33], s[3 * 33]); o.z = pk2(s[4 * 33], s[5 * 33]); o.w = pk2(s[6 * 33], s[7 * 33]);
        *(uint4*)(dst + (size_t)n * ldd + 8 * c) = o; }
    LDS_WAIT();
}
__device__ __forceinline__ void ph_prep_w_fast(const Params& p, int l, int part, char* lds) {
    const int tid_ = opq_tid(), bid_ = opq_bid(); (void)tid_; (void)bid_;
    const int lane = tid_ & 63, wid = tid_ >> 6, gw = bid_ * 4 + wid, nw = gridDim.x * 4;
    float* scr = (float*)(lds + wid * 8448);
    constexpr int I_IN = (D / 64) * (NINP / 32), I_OUT = (DMIX / 64) * (D / 32), I_GU1 = (D / 64) * (2 * DE / 32), I_D1 = (DE / 64) * (D / 32);
    constexpr int NITEMS = I_IN + I_OUT + NEXP * (I_GU1 + I_D1);
    const int it0 = part == 0 ? 0 : I_IN + I_OUT, it1 = part == 0 ? I_IN + I_OUT : NITEMS;
    for (int it = it0 + gw; it < it1; it += nw) {
        int r = it;
        if (r < I_IN) { const int kb = r / (NINP / 32), n0 = 32 * (r % (NINP / 32));
            const float* s = nullptr;
            if (n0 < N_IN) { const int oc = (n0 < ZA) ? n0 + A_IN : n0 - ZA; s = p.w_in + ((size_t)l * D + 64 * kb) * N_IN + oc + (lane & 31); }
            tr_item(s, N_IN, p.win_t + (size_t)n0 * D + 64 * kb, D, scr, lane); continue; }
        r -= I_IN;
        if (r < I_OUT) { const int kb = r / (D / 32), n0 = 32 * (r % (D / 32));
            tr_item(p.w_out + ((size_t)l * DMIX + 64 * kb) * D + n0 + (lane & 31), D, p.wout_t + (size_t)n0 * DMIX + 64 * kb, DMIX, scr, lane); continue; }
        r -= I_OUT;
        const int e = r / (I_GU1 + I_D1); r %= (I_GU1 + I_D1);
        if (r < I_GU1) { const int kb = r / (2 * DE / 32), q = r % (2 * DE / 32);
            const float* s = (((lane & 31) >> 4) ? p.w_up : p.w_gate) + (((size_t)l * NEXP + e) * D + 64 * kb) * DE + 16 * q + (lane & 15);
            tr_item(s, DE, p.wgu_t + ((size_t)e * 2 * DE + 32 * q) * D + 64 * kb, D, scr, lane); continue; }
        r -= I_GU1;
        { const int kb = r / (D / 32), n0 = 32 * (r % (D / 32));
            tr_item(p.w_down + (((size_t)l * NEXP + e) * DE + 64 * kb) * D + n0 + (lane & 31), D, p.wd_t + ((size_t)e * D + n0) * DE + 64 * kb, DE, scr, lane); }
    }
    if (part != 0) return;
    const long gt = (long)bid_ * blockDim.x + tid_, gs = (long)gridDim.x * blockDim.x;
    for (long i = gt; i < 2 * 256 * 64; i += gs) { const int k = (int)(i & 63), n = (int)((i >> 6) & 255), d = (int)(i >> 14);
        p.wupT[i] = f2bf(p.a_w_up[(((size_t)l * 2 + d) * 64 + k) * DA + n]); p.aupT[i] = f2bf(p.a_a_up[(((size_t)l * 2 + d) * 64 + k) * DA + n]); }
    for (long i = gt; i < 256 * 160; i += gs) { const int k = (int)(i % 160), n = (int)(i / 160); p.gupT[i] = f2bf(p.a_g_up[((size_t)l * 160 + k) * DA + n]); }
}

__device__ __forceinline__ void ph_streams_s1(const Params& p, int l) {
    const int tid_ = opq_tid(), bid_ = opq_bid(); (void)tid_; (void)bid_;
    const int lane = tid_ & 63, gw = bid_ * 4 + (tid_ >> 6), nw = gridDim.x * 4;
    const float* sh = p.a_shift + (size_t)l * 3 * A_IN;
    for (int m = gw; m < T; m += nw) {
        int t, len;
        if (m < TL) { t = m % S; len = S; } else { t = (m - TL) % L; len = L; }
        const bool hp = t > 0, hn = t < len - 1;
        const bf16_t* z = p.Z + (size_t)m * ZP + ZA;
#pragma unroll 1
        for (int i = 0; i < (A_IN + 63) / 64; ++i) {
            const int c = 64 * i + lane; float v = 0.f;
            if (c < A_IN) {
                v = sh[A_IN + c] * bf2f(z[c]);
                if (hp) v += sh[c] * bf2f(z[c - ZP]);
                if (hn) v += sh[2 * A_IN + c] * bf2f(z[c + ZP]);
                if (c < 256) p.sR[(size_t)m * DA + c] = v;
                else if (c < 512) p.kT[(size_t)m * DA + c - 256] = v;
                else if (c < 768) p.sV[(size_t)m * DA + c - 512] = v;
                else if (c < 896) p.LA[(size_t)m * 416 + c - 768] = f2bf(tanhf(v));
                else if (c < 1024) p.LA[(size_t)m * 416 + c - 768] = f2bf(v);
                else p.LA[(size_t)m * 416 + c - 768] = f2bf(sigmoidf_(v));
            }
            if (i >= 4 && i < 8) {
                const float t2 = v * p.a_k_k[l * DA + c - 256]; const float nrm = wave_sum(t2 * t2);
                if (lane == 0) p.kN[(size_t)m * 4 + i - 4] = 1.0f / sqrtf(nrm + 1e-12f);
            }
        }
    }
}
__device__ __forceinline__ void g_streams_s2(const Params& p, int l, char* lds) {
    const int tid_ = opq_tid(), bid_ = opq_bid(); (void)tid_; (void)bid_;
    constexpr int MT = T / 128;
    for (int job = bid_; job < 5 * MT * 2; job += gridDim.x) {
        const int type = job / (MT * 2), r = job % (MT * 2), tm = r >> 1, tn = r & 1;
        const int coff = type < 2 ? type * 64 : type < 4 ? 128 + (type - 2) * 64 : 256, K = type < 4 ? 64 : 160, d = type & 1;
        const bf16_t* Bt = type < 2 ? p.wupT + type * 256 * 64 : type < 4 ? p.aupT + (type - 2) * 256 * 64 : p.gupT;
        const bf16_t* a0 = p.LA + (size_t)(tm * 128 + STG_ROW(0)) * 416 + coff + STG_K; const bf16_t* a1 = p.LA + (size_t)(tm * 128 + STG_ROW(1)) * 416 + coff + STG_K;
        const bf16_t* b0 = Bt + (size_t)(tn * 128 + STG_ROW(0)) * K + STG_K; const bf16_t* b1 = Bt + (size_t)(tn * 128 + STG_ROW(1)) * K + STG_K;
        if (type < 2) gemm_tile(a0, a1, b0, b1, K, lds, [&](const f32x4 (&acc)[4][4], int wr, int wc, int fr, int fq) {
#pragma unroll
            for (int mi = 0; mi < 4; ++mi) {
#pragma unroll
                for (int n = 0; n < 4; ++n) { const int c = tn * 128 + wc * 64 + n * 16 + fr; const float w0 = p.a_w0[(l * 2 + d) * DA + c];
#pragma unroll
                    for (int j = 0; j < 4; ++j) { const int row = tm * 128 + wr * 64 + mi * 16 + fq * 4 + j;
                        const float e = __expf(-(w0 + acc[mi][n][j]));
                        p.sW[((size_t)d * T + row) * DA + c] = __expf(-0.60653065971f / (1.0f + e)); } }
                asm volatile("" ::: "memory"); }
        });
        else if (type < 4) gemm_tile(a0, a1, b0, b1, K, lds, [&](const f32x4 (&acc)[4][4], int wr, int wc, int fr, int fq) {
#pragma unroll
            for (int mi = 0; mi < 4; ++mi) {
#pragma unroll
                for (int n = 0; n < 4; ++n) { const int c = tn * 128 + wc * 64 + n * 16 + fr;
                    const float a0v = p.a_a0[(l * 2 + d) * DA + c], kkc = p.a_k_k[l * DA + c], kac = p.a_k_a[l * DA + c];
#pragma unroll
                    for (int j = 0; j < 4; ++j) { const int row = tm * 128 + wr * 64 + mi * 16 + fq * 4 + j;
                        const size_t o = (size_t)row * DA + c, od = ((size_t)d * T + row) * DA + c;
                        const float av = 1.0f / (1.0f + __expf(-(a0v + acc[mi][n][j]))); const float k = p.kT[o];
                        const float kk = k * kkc * p.kN[(size_t)row * 4 + (c >> 6)];
                        p.sKD[od] = k * (1.0f + (av - 1.0f) * kac); p.sB[od] = kk * av; if (d == 0) p.sKK[o] = kk; } }
                asm volatile("" ::: "memory"); }
        });
        else gemm_tile(a0, a1, b0, b1, K, lds, [&](const f32x4 (&acc)[4][4], int wr, int wc, int fr, int fq) {
#pragma unroll
            for (int mi = 0; mi < 4; ++mi)
#pragma unroll
                for (int n = 0; n < 4; ++n) { const int c = tn * 128 + wc * 64 + n * 16 + fr;
#pragma unroll
                    for (int j = 0; j < 4; ++j) p.sG[(size_t)(tm * 128 + wr * 64 + mi * 16 + fq * 4 + j) * DA + c] = acc[mi][n][j]; }
        });
    }
}


typedef float f32x16 __attribute__((ext_vector_type(16)));
typedef short s16x4 __attribute__((ext_vector_type(4)));
typedef unsigned u32x4_t __attribute__((ext_vector_type(4)));
typedef float f32x2_t __attribute__((ext_vector_type(2)));
typedef __bf16 bf16x2_t __attribute__((ext_vector_type(2)));
__device__ __forceinline__ unsigned cvtpk(float lo, float hi) { f32x2_t v = {lo, hi}; bf16x2_t b = __builtin_convertvector(v, bf16x2_t); return __builtin_bit_cast(unsigned, b); }
__device__ __forceinline__ int crow(int r, int hi) { return (r & 3) + 8 * (r >> 2) + 4 * hi; }

template <class MaskF>
__device__ __forceinline__ void attn_tile(const bf16x8 (&qf)[4], const bf16_t* krow, const bf16_t* vt0, const bf16_t* vt1, const MaskF& mask,
                                          float& m_run, float& l_run, f32x16& o0, f32x16& o1, int hi) {
    f32x16 s;
#pragma unroll
    for (int r = 0; r < 16; ++r) s[r] = 0.f;
#pragma unroll
    for (int ks = 0; ks < 4; ++ks) { const bf16x8 kf = *(const bf16x8*)(krow + 16 * ks); s = __builtin_amdgcn_mfma_f32_32x32x16_bf16(kf, qf[ks], s, 0, 0, 0); }
    float mx = -INFINITY;
#pragma unroll
    for (int r = 0; r < 16; ++r) { s[r] = mask(crow(r, hi), s[r] * ATT_SCALE); mx = fmaxf(mx, s[r]); }
    mx = fmaxf(mx, __shfl_xor(mx, 32));
    const float mn = fmaxf(m_run, mx), alpha = __expf(m_run - mn);
    m_run = mn;
    float ps = 0.f;
#pragma unroll
    for (int r = 0; r < 16; ++r) { s[r] = __expf(s[r] - mn); ps += s[r]; }
    l_run = l_run * alpha + ps;
#pragma unroll
    for (int r = 0; r < 16; ++r) { o0[r] *= alpha; o1[r] *= alpha; }
#pragma unroll
    for (int s2 = 0; s2 < 2; ++s2) {
        u32x4_t pw; pw[0] = cvtpk(s[8 * s2], s[8 * s2 + 1]); pw[1] = cvtpk(s[8 * s2 + 2], s[8 * s2 + 3]); pw[2] = cvtpk(s[8 * s2 + 4], s[8 * s2 + 5]); pw[3] = cvtpk(s[8 * s2 + 6], s[8 * s2 + 7]);
        const bf16x8 pb = __builtin_bit_cast(bf16x8, pw);
        const s16x4 a0 = *(const s16x4*)(vt0 + 16 * s2), a1 = *(const s16x4*)(vt0 + 16 * s2 + 8);
        const s16x4 c0 = *(const s16x4*)(vt1 + 16 * s2), c1 = *(const s16x4*)(vt1 + 16 * s2 + 8);
        o0 = __builtin_amdgcn_mfma_f32_32x32x16_bf16(__builtin_shufflevector(a0, a1, 0, 1, 2, 3, 4, 5, 6, 7), pb, o0, 0, 0, 0);
        o1 = __builtin_amdgcn_mfma_f32_32x32x16_bf16(__builtin_shufflevector(c0, c1, 0, 1, 2, 3, 4, 5, 6, 7), pb, o1, 0, 0, 0);
    }
}
struct NoMask { __device__ __forceinline__ float operator()(int, float v) const { return v; } };

__device__ __forceinline__ void ph_attn_mfma(const Params& p, int l, bool with_ctx) {
    const int tid_ = opq_tid(), bid_ = opq_bid(); (void)tid_; (void)bid_;
    const int lane = tid_ & 63, hi = lane >> 5, ql = lane & 31;
    const int gw = bid_ * 4 + (tid_ >> 6), nw = gridDim.x * 4;
    constexpr int NQT = S / 32, NCT = L / 32, N_LAT = NB * 6 * NQT, N_CTX = NB * 6 * NCT;
    const int ntask = 2 * N_LAT + (with_ctx ? 2 * N_CTX : 0);
    for (int task = gw; task < ntask; task += nw) {
        bool isC, isCtx; int r;
        if (task < N_LAT) { isC = true; isCtx = false; r = task; }
        else if (task < 2 * N_LAT) { isC = false; isCtx = false; r = task - N_LAT; }
        else { r = task - 2 * N_LAT; isCtx = true; isC = r >= N_CTX; if (isC) r -= N_CTX; }
        const int nqt = isCtx ? NCT : NQT, qt = r % nqt, h = (r / nqt) % 6, b = r / (nqt * 6);
        const int m = isCtx ? TL + b * L + 32 * qt + ql : b * S + 32 * qt + ql;
        const int qcol = isC ? ZQN + h * 64 : ZQB + h * 64, kcol = isC ? ZKN + h * 64 : ZKB + (h / 3) * 64, hv = isC ? 2 + h : h / 3;
        bf16x8 qf[4];
        { const bf16_t* qp = p.Z + (size_t)m * ZP + qcol + 8 * hi;
#pragma unroll
          for (int ks = 0; ks < 4; ++ks) qf[ks] = *(const bf16x8*)(qp + 16 * ks); }
        const bf16_t* kc0 = p.Z + (size_t)(TL + b * L + ql) * ZP + kcol + 8 * hi;
        const bf16_t* kl0 = p.Z + (size_t)(b * S + ql) * ZP + kcol + 8 * hi;
        const bf16_t* vt0 = p.VT + ((size_t)(b * 8 + hv) * 64 + ql) * PU + 4 * hi; const bf16_t* vt1 = vt0 + (size_t)32 * PU;
        f32x16 o0, o1;
#pragma unroll
        for (int rr = 0; rr < 16; ++rr) { o0[rr] = 0.f; o1[rr] = 0.f; }
        float m_run, l_run;
        if (isC) { m_run = -1e30f; l_run = 0.f; } else { m_run = p.b_sink[l * 6 + h]; l_run = hi == 0 ? 1.0f : 0.f; }
#pragma unroll 1
        for (int i = 0; i < NCT; ++i) attn_tile(qf, kc0 + (size_t)(32 * i) * ZP, vt0 + 32 * i, vt1 + 32 * i, NoMask(), m_run, l_run, o0, o1, hi);
        if (!isCtx) {
            if (!isC) {
#pragma unroll 1
                for (int jt = qt - 4; jt <= qt + 4; ++jt) {
                    if (jt < 0 || jt >= NQT) continue;
                    const bf16_t* kr = kl0 + (size_t)(32 * jt) * ZP; const bf16_t* v0 = vt0 + L + 32 * jt; const bf16_t* v1 = vt1 + L + 32 * jt;
                    if (jt == qt - 4 || jt == qt + 4) { const int base = 32 * (jt - qt) - ql;
                        attn_tile(qf, kr, v0, v1, [&](int ko, float v) { const int rel = base + ko; return (rel >= -128 && rel <= 128) ? v : -INFINITY; }, m_run, l_run, o0, o1, hi); }
                    else attn_tile(qf, kr, v0, v1, NoMask(), m_run, l_run, o0, o1, hi);
                }
            } else {
                constexpr int ROWS = S / GRID_W;
                const int gr = qt >> 1, c = 32 * (qt & 1) + ql;
                int r0 = gr - 4; r0 = r0 < 0 ? 0 : (r0 > ROWS - 8 ? ROWS - 8 : r0);
                int c0 = c - 8; c0 = c0 < 0 ? 0 : (c0 > GRID_W - 16 ? GRID_W - 16 : c0);
                const float* rpb = p.c_rpb + ((size_t)l * 6 + h) * 15 * 31;
#pragma unroll 1
                for (int a = 0; a < 8; ++a) {
                    const int kr_ = r0 + a; const float* rp = rpb + (kr_ - gr + 7) * 31 + 15 - c;
#pragma unroll 1
                    for (int ct = 0; ct < 2; ++ct) {
                        const int t0 = kr_ * GRID_W + 32 * ct;
                        attn_tile(qf, kl0 + (size_t)t0 * ZP, vt0 + L + t0, vt1 + L + t0,
                                  [&](int ko, float v) { const int kc = 32 * ct + ko; return (kc >= c0 && kc < c0 + 16) ? v + rp[kc] : -INFINITY; }, m_run, l_run, o0, o1, hi);
                    }
                }
            }
        }
        const float lt = l_run + __shfl_xor(l_run, 32), inv = 1.0f / lt;
        bf16_t* op = p.MIX + (size_t)m * DMIX + (isC ? 640 : 256) + h * 64 + 4 * hi;
#pragma unroll
        for (int g = 0; g < 4; ++g) {
            st_bf16x4(op + 8 * g, (f32x4){o0[4 * g] * inv, o0[4 * g + 1] * inv, o0[4 * g + 2] * inv, o0[4 * g + 3] * inv});
            st_bf16x4(op + 32 + 8 * g, (f32x4){o1[4 * g] * inv, o1[4 * g + 1] * inv, o1[4 * g + 2] * inv, o1[4 * g + 3] * inv});
        }
    }
}


#define RNB " row_newbcast:%c[n] row_mask:0xf bank_mask:0xf\n\t"
template <int N, bool FIRST>
__device__ __forceinline__ void dpp_dot4(float& a0, float& a1, float& a2, float& a3, const f32x4& v, float s0, float s1, float s2, float s3) {
    if (FIRST) asm volatile("s_nop 1");
    asm("v_fmac_f32_dpp %0, %4, %8" RNB "v_fmac_f32_dpp %1, %5, %9" RNB "v_fmac_f32_dpp %2, %6, %10" RNB "v_fmac_f32_dpp %3, %7, %11" RNB
        : "+v"(a0), "+v"(a1), "+v"(a2), "+v"(a3) : "v"(v[0]), "v"(v[1]), "v"(v[2]), "v"(v[3]), "v"(s0), "v"(s1), "v"(s2), "v"(s3), [n] "i"(N));
}
template <int N, bool FIRST>
__device__ __forceinline__ void dpp_upd4s(float& s0, float& s1, float& s2, float& s3, float& y0, float& y1, float& y2, float& y3,
                                          const f32x4& w, const f32x4& b, const f32x4& kd, const f32x4& r, float nsk, float vv) {
    if (FIRST) asm volatile("s_nop 1");
    asm("v_mul_f32_dpp %0, %8, %0" RNB "v_mul_f32_dpp %1, %9, %1" RNB "v_mul_f32_dpp %2, %10, %2" RNB "v_mul_f32_dpp %3, %11, %3" RNB
        "v_fmac_f32_dpp %0, %12, %24" RNB "v_fmac_f32_dpp %1, %13, %24" RNB "v_fmac_f32_dpp %2, %14, %24" RNB "v_fmac_f32_dpp %3, %15, %24" RNB
        "v_fmac_f32_dpp %0, %16, %25" RNB "v_fmac_f32_dpp %1, %17, %25" RNB "v_fmac_f32_dpp %2, %18, %25" RNB "v_fmac_f32_dpp %3, %19, %25" RNB
        "v_fmac_f32_dpp %4, %20, %0" RNB "v_fmac_f32_dpp %5, %21, %1" RNB "v_fmac_f32_dpp %6, %22, %2" RNB "v_fmac_f32_dpp %7, %23, %3" RNB
        : "+v"(s0), "+v"(s1), "+v"(s2), "+v"(s3), "+v"(y0), "+v"(y1), "+v"(y2), "+v"(y3)
        : "v"(w[0]), "v"(w[1]), "v"(w[2]), "v"(w[3]), "v"(b[0]), "v"(b[1]), "v"(b[2]), "v"(b[3]), "v"(kd[0]), "v"(kd[1]), "v"(kd[2]), "v"(kd[3]),
          "v"(r[0]), "v"(r[1]), "v"(r[2]), "v"(r[3]), "v"(nsk), "v"(vv), [n] "i"(N));
}
template <int N, bool FIRST>
__device__ __forceinline__ void dpp_upd4p(float& s0, float& s1, float& s2, float& s3, float& y0, float& y1, float& y2, float& y3,
                                          const f32x4& w, const f32x4& b, const f32x4& r, float nsk) {
    if (FIRST) asm volatile("s_nop 1");
    asm("v_mul_f32_dpp %0, %8, %0" RNB "v_mul_f32_dpp %1, %9, %1" RNB "v_mul_f32_dpp %2, %10, %2" RNB "v_mul_f32_dpp %3, %11, %3" RNB
        "v_fmac_f32_dpp %0, %12, %20" RNB "v_fmac_f32_dpp %1, %13, %20" RNB "v_fmac_f32_dpp %2, %14, %20" RNB "v_fmac_f32_dpp %3, %15, %20" RNB
        "v_fmac_f32_dpp %4, %16, %0" RNB "v_fmac_f32_dpp %5, %17, %1" RNB "v_fmac_f32_dpp %6, %18, %2" RNB "v_fmac_f32_dpp %7, %19, %3" RNB
        : "+v"(s0), "+v"(s1), "+v"(s2), "+v"(s3), "+v"(y0), "+v"(y1), "+v"(y2), "+v"(y3)
        : "v"(w[0]), "v"(w[1]), "v"(w[2]), "v"(w[3]), "v"(b[0]), "v"(b[1]), "v"(b[2]), "v"(b[3]), "v"(r[0]), "v"(r[1]), "v"(r[2]), "v"(r[3]), "v"(nsk), [n] "i"(N));
}
template <int N> struct ScanRep {
    static __device__ __forceinline__ void dot(float& a0, float& a1, float& a2, float& a3, const f32x4& v, const float (&st)[64]) {
        dpp_dot4<N, N == 0>(a0, a1, a2, a3, v, st[4 * N], st[4 * N + 1], st[4 * N + 2], st[4 * N + 3]);
        if constexpr (N < 15) ScanRep<N + 1>::dot(a0, a1, a2, a3, v, st);
    }
    static __device__ __forceinline__ void upds(float (&st)[64], float& y0, float& y1, float& y2, float& y3, const f32x4& w, const f32x4& b, const f32x4& kd, const f32x4& r, float nsk, float vv) {
        dpp_upd4s<N, N == 0>(st[4 * N], st[4 * N + 1], st[4 * N + 2], st[4 * N + 3], y0, y1, y2, y3, w, b, kd, r, nsk, vv);
        if constexpr (N < 15) ScanRep<N + 1>::upds(st, y0, y1, y2, y3, w, b, kd, r, nsk, vv);
    }
    static __device__ __forceinline__ void updp(float (&st)[64], float& y0, float& y1, float& y2, float& y3, const f32x4& w, const f32x4& b, const f32x4& r, float nsk) {
        dpp_upd4p<N, N == 0>(st[4 * N], st[4 * N + 1], st[4 * N + 2], st[4 * N + 3], y0, y1, y2, y3, w, b, r, nsk);
        if constexpr (N < 15) ScanRep<N + 1>::updp(st, y0, y1, y2, y3, w, b, r, nsk);
    }
};
__device__ __forceinline__ int seg_row0(int b, int d, int s) { const int pos0 = 128 * s; return pos0 < L ? TL + b * L + (d ? L - 1 - pos0 : pos0) : b * S + (d ? S - 1 - (pos0 - L) : pos0 - L); }

template <bool ISP>
__device__ __forceinline__ void scan_task(const Params& p, int c, int s, int lane) {
    const int h = c & 3, b = (c >> 2) % NB, d = (c >> 2) / NB;
    const int m0 = seg_row0(b, d, s); const long step = d ? -(long)DA : (long)DA;
    const size_t o = (size_t)m0 * DA + h * 64, od = ((size_t)d * T + m0) * DA + h * 64; const int q = 4 * (lane & 15);
    const float* pkk = p.sKK + o + q; const float* pr = p.sR + o + q; const float* pw = p.sW + od + q; const float* pb = p.sB + od + q;
    const float* pkd = p.sKD + od + q; const float* pv = p.sV + o + lane;
    float* py = (ISP ? p.PV : p.Y) + od + lane;
    float st[64];
#pragma unroll
    for (int k = 0; k < 64; ++k) st[k] = (ISP && k == lane) ? 1.0f : 0.f;
    f32x4 kk = *(const f32x4*)pkk, w = *(const f32x4*)pw, bb = *(const f32x4*)pb, r = *(const f32x4*)pr, kd = w; float vv = 0.f;
    if (!ISP) { kd = *(const f32x4*)pkd; vv = *pv; }
#pragma unroll 1
    for (int i = 0; i < 128; ++i) {
        const long nx = (i < 127) ? step : 0;
        pkk += nx; pw += nx; pb += nx; pr += nx; pkd += nx; pv += nx;
        const f32x4 nkk = *(const f32x4*)pkk, nw = *(const f32x4*)pw, nb = *(const f32x4*)pb, nr = *(const f32x4*)pr;
        f32x4 nkd = nw; float nv = 0.f;
        if (!ISP) { nkd = *(const f32x4*)pkd; nv = *pv; }
        float a0 = 0.f, a1 = 0.f, a2 = 0.f, a3 = 0.f;
        ScanRep<0>::dot(a0, a1, a2, a3, kk, st);
        const float nsk = -((a0 + a1) + (a2 + a3));
        float y0 = 0.f, y1 = 0.f, y2 = 0.f, y3 = 0.f;
        if (ISP) ScanRep<0>::updp(st, y0, y1, y2, y3, w, bb, r, nsk); else ScanRep<0>::upds(st, y0, y1, y2, y3, w, bb, kd, r, nsk, vv);
        *py = (y0 + y1) + (y2 + y3); py += step;
        kk = nkk; w = nw; bb = nb; r = nr; kd = nkd; vv = nv;
    }
    if (s < NSG - 1) {
        float* dst = (ISP ? p.PS : p.QS) + (((size_t)c * NSG + s) * 64 + lane) * 64;
#pragma unroll
        for (int k4 = 0; k4 < 16; ++k4) *(f32x4*)(dst + 4 * k4) = (f32x4){st[4 * k4], st[4 * k4 + 1], st[4 * k4 + 2], st[4 * k4 + 3]};
    }
}
__device__ __forceinline__ void ph_scan_fast(const Params& p) {
    const int tid_ = opq_tid(), bid_ = opq_bid(); (void)tid_; (void)bid_;
    const int lane = tid_ & 63, gw = bid_ * 4 + (tid_ >> 6), nw = gridDim.x * 4;
    constexpr int NS_T = 64 * NSG, NP_T = 64 * (NSG - 1);
    for (int tsk = gw; tsk < NS_T + NP_T; tsk += nw) {
        const int t2 = __builtin_amdgcn_readfirstlane(tsk);
        if (t2 < NS_T) scan_task<false>(p, t2 & 63, t2 >> 6, lane);
        else scan_task<true>(p, (t2 - NS_T) & 63, 1 + ((t2 - NS_T) >> 6), lane);
    }
}
__device__ __forceinline__ void ph_combine(const Params& p, char* lds) {
    const int tid_ = opq_tid(), bid_ = opq_bid(); (void)tid_; (void)bid_;
    if (bid_ >= 64) return;
    const int c = bid_, tid = tid_, v = tid >> 2, jq = tid & 3;
    float* SSc = (float*)lds; float* Pm = (float*)(lds + 64 * 65 * 4 + 16);
    const float* QSc = p.QS + (size_t)c * NSG * 4096; const float* PSc = p.PS + (size_t)c * NSG * 4096; float* SSg = p.SS + (size_t)c * NSG * 4096;
    f32x4 acc[4];
#pragma unroll
    for (int i = 0; i < 4; ++i) { acc[i] = *(const f32x4*)(QSc + v * 64 + 16 * jq + 4 * i); *(f32x4*)(SSg + 4096 + v * 64 + 16 * jq + 4 * i) = acc[i];
#pragma unroll
        for (int e = 0; e < 4; ++e) SSc[v * 65 + 16 * jq + 4 * i + e] = acc[i][e]; }
    for (int s = 1; s < NSG - 1; ++s) {
#pragma unroll
        for (int qq = 0; qq < 4; ++qq) ((f32x4*)Pm)[tid + 256 * qq] = ((const f32x4*)(PSc + (size_t)s * 4096))[tid + 256 * qq];
#pragma unroll
        for (int i = 0; i < 4; ++i) acc[i] = *(const f32x4*)(QSc + (size_t)s * 4096 + v * 64 + 16 * jq + 4 * i);
        __syncthreads();
#pragma unroll 8
        for (int k = 0; k < 64; ++k) { const float a = SSc[v * 65 + k];
#pragma unroll
            for (int i = 0; i < 4; ++i) acc[i] += ((const f32x4*)Pm)[k * 16 + 4 * jq + i] * a; }
        __syncthreads();
#pragma unroll
        for (int i = 0; i < 4; ++i) { *(f32x4*)(SSg + (size_t)(s + 1) * 4096 + v * 64 + 16 * jq + 4 * i) = acc[i];
#pragma unroll
            for (int e = 0; e < 4; ++e) SSc[v * 65 + 16 * jq + 4 * i + e] = acc[i][e]; }
        __syncthreads();
    }
}
__device__ __forceinline__ void ph_rwkv_out_fast(const Params& p, int l, bool with_ctx) {
    const int tid_ = opq_tid(), bid_ = opq_bid(); (void)tid_; (void)bid_;
    const int lane = tid_ & 63, gw = bid_ * 4 + (tid_ >> 6), nw = gridDim.x * 4;
    constexpr int NLT = NB * (S / 32) * 4, NCTK = NB * (L / 32) * 4;
    const int ntask = NLT + (with_ctx ? NCTK : 0);
    for (int tsk = gw; tsk < ntask; tsk += nw) {
        const bool isCtx = tsk >= NLT; const int r = isCtx ? tsk - NLT : tsk;
        const int h = r & 3, npt = isCtx ? L / 32 : S / 32, tt = (r >> 2) % npt, b = (r >> 2) / npt;
        const int seg0 = isCtx ? (tt >> 2) : 2 + (tt >> 2), seg1 = isCtx ? (L / 128 - 1) - (tt >> 2) : 2 + (S / 128 - 1) - (tt >> 2);
        const int mbase = isCtx ? TL + b * L + 32 * tt : b * S + 32 * tt;
        float ss0[64], ss1[64];
        { const float* s0p = p.SS + ((((size_t)(0 * NB + b) * 4 + h) * NSG + seg0) * 64 + lane) * 64; const float* s1p = p.SS + ((((size_t)(1 * NB + b) * 4 + h) * NSG + seg1) * 64 + lane) * 64;
#pragma unroll
          for (int k4 = 0; k4 < 16; ++k4) { f32x4 a = {0.f, 0.f, 0.f, 0.f}, c2 = a; if (seg0 > 0) a = *(const f32x4*)(s0p + 4 * k4); if (seg1 > 0) c2 = *(const f32x4*)(s1p + 4 * k4);
#pragma unroll
              for (int e = 0; e < 4; ++e) { ss0[4 * k4 + e] = a[e]; ss1[4 * k4 + e] = c2[e]; } } }
        const float rk = p.a_r_k[l * DA + h * 64 + lane], gln = p.a_lnx_g[l * DA + h * 64 + lane], bln = p.a_lnx_b[l * DA + h * 64 + lane];
#pragma unroll 1
        for (int i = 0; i < 32; ++i) {
            const size_t o = (size_t)(mbase + i) * DA + h * 64, o1 = o + (size_t)T * DA;
            f32x4 pv0 = {0.f, 0.f, 0.f, 0.f}, pv1 = pv0;
            if (seg0 > 0) pv0 = *(const f32x4*)(p.PV + o + 4 * (lane & 15));
            if (seg1 > 0) pv1 = *(const f32x4*)(p.PV + o1 + 4 * (lane & 15));
            float a0 = p.Y[o + lane], a1 = p.Y[o1 + lane], a2 = 0.f, a3 = 0.f;
            const float rr = p.sR[o + lane], kds = p.sKD[o + lane] + p.sKD[o1 + lane], vv = p.sV[o + lane], gg = p.sG[o + lane];
            ScanRep<0>::dot(a0, a1, a2, a3, pv0, ss0);
            ScanRep<0>::dot(a0, a1, a2, a3, pv1, ss1);
            const float y = (a0 + a1) + (a2 + a3);
            const float mu = wave_sum(y) * (1.0f / 64.f), dy = y - mu;
            const float rstd = 1.0f / sqrtf(wave_sum(dy * dy) * (1.0f / 64.f) + GN_EPS);
            const float bon = wave_sum(rr * kds * rk);
            p.MIX[(size_t)(mbase + i) * DMIX + h * 64 + lane] = f2bf((dy * rstd * gln + bln + bon * vv) * gg);
        }
    }
}


#define LAS __attribute__((address_space(3)))
#define XB_TMO      128
#define XB_XCNT(j)  (256  + 64 * (j))
#define XB_XSUB(j)  (1280 + 64 * (j))
#define XB_XGEN(j)  (2304 + 64 * (j))
#define XB_TOP      3328
#define XB_TOPGEN   3392
#define XCD_BAR_WORDS 3456
#define XB_SPIN_CAP (1u << 20)
static_assert(XCD_BAR_WORDS * 4 <= 16384, "barrier words fit the control region");
__device__ __forceinline__ unsigned xb_ld(unsigned* p)              { return __hip_atomic_load(p, __ATOMIC_RELAXED, __HIP_MEMORY_SCOPE_AGENT); }
__device__ __forceinline__ unsigned xb_add(unsigned* p, unsigned v) { return __hip_atomic_fetch_add(p, v, __ATOMIC_RELAXED, __HIP_MEMORY_SCOPE_AGENT); }
__device__ __forceinline__ unsigned xb_xcc_id() { return (unsigned)__builtin_amdgcn_s_getreg((3 << 11) | 20) & 0xFu; }
#define XB_SPIN(cond, bar) do { unsigned _sp = 0; while (cond) { __builtin_amdgcn_s_sleep(1); \
    if ((++_sp & 255u) == 0u) { if (xb_ld(&(bar)[XB_TMO])) break; if (_sp > XB_SPIN_CAP) { atomicAdd(&(bar)[XB_TMO], 1u); break; } } } } while (0)
struct XcdBarrier { unsigned* bar; unsigned x; volatile LAS unsigned* st; };
__device__ __forceinline__ XcdBarrier xcd_barrier_post(unsigned* bar, volatile LAS unsigned* st) {
    XcdBarrier b; b.bar = bar; b.x = xb_xcc_id(); b.st = st;
    if (threadIdx.x == 0) (void)xb_add(&bar[XB_XCNT(b.x)], 1u);
    return b;
}
__device__ __forceinline__ void xcd_barrier_complete(unsigned* bar, unsigned x, unsigned& nloc, unsigned& nx) {
    const unsigned G = gridDim.x * gridDim.y * gridDim.z;
    unsigned sum, cnt, mine, sp = 0u;
    for (;;) {
        sum = 0u; cnt = 0u; mine = 0u;
#pragma unroll
        for (unsigned j = 0; j < 16; ++j) { const unsigned c = xb_ld(&bar[XB_XCNT(j)]); sum += c; cnt += (c > 0u) ? 1u : 0u; mine = (j == x) ? c : mine; }
        if (sum == G) break;
        __builtin_amdgcn_s_sleep(1);
        if ((++sp & 255u) == 0u) { if (xb_ld(&bar[XB_TMO])) break; if (sp > XB_SPIN_CAP) { atomicAdd(&bar[XB_TMO], 1u); break; } }
    }
    nloc = mine > 0u ? mine : 1u; nx = cnt > 0u ? cnt : 1u;
}
__device__ __forceinline__ void xcd_barrier(const XcdBarrier& b) {
    asm volatile("s_waitcnt vmcnt(0)" ::: "memory");
    __syncthreads();
    if (threadIdx.x == 0) {
        unsigned* bar = b.bar;
        __builtin_amdgcn_s_waitcnt(0);
        unsigned nloc = b.st[0], nx = b.st[1];
        if (nloc == 0u) { xcd_barrier_complete(bar, b.x, nloc, nx); b.st[0] = nloc; b.st[1] = nx; }
        const unsigned old = xb_add(&bar[XB_XSUB(b.x)], 1u);
        const unsigned gen = old / nloc;
        if (old + 1u == (gen + 1u) * nloc) {
            __builtin_amdgcn_fence(__ATOMIC_RELEASE, "agent");
            asm volatile("s_waitcnt vmcnt(0)" ::: "memory");
            const unsigned og = xb_add(&bar[XB_TOP], 1u);
            const unsigned tg = og / nx;
            if (og + 1u == (tg + 1u) * nx) xb_add(&bar[XB_TOPGEN], 1u);
            else XB_SPIN(xb_ld(&bar[XB_TOPGEN]) == tg, bar);
            __builtin_amdgcn_fence(__ATOMIC_ACQUIRE, "agent");
            xb_add(&bar[XB_XGEN(b.x)], 1u);
            asm volatile("s_waitcnt vmcnt(0)" ::: "memory");
        } else {
            XB_SPIN(xb_ld(&bar[XB_XGEN(b.x)]) == gen, bar);
            __builtin_amdgcn_fence(__ATOMIC_ACQUIRE, "agent");
            asm volatile("s_waitcnt vmcnt(0)" ::: "memory");
        }
    }
    __syncthreads();
}

#define GT ((long)blockIdx.x * blockDim.x + threadIdx.x)
#define GS ((long)gridDim.x * blockDim.x)
__global__ void __launch_bounds__(256, 2) mega_fwd(Params p) {
    __shared__ __attribute__((aligned(16))) char lds[40960 + 64];
    cg::grid_group grid = cg::this_grid();
    const long gt = GT, gs = GS;
    volatile LAS unsigned* bst = (volatile LAS unsigned*)(LAS char*)(lds + 40960);
    if (threadIdx.x < 2) bst[threadIdx.x] = 0u;
    __syncthreads();
    const XcdBarrier xb = xcd_barrier_post(p.bar, bst);
#define GSYNC() xcd_barrier(xb)
    ph_prep_w_fast(p, 0, 0, lds); ph_prep_misc(p, 0, gt, gs);
    grid.sync();
    for (int l = 0; l < 2; ++l) {
        const int nrows = (l == 0) ? T : TL;
        ph_lnmod_fast(p, l);
        GSYNC();
        g_gemm_in(p, lds);
        GSYNC();
        ph_streams_s1(p, l); ph_rope(p, gt, gs);
        GSYNC();
        g_streams_s2(p, l, lds);
        GSYNC();
        ph_scan_fast(p);
        GSYNC();
        ph_combine(p, lds); ph_attn_mfma(p, l, l == 0);
        GSYNC();
        ph_rwkv_out_fast(p, l, l == 0);
        GSYNC();
        g_gemm_out(p, nrows, lds); ph_prep_w_fast(p, l, 1, lds);
        GSYNC();
        ph_post_mixer_fast(p, l, nrows);
        GSYNC();
        ph_dispatch(p, l, nrows, gt, gs);
        GSYNC();
        g_moe1(p, l, lds);
        GSYNC();
        g_moe2(p, l, lds);
        GSYNC();
        ph_final_fast(p, l, nrows);
        if (l == 0) { ph_prep_w_fast(p, 1, 0, lds); ph_prep_misc(p, 1, gt, gs); }
        GSYNC();
    }
}

extern "C" void kernel_launch(void* const* d_in, const int* in_sizes, int n_in, void* d_out, int out_size, void* d_ws, size_t ws_size, hipStream_t stream) {
    if (n_in != 32 || out_size != TL * D || ws_size < WS_NEED) { fprintf(stderr, "kernel_launch: unexpected shapes / workspace (n_in %d out %d ws %zu need %zu)\n", n_in, out_size, ws_size, (size_t)WS_NEED); return; }
    static int grid_blocks = 0;
    if (!grid_blocks) {
        int dev = 0, cus = 0, per_cu = 0;
        (void)hipGetDevice(&dev);
        (void)hipDeviceGetAttribute(&cus, hipDeviceAttributeMultiprocessorCount, dev);
        (void)hipOccupancyMaxActiveBlocksPerMultiprocessor(&per_cu, mega_fwd, 256, 0);
        if (per_cu < 1) per_cu = 1;
        if (per_cu > 2) per_cu = 2;
        grid_blocks = cus * per_cu;
        fprintf(stderr, "kernel_launch: %d CUs x %d blocks\n", cus, per_cu);
    }
    Params p = make_params(d_in, d_out, d_ws);
    (void)hipMemsetAsync(d_ws, 0, CTL_BYTES, stream);
    void* args[] = {&p};
    hipError_t e = hipLaunchCooperativeKernel((void*)mega_fwd, dim3(grid_blocks), dim3(256), args, 0, stream);
    if (e != hipSuccess) fprintf(stderr, "cooperative launch failed: %s (grid %d)\n", hipGetErrorString(e), grid_blocks);
}
#endif

#ifdef HOST_EMU
static void host_forward(void* const* d_in, void* d_out, void* d_ws) {
    const Params p = make_params(d_in, d_out, d_ws);
    for (int l = 0; l < 2; ++l) {
        const int nrows = (l == 0) ? T : TL;
        ph_prep_w(p, l, 0, 1); ph_prep_misc(p, l, 0, 1); ph_lnmod(p, l, 0, 1); host_gemm_in(p); ph_streams(p, l, 0, 1); ph_rope(p, 0, 1); ph_scan(p, 0, 1);
        ph_attn(p, l, nrows, 0, 1); ph_rwkv_out(p, l, nrows, 0, 1); host_gemm_out(p, nrows); ph_post_mixer(p, l, nrows, 0, 1);
        ph_dispatch(p, l, nrows, 0, 1); host_moe1(p, l); host_moe2(p, l); ph_final(p, l, nrows, 0, 1);
    }
}
#endif
```

```cpp
#ifdef HOST_EMU
#include <cmath>
#include <cstdio>
#include <cstring>
#include <cstdint>
#include <cstdlib>
#define __device__
#define __global__
#define __host__
#define __forceinline__ inline
#else
#include <hip/hip_runtime.h>
#include <hip/hip_cooperative_groups.h>
#include <cstdio>
#include <cstdint>
namespace cg = cooperative_groups;
#endif

#ifndef CFG_D
#define CFG_D 1024
#define CFG_B 8
#define CFG_S 2048
#define CFG_L 256
#define CFG_DE 512
#endif
constexpr int D = CFG_D, NB = CFG_B, S = CFG_S, L = CFG_L, DE = CFG_DE;
constexpr int TL = NB * S, TC = NB * L, T = TL + TC;
constexpr int GRID_W = 64, HD = 64;
constexpr int DA = 256, A_IN = 1184, N_IN = 2976, NINP = 3072, DMIX = 1024;
constexpr int NEXP = 32, NSLOT = 2 * T + NEXP * 128;
constexpr int ZQB = 0, ZKB = 384, ZVB = 512, ZQN = 640, ZKN = 1024, ZVN = 1408, ZA = 1792, ZP = 2976;
constexpr float LN_EPS = 1e-6f, GN_EPS = 64e-5f, ATT_SCALE = 0.125f;
constexpr float ALPHA = 1.41421356237309515f;

typedef unsigned short bf16_t;

__device__ __forceinline__ float bf2f(bf16_t v) {
    unsigned u = ((unsigned)v) << 16; float f;
#ifdef HOST_EMU
    memcpy(&f, &u, 4);
#else
    f = __uint_as_float(u);
#endif
    return f;
}
__device__ __forceinline__ bf16_t f2bf(float f) {
    unsigned u;
#ifdef HOST_EMU
    memcpy(&u, &f, 4);
#else
    u = __float_as_uint(f);
#endif
    return (bf16_t)((u + 0x7fffu + ((u >> 16) & 1u)) >> 16);
}
__device__ __forceinline__ float sigmoidf_(float x) { return 1.0f / (1.0f + expf(-x)); }
__device__ __forceinline__ float siluf_(float x) { return x / (1.0f + expf(-x)); }
__device__ __forceinline__ int atomic_inc_int(int* p) {
#ifdef HOST_EMU
    int o = *p; *p = o + 1; return o;
#else
    return atomicAdd(p, 1);
#endif
}

struct Params {
    const float *x, *c, *ctx, *c_ctx, *w_mod, *b_mod, *w_in, *w_out, *a_shift, *a_w0, *a_w_up, *a_a0, *a_a_up, *a_g_up,
        *a_k_k, *a_k_a, *a_r_k, *a_lnx_g, *a_lnx_b, *b_sink, *c_rpb, *ln1_g, *ln1_b, *ln2_g, *ln2_b, *w_rg, *b_rg, *w_re,
        *b_re, *w_gate, *w_up, *w_down;
    float* out;
    int* cnt;
    unsigned* bar;
    float* mod;
    float* rope;
    bf16_t *win_t, *wout_t, *wgu_t, *wd_t;
    bf16_t *wrt;
    float* LG;
    bf16_t* HLO;
    bf16_t *wupT, *aupT, *gupT;
    bf16_t* LA;
    float *kT, *kN;
    bf16_t* H;
    bf16_t* Z;
    bf16_t* VT;
    float *sR, *sV, *sKK, *sG, *sW, *sKD, *sB;
    float* Y;
    bf16_t* MIX;
    float *PV, *QS, *PS, *SS;
    float* XC;
    float* O;
    int *rE, *rPos, *rSlot; float* rW;
    int* slotTok;
    bf16_t* ACT;
    float* YS;
};

constexpr size_t al256(size_t v) { return (v + 255) & ~(size_t)255; }
constexpr size_t OFF_CNT = 0;
constexpr size_t OFF_BAR = 4096, CTL_BYTES = 4096 + 16384;
constexpr size_t OFF_MOD = CTL_BYTES;
constexpr size_t OFF_ROPE = al256(OFF_MOD + (size_t)2 * (NB + 1) * 6 * D * 4);
constexpr size_t OFF_LORA = al256(OFF_ROPE + 64 * 16 * 2 * 4);
constexpr size_t OFF_WRT = al256(OFF_LORA + (size_t)(2 * 256 * 64 * 2 + 256 * 160) * 2);
constexpr size_t OFF_LG = al256(OFF_WRT + (size_t)2 * 128 * D * 2);
constexpr size_t OFF_WIN = al256(OFF_LG + (size_t)T * 36 * 4);
constexpr size_t OFF_WOUT = al256(OFF_WIN + (size_t)NINP * D * 2);
constexpr size_t OFF_WGU = al256(OFF_WOUT + (size_t)D * DMIX * 2);
constexpr size_t OFF_WD = al256(OFF_WGU + (size_t)NEXP * 2 * DE * D * 2);
constexpr size_t OFF_H = al256(OFF_WD + (size_t)NEXP * D * DE * 2);
constexpr size_t OFF_Z = al256(OFF_H + (size_t)(T + 1) * D * 2);
constexpr int PU = L + S;
constexpr int NSG = (L + S) / 128;
static_assert((size_t)3 * 64 * ((L + S) / 128) * 4096 * 4 <= (size_t)NEXP * 2 * DE * D * 2 || (L % 128) != 0, "scan segment states overlay wgu_t");
constexpr size_t OFF_VT = al256(OFF_Z + (size_t)T * ZP * 2);
constexpr size_t OFF_S = al256(OFF_VT + (size_t)NB * 8 * 64 * PU * 2);
constexpr size_t S1 = (size_t)T * 256 * 4;
constexpr size_t OFF_Y = al256(OFF_S + 10 * S1);
constexpr size_t OFF_MIX = al256(OFF_Y + 2 * S1);
constexpr size_t OFF_XC = al256(OFF_MIX + (size_t)T * 1024 * 2);
constexpr size_t OFF_ROUTE = al256(OFF_XC + (size_t)TC * D * 4);
constexpr size_t OFF_SLOTTOK = al256(OFF_ROUTE + (size_t)T * 2 * 4 * 4);
constexpr size_t WS_NEED = al256(OFF_SLOTTOK + (size_t)NSLOT * 4);
static_assert((size_t)NSLOT * DE * 2 <= (size_t)T * ZP * 2 && (size_t)T * D * 2 <= (size_t)T * ZP * 2, "ACT / HLO overlay Z");
static_assert((size_t)T * 4 * 4 + (size_t)T * 416 * 2 <= S1, "kN + LA overlay Y[1]");
static_assert((size_t)NSLOT * D * 4 <= 10 * S1 && (size_t)T * D * 4 <= 10 * S1, "YS / O overlay the stream buffers");

static Params make_params(void* const* d_in, void* d_out, void* d_ws) {
    Params p{};
    const float** f = (const float**)&p.x;
    for (int i = 0; i < 32; ++i) f[i] = (const float*)d_in[i];
    p.out = (float*)d_out;
    char* w = (char*)d_ws;
    p.cnt = (int*)(w + OFF_CNT); p.bar = (unsigned*)(w + OFF_BAR); p.mod = (float*)(w + OFF_MOD); p.rope = (float*)(w + OFF_ROPE);
    p.win_t = (bf16_t*)(w + OFF_WIN); p.wout_t = (bf16_t*)(w + OFF_WOUT); p.wgu_t = (bf16_t*)(w + OFF_WGU); p.wd_t = (bf16_t*)(w + OFF_WD);
    p.wrt = (bf16_t*)(w + OFF_WRT); p.LG = (float*)(w + OFF_LG); p.HLO = (bf16_t*)(w + OFF_Z);
    p.wupT = (bf16_t*)(w + OFF_LORA); p.aupT = p.wupT + 2 * 256 * 64; p.gupT = p.aupT + 2 * 256 * 64;
    p.H = (bf16_t*)(w + OFF_H); p.Z = (bf16_t*)(w + OFF_Z); p.VT = (bf16_t*)(w + OFF_VT);
    float* s = (float*)(w + OFF_S); const size_t n1 = (size_t)T * 256;
    p.sR = s; p.sV = s + n1; p.sKK = s + 2 * n1; p.sG = s + 3 * n1; p.sW = s + 4 * n1; p.sKD = s + 6 * n1; p.sB = s + 8 * n1;
    p.Y = (float*)(w + OFF_Y); p.MIX = (bf16_t*)(w + OFF_MIX); p.XC = (float*)(w + OFF_XC);
    p.O = (float*)(w + OFF_S);
    p.PV = (float*)(w + OFF_H); p.QS = (float*)(w + OFF_WGU); p.PS = p.QS + (size_t)64 * NSG * 4096; p.SS = p.PS + (size_t)64 * NSG * 4096;
    p.kT = p.Y; p.kN = p.Y + (size_t)T * 256; p.LA = (bf16_t*)(p.Y + (size_t)T * 256 + (size_t)T * 4);
    int* r = (int*)(w + OFF_ROUTE); p.rE = r; p.rPos = r + 2 * T; p.rSlot = r + 4 * T; p.rW = (float*)(r + 6 * T);
    p.slotTok = (int*)(w + OFF_SLOTTOK);
    p.ACT = (bf16_t*)(w + OFF_Z); p.YS = (float*)(w + OFF_S);
    return p;
}

__device__ void ph_prep_w(const Params& p, int l, long gtid, long gsz) {
    for (long i = gtid; i < (long)D * NINP; i += gsz) {
        const int k = (int)(i / NINP), n = (int)(i % NINP);
        float v = 0.f;
        if (n < N_IN) { const int oc = (n < ZA) ? n + A_IN : n - ZA; v = p.w_in[((size_t)l * D + k) * N_IN + oc]; }
        p.win_t[(size_t)n * D + k] = f2bf(v);
    }
    for (long i = gtid; i < (long)DMIX * D; i += gsz) {
        const int k = (int)(i / D), n = (int)(i % D);
        p.wout_t[(size_t)n * DMIX + k] = f2bf(p.w_out[((size_t)l * DMIX + k) * D + n]);
    }
    for (long i = gtid; i < (long)NEXP * D * 2 * DE; i += gsz) {
        const int rho = (int)(i % (2 * DE)); const long t = i / (2 * DE); const int k = (int)(t % D), e = (int)(t / D);
        const int q = rho >> 5, half = (rho >> 4) & 1, ii = rho & 15, cc = 16 * q + ii;
        const float* src = half ? p.w_up : p.w_gate;
        p.wgu_t[((size_t)e * 2 * DE + rho) * D + k] = f2bf(src[(((size_t)l * NEXP + e) * D + k) * DE + cc]);
    }
    for (long i = gtid; i < (long)NEXP * DE * D; i += gsz) {
        const int n = (int)(i % D); const long t = i / D; const int k = (int)(t % DE), e = (int)(t / DE);
        p.wd_t[((size_t)e * D + n) * DE + k] = f2bf(p.w_down[(((size_t)l * NEXP + e) * DE + k) * D + n]);
    }
}
__device__ __forceinline__ void ph_prep_misc(const Params& p, int l, long gtid, long gsz, bool do_mod = true) {
    if (l == 0 && do_mod) for (long i = gtid; i < (long)2 * (NB + 1) * 6 * D; i += gsz) {
        const int j = (int)(i % (6 * D)), b = (int)((i / (6 * D)) % (NB + 1)), ll = (int)(i / ((long)6 * D * (NB + 1)));
        const float* cv = (b < NB) ? p.c + (size_t)b * D : p.c_ctx;
        float acc = 0.f;
        for (int k = 0; k < D; ++k) acc += siluf_(cv[k]) * p.w_mod[((size_t)ll * D + k) * 6 * D + j];
        p.mod[((size_t)ll * (NB + 1) + b) * 6 * D + j] = acc + p.b_mod[(size_t)ll * 6 * D + j];
    }
    if (l == 0) for (long i = gtid; i < 64 * 16; i += gsz) {
        const int pos = (int)(i / 16), fi = (int)(i % 16);
        const float inv = powf(10000.0f, -(float)fi / 16.0f), ang = (float)pos * inv;
        p.rope[i] = cosf(ang); p.rope[1024 + i] = sinf(ang);
    }
    for (long i = gtid; i < NEXP; i += gsz) p.cnt[l * NEXP + i] = 0;
    for (long i = gtid; i < NSLOT; i += gsz) p.slotTok[i] = T;
    for (long i = gtid; i < D; i += gsz) p.H[(size_t)T * D + i] = 0;
}

__device__ __forceinline__ const float* xrow_in(const Params& p, int l, int m) {
    if (m < TL) return (l == 0 ? p.x : p.out) + (size_t)m * D;
    return (l == 0 ? p.ctx : p.XC) + (size_t)(m - TL) * D;
}
__device__ __forceinline__ const float* modrow(const Params& p, int l, int m) { return p.mod + ((size_t)l * (NB + 1) + (m < TL ? m / S : NB)) * 6 * D; }

__device__ void ph_lnmod(const Params& p, int l, long gtid, long gsz) {
    for (long m = gtid; m < T; m += gsz) {
        const float* xr = xrow_in(p, l, (int)m); const float* md = modrow(p, l, (int)m);
        float s = 0.f; for (int j = 0; j < D; ++j) s += xr[j];
        const float mu = s / D; float q = 0.f;
        for (int j = 0; j < D; ++j) { const float d = xr[j] - mu; q += d * d; }
        const float rstd = 1.0f / sqrtf(q / D + LN_EPS);
        for (int j = 0; j < D; ++j) p.H[(size_t)m * D + j] = f2bf((xr[j] - mu) * rstd * (1.0f + md[D + j]) + md[j]);
    }
}

__device__ __forceinline__ float zshift(const Params& p, int l, int m, int col) {
    int t, len;
    if (m < TL) { t = m % S; len = S; } else { t = (m - TL) % L; len = L; }
    const float* sh = p.a_shift + (size_t)l * 3 * A_IN;
    const bf16_t* z = p.Z + (size_t)m * ZP + ZA + col;
    float v = sh[A_IN + col] * bf2f(z[0]);
    if (t > 0) v += sh[col] * bf2f(z[-ZP]);
    if (t < len - 1) v += sh[2 * A_IN + col] * bf2f(z[ZP]);
    return v;
}

__device__ void ph_streams(const Params& p, int l, long gtid, long gsz) {
    for (long i = gtid; i < (long)T * DA; i += gsz) {
        const int m = (int)(i / DA), c = (int)(i % DA), h0 = c & ~63;
        const float r = zshift(p, l, m, c), k = zshift(p, l, m, 256 + c), v = zshift(p, l, m, 512 + c);
        float nrm = 0.f;
        for (int j = 0; j < 64; ++j) { const float t = zshift(p, l, m, 256 + h0 + j) * p.a_k_k[l * DA + h0 + j]; nrm += t * t; }
        const float kk = k * p.a_k_k[l * DA + c] / sqrtf(nrm + 1e-12f);
        float g = 0.f;
        for (int j = 0; j < 160; ++j) g += sigmoidf_(zshift(p, l, m, 1024 + j)) * p.a_g_up[((size_t)l * 160 + j) * DA + c];
        const size_t o = (size_t)m * DA + c;
        p.sR[o] = r; p.sV[o] = v; p.sKK[o] = kk; p.sG[o] = g;
        for (int d = 0; d < 2; ++d) {
            float aw = 0.f, aa = 0.f;
            for (int j = 0; j < 64; ++j) {
                aw += tanhf(zshift(p, l, m, 768 + d * 64 + j)) * p.a_w_up[(((size_t)l * 2 + d) * 64 + j) * DA + c];
                aa += zshift(p, l, m, 896 + d * 64 + j) * p.a_a_up[(((size_t)l * 2 + d) * 64 + j) * DA + c];
            }
            const float u = -(p.a_w0[(l * 2 + d) * DA + c] + aw);
            const float sp = (u > 20.f) ? u : log1pf(expf(u));
            const float w = expf(-expf(-sp - 0.5f));
            const float a = sigmoidf_(p.a_a0[(l * 2 + d) * DA + c] + aa);
            const size_t od = ((size_t)d * T + m) * DA + c;
            p.sW[od] = w; p.sKD[od] = k * (1.0f + (a - 1.0f) * p.a_k_a[l * DA + c]); p.sB[od] = kk * a;
        }
    }
}

__device__ __forceinline__ void ph_rope(const Params& p, long gtid, long gsz) {
    for (long i = gtid; i < (long)TL * 8 * 32; i += gsz) {
        const int pr = (int)(i & 31), hs = (int)((i >> 5) & 7), m = (int)(i >> 8);
        const int t = m % S, axis = pr >> 4, fi = pr & 15, pos = axis ? (t % GRID_W) : (t / GRID_W);
        bf16_t* z = p.Z + (size_t)m * ZP + hs * 64 + axis * 32 + fi;
        const float cs = p.rope[pos * 16 + fi], sn = p.rope[1024 + pos * 16 + fi];
        const float x0 = bf2f(z[0]), x1 = bf2f(z[16]);
        z[0] = f2bf(x0 * cs - x1 * sn); z[16] = f2bf(x1 * cs + x0 * sn);
    }
}

__device__ void ph_scan(const Params& p, long gtid, long gsz) {
    for (long i = gtid; i < (long)2 * NB * 4 * 64; i += gsz) {
        const int v = (int)(i & 63), h = (int)((i >> 6) & 3), b = (int)((i >> 8) % NB), d = (int)((i >> 8) / NB);
        float st[64];
#pragma unroll
        for (int k = 0; k < 64; ++k) st[k] = 0.f;
        for (int pos = 0; pos < L + S; ++pos) {
            int m;
            if (pos < L) m = TL + b * L + (d ? L - 1 - pos : pos);
            else m = b * S + (d ? S - 1 - (pos - L) : pos - L);
            const size_t o = (size_t)m * DA + h * 64, od = ((size_t)d * T + m) * DA + h * 64;
            const float* kk = p.sKK + o; const float* r = p.sR + o;
            const float* w = p.sW + od; const float* bb = p.sB + od; const float* kd = p.sKD + od;
            const float vv = p.sV[o + v];
            float sk = 0.f;
#pragma unroll
            for (int k = 0; k < 64; ++k) sk += st[k] * kk[k];
            float y = 0.f;
#pragma unroll
            for (int k = 0; k < 64; ++k) { st[k] = st[k] * w[k] - sk * bb[k] + vv * kd[k]; y += st[k] * r[k]; }
            p.Y[od + v] = y;
        }
    }
}

__device__ void ph_rwkv_out(const Params& p, int l, int nrows, long gtid, long gsz) {
    for (long i = gtid; i < (long)nrows * 4; i += gsz) {
        const int m = (int)(i >> 2), h = (int)(i & 3);
        const size_t o = (size_t)m * DA + h * 64;
        const float* y0 = p.Y + o; const float* y1 = p.Y + (size_t)T * DA + o;
        float s = 0.f, bon = 0.f;
        for (int n = 0; n < 64; ++n) {
            s += y0[n] + y1[n];
            bon += p.sR[o + n] * (p.sKD[o + n] + p.sKD[(size_t)T * DA + o + n]) * p.a_r_k[l * DA + h * 64 + n];
        }
        const float mu = s / 64.f; float q = 0.f;
        for (int n = 0; n < 64; ++n) { const float dd = y0[n] + y1[n] - mu; q += dd * dd; }
        const float rstd = 1.0f / sqrtf(q / 64.f + GN_EPS);
        for (int n = 0; n < 64; ++n) {
            const int c = h * 64 + n;
            const float yn = (y0[n] + y1[n] - mu) * rstd * p.a_lnx_g[l * DA + c] + p.a_lnx_b[l * DA + c];
            p.MIX[(size_t)m * DMIX + c] = f2bf((yn + bon * p.sV[o + n]) * p.sG[o + n]);
        }
    }
}

__device__ __forceinline__ void att_key(const float (&q)[64], const bf16_t* kr, const bf16_t* vr, float bias, float& mx, float& ls, float (&acc)[64]) {
    float s = 0.f;
#pragma unroll
    for (int d = 0; d < 64; ++d) s += q[d] * bf2f(kr[d]);
    s = s * ATT_SCALE + bias;
    const float mn = fmaxf(mx, s), f = expf(mx - mn), pe = expf(s - mn);
    ls = ls * f + pe;
#pragma unroll
    for (int d = 0; d < 64; ++d) acc[d] = acc[d] * f + pe * bf2f(vr[d]);
    mx = mn;
}

__device__ void ph_attn(const Params& p, int l, int nrows, long gtid, long gsz) {
    for (long i = gtid; i < (long)nrows * 12; i += gsz) {
        const int m = (int)(i / 12), u = (int)(i % 12);
        const bool isB = u < 6; const int hq = isB ? u : u - 6;
        const int b = (m < TL) ? m / S : (m - TL) / L;
        const int qcol = isB ? ZQB + hq * 64 : ZQN + hq * 64;
        const int kcol = isB ? ZKB + (hq / 3) * 64 : ZKN + hq * 64;
        const int vcol = isB ? ZVB + (hq / 3) * 64 : ZVN + hq * 64;
        float q[64], acc[64];
        const bf16_t* qr = p.Z + (size_t)m * ZP + qcol;
#pragma unroll
        for (int d = 0; d < 64; ++d) { q[d] = bf2f(qr[d]); acc[d] = 0.f; }
        float mx, ls;
        if (isB) { mx = p.b_sink[l * 6 + hq]; ls = 1.0f; } else { mx = -1e30f; ls = 0.f; }
        for (int j = 0; j < L; ++j) { const bf16_t* zr = p.Z + (size_t)(TL + b * L + j) * ZP; att_key(q, zr + kcol, zr + vcol, 0.f, mx, ls, acc); }
        if (m < TL) {
            const int t = m % S;
            if (isB) {
                const int j0 = t - 128 < 0 ? 0 : t - 128, j1 = t + 128 > S - 1 ? S - 1 : t + 128;
                for (int j = j0; j <= j1; ++j) { const bf16_t* zr = p.Z + (size_t)(b * S + j) * ZP; att_key(q, zr + kcol, zr + vcol, 0.f, mx, ls, acc); }
            } else {
                const int rows = S / GRID_W, r = t / GRID_W, c = t % GRID_W;
                int r0 = r - 4; r0 = r0 < 0 ? 0 : (r0 > rows - 8 ? rows - 8 : r0);
                int c0 = c - 8; c0 = c0 < 0 ? 0 : (c0 > GRID_W - 16 ? GRID_W - 16 : c0);
                for (int a = 0; a < 8; ++a)
                    for (int e = 0; e < 16; ++e) {
                        const int kr = r0 + a, kc = c0 + e;
                        const float bias = p.c_rpb[(((size_t)l * 6 + hq) * 15 + (kr - r + 7)) * 31 + (kc - c + 15)];
                        const bf16_t* zr = p.Z + (size_t)(b * S + kr * GRID_W + kc) * ZP;
                        att_key(q, zr + kcol, zr + vcol, bias, mx, ls, acc);
                    }
            }
        }
        const float inv = 1.0f / ls;
        bf16_t* o = p.MIX + (size_t)m * DMIX + (isB ? 256 : 640) + hq * 64;
#pragma unroll
        for (int d = 0; d < 64; ++d) o[d] = f2bf(acc[d] * inv);
    }
}

__device__ void ph_post_mixer(const Params& p, int l, int nrows, long gtid, long gsz) {
    for (long mm = gtid; mm < nrows; mm += gsz) {
        const int m = (int)mm;
        const float* xr = xrow_in(p, l, m); const float* md = modrow(p, l, m); const float* orow = p.O + (size_t)m * D;
        float* x1 = (m < TL) ? p.out + (size_t)m * D : p.XC + (size_t)(m - TL) * D;
        const float* g1 = p.ln1_g + (size_t)l * D; const float* b1 = p.ln1_b + (size_t)l * D;
        float s = 0.f; for (int j = 0; j < D; ++j) s += ALPHA * xr[j] + md[2 * D + j] * orow[j];
        float mu = s / D, q = 0.f;
        for (int j = 0; j < D; ++j) { const float d = ALPHA * xr[j] + md[2 * D + j] * orow[j] - mu; q += d * d; }
        float rstd = 1.0f / sqrtf(q / D + LN_EPS);
        s = 0.f;
        for (int j = 0; j < D; ++j) { const float v = (ALPHA * xr[j] + md[2 * D + j] * orow[j] - mu) * rstd * g1[j] + b1[j]; x1[j] = v; s += v; }
        mu = s / D; q = 0.f;
        for (int j = 0; j < D; ++j) { const float d = x1[j] - mu; q += d * d; }
        rstd = 1.0f / sqrtf(q / D + LN_EPS);
        float gl[4], el[32];
#pragma unroll
        for (int g = 0; g < 4; ++g) gl[g] = p.b_rg[l * 4 + g];
#pragma unroll
        for (int e = 0; e < 32; ++e) el[e] = p.b_re[l * 32 + e];
        for (int j = 0; j < D; ++j) {
            const float hv = (x1[j] - mu) * rstd * (1.0f + md[4 * D + j]) + md[3 * D + j];
            p.H[(size_t)m * D + j] = f2bf(hv);
            const float* wg = p.w_rg + ((size_t)l * D + j) * 4; const float* we = p.w_re + ((size_t)l * D + j) * 32;
#pragma unroll
            for (int g = 0; g < 4; ++g) gl[g] += hv * wg[g];
#pragma unroll
            for (int e = 0; e < 32; ++e) el[e] += hv * we[e];
        }
        int gs = 0; float gm = gl[0];
#pragma unroll
        for (int g = 1; g < 4; ++g) if (gl[g] > gm) { gm = gl[g]; gs = g; }
        float den = 0.f;
#pragma unroll
        for (int g = 0; g < 4; ++g) den += expf(gl[g] - gm);
        const float pg = 1.0f / den;
        float v1 = -3e38f, v2 = -3e38f; int i1 = 0, i2 = 0;
#pragma unroll
        for (int j = 0; j < 8; ++j) {
            const float v = gs == 0 ? el[j] : gs == 1 ? el[8 + j] : gs == 2 ? el[16 + j] : el[24 + j];
            if (v > v1) { v2 = v1; i2 = i1; v1 = v; i1 = j; } else if (v > v2) { v2 = v; i2 = j; }
        }
        const float e2 = expf(v2 - v1), w1 = pg / (1.0f + e2), w2 = pg * e2 / (1.0f + e2);
        const int ea = gs * 8 + i1, eb = gs * 8 + i2;
        p.rE[2 * m] = ea; p.rE[2 * m + 1] = eb; p.rW[2 * m] = w1; p.rW[2 * m + 1] = w2;
        p.rPos[2 * m] = atomic_inc_int(p.cnt + l * NEXP + ea); p.rPos[2 * m + 1] = atomic_inc_int(p.cnt + l * NEXP + eb);
    }
}

__device__ __forceinline__ int pstart_of(const int* cnt, int e) {
    int s = 0;
    for (int j = 0; j < NEXP; ++j) if (j < e) s += (cnt[j] + 127) & ~127;
    return s;
}
__device__ __forceinline__ void ph_dispatch(const Params& p, int l, int nrows, long gtid, long gsz) {
    for (long i = gtid; i < (long)nrows * 2; i += gsz) {
        const int slot = pstart_of(p.cnt + l * NEXP, p.rE[i]) + p.rPos[i];
        p.rSlot[i] = slot; p.slotTok[slot] = (int)(i >> 1);
    }
}

__device__ void ph_final(const Params& p, int l, int nrows, long gtid, long gsz) {
    for (long mm = gtid; mm < nrows; mm += gsz) {
        const int m = (int)mm;
        float* x1 = (m < TL) ? p.out + (size_t)m * D : p.XC + (size_t)(m - TL) * D;
        const float* md = modrow(p, l, m);
        const float* ya = p.YS + (size_t)p.rSlot[2 * m] * D; const float* yb = p.YS + (size_t)p.rSlot[2 * m + 1] * D;
        const float wa = p.rW[2 * m], wb = p.rW[2 * m + 1];
        const float* g2 = p.ln2_g + (size_t)l * D; const float* b2 = p.ln2_b + (size_t)l * D;
        float s = 0.f; for (int j = 0; j < D; ++j) s += ALPHA * x1[j] + md[5 * D + j] * (wa * ya[j] + wb * yb[j]);
        const float mu = s / D; float q = 0.f;
        for (int j = 0; j < D; ++j) { const float d = ALPHA * x1[j] + md[5 * D + j] * (wa * ya[j] + wb * yb[j]) - mu; q += d * d; }
        const float rstd = 1.0f / sqrtf(q / D + LN_EPS);
        for (int j = 0; j < D; ++j) x1[j] = (ALPHA * x1[j] + md[5 * D + j] * (wa * ya[j] + wb * yb[j]) - mu) * rstd * g2[j] + b2[j];
    }
}

__device__ __forceinline__ int moe_blocks(const int* cnt) { int s = 0; for (int j = 0; j < NEXP; ++j) s += (cnt[j] + 127) >> 7; return s; }
__device__ __forceinline__ int moe_block_expert(const int* cnt, int rb) {
    int s = 0, e = 0;
    for (int j = 0; j < NEXP; ++j) { const int nb = (cnt[j] + 127) >> 7; if (rb >= s && rb < s + nb) e = j; s += nb; }
    return e;
}

#ifdef HOST_EMU
static void host_gemm_in(const Params& p) {
    for (int m = 0; m < T; ++m) for (int n = 0; n < ZP; ++n) { float a = 0.f; for (int k = 0; k < D; ++k) a += bf2f(p.H[(size_t)m * D + k]) * bf2f(p.win_t[(size_t)n * D + k]); p.Z[(size_t)m * ZP + n] = f2bf(a); }
}
static void host_gemm_out(const Params& p, int nrows) {
    for (int m = 0; m < nrows; ++m) for (int n = 0; n < D; ++n) { float a = 0.f; for (int k = 0; k < DMIX; ++k) a += bf2f(p.MIX[(size_t)m * DMIX + k]) * bf2f(p.wout_t[(size_t)n * DMIX + k]); p.O[(size_t)m * D + n] = a; }
}
static void host_moe1(const Params& p, int l) {
    const int* cnt = p.cnt + l * NEXP; const int nrb = moe_blocks(cnt);
    for (int rb = 0; rb < nrb; ++rb) { const int e = moe_block_expert(cnt, rb);
        for (int r = 0; r < 128; ++r) { const int slot = rb * 128 + r; const bf16_t* a = p.H + (size_t)p.slotTok[slot] * D;
            for (int c = 0; c < DE; ++c) { const int q = c >> 4, ii = c & 15; float g = 0.f, u = 0.f;
                const bf16_t* wg = p.wgu_t + ((size_t)e * 2 * DE + 32 * q + ii) * D; const bf16_t* wu = wg + (size_t)16 * D;
                for (int k = 0; k < D; ++k) { g += bf2f(a[k]) * bf2f(wg[k]); u += bf2f(a[k]) * bf2f(wu[k]); }
                p.ACT[(size_t)slot * DE + c] = f2bf(siluf_(g) * u); } } }
}
static void host_moe2(const Params& p, int l) {
    const int* cnt = p.cnt + l * NEXP; const int nrb = moe_blocks(cnt);
    for (int rb = 0; rb < nrb; ++rb) { const int e = moe_block_expert(cnt, rb);
        for (int r = 0; r < 128; ++r) { const int slot = rb * 128 + r;
            for (int n = 0; n < D; ++n) { float a = 0.f; const bf16_t* w = p.wd_t + ((size_t)e * D + n) * DE;
                for (int k = 0; k < DE; ++k) a += bf2f(p.ACT[(size_t)slot * DE + k]) * bf2f(w[k]);
                p.YS[(size_t)slot * D + n] = a; } } }
}
#else
typedef short bf16x8 __attribute__((ext_vector_type(8)));
typedef float f32x4 __attribute__((ext_vector_type(4)));
__device__ __forceinline__ int opq_tid() { int t = threadIdx.x; asm volatile("" : "+v"(t)); return t; }
__device__ __forceinline__ int opq_bid() { int b = blockIdx.x; asm volatile("" : "+s"(b)); return b; }
__device__ __forceinline__ unsigned pk2(float lo, float hi) { return (unsigned)f2bf(lo) | ((unsigned)f2bf(hi) << 16); }
struct u32x2_t { unsigned x, y; };
__device__ __forceinline__ void st_bf16x4(bf16_t* dst, f32x4 v) { u32x2_t o; o.x = pk2(v[0], v[1]); o.y = pk2(v[2], v[3]); *(u32x2_t*)dst = o; }
template <class Epi>
__device__ __forceinline__ void gemm_tile(const bf16_t* a0, const bf16_t* a1, const bf16_t* b0, const bf16_t* b1, int K, char* lds, const Epi& epi, int nseg = 1, size_t aseg = 0, size_t bseg = 0) {
    const int tid = opq_tid(), wid = tid >> 6, lane = tid & 63, wr = wid >> 1, wc = wid & 1, fr = lane & 15, fq = lane >> 4;
    char* SA = lds; char* SB = lds + 8192;
    f32x4 acc[4][4];
#pragma unroll
    for (int m = 0; m < 4; ++m)
#pragma unroll
        for (int n = 0; n < 4; ++n) acc[m][n] = (f32x4){0.f, 0.f, 0.f, 0.f};
    for (int sg = 0; sg < nseg; ++sg, a0 += aseg, a1 += aseg, b0 += bseg, b1 += bseg)
    for (int kt = 0; kt < K; kt += 32) {
        __builtin_amdgcn_global_load_lds((const unsigned*)(a0 + kt), (__attribute__((address_space(3))) unsigned*)(SA + tid * 16), 16, 0, 0);
        __builtin_amdgcn_global_load_lds((const unsigned*)(a1 + kt), (__attribute__((address_space(3))) unsigned*)(SA + tid * 16 + 4096), 16, 0, 0);
        __builtin_amdgcn_global_load_lds((const unsigned*)(b0 + kt), (__attribute__((address_space(3))) unsigned*)(SB + tid * 16), 16, 0, 0);
        __builtin_amdgcn_global_load_lds((const unsigned*)(b1 + kt), (__attribute__((address_space(3))) unsigned*)(SB + tid * 16 + 4096), 16, 0, 0);
        asm volatile("s_waitcnt vmcnt(0)" ::: "memory");
        __syncthreads();
        bf16x8 At[4], Bt[4];
#pragma unroll
        for (int m = 0; m < 4; ++m) At[m] = *(const bf16x8*)(SA + (wr * 64 + m * 16 + fr) * 64 + fq * 16);
#pragma unroll
        for (int n = 0; n < 4; ++n) Bt[n] = *(const bf16x8*)(SB + (wc * 64 + n * 16 + fr) * 64 + fq * 16);
#pragma unroll
        for (int m = 0; m < 4; ++m)
#pragma unroll
            for (int n = 0; n < 4; ++n) acc[m][n] = __builtin_amdgcn_mfma_f32_16x16x32_bf16(At[m], Bt[n], acc[m][n], 0, 0, 0);
        __syncthreads();
    }
    epi(acc, wr, wc, fr, fq);
}
#define STG_ROW(i) ((tid_ + (i) * 256) >> 2)
#define STG_K ((tid_ & 3) * 8)

__device__ __forceinline__ void g_gemm_in(const Params& p, char* lds) {
    const int tid_ = opq_tid(), bid_ = opq_bid(); (void)tid_; (void)bid_;
    constexpr int NT = NINP / 128, MT = T / 128;
    for (int tile = bid_; tile < NT * MT; tile += gridDim.x) {
        const int tm = tile / NT, tn = tile % NT;
        const bf16_t* a0 = p.H + (size_t)(tm * 128 + STG_ROW(0)) * D + STG_K; const bf16_t* a1 = p.H + (size_t)(tm * 128 + STG_ROW(1)) * D + STG_K;
        const bf16_t* b0 = p.win_t + (size_t)(tn * 128 + STG_ROW(0)) * D + STG_K; const bf16_t* b1 = p.win_t + (size_t)(tn * 128 + STG_ROW(1)) * D + STG_K;
        gemm_tile(a0, a1, b0, b1, D, lds, [&](const f32x4 (&acc)[4][4], int wr, int wc, int fr, int fq) {
            if (tn < ZVB / 128 && tm < TL / 128) {
#pragma unroll
                for (int m = 0; m < 4; ++m)
#pragma unroll
                    for (int j = 0; j < 4; ++j) { const int row = tm * 128 + wr * 64 + m * 16 + fq * 4 + j, t = row % S;
                        bf16_t* zr = p.Z + (size_t)row * ZP + tn * 128 + wc * 64 + fr;
#pragma unroll
                        for (int ax = 0; ax < 2; ++ax) { const int pos = ax ? t % GRID_W : t / GRID_W; const float cs = p.rope[pos * 16 + fr], sn = p.rope[1024 + pos * 16 + fr];
                            const float x0 = acc[m][2 * ax][j], x1 = acc[m][2 * ax + 1][j];
                            zr[32 * ax] = f2bf(x0 * cs - x1 * sn); zr[32 * ax + 16] = f2bf(x1 * cs + x0 * sn); } }
            } else {
#pragma unroll
            for (int m = 0; m < 4; ++m)
#pragma unroll
                for (int n = 0; n < 4; ++n) { const int col = tn * 128 + wc * 64 + n * 16 + fr;
                    if (col < ZP) {
#pragma unroll
                        for (int j = 0; j < 4; ++j) p.Z[(size_t)(tm * 128 + wr * 64 + m * 16 + fq * 4 + j) * ZP + col] = f2bf(acc[m][n][j]); } }
            }
            if (tn == ZVB / 128 || (tn >= ZVN / 128 && tn < ZA / 128)) {
#pragma unroll
                for (int m = 0; m < 4; ++m) { const int m0 = tm * 128 + wr * 64 + m * 16 + fq * 4; int b, u;
                    if (m0 < TL) { b = m0 / S; u = L + m0 % S; } else { b = (m0 - TL) / L; u = (m0 - TL) % L; }
#pragma unroll
                    for (int n = 0; n < 4; ++n) { const int col = tn * 128 + wc * 64 + n * 16 + fr;
                        const int hv = col < ZVN ? (col - ZVB) >> 6 : 2 + ((col - ZVN) >> 6), d = col < ZVN ? (col - ZVB) & 63 : (col - ZVN) & 63;
                        st_bf16x4(p.VT + ((size_t)(b * 8 + hv) * 64 + d) * PU + u, acc[m][n]); } }
            }
        });
    }
}
__device__ __forceinline__ void g_gemm_out(const Params& p, int nrows, char* lds) {
    const int tid_ = opq_tid(), bid_ = opq_bid(); (void)tid_; (void)bid_;
    constexpr int NT = D / 128; const int MT = nrows / 128;
    for (int tile = bid_; tile < NT * MT; tile += gridDim.x) {
        const int tm = tile / NT, tn = tile % NT;
        const bf16_t* a0 = p.MIX + (size_t)(tm * 128 + STG_ROW(0)) * DMIX + STG_K; const bf16_t* a1 = p.MIX + (size_t)(tm * 128 + STG_ROW(1)) * DMIX + STG_K;
        const bf16_t* b0 = p.wout_t + (size_t)(tn * 128 + STG_ROW(0)) * DMIX + STG_K; const bf16_t* b1 = p.wout_t + (size_t)(tn * 128 + STG_ROW(1)) * DMIX + STG_K;
        gemm_tile(a0, a1, b0, b1, DMIX, lds, [&](const f32x4 (&acc)[4][4], int wr, int wc, int fr, int fq) {
#pragma unroll
            for (int m = 0; m < 4; ++m)
#pragma unroll
                for (int n = 0; n < 4; ++n)
#pragma unroll
                    for (int j = 0; j < 4; ++j) p.O[(size_t)(tm * 128 + wr * 64 + m * 16 + fq * 4 + j) * D + tn * 128 + wc * 64 + n * 16 + fr] = acc[m][n][j];
        });
    }
}
__device__ __forceinline__ void g_moe1(const Params& p, int l, char* lds) {
    const int tid_ = opq_tid(), bid_ = opq_bid(); (void)tid_; (void)bid_;
    const int* cnt = p.cnt + l * NEXP; const int nrb = moe_blocks(cnt); constexpr int NT = 2 * DE / 128;
    for (int tile = bid_; tile < nrb * NT; tile += gridDim.x) {
        const int rb = tile / NT, tn = tile % NT, e = moe_block_expert(cnt, rb);
        const bf16_t* a0 = p.H + (size_t)p.slotTok[rb * 128 + STG_ROW(0)] * D + STG_K; const bf16_t* a1 = p.H + (size_t)p.slotTok[rb * 128 + STG_ROW(1)] * D + STG_K;
        const bf16_t* bw = p.wgu_t + (size_t)e * 2 * DE * D;
        const bf16_t* b0 = bw + (size_t)(tn * 128 + STG_ROW(0)) * D + STG_K; const bf16_t* b1 = bw + (size_t)(tn * 128 + STG_ROW(1)) * D + STG_K;
        gemm_tile(a0, a1, b0, b1, D, lds, [&](const f32x4 (&acc)[4][4], int wr, int wc, int fr, int fq) {
#pragma unroll
            for (int m = 0; m < 4; ++m)
#pragma unroll
                for (int n2 = 0; n2 < 2; ++n2) { const int col = tn * 64 + wc * 32 + n2 * 16 + fr;
#pragma unroll
                    for (int j = 0; j < 4; ++j) { const float g = acc[m][2 * n2][j], u = acc[m][2 * n2 + 1][j];
                        p.ACT[(size_t)(rb * 128 + wr * 64 + m * 16 + fq * 4 + j) * DE + col] = f2bf(g / (1.0f + __expf(-g)) * u); } }
        });
    }
}
__device__ __forceinline__ void g_moe2(const Params& p, int l, char* lds) {
    const int tid_ = opq_tid(), bid_ = opq_bid(); (void)tid_; (void)bid_;
    const int* cnt = p.cnt + l * NEXP; const int nrb = moe_blocks(cnt); constexpr int NT = D / 128;
    for (int tile = bid_; tile < nrb * NT; tile += gridDim.x) {
        const int rb = tile / NT, tn = tile % NT, e = moe_block_expert(cnt, rb);
        const bf16_t* a0 = p.ACT + (size_t)(rb * 128 + STG_ROW(0)) * DE + STG_K; const bf16_t* a1 = p.ACT + (size_t)(rb * 128 + STG_ROW(1)) * DE + STG_K;
        const bf16_t* bw = p.wd_t + (size_t)e * D * DE;
        const bf16_t* b0 = bw + (size_t)(tn * 128 + STG_ROW(0)) * DE + STG_K; const bf16_t* b1 = bw + (size_t)(tn * 128 + STG_ROW(1)) * DE + STG_K;
        gemm_tile(a0, a1, b0, b1, DE, lds, [&](const f32x4 (&acc)[4][4], int wr, int wc, int fr, int fq) {
#pragma unroll
            for (int m = 0; m < 4; ++m)
#pragma unroll
                for (int n = 0; n < 4; ++n)
#pragma unroll
                    for (int j = 0; j < 4; ++j) p.YS[(size_t)(rb * 128 + wr * 64 + m * 16 + fq * 4 + j) * D + tn * 128 + wc * 64 + n * 16 + fr] = acc[m][n][j];
        });
    }
}


constexpr int DV = D / 256;
static_assert(D % 256 == 0, "row phases hold a row as DV float4 per lane");
template <int CTRL> __device__ __forceinline__ float dppf(float v) { return __builtin_bit_cast(float, __builtin_amdgcn_update_dpp(0, __builtin_bit_cast(int, v), CTRL, 0xf, 0xf, true)); }
__device__ __forceinline__ float wave_sum(float v) {
    v += dppf<0xB1>(v); v += dppf<0x4E>(v); v += dppf<0x141>(v); v += dppf<0x140>(v);
    float a = v, b = v;
    asm volatile("s_nop 1\n\tv_permlane16_swap_b32 %0, %1" : "+v"(a), "+v"(b));
    v = a + b; a = v; b = v;
    asm volatile("s_nop 1\n\tv_permlane32_swap_b32 %0, %1" : "+v"(a), "+v"(b));
    return a + b;
}
__device__ __forceinline__ float sum8(float v) { v += dppf<0xB1>(v); v += dppf<0x4E>(v); v += dppf<0x141>(v); return v; }
__device__ __forceinline__ float sum4(f32x4 a) { return (a[0] + a[1]) + (a[2] + a[3]); }
#define LDS_WAIT() asm volatile("s_waitcnt lgkmcnt(0)" ::: "memory")

__device__ __forceinline__ void row_stats(const f32x4 (&v)[DV], float& mu, float& rstd) {
    float s = 0.f;
#pragma unroll
    for (int j = 0; j < DV; ++j) s += sum4(v[j]);
    mu = wave_sum(s) * (1.0f / D);
    float q = 0.f;
#pragma unroll
    for (int j = 0; j < DV; ++j) { const f32x4 d = v[j] - mu; q += sum4(d * d); }
    rstd = 1.0f / sqrtf(wave_sum(q) * (1.0f / D) + LN_EPS);
}

__device__ __forceinline__ void ph_lnmod_fast(const Params& p, int l) {
    const int tid_ = opq_tid(), bid_ = opq_bid(); (void)tid_; (void)bid_;
    const int lane = tid_ & 63, gw = bid_ * 4 + (tid_ >> 6), nw = gridDim.x * 4;
    for (int m = gw; m < T; m += nw) {
        const f32x4* xr = (const f32x4*)xrow_in(p, l, m) + lane; const f32x4* md = (const f32x4*)modrow(p, l, m) + lane;
        f32x4 v[DV];
#pragma unroll
        for (int j = 0; j < DV; ++j) v[j] = xr[64 * j];
        float mu, rstd; row_stats(v, mu, rstd);
#pragma unroll
        for (int j = 0; j < DV; ++j) { const f32x4 sh = md[64 * j], sc = md[D / 4 + 64 * j];
            st_bf16x4(p.H + (size_t)m * D + 4 * (lane + 64 * j), (v[j] - mu) * rstd * (sc + 1.0f) + sh); }
    }
}

__device__ __forceinline__ void ph_post_mixer_fast(const Params& p, int l, int nrows) {
    const int tid_ = opq_tid(), bid_ = opq_bid(); (void)tid_; (void)bid_;
    const int lane = tid_ & 63, gw = bid_ * 4 + (tid_ >> 6), nw = gridDim.x * 4;
    for (int m = gw; m < nrows; m += nw) {
        const f32x4* xr = (const f32x4*)xrow_in(p, l, m) + lane; const f32x4* md = (const f32x4*)modrow(p, l, m) + lane;
        const f32x4* orow = (const f32x4*)(p.O + (size_t)m * D) + lane;
        f32x4* x1 = (f32x4*)((m < TL) ? p.out + (size_t)m * D : p.XC + (size_t)(m - TL) * D) + lane;
        const f32x4* g1 = (const f32x4*)(p.ln1_g + (size_t)l * D) + lane; const f32x4* b1 = (const f32x4*)(p.ln1_b + (size_t)l * D) + lane;
        f32x4 v[DV];
#pragma unroll
        for (int j = 0; j < DV; ++j) v[j] = xr[64 * j] * ALPHA + md[2 * (D / 4) + 64 * j] * orow[64 * j];
        float mu, rstd; row_stats(v, mu, rstd);
#pragma unroll
        for (int j = 0; j < DV; ++j) { v[j] = (v[j] - mu) * rstd * g1[64 * j] + b1[64 * j]; x1[64 * j] = v[j]; }
        row_stats(v, mu, rstd);
#pragma unroll
        for (int j = 0; j < DV; ++j) {
            const f32x4 hv = (v[j] - mu) * rstd * (md[4 * (D / 4) + 64 * j] + 1.0f) + md[3 * (D / 4) + 64 * j];
            f32x4 hh, lo;
#pragma unroll
            for (int e = 0; e < 4; ++e) { hh[e] = bf2f(f2bf(hv[e])); lo[e] = hv[e] - hh[e]; }
            st_bf16x4(p.H + (size_t)m * D + 4 * (lane + 64 * j), hh);
            st_bf16x4(p.HLO + (size_t)m * D + 4 * (lane + 64 * j), lo);
        }
    }
}

__device__ __forceinline__ void g_router(const Params& p, int l, int nrows, char* lds) {
    const int tid_ = opq_tid(), bid_ = opq_bid(); (void)tid_; (void)bid_;
    const int MT = nrows / 128;
    for (int tm = bid_; tm < MT; tm += gridDim.x) {
        const bf16_t* a0 = p.H + (size_t)(tm * 128 + STG_ROW(0)) * D + STG_K; const bf16_t* a1 = p.H + (size_t)(tm * 128 + STG_ROW(1)) * D + STG_K;
        const bf16_t* b0 = p.wrt + (size_t)STG_ROW(0) * D + STG_K; const bf16_t* b1 = p.wrt + (size_t)STG_ROW(1) * D + STG_K;
        const size_t hl = (size_t)(p.HLO - p.H);
        f32x4 keep[4][4];
        gemm_tile(a0, a1, b0, b1, D, lds, [&](const f32x4 (&acc)[4][4], int, int, int, int) {
#pragma unroll
            for (int m = 0; m < 4; ++m)
#pragma unroll
                for (int n = 0; n < 4; ++n) keep[m][n] = acc[m][n]; }, 2, 0, (size_t)128 * D);
        gemm_tile(a0 + hl, a1 + hl, b0, b1, D, lds, [&](const f32x4 (&acc)[4][4], int wr, int wc, int fr, int fq) {
            if (wc == 0) {
#pragma unroll
                for (int m = 0; m < 4; ++m)
#pragma unroll
                    for (int n = 0; n < 3; ++n) { const int col = n * 16 + fr;
                        if (col < 36) {
#pragma unroll
                            for (int j = 0; j < 4; ++j) p.LG[(size_t)(tm * 128 + wr * 64 + m * 16 + fq * 4 + j) * 36 + col] = acc[m][n][j] + keep[m][n][j]; } }
            } });
        asm volatile("s_waitcnt vmcnt(0)" ::: "memory");
        __syncthreads();
        if (tid_ < 128) {
            const int m = tm * 128 + tid_; const float* lg = p.LG + (size_t)m * 36;
            float gl[4], el[32];
#pragma unroll
            for (int g = 0; g < 4; ++g) gl[g] = lg[g] + p.b_rg[l * 4 + g];
#pragma unroll
            for (int e = 0; e < 32; ++e) el[e] = lg[4 + e] + p.b_re[l * 32 + e];
            int gs = 0; float gm = gl[0];
#pragma unroll
            for (int g = 1; g < 4; ++g) if (gl[g] > gm) { gm = gl[g]; gs = g; }
            float den = 0.f;
#pragma unroll
            for (int g = 0; g < 4; ++g) den += expf(gl[g] - gm);
            const float pg = 1.0f / den;
            float v1 = -3e38f, v2 = -3e38f; int i1 = 0, i2 = 0;
#pragma unroll
            for (int j = 0; j < 8; ++j) {
                const float vv = gs == 0 ? el[j] : gs == 1 ? el[8 + j] : gs == 2 ? el[16 + j] : el[24 + j];
                if (vv > v1) { v2 = v1; i2 = i1; v1 = vv; i1 = j; } else if (vv > v2) { v2 = vv; i2 = j; }
            }
            const float e2 = expf(v2 - v1), w1 = pg / (1.0f + e2), w2 = pg * e2 / (1.0f + e2);
            const int ea = gs * 8 + i1, eb = gs * 8 + i2;
            p.rE[2 * m] = ea; p.rE[2 * m + 1] = eb; p.rW[2 * m] = w1; p.rW[2 * m + 1] = w2;
            p.rPos[2 * m] = atomicAdd(p.cnt + l * NEXP + ea, 1); p.rPos[2 * m + 1] = atomicAdd(p.cnt + l * NEXP + eb, 1);
        }
        __syncthreads();
    }
}

__device__ __forceinline__ void ph_final_fast(const Params& p, int l, int nrows) {
    const int tid_ = opq_tid(), bid_ = opq_bid(); (void)tid_; (void)bid_;
    const int lane = tid_ & 63, gw = bid_ * 4 + (tid_ >> 6), nw = gridDim.x * 4;
    for (int m = gw; m < nrows; m += nw) {
        f32x4* x1 = (f32x4*)((m < TL) ? p.out + (size_t)m * D : p.XC + (size_t)(m - TL) * D) + lane;
        const f32x4* md = (const f32x4*)modrow(p, l, m) + lane;
        const f32x4* ya = (const f32x4*)(p.YS + (size_t)p.rSlot[2 * m] * D) + lane; const f32x4* yb = (const f32x4*)(p.YS + (size_t)p.rSlot[2 * m + 1] * D) + lane;
        const float wa = p.rW[2 * m], wb = p.rW[2 * m + 1];
        const f32x4* g2 = (const f32x4*)(p.ln2_g + (size_t)l * D) + lane; const f32x4* b2 = (const f32x4*)(p.ln2_b + (size_t)l * D) + lane;
        f32x4 v[DV];
#pragma unroll
        for (int j = 0; j < DV; ++j) v[j] = x1[64 * j] * ALPHA + md[5 * (D / 4) + 64 * j] * (ya[64 * j] * wa + yb[64 * j] * wb);
        float mu, rstd; row_stats(v, mu, rstd);
#pragma unroll
        for (int j = 0; j < DV; ++j) x1[64 * j] = (v[j] - mu) * rstd * g2[64 * j] + b2[64 * j];
    }
}

__device__ __forceinline__ void ph_mod_fast(const Params& p, char* lds) {
    const int tid_ = opq_tid(), bid_ = opq_bid(); (void)tid_; (void)bid_;
    constexpr int NR = NB + 1, NTASK = 2 * (6 * D / 64);
    if (bid_ >= NTASK) return;
    float* sc = (float*)lds;
    float* part = sc + NR * D;
    for (int i = tid_; i < NR * D; i += 256) { const int b = i / D, k = i % D; const float cv = b < NB ? p.c[(size_t)b * D + k] : p.c_ctx[k]; sc[i] = cv / (1.0f + __expf(-cv)); }
    __syncthreads();
    const int lane = tid_ & 63, wid = tid_ >> 6;
    for (int task = bid_; task < NTASK; task += gridDim.x) {
        const int ll = task / (6 * D / 64), col = 64 * (task % (6 * D / 64)) + lane;
        float acc[NR];
#pragma unroll
        for (int b = 0; b < NR; ++b) acc[b] = 0.f;
        const float* wp = p.w_mod + ((size_t)ll * D + wid * (D / 4)) * 6 * D + col;
#pragma unroll 4
        for (int k = 0; k < D / 4; ++k) { const float w = wp[(size_t)k * 6 * D];
#pragma unroll
            for (int b = 0; b < NR; ++b) acc[b] += sc[b * D + wid * (D / 4) + k] * w; }
#pragma unroll
        for (int b = 0; b < NR; ++b) part[(wid * NR + b) * 64 + lane] = acc[b];
        __syncthreads();
        for (int i = tid_; i < NR * 64; i += 256) { const int b = i / 64, cl = i % 64;
            p.mod[((size_t)ll * NR + b) * 6 * D + 64 * (task % (6 * D / 64)) + cl] = (part[(0 * NR + b) * 64 + cl] + part[(1 * NR + b) * 64 + cl]) + (part[(2 * NR + b) * 64 + cl] + part[(3 * NR + b) * 64 + cl]) + p.b_mod[(size_t)ll * 6 * D + 64 * (task % (6 * D / 64)) + cl]; }
        __syncthreads();
    }
}

__device__ __forceinline__ void tr_item(const float* srcl, size_t ldw, bf16_t* dst, size_t ldd, float* scr, int lane) {
#pragma unroll 8
    for (int i = 0; i < 32; ++i) { const int kk = 2 * i + (lane >> 5); scr[kk * 33 + (lane & 31)] = srcl ? srcl[(size_t)kk * ldw] : 0.f; }
    LDS_WAIT();
    const int c = lane & 7;
#pragma unroll
    for (int j = 0; j < 4; ++j) { const int n = (lane >> 3) + 8 * j; const float* s = scr + (8 * c) * 33 + n;
        uint4 o; o.x = pk2(s[0], s[33]); o.y = pk2(s[2 * 33], s[3 * 33]); o.z = pk2(s[4 * 33], s[5 * 33]); o.w = pk2(s[6 * 33], s[7 * 33]);
        *(uint4*)(dst + (size_t)n * ldd + 8 * c) = o; }
    LDS_WAIT();
}
__device__ __forceinline__ void ph_prep_w_fast(const Params& p, int l, int part, char* lds) {
    const int tid_ = opq_tid(), bid_ = opq_bid(); (void)tid_; (void)bid_;
    const int lane = tid_ & 63, wid = tid_ >> 6, gw = bid_ * 4 + wid, nw = gridDim.x * 4;
    float* scr = (float*)(lds + wid * 8448);
    constexpr int I_IN = (D / 64) * (NINP / 32), I_OUT = (DMIX / 64) * (D / 32), I_GU1 = (D / 64) * (2 * DE / 32), I_D1 = (DE / 64) * (D / 32);
    constexpr int NITEMS = I_IN + I_OUT + NEXP * (I_GU1 + I_D1);
    const int it0 = part == 0 ? 0 : I_IN + I_OUT, it1 = part == 0 ? I_IN + I_OUT : NITEMS;
    for (int it = it0 + gw; it < it1; it += nw) {
        int r = it;
        if (r < I_IN) { const int kb = r / (NINP / 32), n0 = 32 * (r % (NINP / 32));
            const float* s = nullptr;
            if (n0 < N_IN) { const int oc = (n0 < ZA) ? n0 + A_IN : n0 - ZA; s = p.w_in + ((size_t)l * D + 64 * kb) * N_IN + oc + (lane & 31); }
            tr_item(s, N_IN, p.win_t + (size_t)n0 * D + 64 * kb, D, scr, lane); continue; }
        r -= I_IN;
        if (r < I_OUT) { const int kb = r / (D / 32), n0 = 32 * (r % (D / 32));
            tr_item(p.w_out + ((size_t)l * DMIX + 64 * kb) * D + n0 + (lane & 31), D, p.wout_t + (size_t)n0 * DMIX + 64 * kb, DMIX, scr, lane); continue; }
        r -= I_OUT;
        const int e = r / (I_GU1 + I_D1); r %= (I_GU1 + I_D1);
        if (r < I_GU1) { const int kb = r / (2 * DE / 32), q = r % (2 * DE / 32);
            const float* s = (((lane & 31) >> 4) ? p.w_up : p.w_gate) + (((size_t)l * NEXP + e) * D + 64 * kb) * DE + 16 * q + (lane & 15);
            tr_item(s, DE, p.wgu_t + ((size_t)e * 2 * DE + 32 * q) * D + 64 * kb, D, scr, lane); continue; }
        r -= I_GU1;
        { const int kb = r / (D / 32), n0 = 32 * (r % (D / 32));
            tr_item(p.w_down + (((size_t)l * NEXP + e) * DE + 64 * kb) * D + n0 + (lane & 31), D, p.wd_t + ((size_t)e * D + n0) * DE + 64 * kb, DE, scr, lane); }
    }
    if (part != 0) return;
    const long gt = (long)bid_ * blockDim.x + tid_, gs = (long)gridDim.x * blockDim.x;
    for (long i = gt; i < 2 * 256 * 64; i += gs) { const int k = (int)(i & 63), n = (int)((i >> 6) & 255), d = (int)(i >> 14);
        p.wupT[i] = f2bf(p.a_w_up[(((size_t)l * 2 + d) * 64 + k) * DA + n]); p.aupT[i] = f2bf(p.a_a_up[(((size_t)l * 2 + d) * 64 + k) * DA + n]); }
    for (long i = gt; i < 256 * 160; i += gs) { const int k = (int)(i % 160), n = (int)(i / 160); p.gupT[i] = f2bf(p.a_g_up[((size_t)l * 160 + k) * DA + n]); }
    for (long i = gt; i < (long)128 * D; i += gs) { const int n = (int)(i / D), k = (int)(i % D);
        const float w = n < 4 ? p.w_rg[((size_t)l * D + k) * 4 + n] : n < 36 ? p.w_re[((size_t)l * D + k) * 32 + n - 4] : 0.f;
        const bf16_t hb = f2bf(w); p.wrt[i] = hb; p.wrt[(size_t)128 * D + i] = f2bf(w - bf2f(hb)); }
}

__device__ __forceinline__ float tanh_fast(float x) { return 1.0f - 2.0f / (1.0f + __expf(2.0f * x)); }
__device__ __forceinline__ void ph_streams_s1(const Params& p, int l) {
    const int tid_ = opq_tid(), bid_ = opq_bid(); (void)tid_; (void)bid_;
    constexpr int NCH = A_IN / 8, NCHP = (NCH + 7) & ~7;
    const float* sh = p.a_shift + (size_t)l * 3 * A_IN;
    for (long it = (long)bid_ * 256 + tid_; it < (long)T * NCHP; it += (long)gridDim.x * 256) {
        const int m = (int)(it / NCHP), ch = (int)(it % NCHP), c0 = 8 * ch;
        const bool act = ch < NCH;
        int t, len;
        if (m < TL) { t = m % S; len = S; } else { t = (m - TL) % L; len = L; }
        float v[8];
#pragma unroll
        for (int e = 0; e < 8; ++e) v[e] = 0.f;
        if (act) {
            const bf16_t* z = p.Z + (size_t)m * ZP + ZA + c0;
            const bf16x8 zc = *(const bf16x8*)z;
            const f32x4 s1a = *(const f32x4*)(sh + A_IN + c0), s1b = *(const f32x4*)(sh + A_IN + c0 + 4);
#pragma unroll
            for (int e = 0; e < 8; ++e) v[e] = (e < 4 ? s1a[e] : s1b[e - 4]) * bf2f((bf16_t)zc[e]);
            if (t > 0) { const bf16x8 zp = *(const bf16x8*)(z - ZP); const f32x4 a = *(const f32x4*)(sh + c0), b = *(const f32x4*)(sh + c0 + 4);
#pragma unroll
                for (int e = 0; e < 8; ++e) v[e] += (e < 4 ? a[e] : b[e - 4]) * bf2f((bf16_t)zp[e]); }
            if (t < len - 1) { const bf16x8 zn = *(const bf16x8*)(z + ZP); const f32x4 a = *(const f32x4*)(sh + 2 * A_IN + c0), b = *(const f32x4*)(sh + 2 * A_IN + c0 + 4);
#pragma unroll
                for (int e = 0; e < 8; ++e) v[e] += (e < 4 ? a[e] : b[e - 4]) * bf2f((bf16_t)zn[e]); }
        }
        float nrm = 0.f;
        if (ch >= 32 && ch < 64) {
#pragma unroll
            for (int e = 0; e < 8; ++e) { const float t2 = v[e] * p.a_k_k[l * DA + c0 - 256 + e]; nrm += t2 * t2; } }
        nrm = sum8(nrm);
        if (!act) continue;
        if (c0 < 768) {
            float* dst = (c0 < 256 ? p.sR + (size_t)m * DA + c0 : c0 < 512 ? p.kT + (size_t)m * DA + c0 - 256 : p.sV + (size_t)m * DA + c0 - 512);
            *(f32x4*)dst = (f32x4){v[0], v[1], v[2], v[3]}; *(f32x4*)(dst + 4) = (f32x4){v[4], v[5], v[6], v[7]};
            if (ch >= 32 && ch < 64 && (ch & 7) == 0) p.kN[(size_t)m * 4 + ((ch - 32) >> 3)] = 1.0f / sqrtf(nrm + 1e-12f);
        } else {
            if (c0 < 896) {
#pragma unroll
                for (int e = 0; e < 8; ++e) v[e] = tanh_fast(v[e]); }
            else if (c0 >= 1024) {
#pragma unroll
                for (int e = 0; e < 8; ++e) v[e] = 1.0f / (1.0f + __expf(-v[e])); }
            uint4 o; o.x = pk2(v[0], v[1]); o.y = pk2(v[2], v[3]); o.z = pk2(v[4], v[5]); o.w = pk2(v[6], v[7]);
            *(uint4*)(p.LA + (size_t)m * 416 + c0 - 768) = o;
        }
    }
}
__device__ __forceinline__ void g_streams_s2(const Params& p, int l, char* lds) {
    const int tid_ = opq_tid(), bid_ = opq_bid(); (void)tid_; (void)bid_;
    constexpr int MT = T / 128;
    for (int job = bid_; job < 5 * MT * 2; job += gridDim.x) {
        const int type = job / (MT * 2), r = job % (MT * 2), tm = r >> 1, tn = r & 1;
        const int coff = type < 2 ? type * 64 : type < 4 ? 128 + (type - 2) * 64 : 256, K = type < 4 ? 64 : 160, d = type & 1;
        const bf16_t* Bt = type < 2 ? p.wupT + type * 256 * 64 : type < 4 ? p.aupT + (type - 2) * 256 * 64 : p.gupT;
        const bf16_t* a0 = p.LA + (size_t)(tm * 128 + STG_ROW(0)) * 416 + coff + STG_K; const bf16_t* a1 = p.LA + (size_t)(tm * 128 + STG_ROW(1)) * 416 + coff + STG_K;
        const bf16_t* b0 = Bt + (size_t)(tn * 128 + STG_ROW(0)) * K + STG_K; const bf16_t* b1 = Bt + (size_t)(tn * 128 + STG_ROW(1)) * K + STG_K;
        if (type < 2) gemm_tile(a0, a1, b0, b1, K, lds, [&](const f32x4 (&acc)[4][4], int wr, int wc, int fr, int fq) {
#pragma unroll
            for (int mi = 0; mi < 4; ++mi) {
#pragma unroll
                for (int n = 0; n < 4; ++n) { const int c = tn * 128 + wc * 64 + n * 16 + fr; const float w0 = p.a_w0[(l * 2 + d) * DA + c];
#pragma unroll
                    for (int j = 0; j < 4; ++j) { const int row = tm * 128 + wr * 64 + mi * 16 + fq * 4 + j;
                        const float e = __expf(-(w0 + acc[mi][n][j]));
                        p.sW[((size_t)d * T + row) * DA + c] = __expf(-0.60653065971f / (1.0f + e)); } }
                asm volatile("" ::: "memory"); }
        });
        else if (type < 4) gemm_tile(a0, a1, b0, b1, K, lds, [&](const f32x4 (&acc)[4][4], int wr, int wc, int fr, int fq) {
#pragma unroll
            for (int mi = 0; mi < 4; ++mi) {
#pragma unroll
                for (int n = 0; n < 4; ++n) { const int c = tn * 128 + wc * 64 + n * 16 + fr;
                    const float a0v = p.a_a0[(l * 2 + d) * DA + c], kkc = p.a_k_k[l * DA + c], kac = p.a_k_a[l * DA + c];
#pragma unroll
                    for (int j = 0; j < 4; ++j) { const int row = tm * 128 + wr * 64 + mi * 16 + fq * 4 + j;
                        const size_t o = (size_t)row * DA + c, od = ((size_t)d * T + row) * DA + c;
                        const float av = 1.0f / (1.0f + __expf(-(a0v + acc[mi][n][j]))); const float k = p.kT[o];
                        const float kk = k * kkc * p.kN[(size_t)row * 4 + (c >> 6)];
                        p.sKD[od] = k * (1.0f + (av - 1.0f) * kac); p.sB[od] = kk * av; if (d == 0) p.sKK[o] = kk; } }
                asm volatile("" ::: "memory"); }
        });
        else gemm_tile(a0, a1, b0, b1, K, lds, [&](const f32x4 (&acc)[4][4], int wr, int wc, int fr, int fq) {
#pragma unroll
            for (int mi = 0; mi < 4; ++mi)
#pragma unroll
                for (int n = 0; n < 4; ++n) { const int c = tn * 128 + wc * 64 + n * 16 + fr;
#pragma unroll
                    for (int j = 0; j < 4; ++j) p.sG[(size_t)(tm * 128 + wr * 64 + mi * 16 + fq * 4 + j) * DA + c] = acc[mi][n][j]; }
        });
    }
}


typedef float f32x16 __attribute__((ext_vector_type(16)));
typedef short s16x4 __attribute__((ext_vector_type(4)));
typedef unsigned u32x4_t __attribute__((ext_vector_type(4)));
typedef float f32x2_t __attribute__((ext_vector_type(2)));
typedef __bf16 bf16x2_t __attribute__((ext_vector_type(2)));
__device__ __forceinline__ unsigned cvtpk(float lo, float hi) { f32x2_t v = {lo, hi}; bf16x2_t b = __builtin_convertvector(v, bf16x2_t); return __builtin_bit_cast(unsigned, b); }
__device__ __forceinline__ int crow(int r, int hi) { return (r & 3) + 8 * (r >> 2) + 4 * hi; }

template <class MaskF>
__device__ __forceinline__ void attn_tile(const bf16x8 (&qf)[4], const bf16_t* krow, const bf16_t* vt0, const bf16_t* vt1, const MaskF& mask,
                                          float& m_run, float& l_run, f32x16& o0, f32x16& o1, int hi) {
    f32x16 s;
#pragma unroll
    for (int r = 0; r < 16; ++r) s[r] = 0.f;
#pragma unroll
    for (int ks = 0; ks < 4; ++ks) { const bf16x8 kf = *(const bf16x8*)(krow + 16 * ks); s = __builtin_amdgcn_mfma_f32_32x32x16_bf16(kf, qf[ks], s, 0, 0, 0); }
    float mx = -INFINITY;
#pragma unroll
    for (int r = 0; r < 16; ++r) { s[r] = mask(crow(r, hi), s[r] * ATT_SCALE); mx = fmaxf(mx, s[r]); }
    mx = fmaxf(mx, __shfl_xor(mx, 32));
    const float mn = fmaxf(m_run, mx), alpha = __expf(m_run - mn);
    m_run = mn;
    float ps = 0.f;
#pragma unroll
    for (int r = 0; r < 16; ++r) { s[r] = __expf(s[r] - mn); ps += s[r]; }
    l_run = l_run * alpha + ps;
#pragma unroll
    for (int r = 0; r < 16; ++r) { o0[r] *= alpha; o1[r] *= alpha; }
#pragma unroll
    for (int s2 = 0; s2 < 2; ++s2) {
        u32x4_t pw; pw[0] = cvtpk(s[8 * s2], s[8 * s2 + 1]); pw[1] = cvtpk(s[8 * s2 + 2], s[8 * s2 + 3]); pw[2] = cvtpk(s[8 * s2 + 4], s[8 * s2 + 5]); pw[3] = cvtpk(s[8 * s2 + 6], s[8 * s2 + 7]);
        const bf16x8 pb = __builtin_bit_cast(bf16x8, pw);
        const s16x4 a0 = *(const s16x4*)(vt0 + 16 * s2), a1 = *(const s16x4*)(vt0 + 16 * s2 + 8);
        const s16x4 c0 = *(const s16x4*)(vt1 + 16 * s2), c1 = *(const s16x4*)(vt1 + 16 * s2 + 8);
        o0 = __builtin_amdgcn_mfma_f32_32x32x16_bf16(__builtin_shufflevector(a0, a1, 0, 1, 2, 3, 4, 5, 6, 7), pb, o0, 0, 0, 0);
        o1 = __builtin_amdgcn_mfma_f32_32x32x16_bf16(__builtin_shufflevector(c0, c1, 0, 1, 2, 3, 4, 5, 6, 7), pb, o1, 0, 0, 0);
    }
}
struct NoMask { __device__ __forceinline__ float operator()(int, float v) const { return v; } };

__device__ __forceinline__ void ph_attn_mfma(const Params& p, int l, bool with_ctx) {
    const int tid_ = opq_tid(), bid_ = opq_bid(); (void)tid_; (void)bid_;
    const int lane = tid_ & 63, hi = lane >> 5, ql = lane & 31;
    const int gw = bid_ * 4 + (tid_ >> 6), nw = gridDim.x * 4;
    constexpr int NQT = S / 32, NCT = L / 32, N_LAT = NB * 6 * NQT, N_CTX = NB * 6 * NCT;
    const int ntask = 2 * N_LAT + (with_ctx ? 2 * N_CTX : 0);
    for (int task = gw; task < ntask; task += nw) {
        bool isC, isCtx; int r;
        if (task < N_LAT) { isC = true; isCtx = false; r = task; }
        else if (task < 2 * N_LAT) { isC = false; isCtx = false; r = task - N_LAT; }
        else { r = task - 2 * N_LAT; isCtx = true; isC = r >= N_CTX; if (isC) r -= N_CTX; }
        const int nqt = isCtx ? NCT : NQT, qt = r % nqt, h = (r / nqt) % 6, b = r / (nqt * 6);
        const int m = isCtx ? TL + b * L + 32 * qt + ql : b * S + 32 * qt + ql;
        const int qcol = isC ? ZQN + h * 64 : ZQB + h * 64, kcol = isC ? ZKN + h * 64 : ZKB + (h / 3) * 64, hv = isC ? 2 + h : h / 3;
        bf16x8 qf[4];
        { const bf16_t* qp = p.Z + (size_t)m * ZP + qcol + 8 * hi;
#pragma unroll
          for (int ks = 0; ks < 4; ++ks) qf[ks] = *(const bf16x8*)(qp + 16 * ks); }
        const bf16_t* kc0 = p.Z + (size_t)(TL + b * L + ql) * ZP + kcol + 8 * hi;
        const bf16_t* kl0 = p.Z + (size_t)(b * S + ql) * ZP + kcol + 8 * hi;
        const bf16_t* vt0 = p.VT + ((size_t)(b * 8 + hv) * 64 + ql) * PU + 4 * hi; const bf16_t* vt1 = vt0 + (size_t)32 * PU;
        f32x16 o0, o1;
#pragma unroll
        for (int rr = 0; rr < 16; ++rr) { o0[rr] = 0.f; o1[rr] = 0.f; }
        float m_run, l_run;
        if (isC) { m_run = -1e30f; l_run = 0.f; } else { m_run = p.b_sink[l * 6 + h]; l_run = hi == 0 ? 1.0f : 0.f; }
#pragma unroll 1
        for (int i = 0; i < NCT; ++i) attn_tile(qf, kc0 + (size_t)(32 * i) * ZP, vt0 + 32 * i, vt1 + 32 * i, NoMask(), m_run, l_run, o0, o1, hi);
        if (!isCtx) {
            if (!isC) {
#pragma unroll 1
                for (int jt = qt - 4; jt <= qt + 4; ++jt) {
                    if (jt < 0 || jt >= NQT) continue;
                    const bf16_t* kr = kl0 + (size_t)(32 * jt) * ZP; const bf16_t* v0 = vt0 + L + 32 * jt; const bf16_t* v1 = vt1 + L + 32 * jt;
                    if (jt == qt - 4 || jt == qt + 4) { const int base = 32 * (jt - qt) - ql;
                        attn_tile(qf, kr, v0, v1, [&](int ko, float v) { const int rel = base + ko; return (rel >= -128 && rel <= 128) ? v : -INFINITY; }, m_run, l_run, o0, o1, hi); }
                    else attn_tile(qf, kr, v0, v1, NoMask(), m_run, l_run, o0, o1, hi);
                }
            } else {
                constexpr int ROWS = S / GRID_W;
                const int gr = qt >> 1, c = 32 * (qt & 1) + ql;
                int r0 = gr - 4; r0 = r0 < 0 ? 0 : (r0 > ROWS - 8 ? ROWS - 8 : r0);
                int c0 = c - 8; c0 = c0 < 0 ? 0 : (c0 > GRID_W - 16 ? GRID_W - 16 : c0);
                const float* rpb = p.c_rpb + ((size_t)l * 6 + h) * 15 * 31;
#pragma unroll 1
                for (int a = 0; a < 8; ++a) {
                    const int kr_ = r0 + a; const float* rp = rpb + (kr_ - gr + 7) * 31 + 15 - c;
#pragma unroll 1
                    for (int ct = 0; ct < 2; ++ct) {
                        const int t0 = kr_ * GRID_W + 32 * ct;
                        attn_tile(qf, kl0 + (size_t)t0 * ZP, vt0 + L + t0, vt1 + L + t0,
                                  [&](int ko, float v) { const int kc = 32 * ct + ko; return (kc >= c0 && kc < c0 + 16) ? v + rp[kc] : -INFINITY; }, m_run, l_run, o0, o1, hi);
                    }
                }
            }
        }
        const float lt = l_run + __shfl_xor(l_run, 32), inv = 1.0f / lt;
        bf16_t* op = p.MIX + (size_t)m * DMIX + (isC ? 640 : 256) + h * 64 + 4 * hi;
#pragma unroll
        for (int g = 0; g < 4; ++g) {
            st_bf16x4(op + 8 * g, (f32x4){o0[4 * g] * inv, o0[4 * g + 1] * inv, o0[4 * g + 2] * inv, o0[4 * g + 3] * inv});
            st_bf16x4(op + 32 + 8 * g, (f32x4){o1[4 * g] * inv, o1[4 * g + 1] * inv, o1[4 * g + 2] * inv, o1[4 * g + 3] * inv});
        }
    }
}


#define RNB " row_newbcast:%c[n] row_mask:0xf bank_mask:0xf\n\t"
template <int N, bool FIRST>
__device__ __forceinline__ void dpp_dot4(float& a0, float& a1, float& a2, float& a3, const f32x4& v, float s0, float s1, float s2, float s3) {
    if (FIRST) asm volatile("s_nop 1");
    asm("v_fmac_f32_dpp %0, %4, %8" RNB "v_fmac_f32_dpp %1, %5, %9" RNB "v_fmac_f32_dpp %2, %6, %10" RNB "v_fmac_f32_dpp %3, %7, %11" RNB
        : "+v"(a0), "+v"(a1), "+v"(a2), "+v"(a3) : "v"(v[0]), "v"(v[1]), "v"(v[2]), "v"(v[3]), "v"(s0), "v"(s1), "v"(s2), "v"(s3), [n] "i"(N));
}
template <int N, bool FIRST>
__device__ __forceinline__ void dpp_upd4s(float& s0, float& s1, float& s2, float& s3, float& y0, float& y1, float& y2, float& y3,
                                          const f32x4& w, const f32x4& b, const f32x4& kd, const f32x4& r, float nsk, float vv) {
    if (FIRST) asm volatile("s_nop 1");
    asm("v_mul_f32_dpp %0, %8, %0" RNB "v_mul_f32_dpp %1, %9, %1" RNB "v_mul_f32_dpp %2, %10, %2" RNB "v_mul_f32_dpp %3, %11, %3" RNB
        "v_fmac_f32_dpp %0, %12, %24" RNB "v_fmac_f32_dpp %1, %13, %24" RNB "v_fmac_f32_dpp %2, %14, %24" RNB "v_fmac_f32_dpp %3, %15, %24" RNB
        "v_fmac_f32_dpp %0, %16, %25" RNB "v_fmac_f32_dpp %1, %17, %25" RNB "v_fmac_f32_dpp %2, %18, %25" RNB "v_fmac_f32_dpp %3, %19, %25" RNB
        "v_fmac_f32_dpp %4, %20, %0" RNB "v_fmac_f32_dpp %5, %21, %1" RNB "v_fmac_f32_dpp %6, %22, %2" RNB "v_fmac_f32_dpp %7, %23, %3" RNB
        : "+v"(s0), "+v"(s1), "+v"(s2), "+v"(s3), "+v"(y0), "+v"(y1), "+v"(y2), "+v"(y3)
        : "v"(w[0]), "v"(w[1]), "v"(w[2]), "v"(w[3]), "v"(b[0]), "v"(b[1]), "v"(b[2]), "v"(b[3]), "v"(kd[0]), "v"(kd[1]), "v"(kd[2]), "v"(kd[3]),
          "v"(r[0]), "v"(r[1]), "v"(r[2]), "v"(r[3]), "v"(nsk), "v"(vv), [n] "i"(N));
}
template <int N, bool FIRST>
__device__ __forceinline__ void dpp_upd4p(float& s0, float& s1, float& s2, float& s3, float& y0, float& y1, float& y2, float& y3,
                                          const f32x4& w, const f32x4& b, const f32x4& r, float nsk) {
    if (FIRST) asm volatile("s_nop 1");
    asm("v_mul_f32_dpp %0, %8, %0" RNB "v_mul_f32_dpp %1, %9, %1" RNB "v_mul_f32_dpp %2, %10, %2" RNB "v_mul_f32_dpp %3, %11, %3" RNB
        "v_fmac_f32_dpp %0, %12, %20" RNB "v_fmac_f32_dpp %1, %13, %20" RNB "v_fmac_f32_dpp %2, %14, %20" RNB "v_fmac_f32_dpp %3, %15, %20" RNB
        "v_fmac_f32_dpp %4, %16, %0" RNB "v_fmac_f32_dpp %5, %17, %1" RNB "v_fmac_f32_dpp %6, %18, %2" RNB "v_fmac_f32_dpp %7, %19, %3" RNB
        : "+v"(s0), "+v"(s1), "+v"(s2), "+v"(s3), "+v"(y0), "+v"(y1), "+v"(y2), "+v"(y3)
        : "v"(w[0]), "v"(w[1]), "v"(w[2]), "v"(w[3]), "v"(b[0]), "v"(b[1]), "v"(b[2]), "v"(b[3]), "v"(r[0]), "v"(r[1]), "v"(r[2]), "v"(r[3]), "v"(nsk), [n] "i"(N));
}
template <int N> struct ScanRep {
    static __device__ __forceinline__ void dot(float& a0, float& a1, float& a2, float& a3, const f32x4& v, const float (&st)[64]) {
        dpp_dot4<N, N == 0>(a0, a1, a2, a3, v, st[4 * N], st[4 * N + 1], st[4 * N + 2], st[4 * N + 3]);
        if constexpr (N < 15) ScanRep<N + 1>::dot(a0, a1, a2, a3, v, st);
    }
    static __device__ __forceinline__ void upds(float (&st)[64], float& y0, float& y1, float& y2, float& y3, const f32x4& w, const f32x4& b, const f32x4& kd, const f32x4& r, float nsk, float vv) {
        dpp_upd4s<N, N == 0>(st[4 * N], st[4 * N + 1], st[4 * N + 2], st[4 * N + 3], y0, y1, y2, y3, w, b, kd, r, nsk, vv);
        if constexpr (N < 15) ScanRep<N + 1>::upds(st, y0, y1, y2, y3, w, b, kd, r, nsk, vv);
    }
    static __device__ __forceinline__ void updp(float (&st)[64], float& y0, float& y1, float& y2, float& y3, const f32x4& w, const f32x4& b, const f32x4& r, float nsk) {
        dpp_upd4p<N, N == 0>(st[4 * N], st[4 * N + 1], st[4 * N + 2], st[4 * N + 3], y0, y1, y2, y3, w, b, r, nsk);
        if constexpr (N < 15) ScanRep<N + 1>::updp(st, y0, y1, y2, y3, w, b, r, nsk);
    }
};
__device__ __forceinline__ int seg_row0(int b, int d, int s) { const int pos0 = 128 * s; return pos0 < L ? TL + b * L + (d ? L - 1 - pos0 : pos0) : b * S + (d ? S - 1 - (pos0 - L) : pos0 - L); }

template <bool ISP>
__device__ __forceinline__ void scan_task(const Params& p, int c, int s, int lane) {
    const int h = c & 3, b = (c >> 2) % NB, d = (c >> 2) / NB;
    const int m0 = seg_row0(b, d, s); const long step = d ? -(long)DA : (long)DA;
    const size_t o = (size_t)m0 * DA + h * 64, od = ((size_t)d * T + m0) * DA + h * 64; const int q = 4 * (lane & 15);
    const float* pkk = p.sKK + o + q; const float* pr = p.sR + o + q; const float* pw = p.sW + od + q; const float* pb = p.sB + od + q;
    const float* pkd = p.sKD + od + q; const float* pv = p.sV + o + lane;
    float* py = (ISP ? p.PV : p.Y) + od + lane;
    float st[64];
#pragma unroll
    for (int k = 0; k < 64; ++k) st[k] = (ISP && k == lane) ? 1.0f : 0.f;
    f32x4 kk = *(const f32x4*)pkk, w = *(const f32x4*)pw, bb = *(const f32x4*)pb, r = *(const f32x4*)pr, kd = w; float vv = 0.f;
    if (!ISP) { kd = *(const f32x4*)pkd; vv = *pv; }
#pragma unroll 1
    for (int i = 0; i < 128; ++i) {
        const long nx = (i < 127) ? step : 0;
        pkk += nx; pw += nx; pb += nx; pr += nx; pkd += nx; pv += nx;
        const f32x4 nkk = *(const f32x4*)pkk, nw = *(const f32x4*)pw, nb = *(const f32x4*)pb, nr = *(const f32x4*)pr;
        f32x4 nkd = nw; float nv = 0.f;
        if (!ISP) { nkd = *(const f32x4*)pkd; nv = *pv; }
        float a0 = 0.f, a1 = 0.f, a2 = 0.f, a3 = 0.f;
        ScanRep<0>::dot(a0, a1, a2, a3, kk, st);
        const float nsk = -((a0 + a1) + (a2 + a3));
        float y0 = 0.f, y1 = 0.f, y2 = 0.f, y3 = 0.f;
        if (ISP) ScanRep<0>::updp(st, y0, y1, y2, y3, w, bb, r, nsk); else ScanRep<0>::upds(st, y0, y1, y2, y3, w, bb, kd, r, nsk, vv);
        *py = (y0 + y1) + (y2 + y3); py += step;
        kk = nkk; w = nw; bb = nb; r = nr; kd = nkd; vv = nv;
    }
    if (s < NSG - 1) {
        float* dst = (ISP ? p.PS : p.QS) + (((size_t)c * NSG + s) * 64 + lane) * 64;
#pragma unroll
        for (int k4 = 0; k4 < 16; ++k4) *(f32x4*)(dst + 4 * k4) = (f32x4){st[4 * k4], st[4 * k4 + 1], st[4 * k4 + 2], st[4 * k4 + 3]};
    }
}
__device__ __forceinline__ void ph_scan_fast(const Params& p) {
    const int tid_ = opq_tid(), bid_ = opq_bid(); (void)tid_; (void)bid_;
    const int lane = tid_ & 63, gw = bid_ * 4 + (tid_ >> 6), nw = gridDim.x * 4;
    constexpr int NS_T = 64 * NSG, NP_T = 64 * (NSG - 1);
    for (int tsk = gw; tsk < NS_T + NP_T; tsk += nw) {
        const int t2 = __builtin_amdgcn_readfirstlane(tsk);
        if (t2 < NS_T) scan_task<false>(p, t2 & 63, t2 >> 6, lane);
        else scan_task<true>(p, (t2 - NS_T) & 63, 1 + ((t2 - NS_T) >> 6), lane);
    }
}
__device__ __forceinline__ void ph_combine(const Params& p, char* lds) {
    const int tid_ = opq_tid(), bid_ = opq_bid(); (void)tid_; (void)bid_;
    if (bid_ >= 64) return;
    const int c = bid_, tid = tid_, v = tid >> 2, jq = tid & 3;
    float* SSc = (float*)lds; float* Pm = (float*)(lds + 64 * 65 * 4 + 16);
    const float* QSc = p.QS + (size_t)c * NSG * 4096; const float* PSc = p.PS + (size_t)c * NSG * 4096; float* SSg = p.SS + (size_t)c * NSG * 4096;
    f32x4 acc[4];
#pragma unroll
    for (int i = 0; i < 4; ++i) { acc[i] = *(const f32x4*)(QSc + v * 64 + 16 * jq + 4 * i); *(f32x4*)(SSg + 4096 + v * 64 + 16 * jq + 4 * i) = acc[i];
#pragma unroll
        for (int e = 0; e < 4; ++e) SSc[v * 65 + 16 * jq + 4 * i + e] = acc[i][e]; }
    for (int s = 1; s < NSG - 1; ++s) {
#pragma unroll
        for (int qq = 0; qq < 4; ++qq) ((f32x4*)Pm)[tid + 256 * qq] = ((const f32x4*)(PSc + (size_t)s * 4096))[tid + 256 * qq];
#pragma unroll
        for (int i = 0; i < 4; ++i) acc[i] = *(const f32x4*)(QSc + (size_t)s * 4096 + v * 64 + 16 * jq + 4 * i);
        __syncthreads();
#pragma unroll 8
        for (int k = 0; k < 64; ++k) { const float a = SSc[v * 65 + k];
#pragma unroll
            for (int i = 0; i < 4; ++i) acc[i] += ((const f32x4*)Pm)[k * 16 + 4 * jq + i] * a; }
        __syncthreads();
#pragma unroll
        for (int i = 0; i < 4; ++i) { *(f32x4*)(SSg + (size_t)(s + 1) * 4096 + v * 64 + 16 * jq + 4 * i) = acc[i];
#pragma unroll
            for (int e = 0; e < 4; ++e) SSc[v * 65 + 16 * jq + 4 * i + e] = acc[i][e]; }
        __syncthreads();
    }
}
__device__ __forceinline__ void ph_rwkv_out_fast(const Params& p, int l, bool with_ctx) {
    const int tid_ = opq_tid(), bid_ = opq_bid(); (void)tid_; (void)bid_;
    const int lane = tid_ & 63, gw = bid_ * 4 + (tid_ >> 6), nw = gridDim.x * 4;
    constexpr int TOK = 16, NLT = NB * (S / TOK) * 4, NCTK = NB * (L / TOK) * 4;
    const int ntask = NLT + (with_ctx ? NCTK : 0);
    for (int tsk = gw; tsk < ntask; tsk += nw) {
        const bool isCtx = tsk >= NLT; const int r = isCtx ? tsk - NLT : tsk;
        const int h = r & 3, npt = isCtx ? L / TOK : S / TOK, tt = (r >> 2) % npt, b = (r >> 2) / npt, t128 = tt / (128 / TOK);
        const int seg0 = isCtx ? t128 : L / 128 + t128, seg1 = isCtx ? (L / 128 - 1) - t128 : L / 128 + (S / 128 - 1) - t128;
        const int mbase = isCtx ? TL + b * L + TOK * tt : b * S + TOK * tt;
        float ss0[64], ss1[64];
        { const float* s0p = p.SS + ((((size_t)(0 * NB + b) * 4 + h) * NSG + seg0) * 64 + lane) * 64; const float* s1p = p.SS + ((((size_t)(1 * NB + b) * 4 + h) * NSG + seg1) * 64 + lane) * 64;
#pragma unroll
          for (int k4 = 0; k4 < 16; ++k4) { f32x4 a = {0.f, 0.f, 0.f, 0.f}, c2 = a; if (seg0 > 0) a = *(const f32x4*)(s0p + 4 * k4); if (seg1 > 0) c2 = *(const f32x4*)(s1p + 4 * k4);
#pragma unroll
              for (int e = 0; e < 4; ++e) { ss0[4 * k4 + e] = a[e]; ss1[4 * k4 + e] = c2[e]; } } }
        const float rk = p.a_r_k[l * DA + h * 64 + lane], gln = p.a_lnx_g[l * DA + h * 64 + lane], bln = p.a_lnx_b[l * DA + h * 64 + lane];
#pragma unroll 2
        for (int i = 0; i < TOK; ++i) {
            const size_t o = (size_t)(mbase + i) * DA + h * 64, o1 = o + (size_t)T * DA;
            f32x4 pv0 = {0.f, 0.f, 0.f, 0.f}, pv1 = pv0;
            if (seg0 > 0) pv0 = *(const f32x4*)(p.PV + o + 4 * (lane & 15));
            if (seg1 > 0) pv1 = *(const f32x4*)(p.PV + o1 + 4 * (lane & 15));
            float a0 = p.Y[o + lane], a1 = p.Y[o1 + lane], a2 = 0.f, a3 = 0.f;
            const float rr = p.sR[o + lane], kds = p.sKD[o + lane] + p.sKD[o1 + lane], vv = p.sV[o + lane], gg = p.sG[o + lane];
            ScanRep<0>::dot(a0, a1, a2, a3, pv0, ss0);
            ScanRep<0>::dot(a0, a1, a2, a3, pv1, ss1);
            const float y = (a0 + a1) + (a2 + a3);
            const float mu = wave_sum(y) * (1.0f / 64.f), dy = y - mu;
            const float rstd = 1.0f / sqrtf(wave_sum(dy * dy) * (1.0f / 64.f) + GN_EPS);
            const float bon = wave_sum(rr * kds * rk);
            p.MIX[(size_t)(mbase + i) * DMIX + h * 64 + lane] = f2bf((dy * rstd * gln + bln + bon * vv) * gg);
        }
    }
}


#define LAS __attribute__((address_space(3)))
#define XB_TMO      128
#define XB_XCNT(j)  (256  + 64 * (j))
#define XB_XSUB(j)  (1280 + 64 * (j))
#define XB_XGEN(j)  (2304 + 64 * (j))
#define XB_TOP      3328
#define XB_TOPGEN   3392
#define XCD_BAR_WORDS 3456
#define XB_SPIN_CAP (1u << 20)
static_assert(XCD_BAR_WORDS * 4 <= 16384, "barrier words fit the control region");
__device__ __forceinline__ unsigned xb_ld(unsigned* p)              { return __hip_atomic_load(p, __ATOMIC_RELAXED, __HIP_MEMORY_SCOPE_AGENT); }
__device__ __forceinline__ unsigned xb_add(unsigned* p, unsigned v) { return __hip_atomic_fetch_add(p, v, __ATOMIC_RELAXED, __HIP_MEMORY_SCOPE_AGENT); }
__device__ __forceinline__ unsigned xb_xcc_id() { return (unsigned)__builtin_amdgcn_s_getreg((3 << 11) | 20) & 0xFu; }
#define XB_SPIN(cond, bar) do { unsigned _sp = 0; while (cond) { __builtin_amdgcn_s_sleep(1); \
    if ((++_sp & 255u) == 0u) { if (xb_ld(&(bar)[XB_TMO])) break; if (_sp > XB_SPIN_CAP) { atomicAdd(&(bar)[XB_TMO], 1u); break; } } } } while (0)
struct XcdBarrier { unsigned* bar; unsigned x; volatile LAS unsigned* st; };
__device__ __forceinline__ XcdBarrier xcd_barrier_post(unsigned* bar, volatile LAS unsigned* st) {
    XcdBarrier b; b.bar = bar; b.x = xb_xcc_id(); b.st = st;
    if (threadIdx.x == 0) (void)xb_add(&bar[XB_XCNT(b.x)], 1u);
    return b;
}
__device__ __forceinline__ void xcd_barrier_complete(unsigned* bar, unsigned x, unsigned& nloc, unsigned& nx) {
    const unsigned G = gridDim.x * gridDim.y * gridDim.z;
    unsigned sum, cnt, mine, sp = 0u;
    for (;;) {
        sum = 0u; cnt = 0u; mine = 0u;
#pragma unroll
        for (unsigned j = 0; j < 16; ++j) { const unsigned c = xb_ld(&bar[XB_XCNT(j)]); sum += c; cnt += (c > 0u) ? 1u : 0u; mine = (j == x) ? c : mine; }
        if (sum == G) break;
        __builtin_amdgcn_s_sleep(1);
        if ((++sp & 255u) == 0u) { if (xb_ld(&bar[XB_TMO])) break; if (sp > XB_SPIN_CAP) { atomicAdd(&bar[XB_TMO], 1u); break; } }
    }
    nloc = mine > 0u ? mine : 1u; nx = cnt > 0u ? cnt : 1u;
}
__device__ __forceinline__ void xcd_barrier(const XcdBarrier& b) {
    asm volatile("s_waitcnt vmcnt(0)" ::: "memory");
    __syncthreads();
    if (threadIdx.x == 0) {
        unsigned* bar = b.bar;
        __builtin_amdgcn_s_waitcnt(0);
        unsigned nloc = b.st[0], nx = b.st[1];
        if (nloc == 0u) { xcd_barrier_complete(bar, b.x, nloc, nx); b.st[0] = nloc; b.st[1] = nx; }
        const unsigned old = xb_add(&bar[XB_XSUB(b.x)], 1u);
        const unsigned gen = old / nloc;
        if (old + 1u == (gen + 1u) * nloc) {
            __builtin_amdgcn_fence(__ATOMIC_RELEASE, "agent");
            asm volatile("s_waitcnt vmcnt(0)" ::: "memory");
            const unsigned og = xb_add(&bar[XB_TOP], 1u);
            const unsigned tg = og / nx;
            if (og + 1u == (tg + 1u) * nx) xb_add(&bar[XB_TOPGEN], 1u);
            else XB_SPIN(xb_ld(&bar[XB_TOPGEN]) == tg, bar);
            __builtin_amdgcn_fence(__ATOMIC_ACQUIRE, "agent");
            xb_add(&bar[XB_XGEN(b.x)], 1u);
            asm volatile("s_waitcnt vmcnt(0)" ::: "memory");
        } else {
            XB_SPIN(xb_ld(&bar[XB_XGEN(b.x)]) == gen, bar);
            __builtin_amdgcn_fence(__ATOMIC_ACQUIRE, "agent");
            asm volatile("s_waitcnt vmcnt(0)" ::: "memory");
        }
    }
    __syncthreads();
}

#define GT ((long)blockIdx.x * blockDim.x + threadIdx.x)
#define GS ((long)gridDim.x * blockDim.x)
__global__ void __launch_bounds__(256, 2) mega_fwd(Params p) {
    __shared__ __attribute__((aligned(16))) char lds[49152 + 64];
    cg::grid_group grid = cg::this_grid();
    const long gt = GT, gs = GS;
    volatile LAS unsigned* bst = (volatile LAS unsigned*)(LAS char*)(lds + 49152);
    if (threadIdx.x < 2) bst[threadIdx.x] = 0u;
    __syncthreads();
    const XcdBarrier xb = xcd_barrier_post(p.bar, bst);
#ifndef PROBE_PHASE
#define PROBE_PHASE -1
#endif
#define PROBE_AMP 8
    unsigned long long t_prev = 0; int nts = 0;
#define STAMP() do { if (PROBE_PHASE >= 0 && blockIdx.x == 0 && threadIdx.x == 0) { const unsigned long long t_now = __builtin_amdgcn_s_memrealtime(); \
        if (nts == PROBE_PHASE + 1) { const unsigned long long t_end = t_now + PROBE_AMP * (t_now - t_prev); while (__builtin_amdgcn_s_memrealtime() < t_end) __builtin_amdgcn_s_sleep(8); } \
        t_prev = __builtin_amdgcn_s_memrealtime(); } ++nts; } while (0)
#define GSYNC() do { xcd_barrier(xb); STAMP(); } while (0)
    STAMP();
    ph_mod_fast(p, lds); ph_prep_w_fast(p, 0, 0, lds); ph_prep_misc(p, 0, gt, gs, false);
    grid.sync(); STAMP();
    for (int l = 0; l < 2; ++l) {
        const int nrows = (l == 0) ? T : TL;
        ph_lnmod_fast(p, l);
        GSYNC();
        g_gemm_in(p, lds);
        GSYNC();
        ph_streams_s1(p, l);
        GSYNC();
        g_streams_s2(p, l, lds);
        GSYNC();
        ph_scan_fast(p);
        GSYNC();
        ph_combine(p, lds); ph_attn_mfma(p, l, l == 0);
        GSYNC();
        ph_rwkv_out_fast(p, l, l == 0);
        GSYNC();
        g_gemm_out(p, nrows, lds); ph_prep_w_fast(p, l, 1, lds);
        GSYNC();
        ph_post_mixer_fast(p, l, nrows);
        GSYNC();
        g_router(p, l, nrows, lds);
        GSYNC();
        ph_dispatch(p, l, nrows, gt, gs);
        GSYNC();
        g_moe1(p, l, lds);
        GSYNC();
        g_moe2(p, l, lds);
        GSYNC();
        ph_final_fast(p, l, nrows);
        if (l == 0) { ph_prep_w_fast(p, 1, 0, lds); ph_prep_misc(p, 1, gt, gs, false); }
        GSYNC();
    }}

extern "C" void kernel_launch(void* const* d_in, const int* in_sizes, int n_in, void* d_out, int out_size, void* d_ws, size_t ws_size, hipStream_t stream) {
    if (n_in != 32 || out_size != TL * D || ws_size < WS_NEED) { fprintf(stderr, "kernel_launch: unexpected shapes / workspace (n_in %d out %d ws %zu need %zu)\n", n_in, out_size, ws_size, (size_t)WS_NEED); return; }
    static int grid_blocks = 0;
    if (!grid_blocks) {
        int dev = 0, cus = 0, per_cu = 0;
        (void)hipGetDevice(&dev);
        (void)hipDeviceGetAttribute(&cus, hipDeviceAttributeMultiprocessorCount, dev);
        (void)hipOccupancyMaxActiveBlocksPerMultiprocessor(&per_cu, mega_fwd, 256, 0);
        if (per_cu < 1) per_cu = 1;
        if (per_cu > 2) per_cu = 2;
        grid_blocks = cus * per_cu;
        fprintf(stderr, "kernel_launch: %d CUs x %d blocks\n", cus, per_cu);
    }
    Params p = make_params(d_in, d_out, d_ws);
    (void)hipMemsetAsync(d_ws, 0, CTL_BYTES, stream);
    void* args[] = {&p};
    hipError_t e = hipLaunchCooperativeKernel((void*)mega_fwd, dim3(grid_blocks), dim3(256), args, 0, stream);
    if (e != hipSuccess) fprintf(stderr, "cooperative launch failed: %s (grid %d)\n", hipGetErrorString(e), grid_blocks);
}
#endif

#ifdef HOST_EMU
static void host_forward(void* const* d_in, void* d_out, void* d_ws) {
    const Params p = make_params(d_in, d_out, d_ws);
    for (int l = 0; l < 2; ++l) {
        const int nrows = (l == 0) ? T : TL;
        ph_prep_w(p, l, 0, 1); ph_prep_misc(p, l, 0, 1); ph_lnmod(p, l, 0, 1); host_gemm_in(p); ph_streams(p, l, 0, 1); ph_rope(p, 0, 1); ph_scan(p, 0, 1);
        ph_attn(p, l, nrows, 0, 1); ph_rwkv_out(p, l, nrows, 0, 1); host_gemm_out(p, nrows); ph_post_mixer(p, l, nrows, 0, 1);
        ph_dispatch(p, l, nrows, 0, 1); host_moe1(p, l); host_moe2(p, l); ph_final(p, l, nrows, 0, 1);
    }
}
#endif
```

```cpp
#ifdef HOST_EMU
#include <cmath>
#include <cstdio>
#include <cstring>
#include <cstdint>
#include <cstdlib>
#define __device__
#define __global__
#define __host__
#define __forceinline__ inline
#else
#include <hip/hip_runtime.h>
#include <hip/hip_cooperative_groups.h>
#include <cstdio>
#include <cstdint>
namespace cg = cooperative_groups;
#endif

#ifndef CFG_D
#define CFG_D 1024
#define CFG_B 8
#define CFG_S 2048
#define CFG_L 256
#define CFG_DE 512
#endif
constexpr int D = CFG_D, NB = CFG_B, S = CFG_S, L = CFG_L, DE = CFG_DE;
constexpr int TL = NB * S, TC = NB * L, T = TL + TC;
constexpr int GRID_W = 64, HD = 64;
constexpr int DA = 256, A_IN = 1184, N_IN = 2976, NINP = 3072, DMIX = 1024;
constexpr int NEXP = 32, NSLOT = 2 * T + NEXP * 128;
constexpr int ZQB = 0, ZKB = 384, ZVB = 512, ZQN = 640, ZKN = 1024, ZVN = 1408, ZA = 1792, ZP = 2976;
constexpr float LN_EPS = 1e-6f, GN_EPS = 64e-5f, ATT_SCALE = 0.125f;
constexpr float ALPHA = 1.41421356237309515f;

typedef unsigned short bf16_t;

__device__ __forceinline__ float bf2f(bf16_t v) {
    unsigned u = ((unsigned)v) << 16; float f;
#ifdef HOST_EMU
    memcpy(&f, &u, 4);
#else
    f = __uint_as_float(u);
#endif
    return f;
}
__device__ __forceinline__ bf16_t f2bf(float f) {
    unsigned u;
#ifdef HOST_EMU
    memcpy(&u, &f, 4);
#else
    u = __float_as_uint(f);
#endif
    return (bf16_t)((u + 0x7fffu + ((u >> 16) & 1u)) >> 16);
}
__device__ __forceinline__ float sigmoidf_(float x) { return 1.0f / (1.0f + expf(-x)); }
__device__ __forceinline__ float siluf_(float x) { return x / (1.0f + expf(-x)); }
__device__ __forceinline__ int atomic_inc_int(int* p) {
#ifdef HOST_EMU
    int o = *p; *p = o + 1; return o;
#else
    return atomicAdd(p, 1);
#endif
}

struct Params {
    const float *x, *c, *ctx, *c_ctx, *w_mod, *b_mod, *w_in, *w_out, *a_shift, *a_w0, *a_w_up, *a_a0, *a_a_up, *a_g_up,
        *a_k_k, *a_k_a, *a_r_k, *a_lnx_g, *a_lnx_b, *b_sink, *c_rpb, *ln1_g, *ln1_b, *ln2_g, *ln2_b, *w_rg, *b_rg, *w_re,
        *b_re, *w_gate, *w_up, *w_down;
    float* out;
    int* cnt;
    unsigned* bar;
    float* mod;
    float* rope;
    bf16_t *win_t, *wout_t, *wgu_t, *wd_t;
    bf16_t *wrt;
    float* LG;
    bf16_t* HLO;
    bf16_t *wupT, *aupT, *gupT;
    bf16_t* LA;
    float *kT, *kN;
    bf16_t* H;
    bf16_t* Z;
    bf16_t* VT;
    float *sR, *sV, *sKK, *sG, *sW, *sKD, *sB;
    float* Y;
    bf16_t* MIX;
    float *PV, *QS, *PS, *SS;
    float* XC;
    float* O;
    int *rE, *rPos, *rSlot; float* rW;
    int* slotTok;
    bf16_t* ACT;
    float* YS;
};

constexpr size_t al256(size_t v) { return (v + 255) & ~(size_t)255; }
constexpr size_t OFF_CNT = 0;
constexpr size_t OFF_BAR = 4096, CTL_BYTES = 4096 + 16384;
constexpr size_t OFF_MOD = CTL_BYTES;
constexpr size_t OFF_ROPE = al256(OFF_MOD + (size_t)2 * (NB + 1) * 6 * D * 4);
constexpr size_t OFF_LORA = al256(OFF_ROPE + 64 * 16 * 2 * 4);
constexpr size_t OFF_WRT = al256(OFF_LORA + (size_t)(2 * 256 * 64 * 2 + 256 * 160) * 2);
constexpr size_t OFF_LG = al256(OFF_WRT + (size_t)2 * 128 * D * 2);
constexpr size_t OFF_WIN = al256(OFF_LG + (size_t)T * 36 * 4);
constexpr size_t OFF_WOUT = al256(OFF_WIN + (size_t)NINP * D * 2);
constexpr size_t OFF_WGU = al256(OFF_WOUT + (size_t)D * DMIX * 2);
constexpr size_t OFF_WD = al256(OFF_WGU + (size_t)NEXP * 2 * DE * D * 2);
constexpr size_t OFF_H = al256(OFF_WD + (size_t)NEXP * D * DE * 2);
constexpr size_t OFF_Z = al256(OFF_H + (size_t)(T + 1) * D * 2);
constexpr int PU = L + S;
constexpr int NSG = (L + S) / 128;
static_assert((size_t)3 * 64 * ((L + S) / 128) * 4096 * 4 <= (size_t)NEXP * 2 * DE * D * 2 || (L % 128) != 0, "scan segment states overlay wgu_t");
constexpr size_t OFF_VT = al256(OFF_Z + (size_t)T * ZP * 2);
constexpr size_t OFF_S = al256(OFF_VT + (size_t)NB * 8 * 64 * PU * 2);
constexpr size_t S1 = (size_t)T * 256 * 4;
constexpr size_t OFF_Y = al256(OFF_S + 10 * S1);
constexpr size_t OFF_MIX = al256(OFF_Y + 2 * S1);
constexpr size_t OFF_XC = al256(OFF_MIX + (size_t)T * 1024 * 2);
constexpr size_t OFF_ROUTE = al256(OFF_XC + (size_t)TC * D * 4);
constexpr size_t OFF_SLOTTOK = al256(OFF_ROUTE + (size_t)T * 2 * 4 * 4);
constexpr size_t WS_NEED = al256(OFF_SLOTTOK + (size_t)NSLOT * 4);
static_assert((size_t)NSLOT * DE * 2 <= (size_t)T * ZP * 2 && (size_t)T * D * 2 <= (size_t)T * ZP * 2, "ACT / HLO overlay Z");
static_assert((size_t)T * 4 * 4 + (size_t)T * 416 * 2 <= S1, "kN + LA overlay Y[1]");
static_assert((size_t)NSLOT * D * 4 <= 10 * S1 && (size_t)T * D * 4 <= 10 * S1, "YS / O overlay the stream buffers");

static Params make_params(void* const* d_in, void* d_out, void* d_ws) {
    Params p{};
    const float** f = (const float**)&p.x;
    for (int i = 0; i < 32; ++i) f[i] = (const float*)d_in[i];
    p.out = (float*)d_out;
    char* w = (char*)d_ws;
    p.cnt = (int*)(w + OFF_CNT); p.bar = (unsigned*)(w + OFF_BAR); p.mod = (float*)(w + OFF_MOD); p.rope = (float*)(w + OFF_ROPE);
    p.win_t = (bf16_t*)(w + OFF_WIN); p.wout_t = (bf16_t*)(w + OFF_WOUT); p.wgu_t = (bf16_t*)(w + OFF_WGU); p.wd_t = (bf16_t*)(w + OFF_WD);
    p.wrt = (bf16_t*)(w + OFF_WRT); p.LG = (float*)(w + OFF_LG); p.HLO = (bf16_t*)(w + OFF_Z);
    p.wupT = (bf16_t*)(w + OFF_LORA); p.aupT = p.wupT + 2 * 256 * 64; p.gupT = p.aupT + 2 * 256 * 64;
    p.H = (bf16_t*)(w + OFF_H); p.Z = (bf16_t*)(w + OFF_Z); p.VT = (bf16_t*)(w + OFF_VT);
    float* s = (float*)(w + OFF_S); const size_t n1 = (size_t)T * 256;
    p.sR = s; p.sV = s + n1; p.sKK = s + 2 * n1; p.sG = s + 3 * n1; p.sW = s + 4 * n1; p.sKD = s + 6 * n1; p.sB = s + 8 * n1;
    p.Y = (float*)(w + OFF_Y); p.MIX = (bf16_t*)(w + OFF_MIX); p.XC = (float*)(w + OFF_XC);
    p.O = (float*)(w + OFF_S);
    p.PV = (float*)(w + OFF_H); p.QS = (float*)(w + OFF_WGU); p.PS = p.QS + (size_t)64 * NSG * 4096; p.SS = p.PS + (size_t)64 * NSG * 4096;
    p.kT = p.Y; p.kN = p.Y + (size_t)T * 256; p.LA = (bf16_t*)(p.Y + (size_t)T * 256 + (size_t)T * 4);
    int* r = (int*)(w + OFF_ROUTE); p.rE = r; p.rPos = r + 2 * T; p.rSlot = r + 4 * T; p.rW = (float*)(r + 6 * T);
    p.slotTok = (int*)(w + OFF_SLOTTOK);
    p.ACT = (bf16_t*)(w + OFF_Z); p.YS = (float*)(w + OFF_S);
    return p;
}

__device__ void ph_prep_w(const Params& p, int l, long gtid, long gsz) {
    for (long i = gtid; i < (long)D * NINP; i += gsz) {
        const int k = (int)(i / NINP), n = (int)(i % NINP);
        float v = 0.f;
        if (n < N_IN) { const int oc = (n < ZA) ? n + A_IN : n - ZA; v = p.w_in[((size_t)l * D + k) * N_IN + oc]; }
        p.win_t[(size_t)n * D + k] = f2bf(v);
    }
    for (long i = gtid; i < (long)DMIX * D; i += gsz) {
        const int k = (int)(i / D), n = (int)(i % D);
        p.wout_t[(size_t)n * DMIX + k] = f2bf(p.w_out[((size_t)l * DMIX + k) * D + n]);
    }
    for (long i = gtid; i < (long)NEXP * D * 2 * DE; i += gsz) {
        const int rho = (int)(i % (2 * DE)); const long t = i / (2 * DE); const int k = (int)(t % D), e = (int)(t / D);
        const int q = rho >> 5, half = (rho >> 4) & 1, ii = rho & 15, cc = 16 * q + ii;
        const float* src = half ? p.w_up : p.w_gate;
        p.wgu_t[((size_t)e * 2 * DE + rho) * D + k] = f2bf(src[(((size_t)l * NEXP + e) * D + k) * DE + cc]);
    }
    for (long i = gtid; i < (long)NEXP * DE * D; i += gsz) {
        const int n = (int)(i % D); const long t = i / D; const int k = (int)(t % DE), e = (int)(t / DE);
        p.wd_t[((size_t)e * D + n) * DE + k] = f2bf(p.w_down[(((size_t)l * NEXP + e) * DE + k) * D + n]);
    }
}
__device__ __forceinline__ void ph_prep_misc(const Params& p, int l, long gtid, long gsz, bool do_mod = true) {
    if (l == 0 && do_mod) for (long i = gtid; i < (long)2 * (NB + 1) * 6 * D; i += gsz) {
        const int j = (int)(i % (6 * D)), b = (int)((i / (6 * D)) % (NB + 1)), ll = (int)(i / ((long)6 * D * (NB + 1)));
        const float* cv = (b < NB) ? p.c + (size_t)b * D : p.c_ctx;
        float acc = 0.f;
        for (int k = 0; k < D; ++k) acc += siluf_(cv[k]) * p.w_mod[((size_t)ll * D + k) * 6 * D + j];
        p.mod[((size_t)ll * (NB + 1) + b) * 6 * D + j] = acc + p.b_mod[(size_t)ll * 6 * D + j];
    }
    if (l == 0) for (long i = gtid; i < 64 * 16; i += gsz) {
        const int pos = (int)(i / 16), fi = (int)(i % 16);
        const float inv = powf(10000.0f, -(float)fi / 16.0f), ang = (float)pos * inv;
        p.rope[i] = cosf(ang); p.rope[1024 + i] = sinf(ang);
    }
    for (long i = gtid; i < NEXP; i += gsz) p.cnt[l * NEXP + i] = 0;
    for (long i = gtid; i < NSLOT; i += gsz) p.slotTok[i] = T;
    for (long i = gtid; i < D; i += gsz) p.H[(size_t)T * D + i] = 0;
}

__device__ __forceinline__ const float* xrow_in(const Params& p, int l, int m) {
    if (m < TL) return (l == 0 ? p.x : p.out) + (size_t)m * D;
    return (l == 0 ? p.ctx : p.XC) + (size_t)(m - TL) * D;
}
__device__ __forceinline__ const float* modrow(const Params& p, int l, int m) { return p.mod + ((size_t)l * (NB + 1) + (m < TL ? m / S : NB)) * 6 * D; }

__device__ void ph_lnmod(const Params& p, int l, long gtid, long gsz) {
    for (long m = gtid; m < T; m += gsz) {
        const float* xr = xrow_in(p, l, (int)m); const float* md = modrow(p, l, (int)m);
        float s = 0.f; for (int j = 0; j < D; ++j) s += xr[j];
        const float mu = s / D; float q = 0.f;
        for (int j = 0; j < D; ++j) { const float d = xr[j] - mu; q += d * d; }
        const float rstd = 1.0f / sqrtf(q / D + LN_EPS);
        for (int j = 0; j < D; ++j) p.H[(size_t)m * D + j] = f2bf((xr[j] - mu) * rstd * (1.0f + md[D + j]) + md[j]);
    }
}

__device__ __forceinline__ float zshift(const Params& p, int l, int m, int col) {
    int t, len;
    if (m < TL) { t = m % S; len = S; } else { t = (m - TL) % L; len = L; }
    const float* sh = p.a_shift + (size_t)l * 3 * A_IN;
    const bf16_t* z = p.Z + (size_t)m * ZP + ZA + col;
    float v = sh[A_IN + col] * bf2f(z[0]);
    if (t > 0) v += sh[col] * bf2f(z[-ZP]);
    if (t < len - 1) v += sh[2 * A_IN + col] * bf2f(z[ZP]);
    return v;
}

__device__ void ph_streams(const Params& p, int l, long gtid, long gsz) {
    for (long i = gtid; i < (long)T * DA; i += gsz) {
        const int m = (int)(i / DA), c = (int)(i % DA), h0 = c & ~63;
        const float r = zshift(p, l, m, c), k = zshift(p, l, m, 256 + c), v = zshift(p, l, m, 512 + c);
        float nrm = 0.f;
        for (int j = 0; j < 64; ++j) { const float t = zshift(p, l, m, 256 + h0 + j) * p.a_k_k[l * DA + h0 + j]; nrm += t * t; }
        const float kk = k * p.a_k_k[l * DA + c] / sqrtf(nrm + 1e-12f);
        float g = 0.f;
        for (int j = 0; j < 160; ++j) g += sigmoidf_(zshift(p, l, m, 1024 + j)) * p.a_g_up[((size_t)l * 160 + j) * DA + c];
        const size_t o = (size_t)m * DA + c;
        p.sR[o] = r; p.sV[o] = v; p.sKK[o] = kk; p.sG[o] = g;
        for (int d = 0; d < 2; ++d) {
            float aw = 0.f, aa = 0.f;
            for (int j = 0; j < 64; ++j) {
                aw += tanhf(zshift(p, l, m, 768 + d * 64 + j)) * p.a_w_up[(((size_t)l * 2 + d) * 64 + j) * DA + c];
                aa += zshift(p, l, m, 896 + d * 64 + j) * p.a_a_up[(((size_t)l * 2 + d) * 64 + j) * DA + c];
            }
            const float u = -(p.a_w0[(l * 2 + d) * DA + c] + aw);
            const float sp = (u > 20.f) ? u : log1pf(expf(u));
            const float w = expf(-expf(-sp - 0.5f));
            const float a = sigmoidf_(p.a_a0[(l * 2 + d) * DA + c] + aa);
            const size_t od = ((size_t)d * T + m) * DA + c;
            p.sW[od] = w; p.sKD[od] = k * (1.0f + (a - 1.0f) * p.a_k_a[l * DA + c]); p.sB[od] = kk * a;
        }
    }
}

__device__ __forceinline__ void ph_rope(const Params& p, long gtid, long gsz) {
    for (long i = gtid; i < (long)TL * 8 * 32; i += gsz) {
        const int pr = (int)(i & 31), hs = (int)((i >> 5) & 7), m = (int)(i >> 8);
        const int t = m % S, axis = pr >> 4, fi = pr & 15, pos = axis ? (t % GRID_W) : (t / GRID_W);
        bf16_t* z = p.Z + (size_t)m * ZP + hs * 64 + axis * 32 + fi;
        const float cs = p.rope[pos * 16 + fi], sn = p.rope[1024 + pos * 16 + fi];
        const float x0 = bf2f(z[0]), x1 = bf2f(z[16]);
        z[0] = f2bf(x0 * cs - x1 * sn); z[16] = f2bf(x1 * cs + x0 * sn);
    }
}

__device__ void ph_scan(const Params& p, long gtid, long gsz) {
    for (long i = gtid; i < (long)2 * NB * 4 * 64; i += gsz) {
        const int v = (int)(i & 63), h = (int)((i >> 6) & 3), b = (int)((i >> 8) % NB), d = (int)((i >> 8) / NB);
        float st[64];
#pragma unroll
        for (int k = 0; k < 64; ++k) st[k] = 0.f;
        for (int pos = 0; pos < L + S; ++pos) {
            int m;
            if (pos < L) m = TL + b * L + (d ? L - 1 - pos : pos);
            else m = b * S + (d ? S - 1 - (pos - L) : pos - L);
            const size_t o = (size_t)m * DA + h * 64, od = ((size_t)d * T + m) * DA + h * 64;
            const float* kk = p.sKK + o; const float* r = p.sR + o;
            const float* w = p.sW + od; const float* bb = p.sB + od; const float* kd = p.sKD + od;
            const float vv = p.sV[o + v];
            float sk = 0.f;
#pragma unroll
            for (int k = 0; k < 64; ++k) sk += st[k] * kk[k];
            float y = 0.f;
#pragma unroll
            for (int k = 0; k < 64; ++k) { st[k] = st[k] * w[k] - sk * bb[k] + vv * kd[k]; y += st[k] * r[k]; }
            p.Y[od + v] = y;
        }
    }
}

__device__ void ph_rwkv_out(const Params& p, int l, int nrows, long gtid, long gsz) {
    for (long i = gtid; i < (long)nrows * 4; i += gsz) {
        const int m = (int)(i >> 2), h = (int)(i & 3);
        const size_t o = (size_t)m * DA + h * 64;
        const float* y0 = p.Y + o; const float* y1 = p.Y + (size_t)T * DA + o;
        float s = 0.f, bon = 0.f;
        for (int n = 0; n < 64; ++n) {
            s += y0[n] + y1[n];
            bon += p.sR[o + n] * (p.sKD[o + n] + p.sKD[(size_t)T * DA + o + n]) * p.a_r_k[l * DA + h * 64 + n];
        }
        const float mu = s / 64.f; float q = 0.f;
        for (int n = 0; n < 64; ++n) { const float dd = y0[n] + y1[n] - mu; q += dd * dd; }
        const float rstd = 1.0f / sqrtf(q / 64.f + GN_EPS);
        for (int n = 0; n < 64; ++n) {
            const int c = h * 64 + n;
            const float yn = (y0[n] + y1[n] - mu) * rstd * p.a_lnx_g[l * DA + c] + p.a_lnx_b[l * DA + c];
            p.MIX[(size_t)m * DMIX + c] = f2bf((yn + bon * p.sV[o + n]) * p.sG[o + n]);
        }
    }
}

__device__ __forceinline__ void att_key(const float (&q)[64], const bf16_t* kr, const bf16_t* vr, float bias, float& mx, float& ls, float (&acc)[64]) {
    float s = 0.f;
#pragma unroll
    for (int d = 0; d < 64; ++d) s += q[d] * bf2f(kr[d]);
    s = s * ATT_SCALE + bias;
    const float mn = fmaxf(mx, s), f = expf(mx - mn), pe = expf(s - mn);
    ls = ls * f + pe;
#pragma unroll
    for (int d = 0; d < 64; ++d) acc[d] = acc[d] * f + pe * bf2f(vr[d]);
    mx = mn;
}

__device__ void ph_attn(const Params& p, int l, int nrows, long gtid, long gsz) {
    for (long i = gtid; i < (long)nrows * 12; i += gsz) {
        const int m = (int)(i / 12), u = (int)(i % 12);
        const bool isB = u < 6; const int hq = isB ? u : u - 6;
        const int b = (m < TL) ? m / S : (m - TL) / L;
        const int qcol = isB ? ZQB + hq * 64 : ZQN + hq * 64;
        const int kcol = isB ? ZKB + (hq / 3) * 64 : ZKN + hq * 64;
        const int vcol = isB ? ZVB + (hq / 3) * 64 : ZVN + hq * 64;
        float q[64], acc[64];
        const bf16_t* qr = p.Z + (size_t)m * ZP + qcol;
#pragma unroll
        for (int d = 0; d < 64; ++d) { q[d] = bf2f(qr[d]); acc[d] = 0.f; }
        float mx, ls;
        if (isB) { mx = p.b_sink[l * 6 + hq]; ls = 1.0f; } else { mx = -1e30f; ls = 0.f; }
        for (int j = 0; j < L; ++j) { const bf16_t* zr = p.Z + (size_t)(TL + b * L + j) * ZP; att_key(q, zr + kcol, zr + vcol, 0.f, mx, ls, acc); }
        if (m < TL) {
            const int t = m % S;
            if (isB) {
                const int j0 = t - 128 < 0 ? 0 : t - 128, j1 = t + 128 > S - 1 ? S - 1 : t + 128;
                for (int j = j0; j <= j1; ++j) { const bf16_t* zr = p.Z + (size_t)(b * S + j) * ZP; att_key(q, zr + kcol, zr + vcol, 0.f, mx, ls, acc); }
            } else {
                const int rows = S / GRID_W, r = t / GRID_W, c = t % GRID_W;
                int r0 = r - 4; r0 = r0 < 0 ? 0 : (r0 > rows - 8 ? rows - 8 : r0);
                int c0 = c - 8; c0 = c0 < 0 ? 0 : (c0 > GRID_W - 16 ? GRID_W - 16 : c0);
                for (int a = 0; a < 8; ++a)
                    for (int e = 0; e < 16; ++e) {
                        const int kr = r0 + a, kc = c0 + e;
                        const float bias = p.c_rpb[(((size_t)l * 6 + hq) * 15 + (kr - r + 7)) * 31 + (kc - c + 15)];
                        const bf16_t* zr = p.Z + (size_t)(b * S + kr * GRID_W + kc) * ZP;
                        att_key(q, zr + kcol, zr + vcol, bias, mx, ls, acc);
                    }
            }
        }
        const float inv = 1.0f / ls;
        bf16_t* o = p.MIX + (size_t)m * DMIX + (isB ? 256 : 640) + hq * 64;
#pragma unroll
        for (int d = 0; d < 64; ++d) o[d] = f2bf(acc[d] * inv);
    }
}

__device__ void ph_post_mixer(const Params& p, int l, int nrows, long gtid, long gsz) {
    for (long mm = gtid; mm < nrows; mm += gsz) {
        const int m = (int)mm;
        const float* xr = xrow_in(p, l, m); const float* md = modrow(p, l, m); const float* orow = p.O + (size_t)m * D;
        float* x1 = (m < TL) ? p.out + (size_t)m * D : p.XC + (size_t)(m - TL) * D;
        const float* g1 = p.ln1_g + (size_t)l * D; const float* b1 = p.ln1_b + (size_t)l * D;
        float s = 0.f; for (int j = 0; j < D; ++j) s += ALPHA * xr[j] + md[2 * D + j] * orow[j];
        float mu = s / D, q = 0.f;
        for (int j = 0; j < D; ++j) { const float d = ALPHA * xr[j] + md[2 * D + j] * orow[j] - mu; q += d * d; }
        float rstd = 1.0f / sqrtf(q / D + LN_EPS);
        s = 0.f;
        for (int j = 0; j < D; ++j) { const float v = (ALPHA * xr[j] + md[2 * D + j] * orow[j] - mu) * rstd * g1[j] + b1[j]; x1[j] = v; s += v; }
        mu = s / D; q = 0.f;
        for (int j = 0; j < D; ++j) { const float d = x1[j] - mu; q += d * d; }
        rstd = 1.0f / sqrtf(q / D + LN_EPS);
        float gl[4], el[32];
#pragma unroll
        for (int g = 0; g < 4; ++g) gl[g] = p.b_rg[l * 4 + g];
#pragma unroll
        for (int e = 0; e < 32; ++e) el[e] = p.b_re[l * 32 + e];
        for (int j = 0; j < D; ++j) {
            const float hv = (x1[j] - mu) * rstd * (1.0f + md[4 * D + j]) + md[3 * D + j];
            p.H[(size_t)m * D + j] = f2bf(hv);
            const float* wg = p.w_rg + ((size_t)l * D + j) * 4; const float* we = p.w_re + ((size_t)l * D + j) * 32;
#pragma unroll
            for (int g = 0; g < 4; ++g) gl[g] += hv * wg[g];
#pragma unroll
            for (int e = 0; e < 32; ++e) el[e] += hv * we[e];
        }
        int gs = 0; float gm = gl[0];
#pragma unroll
        for (int g = 1; g < 4; ++g) if (gl[g] > gm) { gm = gl[g]; gs = g; }
        float den = 0.f;
#pragma unroll
        for (int g = 0; g < 4; ++g) den += expf(gl[g] - gm);
        const float pg = 1.0f / den;
        float v1 = -3e38f, v2 = -3e38f; int i1 = 0, i2 = 0;
#pragma unroll
        for (int j = 0; j < 8; ++j) {
            const float v = gs == 0 ? el[j] : gs == 1 ? el[8 + j] : gs == 2 ? el[16 + j] : el[24 + j];
            if (v > v1) { v2 = v1; i2 = i1; v1 = v; i1 = j; } else if (v > v2) { v2 = v; i2 = j; }
        }
        const float e2 = expf(v2 - v1), w1 = pg / (1.0f + e2), w2 = pg * e2 / (1.0f + e2);
        const int ea = gs * 8 + i1, eb = gs * 8 + i2;
        p.rE[2 * m] = ea; p.rE[2 * m + 1] = eb; p.rW[2 * m] = w1; p.rW[2 * m + 1] = w2;
        p.rPos[2 * m] = atomic_inc_int(p.cnt + l * NEXP + ea); p.rPos[2 * m + 1] = atomic_inc_int(p.cnt + l * NEXP + eb);
    }
}

__device__ __forceinline__ int pstart_of(const int* cnt, int e) {
    int s = 0;
    for (int j = 0; j < NEXP; ++j) if (j < e) s += (cnt[j] + 127) & ~127;
    return s;
}
__device__ __forceinline__ void ph_dispatch(const Params& p, int l, int nrows, long gtid, long gsz) {
    for (long i = gtid; i < (long)nrows * 2; i += gsz) {
        const int slot = pstart_of(p.cnt + l * NEXP, p.rE[i]) + p.rPos[i];
        p.rSlot[i] = slot; p.slotTok[slot] = (int)(i >> 1);
    }
}

__device__ void ph_final(const Params& p, int l, int nrows, long gtid, long gsz) {
    for (long mm = gtid; mm < nrows; mm += gsz) {
        const int m = (int)mm;
        float* x1 = (m < TL) ? p.out + (size_t)m * D : p.XC + (size_t)(m - TL) * D;
        const float* md = modrow(p, l, m);
        const float* ya = p.YS + (size_t)p.rSlot[2 * m] * D; const float* yb = p.YS + (size_t)p.rSlot[2 * m + 1] * D;
        const float wa = p.rW[2 * m], wb = p.rW[2 * m + 1];
        const float* g2 = p.ln2_g + (size_t)l * D; const float* b2 = p.ln2_b + (size_t)l * D;
        float s = 0.f; for (int j = 0; j < D; ++j) s += ALPHA * x1[j] + md[5 * D + j] * (wa * ya[j] + wb * yb[j]);
        const float mu = s / D; float q = 0.f;
        for (int j = 0; j < D; ++j) { const float d = ALPHA * x1[j] + md[5 * D + j] * (wa * ya[j] + wb * yb[j]) - mu; q += d * d; }
        const float rstd = 1.0f / sqrtf(q / D + LN_EPS);
        for (int j = 0; j < D; ++j) x1[j] = (ALPHA * x1[j] + md[5 * D + j] * (wa * ya[j] + wb * yb[j]) - mu) * rstd * g2[j] + b2[j];
    }
}

__device__ __forceinline__ int moe_blocks(const int* cnt) { int s = 0; for (int j = 0; j < NEXP; ++j) s += (cnt[j] + 127) >> 7; return s; }
__device__ __forceinline__ int moe_block_expert(const int* cnt, int rb) {
    int s = 0, e = 0;
    for (int j = 0; j < NEXP; ++j) { const int nb = (cnt[j] + 127) >> 7; if (rb >= s && rb < s + nb) e = j; s += nb; }
    return e;
}

#ifdef HOST_EMU
static void host_gemm_in(const Params& p) {
    for (int m = 0; m < T; ++m) for (int n = 0; n < ZP; ++n) { float a = 0.f; for (int k = 0; k < D; ++k) a += bf2f(p.H[(size_t)m * D + k]) * bf2f(p.win_t[(size_t)n * D + k]); p.Z[(size_t)m * ZP + n] = f2bf(a); }
}
static void host_gemm_out(const Params& p, int nrows) {
    for (int m = 0; m < nrows; ++m) for (int n = 0; n < D; ++n) { float a = 0.f; for (int k = 0; k < DMIX; ++k) a += bf2f(p.MIX[(size_t)m * DMIX + k]) * bf2f(p.wout_t[(size_t)n * DMIX + k]); p.O[(size_t)m * D + n] = a; }
}
static void host_moe1(const Params& p, int l) {
    const int* cnt = p.cnt + l * NEXP; const int nrb = moe_blocks(cnt);
    for (int rb = 0; rb < nrb; ++rb) { const int e = moe_block_expert(cnt, rb);
        for (int r = 0; r < 128; ++r) { const int slot = rb * 128 + r; const bf16_t* a = p.H + (size_t)p.slotTok[slot] * D;
            for (int c = 0; c < DE; ++c) { const int q = c >> 4, ii = c & 15; float g = 0.f, u = 0.f;
                const bf16_t* wg = p.wgu_t + ((size_t)e * 2 * DE + 32 * q + ii) * D; const bf16_t* wu = wg + (size_t)16 * D;
                for (int k = 0; k < D; ++k) { g += bf2f(a[k]) * bf2f(wg[k]); u += bf2f(a[k]) * bf2f(wu[k]); }
                p.ACT[(size_t)slot * DE + c] = f2bf(siluf_(g) * u); } } }
}
static void host_moe2(const Params& p, int l) {
    const int* cnt = p.cnt + l * NEXP; const int nrb = moe_blocks(cnt);
    for (int rb = 0; rb < nrb; ++rb) { const int e = moe_block_expert(cnt, rb);
        for (int r = 0; r < 128; ++r) { const int slot = rb * 128 + r;
            for (int n = 0; n < D; ++n) { float a = 0.f; const bf16_t* w = p.wd_t + ((size_t)e * D + n) * DE;
                for (int k = 0; k < DE; ++k) a += bf2f(p.ACT[(size_t)slot * DE + k]) * bf2f(w[k]);
                p.YS[(size_t)slot * D + n] = a; } } }
}
#else
typedef short bf16x8 __attribute__((ext_vector_type(8)));
typedef float f32x4 __attribute__((ext_vector_type(4)));
__device__ __forceinline__ int opq_tid() { int t = threadIdx.x; asm volatile("" : "+v"(t)); return t; }
__device__ __forceinline__ int opq_bid() { int b = blockIdx.x; asm volatile("" : "+s"(b)); return b; }
__device__ __forceinline__ unsigned pk2(float lo, float hi) { return (unsigned)f2bf(lo) | ((unsigned)f2bf(hi) << 16); }
struct u32x2_t { unsigned x, y; };
__device__ __forceinline__ void st_bf16x4(bf16_t* dst, f32x4 v) { u32x2_t o; o.x = pk2(v[0], v[1]); o.y = pk2(v[2], v[3]); *(u32x2_t*)dst = o; }
template <class Epi>
__device__ __forceinline__ void gemm_tile(const bf16_t* a0, const bf16_t* a1, const bf16_t* b0, const bf16_t* b1, int K, char* lds, const Epi& epi, int nseg = 1, size_t aseg = 0, size_t bseg = 0) {
    const int tid = opq_tid(), wid = tid >> 6, lane = tid & 63, wr = wid >> 1, wc = wid & 1, fr = lane & 15, fq = lane >> 4;
    char* SA = lds; char* SB = lds + 8192;
    f32x4 acc[4][4];
#pragma unroll
    for (int m = 0; m < 4; ++m)
#pragma unroll
        for (int n = 0; n < 4; ++n) acc[m][n] = (f32x4){0.f, 0.f, 0.f, 0.f};
    for (int sg = 0; sg < nseg; ++sg, a0 += aseg, a1 += aseg, b0 += bseg, b1 += bseg)
    for (int kt = 0; kt < K; kt += 32) {
        __builtin_amdgcn_global_load_lds((const unsigned*)(a0 + kt), (__attribute__((address_space(3))) unsigned*)(SA + tid * 16), 16, 0, 0);
        __builtin_amdgcn_global_load_lds((const unsigned*)(a1 + kt), (__attribute__((address_space(3))) unsigned*)(SA + tid * 16 + 4096), 16, 0, 0);
        __builtin_amdgcn_global_load_lds((const unsigned*)(b0 + kt), (__attribute__((address_space(3))) unsigned*)(SB + tid * 16), 16, 0, 0);
        __builtin_amdgcn_global_load_lds((const unsigned*)(b1 + kt), (__attribute__((address_space(3))) unsigned*)(SB + tid * 16 + 4096), 16, 0, 0);
        asm volatile("s_waitcnt vmcnt(0)" ::: "memory");
        __syncthreads();
        bf16x8 At[4], Bt[4];
#pragma unroll
        for (int m = 0; m < 4; ++m) At[m] = *(const bf16x8*)(SA + (wr * 64 + m * 16 + fr) * 64 + fq * 16);
#pragma unroll
        for (int n = 0; n < 4; ++n) Bt[n] = *(const bf16x8*)(SB + (wc * 64 + n * 16 + fr) * 64 + fq * 16);
#pragma unroll
        for (int m = 0; m < 4; ++m)
#pragma unroll
            for (int n = 0; n < 4; ++n) acc[m][n] = __builtin_amdgcn_mfma_f32_16x16x32_bf16(At[m], Bt[n], acc[m][n], 0, 0, 0);
        __syncthreads();
    }
    epi(acc, wr, wc, fr, fq);
}
#define STG_ROW(i) ((tid_ + (i) * 256) >> 2)
#define STG_K ((tid_ & 3) * 8)

__device__ __forceinline__ void g_gemm_in(const Params& p, char* lds) {
    const int tid_ = opq_tid(), bid_ = opq_bid(); (void)tid_; (void)bid_;
    constexpr int NT = NINP / 128, MT = T / 128;
    for (int tile = bid_; tile < NT * MT; tile += gridDim.x) {
        const int tm = tile / NT, tn = tile % NT;
        const bf16_t* a0 = p.H + (size_t)(tm * 128 + STG_ROW(0)) * D + STG_K; const bf16_t* a1 = p.H + (size_t)(tm * 128 + STG_ROW(1)) * D + STG_K;
        const bf16_t* b0 = p.win_t + (size_t)(tn * 128 + STG_ROW(0)) * D + STG_K; const bf16_t* b1 = p.win_t + (size_t)(tn * 128 + STG_ROW(1)) * D + STG_K;
        gemm_tile(a0, a1, b0, b1, D, lds, [&](const f32x4 (&acc)[4][4], int wr, int wc, int fr, int fq) {
            if (tn < ZVB / 128 && tm < TL / 128) {
#pragma unroll
                for (int m = 0; m < 4; ++m)
#pragma unroll
                    for (int j = 0; j < 4; ++j) { const int row = tm * 128 + wr * 64 + m * 16 + fq * 4 + j, t = row % S;
                        bf16_t* zr = p.Z + (size_t)row * ZP + tn * 128 + wc * 64 + fr;
#pragma unroll
                        for (int ax = 0; ax < 2; ++ax) { const int pos = ax ? t % GRID_W : t / GRID_W; const float cs = p.rope[pos * 16 + fr], sn = p.rope[1024 + pos * 16 + fr];
                            const float x0 = acc[m][2 * ax][j], x1 = acc[m][2 * ax + 1][j];
                            zr[32 * ax] = f2bf(x0 * cs - x1 * sn); zr[32 * ax + 16] = f2bf(x1 * cs + x0 * sn); } }
            } else {
#pragma unroll
            for (int m = 0; m < 4; ++m)
#pragma unroll
                for (int n = 0; n < 4; ++n) { const int col = tn * 128 + wc * 64 + n * 16 + fr;
                    if (col < ZP) {
#pragma unroll
                        for (int j = 0; j < 4; ++j) p.Z[(size_t)(tm * 128 + wr * 64 + m * 16 + fq * 4 + j) * ZP + col] = f2bf(acc[m][n][j]); } }
            }
            if (tn == ZVB / 128 || (tn >= ZVN / 128 && tn < ZA / 128)) {
#pragma unroll
                for (int m = 0; m < 4; ++m) { const int m0 = tm * 128 + wr * 64 + m * 16 + fq * 4; int b, u;
                    if (m0 < TL) { b = m0 / S; u = L + m0 % S; } else { b = (m0 - TL) / L; u = (m0 - TL) % L; }
#pragma unroll
                    for (int n = 0; n < 4; ++n) { const int col = tn * 128 + wc * 64 + n * 16 + fr;
                        const int hv = col < ZVN ? (col - ZVB) >> 6 : 2 + ((col - ZVN) >> 6), d = col < ZVN ? (col - ZVB) & 63 : (col - ZVN) & 63;
                        st_bf16x4(p.VT + ((size_t)(b * 8 + hv) * 64 + d) * PU + u, acc[m][n]); } }
            }
        });
    }
}
__device__ __forceinline__ void g_gemm_out(const Params& p, int nrows, char* lds) {
    const int tid_ = opq_tid(), bid_ = opq_bid(); (void)tid_; (void)bid_;
    constexpr int NT = D / 128; const int MT = nrows / 128;
    for (int tile = bid_; tile < NT * MT; tile += gridDim.x) {
        const int tm = tile / NT, tn = tile % NT;
        const bf16_t* a0 = p.MIX + (size_t)(tm * 128 + STG_ROW(0)) * DMIX + STG_K; const bf16_t* a1 = p.MIX + (size_t)(tm * 128 + STG_ROW(1)) * DMIX + STG_K;
        const bf16_t* b0 = p.wout_t + (size_t)(tn * 128 + STG_ROW(0)) * DMIX + STG_K; const bf16_t* b1 = p.wout_t + (size_t)(tn * 128 + STG_ROW(1)) * DMIX + STG_K;
        gemm_tile(a0, a1, b0, b1, DMIX, lds, [&](const f32x4 (&acc)[4][4], int wr, int wc, int fr, int fq) {
#pragma unroll
            for (int m = 0; m < 4; ++m)
#pragma unroll
                for (int n = 0; n < 4; ++n)
#pragma unroll
                    for (int j = 0; j < 4; ++j) p.O[(size_t)(tm * 128 + wr * 64 + m * 16 + fq * 4 + j) * D + tn * 128 + wc * 64 + n * 16 + fr] = acc[m][n][j];
        });
    }
}
__device__ __forceinline__ void g_moe1(const Params& p, int l, char* lds) {
    const int tid_ = opq_tid(), bid_ = opq_bid(); (void)tid_; (void)bid_;
    const int* cnt = p.cnt + l * NEXP; const int nrb = moe_blocks(cnt); constexpr int NT = 2 * DE / 128;
    for (int tile = bid_; tile < nrb * NT; tile += gridDim.x) {
        const int rb = tile / NT, tn = tile % NT, e = moe_block_expert(cnt, rb);
        const bf16_t* a0 = p.H + (size_t)p.slotTok[rb * 128 + STG_ROW(0)] * D + STG_K; const bf16_t* a1 = p.H + (size_t)p.slotTok[rb * 128 + STG_ROW(1)] * D + STG_K;
        const bf16_t* bw = p.wgu_t + (size_t)e * 2 * DE * D;
        const bf16_t* b0 = bw + (size_t)(tn * 128 + STG_ROW(0)) * D + STG_K; const bf16_t* b1 = bw + (size_t)(tn * 128 + STG_ROW(1)) * D + STG_K;
        gemm_tile(a0, a1, b0, b1, D, lds, [&](const f32x4 (&acc)[4][4], int wr, int wc, int fr, int fq) {
#pragma unroll
            for (int m = 0; m < 4; ++m)
#pragma unroll
                for (int n2 = 0; n2 < 2; ++n2) { const int col = tn * 64 + wc * 32 + n2 * 16 + fr;
#pragma unroll
                    for (int j = 0; j < 4; ++j) { const float g = acc[m][2 * n2][j], u = acc[m][2 * n2 + 1][j];
                        p.ACT[(size_t)(rb * 128 + wr * 64 + m * 16 + fq * 4 + j) * DE + col] = f2bf(g / (1.0f + __expf(-g)) * u); } }
        });
    }
}
__device__ __forceinline__ void g_moe2(const Params& p, int l, char* lds) {
    const int tid_ = opq_tid(), bid_ = opq_bid(); (void)tid_; (void)bid_;
    const int* cnt = p.cnt + l * NEXP; const int nrb = moe_blocks(cnt); constexpr int NT = D / 128;
    for (int tile = bid_; tile < nrb * NT; tile += gridDim.x) {
        const int rb = tile / NT, tn = tile % NT, e = moe_block_expert(cnt, rb);
        const bf16_t* a0 = p.ACT + (size_t)(rb * 128 + STG_ROW(0)) * DE + STG_K; const bf16_t* a1 = p.ACT + (size_t)(rb * 128 + STG_ROW(1)) * DE + STG_K;
        const bf16_t* bw = p.wd_t + (size_t)e * D * DE;
        const bf16_t* b0 = bw + (size_t)(tn * 128 + STG_ROW(0)) * DE + STG_K; const bf16_t* b1 = bw + (size_t)(tn * 128 + STG_ROW(1)) * DE + STG_K;
        gemm_tile(a0, a1, b0, b1, DE, lds, [&](const f32x4 (&acc)[4][4], int wr, int wc, int fr, int fq) {
#pragma unroll
            for (int m = 0; m < 4; ++m)
#pragma unroll
                for (int n = 0; n < 4; ++n)
#pragma unroll
                    for (int j = 0; j < 4; ++j) p.YS[(size_t)(rb * 128 + wr * 64 + m * 16 + fq * 4 + j) * D + tn * 128 + wc * 64 + n * 16 + fr] = acc[m][n][j];
        });
    }
}


constexpr int DV = D / 256;
static_assert(D % 256 == 0, "row phases hold a row as DV float4 per lane");
template <int CTRL> __device__ __forceinline__ float dppf(float v) { return __builtin_bit_cast(float, __builtin_amdgcn_update_dpp(0, __builtin_bit_cast(int, v), CTRL, 0xf, 0xf, true)); }
__device__ __forceinline__ float wave_sum(float v) {
    v += dppf<0xB1>(v); v += dppf<0x4E>(v); v += dppf<0x141>(v); v += dppf<0x140>(v);
    float a = v, b = v;
    asm volatile("s_nop 1\n\tv_permlane16_swap_b32 %0, %1" : "+v"(a), "+v"(b));
    v = a + b; a = v; b = v;
    asm volatile("s_nop 1\n\tv_permlane32_swap_b32 %0, %1" : "+v"(a), "+v"(b));
    return a + b;
}
__device__ __forceinline__ float sum8(float v) { v += dppf<0xB1>(v); v += dppf<0x4E>(v); v += dppf<0x141>(v); return v; }
__device__ __forceinline__ float sum4(f32x4 a) { return (a[0] + a[1]) + (a[2] + a[3]); }
#define LDS_WAIT() asm volatile("s_waitcnt lgkmcnt(0)" ::: "memory")

__device__ __forceinline__ void row_stats(const f32x4 (&v)[DV], float& mu, float& rstd) {
    float s = 0.f;
#pragma unroll
    for (int j = 0; j < DV; ++j) s += sum4(v[j]);
    mu = wave_sum(s) * (1.0f / D);
    float q = 0.f;
#pragma unroll
    for (int j = 0; j < DV; ++j) { const f32x4 d = v[j] - mu; q += sum4(d * d); }
    rstd = 1.0f / sqrtf(wave_sum(q) * (1.0f / D) + LN_EPS);
}

__device__ __forceinline__ void ph_lnmod_fast(const Params& p, int l) {
    const int tid_ = opq_tid(), bid_ = opq_bid(); (void)tid_; (void)bid_;
    const int lane = tid_ & 63, gw = bid_ * 4 + (tid_ >> 6), nw = gridDim.x * 4;
    for (int m = gw; m < T; m += nw) {
        const f32x4* xr = (const f32x4*)xrow_in(p, l, m) + lane; const f32x4* md = (const f32x4*)modrow(p, l, m) + lane;
        f32x4 v[DV];
#pragma unroll
        for (int j = 0; j < DV; ++j) v[j] = xr[64 * j];
        float mu, rstd; row_stats(v, mu, rstd);
#pragma unroll
        for (int j = 0; j < DV; ++j) { const f32x4 sh = md[64 * j], sc = md[D / 4 + 64 * j];
            st_bf16x4(p.H + (size_t)m * D + 4 * (lane + 64 * j), (v[j] - mu) * rstd * (sc + 1.0f) + sh); }
    }
}

__device__ __forceinline__ void ph_post_mixer_fast(const Params& p, int l, int nrows) {
    const int tid_ = opq_tid(), bid_ = opq_bid(); (void)tid_; (void)bid_;
    const int lane = tid_ & 63, gw = bid_ * 4 + (tid_ >> 6), nw = gridDim.x * 4;
    for (int m = gw; m < nrows; m += nw) {
        const f32x4* xr = (const f32x4*)xrow_in(p, l, m) + lane; const f32x4* md = (const f32x4*)modrow(p, l, m) + lane;
        const f32x4* orow = (const f32x4*)(p.O + (size_t)m * D) + lane;
        f32x4* x1 = (f32x4*)((m < TL) ? p.out + (size_t)m * D : p.XC + (size_t)(m - TL) * D) + lane;
        const f32x4* g1 = (const f32x4*)(p.ln1_g + (size_t)l * D) + lane; const f32x4* b1 = (const f32x4*)(p.ln1_b + (size_t)l * D) + lane;
        f32x4 v[DV];
#pragma unroll
        for (int j = 0; j < DV; ++j) v[j] = xr[64 * j] * ALPHA + md[2 * (D / 4) + 64 * j] * orow[64 * j];
        float mu, rstd; row_stats(v, mu, rstd);
#pragma unroll
        for (int j = 0; j < DV; ++j) { v[j] = (v[j] - mu) * rstd * g1[64 * j] + b1[64 * j]; x1[64 * j] = v[j]; }
        row_stats(v, mu, rstd);
#pragma unroll
        for (int j = 0; j < DV; ++j) {
            const f32x4 hv = (v[j] - mu) * rstd * (md[4 * (D / 4) + 64 * j] + 1.0f) + md[3 * (D / 4) + 64 * j];
            f32x4 hh, lo;
#pragma unroll
            for (int e = 0; e < 4; ++e) { hh[e] = bf2f(f2bf(hv[e])); lo[e] = hv[e] - hh[e]; }
            st_bf16x4(p.H + (size_t)m * D + 4 * (lane + 64 * j), hh);
            st_bf16x4(p.HLO + (size_t)m * D + 4 * (lane + 64 * j), lo);
        }
    }
}

__device__ __forceinline__ void g_router(const Params& p, int l, int nrows, char* lds) {
    const int tid_ = opq_tid(), bid_ = opq_bid(); (void)tid_; (void)bid_;
    const int lane = tid_ & 63, wid = tid_ >> 6, fr = lane & 15, fq = lane >> 4;
    float* part = (float*)lds;
    float* lgt = part + 4 * 6 * 64 * 4;
    for (int rg = bid_; rg < nrows / 32; rg += gridDim.x) {
        f32x4 acc[2][3];
#pragma unroll
        for (int a = 0; a < 2; ++a)
#pragma unroll
            for (int b = 0; b < 3; ++b) acc[a][b] = (f32x4){0.f, 0.f, 0.f, 0.f};
#pragma unroll
        for (int seg = 0; seg < 3; ++seg) {
            const bf16_t* ap = (seg < 2 ? p.H : p.HLO) + (size_t)(rg * 32 + fr) * D + wid * (D / 4) + fq * 8;
            const bf16_t* bp = p.wrt + (seg == 1 ? (size_t)128 * D : 0) + (size_t)fr * D + wid * (D / 4) + fq * 8;
#pragma unroll 4
            for (int ks = 0; ks < D / 128; ++ks) {
                const bf16x8 a0 = *(const bf16x8*)(ap + ks * 32), a1 = *(const bf16x8*)(ap + (size_t)16 * D + ks * 32);
                const bf16x8 b0 = *(const bf16x8*)(bp + ks * 32), b1 = *(const bf16x8*)(bp + (size_t)16 * D + ks * 32), b2 = *(const bf16x8*)(bp + (size_t)32 * D + ks * 32);
                acc[0][0] = __builtin_amdgcn_mfma_f32_16x16x32_bf16(a0, b0, acc[0][0], 0, 0, 0); acc[0][1] = __builtin_amdgcn_mfma_f32_16x16x32_bf16(a0, b1, acc[0][1], 0, 0, 0);
                acc[0][2] = __builtin_amdgcn_mfma_f32_16x16x32_bf16(a0, b2, acc[0][2], 0, 0, 0); acc[1][0] = __builtin_amdgcn_mfma_f32_16x16x32_bf16(a1, b0, acc[1][0], 0, 0, 0);
                acc[1][1] = __builtin_amdgcn_mfma_f32_16x16x32_bf16(a1, b1, acc[1][1], 0, 0, 0); acc[1][2] = __builtin_amdgcn_mfma_f32_16x16x32_bf16(a1, b2, acc[1][2], 0, 0, 0);
            }
        }
#pragma unroll
        for (int a = 0; a < 2; ++a)
#pragma unroll
            for (int b = 0; b < 3; ++b) *(f32x4*)(part + ((wid * 6 + a * 3 + b) * 64 + lane) * 4) = acc[a][b];
        __syncthreads();
#pragma unroll
        for (int i = 0; i < 6; ++i) { const int e = tid_ + 256 * i, f = e >> 8, ln = (e & 255) >> 2, j = e & 3;
            const float sm = (part[((0 * 6 + f) * 64 + ln) * 4 + j] + part[((1 * 6 + f) * 64 + ln) * 4 + j]) + (part[((2 * 6 + f) * 64 + ln) * 4 + j] + part[((3 * 6 + f) * 64 + ln) * 4 + j]);
            lgt[((f / 3) * 16 + (ln >> 4) * 4 + j) * 48 + (f % 3) * 16 + (ln & 15)] = sm; }
        __syncthreads();
        if (tid_ < 32) {
            const int m = rg * 32 + tid_; const float* lg = lgt + tid_ * 48;
            float gl[4], el[32];
#pragma unroll
            for (int g = 0; g < 4; ++g) gl[g] = lg[g] + p.b_rg[l * 4 + g];
#pragma unroll
            for (int e = 0; e < 32; ++e) el[e] = lg[4 + e] + p.b_re[l * 32 + e];
            int gs = 0; float gm = gl[0];
#pragma unroll
            for (int g = 1; g < 4; ++g) if (gl[g] > gm) { gm = gl[g]; gs = g; }
            float den = 0.f;
#pragma unroll
            for (int g = 0; g < 4; ++g) den += expf(gl[g] - gm);
            const float pg = 1.0f / den;
            float v1 = -3e38f, v2 = -3e38f; int i1 = 0, i2 = 0;
#pragma unroll
            for (int j = 0; j < 8; ++j) {
                const float vv = gs == 0 ? el[j] : gs == 1 ? el[8 + j] : gs == 2 ? el[16 + j] : el[24 + j];
                if (vv > v1) { v2 = v1; i2 = i1; v1 = vv; i1 = j; } else if (vv > v2) { v2 = vv; i2 = j; }
            }
            const float e2 = expf(v2 - v1), w1 = pg / (1.0f + e2), w2 = pg * e2 / (1.0f + e2);
            const int ea = gs * 8 + i1, eb = gs * 8 + i2;
            p.rE[2 * m] = ea; p.rE[2 * m + 1] = eb; p.rW[2 * m] = w1; p.rW[2 * m + 1] = w2;
            p.rPos[2 * m] = atomicAdd(p.cnt + l * NEXP + ea, 1); p.rPos[2 * m + 1] = atomicAdd(p.cnt + l * NEXP + eb, 1);
        }
        __syncthreads();
    }
}

__device__ __forceinline__ void ph_final_fast(const Params& p, int l, int nrows) {
    const int tid_ = opq_tid(), bid_ = opq_bid(); (void)tid_; (void)bid_;
    const int lane = tid_ & 63, gw = bid_ * 4 + (tid_ >> 6), nw = gridDim.x * 4;
    for (int m = gw; m < nrows; m += nw) {
        f32x4* x1 = (f32x4*)((m < TL) ? p.out + (size_t)m * D : p.XC + (size_t)(m - TL) * D) + lane;
        const f32x4* md = (const f32x4*)modrow(p, l, m) + lane;
        const f32x4* ya = (const f32x4*)(p.YS + (size_t)p.rSlot[2 * m] * D) + lane; const f32x4* yb = (const f32x4*)(p.YS + (size_t)p.rSlot[2 * m + 1] * D) + lane;
        const float wa = p.rW[2 * m], wb = p.rW[2 * m + 1];
        const f32x4* g2 = (const f32x4*)(p.ln2_g + (size_t)l * D) + lane; const f32x4* b2 = (const f32x4*)(p.ln2_b + (size_t)l * D) + lane;
        f32x4 v[DV];
#pragma unroll
        for (int j = 0; j < DV; ++j) v[j] = x1[64 * j] * ALPHA + md[5 * (D / 4) + 64 * j] * (ya[64 * j] * wa + yb[64 * j] * wb);
        float mu, rstd; row_stats(v, mu, rstd);
#pragma unroll
        for (int j = 0; j < DV; ++j) x1[64 * j] = (v[j] - mu) * rstd * g2[64 * j] + b2[64 * j];
    }
}

__device__ __forceinline__ void ph_mod_fast(const Params& p, char* lds) {
    const int tid_ = opq_tid(), bid_ = opq_bid(); (void)tid_; (void)bid_;
    constexpr int NR = NB + 1, NTASK = 2 * (6 * D / 64);
    if (bid_ >= NTASK) return;
    float* sc = (float*)lds;
    float* part = sc + NR * D;
    for (int i = tid_; i < NR * D; i += 256) { const int b = i / D, k = i % D; const float cv = b < NB ? p.c[(size_t)b * D + k] : p.c_ctx[k]; sc[i] = cv / (1.0f + __expf(-cv)); }
    __syncthreads();
    const int lane = tid_ & 63, wid = tid_ >> 6;
    for (int task = bid_; task < NTASK; task += gridDim.x) {
        const int ll = task / (6 * D / 64), col = 64 * (task % (6 * D / 64)) + lane;
        float acc[NR];
#pragma unroll
        for (int b = 0; b < NR; ++b) acc[b] = 0.f;
        const float* wp = p.w_mod + ((size_t)ll * D + wid * (D / 4)) * 6 * D + col;
#pragma unroll 16
        for (int k = 0; k < D / 4; ++k) { const float w = wp[(size_t)k * 6 * D];
#pragma unroll
            for (int b = 0; b < NR; ++b) acc[b] += sc[b * D + wid * (D / 4) + k] * w; }
#pragma unroll
        for (int b = 0; b < NR; ++b) part[(wid * NR + b) * 64 + lane] = acc[b];
        __syncthreads();
        for (int i = tid_; i < NR * 64; i += 256) { const int b = i / 64, cl = i % 64;
            p.mod[((size_t)ll * NR + b) * 6 * D + 64 * (task % (6 * D / 64)) + cl] = (part[(0 * NR + b) * 64 + cl] + part[(1 * NR + b) * 64 + cl]) + (part[(2 * NR + b) * 64 + cl] + part[(3 * NR + b) * 64 + cl]) + p.b_mod[(size_t)ll * 6 * D + 64 * (task % (6 * D / 64)) + cl]; }
        __syncthreads();
    }
}

__device__ __forceinline__ void tr_item(const float* srcl, size_t ldw, bf16_t* dst, size_t ldd, float* scr, int lane) {
#pragma unroll 8
    for (int i = 0; i < 32; ++i) { const int kk = 2 * i + (lane >> 5); scr[kk * 33 + (lane & 31)] = srcl ? srcl[(size_t)kk * ldw] : 0.f; }
    LDS_WAIT();
    const int c = lane & 7;
#pragma unroll
    for (int j = 0; j < 4; ++j) { const int n = (lane >> 3) + 8 * j; const float* s = scr + (8 * c) * 33 + n;
        uint4 o; o.x = pk2(s[0], s[33]); o.y = pk2(s[2 * 33], s[3 * 33]); o.z = pk2(s[4 * 33], s[5 * 33]); o.w = pk2(s[6 * 33], s[7 * 33]);
        *(uint4*)(dst + (size_t)n * ldd + 8 * c) = o; }
    LDS_WAIT();
}
__device__ __forceinline__ void ph_prep_w_fast(const Params& p, int l, int part, char* lds) {
    const int tid_ = opq_tid(), bid_ = opq_bid(); (void)tid_; (void)bid_;
    const int lane = tid_ & 63, wid = tid_ >> 6, gw = bid_ * 4 + wid, nw = gridDim.x * 4;
    float* scr = (float*)(lds + wid * 8448);
    constexpr int I_IN = (D / 64) * (NINP / 32), I_OUT = (DMIX / 64) * (D / 32), I_GU1 = (D / 64) * (2 * DE / 32), I_D1 = (DE / 64) * (D / 32);
    constexpr int NITEMS = I_IN + I_OUT + NEXP * (I_GU1 + I_D1);
    const int it0 = part == 0 ? 0 : I_IN + I_OUT, it1 = part == 0 ? I_IN + I_OUT : NITEMS;
    for (int it = it0 + gw; it < it1; it += nw) {
        int r = it;
        if (r < I_IN) { const int kb = r / (NINP / 32), n0 = 32 * (r % (NINP / 32));
            const float* s = nullptr;
            if (n0 < N_IN) { const int oc = (n0 < ZA) ? n0 + A_IN : n0 - ZA; s = p.w_in + ((size_t)l * D + 64 * kb) * N_IN + oc + (lane & 31); }
            tr_item(s, N_IN, p.win_t + (size_t)n0 * D + 64 * kb, D, scr, lane); continue; }
        r -= I_IN;
        if (r < I_OUT) { const int kb = r / (D / 32), n0 = 32 * (r % (D / 32));
            tr_item(p.w_out + ((size_t)l * DMIX + 64 * kb) * D + n0 + (lane & 31), D, p.wout_t + (size_t)n0 * DMIX + 64 * kb, DMIX, scr, lane); continue; }
        r -= I_OUT;
        const int e = r / (I_GU1 + I_D1); r %= (I_GU1 + I_D1);
        if (r < I_GU1) { const int kb = r / (2 * DE / 32), q = r % (2 * DE / 32);
            const float* s = (((lane & 31) >> 4) ? p.w_up : p.w_gate) + (((size_t)l * NEXP + e) * D + 64 * kb) * DE + 16 * q + (lane & 15);
            tr_item(s, DE, p.wgu_t + ((size_t)e * 2 * DE + 32 * q) * D + 64 * kb, D, scr, lane); continue; }
        r -= I_GU1;
        { const int kb = r / (D / 32), n0 = 32 * (r % (D / 32));
            tr_item(p.w_down + (((size_t)l * NEXP + e) * DE + 64 * kb) * D + n0 + (lane & 31), D, p.wd_t + ((size_t)e * D + n0) * DE + 64 * kb, DE, scr, lane); }
    }
    if (part != 0) return;
    const long gt = (long)bid_ * blockDim.x + tid_, gs = (long)gridDim.x * blockDim.x;
    for (long i = gt; i < 2 * 256 * 64; i += gs) { const int k = (int)(i & 63), n = (int)((i >> 6) & 255), d = (int)(i >> 14);
        p.wupT[i] = f2bf(p.a_w_up[(((size_t)l * 2 + d) * 64 + k) * DA + n]); p.aupT[i] = f2bf(p.a_a_up[(((size_t)l * 2 + d) * 64 + k) * DA + n]); }
    for (long i = gt; i < 256 * 160; i += gs) { const int k = (int)(i % 160), n = (int)(i / 160); p.gupT[i] = f2bf(p.a_g_up[((size_t)l * 160 + k) * DA + n]); }
    for (long i = gt; i < (long)128 * D; i += gs) { const int n = (int)(i / D), k = (int)(i % D);
        const float w = n < 4 ? p.w_rg[((size_t)l * D + k) * 4 + n] : n < 36 ? p.w_re[((size_t)l * D + k) * 32 + n - 4] : 0.f;
        const bf16_t hb = f2bf(w); p.wrt[i] = hb; p.wrt[(size_t)128 * D + i] = f2bf(w - bf2f(hb)); }
}

__device__ __forceinline__ float tanh_fast(float x) { return 1.0f - 2.0f / (1.0f + __expf(2.0f * x)); }
__device__ __forceinline__ void ph_streams_s1(const Params& p, int l) {
    const int tid_ = opq_tid(), bid_ = opq_bid(); (void)tid_; (void)bid_;
    constexpr int NCH = A_IN / 8, NCHP = (NCH + 7) & ~7;
    const float* sh = p.a_shift + (size_t)l * 3 * A_IN;
    for (long it = (long)bid_ * 256 + tid_; it < (long)T * NCHP; it += (long)gridDim.x * 256) {
        const int m = (int)(it / NCHP), ch = (int)(it % NCHP), c0 = 8 * ch;
        const bool act = ch < NCH;
        int t, len;
        if (m < TL) { t = m % S; len = S; } else { t = (m - TL) % L; len = L; }
        float v[8];
#pragma unroll
        for (int e = 0; e < 8; ++e) v[e] = 0.f;
        if (act) {
            const bf16_t* z = p.Z + (size_t)m * ZP + ZA + c0;
            const bf16x8 zc = *(const bf16x8*)z;
            const f32x4 s1a = *(const f32x4*)(sh + A_IN + c0), s1b = *(const f32x4*)(sh + A_IN + c0 + 4);
#pragma unroll
            for (int e = 0; e < 8; ++e) v[e] = (e < 4 ? s1a[e] : s1b[e - 4]) * bf2f((bf16_t)zc[e]);
            if (t > 0) { const bf16x8 zp = *(const bf16x8*)(z - ZP); const f32x4 a = *(const f32x4*)(sh + c0), b = *(const f32x4*)(sh + c0 + 4);
#pragma unroll
                for (int e = 0; e < 8; ++e) v[e] += (e < 4 ? a[e] : b[e - 4]) * bf2f((bf16_t)zp[e]); }
            if (t < len - 1) { const bf16x8 zn = *(const bf16x8*)(z + ZP); const f32x4 a = *(const f32x4*)(sh + 2 * A_IN + c0), b = *(const f32x4*)(sh + 2 * A_IN + c0 + 4);
#pragma unroll
                for (int e = 0; e < 8; ++e) v[e] += (e < 4 ? a[e] : b[e - 4]) * bf2f((bf16_t)zn[e]); }
        }
        float nrm = 0.f;
        if (ch >= 32 && ch < 64) {
#pragma unroll
            for (int e = 0; e < 8; ++e) { const float t2 = v[e] * p.a_k_k[l * DA + c0 - 256 + e]; nrm += t2 * t2; } }
        nrm = sum8(nrm);
        if (!act) continue;
        if (c0 < 768) {
            float* dst = (c0 < 256 ? p.sR + (size_t)m * DA + c0 : c0 < 512 ? p.kT + (size_t)m * DA + c0 - 256 : p.sV + (size_t)m * DA + c0 - 512);
            *(f32x4*)dst = (f32x4){v[0], v[1], v[2], v[3]}; *(f32x4*)(dst + 4) = (f32x4){v[4], v[5], v[6], v[7]};
            if (ch >= 32 && ch < 64 && (ch & 7) == 0) p.kN[(size_t)m * 4 + ((ch - 32) >> 3)] = 1.0f / sqrtf(nrm + 1e-12f);
        } else {
            if (c0 < 896) {
#pragma unroll
                for (int e = 0; e < 8; ++e) v[e] = tanh_fast(v[e]); }
            else if (c0 >= 1024) {
#pragma unroll
                for (int e = 0; e < 8; ++e) v[e] = 1.0f / (1.0f + __expf(-v[e])); }
            uint4 o; o.x = pk2(v[0], v[1]); o.y = pk2(v[2], v[3]); o.z = pk2(v[4], v[5]); o.w = pk2(v[6], v[7]);
            *(uint4*)(p.LA + (size_t)m * 416 + c0 - 768) = o;
        }
    }
}
__device__ __forceinline__ void g_streams_s2(const Params& p, int l, char* lds) {
    const int tid_ = opq_tid(), bid_ = opq_bid(); (void)tid_; (void)bid_;
    constexpr int MT = T / 128;
    for (int job = bid_; job < 5 * MT * 2; job += gridDim.x) {
        const int type = job / (MT * 2), r = job % (MT * 2), tm = r >> 1, tn = r & 1;
        const int coff = type < 2 ? type * 64 : type < 4 ? 128 + (type - 2) * 64 : 256, K = type < 4 ? 64 : 160, d = type & 1;
        const bf16_t* Bt = type < 2 ? p.wupT + type * 256 * 64 : type < 4 ? p.aupT + (type - 2) * 256 * 64 : p.gupT;
        const bf16_t* a0 = p.LA + (size_t)(tm * 128 + STG_ROW(0)) * 416 + coff + STG_K; const bf16_t* a1 = p.LA + (size_t)(tm * 128 + STG_ROW(1)) * 416 + coff + STG_K;
        const bf16_t* b0 = Bt + (size_t)(tn * 128 + STG_ROW(0)) * K + STG_K; const bf16_t* b1 = Bt + (size_t)(tn * 128 + STG_ROW(1)) * K + STG_K;
        if (type < 2) gemm_tile(a0, a1, b0, b1, K, lds, [&](const f32x4 (&acc)[4][4], int wr, int wc, int fr, int fq) {
#pragma unroll
            for (int mi = 0; mi < 4; ++mi) {
#pragma unroll
                for (int n = 0; n < 4; ++n) { const int c = tn * 128 + wc * 64 + n * 16 + fr; const float w0 = p.a_w0[(l * 2 + d) * DA + c];
#pragma unroll
                    for (int j = 0; j < 4; ++j) { const int row = tm * 128 + wr * 64 + mi * 16 + fq * 4 + j;
                        const float e = __expf(-(w0 + acc[mi][n][j]));
                        p.sW[((size_t)d * T + row) * DA + c] = __expf(-0.60653065971f / (1.0f + e)); } }
                asm volatile("" ::: "memory"); }
        });
        else if (type < 4) gemm_tile(a0, a1, b0, b1, K, lds, [&](const f32x4 (&acc)[4][4], int wr, int wc, int fr, int fq) {
#pragma unroll
            for (int mi = 0; mi < 4; ++mi) {
#pragma unroll
                for (int n = 0; n < 4; ++n) { const int c = tn * 128 + wc * 64 + n * 16 + fr;
                    const float a0v = p.a_a0[(l * 2 + d) * DA + c], kkc = p.a_k_k[l * DA + c], kac = p.a_k_a[l * DA + c];
#pragma unroll
                    for (int j = 0; j < 4; ++j) { const int row = tm * 128 + wr * 64 + mi * 16 + fq * 4 + j;
                        const size_t o = (size_t)row * DA + c, od = ((size_t)d * T + row) * DA + c;
                        const float av = 1.0f / (1.0f + __expf(-(a0v + acc[mi][n][j]))); const float k = p.kT[o];
                        const float kk = k * kkc * p.kN[(size_t)row * 4 + (c >> 6)];
                        p.sKD[od] = k * (1.0f + (av - 1.0f) * kac); p.sB[od] = kk * av; if (d == 0) p.sKK[o] = kk; } }
                asm volatile("" ::: "memory"); }
        });
        else gemm_tile(a0, a1, b0, b1, K, lds, [&](const f32x4 (&acc)[4][4], int wr, int wc, int fr, int fq) {
#pragma unroll
            for (int mi = 0; mi < 4; ++mi)
#pragma unroll
                for (int n = 0; n < 4; ++n) { const int c = tn * 128 + wc * 64 + n * 16 + fr;
#pragma unroll
                    for (int j = 0; j < 4; ++j) p.sG[(size_t)(tm * 128 + wr * 64 + mi * 16 + fq * 4 + j) * DA + c] = acc[mi][n][j]; }
        });
    }
}


typedef float f32x16 __attribute__((ext_vector_type(16)));
typedef short s16x4 __attribute__((ext_vector_type(4)));
typedef unsigned u32x4_t __attribute__((ext_vector_type(4)));
typedef float f32x2_t __attribute__((ext_vector_type(2)));
typedef __bf16 bf16x2_t __attribute__((ext_vector_type(2)));
__device__ __forceinline__ unsigned cvtpk(float lo, float hi) { f32x2_t v = {lo, hi}; bf16x2_t b = __builtin_convertvector(v, bf16x2_t); return __builtin_bit_cast(unsigned, b); }
__device__ __forceinline__ int crow(int r, int hi) { return (r & 3) + 8 * (r >> 2) + 4 * hi; }

template <class MaskF>
__device__ __forceinline__ void attn_tile(const bf16x8 (&qf)[4], const bf16_t* krow, const bf16_t* vt0, const bf16_t* vt1, const MaskF& mask,
                                          float& m_run, float& l_run, f32x16& o0, f32x16& o1, int hi) {
    f32x16 s;
#pragma unroll
    for (int r = 0; r < 16; ++r) s[r] = 0.f;
#pragma unroll
    for (int ks = 0; ks < 4; ++ks) { const bf16x8 kf = *(const bf16x8*)(krow + 16 * ks); s = __builtin_amdgcn_mfma_f32_32x32x16_bf16(kf, qf[ks], s, 0, 0, 0); }
    float mx = -INFINITY;
#pragma unroll
    for (int r = 0; r < 16; ++r) { s[r] = mask(crow(r, hi), s[r] * ATT_SCALE); mx = fmaxf(mx, s[r]); }
    mx = fmaxf(mx, __shfl_xor(mx, 32));
    const float mn = fmaxf(m_run, mx), alpha = __expf(m_run - mn);
    m_run = mn;
    float ps = 0.f;
#pragma unroll
    for (int r = 0; r < 16; ++r) { s[r] = __expf(s[r] - mn); ps += s[r]; }
    l_run = l_run * alpha + ps;
#pragma unroll
    for (int r = 0; r < 16; ++r) { o0[r] *= alpha; o1[r] *= alpha; }
#pragma unroll
    for (int s2 = 0; s2 < 2; ++s2) {
        u32x4_t pw; pw[0] = cvtpk(s[8 * s2], s[8 * s2 + 1]); pw[1] = cvtpk(s[8 * s2 + 2], s[8 * s2 + 3]); pw[2] = cvtpk(s[8 * s2 + 4], s[8 * s2 + 5]); pw[3] = cvtpk(s[8 * s2 + 6], s[8 * s2 + 7]);
        const bf16x8 pb = __builtin_bit_cast(bf16x8, pw);
        const s16x4 a0 = *(const s16x4*)(vt0 + 16 * s2), a1 = *(const s16x4*)(vt0 + 16 * s2 + 8);
        const s16x4 c0 = *(const s16x4*)(vt1 + 16 * s2), c1 = *(const s16x4*)(vt1 + 16 * s2 + 8);
        o0 = __builtin_amdgcn_mfma_f32_32x32x16_bf16(__builtin_shufflevector(a0, a1, 0, 1, 2, 3, 4, 5, 6, 7), pb, o0, 0, 0, 0);
        o1 = __builtin_amdgcn_mfma_f32_32x32x16_bf16(__builtin_shufflevector(c0, c1, 0, 1, 2, 3, 4, 5, 6, 7), pb, o1, 0, 0, 0);
    }
}
struct NoMask { __device__ __forceinline__ float operator()(int, float v) const { return v; } };

__device__ __forceinline__ void ph_attn_mfma(const Params& p, int l, bool with_ctx) {
    const int tid_ = opq_tid(), bid_ = opq_bid(); (void)tid_; (void)bid_;
    const int lane = tid_ & 63, hi = lane >> 5, ql = lane & 31;
    const int gw = bid_ * 4 + (tid_ >> 6), nw = gridDim.x * 4;
    constexpr int NQT = S / 32, NCT = L / 32, N_LAT = NB * 6 * NQT, N_CTX = NB * 6 * NCT;
    const int ntask = 2 * N_LAT + (with_ctx ? 2 * N_CTX : 0);
    for (int task = gw; task < ntask; task += nw) {
        bool isC, isCtx; int r;
        if (task < N_LAT) { isC = true; isCtx = false; r = task; }
        else if (task < 2 * N_LAT) { isC = false; isCtx = false; r = task - N_LAT; }
        else { r = task - 2 * N_LAT; isCtx = true; isC = r >= N_CTX; if (isC) r -= N_CTX; }
        const int nqt = isCtx ? NCT : NQT, qt = r % nqt, h = (r / nqt) % 6, b = r / (nqt * 6);
        const int m = isCtx ? TL + b * L + 32 * qt + ql : b * S + 32 * qt + ql;
        const int qcol = isC ? ZQN + h * 64 : ZQB + h * 64, kcol = isC ? ZKN + h * 64 : ZKB + (h / 3) * 64, hv = isC ? 2 + h : h / 3;
        bf16x8 qf[4];
        { const bf16_t* qp = p.Z + (size_t)m * ZP + qcol + 8 * hi;
#pragma unroll
          for (int ks = 0; ks < 4; ++ks) qf[ks] = *(const bf16x8*)(qp + 16 * ks); }
        const bf16_t* kc0 = p.Z + (size_t)(TL + b * L + ql) * ZP + kcol + 8 * hi;
        const bf16_t* kl0 = p.Z + (size_t)(b * S + ql) * ZP + kcol + 8 * hi;
        const bf16_t* vt0 = p.VT + ((size_t)(b * 8 + hv) * 64 + ql) * PU + 4 * hi; const bf16_t* vt1 = vt0 + (size_t)32 * PU;
        f32x16 o0, o1;
#pragma unroll
        for (int rr = 0; rr < 16; ++rr) { o0[rr] = 0.f; o1[rr] = 0.f; }
        float m_run, l_run;
        if (isC) { m_run = -1e30f; l_run = 0.f; } else { m_run = p.b_sink[l * 6 + h]; l_run = hi == 0 ? 1.0f : 0.f; }
#pragma unroll 1
        for (int i = 0; i < NCT; ++i) attn_tile(qf, kc0 + (size_t)(32 * i) * ZP, vt0 + 32 * i, vt1 + 32 * i, NoMask(), m_run, l_run, o0, o1, hi);
        if (!isCtx) {
            if (!isC) {
#pragma unroll 1
                for (int jt = qt - 4; jt <= qt + 4; ++jt) {
                    if (jt < 0 || jt >= NQT) continue;
                    const bf16_t* kr = kl0 + (size_t)(32 * jt) * ZP; const bf16_t* v0 = vt0 + L + 32 * jt; const bf16_t* v1 = vt1 + L + 32 * jt;
                    if (jt == qt - 4 || jt == qt + 4) { const int base = 32 * (jt - qt) - ql;
                        attn_tile(qf, kr, v0, v1, [&](int ko, float v) { const int rel = base + ko; return (rel >= -128 && rel <= 128) ? v : -INFINITY; }, m_run, l_run, o0, o1, hi); }
                    else attn_tile(qf, kr, v0, v1, NoMask(), m_run, l_run, o0, o1, hi);
                }
            } else {
                constexpr int ROWS = S / GRID_W;
                const int gr = qt >> 1, c = 32 * (qt & 1) + ql;
                int r0 = gr - 4; r0 = r0 < 0 ? 0 : (r0 > ROWS - 8 ? ROWS - 8 : r0);
                int c0 = c - 8; c0 = c0 < 0 ? 0 : (c0 > GRID_W - 16 ? GRID_W - 16 : c0);
                const float* rpb = p.c_rpb + ((size_t)l * 6 + h) * 15 * 31;
#pragma unroll 1
                for (int a = 0; a < 8; ++a) {
                    const int kr_ = r0 + a; const float* rp = rpb + (kr_ - gr + 7) * 31 + 15 - c;
#pragma unroll 1
                    for (int ct = 0; ct < 2; ++ct) {
                        const int t0 = kr_ * GRID_W + 32 * ct;
                        attn_tile(qf, kl0 + (size_t)t0 * ZP, vt0 + L + t0, vt1 + L + t0,
                                  [&](int ko, float v) { const int kc = 32 * ct + ko; return (kc >= c0 && kc < c0 + 16) ? v + rp[kc] : -INFINITY; }, m_run, l_run, o0, o1, hi);
                    }
                }
            }
        }
        const float lt = l_run + __shfl_xor(l_run, 32), inv = 1.0f / lt;
        bf16_t* op = p.MIX + (size_t)m * DMIX + (isC ? 640 : 256) + h * 64 + 4 * hi;
#pragma unroll
        for (int g = 0; g < 4; ++g) {
            st_bf16x4(op + 8 * g, (f32x4){o0[4 * g] * inv, o0[4 * g + 1] * inv, o0[4 * g + 2] * inv, o0[4 * g + 3] * inv});
            st_bf16x4(op + 32 + 8 * g, (f32x4){o1[4 * g] * inv, o1[4 * g + 1] * inv, o1[4 * g + 2] * inv, o1[4 * g + 3] * inv});
        }
    }
}


#define RNB " row_newbcast:%c[n] row_mask:0xf bank_mask:0xf\n\t"
template <int N, bool FIRST>
__device__ __forceinline__ void dpp_dot4(float& a0, float& a1, float& a2, float& a3, const f32x4& v, float s0, float s1, float s2, float s3) {
    if (FIRST) asm volatile("s_nop 1");
    asm("v_fmac_f32_dpp %0, %4, %8" RNB "v_fmac_f32_dpp %1, %5, %9" RNB "v_fmac_f32_dpp %2, %6, %10" RNB "v_fmac_f32_dpp %3, %7, %11" RNB
        : "+v"(a0), "+v"(a1), "+v"(a2), "+v"(a3) : "v"(v[0]), "v"(v[1]), "v"(v[2]), "v"(v[3]), "v"(s0), "v"(s1), "v"(s2), "v"(s3), [n] "i"(N));
}
template <int N, bool FIRST>
__device__ __forceinline__ void dpp_upd4s(float& s0, float& s1, float& s2, float& s3, float& y0, float& y1, float& y2, float& y3,
                                          const f32x4& w, const f32x4& b, const f32x4& kd, const f32x4& r, float nsk, float vv) {
    if (FIRST) asm volatile("s_nop 1");
    asm("v_mul_f32_dpp %0, %8, %0" RNB "v_mul_f32_dpp %1, %9, %1" RNB "v_mul_f32_dpp %2, %10, %2" RNB "v_mul_f32_dpp %3, %11, %3" RNB
        "v_fmac_f32_dpp %0, %12, %24" RNB "v_fmac_f32_dpp %1, %13, %24" RNB "v_fmac_f32_dpp %2, %14, %24" RNB "v_fmac_f32_dpp %3, %15, %24" RNB
        "v_fmac_f32_dpp %0, %16, %25" RNB "v_fmac_f32_dpp %1, %17, %25" RNB "v_fmac_f32_dpp %2, %18, %25" RNB "v_fmac_f32_dpp %3, %19, %25" RNB
        "v_fmac_f32_dpp %4, %20, %0" RNB "v_fmac_f32_dpp %5, %21, %1" RNB "v_fmac_f32_dpp %6, %22, %2" RNB "v_fmac_f32_dpp %7, %23, %3" RNB
        : "+v"(s0), "+v"(s1), "+v"(s2), "+v"(s3), "+v"(y0), "+v"(y1), "+v"(y2), "+v"(y3)
        : "v"(w[0]), "v"(w[1]), "v"(w[2]), "v"(w[3]), "v"(b[0]), "v"(b[1]), "v"(b[2]), "v"(b[3]), "v"(kd[0]), "v"(kd[1]), "v"(kd[2]), "v"(kd[3]),
          "v"(r[0]), "v"(r[1]), "v"(r[2]), "v"(r[3]), "v"(nsk), "v"(vv), [n] "i"(N));
}
template <int N, bool FIRST>
__device__ __forceinline__ void dpp_upd4p(float& s0, float& s1, float& s2, float& s3, float& y0, float& y1, float& y2, float& y3,
                                          const f32x4& w, const f32x4& b, const f32x4& r, float nsk) {
    if (FIRST) asm volatile("s_nop 1");
    asm("v_mul_f32_dpp %0, %8, %0" RNB "v_mul_f32_dpp %1, %9, %1" RNB "v_mul_f32_dpp %2, %10, %2" RNB "v_mul_f32_dpp %3, %11, %3" RNB
        "v_fmac_f32_dpp %0, %12, %20" RNB "v_fmac_f32_dpp %1, %13, %20" RNB "v_fmac_f32_dpp %2, %14, %20" RNB "v_fmac_f32_dpp %3, %15, %20" RNB
        "v_fmac_f32_dpp %4, %16, %0" RNB "v_fmac_f32_dpp %5, %17, %1" RNB "v_fmac_f32_dpp %6, %18, %2" RNB "v_fmac_f32_dpp %7, %19, %3" RNB
        : "+v"(s0), "+v"(s1), "+v"(s2), "+v"(s3), "+v"(y0), "+v"(y1), "+v"(y2), "+v"(y3)
        : "v"(w[0]), "v"(w[1]), "v"(w[2]), "v"(w[3]), "v"(b[0]), "v"(b[1]), "v"(b[2]), "v"(b[3]), "v"(r[0]), "v"(r[1]), "v"(r[2]), "v"(r[3]), "v"(nsk), [n] "i"(N));
}
template <int N> struct ScanRep {
    static __device__ __forceinline__ void dot(float& a0, float& a1, float& a2, float& a3, const f32x4& v, const float (&st)[64]) {
        dpp_dot4<N, N == 0>(a0, a1, a2, a3, v, st[4 * N], st[4 * N + 1], st[4 * N + 2], st[4 * N + 3]);
        if constexpr (N < 15) ScanRep<N + 1>::dot(a0, a1, a2, a3, v, st);
    }
    static __device__ __forceinline__ void upds(float (&st)[64], float& y0, float& y1, float& y2, float& y3, const f32x4& w, const f32x4& b, const f32x4& kd, const f32x4& r, float nsk, float vv) {
        dpp_upd4s<N, N == 0>(st[4 * N], st[4 * N + 1], st[4 * N + 2], st[4 * N + 3], y0, y1, y2, y3, w, b, kd, r, nsk, vv);
        if constexpr (N < 15) ScanRep<N + 1>::upds(st, y0, y1, y2, y3, w, b, kd, r, nsk, vv);
    }
    static __device__ __forceinline__ void updp(float (&st)[64], float& y0, float& y1, float& y2, float& y3, const f32x4& w, const f32x4& b, const f32x4& r, float nsk) {
        dpp_upd4p<N, N == 0>(st[4 * N], st[4 * N + 1], st[4 * N + 2], st[4 * N + 3], y0, y1, y2, y3, w, b, r, nsk);
        if constexpr (N < 15) ScanRep<N + 1>::updp(st, y0, y1, y2, y3, w, b, r, nsk);
    }
};
__device__ __forceinline__ int seg_row0(int b, int d, int s) { const int pos0 = 128 * s; return pos0 < L ? TL + b * L + (d ? L - 1 - pos0 : pos0) : b * S + (d ? S - 1 - (pos0 - L) : pos0 - L); }

template <bool ISP>
__device__ __forceinline__ void scan_task(const Params& p, int c, int s, int lane) {
    const int h = c & 3, b = (c >> 2) % NB, d = (c >> 2) / NB;
    const int m0 = seg_row0(b, d, s); const long step = d ? -(long)DA : (long)DA;
    const size_t o = (size_t)m0 * DA + h * 64, od = ((size_t)d * T + m0) * DA + h * 64; const int q = 4 * (lane & 15);
    const float* pkk = p.sKK + o + q; const float* pr = p.sR + o + q; const float* pw = p.sW + od + q; const float* pb = p.sB + od + q;
    const float* pkd = p.sKD + od + q; const float* pv = p.sV + o + lane;
    float* py = (ISP ? p.PV : p.Y) + od + lane;
    float st[64];
#pragma unroll
    for (int k = 0; k < 64; ++k) st[k] = (ISP && k == lane) ? 1.0f : 0.f;
    f32x4 kk = *(const f32x4*)pkk, w = *(const f32x4*)pw, bb = *(const f32x4*)pb, r = *(const f32x4*)pr, kd = w; float vv = 0.f;
    if (!ISP) { kd = *(const f32x4*)pkd; vv = *pv; }
#pragma unroll 1
    for (int i = 0; i < 128; ++i) {
        const long nx = (i < 127) ? step : 0;
        pkk += nx; pw += nx; pb += nx; pr += nx; pkd += nx; pv += nx;
        const f32x4 nkk = *(const f32x4*)pkk, nw = *(const f32x4*)pw, nb = *(const f32x4*)pb, nr = *(const f32x4*)pr;
        f32x4 nkd = nw; float nv = 0.f;
        if (!ISP) { nkd = *(const f32x4*)pkd; nv = *pv; }
        float a0 = 0.f, a1 = 0.f, a2 = 0.f, a3 = 0.f;
        ScanRep<0>::dot(a0, a1, a2, a3, kk, st);
        const float nsk = -((a0 + a1) + (a2 + a3));
        float y0 = 0.f, y1 = 0.f, y2 = 0.f, y3 = 0.f;
        if (ISP) ScanRep<0>::updp(st, y0, y1, y2, y3, w, bb, r, nsk); else ScanRep<0>::upds(st, y0, y1, y2, y3, w, bb, kd, r, nsk, vv);
        *py = (y0 + y1) + (y2 + y3); py += step;
        kk = nkk; w = nw; bb = nb; r = nr; kd = nkd; vv = nv;
    }
    if (s < NSG - 1) {
        float* dst = (ISP ? p.PS : p.QS) + (((size_t)c * NSG + s) * 64 + lane) * 64;
#pragma unroll
        for (int k4 = 0; k4 < 16; ++k4) *(f32x4*)(dst + 4 * k4) = (f32x4){st[4 * k4], st[4 * k4 + 1], st[4 * k4 + 2], st[4 * k4 + 3]};
    }
}
__device__ __forceinline__ void ph_scan_fast(const Params& p) {
    const int tid_ = opq_tid(), bid_ = opq_bid(); (void)tid_; (void)bid_;
    const int lane = tid_ & 63, gw = bid_ * 4 + (tid_ >> 6), nw = gridDim.x * 4;
    constexpr int NS_T = 64 * NSG, NP_T = 64 * (NSG - 1);
    for (int tsk = gw; tsk < NS_T + NP_T; tsk += nw) {
        const int t2 = __builtin_amdgcn_readfirstlane(tsk);
        if (t2 < NS_T) scan_task<false>(p, t2 & 63, t2 >> 6, lane);
        else scan_task<true>(p, (t2 - NS_T) & 63, 1 + ((t2 - NS_T) >> 6), lane);
    }
}
__device__ __forceinline__ void ph_combine(const Params& p, char* lds) {
    const int tid_ = opq_tid(), bid_ = opq_bid(); (void)tid_; (void)bid_;
    if (bid_ >= 64) return;
    const int c = bid_, tid = tid_, v = tid >> 2, jq = tid & 3;
    float* SSc = (float*)lds; float* Pm = (float*)(lds + 64 * 65 * 4 + 16);
    const float* QSc = p.QS + (size_t)c * NSG * 4096; const float* PSc = p.PS + (size_t)c * NSG * 4096; float* SSg = p.SS + (size_t)c * NSG * 4096;
    f32x4 acc[4], nP[4], nQ[4];
#pragma unroll
    for (int i = 0; i < 4; ++i) { acc[i] = *(const f32x4*)(QSc + v * 64 + 16 * jq + 4 * i); *(f32x4*)(SSg + 4096 + v * 64 + 16 * jq + 4 * i) = acc[i];
#pragma unroll
        for (int e = 0; e < 4; ++e) SSc[v * 65 + 16 * jq + 4 * i + e] = acc[i][e]; }
#pragma unroll
    for (int i = 0; i < 4; ++i) { nP[i] = ((const f32x4*)(PSc + (size_t)4096))[tid + 256 * i]; nQ[i] = *(const f32x4*)(QSc + (size_t)4096 + v * 64 + 16 * jq + 4 * i); }
    for (int s = 1; s < NSG - 1; ++s) {
#pragma unroll
        for (int i = 0; i < 4; ++i) { ((f32x4*)Pm)[tid + 256 * i] = nP[i]; acc[i] = nQ[i]; }
        __syncthreads();
        if (s + 1 < NSG - 1) {
#pragma unroll
            for (int i = 0; i < 4; ++i) { nP[i] = ((const f32x4*)(PSc + (size_t)(s + 1) * 4096))[tid + 256 * i]; nQ[i] = *(const f32x4*)(QSc + (size_t)(s + 1) * 4096 + v * 64 + 16 * jq + 4 * i); }
        }
#pragma unroll 8
        for (int k = 0; k < 64; ++k) { const float a = SSc[v * 65 + k];
#pragma unroll
            for (int i = 0; i < 4; ++i) acc[i] += ((const f32x4*)Pm)[k * 16 + 4 * jq + i] * a; }
        __syncthreads();
#pragma unroll
        for (int i = 0; i < 4; ++i) { *(f32x4*)(SSg + (size_t)(s + 1) * 4096 + v * 64 + 16 * jq + 4 * i) = acc[i];
#pragma unroll
            for (int e = 0; e < 4; ++e) SSc[v * 65 + 16 * jq + 4 * i + e] = acc[i][e]; }
    }
}
__device__ __forceinline__ void ph_rwkv_out_fast(const Params& p, int l, bool with_ctx) {
    const int tid_ = opq_tid(), bid_ = opq_bid(); (void)tid_; (void)bid_;
    const int lane = tid_ & 63, gw = bid_ * 4 + (tid_ >> 6), nw = gridDim.x * 4;
    constexpr int TOK = 16, NLT = NB * (S / TOK) * 4, NCTK = NB * (L / TOK) * 4;
    const int ntask = NLT + (with_ctx ? NCTK : 0);
    for (int tsk = gw; tsk < ntask; tsk += nw) {
        const bool isCtx = tsk >= NLT; const int r = isCtx ? tsk - NLT : tsk;
        const int h = r & 3, npt = isCtx ? L / TOK : S / TOK, tt = (r >> 2) % npt, b = (r >> 2) / npt, t128 = tt / (128 / TOK);
        const int seg0 = isCtx ? t128 : L / 128 + t128, seg1 = isCtx ? (L / 128 - 1) - t128 : L / 128 + (S / 128 - 1) - t128;
        const int mbase = isCtx ? TL + b * L + TOK * tt : b * S + TOK * tt;
        float ss0[64], ss1[64];
        { const float* s0p = p.SS + ((((size_t)(0 * NB + b) * 4 + h) * NSG + seg0) * 64 + lane) * 64; const float* s1p = p.SS + ((((size_t)(1 * NB + b) * 4 + h) * NSG + seg1) * 64 + lane) * 64;
#pragma unroll
          for (int k4 = 0; k4 < 16; ++k4) { f32x4 a = {0.f, 0.f, 0.f, 0.f}, c2 = a; if (seg0 > 0) a = *(const f32x4*)(s0p + 4 * k4); if (seg1 > 0) c2 = *(const f32x4*)(s1p + 4 * k4);
#pragma unroll
              for (int e = 0; e < 4; ++e) { ss0[4 * k4 + e] = a[e]; ss1[4 * k4 + e] = c2[e]; } } }
        const float rk = p.a_r_k[l * DA + h * 64 + lane], gln = p.a_lnx_g[l * DA + h * 64 + lane], bln = p.a_lnx_b[l * DA + h * 64 + lane];
        f32x4 pv0 = {0.f, 0.f, 0.f, 0.f}, pv1 = pv0; float y0l, y1l, rr, kds, vv, gg;
#define ROUT_LOAD(i_) do { const size_t o_ = (size_t)(mbase + (i_)) * DA + h * 64, o1_ = o_ + (size_t)T * DA; \
            if (seg0 > 0) pv0 = *(const f32x4*)(p.PV + o_ + 4 * (lane & 15)); if (seg1 > 0) pv1 = *(const f32x4*)(p.PV + o1_ + 4 * (lane & 15)); \
            y0l = p.Y[o_ + lane]; y1l = p.Y[o1_ + lane]; rr = p.sR[o_ + lane]; kds = p.sKD[o_ + lane] + p.sKD[o1_ + lane]; vv = p.sV[o_ + lane]; gg = p.sG[o_ + lane]; } while (0)
        ROUT_LOAD(0);
#pragma unroll 1
        for (int i = 0; i < TOK; ++i) {
            const f32x4 cpv0 = pv0, cpv1 = pv1; float a0 = y0l, a1 = y1l, a2 = 0.f, a3 = 0.f; const float crr = rr, ckds = kds, cvv = vv, cgg = gg;
            ROUT_LOAD(i + 1 < TOK ? i + 1 : i);
            ScanRep<0>::dot(a0, a1, a2, a3, cpv0, ss0);
            ScanRep<0>::dot(a0, a1, a2, a3, cpv1, ss1);
            const float y = (a0 + a1) + (a2 + a3);
            const float mu = wave_sum(y) * (1.0f / 64.f), dy = y - mu;
            const float rstd = 1.0f / sqrtf(wave_sum(dy * dy) * (1.0f / 64.f) + GN_EPS);
            const float bon = wave_sum(crr * ckds * rk);
            p.MIX[(size_t)(mbase + i) * DMIX + h * 64 + lane] = f2bf((dy * rstd * gln + bln + bon * cvv) * cgg);
        }
#undef ROUT_LOAD
    }
}


#define LAS __attribute__((address_space(3)))
#define XB_TMO      128
#define XB_XCNT(j)  (256  + 64 * (j))
#define XB_XSUB(j)  (1280 + 64 * (j))
#define XB_XGEN(j)  (2304 + 64 * (j))
#define XB_TOP      3328
#define XB_TOPGEN   3392
#define XCD_BAR_WORDS 3456
#define XB_SPIN_CAP (1u << 20)
static_assert(XCD_BAR_WORDS * 4 <= 16384, "barrier words fit the control region");
__device__ __forceinline__ unsigned xb_ld(unsigned* p)              { return __hip_atomic_load(p, __ATOMIC_RELAXED, __HIP_MEMORY_SCOPE_AGENT); }
__device__ __forceinline__ unsigned xb_add(unsigned* p, unsigned v) { return __hip_atomic_fetch_add(p, v, __ATOMIC_RELAXED, __HIP_MEMORY_SCOPE_AGENT); }
__device__ __forceinline__ unsigned xb_xcc_id() { return (unsigned)__builtin_amdgcn_s_getreg((3 << 11) | 20) & 0xFu; }
#define XB_SPIN(cond, bar) do { unsigned _sp = 0; while (cond) { __builtin_amdgcn_s_sleep(1); \
    if ((++_sp & 255u) == 0u) { if (xb_ld(&(bar)[XB_TMO])) break; if (_sp > XB_SPIN_CAP) { atomicAdd(&(bar)[XB_TMO], 1u); break; } } } } while (0)
struct XcdBarrier { unsigned* bar; unsigned x; volatile LAS unsigned* st; };
__device__ __forceinline__ XcdBarrier xcd_barrier_post(unsigned* bar, volatile LAS unsigned* st) {
    XcdBarrier b; b.bar = bar; b.x = xb_xcc_id(); b.st = st;
    if (threadIdx.x == 0) (void)xb_add(&bar[XB_XCNT(b.x)], 1u);
    return b;
}
__device__ __forceinline__ void xcd_barrier_complete(unsigned* bar, unsigned x, unsigned& nloc, unsigned& nx) {
    const unsigned G = gridDim.x * gridDim.y * gridDim.z;
    unsigned sum, cnt, mine, sp = 0u;
    for (;;) {
        sum = 0u; cnt = 0u; mine = 0u;
#pragma unroll
        for (unsigned j = 0; j < 16; ++j) { const unsigned c = xb_ld(&bar[XB_XCNT(j)]); sum += c; cnt += (c > 0u) ? 1u : 0u; mine = (j == x) ? c : mine; }
        if (sum == G) break;
        __builtin_amdgcn_s_sleep(1);
        if ((++sp & 255u) == 0u) { if (xb_ld(&bar[XB_TMO])) break; if (sp > XB_SPIN_CAP) { atomicAdd(&bar[XB_TMO], 1u); break; } }
    }
    nloc = mine > 0u ? mine : 1u; nx = cnt > 0u ? cnt : 1u;
}
__device__ __forceinline__ void xcd_barrier(const XcdBarrier& b) {
    asm volatile("s_waitcnt vmcnt(0)" ::: "memory");
    __syncthreads();
    if (threadIdx.x == 0) {
        unsigned* bar = b.bar;
        __builtin_amdgcn_s_waitcnt(0);
        unsigned nloc = b.st[0], nx = b.st[1];
        if (nloc == 0u) { xcd_barrier_complete(bar, b.x, nloc, nx); b.st[0] = nloc; b.st[1] = nx; }
        const unsigned old = xb_add(&bar[XB_XSUB(b.x)], 1u);
        const unsigned gen = old / nloc;
        if (old + 1u == (gen + 1u) * nloc) {
            __builtin_amdgcn_fence(__ATOMIC_RELEASE, "agent");
            asm volatile("s_waitcnt vmcnt(0)" ::: "memory");
            const unsigned og = xb_add(&bar[XB_TOP], 1u);
            const unsigned tg = og / nx;
            if (og + 1u == (tg + 1u) * nx) xb_add(&bar[XB_TOPGEN], 1u);
            else XB_SPIN(xb_ld(&bar[XB_TOPGEN]) == tg, bar);
            __builtin_amdgcn_fence(__ATOMIC_ACQUIRE, "agent");
            xb_add(&bar[XB_XGEN(b.x)], 1u);
            asm volatile("s_waitcnt vmcnt(0)" ::: "memory");
        } else {
            XB_SPIN(xb_ld(&bar[XB_XGEN(b.x)]) == gen, bar);
            __builtin_amdgcn_fence(__ATOMIC_ACQUIRE, "agent");
            asm volatile("s_waitcnt vmcnt(0)" ::: "memory");
        }
    }
    __syncthreads();
}

#define GT ((long)blockIdx.x * blockDim.x + threadIdx.x)
#define GS ((long)gridDim.x * blockDim.x)
__global__ void __launch_bounds__(256, 2) mega_fwd(Params p) {
    __shared__ __attribute__((aligned(16))) char lds[49152 + 64];
    cg::grid_group grid = cg::this_grid();
    const long gt = GT, gs = GS;
    volatile LAS unsigned* bst = (volatile LAS unsigned*)(LAS char*)(lds + 49152);
    if (threadIdx.x < 2) bst[threadIdx.x] = 0u;
    __syncthreads();
    const XcdBarrier xb = xcd_barrier_post(p.bar, bst);
#ifndef PROBE_PHASE
#define PROBE_PHASE -1
#endif
#define PROBE_AMP 8
    unsigned long long t_prev = 0; int nts = 0;
#define STAMP() do { if (PROBE_PHASE >= 0 && blockIdx.x == 0 && threadIdx.x == 0) { const unsigned long long t_now = __builtin_amdgcn_s_memrealtime(); \
        if (nts == PROBE_PHASE + 1) { const unsigned long long t_end = t_now + PROBE_AMP * (t_now - t_prev); while (__builtin_amdgcn_s_memrealtime() < t_end) __builtin_amdgcn_s_sleep(8); } \
        t_prev = __builtin_amdgcn_s_memrealtime(); } ++nts; } while (0)
#define GSYNC() do { xcd_barrier(xb); STAMP(); } while (0)
    STAMP();
    ph_mod_fast(p, lds); ph_prep_w_fast(p, 0, 0, lds); ph_prep_misc(p, 0, gt, gs, false);
    grid.sync(); STAMP();
    for (int l = 0; l < 2; ++l) {
        const int nrows = (l == 0) ? T : TL;
        ph_lnmod_fast(p, l);
        GSYNC();
        g_gemm_in(p, lds);
        GSYNC();
        ph_streams_s1(p, l);
        GSYNC();
        g_streams_s2(p, l, lds);
        GSYNC();
        ph_scan_fast(p);
        GSYNC();
        ph_combine(p, lds); ph_attn_mfma(p, l, l == 0);
        GSYNC();
        ph_rwkv_out_fast(p, l, l == 0);
        GSYNC();
        g_gemm_out(p, nrows, lds); ph_prep_w_fast(p, l, 1, lds);
        GSYNC();
        ph_post_mixer_fast(p, l, nrows);
        GSYNC();
        g_router(p, l, nrows, lds);
        GSYNC();
        ph_dispatch(p, l, nrows, gt, gs);
        GSYNC();
        g_moe1(p, l, lds);
        GSYNC();
        g_moe2(p, l, lds);
        GSYNC();
        ph_final_fast(p, l, nrows);
        if (l == 0) { ph_prep_w_fast(p, 1, 0, lds); ph_prep_misc(p, 1, gt, gs, false); }
        GSYNC();
    }}

extern "C" void kernel_launch(void* const* d_in, const int* in_sizes, int n_in, void* d_out, int out_size, void* d_ws, size_t ws_size, hipStream_t stream) {
    if (n_in != 32 || out_size != TL * D || ws_size < WS_NEED) { fprintf(stderr, "kernel_launch: unexpected shapes / workspace (n_in %d out %d ws %zu need %zu)\n", n_in, out_size, ws_size, (size_t)WS_NEED); return; }
    static int grid_blocks = 0;
    if (!grid_blocks) {
        int dev = 0, cus = 0, per_cu = 0;
        (void)hipGetDevice(&dev);
        (void)hipDeviceGetAttribute(&cus, hipDeviceAttributeMultiprocessorCount, dev);
        (void)hipOccupancyMaxActiveBlocksPerMultiprocessor(&per_cu, mega_fwd, 256, 0);
        if (per_cu < 1) per_cu = 1;
        if (per_cu > 2) per_cu = 2;
        grid_blocks = cus * per_cu;
        fprintf(stderr, "kernel_launch: %d CUs x %d blocks\n", cus, per_cu);
    }
    Params p = make_params(d_in, d_out, d_ws);
    (void)hipMemsetAsync(d_ws, 0, CTL_BYTES, stream);
    void* args[] = {&p};
    hipError_t e = hipLaunchCooperativeKernel((void*)mega_fwd, dim3(grid_blocks), dim3(256), args, 0, stream);
    if (e != hipSuccess) fprintf(stderr, "cooperative launch failed: %s (grid %d)\n", hipGetErrorString(e), grid_blocks);
}
#endif

#ifdef HOST_EMU
static void host_forward(void* const* d_in, void* d_out, void* d_ws) {
    const Params p = make_params(d_in, d_out, d_ws);
    for (int l = 0; l < 2; ++l) {
        const int nrows = (l == 0) ? T : TL;
        ph_prep_w(p, l, 0, 1); ph_prep_misc(p, l, 0, 1); ph_lnmod(p, l, 0, 1); host_gemm_in(p); ph_streams(p, l, 0, 1); ph_rope(p, 0, 1); ph_scan(p, 0, 1);
        ph_attn(p, l, nrows, 0, 1); ph_rwkv_out(p, l, nrows, 0, 1); host_gemm_out(p, nrows); ph_post_mixer(p, l, nrows, 0, 1);
        ph_dispatch(p, l, nrows, 0, 1); host_moe1(p, l); host_moe2(p, l); ph_final(p, l, nrows, 0, 1);
    }
}
#endif
```

```cpp
#ifdef HOST_EMU
#include <cmath>
#include <cstdio>
#include <cstring>
#include <cstdint>
#include <cstdlib>
#define __device__
#define __global__
#define __host__
#define __forceinline__ inline
#else
#include <hip/hip_runtime.h>
#include <hip/hip_cooperative_groups.h>
#include <cstdio>
#include <cstdint>
namespace cg = cooperative_groups;
#endif

#ifndef CFG_D
#define CFG_D 1024
#define CFG_B 8
#define CFG_S 2048
#define CFG_L 256
#define CFG_DE 512
#endif
constexpr int D = CFG_D, NB = CFG_B, S = CFG_S, L = CFG_L, DE = CFG_DE;
constexpr int TL = NB * S, TC = NB * L, T = TL + TC;
constexpr int GRID_W = 64, HD = 64;
constexpr int DA = 256, A_IN = 1184, N_IN = 2976, NINP = 3072, DMIX = 1024;
constexpr int NEXP = 32, NSLOT = 2 * T + NEXP * 128;
constexpr int ZQB = 0, ZKB = 384, ZVB = 512, ZQN = 640, ZKN = 1024, ZVN = 1408, ZA = 1792, ZP = 2976;
constexpr float LN_EPS = 1e-6f, GN_EPS = 64e-5f, ATT_SCALE = 0.125f;
constexpr float ALPHA = 1.41421356237309515f;

typedef unsigned short bf16_t;

__device__ __forceinline__ float bf2f(bf16_t v) {
    unsigned u = ((unsigned)v) << 16; float f;
#ifdef HOST_EMU
    memcpy(&f, &u, 4);
#else
    f = __uint_as_float(u);
#endif
    return f;
}
__device__ __forceinline__ bf16_t f2bf(float f) {
    unsigned u;
#ifdef HOST_EMU
    memcpy(&u, &f, 4);
#else
    u = __float_as_uint(f);
#endif
    return (bf16_t)((u + 0x7fffu + ((u >> 16) & 1u)) >> 16);
}
__device__ __forceinline__ float sigmoidf_(float x) { return 1.0f / (1.0f + expf(-x)); }
__device__ __forceinline__ float siluf_(float x) { return x / (1.0f + expf(-x)); }
__device__ __forceinline__ int atomic_inc_int(int* p) {
#ifdef HOST_EMU
    int o = *p; *p = o + 1; return o;
#else
    return atomicAdd(p, 1);
#endif
}

struct Params {
    const float *x, *c, *ctx, *c_ctx, *w_mod, *b_mod, *w_in, *w_out, *a_shift, *a_w0, *a_w_up, *a_a0, *a_a_up, *a_g_up,
        *a_k_k, *a_k_a, *a_r_k, *a_lnx_g, *a_lnx_b, *b_sink, *c_rpb, *ln1_g, *ln1_b, *ln2_g, *ln2_b, *w_rg, *b_rg, *w_re,
        *b_re, *w_gate, *w_up, *w_down;
    float* out;
    int* cnt;
    unsigned* bar;
    float* mod;
    float* rope;
    bf16_t *win_t, *wout_t, *wgu_t, *wd_t;
    bf16_t *wrt;
    float* LG;
    bf16_t* HLO;
    bf16_t *wupT, *aupT, *gupT;
    bf16_t* LA;
    float *kT, *kN;
    bf16_t* H;
    bf16_t* Z;
    bf16_t* VT;
    float *sR, *sV, *sKK, *sG, *sW, *sKD, *sB;
    float* Y;
    bf16_t* MIX;
    float *PV, *QS, *PS, *SS;
    float* XC;
    float* O;
    int *rE, *rPos, *rSlot; float* rW;
    int* slotTok;
    bf16_t* ACT;
    float* YS;
};

constexpr size_t al256(size_t v) { return (v + 255) & ~(size_t)255; }
constexpr size_t OFF_CNT = 0;
constexpr size_t OFF_BAR = 4096, CTL_BYTES = 4096 + 16384;
constexpr size_t OFF_MOD = CTL_BYTES;
constexpr size_t OFF_ROPE = al256(OFF_MOD + (size_t)2 * (NB + 1) * 6 * D * 4);
constexpr size_t OFF_LORA = al256(OFF_ROPE + 64 * 16 * 2 * 4);
constexpr size_t OFF_WRT = al256(OFF_LORA + (size_t)(2 * 256 * 64 * 2 + 256 * 160) * 2);
constexpr size_t OFF_LG = al256(OFF_WRT + (size_t)2 * 128 * D * 2);
constexpr size_t OFF_WIN = al256(OFF_LG + (size_t)T * 36 * 4);
constexpr size_t OFF_WOUT = al256(OFF_WIN + (size_t)NINP * D * 2);
constexpr size_t OFF_WGU = al256(OFF_WOUT + (size_t)D * DMIX * 2);
constexpr size_t OFF_WD = al256(OFF_WGU + (size_t)NEXP * 2 * DE * D * 2);
constexpr size_t OFF_H = al256(OFF_WD + (size_t)NEXP * D * DE * 2);
constexpr size_t OFF_Z = al256(OFF_H + (size_t)(T + 1) * D * 2);
constexpr int PU = L + S;
constexpr int NSG = (L + S) / 128;
static_assert((size_t)3 * 64 * ((L + S) / 128) * 4096 * 4 <= (size_t)NEXP * 2 * DE * D * 2 || (L % 128) != 0, "scan segment states overlay wgu_t");
constexpr size_t OFF_VT = al256(OFF_Z + (size_t)T * ZP * 2);
constexpr size_t OFF_S = al256(OFF_VT + (size_t)NB * 8 * 64 * PU * 2);
constexpr size_t S1 = (size_t)T * 256 * 4;
constexpr size_t OFF_Y = al256(OFF_S + 10 * S1);
constexpr size_t OFF_MIX = al256(OFF_Y + 2 * S1);
constexpr size_t OFF_XC = al256(OFF_MIX + (size_t)T * 1024 * 2);
constexpr size_t OFF_ROUTE = al256(OFF_XC + (size_t)TC * D * 4);
constexpr size_t OFF_SLOTTOK = al256(OFF_ROUTE + (size_t)T * 2 * 4 * 4);
constexpr size_t WS_NEED = al256(OFF_SLOTTOK + (size_t)NSLOT * 4);
static_assert((size_t)NSLOT * DE * 2 <= (size_t)T * ZP * 2 && (size_t)T * D * 2 <= (size_t)T * ZP * 2, "ACT / HLO overlay Z");
static_assert((size_t)T * 4 * 4 + (size_t)T * 416 * 2 <= S1, "kN + LA overlay Y[1]");
static_assert((size_t)NSLOT * D * 4 <= 10 * S1 && (size_t)T * D * 4 <= 10 * S1, "YS / O overlay the stream buffers");

static Params make_params(void* const* d_in, void* d_out, void* d_ws) {
    Params p{};
    const float** f = (const float**)&p.x;
    for (int i = 0; i < 32; ++i) f[i] = (const float*)d_in[i];
    p.out = (float*)d_out;
    char* w = (char*)d_ws;
    p.cnt = (int*)(w + OFF_CNT); p.bar = (unsigned*)(w + OFF_BAR); p.mod = (float*)(w + OFF_MOD); p.rope = (float*)(w + OFF_ROPE);
    p.win_t = (bf16_t*)(w + OFF_WIN); p.wout_t = (bf16_t*)(w + OFF_WOUT); p.wgu_t = (bf16_t*)(w + OFF_WGU); p.wd_t = (bf16_t*)(w + OFF_WD);
    p.wrt = (bf16_t*)(w + OFF_WRT); p.LG = (float*)(w + OFF_LG); p.HLO = (bf16_t*)(w + OFF_Z);
    p.wupT = (bf16_t*)(w + OFF_LORA); p.aupT = p.wupT + 2 * 256 * 64; p.gupT = p.aupT + 2 * 256 * 64;
    p.H = (bf16_t*)(w + OFF_H); p.Z = (bf16_t*)(w + OFF_Z); p.VT = (bf16_t*)(w + OFF_VT);
    float* s = (float*)(w + OFF_S); const size_t n1 = (size_t)T * 256;
    p.sR = s; p.sV = s + n1; p.sKK = s + 2 * n1; p.sG = s + 3 * n1; p.sW = s + 4 * n1; p.sKD = s + 6 * n1; p.sB = s + 8 * n1;
    p.Y = (float*)(w + OFF_Y); p.MIX = (bf16_t*)(w + OFF_MIX); p.XC = (float*)(w + OFF_XC);
    p.O = (float*)(w + OFF_S);
    p.PV = (float*)(w + OFF_H); p.QS = (float*)(w + OFF_WGU); p.PS = p.QS + (size_t)64 * NSG * 4096; p.SS = p.PS + (size_t)64 * NSG * 4096;
    p.kT = p.Y; p.kN = p.Y + (size_t)T * 256; p.LA = (bf16_t*)(p.Y + (size_t)T * 256 + (size_t)T * 4);
    int* r = (int*)(w + OFF_ROUTE); p.rE = r; p.rPos = r + 2 * T; p.rSlot = r + 4 * T; p.rW = (float*)(r + 6 * T);
    p.slotTok = (int*)(w + OFF_SLOTTOK);
    p.ACT = (bf16_t*)(w + OFF_Z); p.YS = (float*)(w + OFF_S);
    return p;
}

__device__ void ph_prep_w(const Params& p, int l, long gtid, long gsz) {
    for (long i = gtid; i < (long)D * NINP; i += gsz) {
        const int k = (int)(i / NINP), n = (int)(i % NINP);
        float v = 0.f;
        if (n < N_IN) { const int oc = (n < ZA) ? n + A_IN : n - ZA; v = p.w_in[((size_t)l * D + k) * N_IN + oc]; }
        p.win_t[(size_t)n * D + k] = f2bf(v);
    }
    for (long i = gtid; i < (long)DMIX * D; i += gsz) {
        const int k = (int)(i / D), n = (int)(i % D);
        p.wout_t[(size_t)n * DMIX + k] = f2bf(p.w_out[((size_t)l * DMIX + k) * D + n]);
    }
    for (long i = gtid; i < (long)NEXP * D * 2 * DE; i += gsz) {
        const int rho = (int)(i % (2 * DE)); const long t = i / (2 * DE); const int k = (int)(t % D), e = (int)(t / D);
        const int q = rho >> 5, half = (rho >> 4) & 1, ii = rho & 15, cc = 16 * q + ii;
        const float* src = half ? p.w_up : p.w_gate;
        p.wgu_t[((size_t)e * 2 * DE + rho) * D + k] = f2bf(src[(((size_t)l * NEXP + e) * D + k) * DE + cc]);
    }
    for (long i = gtid; i < (long)NEXP * DE * D; i += gsz) {
        const int n = (int)(i % D); const long t = i / D; const int k = (int)(t % DE), e = (int)(t / DE);
        p.wd_t[((size_t)e * D + n) * DE + k] = f2bf(p.w_down[(((size_t)l * NEXP + e) * DE + k) * D + n]);
    }
}
__device__ __forceinline__ void ph_prep_misc(const Params& p, int l, long gtid, long gsz, bool do_mod = true) {
    if (l == 0 && do_mod) for (long i = gtid; i < (long)2 * (NB + 1) * 6 * D; i += gsz) {
        const int j = (int)(i % (6 * D)), b = (int)((i / (6 * D)) % (NB + 1)), ll = (int)(i / ((long)6 * D * (NB + 1)));
        const float* cv = (b < NB) ? p.c + (size_t)b * D : p.c_ctx;
        float acc = 0.f;
        for (int k = 0; k < D; ++k) acc += siluf_(cv[k]) * p.w_mod[((size_t)ll * D + k) * 6 * D + j];
        p.mod[((size_t)ll * (NB + 1) + b) * 6 * D + j] = acc + p.b_mod[(size_t)ll * 6 * D + j];
    }
    if (l == 0) for (long i = gtid; i < 64 * 16; i += gsz) {
        const int pos = (int)(i / 16), fi = (int)(i % 16);
        const float inv = powf(10000.0f, -(float)fi / 16.0f), ang = (float)pos * inv;
        p.rope[i] = cosf(ang); p.rope[1024 + i] = sinf(ang);
    }
    for (long i = gtid; i < NEXP; i += gsz) p.cnt[l * NEXP + i] = 0;
    for (long i = gtid; i < NSLOT; i += gsz) p.slotTok[i] = T;
    for (long i = gtid; i < D; i += gsz) p.H[(size_t)T * D + i] = 0;
}

__device__ __forceinline__ const float* xrow_in(const Params& p, int l, int m) {
    if (m < TL) return (l == 0 ? p.x : p.out) + (size_t)m * D;
    return (l == 0 ? p.ctx : p.XC) + (size_t)(m - TL) * D;
}
__device__ __forceinline__ const float* modrow(const Params& p, int l, int m) { return p.mod + ((size_t)l * (NB + 1) + (m < TL ? m / S : NB)) * 6 * D; }

__device__ void ph_lnmod(const Params& p, int l, long gtid, long gsz) {
    for (long m = gtid; m < T; m += gsz) {
        const float* xr = xrow_in(p, l, (int)m); const float* md = modrow(p, l, (int)m);
        float s = 0.f; for (int j = 0; j < D; ++j) s += xr[j];
        const float mu = s / D; float q = 0.f;
        for (int j = 0; j < D; ++j) { const float d = xr[j] - mu; q += d * d; }
        const float rstd = 1.0f / sqrtf(q / D + LN_EPS);
        for (int j = 0; j < D; ++j) p.H[(size_t)m * D + j] = f2bf((xr[j] - mu) * rstd * (1.0f + md[D + j]) + md[j]);
    }
}

__device__ __forceinline__ float zshift(const Params& p, int l, int m, int col) {
    int t, len;
    if (m < TL) { t = m % S; len = S; } else { t = (m - TL) % L; len = L; }
    const float* sh = p.a_shift + (size_t)l * 3 * A_IN;
    const bf16_t* z = p.Z + (size_t)m * ZP + ZA + col;
    float v = sh[A_IN + col] * bf2f(z[0]);
    if (t > 0) v += sh[col] * bf2f(z[-ZP]);
    if (t < len - 1) v += sh[2 * A_IN + col] * bf2f(z[ZP]);
    return v;
}

__device__ void ph_streams(const Params& p, int l, long gtid, long gsz) {
    for (long i = gtid; i < (long)T * DA; i += gsz) {
        const int m = (int)(i / DA), c = (int)(i % DA), h0 = c & ~63;
        const float r = zshift(p, l, m, c), k = zshift(p, l, m, 256 + c), v = zshift(p, l, m, 512 + c);
        float nrm = 0.f;
        for (int j = 0; j < 64; ++j) { const float t = zshift(p, l, m, 256 + h0 + j) * p.a_k_k[l * DA + h0 + j]; nrm += t * t; }
        const float kk = k * p.a_k_k[l * DA + c] / sqrtf(nrm + 1e-12f);
        float g = 0.f;
        for (int j = 0; j < 160; ++j) g += sigmoidf_(zshift(p, l, m, 1024 + j)) * p.a_g_up[((size_t)l * 160 + j) * DA + c];
        const size_t o = (size_t)m * DA + c;
        p.sR[o] = r; p.sV[o] = v; p.sKK[o] = kk; p.sG[o] = g;
        for (int d = 0; d < 2; ++d) {
            float aw = 0.f, aa = 0.f;
            for (int j = 0; j < 64; ++j) {
                aw += tanhf(zshift(p, l, m, 768 + d * 64 + j)) * p.a_w_up[(((size_t)l * 2 + d) * 64 + j) * DA + c];
                aa += zshift(p, l, m, 896 + d * 64 + j) * p.a_a_up[(((size_t)l * 2 + d) * 64 + j) * DA + c];
            }
            const float u = -(p.a_w0[(l * 2 + d) * DA + c] + aw);
            const float sp = (u > 20.f) ? u : log1pf(expf(u));
            const float w = expf(-expf(-sp - 0.5f));
            const float a = sigmoidf_(p.a_a0[(l * 2 + d) * DA + c] + aa);
            const size_t od = ((size_t)d * T + m) * DA + c;
            p.sW[od] = w; p.sKD[od] = k * (1.0f + (a - 1.0f) * p.a_k_a[l * DA + c]); p.sB[od] = kk * a;
        }
    }
}

__device__ __forceinline__ void ph_rope(const Params& p, long gtid, long gsz) {
    for (long i = gtid; i < (long)TL * 8 * 32; i += gsz) {
        const int pr = (int)(i & 31), hs = (int)((i >> 5) & 7), m = (int)(i >> 8);
        const int t = m % S, axis = pr >> 4, fi = pr & 15, pos = axis ? (t % GRID_W) : (t / GRID_W);
        bf16_t* z = p.Z + (size_t)m * ZP + hs * 64 + axis * 32 + fi;
        const float cs = p.rope[pos * 16 + fi], sn = p.rope[1024 + pos * 16 + fi];
        const float x0 = bf2f(z[0]), x1 = bf2f(z[16]);
        z[0] = f2bf(x0 * cs - x1 * sn); z[16] = f2bf(x1 * cs + x0 * sn);
    }
}

__device__ void ph_scan(const Params& p, long gtid, long gsz) {
    for (long i = gtid; i < (long)2 * NB * 4 * 64; i += gsz) {
        const int v = (int)(i & 63), h = (int)((i >> 6) & 3), b = (int)((i >> 8) % NB), d = (int)((i >> 8) / NB);
        float st[64];
#pragma unroll
        for (int k = 0; k < 64; ++k) st[k] = 0.f;
        for (int pos = 0; pos < L + S; ++pos) {
            int m;
            if (pos < L) m = TL + b * L + (d ? L - 1 - pos : pos);
            else m = b * S + (d ? S - 1 - (pos - L) : pos - L);
            const size_t o = (size_t)m * DA + h * 64, od = ((size_t)d * T + m) * DA + h * 64;
            const float* kk = p.sKK + o; const float* r = p.sR + o;
            const float* w = p.sW + od; const float* bb = p.sB + od; const float* kd = p.sKD + od;
            const float vv = p.sV[o + v];
            float sk = 0.f;
#pragma unroll
            for (int k = 0; k < 64; ++k) sk += st[k] * kk[k];
            float y = 0.f;
#pragma unroll
            for (int k = 0; k < 64; ++k) { st[k] = st[k] * w[k] - sk * bb[k] + vv * kd[k]; y += st[k] * r[k]; }
            p.Y[od + v] = y;
        }
    }
}

__device__ void ph_rwkv_out(const Params& p, int l, int nrows, long gtid, long gsz) {
    for (long i = gtid; i < (long)nrows * 4; i += gsz) {
        const int m = (int)(i >> 2), h = (int)(i & 3);
        const size_t o = (size_t)m * DA + h * 64;
        const float* y0 = p.Y + o; const float* y1 = p.Y + (size_t)T * DA + o;
        float s = 0.f, bon = 0.f;
        for (int n = 0; n < 64; ++n) {
            s += y0[n] + y1[n];
            bon += p.sR[o + n] * (p.sKD[o + n] + p.sKD[(size_t)T * DA + o + n]) * p.a_r_k[l * DA + h * 64 + n];
        }
        const float mu = s / 64.f; float q = 0.f;
        for (int n = 0; n < 64; ++n) { const float dd = y0[n] + y1[n] - mu; q += dd * dd; }
        const float rstd = 1.0f / sqrtf(q / 64.f + GN_EPS);
        for (int n = 0; n < 64; ++n) {
            const int c = h * 64 + n;
            const float yn = (y0[n] + y1[n] - mu) * rstd * p.a_lnx_g[l * DA + c] + p.a_lnx_b[l * DA + c];
            p.MIX[(size_t)m * DMIX + c] = f2bf((yn + bon * p.sV[o + n]) * p.sG[o + n]);
        }
    }
}

__device__ __forceinline__ void att_key(const float (&q)[64], const bf16_t* kr, const bf16_t* vr, float bias, float& mx, float& ls, float (&acc)[64]) {
    float s = 0.f;
#pragma unroll
    for (int d = 0; d < 64; ++d) s += q[d] * bf2f(kr[d]);
    s = s * ATT_SCALE + bias;
    const float mn = fmaxf(mx, s), f = expf(mx - mn), pe = expf(s - mn);
    ls = ls * f + pe;
#pragma unroll
    for (int d = 0; d < 64; ++d) acc[d] = acc[d] * f + pe * bf2f(vr[d]);
    mx = mn;
}

__device__ void ph_attn(const Params& p, int l, int nrows, long gtid, long gsz) {
    for (long i = gtid; i < (long)nrows * 12; i += gsz) {
        const int m = (int)(i / 12), u = (int)(i % 12);
        const bool isB = u < 6; const int hq = isB ? u : u - 6;
        const int b = (m < TL) ? m / S : (m - TL) / L;
        const int qcol = isB ? ZQB + hq * 64 : ZQN + hq * 64;
        const int kcol = isB ? ZKB + (hq / 3) * 64 : ZKN + hq * 64;
        const int vcol = isB ? ZVB + (hq / 3) * 64 : ZVN + hq * 64;
        float q[64], acc[64];
        const bf16_t* qr = p.Z + (size_t)m * ZP + qcol;
#pragma unroll
        for (int d = 0; d < 64; ++d) { q[d] = bf2f(qr[d]); acc[d] = 0.f; }
        float mx, ls;
        if (isB) { mx = p.b_sink[l * 6 + hq]; ls = 1.0f; } else { mx = -1e30f; ls = 0.f; }
        for (int j = 0; j < L; ++j) { const bf16_t* zr = p.Z + (size_t)(TL + b * L + j) * ZP; att_key(q, zr + kcol, zr + vcol, 0.f, mx, ls, acc); }
        if (m < TL) {
            const int t = m % S;
            if (isB) {
                const int j0 = t - 128 < 0 ? 0 : t - 128, j1 = t + 128 > S - 1 ? S - 1 : t + 128;
                for (int j = j0; j <= j1; ++j) { const bf16_t* zr = p.Z + (size_t)(b * S + j) * ZP; att_key(q, zr + kcol, zr + vcol, 0.f, mx, ls, acc); }
            } else {
                const int rows = S / GRID_W, r = t / GRID_W, c = t % GRID_W;
                int r0 = r - 4; r0 = r0 < 0 ? 0 : (r0 > rows - 8 ? rows - 8 : r0);
                int c0 = c - 8; c0 = c0 < 0 ? 0 : (c0 > GRID_W - 16 ? GRID_W - 16 : c0);
                for (int a = 0; a < 8; ++a)
                    for (int e = 0; e < 16; ++e) {
                        const int kr = r0 + a, kc = c0 + e;
                        const float bias = p.c_rpb[(((size_t)l * 6 + hq) * 15 + (kr - r + 7)) * 31 + (kc - c + 15)];
                        const bf16_t* zr = p.Z + (size_t)(b * S + kr * GRID_W + kc) * ZP;
                        att_key(q, zr + kcol, zr + vcol, bias, mx, ls, acc);
                    }
            }
        }
        const float inv = 1.0f / ls;
        bf16_t* o = p.MIX + (size_t)m * DMIX + (isB ? 256 : 640) + hq * 64;
#pragma unroll
        for (int d = 0; d < 64; ++d) o[d] = f2bf(acc[d] * inv);
    }
}

__device__ void ph_post_mixer(const Params& p, int l, int nrows, long gtid, long gsz) {
    for (long mm = gtid; mm < nrows; mm += gsz) {
        const int m = (int)mm;
        const float* xr = xrow_in(p, l, m); const float* md = modrow(p, l, m); const float* orow = p.O + (size_t)m * D;
        float* x1 = (m < TL) ? p.out + (size_t)m * D : p.XC + (size_t)(m - TL) * D;
        const float* g1 = p.ln1_g + (size_t)l * D; const float* b1 = p.ln1_b + (size_t)l * D;
        float s = 0.f; for (int j = 0; j < D; ++j) s += ALPHA * xr[j] + md[2 * D + j] * orow[j];
        float mu = s / D, q = 0.f;
        for (int j = 0; j < D; ++j) { const float d = ALPHA * xr[j] + md[2 * D + j] * orow[j] - mu; q += d * d; }
        float rstd = 1.0f / sqrtf(q / D + LN_EPS);
        s = 0.f;
        for (int j = 0; j < D; ++j) { const float v = (ALPHA * xr[j] + md[2 * D + j] * orow[j] - mu) * rstd * g1[j] + b1[j]; x1[j] = v; s += v; }
        mu = s / D; q = 0.f;
        for (int j = 0; j < D; ++j) { const float d = x1[j] - mu; q += d * d; }
        rstd = 1.0f / sqrtf(q / D + LN_EPS);
        float gl[4], el[32];
#pragma unroll
        for (int g = 0; g < 4; ++g) gl[g] = p.b_rg[l * 4 + g];
#pragma unroll
        for (int e = 0; e < 32; ++e) el[e] = p.b_re[l * 32 + e];
        for (int j = 0; j < D; ++j) {
            const float hv = (x1[j] - mu) * rstd * (1.0f + md[4 * D + j]) + md[3 * D + j];
            p.H[(size_t)m * D + j] = f2bf(hv);
            const float* wg = p.w_rg + ((size_t)l * D + j) * 4; const float* we = p.w_re + ((size_t)l * D + j) * 32;
#pragma unroll
            for (int g = 0; g < 4; ++g) gl[g] += hv * wg[g];
#pragma unroll
            for (int e = 0; e < 32; ++e) el[e] += hv * we[e];
        }
        int gs = 0; float gm = gl[0];
#pragma unroll
        for (int g = 1; g < 4; ++g) if (gl[g] > gm) { gm = gl[g]; gs = g; }
        float den = 0.f;
#pragma unroll
        for (int g = 0; g < 4; ++g) den += expf(gl[g] - gm);
        const float pg = 1.0f / den;
        float v1 = -3e38f, v2 = -3e38f; int i1 = 0, i2 = 0;
#pragma unroll
        for (int j = 0; j < 8; ++j) {
            const float v = gs == 0 ? el[j] : gs == 1 ? el[8 + j] : gs == 2 ? el[16 + j] : el[24 + j];
            if (v > v1) { v2 = v1; i2 = i1; v1 = v; i1 = j; } else if (v > v2) { v2 = v; i2 = j; }
        }
        const float e2 = expf(v2 - v1), w1 = pg / (1.0f + e2), w2 = pg * e2 / (1.0f + e2);
        const int ea = gs * 8 + i1, eb = gs * 8 + i2;
        p.rE[2 * m] = ea; p.rE[2 * m + 1] = eb; p.rW[2 * m] = w1; p.rW[2 * m + 1] = w2;
        p.rPos[2 * m] = atomic_inc_int(p.cnt + l * NEXP + ea); p.rPos[2 * m + 1] = atomic_inc_int(p.cnt + l * NEXP + eb);
    }
}

__device__ __forceinline__ int pstart_of(const int* cnt, int e) {
    int s = 0;
    for (int j = 0; j < NEXP; ++j) if (j < e) s += (cnt[j] + 127) & ~127;
    return s;
}
__device__ __forceinline__ void ph_dispatch(const Params& p, int l, int nrows, long gtid, long gsz) {
    for (long i = gtid; i < (long)nrows * 2; i += gsz) {
        const int slot = pstart_of(p.cnt + l * NEXP, p.rE[i]) + p.rPos[i];
        p.rSlot[i] = slot; p.slotTok[slot] = (int)(i >> 1);
    }
}

__device__ void ph_final(const Params& p, int l, int nrows, long gtid, long gsz) {
    for (long mm = gtid; mm < nrows; mm += gsz) {
        const int m = (int)mm;
        float* x1 = (m < TL) ? p.out + (size_t)m * D : p.XC + (size_t)(m - TL) * D;
        const float* md = modrow(p, l, m);
        const float* ya = p.YS + (size_t)p.rSlot[2 * m] * D; const float* yb = p.YS + (size_t)p.rSlot[2 * m + 1] * D;
        const float wa = p.rW[2 * m], wb = p.rW[2 * m + 1];
        const float* g2 = p.ln2_g + (size_t)l * D; const float* b2 = p.ln2_b + (size_t)l * D;
        float s = 0.f; for (int j = 0; j < D; ++j) s += ALPHA * x1[j] + md[5 * D + j] * (wa * ya[j] + wb * yb[j]);
        const float mu = s / D; float q = 0.f;
        for (int j = 0; j < D; ++j) { const float d = ALPHA * x1[j] + md[5 * D + j] * (wa * ya[j] + wb * yb[j]) - mu; q += d * d; }
        const float rstd = 1.0f / sqrtf(q / D + LN_EPS);
        for (int j = 0; j < D; ++j) x1[j] = (ALPHA * x1[j] + md[5 * D + j] * (wa * ya[j] + wb * yb[j]) - mu) * rstd * g2[j] + b2[j];
    }
}

__device__ __forceinline__ int moe_blocks(const int* cnt) { int s = 0; for (int j = 0; j < NEXP; ++j) s += (cnt[j] + 127) >> 7; return s; }
__device__ __forceinline__ int moe_block_expert(const int* cnt, int rb) {
    int s = 0, e = 0;
    for (int j = 0; j < NEXP; ++j) { const int nb = (cnt[j] + 127) >> 7; if (rb >= s && rb < s + nb) e = j; s += nb; }
    return e;
}

#ifdef HOST_EMU
static void host_gemm_in(const Params& p) {
    for (int m = 0; m < T; ++m) for (int n = 0; n < ZP; ++n) { float a = 0.f; for (int k = 0; k < D; ++k) a += bf2f(p.H[(size_t)m * D + k]) * bf2f(p.win_t[(size_t)n * D + k]); p.Z[(size_t)m * ZP + n] = f2bf(a); }
}
static void host_gemm_out(const Params& p, int nrows) {
    for (int m = 0; m < nrows; ++m) for (int n = 0; n < D; ++n) { float a = 0.f; for (int k = 0; k < DMIX; ++k) a += bf2f(p.MIX[(size_t)m * DMIX + k]) * bf2f(p.wout_t[(size_t)n * DMIX + k]); p.O[(size_t)m * D + n] = a; }
}
static void host_moe1(const Params& p, int l) {
    const int* cnt = p.cnt + l * NEXP; const int nrb = moe_blocks(cnt);
    for (int rb = 0; rb < nrb; ++rb) { const int e = moe_block_expert(cnt, rb);
        for (int r = 0; r < 128; ++r) { const int slot = rb * 128 + r; const bf16_t* a = p.H + (size_t)p.slotTok[slot] * D;
            for (int c = 0; c < DE; ++c) { const int q = c >> 4, ii = c & 15; float g = 0.f, u = 0.f;
                const bf16_t* wg = p.wgu_t + ((size_t)e * 2 * DE + 32 * q + ii) * D; const bf16_t* wu = wg + (size_t)16 * D;
                for (int k = 0; k < D; ++k) { g += bf2f(a[k]) * bf2f(wg[k]); u += bf2f(a[k]) * bf2f(wu[k]); }
                p.ACT[(size_t)slot * DE + c] = f2bf(siluf_(g) * u); } } }
}
static void host_moe2(const Params& p, int l) {
    const int* cnt = p.cnt + l * NEXP; const int nrb = moe_blocks(cnt);
    for (int rb = 0; rb < nrb; ++rb) { const int e = moe_block_expert(cnt, rb);
        for (int r = 0; r < 128; ++r) { const int slot = rb * 128 + r;
            for (int n = 0; n < D; ++n) { float a = 0.f; const bf16_t* w = p.wd_t + ((size_t)e * D + n) * DE;
                for (int k = 0; k < DE; ++k) a += bf2f(p.ACT[(size_t)slot * DE + k]) * bf2f(w[k]);
                p.YS[(size_t)slot * D + n] = a; } } }
}
#else
typedef short bf16x8 __attribute__((ext_vector_type(8)));
typedef float f32x4 __attribute__((ext_vector_type(4)));
__device__ __forceinline__ int opq_tid() { int t = threadIdx.x; asm volatile("" : "+v"(t)); return t; }
__device__ __forceinline__ int opq_bid() { int b = blockIdx.x; asm volatile("" : "+s"(b)); return b; }
__device__ __forceinline__ unsigned pk2(float lo, float hi) { return (unsigned)f2bf(lo) | ((unsigned)f2bf(hi) << 16); }
struct u32x2_t { unsigned x, y; };
__device__ __forceinline__ void st_bf16x4(bf16_t* dst, f32x4 v) { u32x2_t o; o.x = pk2(v[0], v[1]); o.y = pk2(v[2], v[3]); *(u32x2_t*)dst = o; }
template <class Epi>
__device__ __forceinline__ void gemm_tile(const bf16_t* a0, const bf16_t* a1, const bf16_t* b0, const bf16_t* b1, int K, char* lds, const Epi& epi, int nseg = 1, size_t aseg = 0, size_t bseg = 0) {
    const int tid = opq_tid(), wid = tid >> 6, lane = tid & 63, wr = wid >> 1, wc = wid & 1, fr = lane & 15, fq = lane >> 4;
    char* SA = lds; char* SB = lds + 8192;
    f32x4 acc[4][4];
#pragma unroll
    for (int m = 0; m < 4; ++m)
#pragma unroll
        for (int n = 0; n < 4; ++n) acc[m][n] = (f32x4){0.f, 0.f, 0.f, 0.f};
    for (int sg = 0; sg < nseg; ++sg, a0 += aseg, a1 += aseg, b0 += bseg, b1 += bseg)
    for (int kt = 0; kt < K; kt += 32) {
        __builtin_amdgcn_global_load_lds((const unsigned*)(a0 + kt), (__attribute__((address_space(3))) unsigned*)(SA + tid * 16), 16, 0, 0);
        __builtin_amdgcn_global_load_lds((const unsigned*)(a1 + kt), (__attribute__((address_space(3))) unsigned*)(SA + tid * 16 + 4096), 16, 0, 0);
        __builtin_amdgcn_global_load_lds((const unsigned*)(b0 + kt), (__attribute__((address_space(3))) unsigned*)(SB + tid * 16), 16, 0, 0);
        __builtin_amdgcn_global_load_lds((const unsigned*)(b1 + kt), (__attribute__((address_space(3))) unsigned*)(SB + tid * 16 + 4096), 16, 0, 0);
        asm volatile("s_waitcnt vmcnt(0)" ::: "memory");
        __syncthreads();
        bf16x8 At[4], Bt[4];
#pragma unroll
        for (int m = 0; m < 4; ++m) At[m] = *(const bf16x8*)(SA + (wr * 64 + m * 16 + fr) * 64 + fq * 16);
#pragma unroll
        for (int n = 0; n < 4; ++n) Bt[n] = *(const bf16x8*)(SB + (wc * 64 + n * 16 + fr) * 64 + fq * 16);
#pragma unroll
        for (int m = 0; m < 4; ++m)
#pragma unroll
            for (int n = 0; n < 4; ++n) acc[m][n] = __builtin_amdgcn_mfma_f32_16x16x32_bf16(At[m], Bt[n], acc[m][n], 0, 0, 0);
        __syncthreads();
    }
    epi(acc, wr, wc, fr, fq);
}
#define STG_ROW(i) ((tid_ + (i) * 256) >> 2)
#define STG_K ((tid_ & 3) * 8)

__device__ __forceinline__ void g_gemm_in(const Params& p, char* lds) {
    const int tid_ = opq_tid(), bid_ = opq_bid(); (void)tid_; (void)bid_;
    constexpr int NT = NINP / 128, MT = T / 128;
    for (int tile = bid_; tile < NT * MT; tile += gridDim.x) {
        const int tm = tile / NT, tn = tile % NT;
        const bf16_t* a0 = p.H + (size_t)(tm * 128 + STG_ROW(0)) * D + STG_K; const bf16_t* a1 = p.H + (size_t)(tm * 128 + STG_ROW(1)) * D + STG_K;
        const bf16_t* b0 = p.win_t + (size_t)(tn * 128 + STG_ROW(0)) * D + STG_K; const bf16_t* b1 = p.win_t + (size_t)(tn * 128 + STG_ROW(1)) * D + STG_K;
        gemm_tile(a0, a1, b0, b1, D, lds, [&](const f32x4 (&acc)[4][4], int wr, int wc, int fr, int fq) {
            if (tn < ZVB / 128 && tm < TL / 128) {
#pragma unroll
                for (int m = 0; m < 4; ++m)
#pragma unroll
                    for (int j = 0; j < 4; ++j) { const int row = tm * 128 + wr * 64 + m * 16 + fq * 4 + j, t = row % S;
                        bf16_t* zr = p.Z + (size_t)row * ZP + tn * 128 + wc * 64 + fr;
#pragma unroll
                        for (int ax = 0; ax < 2; ++ax) { const int pos = ax ? t % GRID_W : t / GRID_W; const float cs = p.rope[pos * 16 + fr], sn = p.rope[1024 + pos * 16 + fr];
                            const float x0 = acc[m][2 * ax][j], x1 = acc[m][2 * ax + 1][j];
                            zr[32 * ax] = f2bf(x0 * cs - x1 * sn); zr[32 * ax + 16] = f2bf(x1 * cs + x0 * sn); } }
            } else {
#pragma unroll
            for (int m = 0; m < 4; ++m)
#pragma unroll
                for (int n = 0; n < 4; ++n) { const int col = tn * 128 + wc * 64 + n * 16 + fr;
                    if (col < ZP) {
#pragma unroll
                        for (int j = 0; j < 4; ++j) p.Z[(size_t)(tm * 128 + wr * 64 + m * 16 + fq * 4 + j) * ZP + col] = f2bf(acc[m][n][j]); } }
            }
            if (tn == ZVB / 128 || (tn >= ZVN / 128 && tn < ZA / 128)) {
#pragma unroll
                for (int m = 0; m < 4; ++m) { const int m0 = tm * 128 + wr * 64 + m * 16 + fq * 4; int b, u;
                    if (m0 < TL) { b = m0 / S; u = L + m0 % S; } else { b = (m0 - TL) / L; u = (m0 - TL) % L; }
#pragma unroll
                    for (int n = 0; n < 4; ++n) { const int col = tn * 128 + wc * 64 + n * 16 + fr;
                        const int hv = col < ZVN ? (col - ZVB) >> 6 : 2 + ((col - ZVN) >> 6), d = col < ZVN ? (col - ZVB) & 63 : (col - ZVN) & 63;
                        st_bf16x4(p.VT + ((size_t)(b * 8 + hv) * 64 + d) * PU + u, acc[m][n]); } }
            }
        });
    }
}
__device__ __forceinline__ void g_gemm_out(const Params& p, int nrows, char* lds) {
    const int tid_ = opq_tid(), bid_ = opq_bid(); (void)tid_; (void)bid_;
    constexpr int NT = D / 128; const int MT = nrows / 128;
    for (int tile = bid_; tile < NT * MT; tile += gridDim.x) {
        const int tm = tile / NT, tn = tile % NT;
        const bf16_t* a0 = p.MIX + (size_t)(tm * 128 + STG_ROW(0)) * DMIX + STG_K; const bf16_t* a1 = p.MIX + (size_t)(tm * 128 + STG_ROW(1)) * DMIX + STG_K;
        const bf16_t* b0 = p.wout_t + (size_t)(tn * 128 + STG_ROW(0)) * DMIX + STG_K; const bf16_t* b1 = p.wout_t + (size_t)(tn * 128 + STG_ROW(1)) * DMIX + STG_K;
        gemm_tile(a0, a1, b0, b1, DMIX, lds, [&](const f32x4 (&acc)[4][4], int wr, int wc, int fr, int fq) {
#pragma unroll
            for (int m = 0; m < 4; ++m)
#pragma unroll
                for (int n = 0; n < 4; ++n)
#pragma unroll
                    for (int j = 0; j < 4; ++j) p.O[(size_t)(tm * 128 + wr * 64 + m * 16 + fq * 4 + j) * D + tn * 128 + wc * 64 + n * 16 + fr] = acc[m][n][j];
        });
    }
}
__device__ __forceinline__ void g_moe1(const Params& p, int l, char* lds) {
    const int tid_ = opq_tid(), bid_ = opq_bid(); (void)tid_; (void)bid_;
    const int* cnt = p.cnt + l * NEXP; const int nrb = moe_blocks(cnt); constexpr int NT = 2 * DE / 128;
    for (int tile = bid_; tile < nrb * NT; tile += gridDim.x) {
        const int rb = tile / NT, tn = tile % NT, e = moe_block_expert(cnt, rb);
        const bf16_t* a0 = p.H + (size_t)p.slotTok[rb * 128 + STG_ROW(0)] * D + STG_K; const bf16_t* a1 = p.H + (size_t)p.slotTok[rb * 128 + STG_ROW(1)] * D + STG_K;
        const bf16_t* bw = p.wgu_t + (size_t)e * 2 * DE * D;
        const bf16_t* b0 = bw + (size_t)(tn * 128 + STG_ROW(0)) * D + STG_K; const bf16_t* b1 = bw + (size_t)(tn * 128 + STG_ROW(1)) * D + STG_K;
        gemm_tile(a0, a1, b0, b1, D, lds, [&](const f32x4 (&acc)[4][4], int wr, int wc, int fr, int fq) {
#pragma unroll
            for (int m = 0; m < 4; ++m)
#pragma unroll
                for (int n2 = 0; n2 < 2; ++n2) { const int col = tn * 64 + wc * 32 + n2 * 16 + fr;
#pragma unroll
                    for (int j = 0; j < 4; ++j) { const float g = acc[m][2 * n2][j], u = acc[m][2 * n2 + 1][j];
                        p.ACT[(size_t)(rb * 128 + wr * 64 + m * 16 + fq * 4 + j) * DE + col] = f2bf(g / (1.0f + __expf(-g)) * u); } }
        });
    }
}
__device__ __forceinline__ void g_moe2(const Params& p, int l, char* lds) {
    const int tid_ = opq_tid(), bid_ = opq_bid(); (void)tid_; (void)bid_;
    const int* cnt = p.cnt + l * NEXP; const int nrb = moe_blocks(cnt); constexpr int NT = D / 128;
    for (int tile = bid_; tile < nrb * NT; tile += gridDim.x) {
        const int rb = tile / NT, tn = tile % NT, e = moe_block_expert(cnt, rb);
        const bf16_t* a0 = p.ACT + (size_t)(rb * 128 + STG_ROW(0)) * DE + STG_K; const bf16_t* a1 = p.ACT + (size_t)(rb * 128 + STG_ROW(1)) * DE + STG_K;
        const bf16_t* bw = p.wd_t + (size_t)e * D * DE;
        const bf16_t* b0 = bw + (size_t)(tn * 128 + STG_ROW(0)) * DE + STG_K; const bf16_t* b1 = bw + (size_t)(tn * 128 + STG_ROW(1)) * DE + STG_K;
        gemm_tile(a0, a1, b0, b1, DE, lds, [&](const f32x4 (&acc)[4][4], int wr, int wc, int fr, int fq) {
#pragma unroll
            for (int m = 0; m < 4; ++m)
#pragma unroll
                for (int n = 0; n < 4; ++n)
#pragma unroll
                    for (int j = 0; j < 4; ++j) p.YS[(size_t)(rb * 128 + wr * 64 + m * 16 + fq * 4 + j) * D + tn * 128 + wc * 64 + n * 16 + fr] = acc[m][n][j];
        });
    }
}


constexpr int DV = D / 256;
static_assert(D % 256 == 0, "row phases hold a row as DV float4 per lane");
template <int CTRL> __device__ __forceinline__ float dppf(float v) { return __builtin_bit_cast(float, __builtin_amdgcn_update_dpp(0, __builtin_bit_cast(int, v), CTRL, 0xf, 0xf, true)); }
__device__ __forceinline__ float wave_sum(float v) {
    v += dppf<0xB1>(v); v += dppf<0x4E>(v); v += dppf<0x141>(v); v += dppf<0x140>(v);
    float a = v, b = v;
    asm volatile("s_nop 1\n\tv_permlane16_swap_b32 %0, %1" : "+v"(a), "+v"(b));
    v = a + b; a = v; b = v;
    asm volatile("s_nop 1\n\tv_permlane32_swap_b32 %0, %1" : "+v"(a), "+v"(b));
    return a + b;
}
__device__ __forceinline__ float sum8(float v) { v += dppf<0xB1>(v); v += dppf<0x4E>(v); v += dppf<0x141>(v); return v; }
__device__ __forceinline__ float sum4(f32x4 a) { return (a[0] + a[1]) + (a[2] + a[3]); }
#define LDS_WAIT() asm volatile("s_waitcnt lgkmcnt(0)" ::: "memory")

__device__ __forceinline__ void row_stats(const f32x4 (&v)[DV], float& mu, float& rstd) {
    float s = 0.f;
#pragma unroll
    for (int j = 0; j < DV; ++j) s += sum4(v[j]);
    mu = wave_sum(s) * (1.0f / D);
    float q = 0.f;
#pragma unroll
    for (int j = 0; j < DV; ++j) { const f32x4 d = v[j] - mu; q += sum4(d * d); }
    rstd = 1.0f / sqrtf(wave_sum(q) * (1.0f / D) + LN_EPS);
}

__device__ __forceinline__ void ph_lnmod_fast(const Params& p, int l) {
    const int tid_ = opq_tid(), bid_ = opq_bid(); (void)tid_; (void)bid_;
    const int lane = tid_ & 63, gw = bid_ * 4 + (tid_ >> 6), nw = gridDim.x * 4;
    for (int m = gw; m < T; m += nw) {
        const f32x4* xr = (const f32x4*)xrow_in(p, l, m) + lane; const f32x4* md = (const f32x4*)modrow(p, l, m) + lane;
        f32x4 v[DV];
#pragma unroll
        for (int j = 0; j < DV; ++j) v[j] = xr[64 * j];
        float mu, rstd; row_stats(v, mu, rstd);
#pragma unroll
        for (int j = 0; j < DV; ++j) { const f32x4 sh = md[64 * j], sc = md[D / 4 + 64 * j];
            st_bf16x4(p.H + (size_t)m * D + 4 * (lane + 64 * j), (v[j] - mu) * rstd * (sc + 1.0f) + sh); }
    }
}

__device__ __forceinline__ void ph_post_mixer_fast(const Params& p, int l, int nrows) {
    const int tid_ = opq_tid(), bid_ = opq_bid(); (void)tid_; (void)bid_;
    const int lane = tid_ & 63, gw = bid_ * 4 + (tid_ >> 6), nw = gridDim.x * 4;
    for (int m = gw; m < nrows; m += nw) {
        const f32x4* xr = (const f32x4*)xrow_in(p, l, m) + lane; const f32x4* md = (const f32x4*)modrow(p, l, m) + lane;
        const f32x4* orow = (const f32x4*)(p.O + (size_t)m * D) + lane;
        f32x4* x1 = (f32x4*)((m < TL) ? p.out + (size_t)m * D : p.XC + (size_t)(m - TL) * D) + lane;
        const f32x4* g1 = (const f32x4*)(p.ln1_g + (size_t)l * D) + lane; const f32x4* b1 = (const f32x4*)(p.ln1_b + (size_t)l * D) + lane;
        f32x4 v[DV];
#pragma unroll
        for (int j = 0; j < DV; ++j) v[j] = xr[64 * j] * ALPHA + md[2 * (D / 4) + 64 * j] * orow[64 * j];
        float mu, rstd; row_stats(v, mu, rstd);
#pragma unroll
        for (int j = 0; j < DV; ++j) { v[j] = (v[j] - mu) * rstd * g1[64 * j] + b1[64 * j]; x1[64 * j] = v[j]; }
        row_stats(v, mu, rstd);
#pragma unroll
        for (int j = 0; j < DV; ++j) {
            const f32x4 hv = (v[j] - mu) * rstd * (md[4 * (D / 4) + 64 * j] + 1.0f) + md[3 * (D / 4) + 64 * j];
            f32x4 hh, lo;
#pragma unroll
            for (int e = 0; e < 4; ++e) { hh[e] = bf2f(f2bf(hv[e])); lo[e] = hv[e] - hh[e]; }
            st_bf16x4(p.H + (size_t)m * D + 4 * (lane + 64 * j), hh);
            st_bf16x4(p.HLO + (size_t)m * D + 4 * (lane + 64 * j), lo);
        }
    }
}

__device__ __forceinline__ void g_router(const Params& p, int l, int nrows, char* lds) {
    const int tid_ = opq_tid(), bid_ = opq_bid(); (void)tid_; (void)bid_;
    const int lane = tid_ & 63, wid = tid_ >> 6, fr = lane & 15, fq = lane >> 4;
    float* part = (float*)lds;
    float* lgt = part + 4 * 6 * 64 * 4;
    for (int rg = bid_; rg < nrows / 32; rg += gridDim.x) {
        f32x4 acc[2][3];
#pragma unroll
        for (int a = 0; a < 2; ++a)
#pragma unroll
            for (int b = 0; b < 3; ++b) acc[a][b] = (f32x4){0.f, 0.f, 0.f, 0.f};
#pragma unroll
        for (int seg = 0; seg < 3; ++seg) {
            const bf16_t* ap = (seg < 2 ? p.H : p.HLO) + (size_t)(rg * 32 + fr) * D + wid * (D / 4) + fq * 8;
            const bf16_t* bp = p.wrt + (seg == 1 ? (size_t)128 * D : 0) + (size_t)fr * D + wid * (D / 4) + fq * 8;
#pragma unroll 1
            for (int ks0 = 0; ks0 < D / 128; ks0 += 4) {
                bf16x8 av[4][2], bv[4][3];
#pragma unroll
                for (int u = 0; u < 4; ++u) { const int ko = (ks0 + u) * 32;
                    av[u][0] = *(const bf16x8*)(ap + ko); av[u][1] = *(const bf16x8*)(ap + (size_t)16 * D + ko);
                    bv[u][0] = *(const bf16x8*)(bp + ko); bv[u][1] = *(const bf16x8*)(bp + (size_t)16 * D + ko); bv[u][2] = *(const bf16x8*)(bp + (size_t)32 * D + ko); }
                asm volatile("" ::: "memory");
#pragma unroll
                for (int u = 0; u < 4; ++u)
#pragma unroll
                    for (int a = 0; a < 2; ++a)
#pragma unroll
                        for (int b = 0; b < 3; ++b) acc[a][b] = __builtin_amdgcn_mfma_f32_16x16x32_bf16(av[u][a], bv[u][b], acc[a][b], 0, 0, 0);
            }
        }
#pragma unroll
        for (int a = 0; a < 2; ++a)
#pragma unroll
            for (int b = 0; b < 3; ++b) *(f32x4*)(part + ((wid * 6 + a * 3 + b) * 64 + lane) * 4) = acc[a][b];
        __syncthreads();
#pragma unroll
        for (int i = 0; i < 6; ++i) { const int e = tid_ + 256 * i, f = e >> 8, ln = (e & 255) >> 2, j = e & 3;
            const float sm = (part[((0 * 6 + f) * 64 + ln) * 4 + j] + part[((1 * 6 + f) * 64 + ln) * 4 + j]) + (part[((2 * 6 + f) * 64 + ln) * 4 + j] + part[((3 * 6 + f) * 64 + ln) * 4 + j]);
            lgt[((f / 3) * 16 + (ln >> 4) * 4 + j) * 48 + (f % 3) * 16 + (ln & 15)] = sm; }
        __syncthreads();
        if (tid_ < 32) {
            const int m = rg * 32 + tid_; const float* lg = lgt + tid_ * 48;
            float gl[4], el[32];
#pragma unroll
            for (int g = 0; g < 4; ++g) gl[g] = lg[g] + p.b_rg[l * 4 + g];
#pragma unroll
            for (int e = 0; e < 32; ++e) el[e] = lg[4 + e] + p.b_re[l * 32 + e];
            int gs = 0; float gm = gl[0];
#pragma unroll
            for (int g = 1; g < 4; ++g) if (gl[g] > gm) { gm = gl[g]; gs = g; }
            float den = 0.f;
#pragma unroll
            for (int g = 0; g < 4; ++g) den += expf(gl[g] - gm);
            const float pg = 1.0f / den;
            float v1 = -3e38f, v2 = -3e38f; int i1 = 0, i2 = 0;
#pragma unroll
            for (int j = 0; j < 8; ++j) {
                const float vv = gs == 0 ? el[j] : gs == 1 ? el[8 + j] : gs == 2 ? el[16 + j] : el[24 + j];
                if (vv > v1) { v2 = v1; i2 = i1; v1 = vv; i1 = j; } else if (vv > v2) { v2 = vv; i2 = j; }
            }
            const float e2 = expf(v2 - v1), w1 = pg / (1.0f + e2), w2 = pg * e2 / (1.0f + e2);
            const int ea = gs * 8 + i1, eb = gs * 8 + i2;
            p.rE[2 * m] = ea; p.rE[2 * m + 1] = eb; p.rW[2 * m] = w1; p.rW[2 * m + 1] = w2;
            p.rPos[2 * m] = atomicAdd(p.cnt + l * NEXP + ea, 1); p.rPos[2 * m + 1] = atomicAdd(p.cnt + l * NEXP + eb, 1);
        }
        __syncthreads();
    }
}

__device__ __forceinline__ void ph_final_fast(const Params& p, int l, int nrows) {
    const int tid_ = opq_tid(), bid_ = opq_bid(); (void)tid_; (void)bid_;
    const int lane = tid_ & 63, gw = bid_ * 4 + (tid_ >> 6), nw = gridDim.x * 4;
    for (int m = gw; m < nrows; m += nw) {
        f32x4* x1 = (f32x4*)((m < TL) ? p.out + (size_t)m * D : p.XC + (size_t)(m - TL) * D) + lane;
        const f32x4* md = (const f32x4*)modrow(p, l, m) + lane;
        const f32x4* ya = (const f32x4*)(p.YS + (size_t)p.rSlot[2 * m] * D) + lane; const f32x4* yb = (const f32x4*)(p.YS + (size_t)p.rSlot[2 * m + 1] * D) + lane;
        const float wa = p.rW[2 * m], wb = p.rW[2 * m + 1];
        const f32x4* g2 = (const f32x4*)(p.ln2_g + (size_t)l * D) + lane; const f32x4* b2 = (const f32x4*)(p.ln2_b + (size_t)l * D) + lane;
        f32x4 v[DV];
#pragma unroll
        for (int j = 0; j < DV; ++j) v[j] = x1[64 * j] * ALPHA + md[5 * (D / 4) + 64 * j] * (ya[64 * j] * wa + yb[64 * j] * wb);
        float mu, rstd; row_stats(v, mu, rstd);
#pragma unroll
        for (int j = 0; j < DV; ++j) x1[64 * j] = (v[j] - mu) * rstd * g2[64 * j] + b2[64 * j];
    }
}

__device__ __forceinline__ void ph_mod_fast(const Params& p, char* lds) {
    const int tid_ = opq_tid(), bid_ = opq_bid(); (void)tid_; (void)bid_;
    constexpr int NR = NB + 1, NTASK = 2 * (6 * D / 64);
    if (bid_ >= NTASK) return;
    float* sc = (float*)lds;
    float* part = sc + NR * D;
    for (int i = tid_; i < NR * D; i += 256) { const int b = i / D, k = i % D; const float cv = b < NB ? p.c[(size_t)b * D + k] : p.c_ctx[k]; sc[i] = cv / (1.0f + __expf(-cv)); }
    __syncthreads();
    const int lane = tid_ & 63, wid = tid_ >> 6;
    for (int task = bid_; task < NTASK; task += gridDim.x) {
        const int ll = task / (6 * D / 64), col = 64 * (task % (6 * D / 64)) + lane;
        float acc[NR];
#pragma unroll
        for (int b = 0; b < NR; ++b) acc[b] = 0.f;
        const float* wp = p.w_mod + ((size_t)ll * D + wid * (D / 4)) * 6 * D + col;
#pragma unroll 16
        for (int k = 0; k < D / 4; ++k) { const float w = wp[(size_t)k * 6 * D];
#pragma unroll
            for (int b = 0; b < NR; ++b) acc[b] += sc[b * D + wid * (D / 4) + k] * w; }
#pragma unroll
        for (int b = 0; b < NR; ++b) part[(wid * NR + b) * 64 + lane] = acc[b];
        __syncthreads();
        for (int i = tid_; i < NR * 64; i += 256) { const int b = i / 64, cl = i % 64;
            p.mod[((size_t)ll * NR + b) * 6 * D + 64 * (task % (6 * D / 64)) + cl] = (part[(0 * NR + b) * 64 + cl] + part[(1 * NR + b) * 64 + cl]) + (part[(2 * NR + b) * 64 + cl] + part[(3 * NR + b) * 64 + cl]) + p.b_mod[(size_t)ll * 6 * D + 64 * (task % (6 * D / 64)) + cl]; }
        __syncthreads();
    }
}

__device__ __forceinline__ void tr_item(const float* srcl, size_t ldw, bf16_t* dst, size_t ldd, float* scr, int lane) {
#pragma unroll 8
    for (int i = 0; i < 32; ++i) { const int kk = 2 * i + (lane >> 5); scr[kk * 33 + (lane & 31)] = srcl ? srcl[(size_t)kk * ldw] : 0.f; }
    LDS_WAIT();
    const int c = lane & 7;
#pragma unroll
    for (int j = 0; j < 4; ++j) { const int n = (lane >> 3) + 8 * j; const float* s = scr + (8 * c) * 33 + n;
        uint4 o; o.x = pk2(s[0], s[33]); o.y = pk2(s[2 * 33], s[3 * 33]); o.z = pk2(s[4 * 33], s[5 * 33]); o.w = pk2(s[6 * 33], s[7 * 33]);
        *(uint4*)(dst + (size_t)n * ldd + 8 * c) = o; }
    LDS_WAIT();
}
__device__ __forceinline__ void ph_prep_w_fast(const Params& p, int l, int part, char* lds) {
    const int tid_ = opq_tid(), bid_ = opq_bid(); (void)tid_; (void)bid_;
    const int lane = tid_ & 63, wid = tid_ >> 6, gw = bid_ * 4 + wid, nw = gridDim.x * 4;
    float* scr = (float*)(lds + wid * 8448);
    constexpr int I_IN = (D / 64) * (NINP / 32), I_OUT = (DMIX / 64) * (D / 32), I_GU1 = (D / 64) * (2 * DE / 32), I_D1 = (DE / 64) * (D / 32);
    constexpr int NITEMS = I_IN + I_OUT + NEXP * (I_GU1 + I_D1);
    const int it0 = part == 0 ? 0 : I_IN + I_OUT, it1 = part == 0 ? I_IN + I_OUT : NITEMS;
    for (int it = it0 + gw; it < it1; it += nw) {
        int r = it;
        if (r < I_IN) { const int kb = r / (NINP / 32), n0 = 32 * (r % (NINP / 32));
            const float* s = nullptr;
            if (n0 < N_IN) { const int oc = (n0 < ZA) ? n0 + A_IN : n0 - ZA; s = p.w_in + ((size_t)l * D + 64 * kb) * N_IN + oc + (lane & 31); }
            tr_item(s, N_IN, p.win_t + (size_t)n0 * D + 64 * kb, D, scr, lane); continue; }
        r -= I_IN;
        if (r < I_OUT) { const int kb = r / (D / 32), n0 = 32 * (r % (D / 32));
            tr_item(p.w_out + ((size_t)l * DMIX + 64 * kb) * D + n0 + (lane & 31), D, p.wout_t + (size_t)n0 * DMIX + 64 * kb, DMIX, scr, lane); continue; }
        r -= I_OUT;
        const int e = r / (I_GU1 + I_D1); r %= (I_GU1 + I_D1);
        if (r < I_GU1) { const int kb = r / (2 * DE / 32), q = r % (2 * DE / 32);
            const float* s = (((lane & 31) >> 4) ? p.w_up : p.w_gate) + (((size_t)l * NEXP + e) * D + 64 * kb) * DE + 16 * q + (lane & 15);
            tr_item(s, DE, p.wgu_t + ((size_t)e * 2 * DE + 32 * q) * D + 64 * kb, D, scr, lane); continue; }
        r -= I_GU1;
        { const int kb = r / (D / 32), n0 = 32 * (r % (D / 32));
            tr_item(p.w_down + (((size_t)l * NEXP + e) * DE + 64 * kb) * D + n0 + (lane & 31), D, p.wd_t + ((size_t)e * D + n0) * DE + 64 * kb, DE, scr, lane); }
    }
    if (part != 0) return;
    const long gt = (long)bid_ * blockDim.x + tid_, gs = (long)gridDim.x * blockDim.x;
    for (long i = gt; i < 2 * 256 * 64; i += gs) { const int k = (int)(i & 63), n = (int)((i >> 6) & 255), d = (int)(i >> 14);
        p.wupT[i] = f2bf(p.a_w_up[(((size_t)l * 2 + d) * 64 + k) * DA + n]); p.aupT[i] = f2bf(p.a_a_up[(((size_t)l * 2 + d) * 64 + k) * DA + n]); }
    for (long i = gt; i < 256 * 160; i += gs) { const int k = (int)(i % 160), n = (int)(i / 160); p.gupT[i] = f2bf(p.a_g_up[((size_t)l * 160 + k) * DA + n]); }
    for (long i = gt; i < (long)128 * D; i += gs) { const int n = (int)(i / D), k = (int)(i % D);
        const float w = n < 4 ? p.w_rg[((size_t)l * D + k) * 4 + n] : n < 36 ? p.w_re[((size_t)l * D + k) * 32 + n - 4] : 0.f;
        const bf16_t hb = f2bf(w); p.wrt[i] = hb; p.wrt[(size_t)128 * D + i] = f2bf(w - bf2f(hb)); }
}

__device__ __forceinline__ float tanh_fast(float x) { return 1.0f - 2.0f / (1.0f + __expf(2.0f * x)); }
__device__ __forceinline__ void ph_streams_s1(const Params& p, int l) {
    const int tid_ = opq_tid(), bid_ = opq_bid(); (void)tid_; (void)bid_;
    constexpr int NCH = A_IN / 8, NCHP = (NCH + 7) & ~7;
    const float* sh = p.a_shift + (size_t)l * 3 * A_IN;
    for (long it = (long)bid_ * 256 + tid_; it < (long)T * NCHP; it += (long)gridDim.x * 256) {
        const int m = (int)(it / NCHP), ch = (int)(it % NCHP), c0 = 8 * ch;
        const bool act = ch < NCH;
        int t, len;
        if (m < TL) { t = m % S; len = S; } else { t = (m - TL) % L; len = L; }
        float v[8];
#pragma unroll
        for (int e = 0; e < 8; ++e) v[e] = 0.f;
        if (act) {
            const bf16_t* z = p.Z + (size_t)m * ZP + ZA + c0;
            const bf16x8 zc = *(const bf16x8*)z;
            const f32x4 s1a = *(const f32x4*)(sh + A_IN + c0), s1b = *(const f32x4*)(sh + A_IN + c0 + 4);
#pragma unroll
            for (int e = 0; e < 8; ++e) v[e] = (e < 4 ? s1a[e] : s1b[e - 4]) * bf2f((bf16_t)zc[e]);
            if (t > 0) { const bf16x8 zp = *(const bf16x8*)(z - ZP); const f32x4 a = *(const f32x4*)(sh + c0), b = *(const f32x4*)(sh + c0 + 4);
#pragma unroll
                for (int e = 0; e < 8; ++e) v[e] += (e < 4 ? a[e] : b[e - 4]) * bf2f((bf16_t)zp[e]); }
            if (t < len - 1) { const bf16x8 zn = *(const bf16x8*)(z + ZP); const f32x4 a = *(const f32x4*)(sh + 2 * A_IN + c0), b = *(const f32x4*)(sh + 2 * A_IN + c0 + 4);
#pragma unroll
                for (int e = 0; e < 8; ++e) v[e] += (e < 4 ? a[e] : b[e - 4]) * bf2f((bf16_t)zn[e]); }
        }
        float nrm = 0.f;
        if (ch >= 32 && ch < 64) {
#pragma unroll
            for (int e = 0; e < 8; ++e) { const float t2 = v[e] * p.a_k_k[l * DA + c0 - 256 + e]; nrm += t2 * t2; } }
        nrm = sum8(nrm);
        if (!act) continue;
        if (c0 < 768) {
            float* dst = (c0 < 256 ? p.sR + (size_t)m * DA + c0 : c0 < 512 ? p.kT + (size_t)m * DA + c0 - 256 : p.sV + (size_t)m * DA + c0 - 512);
            *(f32x4*)dst = (f32x4){v[0], v[1], v[2], v[3]}; *(f32x4*)(dst + 4) = (f32x4){v[4], v[5], v[6], v[7]};
            if (ch >= 32 && ch < 64 && (ch & 7) == 0) p.kN[(size_t)m * 4 + ((ch - 32) >> 3)] = 1.0f / sqrtf(nrm + 1e-12f);
        } else {
            if (c0 < 896) {
#pragma unroll
                for (int e = 0; e < 8; ++e) v[e] = tanh_fast(v[e]); }
            else if (c0 >= 1024) {
#pragma unroll
                for (int e = 0; e < 8; ++e) v[e] = 1.0f / (1.0f + __expf(-v[e])); }
            uint4 o; o.x = pk2(v[0], v[1]); o.y = pk2(v[2], v[3]); o.z = pk2(v[4], v[5]); o.w = pk2(v[6], v[7]);
            *(uint4*)(p.LA + (size_t)m * 416 + c0 - 768) = o;
        }
    }
}
__device__ __forceinline__ void g_streams_s2(const Params& p, int l, char* lds) {
    const int tid_ = opq_tid(), bid_ = opq_bid(); (void)tid_; (void)bid_;
    constexpr int MT = T / 128;
    for (int job = bid_; job < 5 * MT * 2; job += gridDim.x) {
        const int type = job / (MT * 2), r = job % (MT * 2), tm = r >> 1, tn = r & 1;
        const int coff = type < 2 ? type * 64 : type < 4 ? 128 + (type - 2) * 64 : 256, K = type < 4 ? 64 : 160, d = type & 1;
        const bf16_t* Bt = type < 2 ? p.wupT + type * 256 * 64 : type < 4 ? p.aupT + (type - 2) * 256 * 64 : p.gupT;
        const bf16_t* a0 = p.LA + (size_t)(tm * 128 + STG_ROW(0)) * 416 + coff + STG_K; const bf16_t* a1 = p.LA + (size_t)(tm * 128 + STG_ROW(1)) * 416 + coff + STG_K;
        const bf16_t* b0 = Bt + (size_t)(tn * 128 + STG_ROW(0)) * K + STG_K; const bf16_t* b1 = Bt + (size_t)(tn * 128 + STG_ROW(1)) * K + STG_K;
        if (type < 2) gemm_tile(a0, a1, b0, b1, K, lds, [&](const f32x4 (&acc)[4][4], int wr, int wc, int fr, int fq) {
#pragma unroll
            for (int mi = 0; mi < 4; ++mi) {
#pragma unroll
                for (int n = 0; n < 4; ++n) { const int c = tn * 128 + wc * 64 + n * 16 + fr; const float w0 = p.a_w0[(l * 2 + d) * DA + c];
#pragma unroll
                    for (int j = 0; j < 4; ++j) { const int row = tm * 128 + wr * 64 + mi * 16 + fq * 4 + j;
                        const float e = __expf(-(w0 + acc[mi][n][j]));
                        p.sW[((size_t)d * T + row) * DA + c] = __expf(-0.60653065971f / (1.0f + e)); } }
                asm volatile("" ::: "memory"); }
        });
        else if (type < 4) gemm_tile(a0, a1, b0, b1, K, lds, [&](const f32x4 (&acc)[4][4], int wr, int wc, int fr, int fq) {
#pragma unroll
            for (int mi = 0; mi < 4; ++mi) {
#pragma unroll
                for (int n = 0; n < 4; ++n) { const int c = tn * 128 + wc * 64 + n * 16 + fr;
                    const float a0v = p.a_a0[(l * 2 + d) * DA + c], kkc = p.a_k_k[l * DA + c], kac = p.a_k_a[l * DA + c];
#pragma unroll
                    for (int j = 0; j < 4; ++j) { const int row = tm * 128 + wr * 64 + mi * 16 + fq * 4 + j;
                        const size_t o = (size_t)row * DA + c, od = ((size_t)d * T + row) * DA + c;
                        const float av = 1.0f / (1.0f + __expf(-(a0v + acc[mi][n][j]))); const float k = p.kT[o];
                        const float kk = k * kkc * p.kN[(size_t)row * 4 + (c >> 6)];
                        p.sKD[od] = k * (1.0f + (av - 1.0f) * kac); p.sB[od] = kk * av; if (d == 0) p.sKK[o] = kk; } }
                asm volatile("" ::: "memory"); }
        });
        else gemm_tile(a0, a1, b0, b1, K, lds, [&](const f32x4 (&acc)[4][4], int wr, int wc, int fr, int fq) {
#pragma unroll
            for (int mi = 0; mi < 4; ++mi)
#pragma unroll
                for (int n = 0; n < 4; ++n) { const int c = tn * 128 + wc * 64 + n * 16 + fr;
#pragma unroll
                    for (int j = 0; j < 4; ++j) p.sG[(size_t)(tm * 128 + wr * 64 + mi * 16 + fq * 4 + j) * DA + c] = acc[mi][n][j]; }
        });
    }
}


typedef float f32x16 __attribute__((ext_vector_type(16)));
typedef short s16x4 __attribute__((ext_vector_type(4)));
typedef unsigned u32x4_t __attribute__((ext_vector_type(4)));
typedef float f32x2_t __attribute__((ext_vector_type(2)));
typedef __bf16 bf16x2_t __attribute__((ext_vector_type(2)));
__device__ __forceinline__ unsigned cvtpk(float lo, float hi) { f32x2_t v = {lo, hi}; bf16x2_t b = __builtin_convertvector(v, bf16x2_t); return __builtin_bit_cast(unsigned, b); }
__device__ __forceinline__ int crow(int r, int hi) { return (r & 3) + 8 * (r >> 2) + 4 * hi; }

template <class MaskF>
__device__ __forceinline__ void attn_tile(const bf16x8 (&qf)[4], const bf16_t* krow, const bf16_t* vt0, const bf16_t* vt1, const MaskF& mask,
                                          float& m_run, float& l_run, f32x16& o0, f32x16& o1, int hi) {
    f32x16 s;
#pragma unroll
    for (int r = 0; r < 16; ++r) s[r] = 0.f;
#pragma unroll
    for (int ks = 0; ks < 4; ++ks) { const bf16x8 kf = *(const bf16x8*)(krow + 16 * ks); s = __builtin_amdgcn_mfma_f32_32x32x16_bf16(kf, qf[ks], s, 0, 0, 0); }
    float mx = -INFINITY;
#pragma unroll
    for (int r = 0; r < 16; ++r) { s[r] = mask(crow(r, hi), s[r] * ATT_SCALE); mx = fmaxf(mx, s[r]); }
    mx = fmaxf(mx, __shfl_xor(mx, 32));
    const float mn = fmaxf(m_run, mx), alpha = __expf(m_run - mn);
    m_run = mn;
    float ps = 0.f;
#pragma unroll
    for (int r = 0; r < 16; ++r) { s[r] = __expf(s[r] - mn); ps += s[r]; }
    l_run = l_run * alpha + ps;
#pragma unroll
    for (int r = 0; r < 16; ++r) { o0[r] *= alpha; o1[r] *= alpha; }
#pragma unroll
    for (int s2 = 0; s2 < 2; ++s2) {
        u32x4_t pw; pw[0] = cvtpk(s[8 * s2], s[8 * s2 + 1]); pw[1] = cvtpk(s[8 * s2 + 2], s[8 * s2 + 3]); pw[2] = cvtpk(s[8 * s2 + 4], s[8 * s2 + 5]); pw[3] = cvtpk(s[8 * s2 + 6], s[8 * s2 + 7]);
        const bf16x8 pb = __builtin_bit_cast(bf16x8, pw);
        const s16x4 a0 = *(const s16x4*)(vt0 + 16 * s2), a1 = *(const s16x4*)(vt0 + 16 * s2 + 8);
        const s16x4 c0 = *(const s16x4*)(vt1 + 16 * s2), c1 = *(const s16x4*)(vt1 + 16 * s2 + 8);
        o0 = __builtin_amdgcn_mfma_f32_32x32x16_bf16(__builtin_shufflevector(a0, a1, 0, 1, 2, 3, 4, 5, 6, 7), pb, o0, 0, 0, 0);
        o1 = __builtin_amdgcn_mfma_f32_32x32x16_bf16(__builtin_shufflevector(c0, c1, 0, 1, 2, 3, 4, 5, 6, 7), pb, o1, 0, 0, 0);
    }
}
struct NoMask { __device__ __forceinline__ float operator()(int, float v) const { return v; } };

__device__ __forceinline__ void ph_attn_mfma(const Params& p, int l, bool with_ctx) {
    const int tid_ = opq_tid(), bid_ = opq_bid(); (void)tid_; (void)bid_;
    const int lane = tid_ & 63, hi = lane >> 5, ql = lane & 31;
    const int gw = bid_ * 4 + (tid_ >> 6), nw = gridDim.x * 4;
    constexpr int NQT = S / 32, NCT = L / 32, N_LAT = NB * 6 * NQT, N_CTX = NB * 6 * NCT;
    const int ntask = 2 * N_LAT + (with_ctx ? 2 * N_CTX : 0);
    for (int task = gw; task < ntask; task += nw) {
        bool isC, isCtx; int r;
        if (task < N_LAT) { isC = true; isCtx = false; r = task; }
        else if (task < 2 * N_LAT) { isC = false; isCtx = false; r = task - N_LAT; }
        else { r = task - 2 * N_LAT; isCtx = true; isC = r >= N_CTX; if (isC) r -= N_CTX; }
        const int nqt = isCtx ? NCT : NQT, qt = r % nqt, h = (r / nqt) % 6, b = r / (nqt * 6);
        const int m = isCtx ? TL + b * L + 32 * qt + ql : b * S + 32 * qt + ql;
        const int qcol = isC ? ZQN + h * 64 : ZQB + h * 64, kcol = isC ? ZKN + h * 64 : ZKB + (h / 3) * 64, hv = isC ? 2 + h : h / 3;
        bf16x8 qf[4];
        { const bf16_t* qp = p.Z + (size_t)m * ZP + qcol + 8 * hi;
#pragma unroll
          for (int ks = 0; ks < 4; ++ks) qf[ks] = *(const bf16x8*)(qp + 16 * ks); }
        const bf16_t* kc0 = p.Z + (size_t)(TL + b * L + ql) * ZP + kcol + 8 * hi;
        const bf16_t* kl0 = p.Z + (size_t)(b * S + ql) * ZP + kcol + 8 * hi;
        const bf16_t* vt0 = p.VT + ((size_t)(b * 8 + hv) * 64 + ql) * PU + 4 * hi; const bf16_t* vt1 = vt0 + (size_t)32 * PU;
        f32x16 o0, o1;
#pragma unroll
        for (int rr = 0; rr < 16; ++rr) { o0[rr] = 0.f; o1[rr] = 0.f; }
        float m_run, l_run;
        if (isC) { m_run = -1e30f; l_run = 0.f; } else { m_run = p.b_sink[l * 6 + h]; l_run = hi == 0 ? 1.0f : 0.f; }
#pragma unroll 1
        for (int i = 0; i < NCT; ++i) attn_tile(qf, kc0 + (size_t)(32 * i) * ZP, vt0 + 32 * i, vt1 + 32 * i, NoMask(), m_run, l_run, o0, o1, hi);
        if (!isCtx) {
            if (!isC) {
#pragma unroll 1
                for (int jt = qt - 4; jt <= qt + 4; ++jt) {
                    if (jt < 0 || jt >= NQT) continue;
                    const bf16_t* kr = kl0 + (size_t)(32 * jt) * ZP; const bf16_t* v0 = vt0 + L + 32 * jt; const bf16_t* v1 = vt1 + L + 32 * jt;
                    if (jt == qt - 4 || jt == qt + 4) { const int base = 32 * (jt - qt) - ql;
                        attn_tile(qf, kr, v0, v1, [&](int ko, float v) { const int rel = base + ko; return (rel >= -128 && rel <= 128) ? v : -INFINITY; }, m_run, l_run, o0, o1, hi); }
                    else attn_tile(qf, kr, v0, v1, NoMask(), m_run, l_run, o0, o1, hi);
                }
            } else {
                constexpr int ROWS = S / GRID_W;
                const int gr = qt >> 1, c = 32 * (qt & 1) + ql;
                int r0 = gr - 4; r0 = r0 < 0 ? 0 : (r0 > ROWS - 8 ? ROWS - 8 : r0);
                int c0 = c - 8; c0 = c0 < 0 ? 0 : (c0 > GRID_W - 16 ? GRID_W - 16 : c0);
                const float* rpb = p.c_rpb + ((size_t)l * 6 + h) * 15 * 31;
#pragma unroll 1
                for (int a = 0; a < 8; ++a) {
                    const int kr_ = r0 + a; const float* rp = rpb + (kr_ - gr + 7) * 31 + 15 - c;
#pragma unroll 1
                    for (int ct = 0; ct < 2; ++ct) {
                        const int t0 = kr_ * GRID_W + 32 * ct;
                        attn_tile(qf, kl0 + (size_t)t0 * ZP, vt0 + L + t0, vt1 + L + t0,
                                  [&](int ko, float v) { const int kc = 32 * ct + ko; return (kc >= c0 && kc < c0 + 16) ? v + rp[kc] : -INFINITY; }, m_run, l_run, o0, o1, hi);
                    }
                }
            }
        }
        const float lt = l_run + __shfl_xor(l_run, 32), inv = 1.0f / lt;
        bf16_t* op = p.MIX + (size_t)m * DMIX + (isC ? 640 : 256) + h * 64 + 4 * hi;
#pragma unroll
        for (int g = 0; g < 4; ++g) {
            st_bf16x4(op + 8 * g, (f32x4){o0[4 * g] * inv, o0[4 * g + 1] * inv, o0[4 * g + 2] * inv, o0[4 * g + 3] * inv});
            st_bf16x4(op + 32 + 8 * g, (f32x4){o1[4 * g] * inv, o1[4 * g + 1] * inv, o1[4 * g + 2] * inv, o1[4 * g + 3] * inv});
        }
    }
}


#define RNB " row_newbcast:%c[n] row_mask:0xf bank_mask:0xf\n\t"
template <int N, bool FIRST>
__device__ __forceinline__ void dpp_dot4(float& a0, float& a1, float& a2, float& a3, const f32x4& v, float s0, float s1, float s2, float s3) {
    if (FIRST) asm volatile("s_nop 1");
    asm("v_fmac_f32_dpp %0, %4, %8" RNB "v_fmac_f32_dpp %1, %5, %9" RNB "v_fmac_f32_dpp %2, %6, %10" RNB "v_fmac_f32_dpp %3, %7, %11" RNB
        : "+v"(a0), "+v"(a1), "+v"(a2), "+v"(a3) : "v"(v[0]), "v"(v[1]), "v"(v[2]), "v"(v[3]), "v"(s0), "v"(s1), "v"(s2), "v"(s3), [n] "i"(N));
}
template <int N, bool FIRST>
__device__ __forceinline__ void dpp_upd4s(float& s0, float& s1, float& s2, float& s3, float& y0, float& y1, float& y2, float& y3,
                                          const f32x4& w, const f32x4& b, const f32x4& kd, const f32x4& r, float nsk, float vv) {
    if (FIRST) asm volatile("s_nop 1");
    asm("v_mul_f32_dpp %0, %8, %0" RNB "v_mul_f32_dpp %1, %9, %1" RNB "v_mul_f32_dpp %2, %10, %2" RNB "v_mul_f32_dpp %3, %11, %3" RNB
        "v_fmac_f32_dpp %0, %12, %24" RNB "v_fmac_f32_dpp %1, %13, %24" RNB "v_fmac_f32_dpp %2, %14, %24" RNB "v_fmac_f32_dpp %3, %15, %24" RNB
        "v_fmac_f32_dpp %0, %16, %25" RNB "v_fmac_f32_dpp %1, %17, %25" RNB "v_fmac_f32_dpp %2, %18, %25" RNB "v_fmac_f32_dpp %3, %19, %25" RNB
        "v_fmac_f32_dpp %4, %20, %0" RNB "v_fmac_f32_dpp %5, %21, %1" RNB "v_fmac_f32_dpp %6, %22, %2" RNB "v_fmac_f32_dpp %7, %23, %3" RNB
        : "+v"(s0), "+v"(s1), "+v"(s2), "+v"(s3), "+v"(y0), "+v"(y1), "+v"(y2), "+v"(y3)
        : "v"(w[0]), "v"(w[1]), "v"(w[2]), "v"(w[3]), "v"(b[0]), "v"(b[1]), "v"(b[2]), "v"(b[3]), "v"(kd[0]), "v"(kd[1]), "v"(kd[2]), "v"(kd[3]),
          "v"(r[0]), "v"(r[1]), "v"(r[2]), "v"(r[3]), "v"(nsk), "v"(vv), [n] "i"(N));
}
template <int N, bool FIRST>
__device__ __forceinline__ void dpp_upd4p(float& s0, float& s1, float& s2, float& s3, float& y0, float& y1, float& y2, float& y3,
                                          const f32x4& w, const f32x4& b, const f32x4& r, float nsk) {
    if (FIRST) asm volatile("s_nop 1");
    asm("v_mul_f32_dpp %0, %8, %0" RNB "v_mul_f32_dpp %1, %9, %1" RNB "v_mul_f32_dpp %2, %10, %2" RNB "v_mul_f32_dpp %3, %11, %3" RNB
        "v_fmac_f32_dpp %0, %12, %20" RNB "v_fmac_f32_dpp %1, %13, %20" RNB "v_fmac_f32_dpp %2, %14, %20" RNB "v_fmac_f32_dpp %3, %15, %20" RNB
        "v_fmac_f32_dpp %4, %16, %0" RNB "v_fmac_f32_dpp %5, %17, %1" RNB "v_fmac_f32_dpp %6, %18, %2" RNB "v_fmac_f32_dpp %7, %19, %3" RNB
        : "+v"(s0), "+v"(s1), "+v"(s2), "+v"(s3), "+v"(y0), "+v"(y1), "+v"(y2), "+v"(y3)
        : "v"(w[0]), "v"(w[1]), "v"(w[2]), "v"(w[3]), "v"(b[0]), "v"(b[1]), "v"(b[2]), "v"(b[3]), "v"(r[0]), "v"(r[1]), "v"(r[2]), "v"(r[3]), "v"(nsk), [n] "i"(N));
}
template <int N> struct ScanRep {
    static __device__ __forceinline__ void dot(float& a0, float& a1, float& a2, float& a3, const f32x4& v, const float (&st)[64]) {
        dpp_dot4<N, N == 0>(a0, a1, a2, a3, v, st[4 * N], st[4 * N + 1], st[4 * N + 2], st[4 * N + 3]);
        if constexpr (N < 15) ScanRep<N + 1>::dot(a0, a1, a2, a3, v, st);
    }
    static __device__ __forceinline__ void upds(float (&st)[64], float& y0, float& y1, float& y2, float& y3, const f32x4& w, const f32x4& b, const f32x4& kd, const f32x4& r, float nsk, float vv) {
        dpp_upd4s<N, N == 0>(st[4 * N], st[4 * N + 1], st[4 * N + 2], st[4 * N + 3], y0, y1, y2, y3, w, b, kd, r, nsk, vv);
        if constexpr (N < 15) ScanRep<N + 1>::upds(st, y0, y1, y2, y3, w, b, kd, r, nsk, vv);
    }
    static __device__ __forceinline__ void updp(float (&st)[64], float& y0, float& y1, float& y2, float& y3, const f32x4& w, const f32x4& b, const f32x4& r, float nsk) {
        dpp_upd4p<N, N == 0>(st[4 * N], st[4 * N + 1], st[4 * N + 2], st[4 * N + 3], y0, y1, y2, y3, w, b, r, nsk);
        if constexpr (N < 15) ScanRep<N + 1>::updp(st, y0, y1, y2, y3, w, b, r, nsk);
    }
};
__device__ __forceinline__ int seg_row0(int b, int d, int s) { const int pos0 = 128 * s; return pos0 < L ? TL + b * L + (d ? L - 1 - pos0 : pos0) : b * S + (d ? S - 1 - (pos0 - L) : pos0 - L); }

template <bool ISP>
__device__ __forceinline__ void scan_task(const Params& p, int c, int s, int lane) {
    const int h = c & 3, b = (c >> 2) % NB, d = (c >> 2) / NB;
    const int m0 = seg_row0(b, d, s); const long step = d ? -(long)DA : (long)DA;
    const size_t o = (size_t)m0 * DA + h * 64, od = ((size_t)d * T + m0) * DA + h * 64; const int q = 4 * (lane & 15);
    const float* pkk = p.sKK + o + q; const float* pr = p.sR + o + q; const float* pw = p.sW + od + q; const float* pb = p.sB + od + q;
    const float* pkd = p.sKD + od + q; const float* pv = p.sV + o + lane;
    float* py = (ISP ? p.PV : p.Y) + od + lane;
    float st[64];
#pragma unroll
    for (int k = 0; k < 64; ++k) st[k] = (ISP && k == lane) ? 1.0f : 0.f;
    f32x4 kk = *(const f32x4*)pkk, w = *(const f32x4*)pw, bb = *(const f32x4*)pb, r = *(const f32x4*)pr, kd = w; float vv = 0.f;
    if (!ISP) { kd = *(const f32x4*)pkd; vv = *pv; }
#pragma unroll 1
    for (int i = 0; i < 128; ++i) {
        const long nx = (i < 127) ? step : 0;
        pkk += nx; pw += nx; pb += nx; pr += nx; pkd += nx; pv += nx;
        const f32x4 nkk = *(const f32x4*)pkk, nw = *(const f32x4*)pw, nb = *(const f32x4*)pb, nr = *(const f32x4*)pr;
        f32x4 nkd = nw; float nv = 0.f;
        if (!ISP) { nkd = *(const f32x4*)pkd; nv = *pv; }
        float a0 = 0.f, a1 = 0.f, a2 = 0.f, a3 = 0.f;
        ScanRep<0>::dot(a0, a1, a2, a3, kk, st);
        const float nsk = -((a0 + a1) + (a2 + a3));
        float y0 = 0.f, y1 = 0.f, y2 = 0.f, y3 = 0.f;
        if (ISP) ScanRep<0>::updp(st, y0, y1, y2, y3, w, bb, r, nsk); else ScanRep<0>::upds(st, y0, y1, y2, y3, w, bb, kd, r, nsk, vv);
        *py = (y0 + y1) + (y2 + y3); py += step;
        kk = nkk; w = nw; bb = nb; r = nr; kd = nkd; vv = nv;
    }
    if (s < NSG - 1) {
        float* dst = (ISP ? p.PS : p.QS) + (((size_t)c * NSG + s) * 64 + lane) * 64;
#pragma unroll
        for (int k4 = 0; k4 < 16; ++k4) *(f32x4*)(dst + 4 * k4) = (f32x4){st[4 * k4], st[4 * k4 + 1], st[4 * k4 + 2], st[4 * k4 + 3]};
    }
}
__device__ __forceinline__ void ph_scan_fast(const Params& p) {
    const int tid_ = opq_tid(), bid_ = opq_bid(); (void)tid_; (void)bid_;
    const int lane = tid_ & 63, gw = bid_ * 4 + (tid_ >> 6), nw = gridDim.x * 4;
    constexpr int NS_T = 64 * NSG, NP_T = 64 * (NSG - 1);
    for (int tsk = gw; tsk < NS_T + NP_T; tsk += nw) {
        const int t2 = __builtin_amdgcn_readfirstlane(tsk);
        if (t2 < NS_T) scan_task<false>(p, t2 & 63, t2 >> 6, lane);
        else scan_task<true>(p, (t2 - NS_T) & 63, 1 + ((t2 - NS_T) >> 6), lane);
    }
}
__device__ __forceinline__ void ph_combine(const Params& p, char* lds) {
    const int tid_ = opq_tid(), bid_ = opq_bid(); (void)tid_; (void)bid_;
    if (bid_ >= 64) return;
    const int c = bid_, tid = tid_, v = tid >> 2, jq = tid & 3;
    float* SSc = (float*)lds; float* Pm = (float*)(lds + 64 * 65 * 4 + 16);
    const float* QSc = p.QS + (size_t)c * NSG * 4096; const float* PSc = p.PS + (size_t)c * NSG * 4096; float* SSg = p.SS + (size_t)c * NSG * 4096;
    f32x4 acc[4], nP[4], nQ[4];
#pragma unroll
    for (int i = 0; i < 4; ++i) { acc[i] = *(const f32x4*)(QSc + v * 64 + 16 * jq + 4 * i);
#pragma unroll
        for (int e = 0; e < 4; ++e) { SSg[4096 + (16 * jq + 4 * i + e) * 64 + v] = acc[i][e]; SSc[v * 65 + 16 * jq + 4 * i + e] = acc[i][e]; } }
#pragma unroll
    for (int i = 0; i < 4; ++i) { nP[i] = ((const f32x4*)(PSc + (size_t)4096))[tid + 256 * i]; nQ[i] = *(const f32x4*)(QSc + (size_t)4096 + v * 64 + 16 * jq + 4 * i); }
    for (int s = 1; s < NSG - 1; ++s) {
#pragma unroll
        for (int i = 0; i < 4; ++i) { ((f32x4*)Pm)[tid + 256 * i] = nP[i]; acc[i] = nQ[i]; }
        __syncthreads();
        if (s + 1 < NSG - 1) {
#pragma unroll
            for (int i = 0; i < 4; ++i) { nP[i] = ((const f32x4*)(PSc + (size_t)(s + 1) * 4096))[tid + 256 * i]; nQ[i] = *(const f32x4*)(QSc + (size_t)(s + 1) * 4096 + v * 64 + 16 * jq + 4 * i); }
        }
#pragma unroll 8
        for (int k = 0; k < 64; ++k) { const float a = SSc[v * 65 + k];
#pragma unroll
            for (int i = 0; i < 4; ++i) acc[i] += ((const f32x4*)Pm)[k * 16 + 4 * jq + i] * a; }
        __syncthreads();
#pragma unroll
        for (int i = 0; i < 4; ++i) {
#pragma unroll
            for (int e = 0; e < 4; ++e) { SSg[(size_t)(s + 1) * 4096 + (16 * jq + 4 * i + e) * 64 + v] = acc[i][e]; SSc[v * 65 + 16 * jq + 4 * i + e] = acc[i][e]; } }
    }
}
__device__ __forceinline__ void ph_rwkv_out_fast(const Params& p, int l, bool with_ctx) {
    const int tid_ = opq_tid(), bid_ = opq_bid(); (void)tid_; (void)bid_;
    const int lane = tid_ & 63, gw = bid_ * 4 + (tid_ >> 6), nw = gridDim.x * 4;
    constexpr int TOK = 16, NLT = NB * (S / TOK) * 4, NCTK = NB * (L / TOK) * 4;
    const int ntask = NLT + (with_ctx ? NCTK : 0);
    for (int tsk = gw; tsk < ntask; tsk += nw) {
        const bool isCtx = tsk >= NLT; const int r = isCtx ? tsk - NLT : tsk;
        const int h = r & 3, npt = isCtx ? L / TOK : S / TOK, tt = (r >> 2) % npt, b = (r >> 2) / npt, t128 = tt / (128 / TOK);
        const int seg0 = isCtx ? t128 : L / 128 + t128, seg1 = isCtx ? (L / 128 - 1) - t128 : L / 128 + (S / 128 - 1) - t128;
        const int mbase = isCtx ? TL + b * L + TOK * tt : b * S + TOK * tt;
        float ss0[64], ss1[64];
        { const float* s0p = p.SS + (((size_t)(0 * NB + b) * 4 + h) * NSG + seg0) * 4096 + lane; const float* s1p = p.SS + (((size_t)(1 * NB + b) * 4 + h) * NSG + seg1) * 4096 + lane;
#pragma unroll
          for (int k = 0; k < 64; ++k) { ss0[k] = seg0 > 0 ? s0p[k * 64] : 0.f; ss1[k] = seg1 > 0 ? s1p[k * 64] : 0.f; } }
        const float rk = p.a_r_k[l * DA + h * 64 + lane], gln = p.a_lnx_g[l * DA + h * 64 + lane], bln = p.a_lnx_b[l * DA + h * 64 + lane];
        f32x4 pv0 = {0.f, 0.f, 0.f, 0.f}, pv1 = pv0; float y0l, y1l, rr, kds, vv, gg;
#define ROUT_LOAD(i_) do { const size_t o_ = (size_t)(mbase + (i_)) * DA + h * 64, o1_ = o_ + (size_t)T * DA; \
            if (seg0 > 0) pv0 = *(const f32x4*)(p.PV + o_ + 4 * (lane & 15)); if (seg1 > 0) pv1 = *(const f32x4*)(p.PV + o1_ + 4 * (lane & 15)); \
            y0l = p.Y[o_ + lane]; y1l = p.Y[o1_ + lane]; rr = p.sR[o_ + lane]; kds = p.sKD[o_ + lane] + p.sKD[o1_ + lane]; vv = p.sV[o_ + lane]; gg = p.sG[o_ + lane]; } while (0)
        ROUT_LOAD(0);
#pragma unroll 1
        for (int i = 0; i < TOK; ++i) {
            const f32x4 cpv0 = pv0, cpv1 = pv1; float a0 = y0l, a1 = y1l, a2 = 0.f, a3 = 0.f; const float crr = rr, ckds = kds, cvv = vv, cgg = gg;
            ROUT_LOAD(i + 1 < TOK ? i + 1 : i);
            ScanRep<0>::dot(a0, a1, a2, a3, cpv0, ss0);
            ScanRep<0>::dot(a0, a1, a2, a3, cpv1, ss1);
            const float y = (a0 + a1) + (a2 + a3);
            const float mu = wave_sum(y) * (1.0f / 64.f), dy = y - mu;
            const float rstd = 1.0f / sqrtf(wave_sum(dy * dy) * (1.0f / 64.f) + GN_EPS);
            const float bon = wave_sum(crr * ckds * rk);
            p.MIX[(size_t)(mbase + i) * DMIX + h * 64 + lane] = f2bf((dy * rstd * gln + bln + bon * cvv) * cgg);
        }
#undef ROUT_LOAD
    }
}


#define LAS __attribute__((address_space(3)))
#define XB_TMO      128
#define XB_XCNT(j)  (256  + 64 * (j))
#define XB_XSUB(j)  (1280 + 64 * (j))
#define XB_XGEN(j)  (2304 + 64 * (j))
#define XB_TOP      3328
#define XB_TOPGEN   3392
#define XCD_BAR_WORDS 3456
#define XB_SPIN_CAP (1u << 20)
static_assert(XCD_BAR_WORDS * 4 <= 16384, "barrier words fit the control region");
__device__ __forceinline__ unsigned xb_ld(unsigned* p)              { return __hip_atomic_load(p, __ATOMIC_RELAXED, __HIP_MEMORY_SCOPE_AGENT); }
__device__ __forceinline__ unsigned xb_add(unsigned* p, unsigned v) { return __hip_atomic_fetch_add(p, v, __ATOMIC_RELAXED, __HIP_MEMORY_SCOPE_AGENT); }
__device__ __forceinline__ unsigned xb_xcc_id() { return (unsigned)__builtin_amdgcn_s_getreg((3 << 11) | 20) & 0xFu; }
#define XB_SPIN(cond, bar) do { unsigned _sp = 0; while (cond) { __builtin_amdgcn_s_sleep(1); \
    if ((++_sp & 255u) == 0u) { if (xb_ld(&(bar)[XB_TMO])) break; if (_sp > XB_SPIN_CAP) { atomicAdd(&(bar)[XB_TMO], 1u); break; } } } } while (0)
struct XcdBarrier { unsigned* bar; unsigned x; volatile LAS unsigned* st; };
__device__ __forceinline__ XcdBarrier xcd_barrier_post(unsigned* bar, volatile LAS unsigned* st) {
    XcdBarrier b; b.bar = bar; b.x = xb_xcc_id(); b.st = st;
    if (threadIdx.x == 0) (void)xb_add(&bar[XB_XCNT(b.x)], 1u);
    return b;
}
__device__ __forceinline__ void xcd_barrier_complete(unsigned* bar, unsigned x, unsigned& nloc, unsigned& nx) {
    const unsigned G = gridDim.x * gridDim.y * gridDim.z;
    unsigned sum, cnt, mine, sp = 0u;
    for (;;) {
        sum = 0u; cnt = 0u; mine = 0u;
#pragma unroll
        for (unsigned j = 0; j < 16; ++j) { const unsigned c = xb_ld(&bar[XB_XCNT(j)]); sum += c; cnt += (c > 0u) ? 1u : 0u; mine = (j == x) ? c : mine; }
        if (sum == G) break;
        __builtin_amdgcn_s_sleep(1);
        if ((++sp & 255u) == 0u) { if (xb_ld(&bar[XB_TMO])) break; if (sp > XB_SPIN_CAP) { atomicAdd(&bar[XB_TMO], 1u); break; } }
    }
    nloc = mine > 0u ? mine : 1u; nx = cnt > 0u ? cnt : 1u;
}
__device__ __forceinline__ void xcd_barrier(const XcdBarrier& b) {
    asm volatile("s_waitcnt vmcnt(0)" ::: "memory");
    __syncthreads();
    if (threadIdx.x == 0) {
        unsigned* bar = b.bar;
        __builtin_amdgcn_s_waitcnt(0);
        unsigned nloc = b.st[0], nx = b.st[1];
        if (nloc == 0u) { xcd_barrier_complete(bar, b.x, nloc, nx); b.st[0] = nloc; b.st[1] = nx; }
        const unsigned old = xb_add(&bar[XB_XSUB(b.x)], 1u);
        const unsigned gen = old / nloc;
        if (old + 1u == (gen + 1u) * nloc) {
            __builtin_amdgcn_fence(__ATOMIC_RELEASE, "agent");
            asm volatile("s_waitcnt vmcnt(0)" ::: "memory");
            const unsigned og = xb_add(&bar[XB_TOP], 1u);
            const unsigned tg = og / nx;
            if (og + 1u == (tg + 1u) * nx) xb_add(&bar[XB_TOPGEN], 1u);
            else XB_SPIN(xb_ld(&bar[XB_TOPGEN]) == tg, bar);
            __builtin_amdgcn_fence(__ATOMIC_ACQUIRE, "agent");
            xb_add(&bar[XB_XGEN(b.x)], 1u);
            asm volatile("s_waitcnt vmcnt(0)" ::: "memory");
        } else {
            XB_SPIN(xb_ld(&bar[XB_XGEN(b.x)]) == gen, bar);
            __builtin_amdgcn_fence(__ATOMIC_ACQUIRE, "agent");
            asm volatile("s_waitcnt vmcnt(0)" ::: "memory");
        }
    }
    __syncthreads();
}

#define GT ((long)blockIdx.x * blockDim.x + threadIdx.x)
#define GS ((long)gridDim.x * blockDim.x)
__global__ void __launch_bounds__(256, 2) mega_fwd(Params p) {
    __shared__ __attribute__((aligned(16))) char lds[49152 + 64];
    cg::grid_group grid = cg::this_grid();
    const long gt = GT, gs = GS;
    volatile LAS unsigned* bst = (volatile LAS unsigned*)(LAS char*)(lds + 49152);
    if (threadIdx.x < 2) bst[threadIdx.x] = 0u;
    __syncthreads();
    const XcdBarrier xb = xcd_barrier_post(p.bar, bst);
#ifndef PROBE_PHASE
#define PROBE_PHASE -1
#endif
#define PROBE_AMP 8
    unsigned long long t_prev = 0; int nts = 0;
#define STAMP() do { if (PROBE_PHASE >= 0 && blockIdx.x == 0 && threadIdx.x == 0) { const unsigned long long t_now = __builtin_amdgcn_s_memrealtime(); \
        if (nts == PROBE_PHASE + 1) { const unsigned long long t_end = t_now + PROBE_AMP * (t_now - t_prev); while (__builtin_amdgcn_s_memrealtime() < t_end) __builtin_amdgcn_s_sleep(8); } \
        t_prev = __builtin_amdgcn_s_memrealtime(); } ++nts; } while (0)
#define GSYNC() do { xcd_barrier(xb); STAMP(); } while (0)
    STAMP();
    ph_mod_fast(p, lds); ph_prep_w_fast(p, 0, 0, lds); ph_prep_misc(p, 0, gt, gs, false);
    grid.sync(); STAMP();
    for (int l = 0; l < 2; ++l) {
        const int nrows = (l == 0) ? T : TL;
        ph_lnmod_fast(p, l);
        GSYNC();
        g_gemm_in(p, lds);
        GSYNC();
        ph_streams_s1(p, l);
        GSYNC();
        g_streams_s2(p, l, lds);
        GSYNC();
        ph_scan_fast(p);
        GSYNC();
        ph_combine(p, lds); ph_attn_mfma(p, l, l == 0);
        GSYNC();
        ph_rwkv_out_fast(p, l, l == 0);
        GSYNC();
        g_gemm_out(p, nrows, lds); ph_prep_w_fast(p, l, 1, lds);
        GSYNC();
        ph_post_mixer_fast(p, l, nrows);
        GSYNC();
        g_router(p, l, nrows, lds);
        GSYNC();
        ph_dispatch(p, l, nrows, gt, gs);
        GSYNC();
        g_moe1(p, l, lds);
        GSYNC();
        g_moe2(p, l, lds);
        GSYNC();
        ph_final_fast(p, l, nrows);
        if (l == 0) { ph_prep_w_fast(p, 1, 0, lds); ph_prep_misc(p, 1, gt, gs, false); }
        GSYNC();
    }}

extern "C" void kernel_launch(void* const* d_in, const int* in_sizes, int n_in, void* d_out, int out_size, void* d_ws, size_t ws_size, hipStream_t stream) {
    if (n_in != 32 || out_size != TL * D || ws_size < WS_NEED) { fprintf(stderr, "kernel_launch: unexpected shapes / workspace (n_in %d out %d ws %zu need %zu)\n", n_in, out_size, ws_size, (size_t)WS_NEED); return; }
    static int grid_blocks = 0;
    if (!grid_blocks) {
        int dev = 0, cus = 0, per_cu = 0;
        (void)hipGetDevice(&dev);
        (void)hipDeviceGetAttribute(&cus, hipDeviceAttributeMultiprocessorCount, dev);
        (void)hipOccupancyMaxActiveBlocksPerMultiprocessor(&per_cu, mega_fwd, 256, 0);
        if (per_cu < 1) per_cu = 1;
        if (per_cu > 2) per_cu = 2;
        grid_blocks = cus * per_cu;
        fprintf(stderr, "kernel_launch: %d CUs x %d blocks\n", cus, per_cu);
    }
    Params p = make_params(d_in, d_out, d_ws);
    (void)hipMemsetAsync(d_ws, 0, CTL_BYTES, stream);
    void* args[] = {&p};
    hipError_t e = hipLaunchCooperativeKernel((void*)mega_fwd, dim3(grid_blocks), dim3(256), args, 0, stream);
    if (e != hipSuccess) fprintf(stderr, "cooperative launch failed: %s (grid %d)\n", hipGetErrorString(e), grid_blocks);
}
#endif

#ifdef HOST_EMU
static void host_forward(void* const* d_in, void* d_out, void* d_ws) {
    const Params p = make_params(d_in, d_out, d_ws);
    for (int l = 0; l < 2; ++l) {
        const int nrows = (l == 0) ? T : TL;
        ph_prep_w(p, l, 0, 1); ph_prep_misc(p, l, 0, 1); ph_lnmod(p, l, 0, 1); host_gemm_in(p); ph_streams(p, l, 0, 1); ph_rope(p, 0, 1); ph_scan(p, 0, 1);
        ph_attn(p, l, nrows, 0, 1); ph_rwkv_out(p, l, nrows, 0, 1); host_gemm_out(p, nrows); ph_post_mixer(p, l, nrows, 0, 1);
        ph_dispatch(p, l, nrows, 0, 1); host_moe1(p, l); host_moe2(p, l); ph_final(p, l, nrows, 0, 1);
    }
}
#endif
```

```cpp
#ifdef HOST_EMU
#include <cmath>
#include <cstdio>
#include <cstring>
#include <cstdint>
#include <cstdlib>
#define __device__
#define __global__
#define __host__
#define __forceinline__ inline
#else
#include <hip/hip_runtime.h>
#include <hip/hip_cooperative_groups.h>
#include <cstdio>
#include <cstdint>
namespace cg = cooperative_groups;
#endif

#ifndef CFG_D
#define CFG_D 1024
#define CFG_B 8
#define CFG_S 2048
#define CFG_L 256
#define CFG_DE 512
#endif
constexpr int D = CFG_D, NB = CFG_B, S = CFG_S, L = CFG_L, DE = CFG_DE;
constexpr int TL = NB * S, TC = NB * L, T = TL + TC;
constexpr int GRID_W = 64, HD = 64;
constexpr int DA = 256, A_IN = 1184, N_IN = 2976, NINP = 3072, DMIX = 1024;
constexpr int NEXP = 32, NSLOT = 2 * T + NEXP * 128;
constexpr int ZQB = 0, ZKB = 384, ZVB = 512, ZQN = 640, ZKN = 1024, ZVN = 1408, ZA = 1792, ZP = 2976;
constexpr float LN_EPS = 1e-6f, GN_EPS = 64e-5f, ATT_SCALE = 0.125f;
constexpr float ALPHA = 1.41421356237309515f;

typedef unsigned short bf16_t;

__device__ __forceinline__ float bf2f(bf16_t v) {
    unsigned u = ((unsigned)v) << 16; float f;
#ifdef HOST_EMU
    memcpy(&f, &u, 4);
#else
    f = __uint_as_float(u);
#endif
    return f;
}
__device__ __forceinline__ bf16_t f2bf(float f) {
    unsigned u;
#ifdef HOST_EMU
    memcpy(&u, &f, 4);
#else
    u = __float_as_uint(f);
#endif
    return (bf16_t)((u + 0x7fffu + ((u >> 16) & 1u)) >> 16);
}
__device__ __forceinline__ float sigmoidf_(float x) { return 1.0f / (1.0f + expf(-x)); }
__device__ __forceinline__ float siluf_(float x) { return x / (1.0f + expf(-x)); }
__device__ __forceinline__ int atomic_inc_int(int* p) {
#ifdef HOST_EMU
    int o = *p; *p = o + 1; return o;
#else
    return atomicAdd(p, 1);
#endif
}

struct Params {
    const float *x, *c, *ctx, *c_ctx, *w_mod, *b_mod, *w_in, *w_out, *a_shift, *a_w0, *a_w_up, *a_a0, *a_a_up, *a_g_up,
        *a_k_k, *a_k_a, *a_r_k, *a_lnx_g, *a_lnx_b, *b_sink, *c_rpb, *ln1_g, *ln1_b, *ln2_g, *ln2_b, *w_rg, *b_rg, *w_re,
        *b_re, *w_gate, *w_up, *w_down;
    float* out;
    int* cnt;
    unsigned* bar;
    float* mod;
    float* rope;
    bf16_t *win_t, *wout_t, *wgu_t, *wd_t;
    bf16_t *wrt;
    int* hist;
    bf16_t* HLO;
    bf16_t *wupT, *aupT, *gupT;
    bf16_t* LA;
    float *kT, *kN;
    bf16_t* H;
    bf16_t* Z;
    bf16_t* VT;
    float *sR, *sV, *sKK, *sG, *sW, *sKD, *sB;
    float* Y;
    bf16_t* MIX;
    float *PV, *QS, *PS, *SS;
    float* XC;
    float* O;
    int *rE, *rPos, *rSlot; float* rW;
    int* slotTok;
    bf16_t* ACT;
    float* YS;
};

constexpr size_t al256(size_t v) { return (v + 255) & ~(size_t)255; }
constexpr size_t OFF_CNT = 0;
constexpr size_t OFF_BAR = 4096, CTL_BYTES = 4096 + 16384;
constexpr size_t OFF_MOD = CTL_BYTES;
constexpr size_t OFF_ROPE = al256(OFF_MOD + (size_t)2 * (NB + 1) * 6 * D * 4);
constexpr size_t OFF_LORA = al256(OFF_ROPE + 64 * 16 * 2 * 4);
constexpr size_t OFF_WRT = al256(OFF_LORA + (size_t)(2 * 256 * 64 * 2 + 256 * 160) * 2);
constexpr size_t OFF_LG = al256(OFF_WRT + (size_t)2 * 128 * D * 2);
constexpr size_t OFF_WIN = al256(OFF_LG + (size_t)T * 36 * 4);
constexpr size_t OFF_WOUT = al256(OFF_WIN + (size_t)NINP * D * 2);
constexpr size_t OFF_WGU = al256(OFF_WOUT + (size_t)D * DMIX * 2);
constexpr size_t OFF_WD = al256(OFF_WGU + (size_t)NEXP * 2 * DE * D * 2);
constexpr size_t OFF_H = al256(OFF_WD + (size_t)NEXP * D * DE * 2);
constexpr size_t OFF_Z = al256(OFF_H + (size_t)(T + 1) * D * 2);
constexpr int PU = L + S;
constexpr int NSG = (L + S) / 128;
static_assert((size_t)3 * 64 * ((L + S) / 128) * 4096 * 4 <= (size_t)NEXP * 2 * DE * D * 2 || (L % 128) != 0, "scan segment states overlay wgu_t");
constexpr size_t OFF_VT = al256(OFF_Z + (size_t)T * ZP * 2);
constexpr size_t OFF_S = al256(OFF_VT + (size_t)NB * 8 * 64 * PU * 2);
constexpr size_t S1 = (size_t)T * 256 * 4;
constexpr size_t OFF_Y = al256(OFF_S + 10 * S1);
constexpr size_t OFF_MIX = al256(OFF_Y + 2 * S1);
constexpr size_t OFF_XC = al256(OFF_MIX + (size_t)T * 1024 * 2);
constexpr size_t OFF_ROUTE = al256(OFF_XC + (size_t)TC * D * 4);
constexpr size_t OFF_SLOTTOK = al256(OFF_ROUTE + (size_t)T * 2 * 4 * 4);
constexpr size_t WS_NEED = al256(OFF_SLOTTOK + (size_t)NSLOT * 4);
static_assert((size_t)NSLOT * DE * 2 <= (size_t)T * ZP * 2 && (size_t)T * D * 2 <= (size_t)T * ZP * 2, "ACT / HLO overlay Z");
static_assert((size_t)T * 4 * 4 + (size_t)T * 416 * 2 <= S1, "kN + LA overlay Y[1]");
static_assert((size_t)NSLOT * D * 4 <= 10 * S1 && (size_t)T * D * 4 <= 10 * S1, "YS / O overlay the stream buffers");

static Params make_params(void* const* d_in, void* d_out, void* d_ws) {
    Params p{};
    const float** f = (const float**)&p.x;
    for (int i = 0; i < 32; ++i) f[i] = (const float*)d_in[i];
    p.out = (float*)d_out;
    char* w = (char*)d_ws;
    p.cnt = (int*)(w + OFF_CNT); p.bar = (unsigned*)(w + OFF_BAR); p.mod = (float*)(w + OFF_MOD); p.rope = (float*)(w + OFF_ROPE);
    p.win_t = (bf16_t*)(w + OFF_WIN); p.wout_t = (bf16_t*)(w + OFF_WOUT); p.wgu_t = (bf16_t*)(w + OFF_WGU); p.wd_t = (bf16_t*)(w + OFF_WD);
    p.wrt = (bf16_t*)(w + OFF_WRT); p.hist = (int*)(w + OFF_LG); p.HLO = (bf16_t*)(w + OFF_Z);
    p.wupT = (bf16_t*)(w + OFF_LORA); p.aupT = p.wupT + 2 * 256 * 64; p.gupT = p.aupT + 2 * 256 * 64;
    p.H = (bf16_t*)(w + OFF_H); p.Z = (bf16_t*)(w + OFF_Z); p.VT = (bf16_t*)(w + OFF_VT);
    float* s = (float*)(w + OFF_S); const size_t n1 = (size_t)T * 256;
    p.sR = s; p.sV = s + n1; p.sKK = s + 2 * n1; p.sG = s + 3 * n1; p.sW = s + 4 * n1; p.sKD = s + 6 * n1; p.sB = s + 8 * n1;
    p.Y = (float*)(w + OFF_Y); p.MIX = (bf16_t*)(w + OFF_MIX); p.XC = (float*)(w + OFF_XC);
    p.O = (float*)(w + OFF_S);
    p.PV = (float*)(w + OFF_H); p.QS = (float*)(w + OFF_WGU); p.PS = p.QS + (size_t)64 * NSG * 4096; p.SS = p.PS + (size_t)64 * NSG * 4096;
    p.kT = p.Y; p.kN = p.Y + (size_t)T * 256; p.LA = (bf16_t*)(p.Y + (size_t)T * 256 + (size_t)T * 4);
    int* r = (int*)(w + OFF_ROUTE); p.rE = r; p.rPos = r + 2 * T; p.rSlot = r + 4 * T; p.rW = (float*)(r + 6 * T);
    p.slotTok = (int*)(w + OFF_SLOTTOK);
    p.ACT = (bf16_t*)(w + OFF_Z); p.YS = (float*)(w + OFF_S);
    return p;
}

__device__ void ph_prep_w(const Params& p, int l, long gtid, long gsz) {
    for (long i = gtid; i < (long)D * NINP; i += gsz) {
        const int k = (int)(i / NINP), n = (int)(i % NINP);
        float v = 0.f;
        if (n < N_IN) { const int oc = (n < ZA) ? n + A_IN : n - ZA; v = p.w_in[((size_t)l * D + k) * N_IN + oc]; }
        p.win_t[(size_t)n * D + k] = f2bf(v);
    }
    for (long i = gtid; i < (long)DMIX * D; i += gsz) {
        const int k = (int)(i / D), n = (int)(i % D);
        p.wout_t[(size_t)n * DMIX + k] = f2bf(p.w_out[((size_t)l * DMIX + k) * D + n]);
    }
    for (long i = gtid; i < (long)NEXP * D * 2 * DE; i += gsz) {
        const int rho = (int)(i % (2 * DE)); const long t = i / (2 * DE); const int k = (int)(t % D), e = (int)(t / D);
        const int q = rho >> 5, half = (rho >> 4) & 1, ii = rho & 15, cc = 16 * q + ii;
        const float* src = half ? p.w_up : p.w_gate;
        p.wgu_t[((size_t)e * 2 * DE + rho) * D + k] = f2bf(src[(((size_t)l * NEXP + e) * D + k) * DE + cc]);
    }
    for (long i = gtid; i < (long)NEXP * DE * D; i += gsz) {
        const int n = (int)(i % D); const long t = i / D; const int k = (int)(t % DE), e = (int)(t / DE);
        p.wd_t[((size_t)e * D + n) * DE + k] = f2bf(p.w_down[(((size_t)l * NEXP + e) * DE + k) * D + n]);
    }
}
__device__ __forceinline__ void ph_prep_misc(const Params& p, int l, long gtid, long gsz, bool do_mod = true) {
    if (l == 0 && do_mod) for (long i = gtid; i < (long)2 * (NB + 1) * 6 * D; i += gsz) {
        const int j = (int)(i % (6 * D)), b = (int)((i / (6 * D)) % (NB + 1)), ll = (int)(i / ((long)6 * D * (NB + 1)));
        const float* cv = (b < NB) ? p.c + (size_t)b * D : p.c_ctx;
        float acc = 0.f;
        for (int k = 0; k < D; ++k) acc += siluf_(cv[k]) * p.w_mod[((size_t)ll * D + k) * 6 * D + j];
        p.mod[((size_t)ll * (NB + 1) + b) * 6 * D + j] = acc + p.b_mod[(size_t)ll * 6 * D + j];
    }
    if (l == 0) for (long i = gtid; i < 64 * 16; i += gsz) {
        const int pos = (int)(i / 16), fi = (int)(i % 16);
        const float inv = powf(10000.0f, -(float)fi / 16.0f), ang = (float)pos * inv;
        p.rope[i] = cosf(ang); p.rope[1024 + i] = sinf(ang);
    }
    for (long i = gtid; i < NEXP; i += gsz) p.cnt[l * NEXP + i] = 0;
    for (long i = gtid; i < NSLOT; i += gsz) p.slotTok[i] = T;
    for (long i = gtid; i < D; i += gsz) p.H[(size_t)T * D + i] = 0;
}

__device__ __forceinline__ const float* xrow_in(const Params& p, int l, int m) {
    if (m < TL) return (l == 0 ? p.x : p.out) + (size_t)m * D;
    return (l == 0 ? p.ctx : p.XC) + (size_t)(m - TL) * D;
}
__device__ __forceinline__ const float* modrow(const Params& p, int l, int m) { return p.mod + ((size_t)l * (NB + 1) + (m < TL ? m / S : NB)) * 6 * D; }

__device__ void ph_lnmod(const Params& p, int l, long gtid, long gsz) {
    for (long m = gtid; m < T; m += gsz) {
        const float* xr = xrow_in(p, l, (int)m); const float* md = modrow(p, l, (int)m);
        float s = 0.f; for (int j = 0; j < D; ++j) s += xr[j];
        const float mu = s / D; float q = 0.f;
        for (int j = 0; j < D; ++j) { const float d = xr[j] - mu; q += d * d; }
        const float rstd = 1.0f / sqrtf(q / D + LN_EPS);
        for (int j = 0; j < D; ++j) p.H[(size_t)m * D + j] = f2bf((xr[j] - mu) * rstd * (1.0f + md[D + j]) + md[j]);
    }
}

__device__ __forceinline__ float zshift(const Params& p, int l, int m, int col) {
    int t, len;
    if (m < TL) { t = m % S; len = S; } else { t = (m - TL) % L; len = L; }
    const float* sh = p.a_shift + (size_t)l * 3 * A_IN;
    const bf16_t* z = p.Z + (size_t)m * ZP + ZA + col;
    float v = sh[A_IN + col] * bf2f(z[0]);
    if (t > 0) v += sh[col] * bf2f(z[-ZP]);
    if (t < len - 1) v += sh[2 * A_IN + col] * bf2f(z[ZP]);
    return v;
}

__device__ void ph_streams(const Params& p, int l, long gtid, long gsz) {
    for (long i = gtid; i < (long)T * DA; i += gsz) {
        const int m = (int)(i / DA), c = (int)(i % DA), h0 = c & ~63;
        const float r = zshift(p, l, m, c), k = zshift(p, l, m, 256 + c), v = zshift(p, l, m, 512 + c);
        float nrm = 0.f;
        for (int j = 0; j < 64; ++j) { const float t = zshift(p, l, m, 256 + h0 + j) * p.a_k_k[l * DA + h0 + j]; nrm += t * t; }
        const float kk = k * p.a_k_k[l * DA + c] / sqrtf(nrm + 1e-12f);
        float g = 0.f;
        for (int j = 0; j < 160; ++j) g += sigmoidf_(zshift(p, l, m, 1024 + j)) * p.a_g_up[((size_t)l * 160 + j) * DA + c];
        const size_t o = (size_t)m * DA + c;
        p.sR[o] = r; p.sV[o] = v; p.sKK[o] = kk; p.sG[o] = g;
        for (int d = 0; d < 2; ++d) {
            float aw = 0.f, aa = 0.f;
            for (int j = 0; j < 64; ++j) {
                aw += tanhf(zshift(p, l, m, 768 + d * 64 + j)) * p.a_w_up[(((size_t)l * 2 + d) * 64 + j) * DA + c];
                aa += zshift(p, l, m, 896 + d * 64 + j) * p.a_a_up[(((size_t)l * 2 + d) * 64 + j) * DA + c];
            }
            const float u = -(p.a_w0[(l * 2 + d) * DA + c] + aw);
            const float sp = (u > 20.f) ? u : log1pf(expf(u));
            const float w = expf(-expf(-sp - 0.5f));
            const float a = sigmoidf_(p.a_a0[(l * 2 + d) * DA + c] + aa);
            const size_t od = ((size_t)d * T + m) * DA + c;
            p.sW[od] = w; p.sKD[od] = k * (1.0f + (a - 1.0f) * p.a_k_a[l * DA + c]); p.sB[od] = kk * a;
        }
    }
}

__device__ __forceinline__ void ph_rope(const Params& p, long gtid, long gsz) {
    for (long i = gtid; i < (long)TL * 8 * 32; i += gsz) {
        const int pr = (int)(i & 31), hs = (int)((i >> 5) & 7), m = (int)(i >> 8);
        const int t = m % S, axis = pr >> 4, fi = pr & 15, pos = axis ? (t % GRID_W) : (t / GRID_W);
        bf16_t* z = p.Z + (size_t)m * ZP + hs * 64 + axis * 32 + fi;
        const float cs = p.rope[pos * 16 + fi], sn = p.rope[1024 + pos * 16 + fi];
        const float x0 = bf2f(z[0]), x1 = bf2f(z[16]);
        z[0] = f2bf(x0 * cs - x1 * sn); z[16] = f2bf(x1 * cs + x0 * sn);
    }
}

__device__ void ph_scan(const Params& p, long gtid, long gsz) {
    for (long i = gtid; i < (long)2 * NB * 4 * 64; i += gsz) {
        const int v = (int)(i & 63), h = (int)((i >> 6) & 3), b = (int)((i >> 8) % NB), d = (int)((i >> 8) / NB);
        float st[64];
#pragma unroll
        for (int k = 0; k < 64; ++k) st[k] = 0.f;
        for (int pos = 0; pos < L + S; ++pos) {
            int m;
            if (pos < L) m = TL + b * L + (d ? L - 1 - pos : pos);
            else m = b * S + (d ? S - 1 - (pos - L) : pos - L);
            const size_t o = (size_t)m * DA + h * 64, od = ((size_t)d * T + m) * DA + h * 64;
            const float* kk = p.sKK + o; const float* r = p.sR + o;
            const float* w = p.sW + od; const float* bb = p.sB + od; const float* kd = p.sKD + od;
            const float vv = p.sV[o + v];
            float sk = 0.f;
#pragma unroll
            for (int k = 0; k < 64; ++k) sk += st[k] * kk[k];
            float y = 0.f;
#pragma unroll
            for (int k = 0; k < 64; ++k) { st[k] = st[k] * w[k] - sk * bb[k] + vv * kd[k]; y += st[k] * r[k]; }
            p.Y[od + v] = y;
        }
    }
}

__device__ void ph_rwkv_out(const Params& p, int l, int nrows, long gtid, long gsz) {
    for (long i = gtid; i < (long)nrows * 4; i += gsz) {
        const int m = (int)(i >> 2), h = (int)(i & 3);
        const size_t o = (size_t)m * DA + h * 64;
        const float* y0 = p.Y + o; const float* y1 = p.Y + (size_t)T * DA + o;
        float s = 0.f, bon = 0.f;
        for (int n = 0; n < 64; ++n) {
            s += y0[n] + y1[n];
            bon += p.sR[o + n] * (p.sKD[o + n] + p.sKD[(size_t)T * DA + o + n]) * p.a_r_k[l * DA + h * 64 + n];
        }
        const float mu = s / 64.f; float q = 0.f;
        for (int n = 0; n < 64; ++n) { const float dd = y0[n] + y1[n] - mu; q += dd * dd; }
        const float rstd = 1.0f / sqrtf(q / 64.f + GN_EPS);
        for (int n = 0; n < 64; ++n) {
            const int c = h * 64 + n;
            const float yn = (y0[n] + y1[n] - mu) * rstd * p.a_lnx_g[l * DA + c] + p.a_lnx_b[l * DA + c];
            p.MIX[(size_t)m * DMIX + c] = f2bf((yn + bon * p.sV[o + n]) * p.sG[o + n]);
        }
    }
}

__device__ __forceinline__ void att_key(const float (&q)[64], const bf16_t* kr, const bf16_t* vr, float bias, float& mx, float& ls, float (&acc)[64]) {
    float s = 0.f;
#pragma unroll
    for (int d = 0; d < 64; ++d) s += q[d] * bf2f(kr[d]);
    s = s * ATT_SCALE + bias;
    const float mn = fmaxf(mx, s), f = expf(mx - mn), pe = expf(s - mn);
    ls = ls * f + pe;
#pragma unroll
    for (int d = 0; d < 64; ++d) acc[d] = acc[d] * f + pe * bf2f(vr[d]);
    mx = mn;
}

__device__ void ph_attn(const Params& p, int l, int nrows, long gtid, long gsz) {
    for (long i = gtid; i < (long)nrows * 12; i += gsz) {
        const int m = (int)(i / 12), u = (int)(i % 12);
        const bool isB = u < 6; const int hq = isB ? u : u - 6;
        const int b = (m < TL) ? m / S : (m - TL) / L;
        const int qcol = isB ? ZQB + hq * 64 : ZQN + hq * 64;
        const int kcol = isB ? ZKB + (hq / 3) * 64 : ZKN + hq * 64;
        const int vcol = isB ? ZVB + (hq / 3) * 64 : ZVN + hq * 64;
        float q[64], acc[64];
        const bf16_t* qr = p.Z + (size_t)m * ZP + qcol;
#pragma unroll
        for (int d = 0; d < 64; ++d) { q[d] = bf2f(qr[d]); acc[d] = 0.f; }
        float mx, ls;
        if (isB) { mx = p.b_sink[l * 6 + hq]; ls = 1.0f; } else { mx = -1e30f; ls = 0.f; }
        for (int j = 0; j < L; ++j) { const bf16_t* zr = p.Z + (size_t)(TL + b * L + j) * ZP; att_key(q, zr + kcol, zr + vcol, 0.f, mx, ls, acc); }
        if (m < TL) {
            const int t = m % S;
            if (isB) {
                const int j0 = t - 128 < 0 ? 0 : t - 128, j1 = t + 128 > S - 1 ? S - 1 : t + 128;
                for (int j = j0; j <= j1; ++j) { const bf16_t* zr = p.Z + (size_t)(b * S + j) * ZP; att_key(q, zr + kcol, zr + vcol, 0.f, mx, ls, acc); }
            } else {
                const int rows = S / GRID_W, r = t / GRID_W, c = t % GRID_W;
                int r0 = r - 4; r0 = r0 < 0 ? 0 : (r0 > rows - 8 ? rows - 8 : r0);
                int c0 = c - 8; c0 = c0 < 0 ? 0 : (c0 > GRID_W - 16 ? GRID_W - 16 : c0);
                for (int a = 0; a < 8; ++a)
                    for (int e = 0; e < 16; ++e) {
                        const int kr = r0 + a, kc = c0 + e;
                        const float bias = p.c_rpb[(((size_t)l * 6 + hq) * 15 + (kr - r + 7)) * 31 + (kc - c + 15)];
                        const bf16_t* zr = p.Z + (size_t)(b * S + kr * GRID_W + kc) * ZP;
                        att_key(q, zr + kcol, zr + vcol, bias, mx, ls, acc);
                    }
            }
        }
        const float inv = 1.0f / ls;
        bf16_t* o = p.MIX + (size_t)m * DMIX + (isB ? 256 : 640) + hq * 64;
#pragma unroll
        for (int d = 0; d < 64; ++d) o[d] = f2bf(acc[d] * inv);
    }
}

__device__ void ph_post_mixer(const Params& p, int l, int nrows, long gtid, long gsz) {
    for (long mm = gtid; mm < nrows; mm += gsz) {
        const int m = (int)mm;
        const float* xr = xrow_in(p, l, m); const float* md = modrow(p, l, m); const float* orow = p.O + (size_t)m * D;
        float* x1 = (m < TL) ? p.out + (size_t)m * D : p.XC + (size_t)(m - TL) * D;
        const float* g1 = p.ln1_g + (size_t)l * D; const float* b1 = p.ln1_b + (size_t)l * D;
        float s = 0.f; for (int j = 0; j < D; ++j) s += ALPHA * xr[j] + md[2 * D + j] * orow[j];
        float mu = s / D, q = 0.f;
        for (int j = 0; j < D; ++j) { const float d = ALPHA * xr[j] + md[2 * D + j] * orow[j] - mu; q += d * d; }
        float rstd = 1.0f / sqrtf(q / D + LN_EPS);
        s = 0.f;
        for (int j = 0; j < D; ++j) { const float v = (ALPHA * xr[j] + md[2 * D + j] * orow[j] - mu) * rstd * g1[j] + b1[j]; x1[j] = v; s += v; }
        mu = s / D; q = 0.f;
        for (int j = 0; j < D; ++j) { const float d = x1[j] - mu; q += d * d; }
        rstd = 1.0f / sqrtf(q / D + LN_EPS);
        float gl[4], el[32];
#pragma unroll
        for (int g = 0; g < 4; ++g) gl[g] = p.b_rg[l * 4 + g];
#pragma unroll
        for (int e = 0; e < 32; ++e) el[e] = p.b_re[l * 32 + e];
        for (int j = 0; j < D; ++j) {
            const float hv = (x1[j] - mu) * rstd * (1.0f + md[4 * D + j]) + md[3 * D + j];
            p.H[(size_t)m * D + j] = f2bf(hv);
            const float* wg = p.w_rg + ((size_t)l * D + j) * 4; const float* we = p.w_re + ((size_t)l * D + j) * 32;
#pragma unroll
            for (int g = 0; g < 4; ++g) gl[g] += hv * wg[g];
#pragma unroll
            for (int e = 0; e < 32; ++e) el[e] += hv * we[e];
        }
        int gs = 0; float gm = gl[0];
#pragma unroll
        for (int g = 1; g < 4; ++g) if (gl[g] > gm) { gm = gl[g]; gs = g; }
        float den = 0.f;
#pragma unroll
        for (int g = 0; g < 4; ++g) den += expf(gl[g] - gm);
        const float pg = 1.0f / den;
        float v1 = -3e38f, v2 = -3e38f; int i1 = 0, i2 = 0;
#pragma unroll
        for (int j = 0; j < 8; ++j) {
            const float v = gs == 0 ? el[j] : gs == 1 ? el[8 + j] : gs == 2 ? el[16 + j] : el[24 + j];
            if (v > v1) { v2 = v1; i2 = i1; v1 = v; i1 = j; } else if (v > v2) { v2 = v; i2 = j; }
        }
        const float e2 = expf(v2 - v1), w1 = pg / (1.0f + e2), w2 = pg * e2 / (1.0f + e2);
        const int ea = gs * 8 + i1, eb = gs * 8 + i2;
        p.rE[2 * m] = ea; p.rE[2 * m + 1] = eb; p.rW[2 * m] = w1; p.rW[2 * m + 1] = w2;
        p.rPos[2 * m] = atomic_inc_int(p.cnt + l * NEXP + ea); p.rPos[2 * m + 1] = atomic_inc_int(p.cnt + l * NEXP + eb);
    }
}

__device__ __forceinline__ int pstart_of(const int* cnt, int e) {
    int s = 0;
    for (int j = 0; j < NEXP; ++j) if (j < e) s += (cnt[j] + 127) & ~127;
    return s;
}
__device__ __forceinline__ void ph_dispatch(const Params& p, int l, int nrows, long gtid, long gsz) {
    for (long i = gtid; i < (long)nrows * 2; i += gsz) {
        const int slot = pstart_of(p.cnt + l * NEXP, p.rE[i]) + p.rPos[i];
        p.rSlot[i] = slot; p.slotTok[slot] = (int)(i >> 1);
    }
}

__device__ void ph_final(const Params& p, int l, int nrows, long gtid, long gsz) {
    for (long mm = gtid; mm < nrows; mm += gsz) {
        const int m = (int)mm;
        float* x1 = (m < TL) ? p.out + (size_t)m * D : p.XC + (size_t)(m - TL) * D;
        const float* md = modrow(p, l, m);
        const float* ya = p.YS + (size_t)p.rSlot[2 * m] * D; const float* yb = p.YS + (size_t)p.rSlot[2 * m + 1] * D;
        const float wa = p.rW[2 * m], wb = p.rW[2 * m + 1];
        const float* g2 = p.ln2_g + (size_t)l * D; const float* b2 = p.ln2_b + (size_t)l * D;
        float s = 0.f; for (int j = 0; j < D; ++j) s += ALPHA * x1[j] + md[5 * D + j] * (wa * ya[j] + wb * yb[j]);
        const float mu = s / D; float q = 0.f;
        for (int j = 0; j < D; ++j) { const float d = ALPHA * x1[j] + md[5 * D + j] * (wa * ya[j] + wb * yb[j]) - mu; q += d * d; }
        const float rstd = 1.0f / sqrtf(q / D + LN_EPS);
        for (int j = 0; j < D; ++j) x1[j] = (ALPHA * x1[j] + md[5 * D + j] * (wa * ya[j] + wb * yb[j]) - mu) * rstd * g2[j] + b2[j];
    }
}

__device__ __forceinline__ int moe_blocks(const int* cnt) { int s = 0; for (int j = 0; j < NEXP; ++j) s += (cnt[j] + 127) >> 7; return s; }
__device__ __forceinline__ int moe_block_expert(const int* cnt, int rb) {
    int s = 0, e = 0;
    for (int j = 0; j < NEXP; ++j) { const int nb = (cnt[j] + 127) >> 7; if (rb >= s && rb < s + nb) e = j; s += nb; }
    return e;
}

#ifdef HOST_EMU
static void host_gemm_in(const Params& p) {
    for (int m = 0; m < T; ++m) for (int n = 0; n < ZP; ++n) { float a = 0.f; for (int k = 0; k < D; ++k) a += bf2f(p.H[(size_t)m * D + k]) * bf2f(p.win_t[(size_t)n * D + k]); p.Z[(size_t)m * ZP + n] = f2bf(a); }
}
static void host_gemm_out(const Params& p, int nrows) {
    for (int m = 0; m < nrows; ++m) for (int n = 0; n < D; ++n) { float a = 0.f; for (int k = 0; k < DMIX; ++k) a += bf2f(p.MIX[(size_t)m * DMIX + k]) * bf2f(p.wout_t[(size_t)n * DMIX + k]); p.O[(size_t)m * D + n] = a; }
}
static void host_moe1(const Params& p, int l) {
    const int* cnt = p.cnt + l * NEXP; const int nrb = moe_blocks(cnt);
    for (int rb = 0; rb < nrb; ++rb) { const int e = moe_block_expert(cnt, rb);
        for (int r = 0; r < 128; ++r) { const int slot = rb * 128 + r; const bf16_t* a = p.H + (size_t)p.slotTok[slot] * D;
            for (int c = 0; c < DE; ++c) { const int q = c >> 4, ii = c & 15; float g = 0.f, u = 0.f;
                const bf16_t* wg = p.wgu_t + ((size_t)e * 2 * DE + 32 * q + ii) * D; const bf16_t* wu = wg + (size_t)16 * D;
                for (int k = 0; k < D; ++k) { g += bf2f(a[k]) * bf2f(wg[k]); u += bf2f(a[k]) * bf2f(wu[k]); }
                p.ACT[(size_t)slot * DE + c] = f2bf(siluf_(g) * u); } } }
}
static void host_moe2(const Params& p, int l) {
    const int* cnt = p.cnt + l * NEXP; const int nrb = moe_blocks(cnt);
    for (int rb = 0; rb < nrb; ++rb) { const int e = moe_block_expert(cnt, rb);
        for (int r = 0; r < 128; ++r) { const int slot = rb * 128 + r;
            for (int n = 0; n < D; ++n) { float a = 0.f; const bf16_t* w = p.wd_t + ((size_t)e * D + n) * DE;
                for (int k = 0; k < DE; ++k) a += bf2f(p.ACT[(size_t)slot * DE + k]) * bf2f(w[k]);
                p.YS[(size_t)slot * D + n] = a; } } }
}
#else
typedef short bf16x8 __attribute__((ext_vector_type(8)));
typedef float f32x4 __attribute__((ext_vector_type(4)));
__device__ __forceinline__ int opq_tid() { int t = threadIdx.x; asm volatile("" : "+v"(t)); return t; }
__device__ __forceinline__ int opq_bid() { int b = blockIdx.x; asm volatile("" : "+s"(b)); return b; }
__device__ __forceinline__ unsigned pk2(float lo, float hi) { return (unsigned)f2bf(lo) | ((unsigned)f2bf(hi) << 16); }
struct u32x2_t { unsigned x, y; };
__device__ __forceinline__ void st_bf16x4(bf16_t* dst, f32x4 v) { u32x2_t o; o.x = pk2(v[0], v[1]); o.y = pk2(v[2], v[3]); *(u32x2_t*)dst = o; }
template <class Epi>
__device__ __forceinline__ void gemm_tile(const bf16_t* a0, const bf16_t* a1, const bf16_t* b0, const bf16_t* b1, int K, char* lds, const Epi& epi, int nseg = 1, size_t aseg = 0, size_t bseg = 0) {
    const int tid = opq_tid(), wid = tid >> 6, lane = tid & 63, wr = wid >> 1, wc = wid & 1, fr = lane & 15, fq = lane >> 4;
    char* SA = lds; char* SB = lds + 8192;
    f32x4 acc[4][4];
#pragma unroll
    for (int m = 0; m < 4; ++m)
#pragma unroll
        for (int n = 0; n < 4; ++n) acc[m][n] = (f32x4){0.f, 0.f, 0.f, 0.f};
    for (int sg = 0; sg < nseg; ++sg, a0 += aseg, a1 += aseg, b0 += bseg, b1 += bseg)
    for (int kt = 0; kt < K; kt += 32) {
        __builtin_amdgcn_global_load_lds((const unsigned*)(a0 + kt), (__attribute__((address_space(3))) unsigned*)(SA + tid * 16), 16, 0, 0);
        __builtin_amdgcn_global_load_lds((const unsigned*)(a1 + kt), (__attribute__((address_space(3))) unsigned*)(SA + tid * 16 + 4096), 16, 0, 0);
        __builtin_amdgcn_global_load_lds((const unsigned*)(b0 + kt), (__attribute__((address_space(3))) unsigned*)(SB + tid * 16), 16, 0, 0);
        __builtin_amdgcn_global_load_lds((const unsigned*)(b1 + kt), (__attribute__((address_space(3))) unsigned*)(SB + tid * 16 + 4096), 16, 0, 0);
        asm volatile("s_waitcnt vmcnt(0)" ::: "memory");
        __syncthreads();
        bf16x8 At[4], Bt[4];
#pragma unroll
        for (int m = 0; m < 4; ++m) At[m] = *(const bf16x8*)(SA + (wr * 64 + m * 16 + fr) * 64 + fq * 16);
#pragma unroll
        for (int n = 0; n < 4; ++n) Bt[n] = *(const bf16x8*)(SB + (wc * 64 + n * 16 + fr) * 64 + fq * 16);
#pragma unroll
        for (int m = 0; m < 4; ++m)
#pragma unroll
            for (int n = 0; n < 4; ++n) acc[m][n] = __builtin_amdgcn_mfma_f32_16x16x32_bf16(At[m], Bt[n], acc[m][n], 0, 0, 0);
        __syncthreads();
    }
    epi(acc, wr, wc, fr, fq);
}
#define STG_ROW(i) ((tid_ + (i) * 256) >> 2)
#define STG_K ((tid_ & 3) * 8)

__device__ __forceinline__ void g_gemm_in(const Params& p, char* lds) {
    const int tid_ = opq_tid(), bid_ = opq_bid(); (void)tid_; (void)bid_;
    constexpr int NT = NINP / 128, MT = T / 128;
    for (int tile = bid_; tile < NT * MT; tile += gridDim.x) {
        const int tm = tile / NT, tn = tile % NT;
        const bf16_t* a0 = p.H + (size_t)(tm * 128 + STG_ROW(0)) * D + STG_K; const bf16_t* a1 = p.H + (size_t)(tm * 128 + STG_ROW(1)) * D + STG_K;
        const bf16_t* b0 = p.win_t + (size_t)(tn * 128 + STG_ROW(0)) * D + STG_K; const bf16_t* b1 = p.win_t + (size_t)(tn * 128 + STG_ROW(1)) * D + STG_K;
        gemm_tile(a0, a1, b0, b1, D, lds, [&](const f32x4 (&acc)[4][4], int wr, int wc, int fr, int fq) {
            if (tn < ZVB / 128 && tm < TL / 128) {
#pragma unroll
                for (int m = 0; m < 4; ++m)
#pragma unroll
                    for (int j = 0; j < 4; ++j) { const int row = tm * 128 + wr * 64 + m * 16 + fq * 4 + j, t = row % S;
                        bf16_t* zr = p.Z + (size_t)row * ZP + tn * 128 + wc * 64 + fr;
#pragma unroll
                        for (int ax = 0; ax < 2; ++ax) { const int pos = ax ? t % GRID_W : t / GRID_W; const float cs = p.rope[pos * 16 + fr], sn = p.rope[1024 + pos * 16 + fr];
                            const float x0 = acc[m][2 * ax][j], x1 = acc[m][2 * ax + 1][j];
                            zr[32 * ax] = f2bf(x0 * cs - x1 * sn); zr[32 * ax + 16] = f2bf(x1 * cs + x0 * sn); } }
            } else {
#pragma unroll
            for (int m = 0; m < 4; ++m)
#pragma unroll
                for (int n = 0; n < 4; ++n) { const int col = tn * 128 + wc * 64 + n * 16 + fr;
                    if (col < ZP) {
#pragma unroll
                        for (int j = 0; j < 4; ++j) p.Z[(size_t)(tm * 128 + wr * 64 + m * 16 + fq * 4 + j) * ZP + col] = f2bf(acc[m][n][j]); } }
            }
            if (tn == ZVB / 128 || (tn >= ZVN / 128 && tn < ZA / 128)) {
#pragma unroll
                for (int m = 0; m < 4; ++m) { const int m0 = tm * 128 + wr * 64 + m * 16 + fq * 4; int b, u;
                    if (m0 < TL) { b = m0 / S; u = L + m0 % S; } else { b = (m0 - TL) / L; u = (m0 - TL) % L; }
#pragma unroll
                    for (int n = 0; n < 4; ++n) { const int col = tn * 128 + wc * 64 + n * 16 + fr;
                        const int hv = col < ZVN ? (col - ZVB) >> 6 : 2 + ((col - ZVN) >> 6), d = col < ZVN ? (col - ZVB) & 63 : (col - ZVN) & 63;
                        st_bf16x4(p.VT + ((size_t)(b * 8 + hv) * 64 + d) * PU + u, acc[m][n]); } }
            }
        });
    }
}
__device__ __forceinline__ void g_gemm_out(const Params& p, int nrows, char* lds) {
    const int tid_ = opq_tid(), bid_ = opq_bid(); (void)tid_; (void)bid_;
    constexpr int NT = D / 128; const int MT = nrows / 128;
    for (int tile = bid_; tile < NT * MT; tile += gridDim.x) {
        const int tm = tile / NT, tn = tile % NT;
        const bf16_t* a0 = p.MIX + (size_t)(tm * 128 + STG_ROW(0)) * DMIX + STG_K; const bf16_t* a1 = p.MIX + (size_t)(tm * 128 + STG_ROW(1)) * DMIX + STG_K;
        const bf16_t* b0 = p.wout_t + (size_t)(tn * 128 + STG_ROW(0)) * DMIX + STG_K; const bf16_t* b1 = p.wout_t + (size_t)(tn * 128 + STG_ROW(1)) * DMIX + STG_K;
        gemm_tile(a0, a1, b0, b1, DMIX, lds, [&](const f32x4 (&acc)[4][4], int wr, int wc, int fr, int fq) {
#pragma unroll
            for (int m = 0; m < 4; ++m)
#pragma unroll
                for (int n = 0; n < 4; ++n)
#pragma unroll
                    for (int j = 0; j < 4; ++j) p.O[(size_t)(tm * 128 + wr * 64 + m * 16 + fq * 4 + j) * D + tn * 128 + wc * 64 + n * 16 + fr] = acc[m][n][j];
        });
    }
}
__device__ __forceinline__ void g_moe1(const Params& p, int l, char* lds) {
    const int tid_ = opq_tid(), bid_ = opq_bid(); (void)tid_; (void)bid_;
    const int* cnt = p.cnt + l * NEXP; const int nrb = moe_blocks(cnt); constexpr int NT = 2 * DE / 128;
    for (int tile = bid_; tile < nrb * NT; tile += gridDim.x) {
        const int rb = tile / NT, tn = tile % NT, e = moe_block_expert(cnt, rb);
        const bf16_t* a0 = p.H + (size_t)p.slotTok[rb * 128 + STG_ROW(0)] * D + STG_K; const bf16_t* a1 = p.H + (size_t)p.slotTok[rb * 128 + STG_ROW(1)] * D + STG_K;
        const bf16_t* bw = p.wgu_t + (size_t)e * 2 * DE * D;
        const bf16_t* b0 = bw + (size_t)(tn * 128 + STG_ROW(0)) * D + STG_K; const bf16_t* b1 = bw + (size_t)(tn * 128 + STG_ROW(1)) * D + STG_K;
        gemm_tile(a0, a1, b0, b1, D, lds, [&](const f32x4 (&acc)[4][4], int wr, int wc, int fr, int fq) {
#pragma unroll
            for (int m = 0; m < 4; ++m)
#pragma unroll
                for (int n2 = 0; n2 < 2; ++n2) { const int col = tn * 64 + wc * 32 + n2 * 16 + fr;
#pragma unroll
                    for (int j = 0; j < 4; ++j) { const float g = acc[m][2 * n2][j], u = acc[m][2 * n2 + 1][j];
                        p.ACT[(size_t)(rb * 128 + wr * 64 + m * 16 + fq * 4 + j) * DE + col] = f2bf(g / (1.0f + __expf(-g)) * u); } }
        });
    }
}
__device__ __forceinline__ void g_moe2(const Params& p, int l, char* lds) {
    const int tid_ = opq_tid(), bid_ = opq_bid(); (void)tid_; (void)bid_;
    const int* cnt = p.cnt + l * NEXP; const int nrb = moe_blocks(cnt); constexpr int NT = D / 128;
    for (int tile = bid_; tile < nrb * NT; tile += gridDim.x) {
        const int rb = tile / NT, tn = tile % NT, e = moe_block_expert(cnt, rb);
        const bf16_t* a0 = p.ACT + (size_t)(rb * 128 + STG_ROW(0)) * DE + STG_K; const bf16_t* a1 = p.ACT + (size_t)(rb * 128 + STG_ROW(1)) * DE + STG_K;
        const bf16_t* bw = p.wd_t + (size_t)e * D * DE;
        const bf16_t* b0 = bw + (size_t)(tn * 128 + STG_ROW(0)) * DE + STG_K; const bf16_t* b1 = bw + (size_t)(tn * 128 + STG_ROW(1)) * DE + STG_K;
        gemm_tile(a0, a1, b0, b1, DE, lds, [&](const f32x4 (&acc)[4][4], int wr, int wc, int fr, int fq) {
#pragma unroll
            for (int m = 0; m < 4; ++m)
#pragma unroll
                for (int n = 0; n < 4; ++n)
#pragma unroll
                    for (int j = 0; j < 4; ++j) p.YS[(size_t)(rb * 128 + wr * 64 + m * 16 + fq * 4 + j) * D + tn * 128 + wc * 64 + n * 16 + fr] = acc[m][n][j];
        });
    }
}


constexpr int DV = D / 256;
static_assert(D % 256 == 0, "row phases hold a row as DV float4 per lane");
template <int CTRL> __device__ __forceinline__ float dppf(float v) { return __builtin_bit_cast(float, __builtin_amdgcn_update_dpp(0, __builtin_bit_cast(int, v), CTRL, 0xf, 0xf, true)); }
__device__ __forceinline__ float wave_sum(float v) {
    v += dppf<0xB1>(v); v += dppf<0x4E>(v); v += dppf<0x141>(v); v += dppf<0x140>(v);
    float a = v, b = v;
    asm volatile("s_nop 1\n\tv_permlane16_swap_b32 %0, %1" : "+v"(a), "+v"(b));
    v = a + b; a = v; b = v;
    asm volatile("s_nop 1\n\tv_permlane32_swap_b32 %0, %1" : "+v"(a), "+v"(b));
    return a + b;
}
__device__ __forceinline__ float sum8(float v) { v += dppf<0xB1>(v); v += dppf<0x4E>(v); v += dppf<0x141>(v); return v; }
__device__ __forceinline__ float sum4(f32x4 a) { return (a[0] + a[1]) + (a[2] + a[3]); }
#define LDS_WAIT() asm volatile("s_waitcnt lgkmcnt(0)" ::: "memory")

__device__ __forceinline__ void row_stats(const f32x4 (&v)[DV], float& mu, float& rstd) {
    float s = 0.f;
#pragma unroll
    for (int j = 0; j < DV; ++j) s += sum4(v[j]);
    mu = wave_sum(s) * (1.0f / D);
    float q = 0.f;
#pragma unroll
    for (int j = 0; j < DV; ++j) { const f32x4 d = v[j] - mu; q += sum4(d * d); }
    rstd = 1.0f / sqrtf(wave_sum(q) * (1.0f / D) + LN_EPS);
}

__device__ __forceinline__ void ph_lnmod_fast(const Params& p, int l) {
    const int tid_ = opq_tid(), bid_ = opq_bid(); (void)tid_; (void)bid_;
    const int lane = tid_ & 63, gw = bid_ * 4 + (tid_ >> 6), nw = gridDim.x * 4;
    for (int m = gw; m < T; m += nw) {
        const f32x4* xr = (const f32x4*)xrow_in(p, l, m) + lane; const f32x4* md = (const f32x4*)modrow(p, l, m) + lane;
        f32x4 v[DV];
#pragma unroll
        for (int j = 0; j < DV; ++j) v[j] = xr[64 * j];
        float mu, rstd; row_stats(v, mu, rstd);
#pragma unroll
        for (int j = 0; j < DV; ++j) { const f32x4 sh = md[64 * j], sc = md[D / 4 + 64 * j];
            st_bf16x4(p.H + (size_t)m * D + 4 * (lane + 64 * j), (v[j] - mu) * rstd * (sc + 1.0f) + sh); }
    }
}

__device__ __forceinline__ void ph_post_mixer_fast(const Params& p, int l, int nrows) {
    const int tid_ = opq_tid(), bid_ = opq_bid(); (void)tid_; (void)bid_;
    const int lane = tid_ & 63, gw = bid_ * 4 + (tid_ >> 6), nw = gridDim.x * 4;
    for (int m = gw; m < nrows; m += nw) {
        const f32x4* xr = (const f32x4*)xrow_in(p, l, m) + lane; const f32x4* md = (const f32x4*)modrow(p, l, m) + lane;
        const f32x4* orow = (const f32x4*)(p.O + (size_t)m * D) + lane;
        f32x4* x1 = (f32x4*)((m < TL) ? p.out + (size_t)m * D : p.XC + (size_t)(m - TL) * D) + lane;
        const f32x4* g1 = (const f32x4*)(p.ln1_g + (size_t)l * D) + lane; const f32x4* b1 = (const f32x4*)(p.ln1_b + (size_t)l * D) + lane;
        f32x4 v[DV];
#pragma unroll
        for (int j = 0; j < DV; ++j) v[j] = xr[64 * j] * ALPHA + md[2 * (D / 4) + 64 * j] * orow[64 * j];
        float mu, rstd; row_stats(v, mu, rstd);
#pragma unroll
        for (int j = 0; j < DV; ++j) { v[j] = (v[j] - mu) * rstd * g1[64 * j] + b1[64 * j]; x1[64 * j] = v[j]; }
        row_stats(v, mu, rstd);
#pragma unroll
        for (int j = 0; j < DV; ++j) {
            const f32x4 hv = (v[j] - mu) * rstd * (md[4 * (D / 4) + 64 * j] + 1.0f) + md[3 * (D / 4) + 64 * j];
            f32x4 hh, lo;
#pragma unroll
            for (int e = 0; e < 4; ++e) { hh[e] = bf2f(f2bf(hv[e])); lo[e] = hv[e] - hh[e]; }
            st_bf16x4(p.H + (size_t)m * D + 4 * (lane + 64 * j), hh);
            st_bf16x4(p.HLO + (size_t)m * D + 4 * (lane + 64 * j), lo);
        }
    }
}

__device__ __forceinline__ void g_router(const Params& p, int l, int nrows, char* lds) {
    const int tid_ = opq_tid(), bid_ = opq_bid(); (void)tid_; (void)bid_;
    const int lane = tid_ & 63, wid = tid_ >> 6, fr = lane & 15, fq = lane >> 4;
    float* part = (float*)lds;
    float* lgt = part + 4 * 6 * 64 * 4;
    int* eids = (int*)(lgt + 32 * 48);
    for (int rg = bid_; rg < nrows / 32; rg += gridDim.x) {
        f32x4 acc[2][3];
#pragma unroll
        for (int a = 0; a < 2; ++a)
#pragma unroll
            for (int b = 0; b < 3; ++b) acc[a][b] = (f32x4){0.f, 0.f, 0.f, 0.f};
#pragma unroll
        for (int seg = 0; seg < 3; ++seg) {
            const bf16_t* ap = (seg < 2 ? p.H : p.HLO) + (size_t)(rg * 32 + fr) * D + wid * (D / 4) + fq * 8;
            const bf16_t* bp = p.wrt + (seg == 1 ? (size_t)128 * D : 0) + (size_t)fr * D + wid * (D / 4) + fq * 8;
#pragma unroll 1
            for (int ks0 = 0; ks0 < D / 128; ks0 += 4) {
                bf16x8 av[4][2], bv[4][3];
#pragma unroll
                for (int u = 0; u < 4; ++u) { const int ko = (ks0 + u) * 32;
                    av[u][0] = *(const bf16x8*)(ap + ko); av[u][1] = *(const bf16x8*)(ap + (size_t)16 * D + ko);
                    bv[u][0] = *(const bf16x8*)(bp + ko); bv[u][1] = *(const bf16x8*)(bp + (size_t)16 * D + ko); bv[u][2] = *(const bf16x8*)(bp + (size_t)32 * D + ko); }
                asm volatile("" ::: "memory");
#pragma unroll
                for (int u = 0; u < 4; ++u)
#pragma unroll
                    for (int a = 0; a < 2; ++a)
#pragma unroll
                        for (int b = 0; b < 3; ++b) acc[a][b] = __builtin_amdgcn_mfma_f32_16x16x32_bf16(av[u][a], bv[u][b], acc[a][b], 0, 0, 0);
            }
        }
#pragma unroll
        for (int a = 0; a < 2; ++a)
#pragma unroll
            for (int b = 0; b < 3; ++b) *(f32x4*)(part + ((wid * 6 + a * 3 + b) * 64 + lane) * 4) = acc[a][b];
        __syncthreads();
#pragma unroll
        for (int i = 0; i < 6; ++i) { const int e = tid_ + 256 * i, f = e >> 8, ln = (e & 255) >> 2, j = e & 3;
            const float sm = (part[((0 * 6 + f) * 64 + ln) * 4 + j] + part[((1 * 6 + f) * 64 + ln) * 4 + j]) + (part[((2 * 6 + f) * 64 + ln) * 4 + j] + part[((3 * 6 + f) * 64 + ln) * 4 + j]);
            lgt[((f / 3) * 16 + (ln >> 4) * 4 + j) * 48 + (f % 3) * 16 + (ln & 15)] = sm; }
        __syncthreads();
        if (tid_ < 32) {
            const int m = rg * 32 + tid_; const float* lg = lgt + tid_ * 48;
            float gl[4], el[32];
#pragma unroll
            for (int g = 0; g < 4; ++g) gl[g] = lg[g] + p.b_rg[l * 4 + g];
#pragma unroll
            for (int e = 0; e < 32; ++e) el[e] = lg[4 + e] + p.b_re[l * 32 + e];
            int gs = 0; float gm = gl[0];
#pragma unroll
            for (int g = 1; g < 4; ++g) if (gl[g] > gm) { gm = gl[g]; gs = g; }
            float den = 0.f;
#pragma unroll
            for (int g = 0; g < 4; ++g) den += expf(gl[g] - gm);
            const float pg = 1.0f / den;
            float v1 = -3e38f, v2 = -3e38f; int i1 = 0, i2 = 0;
#pragma unroll
            for (int j = 0; j < 8; ++j) {
                const float vv = gs == 0 ? el[j] : gs == 1 ? el[8 + j] : gs == 2 ? el[16 + j] : el[24 + j];
                if (vv > v1) { v2 = v1; i2 = i1; v1 = vv; i1 = j; } else if (vv > v2) { v2 = vv; i2 = j; }
            }
            const float e2 = expf(v2 - v1), w1 = pg / (1.0f + e2), w2 = pg * e2 / (1.0f + e2);
            const int ea = gs * 8 + i1, eb = gs * 8 + i2;
            p.rE[2 * m] = ea; p.rE[2 * m + 1] = eb; p.rW[2 * m] = w1; p.rW[2 * m + 1] = w2;
            eids[2 * tid_] = ea; eids[2 * tid_ + 1] = eb;
        }
        __syncthreads();
        if (tid_ < 64) { const int e = eids[tid_]; int rk = 0; for (int j = 0; j < tid_; ++j) rk += (eids[j] == e) ? 1 : 0; p.rPos[2 * (rg * 32) + tid_] = rk; }
        else if (tid_ < 96) { const int e = tid_ - 64; int c = 0; for (int j = 0; j < 64; ++j) c += (eids[j] == e) ? 1 : 0; p.hist[rg * 32 + e] = c; }
        __syncthreads();
    }
}

__device__ __forceinline__ void ph_dispatch_fast(const Params& p, int l, int nrows, char* lds) {
    const int tid_ = opq_tid(), bid_ = opq_bid(); (void)tid_; (void)bid_;
    const int nrg = nrows / 32, e = tid_ & 31, part = tid_ >> 5;
    int* tot = (int*)lds; int* pst = tot + 32; int* pre = pst + 32; int* red = pre + 32;
    { int s = 0; for (int b = part; b < nrg; b += 8) s += p.hist[b * 32 + e]; red[part * 32 + e] = s; }
    __syncthreads();
    if (tid_ < 32) { int s = 0; for (int q = 0; q < 8; ++q) s += red[q * 32 + tid_]; tot[tid_] = s; }
    __syncthreads();
    if (tid_ < 32) { int s = 0; for (int j = 0; j < tid_; ++j) s += (tot[j] + 127) & ~127; pst[tid_] = s; if (bid_ == 0) p.cnt[l * NEXP + tid_] = tot[tid_]; }
    for (int rg = bid_; rg < nrg; rg += gridDim.x) {
        __syncthreads();
        { int s = 0; for (int b = part; b < rg; b += 8) s += p.hist[b * 32 + e]; red[part * 32 + e] = s; }
        __syncthreads();
        if (tid_ < 32) { int s = 0; for (int q = 0; q < 8; ++q) s += red[q * 32 + tid_]; pre[tid_] = s; }
        __syncthreads();
        if (tid_ < 64) { const int i = 2 * (rg * 32) + tid_, ee = p.rE[i], slot = pst[ee] + pre[ee] + p.rPos[i]; p.rSlot[i] = slot; p.slotTok[slot] = i >> 1; }
    }
}

__device__ __forceinline__ void ph_final_fast(const Params& p, int l, int nrows) {
    const int tid_ = opq_tid(), bid_ = opq_bid(); (void)tid_; (void)bid_;
    const int lane = tid_ & 63, gw = bid_ * 4 + (tid_ >> 6), nw = gridDim.x * 4;
    for (int m = gw; m < nrows; m += nw) {
        f32x4* x1 = (f32x4*)((m < TL) ? p.out + (size_t)m * D : p.XC + (size_t)(m - TL) * D) + lane;
        const f32x4* md = (const f32x4*)modrow(p, l, m) + lane;
        const f32x4* ya = (const f32x4*)(p.YS + (size_t)p.rSlot[2 * m] * D) + lane; const f32x4* yb = (const f32x4*)(p.YS + (size_t)p.rSlot[2 * m + 1] * D) + lane;
        const float wa = p.rW[2 * m], wb = p.rW[2 * m + 1];
        const f32x4* g2 = (const f32x4*)(p.ln2_g + (size_t)l * D) + lane; const f32x4* b2 = (const f32x4*)(p.ln2_b + (size_t)l * D) + lane;
        f32x4 v[DV];
#pragma unroll
        for (int j = 0; j < DV; ++j) v[j] = x1[64 * j] * ALPHA + md[5 * (D / 4) + 64 * j] * (ya[64 * j] * wa + yb[64 * j] * wb);
        float mu, rstd; row_stats(v, mu, rstd);
#pragma unroll
        for (int j = 0; j < DV; ++j) x1[64 * j] = (v[j] - mu) * rstd * g2[64 * j] + b2[64 * j];
    }
}

__device__ __forceinline__ void ph_mod_fast(const Params& p, char* lds) {
    const int tid_ = opq_tid(), bid_ = opq_bid(); (void)tid_; (void)bid_;
    constexpr int NR = NB + 1, NTASK = 2 * (6 * D / 64);
    if (bid_ >= NTASK) return;
    float* sc = (float*)lds;
    float* part = sc + NR * D;
    for (int i = tid_; i < NR * D; i += 256) { const int b = i / D, k = i % D; const float cv = b < NB ? p.c[(size_t)b * D + k] : p.c_ctx[k]; sc[i] = cv / (1.0f + __expf(-cv)); }
    __syncthreads();
    const int lane = tid_ & 63, wid = tid_ >> 6;
    for (int task = bid_; task < NTASK; task += gridDim.x) {
        const int ll = task / (6 * D / 64), col = 64 * (task % (6 * D / 64)) + lane;
        float acc[NR];
#pragma unroll
        for (int b = 0; b < NR; ++b) acc[b] = 0.f;
        const float* wp = p.w_mod + ((size_t)ll * D + wid * (D / 4)) * 6 * D + col;
#pragma unroll 16
        for (int k = 0; k < D / 4; ++k) { const float w = wp[(size_t)k * 6 * D];
#pragma unroll
            for (int b = 0; b < NR; ++b) acc[b] += sc[b * D + wid * (D / 4) + k] * w; }
#pragma unroll
        for (int b = 0; b < NR; ++b) part[(wid * NR + b) * 64 + lane] = acc[b];
        __syncthreads();
        for (int i = tid_; i < NR * 64; i += 256) { const int b = i / 64, cl = i % 64;
            p.mod[((size_t)ll * NR + b) * 6 * D + 64 * (task % (6 * D / 64)) + cl] = (part[(0 * NR + b) * 64 + cl] + part[(1 * NR + b) * 64 + cl]) + (part[(2 * NR + b) * 64 + cl] + part[(3 * NR + b) * 64 + cl]) + p.b_mod[(size_t)ll * 6 * D + 64 * (task % (6 * D / 64)) + cl]; }
        __syncthreads();
    }
}

__device__ __forceinline__ void tr_item(const float* srcl, size_t ldw, bf16_t* dst, size_t ldd, float* scr, int lane) {
#pragma unroll 8
    for (int i = 0; i < 32; ++i) { const int kk = 2 * i + (lane >> 5); scr[kk * 33 + (lane & 31)] = srcl ? srcl[(size_t)kk * ldw] : 0.f; }
    LDS_WAIT();
    const int c = lane & 7;
#pragma unroll
    for (int j = 0; j < 4; ++j) { const int n = (lane >> 3) + 8 * j; const float* s = scr + (8 * c) * 33 + n;
        uint4 o; o.x = pk2(s[0], s[33]); o.y = pk2(s[2 * 33], s[3 * 33]); o.z = pk2(s[4 * 33], s[5 * 33]); o.w = pk2(s[6 * 33], s[7 * 33]);
        *(uint4*)(dst + (size_t)n * ldd + 8 * c) = o; }
    LDS_WAIT();
}
__device__ __forceinline__ void ph_prep_w_fast(const Params& p, int l, int part, char* lds) {
    const int tid_ = opq_tid(), bid_ = opq_bid(); (void)tid_; (void)bid_;
    const int lane = tid_ & 63, wid = tid_ >> 6, gw = bid_ * 4 + wid, nw = gridDim.x * 4;
    float* scr = (float*)(lds + wid * 8448);
    constexpr int I_IN = (D / 64) * (NINP / 32), I_OUT = (DMIX / 64) * (D / 32), I_GU1 = (D / 64) * (2 * DE / 32), I_D1 = (DE / 64) * (D / 32);
    constexpr int NITEMS = I_IN + I_OUT + NEXP * (I_GU1 + I_D1);
    const int it0 = part == 0 ? 0 : I_IN + I_OUT, it1 = part == 0 ? I_IN + I_OUT : NITEMS;
    for (int it = it0 + gw; it < it1; it += nw) {
        int r = it;
        if (r < I_IN) { const int kb = r / (NINP / 32), n0 = 32 * (r % (NINP / 32));
            const float* s = nullptr;
            if (n0 < N_IN) { const int oc = (n0 < ZA) ? n0 + A_IN : n0 - ZA; s = p.w_in + ((size_t)l * D + 64 * kb) * N_IN + oc + (lane & 31); }
            tr_item(s, N_IN, p.win_t + (size_t)n0 * D + 64 * kb, D, scr, lane); continue; }
        r -= I_IN;
        if (r < I_OUT) { const int kb = r / (D / 32), n0 = 32 * (r % (D / 32));
            tr_item(p.w_out + ((size_t)l * DMIX + 64 * kb) * D + n0 + (lane & 31), D, p.wout_t + (size_t)n0 * DMIX + 64 * kb, DMIX, scr, lane); continue; }
        r -= I_OUT;
        const int e = r / (I_GU1 + I_D1); r %= (I_GU1 + I_D1);
        if (r < I_GU1) { const int kb = r / (2 * DE / 32), q = r % (2 * DE / 32);
            const float* s = (((lane & 31) >> 4) ? p.w_up : p.w_gate) + (((size_t)l * NEXP + e) * D + 64 * kb) * DE + 16 * q + (lane & 15);
            tr_item(s, DE, p.wgu_t + ((size_t)e * 2 * DE + 32 * q) * D + 64 * kb, D, scr, lane); continue; }
        r -= I_GU1;
        { const int kb = r / (D / 32), n0 = 32 * (r % (D / 32));
            tr_item(p.w_down + (((size_t)l * NEXP + e) * DE + 64 * kb) * D + n0 + (lane & 31), D, p.wd_t + ((size_t)e * D + n0) * DE + 64 * kb, DE, scr, lane); }
    }
    if (part != 0) return;
    const long gt = (long)bid_ * blockDim.x + tid_, gs = (long)gridDim.x * blockDim.x;
    for (long i = gt; i < 2 * 256 * 64; i += gs) { const int k = (int)(i & 63), n = (int)((i >> 6) & 255), d = (int)(i >> 14);
        p.wupT[i] = f2bf(p.a_w_up[(((size_t)l * 2 + d) * 64 + k) * DA + n]); p.aupT[i] = f2bf(p.a_a_up[(((size_t)l * 2 + d) * 64 + k) * DA + n]); }
    for (long i = gt; i < 256 * 160; i += gs) { const int k = (int)(i % 160), n = (int)(i / 160); p.gupT[i] = f2bf(p.a_g_up[((size_t)l * 160 + k) * DA + n]); }
    for (long i = gt; i < (long)128 * D; i += gs) { const int n = (int)(i / D), k = (int)(i % D);
        const float w = n < 4 ? p.w_rg[((size_t)l * D + k) * 4 + n] : n < 36 ? p.w_re[((size_t)l * D + k) * 32 + n - 4] : 0.f;
        const bf16_t hb = f2bf(w); p.wrt[i] = hb; p.wrt[(size_t)128 * D + i] = f2bf(w - bf2f(hb)); }
}

__device__ __forceinline__ float tanh_fast(float x) { return 1.0f - 2.0f / (1.0f + __expf(2.0f * x)); }
__device__ __forceinline__ void ph_streams_s1(const Params& p, int l) {
    const int tid_ = opq_tid(), bid_ = opq_bid(); (void)tid_; (void)bid_;
    constexpr int NCH = A_IN / 8, NCHP = (NCH + 7) & ~7;
    const float* sh = p.a_shift + (size_t)l * 3 * A_IN;
    for (long it = (long)bid_ * 256 + tid_; it < (long)T * NCHP; it += (long)gridDim.x * 256) {
        const int m = (int)(it / NCHP), ch = (int)(it % NCHP), c0 = 8 * ch;
        const bool act = ch < NCH;
        int t, len;
        if (m < TL) { t = m % S; len = S; } else { t = (m - TL) % L; len = L; }
        float v[8];
#pragma unroll
        for (int e = 0; e < 8; ++e) v[e] = 0.f;
        if (act) {
            const bf16_t* z = p.Z + (size_t)m * ZP + ZA + c0;
            const bf16x8 zc = *(const bf16x8*)z;
            const f32x4 s1a = *(const f32x4*)(sh + A_IN + c0), s1b = *(const f32x4*)(sh + A_IN + c0 + 4);
#pragma unroll
            for (int e = 0; e < 8; ++e) v[e] = (e < 4 ? s1a[e] : s1b[e - 4]) * bf2f((bf16_t)zc[e]);
            if (t > 0) { const bf16x8 zp = *(const bf16x8*)(z - ZP); const f32x4 a = *(const f32x4*)(sh + c0), b = *(const f32x4*)(sh + c0 + 4);
#pragma unroll
                for (int e = 0; e < 8; ++e) v[e] += (e < 4 ? a[e] : b[e - 4]) * bf2f((bf16_t)zp[e]); }
            if (t < len - 1) { const bf16x8 zn = *(const bf16x8*)(z + ZP); const f32x4 a = *(const f32x4*)(sh + 2 * A_IN + c0), b = *(const f32x4*)(sh + 2 * A_IN + c0 + 4);
#pragma unroll
                for (int e = 0; e < 8; ++e) v[e] += (e < 4 ? a[e] : b[e - 4]) * bf2f((bf16_t)zn[e]); }
        }
        float nrm = 0.f;
        if (ch >= 32 && ch < 64) {
#pragma unroll
            for (int e = 0; e < 8; ++e) { const float t2 = v[e] * p.a_k_k[l * DA + c0 - 256 + e]; nrm += t2 * t2; } }
        nrm = sum8(nrm);
        if (!act) continue;
        if (c0 < 768) {
            float* dst = (c0 < 256 ? p.sR + (size_t)m * DA + c0 : c0 < 512 ? p.kT + (size_t)m * DA + c0 - 256 : p.sV + (size_t)m * DA + c0 - 512);
            *(f32x4*)dst = (f32x4){v[0], v[1], v[2], v[3]}; *(f32x4*)(dst + 4) = (f32x4){v[4], v[5], v[6], v[7]};
            if (ch >= 32 && ch < 64 && (ch & 7) == 0) p.kN[(size_t)m * 4 + ((ch - 32) >> 3)] = 1.0f / sqrtf(nrm + 1e-12f);
        } else {
            if (c0 < 896) {
#pragma unroll
                for (int e = 0; e < 8; ++e) v[e] = tanh_fast(v[e]); }
            else if (c0 >= 1024) {
#pragma unroll
                for (int e = 0; e < 8; ++e) v[e] = 1.0f / (1.0f + __expf(-v[e])); }
            uint4 o; o.x = pk2(v[0], v[1]); o.y = pk2(v[2], v[3]); o.z = pk2(v[4], v[5]); o.w = pk2(v[6], v[7]);
            *(uint4*)(p.LA + (size_t)m * 416 + c0 - 768) = o;
        }
    }
}
__device__ __forceinline__ void g_streams_s2(const Params& p, int l, char* lds) {
    const int tid_ = opq_tid(), bid_ = opq_bid(); (void)tid_; (void)bid_;
    constexpr int MT = T / 128;
    for (int job = bid_; job < 5 * MT * 2; job += gridDim.x) {
        const int type = job / (MT * 2), r = job % (MT * 2), tm = r >> 1, tn = r & 1;
        const int coff = type < 2 ? type * 64 : type < 4 ? 128 + (type - 2) * 64 : 256, K = type < 4 ? 64 : 160, d = type & 1;
        const bf16_t* Bt = type < 2 ? p.wupT + type * 256 * 64 : type < 4 ? p.aupT + (type - 2) * 256 * 64 : p.gupT;
        const bf16_t* a0 = p.LA + (size_t)(tm * 128 + STG_ROW(0)) * 416 + coff + STG_K; const bf16_t* a1 = p.LA + (size_t)(tm * 128 + STG_ROW(1)) * 416 + coff + STG_K;
        const bf16_t* b0 = Bt + (size_t)(tn * 128 + STG_ROW(0)) * K + STG_K; const bf16_t* b1 = Bt + (size_t)(tn * 128 + STG_ROW(1)) * K + STG_K;
        if (type < 2) gemm_tile(a0, a1, b0, b1, K, lds, [&](const f32x4 (&acc)[4][4], int wr, int wc, int fr, int fq) {
#pragma unroll
            for (int mi = 0; mi < 4; ++mi) {
#pragma unroll
                for (int n = 0; n < 4; ++n) { const int c = tn * 128 + wc * 64 + n * 16 + fr; const float w0 = p.a_w0[(l * 2 + d) * DA + c];
#pragma unroll
                    for (int j = 0; j < 4; ++j) { const int row = tm * 128 + wr * 64 + mi * 16 + fq * 4 + j;
                        const float e = __expf(-(w0 + acc[mi][n][j]));
                        p.sW[((size_t)d * T + row) * DA + c] = __expf(-0.60653065971f / (1.0f + e)); } }
                asm volatile("" ::: "memory"); }
        });
        else if (type < 4) gemm_tile(a0, a1, b0, b1, K, lds, [&](const f32x4 (&acc)[4][4], int wr, int wc, int fr, int fq) {
#pragma unroll
            for (int mi = 0; mi < 4; ++mi) {
#pragma unroll
                for (int n = 0; n < 4; ++n) { const int c = tn * 128 + wc * 64 + n * 16 + fr;
                    const float a0v = p.a_a0[(l * 2 + d) * DA + c], kkc = p.a_k_k[l * DA + c], kac = p.a_k_a[l * DA + c];
#pragma unroll
                    for (int j = 0; j < 4; ++j) { const int row = tm * 128 + wr * 64 + mi * 16 + fq * 4 + j;
                        const size_t o = (size_t)row * DA + c, od = ((size_t)d * T + row) * DA + c;
                        const float av = 1.0f / (1.0f + __expf(-(a0v + acc[mi][n][j]))); const float k = p.kT[o];
                        const float kk = k * kkc * p.kN[(size_t)row * 4 + (c >> 6)];
                        p.sKD[od] = k * (1.0f + (av - 1.0f) * kac); p.sB[od] = kk * av; if (d == 0) p.sKK[o] = kk; } }
                asm volatile("" ::: "memory"); }
        });
        else gemm_tile(a0, a1, b0, b1, K, lds, [&](const f32x4 (&acc)[4][4], int wr, int wc, int fr, int fq) {
#pragma unroll
            for (int mi = 0; mi < 4; ++mi)
#pragma unroll
                for (int n = 0; n < 4; ++n) { const int c = tn * 128 + wc * 64 + n * 16 + fr;
#pragma unroll
                    for (int j = 0; j < 4; ++j) p.sG[(size_t)(tm * 128 + wr * 64 + mi * 16 + fq * 4 + j) * DA + c] = acc[mi][n][j]; }
        });
    }
}


typedef float f32x16 __attribute__((ext_vector_type(16)));
typedef short s16x4 __attribute__((ext_vector_type(4)));
typedef unsigned u32x4_t __attribute__((ext_vector_type(4)));
typedef float f32x2_t __attribute__((ext_vector_type(2)));
typedef __bf16 bf16x2_t __attribute__((ext_vector_type(2)));
__device__ __forceinline__ unsigned cvtpk(float lo, float hi) { f32x2_t v = {lo, hi}; bf16x2_t b = __builtin_convertvector(v, bf16x2_t); return __builtin_bit_cast(unsigned, b); }
__device__ __forceinline__ int crow(int r, int hi) { return (r & 3) + 8 * (r >> 2) + 4 * hi; }

template <class MaskF>
__device__ __forceinline__ void attn_tile(const bf16x8 (&qf)[4], const bf16_t* krow, const bf16_t* vt0, const bf16_t* vt1, const MaskF& mask,
                                          float& m_run, float& l_run, f32x16& o0, f32x16& o1, int hi) {
    f32x16 s;
#pragma unroll
    for (int r = 0; r < 16; ++r) s[r] = 0.f;
#pragma unroll
    for (int ks = 0; ks < 4; ++ks) { const bf16x8 kf = *(const bf16x8*)(krow + 16 * ks); s = __builtin_amdgcn_mfma_f32_32x32x16_bf16(kf, qf[ks], s, 0, 0, 0); }
    float mx = -INFINITY;
#pragma unroll
    for (int r = 0; r < 16; ++r) { s[r] = mask(crow(r, hi), s[r] * ATT_SCALE); mx = fmaxf(mx, s[r]); }
    mx = fmaxf(mx, __shfl_xor(mx, 32));
    const float mn = fmaxf(m_run, mx), alpha = __expf(m_run - mn);
    m_run = mn;
    float ps = 0.f;
#pragma unroll
    for (int r = 0; r < 16; ++r) { s[r] = __expf(s[r] - mn); ps += s[r]; }
    l_run = l_run * alpha + ps;
#pragma unroll
    for (int r = 0; r < 16; ++r) { o0[r] *= alpha; o1[r] *= alpha; }
#pragma unroll
    for (int s2 = 0; s2 < 2; ++s2) {
        u32x4_t pw; pw[0] = cvtpk(s[8 * s2], s[8 * s2 + 1]); pw[1] = cvtpk(s[8 * s2 + 2], s[8 * s2 + 3]); pw[2] = cvtpk(s[8 * s2 + 4], s[8 * s2 + 5]); pw[3] = cvtpk(s[8 * s2 + 6], s[8 * s2 + 7]);
        const bf16x8 pb = __builtin_bit_cast(bf16x8, pw);
        const s16x4 a0 = *(const s16x4*)(vt0 + 16 * s2), a1 = *(const s16x4*)(vt0 + 16 * s2 + 8);
        const s16x4 c0 = *(const s16x4*)(vt1 + 16 * s2), c1 = *(const s16x4*)(vt1 + 16 * s2 + 8);
        o0 = __builtin_amdgcn_mfma_f32_32x32x16_bf16(__builtin_shufflevector(a0, a1, 0, 1, 2, 3, 4, 5, 6, 7), pb, o0, 0, 0, 0);
        o1 = __builtin_amdgcn_mfma_f32_32x32x16_bf16(__builtin_shufflevector(c0, c1, 0, 1, 2, 3, 4, 5, 6, 7), pb, o1, 0, 0, 0);
    }
}
struct NoMask { __device__ __forceinline__ float operator()(int, float v) const { return v; } };

__device__ __forceinline__ void ph_attn_mfma(const Params& p, int l, bool with_ctx) {
    const int tid_ = opq_tid(), bid_ = opq_bid(); (void)tid_; (void)bid_;
    const int lane = tid_ & 63, hi = lane >> 5, ql = lane & 31;
    const int gw = bid_ * 4 + (tid_ >> 6), nw = gridDim.x * 4;
    constexpr int NQT = S / 32, NCT = L / 32, N_LAT = NB * 6 * NQT, N_CTX = NB * 6 * NCT;
    const int ntask = 2 * N_LAT + (with_ctx ? 2 * N_CTX : 0);
    for (int task = gw; task < ntask; task += nw) {
        bool isC, isCtx; int r;
        if (task < N_LAT) { isC = true; isCtx = false; r = task; }
        else if (task < 2 * N_LAT) { isC = false; isCtx = false; r = task - N_LAT; }
        else { r = task - 2 * N_LAT; isCtx = true; isC = r >= N_CTX; if (isC) r -= N_CTX; }
        const int nqt = isCtx ? NCT : NQT, qt = r % nqt, h = (r / nqt) % 6, b = r / (nqt * 6);
        const int m = isCtx ? TL + b * L + 32 * qt + ql : b * S + 32 * qt + ql;
        const int qcol = isC ? ZQN + h * 64 : ZQB + h * 64, kcol = isC ? ZKN + h * 64 : ZKB + (h / 3) * 64, hv = isC ? 2 + h : h / 3;
        bf16x8 qf[4];
        { const bf16_t* qp = p.Z + (size_t)m * ZP + qcol + 8 * hi;
#pragma unroll
          for (int ks = 0; ks < 4; ++ks) qf[ks] = *(const bf16x8*)(qp + 16 * ks); }
        const bf16_t* kc0 = p.Z + (size_t)(TL + b * L + ql) * ZP + kcol + 8 * hi;
        const bf16_t* kl0 = p.Z + (size_t)(b * S + ql) * ZP + kcol + 8 * hi;
        const bf16_t* vt0 = p.VT + ((size_t)(b * 8 + hv) * 64 + ql) * PU + 4 * hi; const bf16_t* vt1 = vt0 + (size_t)32 * PU;
        f32x16 o0, o1;
#pragma unroll
        for (int rr = 0; rr < 16; ++rr) { o0[rr] = 0.f; o1[rr] = 0.f; }
        float m_run, l_run;
        if (isC) { m_run = -1e30f; l_run = 0.f; } else { m_run = p.b_sink[l * 6 + h]; l_run = hi == 0 ? 1.0f : 0.f; }
#pragma unroll 1
        for (int i = 0; i < NCT; ++i) attn_tile(qf, kc0 + (size_t)(32 * i) * ZP, vt0 + 32 * i, vt1 + 32 * i, NoMask(), m_run, l_run, o0, o1, hi);
        if (!isCtx) {
            if (!isC) {
#pragma unroll 1
                for (int jt = qt - 4; jt <= qt + 4; ++jt) {
                    if (jt < 0 || jt >= NQT) continue;
                    const bf16_t* kr = kl0 + (size_t)(32 * jt) * ZP; const bf16_t* v0 = vt0 + L + 32 * jt; const bf16_t* v1 = vt1 + L + 32 * jt;
                    if (jt == qt - 4 || jt == qt + 4) { const int base = 32 * (jt - qt) - ql;
                        attn_tile(qf, kr, v0, v1, [&](int ko, float v) { const int rel = base + ko; return (rel >= -128 && rel <= 128) ? v : -INFINITY; }, m_run, l_run, o0, o1, hi); }
                    else attn_tile(qf, kr, v0, v1, NoMask(), m_run, l_run, o0, o1, hi);
                }
            } else {
                constexpr int ROWS = S / GRID_W;
                const int gr = qt >> 1, c = 32 * (qt & 1) + ql;
                int r0 = gr - 4; r0 = r0 < 0 ? 0 : (r0 > ROWS - 8 ? ROWS - 8 : r0);
                int c0 = c - 8; c0 = c0 < 0 ? 0 : (c0 > GRID_W - 16 ? GRID_W - 16 : c0);
                const float* rpb = p.c_rpb + ((size_t)l * 6 + h) * 15 * 31;
#pragma unroll 1
                for (int a = 0; a < 8; ++a) {
                    const int kr_ = r0 + a; const float* rp = rpb + (kr_ - gr + 7) * 31 + 15 - c;
#pragma unroll 1
                    for (int ct = 0; ct < 2; ++ct) {
                        const int t0 = kr_ * GRID_W + 32 * ct;
                        attn_tile(qf, kl0 + (size_t)t0 * ZP, vt0 + L + t0, vt1 + L + t0,
                                  [&](int ko, float v) { const int kc = 32 * ct + ko; return (kc >= c0 && kc < c0 + 16) ? v + rp[kc] : -INFINITY; }, m_run, l_run, o0, o1, hi);
                    }
                }
            }
        }
        const float lt = l_run + __shfl_xor(l_run, 32), inv = 1.0f / lt;
        bf16_t* op = p.MIX + (size_t)m * DMIX + (isC ? 640 : 256) + h * 64 + 4 * hi;
#pragma unroll
        for (int g = 0; g < 4; ++g) {
            st_bf16x4(op + 8 * g, (f32x4){o0[4 * g] * inv, o0[4 * g + 1] * inv, o0[4 * g + 2] * inv, o0[4 * g + 3] * inv});
            st_bf16x4(op + 32 + 8 * g, (f32x4){o1[4 * g] * inv, o1[4 * g + 1] * inv, o1[4 * g + 2] * inv, o1[4 * g + 3] * inv});
        }
    }
}


#define RNB " row_newbcast:%c[n] row_mask:0xf bank_mask:0xf\n\t"
template <int N, bool FIRST>
__device__ __forceinline__ void dpp_dot4(float& a0, float& a1, float& a2, float& a3, const f32x4& v, float s0, float s1, float s2, float s3) {
    if (FIRST) asm volatile("s_nop 1");
    asm("v_fmac_f32_dpp %0, %4, %8" RNB "v_fmac_f32_dpp %1, %5, %9" RNB "v_fmac_f32_dpp %2, %6, %10" RNB "v_fmac_f32_dpp %3, %7, %11" RNB
        : "+v"(a0), "+v"(a1), "+v"(a2), "+v"(a3) : "v"(v[0]), "v"(v[1]), "v"(v[2]), "v"(v[3]), "v"(s0), "v"(s1), "v"(s2), "v"(s3), [n] "i"(N));
}
template <int N, bool FIRST>
__device__ __forceinline__ void dpp_upd4s(float& s0, float& s1, float& s2, float& s3, float& y0, float& y1, float& y2, float& y3,
                                          const f32x4& w, const f32x4& b, const f32x4& kd, const f32x4& r, float nsk, float vv) {
    if (FIRST) asm volatile("s_nop 1");
    asm("v_mul_f32_dpp %0, %8, %0" RNB "v_mul_f32_dpp %1, %9, %1" RNB "v_mul_f32_dpp %2, %10, %2" RNB "v_mul_f32_dpp %3, %11, %3" RNB
        "v_fmac_f32_dpp %0, %12, %24" RNB "v_fmac_f32_dpp %1, %13, %24" RNB "v_fmac_f32_dpp %2, %14, %24" RNB "v_fmac_f32_dpp %3, %15, %24" RNB
        "v_fmac_f32_dpp %0, %16, %25" RNB "v_fmac_f32_dpp %1, %17, %25" RNB "v_fmac_f32_dpp %2, %18, %25" RNB "v_fmac_f32_dpp %3, %19, %25" RNB
        "v_fmac_f32_dpp %4, %20, %0" RNB "v_fmac_f32_dpp %5, %21, %1" RNB "v_fmac_f32_dpp %6, %22, %2" RNB "v_fmac_f32_dpp %7, %23, %3" RNB
        : "+v"(s0), "+v"(s1), "+v"(s2), "+v"(s3), "+v"(y0), "+v"(y1), "+v"(y2), "+v"(y3)
        : "v"(w[0]), "v"(w[1]), "v"(w[2]), "v"(w[3]), "v"(b[0]), "v"(b[1]), "v"(b[2]), "v"(b[3]), "v"(kd[0]), "v"(kd[1]), "v"(kd[2]), "v"(kd[3]),
          "v"(r[0]), "v"(r[1]), "v"(r[2]), "v"(r[3]), "v"(nsk), "v"(vv), [n] "i"(N));
}
template <int N, bool FIRST>
__device__ __forceinline__ void dpp_upd4p(float& s0, float& s1, float& s2, float& s3, float& y0, float& y1, float& y2, float& y3,
                                          const f32x4& w, const f32x4& b, const f32x4& r, float nsk) {
    if (FIRST) asm volatile("s_nop 1");
    asm("v_mul_f32_dpp %0, %8, %0" RNB "v_mul_f32_dpp %1, %9, %1" RNB "v_mul_f32_dpp %2, %10, %2" RNB "v_mul_f32_dpp %3, %11, %3" RNB
        "v_fmac_f32_dpp %0, %12, %20" RNB "v_fmac_f32_dpp %1, %13, %20" RNB "v_fmac_f32_dpp %2, %14, %20" RNB "v_fmac_f32_dpp %3, %15, %20" RNB
        "v_fmac_f32_dpp %4, %16, %0" RNB "v_fmac_f32_dpp %5, %17, %1" RNB "v_fmac_f32_dpp %6, %18, %2" RNB "v_fmac_f32_dpp %7, %19, %3" RNB
        : "+v"(s0), "+v"(s1), "+v"(s2), "+v"(s3), "+v"(y0), "+v"(y1), "+v"(y2), "+v"(y3)
        : "v"(w[0]), "v"(w[1]), "v"(w[2]), "v"(w[3]), "v"(b[0]), "v"(b[1]), "v"(b[2]), "v"(b[3]), "v"(r[0]), "v"(r[1]), "v"(r[2]), "v"(r[3]), "v"(nsk), [n] "i"(N));
}
template <int N> struct ScanRep {
    static __device__ __forceinline__ void dot(float& a0, float& a1, float& a2, float& a3, const f32x4& v, const float (&st)[64]) {
        dpp_dot4<N, N == 0>(a0, a1, a2, a3, v, st[4 * N], st[4 * N + 1], st[4 * N + 2], st[4 * N + 3]);
        if constexpr (N < 15) ScanRep<N + 1>::dot(a0, a1, a2, a3, v, st);
    }
    static __device__ __forceinline__ void upds(float (&st)[64], float& y0, float& y1, float& y2, float& y3, const f32x4& w, const f32x4& b, const f32x4& kd, const f32x4& r, float nsk, float vv) {
        dpp_upd4s<N, N == 0>(st[4 * N], st[4 * N + 1], st[4 * N + 2], st[4 * N + 3], y0, y1, y2, y3, w, b, kd, r, nsk, vv);
        if constexpr (N < 15) ScanRep<N + 1>::upds(st, y0, y1, y2, y3, w, b, kd, r, nsk, vv);
    }
    static __device__ __forceinline__ void updp(float (&st)[64], float& y0, float& y1, float& y2, float& y3, const f32x4& w, const f32x4& b, const f32x4& r, float nsk) {
        dpp_upd4p<N, N == 0>(st[4 * N], st[4 * N + 1], st[4 * N + 2], st[4 * N + 3], y0, y1, y2, y3, w, b, r, nsk);
        if constexpr (N < 15) ScanRep<N + 1>::updp(st, y0, y1, y2, y3, w, b, r, nsk);
    }
};
__device__ __forceinline__ int seg_row0(int b, int d, int s) { const int pos0 = 128 * s; return pos0 < L ? TL + b * L + (d ? L - 1 - pos0 : pos0) : b * S + (d ? S - 1 - (pos0 - L) : pos0 - L); }

template <bool ISP>
__device__ __forceinline__ void scan_task(const Params& p, int c, int s, int lane) {
    const int h = c & 3, b = (c >> 2) % NB, d = (c >> 2) / NB;
    const int m0 = seg_row0(b, d, s); const long step = d ? -(long)DA : (long)DA;
    const size_t o = (size_t)m0 * DA + h * 64, od = ((size_t)d * T + m0) * DA + h * 64; const int q = 4 * (lane & 15);
    const float* pkk = p.sKK + o + q; const float* pr = p.sR + o + q; const float* pw = p.sW + od + q; const float* pb = p.sB + od + q;
    const float* pkd = p.sKD + od + q; const float* pv = p.sV + o + lane;
    float* py = (ISP ? p.PV : p.Y) + od + lane;
    float st[64];
#pragma unroll
    for (int k = 0; k < 64; ++k) st[k] = (ISP && k == lane) ? 1.0f : 0.f;
    f32x4 kk = *(const f32x4*)pkk, w = *(const f32x4*)pw, bb = *(const f32x4*)pb, r = *(const f32x4*)pr, kd = w; float vv = 0.f;
    if (!ISP) { kd = *(const f32x4*)pkd; vv = *pv; }
#pragma unroll 1
    for (int i = 0; i < 128; ++i) {
        const long nx = (i < 127) ? step : 0;
        pkk += nx; pw += nx; pb += nx; pr += nx; pkd += nx; pv += nx;
        const f32x4 nkk = *(const f32x4*)pkk, nw = *(const f32x4*)pw, nb = *(const f32x4*)pb, nr = *(const f32x4*)pr;
        f32x4 nkd = nw; float nv = 0.f;
        if (!ISP) { nkd = *(const f32x4*)pkd; nv = *pv; }
        float a0 = 0.f, a1 = 0.f, a2 = 0.f, a3 = 0.f;
        ScanRep<0>::dot(a0, a1, a2, a3, kk, st);
        const float nsk = -((a0 + a1) + (a2 + a3));
        float y0 = 0.f, y1 = 0.f, y2 = 0.f, y3 = 0.f;
        if (ISP) ScanRep<0>::updp(st, y0, y1, y2, y3, w, bb, r, nsk); else ScanRep<0>::upds(st, y0, y1, y2, y3, w, bb, kd, r, nsk, vv);
        *py = (y0 + y1) + (y2 + y3); py += step;
        kk = nkk; w = nw; bb = nb; r = nr; kd = nkd; vv = nv;
    }
    if (s < NSG - 1) {
        float* dst = (ISP ? p.PS : p.QS) + (((size_t)c * NSG + s) * 64 + lane) * 64;
#pragma unroll
        for (int k4 = 0; k4 < 16; ++k4) *(f32x4*)(dst + 4 * k4) = (f32x4){st[4 * k4], st[4 * k4 + 1], st[4 * k4 + 2], st[4 * k4 + 3]};
    }
}
__device__ __forceinline__ void ph_scan_fast(const Params& p) {
    const int tid_ = opq_tid(), bid_ = opq_bid(); (void)tid_; (void)bid_;
    const int lane = tid_ & 63, gw = bid_ * 4 + (tid_ >> 6), nw = gridDim.x * 4;
    constexpr int NS_T = 64 * NSG, NP_T = 64 * (NSG - 1);
    for (int tsk = gw; tsk < NS_T + NP_T; tsk += nw) {
        const int t2 = __builtin_amdgcn_readfirstlane(tsk);
        if (t2 < NS_T) scan_task<false>(p, t2 & 63, t2 >> 6, lane);
        else scan_task<true>(p, (t2 - NS_T) & 63, 1 + ((t2 - NS_T) >> 6), lane);
    }
}
__device__ __forceinline__ void ph_combine(const Params& p, char* lds) {
    const int tid_ = opq_tid(), bid_ = opq_bid(); (void)tid_; (void)bid_;
    if (bid_ >= 64) return;
    const int c = bid_, tid = tid_, v = tid >> 2, jq = tid & 3;
    float* SSc = (float*)lds; float* Pm = (float*)(lds + 64 * 65 * 4 + 16);
    const float* QSc = p.QS + (size_t)c * NSG * 4096; const float* PSc = p.PS + (size_t)c * NSG * 4096; float* SSg = p.SS + (size_t)c * NSG * 4096;
    f32x4 acc[4], nP[4], nQ[4];
#pragma unroll
    for (int i = 0; i < 4; ++i) { acc[i] = *(const f32x4*)(QSc + v * 64 + 16 * jq + 4 * i);
#pragma unroll
        for (int e = 0; e < 4; ++e) { SSg[4096 + (16 * jq + 4 * i + e) * 64 + v] = acc[i][e]; SSc[v * 65 + 16 * jq + 4 * i + e] = acc[i][e]; } }
#pragma unroll
    for (int i = 0; i < 4; ++i) { nP[i] = ((const f32x4*)(PSc + (size_t)4096))[tid + 256 * i]; nQ[i] = *(const f32x4*)(QSc + (size_t)4096 + v * 64 + 16 * jq + 4 * i); }
    for (int s = 1; s < NSG - 1; ++s) {
#pragma unroll
        for (int i = 0; i < 4; ++i) { ((f32x4*)Pm)[tid + 256 * i] = nP[i]; acc[i] = nQ[i]; }
        __syncthreads();
        if (s + 1 < NSG - 1) {
#pragma unroll
            for (int i = 0; i < 4; ++i) { nP[i] = ((const f32x4*)(PSc + (size_t)(s + 1) * 4096))[tid + 256 * i]; nQ[i] = *(const f32x4*)(QSc + (size_t)(s + 1) * 4096 + v * 64 + 16 * jq + 4 * i); }
        }
#pragma unroll 8
        for (int k = 0; k < 64; ++k) { const float a = SSc[v * 65 + k];
#pragma unroll
            for (int i = 0; i < 4; ++i) acc[i] += ((const f32x4*)Pm)[k * 16 + 4 * jq + i] * a; }
        __syncthreads();
#pragma unroll
        for (int i = 0; i < 4; ++i) {
#pragma unroll
            for (int e = 0; e < 4; ++e) { SSg[(size_t)(s + 1) * 4096 + (16 * jq + 4 * i + e) * 64 + v] = acc[i][e]; SSc[v * 65 + 16 * jq + 4 * i + e] = acc[i][e]; } }
    }
}
__device__ __forceinline__ void ph_rwkv_out_fast(const Params& p, int l, bool with_ctx) {
    const int tid_ = opq_tid(), bid_ = opq_bid(); (void)tid_; (void)bid_;
    const int lane = tid_ & 63, gw = bid_ * 4 + (tid_ >> 6), nw = gridDim.x * 4;
    constexpr int TOK = 16, NLT = NB * (S / TOK) * 4, NCTK = NB * (L / TOK) * 4;
    const int ntask = NLT + (with_ctx ? NCTK : 0);
    for (int tsk = gw; tsk < ntask; tsk += nw) {
        const bool isCtx = tsk >= NLT; const int r = isCtx ? tsk - NLT : tsk;
        const int h = r & 3, npt = isCtx ? L / TOK : S / TOK, tt = (r >> 2) % npt, b = (r >> 2) / npt, t128 = tt / (128 / TOK);
        const int seg0 = isCtx ? t128 : L / 128 + t128, seg1 = isCtx ? (L / 128 - 1) - t128 : L / 128 + (S / 128 - 1) - t128;
        const int mbase = isCtx ? TL + b * L + TOK * tt : b * S + TOK * tt;
        float ss0[64], ss1[64];
        { const float* s0p = p.SS + (((size_t)(0 * NB + b) * 4 + h) * NSG + seg0) * 4096 + lane; const float* s1p = p.SS + (((size_t)(1 * NB + b) * 4 + h) * NSG + seg1) * 4096 + lane;
#pragma unroll
          for (int k = 0; k < 64; ++k) { ss0[k] = seg0 > 0 ? s0p[k * 64] : 0.f; ss1[k] = seg1 > 0 ? s1p[k * 64] : 0.f; } }
        const float rk = p.a_r_k[l * DA + h * 64 + lane], gln = p.a_lnx_g[l * DA + h * 64 + lane], bln = p.a_lnx_b[l * DA + h * 64 + lane];
        f32x4 pv0 = {0.f, 0.f, 0.f, 0.f}, pv1 = pv0; float y0l, y1l, rr, kds, vv, gg;
#define ROUT_LOAD(i_) do { const size_t o_ = (size_t)(mbase + (i_)) * DA + h * 64, o1_ = o_ + (size_t)T * DA; \
            if (seg0 > 0) pv0 = *(const f32x4*)(p.PV + o_ + 4 * (lane & 15)); if (seg1 > 0) pv1 = *(const f32x4*)(p.PV + o1_ + 4 * (lane & 15)); \
            y0l = p.Y[o_ + lane]; y1l = p.Y[o1_ + lane]; rr = p.sR[o_ + lane]; kds = p.sKD[o_ + lane] + p.sKD[o1_ + lane]; vv = p.sV[o_ + lane]; gg = p.sG[o_ + lane]; } while (0)
        ROUT_LOAD(0);
#pragma unroll 1
        for (int i = 0; i < TOK; ++i) {
            const f32x4 cpv0 = pv0, cpv1 = pv1; float a0 = y0l, a1 = y1l, a2 = 0.f, a3 = 0.f; const float crr = rr, ckds = kds, cvv = vv, cgg = gg;
            ROUT_LOAD(i + 1 < TOK ? i + 1 : i);
            ScanRep<0>::dot(a0, a1, a2, a3, cpv0, ss0);
            ScanRep<0>::dot(a0, a1, a2, a3, cpv1, ss1);
            const float y = (a0 + a1) + (a2 + a3);
            const float mu = wave_sum(y) * (1.0f / 64.f), dy = y - mu;
            const float rstd = 1.0f / sqrtf(wave_sum(dy * dy) * (1.0f / 64.f) + GN_EPS);
            const float bon = wave_sum(crr * ckds * rk);
            p.MIX[(size_t)(mbase + i) * DMIX + h * 64 + lane] = f2bf((dy * rstd * gln + bln + bon * cvv) * cgg);
        }
#undef ROUT_LOAD
    }
}


#define LAS __attribute__((address_space(3)))
#define XB_TMO      128
#define XB_XCNT(j)  (256  + 64 * (j))
#define XB_XSUB(j)  (1280 + 64 * (j))
#define XB_XGEN(j)  (2304 + 64 * (j))
#define XB_TOP      3328
#define XB_TOPGEN   3392
#define XCD_BAR_WORDS 3456
#define XB_SPIN_CAP (1u << 20)
static_assert(XCD_BAR_WORDS * 4 <= 16384, "barrier words fit the control region");
__device__ __forceinline__ unsigned xb_ld(unsigned* p)              { return __hip_atomic_load(p, __ATOMIC_RELAXED, __HIP_MEMORY_SCOPE_AGENT); }
__device__ __forceinline__ unsigned xb_add(unsigned* p, unsigned v) { return __hip_atomic_fetch_add(p, v, __ATOMIC_RELAXED, __HIP_MEMORY_SCOPE_AGENT); }
__device__ __forceinline__ unsigned xb_xcc_id() { return (unsigned)__builtin_amdgcn_s_getreg((3 << 11) | 20) & 0xFu; }
#define XB_SPIN(cond, bar) do { unsigned _sp = 0; while (cond) { __builtin_amdgcn_s_sleep(1); \
    if ((++_sp & 255u) == 0u) { if (xb_ld(&(bar)[XB_TMO])) break; if (_sp > XB_SPIN_CAP) { atomicAdd(&(bar)[XB_TMO], 1u); break; } } } } while (0)
struct XcdBarrier { unsigned* bar; unsigned x; volatile LAS unsigned* st; };
__device__ __forceinline__ XcdBarrier xcd_barrier_post(unsigned* bar, volatile LAS unsigned* st) {
    XcdBarrier b; b.bar = bar; b.x = xb_xcc_id(); b.st = st;
    if (threadIdx.x == 0) (void)xb_add(&bar[XB_XCNT(b.x)], 1u);
    return b;
}
__device__ __forceinline__ void xcd_barrier_complete(unsigned* bar, unsigned x, unsigned& nloc, unsigned& nx) {
    const unsigned G = gridDim.x * gridDim.y * gridDim.z;
    unsigned sum, cnt, mine, sp = 0u;
    for (;;) {
        sum = 0u; cnt = 0u; mine = 0u;
#pragma unroll
        for (unsigned j = 0; j < 16; ++j) { const unsigned c = xb_ld(&bar[XB_XCNT(j)]); sum += c; cnt += (c > 0u) ? 1u : 0u; mine = (j == x) ? c : mine; }
        if (sum == G) break;
        __builtin_amdgcn_s_sleep(1);
        if ((++sp & 255u) == 0u) { if (xb_ld(&bar[XB_TMO])) break; if (sp > XB_SPIN_CAP) { atomicAdd(&bar[XB_TMO], 1u); break; } }
    }
    nloc = mine > 0u ? mine : 1u; nx = cnt > 0u ? cnt : 1u;
}
__device__ __forceinline__ void xcd_barrier(const XcdBarrier& b) {
    asm volatile("s_waitcnt vmcnt(0)" ::: "memory");
    __syncthreads();
    if (threadIdx.x == 0) {
        unsigned* bar = b.bar;
        __builtin_amdgcn_s_waitcnt(0);
        unsigned nloc = b.st[0], nx = b.st[1];
        if (nloc == 0u) { xcd_barrier_complete(bar, b.x, nloc, nx); b.st[0] = nloc; b.st[1] = nx; }
        const unsigned old = xb_add(&bar[XB_XSUB(b.x)], 1u);
        const unsigned gen = old / nloc;
        if (old + 1u == (gen + 1u) * nloc) {
            __builtin_amdgcn_fence(__ATOMIC_RELEASE, "agent");
            asm volatile("s_waitcnt vmcnt(0)" ::: "memory");
            const unsigned og = xb_add(&bar[XB_TOP], 1u);
            const unsigned tg = og / nx;
            if (og + 1u == (tg + 1u) * nx) xb_add(&bar[XB_TOPGEN], 1u);
            else XB_SPIN(xb_ld(&bar[XB_TOPGEN]) == tg, bar);
            __builtin_amdgcn_fence(__ATOMIC_ACQUIRE, "agent");
            xb_add(&bar[XB_XGEN(b.x)], 1u);
            asm volatile("s_waitcnt vmcnt(0)" ::: "memory");
        } else {
            XB_SPIN(xb_ld(&bar[XB_XGEN(b.x)]) == gen, bar);
            __builtin_amdgcn_fence(__ATOMIC_ACQUIRE, "agent");
            asm volatile("s_waitcnt vmcnt(0)" ::: "memory");
        }
    }
    __syncthreads();
}

#define GT ((long)blockIdx.x * blockDim.x + threadIdx.x)
#define GS ((long)gridDim.x * blockDim.x)
__global__ void __launch_bounds__(256, 2) mega_fwd(Params p) {
    __shared__ __attribute__((aligned(16))) char lds[49152 + 64];
    cg::grid_group grid = cg::this_grid();
    const long gt = GT, gs = GS;
    volatile LAS unsigned* bst = (volatile LAS unsigned*)(LAS char*)(lds + 49152);
    if (threadIdx.x < 2) bst[threadIdx.x] = 0u;
    __syncthreads();
    const XcdBarrier xb = xcd_barrier_post(p.bar, bst);
#ifndef PROBE_PHASE
#define PROBE_PHASE -1
#endif
#define PROBE_AMP 8
    unsigned long long t_prev = 0; int nts = 0;
#define STAMP() do { if (PROBE_PHASE >= 0 && blockIdx.x == 0 && threadIdx.x == 0) { const unsigned long long t_now = __builtin_amdgcn_s_memrealtime(); \
        if (nts == PROBE_PHASE + 1) { const unsigned long long t_end = t_now + PROBE_AMP * (t_now - t_prev); while (__builtin_amdgcn_s_memrealtime() < t_end) __builtin_amdgcn_s_sleep(8); } \
        t_prev = __builtin_amdgcn_s_memrealtime(); } ++nts; } while (0)
#define GSYNC() do { xcd_barrier(xb); STAMP(); } while (0)
    STAMP();
    ph_mod_fast(p, lds); ph_prep_w_fast(p, 0, 0, lds); ph_prep_misc(p, 0, gt, gs, false);
    grid.sync(); STAMP();
    for (int l = 0; l < 2; ++l) {
        const int nrows = (l == 0) ? T : TL;
        ph_lnmod_fast(p, l);
        GSYNC();
        g_gemm_in(p, lds);
        GSYNC();
        ph_streams_s1(p, l);
        GSYNC();
        g_streams_s2(p, l, lds);
        GSYNC();
        ph_scan_fast(p);
        GSYNC();
        ph_combine(p, lds); ph_attn_mfma(p, l, l == 0);
        GSYNC();
        ph_rwkv_out_fast(p, l, l == 0);
        GSYNC();
        g_gemm_out(p, nrows, lds); ph_prep_w_fast(p, l, 1, lds);
        GSYNC();
        ph_post_mixer_fast(p, l, nrows);
        GSYNC();
        g_router(p, l, nrows, lds);
        GSYNC();
        ph_dispatch_fast(p, l, nrows, lds);
        GSYNC();
        g_moe1(p, l, lds);
        GSYNC();
        g_moe2(p, l, lds);
        GSYNC();
        ph_final_fast(p, l, nrows);
        if (l == 0) { ph_prep_w_fast(p, 1, 0, lds); ph_prep_misc(p, 1, gt, gs, false); }
        GSYNC();
    }}

extern "C" void kernel_launch(void* const* d_in, const int* in_sizes, int n_in, void* d_out, int out_size, void* d_ws, size_t ws_size, hipStream_t stream) {
    if (n_in != 32 || out_size != TL * D || ws_size < WS_NEED) { fprintf(stderr, "kernel_launch: unexpected shapes / workspace (n_in %d out %d ws %zu need %zu)\n", n_in, out_size, ws_size, (size_t)WS_NEED); return; }
    static int grid_blocks = 0;
    if (!grid_blocks) {
        int dev = 0, cus = 0, per_cu = 0;
        (void)hipGetDevice(&dev);
        (void)hipDeviceGetAttribute(&cus, hipDeviceAttributeMultiprocessorCount, dev);
        (void)hipOccupancyMaxActiveBlocksPerMultiprocessor(&per_cu, mega_fwd, 256, 0);
        if (per_cu < 1) per_cu = 1;
        if (per_cu > 2) per_cu = 2;
        grid_blocks = cus * per_cu;
        fprintf(stderr, "kernel_launch: %d CUs x %d blocks\n", cus, per_cu);
    }
    Params p = make_params(d_in, d_out, d_ws);
    (void)hipMemsetAsync(d_ws, 0, CTL_BYTES, stream);
    void* args[] = {&p};
    hipError_t e = hipLaunchCooperativeKernel((void*)mega_fwd, dim3(grid_blocks), dim3(256), args, 0, stream);
    if (e != hipSuccess) fprintf(stderr, "cooperative launch failed: %s (grid %d)\n", hipGetErrorString(e), grid_blocks);
}
#endif

#ifdef HOST_EMU
static void host_forward(void* const* d_in, void* d_out, void* d_ws) {
    const Params p = make_params(d_in, d_out, d_ws);
    for (int l = 0; l < 2; ++l) {
        const int nrows = (l == 0) ? T : TL;
        ph_prep_w(p, l, 0, 1); ph_prep_misc(p, l, 0, 1); ph_lnmod(p, l, 0, 1); host_gemm_in(p); ph_streams(p, l, 0, 1); ph_rope(p, 0, 1); ph_scan(p, 0, 1);
        ph_attn(p, l, nrows, 0, 1); ph_rwkv_out(p, l, nrows, 0, 1); host_gemm_out(p, nrows); ph_post_mixer(p, l, nrows, 0, 1);
        ph_dispatch(p, l, nrows, 0, 1); host_moe1(p, l); host_moe2(p, l); ph_final(p, l, nrows, 0, 1);
    }
}
#endif
```

```cpp
#ifdef HOST_EMU
#include <cmath>
#include <cstdio>
#include <cstring>
#include <cstdint>
#include <cstdlib>
#define __device__
#define __global__
#define __host__
#define __forceinline__ inline
#else
#include <hip/hip_runtime.h>
#include <hip/hip_cooperative_groups.h>
#include <cstdio>
#include <cstdint>
namespace cg = cooperative_groups;
#endif

#ifndef CFG_D
#define CFG_D 1024
#define CFG_B 8
#define CFG_S 2048
#define CFG_L 256
#define CFG_DE 512
#endif
constexpr int D = CFG_D, NB = CFG_B, S = CFG_S, L = CFG_L, DE = CFG_DE;
constexpr int TL = NB * S, TC = NB * L, T = TL + TC;
constexpr int GRID_W = 64, HD = 64;
constexpr int DA = 256, A_IN = 1184, N_IN = 2976, NINP = 3072, DMIX = 1024;
constexpr int NEXP = 32, NSLOT = 2 * T + NEXP * 128;
constexpr int ZQB = 0, ZKB = 384, ZVB = 512, ZQN = 640, ZKN = 1024, ZVN = 1408, ZA = 1792, ZP = 2976;
constexpr float LN_EPS = 1e-6f, GN_EPS = 64e-5f, ATT_SCALE = 0.125f;
constexpr float ALPHA = 1.41421356237309515f;

typedef unsigned short bf16_t;

__device__ __forceinline__ float bf2f(bf16_t v) {
    unsigned u = ((unsigned)v) << 16; float f;
#ifdef HOST_EMU
    memcpy(&f, &u, 4);
#else
    f = __uint_as_float(u);
#endif
    return f;
}
__device__ __forceinline__ bf16_t f2bf(float f) {
    unsigned u;
#ifdef HOST_EMU
    memcpy(&u, &f, 4);
#else
    u = __float_as_uint(f);
#endif
    return (bf16_t)((u + 0x7fffu + ((u >> 16) & 1u)) >> 16);
}
__device__ __forceinline__ float sigmoidf_(float x) { return 1.0f / (1.0f + expf(-x)); }
__device__ __forceinline__ float siluf_(float x) { return x / (1.0f + expf(-x)); }
__device__ __forceinline__ int atomic_inc_int(int* p) {
#ifdef HOST_EMU
    int o = *p; *p = o + 1; return o;
#else
    return atomicAdd(p, 1);
#endif
}

struct Params {
    const float *x, *c, *ctx, *c_ctx, *w_mod, *b_mod, *w_in, *w_out, *a_shift, *a_w0, *a_w_up, *a_a0, *a_a_up, *a_g_up,
        *a_k_k, *a_k_a, *a_r_k, *a_lnx_g, *a_lnx_b, *b_sink, *c_rpb, *ln1_g, *ln1_b, *ln2_g, *ln2_b, *w_rg, *b_rg, *w_re,
        *b_re, *w_gate, *w_up, *w_down;
    float* out;
    int* cnt;
    unsigned* bar;
    float* mod;
    float* rope;
    bf16_t *win_t, *wout_t, *wgu_t, *wd_t;
    bf16_t *wrt;
    int* hist;
    bf16_t* HLO;
    bf16_t *wupT, *aupT, *gupT;
    bf16_t* LA;
    float *kT, *kN;
    bf16_t* H;
    bf16_t* Z;
    bf16_t* VT;
    float *sR, *sV, *sKK, *sG, *sW, *sKD, *sB;
    float* Y;
    bf16_t* MIX;
    float *PV, *QS, *PS, *SS;
    float* XC;
    float* O;
    int *rE, *rPos, *rSlot; float* rW;
    int* slotTok;
    bf16_t* ACT;
    float* YS;
};

constexpr size_t al256(size_t v) { return (v + 255) & ~(size_t)255; }
constexpr size_t OFF_CNT = 0;
constexpr size_t OFF_BAR = 4096, CTL_BYTES = 4096 + 16384;
constexpr size_t OFF_MOD = CTL_BYTES;
constexpr size_t OFF_ROPE = al256(OFF_MOD + (size_t)2 * (NB + 1) * 6 * D * 4);
constexpr size_t OFF_LORA = al256(OFF_ROPE + 64 * 16 * 2 * 4);
constexpr size_t OFF_WRT = al256(OFF_LORA + (size_t)(2 * 256 * 64 * 2 + 256 * 160) * 2);
constexpr size_t OFF_LG = al256(OFF_WRT + (size_t)2 * 128 * D * 2);
constexpr size_t OFF_WIN = al256(OFF_LG + (size_t)T * 36 * 4);
constexpr size_t OFF_WOUT = al256(OFF_WIN + (size_t)NINP * D * 2);
constexpr size_t OFF_WGU = al256(OFF_WOUT + (size_t)D * DMIX * 2);
constexpr size_t OFF_WD = al256(OFF_WGU + (size_t)NEXP * 2 * DE * D * 2);
constexpr size_t OFF_H = al256(OFF_WD + (size_t)NEXP * D * DE * 2);
constexpr size_t OFF_Z = al256(OFF_H + (size_t)(T + 1) * D * 2);
constexpr int PU = L + S;
constexpr int NSG = (L + S) / 128;
static_assert((size_t)3 * 64 * ((L + S) / 128) * 4096 * 4 <= (size_t)NEXP * 2 * DE * D * 2 || (L % 128) != 0, "scan segment states overlay wgu_t");
constexpr size_t OFF_VT = al256(OFF_Z + (size_t)T * ZP * 2);
constexpr size_t OFF_S = al256(OFF_VT + (size_t)NB * 8 * 64 * PU * 2);
constexpr size_t S1 = (size_t)T * 256 * 4;
constexpr size_t OFF_Y = al256(OFF_S + 10 * S1);
constexpr size_t OFF_MIX = al256(OFF_Y + 2 * S1);
constexpr size_t OFF_XC = al256(OFF_MIX + (size_t)T * 1024 * 2);
constexpr size_t OFF_ROUTE = al256(OFF_XC + (size_t)TC * D * 4);
constexpr size_t OFF_SLOTTOK = al256(OFF_ROUTE + (size_t)T * 2 * 4 * 4);
constexpr size_t WS_NEED = al256(OFF_SLOTTOK + (size_t)NSLOT * 4);
static_assert((size_t)NSLOT * DE * 2 <= (size_t)T * ZP * 2 && (size_t)T * D * 2 <= (size_t)T * ZP * 2, "ACT / HLO overlay Z");
static_assert((size_t)T * 4 * 4 + (size_t)T * 416 * 2 <= S1, "kN + LA overlay Y[1]");
static_assert((size_t)NSLOT * D * 4 <= 10 * S1 && (size_t)T * D * 4 <= 10 * S1, "YS / O overlay the stream buffers");

static Params make_params(void* const* d_in, void* d_out, void* d_ws) {
    Params p{};
    const float** f = (const float**)&p.x;
    for (int i = 0; i < 32; ++i) f[i] = (const float*)d_in[i];
    p.out = (float*)d_out;
    char* w = (char*)d_ws;
    p.cnt = (int*)(w + OFF_CNT); p.bar = (unsigned*)(w + OFF_BAR); p.mod = (float*)(w + OFF_MOD); p.rope = (float*)(w + OFF_ROPE);
    p.win_t = (bf16_t*)(w + OFF_WIN); p.wout_t = (bf16_t*)(w + OFF_WOUT); p.wgu_t = (bf16_t*)(w + OFF_WGU); p.wd_t = (bf16_t*)(w + OFF_WD);
    p.wrt = (bf16_t*)(w + OFF_WRT); p.hist = (int*)(w + OFF_LG); p.HLO = (bf16_t*)(w + OFF_Z);
    p.wupT = (bf16_t*)(w + OFF_LORA); p.aupT = p.wupT + 2 * 256 * 64; p.gupT = p.aupT + 2 * 256 * 64;
    p.H = (bf16_t*)(w + OFF_H); p.Z = (bf16_t*)(w + OFF_Z); p.VT = (bf16_t*)(w + OFF_VT);
    float* s = (float*)(w + OFF_S); const size_t n1 = (size_t)T * 256;
    p.sR = s; p.sV = s + n1; p.sKK = s + 2 * n1; p.sG = s + 3 * n1; p.sW = s + 4 * n1; p.sKD = s + 6 * n1; p.sB = s + 8 * n1;
    p.Y = (float*)(w + OFF_Y); p.MIX = (bf16_t*)(w + OFF_MIX); p.XC = (float*)(w + OFF_XC);
    p.O = (float*)(w + OFF_S);
    p.PV = (float*)(w + OFF_H); p.QS = (float*)(w + OFF_WGU); p.PS = p.QS + (size_t)64 * NSG * 4096; p.SS = p.PS + (size_t)64 * NSG * 4096;
    p.kT = p.Y; p.kN = p.Y + (size_t)T * 256; p.LA = (bf16_t*)(p.Y + (size_t)T * 256 + (size_t)T * 4);
    int* r = (int*)(w + OFF_ROUTE); p.rE = r; p.rPos = r + 2 * T; p.rSlot = r + 4 * T; p.rW = (float*)(r + 6 * T);
    p.slotTok = (int*)(w + OFF_SLOTTOK);
    p.ACT = (bf16_t*)(w + OFF_Z); p.YS = (float*)(w + OFF_S);
    return p;
}

__device__ void ph_prep_w(const Params& p, int l, long gtid, long gsz) {
    for (long i = gtid; i < (long)D * NINP; i += gsz) {
        const int k = (int)(i / NINP), n = (int)(i % NINP);
        float v = 0.f;
        if (n < N_IN) { const int oc = (n < ZA) ? n + A_IN : n - ZA; v = p.w_in[((size_t)l * D + k) * N_IN + oc]; }
        p.win_t[(size_t)n * D + k] = f2bf(v);
    }
    for (long i = gtid; i < (long)DMIX * D; i += gsz) {
        const int k = (int)(i / D), n = (int)(i % D);
        p.wout_t[(size_t)n * DMIX + k] = f2bf(p.w_out[((size_t)l * DMIX + k) * D + n]);
    }
    for (long i = gtid; i < (long)NEXP * D * 2 * DE; i += gsz) {
        const int rho = (int)(i % (2 * DE)); const long t = i / (2 * DE); const int k = (int)(t % D), e = (int)(t / D);
        const int q = rho >> 5, half = (rho >> 4) & 1, ii = rho & 15, cc = 16 * q + ii;
        const float* src = half ? p.w_up : p.w_gate;
        p.wgu_t[((size_t)e * 2 * DE + rho) * D + k] = f2bf(src[(((size_t)l * NEXP + e) * D + k) * DE + cc]);
    }
    for (long i = gtid; i < (long)NEXP * DE * D; i += gsz) {
        const int n = (int)(i % D); const long t = i / D; const int k = (int)(t % DE), e = (int)(t / DE);
        p.wd_t[((size_t)e * D + n) * DE + k] = f2bf(p.w_down[(((size_t)l * NEXP + e) * DE + k) * D + n]);
    }
}
__device__ __forceinline__ void ph_prep_misc(const Params& p, int l, long gtid, long gsz, bool do_mod = true) {
    if (l == 0 && do_mod) for (long i = gtid; i < (long)2 * (NB + 1) * 6 * D; i += gsz) {
        const int j = (int)(i % (6 * D)), b = (int)((i / (6 * D)) % (NB + 1)), ll = (int)(i / ((long)6 * D * (NB + 1)));
        const float* cv = (b < NB) ? p.c + (size_t)b * D : p.c_ctx;
        float acc = 0.f;
        for (int k = 0; k < D; ++k) acc += siluf_(cv[k]) * p.w_mod[((size_t)ll * D + k) * 6 * D + j];
        p.mod[((size_t)ll * (NB + 1) + b) * 6 * D + j] = acc + p.b_mod[(size_t)ll * 6 * D + j];
    }
    if (l == 0) for (long i = gtid; i < 64 * 16; i += gsz) {
        const int pos = (int)(i / 16), fi = (int)(i % 16);
        const float inv = powf(10000.0f, -(float)fi / 16.0f), ang = (float)pos * inv;
        p.rope[i] = cosf(ang); p.rope[1024 + i] = sinf(ang);
    }
    for (long i = gtid; i < NEXP; i += gsz) p.cnt[l * NEXP + i] = 0;
    for (long i = gtid; i < NSLOT; i += gsz) p.slotTok[i] = T;
    for (long i = gtid; i < D; i += gsz) p.H[(size_t)T * D + i] = 0;
}

__device__ __forceinline__ const float* xrow_in(const Params& p, int l, int m) {
    if (m < TL) return (l == 0 ? p.x : p.out) + (size_t)m * D;
    return (l == 0 ? p.ctx : p.XC) + (size_t)(m - TL) * D;
}
__device__ __forceinline__ const float* modrow(const Params& p, int l, int m) { return p.mod + ((size_t)l * (NB + 1) + (m < TL ? m / S : NB)) * 6 * D; }

__device__ void ph_lnmod(const Params& p, int l, long gtid, long gsz) {
    for (long m = gtid; m < T; m += gsz) {
        const float* xr = xrow_in(p, l, (int)m); const float* md = modrow(p, l, (int)m);
        float s = 0.f; for (int j = 0; j < D; ++j) s += xr[j];
        const float mu = s / D; float q = 0.f;
        for (int j = 0; j < D; ++j) { const float d = xr[j] - mu; q += d * d; }
        const float rstd = 1.0f / sqrtf(q / D + LN_EPS);
        for (int j = 0; j < D; ++j) p.H[(size_t)m * D + j] = f2bf((xr[j] - mu) * rstd * (1.0f + md[D + j]) + md[j]);
    }
}

__device__ __forceinline__ float zshift(const Params& p, int l, int m, int col) {
    int t, len;
    if (m < TL) { t = m % S; len = S; } else { t = (m - TL) % L; len = L; }
    const float* sh = p.a_shift + (size_t)l * 3 * A_IN;
    const bf16_t* z = p.Z + (size_t)m * ZP + ZA + col;
    float v = sh[A_IN + col] * bf2f(z[0]);
    if (t > 0) v += sh[col] * bf2f(z[-ZP]);
    if (t < len - 1) v += sh[2 * A_IN + col] * bf2f(z[ZP]);
    return v;
}

__device__ void ph_streams(const Params& p, int l, long gtid, long gsz) {
    for (long i = gtid; i < (long)T * DA; i += gsz) {
        const int m = (int)(i / DA), c = (int)(i % DA), h0 = c & ~63;
        const float r = zshift(p, l, m, c), k = zshift(p, l, m, 256 + c), v = zshift(p, l, m, 512 + c);
        float nrm = 0.f;
        for (int j = 0; j < 64; ++j) { const float t = zshift(p, l, m, 256 + h0 + j) * p.a_k_k[l * DA + h0 + j]; nrm += t * t; }
        const float kk = k * p.a_k_k[l * DA + c] / sqrtf(nrm + 1e-12f);
        float g = 0.f;
        for (int j = 0; j < 160; ++j) g += sigmoidf_(zshift(p, l, m, 1024 + j)) * p.a_g_up[((size_t)l * 160 + j) * DA + c];
        const size_t o = (size_t)m * DA + c;
        p.sR[o] = r; p.sV[o] = v; p.sKK[o] = kk; p.sG[o] = g;
        for (int d = 0; d < 2; ++d) {
            float aw = 0.f, aa = 0.f;
            for (int j = 0; j < 64; ++j) {
                aw += tanhf(zshift(p, l, m, 768 + d * 64 + j)) * p.a_w_up[(((size_t)l * 2 + d) * 64 + j) * DA + c];
                aa += zshift(p, l, m, 896 + d * 64 + j) * p.a_a_up[(((size_t)l * 2 + d) * 64 + j) * DA + c];
            }
            const float u = -(p.a_w0[(l * 2 + d) * DA + c] + aw);
            const float sp = (u > 20.f) ? u : log1pf(expf(u));
            const float w = expf(-expf(-sp - 0.5f));
            const float a = sigmoidf_(p.a_a0[(l * 2 + d) * DA + c] + aa);
            const size_t od = ((size_t)d * T + m) * DA + c;
            p.sW[od] = w; p.sKD[od] = k * (1.0f + (a - 1.0f) * p.a_k_a[l * DA + c]); p.sB[od] = kk * a;
        }
    }
}

__device__ __forceinline__ void ph_rope(const Params& p, long gtid, long gsz) {
    for (long i = gtid; i < (long)TL * 8 * 32; i += gsz) {
        const int pr = (int)(i & 31), hs = (int)((i >> 5) & 7), m = (int)(i >> 8);
        const int t = m % S, axis = pr >> 4, fi = pr & 15, pos = axis ? (t % GRID_W) : (t / GRID_W);
        bf16_t* z = p.Z + (size_t)m * ZP + hs * 64 + axis * 32 + fi;
        const float cs = p.rope[pos * 16 + fi], sn = p.rope[1024 + pos * 16 + fi];
        const float x0 = bf2f(z[0]), x1 = bf2f(z[16]);
        z[0] = f2bf(x0 * cs - x1 * sn); z[16] = f2bf(x1 * cs + x0 * sn);
    }
}

__device__ void ph_scan(const Params& p, long gtid, long gsz) {
    for (long i = gtid; i < (long)2 * NB * 4 * 64; i += gsz) {
        const int v = (int)(i & 63), h = (int)((i >> 6) & 3), b = (int)((i >> 8) % NB), d = (int)((i >> 8) / NB);
        float st[64];
#pragma unroll
        for (int k = 0; k < 64; ++k) st[k] = 0.f;
        for (int pos = 0; pos < L + S; ++pos) {
            int m;
            if (pos < L) m = TL + b * L + (d ? L - 1 - pos : pos);
            else m = b * S + (d ? S - 1 - (pos - L) : pos - L);
            const size_t o = (size_t)m * DA + h * 64, od = ((size_t)d * T + m) * DA + h * 64;
            const float* kk = p.sKK + o; const float* r = p.sR + o;
            const float* w = p.sW + od; const float* bb = p.sB + od; const float* kd = p.sKD + od;
            const float vv = p.sV[o + v];
            float sk = 0.f;
#pragma unroll
            for (int k = 0; k < 64; ++k) sk += st[k] * kk[k];
            float y = 0.f;
#pragma unroll
            for (int k = 0; k < 64; ++k) { st[k] = st[k] * w[k] - sk * bb[k] + vv * kd[k]; y += st[k] * r[k]; }
            p.Y[od + v] = y;
        }
    }
}

__device__ void ph_rwkv_out(const Params& p, int l, int nrows, long gtid, long gsz) {
    for (long i = gtid; i < (long)nrows * 4; i += gsz) {
        const int m = (int)(i >> 2), h = (int)(i & 3);
        const size_t o = (size_t)m * DA + h * 64;
        const float* y0 = p.Y + o; const float* y1 = p.Y + (size_t)T * DA + o;
        float s = 0.f, bon = 0.f;
        for (int n = 0; n < 64; ++n) {
            s += y0[n] + y1[n];
            bon += p.sR[o + n] * (p.sKD[o + n] + p.sKD[(size_t)T * DA + o + n]) * p.a_r_k[l * DA + h * 64 + n];
        }
        const float mu = s / 64.f; float q = 0.f;
        for (int n = 0; n < 64; ++n) { const float dd = y0[n] + y1[n] - mu; q += dd * dd; }
        const float rstd = 1.0f / sqrtf(q / 64.f + GN_EPS);
        for (int n = 0; n < 64; ++n) {
            const int c = h * 64 + n;
            const float yn = (y0[n] + y1[n] - mu) * rstd * p.a_lnx_g[l * DA + c] + p.a_lnx_b[l * DA + c];
            p.MIX[(size_t)m * DMIX + c] = f2bf((yn + bon * p.sV[o + n]) * p.sG[o + n]);
        }
    }
}

__device__ __forceinline__ void att_key(const float (&q)[64], const bf16_t* kr, const bf16_t* vr, float bias, float& mx, float& ls, float (&acc)[64]) {
    float s = 0.f;
#pragma unroll
    for (int d = 0; d < 64; ++d) s += q[d] * bf2f(kr[d]);
    s = s * ATT_SCALE + bias;
    const float mn = fmaxf(mx, s), f = expf(mx - mn), pe = expf(s - mn);
    ls = ls * f + pe;
#pragma unroll
    for (int d = 0; d < 64; ++d) acc[d] = acc[d] * f + pe * bf2f(vr[d]);
    mx = mn;
}

__device__ void ph_attn(const Params& p, int l, int nrows, long gtid, long gsz) {
    for (long i = gtid; i < (long)nrows * 12; i += gsz) {
        const int m = (int)(i / 12), u = (int)(i % 12);
        const bool isB = u < 6; const int hq = isB ? u : u - 6;
        const int b = (m < TL) ? m / S : (m - TL) / L;
        const int qcol = isB ? ZQB + hq * 64 : ZQN + hq * 64;
        const int kcol = isB ? ZKB + (hq / 3) * 64 : ZKN + hq * 64;
        const int vcol = isB ? ZVB + (hq / 3) * 64 : ZVN + hq * 64;
        float q[64], acc[64];
        const bf16_t* qr = p.Z + (size_t)m * ZP + qcol;
#pragma unroll
        for (int d = 0; d < 64; ++d) { q[d] = bf2f(qr[d]); acc[d] = 0.f; }
        float mx, ls;
        if (isB) { mx = p.b_sink[l * 6 + hq]; ls = 1.0f; } else { mx = -1e30f; ls = 0.f; }
        for (int j = 0; j < L; ++j) { const bf16_t* zr = p.Z + (size_t)(TL + b * L + j) * ZP; att_key(q, zr + kcol, zr + vcol, 0.f, mx, ls, acc); }
        if (m < TL) {
            const int t = m % S;
            if (isB) {
                const int j0 = t - 128 < 0 ? 0 : t - 128, j1 = t + 128 > S - 1 ? S - 1 : t + 128;
                for (int j = j0; j <= j1; ++j) { const bf16_t* zr = p.Z + (size_t)(b * S + j) * ZP; att_key(q, zr + kcol, zr + vcol, 0.f, mx, ls, acc); }
            } else {
                const int rows = S / GRID_W, r = t / GRID_W, c = t % GRID_W;
                int r0 = r - 4; r0 = r0 < 0 ? 0 : (r0 > rows - 8 ? rows - 8 : r0);
                int c0 = c - 8; c0 = c0 < 0 ? 0 : (c0 > GRID_W - 16 ? GRID_W - 16 : c0);
                for (int a = 0; a < 8; ++a)
                    for (int e = 0; e < 16; ++e) {
                        const int kr = r0 + a, kc = c0 + e;
                        const float bias = p.c_rpb[(((size_t)l * 6 + hq) * 15 + (kr - r + 7)) * 31 + (kc - c + 15)];
                        const bf16_t* zr = p.Z + (size_t)(b * S + kr * GRID_W + kc) * ZP;
                        att_key(q, zr + kcol, zr + vcol, bias, mx, ls, acc);
                    }
            }
        }
        const float inv = 1.0f / ls;
        bf16_t* o = p.MIX + (size_t)m * DMIX + (isB ? 256 : 640) + hq * 64;
#pragma unroll
        for (int d = 0; d < 64; ++d) o[d] = f2bf(acc[d] * inv);
    }
}

__device__ void ph_post_mixer(const Params& p, int l, int nrows, long gtid, long gsz) {
    for (long mm = gtid; mm < nrows; mm += gsz) {
        const int m = (int)mm;
        const float* xr = xrow_in(p, l, m); const float* md = modrow(p, l, m); const float* orow = p.O + (size_t)m * D;
        float* x1 = (m < TL) ? p.out + (size_t)m * D : p.XC + (size_t)(m - TL) * D;
        const float* g1 = p.ln1_g + (size_t)l * D; const float* b1 = p.ln1_b + (size_t)l * D;
        float s = 0.f; for (int j = 0; j < D; ++j) s += ALPHA * xr[j] + md[2 * D + j] * orow[j];
        float mu = s / D, q = 0.f;
        for (int j = 0; j < D; ++j) { const float d = ALPHA * xr[j] + md[2 * D + j] * orow[j] - mu; q += d * d; }
        float rstd = 1.0f / sqrtf(q / D + LN_EPS);
        s = 0.f;
        for (int j = 0; j < D; ++j) { const float v = (ALPHA * xr[j] + md[2 * D + j] * orow[j] - mu) * rstd * g1[j] + b1[j]; x1[j] = v; s += v; }
        mu = s / D; q = 0.f;
        for (int j = 0; j < D; ++j) { const float d = x1[j] - mu; q += d * d; }
        rstd = 1.0f / sqrtf(q / D + LN_EPS);
        float gl[4], el[32];
#pragma unroll
        for (int g = 0; g < 4; ++g) gl[g] = p.b_rg[l * 4 + g];
#pragma unroll
        for (int e = 0; e < 32; ++e) el[e] = p.b_re[l * 32 + e];
        for (int j = 0; j < D; ++j) {
            const float hv = (x1[j] - mu) * rstd * (1.0f + md[4 * D + j]) + md[3 * D + j];
            p.H[(size_t)m * D + j] = f2bf(hv);
            const float* wg = p.w_rg + ((size_t)l * D + j) * 4; const float* we = p.w_re + ((size_t)l * D + j) * 32;
#pragma unroll
            for (int g = 0; g < 4; ++g) gl[g] += hv * wg[g];
#pragma unroll
            for (int e = 0; e < 32; ++e) el[e] += hv * we[e];
        }
        int gs = 0; float gm = gl[0];
#pragma unroll
        for (int g = 1; g < 4; ++g) if (gl[g] > gm) { gm = gl[g]; gs = g; }
        float den = 0.f;
#pragma unroll
        for (int g = 0; g < 4; ++g) den += expf(gl[g] - gm);
        const float pg = 1.0f / den;
        float v1 = -3e38f, v2 = -3e38f; int i1 = 0, i2 = 0;
#pragma unroll
        for (int j = 0; j < 8; ++j) {
            const float v = gs == 0 ? el[j] : gs == 1 ? el[8 + j] : gs == 2 ? el[16 + j] : el[24 + j];
            if (v > v1) { v2 = v1; i2 = i1; v1 = v; i1 = j; } else if (v > v2) { v2 = v; i2 = j; }
        }
        const float e2 = expf(v2 - v1), w1 = pg / (1.0f + e2), w2 = pg * e2 / (1.0f + e2);
        const int ea = gs * 8 + i1, eb = gs * 8 + i2;
        p.rE[2 * m] = ea; p.rE[2 * m + 1] = eb; p.rW[2 * m] = w1; p.rW[2 * m + 1] = w2;
        p.rPos[2 * m] = atomic_inc_int(p.cnt + l * NEXP + ea); p.rPos[2 * m + 1] = atomic_inc_int(p.cnt + l * NEXP + eb);
    }
}

__device__ __forceinline__ int pstart_of(const int* cnt, int e) {
    int s = 0;
    for (int j = 0; j < NEXP; ++j) if (j < e) s += (cnt[j] + 127) & ~127;
    return s;
}
__device__ __forceinline__ void ph_dispatch(const Params& p, int l, int nrows, long gtid, long gsz) {
    for (long i = gtid; i < (long)nrows * 2; i += gsz) {
        const int slot = pstart_of(p.cnt + l * NEXP, p.rE[i]) + p.rPos[i];
        p.rSlot[i] = slot; p.slotTok[slot] = (int)(i >> 1);
    }
}

__device__ void ph_final(const Params& p, int l, int nrows, long gtid, long gsz) {
    for (long mm = gtid; mm < nrows; mm += gsz) {
        const int m = (int)mm;
        float* x1 = (m < TL) ? p.out + (size_t)m * D : p.XC + (size_t)(m - TL) * D;
        const float* md = modrow(p, l, m);
        const float* ya = p.YS + (size_t)p.rSlot[2 * m] * D; const float* yb = p.YS + (size_t)p.rSlot[2 * m + 1] * D;
        const float wa = p.rW[2 * m], wb = p.rW[2 * m + 1];
        const float* g2 = p.ln2_g + (size_t)l * D; const float* b2 = p.ln2_b + (size_t)l * D;
        float s = 0.f; for (int j = 0; j < D; ++j) s += ALPHA * x1[j] + md[5 * D + j] * (wa * ya[j] + wb * yb[j]);
        const float mu = s / D; float q = 0.f;
        for (int j = 0; j < D; ++j) { const float d = ALPHA * x1[j] + md[5 * D + j] * (wa * ya[j] + wb * yb[j]) - mu; q += d * d; }
        const float rstd = 1.0f / sqrtf(q / D + LN_EPS);
        for (int j = 0; j < D; ++j) x1[j] = (ALPHA * x1[j] + md[5 * D + j] * (wa * ya[j] + wb * yb[j]) - mu) * rstd * g2[j] + b2[j];
    }
}

__device__ __forceinline__ int moe_blocks(const int* cnt) { int s = 0; for (int j = 0; j < NEXP; ++j) s += (cnt[j] + 127) >> 7; return s; }
__device__ __forceinline__ int moe_block_expert(const int* cnt, int rb) {
    int s = 0, e = 0;
    for (int j = 0; j < NEXP; ++j) { const int nb = (cnt[j] + 127) >> 7; if (rb >= s && rb < s + nb) e = j; s += nb; }
    return e;
}

#ifdef HOST_EMU
static void host_gemm_in(const Params& p) {
    for (int m = 0; m < T; ++m) for (int n = 0; n < ZP; ++n) { float a = 0.f; for (int k = 0; k < D; ++k) a += bf2f(p.H[(size_t)m * D + k]) * bf2f(p.win_t[(size_t)n * D + k]); p.Z[(size_t)m * ZP + n] = f2bf(a); }
}
static void host_gemm_out(const Params& p, int nrows) {
    for (int m = 0; m < nrows; ++m) for (int n = 0; n < D; ++n) { float a = 0.f; for (int k = 0; k < DMIX; ++k) a += bf2f(p.MIX[(size_t)m * DMIX + k]) * bf2f(p.wout_t[(size_t)n * DMIX + k]); p.O[(size_t)m * D + n] = a; }
}
static void host_moe1(const Params& p, int l) {
    const int* cnt = p.cnt + l * NEXP; const int nrb = moe_blocks(cnt);
    for (int rb = 0; rb < nrb; ++rb) { const int e = moe_block_expert(cnt, rb);
        for (int r = 0; r < 128; ++r) { const int slot = rb * 128 + r; const bf16_t* a = p.H + (size_t)p.slotTok[slot] * D;
            for (int c = 0; c < DE; ++c) { const int q = c >> 4, ii = c & 15; float g = 0.f, u = 0.f;
                const bf16_t* wg = p.wgu_t + ((size_t)e * 2 * DE + 32 * q + ii) * D; const bf16_t* wu = wg + (size_t)16 * D;
                for (int k = 0; k < D; ++k) { g += bf2f(a[k]) * bf2f(wg[k]); u += bf2f(a[k]) * bf2f(wu[k]); }
                p.ACT[(size_t)slot * DE + c] = f2bf(siluf_(g) * u); } } }
}
static void host_moe2(const Params& p, int l) {
    const int* cnt = p.cnt + l * NEXP; const int nrb = moe_blocks(cnt);
    for (int rb = 0; rb < nrb; ++rb) { const int e = moe_block_expert(cnt, rb);
        for (int r = 0; r < 128; ++r) { const int slot = rb * 128 + r;
            for (int n = 0; n < D; ++n) { float a = 0.f; const bf16_t* w = p.wd_t + ((size_t)e * D + n) * DE;
                for (int k = 0; k < DE; ++k) a += bf2f(p.ACT[(size_t)slot * DE + k]) * bf2f(w[k]);
                p.YS[(size_t)slot * D + n] = a; } } }
}
#else
typedef short bf16x8 __attribute__((ext_vector_type(8)));
typedef float f32x4 __attribute__((ext_vector_type(4)));
__device__ __forceinline__ int opq_tid() { int t = threadIdx.x; asm volatile("" : "+v"(t)); return t; }
__device__ __forceinline__ int opq_bid() { int b = blockIdx.x; asm volatile("" : "+s"(b)); return b; }
__device__ __forceinline__ unsigned pk2(float lo, float hi) { return (unsigned)f2bf(lo) | ((unsigned)f2bf(hi) << 16); }
struct u32x2_t { unsigned x, y; };
__device__ __forceinline__ void st_bf16x4(bf16_t* dst, f32x4 v) { u32x2_t o; o.x = pk2(v[0], v[1]); o.y = pk2(v[2], v[3]); *(u32x2_t*)dst = o; }
template <class Epi>
__device__ __forceinline__ void gemm_tile(const bf16_t* a0, const bf16_t* a1, const bf16_t* b0, const bf16_t* b1, int K, char* lds, const Epi& epi) {
    const int tid = opq_tid(), wid = tid >> 6, lane = tid & 63, wr = wid >> 1, wc = wid & 1, fr = lane & 15, fq = lane >> 4;
    f32x4 acc[4][4];
#pragma unroll
    for (int m = 0; m < 4; ++m)
#pragma unroll
        for (int n = 0; n < 4; ++n) acc[m][n] = (f32x4){0.f, 0.f, 0.f, 0.f};
#define GT_STAGE(st_, kt_) do { char* sa_ = lds + (st_) * 16384 + tid * 16; \
        __builtin_amdgcn_global_load_lds((const unsigned*)(a0 + (kt_)), (__attribute__((address_space(3))) unsigned*)(sa_), 16, 0, 0); \
        __builtin_amdgcn_global_load_lds((const unsigned*)(a1 + (kt_)), (__attribute__((address_space(3))) unsigned*)(sa_ + 4096), 16, 0, 0); \
        __builtin_amdgcn_global_load_lds((const unsigned*)(b0 + (kt_)), (__attribute__((address_space(3))) unsigned*)(sa_ + 8192), 16, 0, 0); \
        __builtin_amdgcn_global_load_lds((const unsigned*)(b1 + (kt_)), (__attribute__((address_space(3))) unsigned*)(sa_ + 12288), 16, 0, 0); } while (0)
    const int aoff = (wr * 64 + fr) * 64 + ((fq ^ ((fr >> 2) & 3)) * 16), boff = 8192 + (wc * 64 + fr) * 64 + ((fq ^ ((fr >> 2) & 3)) * 16);
    const int nk = K / 32;
    GT_STAGE(0, 0);
    if (nk > 1) GT_STAGE(1, 32);
    if (nk > 2) GT_STAGE(2, 64);
    for (int t = 0; t < nk; ++t) {
        if (t + 2 < nk) asm volatile("s_waitcnt vmcnt(8)" ::: "memory"); else if (t + 1 < nk) asm volatile("s_waitcnt vmcnt(4)" ::: "memory"); else asm volatile("s_waitcnt vmcnt(0)" ::: "memory");
        asm volatile("s_waitcnt lgkmcnt(0)" ::: "memory");
        __builtin_amdgcn_s_barrier();
        if (t + 3 < nk) GT_STAGE((t + 3) & 3, (t + 3) * 32);
        const char* sb = lds + (t & 3) * 16384;
        bf16x8 At[4], Bt[4];
#pragma unroll
        for (int m = 0; m < 4; ++m) At[m] = *(const bf16x8*)(sb + aoff + m * 1024);
#pragma unroll
        for (int n = 0; n < 4; ++n) Bt[n] = *(const bf16x8*)(sb + boff + n * 1024);
#pragma unroll
        for (int m = 0; m < 4; ++m)
#pragma unroll
            for (int n = 0; n < 4; ++n) acc[m][n] = __builtin_amdgcn_mfma_f32_16x16x32_bf16(At[m], Bt[n], acc[m][n], 0, 0, 0);
    }
    asm volatile("s_waitcnt lgkmcnt(0)" ::: "memory");
    __builtin_amdgcn_s_barrier();
#undef GT_STAGE
    epi(acc, wr, wc, fr, fq);
}
#define STG_ROW(i) ((tid_ + (i) * 256) >> 2)
#define STG_K ((((tid_ & 3) ^ ((tid_ >> 4) & 3))) * 8)

__device__ __forceinline__ void g_gemm_in(const Params& p, char* lds) {
    const int tid_ = opq_tid(), bid_ = opq_bid(); (void)tid_; (void)bid_;
    constexpr int NT = NINP / 128, MT = T / 128;
    for (int tile = bid_; tile < NT * MT; tile += gridDim.x) {
        const int tm = tile / NT, tn = tile % NT;
        const bf16_t* a0 = p.H + (size_t)(tm * 128 + STG_ROW(0)) * D + STG_K; const bf16_t* a1 = p.H + (size_t)(tm * 128 + STG_ROW(1)) * D + STG_K;
        const bf16_t* b0 = p.win_t + (size_t)(tn * 128 + STG_ROW(0)) * D + STG_K; const bf16_t* b1 = p.win_t + (size_t)(tn * 128 + STG_ROW(1)) * D + STG_K;
        gemm_tile(a0, a1, b0, b1, D, lds, [&](const f32x4 (&acc)[4][4], int wr, int wc, int fr, int fq) {
            if (tn < ZVB / 128 && tm < TL / 128) {
#pragma unroll
                for (int m = 0; m < 4; ++m)
#pragma unroll
                    for (int j = 0; j < 4; ++j) { const int row = tm * 128 + wr * 64 + m * 16 + fq * 4 + j, t = row % S;
                        bf16_t* zr = p.Z + (size_t)row * ZP + tn * 128 + wc * 64 + fr;
#pragma unroll
                        for (int ax = 0; ax < 2; ++ax) { const int pos = ax ? t % GRID_W : t / GRID_W; const float cs = p.rope[pos * 16 + fr], sn = p.rope[1024 + pos * 16 + fr];
                            const float x0 = acc[m][2 * ax][j], x1 = acc[m][2 * ax + 1][j];
                            zr[32 * ax] = f2bf(x0 * cs - x1 * sn); zr[32 * ax + 16] = f2bf(x1 * cs + x0 * sn); } }
            } else {
#pragma unroll
            for (int m = 0; m < 4; ++m)
#pragma unroll
                for (int n = 0; n < 4; ++n) { const int col = tn * 128 + wc * 64 + n * 16 + fr;
                    if (col < ZP) {
#pragma unroll
                        for (int j = 0; j < 4; ++j) p.Z[(size_t)(tm * 128 + wr * 64 + m * 16 + fq * 4 + j) * ZP + col] = f2bf(acc[m][n][j]); } }
            }
            if (tn == ZVB / 128 || (tn >= ZVN / 128 && tn < ZA / 128)) {
#pragma unroll
                for (int m = 0; m < 4; ++m) { const int m0 = tm * 128 + wr * 64 + m * 16 + fq * 4; int b, u;
                    if (m0 < TL) { b = m0 / S; u = L + m0 % S; } else { b = (m0 - TL) / L; u = (m0 - TL) % L; }
#pragma unroll
                    for (int n = 0; n < 4; ++n) { const int col = tn * 128 + wc * 64 + n * 16 + fr;
                        const int hv = col < ZVN ? (col - ZVB) >> 6 : 2 + ((col - ZVN) >> 6), d = col < ZVN ? (col - ZVB) & 63 : (col - ZVN) & 63;
                        st_bf16x4(p.VT + ((size_t)(b * 8 + hv) * 64 + d) * PU + u, acc[m][n]); } }
            }
        });
    }
}
__device__ __forceinline__ void g_gemm_out(const Params& p, int nrows, char* lds) {
    const int tid_ = opq_tid(), bid_ = opq_bid(); (void)tid_; (void)bid_;
    constexpr int NT = D / 128; const int MT = nrows / 128;
    for (int tile = bid_; tile < NT * MT; tile += gridDim.x) {
        const int tm = tile / NT, tn = tile % NT;
        const bf16_t* a0 = p.MIX + (size_t)(tm * 128 + STG_ROW(0)) * DMIX + STG_K; const bf16_t* a1 = p.MIX + (size_t)(tm * 128 + STG_ROW(1)) * DMIX + STG_K;
        const bf16_t* b0 = p.wout_t + (size_t)(tn * 128 + STG_ROW(0)) * DMIX + STG_K; const bf16_t* b1 = p.wout_t + (size_t)(tn * 128 + STG_ROW(1)) * DMIX + STG_K;
        gemm_tile(a0, a1, b0, b1, DMIX, lds, [&](const f32x4 (&acc)[4][4], int wr, int wc, int fr, int fq) {
#pragma unroll
            for (int m = 0; m < 4; ++m)
#pragma unroll
                for (int n = 0; n < 4; ++n)
#pragma unroll
                    for (int j = 0; j < 4; ++j) p.O[(size_t)(tm * 128 + wr * 64 + m * 16 + fq * 4 + j) * D + tn * 128 + wc * 64 + n * 16 + fr] = acc[m][n][j];
        });
    }
}
__device__ __forceinline__ void g_moe1(const Params& p, int l, char* lds) {
    const int tid_ = opq_tid(), bid_ = opq_bid(); (void)tid_; (void)bid_;
    const int* cnt = p.cnt + l * NEXP; const int nrb = moe_blocks(cnt); constexpr int NT = 2 * DE / 128;
    for (int tile = bid_; tile < nrb * NT; tile += gridDim.x) {
        const int rb = tile / NT, tn = tile % NT, e = moe_block_expert(cnt, rb);
        const bf16_t* a0 = p.H + (size_t)p.slotTok[rb * 128 + STG_ROW(0)] * D + STG_K; const bf16_t* a1 = p.H + (size_t)p.slotTok[rb * 128 + STG_ROW(1)] * D + STG_K;
        const bf16_t* bw = p.wgu_t + (size_t)e * 2 * DE * D;
        const bf16_t* b0 = bw + (size_t)(tn * 128 + STG_ROW(0)) * D + STG_K; const bf16_t* b1 = bw + (size_t)(tn * 128 + STG_ROW(1)) * D + STG_K;
        gemm_tile(a0, a1, b0, b1, D, lds, [&](const f32x4 (&acc)[4][4], int wr, int wc, int fr, int fq) {
#pragma unroll
            for (int m = 0; m < 4; ++m)
#pragma unroll
                for (int n2 = 0; n2 < 2; ++n2) { const int col = tn * 64 + wc * 32 + n2 * 16 + fr;
#pragma unroll
                    for (int j = 0; j < 4; ++j) { const float g = acc[m][2 * n2][j], u = acc[m][2 * n2 + 1][j];
                        p.ACT[(size_t)(rb * 128 + wr * 64 + m * 16 + fq * 4 + j) * DE + col] = f2bf(g / (1.0f + __expf(-g)) * u); } }
        });
    }
}
__device__ __forceinline__ void g_moe2(const Params& p, int l, char* lds) {
    const int tid_ = opq_tid(), bid_ = opq_bid(); (void)tid_; (void)bid_;
    const int* cnt = p.cnt + l * NEXP; const int nrb = moe_blocks(cnt); constexpr int NT = D / 128;
    for (int tile = bid_; tile < nrb * NT; tile += gridDim.x) {
        const int rb = tile / NT, tn = tile % NT, e = moe_block_expert(cnt, rb);
        const bf16_t* a0 = p.ACT + (size_t)(rb * 128 + STG_ROW(0)) * DE + STG_K; const bf16_t* a1 = p.ACT + (size_t)(rb * 128 + STG_ROW(1)) * DE + STG_K;
        const bf16_t* bw = p.wd_t + (size_t)e * D * DE;
        const bf16_t* b0 = bw + (size_t)(tn * 128 + STG_ROW(0)) * DE + STG_K; const bf16_t* b1 = bw + (size_t)(tn * 128 + STG_ROW(1)) * DE + STG_K;
        gemm_tile(a0, a1, b0, b1, DE, lds, [&](const f32x4 (&acc)[4][4], int wr, int wc, int fr, int fq) {
#pragma unroll
            for (int m = 0; m < 4; ++m)
#pragma unroll
                for (int n = 0; n < 4; ++n)
#pragma unroll
                    for (int j = 0; j < 4; ++j) p.YS[(size_t)(rb * 128 + wr * 64 + m * 16 + fq * 4 + j) * D + tn * 128 + wc * 64 + n * 16 + fr] = acc[m][n][j];
        });
    }
}


constexpr int DV = D / 256;
static_assert(D % 256 == 0, "row phases hold a row as DV float4 per lane");
template <int CTRL> __device__ __forceinline__ float dppf(float v) { return __builtin_bit_cast(float, __builtin_amdgcn_update_dpp(0, __builtin_bit_cast(int, v), CTRL, 0xf, 0xf, true)); }
__device__ __forceinline__ float wave_sum(float v) {
    v += dppf<0xB1>(v); v += dppf<0x4E>(v); v += dppf<0x141>(v); v += dppf<0x140>(v);
    float a = v, b = v;
    asm volatile("s_nop 1\n\tv_permlane16_swap_b32 %0, %1" : "+v"(a), "+v"(b));
    v = a + b; a = v; b = v;
    asm volatile("s_nop 1\n\tv_permlane32_swap_b32 %0, %1" : "+v"(a), "+v"(b));
    return a + b;
}
__device__ __forceinline__ float sum8(float v) { v += dppf<0xB1>(v); v += dppf<0x4E>(v); v += dppf<0x141>(v); return v; }
__device__ __forceinline__ float sum4(f32x4 a) { return (a[0] + a[1]) + (a[2] + a[3]); }
#define LDS_WAIT() asm volatile("s_waitcnt lgkmcnt(0)" ::: "memory")

__device__ __forceinline__ void row_stats(const f32x4 (&v)[DV], float& mu, float& rstd) {
    float s = 0.f;
#pragma unroll
    for (int j = 0; j < DV; ++j) s += sum4(v[j]);
    mu = wave_sum(s) * (1.0f / D);
    float q = 0.f;
#pragma unroll
    for (int j = 0; j < DV; ++j) { const f32x4 d = v[j] - mu; q += sum4(d * d); }
    rstd = 1.0f / sqrtf(wave_sum(q) * (1.0f / D) + LN_EPS);
}

__device__ __forceinline__ void ph_lnmod_fast(const Params& p, int l) {
    const int tid_ = opq_tid(), bid_ = opq_bid(); (void)tid_; (void)bid_;
    const int lane = tid_ & 63, gw = bid_ * 4 + (tid_ >> 6), nw = gridDim.x * 4;
    for (int m = gw; m < T; m += nw) {
        const f32x4* xr = (const f32x4*)xrow_in(p, l, m) + lane; const f32x4* md = (const f32x4*)modrow(p, l, m) + lane;
        f32x4 v[DV];
#pragma unroll
        for (int j = 0; j < DV; ++j) v[j] = xr[64 * j];
        float mu, rstd; row_stats(v, mu, rstd);
#pragma unroll
        for (int j = 0; j < DV; ++j) { const f32x4 sh = md[64 * j], sc = md[D / 4 + 64 * j];
            st_bf16x4(p.H + (size_t)m * D + 4 * (lane + 64 * j), (v[j] - mu) * rstd * (sc + 1.0f) + sh); }
    }
}

__device__ __forceinline__ void ph_post_mixer_fast(const Params& p, int l, int nrows) {
    const int tid_ = opq_tid(), bid_ = opq_bid(); (void)tid_; (void)bid_;
    const int lane = tid_ & 63, gw = bid_ * 4 + (tid_ >> 6), nw = gridDim.x * 4;
    for (int m = gw; m < nrows; m += nw) {
        const f32x4* xr = (const f32x4*)xrow_in(p, l, m) + lane; const f32x4* md = (const f32x4*)modrow(p, l, m) + lane;
        const f32x4* orow = (const f32x4*)(p.O + (size_t)m * D) + lane;
        f32x4* x1 = (f32x4*)((m < TL) ? p.out + (size_t)m * D : p.XC + (size_t)(m - TL) * D) + lane;
        const f32x4* g1 = (const f32x4*)(p.ln1_g + (size_t)l * D) + lane; const f32x4* b1 = (const f32x4*)(p.ln1_b + (size_t)l * D) + lane;
        f32x4 v[DV];
#pragma unroll
        for (int j = 0; j < DV; ++j) v[j] = xr[64 * j] * ALPHA + md[2 * (D / 4) + 64 * j] * orow[64 * j];
        float mu, rstd; row_stats(v, mu, rstd);
#pragma unroll
        for (int j = 0; j < DV; ++j) { v[j] = (v[j] - mu) * rstd * g1[64 * j] + b1[64 * j]; x1[64 * j] = v[j]; }
        row_stats(v, mu, rstd);
#pragma unroll
        for (int j = 0; j < DV; ++j) {
            const f32x4 hv = (v[j] - mu) * rstd * (md[4 * (D / 4) + 64 * j] + 1.0f) + md[3 * (D / 4) + 64 * j];
            f32x4 hh, lo;
#pragma unroll
            for (int e = 0; e < 4; ++e) { hh[e] = bf2f(f2bf(hv[e])); lo[e] = hv[e] - hh[e]; }
            st_bf16x4(p.H + (size_t)m * D + 4 * (lane + 64 * j), hh);
            st_bf16x4(p.HLO + (size_t)m * D + 4 * (lane + 64 * j), lo);
        }
    }
}

__device__ __forceinline__ void g_router(const Params& p, int l, int nrows, char* lds) {
    const int tid_ = opq_tid(), bid_ = opq_bid(); (void)tid_; (void)bid_;
    const int lane = tid_ & 63, wid = tid_ >> 6, fr = lane & 15, fq = lane >> 4;
    float* part = (float*)lds;
    float* lgt = part + 4 * 6 * 64 * 4;
    int* eids = (int*)(lgt + 32 * 48);
    for (int rg = bid_; rg < nrows / 32; rg += gridDim.x) {
        f32x4 acc[2][3];
#pragma unroll
        for (int a = 0; a < 2; ++a)
#pragma unroll
            for (int b = 0; b < 3; ++b) acc[a][b] = (f32x4){0.f, 0.f, 0.f, 0.f};
#pragma unroll
        for (int seg = 0; seg < 3; ++seg) {
            const bf16_t* ap = (seg < 2 ? p.H : p.HLO) + (size_t)(rg * 32 + fr) * D + wid * (D / 4) + fq * 8;
            const bf16_t* bp = p.wrt + (seg == 1 ? (size_t)128 * D : 0) + (size_t)fr * D + wid * (D / 4) + fq * 8;
#pragma unroll 1
            for (int ks0 = 0; ks0 < D / 128; ks0 += 4) {
                bf16x8 av[4][2], bv[4][3];
#pragma unroll
                for (int u = 0; u < 4; ++u) { const int ko = (ks0 + u) * 32;
                    av[u][0] = *(const bf16x8*)(ap + ko); av[u][1] = *(const bf16x8*)(ap + (size_t)16 * D + ko);
                    bv[u][0] = *(const bf16x8*)(bp + ko); bv[u][1] = *(const bf16x8*)(bp + (size_t)16 * D + ko); bv[u][2] = *(const bf16x8*)(bp + (size_t)32 * D + ko); }
                asm volatile("" ::: "memory");
#pragma unroll
                for (int u = 0; u < 4; ++u)
#pragma unroll
                    for (int a = 0; a < 2; ++a)
#pragma unroll
                        for (int b = 0; b < 3; ++b) acc[a][b] = __builtin_amdgcn_mfma_f32_16x16x32_bf16(av[u][a], bv[u][b], acc[a][b], 0, 0, 0);
            }
        }
#pragma unroll
        for (int a = 0; a < 2; ++a)
#pragma unroll
            for (int b = 0; b < 3; ++b) *(f32x4*)(part + ((wid * 6 + a * 3 + b) * 64 + lane) * 4) = acc[a][b];
        __syncthreads();
#pragma unroll
        for (int i = 0; i < 6; ++i) { const int e = tid_ + 256 * i, f = e >> 8, ln = (e & 255) >> 2, j = e & 3;
            const float sm = (part[((0 * 6 + f) * 64 + ln) * 4 + j] + part[((1 * 6 + f) * 64 + ln) * 4 + j]) + (part[((2 * 6 + f) * 64 + ln) * 4 + j] + part[((3 * 6 + f) * 64 + ln) * 4 + j]);
            lgt[((f / 3) * 16 + (ln >> 4) * 4 + j) * 48 + (f % 3) * 16 + (ln & 15)] = sm; }
        __syncthreads();
        if (tid_ < 32) {
            const int m = rg * 32 + tid_; const float* lg = lgt + tid_ * 48;
            float gl[4], el[32];
#pragma unroll
            for (int g = 0; g < 4; ++g) gl[g] = lg[g] + p.b_rg[l * 4 + g];
#pragma unroll
            for (int e = 0; e < 32; ++e) el[e] = lg[4 + e] + p.b_re[l * 32 + e];
            int gs = 0; float gm = gl[0];
#pragma unroll
            for (int g = 1; g < 4; ++g) if (gl[g] > gm) { gm = gl[g]; gs = g; }
            float den = 0.f;
#pragma unroll
            for (int g = 0; g < 4; ++g) den += expf(gl[g] - gm);
            const float pg = 1.0f / den;
            float v1 = -3e38f, v2 = -3e38f; int i1 = 0, i2 = 0;
#pragma unroll
            for (int j = 0; j < 8; ++j) {
                const float vv = gs == 0 ? el[j] : gs == 1 ? el[8 + j] : gs == 2 ? el[16 + j] : el[24 + j];
                if (vv > v1) { v2 = v1; i2 = i1; v1 = vv; i1 = j; } else if (vv > v2) { v2 = vv; i2 = j; }
            }
            const float e2 = expf(v2 - v1), w1 = pg / (1.0f + e2), w2 = pg * e2 / (1.0f + e2);
            const int ea = gs * 8 + i1, eb = gs * 8 + i2;
            p.rE[2 * m] = ea; p.rE[2 * m + 1] = eb; p.rW[2 * m] = w1; p.rW[2 * m + 1] = w2;
            eids[2 * tid_] = ea; eids[2 * tid_ + 1] = eb;
        }
        __syncthreads();
        if (tid_ < 64) { const int e = eids[tid_]; int rk = 0; for (int j = 0; j < tid_; ++j) rk += (eids[j] == e) ? 1 : 0; p.rPos[2 * (rg * 32) + tid_] = rk; }
        else if (tid_ < 96) { const int e = tid_ - 64; int c = 0; for (int j = 0; j < 64; ++j) c += (eids[j] == e) ? 1 : 0; p.hist[rg * 32 + e] = c; }
        __syncthreads();
    }
}

__device__ __forceinline__ void ph_dispatch_fast(const Params& p, int l, int nrows, char* lds) {
    const int tid_ = opq_tid(), bid_ = opq_bid(); (void)tid_; (void)bid_;
    const int nrg = nrows / 32, e = tid_ & 31, part = tid_ >> 5;
    int* tot = (int*)lds; int* pst = tot + 32; int* pre = pst + 32; int* red = pre + 32;
    { int s = 0; for (int b = part; b < nrg; b += 8) s += p.hist[b * 32 + e]; red[part * 32 + e] = s; }
    __syncthreads();
    if (tid_ < 32) { int s = 0; for (int q = 0; q < 8; ++q) s += red[q * 32 + tid_]; tot[tid_] = s; }
    __syncthreads();
    if (tid_ < 32) { int s = 0; for (int j = 0; j < tid_; ++j) s += (tot[j] + 127) & ~127; pst[tid_] = s; if (bid_ == 0) p.cnt[l * NEXP + tid_] = tot[tid_]; }
    for (int rg = bid_; rg < nrg; rg += gridDim.x) {
        __syncthreads();
        { int s = 0; for (int b = part; b < rg; b += 8) s += p.hist[b * 32 + e]; red[part * 32 + e] = s; }
        __syncthreads();
        if (tid_ < 32) { int s = 0; for (int q = 0; q < 8; ++q) s += red[q * 32 + tid_]; pre[tid_] = s; }
        __syncthreads();
        if (tid_ < 64) { const int i = 2 * (rg * 32) + tid_, ee = p.rE[i], slot = pst[ee] + pre[ee] + p.rPos[i]; p.rSlot[i] = slot; p.slotTok[slot] = i >> 1; }
    }
}

__device__ __forceinline__ void ph_final_fast(const Params& p, int l, int nrows) {
    const int tid_ = opq_tid(), bid_ = opq_bid(); (void)tid_; (void)bid_;
    const int lane = tid_ & 63, gw = bid_ * 4 + (tid_ >> 6), nw = gridDim.x * 4;
    for (int m = gw; m < nrows; m += nw) {
        f32x4* x1 = (f32x4*)((m < TL) ? p.out + (size_t)m * D : p.XC + (size_t)(m - TL) * D) + lane;
        const f32x4* md = (const f32x4*)modrow(p, l, m) + lane;
        const f32x4* ya = (const f32x4*)(p.YS + (size_t)p.rSlot[2 * m] * D) + lane; const f32x4* yb = (const f32x4*)(p.YS + (size_t)p.rSlot[2 * m + 1] * D) + lane;
        const float wa = p.rW[2 * m], wb = p.rW[2 * m + 1];
        const f32x4* g2 = (const f32x4*)(p.ln2_g + (size_t)l * D) + lane; const f32x4* b2 = (const f32x4*)(p.ln2_b + (size_t)l * D) + lane;
        f32x4 v[DV];
#pragma unroll
        for (int j = 0; j < DV; ++j) v[j] = x1[64 * j] * ALPHA + md[5 * (D / 4) + 64 * j] * (ya[64 * j] * wa + yb[64 * j] * wb);
        float mu, rstd; row_stats(v, mu, rstd);
#pragma unroll
        for (int j = 0; j < DV; ++j) x1[64 * j] = (v[j] - mu) * rstd * g2[64 * j] + b2[64 * j];
    }
}

__device__ __forceinline__ void ph_mod_fast(const Params& p, char* lds) {
    const int tid_ = opq_tid(), bid_ = opq_bid(); (void)tid_; (void)bid_;
    constexpr int NR = NB + 1, NTASK = 2 * (6 * D / 64);
    if (bid_ >= NTASK) return;
    float* sc = (float*)lds;
    float* part = sc + NR * D;
    for (int i = tid_; i < NR * D; i += 256) { const int b = i / D, k = i % D; const float cv = b < NB ? p.c[(size_t)b * D + k] : p.c_ctx[k]; sc[i] = cv / (1.0f + __expf(-cv)); }
    __syncthreads();
    const int lane = tid_ & 63, wid = tid_ >> 6;
    for (int task = bid_; task < NTASK; task += gridDim.x) {
        const int ll = task / (6 * D / 64), col = 64 * (task % (6 * D / 64)) + lane;
        float acc[NR];
#pragma unroll
        for (int b = 0; b < NR; ++b) acc[b] = 0.f;
        const float* wp = p.w_mod + ((size_t)ll * D + wid * (D / 4)) * 6 * D + col;
#pragma unroll 16
        for (int k = 0; k < D / 4; ++k) { const float w = wp[(size_t)k * 6 * D];
#pragma unroll
            for (int b = 0; b < NR; ++b) acc[b] += sc[b * D + wid * (D / 4) + k] * w; }
#pragma unroll
        for (int b = 0; b < NR; ++b) part[(wid * NR + b) * 64 + lane] = acc[b];
        __syncthreads();
        for (int i = tid_; i < NR * 64; i += 256) { const int b = i / 64, cl = i % 64;
            p.mod[((size_t)ll * NR + b) * 6 * D + 64 * (task % (6 * D / 64)) + cl] = (part[(0 * NR + b) * 64 + cl] + part[(1 * NR + b) * 64 + cl]) + (part[(2 * NR + b) * 64 + cl] + part[(3 * NR + b) * 64 + cl]) + p.b_mod[(size_t)ll * 6 * D + 64 * (task % (6 * D / 64)) + cl]; }
        __syncthreads();
    }
}

__device__ __forceinline__ void tr_item(const float* srcl, size_t ldw, bf16_t* dst, size_t ldd, float* scr, int lane) {
#pragma unroll 8
    for (int i = 0; i < 32; ++i) { const int kk = 2 * i + (lane >> 5); scr[kk * 33 + (lane & 31)] = srcl ? srcl[(size_t)kk * ldw] : 0.f; }
    LDS_WAIT();
    const int c = lane & 7;
#pragma unroll
    for (int j = 0; j < 4; ++j) { const int n = (lane >> 3) + 8 * j; const float* s = scr + (8 * c) * 33 + n;
        uint4 o; o.x = pk2(s[0], s[33]); o.y = pk2(s[2 * 33], s[3 * 33]); o.z = pk2(s[4 * 33], s[5 * 33]); o.w = pk2(s[6 * 33], s[7 * 33]);
        *(uint4*)(dst + (size_t)n * ldd + 8 * c) = o; }
    LDS_WAIT();
}
__device__ __forceinline__ void ph_prep_w_fast(const Params& p, int l, int part, char* lds) {
    const int tid_ = opq_tid(), bid_ = opq_bid(); (void)tid_; (void)bid_;
    const int lane = tid_ & 63, wid = tid_ >> 6, gw = bid_ * 4 + wid, nw = gridDim.x * 4;
    float* scr = (float*)(lds + wid * 8448);
    constexpr int I_IN = (D / 64) * (NINP / 32), I_OUT = (DMIX / 64) * (D / 32), I_GU1 = (D / 64) * (2 * DE / 32), I_D1 = (DE / 64) * (D / 32);
    constexpr int NITEMS = I_IN + I_OUT + NEXP * (I_GU1 + I_D1);
    const int it0 = part == 0 ? 0 : I_IN + I_OUT, it1 = part == 0 ? I_IN + I_OUT : NITEMS;
    for (int it = it0 + gw; it < it1; it += nw) {
        int r = it;
        if (r < I_IN) { const int kb = r / (NINP / 32), n0 = 32 * (r % (NINP / 32));
            const float* s = nullptr;
            if (n0 < N_IN) { const int oc = (n0 < ZA) ? n0 + A_IN : n0 - ZA; s = p.w_in + ((size_t)l * D + 64 * kb) * N_IN + oc + (lane & 31); }
            tr_item(s, N_IN, p.win_t + (size_t)n0 * D + 64 * kb, D, scr, lane); continue; }
        r -= I_IN;
        if (r < I_OUT) { const int kb = r / (D / 32), n0 = 32 * (r % (D / 32));
            tr_item(p.w_out + ((size_t)l * DMIX + 64 * kb) * D + n0 + (lane & 31), D, p.wout_t + (size_t)n0 * DMIX + 64 * kb, DMIX, scr, lane); continue; }
        r -= I_OUT;
        const int e = r / (I_GU1 + I_D1); r %= (I_GU1 + I_D1);
        if (r < I_GU1) { const int kb = r / (2 * DE / 32), q = r % (2 * DE / 32);
            const float* s = (((lane & 31) >> 4) ? p.w_up : p.w_gate) + (((size_t)l * NEXP + e) * D + 64 * kb) * DE + 16 * q + (lane & 15);
            tr_item(s, DE, p.wgu_t + ((size_t)e * 2 * DE + 32 * q) * D + 64 * kb, D, scr, lane); continue; }
        r -= I_GU1;
        { const int kb = r / (D / 32), n0 = 32 * (r % (D / 32));
            tr_item(p.w_down + (((size_t)l * NEXP + e) * DE + 64 * kb) * D + n0 + (lane & 31), D, p.wd_t + ((size_t)e * D + n0) * DE + 64 * kb, DE, scr, lane); }
    }
    if (part != 0) return;
    const long gt = (long)bid_ * blockDim.x + tid_, gs = (long)gridDim.x * blockDim.x;
    for (long i = gt; i < 2 * 256 * 64; i += gs) { const int k = (int)(i & 63), n = (int)((i >> 6) & 255), d = (int)(i >> 14);
        p.wupT[i] = f2bf(p.a_w_up[(((size_t)l * 2 + d) * 64 + k) * DA + n]); p.aupT[i] = f2bf(p.a_a_up[(((size_t)l * 2 + d) * 64 + k) * DA + n]); }
    for (long i = gt; i < 256 * 160; i += gs) { const int k = (int)(i % 160), n = (int)(i / 160); p.gupT[i] = f2bf(p.a_g_up[((size_t)l * 160 + k) * DA + n]); }
    for (long i = gt; i < (long)128 * D; i += gs) { const int n = (int)(i / D), k = (int)(i % D);
        const float w = n < 4 ? p.w_rg[((size_t)l * D + k) * 4 + n] : n < 36 ? p.w_re[((size_t)l * D + k) * 32 + n - 4] : 0.f;
        const bf16_t hb = f2bf(w); p.wrt[i] = hb; p.wrt[(size_t)128 * D + i] = f2bf(w - bf2f(hb)); }
}

__device__ __forceinline__ float tanh_fast(float x) { return 1.0f - 2.0f / (1.0f + __expf(2.0f * x)); }
__device__ __forceinline__ void ph_streams_s1(const Params& p, int l) {
    const int tid_ = opq_tid(), bid_ = opq_bid(); (void)tid_; (void)bid_;
    constexpr int NCH = A_IN / 8, NCHP = (NCH + 7) & ~7;
    const float* sh = p.a_shift + (size_t)l * 3 * A_IN;
    for (long it = (long)bid_ * 256 + tid_; it < (long)T * NCHP; it += (long)gridDim.x * 256) {
        const int m = (int)(it / NCHP), ch = (int)(it % NCHP), c0 = 8 * ch;
        const bool act = ch < NCH;
        int t, len;
        if (m < TL) { t = m % S; len = S; } else { t = (m - TL) % L; len = L; }
        float v[8];
#pragma unroll
        for (int e = 0; e < 8; ++e) v[e] = 0.f;
        if (act) {
            const bf16_t* z = p.Z + (size_t)m * ZP + ZA + c0;
            const bf16x8 zc = *(const bf16x8*)z;
            const f32x4 s1a = *(const f32x4*)(sh + A_IN + c0), s1b = *(const f32x4*)(sh + A_IN + c0 + 4);
#pragma unroll
            for (int e = 0; e < 8; ++e) v[e] = (e < 4 ? s1a[e] : s1b[e - 4]) * bf2f((bf16_t)zc[e]);
            if (t > 0) { const bf16x8 zp = *(const bf16x8*)(z - ZP); const f32x4 a = *(const f32x4*)(sh + c0), b = *(const f32x4*)(sh + c0 + 4);
#pragma unroll
                for (int e = 0; e < 8; ++e) v[e] += (e < 4 ? a[e] : b[e - 4]) * bf2f((bf16_t)zp[e]); }
            if (t < len - 1) { const bf16x8 zn = *(const bf16x8*)(z + ZP); const f32x4 a = *(const f32x4*)(sh + 2 * A_IN + c0), b = *(const f32x4*)(sh + 2 * A_IN + c0 + 4);
#pragma unroll
                for (int e = 0; e < 8; ++e) v[e] += (e < 4 ? a[e] : b[e - 4]) * bf2f((bf16_t)zn[e]); }
        }
        float nrm = 0.f;
        if (ch >= 32 && ch < 64) {
#pragma unroll
            for (int e = 0; e < 8; ++e) { const float t2 = v[e] * p.a_k_k[l * DA + c0 - 256 + e]; nrm += t2 * t2; } }
        nrm = sum8(nrm);
        if (!act) continue;
        if (c0 < 768) {
            float* dst = (c0 < 256 ? p.sR + (size_t)m * DA + c0 : c0 < 512 ? p.kT + (size_t)m * DA + c0 - 256 : p.sV + (size_t)m * DA + c0 - 512);
            *(f32x4*)dst = (f32x4){v[0], v[1], v[2], v[3]}; *(f32x4*)(dst + 4) = (f32x4){v[4], v[5], v[6], v[7]};
            if (ch >= 32 && ch < 64 && (ch & 7) == 0) p.kN[(size_t)m * 4 + ((ch - 32) >> 3)] = 1.0f / sqrtf(nrm + 1e-12f);
        } else {
            if (c0 < 896) {
#pragma unroll
                for (int e = 0; e < 8; ++e) v[e] = tanh_fast(v[e]); }
            else if (c0 >= 1024) {
#pragma unroll
                for (int e = 0; e < 8; ++e) v[e] = 1.0f / (1.0f + __expf(-v[e])); }
            uint4 o; o.x = pk2(v[0], v[1]); o.y = pk2(v[2], v[3]); o.z = pk2(v[4], v[5]); o.w = pk2(v[6], v[7]);
            *(uint4*)(p.LA + (size_t)m * 416 + c0 - 768) = o;
        }
    }
}
__device__ __forceinline__ void g_streams_s2(const Params& p, int l, char* lds) {
    const int tid_ = opq_tid(), bid_ = opq_bid(); (void)tid_; (void)bid_;
    constexpr int MT = T / 128;
    for (int job = bid_; job < 5 * MT * 2; job += gridDim.x) {
        const int type = job / (MT * 2), r = job % (MT * 2), tm = r >> 1, tn = r & 1;
        const int coff = type < 2 ? type * 64 : type < 4 ? 128 + (type - 2) * 64 : 256, K = type < 4 ? 64 : 160, d = type & 1;
        const bf16_t* Bt = type < 2 ? p.wupT + type * 256 * 64 : type < 4 ? p.aupT + (type - 2) * 256 * 64 : p.gupT;
        const bf16_t* a0 = p.LA + (size_t)(tm * 128 + STG_ROW(0)) * 416 + coff + STG_K; const bf16_t* a1 = p.LA + (size_t)(tm * 128 + STG_ROW(1)) * 416 + coff + STG_K;
        const bf16_t* b0 = Bt + (size_t)(tn * 128 + STG_ROW(0)) * K + STG_K; const bf16_t* b1 = Bt + (size_t)(tn * 128 + STG_ROW(1)) * K + STG_K;
        if (type < 2) gemm_tile(a0, a1, b0, b1, K, lds, [&](const f32x4 (&acc)[4][4], int wr, int wc, int fr, int fq) {
#pragma unroll
            for (int mi = 0; mi < 4; ++mi) {
#pragma unroll
                for (int n = 0; n < 4; ++n) { const int c = tn * 128 + wc * 64 + n * 16 + fr; const float w0 = p.a_w0[(l * 2 + d) * DA + c];
#pragma unroll
                    for (int j = 0; j < 4; ++j) { const int row = tm * 128 + wr * 64 + mi * 16 + fq * 4 + j;
                        const float e = __expf(-(w0 + acc[mi][n][j]));
                        p.sW[((size_t)d * T + row) * DA + c] = __expf(-0.60653065971f / (1.0f + e)); } }
                asm volatile("" ::: "memory"); }
        });
        else if (type < 4) gemm_tile(a0, a1, b0, b1, K, lds, [&](const f32x4 (&acc)[4][4], int wr, int wc, int fr, int fq) {
#pragma unroll
            for (int mi = 0; mi < 4; ++mi) {
#pragma unroll
                for (int n = 0; n < 4; ++n) { const int c = tn * 128 + wc * 64 + n * 16 + fr;
                    const float a0v = p.a_a0[(l * 2 + d) * DA + c], kkc = p.a_k_k[l * DA + c], kac = p.a_k_a[l * DA + c];
#pragma unroll
                    for (int j = 0; j < 4; ++j) { const int row = tm * 128 + wr * 64 + mi * 16 + fq * 4 + j;
                        const size_t o = (size_t)row * DA + c, od = ((size_t)d * T + row) * DA + c;
                        const float av = 1.0f / (1.0f + __expf(-(a0v + acc[mi][n][j]))); const float k = p.kT[o];
                        const float kk = k * kkc * p.kN[(size_t)row * 4 + (c >> 6)];
                        p.sKD[od] = k * (1.0f + (av - 1.0f) * kac); p.sB[od] = kk * av; if (d == 0) p.sKK[o] = kk; } }
                asm volatile("" ::: "memory"); }
        });
        else gemm_tile(a0, a1, b0, b1, K, lds, [&](const f32x4 (&acc)[4][4], int wr, int wc, int fr, int fq) {
#pragma unroll
            for (int mi = 0; mi < 4; ++mi)
#pragma unroll
                for (int n = 0; n < 4; ++n) { const int c = tn * 128 + wc * 64 + n * 16 + fr;
#pragma unroll
                    for (int j = 0; j < 4; ++j) p.sG[(size_t)(tm * 128 + wr * 64 + mi * 16 + fq * 4 + j) * DA + c] = acc[mi][n][j]; }
        });
    }
}


typedef float f32x16 __attribute__((ext_vector_type(16)));
typedef short s16x4 __attribute__((ext_vector_type(4)));
typedef unsigned u32x4_t __attribute__((ext_vector_type(4)));
typedef float f32x2_t __attribute__((ext_vector_type(2)));
typedef __bf16 bf16x2_t __attribute__((ext_vector_type(2)));
__device__ __forceinline__ unsigned cvtpk(float lo, float hi) { f32x2_t v = {lo, hi}; bf16x2_t b = __builtin_convertvector(v, bf16x2_t); return __builtin_bit_cast(unsigned, b); }
__device__ __forceinline__ int crow(int r, int hi) { return (r & 3) + 8 * (r >> 2) + 4 * hi; }

template <class MaskF>
__device__ __forceinline__ void attn_tile(const bf16x8 (&qf)[4], const bf16_t* krow, const bf16_t* vt0, const bf16_t* vt1, const MaskF& mask,
                                          float& m_run, float& l_run, f32x16& o0, f32x16& o1, int hi) {
    f32x16 s;
#pragma unroll
    for (int r = 0; r < 16; ++r) s[r] = 0.f;
#pragma unroll
    for (int ks = 0; ks < 4; ++ks) { const bf16x8 kf = *(const bf16x8*)(krow + 16 * ks); s = __builtin_amdgcn_mfma_f32_32x32x16_bf16(kf, qf[ks], s, 0, 0, 0); }
    float mx = -INFINITY;
#pragma unroll
    for (int r = 0; r < 16; ++r) { s[r] = mask(crow(r, hi), s[r] * ATT_SCALE); mx = fmaxf(mx, s[r]); }
    mx = fmaxf(mx, __shfl_xor(mx, 32));
    const float mn = fmaxf(m_run, mx), alpha = __expf(m_run - mn);
    m_run = mn;
    float ps = 0.f;
#pragma unroll
    for (int r = 0; r < 16; ++r) { s[r] = __expf(s[r] - mn); ps += s[r]; }
    l_run = l_run * alpha + ps;
#pragma unroll
    for (int r = 0; r < 16; ++r) { o0[r] *= alpha; o1[r] *= alpha; }
#pragma unroll
    for (int s2 = 0; s2 < 2; ++s2) {
        u32x4_t pw; pw[0] = cvtpk(s[8 * s2], s[8 * s2 + 1]); pw[1] = cvtpk(s[8 * s2 + 2], s[8 * s2 + 3]); pw[2] = cvtpk(s[8 * s2 + 4], s[8 * s2 + 5]); pw[3] = cvtpk(s[8 * s2 + 6], s[8 * s2 + 7]);
        const bf16x8 pb = __builtin_bit_cast(bf16x8, pw);
        const s16x4 a0 = *(const s16x4*)(vt0 + 16 * s2), a1 = *(const s16x4*)(vt0 + 16 * s2 + 8);
        const s16x4 c0 = *(const s16x4*)(vt1 + 16 * s2), c1 = *(const s16x4*)(vt1 + 16 * s2 + 8);
        o0 = __builtin_amdgcn_mfma_f32_32x32x16_bf16(__builtin_shufflevector(a0, a1, 0, 1, 2, 3, 4, 5, 6, 7), pb, o0, 0, 0, 0);
        o1 = __builtin_amdgcn_mfma_f32_32x32x16_bf16(__builtin_shufflevector(c0, c1, 0, 1, 2, 3, 4, 5, 6, 7), pb, o1, 0, 0, 0);
    }
}
struct NoMask { __device__ __forceinline__ float operator()(int, float v) const { return v; } };

__device__ __forceinline__ void ph_attn_mfma(const Params& p, int l, bool with_ctx) {
    const int tid_ = opq_tid(), bid_ = opq_bid(); (void)tid_; (void)bid_;
    const int lane = tid_ & 63, hi = lane >> 5, ql = lane & 31;
    const int gw = bid_ * 4 + (tid_ >> 6), nw = gridDim.x * 4;
    constexpr int NQT = S / 32, NCT = L / 32, N_LAT = NB * 6 * NQT, N_CTX = NB * 6 * NCT;
    const int ntask = 2 * N_LAT + (with_ctx ? 2 * N_CTX : 0);
    for (int task = gw; task < ntask; task += nw) {
        bool isC, isCtx; int r;
        if (task < N_LAT) { isC = true; isCtx = false; r = task; }
        else if (task < 2 * N_LAT) { isC = false; isCtx = false; r = task - N_LAT; }
        else { r = task - 2 * N_LAT; isCtx = true; isC = r >= N_CTX; if (isC) r -= N_CTX; }
        const int nqt = isCtx ? NCT : NQT, qt = r % nqt, h = (r / nqt) % 6, b = r / (nqt * 6);
        const int m = isCtx ? TL + b * L + 32 * qt + ql : b * S + 32 * qt + ql;
        const int qcol = isC ? ZQN + h * 64 : ZQB + h * 64, kcol = isC ? ZKN + h * 64 : ZKB + (h / 3) * 64, hv = isC ? 2 + h : h / 3;
        bf16x8 qf[4];
        { const bf16_t* qp = p.Z + (size_t)m * ZP + qcol + 8 * hi;
#pragma unroll
          for (int ks = 0; ks < 4; ++ks) qf[ks] = *(const bf16x8*)(qp + 16 * ks); }
        const bf16_t* kc0 = p.Z + (size_t)(TL + b * L + ql) * ZP + kcol + 8 * hi;
        const bf16_t* kl0 = p.Z + (size_t)(b * S + ql) * ZP + kcol + 8 * hi;
        const bf16_t* vt0 = p.VT + ((size_t)(b * 8 + hv) * 64 + ql) * PU + 4 * hi; const bf16_t* vt1 = vt0 + (size_t)32 * PU;
        f32x16 o0, o1;
#pragma unroll
        for (int rr = 0; rr < 16; ++rr) { o0[rr] = 0.f; o1[rr] = 0.f; }
        float m_run, l_run;
        if (isC) { m_run = -1e30f; l_run = 0.f; } else { m_run = p.b_sink[l * 6 + h]; l_run = hi == 0 ? 1.0f : 0.f; }
#pragma unroll 1
        for (int i = 0; i < NCT; ++i) attn_tile(qf, kc0 + (size_t)(32 * i) * ZP, vt0 + 32 * i, vt1 + 32 * i, NoMask(), m_run, l_run, o0, o1, hi);
        if (!isCtx) {
            if (!isC) {
#pragma unroll 1
                for (int jt = qt - 4; jt <= qt + 4; ++jt) {
                    if (jt < 0 || jt >= NQT) continue;
                    const bf16_t* kr = kl0 + (size_t)(32 * jt) * ZP; const bf16_t* v0 = vt0 + L + 32 * jt; const bf16_t* v1 = vt1 + L + 32 * jt;
                    if (jt == qt - 4 || jt == qt + 4) { const int base = 32 * (jt - qt) - ql;
                        attn_tile(qf, kr, v0, v1, [&](int ko, float v) { const int rel = base + ko; return (rel >= -128 && rel <= 128) ? v : -INFINITY; }, m_run, l_run, o0, o1, hi); }
                    else attn_tile(qf, kr, v0, v1, NoMask(), m_run, l_run, o0, o1, hi);
                }
            } else {
                constexpr int ROWS = S / GRID_W;
                const int gr = qt >> 1, c = 32 * (qt & 1) + ql;
                int r0 = gr - 4; r0 = r0 < 0 ? 0 : (r0 > ROWS - 8 ? ROWS - 8 : r0);
                int c0 = c - 8; c0 = c0 < 0 ? 0 : (c0 > GRID_W - 16 ? GRID_W - 16 : c0);
                const float* rpb = p.c_rpb + ((size_t)l * 6 + h) * 15 * 31;
#pragma unroll 1
                for (int a = 0; a < 8; ++a) {
                    const int kr_ = r0 + a; const float* rp = rpb + (kr_ - gr + 7) * 31 + 15 - c;
#pragma unroll 1
                    for (int ct = 0; ct < 2; ++ct) {
                        const int t0 = kr_ * GRID_W + 32 * ct;
                        attn_tile(qf, kl0 + (size_t)t0 * ZP, vt0 + L + t0, vt1 + L + t0,
                                  [&](int ko, float v) { const int kc = 32 * ct + ko; return (kc >= c0 && kc < c0 + 16) ? v + rp[kc] : -INFINITY; }, m_run, l_run, o0, o1, hi);
                    }
                }
            }
        }
        const float lt = l_run + __shfl_xor(l_run, 32), inv = 1.0f / lt;
        bf16_t* op = p.MIX + (size_t)m * DMIX + (isC ? 640 : 256) + h * 64 + 4 * hi;
#pragma unroll
        for (int g = 0; g < 4; ++g) {
            st_bf16x4(op + 8 * g, (f32x4){o0[4 * g] * inv, o0[4 * g + 1] * inv, o0[4 * g + 2] * inv, o0[4 * g + 3] * inv});
            st_bf16x4(op + 32 + 8 * g, (f32x4){o1[4 * g] * inv, o1[4 * g + 1] * inv, o1[4 * g + 2] * inv, o1[4 * g + 3] * inv});
        }
    }
}


#define RNB " row_newbcast:%c[n] row_mask:0xf bank_mask:0xf\n\t"
template <int N, bool FIRST>
__device__ __forceinline__ void dpp_dot4(float& a0, float& a1, float& a2, float& a3, const f32x4& v, float s0, float s1, float s2, float s3) {
    if (FIRST) asm volatile("s_nop 1");
    asm("v_fmac_f32_dpp %0, %4, %8" RNB "v_fmac_f32_dpp %1, %5, %9" RNB "v_fmac_f32_dpp %2, %6, %10" RNB "v_fmac_f32_dpp %3, %7, %11" RNB
        : "+v"(a0), "+v"(a1), "+v"(a2), "+v"(a3) : "v"(v[0]), "v"(v[1]), "v"(v[2]), "v"(v[3]), "v"(s0), "v"(s1), "v"(s2), "v"(s3), [n] "i"(N));
}
template <int N, bool FIRST>
__device__ __forceinline__ void dpp_upd4s(float& s0, float& s1, float& s2, float& s3, float& y0, float& y1, float& y2, float& y3,
                                          const f32x4& w, const f32x4& b, const f32x4& kd, const f32x4& r, float nsk, float vv) {
    if (FIRST) asm volatile("s_nop 1");
    asm("v_mul_f32_dpp %0, %8, %0" RNB "v_mul_f32_dpp %1, %9, %1" RNB "v_mul_f32_dpp %2, %10, %2" RNB "v_mul_f32_dpp %3, %11, %3" RNB
        "v_fmac_f32_dpp %0, %12, %24" RNB "v_fmac_f32_dpp %1, %13, %24" RNB "v_fmac_f32_dpp %2, %14, %24" RNB "v_fmac_f32_dpp %3, %15, %24" RNB
        "v_fmac_f32_dpp %0, %16, %25" RNB "v_fmac_f32_dpp %1, %17, %25" RNB "v_fmac_f32_dpp %2, %18, %25" RNB "v_fmac_f32_dpp %3, %19, %25" RNB
        "v_fmac_f32_dpp %4, %20, %0" RNB "v_fmac_f32_dpp %5, %21, %1" RNB "v_fmac_f32_dpp %6, %22, %2" RNB "v_fmac_f32_dpp %7, %23, %3" RNB
        : "+v"(s0), "+v"(s1), "+v"(s2), "+v"(s3), "+v"(y0), "+v"(y1), "+v"(y2), "+v"(y3)
        : "v"(w[0]), "v"(w[1]), "v"(w[2]), "v"(w[3]), "v"(b[0]), "v"(b[1]), "v"(b[2]), "v"(b[3]), "v"(kd[0]), "v"(kd[1]), "v"(kd[2]), "v"(kd[3]),
          "v"(r[0]), "v"(r[1]), "v"(r[2]), "v"(r[3]), "v"(nsk), "v"(vv), [n] "i"(N));
}
template <int N, bool FIRST>
__device__ __forceinline__ void dpp_upd4p(float& s0, float& s1, float& s2, float& s3, float& y0, float& y1, float& y2, float& y3,
                                          const f32x4& w, const f32x4& b, const f32x4& r, float nsk) {
    if (FIRST) asm volatile("s_nop 1");
    asm("v_mul_f32_dpp %0, %8, %0" RNB "v_mul_f32_dpp %1, %9, %1" RNB "v_mul_f32_dpp %2, %10, %2" RNB "v_mul_f32_dpp %3, %11, %3" RNB
        "v_fmac_f32_dpp %0, %12, %20" RNB "v_fmac_f32_dpp %1, %13, %20" RNB "v_fmac_f32_dpp %2, %14, %20" RNB "v_fmac_f32_dpp %3, %15, %20" RNB
        "v_fmac_f32_dpp %4, %16, %0" RNB "v_fmac_f32_dpp %5, %17, %1" RNB "v_fmac_f32_dpp %6, %18, %2" RNB "v_fmac_f32_dpp %7, %19, %3" RNB
        : "+v"(s0), "+v"(s1), "+v"(s2), "+v"(s3), "+v"(y0), "+v"(y1), "+v"(y2), "+v"(y3)
        : "v"(w[0]), "v"(w[1]), "v"(w[2]), "v"(w[3]), "v"(b[0]), "v"(b[1]), "v"(b[2]), "v"(b[3]), "v"(r[0]), "v"(r[1]), "v"(r[2]), "v"(r[3]), "v"(nsk), [n] "i"(N));
}
template <int N> struct ScanRep {
    static __device__ __forceinline__ void dot(float& a0, float& a1, float& a2, float& a3, const f32x4& v, const float (&st)[64]) {
        dpp_dot4<N, N == 0>(a0, a1, a2, a3, v, st[4 * N], st[4 * N + 1], st[4 * N + 2], st[4 * N + 3]);
        if constexpr (N < 15) ScanRep<N + 1>::dot(a0, a1, a2, a3, v, st);
    }
    static __device__ __forceinline__ void upds(float (&st)[64], float& y0, float& y1, float& y2, float& y3, const f32x4& w, const f32x4& b, const f32x4& kd, const f32x4& r, float nsk, float vv) {
        dpp_upd4s<N, N == 0>(st[4 * N], st[4 * N + 1], st[4 * N + 2], st[4 * N + 3], y0, y1, y2, y3, w, b, kd, r, nsk, vv);
        if constexpr (N < 15) ScanRep<N + 1>::upds(st, y0, y1, y2, y3, w, b, kd, r, nsk, vv);
    }
    static __device__ __forceinline__ void updp(float (&st)[64], float& y0, float& y1, float& y2, float& y3, const f32x4& w, const f32x4& b, const f32x4& r, float nsk) {
        dpp_upd4p<N, N == 0>(st[4 * N], st[4 * N + 1], st[4 * N + 2], st[4 * N + 3], y0, y1, y2, y3, w, b, r, nsk);
        if constexpr (N < 15) ScanRep<N + 1>::updp(st, y0, y1, y2, y3, w, b, r, nsk);
    }
};
__device__ __forceinline__ int seg_row0(int b, int d, int s) { const int pos0 = 128 * s; return pos0 < L ? TL + b * L + (d ? L - 1 - pos0 : pos0) : b * S + (d ? S - 1 - (pos0 - L) : pos0 - L); }

template <bool ISP>
__device__ __forceinline__ void scan_task(const Params& p, int c, int s, int lane) {
    const int h = c & 3, b = (c >> 2) % NB, d = (c >> 2) / NB;
    const int m0 = seg_row0(b, d, s); const long step = d ? -(long)DA : (long)DA;
    const size_t o = (size_t)m0 * DA + h * 64, od = ((size_t)d * T + m0) * DA + h * 64; const int q = 4 * (lane & 15);
    const float* pkk = p.sKK + o + q; const float* pr = p.sR + o + q; const float* pw = p.sW + od + q; const float* pb = p.sB + od + q;
    const float* pkd = p.sKD + od + q; const float* pv = p.sV + o + lane;
    float* py = (ISP ? p.PV : p.Y) + od + lane;
    float st[64];
#pragma unroll
    for (int k = 0; k < 64; ++k) st[k] = (ISP && k == lane) ? 1.0f : 0.f;
    f32x4 kk = *(const f32x4*)pkk, w = *(const f32x4*)pw, bb = *(const f32x4*)pb, r = *(const f32x4*)pr, kd = w; float vv = 0.f;
    if (!ISP) { kd = *(const f32x4*)pkd; vv = *pv; }
#pragma unroll 1
    for (int i = 0; i < 128; ++i) {
        const long nx = (i < 127) ? step : 0;
        pkk += nx; pw += nx; pb += nx; pr += nx; pkd += nx; pv += nx;
        const f32x4 nkk = *(const f32x4*)pkk, nw = *(const f32x4*)pw, nb = *(const f32x4*)pb, nr = *(const f32x4*)pr;
        f32x4 nkd = nw; float nv = 0.f;
        if (!ISP) { nkd = *(const f32x4*)pkd; nv = *pv; }
        float a0 = 0.f, a1 = 0.f, a2 = 0.f, a3 = 0.f;
        ScanRep<0>::dot(a0, a1, a2, a3, kk, st);
        const float nsk = -((a0 + a1) + (a2 + a3));
        float y0 = 0.f, y1 = 0.f, y2 = 0.f, y3 = 0.f;
        if (ISP) ScanRep<0>::updp(st, y0, y1, y2, y3, w, bb, r, nsk); else ScanRep<0>::upds(st, y0, y1, y2, y3, w, bb, kd, r, nsk, vv);
        *py = (y0 + y1) + (y2 + y3); py += step;
        kk = nkk; w = nw; bb = nb; r = nr; kd = nkd; vv = nv;
    }
    if (s < NSG - 1) {
        float* dst = (ISP ? p.PS : p.QS) + (((size_t)c * NSG + s) * 64 + lane) * 64;
#pragma unroll
        for (int k4 = 0; k4 < 16; ++k4) *(f32x4*)(dst + 4 * k4) = (f32x4){st[4 * k4], st[4 * k4 + 1], st[4 * k4 + 2], st[4 * k4 + 3]};
    }
}
__device__ __forceinline__ void ph_scan_fast(const Params& p) {
    const int tid_ = opq_tid(), bid_ = opq_bid(); (void)tid_; (void)bid_;
    const int lane = tid_ & 63, gw = bid_ * 4 + (tid_ >> 6), nw = gridDim.x * 4;
    constexpr int NS_T = 64 * NSG, NP_T = 64 * (NSG - 1);
    for (int tsk = gw; tsk < NS_T + NP_T; tsk += nw) {
        const int t2 = __builtin_amdgcn_readfirstlane(tsk);
        if (t2 < NS_T) scan_task<false>(p, t2 & 63, t2 >> 6, lane);
        else scan_task<true>(p, (t2 - NS_T) & 63, 1 + ((t2 - NS_T) >> 6), lane);
    }
}
__device__ __forceinline__ void ph_combine(const Params& p, char* lds) {
    const int tid_ = opq_tid(), bid_ = opq_bid(); (void)tid_; (void)bid_;
    if (bid_ >= 64) return;
    const int c = bid_, tid = tid_, v = tid >> 2, jq = tid & 3;
    float* SSc = (float*)lds; float* Pm = (float*)(lds + 64 * 65 * 4 + 16);
    const float* QSc = p.QS + (size_t)c * NSG * 4096; const float* PSc = p.PS + (size_t)c * NSG * 4096; float* SSg = p.SS + (size_t)c * NSG * 4096;
    f32x4 acc[4], nP[4], nQ[4];
#pragma unroll
    for (int i = 0; i < 4; ++i) { acc[i] = *(const f32x4*)(QSc + v * 64 + 16 * jq + 4 * i);
#pragma unroll
        for (int e = 0; e < 4; ++e) { SSg[4096 + (16 * jq + 4 * i + e) * 64 + v] = acc[i][e]; SSc[v * 65 + 16 * jq + 4 * i + e] = acc[i][e]; } }
#pragma unroll
    for (int i = 0; i < 4; ++i) { nP[i] = ((const f32x4*)(PSc + (size_t)4096))[tid + 256 * i]; nQ[i] = *(const f32x4*)(QSc + (size_t)4096 + v * 64 + 16 * jq + 4 * i); }
    for (int s = 1; s < NSG - 1; ++s) {
#pragma unroll
        for (int i = 0; i < 4; ++i) { ((f32x4*)Pm)[tid + 256 * i] = nP[i]; acc[i] = nQ[i]; }
        __syncthreads();
        if (s + 1 < NSG - 1) {
#pragma unroll
            for (int i = 0; i < 4; ++i) { nP[i] = ((const f32x4*)(PSc + (size_t)(s + 1) * 4096))[tid + 256 * i]; nQ[i] = *(const f32x4*)(QSc + (size_t)(s + 1) * 4096 + v * 64 + 16 * jq + 4 * i); }
        }
#pragma unroll 8
        for (int k = 0; k < 64; ++k) { const float a = SSc[v * 65 + k];
#pragma unroll
            for (int i = 0; i < 4; ++i) acc[i] += ((const f32x4*)Pm)[k * 16 + 4 * jq + i] * a; }
        __syncthreads();
#pragma unroll
        for (int i = 0; i < 4; ++i) {
#pragma unroll
            for (int e = 0; e < 4; ++e) { SSg[(size_t)(s + 1) * 4096 + (16 * jq + 4 * i + e) * 64 + v] = acc[i][e]; SSc[v * 65 + 16 * jq + 4 * i + e] = acc[i][e]; } }
    }
}
__device__ __forceinline__ void ph_rwkv_out_fast(const Params& p, int l, bool with_ctx) {
    const int tid_ = opq_tid(), bid_ = opq_bid(); (void)tid_; (void)bid_;
    const int lane = tid_ & 63, gw = bid_ * 4 + (tid_ >> 6), nw = gridDim.x * 4;
    constexpr int TOK = 16, NLT = NB * (S / TOK) * 4, NCTK = NB * (L / TOK) * 4;
    const int ntask = NLT + (with_ctx ? NCTK : 0);
    for (int tsk = gw; tsk < ntask; tsk += nw) {
        const bool isCtx = tsk >= NLT; const int r = isCtx ? tsk - NLT : tsk;
        const int h = r & 3, npt = isCtx ? L / TOK : S / TOK, tt = (r >> 2) % npt, b = (r >> 2) / npt, t128 = tt / (128 / TOK);
        const int seg0 = isCtx ? t128 : L / 128 + t128, seg1 = isCtx ? (L / 128 - 1) - t128 : L / 128 + (S / 128 - 1) - t128;
        const int mbase = isCtx ? TL + b * L + TOK * tt : b * S + TOK * tt;
        float ss0[64], ss1[64];
        { const float* s0p = p.SS + (((size_t)(0 * NB + b) * 4 + h) * NSG + seg0) * 4096 + lane; const float* s1p = p.SS + (((size_t)(1 * NB + b) * 4 + h) * NSG + seg1) * 4096 + lane;
#pragma unroll
          for (int k = 0; k < 64; ++k) { ss0[k] = seg0 > 0 ? s0p[k * 64] : 0.f; ss1[k] = seg1 > 0 ? s1p[k * 64] : 0.f; } }
        const float rk = p.a_r_k[l * DA + h * 64 + lane], gln = p.a_lnx_g[l * DA + h * 64 + lane], bln = p.a_lnx_b[l * DA + h * 64 + lane];
        f32x4 pv0 = {0.f, 0.f, 0.f, 0.f}, pv1 = pv0; float y0l, y1l, rr, kds, vv, gg;
#define ROUT_LOAD(i_) do { const size_t o_ = (size_t)(mbase + (i_)) * DA + h * 64, o1_ = o_ + (size_t)T * DA; \
            if (seg0 > 0) pv0 = *(const f32x4*)(p.PV + o_ + 4 * (lane & 15)); if (seg1 > 0) pv1 = *(const f32x4*)(p.PV + o1_ + 4 * (lane & 15)); \
            y0l = p.Y[o_ + lane]; y1l = p.Y[o1_ + lane]; rr = p.sR[o_ + lane]; kds = p.sKD[o_ + lane] + p.sKD[o1_ + lane]; vv = p.sV[o_ + lane]; gg = p.sG[o_ + lane]; } while (0)
        ROUT_LOAD(0);
#pragma unroll 1
        for (int i = 0; i < TOK; ++i) {
            const f32x4 cpv0 = pv0, cpv1 = pv1; float a0 = y0l, a1 = y1l, a2 = 0.f, a3 = 0.f; const float crr = rr, ckds = kds, cvv = vv, cgg = gg;
            ROUT_LOAD(i + 1 < TOK ? i + 1 : i);
            ScanRep<0>::dot(a0, a1, a2, a3, cpv0, ss0);
            ScanRep<0>::dot(a0, a1, a2, a3, cpv1, ss1);
            const float y = (a0 + a1) + (a2 + a3);
            const float mu = wave_sum(y) * (1.0f / 64.f), dy = y - mu;
            const float rstd = 1.0f / sqrtf(wave_sum(dy * dy) * (1.0f / 64.f) + GN_EPS);
            const float bon = wave_sum(crr * ckds * rk);
            p.MIX[(size_t)(mbase + i) * DMIX + h * 64 + lane] = f2bf((dy * rstd * gln + bln + bon * cvv) * cgg);
        }
#undef ROUT_LOAD
    }
}


#define LAS __attribute__((address_space(3)))
#define XB_TMO      128
#define XB_XCNT(j)  (256  + 64 * (j))
#define XB_XSUB(j)  (1280 + 64 * (j))
#define XB_XGEN(j)  (2304 + 64 * (j))
#define XB_TOP      3328
#define XB_TOPGEN   3392
#define XCD_BAR_WORDS 3456
#define XB_SPIN_CAP (1u << 20)
static_assert(XCD_BAR_WORDS * 4 <= 16384, "barrier words fit the control region");
__device__ __forceinline__ unsigned xb_ld(unsigned* p)              { return __hip_atomic_load(p, __ATOMIC_RELAXED, __HIP_MEMORY_SCOPE_AGENT); }
__device__ __forceinline__ unsigned xb_add(unsigned* p, unsigned v) { return __hip_atomic_fetch_add(p, v, __ATOMIC_RELAXED, __HIP_MEMORY_SCOPE_AGENT); }
__device__ __forceinline__ unsigned xb_xcc_id() { return (unsigned)__builtin_amdgcn_s_getreg((3 << 11) | 20) & 0xFu; }
#define XB_SPIN(cond, bar) do { unsigned _sp = 0; while (cond) { __builtin_amdgcn_s_sleep(1); \
    if ((++_sp & 255u) == 0u) { if (xb_ld(&(bar)[XB_TMO])) break; if (_sp > XB_SPIN_CAP) { atomicAdd(&(bar)[XB_TMO], 1u); break; } } } } while (0)
struct XcdBarrier { unsigned* bar; unsigned x; volatile LAS unsigned* st; };
__device__ __forceinline__ XcdBarrier xcd_barrier_post(unsigned* bar, volatile LAS unsigned* st) {
    XcdBarrier b; b.bar = bar; b.x = xb_xcc_id(); b.st = st;
    if (threadIdx.x == 0) (void)xb_add(&bar[XB_XCNT(b.x)], 1u);
    return b;
}
__device__ __forceinline__ void xcd_barrier_complete(unsigned* bar, unsigned x, unsigned& nloc, unsigned& nx) {
    const unsigned G = gridDim.x * gridDim.y * gridDim.z;
    unsigned sum, cnt, mine, sp = 0u;
    for (;;) {
        sum = 0u; cnt = 0u; mine = 0u;
#pragma unroll
        for (unsigned j = 0; j < 16; ++j) { const unsigned c = xb_ld(&bar[XB_XCNT(j)]); sum += c; cnt += (c > 0u) ? 1u : 0u; mine = (j == x) ? c : mine; }
        if (sum == G) break;
        __builtin_amdgcn_s_sleep(1);
        if ((++sp & 255u) == 0u) { if (xb_ld(&bar[XB_TMO])) break; if (sp > XB_SPIN_CAP) { atomicAdd(&bar[XB_TMO], 1u); break; } }
    }
    nloc = mine > 0u ? mine : 1u; nx = cnt > 0u ? cnt : 1u;
}
__device__ __forceinline__ void xcd_barrier(const XcdBarrier& b) {
    asm volatile("s_waitcnt vmcnt(0)" ::: "memory");
    __syncthreads();
    if (threadIdx.x == 0) {
        unsigned* bar = b.bar;
        __builtin_amdgcn_s_waitcnt(0);
        unsigned nloc = b.st[0], nx = b.st[1];
        if (nloc == 0u) { xcd_barrier_complete(bar, b.x, nloc, nx); b.st[0] = nloc; b.st[1] = nx; }
        const unsigned old = xb_add(&bar[XB_XSUB(b.x)], 1u);
        const unsigned gen = old / nloc;
        if (old + 1u == (gen + 1u) * nloc) {
            __builtin_amdgcn_fence(__ATOMIC_RELEASE, "agent");
            asm volatile("s_waitcnt vmcnt(0)" ::: "memory");
            const unsigned og = xb_add(&bar[XB_TOP], 1u);
            const unsigned tg = og / nx;
            if (og + 1u == (tg + 1u) * nx) xb_add(&bar[XB_TOPGEN], 1u);
            else XB_SPIN(xb_ld(&bar[XB_TOPGEN]) == tg, bar);
            __builtin_amdgcn_fence(__ATOMIC_ACQUIRE, "agent");
            xb_add(&bar[XB_XGEN(b.x)], 1u);
            asm volatile("s_waitcnt vmcnt(0)" ::: "memory");
        } else {
            XB_SPIN(xb_ld(&bar[XB_XGEN(b.x)]) == gen, bar);
            __builtin_amdgcn_fence(__ATOMIC_ACQUIRE, "agent");
            asm volatile("s_waitcnt vmcnt(0)" ::: "memory");
        }
    }
    __syncthreads();
}

#define GT ((long)blockIdx.x * blockDim.x + threadIdx.x)
#define GS ((long)gridDim.x * blockDim.x)
__global__ void __launch_bounds__(256, 2) mega_fwd(Params p) {
    __shared__ __attribute__((aligned(16))) char lds[65536 + 64];
    cg::grid_group grid = cg::this_grid();
    const long gt = GT, gs = GS;
    volatile LAS unsigned* bst = (volatile LAS unsigned*)(LAS char*)(lds + 65536);
    if (threadIdx.x < 2) bst[threadIdx.x] = 0u;
    __syncthreads();
    const XcdBarrier xb = xcd_barrier_post(p.bar, bst);
#ifndef PROBE_PHASE
#define PROBE_PHASE -1
#endif
#define PROBE_AMP 8
    unsigned long long t_prev = 0; int nts = 0;
#define STAMP() do { if (PROBE_PHASE >= 0 && blockIdx.x == 0 && threadIdx.x == 0) { const unsigned long long t_now = __builtin_amdgcn_s_memrealtime(); \
        if (nts == PROBE_PHASE + 1) { const unsigned long long t_end = t_now + PROBE_AMP * (t_now - t_prev); while (__builtin_amdgcn_s_memrealtime() < t_end) __builtin_amdgcn_s_sleep(8); } \
        t_prev = __builtin_amdgcn_s_memrealtime(); } ++nts; } while (0)
#define GSYNC() do { xcd_barrier(xb); STAMP(); } while (0)
    STAMP();
    ph_mod_fast(p, lds); ph_prep_w_fast(p, 0, 0, lds); ph_prep_misc(p, 0, gt, gs, false);
    grid.sync(); STAMP();
    for (int l = 0; l < 2; ++l) {
        const int nrows = (l == 0) ? T : TL;
        ph_lnmod_fast(p, l);
        GSYNC();
        g_gemm_in(p, lds);
        GSYNC();
        ph_streams_s1(p, l);
        GSYNC();
        g_streams_s2(p, l, lds);
        GSYNC();
        ph_scan_fast(p);
        GSYNC();
        ph_combine(p, lds); ph_attn_mfma(p, l, l == 0);
        GSYNC();
        ph_rwkv_out_fast(p, l, l == 0);
        GSYNC();
        g_gemm_out(p, nrows, lds); ph_prep_w_fast(p, l, 1, lds);
        GSYNC();
        ph_post_mixer_fast(p, l, nrows);
        GSYNC();
        g_router(p, l, nrows, lds);
        GSYNC();
        ph_dispatch_fast(p, l, nrows, lds);
        GSYNC();
        g_moe1(p, l, lds);
        GSYNC();
        g_moe2(p, l, lds);
        GSYNC();
        ph_final_fast(p, l, nrows);
        if (l == 0) { ph_prep_w_fast(p, 1, 0, lds); ph_prep_misc(p, 1, gt, gs, false); }
        GSYNC();
    }}

extern "C" void kernel_launch(void* const* d_in, const int* in_sizes, int n_in, void* d_out, int out_size, void* d_ws, size_t ws_size, hipStream_t stream) {
    if (n_in != 32 || out_size != TL * D || ws_size < WS_NEED) { fprintf(stderr, "kernel_launch: unexpected shapes / workspace (n_in %d out %d ws %zu need %zu)\n", n_in, out_size, ws_size, (size_t)WS_NEED); return; }
    static int grid_blocks = 0;
    if (!grid_blocks) {
        int dev = 0, cus = 0, per_cu = 0;
        (void)hipGetDevice(&dev);
        (void)hipDeviceGetAttribute(&cus, hipDeviceAttributeMultiprocessorCount, dev);
        (void)hipOccupancyMaxActiveBlocksPerMultiprocessor(&per_cu, mega_fwd, 256, 0);
        if (per_cu < 1) per_cu = 1;
        if (per_cu > 2) per_cu = 2;
        grid_blocks = cus * per_cu;
        fprintf(stderr, "kernel_launch: %d CUs x %d blocks\n", cus, per_cu);
    }
    Params p = make_params(d_in, d_out, d_ws);
    (void)hipMemsetAsync(d_ws, 0, CTL_BYTES, stream);
    void* args[] = {&p};
    hipError_t e = hipLaunchCooperativeKernel((void*)mega_fwd, dim3(grid_blocks), dim3(256), args, 0, stream);
    if (e != hipSuccess) fprintf(stderr, "cooperative launch failed: %s (grid %d)\n", hipGetErrorString(e), grid_blocks);
}
#endif

#ifdef HOST_EMU
static void host_forward(void* const* d_in, void* d_out, void* d_ws) {
    const Params p = make_params(d_in, d_out, d_ws);
    for (int l = 0; l < 2; ++l) {
        const int nrows = (l == 0) ? T : TL;
        ph_prep_w(p, l, 0, 1); ph_prep_misc(p, l, 0, 1); ph_lnmod(p, l, 0, 1); host_gemm_in(p); ph_streams(p, l, 0, 1); ph_rope(p, 0, 1); ph_scan(p, 0, 1);
        ph_attn(p, l, nrows, 0, 1); ph_rwkv_out(p, l, nrows, 0, 1); host_gemm_out(p, nrows); ph_post_mixer(p, l, nrows, 0, 1);
        ph_dispatch(p, l, nrows, 0, 1); host_moe1(p, l); host_moe2(p, l); ph_final(p, l, nrows, 0, 1);
    }
}
#endif
```

```cpp
#ifdef HOST_EMU
#include <cmath>
#include <cstdio>
#include <cstring>
#include <cstdint>
#include <cstdlib>
#define __device__
#define __global__
#define __host__
#define __forceinline__ inline
#else
#include <hip/hip_runtime.h>
#include <hip/hip_cooperative_groups.h>
#include <cstdio>
#include <cstdint>
namespace cg = cooperative_groups;
#endif

#ifndef CFG_D
#define CFG_D 1024
#define CFG_B 8
#define CFG_S 2048
#define CFG_L 256
#define CFG_DE 512
#endif
constexpr int D = CFG_D, NB = CFG_B, S = CFG_S, L = CFG_L, DE = CFG_DE;
constexpr int TL = NB * S, TC = NB * L, T = TL + TC;
constexpr int GRID_W = 64, HD = 64;
constexpr int DA = 256, A_IN = 1184, N_IN = 2976, NINP = 3072, DMIX = 1024;
constexpr int NEXP = 32, NSLOT = 2 * T + NEXP * 128;
constexpr int ZQB = 0, ZKB = 384, ZVB = 512, ZQN = 640, ZKN = 1024, ZVN = 1408, ZA = 1792, ZP = 2976;
constexpr float LN_EPS = 1e-6f, GN_EPS = 64e-5f, ATT_SCALE = 0.125f;
constexpr float ALPHA = 1.41421356237309515f;

typedef unsigned short bf16_t;

__device__ __forceinline__ float bf2f(bf16_t v) {
    unsigned u = ((unsigned)v) << 16; float f;
#ifdef HOST_EMU
    memcpy(&f, &u, 4);
#else
    f = __uint_as_float(u);
#endif
    return f;
}
__device__ __forceinline__ bf16_t f2bf(float f) {
    unsigned u;
#ifdef HOST_EMU
    memcpy(&u, &f, 4);
#else
    u = __float_as_uint(f);
#endif
    return (bf16_t)((u + 0x7fffu + ((u >> 16) & 1u)) >> 16);
}
__device__ __forceinline__ float sigmoidf_(float x) { return 1.0f / (1.0f + expf(-x)); }
__device__ __forceinline__ float siluf_(float x) { return x / (1.0f + expf(-x)); }
__device__ __forceinline__ int atomic_inc_int(int* p) {
#ifdef HOST_EMU
    int o = *p; *p = o + 1; return o;
#else
    return atomicAdd(p, 1);
#endif
}

struct Params {
    const float *x, *c, *ctx, *c_ctx, *w_mod, *b_mod, *w_in, *w_out, *a_shift, *a_w0, *a_w_up, *a_a0, *a_a_up, *a_g_up,
        *a_k_k, *a_k_a, *a_r_k, *a_lnx_g, *a_lnx_b, *b_sink, *c_rpb, *ln1_g, *ln1_b, *ln2_g, *ln2_b, *w_rg, *b_rg, *w_re,
        *b_re, *w_gate, *w_up, *w_down;
    float* out;
    int* cnt;
    unsigned* bar;
    float* mod;
    float* rope;
    bf16_t *win_t, *wout_t, *wgu_t, *wd_t;
    bf16_t *wrt;
    int* hist;
    bf16_t* HLO;
    bf16_t *wupT, *aupT, *gupT;
    bf16_t* LA;
    float *kT, *kN;
    bf16_t* H;
    bf16_t* Z;
    bf16_t* VT;
    float *sR, *sV, *sKK, *sG, *sW, *sKD, *sB;
    float* Y;
    bf16_t* MIX;
    float *PV, *QS, *PS, *SS;
    float* XC;
    float* O;
    int *rE, *rPos, *rSlot; float* rW;
    int* slotTok;
    bf16_t* ACT;
    float* YS;
};

constexpr size_t al256(size_t v) { return (v + 255) & ~(size_t)255; }
constexpr size_t OFF_CNT = 0;
constexpr size_t OFF_BAR = 4096, CTL_BYTES = 4096 + 16384;
constexpr size_t OFF_MOD = CTL_BYTES;
constexpr size_t OFF_ROPE = al256(OFF_MOD + (size_t)2 * (NB + 1) * 6 * D * 4);
constexpr size_t OFF_LORA = al256(OFF_ROPE + 64 * 16 * 2 * 4);
constexpr size_t OFF_WRT = al256(OFF_LORA + (size_t)(2 * 256 * 64 * 2 + 256 * 160) * 2);
constexpr size_t OFF_LG = al256(OFF_WRT + (size_t)2 * 128 * D * 2);
constexpr size_t OFF_WIN = al256(OFF_LG + (size_t)T * 36 * 4);
constexpr size_t OFF_WOUT = al256(OFF_WIN + (size_t)NINP * D * 2);
constexpr size_t OFF_WGU = al256(OFF_WOUT + (size_t)D * DMIX * 2);
constexpr size_t OFF_WD = al256(OFF_WGU + (size_t)NEXP * 2 * DE * D * 2);
constexpr size_t OFF_H = al256(OFF_WD + (size_t)NEXP * D * DE * 2);
constexpr size_t OFF_Z = al256(OFF_H + (size_t)(T + 1) * D * 2);
constexpr int PU = L + S;
constexpr int NSG = (L + S) / 128;
static_assert((size_t)3 * 64 * ((L + S) / 128) * 4096 * 4 <= (size_t)NEXP * 2 * DE * D * 2 || (L % 128) != 0, "scan segment states overlay wgu_t");
constexpr size_t OFF_VT = al256(OFF_Z + (size_t)T * ZP * 2);
constexpr size_t OFF_S = al256(OFF_VT + (size_t)NB * 8 * 64 * PU * 2);
constexpr size_t S1 = (size_t)T * 256 * 4;
constexpr size_t OFF_Y = al256(OFF_S + 10 * S1);
constexpr size_t OFF_MIX = al256(OFF_Y + 2 * S1);
constexpr size_t OFF_XC = al256(OFF_MIX + (size_t)T * 1024 * 2);
constexpr size_t OFF_ROUTE = al256(OFF_XC + (size_t)TC * D * 4);
constexpr size_t OFF_SLOTTOK = al256(OFF_ROUTE + (size_t)T * 2 * 4 * 4);
constexpr size_t WS_NEED = al256(OFF_SLOTTOK + (size_t)NSLOT * 4);
static_assert((size_t)NSLOT * DE * 2 <= (size_t)T * ZP * 2 && (size_t)T * D * 2 <= (size_t)T * ZP * 2, "ACT / HLO overlay Z");
static_assert((size_t)T * 4 * 4 + (size_t)T * 416 * 2 <= S1, "kN + LA overlay Y[1]");
static_assert((size_t)NSLOT * D * 4 <= 10 * S1 && (size_t)T * D * 4 <= 10 * S1, "YS / O overlay the stream buffers");

static Params make_params(void* const* d_in, void* d_out, void* d_ws) {
    Params p{};
    const float** f = (const float**)&p.x;
    for (int i = 0; i < 32; ++i) f[i] = (const float*)d_in[i];
    p.out = (float*)d_out;
    char* w = (char*)d_ws;
    p.cnt = (int*)(w + OFF_CNT); p.bar = (unsigned*)(w + OFF_BAR); p.mod = (float*)(w + OFF_MOD); p.rope = (float*)(w + OFF_ROPE);
    p.win_t = (bf16_t*)(w + OFF_WIN); p.wout_t = (bf16_t*)(w + OFF_WOUT); p.wgu_t = (bf16_t*)(w + OFF_WGU); p.wd_t = (bf16_t*)(w + OFF_WD);
    p.wrt = (bf16_t*)(w + OFF_WRT); p.hist = (int*)(w + OFF_LG); p.HLO = (bf16_t*)(w + OFF_Z);
    p.wupT = (bf16_t*)(w + OFF_LORA); p.aupT = p.wupT + 2 * 256 * 64; p.gupT = p.aupT + 2 * 256 * 64;
    p.H = (bf16_t*)(w + OFF_H); p.Z = (bf16_t*)(w + OFF_Z); p.VT = (bf16_t*)(w + OFF_VT);
    float* s = (float*)(w + OFF_S); const size_t n1 = (size_t)T * 256;
    p.sR = s; p.sV = s + n1; p.sKK = s + 2 * n1; p.sG = s + 3 * n1; p.sW = s + 4 * n1; p.sKD = s + 6 * n1; p.sB = s + 8 * n1;
    p.Y = (float*)(w + OFF_Y); p.MIX = (bf16_t*)(w + OFF_MIX); p.XC = (float*)(w + OFF_XC);
    p.O = (float*)(w + OFF_S);
    p.PV = (float*)(w + OFF_H); p.QS = (float*)(w + OFF_WGU); p.PS = p.QS + (size_t)64 * NSG * 4096; p.SS = p.PS + (size_t)64 * NSG * 4096;
    p.kT = p.Y; p.kN = p.Y + (size_t)T * 256; p.LA = (bf16_t*)(p.Y + (size_t)T * 256 + (size_t)T * 4);
    int* r = (int*)(w + OFF_ROUTE); p.rE = r; p.rPos = r + 2 * T; p.rSlot = r + 4 * T; p.rW = (float*)(r + 6 * T);
    p.slotTok = (int*)(w + OFF_SLOTTOK);
    p.ACT = (bf16_t*)(w + OFF_Z); p.YS = (float*)(w + OFF_S);
    return p;
}

__device__ void ph_prep_w(const Params& p, int l, long gtid, long gsz) {
    for (long i = gtid; i < (long)D * NINP; i += gsz) {
        const int k = (int)(i / NINP), n = (int)(i % NINP);
        float v = 0.f;
        if (n < N_IN) { const int oc = (n < ZA) ? n + A_IN : n - ZA; v = p.w_in[((size_t)l * D + k) * N_IN + oc]; }
        p.win_t[(size_t)n * D + k] = f2bf(v);
    }
    for (long i = gtid; i < (long)DMIX * D; i += gsz) {
        const int k = (int)(i / D), n = (int)(i % D);
        p.wout_t[(size_t)n * DMIX + k] = f2bf(p.w_out[((size_t)l * DMIX + k) * D + n]);
    }
    for (long i = gtid; i < (long)NEXP * D * 2 * DE; i += gsz) {
        const int rho = (int)(i % (2 * DE)); const long t = i / (2 * DE); const int k = (int)(t % D), e = (int)(t / D);
        const int q = rho >> 5, half = (rho >> 4) & 1, ii = rho & 15, cc = 16 * q + ii;
        const float* src = half ? p.w_up : p.w_gate;
        p.wgu_t[((size_t)e * 2 * DE + rho) * D + k] = f2bf(src[(((size_t)l * NEXP + e) * D + k) * DE + cc]);
    }
    for (long i = gtid; i < (long)NEXP * DE * D; i += gsz) {
        const int n = (int)(i % D); const long t = i / D; const int k = (int)(t % DE), e = (int)(t / DE);
        p.wd_t[((size_t)e * D + n) * DE + k] = f2bf(p.w_down[(((size_t)l * NEXP + e) * DE + k) * D + n]);
    }
}
__device__ __forceinline__ void ph_prep_misc(const Params& p, int l, long gtid, long gsz, bool do_mod = true) {
    if (l == 0 && do_mod) for (long i = gtid; i < (long)2 * (NB + 1) * 6 * D; i += gsz) {
        const int j = (int)(i % (6 * D)), b = (int)((i / (6 * D)) % (NB + 1)), ll = (int)(i / ((long)6 * D * (NB + 1)));
        const float* cv = (b < NB) ? p.c + (size_t)b * D : p.c_ctx;
        float acc = 0.f;
        for (int k = 0; k < D; ++k) acc += siluf_(cv[k]) * p.w_mod[((size_t)ll * D + k) * 6 * D + j];
        p.mod[((size_t)ll * (NB + 1) + b) * 6 * D + j] = acc + p.b_mod[(size_t)ll * 6 * D + j];
    }
    if (l == 0) for (long i = gtid; i < 64 * 16; i += gsz) {
        const int pos = (int)(i / 16), fi = (int)(i % 16);
        const float inv = powf(10000.0f, -(float)fi / 16.0f), ang = (float)pos * inv;
        p.rope[i] = cosf(ang); p.rope[1024 + i] = sinf(ang);
    }
    for (long i = gtid; i < NEXP; i += gsz) p.cnt[l * NEXP + i] = 0;
    for (long i = gtid; i < NSLOT; i += gsz) p.slotTok[i] = T;
    for (long i = gtid; i < D; i += gsz) p.H[(size_t)T * D + i] = 0;
}

__device__ __forceinline__ const float* xrow_in(const Params& p, int l, int m) {
    if (m < TL) return (l == 0 ? p.x : p.out) + (size_t)m * D;
    return (l == 0 ? p.ctx : p.XC) + (size_t)(m - TL) * D;
}
__device__ __forceinline__ const float* modrow(const Params& p, int l, int m) { return p.mod + ((size_t)l * (NB + 1) + (m < TL ? m / S : NB)) * 6 * D; }

__device__ void ph_lnmod(const Params& p, int l, long gtid, long gsz) {
    for (long m = gtid; m < T; m += gsz) {
        const float* xr = xrow_in(p, l, (int)m); const float* md = modrow(p, l, (int)m);
        float s = 0.f; for (int j = 0; j < D; ++j) s += xr[j];
        const float mu = s / D; float q = 0.f;
        for (int j = 0; j < D; ++j) { const float d = xr[j] - mu; q += d * d; }
        const float rstd = 1.0f / sqrtf(q / D + LN_EPS);
        for (int j = 0; j < D; ++j) p.H[(size_t)m * D + j] = f2bf((xr[j] - mu) * rstd * (1.0f + md[D + j]) + md[j]);
    }
}

__device__ __forceinline__ float zshift(const Params& p, int l, int m, int col) {
    int t, len;
    if (m < TL) { t = m % S; len = S; } else { t = (m - TL) % L; len = L; }
    const float* sh = p.a_shift + (size_t)l * 3 * A_IN;
    const bf16_t* z = p.Z + (size_t)m * ZP + ZA + col;
    float v = sh[A_IN + col] * bf2f(z[0]);
    if (t > 0) v += sh[col] * bf2f(z[-ZP]);
    if (t < len - 1) v += sh[2 * A_IN + col] * bf2f(z[ZP]);
    return v;
}

__device__ void ph_streams(const Params& p, int l, long gtid, long gsz) {
    for (long i = gtid; i < (long)T * DA; i += gsz) {
        const int m = (int)(i / DA), c = (int)(i % DA), h0 = c & ~63;
        const float r = zshift(p, l, m, c), k = zshift(p, l, m, 256 + c), v = zshift(p, l, m, 512 + c);
        float nrm = 0.f;
        for (int j = 0; j < 64; ++j) { const float t = zshift(p, l, m, 256 + h0 + j) * p.a_k_k[l * DA + h0 + j]; nrm += t * t; }
        const float kk = k * p.a_k_k[l * DA + c] / sqrtf(nrm + 1e-12f);
        float g = 0.f;
        for (int j = 0; j < 160; ++j) g += sigmoidf_(zshift(p, l, m, 1024 + j)) * p.a_g_up[((size_t)l * 160 + j) * DA + c];
        const size_t o = (size_t)m * DA + c;
        p.sR[o] = r; p.sV[o] = v; p.sKK[o] = kk; p.sG[o] = g;
        for (int d = 0; d < 2; ++d) {
            float aw = 0.f, aa = 0.f;
            for (int j = 0; j < 64; ++j) {
                aw += tanhf(zshift(p, l, m, 768 + d * 64 + j)) * p.a_w_up[(((size_t)l * 2 + d) * 64 + j) * DA + c];
                aa += zshift(p, l, m, 896 + d * 64 + j) * p.a_a_up[(((size_t)l * 2 + d) * 64 + j) * DA + c];
            }
            const float u = -(p.a_w0[(l * 2 + d) * DA + c] + aw);
            const float sp = (u > 20.f) ? u : log1pf(expf(u));
            const float w = expf(-expf(-sp - 0.5f));
            const float a = sigmoidf_(p.a_a0[(l * 2 + d) * DA + c] + aa);
            const size_t od = ((size_t)d * T + m) * DA + c;
            p.sW[od] = w; p.sKD[od] = k * (1.0f + (a - 1.0f) * p.a_k_a[l * DA + c]); p.sB[od] = kk * a;
        }
    }
}

__device__ __forceinline__ void ph_rope(const Params& p, long gtid, long gsz) {
    for (long i = gtid; i < (long)TL * 8 * 32; i += gsz) {
        const int pr = (int)(i & 31), hs = (int)((i >> 5) & 7), m = (int)(i >> 8);
        const int t = m % S, axis = pr >> 4, fi = pr & 15, pos = axis ? (t % GRID_W) : (t / GRID_W);
        bf16_t* z = p.Z + (size_t)m * ZP + hs * 64 + axis * 32 + fi;
        const float cs = p.rope[pos * 16 + fi], sn = p.rope[1024 + pos * 16 + fi];
        const float x0 = bf2f(z[0]), x1 = bf2f(z[16]);
        z[0] = f2bf(x0 * cs - x1 * sn); z[16] = f2bf(x1 * cs + x0 * sn);
    }
}

__device__ void ph_scan(const Params& p, long gtid, long gsz) {
    for (long i = gtid; i < (long)2 * NB * 4 * 64; i += gsz) {
        const int v = (int)(i & 63), h = (int)((i >> 6) & 3), b = (int)((i >> 8) % NB), d = (int)((i >> 8) / NB);
        float st[64];
#pragma unroll
        for (int k = 0; k < 64; ++k) st[k] = 0.f;
        for (int pos = 0; pos < L + S; ++pos) {
            int m;
            if (pos < L) m = TL + b * L + (d ? L - 1 - pos : pos);
            else m = b * S + (d ? S - 1 - (pos - L) : pos - L);
            const size_t o = (size_t)m * DA + h * 64, od = ((size_t)d * T + m) * DA + h * 64;
            const float* kk = p.sKK + o; const float* r = p.sR + o;
            const float* w = p.sW + od; const float* bb = p.sB + od; const float* kd = p.sKD + od;
            const float vv = p.sV[o + v];
            float sk = 0.f;
#pragma unroll
            for (int k = 0; k < 64; ++k) sk += st[k] * kk[k];
            float y = 0.f;
#pragma unroll
            for (int k = 0; k < 64; ++k) { st[k] = st[k] * w[k] - sk * bb[k] + vv * kd[k]; y += st[k] * r[k]; }
            p.Y[od + v] = y;
        }
    }
}

__device__ void ph_rwkv_out(const Params& p, int l, int nrows, long gtid, long gsz) {
    for (long i = gtid; i < (long)nrows * 4; i += gsz) {
        const int m = (int)(i >> 2), h = (int)(i & 3);
        const size_t o = (size_t)m * DA + h * 64;
        const float* y0 = p.Y + o; const float* y1 = p.Y + (size_t)T * DA + o;
        float s = 0.f, bon = 0.f;
        for (int n = 0; n < 64; ++n) {
            s += y0[n] + y1[n];
            bon += p.sR[o + n] * (p.sKD[o + n] + p.sKD[(size_t)T * DA + o + n]) * p.a_r_k[l * DA + h * 64 + n];
        }
        const float mu = s / 64.f; float q = 0.f;
        for (int n = 0; n < 64; ++n) { const float dd = y0[n] + y1[n] - mu; q += dd * dd; }
        const float rstd = 1.0f / sqrtf(q / 64.f + GN_EPS);
        for (int n = 0; n < 64; ++n) {
            const int c = h * 64 + n;
            const float yn = (y0[n] + y1[n] - mu) * rstd * p.a_lnx_g[l * DA + c] + p.a_lnx_b[l * DA + c];
            p.MIX[(size_t)m * DMIX + c] = f2bf((yn + bon * p.sV[o + n]) * p.sG[o + n]);
        }
    }
}

__device__ __forceinline__ void att_key(const float (&q)[64], const bf16_t* kr, const bf16_t* vr, float bias, float& mx, float& ls, float (&acc)[64]) {
    float s = 0.f;
#pragma unroll
    for (int d = 0; d < 64; ++d) s += q[d] * bf2f(kr[d]);
    s = s * ATT_SCALE + bias;
    const float mn = fmaxf(mx, s), f = expf(mx - mn), pe = expf(s - mn);
    ls = ls * f + pe;
#pragma unroll
    for (int d = 0; d < 64; ++d) acc[d] = acc[d] * f + pe * bf2f(vr[d]);
    mx = mn;
}

__device__ void ph_attn(const Params& p, int l, int nrows, long gtid, long gsz) {
    for (long i = gtid; i < (long)nrows * 12; i += gsz) {
        const int m = (int)(i / 12), u = (int)(i % 12);
        const bool isB = u < 6; const int hq = isB ? u : u - 6;
        const int b = (m < TL) ? m / S : (m - TL) / L;
        const int qcol = isB ? ZQB + hq * 64 : ZQN + hq * 64;
        const int kcol = isB ? ZKB + (hq / 3) * 64 : ZKN + hq * 64;
        const int vcol = isB ? ZVB + (hq / 3) * 64 : ZVN + hq * 64;
        float q[64], acc[64];
        const bf16_t* qr = p.Z + (size_t)m * ZP + qcol;
#pragma unroll
        for (int d = 0; d < 64; ++d) { q[d] = bf2f(qr[d]); acc[d] = 0.f; }
        float mx, ls;
        if (isB) { mx = p.b_sink[l * 6 + hq]; ls = 1.0f; } else { mx = -1e30f; ls = 0.f; }
        for (int j = 0; j < L; ++j) { const bf16_t* zr = p.Z + (size_t)(TL + b * L + j) * ZP; att_key(q, zr + kcol, zr + vcol, 0.f, mx, ls, acc); }
        if (m < TL) {
            const int t = m % S;
            if (isB) {
                const int j0 = t - 128 < 0 ? 0 : t - 128, j1 = t + 128 > S - 1 ? S - 1 : t + 128;
                for (int j = j0; j <= j1; ++j) { const bf16_t* zr = p.Z + (size_t)(b * S + j) * ZP; att_key(q, zr + kcol, zr + vcol, 0.f, mx, ls, acc); }
            } else {
                const int rows = S / GRID_W, r = t / GRID_W, c = t % GRID_W;
                int r0 = r - 4; r0 = r0 < 0 ? 0 : (r0 > rows - 8 ? rows - 8 : r0);
                int c0 = c - 8; c0 = c0 < 0 ? 0 : (c0 > GRID_W - 16 ? GRID_W - 16 : c0);
                for (int a = 0; a < 8; ++a)
                    for (int e = 0; e < 16; ++e) {
                        const int kr = r0 + a, kc = c0 + e;
                        const float bias = p.c_rpb[(((size_t)l * 6 + hq) * 15 + (kr - r + 7)) * 31 + (kc - c + 15)];
                        const bf16_t* zr = p.Z + (size_t)(b * S + kr * GRID_W + kc) * ZP;
                        att_key(q, zr + kcol, zr + vcol, bias, mx, ls, acc);
                    }
            }
        }
        const float inv = 1.0f / ls;
        bf16_t* o = p.MIX + (size_t)m * DMIX + (isB ? 256 : 640) + hq * 64;
#pragma unroll
        for (int d = 0; d < 64; ++d) o[d] = f2bf(acc[d] * inv);
    }
}

__device__ void ph_post_mixer(const Params& p, int l, int nrows, long gtid, long gsz) {
    for (long mm = gtid; mm < nrows; mm += gsz) {
        const int m = (int)mm;
        const float* xr = xrow_in(p, l, m); const float* md = modrow(p, l, m); const float* orow = p.O + (size_t)m * D;
        float* x1 = (m < TL) ? p.out + (size_t)m * D : p.XC + (size_t)(m - TL) * D;
        const float* g1 = p.ln1_g + (size_t)l * D; const float* b1 = p.ln1_b + (size_t)l * D;
        float s = 0.f; for (int j = 0; j < D; ++j) s += ALPHA * xr[j] + md[2 * D + j] * orow[j];
        float mu = s / D, q = 0.f;
        for (int j = 0; j < D; ++j) { const float d = ALPHA * xr[j] + md[2 * D + j] * orow[j] - mu; q += d * d; }
        float rstd = 1.0f / sqrtf(q / D + LN_EPS);
        s = 0.f;
        for (int j = 0; j < D; ++j) { const float v = (ALPHA * xr[j] + md[2 * D + j] * orow[j] - mu) * rstd * g1[j] + b1[j]; x1[j] = v; s += v; }
        mu = s / D; q = 0.f;
        for (int j = 0; j < D; ++j) { const float d = x1[j] - mu; q += d * d; }
        rstd = 1.0f / sqrtf(q / D + LN_EPS);
        float gl[4], el[32];
#pragma unroll
        for (int g = 0; g < 4; ++g) gl[g] = p.b_rg[l * 4 + g];
#pragma unroll
        for (int e = 0; e < 32; ++e) el[e] = p.b_re[l * 32 + e];
        for (int j = 0; j < D; ++j) {
            const float hv = (x1[j] - mu) * rstd * (1.0f + md[4 * D + j]) + md[3 * D + j];
            p.H[(size_t)m * D + j] = f2bf(hv);
            const float* wg = p.w_rg + ((size_t)l * D + j) * 4; const float* we = p.w_re + ((size_t)l * D + j) * 32;
#pragma unroll
            for (int g = 0; g < 4; ++g) gl[g] += hv * wg[g];
#pragma unroll
            for (int e = 0; e < 32; ++e) el[e] += hv * we[e];
        }
        int gs = 0; float gm = gl[0];
#pragma unroll
        for (int g = 1; g < 4; ++g) if (gl[g] > gm) { gm = gl[g]; gs = g; }
        float den = 0.f;
#pragma unroll
        for (int g = 0; g < 4; ++g) den += expf(gl[g] - gm);
        const float pg = 1.0f / den;
        float v1 = -3e38f, v2 = -3e38f; int i1 = 0, i2 = 0;
#pragma unroll
        for (int j = 0; j < 8; ++j) {
            const float v = gs == 0 ? el[j] : gs == 1 ? el[8 + j] : gs == 2 ? el[16 + j] : el[24 + j];
            if (v > v1) { v2 = v1; i2 = i1; v1 = v; i1 = j; } else if (v > v2) { v2 = v; i2 = j; }
        }
        const float e2 = expf(v2 - v1), w1 = pg / (1.0f + e2), w2 = pg * e2 / (1.0f + e2);
        const int ea = gs * 8 + i1, eb = gs * 8 + i2;
        p.rE[2 * m] = ea; p.rE[2 * m + 1] = eb; p.rW[2 * m] = w1; p.rW[2 * m + 1] = w2;
        p.rPos[2 * m] = atomic_inc_int(p.cnt + l * NEXP + ea); p.rPos[2 * m + 1] = atomic_inc_int(p.cnt + l * NEXP + eb);
    }
}

__device__ __forceinline__ int pstart_of(const int* cnt, int e) {
    int s = 0;
    for (int j = 0; j < NEXP; ++j) if (j < e) s += (cnt[j] + 127) & ~127;
    return s;
}
__device__ __forceinline__ void ph_dispatch(const Params& p, int l, int nrows, long gtid, long gsz) {
    for (long i = gtid; i < (long)nrows * 2; i += gsz) {
        const int slot = pstart_of(p.cnt + l * NEXP, p.rE[i]) + p.rPos[i];
        p.rSlot[i] = slot; p.slotTok[slot] = (int)(i >> 1);
    }
}

__device__ void ph_final(const Params& p, int l, int nrows, long gtid, long gsz) {
    for (long mm = gtid; mm < nrows; mm += gsz) {
        const int m = (int)mm;
        float* x1 = (m < TL) ? p.out + (size_t)m * D : p.XC + (size_t)(m - TL) * D;
        const float* md = modrow(p, l, m);
        const float* ya = p.YS + (size_t)p.rSlot[2 * m] * D; const float* yb = p.YS + (size_t)p.rSlot[2 * m + 1] * D;
        const float wa = p.rW[2 * m], wb = p.rW[2 * m + 1];
        const float* g2 = p.ln2_g + (size_t)l * D; const float* b2 = p.ln2_b + (size_t)l * D;
        float s = 0.f; for (int j = 0; j < D; ++j) s += ALPHA * x1[j] + md[5 * D + j] * (wa * ya[j] + wb * yb[j]);
        const float mu = s / D; float q = 0.f;
        for (int j = 0; j < D; ++j) { const float d = ALPHA * x1[j] + md[5 * D + j] * (wa * ya[j] + wb * yb[j]) - mu; q += d * d; }
        const float rstd = 1.0f / sqrtf(q / D + LN_EPS);
        for (int j = 0; j < D; ++j) x1[j] = (ALPHA * x1[j] + md[5 * D + j] * (wa * ya[j] + wb * yb[j]) - mu) * rstd * g2[j] + b2[j];
    }
}

__device__ __forceinline__ int moe_blocks(const int* cnt) { int s = 0; for (int j = 0; j < NEXP; ++j) s += (cnt[j] + 127) >> 7; return s; }
__device__ __forceinline__ int moe_block_expert(const int* cnt, int rb) {
    int s = 0, e = 0;
    for (int j = 0; j < NEXP; ++j) { const int nb = (cnt[j] + 127) >> 7; if (rb >= s && rb < s + nb) e = j; s += nb; }
    return e;
}

#ifdef HOST_EMU
static void host_gemm_in(const Params& p) {
    for (int m = 0; m < T; ++m) for (int n = 0; n < ZP; ++n) { float a = 0.f; for (int k = 0; k < D; ++k) a += bf2f(p.H[(size_t)m * D + k]) * bf2f(p.win_t[(size_t)n * D + k]); p.Z[(size_t)m * ZP + n] = f2bf(a); }
}
static void host_gemm_out(const Params& p, int nrows) {
    for (int m = 0; m < nrows; ++m) for (int n = 0; n < D; ++n) { float a = 0.f; for (int k = 0; k < DMIX; ++k) a += bf2f(p.MIX[(size_t)m * DMIX + k]) * bf2f(p.wout_t[(size_t)n * DMIX + k]); p.O[(size_t)m * D + n] = a; }
}
static void host_moe1(const Params& p, int l) {
    const int* cnt = p.cnt + l * NEXP; const int nrb = moe_blocks(cnt);
    for (int rb = 0; rb < nrb; ++rb) { const int e = moe_block_expert(cnt, rb);
        for (int r = 0; r < 128; ++r) { const int slot = rb * 128 + r; const bf16_t* a = p.H + (size_t)p.slotTok[slot] * D;
            for (int c = 0; c < DE; ++c) { const int q = c >> 4, ii = c & 15; float g = 0.f, u = 0.f;
                const bf16_t* wg = p.wgu_t + ((size_t)e * 2 * DE + 32 * q + ii) * D; const bf16_t* wu = wg + (size_t)16 * D;
                for (int k = 0; k < D; ++k) { g += bf2f(a[k]) * bf2f(wg[k]); u += bf2f(a[k]) * bf2f(wu[k]); }
                p.ACT[(size_t)slot * DE + c] = f2bf(siluf_(g) * u); } } }
}
static void host_moe2(const Params& p, int l) {
    const int* cnt = p.cnt + l * NEXP; const int nrb = moe_blocks(cnt);
    for (int rb = 0; rb < nrb; ++rb) { const int e = moe_block_expert(cnt, rb);
        for (int r = 0; r < 128; ++r) { const int slot = rb * 128 + r;
            for (int n = 0; n < D; ++n) { float a = 0.f; const bf16_t* w = p.wd_t + ((size_t)e * D + n) * DE;
                for (int k = 0; k < DE; ++k) a += bf2f(p.ACT[(size_t)slot * DE + k]) * bf2f(w[k]);
                p.YS[(size_t)slot * D + n] = a; } } }
}
#else
typedef short bf16x8 __attribute__((ext_vector_type(8)));
typedef float f32x4 __attribute__((ext_vector_type(4)));
__device__ __forceinline__ int opq_tid() { int t = threadIdx.x; asm volatile("" : "+v"(t)); return t; }
__device__ __forceinline__ int opq_bid() { int b = blockIdx.x; asm volatile("" : "+s"(b)); return b; }
__device__ __forceinline__ unsigned pk2(float lo, float hi) { return (unsigned)f2bf(lo) | ((unsigned)f2bf(hi) << 16); }
struct u32x2_t { unsigned x, y; };
__device__ __forceinline__ void st_bf16x4(bf16_t* dst, f32x4 v) { u32x2_t o; o.x = pk2(v[0], v[1]); o.y = pk2(v[2], v[3]); *(u32x2_t*)dst = o; }
template <class Epi>
__device__ __forceinline__ void gemm_tile(const bf16_t* a0, const bf16_t* a1, const bf16_t* b0, const bf16_t* b1, int K, char* lds, const Epi& epi) {
    const int tid = opq_tid(), wid = tid >> 6, lane = tid & 63, wr = wid >> 1, wc = wid & 1, fr = lane & 15, fq = lane >> 4;
    f32x4 acc[4][4];
#pragma unroll
    for (int m = 0; m < 4; ++m)
#pragma unroll
        for (int n = 0; n < 4; ++n) acc[m][n] = (f32x4){0.f, 0.f, 0.f, 0.f};
#define GT_STAGE(st_, kt_) do { char* sa_ = lds + (st_) * 16384 + tid * 16; \
        __builtin_amdgcn_global_load_lds((const unsigned*)(a0 + (kt_)), (__attribute__((address_space(3))) unsigned*)(sa_), 16, 0, 0); \
        __builtin_amdgcn_global_load_lds((const unsigned*)(a1 + (kt_)), (__attribute__((address_space(3))) unsigned*)(sa_ + 4096), 16, 0, 0); \
        __builtin_amdgcn_global_load_lds((const unsigned*)(b0 + (kt_)), (__attribute__((address_space(3))) unsigned*)(sa_ + 8192), 16, 0, 0); \
        __builtin_amdgcn_global_load_lds((const unsigned*)(b1 + (kt_)), (__attribute__((address_space(3))) unsigned*)(sa_ + 12288), 16, 0, 0); } while (0)
    const int aoff = (wr * 64 + fr) * 64 + ((fq ^ ((fr >> 2) & 3)) * 16), boff = 8192 + (wc * 64 + fr) * 64 + ((fq ^ ((fr >> 2) & 3)) * 16);
    const int nk = K / 32;
    GT_STAGE(0, 0);
    if (nk > 1) GT_STAGE(1, 32);
    if (nk > 2) GT_STAGE(2, 64);
    for (int t = 0; t < nk; ++t) {
        if (t + 2 < nk) asm volatile("s_waitcnt vmcnt(8)" ::: "memory"); else if (t + 1 < nk) asm volatile("s_waitcnt vmcnt(4)" ::: "memory"); else asm volatile("s_waitcnt vmcnt(0)" ::: "memory");
        asm volatile("s_waitcnt lgkmcnt(0)" ::: "memory");
        __builtin_amdgcn_s_barrier();
        if (t + 3 < nk) GT_STAGE((t + 3) & 3, (t + 3) * 32);
        const char* sb = lds + (t & 3) * 16384;
        bf16x8 At[4], Bt[4];
#pragma unroll
        for (int m = 0; m < 4; ++m) At[m] = *(const bf16x8*)(sb + aoff + m * 1024);
#pragma unroll
        for (int n = 0; n < 4; ++n) Bt[n] = *(const bf16x8*)(sb + boff + n * 1024);
#pragma unroll
        for (int m = 0; m < 4; ++m)
#pragma unroll
            for (int n = 0; n < 4; ++n) acc[m][n] = __builtin_amdgcn_mfma_f32_16x16x32_bf16(At[m], Bt[n], acc[m][n], 0, 0, 0);
    }
    asm volatile("s_waitcnt lgkmcnt(0)" ::: "memory");
    __builtin_amdgcn_s_barrier();
#undef GT_STAGE
    epi(acc, wr, wc, fr, fq);
}
#define STG_ROW(i) ((tid_ + (i) * 256) >> 2)
#define STG_K ((((tid_ & 3) ^ ((tid_ >> 4) & 3))) * 8)

__device__ __forceinline__ void g_gemm_in(const Params& p, char* lds) {
    const int tid_ = opq_tid(), bid_ = opq_bid(); (void)tid_; (void)bid_;
    constexpr int NT = NINP / 128, MT = T / 128;
    for (int tile = bid_; tile < NT * MT; tile += gridDim.x) {
        const int tm = tile / NT, tn = tile % NT;
        const bf16_t* a0 = p.H + (size_t)(tm * 128 + STG_ROW(0)) * D + STG_K; const bf16_t* a1 = p.H + (size_t)(tm * 128 + STG_ROW(1)) * D + STG_K;
        const bf16_t* b0 = p.win_t + (size_t)(tn * 128 + STG_ROW(0)) * D + STG_K; const bf16_t* b1 = p.win_t + (size_t)(tn * 128 + STG_ROW(1)) * D + STG_K;
        gemm_tile(a0, a1, b0, b1, D, lds, [&](const f32x4 (&acc)[4][4], int wr, int wc, int fr, int fq) {
            if (tn < ZVB / 128 && tm < TL / 128) {
#pragma unroll
                for (int m = 0; m < 4; ++m)
#pragma unroll
                    for (int j = 0; j < 4; ++j) { const int row = tm * 128 + wr * 64 + m * 16 + fq * 4 + j, t = row % S;
                        bf16_t* zr = p.Z + (size_t)row * ZP + tn * 128 + wc * 64 + fr;
#pragma unroll
                        for (int ax = 0; ax < 2; ++ax) { const int pos = ax ? t % GRID_W : t / GRID_W; const float cs = p.rope[pos * 16 + fr], sn = p.rope[1024 + pos * 16 + fr];
                            const float x0 = acc[m][2 * ax][j], x1 = acc[m][2 * ax + 1][j];
                            zr[32 * ax] = f2bf(x0 * cs - x1 * sn); zr[32 * ax + 16] = f2bf(x1 * cs + x0 * sn); } }
            } else {
#pragma unroll
            for (int m = 0; m < 4; ++m)
#pragma unroll
                for (int n = 0; n < 4; ++n) { const int col = tn * 128 + wc * 64 + n * 16 + fr;
                    if (col < ZP) {
#pragma unroll
                        for (int j = 0; j < 4; ++j) p.Z[(size_t)(tm * 128 + wr * 64 + m * 16 + fq * 4 + j) * ZP + col] = f2bf(acc[m][n][j]); } }
            }
            if (tn == ZVB / 128 || (tn >= ZVN / 128 && tn < ZA / 128)) {
#pragma unroll
                for (int m = 0; m < 4; ++m) { const int m0 = tm * 128 + wr * 64 + m * 16 + fq * 4; int b, u;
                    if (m0 < TL) { b = m0 / S; u = L + m0 % S; } else { b = (m0 - TL) / L; u = (m0 - TL) % L; }
#pragma unroll
                    for (int n = 0; n < 4; ++n) { const int col = tn * 128 + wc * 64 + n * 16 + fr;
                        const int hv = col < ZVN ? (col - ZVB) >> 6 : 2 + ((col - ZVN) >> 6), d = col < ZVN ? (col - ZVB) & 63 : (col - ZVN) & 63;
                        st_bf16x4(p.VT + ((size_t)(b * 8 + hv) * 64 + d) * PU + u, acc[m][n]); } }
            }
        });
    }
}
__device__ __forceinline__ void g_gemm_out(const Params& p, int nrows, char* lds) {
    const int tid_ = opq_tid(), bid_ = opq_bid(); (void)tid_; (void)bid_;
    constexpr int NT = D / 128; const int MT = nrows / 128;
    for (int tile = bid_; tile < NT * MT; tile += gridDim.x) {
        const int tm = tile / NT, tn = tile % NT;
        const bf16_t* a0 = p.MIX + (size_t)(tm * 128 + STG_ROW(0)) * DMIX + STG_K; const bf16_t* a1 = p.MIX + (size_t)(tm * 128 + STG_ROW(1)) * DMIX + STG_K;
        const bf16_t* b0 = p.wout_t + (size_t)(tn * 128 + STG_ROW(0)) * DMIX + STG_K; const bf16_t* b1 = p.wout_t + (size_t)(tn * 128 + STG_ROW(1)) * DMIX + STG_K;
        gemm_tile(a0, a1, b0, b1, DMIX, lds, [&](const f32x4 (&acc)[4][4], int wr, int wc, int fr, int fq) {
#pragma unroll
            for (int m = 0; m < 4; ++m)
#pragma unroll
                for (int n = 0; n < 4; ++n)
#pragma unroll
                    for (int j = 0; j < 4; ++j) p.O[(size_t)(tm * 128 + wr * 64 + m * 16 + fq * 4 + j) * D + tn * 128 + wc * 64 + n * 16 + fr] = acc[m][n][j];
        });
    }
}
__device__ __forceinline__ void g_moe1(const Params& p, int l, char* lds) {
    const int tid_ = opq_tid(), bid_ = opq_bid(); (void)tid_; (void)bid_;
    const int* cnt = p.cnt + l * NEXP; const int nrb = moe_blocks(cnt); constexpr int NT = 2 * DE / 128;
    for (int tile = bid_; tile < nrb * NT; tile += gridDim.x) {
        const int rb = tile / NT, tn = tile % NT, e = moe_block_expert(cnt, rb);
        const bf16_t* a0 = p.H + (size_t)p.slotTok[rb * 128 + STG_ROW(0)] * D + STG_K; const bf16_t* a1 = p.H + (size_t)p.slotTok[rb * 128 + STG_ROW(1)] * D + STG_K;
        const bf16_t* bw = p.wgu_t + (size_t)e * 2 * DE * D;
        const bf16_t* b0 = bw + (size_t)(tn * 128 + STG_ROW(0)) * D + STG_K; const bf16_t* b1 = bw + (size_t)(tn * 128 + STG_ROW(1)) * D + STG_K;
        gemm_tile(a0, a1, b0, b1, D, lds, [&](const f32x4 (&acc)[4][4], int wr, int wc, int fr, int fq) {
#pragma unroll
            for (int m = 0; m < 4; ++m)
#pragma unroll
                for (int n2 = 0; n2 < 2; ++n2) { const int col = tn * 64 + wc * 32 + n2 * 16 + fr;
#pragma unroll
                    for (int j = 0; j < 4; ++j) { const float g = acc[m][2 * n2][j], u = acc[m][2 * n2 + 1][j];
                        p.ACT[(size_t)(rb * 128 + wr * 64 + m * 16 + fq * 4 + j) * DE + col] = f2bf(g / (1.0f + __expf(-g)) * u); } }
        });
    }
}
__device__ __forceinline__ void g_moe2(const Params& p, int l, char* lds) {
    const int tid_ = opq_tid(), bid_ = opq_bid(); (void)tid_; (void)bid_;
    const int* cnt = p.cnt + l * NEXP; const int nrb = moe_blocks(cnt); constexpr int NT = D / 128;
    for (int tile = bid_; tile < nrb * NT; tile += gridDim.x) {
        const int rb = tile / NT, tn = tile % NT, e = moe_block_expert(cnt, rb);
        const bf16_t* a0 = p.ACT + (size_t)(rb * 128 + STG_ROW(0)) * DE + STG_K; const bf16_t* a1 = p.ACT + (size_t)(rb * 128 + STG_ROW(1)) * DE + STG_K;
        const bf16_t* bw = p.wd_t + (size_t)e * D * DE;
        const bf16_t* b0 = bw + (size_t)(tn * 128 + STG_ROW(0)) * DE + STG_K; const bf16_t* b1 = bw + (size_t)(tn * 128 + STG_ROW(1)) * DE + STG_K;
        gemm_tile(a0, a1, b0, b1, DE, lds, [&](const f32x4 (&acc)[4][4], int wr, int wc, int fr, int fq) {
#pragma unroll
            for (int m = 0; m < 4; ++m)
#pragma unroll
                for (int n = 0; n < 4; ++n)
#pragma unroll
                    for (int j = 0; j < 4; ++j) p.YS[(size_t)(rb * 128 + wr * 64 + m * 16 + fq * 4 + j) * D + tn * 128 + wc * 64 + n * 16 + fr] = acc[m][n][j];
        });
    }
}


constexpr int DV = D / 256;
static_assert(D % 256 == 0, "row phases hold a row as DV float4 per lane");
template <int CTRL> __device__ __forceinline__ float dppf(float v) { return __builtin_bit_cast(float, __builtin_amdgcn_update_dpp(0, __builtin_bit_cast(int, v), CTRL, 0xf, 0xf, true)); }
__device__ __forceinline__ float wave_sum(float v) {
    v += dppf<0xB1>(v); v += dppf<0x4E>(v); v += dppf<0x141>(v); v += dppf<0x140>(v);
    float a = v, b = v;
    asm volatile("s_nop 1\n\tv_permlane16_swap_b32 %0, %1" : "+v"(a), "+v"(b));
    v = a + b; a = v; b = v;
    asm volatile("s_nop 1\n\tv_permlane32_swap_b32 %0, %1" : "+v"(a), "+v"(b));
    return a + b;
}
__device__ __forceinline__ float sum8(float v) { v += dppf<0xB1>(v); v += dppf<0x4E>(v); v += dppf<0x141>(v); return v; }
__device__ __forceinline__ float sum4(f32x4 a) { return (a[0] + a[1]) + (a[2] + a[3]); }
#define LDS_WAIT() asm volatile("s_waitcnt lgkmcnt(0)" ::: "memory")

__device__ __forceinline__ void row_stats(const f32x4 (&v)[DV], float& mu, float& rstd) {
    float s = 0.f;
#pragma unroll
    for (int j = 0; j < DV; ++j) s += sum4(v[j]);
    mu = wave_sum(s) * (1.0f / D);
    float q = 0.f;
#pragma unroll
    for (int j = 0; j < DV; ++j) { const f32x4 d = v[j] - mu; q += sum4(d * d); }
    rstd = 1.0f / sqrtf(wave_sum(q) * (1.0f / D) + LN_EPS);
}

__device__ __forceinline__ void ph_lnmod_fast(const Params& p, int l) {
    const int tid_ = opq_tid(), bid_ = opq_bid(); (void)tid_; (void)bid_;
    const int lane = tid_ & 63, gw = bid_ * 4 + (tid_ >> 6), nw = gridDim.x * 4;
    for (int m = gw; m < T; m += nw) {
        const f32x4* xr = (const f32x4*)xrow_in(p, l, m) + lane; const f32x4* md = (const f32x4*)modrow(p, l, m) + lane;
        f32x4 v[DV];
#pragma unroll
        for (int j = 0; j < DV; ++j) v[j] = xr[64 * j];
        float mu, rstd; row_stats(v, mu, rstd);
#pragma unroll
        for (int j = 0; j < DV; ++j) { const f32x4 sh = md[64 * j], sc = md[D / 4 + 64 * j];
            st_bf16x4(p.H + (size_t)m * D + 4 * (lane + 64 * j), (v[j] - mu) * rstd * (sc + 1.0f) + sh); }
    }
}

__device__ __forceinline__ void ph_post_mixer_fast(const Params& p, int l, int nrows) {
    const int tid_ = opq_tid(), bid_ = opq_bid(); (void)tid_; (void)bid_;
    const int lane = tid_ & 63, gw = bid_ * 4 + (tid_ >> 6), nw = gridDim.x * 4;
    for (int m = gw; m < nrows; m += nw) {
        const f32x4* xr = (const f32x4*)xrow_in(p, l, m) + lane; const f32x4* md = (const f32x4*)modrow(p, l, m) + lane;
        const f32x4* orow = (const f32x4*)(p.O + (size_t)m * D) + lane;
        f32x4* x1 = (f32x4*)((m < TL) ? p.out + (size_t)m * D : p.XC + (size_t)(m - TL) * D) + lane;
        const f32x4* g1 = (const f32x4*)(p.ln1_g + (size_t)l * D) + lane; const f32x4* b1 = (const f32x4*)(p.ln1_b + (size_t)l * D) + lane;
        f32x4 v[DV];
#pragma unroll
        for (int j = 0; j < DV; ++j) v[j] = xr[64 * j] * ALPHA + md[2 * (D / 4) + 64 * j] * orow[64 * j];
        float mu, rstd; row_stats(v, mu, rstd);
#pragma unroll
        for (int j = 0; j < DV; ++j) { v[j] = (v[j] - mu) * rstd * g1[64 * j] + b1[64 * j]; x1[64 * j] = v[j]; }
        row_stats(v, mu, rstd);
#pragma unroll
        for (int j = 0; j < DV; ++j) {
            const f32x4 hv = (v[j] - mu) * rstd * (md[4 * (D / 4) + 64 * j] + 1.0f) + md[3 * (D / 4) + 64 * j];
            f32x4 hh, lo;
#pragma unroll
            for (int e = 0; e < 4; ++e) { hh[e] = bf2f(f2bf(hv[e])); lo[e] = hv[e] - hh[e]; }
            st_bf16x4(p.H + (size_t)m * D + 4 * (lane + 64 * j), hh);
            st_bf16x4(p.HLO + (size_t)m * D + 4 * (lane + 64 * j), lo);
        }
    }
}

__device__ __forceinline__ void g_router(const Params& p, int l, int nrows, char* lds) {
    const int tid_ = opq_tid(), bid_ = opq_bid(); (void)tid_; (void)bid_;
    const int lane = tid_ & 63, wid = tid_ >> 6, fr = lane & 15, fq = lane >> 4;
    float* part = (float*)lds;
    float* lgt = part + 4 * 6 * 64 * 4;
    int* eids = (int*)(lgt + 32 * 48);
    for (int rg = bid_; rg < nrows / 32; rg += gridDim.x) {
        f32x4 acc[2][3];
#pragma unroll
        for (int a = 0; a < 2; ++a)
#pragma unroll
            for (int b = 0; b < 3; ++b) acc[a][b] = (f32x4){0.f, 0.f, 0.f, 0.f};
#pragma unroll
        for (int seg = 0; seg < 3; ++seg) {
            const bf16_t* ap = (seg < 2 ? p.H : p.HLO) + (size_t)(rg * 32 + fr) * D + wid * (D / 4) + fq * 8;
            const bf16_t* bp = p.wrt + (seg == 1 ? (size_t)128 * D : 0) + (size_t)fr * D + wid * (D / 4) + fq * 8;
#pragma unroll 1
            for (int ks0 = 0; ks0 < D / 128; ks0 += 4) {
                bf16x8 av[4][2], bv[4][3];
#pragma unroll
                for (int u = 0; u < 4; ++u) { const int ko = (ks0 + u) * 32;
                    av[u][0] = *(const bf16x8*)(ap + ko); av[u][1] = *(const bf16x8*)(ap + (size_t)16 * D + ko);
                    bv[u][0] = *(const bf16x8*)(bp + ko); bv[u][1] = *(const bf16x8*)(bp + (size_t)16 * D + ko); bv[u][2] = *(const bf16x8*)(bp + (size_t)32 * D + ko); }
                asm volatile("" ::: "memory");
#pragma unroll
                for (int u = 0; u < 4; ++u)
#pragma unroll
                    for (int a = 0; a < 2; ++a)
#pragma unroll
                        for (int b = 0; b < 3; ++b) acc[a][b] = __builtin_amdgcn_mfma_f32_16x16x32_bf16(av[u][a], bv[u][b], acc[a][b], 0, 0, 0);
            }
        }
#pragma unroll
        for (int a = 0; a < 2; ++a)
#pragma unroll
            for (int b = 0; b < 3; ++b) *(f32x4*)(part + ((wid * 6 + a * 3 + b) * 64 + lane) * 4) = acc[a][b];
        __syncthreads();
#pragma unroll
        for (int i = 0; i < 6; ++i) { const int e = tid_ + 256 * i, f = e >> 8, ln = (e & 255) >> 2, j = e & 3;
            const float sm = (part[((0 * 6 + f) * 64 + ln) * 4 + j] + part[((1 * 6 + f) * 64 + ln) * 4 + j]) + (part[((2 * 6 + f) * 64 + ln) * 4 + j] + part[((3 * 6 + f) * 64 + ln) * 4 + j]);
            lgt[((f / 3) * 16 + (ln >> 4) * 4 + j) * 48 + (f % 3) * 16 + (ln & 15)] = sm; }
        __syncthreads();
        if (tid_ < 32) {
            const int m = rg * 32 + tid_; const float* lg = lgt + tid_ * 48;
            float gl[4], el[32];
#pragma unroll
            for (int g = 0; g < 4; ++g) gl[g] = lg[g] + p.b_rg[l * 4 + g];
#pragma unroll
            for (int e = 0; e < 32; ++e) el[e] = lg[4 + e] + p.b_re[l * 32 + e];
            int gs = 0; float gm = gl[0];
#pragma unroll
            for (int g = 1; g < 4; ++g) if (gl[g] > gm) { gm = gl[g]; gs = g; }
            float den = 0.f;
#pragma unroll
            for (int g = 0; g < 4; ++g) den += expf(gl[g] - gm);
            const float pg = 1.0f / den;
            float v1 = -3e38f, v2 = -3e38f; int i1 = 0, i2 = 0;
#pragma unroll
            for (int j = 0; j < 8; ++j) {
                const float vv = gs == 0 ? el[j] : gs == 1 ? el[8 + j] : gs == 2 ? el[16 + j] : el[24 + j];
                if (vv > v1) { v2 = v1; i2 = i1; v1 = vv; i1 = j; } else if (vv > v2) { v2 = vv; i2 = j; }
            }
            const float e2 = expf(v2 - v1), w1 = pg / (1.0f + e2), w2 = pg * e2 / (1.0f + e2);
            const int ea = gs * 8 + i1, eb = gs * 8 + i2;
            p.rE[2 * m] = ea; p.rE[2 * m + 1] = eb; p.rW[2 * m] = w1; p.rW[2 * m + 1] = w2;
            eids[2 * tid_] = ea; eids[2 * tid_ + 1] = eb;
        }
        __syncthreads();
        if (tid_ < 64) { const int e = eids[tid_]; int rk = 0; for (int j = 0; j < tid_; ++j) rk += (eids[j] == e) ? 1 : 0; p.rPos[2 * (rg * 32) + tid_] = rk; }
        else if (tid_ < 96) { const int e = tid_ - 64; int c = 0; for (int j = 0; j < 64; ++j) c += (eids[j] == e) ? 1 : 0; p.hist[rg * 32 + e] = c; }
        __syncthreads();
    }
}

__device__ __forceinline__ void ph_dispatch_fast(const Params& p, int l, int nrows, char* lds) {
    const int tid_ = opq_tid(), bid_ = opq_bid(); (void)tid_; (void)bid_;
    const int nrg = nrows / 32, e = tid_ & 31, part = tid_ >> 5;
    int* tot = (int*)lds; int* pst = tot + 32; int* pre = pst + 32; int* red = pre + 32;
    { int s = 0; for (int b = part; b < nrg; b += 8) s += p.hist[b * 32 + e]; red[part * 32 + e] = s; }
    __syncthreads();
    if (tid_ < 32) { int s = 0; for (int q = 0; q < 8; ++q) s += red[q * 32 + tid_]; tot[tid_] = s; }
    __syncthreads();
    if (tid_ < 32) { int s = 0; for (int j = 0; j < tid_; ++j) s += (tot[j] + 127) & ~127; pst[tid_] = s; if (bid_ == 0) p.cnt[l * NEXP + tid_] = tot[tid_]; }
    for (int rg = bid_; rg < nrg; rg += gridDim.x) {
        __syncthreads();
        { int s = 0; for (int b = part; b < rg; b += 8) s += p.hist[b * 32 + e]; red[part * 32 + e] = s; }
        __syncthreads();
        if (tid_ < 32) { int s = 0; for (int q = 0; q < 8; ++q) s += red[q * 32 + tid_]; pre[tid_] = s; }
        __syncthreads();
        if (tid_ < 64) { const int i = 2 * (rg * 32) + tid_, ee = p.rE[i], slot = pst[ee] + pre[ee] + p.rPos[i]; p.rSlot[i] = slot; p.slotTok[slot] = i >> 1; }
    }
}

__device__ __forceinline__ void ph_final_fast(const Params& p, int l, int nrows) {
    const int tid_ = opq_tid(), bid_ = opq_bid(); (void)tid_; (void)bid_;
    const int lane = tid_ & 63, gw = bid_ * 4 + (tid_ >> 6), nw = gridDim.x * 4;
    for (int m = gw; m < nrows; m += nw) {
        f32x4* x1 = (f32x4*)((m < TL) ? p.out + (size_t)m * D : p.XC + (size_t)(m - TL) * D) + lane;
        const f32x4* md = (const f32x4*)modrow(p, l, m) + lane;
        const f32x4* ya = (const f32x4*)(p.YS + (size_t)p.rSlot[2 * m] * D) + lane; const f32x4* yb = (const f32x4*)(p.YS + (size_t)p.rSlot[2 * m + 1] * D) + lane;
        const float wa = p.rW[2 * m], wb = p.rW[2 * m + 1];
        const f32x4* g2 = (const f32x4*)(p.ln2_g + (size_t)l * D) + lane; const f32x4* b2 = (const f32x4*)(p.ln2_b + (size_t)l * D) + lane;
        f32x4 v[DV];
#pragma unroll
        for (int j = 0; j < DV; ++j) v[j] = x1[64 * j] * ALPHA + md[5 * (D / 4) + 64 * j] * (ya[64 * j] * wa + yb[64 * j] * wb);
        float mu, rstd; row_stats(v, mu, rstd);
#pragma unroll
        for (int j = 0; j < DV; ++j) x1[64 * j] = (v[j] - mu) * rstd * g2[64 * j] + b2[64 * j];
    }
}

__device__ __forceinline__ void ph_mod_fast(const Params& p, char* lds) {
    const int tid_ = opq_tid(), bid_ = opq_bid(); (void)tid_; (void)bid_;
    constexpr int NR = NB + 1, NTASK = 2 * (6 * D / 64);
    if (bid_ >= NTASK) return;
    float* sc = (float*)lds;
    float* part = sc + NR * D;
    for (int i = tid_; i < NR * D; i += 256) { const int b = i / D, k = i % D; const float cv = b < NB ? p.c[(size_t)b * D + k] : p.c_ctx[k]; sc[i] = cv / (1.0f + __expf(-cv)); }
    __syncthreads();
    const int lane = tid_ & 63, wid = tid_ >> 6;
    for (int task = bid_; task < NTASK; task += gridDim.x) {
        const int ll = task / (6 * D / 64), col = 64 * (task % (6 * D / 64)) + lane;
        float acc[NR];
#pragma unroll
        for (int b = 0; b < NR; ++b) acc[b] = 0.f;
        const float* wp = p.w_mod + ((size_t)ll * D + wid * (D / 4)) * 6 * D + col;
#pragma unroll 16
        for (int k = 0; k < D / 4; ++k) { const float w = wp[(size_t)k * 6 * D];
#pragma unroll
            for (int b = 0; b < NR; ++b) acc[b] += sc[b * D + wid * (D / 4) + k] * w; }
#pragma unroll
        for (int b = 0; b < NR; ++b) part[(wid * NR + b) * 64 + lane] = acc[b];
        __syncthreads();
        for (int i = tid_; i < NR * 64; i += 256) { const int b = i / 64, cl = i % 64;
            p.mod[((size_t)ll * NR + b) * 6 * D + 64 * (task % (6 * D / 64)) + cl] = (part[(0 * NR + b) * 64 + cl] + part[(1 * NR + b) * 64 + cl]) + (part[(2 * NR + b) * 64 + cl] + part[(3 * NR + b) * 64 + cl]) + p.b_mod[(size_t)ll * 6 * D + 64 * (task % (6 * D / 64)) + cl]; }
        __syncthreads();
    }
}

__device__ __forceinline__ void tr_item(const float* srcl, size_t ldw, bf16_t* dst, size_t ldd, float* scr, int lane) {
#pragma unroll 8
    for (int i = 0; i < 32; ++i) { const int kk = 2 * i + (lane >> 5); scr[kk * 33 + (lane & 31)] = srcl ? srcl[(size_t)kk * ldw] : 0.f; }
    LDS_WAIT();
    const int c = lane & 7;
#pragma unroll
    for (int j = 0; j < 4; ++j) { const int n = (lane >> 3) + 8 * j; const float* s = scr + (8 * c) * 33 + n;
        uint4 o; o.x = pk2(s[0], s[33]); o.y = pk2(s[2 * 33], s[3 * 33]); o.z = pk2(s[4 * 33], s[5 * 33]); o.w = pk2(s[6 * 33], s[7 * 33]);
        *(uint4*)(dst + (size_t)n * ldd + 8 * c) = o; }
    LDS_WAIT();
}
__device__ __forceinline__ void ph_prep_w_fast(const Params& p, int l, int part, char* lds) {
    const int tid_ = opq_tid(), bid_ = opq_bid(); (void)tid_; (void)bid_;
    const int lane = tid_ & 63, wid = tid_ >> 6, gw = bid_ * 4 + wid, nw = gridDim.x * 4;
    float* scr = (float*)(lds + wid * 8448);
    constexpr int I_IN = (D / 64) * (NINP / 32), I_OUT = (DMIX / 64) * (D / 32), I_GU1 = (D / 64) * (2 * DE / 32), I_D1 = (DE / 64) * (D / 32);
    constexpr int NITEMS = I_IN + I_OUT + NEXP * (I_GU1 + I_D1);
    const int it0 = part == 0 ? 0 : I_IN + I_OUT, it1 = part == 0 ? I_IN + I_OUT : NITEMS;
    for (int it = it0 + gw; it < it1; it += nw) {
        int r = it;
        if (r < I_IN) { const int kb = r / (NINP / 32), n0 = 32 * (r % (NINP / 32));
            const float* s = nullptr;
            if (n0 < N_IN) { const int oc = (n0 < ZA) ? n0 + A_IN : n0 - ZA; s = p.w_in + ((size_t)l * D + 64 * kb) * N_IN + oc + (lane & 31); }
            tr_item(s, N_IN, p.win_t + (size_t)n0 * D + 64 * kb, D, scr, lane); continue; }
        r -= I_IN;
        if (r < I_OUT) { const int kb = r / (D / 32), n0 = 32 * (r % (D / 32));
            tr_item(p.w_out + ((size_t)l * DMIX + 64 * kb) * D + n0 + (lane & 31), D, p.wout_t + (size_t)n0 * DMIX + 64 * kb, DMIX, scr, lane); continue; }
        r -= I_OUT;
        const int e = r / (I_GU1 + I_D1); r %= (I_GU1 + I_D1);
        if (r < I_GU1) { const int kb = r / (2 * DE / 32), q = r % (2 * DE / 32);
            const float* s = (((lane & 31) >> 4) ? p.w_up : p.w_gate) + (((size_t)l * NEXP + e) * D + 64 * kb) * DE + 16 * q + (lane & 15);
            tr_item(s, DE, p.wgu_t + ((size_t)e * 2 * DE + 32 * q) * D + 64 * kb, D, scr, lane); continue; }
        r -= I_GU1;
        { const int kb = r / (D / 32), n0 = 32 * (r % (D / 32));
            tr_item(p.w_down + (((size_t)l * NEXP + e) * DE + 64 * kb) * D + n0 + (lane & 31), D, p.wd_t + ((size_t)e * D + n0) * DE + 64 * kb, DE, scr, lane); }
    }
    if (part != 0) return;
    const long gt = (long)bid_ * blockDim.x + tid_, gs = (long)gridDim.x * blockDim.x;
    for (long i = gt; i < 2 * 256 * 64; i += gs) { const int k = (int)(i & 63), n = (int)((i >> 6) & 255), d = (int)(i >> 14);
        p.wupT[i] = f2bf(p.a_w_up[(((size_t)l * 2 + d) * 64 + k) * DA + n]); p.aupT[i] = f2bf(p.a_a_up[(((size_t)l * 2 + d) * 64 + k) * DA + n]); }
    for (long i = gt; i < 256 * 160; i += gs) { const int k = (int)(i % 160), n = (int)(i / 160); p.gupT[i] = f2bf(p.a_g_up[((size_t)l * 160 + k) * DA + n]); }
    for (long i = gt; i < (long)128 * D; i += gs) { const int n = (int)(i / D), k = (int)(i % D);
        const float w = n < 4 ? p.w_rg[((size_t)l * D + k) * 4 + n] : n < 36 ? p.w_re[((size_t)l * D + k) * 32 + n - 4] : 0.f;
        const bf16_t hb = f2bf(w); p.wrt[i] = hb; p.wrt[(size_t)128 * D + i] = f2bf(w - bf2f(hb)); }
}

__device__ __forceinline__ float tanh_fast(float x) { return 1.0f - 2.0f / (1.0f + __expf(2.0f * x)); }
__device__ __forceinline__ void ph_streams_s1(const Params& p, int l) {
    const int tid_ = opq_tid(), bid_ = opq_bid(); (void)tid_; (void)bid_;
    constexpr int NCH = A_IN / 8, NCHP = (NCH + 7) & ~7;
    const float* sh = p.a_shift + (size_t)l * 3 * A_IN;
    for (long it = (long)bid_ * 256 + tid_; it < (long)T * NCHP; it += (long)gridDim.x * 256) {
        const int m = (int)(it / NCHP), ch = (int)(it % NCHP), c0 = 8 * ch;
        const bool act = ch < NCH;
        int t, len;
        if (m < TL) { t = m % S; len = S; } else { t = (m - TL) % L; len = L; }
        float v[8];
#pragma unroll
        for (int e = 0; e < 8; ++e) v[e] = 0.f;
        if (act) {
            const bf16_t* z = p.Z + (size_t)m * ZP + ZA + c0;
            const bf16x8 zc = *(const bf16x8*)z;
            const f32x4 s1a = *(const f32x4*)(sh + A_IN + c0), s1b = *(const f32x4*)(sh + A_IN + c0 + 4);
#pragma unroll
            for (int e = 0; e < 8; ++e) v[e] = (e < 4 ? s1a[e] : s1b[e - 4]) * bf2f((bf16_t)zc[e]);
            if (t > 0) { const bf16x8 zp = *(const bf16x8*)(z - ZP); const f32x4 a = *(const f32x4*)(sh + c0), b = *(const f32x4*)(sh + c0 + 4);
#pragma unroll
                for (int e = 0; e < 8; ++e) v[e] += (e < 4 ? a[e] : b[e - 4]) * bf2f((bf16_t)zp[e]); }
            if (t < len - 1) { const bf16x8 zn = *(const bf16x8*)(z + ZP); const f32x4 a = *(const f32x4*)(sh + 2 * A_IN + c0), b = *(const f32x4*)(sh + 2 * A_IN + c0 + 4);
#pragma unroll
                for (int e = 0; e < 8; ++e) v[e] += (e < 4 ? a[e] : b[e - 4]) * bf2f((bf16_t)zn[e]); }
        }
        float nrm = 0.f;
        if (ch >= 32 && ch < 64) {
#pragma unroll
            for (int e = 0; e < 8; ++e) { const float t2 = v[e] * p.a_k_k[l * DA + c0 - 256 + e]; nrm += t2 * t2; } }
        nrm = sum8(nrm);
        if (!act) continue;
        if (c0 < 768) {
            float* dst = (c0 < 256 ? p.sR + (size_t)m * DA + c0 : c0 < 512 ? p.kT + (size_t)m * DA + c0 - 256 : p.sV + (size_t)m * DA + c0 - 512);
            *(f32x4*)dst = (f32x4){v[0], v[1], v[2], v[3]}; *(f32x4*)(dst + 4) = (f32x4){v[4], v[5], v[6], v[7]};
            if (ch >= 32 && ch < 64 && (ch & 7) == 0) p.kN[(size_t)m * 4 + ((ch - 32) >> 3)] = 1.0f / sqrtf(nrm + 1e-12f);
        } else {
            if (c0 < 896) {
#pragma unroll
                for (int e = 0; e < 8; ++e) v[e] = tanh_fast(v[e]); }
            else if (c0 >= 1024) {
#pragma unroll
                for (int e = 0; e < 8; ++e) v[e] = 1.0f / (1.0f + __expf(-v[e])); }
            uint4 o; o.x = pk2(v[0], v[1]); o.y = pk2(v[2], v[3]); o.z = pk2(v[4], v[5]); o.w = pk2(v[6], v[7]);
            *(uint4*)(p.LA + (size_t)m * 416 + c0 - 768) = o;
        }
    }
}
__device__ __forceinline__ void g_streams_s2(const Params& p, int l, char* lds) {
    const int tid_ = opq_tid(), bid_ = opq_bid(); (void)tid_; (void)bid_;
    constexpr int MT = T / 128;
    for (int job = bid_; job < 5 * MT * 2; job += gridDim.x) {
        const int type = job / (MT * 2), r = job % (MT * 2), tm = r >> 1, tn = r & 1;
        const int coff = type < 2 ? type * 64 : type < 4 ? 128 + (type - 2) * 64 : 256, K = type < 4 ? 64 : 160, d = type & 1;
        const bf16_t* Bt = type < 2 ? p.wupT + type * 256 * 64 : type < 4 ? p.aupT + (type - 2) * 256 * 64 : p.gupT;
        const bf16_t* a0 = p.LA + (size_t)(tm * 128 + STG_ROW(0)) * 416 + coff + STG_K; const bf16_t* a1 = p.LA + (size_t)(tm * 128 + STG_ROW(1)) * 416 + coff + STG_K;
        const bf16_t* b0 = Bt + (size_t)(tn * 128 + STG_ROW(0)) * K + STG_K; const bf16_t* b1 = Bt + (size_t)(tn * 128 + STG_ROW(1)) * K + STG_K;
        if (type < 2) gemm_tile(a0, a1, b0, b1, K, lds, [&](const f32x4 (&acc)[4][4], int wr, int wc, int fr, int fq) {
#pragma unroll
            for (int mi = 0; mi < 4; ++mi) {
#pragma unroll
                for (int n = 0; n < 4; ++n) { const int c = tn * 128 + wc * 64 + n * 16 + fr; const float w0 = p.a_w0[(l * 2 + d) * DA + c];
#pragma unroll
                    for (int j = 0; j < 4; ++j) { const int row = tm * 128 + wr * 64 + mi * 16 + fq * 4 + j;
                        const float e = __expf(-(w0 + acc[mi][n][j]));
                        p.sW[((size_t)d * T + row) * DA + c] = __expf(-0.60653065971f / (1.0f + e)); } }
                asm volatile("" ::: "memory"); }
        });
        else if (type < 4) gemm_tile(a0, a1, b0, b1, K, lds, [&](const f32x4 (&acc)[4][4], int wr, int wc, int fr, int fq) {
#pragma unroll
            for (int mi = 0; mi < 4; ++mi) {
#pragma unroll
                for (int n = 0; n < 4; ++n) { const int c = tn * 128 + wc * 64 + n * 16 + fr;
                    const float a0v = p.a_a0[(l * 2 + d) * DA + c], kkc = p.a_k_k[l * DA + c], kac = p.a_k_a[l * DA + c];
#pragma unroll
                    for (int j = 0; j < 4; ++j) { const int row = tm * 128 + wr * 64 + mi * 16 + fq * 4 + j;
                        const size_t o = (size_t)row * DA + c, od = ((size_t)d * T + row) * DA + c;
                        const float av = 1.0f / (1.0f + __expf(-(a0v + acc[mi][n][j]))); const float k = p.kT[o];
                        const float kk = k * kkc * p.kN[(size_t)row * 4 + (c >> 6)];
                        p.sKD[od] = k * (1.0f + (av - 1.0f) * kac); p.sB[od] = kk * av; if (d == 0) p.sKK[o] = kk; } }
                asm volatile("" ::: "memory"); }
        });
        else gemm_tile(a0, a1, b0, b1, K, lds, [&](const f32x4 (&acc)[4][4], int wr, int wc, int fr, int fq) {
#pragma unroll
            for (int mi = 0; mi < 4; ++mi)
#pragma unroll
                for (int n = 0; n < 4; ++n) { const int c = tn * 128 + wc * 64 + n * 16 + fr;
#pragma unroll
                    for (int j = 0; j < 4; ++j) p.sG[(size_t)(tm * 128 + wr * 64 + mi * 16 + fq * 4 + j) * DA + c] = acc[mi][n][j]; }
        });
    }
}


typedef float f32x16 __attribute__((ext_vector_type(16)));
typedef short s16x4 __attribute__((ext_vector_type(4)));
typedef unsigned u32x4_t __attribute__((ext_vector_type(4)));
typedef float f32x2_t __attribute__((ext_vector_type(2)));
typedef __bf16 bf16x2_t __attribute__((ext_vector_type(2)));
__device__ __forceinline__ unsigned cvtpk(float lo, float hi) { f32x2_t v = {lo, hi}; bf16x2_t b = __builtin_convertvector(v, bf16x2_t); return __builtin_bit_cast(unsigned, b); }
__device__ __forceinline__ int crow(int r, int hi) { return (r & 3) + 8 * (r >> 2) + 4 * hi; }

template <class MaskF>
__device__ __forceinline__ void attn_tile(const bf16x8 (&qf)[4], const bf16_t* krow, const bf16_t* vt0, const bf16_t* vt1, const MaskF& mask,
                                          float& m_run, float& l_run, f32x16& o0, f32x16& o1, int hi) {
    f32x16 s;
#pragma unroll
    for (int r = 0; r < 16; ++r) s[r] = 0.f;
#pragma unroll
    for (int ks = 0; ks < 4; ++ks) { const bf16x8 kf = *(const bf16x8*)(krow + 16 * ks); s = __builtin_amdgcn_mfma_f32_32x32x16_bf16(kf, qf[ks], s, 0, 0, 0); }
    float mx = -INFINITY;
#pragma unroll
    for (int r = 0; r < 16; ++r) { s[r] = mask(crow(r, hi), s[r] * ATT_SCALE); mx = fmaxf(mx, s[r]); }
    mx = fmaxf(mx, __shfl_xor(mx, 32));
    const float mn = fmaxf(m_run, mx), alpha = __expf(m_run - mn);
    m_run = mn;
    float ps = 0.f;
#pragma unroll
    for (int r = 0; r < 16; ++r) { s[r] = __expf(s[r] - mn); ps += s[r]; }
    l_run = l_run * alpha + ps;
#pragma unroll
    for (int r = 0; r < 16; ++r) { o0[r] *= alpha; o1[r] *= alpha; }
#pragma unroll
    for (int s2 = 0; s2 < 2; ++s2) {
        u32x4_t pw; pw[0] = cvtpk(s[8 * s2], s[8 * s2 + 1]); pw[1] = cvtpk(s[8 * s2 + 2], s[8 * s2 + 3]); pw[2] = cvtpk(s[8 * s2 + 4], s[8 * s2 + 5]); pw[3] = cvtpk(s[8 * s2 + 6], s[8 * s2 + 7]);
        const bf16x8 pb = __builtin_bit_cast(bf16x8, pw);
        const s16x4 a0 = *(const s16x4*)(vt0 + 16 * s2), a1 = *(const s16x4*)(vt0 + 16 * s2 + 8);
        const s16x4 c0 = *(const s16x4*)(vt1 + 16 * s2), c1 = *(const s16x4*)(vt1 + 16 * s2 + 8);
        o0 = __builtin_amdgcn_mfma_f32_32x32x16_bf16(__builtin_shufflevector(a0, a1, 0, 1, 2, 3, 4, 5, 6, 7), pb, o0, 0, 0, 0);
        o1 = __builtin_amdgcn_mfma_f32_32x32x16_bf16(__builtin_shufflevector(c0, c1, 0, 1, 2, 3, 4, 5, 6, 7), pb, o1, 0, 0, 0);
    }
}
struct NoMask { __device__ __forceinline__ float operator()(int, float v) const { return v; } };

__device__ __forceinline__ void ph_attn_mfma(const Params& p, int l, bool with_ctx) {
    const int tid_ = opq_tid(), bid_ = opq_bid(); (void)tid_; (void)bid_;
    const int lane = tid_ & 63, hi = lane >> 5, ql = lane & 31;
    const int gw = bid_ * 4 + (tid_ >> 6), nw = gridDim.x * 4;
    constexpr int NQT = S / 32, NCT = L / 32, N_LAT = NB * 6 * NQT, N_CTX = NB * 6 * NCT;
    const int ntask = 2 * N_LAT + (with_ctx ? 2 * N_CTX : 0);
    for (int task = gw; task < ntask; task += nw) {
        bool isC, isCtx; int r;
        if (task < N_LAT) { isC = true; isCtx = false; r = task; }
        else if (task < 2 * N_LAT) { isC = false; isCtx = false; r = task - N_LAT; }
        else { r = task - 2 * N_LAT; isCtx = true; isC = r >= N_CTX; if (isC) r -= N_CTX; }
        const int nqt = isCtx ? NCT : NQT, qt = r % nqt, h = (r / nqt) % 6, b = r / (nqt * 6);
        const int m = isCtx ? TL + b * L + 32 * qt + ql : b * S + 32 * qt + ql;
        const int qcol = isC ? ZQN + h * 64 : ZQB + h * 64, kcol = isC ? ZKN + h * 64 : ZKB + (h / 3) * 64, hv = isC ? 2 + h : h / 3;
        bf16x8 qf[4];
        { const bf16_t* qp = p.Z + (size_t)m * ZP + qcol + 8 * hi;
#pragma unroll
          for (int ks = 0; ks < 4; ++ks) qf[ks] = *(const bf16x8*)(qp + 16 * ks); }
        const bf16_t* kc0 = p.Z + (size_t)(TL + b * L + ql) * ZP + kcol + 8 * hi;
        const bf16_t* kl0 = p.Z + (size_t)(b * S + ql) * ZP + kcol + 8 * hi;
        const bf16_t* vt0 = p.VT + ((size_t)(b * 8 + hv) * 64 + ql) * PU + 4 * hi; const bf16_t* vt1 = vt0 + (size_t)32 * PU;
        f32x16 o0, o1;
#pragma unroll
        for (int rr = 0; rr < 16; ++rr) { o0[rr] = 0.f; o1[rr] = 0.f; }
        float m_run, l_run;
        if (isC) { m_run = -1e30f; l_run = 0.f; } else { m_run = p.b_sink[l * 6 + h]; l_run = hi == 0 ? 1.0f : 0.f; }
#pragma unroll 1
        for (int i = 0; i < NCT; ++i) attn_tile(qf, kc0 + (size_t)(32 * i) * ZP, vt0 + 32 * i, vt1 + 32 * i, NoMask(), m_run, l_run, o0, o1, hi);
        if (!isCtx) {
            if (!isC) {
#pragma unroll 1
                for (int jt = qt - 4; jt <= qt + 4; ++jt) {
                    if (jt < 0 || jt >= NQT) continue;
                    const bf16_t* kr = kl0 + (size_t)(32 * jt) * ZP; const bf16_t* v0 = vt0 + L + 32 * jt; const bf16_t* v1 = vt1 + L + 32 * jt;
                    if (jt == qt - 4 || jt == qt + 4) { const int base = 32 * (jt - qt) - ql;
                        attn_tile(qf, kr, v0, v1, [&](int ko, float v) { const int rel = base + ko; return (rel >= -128 && rel <= 128) ? v : -INFINITY; }, m_run, l_run, o0, o1, hi); }
                    else attn_tile(qf, kr, v0, v1, NoMask(), m_run, l_run, o0, o1, hi);
                }
            } else {
                constexpr int ROWS = S / GRID_W;
                const int gr = qt >> 1, c = 32 * (qt & 1) + ql;
                int r0 = gr - 4; r0 = r0 < 0 ? 0 : (r0 > ROWS - 8 ? ROWS - 8 : r0);
                int c0 = c - 8; c0 = c0 < 0 ? 0 : (c0 > GRID_W - 16 ? GRID_W - 16 : c0);
                const float* rpb = p.c_rpb + ((size_t)l * 6 + h) * 15 * 31;
#pragma unroll 1
                for (int a = 0; a < 8; ++a) {
                    const int kr_ = r0 + a; const float* rp = rpb + (kr_ - gr + 7) * 31 + 15 - c;
#pragma unroll 1
                    for (int ct = 0; ct < 2; ++ct) {
                        const int t0 = kr_ * GRID_W + 32 * ct;
                        attn_tile(qf, kl0 + (size_t)t0 * ZP, vt0 + L + t0, vt1 + L + t0,
                                  [&](int ko, float v) { const int kc = 32 * ct + ko; return (kc >= c0 && kc < c0 + 16) ? v + rp[kc] : -INFINITY; }, m_run, l_run, o0, o1, hi);
                    }
                }
            }
        }
        const float lt = l_run + __shfl_xor(l_run, 32), inv = 1.0f / lt;
        bf16_t* op = p.MIX + (size_t)m * DMIX + (isC ? 640 : 256) + h * 64 + 4 * hi;
#pragma unroll
        for (int g = 0; g < 4; ++g) {
            st_bf16x4(op + 8 * g, (f32x4){o0[4 * g] * inv, o0[4 * g + 1] * inv, o0[4 * g + 2] * inv, o0[4 * g + 3] * inv});
            st_bf16x4(op + 32 + 8 * g, (f32x4){o1[4 * g] * inv, o1[4 * g + 1] * inv, o1[4 * g + 2] * inv, o1[4 * g + 3] * inv});
        }
    }
}


template <class MaskF>
__device__ __forceinline__ void attn_tile_lds(const bf16x8 (&qf)[4], const char* ks, const char* vs, const MaskF& mask, float& m_run, float& l_run, f32x16& o0, f32x16& o1, int ql, int hi) {
    f32x16 s;
#pragma unroll
    for (int r = 0; r < 16; ++r) s[r] = 0.f;
#pragma unroll
    for (int k4 = 0; k4 < 4; ++k4) { const bf16x8 kf = *(const bf16x8*)(ks + ql * 128 + (((2 * k4 + hi) ^ (ql & 7)) * 16)); s = __builtin_amdgcn_mfma_f32_32x32x16_bf16(kf, qf[k4], s, 0, 0, 0); }
    float mx = -INFINITY;
#pragma unroll
    for (int r = 0; r < 16; ++r) { s[r] = mask(crow(r, hi), s[r] * ATT_SCALE); mx = fmaxf(mx, s[r]); }
    mx = fmaxf(mx, __shfl_xor(mx, 32));
    const float mn = fmaxf(m_run, mx), alpha = __expf(m_run - mn);
    m_run = mn;
    float ps = 0.f;
#pragma unroll
    for (int r = 0; r < 16; ++r) { s[r] = __expf(s[r] - mn); ps += s[r]; }
    l_run = l_run * alpha + ps;
#pragma unroll
    for (int r = 0; r < 16; ++r) { o0[r] *= alpha; o1[r] *= alpha; }
    const int sw0 = (ql >> 2) & 3;
#pragma unroll
    for (int s2 = 0; s2 < 2; ++s2) {
        u32x4_t pw; pw[0] = cvtpk(s[8 * s2], s[8 * s2 + 1]); pw[1] = cvtpk(s[8 * s2 + 2], s[8 * s2 + 3]); pw[2] = cvtpk(s[8 * s2 + 4], s[8 * s2 + 5]); pw[3] = cvtpk(s[8 * s2 + 6], s[8 * s2 + 7]);
        const bf16x8 pb = __builtin_bit_cast(bf16x8, pw);
        const char* v0 = vs + ql * 64 + 8 * hi; const char* v1 = v0 + 32 * 64;
        const s16x4 a0 = *(const s16x4*)(v0 + (((2 * s2) ^ sw0) * 16)), a1 = *(const s16x4*)(v0 + (((2 * s2 + 1) ^ sw0) * 16));
        const s16x4 c0 = *(const s16x4*)(v1 + (((2 * s2) ^ sw0) * 16)), c1 = *(const s16x4*)(v1 + (((2 * s2 + 1) ^ sw0) * 16));
        o0 = __builtin_amdgcn_mfma_f32_32x32x16_bf16(__builtin_shufflevector(a0, a1, 0, 1, 2, 3, 4, 5, 6, 7), pb, o0, 0, 0, 0);
        o1 = __builtin_amdgcn_mfma_f32_32x32x16_bf16(__builtin_shufflevector(c0, c1, 0, 1, 2, 3, 4, 5, 6, 7), pb, o1, 0, 0, 0);
    }
}

__device__ __forceinline__ void ph_attn_blk(const Params& p, int l, bool with_ctx, int first_blk, char* lds) {
    const int tid_ = opq_tid(), bid_ = opq_bid(); (void)tid_; (void)bid_;
    if (bid_ < first_blk) return;
    const int lane = tid_ & 63, hi = lane >> 5, ql = lane & 31, wid = tid_ >> 6;
    constexpr int NQG = S / 128, NCG = L / 128, ROWS = S / GRID_W, N_LAT = NB * 6 * NQG, N_CTX = NB * 6 * NCG, TPB = (S + L) / 32;
    const int ntask = 2 * N_LAT + (with_ctx ? 2 * N_CTX : 0);
    const int krow = tid_ >> 3, kch = (tid_ & 7) ^ (krow & 7), vrow = tid_ >> 2, vpc = (tid_ & 3) ^ ((vrow >> 2) & 3);
    for (int task = bid_ - first_blk; task < ntask; task += gridDim.x - first_blk) {
        bool isC, isCtx; int r;
        if (task < N_LAT) { isC = true; isCtx = false; r = task; }
        else if (task < 2 * N_LAT) { isC = false; isCtx = false; r = task - N_LAT; }
        else { r = task - 2 * N_LAT; isCtx = true; isC = r >= N_CTX; if (isC) r -= N_CTX; }
        const int ng = isCtx ? NCG : NQG, g = r % ng, h = (r / ng) % 6, b = r / (ng * 6);
        const int qt = 4 * g + wid;
        const int m = isCtx ? TL + b * L + 32 * qt + ql : b * S + 32 * qt + ql;
        const int qcol = isC ? ZQN + h * 64 : ZQB + h * 64, kcol = isC ? ZKN + h * 64 : ZKB + (h / 3) * 64, hv = isC ? 2 + h : h / 3;
        bf16x8 qf[4];
        { const bf16_t* qp = p.Z + (size_t)m * ZP + qcol + 8 * hi;
#pragma unroll
          for (int k4 = 0; k4 < 4; ++k4) qf[k4] = *(const bf16x8*)(qp + 16 * k4); }
        int lo = 0, hi_t = 0, gr0 = 0;
        if (!isCtx) {
            if (!isC) { lo = 4 * g - 4; hi_t = 4 * g + 8; lo = lo < 0 ? 0 : lo; hi_t = hi_t > S / 32 ? S / 32 : hi_t; }
            else { const int ra = 2 * g, rb = 2 * g + 1; int r0a = ra - 4; r0a = r0a < 0 ? 0 : (r0a > ROWS - 8 ? ROWS - 8 : r0a); int r0b = rb - 4; r0b = r0b < 0 ? 0 : (r0b > ROWS - 8 ? ROWS - 8 : r0b);
                   lo = 2 * r0a; hi_t = 2 * (r0b + 8); gr0 = 0; }
        }
        const int ntile = L / 32 + (hi_t - lo);
        const bf16_t* kbase = p.Z + (size_t)krow * ZP + kcol + 8 * kch;
        const bf16_t* vbase = p.VT + ((size_t)(b * 8 + hv) * 64 + vrow) * PU + 8 * vpc;
#define AT_TOK(i_) ((i_) < L / 32 ? 32 * (i_) : L + 32 * (lo + (i_) - L / 32))
#define AT_STAGE(i_) do { const int u0_ = AT_TOK(i_); const int zrow_ = u0_ < L ? TL + b * L + u0_ : b * S + (u0_ - L); char* sl_ = lds + ((i_) % 3) * 8192 + tid_ * 16; \
            __builtin_amdgcn_global_load_lds((const unsigned*)(kbase + (size_t)zrow_ * ZP), (__attribute__((address_space(3))) unsigned*)(sl_), 16, 0, 0); \
            __builtin_amdgcn_global_load_lds((const unsigned*)(vbase + u0_), (__attribute__((address_space(3))) unsigned*)(sl_ + 4096), 16, 0, 0); } while (0)
        f32x16 o0, o1;
#pragma unroll
        for (int rr = 0; rr < 16; ++rr) { o0[rr] = 0.f; o1[rr] = 0.f; }
        float m_run, l_run;
        if (isC) { m_run = -1e30f; l_run = 0.f; } else { m_run = p.b_sink[l * 6 + h]; l_run = hi == 0 ? 1.0f : 0.f; }
        const int gr = qt >> 1, c = 32 * (qt & 1) + ql;
        int r0 = gr - 4; r0 = r0 < 0 ? 0 : (r0 > ROWS - 8 ? ROWS - 8 : r0);
        int c0 = c - 8; c0 = c0 < 0 ? 0 : (c0 > GRID_W - 16 ? GRID_W - 16 : c0);
        float* rpb = (float*)(lds + 24576);
        if (isC && !isCtx) for (int i = tid_; i < 15 * 31; i += 256) rpb[i] = p.c_rpb[((size_t)l * 6 + h) * 15 * 31 + i];
        AT_STAGE(0);
        if (ntile > 1) AT_STAGE(1);
#pragma unroll 1
        for (int i = 0; i < ntile; ++i) {
            if (i + 1 < ntile) asm volatile("s_waitcnt vmcnt(2)" ::: "memory"); else asm volatile("s_waitcnt vmcnt(0)" ::: "memory");
            asm volatile("s_waitcnt lgkmcnt(0)" ::: "memory");
            __builtin_amdgcn_s_barrier();
            if (i + 2 < ntile) AT_STAGE(i + 2);
            const char* ks = lds + (i % 3) * 8192; const char* vs = ks + 4096;
            if (i < L / 32) attn_tile_lds(qf, ks, vs, NoMask(), m_run, l_run, o0, o1, ql, hi);
            else {
                const int jt = lo + i - L / 32;
                if (!isC) {
                    const int dq = jt - qt;
                    if (dq >= -3 && dq <= 3) attn_tile_lds(qf, ks, vs, NoMask(), m_run, l_run, o0, o1, ql, hi);
                    else if (dq == -4 || dq == 4) { const int base = 32 * dq - ql;
                        attn_tile_lds(qf, ks, vs, [&](int ko, float v) { const int rel = base + ko; return (rel >= -128 && rel <= 128) ? v : -INFINITY; }, m_run, l_run, o0, o1, ql, hi); }
                } else {
                    const int kr_ = jt >> 1, ct = jt & 1;
                    if (kr_ >= r0 && kr_ < r0 + 8) { const float* rp = rpb + (kr_ - gr + 7) * 31 + 15 - c;
                        attn_tile_lds(qf, ks, vs, [&](int ko, float v) { const int kc = 32 * ct + ko; return (kc >= c0 && kc < c0 + 16) ? v + rp[kc] : -INFINITY; }, m_run, l_run, o0, o1, ql, hi); }
                }
            }
        }
        asm volatile("s_waitcnt lgkmcnt(0)" ::: "memory");
        __builtin_amdgcn_s_barrier();
#undef AT_STAGE
#undef AT_TOK
        (void)gr0;
        const float lt = l_run + __shfl_xor(l_run, 32), inv = 1.0f / lt;
        bf16_t* op = p.MIX + (size_t)m * DMIX + (isC ? 640 : 256) + h * 64 + 4 * hi;
#pragma unroll
        for (int gq = 0; gq < 4; ++gq) {
            st_bf16x4(op + 8 * gq, (f32x4){o0[4 * gq] * inv, o0[4 * gq + 1] * inv, o0[4 * gq + 2] * inv, o0[4 * gq + 3] * inv});
            st_bf16x4(op + 32 + 8 * gq, (f32x4){o1[4 * gq] * inv, o1[4 * gq + 1] * inv, o1[4 * gq + 2] * inv, o1[4 * gq + 3] * inv});
        }
    }
}

#define RNB " row_newbcast:%c[n] row_mask:0xf bank_mask:0xf\n\t"
template <int N, bool FIRST>
__device__ __forceinline__ void dpp_dot4(float& a0, float& a1, float& a2, float& a3, const f32x4& v, float s0, float s1, float s2, float s3) {
    if (FIRST) asm volatile("s_nop 1");
    asm("v_fmac_f32_dpp %0, %4, %8" RNB "v_fmac_f32_dpp %1, %5, %9" RNB "v_fmac_f32_dpp %2, %6, %10" RNB "v_fmac_f32_dpp %3, %7, %11" RNB
        : "+v"(a0), "+v"(a1), "+v"(a2), "+v"(a3) : "v"(v[0]), "v"(v[1]), "v"(v[2]), "v"(v[3]), "v"(s0), "v"(s1), "v"(s2), "v"(s3), [n] "i"(N));
}
template <int N, bool FIRST>
__device__ __forceinline__ void dpp_upd4s(float& s0, float& s1, float& s2, float& s3, float& y0, float& y1, float& y2, float& y3,
                                          const f32x4& w, const f32x4& b, const f32x4& kd, const f32x4& r, float nsk, float vv) {
    if (FIRST) asm volatile("s_nop 1");
    asm("v_mul_f32_dpp %0, %8, %0" RNB "v_mul_f32_dpp %1, %9, %1" RNB "v_mul_f32_dpp %2, %10, %2" RNB "v_mul_f32_dpp %3, %11, %3" RNB
        "v_fmac_f32_dpp %0, %12, %24" RNB "v_fmac_f32_dpp %1, %13, %24" RNB "v_fmac_f32_dpp %2, %14, %24" RNB "v_fmac_f32_dpp %3, %15, %24" RNB
        "v_fmac_f32_dpp %0, %16, %25" RNB "v_fmac_f32_dpp %1, %17, %25" RNB "v_fmac_f32_dpp %2, %18, %25" RNB "v_fmac_f32_dpp %3, %19, %25" RNB
        "v_fmac_f32_dpp %4, %20, %0" RNB "v_fmac_f32_dpp %5, %21, %1" RNB "v_fmac_f32_dpp %6, %22, %2" RNB "v_fmac_f32_dpp %7, %23, %3" RNB
        : "+v"(s0), "+v"(s1), "+v"(s2), "+v"(s3), "+v"(y0), "+v"(y1), "+v"(y2), "+v"(y3)
        : "v"(w[0]), "v"(w[1]), "v"(w[2]), "v"(w[3]), "v"(b[0]), "v"(b[1]), "v"(b[2]), "v"(b[3]), "v"(kd[0]), "v"(kd[1]), "v"(kd[2]), "v"(kd[3]),
          "v"(r[0]), "v"(r[1]), "v"(r[2]), "v"(r[3]), "v"(nsk), "v"(vv), [n] "i"(N));
}
template <int N, bool FIRST>
__device__ __forceinline__ void dpp_upd4p(float& s0, float& s1, float& s2, float& s3, float& y0, float& y1, float& y2, float& y3,
                                          const f32x4& w, const f32x4& b, const f32x4& r, float nsk) {
    if (FIRST) asm volatile("s_nop 1");
    asm("v_mul_f32_dpp %0, %8, %0" RNB "v_mul_f32_dpp %1, %9, %1" RNB "v_mul_f32_dpp %2, %10, %2" RNB "v_mul_f32_dpp %3, %11, %3" RNB
        "v_fmac_f32_dpp %0, %12, %20" RNB "v_fmac_f32_dpp %1, %13, %20" RNB "v_fmac_f32_dpp %2, %14, %20" RNB "v_fmac_f32_dpp %3, %15, %20" RNB
        "v_fmac_f32_dpp %4, %16, %0" RNB "v_fmac_f32_dpp %5, %17, %1" RNB "v_fmac_f32_dpp %6, %18, %2" RNB "v_fmac_f32_dpp %7, %19, %3" RNB
        : "+v"(s0), "+v"(s1), "+v"(s2), "+v"(s3), "+v"(y0), "+v"(y1), "+v"(y2), "+v"(y3)
        : "v"(w[0]), "v"(w[1]), "v"(w[2]), "v"(w[3]), "v"(b[0]), "v"(b[1]), "v"(b[2]), "v"(b[3]), "v"(r[0]), "v"(r[1]), "v"(r[2]), "v"(r[3]), "v"(nsk), [n] "i"(N));
}
template <int N> struct ScanRep {
    static __device__ __forceinline__ void dot(float& a0, float& a1, float& a2, float& a3, const f32x4& v, const float (&st)[64]) {
        dpp_dot4<N, N == 0>(a0, a1, a2, a3, v, st[4 * N], st[4 * N + 1], st[4 * N + 2], st[4 * N + 3]);
        if constexpr (N < 15) ScanRep<N + 1>::dot(a0, a1, a2, a3, v, st);
    }
    static __device__ __forceinline__ void upds(float (&st)[64], float& y0, float& y1, float& y2, float& y3, const f32x4& w, const f32x4& b, const f32x4& kd, const f32x4& r, float nsk, float vv) {
        dpp_upd4s<N, N == 0>(st[4 * N], st[4 * N + 1], st[4 * N + 2], st[4 * N + 3], y0, y1, y2, y3, w, b, kd, r, nsk, vv);
        if constexpr (N < 15) ScanRep<N + 1>::upds(st, y0, y1, y2, y3, w, b, kd, r, nsk, vv);
    }
    static __device__ __forceinline__ void updp(float (&st)[64], float& y0, float& y1, float& y2, float& y3, const f32x4& w, const f32x4& b, const f32x4& r, float nsk) {
        dpp_upd4p<N, N == 0>(st[4 * N], st[4 * N + 1], st[4 * N + 2], st[4 * N + 3], y0, y1, y2, y3, w, b, r, nsk);
        if constexpr (N < 15) ScanRep<N + 1>::updp(st, y0, y1, y2, y3, w, b, r, nsk);
    }
};
__device__ __forceinline__ int seg_row0(int b, int d, int s) { const int pos0 = 128 * s; return pos0 < L ? TL + b * L + (d ? L - 1 - pos0 : pos0) : b * S + (d ? S - 1 - (pos0 - L) : pos0 - L); }

template <bool ISP>
__device__ __forceinline__ void scan_task(const Params& p, int c, int s, int lane) {
    const int h = c & 3, b = (c >> 2) % NB, d = (c >> 2) / NB;
    const int m0 = seg_row0(b, d, s); const long step = d ? -(long)DA : (long)DA;
    const size_t o = (size_t)m0 * DA + h * 64, od = ((size_t)d * T + m0) * DA + h * 64; const int q = 4 * (lane & 15);
    const float* pkk = p.sKK + o + q; const float* pr = p.sR + o + q; const float* pw = p.sW + od + q; const float* pb = p.sB + od + q;
    const float* pkd = p.sKD + od + q; const float* pv = p.sV + o + lane;
    float* py = (ISP ? p.PV : p.Y) + od + lane;
    float st[64];
#pragma unroll
    for (int k = 0; k < 64; ++k) st[k] = (ISP && k == lane) ? 1.0f : 0.f;
    f32x4 kk = *(const f32x4*)pkk, w = *(const f32x4*)pw, bb = *(const f32x4*)pb, r = *(const f32x4*)pr, kd = w; float vv = 0.f;
    if (!ISP) { kd = *(const f32x4*)pkd; vv = *pv; }
#pragma unroll 1
    for (int i = 0; i < 128; ++i) {
        const long nx = (i < 127) ? step : 0;
        pkk += nx; pw += nx; pb += nx; pr += nx; pkd += nx; pv += nx;
        const f32x4 nkk = *(const f32x4*)pkk, nw = *(const f32x4*)pw, nb = *(const f32x4*)pb, nr = *(const f32x4*)pr;
        f32x4 nkd = nw; float nv = 0.f;
        if (!ISP) { nkd = *(const f32x4*)pkd; nv = *pv; }
        float a0 = 0.f, a1 = 0.f, a2 = 0.f, a3 = 0.f;
        ScanRep<0>::dot(a0, a1, a2, a3, kk, st);
        const float nsk = -((a0 + a1) + (a2 + a3));
        float y0 = 0.f, y1 = 0.f, y2 = 0.f, y3 = 0.f;
        if (ISP) ScanRep<0>::updp(st, y0, y1, y2, y3, w, bb, r, nsk); else ScanRep<0>::upds(st, y0, y1, y2, y3, w, bb, kd, r, nsk, vv);
        *py = (y0 + y1) + (y2 + y3); py += step;
        kk = nkk; w = nw; bb = nb; r = nr; kd = nkd; vv = nv;
    }
    if (s < NSG - 1) {
        float* dst = (ISP ? p.PS : p.QS) + (((size_t)c * NSG + s) * 64 + lane) * 64;
#pragma unroll
        for (int k4 = 0; k4 < 16; ++k4) *(f32x4*)(dst + 4 * k4) = (f32x4){st[4 * k4], st[4 * k4 + 1], st[4 * k4 + 2], st[4 * k4 + 3]};
    }
}
__device__ __forceinline__ void ph_scan_fast(const Params& p) {
    const int tid_ = opq_tid(), bid_ = opq_bid(); (void)tid_; (void)bid_;
    const int lane = tid_ & 63, gw = bid_ * 4 + (tid_ >> 6), nw = gridDim.x * 4;
    constexpr int NS_T = 64 * NSG, NP_T = 64 * (NSG - 1);
    for (int tsk = gw; tsk < NS_T + NP_T; tsk += nw) {
        const int t2 = __builtin_amdgcn_readfirstlane(tsk);
        if (t2 < NS_T) scan_task<false>(p, t2 & 63, t2 >> 6, lane);
        else scan_task<true>(p, (t2 - NS_T) & 63, 1 + ((t2 - NS_T) >> 6), lane);
    }
}
__device__ __forceinline__ void ph_combine(const Params& p, char* lds) {
    const int tid_ = opq_tid(), bid_ = opq_bid(); (void)tid_; (void)bid_;
    if (bid_ >= 64) return;
    const int c = bid_, tid = tid_, v = tid >> 2, jq = tid & 3;
    float* SSc = (float*)lds; float* Pm = (float*)(lds + 64 * 65 * 4 + 16);
    const float* QSc = p.QS + (size_t)c * NSG * 4096; const float* PSc = p.PS + (size_t)c * NSG * 4096; float* SSg = p.SS + (size_t)c * NSG * 4096;
    f32x4 acc[4], nP[4], nQ[4];
#pragma unroll
    for (int i = 0; i < 4; ++i) { acc[i] = *(const f32x4*)(QSc + v * 64 + 16 * jq + 4 * i);
#pragma unroll
        for (int e = 0; e < 4; ++e) { SSg[4096 + (16 * jq + 4 * i + e) * 64 + v] = acc[i][e]; SSc[v * 65 + 16 * jq + 4 * i + e] = acc[i][e]; } }
#pragma unroll
    for (int i = 0; i < 4; ++i) { nP[i] = ((const f32x4*)(PSc + (size_t)4096))[tid + 256 * i]; nQ[i] = *(const f32x4*)(QSc + (size_t)4096 + v * 64 + 16 * jq + 4 * i); }
    for (int s = 1; s < NSG - 1; ++s) {
#pragma unroll
        for (int i = 0; i < 4; ++i) { ((f32x4*)Pm)[tid + 256 * i] = nP[i]; acc[i] = nQ[i]; }
        __syncthreads();
        if (s + 1 < NSG - 1) {
#pragma unroll
            for (int i = 0; i < 4; ++i) { nP[i] = ((const f32x4*)(PSc + (size_t)(s + 1) * 4096))[tid + 256 * i]; nQ[i] = *(const f32x4*)(QSc + (size_t)(s + 1) * 4096 + v * 64 + 16 * jq + 4 * i); }
        }
#pragma unroll 8
        for (int k = 0; k < 64; ++k) { const float a = SSc[v * 65 + k];
#pragma unroll
            for (int i = 0; i < 4; ++i) acc[i] += ((const f32x4*)Pm)[k * 16 + 4 * jq + i] * a; }
        __syncthreads();
#pragma unroll
        for (int i = 0; i < 4; ++i) {
#pragma unroll
            for (int e = 0; e < 4; ++e) { SSg[(size_t)(s + 1) * 4096 + (16 * jq + 4 * i + e) * 64 + v] = acc[i][e]; SSc[v * 65 + 16 * jq + 4 * i + e] = acc[i][e]; } }
    }
}
__device__ __forceinline__ void ph_rwkv_out_fast(const Params& p, int l, bool with_ctx) {
    const int tid_ = opq_tid(), bid_ = opq_bid(); (void)tid_; (void)bid_;
    const int lane = tid_ & 63, gw = bid_ * 4 + (tid_ >> 6), nw = gridDim.x * 4;
    constexpr int TOK = 16, NLT = NB * (S / TOK) * 4, NCTK = NB * (L / TOK) * 4;
    const int ntask = NLT + (with_ctx ? NCTK : 0);
    for (int tsk = gw; tsk < ntask; tsk += nw) {
        const bool isCtx = tsk >= NLT; const int r = isCtx ? tsk - NLT : tsk;
        const int h = r & 3, npt = isCtx ? L / TOK : S / TOK, tt = (r >> 2) % npt, b = (r >> 2) / npt, t128 = tt / (128 / TOK);
        const int seg0 = isCtx ? t128 : L / 128 + t128, seg1 = isCtx ? (L / 128 - 1) - t128 : L / 128 + (S / 128 - 1) - t128;
        const int mbase = isCtx ? TL + b * L + TOK * tt : b * S + TOK * tt;
        float ss0[64], ss1[64];
        { const float* s0p = p.SS + (((size_t)(0 * NB + b) * 4 + h) * NSG + seg0) * 4096 + lane; const float* s1p = p.SS + (((size_t)(1 * NB + b) * 4 + h) * NSG + seg1) * 4096 + lane;
#pragma unroll
          for (int k = 0; k < 64; ++k) { ss0[k] = seg0 > 0 ? s0p[k * 64] : 0.f; ss1[k] = seg1 > 0 ? s1p[k * 64] : 0.f; } }
        const float rk = p.a_r_k[l * DA + h * 64 + lane], gln = p.a_lnx_g[l * DA + h * 64 + lane], bln = p.a_lnx_b[l * DA + h * 64 + lane];
        f32x4 pv0 = {0.f, 0.f, 0.f, 0.f}, pv1 = pv0; float y0l, y1l, rr, kds, vv, gg;
#define ROUT_LOAD(i_) do { const size_t o_ = (size_t)(mbase + (i_)) * DA + h * 64, o1_ = o_ + (size_t)T * DA; \
            if (seg0 > 0) pv0 = *(const f32x4*)(p.PV + o_ + 4 * (lane & 15)); if (seg1 > 0) pv1 = *(const f32x4*)(p.PV + o1_ + 4 * (lane & 15)); \
            y0l = p.Y[o_ + lane]; y1l = p.Y[o1_ + lane]; rr = p.sR[o_ + lane]; kds = p.sKD[o_ + lane] + p.sKD[o1_ + lane]; vv = p.sV[o_ + lane]; gg = p.sG[o_ + lane]; } while (0)
        ROUT_LOAD(0);
#pragma unroll 1
        for (int i = 0; i < TOK; ++i) {
            const f32x4 cpv0 = pv0, cpv1 = pv1; float a0 = y0l, a1 = y1l, a2 = 0.f, a3 = 0.f; const float crr = rr, ckds = kds, cvv = vv, cgg = gg;
            ROUT_LOAD(i + 1 < TOK ? i + 1 : i);
            ScanRep<0>::dot(a0, a1, a2, a3, cpv0, ss0);
            ScanRep<0>::dot(a0, a1, a2, a3, cpv1, ss1);
            const float y = (a0 + a1) + (a2 + a3);
            const float mu = wave_sum(y) * (1.0f / 64.f), dy = y - mu;
            const float rstd = 1.0f / sqrtf(wave_sum(dy * dy) * (1.0f / 64.f) + GN_EPS);
            const float bon = wave_sum(crr * ckds * rk);
            p.MIX[(size_t)(mbase + i) * DMIX + h * 64 + lane] = f2bf((dy * rstd * gln + bln + bon * cvv) * cgg);
        }
#undef ROUT_LOAD
    }
}


#define LAS __attribute__((address_space(3)))
#define XB_TMO      128
#define XB_XCNT(j)  (256  + 64 * (j))
#define XB_XSUB(j)  (1280 + 64 * (j))
#define XB_XGEN(j)  (2304 + 64 * (j))
#define XB_TOP      3328
#define XB_TOPGEN   3392
#define XCD_BAR_WORDS 3456
#define XB_SPIN_CAP (1u << 20)
static_assert(XCD_BAR_WORDS * 4 <= 16384, "barrier words fit the control region");
__device__ __forceinline__ unsigned xb_ld(unsigned* p)              { return __hip_atomic_load(p, __ATOMIC_RELAXED, __HIP_MEMORY_SCOPE_AGENT); }
__device__ __forceinline__ unsigned xb_add(unsigned* p, unsigned v) { return __hip_atomic_fetch_add(p, v, __ATOMIC_RELAXED, __HIP_MEMORY_SCOPE_AGENT); }
__device__ __forceinline__ unsigned xb_xcc_id() { return (unsigned)__builtin_amdgcn_s_getreg((3 << 11) | 20) & 0xFu; }
#define XB_SPIN(cond, bar) do { unsigned _sp = 0; while (cond) { __builtin_amdgcn_s_sleep(1); \
    if ((++_sp & 255u) == 0u) { if (xb_ld(&(bar)[XB_TMO])) break; if (_sp > XB_SPIN_CAP) { atomicAdd(&(bar)[XB_TMO], 1u); break; } } } } while (0)
struct XcdBarrier { unsigned* bar; unsigned x; volatile LAS unsigned* st; };
__device__ __forceinline__ XcdBarrier xcd_barrier_post(unsigned* bar, volatile LAS unsigned* st) {
    XcdBarrier b; b.bar = bar; b.x = xb_xcc_id(); b.st = st;
    if (threadIdx.x == 0) (void)xb_add(&bar[XB_XCNT(b.x)], 1u);
    return b;
}
__device__ __forceinline__ void xcd_barrier_complete(unsigned* bar, unsigned x, unsigned& nloc, unsigned& nx) {
    const unsigned G = gridDim.x * gridDim.y * gridDim.z;
    unsigned sum, cnt, mine, sp = 0u;
    for (;;) {
        sum = 0u; cnt = 0u; mine = 0u;
#pragma unroll
        for (unsigned j = 0; j < 16; ++j) { const unsigned c = xb_ld(&bar[XB_XCNT(j)]); sum += c; cnt += (c > 0u) ? 1u : 0u; mine = (j == x) ? c : mine; }
        if (sum == G) break;
        __builtin_amdgcn_s_sleep(1);
        if ((++sp & 255u) == 0u) { if (xb_ld(&bar[XB_TMO])) break; if (sp > XB_SPIN_CAP) { atomicAdd(&bar[XB_TMO], 1u); break; } }
    }
    nloc = mine > 0u ? mine : 1u; nx = cnt > 0u ? cnt : 1u;
}
__device__ __forceinline__ void xcd_barrier(const XcdBarrier& b) {
    asm volatile("s_waitcnt vmcnt(0)" ::: "memory");
    __syncthreads();
    if (threadIdx.x == 0) {
        unsigned* bar = b.bar;
        __builtin_amdgcn_s_waitcnt(0);
        unsigned nloc = b.st[0], nx = b.st[1];
        if (nloc == 0u) { xcd_barrier_complete(bar, b.x, nloc, nx); b.st[0] = nloc; b.st[1] = nx; }
        const unsigned old = xb_add(&bar[XB_XSUB(b.x)], 1u);
        const unsigned gen = old / nloc;
        if (old + 1u == (gen + 1u) * nloc) {
            __builtin_amdgcn_fence(__ATOMIC_RELEASE, "agent");
            asm volatile("s_waitcnt vmcnt(0)" ::: "memory");
            const unsigned og = xb_add(&bar[XB_TOP], 1u);
            const unsigned tg = og / nx;
            if (og + 1u == (tg + 1u) * nx) xb_add(&bar[XB_TOPGEN], 1u);
            else XB_SPIN(xb_ld(&bar[XB_TOPGEN]) == tg, bar);
            __builtin_amdgcn_fence(__ATOMIC_ACQUIRE, "agent");
            xb_add(&bar[XB_XGEN(b.x)], 1u);
            asm volatile("s_waitcnt vmcnt(0)" ::: "memory");
        } else {
            XB_SPIN(xb_ld(&bar[XB_XGEN(b.x)]) == gen, bar);
            __builtin_amdgcn_fence(__ATOMIC_ACQUIRE, "agent");
            asm volatile("s_waitcnt vmcnt(0)" ::: "memory");
        }
    }
    __syncthreads();
}

#define GT ((long)blockIdx.x * blockDim.x + threadIdx.x)
#define GS ((long)gridDim.x * blockDim.x)
__global__ void __launch_bounds__(256, 2) mega_fwd(Params p) {
    __shared__ __attribute__((aligned(16))) char lds[65536 + 64];
    cg::grid_group grid = cg::this_grid();
    const long gt = GT, gs = GS;
    volatile LAS unsigned* bst = (volatile LAS unsigned*)(LAS char*)(lds + 65536);
    if (threadIdx.x < 2) bst[threadIdx.x] = 0u;
    __syncthreads();
    const XcdBarrier xb = xcd_barrier_post(p.bar, bst);
#ifndef PROBE_PHASE
#define PROBE_PHASE -1
#endif
#define PROBE_AMP 8
    unsigned long long t_prev = 0; int nts = 0;
#define STAMP() do { if (PROBE_PHASE >= 0 && blockIdx.x == 0 && threadIdx.x == 0) { const unsigned long long t_now = __builtin_amdgcn_s_memrealtime(); \
        if (nts == PROBE_PHASE + 1) { const unsigned long long t_end = t_now + PROBE_AMP * (t_now - t_prev); while (__builtin_amdgcn_s_memrealtime() < t_end) __builtin_amdgcn_s_sleep(8); } \
        t_prev = __builtin_amdgcn_s_memrealtime(); } ++nts; } while (0)
#define GSYNC() do { xcd_barrier(xb); STAMP(); } while (0)
    STAMP();
    ph_mod_fast(p, lds); ph_prep_w_fast(p, 0, 0, lds); ph_prep_misc(p, 0, gt, gs, false);
    grid.sync(); STAMP();
    for (int l = 0; l < 2; ++l) {
        const int nrows = (l == 0) ? T : TL;
        ph_lnmod_fast(p, l);
        GSYNC();
        g_gemm_in(p, lds);
        GSYNC();
        ph_streams_s1(p, l);
        GSYNC();
        g_streams_s2(p, l, lds);
        GSYNC();
        ph_scan_fast(p);
        GSYNC();
        ph_combine(p, lds); ph_attn_blk(p, l, l == 0, 64, lds);
        GSYNC();
        ph_rwkv_out_fast(p, l, l == 0);
        GSYNC();
        g_gemm_out(p, nrows, lds); ph_prep_w_fast(p, l, 1, lds);
        GSYNC();
        ph_post_mixer_fast(p, l, nrows);
        GSYNC();
        g_router(p, l, nrows, lds);
        GSYNC();
        ph_dispatch_fast(p, l, nrows, lds);
        GSYNC();
        g_moe1(p, l, lds);
        GSYNC();
        g_moe2(p, l, lds);
        GSYNC();
        ph_final_fast(p, l, nrows);
        if (l == 0) { ph_prep_w_fast(p, 1, 0, lds); ph_prep_misc(p, 1, gt, gs, false); }
        GSYNC();
    }}

extern "C" void kernel_launch(void* const* d_in, const int* in_sizes, int n_in, void* d_out, int out_size, void* d_ws, size_t ws_size, hipStream_t stream) {
    if (n_in != 32 || out_size != TL * D || ws_size < WS_NEED) { fprintf(stderr, "kernel_launch: unexpected shapes / workspace (n_in %d out %d ws %zu need %zu)\n", n_in, out_size, ws_size, (size_t)WS_NEED); return; }
    static int grid_blocks = 0;
    if (!grid_blocks) {
        int dev = 0, cus = 0, per_cu = 0;
        (void)hipGetDevice(&dev);
        (void)hipDeviceGetAttribute(&cus, hipDeviceAttributeMultiprocessorCount, dev);
        (void)hipOccupancyMaxActiveBlocksPerMultiprocessor(&per_cu, mega_fwd, 256, 0);
        if (per_cu < 1) per_cu = 1;
        if (per_cu > 2) per_cu = 2;
        grid_blocks = cus * per_cu;
        fprintf(stderr, "kernel_launch: %d CUs x %d blocks\n", cus, per_cu);
    }
    Params p = make_params(d_in, d_out, d_ws);
    (void)hipMemsetAsync(d_ws, 0, CTL_BYTES, stream);
    void* args[] = {&p};
    hipError_t e = hipLaunchCooperativeKernel((void*)mega_fwd, dim3(grid_blocks), dim3(256), args, 0, stream);
    if (e != hipSuccess) fprintf(stderr, "cooperative launch failed: %s (grid %d)\n", hipGetErrorString(e), grid_blocks);
}
#endif

#ifdef HOST_EMU
static void host_forward(void* const* d_in, void* d_out, void* d_ws) {
    const Params p = make_params(d_in, d_out, d_ws);
    for (int l = 0; l < 2; ++l) {
        const int nrows = (l == 0) ? T : TL;
        ph_prep_w(p, l, 0, 1); ph_prep_misc(p, l, 0, 1); ph_lnmod(p, l, 0, 1); host_gemm_in(p); ph_streams(p, l, 0, 1); ph_rope(p, 0, 1); ph_scan(p, 0, 1);
        ph_attn(p, l, nrows, 0, 1); ph_rwkv_out(p, l, nrows, 0, 1); host_gemm_out(p, nrows); ph_post_mixer(p, l, nrows, 0, 1);
        ph_dispatch(p, l, nrows, 0, 1); host_moe1(p, l); host_moe2(p, l); ph_final(p, l, nrows, 0, 1);
    }
}
#endif
```

```cpp
#ifdef HOST_EMU
#include <cmath>
#include <cstdio>
#include <cstring>
#include <cstdint>
#include <cstdlib>
#define __device__
#define __global__
#define __host__
#define __forceinline__ inline
#else
#include <hip/hip_runtime.h>
#include <hip/hip_cooperative_groups.h>
#include <cstdio>
#include <cstdint>
namespace cg = cooperative_groups;
#endif

#ifndef CFG_D
#define CFG_D 1024
#define CFG_B 8
#define CFG_S 2048
#define CFG_L 256
#define CFG_DE 512
#endif
constexpr int D = CFG_D, NB = CFG_B, S = CFG_S, L = CFG_L, DE = CFG_DE;
constexpr int TL = NB * S, TC = NB * L, T = TL + TC;
constexpr int GRID_W = 64, HD = 64;
constexpr int DA = 256, A_IN = 1184, N_IN = 2976, NINP = 3072, DMIX = 1024;
constexpr int NEXP = 32, NSLOT = 2 * T + NEXP * 128;
constexpr int ZQB = 0, ZKB = 384, ZVB = 512, ZQN = 640, ZKN = 1024, ZVN = 1408, ZA = 1792, ZP = 2976;
constexpr float LN_EPS = 1e-6f, GN_EPS = 64e-5f, ATT_SCALE = 0.125f;
constexpr float ALPHA = 1.41421356237309515f;

typedef unsigned short bf16_t;

__device__ __forceinline__ float bf2f(bf16_t v) {
    unsigned u = ((unsigned)v) << 16; float f;
#ifdef HOST_EMU
    memcpy(&f, &u, 4);
#else
    f = __uint_as_float(u);
#endif
    return f;
}
__device__ __forceinline__ bf16_t f2bf(float f) {
    unsigned u;
#ifdef HOST_EMU
    memcpy(&u, &f, 4);
#else
    u = __float_as_uint(f);
#endif
    return (bf16_t)((u + 0x7fffu + ((u >> 16) & 1u)) >> 16);
}
__device__ __forceinline__ float sigmoidf_(float x) { return 1.0f / (1.0f + expf(-x)); }
__device__ __forceinline__ float siluf_(float x) { return x / (1.0f + expf(-x)); }
__device__ __forceinline__ int atomic_inc_int(int* p) {
#ifdef HOST_EMU
    int o = *p; *p = o + 1; return o;
#else
    return atomicAdd(p, 1);
#endif
}

struct Params {
    const float *x, *c, *ctx, *c_ctx, *w_mod, *b_mod, *w_in, *w_out, *a_shift, *a_w0, *a_w_up, *a_a0, *a_a_up, *a_g_up,
        *a_k_k, *a_k_a, *a_r_k, *a_lnx_g, *a_lnx_b, *b_sink, *c_rpb, *ln1_g, *ln1_b, *ln2_g, *ln2_b, *w_rg, *b_rg, *w_re,
        *b_re, *w_gate, *w_up, *w_down;
    float* out;
    int* cnt;
    unsigned* bar;
    float* mod;
    float* rope;
    bf16_t *win_t, *wout_t, *wgu_t, *wd_t;
    bf16_t *wrt;
    int* hist;
    bf16_t* HLO;
    bf16_t *wupT, *aupT, *gupT;
    bf16_t* LA;
    float *kT, *kN;
    bf16_t* H;
    bf16_t* Z;
    bf16_t* VT;
    float *sR, *sV, *sKK, *sG, *sW, *sKD, *sB;
    float* Y;
    bf16_t* MIX;
    float *PV, *QS, *PS, *SS;
    float* XC;
    float* O;
    int *rE, *rPos, *rSlot; float* rW;
    int* slotTok;
    bf16_t* ACT;
    float* YS;
};

constexpr size_t al256(size_t v) { return (v + 255) & ~(size_t)255; }
constexpr size_t OFF_CNT = 0;
constexpr size_t OFF_BAR = 4096, CTL_BYTES = 4096 + 16384;
constexpr size_t OFF_MOD = CTL_BYTES;
constexpr size_t OFF_ROPE = al256(OFF_MOD + (size_t)2 * (NB + 1) * 6 * D * 4);
constexpr size_t OFF_LORA = al256(OFF_ROPE + 64 * 16 * 2 * 4);
constexpr size_t OFF_WRT = al256(OFF_LORA + (size_t)(2 * 256 * 64 * 2 + 256 * 160) * 2);
constexpr size_t OFF_LG = al256(OFF_WRT + (size_t)2 * 128 * D * 2);
constexpr size_t OFF_WIN = al256(OFF_LG + (size_t)T * 36 * 4);
constexpr size_t OFF_WOUT = al256(OFF_WIN + (size_t)NINP * D * 2);
constexpr size_t OFF_WGU = al256(OFF_WOUT + (size_t)D * DMIX * 2);
constexpr size_t OFF_WD = al256(OFF_WGU + (size_t)NEXP * 2 * DE * D * 2);
constexpr size_t OFF_H = al256(OFF_WD + (size_t)NEXP * D * DE * 2);
constexpr size_t OFF_Z = al256(OFF_H + (size_t)(T + 1) * D * 2);
constexpr int PU = L + S;
constexpr int NSG = (L + S) / 128;
static_assert((size_t)3 * 64 * ((L + S) / 128) * 4096 * 4 <= (size_t)NEXP * 2 * DE * D * 2 || (L % 128) != 0, "scan segment states overlay wgu_t");
constexpr size_t OFF_VT = al256(OFF_Z + (size_t)T * ZP * 2);
constexpr size_t OFF_S = al256(OFF_VT + (size_t)NB * 8 * 64 * PU * 2);
constexpr size_t S1 = (size_t)T * 256 * 4;
constexpr size_t OFF_Y = al256(OFF_S + 10 * S1);
constexpr size_t OFF_MIX = al256(OFF_Y + 2 * S1);
constexpr size_t OFF_XC = al256(OFF_MIX + (size_t)T * 1024 * 2);
constexpr size_t OFF_ROUTE = al256(OFF_XC + (size_t)TC * D * 4);
constexpr size_t OFF_SLOTTOK = al256(OFF_ROUTE + (size_t)T * 2 * 4 * 4);
constexpr size_t WS_NEED = al256(OFF_SLOTTOK + (size_t)NSLOT * 4);
static_assert((size_t)NSLOT * DE * 2 <= (size_t)T * ZP * 2 && (size_t)T * D * 2 <= (size_t)T * ZP * 2, "ACT / HLO overlay Z");
static_assert((size_t)T * 4 * 4 + (size_t)T * 416 * 2 <= S1, "kN + LA overlay Y[1]");
static_assert((size_t)NSLOT * D * 4 <= 10 * S1 && (size_t)T * D * 4 <= 10 * S1, "YS / O overlay the stream buffers");

static Params make_params(void* const* d_in, void* d_out, void* d_ws) {
    Params p{};
    const float** f = (const float**)&p.x;
    for (int i = 0; i < 32; ++i) f[i] = (const float*)d_in[i];
    p.out = (float*)d_out;
    char* w = (char*)d_ws;
    p.cnt = (int*)(w + OFF_CNT); p.bar = (unsigned*)(w + OFF_BAR); p.mod = (float*)(w + OFF_MOD); p.rope = (float*)(w + OFF_ROPE);
    p.win_t = (bf16_t*)(w + OFF_WIN); p.wout_t = (bf16_t*)(w + OFF_WOUT); p.wgu_t = (bf16_t*)(w + OFF_WGU); p.wd_t = (bf16_t*)(w + OFF_WD);
    p.wrt = (bf16_t*)(w + OFF_WRT); p.hist = (int*)(w + OFF_LG); p.HLO = (bf16_t*)(w + OFF_Z);
    p.wupT = (bf16_t*)(w + OFF_LORA); p.aupT = p.wupT + 2 * 256 * 64; p.gupT = p.aupT + 2 * 256 * 64;
    p.H = (bf16_t*)(w + OFF_H); p.Z = (bf16_t*)(w + OFF_Z); p.VT = (bf16_t*)(w + OFF_VT);
    float* s = (float*)(w + OFF_S); const size_t n1 = (size_t)T * 256;
    p.sR = s; p.sV = s + n1; p.sKK = s + 2 * n1; p.sG = s + 3 * n1; p.sW = s + 4 * n1; p.sKD = s + 6 * n1; p.sB = s + 8 * n1;
    p.Y = (float*)(w + OFF_Y); p.MIX = (bf16_t*)(w + OFF_MIX); p.XC = (float*)(w + OFF_XC);
    p.O = (float*)(w + OFF_S);
    p.PV = (float*)(w + OFF_H); p.QS = (float*)(w + OFF_WGU); p.PS = p.QS + (size_t)64 * NSG * 4096; p.SS = p.PS + (size_t)64 * NSG * 4096;
    p.kT = p.Y; p.kN = p.Y + (size_t)T * 256; p.LA = (bf16_t*)(p.Y + (size_t)T * 256 + (size_t)T * 4);
    int* r = (int*)(w + OFF_ROUTE); p.rE = r; p.rPos = r + 2 * T; p.rSlot = r + 4 * T; p.rW = (float*)(r + 6 * T);
    p.slotTok = (int*)(w + OFF_SLOTTOK);
    p.ACT = (bf16_t*)(w + OFF_Z); p.YS = (float*)(w + OFF_S);
    return p;
}

__device__ void ph_prep_w(const Params& p, int l, long gtid, long gsz) {
    for (long i = gtid; i < (long)D * NINP; i += gsz) {
        const int k = (int)(i / NINP), n = (int)(i % NINP);
        float v = 0.f;
        if (n < N_IN) { const int oc = (n < ZA) ? n + A_IN : n - ZA; v = p.w_in[((size_t)l * D + k) * N_IN + oc]; }
        p.win_t[(size_t)n * D + k] = f2bf(v);
    }
    for (long i = gtid; i < (long)DMIX * D; i += gsz) {
        const int k = (int)(i / D), n = (int)(i % D);
        p.wout_t[(size_t)n * DMIX + k] = f2bf(p.w_out[((size_t)l * DMIX + k) * D + n]);
    }
    for (long i = gtid; i < (long)NEXP * D * 2 * DE; i += gsz) {
        const int rho = (int)(i % (2 * DE)); const long t = i / (2 * DE); const int k = (int)(t % D), e = (int)(t / D);
        const int q = rho >> 5, half = (rho >> 4) & 1, ii = rho & 15, cc = 16 * q + ii;
        const float* src = half ? p.w_up : p.w_gate;
        p.wgu_t[((size_t)e * 2 * DE + rho) * D + k] = f2bf(src[(((size_t)l * NEXP + e) * D + k) * DE + cc]);
    }
    for (long i = gtid; i < (long)NEXP * DE * D; i += gsz) {
        const int n = (int)(i % D); const long t = i / D; const int k = (int)(t % DE), e = (int)(t / DE);
        p.wd_t[((size_t)e * D + n) * DE + k] = f2bf(p.w_down[(((size_t)l * NEXP + e) * DE + k) * D + n]);
    }
}
__device__ __forceinline__ void ph_prep_misc(const Params& p, int l, long gtid, long gsz, bool do_mod = true) {
    if (l == 0 && do_mod) for (long i = gtid; i < (long)2 * (NB + 1) * 6 * D; i += gsz) {
        const int j = (int)(i % (6 * D)), b = (int)((i / (6 * D)) % (NB + 1)), ll = (int)(i / ((long)6 * D * (NB + 1)));
        const float* cv = (b < NB) ? p.c + (size_t)b * D : p.c_ctx;
        float acc = 0.f;
        for (int k = 0; k < D; ++k) acc += siluf_(cv[k]) * p.w_mod[((size_t)ll * D + k) * 6 * D + j];
        p.mod[((size_t)ll * (NB + 1) + b) * 6 * D + j] = acc + p.b_mod[(size_t)ll * 6 * D + j];
    }
    if (l == 0) for (long i = gtid; i < 64 * 16; i += gsz) {
        const int pos = (int)(i / 16), fi = (int)(i % 16);
        const float inv = powf(10000.0f, -(float)fi / 16.0f), ang = (float)pos * inv;
        p.rope[i] = cosf(ang); p.rope[1024 + i] = sinf(ang);
    }
    for (long i = gtid; i < NEXP; i += gsz) p.cnt[l * NEXP + i] = 0;
    for (long i = gtid; i < NSLOT; i += gsz) p.slotTok[i] = T;
    for (long i = gtid; i < D; i += gsz) p.H[(size_t)T * D + i] = 0;
}

__device__ __forceinline__ const float* xrow_in(const Params& p, int l, int m) {
    if (m < TL) return (l == 0 ? p.x : p.out) + (size_t)m * D;
    return (l == 0 ? p.ctx : p.XC) + (size_t)(m - TL) * D;
}
__device__ __forceinline__ const float* modrow(const Params& p, int l, int m) { return p.mod + ((size_t)l * (NB + 1) + (m < TL ? m / S : NB)) * 6 * D; }

__device__ void ph_lnmod(const Params& p, int l, long gtid, long gsz) {
    for (long m = gtid; m < T; m += gsz) {
        const float* xr = xrow_in(p, l, (int)m); const float* md = modrow(p, l, (int)m);
        float s = 0.f; for (int j = 0; j < D; ++j) s += xr[j];
        const float mu = s / D; float q = 0.f;
        for (int j = 0; j < D; ++j) { const float d = xr[j] - mu; q += d * d; }
        const float rstd = 1.0f / sqrtf(q / D + LN_EPS);
        for (int j = 0; j < D; ++j) p.H[(size_t)m * D + j] = f2bf((xr[j] - mu) * rstd * (1.0f + md[D + j]) + md[j]);
    }
}

__device__ __forceinline__ float zshift(const Params& p, int l, int m, int col) {
    int t, len;
    if (m < TL) { t = m % S; len = S; } else { t = (m - TL) % L; len = L; }
    const float* sh = p.a_shift + (size_t)l * 3 * A_IN;
    const bf16_t* z = p.Z + (size_t)m * ZP + ZA + col;
    float v = sh[A_IN + col] * bf2f(z[0]);
    if (t > 0) v += sh[col] * bf2f(z[-ZP]);
    if (t < len - 1) v += sh[2 * A_IN + col] * bf2f(z[ZP]);
    return v;
}

__device__ void ph_streams(const Params& p, int l, long gtid, long gsz) {
    for (long i = gtid; i < (long)T * DA; i += gsz) {
        const int m = (int)(i / DA), c = (int)(i % DA), h0 = c & ~63;
        const float r = zshift(p, l, m, c), k = zshift(p, l, m, 256 + c), v = zshift(p, l, m, 512 + c);
        float nrm = 0.f;
        for (int j = 0; j < 64; ++j) { const float t = zshift(p, l, m, 256 + h0 + j) * p.a_k_k[l * DA + h0 + j]; nrm += t * t; }
        const float kk = k * p.a_k_k[l * DA + c] / sqrtf(nrm + 1e-12f);
        float g = 0.f;
        for (int j = 0; j < 160; ++j) g += sigmoidf_(zshift(p, l, m, 1024 + j)) * p.a_g_up[((size_t)l * 160 + j) * DA + c];
        const size_t o = (size_t)m * DA + c;
        p.sR[o] = r; p.sV[o] = v; p.sKK[o] = kk; p.sG[o] = g;
        for (int d = 0; d < 2; ++d) {
            float aw = 0.f, aa = 0.f;
            for (int j = 0; j < 64; ++j) {
                aw += tanhf(zshift(p, l, m, 768 + d * 64 + j)) * p.a_w_up[(((size_t)l * 2 + d) * 64 + j) * DA + c];
                aa += zshift(p, l, m, 896 + d * 64 + j) * p.a_a_up[(((size_t)l * 2 + d) * 64 + j) * DA + c];
            }
            const float u = -(p.a_w0[(l * 2 + d) * DA + c] + aw);
            const float sp = (u > 20.f) ? u : log1pf(expf(u));
            const float w = expf(-expf(-sp - 0.5f));
            const float a = sigmoidf_(p.a_a0[(l * 2 + d) * DA + c] + aa);
            const size_t od = ((size_t)d * T + m) * DA + c;
            p.sW[od] = w; p.sKD[od] = k * (1.0f + (a - 1.0f) * p.a_k_a[l * DA + c]); p.sB[od] = kk * a;
        }
    }
}

__device__ __forceinline__ void ph_rope(const Params& p, long gtid, long gsz) {
    for (long i = gtid; i < (long)TL * 8 * 32; i += gsz) {
        const int pr = (int)(i & 31), hs = (int)((i >> 5) & 7), m = (int)(i >> 8);
        const int t = m % S, axis = pr >> 4, fi = pr & 15, pos = axis ? (t % GRID_W) : (t / GRID_W);
        bf16_t* z = p.Z + (size_t)m * ZP + hs * 64 + axis * 32 + fi;
        const float cs = p.rope[pos * 16 + fi], sn = p.rope[1024 + pos * 16 + fi];
        const float x0 = bf2f(z[0]), x1 = bf2f(z[16]);
        z[0] = f2bf(x0 * cs - x1 * sn); z[16] = f2bf(x1 * cs + x0 * sn);
    }
}

__device__ void ph_scan(const Params& p, long gtid, long gsz) {
    for (long i = gtid; i < (long)2 * NB * 4 * 64; i += gsz) {
        const int v = (int)(i & 63), h = (int)((i >> 6) & 3), b = (int)((i >> 8) % NB), d = (int)((i >> 8) / NB);
        float st[64];
#pragma unroll
        for (int k = 0; k < 64; ++k) st[k] = 0.f;
        for (int pos = 0; pos < L + S; ++pos) {
            int m;
            if (pos < L) m = TL + b * L + (d ? L - 1 - pos : pos);
            else m = b * S + (d ? S - 1 - (pos - L) : pos - L);
            const size_t o = (size_t)m * DA + h * 64, od = ((size_t)d * T + m) * DA + h * 64;
            const float* kk = p.sKK + o; const float* r = p.sR + o;
            const float* w = p.sW + od; const float* bb = p.sB + od; const float* kd = p.sKD + od;
            const float vv = p.sV[o + v];
            float sk = 0.f;
#pragma unroll
            for (int k = 0; k < 64; ++k) sk += st[k] * kk[k];
            float y = 0.f;
#pragma unroll
            for (int k = 0; k < 64; ++k) { st[k] = st[k] * w[k] - sk * bb[k] + vv * kd[k]; y += st[k] * r[k]; }
            p.Y[od + v] = y;
        }
    }
}

__device__ void ph_rwkv_out(const Params& p, int l, int nrows, long gtid, long gsz) {
    for (long i = gtid; i < (long)nrows * 4; i += gsz) {
        const int m = (int)(i >> 2), h = (int)(i & 3);
        const size_t o = (size_t)m * DA + h * 64;
        const float* y0 = p.Y + o; const float* y1 = p.Y + (size_t)T * DA + o;
        float s = 0.f, bon = 0.f;
        for (int n = 0; n < 64; ++n) {
            s += y0[n] + y1[n];
            bon += p.sR[o + n] * (p.sKD[o + n] + p.sKD[(size_t)T * DA + o + n]) * p.a_r_k[l * DA + h * 64 + n];
        }
        const float mu = s / 64.f; float q = 0.f;
        for (int n = 0; n < 64; ++n) { const float dd = y0[n] + y1[n] - mu; q += dd * dd; }
        const float rstd = 1.0f / sqrtf(q / 64.f + GN_EPS);
        for (int n = 0; n < 64; ++n) {
            const int c = h * 64 + n;
            const float yn = (y0[n] + y1[n] - mu) * rstd * p.a_lnx_g[l * DA + c] + p.a_lnx_b[l * DA + c];
            p.MIX[(size_t)m * DMIX + c] = f2bf((yn + bon * p.sV[o + n]) * p.sG[o + n]);
        }
    }
}

__device__ __forceinline__ void att_key(const float (&q)[64], const bf16_t* kr, const bf16_t* vr, float bias, float& mx, float& ls, float (&acc)[64]) {
    float s = 0.f;
#pragma unroll
    for (int d = 0; d < 64; ++d) s += q[d] * bf2f(kr[d]);
    s = s * ATT_SCALE + bias;
    const float mn = fmaxf(mx, s), f = expf(mx - mn), pe = expf(s - mn);
    ls = ls * f + pe;
#pragma unroll
    for (int d = 0; d < 64; ++d) acc[d] = acc[d] * f + pe * bf2f(vr[d]);
    mx = mn;
}

__device__ void ph_attn(const Params& p, int l, int nrows, long gtid, long gsz) {
    for (long i = gtid; i < (long)nrows * 12; i += gsz) {
        const int m = (int)(i / 12), u = (int)(i % 12);
        const bool isB = u < 6; const int hq = isB ? u : u - 6;
        const int b = (m < TL) ? m / S : (m - TL) / L;
        const int qcol = isB ? ZQB + hq * 64 : ZQN + hq * 64;
        const int kcol = isB ? ZKB + (hq / 3) * 64 : ZKN + hq * 64;
        const int vcol = isB ? ZVB + (hq / 3) * 64 : ZVN + hq * 64;
        float q[64], acc[64];
        const bf16_t* qr = p.Z + (size_t)m * ZP + qcol;
#pragma unroll
        for (int d = 0; d < 64; ++d) { q[d] = bf2f(qr[d]); acc[d] = 0.f; }
        float mx, ls;
        if (isB) { mx = p.b_sink[l * 6 + hq]; ls = 1.0f; } else { mx = -1e30f; ls = 0.f; }
        for (int j = 0; j < L; ++j) { const bf16_t* zr = p.Z + (size_t)(TL + b * L + j) * ZP; att_key(q, zr + kcol, zr + vcol, 0.f, mx, ls, acc); }
        if (m < TL) {
            const int t = m % S;
            if (isB) {
                const int j0 = t - 128 < 0 ? 0 : t - 128, j1 = t + 128 > S - 1 ? S - 1 : t + 128;
                for (int j = j0; j <= j1; ++j) { const bf16_t* zr = p.Z + (size_t)(b * S + j) * ZP; att_key(q, zr + kcol, zr + vcol, 0.f, mx, ls, acc); }
            } else {
                const int rows = S / GRID_W, r = t / GRID_W, c = t % GRID_W;
                int r0 = r - 4; r0 = r0 < 0 ? 0 : (r0 > rows - 8 ? rows - 8 : r0);
                int c0 = c - 8; c0 = c0 < 0 ? 0 : (c0 > GRID_W - 16 ? GRID_W - 16 : c0);
                for (int a = 0; a < 8; ++a)
                    for (int e = 0; e < 16; ++e) {
                        const int kr = r0 + a, kc = c0 + e;
                        const float bias = p.c_rpb[(((size_t)l * 6 + hq) * 15 + (kr - r + 7)) * 31 + (kc - c + 15)];
                        const bf16_t* zr = p.Z + (size_t)(b * S + kr * GRID_W + kc) * ZP;
                        att_key(q, zr + kcol, zr + vcol, bias, mx, ls, acc);
                    }
            }
        }
        const float inv = 1.0f / ls;
        bf16_t* o = p.MIX + (size_t)m * DMIX + (isB ? 256 : 640) + hq * 64;
#pragma unroll
        for (int d = 0; d < 64; ++d) o[d] = f2bf(acc[d] * inv);
    }
}

__device__ void ph_post_mixer(const Params& p, int l, int nrows, long gtid, long gsz) {
    for (long mm = gtid; mm < nrows; mm += gsz) {
        const int m = (int)mm;
        const float* xr = xrow_in(p, l, m); const float* md = modrow(p, l, m); const float* orow = p.O + (size_t)m * D;
        float* x1 = (m < TL) ? p.out + (size_t)m * D : p.XC + (size_t)(m - TL) * D;
        const float* g1 = p.ln1_g + (size_t)l * D; const float* b1 = p.ln1_b + (size_t)l * D;
        float s = 0.f; for (int j = 0; j < D; ++j) s += ALPHA * xr[j] + md[2 * D + j] * orow[j];
        float mu = s / D, q = 0.f;
        for (int j = 0; j < D; ++j) { const float d = ALPHA * xr[j] + md[2 * D + j] * orow[j] - mu; q += d * d; }
        float rstd = 1.0f / sqrtf(q / D + LN_EPS);
        s = 0.f;
        for (int j = 0; j < D; ++j) { const float v = (ALPHA * xr[j] + md[2 * D + j] * orow[j] - mu) * rstd * g1[j] + b1[j]; x1[j] = v; s += v; }
        mu = s / D; q = 0.f;
        for (int j = 0; j < D; ++j) { const float d = x1[j] - mu; q += d * d; }
        rstd = 1.0f / sqrtf(q / D + LN_EPS);
        float gl[4], el[32];
#pragma unroll
        for (int g = 0; g < 4; ++g) gl[g] = p.b_rg[l * 4 + g];
#pragma unroll
        for (int e = 0; e < 32; ++e) el[e] = p.b_re[l * 32 + e];
        for (int j = 0; j < D; ++j) {
            const float hv = (x1[j] - mu) * rstd * (1.0f + md[4 * D + j]) + md[3 * D + j];
            p.H[(size_t)m * D + j] = f2bf(hv);
            const float* wg = p.w_rg + ((size_t)l * D + j) * 4; const float* we = p.w_re + ((size_t)l * D + j) * 32;
#pragma unroll
            for (int g = 0; g < 4; ++g) gl[g] += hv * wg[g];
#pragma unroll
            for (int e = 0; e < 32; ++e) el[e] += hv * we[e];
        }
        int gs = 0; float gm = gl[0];
#pragma unroll
        for (int g = 1; g < 4; ++g) if (gl[g] > gm) { gm = gl[g]; gs = g; }
        float den = 0.f;
#pragma unroll
        for (int g = 0; g < 4; ++g) den += expf(gl[g] - gm);
        const float pg = 1.0f / den;
        float v1 = -3e38f, v2 = -3e38f; int i1 = 0, i2 = 0;
#pragma unroll
        for (int j = 0; j < 8; ++j) {
            const float v = gs == 0 ? el[j] : gs == 1 ? el[8 + j] : gs == 2 ? el[16 + j] : el[24 + j];
            if (v > v1) { v2 = v1; i2 = i1; v1 = v; i1 = j; } else if (v > v2) { v2 = v; i2 = j; }
        }
        const float e2 = expf(v2 - v1), w1 = pg / (1.0f + e2), w2 = pg * e2 / (1.0f + e2);
        const int ea = gs * 8 + i1, eb = gs * 8 + i2;
        p.rE[2 * m] = ea; p.rE[2 * m + 1] = eb; p.rW[2 * m] = w1; p.rW[2 * m + 1] = w2;
        p.rPos[2 * m] = atomic_inc_int(p.cnt + l * NEXP + ea); p.rPos[2 * m + 1] = atomic_inc_int(p.cnt + l * NEXP + eb);
    }
}

__device__ __forceinline__ int pstart_of(const int* cnt, int e) {
    int s = 0;
    for (int j = 0; j < NEXP; ++j) if (j < e) s += (cnt[j] + 127) & ~127;
    return s;
}
__device__ __forceinline__ void ph_dispatch(const Params& p, int l, int nrows, long gtid, long gsz) {
    for (long i = gtid; i < (long)nrows * 2; i += gsz) {
        const int slot = pstart_of(p.cnt + l * NEXP, p.rE[i]) + p.rPos[i];
        p.rSlot[i] = slot; p.slotTok[slot] = (int)(i >> 1);
    }
}

__device__ void ph_final(const Params& p, int l, int nrows, long gtid, long gsz) {
    for (long mm = gtid; mm < nrows; mm += gsz) {
        const int m = (int)mm;
        float* x1 = (m < TL) ? p.out + (size_t)m * D : p.XC + (size_t)(m - TL) * D;
        const float* md = modrow(p, l, m);
        const float* ya = p.YS + (size_t)p.rSlot[2 * m] * D; const float* yb = p.YS + (size_t)p.rSlot[2 * m + 1] * D;
        const float wa = p.rW[2 * m], wb = p.rW[2 * m + 1];
        const float* g2 = p.ln2_g + (size_t)l * D; const float* b2 = p.ln2_b + (size_t)l * D;
        float s = 0.f; for (int j = 0; j < D; ++j) s += ALPHA * x1[j] + md[5 * D + j] * (wa * ya[j] + wb * yb[j]);
        const float mu = s / D; float q = 0.f;
        for (int j = 0; j < D; ++j) { const float d = ALPHA * x1[j] + md[5 * D + j] * (wa * ya[j] + wb * yb[j]) - mu; q += d * d; }
        const float rstd = 1.0f / sqrtf(q / D + LN_EPS);
        for (int j = 0; j < D; ++j) x1[j] = (ALPHA * x1[j] + md[5 * D + j] * (wa * ya[j] + wb * yb[j]) - mu) * rstd * g2[j] + b2[j];
    }
}

__device__ __forceinline__ int moe_blocks(const int* cnt) { int s = 0; for (int j = 0; j < NEXP; ++j) s += (cnt[j] + 127) >> 7; return s; }
__device__ __forceinline__ int moe_block_expert(const int* cnt, int rb) {
    int s = 0, e = 0;
    for (int j = 0; j < NEXP; ++j) { const int nb = (cnt[j] + 127) >> 7; if (rb >= s && rb < s + nb) e = j; s += nb; }
    return e;
}

#ifdef HOST_EMU
static void host_gemm_in(const Params& p) {
    for (int m = 0; m < T; ++m) for (int n = 0; n < ZP; ++n) { float a = 0.f; for (int k = 0; k < D; ++k) a += bf2f(p.H[(size_t)m * D + k]) * bf2f(p.win_t[(size_t)n * D + k]); p.Z[(size_t)m * ZP + n] = f2bf(a); }
}
static void host_gemm_out(const Params& p, int nrows) {
    for (int m = 0; m < nrows; ++m) for (int n = 0; n < D; ++n) { float a = 0.f; for (int k = 0; k < DMIX; ++k) a += bf2f(p.MIX[(size_t)m * DMIX + k]) * bf2f(p.wout_t[(size_t)n * DMIX + k]); p.O[(size_t)m * D + n] = a; }
}
static void host_moe1(const Params& p, int l) {
    const int* cnt = p.cnt + l * NEXP; const int nrb = moe_blocks(cnt);
    for (int rb = 0; rb < nrb; ++rb) { const int e = moe_block_expert(cnt, rb);
        for (int r = 0; r < 128; ++r) { const int slot = rb * 128 + r; const bf16_t* a = p.H + (size_t)p.slotTok[slot] * D;
            for (int c = 0; c < DE; ++c) { const int q = c >> 4, ii = c & 15; float g = 0.f, u = 0.f;
                const bf16_t* wg = p.wgu_t + ((size_t)e * 2 * DE + 32 * q + ii) * D; const bf16_t* wu = wg + (size_t)16 * D;
                for (int k = 0; k < D; ++k) { g += bf2f(a[k]) * bf2f(wg[k]); u += bf2f(a[k]) * bf2f(wu[k]); }
                p.ACT[(size_t)slot * DE + c] = f2bf(siluf_(g) * u); } } }
}
static void host_moe2(const Params& p, int l) {
    const int* cnt = p.cnt + l * NEXP; const int nrb = moe_blocks(cnt);
    for (int rb = 0; rb < nrb; ++rb) { const int e = moe_block_expert(cnt, rb);
        for (int r = 0; r < 128; ++r) { const int slot = rb * 128 + r;
            for (int n = 0; n < D; ++n) { float a = 0.f; const bf16_t* w = p.wd_t + ((size_t)e * D + n) * DE;
                for (int k = 0; k < DE; ++k) a += bf2f(p.ACT[(size_t)slot * DE + k]) * bf2f(w[k]);
                p.YS[(size_t)slot * D + n] = a; } } }
}
#else
typedef short bf16x8 __attribute__((ext_vector_type(8)));
typedef float f32x4 __attribute__((ext_vector_type(4)));
__device__ __forceinline__ int opq_tid() { int t = threadIdx.x; asm volatile("" : "+v"(t)); return t; }
__device__ __forceinline__ int opq_bid() { int b = blockIdx.x; asm volatile("" : "+s"(b)); return b; }
__device__ __forceinline__ unsigned pk2(float lo, float hi) { return (unsigned)f2bf(lo) | ((unsigned)f2bf(hi) << 16); }
struct u32x2_t { unsigned x, y; };
__device__ __forceinline__ void st_bf16x4(bf16_t* dst, f32x4 v) { u32x2_t o; o.x = pk2(v[0], v[1]); o.y = pk2(v[2], v[3]); *(u32x2_t*)dst = o; }
template <class Epi>
__device__ __forceinline__ void gemm_tile(const bf16_t* a0, const bf16_t* a1, const bf16_t* b0, const bf16_t* b1, int K, char* lds, const Epi& epi) {
    const int tid = opq_tid(), wid = tid >> 6, lane = tid & 63, wr = wid >> 1, wc = wid & 1, fr = lane & 15, fq = lane >> 4;
    f32x4 acc[4][4];
#pragma unroll
    for (int m = 0; m < 4; ++m)
#pragma unroll
        for (int n = 0; n < 4; ++n) acc[m][n] = (f32x4){0.f, 0.f, 0.f, 0.f};
#define GT_STAGE(st_, kt_) do { char* sa_ = lds + (st_) * 16384 + tid * 16; \
        __builtin_amdgcn_global_load_lds((const unsigned*)(a0 + (kt_)), (__attribute__((address_space(3))) unsigned*)(sa_), 16, 0, 0); \
        __builtin_amdgcn_global_load_lds((const unsigned*)(a1 + (kt_)), (__attribute__((address_space(3))) unsigned*)(sa_ + 4096), 16, 0, 0); \
        __builtin_amdgcn_global_load_lds((const unsigned*)(b0 + (kt_)), (__attribute__((address_space(3))) unsigned*)(sa_ + 8192), 16, 0, 0); \
        __builtin_amdgcn_global_load_lds((const unsigned*)(b1 + (kt_)), (__attribute__((address_space(3))) unsigned*)(sa_ + 12288), 16, 0, 0); } while (0)
    const int aoff = (wr * 64 + fr) * 64 + ((fq ^ ((fr >> 2) & 3)) * 16), boff = 8192 + (wc * 64 + fr) * 64 + ((fq ^ ((fr >> 2) & 3)) * 16);
    const int nk = K / 32;
    GT_STAGE(0, 0);
    if (nk > 1) GT_STAGE(1, 32);
    if (nk > 2) GT_STAGE(2, 64);
    for (int t = 0; t < nk; ++t) {
        if (t + 2 < nk) asm volatile("s_waitcnt vmcnt(8)" ::: "memory"); else if (t + 1 < nk) asm volatile("s_waitcnt vmcnt(4)" ::: "memory"); else asm volatile("s_waitcnt vmcnt(0)" ::: "memory");
        asm volatile("s_waitcnt lgkmcnt(0)" ::: "memory");
        __builtin_amdgcn_s_barrier();
        if (t + 3 < nk) GT_STAGE((t + 3) & 3, (t + 3) * 32);
        const char* sb = lds + (t & 3) * 16384;
        bf16x8 At[4], Bt[4];
#pragma unroll
        for (int m = 0; m < 4; ++m) At[m] = *(const bf16x8*)(sb + aoff + m * 1024);
#pragma unroll
        for (int n = 0; n < 4; ++n) Bt[n] = *(const bf16x8*)(sb + boff + n * 1024);
#pragma unroll
        for (int m = 0; m < 4; ++m)
#pragma unroll
            for (int n = 0; n < 4; ++n) acc[m][n] = __builtin_amdgcn_mfma_f32_16x16x32_bf16(At[m], Bt[n], acc[m][n], 0, 0, 0);
    }
    asm volatile("s_waitcnt lgkmcnt(0)" ::: "memory");
    __builtin_amdgcn_s_barrier();
#undef GT_STAGE
    epi(acc, wr, wc, fr, fq);
}
#define STG_ROW(i) ((tid_ + (i) * 256) >> 2)
#define STG_K ((((tid_ & 3) ^ ((tid_ >> 4) & 3))) * 8)

__device__ __forceinline__ void g_gemm_in(const Params& p, char* lds) {
    const int tid_ = opq_tid(), bid_ = opq_bid(); (void)tid_; (void)bid_;
    constexpr int NT = NINP / 128, MT = T / 128;
    for (int tile = bid_; tile < NT * MT; tile += gridDim.x) {
        const int tm = tile / NT, tn = tile % NT;
        const bf16_t* a0 = p.H + (size_t)(tm * 128 + STG_ROW(0)) * D + STG_K; const bf16_t* a1 = p.H + (size_t)(tm * 128 + STG_ROW(1)) * D + STG_K;
        const bf16_t* b0 = p.win_t + (size_t)(tn * 128 + STG_ROW(0)) * D + STG_K; const bf16_t* b1 = p.win_t + (size_t)(tn * 128 + STG_ROW(1)) * D + STG_K;
        gemm_tile(a0, a1, b0, b1, D, lds, [&](const f32x4 (&acc)[4][4], int wr, int wc, int fr, int fq) {
            if (tn < ZVB / 128 && tm < TL / 128) {
#pragma unroll
                for (int m = 0; m < 4; ++m)
#pragma unroll
                    for (int j = 0; j < 4; ++j) { const int row = tm * 128 + wr * 64 + m * 16 + fq * 4 + j, t = row % S;
                        bf16_t* zr = p.Z + (size_t)row * ZP + tn * 128 + wc * 64 + fr;
#pragma unroll
                        for (int ax = 0; ax < 2; ++ax) { const int pos = ax ? t % GRID_W : t / GRID_W; const float cs = p.rope[pos * 16 + fr], sn = p.rope[1024 + pos * 16 + fr];
                            const float x0 = acc[m][2 * ax][j], x1 = acc[m][2 * ax + 1][j];
                            zr[32 * ax] = f2bf(x0 * cs - x1 * sn); zr[32 * ax + 16] = f2bf(x1 * cs + x0 * sn); } }
            } else {
#pragma unroll
            for (int m = 0; m < 4; ++m)
#pragma unroll
                for (int n = 0; n < 4; ++n) { const int col = tn * 128 + wc * 64 + n * 16 + fr;
                    if (col < ZP) {
#pragma unroll
                        for (int j = 0; j < 4; ++j) p.Z[(size_t)(tm * 128 + wr * 64 + m * 16 + fq * 4 + j) * ZP + col] = f2bf(acc[m][n][j]); } }
            }
            if (tn == ZVB / 128 || (tn >= ZVN / 128 && tn < ZA / 128)) {
#pragma unroll
                for (int m = 0; m < 4; ++m) { const int m0 = tm * 128 + wr * 64 + m * 16 + fq * 4; int b, u;
                    if (m0 < TL) { b = m0 / S; u = L + m0 % S; } else { b = (m0 - TL) / L; u = (m0 - TL) % L; }
#pragma unroll
                    for (int n = 0; n < 4; ++n) { const int col = tn * 128 + wc * 64 + n * 16 + fr;
                        const int hv = col < ZVN ? (col - ZVB) >> 6 : 2 + ((col - ZVN) >> 6), d = col < ZVN ? (col - ZVB) & 63 : (col - ZVN) & 63;
                        st_bf16x4(p.VT + ((size_t)(b * 8 + hv) * 64 + d) * PU + u, acc[m][n]); } }
            }
        });
    }
}
__device__ __forceinline__ void g_gemm_out(const Params& p, int nrows, char* lds) {
    const int tid_ = opq_tid(), bid_ = opq_bid(); (void)tid_; (void)bid_;
    constexpr int NT = D / 128; const int MT = nrows / 128;
    for (int tile = bid_; tile < NT * MT; tile += gridDim.x) {
        const int tm = tile / NT, tn = tile % NT;
        const bf16_t* a0 = p.MIX + (size_t)(tm * 128 + STG_ROW(0)) * DMIX + STG_K; const bf16_t* a1 = p.MIX + (size_t)(tm * 128 + STG_ROW(1)) * DMIX + STG_K;
        const bf16_t* b0 = p.wout_t + (size_t)(tn * 128 + STG_ROW(0)) * DMIX + STG_K; const bf16_t* b1 = p.wout_t + (size_t)(tn * 128 + STG_ROW(1)) * DMIX + STG_K;
        gemm_tile(a0, a1, b0, b1, DMIX, lds, [&](const f32x4 (&acc)[4][4], int wr, int wc, int fr, int fq) {
#pragma unroll
            for (int m = 0; m < 4; ++m)
#pragma unroll
                for (int n = 0; n < 4; ++n)
#pragma unroll
                    for (int j = 0; j < 4; ++j) p.O[(size_t)(tm * 128 + wr * 64 + m * 16 + fq * 4 + j) * D + tn * 128 + wc * 64 + n * 16 + fr] = acc[m][n][j];
        });
    }
}
__device__ __forceinline__ void g_moe1(const Params& p, int l, char* lds) {
    const int tid_ = opq_tid(), bid_ = opq_bid(); (void)tid_; (void)bid_;
    const int* cnt = p.cnt + l * NEXP; const int nrb = moe_blocks(cnt); constexpr int NT = 2 * DE / 128;
    for (int tile = bid_; tile < nrb * NT; tile += gridDim.x) {
        const int rb = tile / NT, tn = tile % NT, e = moe_block_expert(cnt, rb);
        const bf16_t* a0 = p.H + (size_t)p.slotTok[rb * 128 + STG_ROW(0)] * D + STG_K; const bf16_t* a1 = p.H + (size_t)p.slotTok[rb * 128 + STG_ROW(1)] * D + STG_K;
        const bf16_t* bw = p.wgu_t + (size_t)e * 2 * DE * D;
        const bf16_t* b0 = bw + (size_t)(tn * 128 + STG_ROW(0)) * D + STG_K; const bf16_t* b1 = bw + (size_t)(tn * 128 + STG_ROW(1)) * D + STG_K;
        gemm_tile(a0, a1, b0, b1, D, lds, [&](const f32x4 (&acc)[4][4], int wr, int wc, int fr, int fq) {
#pragma unroll
            for (int m = 0; m < 4; ++m)
#pragma unroll
                for (int n2 = 0; n2 < 2; ++n2) { const int col = tn * 64 + wc * 32 + n2 * 16 + fr;
#pragma unroll
                    for (int j = 0; j < 4; ++j) { const float g = acc[m][2 * n2][j], u = acc[m][2 * n2 + 1][j];
                        p.ACT[(size_t)(rb * 128 + wr * 64 + m * 16 + fq * 4 + j) * DE + col] = f2bf(g / (1.0f + __expf(-g)) * u); } }
        });
    }
}
__device__ __forceinline__ void g_moe2(const Params& p, int l, char* lds) {
    const int tid_ = opq_tid(), bid_ = opq_bid(); (void)tid_; (void)bid_;
    const int* cnt = p.cnt + l * NEXP; const int nrb = moe_blocks(cnt); constexpr int NT = D / 128;
    for (int tile = bid_; tile < nrb * NT; tile += gridDim.x) {
        const int rb = tile / NT, tn = tile % NT, e = moe_block_expert(cnt, rb);
        const bf16_t* a0 = p.ACT + (size_t)(rb * 128 + STG_ROW(0)) * DE + STG_K; const bf16_t* a1 = p.ACT + (size_t)(rb * 128 + STG_ROW(1)) * DE + STG_K;
        const bf16_t* bw = p.wd_t + (size_t)e * D * DE;
        const bf16_t* b0 = bw + (size_t)(tn * 128 + STG_ROW(0)) * DE + STG_K; const bf16_t* b1 = bw + (size_t)(tn * 128 + STG_ROW(1)) * DE + STG_K;
        gemm_tile(a0, a1, b0, b1, DE, lds, [&](const f32x4 (&acc)[4][4], int wr, int wc, int fr, int fq) {
#pragma unroll
            for (int m = 0; m < 4; ++m)
#pragma unroll
                for (int n = 0; n < 4; ++n)
#pragma unroll
                    for (int j = 0; j < 4; ++j) p.YS[(size_t)(rb * 128 + wr * 64 + m * 16 + fq * 4 + j) * D + tn * 128 + wc * 64 + n * 16 + fr] = acc[m][n][j];
        });
    }
}


constexpr int DV = D / 256;
static_assert(D % 256 == 0, "row phases hold a row as DV float4 per lane");
template <int CTRL> __device__ __forceinline__ float dppf(float v) { return __builtin_bit_cast(float, __builtin_amdgcn_update_dpp(0, __builtin_bit_cast(int, v), CTRL, 0xf, 0xf, true)); }
__device__ __forceinline__ float wave_sum(float v) {
    v += dppf<0xB1>(v); v += dppf<0x4E>(v); v += dppf<0x141>(v); v += dppf<0x140>(v);
    float a = v, b = v;
    asm volatile("s_nop 1\n\tv_permlane16_swap_b32 %0, %1" : "+v"(a), "+v"(b));
    v = a + b; a = v; b = v;
    asm volatile("s_nop 1\n\tv_permlane32_swap_b32 %0, %1" : "+v"(a), "+v"(b));
    return a + b;
}
__device__ __forceinline__ float sum8(float v) { v += dppf<0xB1>(v); v += dppf<0x4E>(v); v += dppf<0x141>(v); return v; }
__device__ __forceinline__ float sum4(f32x4 a) { return (a[0] + a[1]) + (a[2] + a[3]); }
#define LDS_WAIT() asm volatile("s_waitcnt lgkmcnt(0)" ::: "memory")

__device__ __forceinline__ void row_stats(const f32x4 (&v)[DV], float& mu, float& rstd) {
    float s = 0.f;
#pragma unroll
    for (int j = 0; j < DV; ++j) s += sum4(v[j]);
    mu = wave_sum(s) * (1.0f / D);
    float q = 0.f;
#pragma unroll
    for (int j = 0; j < DV; ++j) { const f32x4 d = v[j] - mu; q += sum4(d * d); }
    rstd = 1.0f / sqrtf(wave_sum(q) * (1.0f / D) + LN_EPS);
}

__device__ __forceinline__ void ph_lnmod_fast(const Params& p, int l) {
    const int tid_ = opq_tid(), bid_ = opq_bid(); (void)tid_; (void)bid_;
    const int lane = tid_ & 63, gw = bid_ * 4 + (tid_ >> 6), nw = gridDim.x * 4;
    for (int m = gw; m < T; m += nw) {
        const f32x4* xr = (const f32x4*)xrow_in(p, l, m) + lane; const f32x4* md = (const f32x4*)modrow(p, l, m) + lane;
        f32x4 v[DV];
#pragma unroll
        for (int j = 0; j < DV; ++j) v[j] = xr[64 * j];
        float mu, rstd; row_stats(v, mu, rstd);
#pragma unroll
        for (int j = 0; j < DV; ++j) { const f32x4 sh = md[64 * j], sc = md[D / 4 + 64 * j];
            st_bf16x4(p.H + (size_t)m * D + 4 * (lane + 64 * j), (v[j] - mu) * rstd * (sc + 1.0f) + sh); }
    }
}

__device__ __forceinline__ void ph_post_mixer_fast(const Params& p, int l, int nrows) {
    const int tid_ = opq_tid(), bid_ = opq_bid(); (void)tid_; (void)bid_;
    const int lane = tid_ & 63, gw = bid_ * 4 + (tid_ >> 6), nw = gridDim.x * 4;
    for (int m = gw; m < nrows; m += nw) {
        const f32x4* xr = (const f32x4*)xrow_in(p, l, m) + lane; const f32x4* md = (const f32x4*)modrow(p, l, m) + lane;
        const f32x4* orow = (const f32x4*)(p.O + (size_t)m * D) + lane;
        f32x4* x1 = (f32x4*)((m < TL) ? p.out + (size_t)m * D : p.XC + (size_t)(m - TL) * D) + lane;
        const f32x4* g1 = (const f32x4*)(p.ln1_g + (size_t)l * D) + lane; const f32x4* b1 = (const f32x4*)(p.ln1_b + (size_t)l * D) + lane;
        f32x4 v[DV];
#pragma unroll
        for (int j = 0; j < DV; ++j) v[j] = xr[64 * j] * ALPHA + md[2 * (D / 4) + 64 * j] * orow[64 * j];
        float mu, rstd; row_stats(v, mu, rstd);
#pragma unroll
        for (int j = 0; j < DV; ++j) { v[j] = (v[j] - mu) * rstd * g1[64 * j] + b1[64 * j]; x1[64 * j] = v[j]; }
        row_stats(v, mu, rstd);
#pragma unroll
        for (int j = 0; j < DV; ++j) {
            const f32x4 hv = (v[j] - mu) * rstd * (md[4 * (D / 4) + 64 * j] + 1.0f) + md[3 * (D / 4) + 64 * j];
            f32x4 hh, lo;
#pragma unroll
            for (int e = 0; e < 4; ++e) { hh[e] = bf2f(f2bf(hv[e])); lo[e] = hv[e] - hh[e]; }
            st_bf16x4(p.H + (size_t)m * D + 4 * (lane + 64 * j), hh);
            st_bf16x4(p.HLO + (size_t)m * D + 4 * (lane + 64 * j), lo);
        }
    }
}

__device__ __forceinline__ void g_router(const Params& p, int l, int nrows, char* lds) {
    const int tid_ = opq_tid(), bid_ = opq_bid(); (void)tid_; (void)bid_;
    const int lane = tid_ & 63, wid = tid_ >> 6, fr = lane & 15, fq = lane >> 4;
    float* part = (float*)lds;
    float* lgt = part + 4 * 6 * 64 * 4;
    int* eids = (int*)(lgt + 32 * 48);
    for (int rg = bid_; rg < nrows / 32; rg += gridDim.x) {
        f32x4 acc[2][3];
#pragma unroll
        for (int a = 0; a < 2; ++a)
#pragma unroll
            for (int b = 0; b < 3; ++b) acc[a][b] = (f32x4){0.f, 0.f, 0.f, 0.f};
#pragma unroll
        for (int seg = 0; seg < 3; ++seg) {
            const bf16_t* ap = (seg < 2 ? p.H : p.HLO) + (size_t)(rg * 32 + fr) * D + wid * (D / 4) + fq * 8;
            const bf16_t* bp = p.wrt + (seg == 1 ? (size_t)128 * D : 0) + (size_t)fr * D + wid * (D / 4) + fq * 8;
#pragma unroll 1
            for (int ks0 = 0; ks0 < D / 128; ks0 += 4) {
                bf16x8 av[4][2], bv[4][3];
#pragma unroll
                for (int u = 0; u < 4; ++u) { const int ko = (ks0 + u) * 32;
                    av[u][0] = *(const bf16x8*)(ap + ko); av[u][1] = *(const bf16x8*)(ap + (size_t)16 * D + ko);
                    bv[u][0] = *(const bf16x8*)(bp + ko); bv[u][1] = *(const bf16x8*)(bp + (size_t)16 * D + ko); bv[u][2] = *(const bf16x8*)(bp + (size_t)32 * D + ko); }
                asm volatile("" ::: "memory");
#pragma unroll
                for (int u = 0; u < 4; ++u)
#pragma unroll
                    for (int a = 0; a < 2; ++a)
#pragma unroll
                        for (int b = 0; b < 3; ++b) acc[a][b] = __builtin_amdgcn_mfma_f32_16x16x32_bf16(av[u][a], bv[u][b], acc[a][b], 0, 0, 0);
            }
        }
#pragma unroll
        for (int a = 0; a < 2; ++a)
#pragma unroll
            for (int b = 0; b < 3; ++b) *(f32x4*)(part + ((wid * 6 + a * 3 + b) * 64 + lane) * 4) = acc[a][b];
        __syncthreads();
#pragma unroll
        for (int i = 0; i < 6; ++i) { const int e = tid_ + 256 * i, f = e >> 8, ln = (e & 255) >> 2, j = e & 3;
            const float sm = (part[((0 * 6 + f) * 64 + ln) * 4 + j] + part[((1 * 6 + f) * 64 + ln) * 4 + j]) + (part[((2 * 6 + f) * 64 + ln) * 4 + j] + part[((3 * 6 + f) * 64 + ln) * 4 + j]);
            lgt[((f / 3) * 16 + (ln >> 4) * 4 + j) * 48 + (f % 3) * 16 + (ln & 15)] = sm; }
        __syncthreads();
        if (tid_ < 32) {
            const int m = rg * 32 + tid_; const float* lg = lgt + tid_ * 48;
            float gl[4], el[32];
#pragma unroll
            for (int g = 0; g < 4; ++g) gl[g] = lg[g] + p.b_rg[l * 4 + g];
#pragma unroll
            for (int e = 0; e < 32; ++e) el[e] = lg[4 + e] + p.b_re[l * 32 + e];
            int gs = 0; float gm = gl[0];
#pragma unroll
            for (int g = 1; g < 4; ++g) if (gl[g] > gm) { gm = gl[g]; gs = g; }
            float den = 0.f;
#pragma unroll
            for (int g = 0; g < 4; ++g) den += expf(gl[g] - gm);
            const float pg = 1.0f / den;
            float v1 = -3e38f, v2 = -3e38f; int i1 = 0, i2 = 0;
#pragma unroll
            for (int j = 0; j < 8; ++j) {
                const float vv = gs == 0 ? el[j] : gs == 1 ? el[8 + j] : gs == 2 ? el[16 + j] : el[24 + j];
                if (vv > v1) { v2 = v1; i2 = i1; v1 = vv; i1 = j; } else if (vv > v2) { v2 = vv; i2 = j; }
            }
            const float e2 = expf(v2 - v1), w1 = pg / (1.0f + e2), w2 = pg * e2 / (1.0f + e2);
            const int ea = gs * 8 + i1, eb = gs * 8 + i2;
            p.rE[2 * m] = ea; p.rE[2 * m + 1] = eb; p.rW[2 * m] = w1; p.rW[2 * m + 1] = w2;
            eids[2 * tid_] = ea; eids[2 * tid_ + 1] = eb;
        }
        __syncthreads();
        if (tid_ < 64) { const int e = eids[tid_]; int rk = 0; for (int j = 0; j < tid_; ++j) rk += (eids[j] == e) ? 1 : 0; p.rPos[2 * (rg * 32) + tid_] = rk; }
        else if (tid_ < 96) { const int e = tid_ - 64; int c = 0; for (int j = 0; j < 64; ++j) c += (eids[j] == e) ? 1 : 0; p.hist[rg * 32 + e] = c; }
        __syncthreads();
    }
}

__device__ __forceinline__ void ph_dispatch_fast(const Params& p, int l, int nrows, char* lds) {
    const int tid_ = opq_tid(), bid_ = opq_bid(); (void)tid_; (void)bid_;
    const int nrg = nrows / 32, e = tid_ & 31, part = tid_ >> 5;
    int* tot = (int*)lds; int* pst = tot + 32; int* pre = pst + 32; int* red = pre + 32;
    { int s = 0; for (int b = part; b < nrg; b += 8) s += p.hist[b * 32 + e]; red[part * 32 + e] = s; }
    __syncthreads();
    if (tid_ < 32) { int s = 0; for (int q = 0; q < 8; ++q) s += red[q * 32 + tid_]; tot[tid_] = s; }
    __syncthreads();
    if (tid_ < 32) { int s = 0; for (int j = 0; j < tid_; ++j) s += (tot[j] + 127) & ~127; pst[tid_] = s; if (bid_ == 0) p.cnt[l * NEXP + tid_] = tot[tid_]; }
    for (int rg = bid_; rg < nrg; rg += gridDim.x) {
        __syncthreads();
        { int s = 0; for (int b = part; b < rg; b += 8) s += p.hist[b * 32 + e]; red[part * 32 + e] = s; }
        __syncthreads();
        if (tid_ < 32) { int s = 0; for (int q = 0; q < 8; ++q) s += red[q * 32 + tid_]; pre[tid_] = s; }
        __syncthreads();
        if (tid_ < 64) { const int i = 2 * (rg * 32) + tid_, ee = p.rE[i], slot = pst[ee] + pre[ee] + p.rPos[i]; p.rSlot[i] = slot; p.slotTok[slot] = i >> 1; }
    }
}

__device__ __forceinline__ void ph_final_fast(const Params& p, int l, int nrows) {
    const int tid_ = opq_tid(), bid_ = opq_bid(); (void)tid_; (void)bid_;
    const int lane = tid_ & 63, gw = bid_ * 4 + (tid_ >> 6), nw = gridDim.x * 4;
    for (int m = gw; m < nrows; m += nw) {
        f32x4* x1 = (f32x4*)((m < TL) ? p.out + (size_t)m * D : p.XC + (size_t)(m - TL) * D) + lane;
        const f32x4* md = (const f32x4*)modrow(p, l, m) + lane;
        const f32x4* ya = (const f32x4*)(p.YS + (size_t)p.rSlot[2 * m] * D) + lane; const f32x4* yb = (const f32x4*)(p.YS + (size_t)p.rSlot[2 * m + 1] * D) + lane;
        const float wa = p.rW[2 * m], wb = p.rW[2 * m + 1];
        const f32x4* g2 = (const f32x4*)(p.ln2_g + (size_t)l * D) + lane; const f32x4* b2 = (const f32x4*)(p.ln2_b + (size_t)l * D) + lane;
        f32x4 v[DV];
#pragma unroll
        for (int j = 0; j < DV; ++j) v[j] = x1[64 * j] * ALPHA + md[5 * (D / 4) + 64 * j] * (ya[64 * j] * wa + yb[64 * j] * wb);
        float mu, rstd; row_stats(v, mu, rstd);
#pragma unroll
        for (int j = 0; j < DV; ++j) x1[64 * j] = (v[j] - mu) * rstd * g2[64 * j] + b2[64 * j];
    }
}

__device__ __forceinline__ void ph_mod_fast(const Params& p, char* lds) {
    const int tid_ = opq_tid(), bid_ = opq_bid(); (void)tid_; (void)bid_;
    constexpr int NR = NB + 1, NTASK = 2 * (6 * D / 64);
    if (bid_ >= NTASK) return;
    float* sc = (float*)lds;
    float* part = sc + NR * D;
    for (int i = tid_; i < NR * D; i += 256) { const int b = i / D, k = i % D; const float cv = b < NB ? p.c[(size_t)b * D + k] : p.c_ctx[k]; sc[i] = cv / (1.0f + __expf(-cv)); }
    __syncthreads();
    const int lane = tid_ & 63, wid = tid_ >> 6;
    for (int task = bid_; task < NTASK; task += gridDim.x) {
        const int ll = task / (6 * D / 64), col = 64 * (task % (6 * D / 64)) + lane;
        float acc[NR];
#pragma unroll
        for (int b = 0; b < NR; ++b) acc[b] = 0.f;
        const float* wp = p.w_mod + ((size_t)ll * D + wid * (D / 4)) * 6 * D + col;
#pragma unroll 16
        for (int k = 0; k < D / 4; ++k) { const float w = wp[(size_t)k * 6 * D];
#pragma unroll
            for (int b = 0; b < NR; ++b) acc[b] += sc[b * D + wid * (D / 4) + k] * w; }
#pragma unroll
        for (int b = 0; b < NR; ++b) part[(wid * NR + b) * 64 + lane] = acc[b];
        __syncthreads();
        for (int i = tid_; i < NR * 64; i += 256) { const int b = i / 64, cl = i % 64;
            p.mod[((size_t)ll * NR + b) * 6 * D + 64 * (task % (6 * D / 64)) + cl] = (part[(0 * NR + b) * 64 + cl] + part[(1 * NR + b) * 64 + cl]) + (part[(2 * NR + b) * 64 + cl] + part[(3 * NR + b) * 64 + cl]) + p.b_mod[(size_t)ll * 6 * D + 64 * (task % (6 * D / 64)) + cl]; }
        __syncthreads();
    }
}

__device__ __forceinline__ void tr_item(const float* srcl, size_t ldw, bf16_t* dst, size_t ldd, float* scr, int lane) {
#pragma unroll 8
    for (int i = 0; i < 32; ++i) { const int kk = 2 * i + (lane >> 5); scr[kk * 33 + (lane & 31)] = srcl ? srcl[(size_t)kk * ldw] : 0.f; }
    LDS_WAIT();
    const int c = lane & 7;
#pragma unroll
    for (int j = 0; j < 4; ++j) { const int n = (lane >> 3) + 8 * j; const float* s = scr + (8 * c) * 33 + n;
        uint4 o; o.x = pk2(s[0], s[33]); o.y = pk2(s[2 * 33], s[3 * 33]); o.z = pk2(s[4 * 33], s[5 * 33]); o.w = pk2(s[6 * 33], s[7 * 33]);
        *(uint4*)(dst + (size_t)n * ldd + 8 * c) = o; }
    LDS_WAIT();
}
__device__ __forceinline__ void ph_prep_w_fast(const Params& p, int l, int part, char* lds) {
    const int tid_ = opq_tid(), bid_ = opq_bid(); (void)tid_; (void)bid_;
    const int lane = tid_ & 63, wid = tid_ >> 6, gw = bid_ * 4 + wid, nw = gridDim.x * 4;
    float* scr = (float*)(lds + wid * 8448);
    constexpr int I_IN = (D / 64) * (NINP / 32), I_OUT = (DMIX / 64) * (D / 32), I_GU1 = (D / 64) * (2 * DE / 32), I_D1 = (DE / 64) * (D / 32);
    constexpr int NITEMS = I_IN + I_OUT + NEXP * (I_GU1 + I_D1);
    const int it0 = part == 0 ? 0 : I_IN + I_OUT, it1 = part == 0 ? I_IN + I_OUT : NITEMS;
    for (int it = it0 + gw; it < it1; it += nw) {
        int r = it;
        if (r < I_IN) { const int kb = r / (NINP / 32), n0 = 32 * (r % (NINP / 32));
            const float* s = nullptr;
            if (n0 < N_IN) { const int oc = (n0 < ZA) ? n0 + A_IN : n0 - ZA; s = p.w_in + ((size_t)l * D + 64 * kb) * N_IN + oc + (lane & 31); }
            tr_item(s, N_IN, p.win_t + (size_t)n0 * D + 64 * kb, D, scr, lane); continue; }
        r -= I_IN;
        if (r < I_OUT) { const int kb = r / (D / 32), n0 = 32 * (r % (D / 32));
            tr_item(p.w_out + ((size_t)l * DMIX + 64 * kb) * D + n0 + (lane & 31), D, p.wout_t + (size_t)n0 * DMIX + 64 * kb, DMIX, scr, lane); continue; }
        r -= I_OUT;
        const int e = r / (I_GU1 + I_D1); r %= (I_GU1 + I_D1);
        if (r < I_GU1) { const int kb = r / (2 * DE / 32), q = r % (2 * DE / 32);
            const float* s = (((lane & 31) >> 4) ? p.w_up : p.w_gate) + (((size_t)l * NEXP + e) * D + 64 * kb) * DE + 16 * q + (lane & 15);
            tr_item(s, DE, p.wgu_t + ((size_t)e * 2 * DE + 32 * q) * D + 64 * kb, D, scr, lane); continue; }
        r -= I_GU1;
        { const int kb = r / (D / 32), n0 = 32 * (r % (D / 32));
            tr_item(p.w_down + (((size_t)l * NEXP + e) * DE + 64 * kb) * D + n0 + (lane & 31), D, p.wd_t + ((size_t)e * D + n0) * DE + 64 * kb, DE, scr, lane); }
    }
    if (part != 0) return;
    const long gt = (long)bid_ * blockDim.x + tid_, gs = (long)gridDim.x * blockDim.x;
    for (long i = gt; i < 2 * 256 * 64; i += gs) { const int k = (int)(i & 63), n = (int)((i >> 6) & 255), d = (int)(i >> 14);
        p.wupT[i] = f2bf(p.a_w_up[(((size_t)l * 2 + d) * 64 + k) * DA + n]); p.aupT[i] = f2bf(p.a_a_up[(((size_t)l * 2 + d) * 64 + k) * DA + n]); }
    for (long i = gt; i < 256 * 160; i += gs) { const int k = (int)(i % 160), n = (int)(i / 160); p.gupT[i] = f2bf(p.a_g_up[((size_t)l * 160 + k) * DA + n]); }
    for (long i = gt; i < (long)128 * D; i += gs) { const int n = (int)(i / D), k = (int)(i % D);
        const float w = n < 4 ? p.w_rg[((size_t)l * D + k) * 4 + n] : n < 36 ? p.w_re[((size_t)l * D + k) * 32 + n - 4] : 0.f;
        const bf16_t hb = f2bf(w); p.wrt[i] = hb; p.wrt[(size_t)128 * D + i] = f2bf(w - bf2f(hb)); }
}

__device__ __forceinline__ float tanh_fast(float x) { return 1.0f - 2.0f / (1.0f + __expf(2.0f * x)); }
__device__ __forceinline__ void ph_streams_s1(const Params& p, int l) {
    const int tid_ = opq_tid(), bid_ = opq_bid(); (void)tid_; (void)bid_;
    constexpr int NCH = A_IN / 8, NCHP = (NCH + 7) & ~7;
    const float* sh = p.a_shift + (size_t)l * 3 * A_IN;
    for (long it = (long)bid_ * 256 + tid_; it < (long)T * NCHP; it += (long)gridDim.x * 256) {
        const int m = (int)(it / NCHP), ch = (int)(it % NCHP), c0 = 8 * ch;
        const bool act = ch < NCH;
        int t, len;
        if (m < TL) { t = m % S; len = S; } else { t = (m - TL) % L; len = L; }
        float v[8];
#pragma unroll
        for (int e = 0; e < 8; ++e) v[e] = 0.f;
        if (act) {
            const bf16_t* z = p.Z + (size_t)m * ZP + ZA + c0;
            const bf16x8 zc = *(const bf16x8*)z;
            const f32x4 s1a = *(const f32x4*)(sh + A_IN + c0), s1b = *(const f32x4*)(sh + A_IN + c0 + 4);
#pragma unroll
            for (int e = 0; e < 8; ++e) v[e] = (e < 4 ? s1a[e] : s1b[e - 4]) * bf2f((bf16_t)zc[e]);
            if (t > 0) { const bf16x8 zp = *(const bf16x8*)(z - ZP); const f32x4 a = *(const f32x4*)(sh + c0), b = *(const f32x4*)(sh + c0 + 4);
#pragma unroll
                for (int e = 0; e < 8; ++e) v[e] += (e < 4 ? a[e] : b[e - 4]) * bf2f((bf16_t)zp[e]); }
            if (t < len - 1) { const bf16x8 zn = *(const bf16x8*)(z + ZP); const f32x4 a = *(const f32x4*)(sh + 2 * A_IN + c0), b = *(const f32x4*)(sh + 2 * A_IN + c0 + 4);
#pragma unroll
                for (int e = 0; e < 8; ++e) v[e] += (e < 4 ? a[e] : b[e - 4]) * bf2f((bf16_t)zn[e]); }
        }
        float nrm = 0.f;
        if (ch >= 32 && ch < 64) {
#pragma unroll
            for (int e = 0; e < 8; ++e) { const float t2 = v[e] * p.a_k_k[l * DA + c0 - 256 + e]; nrm += t2 * t2; } }
        nrm = sum8(nrm);
        if (!act) continue;
        if (c0 < 768) {
            float* dst = (c0 < 256 ? p.sR + (size_t)m * DA + c0 : c0 < 512 ? p.kT + (size_t)m * DA + c0 - 256 : p.sV + (size_t)m * DA + c0 - 512);
            *(f32x4*)dst = (f32x4){v[0], v[1], v[2], v[3]}; *(f32x4*)(dst + 4) = (f32x4){v[4], v[5], v[6], v[7]};
            if (ch >= 32 && ch < 64 && (ch & 7) == 0) p.kN[(size_t)m * 4 + ((ch - 32) >> 3)] = 1.0f / sqrtf(nrm + 1e-12f);
        } else {
            if (c0 < 896) {
#pragma unroll
                for (int e = 0; e < 8; ++e) v[e] = tanh_fast(v[e]); }
            else if (c0 >= 1024) {
#pragma unroll
                for (int e = 0; e < 8; ++e) v[e] = 1.0f / (1.0f + __expf(-v[e])); }
            uint4 o; o.x = pk2(v[0], v[1]); o.y = pk2(v[2], v[3]); o.z = pk2(v[4], v[5]); o.w = pk2(v[6], v[7]);
            *(uint4*)(p.LA + (size_t)m * 416 + c0 - 768) = o;
        }
    }
}
__device__ __forceinline__ void g_streams_s2(const Params& p, int l, char* lds) {
    const int tid_ = opq_tid(), bid_ = opq_bid(); (void)tid_; (void)bid_;
    constexpr int MT = T / 128;
    for (int job = bid_; job < 5 * MT * 2; job += gridDim.x) {
        const int type = job / (MT * 2), r = job % (MT * 2), tm = r >> 1, tn = r & 1;
        const int coff = type < 2 ? type * 64 : type < 4 ? 128 + (type - 2) * 64 : 256, K = type < 4 ? 64 : 160, d = type & 1;
        const bf16_t* Bt = type < 2 ? p.wupT + type * 256 * 64 : type < 4 ? p.aupT + (type - 2) * 256 * 64 : p.gupT;
        const bf16_t* a0 = p.LA + (size_t)(tm * 128 + STG_ROW(0)) * 416 + coff + STG_K; const bf16_t* a1 = p.LA + (size_t)(tm * 128 + STG_ROW(1)) * 416 + coff + STG_K;
        const bf16_t* b0 = Bt + (size_t)(tn * 128 + STG_ROW(0)) * K + STG_K; const bf16_t* b1 = Bt + (size_t)(tn * 128 + STG_ROW(1)) * K + STG_K;
        if (type < 2) gemm_tile(a0, a1, b0, b1, K, lds, [&](const f32x4 (&acc)[4][4], int wr, int wc, int fr, int fq) {
#pragma unroll
            for (int mi = 0; mi < 4; ++mi) {
#pragma unroll
                for (int n = 0; n < 4; ++n) { const int c = tn * 128 + wc * 64 + n * 16 + fr; const float w0 = p.a_w0[(l * 2 + d) * DA + c];
#pragma unroll
                    for (int j = 0; j < 4; ++j) { const int row = tm * 128 + wr * 64 + mi * 16 + fq * 4 + j;
                        const float e = __expf(-(w0 + acc[mi][n][j]));
                        p.sW[((size_t)d * T + row) * DA + c] = __expf(-0.60653065971f / (1.0f + e)); } }
                asm volatile("" ::: "memory"); }
        });
        else if (type < 4) gemm_tile(a0, a1, b0, b1, K, lds, [&](const f32x4 (&acc)[4][4], int wr, int wc, int fr, int fq) {
#pragma unroll
            for (int mi = 0; mi < 4; ++mi) {
#pragma unroll
                for (int n = 0; n < 4; ++n) { const int c = tn * 128 + wc * 64 + n * 16 + fr;
                    const float a0v = p.a_a0[(l * 2 + d) * DA + c], kkc = p.a_k_k[l * DA + c], kac = p.a_k_a[l * DA + c];
#pragma unroll
                    for (int j = 0; j < 4; ++j) { const int row = tm * 128 + wr * 64 + mi * 16 + fq * 4 + j;
                        const size_t o = (size_t)row * DA + c, od = ((size_t)d * T + row) * DA + c;
                        const float av = 1.0f / (1.0f + __expf(-(a0v + acc[mi][n][j]))); const float k = p.kT[o];
                        const float kk = k * kkc * p.kN[(size_t)row * 4 + (c >> 6)];
                        p.sKD[od] = k * (1.0f + (av - 1.0f) * kac); p.sB[od] = kk * av; if (d == 0) p.sKK[o] = kk; } }
                asm volatile("" ::: "memory"); }
        });
        else gemm_tile(a0, a1, b0, b1, K, lds, [&](const f32x4 (&acc)[4][4], int wr, int wc, int fr, int fq) {
#pragma unroll
            for (int mi = 0; mi < 4; ++mi)
#pragma unroll
                for (int n = 0; n < 4; ++n) { const int c = tn * 128 + wc * 64 + n * 16 + fr;
#pragma unroll
                    for (int j = 0; j < 4; ++j) p.sG[(size_t)(tm * 128 + wr * 64 + mi * 16 + fq * 4 + j) * DA + c] = acc[mi][n][j]; }
        });
    }
}


typedef float f32x16 __attribute__((ext_vector_type(16)));
typedef short s16x4 __attribute__((ext_vector_type(4)));
typedef unsigned u32x4_t __attribute__((ext_vector_type(4)));
typedef float f32x2_t __attribute__((ext_vector_type(2)));
typedef __bf16 bf16x2_t __attribute__((ext_vector_type(2)));
__device__ __forceinline__ unsigned cvtpk(float lo, float hi) { f32x2_t v = {lo, hi}; bf16x2_t b = __builtin_convertvector(v, bf16x2_t); return __builtin_bit_cast(unsigned, b); }
__device__ __forceinline__ int crow(int r, int hi) { return (r & 3) + 8 * (r >> 2) + 4 * hi; }

template <class MaskF>
__device__ __forceinline__ void attn_tile(const bf16x8 (&qf)[4], const bf16_t* krow, const bf16_t* vt0, const bf16_t* vt1, const MaskF& mask,
                                          float& m_run, float& l_run, f32x16& o0, f32x16& o1, int hi) {
    f32x16 s;
#pragma unroll
    for (int r = 0; r < 16; ++r) s[r] = 0.f;
#pragma unroll
    for (int ks = 0; ks < 4; ++ks) { const bf16x8 kf = *(const bf16x8*)(krow + 16 * ks); s = __builtin_amdgcn_mfma_f32_32x32x16_bf16(kf, qf[ks], s, 0, 0, 0); }
    float mx = -INFINITY;
#pragma unroll
    for (int r = 0; r < 16; ++r) { s[r] = mask(crow(r, hi), s[r] * ATT_SCALE); mx = fmaxf(mx, s[r]); }
    mx = fmaxf(mx, __shfl_xor(mx, 32));
    const float mn = fmaxf(m_run, mx), alpha = __expf(m_run - mn);
    m_run = mn;
    float ps = 0.f;
#pragma unroll
    for (int r = 0; r < 16; ++r) { s[r] = __expf(s[r] - mn); ps += s[r]; }
    l_run = l_run * alpha + ps;
#pragma unroll
    for (int r = 0; r < 16; ++r) { o0[r] *= alpha; o1[r] *= alpha; }
#pragma unroll
    for (int s2 = 0; s2 < 2; ++s2) {
        u32x4_t pw; pw[0] = cvtpk(s[8 * s2], s[8 * s2 + 1]); pw[1] = cvtpk(s[8 * s2 + 2], s[8 * s2 + 3]); pw[2] = cvtpk(s[8 * s2 + 4], s[8 * s2 + 5]); pw[3] = cvtpk(s[8 * s2 + 6], s[8 * s2 + 7]);
        const bf16x8 pb = __builtin_bit_cast(bf16x8, pw);
        const s16x4 a0 = *(const s16x4*)(vt0 + 16 * s2), a1 = *(const s16x4*)(vt0 + 16 * s2 + 8);
        const s16x4 c0 = *(const s16x4*)(vt1 + 16 * s2), c1 = *(const s16x4*)(vt1 + 16 * s2 + 8);
        o0 = __builtin_amdgcn_mfma_f32_32x32x16_bf16(__builtin_shufflevector(a0, a1, 0, 1, 2, 3, 4, 5, 6, 7), pb, o0, 0, 0, 0);
        o1 = __builtin_amdgcn_mfma_f32_32x32x16_bf16(__builtin_shufflevector(c0, c1, 0, 1, 2, 3, 4, 5, 6, 7), pb, o1, 0, 0, 0);
    }
}
struct NoMask { __device__ __forceinline__ float operator()(int, float v) const { return v; } };

__device__ __forceinline__ void ph_attn_mfma(const Params& p, int l, bool with_ctx) {
    const int tid_ = opq_tid(), bid_ = opq_bid(); (void)tid_; (void)bid_;
    const int lane = tid_ & 63, hi = lane >> 5, ql = lane & 31;
    const int gw = bid_ * 4 + (tid_ >> 6), nw = gridDim.x * 4;
    constexpr int NQT = S / 32, NCT = L / 32, N_LAT = NB * 6 * NQT, N_CTX = NB * 6 * NCT;
    const int ntask = 2 * N_LAT + (with_ctx ? 2 * N_CTX : 0);
    for (int task = gw; task < ntask; task += nw) {
        bool isC, isCtx; int r;
        if (task < N_LAT) { isC = true; isCtx = false; r = task; }
        else if (task < 2 * N_LAT) { isC = false; isCtx = false; r = task - N_LAT; }
        else { r = task - 2 * N_LAT; isCtx = true; isC = r >= N_CTX; if (isC) r -= N_CTX; }
        const int nqt = isCtx ? NCT : NQT, qt = r % nqt, h = (r / nqt) % 6, b = r / (nqt * 6);
        const int m = isCtx ? TL + b * L + 32 * qt + ql : b * S + 32 * qt + ql;
        const int qcol = isC ? ZQN + h * 64 : ZQB + h * 64, kcol = isC ? ZKN + h * 64 : ZKB + (h / 3) * 64, hv = isC ? 2 + h : h / 3;
        bf16x8 qf[4];
        { const bf16_t* qp = p.Z + (size_t)m * ZP + qcol + 8 * hi;
#pragma unroll
          for (int ks = 0; ks < 4; ++ks) qf[ks] = *(const bf16x8*)(qp + 16 * ks); }
        const bf16_t* kc0 = p.Z + (size_t)(TL + b * L + ql) * ZP + kcol + 8 * hi;
        const bf16_t* kl0 = p.Z + (size_t)(b * S + ql) * ZP + kcol + 8 * hi;
        const bf16_t* vt0 = p.VT + ((size_t)(b * 8 + hv) * 64 + ql) * PU + 4 * hi; const bf16_t* vt1 = vt0 + (size_t)32 * PU;
        f32x16 o0, o1;
#pragma unroll
        for (int rr = 0; rr < 16; ++rr) { o0[rr] = 0.f; o1[rr] = 0.f; }
        float m_run, l_run;
        if (isC) { m_run = -1e30f; l_run = 0.f; } else { m_run = p.b_sink[l * 6 + h]; l_run = hi == 0 ? 1.0f : 0.f; }
#pragma unroll 1
        for (int i = 0; i < NCT; ++i) attn_tile(qf, kc0 + (size_t)(32 * i) * ZP, vt0 + 32 * i, vt1 + 32 * i, NoMask(), m_run, l_run, o0, o1, hi);
        if (!isCtx) {
            if (!isC) {
#pragma unroll 1
                for (int jt = qt - 4; jt <= qt + 4; ++jt) {
                    if (jt < 0 || jt >= NQT) continue;
                    const bf16_t* kr = kl0 + (size_t)(32 * jt) * ZP; const bf16_t* v0 = vt0 + L + 32 * jt; const bf16_t* v1 = vt1 + L + 32 * jt;
                    if (jt == qt - 4 || jt == qt + 4) { const int base = 32 * (jt - qt) - ql;
                        attn_tile(qf, kr, v0, v1, [&](int ko, float v) { const int rel = base + ko; return (rel >= -128 && rel <= 128) ? v : -INFINITY; }, m_run, l_run, o0, o1, hi); }
                    else attn_tile(qf, kr, v0, v1, NoMask(), m_run, l_run, o0, o1, hi);
                }
            } else {
                constexpr int ROWS = S / GRID_W;
                const int gr = qt >> 1, c = 32 * (qt & 1) + ql;
                int r0 = gr - 4; r0 = r0 < 0 ? 0 : (r0 > ROWS - 8 ? ROWS - 8 : r0);
                int c0 = c - 8; c0 = c0 < 0 ? 0 : (c0 > GRID_W - 16 ? GRID_W - 16 : c0);
                const float* rpb = p.c_rpb + ((size_t)l * 6 + h) * 15 * 31;
#pragma unroll 1
                for (int a = 0; a < 8; ++a) {
                    const int kr_ = r0 + a; const float* rp = rpb + (kr_ - gr + 7) * 31 + 15 - c;
#pragma unroll 1
                    for (int ct = 0; ct < 2; ++ct) {
                        const int t0 = kr_ * GRID_W + 32 * ct;
                        attn_tile(qf, kl0 + (size_t)t0 * ZP, vt0 + L + t0, vt1 + L + t0,
                                  [&](int ko, float v) { const int kc = 32 * ct + ko; return (kc >= c0 && kc < c0 + 16) ? v + rp[kc] : -INFINITY; }, m_run, l_run, o0, o1, hi);
                    }
                }
            }
        }
        const float lt = l_run + __shfl_xor(l_run, 32), inv = 1.0f / lt;
        bf16_t* op = p.MIX + (size_t)m * DMIX + (isC ? 640 : 256) + h * 64 + 4 * hi;
#pragma unroll
        for (int g = 0; g < 4; ++g) {
            st_bf16x4(op + 8 * g, (f32x4){o0[4 * g] * inv, o0[4 * g + 1] * inv, o0[4 * g + 2] * inv, o0[4 * g + 3] * inv});
            st_bf16x4(op + 32 + 8 * g, (f32x4){o1[4 * g] * inv, o1[4 * g + 1] * inv, o1[4 * g + 2] * inv, o1[4 * g + 3] * inv});
        }
    }
}


template <class MaskF>
__device__ __forceinline__ void attn_tile_lds(const bf16x8 (&qf)[4], const char* ks, const char* vs, const MaskF& mask, float& m_run, float& l_run, f32x16& o0, f32x16& o1, int ql, int hi) {
    f32x16 s;
#pragma unroll
    for (int r = 0; r < 16; ++r) s[r] = 0.f;
#pragma unroll
    for (int k4 = 0; k4 < 4; ++k4) { const bf16x8 kf = *(const bf16x8*)(ks + ql * 128 + (((2 * k4 + hi) ^ (ql & 7)) * 16)); s = __builtin_amdgcn_mfma_f32_32x32x16_bf16(kf, qf[k4], s, 0, 0, 0); }
    float mx = -INFINITY;
#pragma unroll
    for (int r = 0; r < 16; ++r) { s[r] = mask(crow(r, hi), s[r] * ATT_SCALE); mx = fmaxf(mx, s[r]); }
    mx = fmaxf(mx, __shfl_xor(mx, 32));
    const float mn = fmaxf(m_run, mx), alpha = __expf(m_run - mn);
    m_run = mn;
    float ps = 0.f;
#pragma unroll
    for (int r = 0; r < 16; ++r) { s[r] = __expf(s[r] - mn); ps += s[r]; }
    l_run = l_run * alpha + ps;
#pragma unroll
    for (int r = 0; r < 16; ++r) { o0[r] *= alpha; o1[r] *= alpha; }
    const int sw0 = (ql >> 2) & 3;
#pragma unroll
    for (int s2 = 0; s2 < 2; ++s2) {
        u32x4_t pw; pw[0] = cvtpk(s[8 * s2], s[8 * s2 + 1]); pw[1] = cvtpk(s[8 * s2 + 2], s[8 * s2 + 3]); pw[2] = cvtpk(s[8 * s2 + 4], s[8 * s2 + 5]); pw[3] = cvtpk(s[8 * s2 + 6], s[8 * s2 + 7]);
        const bf16x8 pb = __builtin_bit_cast(bf16x8, pw);
        const char* v0 = vs + ql * 64 + 8 * hi; const char* v1 = v0 + 32 * 64;
        const s16x4 a0 = *(const s16x4*)(v0 + (((2 * s2) ^ sw0) * 16)), a1 = *(const s16x4*)(v0 + (((2 * s2 + 1) ^ sw0) * 16));
        const s16x4 c0 = *(const s16x4*)(v1 + (((2 * s2) ^ sw0) * 16)), c1 = *(const s16x4*)(v1 + (((2 * s2 + 1) ^ sw0) * 16));
        o0 = __builtin_amdgcn_mfma_f32_32x32x16_bf16(__builtin_shufflevector(a0, a1, 0, 1, 2, 3, 4, 5, 6, 7), pb, o0, 0, 0, 0);
        o1 = __builtin_amdgcn_mfma_f32_32x32x16_bf16(__builtin_shufflevector(c0, c1, 0, 1, 2, 3, 4, 5, 6, 7), pb, o1, 0, 0, 0);
    }
}

__device__ __forceinline__ void ph_attn_blk(const Params& p, int l, bool with_ctx, int first_blk, char* lds) {
    const int tid_ = opq_tid(), bid_ = opq_bid(); (void)tid_; (void)bid_;
    if (bid_ < first_blk) return;
    const int lane = tid_ & 63, hi = lane >> 5, ql = lane & 31, wid = tid_ >> 6;
    constexpr int NQG = S / 128, NCG = L / 128, ROWS = S / GRID_W, N_LAT = NB * 6 * NQG, N_CTX = NB * 6 * NCG, TPB = (S + L) / 32;
    const int ntask = 2 * N_LAT + (with_ctx ? 2 * N_CTX : 0);
    const int krow = tid_ >> 3, kch = (tid_ & 7) ^ (krow & 7), vrow = tid_ >> 2, vpc = (tid_ & 3) ^ ((vrow >> 2) & 3);
    for (int task = bid_ - first_blk; task < ntask; task += gridDim.x - first_blk) {
        bool isC, isCtx; int r;
        if (task < N_LAT) { isC = true; isCtx = false; r = task; }
        else if (task < 2 * N_LAT) { isC = false; isCtx = false; r = task - N_LAT; }
        else { r = task - 2 * N_LAT; isCtx = true; isC = r >= N_CTX; if (isC) r -= N_CTX; }
        const int ng = isCtx ? NCG : NQG, g = r % ng, h = (r / ng) % 6, b = r / (ng * 6);
        const int qt = 4 * g + wid;
        const int m = isCtx ? TL + b * L + 32 * qt + ql : b * S + 32 * qt + ql;
        const int qcol = isC ? ZQN + h * 64 : ZQB + h * 64, kcol = isC ? ZKN + h * 64 : ZKB + (h / 3) * 64, hv = isC ? 2 + h : h / 3;
        bf16x8 qf[4];
        { const bf16_t* qp = p.Z + (size_t)m * ZP + qcol + 8 * hi;
#pragma unroll
          for (int k4 = 0; k4 < 4; ++k4) qf[k4] = *(const bf16x8*)(qp + 16 * k4); }
        int lo = 0, hi_t = 0, gr0 = 0;
        if (!isCtx) {
            if (!isC) { lo = 4 * g - 4; hi_t = 4 * g + 8; lo = lo < 0 ? 0 : lo; hi_t = hi_t > S / 32 ? S / 32 : hi_t; }
            else { const int ra = 2 * g, rb = 2 * g + 1; int r0a = ra - 4; r0a = r0a < 0 ? 0 : (r0a > ROWS - 8 ? ROWS - 8 : r0a); int r0b = rb - 4; r0b = r0b < 0 ? 0 : (r0b > ROWS - 8 ? ROWS - 8 : r0b);
                   lo = 2 * r0a; hi_t = 2 * (r0b + 8); gr0 = 0; }
        }
        const int ntile = L / 32 + (hi_t - lo);
        const bf16_t* kbase = p.Z + (size_t)krow * ZP + kcol + 8 * kch;
        const bf16_t* vbase = p.VT + ((size_t)(b * 8 + hv) * 64 + vrow) * PU + 8 * vpc;
#define AT_TOK(i_) ((i_) < L / 32 ? 32 * (i_) : L + 32 * (lo + (i_) - L / 32))
#define AT_STAGE(i_) do { const int u0_ = AT_TOK(i_); const int zrow_ = u0_ < L ? TL + b * L + u0_ : b * S + (u0_ - L); char* sl_ = lds + ((i_) % 3) * 8192 + tid_ * 16; \
            __builtin_amdgcn_global_load_lds((const unsigned*)(kbase + (size_t)zrow_ * ZP), (__attribute__((address_space(3))) unsigned*)(sl_), 16, 0, 0); \
            __builtin_amdgcn_global_load_lds((const unsigned*)(vbase + u0_), (__attribute__((address_space(3))) unsigned*)(sl_ + 4096), 16, 0, 0); } while (0)
        f32x16 o0, o1;
#pragma unroll
        for (int rr = 0; rr < 16; ++rr) { o0[rr] = 0.f; o1[rr] = 0.f; }
        float m_run, l_run;
        if (isC) { m_run = -1e30f; l_run = 0.f; } else { m_run = p.b_sink[l * 6 + h]; l_run = hi == 0 ? 1.0f : 0.f; }
        const int gr = qt >> 1, c = 32 * (qt & 1) + ql;
        int r0 = gr - 4; r0 = r0 < 0 ? 0 : (r0 > ROWS - 8 ? ROWS - 8 : r0);
        int c0 = c - 8; c0 = c0 < 0 ? 0 : (c0 > GRID_W - 16 ? GRID_W - 16 : c0);
        float* rpb = (float*)(lds + 24576);
        if (isC && !isCtx) for (int i = tid_; i < 15 * 31; i += 256) rpb[i] = p.c_rpb[((size_t)l * 6 + h) * 15 * 31 + i];
        AT_STAGE(0);
        if (ntile > 1) AT_STAGE(1);
#pragma unroll 1
        for (int i = 0; i < ntile; ++i) {
            if (i + 1 < ntile) asm volatile("s_waitcnt vmcnt(2)" ::: "memory"); else asm volatile("s_waitcnt vmcnt(0)" ::: "memory");
            asm volatile("s_waitcnt lgkmcnt(0)" ::: "memory");
            __builtin_amdgcn_s_barrier();
            if (i + 2 < ntile) AT_STAGE(i + 2);
            const char* ks = lds + (i % 3) * 8192; const char* vs = ks + 4096;
            if (i < L / 32) attn_tile_lds(qf, ks, vs, NoMask(), m_run, l_run, o0, o1, ql, hi);
            else {
                const int jt = lo + i - L / 32;
                if (!isC) {
                    const int dq = jt - qt;
                    if (dq >= -3 && dq <= 3) attn_tile_lds(qf, ks, vs, NoMask(), m_run, l_run, o0, o1, ql, hi);
                    else if (dq == -4 || dq == 4) { const int base = 32 * dq - ql;
                        attn_tile_lds(qf, ks, vs, [&](int ko, float v) { const int rel = base + ko; return (rel >= -128 && rel <= 128) ? v : -INFINITY; }, m_run, l_run, o0, o1, ql, hi); }
                } else {
                    const int kr_ = jt >> 1, ct = jt & 1;
                    if (kr_ >= r0 && kr_ < r0 + 8) { const float* rp = rpb + (kr_ - gr + 7) * 31 + 15 - c;
                        attn_tile_lds(qf, ks, vs, [&](int ko, float v) { const int kc = 32 * ct + ko; return (kc >= c0 && kc < c0 + 16) ? v + rp[kc] : -INFINITY; }, m_run, l_run, o0, o1, ql, hi); }
                }
            }
        }
        asm volatile("s_waitcnt lgkmcnt(0)" ::: "memory");
        __builtin_amdgcn_s_barrier();
#undef AT_STAGE
#undef AT_TOK
        (void)gr0;
        const float lt = l_run + __shfl_xor(l_run, 32), inv = 1.0f / lt;
        bf16_t* op = p.MIX + (size_t)m * DMIX + (isC ? 640 : 256) + h * 64 + 4 * hi;
#pragma unroll
        for (int gq = 0; gq < 4; ++gq) {
            st_bf16x4(op + 8 * gq, (f32x4){o0[4 * gq] * inv, o0[4 * gq + 1] * inv, o0[4 * gq + 2] * inv, o0[4 * gq + 3] * inv});
            st_bf16x4(op + 32 + 8 * gq, (f32x4){o1[4 * gq] * inv, o1[4 * gq + 1] * inv, o1[4 * gq + 2] * inv, o1[4 * gq + 3] * inv});
        }
    }
}

#define RNB " row_newbcast:%c[n] row_mask:0xf bank_mask:0xf\n\t"
template <int N, bool FIRST>
__device__ __forceinline__ void dpp_dot4(float& a0, float& a1, float& a2, float& a3, const f32x4& v, float s0, float s1, float s2, float s3) {
    if (FIRST) asm volatile("s_nop 1");
    asm("v_fmac_f32_dpp %0, %4, %8" RNB "v_fmac_f32_dpp %1, %5, %9" RNB "v_fmac_f32_dpp %2, %6, %10" RNB "v_fmac_f32_dpp %3, %7, %11" RNB
        : "+v"(a0), "+v"(a1), "+v"(a2), "+v"(a3) : "v"(v[0]), "v"(v[1]), "v"(v[2]), "v"(v[3]), "v"(s0), "v"(s1), "v"(s2), "v"(s3), [n] "i"(N));
}
template <int N, bool FIRST>
__device__ __forceinline__ void dpp_upd4s(float& s0, float& s1, float& s2, float& s3, float& y0, float& y1, float& y2, float& y3,
                                          const f32x4& w, const f32x4& b, const f32x4& kd, const f32x4& r, float nsk, float vv) {
    if (FIRST) asm volatile("s_nop 1");
    asm("v_mul_f32_dpp %0, %8, %0" RNB "v_mul_f32_dpp %1, %9, %1" RNB "v_mul_f32_dpp %2, %10, %2" RNB "v_mul_f32_dpp %3, %11, %3" RNB
        "v_fmac_f32_dpp %0, %12, %24" RNB "v_fmac_f32_dpp %1, %13, %24" RNB "v_fmac_f32_dpp %2, %14, %24" RNB "v_fmac_f32_dpp %3, %15, %24" RNB
        "v_fmac_f32_dpp %0, %16, %25" RNB "v_fmac_f32_dpp %1, %17, %25" RNB "v_fmac_f32_dpp %2, %18, %25" RNB "v_fmac_f32_dpp %3, %19, %25" RNB
        "v_fmac_f32_dpp %4, %20, %0" RNB "v_fmac_f32_dpp %5, %21, %1" RNB "v_fmac_f32_dpp %6, %22, %2" RNB "v_fmac_f32_dpp %7, %23, %3" RNB
        : "+v"(s0), "+v"(s1), "+v"(s2), "+v"(s3), "+v"(y0), "+v"(y1), "+v"(y2), "+v"(y3)
        : "v"(w[0]), "v"(w[1]), "v"(w[2]), "v"(w[3]), "v"(b[0]), "v"(b[1]), "v"(b[2]), "v"(b[3]), "v"(kd[0]), "v"(kd[1]), "v"(kd[2]), "v"(kd[3]),
          "v"(r[0]), "v"(r[1]), "v"(r[2]), "v"(r[3]), "v"(nsk), "v"(vv), [n] "i"(N));
}
template <int N, bool FIRST>
__device__ __forceinline__ void dpp_upd4p(float& s0, float& s1, float& s2, float& s3, float& y0, float& y1, float& y2, float& y3,
                                          const f32x4& w, const f32x4& b, const f32x4& r, float nsk) {
    if (FIRST) asm volatile("s_nop 1");
    asm("v_mul_f32_dpp %0, %8, %0" RNB "v_mul_f32_dpp %1, %9, %1" RNB "v_mul_f32_dpp %2, %10, %2" RNB "v_mul_f32_dpp %3, %11, %3" RNB
        "v_fmac_f32_dpp %0, %12, %20" RNB "v_fmac_f32_dpp %1, %13, %20" RNB "v_fmac_f32_dpp %2, %14, %20" RNB "v_fmac_f32_dpp %3, %15, %20" RNB
        "v_fmac_f32_dpp %4, %16, %0" RNB "v_fmac_f32_dpp %5, %17, %1" RNB "v_fmac_f32_dpp %6, %18, %2" RNB "v_fmac_f32_dpp %7, %19, %3" RNB
        : "+v"(s0), "+v"(s1), "+v"(s2), "+v"(s3), "+v"(y0), "+v"(y1), "+v"(y2), "+v"(y3)
        : "v"(w[0]), "v"(w[1]), "v"(w[2]), "v"(w[3]), "v"(b[0]), "v"(b[1]), "v"(b[2]), "v"(b[3]), "v"(r[0]), "v"(r[1]), "v"(r[2]), "v"(r[3]), "v"(nsk), [n] "i"(N));
}
template <int N> struct ScanRep {
    static __device__ __forceinline__ void dot(float& a0, float& a1, float& a2, float& a3, const f32x4& v, const float (&st)[64]) {
        dpp_dot4<N, N == 0>(a0, a1, a2, a3, v, st[4 * N], st[4 * N + 1], st[4 * N + 2], st[4 * N + 3]);
        if constexpr (N < 15) ScanRep<N + 1>::dot(a0, a1, a2, a3, v, st);
    }
    static __device__ __forceinline__ void upds(float (&st)[64], float& y0, float& y1, float& y2, float& y3, const f32x4& w, const f32x4& b, const f32x4& kd, const f32x4& r, float nsk, float vv) {
        dpp_upd4s<N, N == 0>(st[4 * N], st[4 * N + 1], st[4 * N + 2], st[4 * N + 3], y0, y1, y2, y3, w, b, kd, r, nsk, vv);
        if constexpr (N < 15) ScanRep<N + 1>::upds(st, y0, y1, y2, y3, w, b, kd, r, nsk, vv);
    }
    static __device__ __forceinline__ void updp(float (&st)[64], float& y0, float& y1, float& y2, float& y3, const f32x4& w, const f32x4& b, const f32x4& r, float nsk) {
        dpp_upd4p<N, N == 0>(st[4 * N], st[4 * N + 1], st[4 * N + 2], st[4 * N + 3], y0, y1, y2, y3, w, b, r, nsk);
        if constexpr (N < 15) ScanRep<N + 1>::updp(st, y0, y1, y2, y3, w, b, r, nsk);
    }
};
__device__ __forceinline__ int seg_row0(int b, int d, int s) { const int pos0 = 128 * s; return pos0 < L ? TL + b * L + (d ? L - 1 - pos0 : pos0) : b * S + (d ? S - 1 - (pos0 - L) : pos0 - L); }

template <bool ISP>
__device__ __forceinline__ void scan_task(const Params& p, int c, int s, int lane) {
    const int h = c & 3, b = (c >> 2) % NB, d = (c >> 2) / NB;
    const int m0 = seg_row0(b, d, s); const long step = d ? -(long)DA : (long)DA;
    const size_t o = (size_t)m0 * DA + h * 64, od = ((size_t)d * T + m0) * DA + h * 64; const int q = 4 * (lane & 15);
    const float* pkk = p.sKK + o + q; const float* pr = p.sR + o + q; const float* pw = p.sW + od + q; const float* pb = p.sB + od + q;
    const float* pkd = p.sKD + od + q; const float* pv = p.sV + o + lane;
    float* py = (ISP ? p.PV : p.Y) + od + lane;
    float st[64];
#pragma unroll
    for (int k = 0; k < 64; ++k) st[k] = (ISP && k == lane) ? 1.0f : 0.f;
    f32x4 kk = *(const f32x4*)pkk, w = *(const f32x4*)pw, bb = *(const f32x4*)pb, r = *(const f32x4*)pr, kd = w; float vv = 0.f;
    if (!ISP) { kd = *(const f32x4*)pkd; vv = *pv; }
#pragma unroll 1
    for (int i = 0; i < 128; ++i) {
        const long nx = (i < 127) ? step : 0;
        pkk += nx; pw += nx; pb += nx; pr += nx; pkd += nx; pv += nx;
        const f32x4 nkk = *(const f32x4*)pkk, nw = *(const f32x4*)pw, nb = *(const f32x4*)pb, nr = *(const f32x4*)pr;
        f32x4 nkd = nw; float nv = 0.f;
        if (!ISP) { nkd = *(const f32x4*)pkd; nv = *pv; }
        float a0 = 0.f, a1 = 0.f, a2 = 0.f, a3 = 0.f;
        ScanRep<0>::dot(a0, a1, a2, a3, kk, st);
        const float nsk = -((a0 + a1) + (a2 + a3));
        float y0 = 0.f, y1 = 0.f, y2 = 0.f, y3 = 0.f;
        if (ISP) ScanRep<0>::updp(st, y0, y1, y2, y3, w, bb, r, nsk); else ScanRep<0>::upds(st, y0, y1, y2, y3, w, bb, kd, r, nsk, vv);
        *py = (y0 + y1) + (y2 + y3); py += step;
        kk = nkk; w = nw; bb = nb; r = nr; kd = nkd; vv = nv;
    }
    if (s < NSG - 1) {
        float* dst = (ISP ? p.PS : p.QS) + (((size_t)c * NSG + s) * 64 + lane) * 64;
#pragma unroll
        for (int k4 = 0; k4 < 16; ++k4) *(f32x4*)(dst + 4 * k4) = (f32x4){st[4 * k4], st[4 * k4 + 1], st[4 * k4 + 2], st[4 * k4 + 3]};
    }
}
__device__ __forceinline__ void ph_scan_fast(const Params& p) {
    const int tid_ = opq_tid(), bid_ = opq_bid(); (void)tid_; (void)bid_;
    const int lane = tid_ & 63, gw = bid_ * 4 + (tid_ >> 6), nw = gridDim.x * 4;
    constexpr int NS_T = 64 * NSG, NP_T = 64 * (NSG - 1);
    for (int tsk = gw; tsk < NS_T + NP_T; tsk += nw) {
        const int t2 = __builtin_amdgcn_readfirstlane(tsk);
        if (t2 < NS_T) scan_task<false>(p, t2 & 63, t2 >> 6, lane);
        else scan_task<true>(p, (t2 - NS_T) & 63, 1 + ((t2 - NS_T) >> 6), lane);
    }
}
__device__ __forceinline__ void ph_combine(const Params& p, char* lds) {
    const int tid_ = opq_tid(), bid_ = opq_bid(); (void)tid_; (void)bid_; (void)lds;
    if (bid_ >= 64) return;
    const int lane = tid_ & 63, c = bid_, cb = tid_ >> 6, q = lane >> 4, i16 = lane & 15, v = 16 * cb + i16;
    const float* QSc = p.QS + (size_t)c * NSG * 4096; const float* PSc = p.PS + (size_t)c * NSG * 4096; float* SSg = p.SS + (size_t)c * NSG * 4096;
    f32x4 acc[4];
#pragma unroll
    for (int ro = 0; ro < 4; ++ro) acc[ro] = *(const f32x4*)(QSc + v * 64 + 16 * ro + 4 * q);
#pragma unroll 1
    for (int s = 1; s < NSG; ++s) {
#pragma unroll
        for (int ro = 0; ro < 4; ++ro)
#pragma unroll
            for (int j = 0; j < 4; ++j) SSg[(size_t)s * 4096 + (16 * ro + 4 * q + j) * 64 + v] = acc[ro][j];
        if (s == NSG - 1) break;
        const float* P = PSc + (size_t)s * 4096 + (4 * q) * 64 + i16;
        float a[4][4][4];
#pragma unroll
        for (int rb = 0; rb < 4; ++rb)
#pragma unroll
            for (int kk = 0; kk < 4; ++kk)
#pragma unroll
                for (int ro = 0; ro < 4; ++ro) a[rb][kk][ro] = P[(16 * rb + kk) * 64 + 16 * ro];
#pragma unroll
        for (int rb = 0; rb < 4; ++rb) asm volatile("" : "+v"(a[rb][0][0]), "+v"(a[rb][0][1]), "+v"(a[rb][0][2]), "+v"(a[rb][0][3]), "+v"(a[rb][1][0]), "+v"(a[rb][1][1]), "+v"(a[rb][1][2]), "+v"(a[rb][1][3]),
                                                         "+v"(a[rb][2][0]), "+v"(a[rb][2][1]), "+v"(a[rb][2][2]), "+v"(a[rb][2][3]), "+v"(a[rb][3][0]), "+v"(a[rb][3][1]), "+v"(a[rb][3][2]), "+v"(a[rb][3][3]));
        f32x4 nacc[4];
#pragma unroll
        for (int ro = 0; ro < 4; ++ro) nacc[ro] = *(const f32x4*)(QSc + (size_t)s * 4096 + v * 64 + 16 * ro + 4 * q);
#pragma unroll
        for (int rb = 0; rb < 4; ++rb)
#pragma unroll
            for (int kk = 0; kk < 4; ++kk)
#pragma unroll
                for (int ro = 0; ro < 4; ++ro) nacc[ro] = __builtin_amdgcn_mfma_f32_16x16x4f32(a[rb][kk][ro], acc[rb][kk], nacc[ro], 0, 0, 0);
#pragma unroll
        for (int ro = 0; ro < 4; ++ro) acc[ro] = nacc[ro];
    }
}
__device__ __forceinline__ void ph_rwkv_out_fast(const Params& p, int l, bool with_ctx) {
    const int tid_ = opq_tid(), bid_ = opq_bid(); (void)tid_; (void)bid_;
    const int lane = tid_ & 63, gw = bid_ * 4 + (tid_ >> 6), nw = gridDim.x * 4;
    constexpr int TOK = 16, NLT = NB * (S / TOK) * 4, NCTK = NB * (L / TOK) * 4;
    const int ntask = NLT + (with_ctx ? NCTK : 0);
    for (int tsk = gw; tsk < ntask; tsk += nw) {
        const bool isCtx = tsk >= NLT; const int r = isCtx ? tsk - NLT : tsk;
        const int h = r & 3, npt = isCtx ? L / TOK : S / TOK, tt = (r >> 2) % npt, b = (r >> 2) / npt, t128 = tt / (128 / TOK);
        const int seg0 = isCtx ? t128 : L / 128 + t128, seg1 = isCtx ? (L / 128 - 1) - t128 : L / 128 + (S / 128 - 1) - t128;
        const int mbase = isCtx ? TL + b * L + TOK * tt : b * S + TOK * tt;
        float ss0[64], ss1[64];
        { const float* s0p = p.SS + (((size_t)(0 * NB + b) * 4 + h) * NSG + seg0) * 4096 + lane; const float* s1p = p.SS + (((size_t)(1 * NB + b) * 4 + h) * NSG + seg1) * 4096 + lane;
#pragma unroll
          for (int k = 0; k < 64; ++k) { ss0[k] = seg0 > 0 ? s0p[k * 64] : 0.f; ss1[k] = seg1 > 0 ? s1p[k * 64] : 0.f; } }
        const float rk = p.a_r_k[l * DA + h * 64 + lane], gln = p.a_lnx_g[l * DA + h * 64 + lane], bln = p.a_lnx_b[l * DA + h * 64 + lane];
        f32x4 pv0 = {0.f, 0.f, 0.f, 0.f}, pv1 = pv0; float y0l, y1l, rr, kds, vv, gg;
#define ROUT_LOAD(i_) do { const size_t o_ = (size_t)(mbase + (i_)) * DA + h * 64, o1_ = o_ + (size_t)T * DA; \
            if (seg0 > 0) pv0 = *(const f32x4*)(p.PV + o_ + 4 * (lane & 15)); if (seg1 > 0) pv1 = *(const f32x4*)(p.PV + o1_ + 4 * (lane & 15)); \
            y0l = p.Y[o_ + lane]; y1l = p.Y[o1_ + lane]; rr = p.sR[o_ + lane]; kds = p.sKD[o_ + lane] + p.sKD[o1_ + lane]; vv = p.sV[o_ + lane]; gg = p.sG[o_ + lane]; } while (0)
        ROUT_LOAD(0);
#pragma unroll 1
        for (int i = 0; i < TOK; ++i) {
            const f32x4 cpv0 = pv0, cpv1 = pv1; float a0 = y0l, a1 = y1l, a2 = 0.f, a3 = 0.f; const float crr = rr, ckds = kds, cvv = vv, cgg = gg;
            ROUT_LOAD(i + 1 < TOK ? i + 1 : i);
            ScanRep<0>::dot(a0, a1, a2, a3, cpv0, ss0);
            ScanRep<0>::dot(a0, a1, a2, a3, cpv1, ss1);
            const float y = (a0 + a1) + (a2 + a3);
            const float mu = wave_sum(y) * (1.0f / 64.f), dy = y - mu;
            const float rstd = 1.0f / sqrtf(wave_sum(dy * dy) * (1.0f / 64.f) + GN_EPS);
            const float bon = wave_sum(crr * ckds * rk);
            p.MIX[(size_t)(mbase + i) * DMIX + h * 64 + lane] = f2bf((dy * rstd * gln + bln + bon * cvv) * cgg);
        }
#undef ROUT_LOAD
    }
}


#define LAS __attribute__((address_space(3)))
#define XB_TMO      128
#define XB_XCNT(j)  (256  + 64 * (j))
#define XB_XSUB(j)  (1280 + 64 * (j))
#define XB_XGEN(j)  (2304 + 64 * (j))
#define XB_TOP      3328
#define XB_TOPGEN   3392
#define XCD_BAR_WORDS 3456
#define XB_SPIN_CAP (1u << 20)
static_assert(XCD_BAR_WORDS * 4 <= 16384, "barrier words fit the control region");
__device__ __forceinline__ unsigned xb_ld(unsigned* p)              { return __hip_atomic_load(p, __ATOMIC_RELAXED, __HIP_MEMORY_SCOPE_AGENT); }
__device__ __forceinline__ unsigned xb_add(unsigned* p, unsigned v) { return __hip_atomic_fetch_add(p, v, __ATOMIC_RELAXED, __HIP_MEMORY_SCOPE_AGENT); }
__device__ __forceinline__ unsigned xb_xcc_id() { return (unsigned)__builtin_amdgcn_s_getreg((3 << 11) | 20) & 0xFu; }
#define XB_SPIN(cond, bar) do { unsigned _sp = 0; while (cond) { __builtin_amdgcn_s_sleep(1); \
    if ((++_sp & 255u) == 0u) { if (xb_ld(&(bar)[XB_TMO])) break; if (_sp > XB_SPIN_CAP) { atomicAdd(&(bar)[XB_TMO], 1u); break; } } } } while (0)
struct XcdBarrier { unsigned* bar; unsigned x; volatile LAS unsigned* st; };
__device__ __forceinline__ XcdBarrier xcd_barrier_post(unsigned* bar, volatile LAS unsigned* st) {
    XcdBarrier b; b.bar = bar; b.x = xb_xcc_id(); b.st = st;
    if (threadIdx.x == 0) (void)xb_add(&bar[XB_XCNT(b.x)], 1u);
    return b;
}
__device__ __forceinline__ void xcd_barrier_complete(unsigned* bar, unsigned x, unsigned& nloc, unsigned& nx) {
    const unsigned G = gridDim.x * gridDim.y * gridDim.z;
    unsigned sum, cnt, mine, sp = 0u;
    for (;;) {
        sum = 0u; cnt = 0u; mine = 0u;
#pragma unroll
        for (unsigned j = 0; j < 16; ++j) { const unsigned c = xb_ld(&bar[XB_XCNT(j)]); sum += c; cnt += (c > 0u) ? 1u : 0u; mine = (j == x) ? c : mine; }
        if (sum == G) break;
        __builtin_amdgcn_s_sleep(1);
        if ((++sp & 255u) == 0u) { if (xb_ld(&bar[XB_TMO])) break; if (sp > XB_SPIN_CAP) { atomicAdd(&bar[XB_TMO], 1u); break; } }
    }
    nloc = mine > 0u ? mine : 1u; nx = cnt > 0u ? cnt : 1u;
}
__device__ __forceinline__ void xcd_barrier(const XcdBarrier& b) {
    asm volatile("s_waitcnt vmcnt(0)" ::: "memory");
    __syncthreads();
    if (threadIdx.x == 0) {
        unsigned* bar = b.bar;
        __builtin_amdgcn_s_waitcnt(0);
        unsigned nloc = b.st[0], nx = b.st[1];
        if (nloc == 0u) { xcd_barrier_complete(bar, b.x, nloc, nx); b.st[0] = nloc; b.st[1] = nx; }
        const unsigned old = xb_add(&bar[XB_XSUB(b.x)], 1u);
        const unsigned gen = old / nloc;
        if (old + 1u == (gen + 1u) * nloc) {
            __builtin_amdgcn_fence(__ATOMIC_RELEASE, "agent");
            asm volatile("s_waitcnt vmcnt(0)" ::: "memory");
            const unsigned og = xb_add(&bar[XB_TOP], 1u);
            const unsigned tg = og / nx;
            if (og + 1u == (tg + 1u) * nx) xb_add(&bar[XB_TOPGEN], 1u);
            else XB_SPIN(xb_ld(&bar[XB_TOPGEN]) == tg, bar);
            __builtin_amdgcn_fence(__ATOMIC_ACQUIRE, "agent");
            xb_add(&bar[XB_XGEN(b.x)], 1u);
            asm volatile("s_waitcnt vmcnt(0)" ::: "memory");
        } else {
            XB_SPIN(xb_ld(&bar[XB_XGEN(b.x)]) == gen, bar);
            __builtin_amdgcn_fence(__ATOMIC_ACQUIRE, "agent");
            asm volatile("s_waitcnt vmcnt(0)" ::: "memory");
        }
    }
    __syncthreads();
}

#define GT ((long)blockIdx.x * blockDim.x + threadIdx.x)
#define GS ((long)gridDim.x * blockDim.x)
__global__ void __launch_bounds__(256, 2) mega_fwd(Params p) {
    __shared__ __attribute__((aligned(16))) char lds[65536 + 64];
    cg::grid_group grid = cg::this_grid();
    const long gt = GT, gs = GS;
    volatile LAS unsigned* bst = (volatile LAS unsigned*)(LAS char*)(lds + 65536);
    if (threadIdx.x < 2) bst[threadIdx.x] = 0u;
    __syncthreads();
    const XcdBarrier xb = xcd_barrier_post(p.bar, bst);
#ifndef PROBE_PHASE
#define PROBE_PHASE -1
#endif
#define PROBE_AMP 8
    unsigned long long t_prev = 0; int nts = 0;
#define STAMP() do { if (PROBE_PHASE >= 0 && blockIdx.x == 0 && threadIdx.x == 0) { const unsigned long long t_now = __builtin_amdgcn_s_memrealtime(); \
        if (nts == PROBE_PHASE + 1) { const unsigned long long t_end = t_now + PROBE_AMP * (t_now - t_prev); while (__builtin_amdgcn_s_memrealtime() < t_end) __builtin_amdgcn_s_sleep(8); } \
        t_prev = __builtin_amdgcn_s_memrealtime(); } ++nts; } while (0)
#define GSYNC() do { xcd_barrier(xb); STAMP(); } while (0)
    STAMP();
    ph_mod_fast(p, lds); ph_prep_w_fast(p, 0, 0, lds); ph_prep_misc(p, 0, gt, gs, false);
    grid.sync(); STAMP();
    for (int l = 0; l < 2; ++l) {
        const int nrows = (l == 0) ? T : TL;
        ph_lnmod_fast(p, l);
        GSYNC();
        g_gemm_in(p, lds);
        GSYNC();
        ph_streams_s1(p, l);
        GSYNC();
        g_streams_s2(p, l, lds);
        GSYNC();
        ph_scan_fast(p);
        GSYNC();
        ph_combine(p, lds); ph_attn_blk(p, l, l == 0, 64, lds);
        GSYNC();
        ph_rwkv_out_fast(p, l, l == 0);
        GSYNC();
        g_gemm_out(p, nrows, lds); ph_prep_w_fast(p, l, 1, lds);
        GSYNC();
        ph_post_mixer_fast(p, l, nrows);
        GSYNC();
        g_router(p, l, nrows, lds);
        GSYNC();
        ph_dispatch_fast(p, l, nrows, lds);
        GSYNC();
        g_moe1(p, l, lds);
        GSYNC();
        g_moe2(p, l, lds);
        GSYNC();
        ph_final_fast(p, l, nrows);
        if (l == 0) { ph_prep_w_fast(p, 1, 0, lds); ph_prep_misc(p, 1, gt, gs, false); }
        GSYNC();
    }}

extern "C" void kernel_launch(void* const* d_in, const int* in_sizes, int n_in, void* d_out, int out_size, void* d_ws, size_t ws_size, hipStream_t stream) {
    if (n_in != 32 || out_size != TL * D || ws_size < WS_NEED) { fprintf(stderr, "kernel_launch: unexpected shapes / workspace (n_in %d out %d ws %zu need %zu)\n", n_in, out_size, ws_size, (size_t)WS_NEED); return; }
    static int grid_blocks = 0;
    if (!grid_blocks) {
        int dev = 0, cus = 0, per_cu = 0;
        (void)hipGetDevice(&dev);
        (void)hipDeviceGetAttribute(&cus, hipDeviceAttributeMultiprocessorCount, dev);
        (void)hipOccupancyMaxActiveBlocksPerMultiprocessor(&per_cu, mega_fwd, 256, 0);
        if (per_cu < 1) per_cu = 1;
        if (per_cu > 2) per_cu = 2;
        grid_blocks = cus * per_cu;
        fprintf(stderr, "kernel_launch: %d CUs x %d blocks\n", cus, per_cu);
    }
    Params p = make_params(d_in, d_out, d_ws);
    (void)hipMemsetAsync(d_ws, 0, CTL_BYTES, stream);
    void* args[] = {&p};
    hipError_t e = hipLaunchCooperativeKernel((void*)mega_fwd, dim3(grid_blocks), dim3(256), args, 0, stream);
    if (e != hipSuccess) fprintf(stderr, "cooperative launch failed: %s (grid %d)\n", hipGetErrorString(e), grid_blocks);
}
#endif

#ifdef HOST_EMU
static void host_forward(void* const* d_in, void* d_out, void* d_ws) {
    const Params p = make_params(d_in, d_out, d_ws);
    for (int l = 0; l < 2; ++l) {
        const int nrows = (l == 0) ? T : TL;
        ph_prep_w(p, l, 0, 1); ph_prep_misc(p, l, 0, 1); ph_lnmod(p, l, 0, 1); host_gemm_in(p); ph_streams(p, l, 0, 1); ph_rope(p, 0, 1); ph_scan(p, 0, 1);
        ph_attn(p, l, nrows, 0, 1); ph_rwkv_out(p, l, nrows, 0, 1); host_gemm_out(p, nrows); ph_post_mixer(p, l, nrows, 0, 1);
        ph_dispatch(p, l, nrows, 0, 1); host_moe1(p, l); host_moe2(p, l); ph_final(p, l, nrows, 0, 1);
    }
}
#endif
```

```cpp
#ifdef HOST_EMU
#include <cmath>
#include <cstdio>
#include <cstring>
#include <cstdint>
#include <cstdlib>
#define __device__
#define __global__
#define __host__
#define __forceinline__ inline
#else
#include <hip/hip_runtime.h>
#include <hip/hip_cooperative_groups.h>
#include <cstdio>
#include <cstdint>
namespace cg = cooperative_groups;
#endif

#ifndef CFG_D
#define CFG_D 1024
#define CFG_B 8
#define CFG_S 2048
#define CFG_L 256
#define CFG_DE 512
#endif
constexpr int D = CFG_D, NB = CFG_B, S = CFG_S, L = CFG_L, DE = CFG_DE;
constexpr int TL = NB * S, TC = NB * L, T = TL + TC;
constexpr int GRID_W = 64, HD = 64;
constexpr int DA = 256, A_IN = 1184, N_IN = 2976, NINP = 3072, DMIX = 1024;
constexpr int NEXP = 32, NSLOT = 2 * T + NEXP * 128;
constexpr int ZQB = 0, ZKB = 384, ZVB = 512, ZQN = 640, ZKN = 1024, ZVN = 1408, ZA = 1792, ZP = 2976;
constexpr float LN_EPS = 1e-6f, GN_EPS = 64e-5f, ATT_SCALE = 0.125f;
constexpr float ALPHA = 1.41421356237309515f;

typedef unsigned short bf16_t;

__device__ __forceinline__ float bf2f(bf16_t v) {
    unsigned u = ((unsigned)v) << 16; float f;
#ifdef HOST_EMU
    memcpy(&f, &u, 4);
#else
    f = __uint_as_float(u);
#endif
    return f;
}
__device__ __forceinline__ bf16_t f2bf(float f) {
    unsigned u;
#ifdef HOST_EMU
    memcpy(&u, &f, 4);
#else
    u = __float_as_uint(f);
#endif
    return (bf16_t)((u + 0x7fffu + ((u >> 16) & 1u)) >> 16);
}
__device__ __forceinline__ float sigmoidf_(float x) { return 1.0f / (1.0f + expf(-x)); }
__device__ __forceinline__ float siluf_(float x) { return x / (1.0f + expf(-x)); }
__device__ __forceinline__ int atomic_inc_int(int* p) {
#ifdef HOST_EMU
    int o = *p; *p = o + 1; return o;
#else
    return atomicAdd(p, 1);
#endif
}

struct Params {
    const float *x, *c, *ctx, *c_ctx, *w_mod, *b_mod, *w_in, *w_out, *a_shift, *a_w0, *a_w_up, *a_a0, *a_a_up, *a_g_up,
        *a_k_k, *a_k_a, *a_r_k, *a_lnx_g, *a_lnx_b, *b_sink, *c_rpb, *ln1_g, *ln1_b, *ln2_g, *ln2_b, *w_rg, *b_rg, *w_re,
        *b_re, *w_gate, *w_up, *w_down;
    float* out;
    int* cnt;
    unsigned* bar;
    float* mod;
    float* rope;
    bf16_t *win_t, *wout_t, *wgu_t, *wd_t;
    bf16_t *wrt;
    int* hist;
    bf16_t* HLO;
    bf16_t *wupT, *aupT, *gupT;
    bf16_t* LA;
    float *kT, *kN;
    bf16_t* H;
    bf16_t* Z;
    bf16_t* VT;
    float *sR, *sV, *sKK, *sG, *sW, *sKD, *sB;
    float* Y;
    bf16_t* MIX;
    float *PV, *QS, *PS, *SS;
    float* XC;
    float* O;
    int *rE, *rPos, *rSlot; float* rW;
    int* slotTok;
    bf16_t* ACT;
    float* YS;
};

constexpr size_t al256(size_t v) { return (v + 255) & ~(size_t)255; }
constexpr size_t OFF_CNT = 0;
constexpr size_t OFF_BAR = 4096, CTL_BYTES = 4096 + 16384;
constexpr size_t OFF_MOD = CTL_BYTES;
constexpr size_t OFF_ROPE = al256(OFF_MOD + (size_t)2 * (NB + 1) * 6 * D * 4);
constexpr size_t OFF_LORA = al256(OFF_ROPE + 64 * 16 * 2 * 4);
constexpr size_t OFF_WRT = al256(OFF_LORA + (size_t)(2 * 256 * 64 * 2 + 256 * 160) * 2);
constexpr size_t OFF_LG = al256(OFF_WRT + (size_t)2 * 128 * D * 2);
constexpr size_t OFF_WIN = al256(OFF_LG + (size_t)T * 36 * 4);
constexpr size_t OFF_WOUT = al256(OFF_WIN + (size_t)NINP * D * 2);
constexpr size_t OFF_WGU = al256(OFF_WOUT + (size_t)D * DMIX * 2);
constexpr size_t OFF_WD = al256(OFF_WGU + (size_t)NEXP * 2 * DE * D * 2);
constexpr size_t OFF_H = al256(OFF_WD + (size_t)NEXP * D * DE * 2);
constexpr size_t OFF_Z = al256(OFF_H + (size_t)(T + 1) * D * 2);
constexpr int PU = L + S;
constexpr int NSG = (L + S) / 128;
static_assert((size_t)3 * 64 * ((L + S) / 128) * 4096 * 4 <= (size_t)NEXP * 2 * DE * D * 2 || (L % 128) != 0, "scan segment states overlay wgu_t");
constexpr size_t OFF_VT = al256(OFF_Z + (size_t)T * ZP * 2);
constexpr size_t OFF_S = al256(OFF_VT + (size_t)NB * 8 * 64 * PU * 2);
constexpr size_t S1 = (size_t)T * 256 * 4;
constexpr size_t OFF_Y = al256(OFF_S + 10 * S1);
constexpr size_t OFF_MIX = al256(OFF_Y + 2 * S1);
constexpr size_t OFF_XC = al256(OFF_MIX + (size_t)T * 1024 * 2);
constexpr size_t OFF_ROUTE = al256(OFF_XC + (size_t)TC * D * 4);
constexpr size_t OFF_SLOTTOK = al256(OFF_ROUTE + (size_t)T * 2 * 4 * 4);
constexpr size_t WS_NEED = al256(OFF_SLOTTOK + (size_t)NSLOT * 4);
static_assert((size_t)NSLOT * DE * 2 <= (size_t)T * ZP * 2 && (size_t)T * D * 2 <= (size_t)T * ZP * 2, "ACT / HLO overlay Z");
static_assert((size_t)T * 4 * 4 + (size_t)T * 416 * 2 <= S1, "kN + LA overlay Y[1]");
static_assert((size_t)NSLOT * D * 4 <= 10 * S1 && (size_t)T * D * 4 <= 10 * S1, "YS / O overlay the stream buffers");

static Params make_params(void* const* d_in, void* d_out, void* d_ws) {
    Params p{};
    const float** f = (const float**)&p.x;
    for (int i = 0; i < 32; ++i) f[i] = (const float*)d_in[i];
    p.out = (float*)d_out;
    char* w = (char*)d_ws;
    p.cnt = (int*)(w + OFF_CNT); p.bar = (unsigned*)(w + OFF_BAR); p.mod = (float*)(w + OFF_MOD); p.rope = (float*)(w + OFF_ROPE);
    p.win_t = (bf16_t*)(w + OFF_WIN); p.wout_t = (bf16_t*)(w + OFF_WOUT); p.wgu_t = (bf16_t*)(w + OFF_WGU); p.wd_t = (bf16_t*)(w + OFF_WD);
    p.wrt = (bf16_t*)(w + OFF_WRT); p.hist = (int*)(w + OFF_LG); p.HLO = (bf16_t*)(w + OFF_Z);
    p.wupT = (bf16_t*)(w + OFF_LORA); p.aupT = p.wupT + 2 * 256 * 64; p.gupT = p.aupT + 2 * 256 * 64;
    p.H = (bf16_t*)(w + OFF_H); p.Z = (bf16_t*)(w + OFF_Z); p.VT = (bf16_t*)(w + OFF_VT);
    float* s = (float*)(w + OFF_S); const size_t n1 = (size_t)T * 256;
    p.sR = s; p.sV = s + n1; p.sKK = s + 2 * n1; p.sG = s + 3 * n1; p.sW = s + 4 * n1; p.sKD = s + 6 * n1; p.sB = s + 8 * n1;
    p.Y = (float*)(w + OFF_Y); p.MIX = (bf16_t*)(w + OFF_MIX); p.XC = (float*)(w + OFF_XC);
    p.O = (float*)(w + OFF_S);
    p.PV = (float*)(w + OFF_H); p.QS = (float*)(w + OFF_WGU); p.PS = p.QS + (size_t)64 * NSG * 4096; p.SS = p.PS + (size_t)64 * NSG * 4096;
    p.kT = p.Y; p.kN = p.Y + (size_t)T * 256; p.LA = (bf16_t*)(p.Y + (size_t)T * 256 + (size_t)T * 4);
    int* r = (int*)(w + OFF_ROUTE); p.rE = r; p.rPos = r + 2 * T; p.rSlot = r + 4 * T; p.rW = (float*)(r + 6 * T);
    p.slotTok = (int*)(w + OFF_SLOTTOK);
    p.ACT = (bf16_t*)(w + OFF_Z); p.YS = (float*)(w + OFF_S);
    return p;
}

__device__ void ph_prep_w(const Params& p, int l, long gtid, long gsz) {
    for (long i = gtid; i < (long)D * NINP; i += gsz) {
        const int k = (int)(i / NINP), n = (int)(i % NINP);
        float v = 0.f;
        if (n < N_IN) { const int oc = (n < ZA) ? n + A_IN : n - ZA; v = p.w_in[((size_t)l * D + k) * N_IN + oc]; }
        p.win_t[(size_t)n * D + k] = f2bf(v);
    }
    for (long i = gtid; i < (long)DMIX * D; i += gsz) {
        const int k = (int)(i / D), n = (int)(i % D);
        p.wout_t[(size_t)n * DMIX + k] = f2bf(p.w_out[((size_t)l * DMIX + k) * D + n]);
    }
    for (long i = gtid; i < (long)NEXP * D * 2 * DE; i += gsz) {
        const int rho = (int)(i % (2 * DE)); const long t = i / (2 * DE); const int k = (int)(t % D), e = (int)(t / D);
        const int q = rho >> 5, half = (rho >> 4) & 1, ii = rho & 15, cc = 16 * q + ii;
        const float* src = half ? p.w_up : p.w_gate;
        p.wgu_t[((size_t)e * 2 * DE + rho) * D + k] = f2bf(src[(((size_t)l * NEXP + e) * D + k) * DE + cc]);
    }
    for (long i = gtid; i < (long)NEXP * DE * D; i += gsz) {
        const int n = (int)(i % D); const long t = i / D; const int k = (int)(t % DE), e = (int)(t / DE);
        p.wd_t[((size_t)e * D + n) * DE + k] = f2bf(p.w_down[(((size_t)l * NEXP + e) * DE + k) * D + n]);
    }
}
__device__ __forceinline__ void ph_prep_misc(const Params& p, int l, long gtid, long gsz, bool do_mod = true) {
    if (l == 0 && do_mod) for (long i = gtid; i < (long)2 * (NB + 1) * 6 * D; i += gsz) {
        const int j = (int)(i % (6 * D)), b = (int)((i / (6 * D)) % (NB + 1)), ll = (int)(i / ((long)6 * D * (NB + 1)));
        const float* cv = (b < NB) ? p.c + (size_t)b * D : p.c_ctx;
        float acc = 0.f;
        for (int k = 0; k < D; ++k) acc += siluf_(cv[k]) * p.w_mod[((size_t)ll * D + k) * 6 * D + j];
        p.mod[((size_t)ll * (NB + 1) + b) * 6 * D + j] = acc + p.b_mod[(size_t)ll * 6 * D + j];
    }
    if (l == 0) for (long i = gtid; i < 64 * 16; i += gsz) {
        const int pos = (int)(i / 16), fi = (int)(i % 16);
        const float inv = powf(10000.0f, -(float)fi / 16.0f), ang = (float)pos * inv;
        p.rope[i] = cosf(ang); p.rope[1024 + i] = sinf(ang);
    }
    for (long i = gtid; i < NEXP; i += gsz) p.cnt[l * NEXP + i] = 0;
    for (long i = gtid; i < NSLOT; i += gsz) p.slotTok[i] = T;
    for (long i = gtid; i < D; i += gsz) p.H[(size_t)T * D + i] = 0;
}

__device__ __forceinline__ const float* xrow_in(const Params& p, int l, int m) {
    if (m < TL) return (l == 0 ? p.x : p.out) + (size_t)m * D;
    return (l == 0 ? p.ctx : p.XC) + (size_t)(m - TL) * D;
}
__device__ __forceinline__ const float* modrow(const Params& p, int l, int m) { return p.mod + ((size_t)l * (NB + 1) + (m < TL ? m / S : NB)) * 6 * D; }

__device__ void ph_lnmod(const Params& p, int l, long gtid, long gsz) {
    for (long m = gtid; m < T; m += gsz) {
        const float* xr = xrow_in(p, l, (int)m); const float* md = modrow(p, l, (int)m);
        float s = 0.f; for (int j = 0; j < D; ++j) s += xr[j];
        const float mu = s / D; float q = 0.f;
        for (int j = 0; j < D; ++j) { const float d = xr[j] - mu; q += d * d; }
        const float rstd = 1.0f / sqrtf(q / D + LN_EPS);
        for (int j = 0; j < D; ++j) p.H[(size_t)m * D + j] = f2bf((xr[j] - mu) * rstd * (1.0f + md[D + j]) + md[j]);
    }
}

__device__ __forceinline__ float zshift(const Params& p, int l, int m, int col) {
    int t, len;
    if (m < TL) { t = m % S; len = S; } else { t = (m - TL) % L; len = L; }
    const float* sh = p.a_shift + (size_t)l * 3 * A_IN;
    const bf16_t* z = p.Z + (size_t)m * ZP + ZA + col;
    float v = sh[A_IN + col] * bf2f(z[0]);
    if (t > 0) v += sh[col] * bf2f(z[-ZP]);
    if (t < len - 1) v += sh[2 * A_IN + col] * bf2f(z[ZP]);
    return v;
}

__device__ void ph_streams(const Params& p, int l, long gtid, long gsz) {
    for (long i = gtid; i < (long)T * DA; i += gsz) {
        const int m = (int)(i / DA), c = (int)(i % DA), h0 = c & ~63;
        const float r = zshift(p, l, m, c), k = zshift(p, l, m, 256 + c), v = zshift(p, l, m, 512 + c);
        float nrm = 0.f;
        for (int j = 0; j < 64; ++j) { const float t = zshift(p, l, m, 256 + h0 + j) * p.a_k_k[l * DA + h0 + j]; nrm += t * t; }
        const float kk = k * p.a_k_k[l * DA + c] / sqrtf(nrm + 1e-12f);
        float g = 0.f;
        for (int j = 0; j < 160; ++j) g += sigmoidf_(zshift(p, l, m, 1024 + j)) * p.a_g_up[((size_t)l * 160 + j) * DA + c];
        const size_t o = (size_t)m * DA + c;
        p.sR[o] = r; p.sV[o] = v; p.sKK[o] = kk; p.sG[o] = g;
        for (int d = 0; d < 2; ++d) {
            float aw = 0.f, aa = 0.f;
            for (int j = 0; j < 64; ++j) {
                aw += tanhf(zshift(p, l, m, 768 + d * 64 + j)) * p.a_w_up[(((size_t)l * 2 + d) * 64 + j) * DA + c];
                aa += zshift(p, l, m, 896 + d * 64 + j) * p.a_a_up[(((size_t)l * 2 + d) * 64 + j) * DA + c];
            }
            const float u = -(p.a_w0[(l * 2 + d) * DA + c] + aw);
            const float sp = (u > 20.f) ? u : log1pf(expf(u));
            const float w = expf(-expf(-sp - 0.5f));
            const float a = sigmoidf_(p.a_a0[(l * 2 + d) * DA + c] + aa);
            const size_t od = ((size_t)d * T + m) * DA + c;
            p.sW[od] = w; p.sKD[od] = k * (1.0f + (a - 1.0f) * p.a_k_a[l * DA + c]); p.sB[od] = kk * a;
        }
    }
}

__device__ __forceinline__ void ph_rope(const Params& p, long gtid, long gsz) {
    for (long i = gtid; i < (long)TL * 8 * 32; i += gsz) {
        const int pr = (int)(i & 31), hs = (int)((i >> 5) & 7), m = (int)(i >> 8);
        const int t = m % S, axis = pr >> 4, fi = pr & 15, pos = axis ? (t % GRID_W) : (t / GRID_W);
        bf16_t* z = p.Z + (size_t)m * ZP + hs * 64 + axis * 32 + fi;
        const float cs = p.rope[pos * 16 + fi], sn = p.rope[1024 + pos * 16 + fi];
        const float x0 = bf2f(z[0]), x1 = bf2f(z[16]);
        z[0] = f2bf(x0 * cs - x1 * sn); z[16] = f2bf(x1 * cs + x0 * sn);
    }
}

__device__ void ph_scan(const Params& p, long gtid, long gsz) {
    for (long i = gtid; i < (long)2 * NB * 4 * 64; i += gsz) {
        const int v = (int)(i & 63), h = (int)((i >> 6) & 3), b = (int)((i >> 8) % NB), d = (int)((i >> 8) / NB);
        float st[64];
#pragma unroll
        for (int k = 0; k < 64; ++k) st[k] = 0.f;
        for (int pos = 0; pos < L + S; ++pos) {
            int m;
            if (pos < L) m = TL + b * L + (d ? L - 1 - pos : pos);
            else m = b * S + (d ? S - 1 - (pos - L) : pos - L);
            const size_t o = (size_t)m * DA + h * 64, od = ((size_t)d * T + m) * DA + h * 64;
            const float* kk = p.sKK + o; const float* r = p.sR + o;
            const float* w = p.sW + od; const float* bb = p.sB + od; const float* kd = p.sKD + od;
            const float vv = p.sV[o + v];
            float sk = 0.f;
#pragma unroll
            for (int k = 0; k < 64; ++k) sk += st[k] * kk[k];
            float y = 0.f;
#pragma unroll
            for (int k = 0; k < 64; ++k) { st[k] = st[k] * w[k] - sk * bb[k] + vv * kd[k]; y += st[k] * r[k]; }
            p.Y[od + v] = y;
        }
    }
}

__device__ void ph_rwkv_out(const Params& p, int l, int nrows, long gtid, long gsz) {
    for (long i = gtid; i < (long)nrows * 4; i += gsz) {
        const int m = (int)(i >> 2), h = (int)(i & 3);
        const size_t o = (size_t)m * DA + h * 64;
        const float* y0 = p.Y + o; const float* y1 = p.Y + (size_t)T * DA + o;
        float s = 0.f, bon = 0.f;
        for (int n = 0; n < 64; ++n) {
            s += y0[n] + y1[n];
            bon += p.sR[o + n] * (p.sKD[o + n] + p.sKD[(size_t)T * DA + o + n]) * p.a_r_k[l * DA + h * 64 + n];
        }
        const float mu = s / 64.f; float q = 0.f;
        for (int n = 0; n < 64; ++n) { const float dd = y0[n] + y1[n] - mu; q += dd * dd; }
        const float rstd = 1.0f / sqrtf(q / 64.f + GN_EPS);
        for (int n = 0; n < 64; ++n) {
            const int c = h * 64 + n;
            const float yn = (y0[n] + y1[n] - mu) * rstd * p.a_lnx_g[l * DA + c] + p.a_lnx_b[l * DA + c];
            p.MIX[(size_t)m * DMIX + c] = f2bf((yn + bon * p.sV[o + n]) * p.sG[o + n]);
        }
    }
}

__device__ __forceinline__ void att_key(const float (&q)[64], const bf16_t* kr, const bf16_t* vr, float bias, float& mx, float& ls, float (&acc)[64]) {
    float s = 0.f;
#pragma unroll
    for (int d = 0; d < 64; ++d) s += q[d] * bf2f(kr[d]);
    s = s * ATT_SCALE + bias;
    const float mn = fmaxf(mx, s), f = expf(mx - mn), pe = expf(s - mn);
    ls = ls * f + pe;
#pragma unroll
    for (int d = 0; d < 64; ++d) acc[d] = acc[d] * f + pe * bf2f(vr[d]);
    mx = mn;
}

__device__ void ph_attn(const Params& p, int l, int nrows, long gtid, long gsz) {
    for (long i = gtid; i < (long)nrows * 12; i += gsz) {
        const int m = (int)(i / 12), u = (int)(i % 12);
        const bool isB = u < 6; const int hq = isB ? u : u - 6;
        const int b = (m < TL) ? m / S : (m - TL) / L;
        const int qcol = isB ? ZQB + hq * 64 : ZQN + hq * 64;
        const int kcol = isB ? ZKB + (hq / 3) * 64 : ZKN + hq * 64;
        const int vcol = isB ? ZVB + (hq / 3) * 64 : ZVN + hq * 64;
        float q[64], acc[64];
        const bf16_t* qr = p.Z + (size_t)m * ZP + qcol;
#pragma unroll
        for (int d = 0; d < 64; ++d) { q[d] = bf2f(qr[d]); acc[d] = 0.f; }
        float mx, ls;
        if (isB) { mx = p.b_sink[l * 6 + hq]; ls = 1.0f; } else { mx = -1e30f; ls = 0.f; }
        for (int j = 0; j < L; ++j) { const bf16_t* zr = p.Z + (size_t)(TL + b * L + j) * ZP; att_key(q, zr + kcol, zr + vcol, 0.f, mx, ls, acc); }
        if (m < TL) {
            const int t = m % S;
            if (isB) {
                const int j0 = t - 128 < 0 ? 0 : t - 128, j1 = t + 128 > S - 1 ? S - 1 : t + 128;
                for (int j = j0; j <= j1; ++j) { const bf16_t* zr = p.Z + (size_t)(b * S + j) * ZP; att_key(q, zr + kcol, zr + vcol, 0.f, mx, ls, acc); }
            } else {
                const int rows = S / GRID_W, r = t / GRID_W, c = t % GRID_W;
                int r0 = r - 4; r0 = r0 < 0 ? 0 : (r0 > rows - 8 ? rows - 8 : r0);
                int c0 = c - 8; c0 = c0 < 0 ? 0 : (c0 > GRID_W - 16 ? GRID_W - 16 : c0);
                for (int a = 0; a < 8; ++a)
                    for (int e = 0; e < 16; ++e) {
                        const int kr = r0 + a, kc = c0 + e;
                        const float bias = p.c_rpb[(((size_t)l * 6 + hq) * 15 + (kr - r + 7)) * 31 + (kc - c + 15)];
                        const bf16_t* zr = p.Z + (size_t)(b * S + kr * GRID_W + kc) * ZP;
                        att_key(q, zr + kcol, zr + vcol, bias, mx, ls, acc);
                    }
            }
        }
        const float inv = 1.0f / ls;
        bf16_t* o = p.MIX + (size_t)m * DMIX + (isB ? 256 : 640) + hq * 64;
#pragma unroll
        for (int d = 0; d < 64; ++d) o[d] = f2bf(acc[d] * inv);
    }
}

__device__ void ph_post_mixer(const Params& p, int l, int nrows, long gtid, long gsz) {
    for (long mm = gtid; mm < nrows; mm += gsz) {
        const int m = (int)mm;
        const float* xr = xrow_in(p, l, m); const float* md = modrow(p, l, m); const float* orow = p.O + (size_t)m * D;
        float* x1 = (m < TL) ? p.out + (size_t)m * D : p.XC + (size_t)(m - TL) * D;
        const float* g1 = p.ln1_g + (size_t)l * D; const float* b1 = p.ln1_b + (size_t)l * D;
        float s = 0.f; for (int j = 0; j < D; ++j) s += ALPHA * xr[j] + md[2 * D + j] * orow[j];
        float mu = s / D, q = 0.f;
        for (int j = 0; j < D; ++j) { const float d = ALPHA * xr[j] + md[2 * D + j] * orow[j] - mu; q += d * d; }
        float rstd = 1.0f / sqrtf(q / D + LN_EPS);
        s = 0.f;
        for (int j = 0; j < D; ++j) { const float v = (ALPHA * xr[j] + md[2 * D + j] * orow[j] - mu) * rstd * g1[j] + b1[j]; x1[j] = v; s += v; }
        mu = s / D; q = 0.f;
        for (int j = 0; j < D; ++j) { const float d = x1[j] - mu; q += d * d; }
        rstd = 1.0f / sqrtf(q / D + LN_EPS);
        float gl[4], el[32];
#pragma unroll
        for (int g = 0; g < 4; ++g) gl[g] = p.b_rg[l * 4 + g];
#pragma unroll
        for (int e = 0; e < 32; ++e) el[e] = p.b_re[l * 32 + e];
        for (int j = 0; j < D; ++j) {
            const float hv = (x1[j] - mu) * rstd * (1.0f + md[4 * D + j]) + md[3 * D + j];
            p.H[(size_t)m * D + j] = f2bf(hv);
            const float* wg = p.w_rg + ((size_t)l * D + j) * 4; const float* we = p.w_re + ((size_t)l * D + j) * 32;
#pragma unroll
            for (int g = 0; g < 4; ++g) gl[g] += hv * wg[g];
#pragma unroll
            for (int e = 0; e < 32; ++e) el[e] += hv * we[e];
        }
        int gs = 0; float gm = gl[0];
#pragma unroll
        for (int g = 1; g < 4; ++g) if (gl[g] > gm) { gm = gl[g]; gs = g; }
        float den = 0.f;
#pragma unroll
        for (int g = 0; g < 4; ++g) den += expf(gl[g] - gm);
        const float pg = 1.0f / den;
        float v1 = -3e38f, v2 = -3e38f; int i1 = 0, i2 = 0;
#pragma unroll
        for (int j = 0; j < 8; ++j) {
            const float v = gs == 0 ? el[j] : gs == 1 ? el[8 + j] : gs == 2 ? el[16 + j] : el[24 + j];
            if (v > v1) { v2 = v1; i2 = i1; v1 = v; i1 = j; } else if (v > v2) { v2 = v; i2 = j; }
        }
        const float e2 = expf(v2 - v1), w1 = pg / (1.0f + e2), w2 = pg * e2 / (1.0f + e2);
        const int ea = gs * 8 + i1, eb = gs * 8 + i2;
        p.rE[2 * m] = ea; p.rE[2 * m + 1] = eb; p.rW[2 * m] = w1; p.rW[2 * m + 1] = w2;
        p.rPos[2 * m] = atomic_inc_int(p.cnt + l * NEXP + ea); p.rPos[2 * m + 1] = atomic_inc_int(p.cnt + l * NEXP + eb);
    }
}

__device__ __forceinline__ int pstart_of(const int* cnt, int e) {
    int s = 0;
    for (int j = 0; j < NEXP; ++j) if (j < e) s += (cnt[j] + 127) & ~127;
    return s;
}
__device__ __forceinline__ void ph_dispatch(const Params& p, int l, int nrows, long gtid, long gsz) {
    for (long i = gtid; i < (long)nrows * 2; i += gsz) {
        const int slot = pstart_of(p.cnt + l * NEXP, p.rE[i]) + p.rPos[i];
        p.rSlot[i] = slot; p.slotTok[slot] = (int)(i >> 1);
    }
}

__device__ void ph_final(const Params& p, int l, int nrows, long gtid, long gsz) {
    for (long mm = gtid; mm < nrows; mm += gsz) {
        const int m = (int)mm;
        float* x1 = (m < TL) ? p.out + (size_t)m * D : p.XC + (size_t)(m - TL) * D;
        const float* md = modrow(p, l, m);
        const float* ya = p.YS + (size_t)p.rSlot[2 * m] * D; const float* yb = p.YS + (size_t)p.rSlot[2 * m + 1] * D;
        const float wa = p.rW[2 * m], wb = p.rW[2 * m + 1];
        const float* g2 = p.ln2_g + (size_t)l * D; const float* b2 = p.ln2_b + (size_t)l * D;
        float s = 0.f; for (int j = 0; j < D; ++j) s += ALPHA * x1[j] + md[5 * D + j] * (wa * ya[j] + wb * yb[j]);
        const float mu = s / D; float q = 0.f;
        for (int j = 0; j < D; ++j) { const float d = ALPHA * x1[j] + md[5 * D + j] * (wa * ya[j] + wb * yb[j]) - mu; q += d * d; }
        const float rstd = 1.0f / sqrtf(q / D + LN_EPS);
        for (int j = 0; j < D; ++j) x1[j] = (ALPHA * x1[j] + md[5 * D + j] * (wa * ya[j] + wb * yb[j]) - mu) * rstd * g2[j] + b2[j];
    }
}

__device__ __forceinline__ int moe_blocks(const int* cnt) { int s = 0; for (int j = 0; j < NEXP; ++j) s += (cnt[j] + 127) >> 7; return s; }
__device__ __forceinline__ int moe_block_expert(const int* cnt, int rb) {
    int s = 0, e = 0;
    for (int j = 0; j < NEXP; ++j) { const int nb = (cnt[j] + 127) >> 7; if (rb >= s && rb < s + nb) e = j; s += nb; }
    return e;
}

#ifdef HOST_EMU
static void host_gemm_in(const Params& p) {
    for (int m = 0; m < T; ++m) for (int n = 0; n < ZP; ++n) { float a = 0.f; for (int k = 0; k < D; ++k) a += bf2f(p.H[(size_t)m * D + k]) * bf2f(p.win_t[(size_t)n * D + k]); p.Z[(size_t)m * ZP + n] = f2bf(a); }
}
static void host_gemm_out(const Params& p, int nrows) {
    for (int m = 0; m < nrows; ++m) for (int n = 0; n < D; ++n) { float a = 0.f; for (int k = 0; k < DMIX; ++k) a += bf2f(p.MIX[(size_t)m * DMIX + k]) * bf2f(p.wout_t[(size_t)n * DMIX + k]); p.O[(size_t)m * D + n] = a; }
}
static void host_moe1(const Params& p, int l) {
    const int* cnt = p.cnt + l * NEXP; const int nrb = moe_blocks(cnt);
    for (int rb = 0; rb < nrb; ++rb) { const int e = moe_block_expert(cnt, rb);
        for (int r = 0; r < 128; ++r) { const int slot = rb * 128 + r; const bf16_t* a = p.H + (size_t)p.slotTok[slot] * D;
            for (int c = 0; c < DE; ++c) { const int q = c >> 4, ii = c & 15; float g = 0.f, u = 0.f;
                const bf16_t* wg = p.wgu_t + ((size_t)e * 2 * DE + 32 * q + ii) * D; const bf16_t* wu = wg + (size_t)16 * D;
                for (int k = 0; k < D; ++k) { g += bf2f(a[k]) * bf2f(wg[k]); u += bf2f(a[k]) * bf2f(wu[k]); }
                p.ACT[(size_t)slot * DE + c] = f2bf(siluf_(g) * u); } } }
}
static void host_moe2(const Params& p, int l) {
    const int* cnt = p.cnt + l * NEXP; const int nrb = moe_blocks(cnt);
    for (int rb = 0; rb < nrb; ++rb) { const int e = moe_block_expert(cnt, rb);
        for (int r = 0; r < 128; ++r) { const int slot = rb * 128 + r;
            for (int n = 0; n < D; ++n) { float a = 0.f; const bf16_t* w = p.wd_t + ((size_t)e * D + n) * DE;
                for (int k = 0; k < DE; ++k) a += bf2f(p.ACT[(size_t)slot * DE + k]) * bf2f(w[k]);
                p.YS[(size_t)slot * D + n] = a; } } }
}
#else
typedef short bf16x8 __attribute__((ext_vector_type(8)));
typedef float f32x4 __attribute__((ext_vector_type(4)));
__device__ __forceinline__ int opq_tid() { int t = threadIdx.x; asm volatile("" : "+v"(t)); return t; }
__device__ __forceinline__ int opq_bid() { int b = blockIdx.x; asm volatile("" : "+s"(b)); return b; }
__device__ __forceinline__ unsigned pk2(float lo, float hi) { return (unsigned)f2bf(lo) | ((unsigned)f2bf(hi) << 16); }
struct u32x2_t { unsigned x, y; };
__device__ __forceinline__ void st_bf16x4(bf16_t* dst, f32x4 v) { u32x2_t o; o.x = pk2(v[0], v[1]); o.y = pk2(v[2], v[3]); *(u32x2_t*)dst = o; }
template <class Epi>
__device__ __forceinline__ void gemm_tile(const bf16_t* a0, const bf16_t* a1, const bf16_t* b0, const bf16_t* b1, int K, char* lds, const Epi& epi) {
    const int tid = opq_tid(), wid = tid >> 6, lane = tid & 63, wr = wid >> 1, wc = wid & 1, fr = lane & 15, fq = lane >> 4;
    f32x4 acc[4][4];
#pragma unroll
    for (int m = 0; m < 4; ++m)
#pragma unroll
        for (int n = 0; n < 4; ++n) acc[m][n] = (f32x4){0.f, 0.f, 0.f, 0.f};
#define GT_STAGE(st_, kt_) do { char* sa_ = lds + (st_) * 16384 + tid * 16; \
        __builtin_amdgcn_global_load_lds((const unsigned*)(a0 + (kt_)), (__attribute__((address_space(3))) unsigned*)(sa_), 16, 0, 0); \
        __builtin_amdgcn_global_load_lds((const unsigned*)(a1 + (kt_)), (__attribute__((address_space(3))) unsigned*)(sa_ + 4096), 16, 0, 0); \
        __builtin_amdgcn_global_load_lds((const unsigned*)(b0 + (kt_)), (__attribute__((address_space(3))) unsigned*)(sa_ + 8192), 16, 0, 0); \
        __builtin_amdgcn_global_load_lds((const unsigned*)(b1 + (kt_)), (__attribute__((address_space(3))) unsigned*)(sa_ + 12288), 16, 0, 0); } while (0)
    const int aoff = (wr * 64 + fr) * 64 + ((fq ^ ((fr >> 2) & 3)) * 16), boff = 8192 + (wc * 64 + fr) * 64 + ((fq ^ ((fr >> 2) & 3)) * 16);
    const int nk = K / 32;
    GT_STAGE(0, 0);
    if (nk > 1) GT_STAGE(1, 32);
    if (nk > 2) GT_STAGE(2, 64);
    for (int t = 0; t < nk; ++t) {
        if (t + 2 < nk) asm volatile("s_waitcnt vmcnt(8)" ::: "memory"); else if (t + 1 < nk) asm volatile("s_waitcnt vmcnt(4)" ::: "memory"); else asm volatile("s_waitcnt vmcnt(0)" ::: "memory");
        asm volatile("s_waitcnt lgkmcnt(0)" ::: "memory");
        __builtin_amdgcn_s_barrier();
        if (t + 3 < nk) GT_STAGE((t + 3) & 3, (t + 3) * 32);
        const char* sb = lds + (t & 3) * 16384;
        bf16x8 At[4], Bt[4];
#pragma unroll
        for (int m = 0; m < 4; ++m) At[m] = *(const bf16x8*)(sb + aoff + m * 1024);
#pragma unroll
        for (int n = 0; n < 4; ++n) Bt[n] = *(const bf16x8*)(sb + boff + n * 1024);
#pragma unroll
        for (int m = 0; m < 4; ++m)
#pragma unroll
            for (int n = 0; n < 4; ++n) acc[m][n] = __builtin_amdgcn_mfma_f32_16x16x32_bf16(At[m], Bt[n], acc[m][n], 0, 0, 0);
    }
    asm volatile("s_waitcnt lgkmcnt(0)" ::: "memory");
    __builtin_amdgcn_s_barrier();
#undef GT_STAGE
    epi(acc, wr, wc, fr, fq);
}
#define STG_ROW(i) ((tid_ + (i) * 256) >> 2)
#define STG_K ((((tid_ & 3) ^ ((tid_ >> 4) & 3))) * 8)

__device__ __forceinline__ void g_gemm_in(const Params& p, char* lds) {
    const int tid_ = opq_tid(), bid_ = opq_bid(); (void)tid_; (void)bid_;
    constexpr int NT = NINP / 128, MT = T / 128;
    for (int tile = bid_; tile < NT * MT; tile += gridDim.x) {
        const int tm = tile / NT, tn = tile % NT;
        const bf16_t* a0 = p.H + (size_t)(tm * 128 + STG_ROW(0)) * D + STG_K; const bf16_t* a1 = p.H + (size_t)(tm * 128 + STG_ROW(1)) * D + STG_K;
        const bf16_t* b0 = p.win_t + (size_t)(tn * 128 + STG_ROW(0)) * D + STG_K; const bf16_t* b1 = p.win_t + (size_t)(tn * 128 + STG_ROW(1)) * D + STG_K;
        gemm_tile(a0, a1, b0, b1, D, lds, [&](const f32x4 (&acc)[4][4], int wr, int wc, int fr, int fq) {
            if (tn < ZVB / 128 && tm < TL / 128) {
#pragma unroll
                for (int m = 0; m < 4; ++m)
#pragma unroll
                    for (int j = 0; j < 4; ++j) { const int row = tm * 128 + wr * 64 + m * 16 + fq * 4 + j, t = row % S;
                        bf16_t* zr = p.Z + (size_t)row * ZP + tn * 128 + wc * 64 + fr;
#pragma unroll
                        for (int ax = 0; ax < 2; ++ax) { const int pos = ax ? t % GRID_W : t / GRID_W; const float cs = p.rope[pos * 16 + fr], sn = p.rope[1024 + pos * 16 + fr];
                            const float x0 = acc[m][2 * ax][j], x1 = acc[m][2 * ax + 1][j];
                            zr[32 * ax] = f2bf(x0 * cs - x1 * sn); zr[32 * ax + 16] = f2bf(x1 * cs + x0 * sn); } }
            } else {
#pragma unroll
            for (int m = 0; m < 4; ++m)
#pragma unroll
                for (int n = 0; n < 4; ++n) { const int col = tn * 128 + wc * 64 + n * 16 + fr;
                    if (col < ZP) {
#pragma unroll
                        for (int j = 0; j < 4; ++j) p.Z[(size_t)(tm * 128 + wr * 64 + m * 16 + fq * 4 + j) * ZP + col] = f2bf(acc[m][n][j]); } }
            }
            if (tn == ZVB / 128 || (tn >= ZVN / 128 && tn < ZA / 128)) {
#pragma unroll
                for (int m = 0; m < 4; ++m) { const int m0 = tm * 128 + wr * 64 + m * 16 + fq * 4; int b, u;
                    if (m0 < TL) { b = m0 / S; u = L + m0 % S; } else { b = (m0 - TL) / L; u = (m0 - TL) % L; }
#pragma unroll
                    for (int n = 0; n < 4; ++n) { const int col = tn * 128 + wc * 64 + n * 16 + fr;
                        const int hv = col < ZVN ? (col - ZVB) >> 6 : 2 + ((col - ZVN) >> 6), d = col < ZVN ? (col - ZVB) & 63 : (col - ZVN) & 63;
                        st_bf16x4(p.VT + ((size_t)(b * 8 + hv) * 64 + d) * PU + u, acc[m][n]); } }
            }
        });
    }
}
__device__ __forceinline__ void g_gemm_out(const Params& p, int nrows, char* lds) {
    const int tid_ = opq_tid(), bid_ = opq_bid(); (void)tid_; (void)bid_;
    constexpr int NT = D / 128; const int MT = nrows / 128;
    for (int tile = bid_; tile < NT * MT; tile += gridDim.x) {
        const int tm = tile / NT, tn = tile % NT;
        const bf16_t* a0 = p.MIX + (size_t)(tm * 128 + STG_ROW(0)) * DMIX + STG_K; const bf16_t* a1 = p.MIX + (size_t)(tm * 128 + STG_ROW(1)) * DMIX + STG_K;
        const bf16_t* b0 = p.wout_t + (size_t)(tn * 128 + STG_ROW(0)) * DMIX + STG_K; const bf16_t* b1 = p.wout_t + (size_t)(tn * 128 + STG_ROW(1)) * DMIX + STG_K;
        gemm_tile(a0, a1, b0, b1, DMIX, lds, [&](const f32x4 (&acc)[4][4], int wr, int wc, int fr, int fq) {
#pragma unroll
            for (int m = 0; m < 4; ++m)
#pragma unroll
                for (int n = 0; n < 4; ++n)
#pragma unroll
                    for (int j = 0; j < 4; ++j) p.O[(size_t)(tm * 128 + wr * 64 + m * 16 + fq * 4 + j) * D + tn * 128 + wc * 64 + n * 16 + fr] = acc[m][n][j];
        });
    }
}
__device__ __forceinline__ void g_moe1(const Params& p, int l, char* lds) {
    const int tid_ = opq_tid(), bid_ = opq_bid(); (void)tid_; (void)bid_;
    const int* cnt = p.cnt + l * NEXP; const int nrb = moe_blocks(cnt); constexpr int NT = 2 * DE / 128;
    for (int tile = bid_; tile < nrb * NT; tile += gridDim.x) {
        const int rb = tile / NT, tn = tile % NT, e = moe_block_expert(cnt, rb);
        const bf16_t* a0 = p.H + (size_t)p.slotTok[rb * 128 + STG_ROW(0)] * D + STG_K; const bf16_t* a1 = p.H + (size_t)p.slotTok[rb * 128 + STG_ROW(1)] * D + STG_K;
        const bf16_t* bw = p.wgu_t + (size_t)e * 2 * DE * D;
        const bf16_t* b0 = bw + (size_t)(tn * 128 + STG_ROW(0)) * D + STG_K; const bf16_t* b1 = bw + (size_t)(tn * 128 + STG_ROW(1)) * D + STG_K;
        gemm_tile(a0, a1, b0, b1, D, lds, [&](const f32x4 (&acc)[4][4], int wr, int wc, int fr, int fq) {
#pragma unroll
            for (int m = 0; m < 4; ++m)
#pragma unroll
                for (int n2 = 0; n2 < 2; ++n2) { const int col = tn * 64 + wc * 32 + n2 * 16 + fr;
#pragma unroll
                    for (int j = 0; j < 4; ++j) { const float g = acc[m][2 * n2][j], u = acc[m][2 * n2 + 1][j];
                        p.ACT[(size_t)(rb * 128 + wr * 64 + m * 16 + fq * 4 + j) * DE + col] = f2bf(g / (1.0f + __expf(-g)) * u); } }
        });
    }
}
__device__ __forceinline__ void g_moe2(const Params& p, int l, char* lds) {
    const int tid_ = opq_tid(), bid_ = opq_bid(); (void)tid_; (void)bid_;
    const int* cnt = p.cnt + l * NEXP; const int nrb = moe_blocks(cnt); constexpr int NT = D / 128;
    for (int tile = bid_; tile < nrb * NT; tile += gridDim.x) {
        const int rb = tile / NT, tn = tile % NT, e = moe_block_expert(cnt, rb);
        const bf16_t* a0 = p.ACT + (size_t)(rb * 128 + STG_ROW(0)) * DE + STG_K; const bf16_t* a1 = p.ACT + (size_t)(rb * 128 + STG_ROW(1)) * DE + STG_K;
        const bf16_t* bw = p.wd_t + (size_t)e * D * DE;
        const bf16_t* b0 = bw + (size_t)(tn * 128 + STG_ROW(0)) * DE + STG_K; const bf16_t* b1 = bw + (size_t)(tn * 128 + STG_ROW(1)) * DE + STG_K;
        gemm_tile(a0, a1, b0, b1, DE, lds, [&](const f32x4 (&acc)[4][4], int wr, int wc, int fr, int fq) {
#pragma unroll
            for (int m = 0; m < 4; ++m)
#pragma unroll
                for (int n = 0; n < 4; ++n)
#pragma unroll
                    for (int j = 0; j < 4; ++j) p.YS[(size_t)(rb * 128 + wr * 64 + m * 16 + fq * 4 + j) * D + tn * 128 + wc * 64 + n * 16 + fr] = acc[m][n][j];
        });
    }
}


constexpr int DV = D / 256;
static_assert(D % 256 == 0, "row phases hold a row as DV float4 per lane");
template <int CTRL> __device__ __forceinline__ float dppf(float v) { return __builtin_bit_cast(float, __builtin_amdgcn_update_dpp(0, __builtin_bit_cast(int, v), CTRL, 0xf, 0xf, true)); }
__device__ __forceinline__ float wave_sum(float v) {
    v += dppf<0xB1>(v); v += dppf<0x4E>(v); v += dppf<0x141>(v); v += dppf<0x140>(v);
    float a = v, b = v;
    asm volatile("s_nop 1\n\tv_permlane16_swap_b32 %0, %1" : "+v"(a), "+v"(b));
    v = a + b; a = v; b = v;
    asm volatile("s_nop 1\n\tv_permlane32_swap_b32 %0, %1" : "+v"(a), "+v"(b));
    return a + b;
}
__device__ __forceinline__ float sum8(float v) { v += dppf<0xB1>(v); v += dppf<0x4E>(v); v += dppf<0x141>(v); return v; }
__device__ __forceinline__ float sum4(f32x4 a) { return (a[0] + a[1]) + (a[2] + a[3]); }
#define LDS_WAIT() asm volatile("s_waitcnt lgkmcnt(0)" ::: "memory")

__device__ __forceinline__ void row_stats(const f32x4 (&v)[DV], float& mu, float& rstd) {
    float s = 0.f;
#pragma unroll
    for (int j = 0; j < DV; ++j) s += sum4(v[j]);
    mu = wave_sum(s) * (1.0f / D);
    float q = 0.f;
#pragma unroll
    for (int j = 0; j < DV; ++j) { const f32x4 d = v[j] - mu; q += sum4(d * d); }
    rstd = 1.0f / sqrtf(wave_sum(q) * (1.0f / D) + LN_EPS);
}

__device__ __forceinline__ void ph_lnmod_fast(const Params& p, int l) {
    const int tid_ = opq_tid(), bid_ = opq_bid(); (void)tid_; (void)bid_;
    const int lane = tid_ & 63, gw = bid_ * 4 + (tid_ >> 6), nw = gridDim.x * 4;
    for (int m = gw; m < T; m += nw) {
        const f32x4* xr = (const f32x4*)xrow_in(p, l, m) + lane; const f32x4* md = (const f32x4*)modrow(p, l, m) + lane;
        f32x4 v[DV];
#pragma unroll
        for (int j = 0; j < DV; ++j) v[j] = xr[64 * j];
        float mu, rstd; row_stats(v, mu, rstd);
#pragma unroll
        for (int j = 0; j < DV; ++j) { const f32x4 sh = md[64 * j], sc = md[D / 4 + 64 * j];
            st_bf16x4(p.H + (size_t)m * D + 4 * (lane + 64 * j), (v[j] - mu) * rstd * (sc + 1.0f) + sh); }
    }
}

__device__ __forceinline__ void ph_post_mixer_fast(const Params& p, int l, int nrows) {
    const int tid_ = opq_tid(), bid_ = opq_bid(); (void)tid_; (void)bid_;
    const int lane = tid_ & 63, gw = bid_ * 4 + (tid_ >> 6), nw = gridDim.x * 4;
    for (int m = gw; m < nrows; m += nw) {
        const f32x4* xr = (const f32x4*)xrow_in(p, l, m) + lane; const f32x4* md = (const f32x4*)modrow(p, l, m) + lane;
        const f32x4* orow = (const f32x4*)(p.O + (size_t)m * D) + lane;
        f32x4* x1 = (f32x4*)((m < TL) ? p.out + (size_t)m * D : p.XC + (size_t)(m - TL) * D) + lane;
        const f32x4* g1 = (const f32x4*)(p.ln1_g + (size_t)l * D) + lane; const f32x4* b1 = (const f32x4*)(p.ln1_b + (size_t)l * D) + lane;
        f32x4 v[DV];
#pragma unroll
        for (int j = 0; j < DV; ++j) v[j] = xr[64 * j] * ALPHA + md[2 * (D / 4) + 64 * j] * orow[64 * j];
        float mu, rstd; row_stats(v, mu, rstd);
#pragma unroll
        for (int j = 0; j < DV; ++j) { v[j] = (v[j] - mu) * rstd * g1[64 * j] + b1[64 * j]; x1[64 * j] = v[j]; }
        row_stats(v, mu, rstd);
#pragma unroll
        for (int j = 0; j < DV; ++j) {
            const f32x4 hv = (v[j] - mu) * rstd * (md[4 * (D / 4) + 64 * j] + 1.0f) + md[3 * (D / 4) + 64 * j];
            f32x4 hh, lo;
#pragma unroll
            for (int e = 0; e < 4; ++e) { hh[e] = bf2f(f2bf(hv[e])); lo[e] = hv[e] - hh[e]; }
            st_bf16x4(p.H + (size_t)m * D + 4 * (lane + 64 * j), hh);
            st_bf16x4(p.HLO + (size_t)m * D + 4 * (lane + 64 * j), lo);
        }
    }
}

__device__ __forceinline__ void g_router(const Params& p, int l, int nrows, char* lds) {
    const int tid_ = opq_tid(), bid_ = opq_bid(); (void)tid_; (void)bid_;
    const int lane = tid_ & 63, wid = tid_ >> 6, fr = lane & 15, fq = lane >> 4;
    float* part = (float*)lds;
    float* lgt = part + 4 * 6 * 64 * 4;
    int* eids = (int*)(lgt + 32 * 48);
    for (int rg = bid_; rg < nrows / 32; rg += gridDim.x) {
        f32x4 acc[2][3];
#pragma unroll
        for (int a = 0; a < 2; ++a)
#pragma unroll
            for (int b = 0; b < 3; ++b) acc[a][b] = (f32x4){0.f, 0.f, 0.f, 0.f};
#pragma unroll
        for (int seg = 0; seg < 3; ++seg) {
            const bf16_t* ap = (seg < 2 ? p.H : p.HLO) + (size_t)(rg * 32 + fr) * D + wid * (D / 4) + fq * 8;
            const bf16_t* bp = p.wrt + (seg == 1 ? (size_t)128 * D : 0) + (size_t)fr * D + wid * (D / 4) + fq * 8;
#pragma unroll 1
            for (int ks0 = 0; ks0 < D / 128; ks0 += 4) {
                bf16x8 av[4][2], bv[4][3];
#pragma unroll
                for (int u = 0; u < 4; ++u) { const int ko = (ks0 + u) * 32;
                    av[u][0] = *(const bf16x8*)(ap + ko); av[u][1] = *(const bf16x8*)(ap + (size_t)16 * D + ko);
                    bv[u][0] = *(const bf16x8*)(bp + ko); bv[u][1] = *(const bf16x8*)(bp + (size_t)16 * D + ko); bv[u][2] = *(const bf16x8*)(bp + (size_t)32 * D + ko); }
                asm volatile("" ::: "memory");
#pragma unroll
                for (int u = 0; u < 4; ++u)
#pragma unroll
                    for (int a = 0; a < 2; ++a)
#pragma unroll
                        for (int b = 0; b < 3; ++b) acc[a][b] = __builtin_amdgcn_mfma_f32_16x16x32_bf16(av[u][a], bv[u][b], acc[a][b], 0, 0, 0);
            }
        }
#pragma unroll
        for (int a = 0; a < 2; ++a)
#pragma unroll
            for (int b = 0; b < 3; ++b) *(f32x4*)(part + ((wid * 6 + a * 3 + b) * 64 + lane) * 4) = acc[a][b];
        __syncthreads();
#pragma unroll
        for (int i = 0; i < 6; ++i) { const int e = tid_ + 256 * i, f = e >> 8, ln = (e & 255) >> 2, j = e & 3;
            const float sm = (part[((0 * 6 + f) * 64 + ln) * 4 + j] + part[((1 * 6 + f) * 64 + ln) * 4 + j]) + (part[((2 * 6 + f) * 64 + ln) * 4 + j] + part[((3 * 6 + f) * 64 + ln) * 4 + j]);
            lgt[((f / 3) * 16 + (ln >> 4) * 4 + j) * 48 + (f % 3) * 16 + (ln & 15)] = sm; }
        __syncthreads();
        if (tid_ < 32) {
            const int m = rg * 32 + tid_; const float* lg = lgt + tid_ * 48;
            float gl[4], el[32];
#pragma unroll
            for (int g = 0; g < 4; ++g) gl[g] = lg[g] + p.b_rg[l * 4 + g];
#pragma unroll
            for (int e = 0; e < 32; ++e) el[e] = lg[4 + e] + p.b_re[l * 32 + e];
            int gs = 0; float gm = gl[0];
#pragma unroll
            for (int g = 1; g < 4; ++g) if (gl[g] > gm) { gm = gl[g]; gs = g; }
            float den = 0.f;
#pragma unroll
            for (int g = 0; g < 4; ++g) den += expf(gl[g] - gm);
            const float pg = 1.0f / den;
            float v1 = -3e38f, v2 = -3e38f; int i1 = 0, i2 = 0;
#pragma unroll
            for (int j = 0; j < 8; ++j) {
                const float vv = gs == 0 ? el[j] : gs == 1 ? el[8 + j] : gs == 2 ? el[16 + j] : el[24 + j];
                if (vv > v1) { v2 = v1; i2 = i1; v1 = vv; i1 = j; } else if (vv > v2) { v2 = vv; i2 = j; }
            }
            const float e2 = expf(v2 - v1), w1 = pg / (1.0f + e2), w2 = pg * e2 / (1.0f + e2);
            const int ea = gs * 8 + i1, eb = gs * 8 + i2;
            p.rE[2 * m] = ea; p.rE[2 * m + 1] = eb; p.rW[2 * m] = w1; p.rW[2 * m + 1] = w2;
            eids[2 * tid_] = ea; eids[2 * tid_ + 1] = eb;
        }
        __syncthreads();
        if (tid_ < 64) { const int e = eids[tid_]; int rk = 0; for (int j = 0; j < tid_; ++j) rk += (eids[j] == e) ? 1 : 0; p.rPos[2 * (rg * 32) + tid_] = rk; }
        else if (tid_ < 96) { const int e = tid_ - 64; int c = 0; for (int j = 0; j < 64; ++j) c += (eids[j] == e) ? 1 : 0; p.hist[rg * 32 + e] = c; }
        __syncthreads();
    }
}

__device__ __forceinline__ void ph_dispatch_fast(const Params& p, int l, int nrows, char* lds) {
    const int tid_ = opq_tid(), bid_ = opq_bid(); (void)tid_; (void)bid_;
    const int nrg = nrows / 32, e = tid_ & 31, part = tid_ >> 5;
    int* tot = (int*)lds; int* pst = tot + 32; int* pre = pst + 32; int* red = pre + 32;
    { int s = 0; for (int b = part; b < nrg; b += 8) s += p.hist[b * 32 + e]; red[part * 32 + e] = s; }
    __syncthreads();
    if (tid_ < 32) { int s = 0; for (int q = 0; q < 8; ++q) s += red[q * 32 + tid_]; tot[tid_] = s; }
    __syncthreads();
    if (tid_ < 32) { int s = 0; for (int j = 0; j < tid_; ++j) s += (tot[j] + 127) & ~127; pst[tid_] = s; if (bid_ == 0) p.cnt[l * NEXP + tid_] = tot[tid_]; }
    for (int rg = bid_; rg < nrg; rg += gridDim.x) {
        __syncthreads();
        { int s = 0; for (int b = part; b < rg; b += 8) s += p.hist[b * 32 + e]; red[part * 32 + e] = s; }
        __syncthreads();
        if (tid_ < 32) { int s = 0; for (int q = 0; q < 8; ++q) s += red[q * 32 + tid_]; pre[tid_] = s; }
        __syncthreads();
        if (tid_ < 64) { const int i = 2 * (rg * 32) + tid_, ee = p.rE[i], slot = pst[ee] + pre[ee] + p.rPos[i]; p.rSlot[i] = slot; p.slotTok[slot] = i >> 1; }
    }
}

__device__ __forceinline__ void ph_final_fast(const Params& p, int l, int nrows) {
    const int tid_ = opq_tid(), bid_ = opq_bid(); (void)tid_; (void)bid_;
    const int lane = tid_ & 63, gw = bid_ * 4 + (tid_ >> 6), nw = gridDim.x * 4;
    for (int m = gw; m < nrows; m += nw) {
        f32x4* x1 = (f32x4*)((m < TL) ? p.out + (size_t)m * D : p.XC + (size_t)(m - TL) * D) + lane;
        const f32x4* md = (const f32x4*)modrow(p, l, m) + lane;
        const f32x4* ya = (const f32x4*)(p.YS + (size_t)p.rSlot[2 * m] * D) + lane; const f32x4* yb = (const f32x4*)(p.YS + (size_t)p.rSlot[2 * m + 1] * D) + lane;
        const float wa = p.rW[2 * m], wb = p.rW[2 * m + 1];
        const f32x4* g2 = (const f32x4*)(p.ln2_g + (size_t)l * D) + lane; const f32x4* b2 = (const f32x4*)(p.ln2_b + (size_t)l * D) + lane;
        f32x4 v[DV];
#pragma unroll
        for (int j = 0; j < DV; ++j) v[j] = x1[64 * j] * ALPHA + md[5 * (D / 4) + 64 * j] * (ya[64 * j] * wa + yb[64 * j] * wb);
        float mu, rstd; row_stats(v, mu, rstd);
#pragma unroll
        for (int j = 0; j < DV; ++j) x1[64 * j] = (v[j] - mu) * rstd * g2[64 * j] + b2[64 * j];
    }
}

__device__ __forceinline__ void ph_mod_fast(const Params& p, char* lds) {
    const int tid_ = opq_tid(), bid_ = opq_bid(); (void)tid_; (void)bid_;
    constexpr int NR = NB + 1, NTASK = 2 * (6 * D / 64);
    if (bid_ >= NTASK) return;
    float* sc = (float*)lds;
    float* part = sc + NR * D;
    for (int i = tid_; i < NR * D; i += 256) { const int b = i / D, k = i % D; const float cv = b < NB ? p.c[(size_t)b * D + k] : p.c_ctx[k]; sc[i] = cv / (1.0f + __expf(-cv)); }
    __syncthreads();
    const int lane = tid_ & 63, wid = tid_ >> 6;
    for (int task = bid_; task < NTASK; task += gridDim.x) {
        const int ll = task / (6 * D / 64), col = 64 * (task % (6 * D / 64)) + lane;
        float acc[NR];
#pragma unroll
        for (int b = 0; b < NR; ++b) acc[b] = 0.f;
        const float* wp = p.w_mod + ((size_t)ll * D + wid * (D / 4)) * 6 * D + col;
#pragma unroll 16
        for (int k = 0; k < D / 4; ++k) { const float w = wp[(size_t)k * 6 * D];
#pragma unroll
            for (int b = 0; b < NR; ++b) acc[b] += sc[b * D + wid * (D / 4) + k] * w; }
#pragma unroll
        for (int b = 0; b < NR; ++b) part[(wid * NR + b) * 64 + lane] = acc[b];
        __syncthreads();
        for (int i = tid_; i < NR * 64; i += 256) { const int b = i / 64, cl = i % 64;
            p.mod[((size_t)ll * NR + b) * 6 * D + 64 * (task % (6 * D / 64)) + cl] = (part[(0 * NR + b) * 64 + cl] + part[(1 * NR + b) * 64 + cl]) + (part[(2 * NR + b) * 64 + cl] + part[(3 * NR + b) * 64 + cl]) + p.b_mod[(size_t)ll * 6 * D + 64 * (task % (6 * D / 64)) + cl]; }
        __syncthreads();
    }
}

__device__ __forceinline__ void tr_item(const float* srcl, size_t ldw, bf16_t* dst, size_t ldd, float* scr, int lane) {
#pragma unroll 8
    for (int i = 0; i < 32; ++i) { const int kk = 2 * i + (lane >> 5); scr[kk * 33 + (lane & 31)] = srcl ? srcl[(size_t)kk * ldw] : 0.f; }
    LDS_WAIT();
    const int c = lane & 7;
#pragma unroll
    for (int j = 0; j < 4; ++j) { const int n = (lane >> 3) + 8 * j; const float* s = scr + (8 * c) * 33 + n;
        uint4 o; o.x = pk2(s[0], s[33]); o.y = pk2(s[2 * 33], s[3 * 33]); o.z = pk2(s[4 * 33], s[5 * 33]); o.w = pk2(s[6 * 33], s[7 * 33]);
        *(uint4*)(dst + (size_t)n * ldd + 8 * c) = o; }
    LDS_WAIT();
}
__device__ __forceinline__ void ph_prep_w_fast(const Params& p, int l, int part, char* lds) {
    const int tid_ = opq_tid(), bid_ = opq_bid(); (void)tid_; (void)bid_;
    const int lane = tid_ & 63, wid = tid_ >> 6, gw = bid_ * 4 + wid, nw = gridDim.x * 4;
    float* scr = (float*)(lds + wid * 8448);
    constexpr int I_IN = (D / 64) * (NINP / 32), I_OUT = (DMIX / 64) * (D / 32), I_GU1 = (D / 64) * (2 * DE / 32), I_D1 = (DE / 64) * (D / 32);
    constexpr int NITEMS = I_IN + I_OUT + NEXP * (I_GU1 + I_D1);
    const int it0 = part == 0 ? 0 : I_IN + I_OUT, it1 = part == 0 ? I_IN + I_OUT : NITEMS;
    for (int it = it0 + gw; it < it1; it += nw) {
        int r = it;
        if (r < I_IN) { const int kb = r / (NINP / 32), n0 = 32 * (r % (NINP / 32));
            const float* s = nullptr;
            if (n0 < N_IN) { const int oc = (n0 < ZA) ? n0 + A_IN : n0 - ZA; s = p.w_in + ((size_t)l * D + 64 * kb) * N_IN + oc + (lane & 31); }
            tr_item(s, N_IN, p.win_t + (size_t)n0 * D + 64 * kb, D, scr, lane); continue; }
        r -= I_IN;
        if (r < I_OUT) { const int kb = r / (D / 32), n0 = 32 * (r % (D / 32));
            tr_item(p.w_out + ((size_t)l * DMIX + 64 * kb) * D + n0 + (lane & 31), D, p.wout_t + (size_t)n0 * DMIX + 64 * kb, DMIX, scr, lane); continue; }
        r -= I_OUT;
        const int e = r / (I_GU1 + I_D1); r %= (I_GU1 + I_D1);
        if (r < I_GU1) { const int kb = r / (2 * DE / 32), q = r % (2 * DE / 32);
            const float* s = (((lane & 31) >> 4) ? p.w_up : p.w_gate) + (((size_t)l * NEXP + e) * D + 64 * kb) * DE + 16 * q + (lane & 15);
            tr_item(s, DE, p.wgu_t + ((size_t)e * 2 * DE + 32 * q) * D + 64 * kb, D, scr, lane); continue; }
        r -= I_GU1;
        { const int kb = r / (D / 32), n0 = 32 * (r % (D / 32));
            tr_item(p.w_down + (((size_t)l * NEXP + e) * DE + 64 * kb) * D + n0 + (lane & 31), D, p.wd_t + ((size_t)e * D + n0) * DE + 64 * kb, DE, scr, lane); }
    }
    if (part != 0) return;
    const long gt = (long)bid_ * blockDim.x + tid_, gs = (long)gridDim.x * blockDim.x;
    for (long i = gt; i < 2 * 256 * 64; i += gs) { const int k = (int)(i & 63), n = (int)((i >> 6) & 255), d = (int)(i >> 14);
        p.wupT[i] = f2bf(p.a_w_up[(((size_t)l * 2 + d) * 64 + k) * DA + n]); p.aupT[i] = f2bf(p.a_a_up[(((size_t)l * 2 + d) * 64 + k) * DA + n]); }
    for (long i = gt; i < 256 * 160; i += gs) { const int k = (int)(i % 160), n = (int)(i / 160); p.gupT[i] = f2bf(p.a_g_up[((size_t)l * 160 + k) * DA + n]); }
    for (long i = gt; i < (long)128 * D; i += gs) { const int n = (int)(i / D), k = (int)(i % D);
        const float w = n < 4 ? p.w_rg[((size_t)l * D + k) * 4 + n] : n < 36 ? p.w_re[((size_t)l * D + k) * 32 + n - 4] : 0.f;
        const bf16_t hb = f2bf(w); p.wrt[i] = hb; p.wrt[(size_t)128 * D + i] = f2bf(w - bf2f(hb)); }
}

__device__ __forceinline__ float tanh_fast(float x) { return 1.0f - 2.0f / (1.0f + __expf(2.0f * x)); }
__device__ __forceinline__ void ph_streams_s1(const Params& p, int l) {
    const int tid_ = opq_tid(), bid_ = opq_bid(); (void)tid_; (void)bid_;
    constexpr int NCH = A_IN / 8, NCHP = (NCH + 7) & ~7;
    const float* sh = p.a_shift + (size_t)l * 3 * A_IN;
    for (long it = (long)bid_ * 256 + tid_; it < (long)T * NCHP; it += (long)gridDim.x * 256) {
        const int m = (int)(it / NCHP), ch = (int)(it % NCHP), c0 = 8 * ch;
        const bool act = ch < NCH;
        int t, len;
        if (m < TL) { t = m % S; len = S; } else { t = (m - TL) % L; len = L; }
        float v[8];
#pragma unroll
        for (int e = 0; e < 8; ++e) v[e] = 0.f;
        if (act) {
            const bf16_t* z = p.Z + (size_t)m * ZP + ZA + c0;
            const bf16x8 zc = *(const bf16x8*)z;
            const f32x4 s1a = *(const f32x4*)(sh + A_IN + c0), s1b = *(const f32x4*)(sh + A_IN + c0 + 4);
#pragma unroll
            for (int e = 0; e < 8; ++e) v[e] = (e < 4 ? s1a[e] : s1b[e - 4]) * bf2f((bf16_t)zc[e]);
            if (t > 0) { const bf16x8 zp = *(const bf16x8*)(z - ZP); const f32x4 a = *(const f32x4*)(sh + c0), b = *(const f32x4*)(sh + c0 + 4);
#pragma unroll
                for (int e = 0; e < 8; ++e) v[e] += (e < 4 ? a[e] : b[e - 4]) * bf2f((bf16_t)zp[e]); }
            if (t < len - 1) { const bf16x8 zn = *(const bf16x8*)(z + ZP); const f32x4 a = *(const f32x4*)(sh + 2 * A_IN + c0), b = *(const f32x4*)(sh + 2 * A_IN + c0 + 4);
#pragma unroll
                for (int e = 0; e < 8; ++e) v[e] += (e < 4 ? a[e] : b[e - 4]) * bf2f((bf16_t)zn[e]); }
        }
        float nrm = 0.f;
        if (ch >= 32 && ch < 64) {
#pragma unroll
            for (int e = 0; e < 8; ++e) { const float t2 = v[e] * p.a_k_k[l * DA + c0 - 256 + e]; nrm += t2 * t2; } }
        nrm = sum8(nrm);
        if (!act) continue;
        if (c0 < 768) {
            float* dst = (c0 < 256 ? p.sR + (size_t)m * DA + c0 : c0 < 512 ? p.kT + (size_t)m * DA + c0 - 256 : p.sV + (size_t)m * DA + c0 - 512);
            *(f32x4*)dst = (f32x4){v[0], v[1], v[2], v[3]}; *(f32x4*)(dst + 4) = (f32x4){v[4], v[5], v[6], v[7]};
            if (ch >= 32 && ch < 64 && (ch & 7) == 0) p.kN[(size_t)m * 4 + ((ch - 32) >> 3)] = 1.0f / sqrtf(nrm + 1e-12f);
        } else {
            if (c0 < 896) {
#pragma unroll
                for (int e = 0; e < 8; ++e) v[e] = tanh_fast(v[e]); }
            else if (c0 >= 1024) {
#pragma unroll
                for (int e = 0; e < 8; ++e) v[e] = 1.0f / (1.0f + __expf(-v[e])); }
            uint4 o; o.x = pk2(v[0], v[1]); o.y = pk2(v[2], v[3]); o.z = pk2(v[4], v[5]); o.w = pk2(v[6], v[7]);
            *(uint4*)(p.LA + (size_t)m * 416 + c0 - 768) = o;
        }
    }
}
__device__ __forceinline__ void g_streams_s2(const Params& p, int l, char* lds) {
    const int tid_ = opq_tid(), bid_ = opq_bid(); (void)tid_; (void)bid_;
    constexpr int MT = T / 128;
    for (int job = bid_; job < 5 * MT * 2; job += gridDim.x) {
        const int type = job / (MT * 2), r = job % (MT * 2), tm = r >> 1, tn = r & 1;
        const int coff = type < 2 ? type * 64 : type < 4 ? 128 + (type - 2) * 64 : 256, K = type < 4 ? 64 : 160, d = type & 1;
        const bf16_t* Bt = type < 2 ? p.wupT + type * 256 * 64 : type < 4 ? p.aupT + (type - 2) * 256 * 64 : p.gupT;
        const bf16_t* a0 = p.LA + (size_t)(tm * 128 + STG_ROW(0)) * 416 + coff + STG_K; const bf16_t* a1 = p.LA + (size_t)(tm * 128 + STG_ROW(1)) * 416 + coff + STG_K;
        const bf16_t* b0 = Bt + (size_t)(tn * 128 + STG_ROW(0)) * K + STG_K; const bf16_t* b1 = Bt + (size_t)(tn * 128 + STG_ROW(1)) * K + STG_K;
        if (type < 2) gemm_tile(a0, a1, b0, b1, K, lds, [&](const f32x4 (&acc)[4][4], int wr, int wc, int fr, int fq) {
#pragma unroll
            for (int mi = 0; mi < 4; ++mi) {
#pragma unroll
                for (int n = 0; n < 4; ++n) { const int c = tn * 128 + wc * 64 + n * 16 + fr; const float w0 = p.a_w0[(l * 2 + d) * DA + c];
#pragma unroll
                    for (int j = 0; j < 4; ++j) { const int row = tm * 128 + wr * 64 + mi * 16 + fq * 4 + j;
                        const float e = __expf(-(w0 + acc[mi][n][j]));
                        p.sW[((size_t)d * T + row) * DA + c] = __expf(-0.60653065971f / (1.0f + e)); } }
                asm volatile("" ::: "memory"); }
        });
        else if (type < 4) gemm_tile(a0, a1, b0, b1, K, lds, [&](const f32x4 (&acc)[4][4], int wr, int wc, int fr, int fq) {
#pragma unroll
            for (int mi = 0; mi < 4; ++mi) {
#pragma unroll
                for (int n = 0; n < 4; ++n) { const int c = tn * 128 + wc * 64 + n * 16 + fr;
                    const float a0v = p.a_a0[(l * 2 + d) * DA + c], kkc = p.a_k_k[l * DA + c], kac = p.a_k_a[l * DA + c];
#pragma unroll
                    for (int j = 0; j < 4; ++j) { const int row = tm * 128 + wr * 64 + mi * 16 + fq * 4 + j;
                        const size_t o = (size_t)row * DA + c, od = ((size_t)d * T + row) * DA + c;
                        const float av = 1.0f / (1.0f + __expf(-(a0v + acc[mi][n][j]))); const float k = p.kT[o];
                        const float kk = k * kkc * p.kN[(size_t)row * 4 + (c >> 6)];
                        p.sKD[od] = k * (1.0f + (av - 1.0f) * kac); p.sB[od] = kk * av; if (d == 0) p.sKK[o] = kk; } }
                asm volatile("" ::: "memory"); }
        });
        else gemm_tile(a0, a1, b0, b1, K, lds, [&](const f32x4 (&acc)[4][4], int wr, int wc, int fr, int fq) {
#pragma unroll
            for (int mi = 0; mi < 4; ++mi)
#pragma unroll
                for (int n = 0; n < 4; ++n) { const int c = tn * 128 + wc * 64 + n * 16 + fr;
#pragma unroll
                    for (int j = 0; j < 4; ++j) p.sG[(size_t)(tm * 128 + wr * 64 + mi * 16 + fq * 4 + j) * DA + c] = acc[mi][n][j]; }
        });
    }
}


typedef float f32x16 __attribute__((ext_vector_type(16)));
typedef short s16x4 __attribute__((ext_vector_type(4)));
typedef unsigned u32x4_t __attribute__((ext_vector_type(4)));
typedef float f32x2_t __attribute__((ext_vector_type(2)));
typedef __bf16 bf16x2_t __attribute__((ext_vector_type(2)));
__device__ __forceinline__ unsigned cvtpk(float lo, float hi) { f32x2_t v = {lo, hi}; bf16x2_t b = __builtin_convertvector(v, bf16x2_t); return __builtin_bit_cast(unsigned, b); }
__device__ __forceinline__ int crow(int r, int hi) { return (r & 3) + 8 * (r >> 2) + 4 * hi; }

template <class MaskF>
__device__ __forceinline__ void attn_tile(const bf16x8 (&qf)[4], const bf16_t* krow, const bf16_t* vt0, const bf16_t* vt1, const MaskF& mask,
                                          float& m_run, float& l_run, f32x16& o0, f32x16& o1, int hi) {
    f32x16 s;
#pragma unroll
    for (int r = 0; r < 16; ++r) s[r] = 0.f;
#pragma unroll
    for (int ks = 0; ks < 4; ++ks) { const bf16x8 kf = *(const bf16x8*)(krow + 16 * ks); s = __builtin_amdgcn_mfma_f32_32x32x16_bf16(kf, qf[ks], s, 0, 0, 0); }
    float mx = -INFINITY;
#pragma unroll
    for (int r = 0; r < 16; ++r) { s[r] = mask(crow(r, hi), s[r] * ATT_SCALE); mx = fmaxf(mx, s[r]); }
    mx = fmaxf(mx, __shfl_xor(mx, 32));
    const float mn = fmaxf(m_run, mx), alpha = __expf(m_run - mn);
    m_run = mn;
    float ps = 0.f;
#pragma unroll
    for (int r = 0; r < 16; ++r) { s[r] = __expf(s[r] - mn); ps += s[r]; }
    l_run = l_run * alpha + ps;
#pragma unroll
    for (int r = 0; r < 16; ++r) { o0[r] *= alpha; o1[r] *= alpha; }
#pragma unroll
    for (int s2 = 0; s2 < 2; ++s2) {
        u32x4_t pw; pw[0] = cvtpk(s[8 * s2], s[8 * s2 + 1]); pw[1] = cvtpk(s[8 * s2 + 2], s[8 * s2 + 3]); pw[2] = cvtpk(s[8 * s2 + 4], s[8 * s2 + 5]); pw[3] = cvtpk(s[8 * s2 + 6], s[8 * s2 + 7]);
        const bf16x8 pb = __builtin_bit_cast(bf16x8, pw);
        const s16x4 a0 = *(const s16x4*)(vt0 + 16 * s2), a1 = *(const s16x4*)(vt0 + 16 * s2 + 8);
        const s16x4 c0 = *(const s16x4*)(vt1 + 16 * s2), c1 = *(const s16x4*)(vt1 + 16 * s2 + 8);
        o0 = __builtin_amdgcn_mfma_f32_32x32x16_bf16(__builtin_shufflevector(a0, a1, 0, 1, 2, 3, 4, 5, 6, 7), pb, o0, 0, 0, 0);
        o1 = __builtin_amdgcn_mfma_f32_32x32x16_bf16(__builtin_shufflevector(c0, c1, 0, 1, 2, 3, 4, 5, 6, 7), pb, o1, 0, 0, 0);
    }
}
struct NoMask { __device__ __forceinline__ float operator()(int, float v) const { return v; } };

__device__ __forceinline__ void ph_attn_mfma(const Params& p, int l, bool with_ctx) {
    const int tid_ = opq_tid(), bid_ = opq_bid(); (void)tid_; (void)bid_;
    const int lane = tid_ & 63, hi = lane >> 5, ql = lane & 31;
    const int gw = bid_ * 4 + (tid_ >> 6), nw = gridDim.x * 4;
    constexpr int NQT = S / 32, NCT = L / 32, N_LAT = NB * 6 * NQT, N_CTX = NB * 6 * NCT;
    const int ntask = 2 * N_LAT + (with_ctx ? 2 * N_CTX : 0);
    for (int task = gw; task < ntask; task += nw) {
        bool isC, isCtx; int r;
        if (task < N_LAT) { isC = true; isCtx = false; r = task; }
        else if (task < 2 * N_LAT) { isC = false; isCtx = false; r = task - N_LAT; }
        else { r = task - 2 * N_LAT; isCtx = true; isC = r >= N_CTX; if (isC) r -= N_CTX; }
        const int nqt = isCtx ? NCT : NQT, qt = r % nqt, h = (r / nqt) % 6, b = r / (nqt * 6);
        const int m = isCtx ? TL + b * L + 32 * qt + ql : b * S + 32 * qt + ql;
        const int qcol = isC ? ZQN + h * 64 : ZQB + h * 64, kcol = isC ? ZKN + h * 64 : ZKB + (h / 3) * 64, hv = isC ? 2 + h : h / 3;
        bf16x8 qf[4];
        { const bf16_t* qp = p.Z + (size_t)m * ZP + qcol + 8 * hi;
#pragma unroll
          for (int ks = 0; ks < 4; ++ks) qf[ks] = *(const bf16x8*)(qp + 16 * ks); }
        const bf16_t* kc0 = p.Z + (size_t)(TL + b * L + ql) * ZP + kcol + 8 * hi;
        const bf16_t* kl0 = p.Z + (size_t)(b * S + ql) * ZP + kcol + 8 * hi;
        const bf16_t* vt0 = p.VT + ((size_t)(b * 8 + hv) * 64 + ql) * PU + 4 * hi; const bf16_t* vt1 = vt0 + (size_t)32 * PU;
        f32x16 o0, o1;
#pragma unroll
        for (int rr = 0; rr < 16; ++rr) { o0[rr] = 0.f; o1[rr] = 0.f; }
        float m_run, l_run;
        if (isC) { m_run = -1e30f; l_run = 0.f; } else { m_run = p.b_sink[l * 6 + h]; l_run = hi == 0 ? 1.0f : 0.f; }
#pragma unroll 1
        for (int i = 0; i < NCT; ++i) attn_tile(qf, kc0 + (size_t)(32 * i) * ZP, vt0 + 32 * i, vt1 + 32 * i, NoMask(), m_run, l_run, o0, o1, hi);
        if (!isCtx) {
            if (!isC) {
#pragma unroll 1
                for (int jt = qt - 4; jt <= qt + 4; ++jt) {
                    if (jt < 0 || jt >= NQT) continue;
                    const bf16_t* kr = kl0 + (size_t)(32 * jt) * ZP; const bf16_t* v0 = vt0 + L + 32 * jt; const bf16_t* v1 = vt1 + L + 32 * jt;
                    if (jt == qt - 4 || jt == qt + 4) { const int base = 32 * (jt - qt) - ql;
                        attn_tile(qf, kr, v0, v1, [&](int ko, float v) { const int rel = base + ko; return (rel >= -128 && rel <= 128) ? v : -INFINITY; }, m_run, l_run, o0, o1, hi); }
                    else attn_tile(qf, kr, v0, v1, NoMask(), m_run, l_run, o0, o1, hi);
                }
            } else {
                constexpr int ROWS = S / GRID_W;
                const int gr = qt >> 1, c = 32 * (qt & 1) + ql;
                int r0 = gr - 4; r0 = r0 < 0 ? 0 : (r0 > ROWS - 8 ? ROWS - 8 : r0);
                int c0 = c - 8; c0 = c0 < 0 ? 0 : (c0 > GRID_W - 16 ? GRID_W - 16 : c0);
                const float* rpb = p.c_rpb + ((size_t)l * 6 + h) * 15 * 31;
#pragma unroll 1
                for (int a = 0; a < 8; ++a) {
                    const int kr_ = r0 + a; const float* rp = rpb + (kr_ - gr + 7) * 31 + 15 - c;
#pragma unroll 1
                    for (int ct = 0; ct < 2; ++ct) {
                        const int t0 = kr_ * GRID_W + 32 * ct;
                        attn_tile(qf, kl0 + (size_t)t0 * ZP, vt0 + L + t0, vt1 + L + t0,
                                  [&](int ko, float v) { const int kc = 32 * ct + ko; return (kc >= c0 && kc < c0 + 16) ? v + rp[kc] : -INFINITY; }, m_run, l_run, o0, o1, hi);
                    }
                }
            }
        }
        const float lt = l_run + __shfl_xor(l_run, 32), inv = 1.0f / lt;
        bf16_t* op = p.MIX + (size_t)m * DMIX + (isC ? 640 : 256) + h * 64 + 4 * hi;
#pragma unroll
        for (int g = 0; g < 4; ++g) {
            st_bf16x4(op + 8 * g, (f32x4){o0[4 * g] * inv, o0[4 * g + 1] * inv, o0[4 * g + 2] * inv, o0[4 * g + 3] * inv});
            st_bf16x4(op + 32 + 8 * g, (f32x4){o1[4 * g] * inv, o1[4 * g + 1] * inv, o1[4 * g + 2] * inv, o1[4 * g + 3] * inv});
        }
    }
}


template <class MaskF>
__device__ __forceinline__ void attn_tile_lds(const bf16x8 (&qf)[4], const char* ks, const char* vs, const MaskF& mask, float& m_run, float& l_run, f32x16& o0, f32x16& o1, int ql, int hi) {
    f32x16 s;
#pragma unroll
    for (int r = 0; r < 16; ++r) s[r] = 0.f;
#pragma unroll
    for (int k4 = 0; k4 < 4; ++k4) { const bf16x8 kf = *(const bf16x8*)(ks + ql * 128 + (((2 * k4 + hi) ^ (ql & 7)) * 16)); s = __builtin_amdgcn_mfma_f32_32x32x16_bf16(kf, qf[k4], s, 0, 0, 0); }
    float mx = -INFINITY;
#pragma unroll
    for (int r = 0; r < 16; ++r) { s[r] = mask(crow(r, hi), s[r] * ATT_SCALE); mx = fmaxf(mx, s[r]); }
    mx = fmaxf(mx, __shfl_xor(mx, 32));
    const float mn = fmaxf(m_run, mx), alpha = __expf(m_run - mn);
    m_run = mn;
    float ps = 0.f;
#pragma unroll
    for (int r = 0; r < 16; ++r) { s[r] = __expf(s[r] - mn); ps += s[r]; }
    l_run = l_run * alpha + ps;
#pragma unroll
    for (int r = 0; r < 16; ++r) { o0[r] *= alpha; o1[r] *= alpha; }
    const int sw0 = (ql >> 2) & 3;
#pragma unroll
    for (int s2 = 0; s2 < 2; ++s2) {
        u32x4_t pw; pw[0] = cvtpk(s[8 * s2], s[8 * s2 + 1]); pw[1] = cvtpk(s[8 * s2 + 2], s[8 * s2 + 3]); pw[2] = cvtpk(s[8 * s2 + 4], s[8 * s2 + 5]); pw[3] = cvtpk(s[8 * s2 + 6], s[8 * s2 + 7]);
        const bf16x8 pb = __builtin_bit_cast(bf16x8, pw);
        const char* v0 = vs + ql * 64 + 8 * hi; const char* v1 = v0 + 32 * 64;
        const s16x4 a0 = *(const s16x4*)(v0 + (((2 * s2) ^ sw0) * 16)), a1 = *(const s16x4*)(v0 + (((2 * s2 + 1) ^ sw0) * 16));
        const s16x4 c0 = *(const s16x4*)(v1 + (((2 * s2) ^ sw0) * 16)), c1 = *(const s16x4*)(v1 + (((2 * s2 + 1) ^ sw0) * 16));
        o0 = __builtin_amdgcn_mfma_f32_32x32x16_bf16(__builtin_shufflevector(a0, a1, 0, 1, 2, 3, 4, 5, 6, 7), pb, o0, 0, 0, 0);
        o1 = __builtin_amdgcn_mfma_f32_32x32x16_bf16(__builtin_shufflevector(c0, c1, 0, 1, 2, 3, 4, 5, 6, 7), pb, o1, 0, 0, 0);
    }
}

__device__ __forceinline__ void ph_attn_blk(const Params& p, int l, bool with_ctx, int first_blk, char* lds) {
    const int tid_ = opq_tid(), bid_ = opq_bid(); (void)tid_; (void)bid_;
    if (bid_ < first_blk) return;
    const int lane = tid_ & 63, hi = lane >> 5, ql = lane & 31, wid = tid_ >> 6;
    constexpr int NQG = S / 128, NCG = L / 128, ROWS = S / GRID_W, N_LAT = NB * 6 * NQG, N_CTX = NB * 6 * NCG, TPB = (S + L) / 32;
    const int ntask = 2 * N_LAT + (with_ctx ? 2 * N_CTX : 0);
    const int krow = tid_ >> 3, kch = (tid_ & 7) ^ (krow & 7), vrow = tid_ >> 2, vpc = (tid_ & 3) ^ ((vrow >> 2) & 3);
    for (int task = bid_ - first_blk; task < ntask; task += gridDim.x - first_blk) {
        bool isC, isCtx; int r;
        if (task < N_LAT) { isC = true; isCtx = false; r = task; }
        else if (task < 2 * N_LAT) { isC = false; isCtx = false; r = task - N_LAT; }
        else { r = task - 2 * N_LAT; isCtx = true; isC = r >= N_CTX; if (isC) r -= N_CTX; }
        const int ng = isCtx ? NCG : NQG, g = r % ng, h = (r / ng) % 6, b = r / (ng * 6);
        const int qt = 4 * g + wid;
        const int m = isCtx ? TL + b * L + 32 * qt + ql : b * S + 32 * qt + ql;
        const int qcol = isC ? ZQN + h * 64 : ZQB + h * 64, kcol = isC ? ZKN + h * 64 : ZKB + (h / 3) * 64, hv = isC ? 2 + h : h / 3;
        bf16x8 qf[4];
        { const bf16_t* qp = p.Z + (size_t)m * ZP + qcol + 8 * hi;
#pragma unroll
          for (int k4 = 0; k4 < 4; ++k4) qf[k4] = *(const bf16x8*)(qp + 16 * k4); }
        int lo = 0, hi_t = 0, gr0 = 0;
        if (!isCtx) {
            if (!isC) { lo = 4 * g - 4; hi_t = 4 * g + 8; lo = lo < 0 ? 0 : lo; hi_t = hi_t > S / 32 ? S / 32 : hi_t; }
            else { const int ra = 2 * g, rb = 2 * g + 1; int r0a = ra - 4; r0a = r0a < 0 ? 0 : (r0a > ROWS - 8 ? ROWS - 8 : r0a); int r0b = rb - 4; r0b = r0b < 0 ? 0 : (r0b > ROWS - 8 ? ROWS - 8 : r0b);
                   lo = 2 * r0a; hi_t = 2 * (r0b + 8); gr0 = 0; }
        }
        const int ntile = L / 32 + (hi_t - lo);
        const bf16_t* kbase = p.Z + (size_t)krow * ZP + kcol + 8 * kch;
        const bf16_t* vbase = p.VT + ((size_t)(b * 8 + hv) * 64 + vrow) * PU + 8 * vpc;
#define AT_TOK(i_) ((i_) < L / 32 ? 32 * (i_) : L + 32 * (lo + (i_) - L / 32))
#define AT_STAGE(i_) do { const int u0_ = AT_TOK(i_); const int zrow_ = u0_ < L ? TL + b * L + u0_ : b * S + (u0_ - L); char* sl_ = lds + ((i_) % 3) * 8192 + tid_ * 16; \
            __builtin_amdgcn_global_load_lds((const unsigned*)(kbase + (size_t)zrow_ * ZP), (__attribute__((address_space(3))) unsigned*)(sl_), 16, 0, 0); \
            __builtin_amdgcn_global_load_lds((const unsigned*)(vbase + u0_), (__attribute__((address_space(3))) unsigned*)(sl_ + 4096), 16, 0, 0); } while (0)
        f32x16 o0, o1;
#pragma unroll
        for (int rr = 0; rr < 16; ++rr) { o0[rr] = 0.f; o1[rr] = 0.f; }
        float m_run, l_run;
        if (isC) { m_run = -1e30f; l_run = 0.f; } else { m_run = p.b_sink[l * 6 + h]; l_run = hi == 0 ? 1.0f : 0.f; }
        const int gr = qt >> 1, c = 32 * (qt & 1) + ql;
        int r0 = gr - 4; r0 = r0 < 0 ? 0 : (r0 > ROWS - 8 ? ROWS - 8 : r0);
        int c0 = c - 8; c0 = c0 < 0 ? 0 : (c0 > GRID_W - 16 ? GRID_W - 16 : c0);
        float* rpb = (float*)(lds + 24576);
        if (isC && !isCtx) for (int i = tid_; i < 15 * 31; i += 256) rpb[i] = p.c_rpb[((size_t)l * 6 + h) * 15 * 31 + i];
        AT_STAGE(0);
        if (ntile > 1) AT_STAGE(1);
#pragma unroll 1
        for (int i = 0; i < ntile; ++i) {
            if (i + 1 < ntile) asm volatile("s_waitcnt vmcnt(2)" ::: "memory"); else asm volatile("s_waitcnt vmcnt(0)" ::: "memory");
            asm volatile("s_waitcnt lgkmcnt(0)" ::: "memory");
            __builtin_amdgcn_s_barrier();
            if (i + 2 < ntile) AT_STAGE(i + 2);
            const char* ks = lds + (i % 3) * 8192; const char* vs = ks + 4096;
            if (i < L / 32) attn_tile_lds(qf, ks, vs, NoMask(), m_run, l_run, o0, o1, ql, hi);
            else {
                const int jt = lo + i - L / 32;
                if (!isC) {
                    const int dq = jt - qt;
                    if (dq >= -3 && dq <= 3) attn_tile_lds(qf, ks, vs, NoMask(), m_run, l_run, o0, o1, ql, hi);
                    else if (dq == -4 || dq == 4) { const int base = 32 * dq - ql;
                        attn_tile_lds(qf, ks, vs, [&](int ko, float v) { const int rel = base + ko; return (rel >= -128 && rel <= 128) ? v : -INFINITY; }, m_run, l_run, o0, o1, ql, hi); }
                } else {
                    const int kr_ = jt >> 1, ct = jt & 1;
                    if (kr_ >= r0 && kr_ < r0 + 8) { const float* rp = rpb + (kr_ - gr + 7) * 31 + 15 - c;
                        attn_tile_lds(qf, ks, vs, [&](int ko, float v) { const int kc = 32 * ct + ko; return (kc >= c0 && kc < c0 + 16) ? v + rp[kc] : -INFINITY; }, m_run, l_run, o0, o1, ql, hi); }
                }
            }
        }
        asm volatile("s_waitcnt lgkmcnt(0)" ::: "memory");
        __builtin_amdgcn_s_barrier();
#undef AT_STAGE
#undef AT_TOK
        (void)gr0;
        const float lt = l_run + __shfl_xor(l_run, 32), inv = 1.0f / lt;
        bf16_t* op = p.MIX + (size_t)m * DMIX + (isC ? 640 : 256) + h * 64 + 4 * hi;
#pragma unroll
        for (int gq = 0; gq < 4; ++gq) {
            st_bf16x4(op + 8 * gq, (f32x4){o0[4 * gq] * inv, o0[4 * gq + 1] * inv, o0[4 * gq + 2] * inv, o0[4 * gq + 3] * inv});
            st_bf16x4(op + 32 + 8 * gq, (f32x4){o1[4 * gq] * inv, o1[4 * gq + 1] * inv, o1[4 * gq + 2] * inv, o1[4 * gq + 3] * inv});
        }
    }
}

#define RNB " row_newbcast:%c[n] row_mask:0xf bank_mask:0xf\n\t"
template <int N, bool FIRST>
__device__ __forceinline__ void dpp_dot4(float& a0, float& a1, float& a2, float& a3, const f32x4& v, float s0, float s1, float s2, float s3) {
    if (FIRST) asm volatile("s_nop 1");
    asm("v_fmac_f32_dpp %0, %4, %8" RNB "v_fmac_f32_dpp %1, %5, %9" RNB "v_fmac_f32_dpp %2, %6, %10" RNB "v_fmac_f32_dpp %3, %7, %11" RNB
        : "+v"(a0), "+v"(a1), "+v"(a2), "+v"(a3) : "v"(v[0]), "v"(v[1]), "v"(v[2]), "v"(v[3]), "v"(s0), "v"(s1), "v"(s2), "v"(s3), [n] "i"(N));
}
template <int N, bool FIRST>
__device__ __forceinline__ void dpp_upd4s(float& s0, float& s1, float& s2, float& s3, float& y0, float& y1, float& y2, float& y3,
                                          const f32x4& w, const f32x4& b, const f32x4& kd, const f32x4& r, float nsk, float vv) {
    if (FIRST) asm volatile("s_nop 1");
    asm("v_mul_f32_dpp %0, %8, %0" RNB "v_mul_f32_dpp %1, %9, %1" RNB "v_mul_f32_dpp %2, %10, %2" RNB "v_mul_f32_dpp %3, %11, %3" RNB
        "v_fmac_f32_dpp %0, %12, %24" RNB "v_fmac_f32_dpp %1, %13, %24" RNB "v_fmac_f32_dpp %2, %14, %24" RNB "v_fmac_f32_dpp %3, %15, %24" RNB
        "v_fmac_f32_dpp %0, %16, %25" RNB "v_fmac_f32_dpp %1, %17, %25" RNB "v_fmac_f32_dpp %2, %18, %25" RNB "v_fmac_f32_dpp %3, %19, %25" RNB
        "v_fmac_f32_dpp %4, %20, %0" RNB "v_fmac_f32_dpp %5, %21, %1" RNB "v_fmac_f32_dpp %6, %22, %2" RNB "v_fmac_f32_dpp %7, %23, %3" RNB
        : "+v"(s0), "+v"(s1), "+v"(s2), "+v"(s3), "+v"(y0), "+v"(y1), "+v"(y2), "+v"(y3)
        : "v"(w[0]), "v"(w[1]), "v"(w[2]), "v"(w[3]), "v"(b[0]), "v"(b[1]), "v"(b[2]), "v"(b[3]), "v"(kd[0]), "v"(kd[1]), "v"(kd[2]), "v"(kd[3]),
          "v"(r[0]), "v"(r[1]), "v"(r[2]), "v"(r[3]), "v"(nsk), "v"(vv), [n] "i"(N));
}
template <int N, bool FIRST>
__device__ __forceinline__ void dpp_upd4p(float& s0, float& s1, float& s2, float& s3, float& y0, float& y1, float& y2, float& y3,
                                          const f32x4& w, const f32x4& b, const f32x4& r, float nsk) {
    if (FIRST) asm volatile("s_nop 1");
    asm("v_mul_f32_dpp %0, %8, %0" RNB "v_mul_f32_dpp %1, %9, %1" RNB "v_mul_f32_dpp %2, %10, %2" RNB "v_mul_f32_dpp %3, %11, %3" RNB
        "v_fmac_f32_dpp %0, %12, %20" RNB "v_fmac_f32_dpp %1, %13, %20" RNB "v_fmac_f32_dpp %2, %14, %20" RNB "v_fmac_f32_dpp %3, %15, %20" RNB
        "v_fmac_f32_dpp %4, %16, %0" RNB "v_fmac_f32_dpp %5, %17, %1" RNB "v_fmac_f32_dpp %6, %18, %2" RNB "v_fmac_f32_dpp %7, %19, %3" RNB
        : "+v"(s0), "+v"(s1), "+v"(s2), "+v"(s3), "+v"(y0), "+v"(y1), "+v"(y2), "+v"(y3)
        : "v"(w[0]), "v"(w[1]), "v"(w[2]), "v"(w[3]), "v"(b[0]), "v"(b[1]), "v"(b[2]), "v"(b[3]), "v"(r[0]), "v"(r[1]), "v"(r[2]), "v"(r[3]), "v"(nsk), [n] "i"(N));
}
template <int N> struct ScanRep {
    static __device__ __forceinline__ void dot(float& a0, float& a1, float& a2, float& a3, const f32x4& v, const float (&st)[64]) {
        dpp_dot4<N, N == 0>(a0, a1, a2, a3, v, st[4 * N], st[4 * N + 1], st[4 * N + 2], st[4 * N + 3]);
        if constexpr (N < 15) ScanRep<N + 1>::dot(a0, a1, a2, a3, v, st);
    }
    static __device__ __forceinline__ void upds(float (&st)[64], float& y0, float& y1, float& y2, float& y3, const f32x4& w, const f32x4& b, const f32x4& kd, const f32x4& r, float nsk, float vv) {
        dpp_upd4s<N, N == 0>(st[4 * N], st[4 * N + 1], st[4 * N + 2], st[4 * N + 3], y0, y1, y2, y3, w, b, kd, r, nsk, vv);
        if constexpr (N < 15) ScanRep<N + 1>::upds(st, y0, y1, y2, y3, w, b, kd, r, nsk, vv);
    }
    static __device__ __forceinline__ void updp(float (&st)[64], float& y0, float& y1, float& y2, float& y3, const f32x4& w, const f32x4& b, const f32x4& r, float nsk) {
        dpp_upd4p<N, N == 0>(st[4 * N], st[4 * N + 1], st[4 * N + 2], st[4 * N + 3], y0, y1, y2, y3, w, b, r, nsk);
        if constexpr (N < 15) ScanRep<N + 1>::updp(st, y0, y1, y2, y3, w, b, r, nsk);
    }
};
__device__ __forceinline__ int seg_row0(int b, int d, int s) { const int pos0 = 128 * s; return pos0 < L ? TL + b * L + (d ? L - 1 - pos0 : pos0) : b * S + (d ? S - 1 - (pos0 - L) : pos0 - L); }

template <bool ISP>
__device__ __forceinline__ void scan_task(const Params& p, int c, int s, int lane) {
    const int h = c & 3, b = (c >> 2) % NB, d = (c >> 2) / NB;
    const int m0 = seg_row0(b, d, s); const long step = d ? -(long)DA : (long)DA;
    const size_t o = (size_t)m0 * DA + h * 64, od = ((size_t)d * T + m0) * DA + h * 64; const int q = 4 * (lane & 15);
    const float* pkk = p.sKK + o + q; const float* pr = p.sR + o + q; const float* pw = p.sW + od + q; const float* pb = p.sB + od + q;
    const float* pkd = p.sKD + od + q; const float* pv = p.sV + o + lane;
    float* py = (ISP ? p.PV : p.Y) + od + lane;
    float st[64];
#pragma unroll
    for (int k = 0; k < 64; ++k) st[k] = (ISP && k == lane) ? 1.0f : 0.f;
    f32x4 kk = *(const f32x4*)pkk, w = *(const f32x4*)pw, bb = *(const f32x4*)pb, r = *(const f32x4*)pr, kd = w; float vv = 0.f;
    if (!ISP) { kd = *(const f32x4*)pkd; vv = *pv; }
#pragma unroll 1
    for (int i = 0; i < 128; ++i) {
        const long nx = (i < 127) ? step : 0;
        pkk += nx; pw += nx; pb += nx; pr += nx; pkd += nx; pv += nx;
        const f32x4 nkk = *(const f32x4*)pkk, nw = *(const f32x4*)pw, nb = *(const f32x4*)pb, nr = *(const f32x4*)pr;
        f32x4 nkd = nw; float nv = 0.f;
        if (!ISP) { nkd = *(const f32x4*)pkd; nv = *pv; }
        float a0 = 0.f, a1 = 0.f, a2 = 0.f, a3 = 0.f;
        ScanRep<0>::dot(a0, a1, a2, a3, kk, st);
        const float nsk = -((a0 + a1) + (a2 + a3));
        float y0 = 0.f, y1 = 0.f, y2 = 0.f, y3 = 0.f;
        if (ISP) ScanRep<0>::updp(st, y0, y1, y2, y3, w, bb, r, nsk); else ScanRep<0>::upds(st, y0, y1, y2, y3, w, bb, kd, r, nsk, vv);
        *py = (y0 + y1) + (y2 + y3); py += step;
        kk = nkk; w = nw; bb = nb; r = nr; kd = nkd; vv = nv;
    }
    if (s < NSG - 1) {
        float* dst = (ISP ? p.PS : p.QS) + (((size_t)c * NSG + s) * 64 + lane) * 64;
#pragma unroll
        for (int k4 = 0; k4 < 16; ++k4) *(f32x4*)(dst + 4 * k4) = (f32x4){st[4 * k4], st[4 * k4 + 1], st[4 * k4 + 2], st[4 * k4 + 3]};
    }
}
__device__ __forceinline__ void ph_scan_fast(const Params& p) {
    const int tid_ = opq_tid(), bid_ = opq_bid(); (void)tid_; (void)bid_;
    const int lane = tid_ & 63, gw = bid_ * 4 + (tid_ >> 6), nw = gridDim.x * 4;
    constexpr int NS_T = 64 * NSG, NP_T = 64 * (NSG - 1);
    const int G = gridDim.x, wv = tid_ >> 6; (void)gw; (void)nw;
    for (int tsk = wv * G + bid_; tsk < NS_T + NP_T; tsk += 4 * G) {
        const int t2 = __builtin_amdgcn_readfirstlane(tsk);
        if (t2 < NS_T) scan_task<false>(p, t2 & 63, t2 >> 6, lane);
        else scan_task<true>(p, (t2 - NS_T) & 63, 1 + ((t2 - NS_T) >> 6), lane);
    }
}
__device__ __forceinline__ void ph_combine(const Params& p, char* lds) {
    const int tid_ = opq_tid(), bid_ = opq_bid(); (void)tid_; (void)bid_; (void)lds;
    if (bid_ >= 64) return;
    const int lane = tid_ & 63, c = bid_, cb = tid_ >> 6, q = lane >> 4, i16 = lane & 15, v = 16 * cb + i16;
    const float* QSc = p.QS + (size_t)c * NSG * 4096; const float* PSc = p.PS + (size_t)c * NSG * 4096; float* SSg = p.SS + (size_t)c * NSG * 4096;
    f32x4 acc[4];
#pragma unroll
    for (int ro = 0; ro < 4; ++ro) acc[ro] = *(const f32x4*)(QSc + v * 64 + 16 * ro + 4 * q);
#pragma unroll 1
    for (int s = 1; s < NSG; ++s) {
#pragma unroll
        for (int ro = 0; ro < 4; ++ro)
#pragma unroll
            for (int j = 0; j < 4; ++j) SSg[(size_t)s * 4096 + (16 * ro + 4 * q + j) * 64 + v] = acc[ro][j];
        if (s == NSG - 1) break;
        const float* P = PSc + (size_t)s * 4096 + (4 * q) * 64 + i16;
        float a[4][4][4];
#pragma unroll
        for (int rb = 0; rb < 4; ++rb)
#pragma unroll
            for (int kk = 0; kk < 4; ++kk)
#pragma unroll
                for (int ro = 0; ro < 4; ++ro) a[rb][kk][ro] = P[(16 * rb + kk) * 64 + 16 * ro];
#pragma unroll
        for (int rb = 0; rb < 4; ++rb) asm volatile("" : "+v"(a[rb][0][0]), "+v"(a[rb][0][1]), "+v"(a[rb][0][2]), "+v"(a[rb][0][3]), "+v"(a[rb][1][0]), "+v"(a[rb][1][1]), "+v"(a[rb][1][2]), "+v"(a[rb][1][3]),
                                                         "+v"(a[rb][2][0]), "+v"(a[rb][2][1]), "+v"(a[rb][2][2]), "+v"(a[rb][2][3]), "+v"(a[rb][3][0]), "+v"(a[rb][3][1]), "+v"(a[rb][3][2]), "+v"(a[rb][3][3]));
        f32x4 nacc[4];
#pragma unroll
        for (int ro = 0; ro < 4; ++ro) nacc[ro] = *(const f32x4*)(QSc + (size_t)s * 4096 + v * 64 + 16 * ro + 4 * q);
#pragma unroll
        for (int rb = 0; rb < 4; ++rb)
#pragma unroll
            for (int kk = 0; kk < 4; ++kk)
#pragma unroll
                for (int ro = 0; ro < 4; ++ro) nacc[ro] = __builtin_amdgcn_mfma_f32_16x16x4f32(a[rb][kk][ro], acc[rb][kk], nacc[ro], 0, 0, 0);
#pragma unroll
        for (int ro = 0; ro < 4; ++ro) acc[ro] = nacc[ro];
    }
}
__device__ __forceinline__ void ph_rwkv_out_fast(const Params& p, int l, bool with_ctx) {
    const int tid_ = opq_tid(), bid_ = opq_bid(); (void)tid_; (void)bid_;
    const int lane = tid_ & 63, gw = bid_ * 4 + (tid_ >> 6), nw = gridDim.x * 4;
    constexpr int TOK = 16, NLT = NB * (S / TOK) * 4, NCTK = NB * (L / TOK) * 4;
    const int ntask = NLT + (with_ctx ? NCTK : 0);
    for (int tsk = gw; tsk < ntask; tsk += nw) {
        const bool isCtx = tsk >= NLT; const int r = isCtx ? tsk - NLT : tsk;
        const int h = r & 3, npt = isCtx ? L / TOK : S / TOK, tt = (r >> 2) % npt, b = (r >> 2) / npt, t128 = tt / (128 / TOK);
        const int seg0 = isCtx ? t128 : L / 128 + t128, seg1 = isCtx ? (L / 128 - 1) - t128 : L / 128 + (S / 128 - 1) - t128;
        const int mbase = isCtx ? TL + b * L + TOK * tt : b * S + TOK * tt;
        float ss0[64], ss1[64];
        { const float* s0p = p.SS + (((size_t)(0 * NB + b) * 4 + h) * NSG + seg0) * 4096 + lane; const float* s1p = p.SS + (((size_t)(1 * NB + b) * 4 + h) * NSG + seg1) * 4096 + lane;
#pragma unroll
          for (int k = 0; k < 64; ++k) { ss0[k] = seg0 > 0 ? s0p[k * 64] : 0.f; ss1[k] = seg1 > 0 ? s1p[k * 64] : 0.f; } }
        const float rk = p.a_r_k[l * DA + h * 64 + lane], gln = p.a_lnx_g[l * DA + h * 64 + lane], bln = p.a_lnx_b[l * DA + h * 64 + lane];
        f32x4 pv0 = {0.f, 0.f, 0.f, 0.f}, pv1 = pv0; float y0l, y1l, rr, kds, vv, gg;
#define ROUT_LOAD(i_) do { const size_t o_ = (size_t)(mbase + (i_)) * DA + h * 64, o1_ = o_ + (size_t)T * DA; \
            if (seg0 > 0) pv0 = *(const f32x4*)(p.PV + o_ + 4 * (lane & 15)); if (seg1 > 0) pv1 = *(const f32x4*)(p.PV + o1_ + 4 * (lane & 15)); \
            y0l = p.Y[o_ + lane]; y1l = p.Y[o1_ + lane]; rr = p.sR[o_ + lane]; kds = p.sKD[o_ + lane] + p.sKD[o1_ + lane]; vv = p.sV[o_ + lane]; gg = p.sG[o_ + lane]; } while (0)
        ROUT_LOAD(0);
#pragma unroll 1
        for (int i = 0; i < TOK; ++i) {
            const f32x4 cpv0 = pv0, cpv1 = pv1; float a0 = y0l, a1 = y1l, a2 = 0.f, a3 = 0.f; const float crr = rr, ckds = kds, cvv = vv, cgg = gg;
            ROUT_LOAD(i + 1 < TOK ? i + 1 : i);
            ScanRep<0>::dot(a0, a1, a2, a3, cpv0, ss0);
            ScanRep<0>::dot(a0, a1, a2, a3, cpv1, ss1);
            const float y = (a0 + a1) + (a2 + a3);
            const float mu = wave_sum(y) * (1.0f / 64.f), dy = y - mu;
            const float rstd = 1.0f / sqrtf(wave_sum(dy * dy) * (1.0f / 64.f) + GN_EPS);
            const float bon = wave_sum(crr * ckds * rk);
            p.MIX[(size_t)(mbase + i) * DMIX + h * 64 + lane] = f2bf((dy * rstd * gln + bln + bon * cvv) * cgg);
        }
#undef ROUT_LOAD
    }
}


#define LAS __attribute__((address_space(3)))
#define XB_TMO      128
#define XB_XCNT(j)  (256  + 64 * (j))
#define XB_XSUB(j)  (1280 + 64 * (j))
#define XB_XGEN(j)  (2304 + 64 * (j))
#define XB_TOP      3328
#define XB_TOPGEN   3392
#define XCD_BAR_WORDS 3456
#define XB_SPIN_CAP (1u << 20)
static_assert(XCD_BAR_WORDS * 4 <= 16384, "barrier words fit the control region");
__device__ __forceinline__ unsigned xb_ld(unsigned* p)              { return __hip_atomic_load(p, __ATOMIC_RELAXED, __HIP_MEMORY_SCOPE_AGENT); }
__device__ __forceinline__ unsigned xb_add(unsigned* p, unsigned v) { return __hip_atomic_fetch_add(p, v, __ATOMIC_RELAXED, __HIP_MEMORY_SCOPE_AGENT); }
__device__ __forceinline__ unsigned xb_xcc_id() { return (unsigned)__builtin_amdgcn_s_getreg((3 << 11) | 20) & 0xFu; }
#define XB_SPIN(cond, bar) do { unsigned _sp = 0; while (cond) { __builtin_amdgcn_s_sleep(1); \
    if ((++_sp & 255u) == 0u) { if (xb_ld(&(bar)[XB_TMO])) break; if (_sp > XB_SPIN_CAP) { atomicAdd(&(bar)[XB_TMO], 1u); break; } } } } while (0)
struct XcdBarrier { unsigned* bar; unsigned x; volatile LAS unsigned* st; };
__device__ __forceinline__ XcdBarrier xcd_barrier_post(unsigned* bar, volatile LAS unsigned* st) {
    XcdBarrier b; b.bar = bar; b.x = xb_xcc_id(); b.st = st;
    if (threadIdx.x == 0) (void)xb_add(&bar[XB_XCNT(b.x)], 1u);
    return b;
}
__device__ __forceinline__ void xcd_barrier_complete(unsigned* bar, unsigned x, unsigned& nloc, unsigned& nx) {
    const unsigned G = gridDim.x * gridDim.y * gridDim.z;
    unsigned sum, cnt, mine, sp = 0u;
    for (;;) {
        sum = 0u; cnt = 0u; mine = 0u;
#pragma unroll
        for (unsigned j = 0; j < 16; ++j) { const unsigned c = xb_ld(&bar[XB_XCNT(j)]); sum += c; cnt += (c > 0u) ? 1u : 0u; mine = (j == x) ? c : mine; }
        if (sum == G) break;
        __builtin_amdgcn_s_sleep(1);
        if ((++sp & 255u) == 0u) { if (xb_ld(&bar[XB_TMO])) break; if (sp > XB_SPIN_CAP) { atomicAdd(&bar[XB_TMO], 1u); break; } }
    }
    nloc = mine > 0u ? mine : 1u; nx = cnt > 0u ? cnt : 1u;
}
__device__ __forceinline__ void xcd_barrier(const XcdBarrier& b) {
    asm volatile("s_waitcnt vmcnt(0)" ::: "memory");
    __syncthreads();
    if (threadIdx.x == 0) {
        unsigned* bar = b.bar;
        __builtin_amdgcn_s_waitcnt(0);
        unsigned nloc = b.st[0], nx = b.st[1];
        if (nloc == 0u) { xcd_barrier_complete(bar, b.x, nloc, nx); b.st[0] = nloc; b.st[1] = nx; }
        const unsigned old = xb_add(&bar[XB_XSUB(b.x)], 1u);
        const unsigned gen = old / nloc;
        if (old + 1u == (gen + 1u) * nloc) {
            __builtin_amdgcn_fence(__ATOMIC_RELEASE, "agent");
            asm volatile("s_waitcnt vmcnt(0)" ::: "memory");
            const unsigned og = xb_add(&bar[XB_TOP], 1u);
            const unsigned tg = og / nx;
            if (og + 1u == (tg + 1u) * nx) xb_add(&bar[XB_TOPGEN], 1u);
            else XB_SPIN(xb_ld(&bar[XB_TOPGEN]) == tg, bar);
            __builtin_amdgcn_fence(__ATOMIC_ACQUIRE, "agent");
            xb_add(&bar[XB_XGEN(b.x)], 1u);
            asm volatile("s_waitcnt vmcnt(0)" ::: "memory");
        } else {
            XB_SPIN(xb_ld(&bar[XB_XGEN(b.x)]) == gen, bar);
            __builtin_amdgcn_fence(__ATOMIC_ACQUIRE, "agent");
            asm volatile("s_waitcnt vmcnt(0)" ::: "memory");
        }
    }
    __syncthreads();
}

#define GT ((long)blockIdx.x * blockDim.x + threadIdx.x)
#define GS ((long)gridDim.x * blockDim.x)
__global__ void __launch_bounds__(256, 2) mega_fwd(Params p) {
    __shared__ __attribute__((aligned(16))) char lds[65536 + 64];
    cg::grid_group grid = cg::this_grid();
    const long gt = GT, gs = GS;
    volatile LAS unsigned* bst = (volatile LAS unsigned*)(LAS char*)(lds + 65536);
    if (threadIdx.x < 2) bst[threadIdx.x] = 0u;
    __syncthreads();
    const XcdBarrier xb = xcd_barrier_post(p.bar, bst);
#ifndef PROBE_PHASE
#define PROBE_PHASE -1
#endif
#define PROBE_AMP 8
    unsigned long long t_prev = 0; int nts = 0;
#define STAMP() do { if (PROBE_PHASE >= 0 && blockIdx.x == 0 && threadIdx.x == 0) { const unsigned long long t_now = __builtin_amdgcn_s_memrealtime(); \
        if (nts == PROBE_PHASE + 1) { const unsigned long long t_end = t_now + PROBE_AMP * (t_now - t_prev); while (__builtin_amdgcn_s_memrealtime() < t_end) __builtin_amdgcn_s_sleep(8); } \
        t_prev = __builtin_amdgcn_s_memrealtime(); } ++nts; } while (0)
#define GSYNC() do { xcd_barrier(xb); STAMP(); } while (0)
    STAMP();
    ph_mod_fast(p, lds); ph_prep_w_fast(p, 0, 0, lds); ph_prep_misc(p, 0, gt, gs, false);
    grid.sync(); STAMP();
    for (int l = 0; l < 2; ++l) {
        const int nrows = (l == 0) ? T : TL;
        ph_lnmod_fast(p, l);
        GSYNC();
        g_gemm_in(p, lds);
        GSYNC();
        ph_streams_s1(p, l);
        GSYNC();
        g_streams_s2(p, l, lds);
        GSYNC();
        ph_scan_fast(p);
        GSYNC();
        ph_combine(p, lds); ph_attn_blk(p, l, l == 0, 64, lds);
        GSYNC();
        ph_rwkv_out_fast(p, l, l == 0);
        GSYNC();
        if (blockIdx.x & 1) { ph_prep_w_fast(p, l, 1, lds); __syncthreads(); g_gemm_out(p, nrows, lds); } else { g_gemm_out(p, nrows, lds); ph_prep_w_fast(p, l, 1, lds); }
        GSYNC();
        ph_post_mixer_fast(p, l, nrows);
        GSYNC();
        g_router(p, l, nrows, lds);
        GSYNC();
        ph_dispatch_fast(p, l, nrows, lds);
        GSYNC();
        g_moe1(p, l, lds);
        GSYNC();
        g_moe2(p, l, lds);
        GSYNC();
        ph_final_fast(p, l, nrows);
        if (l == 0) { ph_prep_w_fast(p, 1, 0, lds); ph_prep_misc(p, 1, gt, gs, false); }
        GSYNC();
    }}

extern "C" void kernel_launch(void* const* d_in, const int* in_sizes, int n_in, void* d_out, int out_size, void* d_ws, size_t ws_size, hipStream_t stream) {
    if (n_in != 32 || out_size != TL * D || ws_size < WS_NEED) { fprintf(stderr, "kernel_launch: unexpected shapes / workspace (n_in %d out %d ws %zu need %zu)\n", n_in, out_size, ws_size, (size_t)WS_NEED); return; }
    static int grid_blocks = 0;
    if (!grid_blocks) {
        int dev = 0, cus = 0, per_cu = 0;
        (void)hipGetDevice(&dev);
        (void)hipDeviceGetAttribute(&cus, hipDeviceAttributeMultiprocessorCount, dev);
        (void)hipOccupancyMaxActiveBlocksPerMultiprocessor(&per_cu, mega_fwd, 256, 0);
        if (per_cu < 1) per_cu = 1;
        if (per_cu > 2) per_cu = 2;
        grid_blocks = cus * per_cu;
        fprintf(stderr, "kernel_launch: %d CUs x %d blocks\n", cus, per_cu);
    }
    Params p = make_params(d_in, d_out, d_ws);
    (void)hipMemsetAsync(d_ws, 0, CTL_BYTES, stream);
    void* args[] = {&p};
    hipError_t e = hipLaunchCooperativeKernel((void*)mega_fwd, dim3(grid_blocks), dim3(256), args, 0, stream);
    if (e != hipSuccess) fprintf(stderr, "cooperative launch failed: %s (grid %d)\n", hipGetErrorString(e), grid_blocks);
}
#endif

#ifdef HOST_EMU
static void host_forward(void* const* d_in, void* d_out, void* d_ws) {
    const Params p = make_params(d_in, d_out, d_ws);
    for (int l = 0; l < 2; ++l) {
        const int nrows = (l == 0) ? T : TL;
        ph_prep_w(p, l, 0, 1); ph_prep_misc(p, l, 0, 1); ph_lnmod(p, l, 0, 1); host_gemm_in(p); ph_streams(p, l, 0, 1); ph_rope(p, 0, 1); ph_scan(p, 0, 1);
        ph_attn(p, l, nrows, 0, 1); ph_rwkv_out(p, l, nrows, 0, 1); host_gemm_out(p, nrows); ph_post_mixer(p, l, nrows, 0, 1);
        ph_dispatch(p, l, nrows, 0, 1); host_moe1(p, l); host_moe2(p, l); ph_final(p, l, nrows, 0, 1);
    }
}
#endif
```

```cpp
#ifdef HOST_EMU
#include <cmath>
#include <cstdio>
#include <cstring>
#include <cstdint>
#include <cstdlib>
#define __device__
#define __global__
#define __host__
#define __forceinline__ inline
#else
#include <hip/hip_runtime.h>
#include <hip/hip_cooperative_groups.h>
#include <cstdio>
#include <cstdint>
namespace cg = cooperative_groups;
#endif

#ifndef CFG_D
#define CFG_D 1024
#define CFG_B 8
#define CFG_S 2048
#define CFG_L 256
#define CFG_DE 512
#endif
constexpr int D = CFG_D, NB = CFG_B, S = CFG_S, L = CFG_L, DE = CFG_DE;
constexpr int TL = NB * S, TC = NB * L, T = TL + TC;
constexpr int GRID_W = 64, HD = 64;
constexpr int DA = 256, A_IN = 1184, N_IN = 2976, NINP = 3072, DMIX = 1024;
constexpr int NEXP = 32, NSLOT = 2 * T + NEXP * 128;
constexpr int ZQB = 0, ZKB = 384, ZVB = 512, ZQN = 640, ZKN = 1024, ZVN = 1408, ZA = 1792, ZP = 2976;
constexpr float LN_EPS = 1e-6f, GN_EPS = 64e-5f, ATT_SCALE = 0.125f;
constexpr float ALPHA = 1.41421356237309515f;

typedef unsigned short bf16_t;

__device__ __forceinline__ float bf2f(bf16_t v) {
    unsigned u = ((unsigned)v) << 16; float f;
#ifdef HOST_EMU
    memcpy(&f, &u, 4);
#else
    f = __uint_as_float(u);
#endif
    return f;
}
__device__ __forceinline__ bf16_t f2bf(float f) {
    unsigned u;
#ifdef HOST_EMU
    memcpy(&u, &f, 4);
#else
    u = __float_as_uint(f);
#endif
    return (bf16_t)((u + 0x7fffu + ((u >> 16) & 1u)) >> 16);
}
__device__ __forceinline__ float sigmoidf_(float x) { return 1.0f / (1.0f + expf(-x)); }
__device__ __forceinline__ float siluf_(float x) { return x / (1.0f + expf(-x)); }
__device__ __forceinline__ int atomic_inc_int(int* p) {
#ifdef HOST_EMU
    int o = *p; *p = o + 1; return o;
#else
    return atomicAdd(p, 1);
#endif
}

struct Params {
    const float *x, *c, *ctx, *c_ctx, *w_mod, *b_mod, *w_in, *w_out, *a_shift, *a_w0, *a_w_up, *a_a0, *a_a_up, *a_g_up,
        *a_k_k, *a_k_a, *a_r_k, *a_lnx_g, *a_lnx_b, *b_sink, *c_rpb, *ln1_g, *ln1_b, *ln2_g, *ln2_b, *w_rg, *b_rg, *w_re,
        *b_re, *w_gate, *w_up, *w_down;
    float* out;
    int* cnt;
    unsigned* bar;
    float* mod;
    float* rope;
    bf16_t *win_t, *wout_t, *wgu_t, *wd_t;
    bf16_t *wrt;
    int* hist;
    bf16_t* HLO;
    bf16_t *wupT, *aupT, *gupT;
    bf16_t* LA;
    float *kT, *kN;
    bf16_t* H;
    bf16_t* Z;
    bf16_t* VT;
    float *sR, *sV, *sKK, *sG, *sW, *sKD, *sB;
    float* Y;
    bf16_t* MIX;
    float *PV, *QS, *PS, *SS;
    float* XC;
    float* O;
    int *rE, *rPos, *rSlot; float* rW;
    int* slotTok;
    bf16_t* ACT;
    float* YS;
};

constexpr size_t al256(size_t v) { return (v + 255) & ~(size_t)255; }
constexpr size_t OFF_CNT = 0;
constexpr size_t OFF_BAR = 4096, CTL_BYTES = 4096 + 16384;
constexpr size_t OFF_MOD = CTL_BYTES;
constexpr size_t OFF_ROPE = al256(OFF_MOD + (size_t)2 * (NB + 1) * 6 * D * 4);
constexpr size_t OFF_LORA = al256(OFF_ROPE + 64 * 16 * 2 * 4);
constexpr size_t OFF_WRT = al256(OFF_LORA + (size_t)(2 * 256 * 64 * 2 + 256 * 160) * 2);
constexpr size_t OFF_LG = al256(OFF_WRT + (size_t)2 * 128 * D * 2);
constexpr size_t OFF_WIN = al256(OFF_LG + (size_t)T * 36 * 4);
constexpr size_t OFF_WOUT = al256(OFF_WIN + (size_t)NINP * D * 2);
constexpr size_t OFF_WGU = al256(OFF_WOUT + (size_t)D * DMIX * 2);
constexpr size_t OFF_WD = al256(OFF_WGU + (size_t)NEXP * 2 * DE * D * 2);
constexpr size_t OFF_H = al256(OFF_WD + (size_t)NEXP * D * DE * 2);
constexpr size_t OFF_Z = al256(OFF_H + (size_t)(T + 1) * D * 2);
constexpr int PU = L + S;
constexpr int NSG = (L + S) / 128;
static_assert((size_t)3 * 64 * ((L + S) / 128) * 4096 * 4 <= (size_t)NEXP * 2 * DE * D * 2 || (L % 128) != 0, "scan segment states overlay wgu_t");
constexpr size_t OFF_VT = al256(OFF_Z + (size_t)T * ZP * 2);
constexpr size_t OFF_S = al256(OFF_VT + (size_t)NB * 8 * 64 * PU * 2);
constexpr size_t S1 = (size_t)T * 256 * 4;
constexpr size_t OFF_Y = al256(OFF_S + 10 * S1);
constexpr size_t OFF_MIX = al256(OFF_Y + 2 * S1);
constexpr size_t OFF_XC = al256(OFF_MIX + (size_t)T * 1024 * 2);
constexpr size_t OFF_ROUTE = al256(OFF_XC + (size_t)TC * D * 4);
constexpr size_t OFF_SLOTTOK = al256(OFF_ROUTE + (size_t)T * 2 * 4 * 4);
constexpr size_t WS_NEED = al256(OFF_SLOTTOK + (size_t)NSLOT * 4);
static_assert((size_t)NSLOT * DE * 2 <= (size_t)T * ZP * 2 && (size_t)T * D * 2 <= (size_t)T * ZP * 2, "ACT / HLO overlay Z");
static_assert((size_t)T * 4 * 4 + (size_t)T * 416 * 2 <= S1, "kN + LA overlay Y[1]");
static_assert((size_t)NSLOT * D * 4 <= 10 * S1 && (size_t)T * D * 4 <= 10 * S1, "YS / O overlay the stream buffers");

static Params make_params(void* const* d_in, void* d_out, void* d_ws) {
    Params p{};
    const float** f = (const float**)&p.x;
    for (int i = 0; i < 32; ++i) f[i] = (const float*)d_in[i];
    p.out = (float*)d_out;
    char* w = (char*)d_ws;
    p.cnt = (int*)(w + OFF_CNT); p.bar = (unsigned*)(w + OFF_BAR); p.mod = (float*)(w + OFF_MOD); p.rope = (float*)(w + OFF_ROPE);
    p.win_t = (bf16_t*)(w + OFF_WIN); p.wout_t = (bf16_t*)(w + OFF_WOUT); p.wgu_t = (bf16_t*)(w + OFF_WGU); p.wd_t = (bf16_t*)(w + OFF_WD);
    p.wrt = (bf16_t*)(w + OFF_WRT); p.hist = (int*)(w + OFF_LG); p.HLO = (bf16_t*)(w + OFF_Z);
    p.wupT = (bf16_t*)(w + OFF_LORA); p.aupT = p.wupT + 2 * 256 * 64; p.gupT = p.aupT + 2 * 256 * 64;
    p.H = (bf16_t*)(w + OFF_H); p.Z = (bf16_t*)(w + OFF_Z); p.VT = (bf16_t*)(w + OFF_VT);
    float* s = (float*)(w + OFF_S); const size_t n1 = (size_t)T * 256;
    p.sR = s; p.sV = s + n1; p.sKK = s + 2 * n1; p.sG = s + 3 * n1; p.sW = s + 4 * n1; p.sKD = s + 6 * n1; p.sB = s + 8 * n1;
    p.Y = (float*)(w + OFF_Y); p.MIX = (bf16_t*)(w + OFF_MIX); p.XC = (float*)(w + OFF_XC);
    p.O = (float*)(w + OFF_S);
    p.PV = (float*)(w + OFF_H); p.QS = (float*)(w + OFF_WGU); p.PS = p.QS + (size_t)64 * NSG * 4096; p.SS = p.PS + (size_t)64 * NSG * 4096;
    p.kT = p.Y; p.kN = p.Y + (size_t)T * 256; p.LA = (bf16_t*)(p.Y + (size_t)T * 256 + (size_t)T * 4);
    int* r = (int*)(w + OFF_ROUTE); p.rE = r; p.rPos = r + 2 * T; p.rSlot = r + 4 * T; p.rW = (float*)(r + 6 * T);
    p.slotTok = (int*)(w + OFF_SLOTTOK);
    p.ACT = (bf16_t*)(w + OFF_Z); p.YS = (float*)(w + OFF_S);
    return p;
}

__device__ void ph_prep_w(const Params& p, int l, long gtid, long gsz) {
    for (long i = gtid; i < (long)D * NINP; i += gsz) {
        const int k = (int)(i / NINP), n = (int)(i % NINP);
        float v = 0.f;
        if (n < N_IN) { const int oc = (n < ZA) ? n + A_IN : n - ZA; v = p.w_in[((size_t)l * D + k) * N_IN + oc]; }
        p.win_t[(size_t)n * D + k] = f2bf(v);
    }
    for (long i = gtid; i < (long)DMIX * D; i += gsz) {
        const int k = (int)(i / D), n = (int)(i % D);
        p.wout_t[(size_t)n * DMIX + k] = f2bf(p.w_out[((size_t)l * DMIX + k) * D + n]);
    }
    for (long i = gtid; i < (long)NEXP * D * 2 * DE; i += gsz) {
        const int rho = (int)(i % (2 * DE)); const long t = i / (2 * DE); const int k = (int)(t % D), e = (int)(t / D);
        const int q = rho >> 5, half = (rho >> 4) & 1, ii = rho & 15, cc = 16 * q + ii;
        const float* src = half ? p.w_up : p.w_gate;
        p.wgu_t[((size_t)e * 2 * DE + rho) * D + k] = f2bf(src[(((size_t)l * NEXP + e) * D + k) * DE + cc]);
    }
    for (long i = gtid; i < (long)NEXP * DE * D; i += gsz) {
        const int n = (int)(i % D); const long t = i / D; const int k = (int)(t % DE), e = (int)(t / DE);
        p.wd_t[((size_t)e * D + n) * DE + k] = f2bf(p.w_down[(((size_t)l * NEXP + e) * DE + k) * D + n]);
    }
}
__device__ __forceinline__ void ph_prep_misc(const Params& p, int l, long gtid, long gsz, bool do_mod = true) {
    if (l == 0 && do_mod) for (long i = gtid; i < (long)2 * (NB + 1) * 6 * D; i += gsz) {
        const int j = (int)(i % (6 * D)), b = (int)((i / (6 * D)) % (NB + 1)), ll = (int)(i / ((long)6 * D * (NB + 1)));
        const float* cv = (b < NB) ? p.c + (size_t)b * D : p.c_ctx;
        float acc = 0.f;
        for (int k = 0; k < D; ++k) acc += siluf_(cv[k]) * p.w_mod[((size_t)ll * D + k) * 6 * D + j];
        p.mod[((size_t)ll * (NB + 1) + b) * 6 * D + j] = acc + p.b_mod[(size_t)ll * 6 * D + j];
    }
    if (l == 0) for (long i = gtid; i < 64 * 16; i += gsz) {
        const int pos = (int)(i / 16), fi = (int)(i % 16);
        const float inv = powf(10000.0f, -(float)fi / 16.0f), ang = (float)pos * inv;
        p.rope[i] = cosf(ang); p.rope[1024 + i] = sinf(ang);
    }
    for (long i = gtid; i < NEXP; i += gsz) p.cnt[l * NEXP + i] = 0;
    for (long i = gtid; i < NSLOT; i += gsz) p.slotTok[i] = T;
    for (long i = gtid; i < D; i += gsz) p.H[(size_t)T * D + i] = 0;
}

__device__ __forceinline__ const float* xrow_in(const Params& p, int l, int m) {
    if (m < TL) return (l == 0 ? p.x : p.out) + (size_t)m * D;
    return (l == 0 ? p.ctx : p.XC) + (size_t)(m - TL) * D;
}
__device__ __forceinline__ const float* modrow(const Params& p, int l, int m) { return p.mod + ((size_t)l * (NB + 1) + (m < TL ? m / S : NB)) * 6 * D; }

__device__ void ph_lnmod(const Params& p, int l, long gtid, long gsz) {
    for (long m = gtid; m < T; m += gsz) {
        const float* xr = xrow_in(p, l, (int)m); const float* md = modrow(p, l, (int)m);
        float s = 0.f; for (int j = 0; j < D; ++j) s += xr[j];
        const float mu = s / D; float q = 0.f;
        for (int j = 0; j < D; ++j) { const float d = xr[j] - mu; q += d * d; }
        const float rstd = 1.0f / sqrtf(q / D + LN_EPS);
        for (int j = 0; j < D; ++j) p.H[(size_t)m * D + j] = f2bf((xr[j] - mu) * rstd * (1.0f + md[D + j]) + md[j]);
    }
}

__device__ __forceinline__ float zshift(const Params& p, int l, int m, int col) {
    int t, len;
    if (m < TL) { t = m % S; len = S; } else { t = (m - TL) % L; len = L; }
    const float* sh = p.a_shift + (size_t)l * 3 * A_IN;
    const bf16_t* z = p.Z + (size_t)m * ZP + ZA + col;
    float v = sh[A_IN + col] * bf2f(z[0]);
    if (t > 0) v += sh[col] * bf2f(z[-ZP]);
    if (t < len - 1) v += sh[2 * A_IN + col] * bf2f(z[ZP]);
    return v;
}

__device__ void ph_streams(const Params& p, int l, long gtid, long gsz) {
    for (long i = gtid; i < (long)T * DA; i += gsz) {
        const int m = (int)(i / DA), c = (int)(i % DA), h0 = c & ~63;
        const float r = zshift(p, l, m, c), k = zshift(p, l, m, 256 + c), v = zshift(p, l, m, 512 + c);
        float nrm = 0.f;
        for (int j = 0; j < 64; ++j) { const float t = zshift(p, l, m, 256 + h0 + j) * p.a_k_k[l * DA + h0 + j]; nrm += t * t; }
        const float kk = k * p.a_k_k[l * DA + c] / sqrtf(nrm + 1e-12f);
        float g = 0.f;
        for (int j = 0; j < 160; ++j) g += sigmoidf_(zshift(p, l, m, 1024 + j)) * p.a_g_up[((size_t)l * 160 + j) * DA + c];
        const size_t o = (size_t)m * DA + c;
        p.sR[o] = r; p.sV[o] = v; p.sKK[o] = kk; p.sG[o] = g;
        for (int d = 0; d < 2; ++d) {
            float aw = 0.f, aa = 0.f;
            for (int j = 0; j < 64; ++j) {
                aw += tanhf(zshift(p, l, m, 768 + d * 64 + j)) * p.a_w_up[(((size_t)l * 2 + d) * 64 + j) * DA + c];
                aa += zshift(p, l, m, 896 + d * 64 + j) * p.a_a_up[(((size_t)l * 2 + d) * 64 + j) * DA + c];
            }
            const float u = -(p.a_w0[(l * 2 + d) * DA + c] + aw);
            const float sp = (u > 20.f) ? u : log1pf(expf(u));
            const float w = expf(-expf(-sp - 0.5f));
            const float a = sigmoidf_(p.a_a0[(l * 2 + d) * DA + c] + aa);
            const size_t od = ((size_t)d * T + m) * DA + c;
            p.sW[od] = w; p.sKD[od] = k * (1.0f + (a - 1.0f) * p.a_k_a[l * DA + c]); p.sB[od] = kk * a;
        }
    }
}

__device__ __forceinline__ void ph_rope(const Params& p, long gtid, long gsz) {
    for (long i = gtid; i < (long)TL * 8 * 32; i += gsz) {
        const int pr = (int)(i & 31), hs = (int)((i >> 5) & 7), m = (int)(i >> 8);
        const int t = m % S, axis = pr >> 4, fi = pr & 15, pos = axis ? (t % GRID_W) : (t / GRID_W);
        bf16_t* z = p.Z + (size_t)m * ZP + hs * 64 + axis * 32 + fi;
        const float cs = p.rope[pos * 16 + fi], sn = p.rope[1024 + pos * 16 + fi];
        const float x0 = bf2f(z[0]), x1 = bf2f(z[16]);
        z[0] = f2bf(x0 * cs - x1 * sn); z[16] = f2bf(x1 * cs + x0 * sn);
    }
}

__device__ void ph_scan(const Params& p, long gtid, long gsz) {
    for (long i = gtid; i < (long)2 * NB * 4 * 64; i += gsz) {
        const int v = (int)(i & 63), h = (int)((i >> 6) & 3), b = (int)((i >> 8) % NB), d = (int)((i >> 8) / NB);
        float st[64];
#pragma unroll
        for (int k = 0; k < 64; ++k) st[k] = 0.f;
        for (int pos = 0; pos < L + S; ++pos) {
            int m;
            if (pos < L) m = TL + b * L + (d ? L - 1 - pos : pos);
            else m = b * S + (d ? S - 1 - (pos - L) : pos - L);
            const size_t o = (size_t)m * DA + h * 64, od = ((size_t)d * T + m) * DA + h * 64;
            const float* kk = p.sKK + o; const float* r = p.sR + o;
            const float* w = p.sW + od; const float* bb = p.sB + od; const float* kd = p.sKD + od;
            const float vv = p.sV[o + v];
            float sk = 0.f;
#pragma unroll
            for (int k = 0; k < 64; ++k) sk += st[k] * kk[k];
            float y = 0.f;
#pragma unroll
            for (int k = 0; k < 64; ++k) { st[k] = st[k] * w[k] - sk * bb[k] + vv * kd[k]; y += st[k] * r[k]; }
            p.Y[od + v] = y;
        }
    }
}

__device__ void ph_rwkv_out(const Params& p, int l, int nrows, long gtid, long gsz) {
    for (long i = gtid; i < (long)nrows * 4; i += gsz) {
        const int m = (int)(i >> 2), h = (int)(i & 3);
        const size_t o = (size_t)m * DA + h * 64;
        const float* y0 = p.Y + o; const float* y1 = p.Y + (size_t)T * DA + o;
        float s = 0.f, bon = 0.f;
        for (int n = 0; n < 64; ++n) {
            s += y0[n] + y1[n];
            bon += p.sR[o + n] * (p.sKD[o + n] + p.sKD[(size_t)T * DA + o + n]) * p.a_r_k[l * DA + h * 64 + n];
        }
        const float mu = s / 64.f; float q = 0.f;
        for (int n = 0; n < 64; ++n) { const float dd = y0[n] + y1[n] - mu; q += dd * dd; }
        const float rstd = 1.0f / sqrtf(q / 64.f + GN_EPS);
        for (int n = 0; n < 64; ++n) {
            const int c = h * 64 + n;
            const float yn = (y0[n] + y1[n] - mu) * rstd * p.a_lnx_g[l * DA + c] + p.a_lnx_b[l * DA + c];
            p.MIX[(size_t)m * DMIX + c] = f2bf((yn + bon * p.sV[o + n]) * p.sG[o + n]);
        }
    }
}

__device__ __forceinline__ void att_key(const float (&q)[64], const bf16_t* kr, const bf16_t* vr, float bias, float& mx, float& ls, float (&acc)[64]) {
    float s = 0.f;
#pragma unroll
    for (int d = 0; d < 64; ++d) s += q[d] * bf2f(kr[d]);
    s = s * ATT_SCALE + bias;
    const float mn = fmaxf(mx, s), f = expf(mx - mn), pe = expf(s - mn);
    ls = ls * f + pe;
#pragma unroll
    for (int d = 0; d < 64; ++d) acc[d] = acc[d] * f + pe * bf2f(vr[d]);
    mx = mn;
}

__device__ void ph_attn(const Params& p, int l, int nrows, long gtid, long gsz) {
    for (long i = gtid; i < (long)nrows * 12; i += gsz) {
        const int m = (int)(i / 12), u = (int)(i % 12);
        const bool isB = u < 6; const int hq = isB ? u : u - 6;
        const int b = (m < TL) ? m / S : (m - TL) / L;
        const int qcol = isB ? ZQB + hq * 64 : ZQN + hq * 64;
        const int kcol = isB ? ZKB + (hq / 3) * 64 : ZKN + hq * 64;
        const int vcol = isB ? ZVB + (hq / 3) * 64 : ZVN + hq * 64;
        float q[64], acc[64];
        const bf16_t* qr = p.Z + (size_t)m * ZP + qcol;
#pragma unroll
        for (int d = 0; d < 64; ++d) { q[d] = bf2f(qr[d]); acc[d] = 0.f; }
        float mx, ls;
        if (isB) { mx = p.b_sink[l * 6 + hq]; ls = 1.0f; } else { mx = -1e30f; ls = 0.f; }
        for (int j = 0; j < L; ++j) { const bf16_t* zr = p.Z + (size_t)(TL + b * L + j) * ZP; att_key(q, zr + kcol, zr + vcol, 0.f, mx, ls, acc); }
        if (m < TL) {
            const int t = m % S;
            if (isB) {
                const int j0 = t - 128 < 0 ? 0 : t - 128, j1 = t + 128 > S - 1 ? S - 1 : t + 128;
                for (int j = j0; j <= j1; ++j) { const bf16_t* zr = p.Z + (size_t)(b * S + j) * ZP; att_key(q, zr + kcol, zr + vcol, 0.f, mx, ls, acc); }
            } else {
                const int rows = S / GRID_W, r = t / GRID_W, c = t % GRID_W;
                int r0 = r - 4; r0 = r0 < 0 ? 0 : (r0 > rows - 8 ? rows - 8 : r0);
                int c0 = c - 8; c0 = c0 < 0 ? 0 : (c0 > GRID_W - 16 ? GRID_W - 16 : c0);
                for (int a = 0; a < 8; ++a)
                    for (int e = 0; e < 16; ++e) {
                        const int kr = r0 + a, kc = c0 + e;
                        const float bias = p.c_rpb[(((size_t)l * 6 + hq) * 15 + (kr - r + 7)) * 31 + (kc - c + 15)];
                        const bf16_t* zr = p.Z + (size_t)(b * S + kr * GRID_W + kc) * ZP;
                        att_key(q, zr + kcol, zr + vcol, bias, mx, ls, acc);
                    }
            }
        }
        const float inv = 1.0f / ls;
        bf16_t* o = p.MIX + (size_t)m * DMIX + (isB ? 256 : 640) + hq * 64;
#pragma unroll
        for (int d = 0; d < 64; ++d) o[d] = f2bf(acc[d] * inv);
    }
}

__device__ void ph_post_mixer(const Params& p, int l, int nrows, long gtid, long gsz) {
    for (long mm = gtid; mm < nrows; mm += gsz) {
        const int m = (int)mm;
        const float* xr = xrow_in(p, l, m); const float* md = modrow(p, l, m); const float* orow = p.O + (size_t)m * D;
        float* x1 = (m < TL) ? p.out + (size_t)m * D : p.XC + (size_t)(m - TL) * D;
        const float* g1 = p.ln1_g + (size_t)l * D; const float* b1 = p.ln1_b + (size_t)l * D;
        float s = 0.f; for (int j = 0; j < D; ++j) s += ALPHA * xr[j] + md[2 * D + j] * orow[j];
        float mu = s / D, q = 0.f;
        for (int j = 0; j < D; ++j) { const float d = ALPHA * xr[j] + md[2 * D + j] * orow[j] - mu; q += d * d; }
        float rstd = 1.0f / sqrtf(q / D + LN_EPS);
        s = 0.f;
        for (int j = 0; j < D; ++j) { const float v = (ALPHA * xr[j] + md[2 * D + j] * orow[j] - mu) * rstd * g1[j] + b1[j]; x1[j] = v; s += v; }
        mu = s / D; q = 0.f;
        for (int j = 0; j < D; ++j) { const float d = x1[j] - mu; q += d * d; }
        rstd = 1.0f / sqrtf(q / D + LN_EPS);
        float gl[4], el[32];
#pragma unroll
        for (int g = 0; g < 4; ++g) gl[g] = p.b_rg[l * 4 + g];
#pragma unroll
        for (int e = 0; e < 32; ++e) el[e] = p.b_re[l * 32 + e];
        for (int j = 0; j < D; ++j) {
            const float hv = (x1[j] - mu) * rstd * (1.0f + md[4 * D + j]) + md[3 * D + j];
            p.H[(size_t)m * D + j] = f2bf(hv);
            const float* wg = p.w_rg + ((size_t)l * D + j) * 4; const float* we = p.w_re + ((size_t)l * D + j) * 32;
#pragma unroll
            for (int g = 0; g < 4; ++g) gl[g] += hv * wg[g];
#pragma unroll
            for (int e = 0; e < 32; ++e) el[e] += hv * we[e];
        }
        int gs = 0; float gm = gl[0];
#pragma unroll
        for (int g = 1; g < 4; ++g) if (gl[g] > gm) { gm = gl[g]; gs = g; }
        float den = 0.f;
#pragma unroll
        for (int g = 0; g < 4; ++g) den += expf(gl[g] - gm);
        const float pg = 1.0f / den;
        float v1 = -3e38f, v2 = -3e38f; int i1 = 0, i2 = 0;
#pragma unroll
        for (int j = 0; j < 8; ++j) {
            const float v = gs == 0 ? el[j] : gs == 1 ? el[8 + j] : gs == 2 ? el[16 + j] : el[24 + j];
            if (v > v1) { v2 = v1; i2 = i1; v1 = v; i1 = j; } else if (v > v2) { v2 = v; i2 = j; }
        }
        const float e2 = expf(v2 - v1), w1 = pg / (1.0f + e2), w2 = pg * e2 / (1.0f + e2);
        const int ea = gs * 8 + i1, eb = gs * 8 + i2;
        p.rE[2 * m] = ea; p.rE[2 * m + 1] = eb; p.rW[2 * m] = w1; p.rW[2 * m + 1] = w2;
        p.rPos[2 * m] = atomic_inc_int(p.cnt + l * NEXP + ea); p.rPos[2 * m + 1] = atomic_inc_int(p.cnt + l * NEXP + eb);
    }
}

__device__ __forceinline__ int pstart_of(const int* cnt, int e) {
    int s = 0;
    for (int j = 0; j < NEXP; ++j) if (j < e) s += (cnt[j] + 127) & ~127;
    return s;
}
__device__ __forceinline__ void ph_dispatch(const Params& p, int l, int nrows, long gtid, long gsz) {
    for (long i = gtid; i < (long)nrows * 2; i += gsz) {
        const int slot = pstart_of(p.cnt + l * NEXP, p.rE[i]) + p.rPos[i];
        p.rSlot[i] = slot; p.slotTok[slot] = (int)(i >> 1);
    }
}

__device__ void ph_final(const Params& p, int l, int nrows, long gtid, long gsz) {
    for (long mm = gtid; mm < nrows; mm += gsz) {
        const int m = (int)mm;
        float* x1 = (m < TL) ? p.out + (size_t)m * D : p.XC + (size_t)(m - TL) * D;
        const float* md = modrow(p, l, m);
        const float* ya = p.YS + (size_t)p.rSlot[2 * m] * D; const float* yb = p.YS + (size_t)p.rSlot[2 * m + 1] * D;
        const float wa = p.rW[2 * m], wb = p.rW[2 * m + 1];
        const float* g2 = p.ln2_g + (size_t)l * D; const float* b2 = p.ln2_b + (size_t)l * D;
        float s = 0.f; for (int j = 0; j < D; ++j) s += ALPHA * x1[j] + md[5 * D + j] * (wa * ya[j] + wb * yb[j]);
        const float mu = s / D; float q = 0.f;
        for (int j = 0; j < D; ++j) { const float d = ALPHA * x1[j] + md[5 * D + j] * (wa * ya[j] + wb * yb[j]) - mu; q += d * d; }
        const float rstd = 1.0f / sqrtf(q / D + LN_EPS);
        for (int j = 0; j < D; ++j) x1[j] = (ALPHA * x1[j] + md[5 * D + j] * (wa * ya[j] + wb * yb[j]) - mu) * rstd * g2[j] + b2[j];
    }
}

__device__ __forceinline__ int moe_blocks(const int* cnt) { int s = 0; for (int j = 0; j < NEXP; ++j) s += (cnt[j] + 127) >> 7; return s; }
__device__ __forceinline__ int moe_block_expert(const int* cnt, int rb) {
    int s = 0, e = 0;
    for (int j = 0; j < NEXP; ++j) { const int nb = (cnt[j] + 127) >> 7; if (rb >= s && rb < s + nb) e = j; s += nb; }
    return e;
}

#ifdef HOST_EMU
static void host_gemm_in(const Params& p) {
    for (int m = 0; m < T; ++m) for (int n = 0; n < ZP; ++n) { float a = 0.f; for (int k = 0; k < D; ++k) a += bf2f(p.H[(size_t)m * D + k]) * bf2f(p.win_t[(size_t)n * D + k]); p.Z[(size_t)m * ZP + n] = f2bf(a); }
}
static void host_gemm_out(const Params& p, int nrows) {
    for (int m = 0; m < nrows; ++m) for (int n = 0; n < D; ++n) { float a = 0.f; for (int k = 0; k < DMIX; ++k) a += bf2f(p.MIX[(size_t)m * DMIX + k]) * bf2f(p.wout_t[(size_t)n * DMIX + k]); p.O[(size_t)m * D + n] = a; }
}
static void host_moe1(const Params& p, int l) {
    const int* cnt = p.cnt + l * NEXP; const int nrb = moe_blocks(cnt);
    for (int rb = 0; rb < nrb; ++rb) { const int e = moe_block_expert(cnt, rb);
        for (int r = 0; r < 128; ++r) { const int slot = rb * 128 + r; const bf16_t* a = p.H + (size_t)p.slotTok[slot] * D;
            for (int c = 0; c < DE; ++c) { const int q = c >> 4, ii = c & 15; float g = 0.f, u = 0.f;
                const bf16_t* wg = p.wgu_t + ((size_t)e * 2 * DE + 32 * q + ii) * D; const bf16_t* wu = wg + (size_t)16 * D;
                for (int k = 0; k < D; ++k) { g += bf2f(a[k]) * bf2f(wg[k]); u += bf2f(a[k]) * bf2f(wu[k]); }
                p.ACT[(size_t)slot * DE + c] = f2bf(siluf_(g) * u); } } }
}
static void host_moe2(const Params& p, int l) {
    const int* cnt = p.cnt + l * NEXP; const int nrb = moe_blocks(cnt);
    for (int rb = 0; rb < nrb; ++rb) { const int e = moe_block_expert(cnt, rb);
        for (int r = 0; r < 128; ++r) { const int slot = rb * 128 + r;
            for (int n = 0; n < D; ++n) { float a = 0.f; const bf16_t* w = p.wd_t + ((size_t)e * D + n) * DE;
                for (int k = 0; k < DE; ++k) a += bf2f(p.ACT[(size_t)slot * DE + k]) * bf2f(w[k]);
                p.YS[(size_t)slot * D + n] = a; } } }
}
#else
typedef short bf16x8 __attribute__((ext_vector_type(8)));
typedef float f32x4 __attribute__((ext_vector_type(4)));
__device__ __forceinline__ int opq_tid() { int t = threadIdx.x; asm volatile("" : "+v"(t)); return t; }
__device__ __forceinline__ int opq_bid() { int b = blockIdx.x; asm volatile("" : "+s"(b)); return b; }
__device__ __forceinline__ unsigned pk2(float lo, float hi) { return (unsigned)f2bf(lo) | ((unsigned)f2bf(hi) << 16); }
struct u32x2_t { unsigned x, y; };
__device__ __forceinline__ void st_bf16x4(bf16_t* dst, f32x4 v) { u32x2_t o; o.x = pk2(v[0], v[1]); o.y = pk2(v[2], v[3]); *(u32x2_t*)dst = o; }
template <class Epi>
__device__ __forceinline__ void gemm_tile(const bf16_t* a0, const bf16_t* a1, const bf16_t* b0, const bf16_t* b1, int K, char* lds, const Epi& epi) {
    const int tid = opq_tid(), wid = tid >> 6, lane = tid & 63, wr = wid >> 1, wc = wid & 1, fr = lane & 15, fq = lane >> 4;
    f32x4 acc[4][4];
#pragma unroll
    for (int m = 0; m < 4; ++m)
#pragma unroll
        for (int n = 0; n < 4; ++n) acc[m][n] = (f32x4){0.f, 0.f, 0.f, 0.f};
#define GT_STAGE(st_, kt_) do { char* sa_ = lds + (st_) * 16384 + tid * 16; \
        __builtin_amdgcn_global_load_lds((const unsigned*)(a0 + (kt_)), (__attribute__((address_space(3))) unsigned*)(sa_), 16, 0, 0); \
        __builtin_amdgcn_global_load_lds((const unsigned*)(a1 + (kt_)), (__attribute__((address_space(3))) unsigned*)(sa_ + 4096), 16, 0, 0); \
        __builtin_amdgcn_global_load_lds((const unsigned*)(b0 + (kt_)), (__attribute__((address_space(3))) unsigned*)(sa_ + 8192), 16, 0, 0); \
        __builtin_amdgcn_global_load_lds((const unsigned*)(b1 + (kt_)), (__attribute__((address_space(3))) unsigned*)(sa_ + 12288), 16, 0, 0); } while (0)
    const int fsw = (0 - (fr >> 2)) & 3;
    const int aoff = (wr * 64 + fr) * 64 + ((fq ^ fsw) * 16), boff = 8192 + (wc * 64 + fr) * 64 + ((fq ^ fsw) * 16);
    const int nk = K / 32;
    GT_STAGE(0, 0);
    if (nk > 1) GT_STAGE(1, 32);
    if (nk > 2) GT_STAGE(2, 64);
    for (int t = 0; t < nk; ++t) {
        if (t + 2 < nk) asm volatile("s_waitcnt vmcnt(8)" ::: "memory"); else if (t + 1 < nk) asm volatile("s_waitcnt vmcnt(4)" ::: "memory"); else asm volatile("s_waitcnt vmcnt(0)" ::: "memory");
        asm volatile("s_waitcnt lgkmcnt(0)" ::: "memory");
        __builtin_amdgcn_s_barrier();
        if (t + 3 < nk) GT_STAGE((t + 3) & 3, (t + 3) * 32);
        const char* sb = lds + (t & 3) * 16384;
        bf16x8 At[4], Bt[4];
#pragma unroll
        for (int m = 0; m < 4; ++m) At[m] = *(const bf16x8*)(sb + aoff + m * 1024);
#pragma unroll
        for (int n = 0; n < 4; ++n) Bt[n] = *(const bf16x8*)(sb + boff + n * 1024);
#pragma unroll
        for (int m = 0; m < 4; ++m)
#pragma unroll
            for (int n = 0; n < 4; ++n) acc[m][n] = __builtin_amdgcn_mfma_f32_16x16x32_bf16(At[m], Bt[n], acc[m][n], 0, 0, 0);
    }
    asm volatile("s_waitcnt lgkmcnt(0)" ::: "memory");
    __builtin_amdgcn_s_barrier();
#undef GT_STAGE
    epi(acc, wr, wc, fr, fq);
}
#define STG_ROW(i) ((tid_ + (i) * 256) >> 2)
#define STG_K ((((tid_ & 3) ^ ((0 - (tid_ >> 4)) & 3))) * 8)

__device__ __forceinline__ void g_gemm_in(const Params& p, char* lds) {
    const int tid_ = opq_tid(), bid_ = opq_bid(); (void)tid_; (void)bid_;
    constexpr int NT = NINP / 128, MT = T / 128;
    for (int tile = bid_; tile < NT * MT; tile += gridDim.x) {
        const int tm = tile / NT, tn = tile % NT;
        const bf16_t* a0 = p.H + (size_t)(tm * 128 + STG_ROW(0)) * D + STG_K; const bf16_t* a1 = p.H + (size_t)(tm * 128 + STG_ROW(1)) * D + STG_K;
        const bf16_t* b0 = p.win_t + (size_t)(tn * 128 + STG_ROW(0)) * D + STG_K; const bf16_t* b1 = p.win_t + (size_t)(tn * 128 + STG_ROW(1)) * D + STG_K;
        gemm_tile(a0, a1, b0, b1, D, lds, [&](const f32x4 (&acc)[4][4], int wr, int wc, int fr, int fq) {
            if (tn < ZVB / 128 && tm < TL / 128) {
#pragma unroll
                for (int m = 0; m < 4; ++m)
#pragma unroll
                    for (int j = 0; j < 4; ++j) { const int row = tm * 128 + wr * 64 + m * 16 + fq * 4 + j, t = row % S;
                        bf16_t* zr = p.Z + (size_t)row * ZP + tn * 128 + wc * 64 + fr;
#pragma unroll
                        for (int ax = 0; ax < 2; ++ax) { const int pos = ax ? t % GRID_W : t / GRID_W; const float cs = p.rope[pos * 16 + fr], sn = p.rope[1024 + pos * 16 + fr];
                            const float x0 = acc[m][2 * ax][j], x1 = acc[m][2 * ax + 1][j];
                            zr[32 * ax] = f2bf(x0 * cs - x1 * sn); zr[32 * ax + 16] = f2bf(x1 * cs + x0 * sn); } }
            } else {
#pragma unroll
            for (int m = 0; m < 4; ++m)
#pragma unroll
                for (int n = 0; n < 4; ++n) { const int col = tn * 128 + wc * 64 + n * 16 + fr;
                    if (col < ZP) {
#pragma unroll
                        for (int j = 0; j < 4; ++j) p.Z[(size_t)(tm * 128 + wr * 64 + m * 16 + fq * 4 + j) * ZP + col] = f2bf(acc[m][n][j]); } }
            }
            if (tn == ZVB / 128 || (tn >= ZVN / 128 && tn < ZA / 128)) {
#pragma unroll
                for (int m = 0; m < 4; ++m) { const int m0 = tm * 128 + wr * 64 + m * 16 + fq * 4; int b, u;
                    if (m0 < TL) { b = m0 / S; u = L + m0 % S; } else { b = (m0 - TL) / L; u = (m0 - TL) % L; }
#pragma unroll
                    for (int n = 0; n < 4; ++n) { const int col = tn * 128 + wc * 64 + n * 16 + fr;
                        const int hv = col < ZVN ? (col - ZVB) >> 6 : 2 + ((col - ZVN) >> 6), d = col < ZVN ? (col - ZVB) & 63 : (col - ZVN) & 63;
                        st_bf16x4(p.VT + ((size_t)(b * 8 + hv) * 64 + d) * PU + u, acc[m][n]); } }
            }
        });
    }
}
__device__ __forceinline__ void g_gemm_out(const Params& p, int nrows, char* lds) {
    const int tid_ = opq_tid(), bid_ = opq_bid(); (void)tid_; (void)bid_;
    constexpr int NT = D / 128; const int MT = nrows / 128;
    for (int tile = bid_; tile < NT * MT; tile += gridDim.x) {
        const int tm = tile / NT, tn = tile % NT;
        const bf16_t* a0 = p.MIX + (size_t)(tm * 128 + STG_ROW(0)) * DMIX + STG_K; const bf16_t* a1 = p.MIX + (size_t)(tm * 128 + STG_ROW(1)) * DMIX + STG_K;
        const bf16_t* b0 = p.wout_t + (size_t)(tn * 128 + STG_ROW(0)) * DMIX + STG_K; const bf16_t* b1 = p.wout_t + (size_t)(tn * 128 + STG_ROW(1)) * DMIX + STG_K;
        gemm_tile(a0, a1, b0, b1, DMIX, lds, [&](const f32x4 (&acc)[4][4], int wr, int wc, int fr, int fq) {
#pragma unroll
            for (int m = 0; m < 4; ++m)
#pragma unroll
                for (int n = 0; n < 4; ++n)
#pragma unroll
                    for (int j = 0; j < 4; ++j) p.O[(size_t)(tm * 128 + wr * 64 + m * 16 + fq * 4 + j) * D + tn * 128 + wc * 64 + n * 16 + fr] = acc[m][n][j];
        });
    }
}
__device__ __forceinline__ void g_moe1(const Params& p, int l, char* lds) {
    const int tid_ = opq_tid(), bid_ = opq_bid(); (void)tid_; (void)bid_;
    const int* cnt = p.cnt + l * NEXP; const int nrb = moe_blocks(cnt); constexpr int NT = 2 * DE / 128;
    for (int tile = bid_; tile < nrb * NT; tile += gridDim.x) {
        const int rb = tile / NT, tn = tile % NT, e = moe_block_expert(cnt, rb);
        const bf16_t* a0 = p.H + (size_t)p.slotTok[rb * 128 + STG_ROW(0)] * D + STG_K; const bf16_t* a1 = p.H + (size_t)p.slotTok[rb * 128 + STG_ROW(1)] * D + STG_K;
        const bf16_t* bw = p.wgu_t + (size_t)e * 2 * DE * D;
        const bf16_t* b0 = bw + (size_t)(tn * 128 + STG_ROW(0)) * D + STG_K; const bf16_t* b1 = bw + (size_t)(tn * 128 + STG_ROW(1)) * D + STG_K;
        gemm_tile(a0, a1, b0, b1, D, lds, [&](const f32x4 (&acc)[4][4], int wr, int wc, int fr, int fq) {
#pragma unroll
            for (int m = 0; m < 4; ++m)
#pragma unroll
                for (int n2 = 0; n2 < 2; ++n2) { const int col = tn * 64 + wc * 32 + n2 * 16 + fr;
#pragma unroll
                    for (int j = 0; j < 4; ++j) { const float g = acc[m][2 * n2][j], u = acc[m][2 * n2 + 1][j];
                        p.ACT[(size_t)(rb * 128 + wr * 64 + m * 16 + fq * 4 + j) * DE + col] = f2bf(g / (1.0f + __expf(-g)) * u); } }
        });
    }
}
__device__ __forceinline__ void g_moe2(const Params& p, int l, char* lds) {
    const int tid_ = opq_tid(), bid_ = opq_bid(); (void)tid_; (void)bid_;
    const int* cnt = p.cnt + l * NEXP; const int nrb = moe_blocks(cnt); constexpr int NT = D / 128;
    for (int tile = bid_; tile < nrb * NT; tile += gridDim.x) {
        const int rb = tile / NT, tn = tile % NT, e = moe_block_expert(cnt, rb);
        const bf16_t* a0 = p.ACT + (size_t)(rb * 128 + STG_ROW(0)) * DE + STG_K; const bf16_t* a1 = p.ACT + (size_t)(rb * 128 + STG_ROW(1)) * DE + STG_K;
        const bf16_t* bw = p.wd_t + (size_t)e * D * DE;
        const bf16_t* b0 = bw + (size_t)(tn * 128 + STG_ROW(0)) * DE + STG_K; const bf16_t* b1 = bw + (size_t)(tn * 128 + STG_ROW(1)) * DE + STG_K;
        gemm_tile(a0, a1, b0, b1, DE, lds, [&](const f32x4 (&acc)[4][4], int wr, int wc, int fr, int fq) {
#pragma unroll
            for (int m = 0; m < 4; ++m)
#pragma unroll
                for (int n = 0; n < 4; ++n)
#pragma unroll
                    for (int j = 0; j < 4; ++j) p.YS[(size_t)(rb * 128 + wr * 64 + m * 16 + fq * 4 + j) * D + tn * 128 + wc * 64 + n * 16 + fr] = acc[m][n][j];
        });
    }
}


constexpr int DV = D / 256;
static_assert(D % 256 == 0, "row phases hold a row as DV float4 per lane");
template <int CTRL> __device__ __forceinline__ float dppf(float v) { return __builtin_bit_cast(float, __builtin_amdgcn_update_dpp(0, __builtin_bit_cast(int, v), CTRL, 0xf, 0xf, true)); }
__device__ __forceinline__ float wave_sum(float v) {
    v += dppf<0xB1>(v); v += dppf<0x4E>(v); v += dppf<0x141>(v); v += dppf<0x140>(v);
    float a = v, b = v;
    asm volatile("s_nop 1\n\tv_permlane16_swap_b32 %0, %1" : "+v"(a), "+v"(b));
    v = a + b; a = v; b = v;
    asm volatile("s_nop 1\n\tv_permlane32_swap_b32 %0, %1" : "+v"(a), "+v"(b));
    return a + b;
}
__device__ __forceinline__ float sum8(float v) { v += dppf<0xB1>(v); v += dppf<0x4E>(v); v += dppf<0x141>(v); return v; }
__device__ __forceinline__ float sum4(f32x4 a) { return (a[0] + a[1]) + (a[2] + a[3]); }
#define LDS_WAIT() asm volatile("s_waitcnt lgkmcnt(0)" ::: "memory")

__device__ __forceinline__ void row_stats(const f32x4 (&v)[DV], float& mu, float& rstd) {
    float s = 0.f;
#pragma unroll
    for (int j = 0; j < DV; ++j) s += sum4(v[j]);
    mu = wave_sum(s) * (1.0f / D);
    float q = 0.f;
#pragma unroll
    for (int j = 0; j < DV; ++j) { const f32x4 d = v[j] - mu; q += sum4(d * d); }
    rstd = 1.0f / sqrtf(wave_sum(q) * (1.0f / D) + LN_EPS);
}

__device__ __forceinline__ void ph_lnmod_fast(const Params& p, int l) {
    const int tid_ = opq_tid(), bid_ = opq_bid(); (void)tid_; (void)bid_;
    const int lane = tid_ & 63, gw = bid_ * 4 + (tid_ >> 6), nw = gridDim.x * 4;
    for (int m = gw; m < T; m += nw) {
        const f32x4* xr = (const f32x4*)xrow_in(p, l, m) + lane; const f32x4* md = (const f32x4*)modrow(p, l, m) + lane;
        f32x4 v[DV];
#pragma unroll
        for (int j = 0; j < DV; ++j) v[j] = xr[64 * j];
        float mu, rstd; row_stats(v, mu, rstd);
#pragma unroll
        for (int j = 0; j < DV; ++j) { const f32x4 sh = md[64 * j], sc = md[D / 4 + 64 * j];
            st_bf16x4(p.H + (size_t)m * D + 4 * (lane + 64 * j), (v[j] - mu) * rstd * (sc + 1.0f) + sh); }
    }
}

__device__ __forceinline__ void ph_post_mixer_fast(const Params& p, int l, int nrows) {
    const int tid_ = opq_tid(), bid_ = opq_bid(); (void)tid_; (void)bid_;
    const int lane = tid_ & 63, gw = bid_ * 4 + (tid_ >> 6), nw = gridDim.x * 4;
    for (int m = gw; m < nrows; m += nw) {
        const f32x4* xr = (const f32x4*)xrow_in(p, l, m) + lane; const f32x4* md = (const f32x4*)modrow(p, l, m) + lane;
        const f32x4* orow = (const f32x4*)(p.O + (size_t)m * D) + lane;
        f32x4* x1 = (f32x4*)((m < TL) ? p.out + (size_t)m * D : p.XC + (size_t)(m - TL) * D) + lane;
        const f32x4* g1 = (const f32x4*)(p.ln1_g + (size_t)l * D) + lane; const f32x4* b1 = (const f32x4*)(p.ln1_b + (size_t)l * D) + lane;
        f32x4 v[DV];
#pragma unroll
        for (int j = 0; j < DV; ++j) v[j] = xr[64 * j] * ALPHA + md[2 * (D / 4) + 64 * j] * orow[64 * j];
        float mu, rstd; row_stats(v, mu, rstd);
#pragma unroll
        for (int j = 0; j < DV; ++j) { v[j] = (v[j] - mu) * rstd * g1[64 * j] + b1[64 * j]; x1[64 * j] = v[j]; }
        row_stats(v, mu, rstd);
#pragma unroll
        for (int j = 0; j < DV; ++j) {
            const f32x4 hv = (v[j] - mu) * rstd * (md[4 * (D / 4) + 64 * j] + 1.0f) + md[3 * (D / 4) + 64 * j];
            f32x4 hh, lo;
#pragma unroll
            for (int e = 0; e < 4; ++e) { hh[e] = bf2f(f2bf(hv[e])); lo[e] = hv[e] - hh[e]; }
            st_bf16x4(p.H + (size_t)m * D + 4 * (lane + 64 * j), hh);
            st_bf16x4(p.HLO + (size_t)m * D + 4 * (lane + 64 * j), lo);
        }
    }
}

__device__ __forceinline__ void g_router(const Params& p, int l, int nrows, char* lds) {
    const int tid_ = opq_tid(), bid_ = opq_bid(); (void)tid_; (void)bid_;
    const int lane = tid_ & 63, wid = tid_ >> 6, fr = lane & 15, fq = lane >> 4;
    float* part = (float*)lds;
    float* lgt = part + 4 * 6 * 64 * 4;
    int* eids = (int*)(lgt + 32 * 48);
    for (int rg = bid_; rg < nrows / 32; rg += gridDim.x) {
        f32x4 acc[2][3];
#pragma unroll
        for (int a = 0; a < 2; ++a)
#pragma unroll
            for (int b = 0; b < 3; ++b) acc[a][b] = (f32x4){0.f, 0.f, 0.f, 0.f};
#pragma unroll
        for (int seg = 0; seg < 3; ++seg) {
            const bf16_t* ap = (seg < 2 ? p.H : p.HLO) + (size_t)(rg * 32 + fr) * D + wid * (D / 4) + fq * 8;
            const bf16_t* bp = p.wrt + (seg == 1 ? (size_t)128 * D : 0) + (size_t)fr * D + wid * (D / 4) + fq * 8;
#pragma unroll 1
            for (int ks0 = 0; ks0 < D / 128; ks0 += 4) {
                bf16x8 av[4][2], bv[4][3];
#pragma unroll
                for (int u = 0; u < 4; ++u) { const int ko = (ks0 + u) * 32;
                    av[u][0] = *(const bf16x8*)(ap + ko); av[u][1] = *(const bf16x8*)(ap + (size_t)16 * D + ko);
                    bv[u][0] = *(const bf16x8*)(bp + ko); bv[u][1] = *(const bf16x8*)(bp + (size_t)16 * D + ko); bv[u][2] = *(const bf16x8*)(bp + (size_t)32 * D + ko); }
                asm volatile("" ::: "memory");
#pragma unroll
                for (int u = 0; u < 4; ++u)
#pragma unroll
                    for (int a = 0; a < 2; ++a)
#pragma unroll
                        for (int b = 0; b < 3; ++b) acc[a][b] = __builtin_amdgcn_mfma_f32_16x16x32_bf16(av[u][a], bv[u][b], acc[a][b], 0, 0, 0);
            }
        }
#pragma unroll
        for (int a = 0; a < 2; ++a)
#pragma unroll
            for (int b = 0; b < 3; ++b) *(f32x4*)(part + ((wid * 6 + a * 3 + b) * 64 + lane) * 4) = acc[a][b];
        __syncthreads();
#pragma unroll
        for (int i = 0; i < 6; ++i) { const int e = tid_ + 256 * i, f = e >> 8, ln = (e & 255) >> 2, j = e & 3;
            const float sm = (part[((0 * 6 + f) * 64 + ln) * 4 + j] + part[((1 * 6 + f) * 64 + ln) * 4 + j]) + (part[((2 * 6 + f) * 64 + ln) * 4 + j] + part[((3 * 6 + f) * 64 + ln) * 4 + j]);
            lgt[((f / 3) * 16 + (ln >> 4) * 4 + j) * 48 + (f % 3) * 16 + (ln & 15)] = sm; }
        __syncthreads();
        if (tid_ < 32) {
            const int m = rg * 32 + tid_; const float* lg = lgt + tid_ * 48;
            float gl[4], el[32];
#pragma unroll
            for (int g = 0; g < 4; ++g) gl[g] = lg[g] + p.b_rg[l * 4 + g];
#pragma unroll
            for (int e = 0; e < 32; ++e) el[e] = lg[4 + e] + p.b_re[l * 32 + e];
            int gs = 0; float gm = gl[0];
#pragma unroll
            for (int g = 1; g < 4; ++g) if (gl[g] > gm) { gm = gl[g]; gs = g; }
            float den = 0.f;
#pragma unroll
            for (int g = 0; g < 4; ++g) den += expf(gl[g] - gm);
            const float pg = 1.0f / den;
            float v1 = -3e38f, v2 = -3e38f; int i1 = 0, i2 = 0;
#pragma unroll
            for (int j = 0; j < 8; ++j) {
                const float vv = gs == 0 ? el[j] : gs == 1 ? el[8 + j] : gs == 2 ? el[16 + j] : el[24 + j];
                if (vv > v1) { v2 = v1; i2 = i1; v1 = vv; i1 = j; } else if (vv > v2) { v2 = vv; i2 = j; }
            }
            const float e2 = expf(v2 - v1), w1 = pg / (1.0f + e2), w2 = pg * e2 / (1.0f + e2);
            const int ea = gs * 8 + i1, eb = gs * 8 + i2;
            p.rE[2 * m] = ea; p.rE[2 * m + 1] = eb; p.rW[2 * m] = w1; p.rW[2 * m + 1] = w2;
            eids[2 * tid_] = ea; eids[2 * tid_ + 1] = eb;
        }
        __syncthreads();
        if (tid_ < 64) { const int e = eids[tid_]; int rk = 0; for (int j = 0; j < tid_; ++j) rk += (eids[j] == e) ? 1 : 0; p.rPos[2 * (rg * 32) + tid_] = rk; }
        else if (tid_ < 96) { const int e = tid_ - 64; int c = 0; for (int j = 0; j < 64; ++j) c += (eids[j] == e) ? 1 : 0; p.hist[rg * 32 + e] = c; }
        __syncthreads();
    }
}

__device__ __forceinline__ void ph_dispatch_fast(const Params& p, int l, int nrows, char* lds) {
    const int tid_ = opq_tid(), bid_ = opq_bid(); (void)tid_; (void)bid_;
    const int nrg = nrows / 32, e = tid_ & 31, part = tid_ >> 5;
    int* tot = (int*)lds; int* pst = tot + 32; int* pre = pst + 32; int* red = pre + 32;
    { int s = 0; for (int b = part; b < nrg; b += 8) s += p.hist[b * 32 + e]; red[part * 32 + e] = s; }
    __syncthreads();
    if (tid_ < 32) { int s = 0; for (int q = 0; q < 8; ++q) s += red[q * 32 + tid_]; tot[tid_] = s; }
    __syncthreads();
    if (tid_ < 32) { int s = 0; for (int j = 0; j < tid_; ++j) s += (tot[j] + 127) & ~127; pst[tid_] = s; if (bid_ == 0) p.cnt[l * NEXP + tid_] = tot[tid_]; }
    for (int rg = bid_; rg < nrg; rg += gridDim.x) {
        __syncthreads();
        { int s = 0; for (int b = part; b < rg; b += 8) s += p.hist[b * 32 + e]; red[part * 32 + e] = s; }
        __syncthreads();
        if (tid_ < 32) { int s = 0; for (int q = 0; q < 8; ++q) s += red[q * 32 + tid_]; pre[tid_] = s; }
        __syncthreads();
        if (tid_ < 64) { const int i = 2 * (rg * 32) + tid_, ee = p.rE[i], slot = pst[ee] + pre[ee] + p.rPos[i]; p.rSlot[i] = slot; p.slotTok[slot] = i >> 1; }
    }
}

__device__ __forceinline__ void ph_final_fast(const Params& p, int l, int nrows) {
    const int tid_ = opq_tid(), bid_ = opq_bid(); (void)tid_; (void)bid_;
    const int lane = tid_ & 63, gw = bid_ * 4 + (tid_ >> 6), nw = gridDim.x * 4;
    for (int m = gw; m < nrows; m += nw) {
        f32x4* x1 = (f32x4*)((m < TL) ? p.out + (size_t)m * D : p.XC + (size_t)(m - TL) * D) + lane;
        const f32x4* md = (const f32x4*)modrow(p, l, m) + lane;
        const f32x4* ya = (const f32x4*)(p.YS + (size_t)p.rSlot[2 * m] * D) + lane; const f32x4* yb = (const f32x4*)(p.YS + (size_t)p.rSlot[2 * m + 1] * D) + lane;
        const float wa = p.rW[2 * m], wb = p.rW[2 * m + 1];
        const f32x4* g2 = (const f32x4*)(p.ln2_g + (size_t)l * D) + lane; const f32x4* b2 = (const f32x4*)(p.ln2_b + (size_t)l * D) + lane;
        f32x4 v[DV];
#pragma unroll
        for (int j = 0; j < DV; ++j) v[j] = x1[64 * j] * ALPHA + md[5 * (D / 4) + 64 * j] * (ya[64 * j] * wa + yb[64 * j] * wb);
        float mu, rstd; row_stats(v, mu, rstd);
#pragma unroll
        for (int j = 0; j < DV; ++j) x1[64 * j] = (v[j] - mu) * rstd * g2[64 * j] + b2[64 * j];
    }
}

__device__ __forceinline__ void ph_mod_fast(const Params& p, char* lds) {
    const int tid_ = opq_tid(), bid_ = opq_bid(); (void)tid_; (void)bid_;
    constexpr int NR = NB + 1, NTASK = 2 * (6 * D / 64);
    if (bid_ >= NTASK) return;
    float* sc = (float*)lds;
    float* part = sc + NR * D;
    for (int i = tid_; i < NR * D; i += 256) { const int b = i / D, k = i % D; const float cv = b < NB ? p.c[(size_t)b * D + k] : p.c_ctx[k]; sc[i] = cv / (1.0f + __expf(-cv)); }
    __syncthreads();
    const int lane = tid_ & 63, wid = tid_ >> 6;
    for (int task = bid_; task < NTASK; task += gridDim.x) {
        const int ll = task / (6 * D / 64), col = 64 * (task % (6 * D / 64)) + lane;
        float acc[NR];
#pragma unroll
        for (int b = 0; b < NR; ++b) acc[b] = 0.f;
        const float* wp = p.w_mod + ((size_t)ll * D + wid * (D / 4)) * 6 * D + col;
#pragma unroll 16
        for (int k = 0; k < D / 4; ++k) { const float w = wp[(size_t)k * 6 * D];
#pragma unroll
            for (int b = 0; b < NR; ++b) acc[b] += sc[b * D + wid * (D / 4) + k] * w; }
#pragma unroll
        for (int b = 0; b < NR; ++b) part[(wid * NR + b) * 64 + lane] = acc[b];
        __syncthreads();
        for (int i = tid_; i < NR * 64; i += 256) { const int b = i / 64, cl = i % 64;
            p.mod[((size_t)ll * NR + b) * 6 * D + 64 * (task % (6 * D / 64)) + cl] = (part[(0 * NR + b) * 64 + cl] + part[(1 * NR + b) * 64 + cl]) + (part[(2 * NR + b) * 64 + cl] + part[(3 * NR + b) * 64 + cl]) + p.b_mod[(size_t)ll * 6 * D + 64 * (task % (6 * D / 64)) + cl]; }
        __syncthreads();
    }
}

template <bool SPLIT = false>
__device__ __forceinline__ void tr_item(const float* srcl, size_t ldw, bf16_t* dst, size_t ldd, float* scr, int lane) {
    float v[32];
#pragma unroll
    for (int i = 0; i < 32; ++i) v[i] = srcl ? srcl[(size_t)(2 * i + (lane >> 5)) * ldw] : 0.f;
#pragma unroll
    for (int i = 0; i < 32; ++i) scr[(2 * i + (lane >> 5)) * 33 + (lane & 31)] = v[i];
    LDS_WAIT();
    const int c = lane & 7;
#pragma unroll
    for (int j = 0; j < 4; ++j) { const int n = (lane >> 3) + 8 * j; const float* s = scr + (8 * c) * 33 + n;
        uint4 o; o.x = pk2(s[0], s[33]); o.y = pk2(s[2 * 33], s[3 * 33]); o.z = pk2(s[4 * 33], s[5 * 33]); o.w = pk2(s[6 * 33], s[7 * 33]);
        *(uint4*)(dst + (size_t)(SPLIT ? (n & 15) + 32 * (n >> 4) : n) * ldd + 8 * c) = o; }
    LDS_WAIT();
}
__device__ __forceinline__ void ph_prep_w_fast(const Params& p, int l, int part, char* lds) {
    const int tid_ = opq_tid(), bid_ = opq_bid(); (void)tid_; (void)bid_;
    const int lane = tid_ & 63, wid = tid_ >> 6, gw = bid_ * 4 + wid, nw = gridDim.x * 4;
    float* scr = (float*)(lds + wid * 8448);
    constexpr int I_IN = (D / 64) * (NINP / 32), I_OUT = (DMIX / 64) * (D / 32), I_GU1 = (D / 64) * (2 * DE / 32), I_D1 = (DE / 64) * (D / 32);
    constexpr int NITEMS = I_IN + I_OUT + NEXP * (I_GU1 + I_D1);
    const int it0 = part == 0 ? 0 : I_IN + I_OUT, it1 = part == 0 ? I_IN + I_OUT : NITEMS;
    for (int it = it0 + gw; it < it1; it += nw) {
        int r = it;
        if (r < I_IN) { const int kb = r / (NINP / 32), n0 = 32 * (r % (NINP / 32));
            const float* s = nullptr;
            if (n0 < N_IN) { const int oc = (n0 < ZA) ? n0 + A_IN : n0 - ZA; s = p.w_in + ((size_t)l * D + 64 * kb) * N_IN + oc + (lane & 31); }
            tr_item(s, N_IN, p.win_t + (size_t)n0 * D + 64 * kb, D, scr, lane); continue; }
        r -= I_IN;
        if (r < I_OUT) { const int kb = r / (D / 32), n0 = 32 * (r % (D / 32));
            tr_item(p.w_out + ((size_t)l * DMIX + 64 * kb) * D + n0 + (lane & 31), D, p.wout_t + (size_t)n0 * DMIX + 64 * kb, DMIX, scr, lane); continue; }
        r -= I_OUT;
        const int e = r / (I_GU1 + I_D1); r %= (I_GU1 + I_D1);
        if (r < I_GU1) { const int kb = r / (2 * DE / 32), q = r % (2 * DE / 32), up = q & 1, c0 = 32 * (q >> 1);
            const float* s = (up ? p.w_up : p.w_gate) + (((size_t)l * NEXP + e) * D + 64 * kb) * DE + c0 + (lane & 31);
            tr_item<true>(s, DE, p.wgu_t + ((size_t)e * 2 * DE + 2 * c0 + 16 * up) * D + 64 * kb, D, scr, lane); continue; }
        r -= I_GU1;
        { const int kb = r / (D / 32), n0 = 32 * (r % (D / 32));
            tr_item(p.w_down + (((size_t)l * NEXP + e) * DE + 64 * kb) * D + n0 + (lane & 31), D, p.wd_t + ((size_t)e * D + n0) * DE + 64 * kb, DE, scr, lane); }
    }
    if (part != 0) return;
    const long gt = (long)bid_ * blockDim.x + tid_, gs = (long)gridDim.x * blockDim.x;
    for (long i = gt; i < 2 * 256 * 64; i += gs) { const int k = (int)(i & 63), n = (int)((i >> 6) & 255), d = (int)(i >> 14);
        p.wupT[i] = f2bf(p.a_w_up[(((size_t)l * 2 + d) * 64 + k) * DA + n]); p.aupT[i] = f2bf(p.a_a_up[(((size_t)l * 2 + d) * 64 + k) * DA + n]); }
    for (long i = gt; i < 256 * 160; i += gs) { const int k = (int)(i % 160), n = (int)(i / 160); p.gupT[i] = f2bf(p.a_g_up[((size_t)l * 160 + k) * DA + n]); }
    for (long i = gt; i < (long)128 * D; i += gs) { const int n = (int)(i / D), k = (int)(i % D);
        const float w = n < 4 ? p.w_rg[((size_t)l * D + k) * 4 + n] : n < 36 ? p.w_re[((size_t)l * D + k) * 32 + n - 4] : 0.f;
        const bf16_t hb = f2bf(w); p.wrt[i] = hb; p.wrt[(size_t)128 * D + i] = f2bf(w - bf2f(hb)); }
}

__device__ __forceinline__ float tanh_fast(float x) { return 1.0f - 2.0f / (1.0f + __expf(2.0f * x)); }
__device__ __forceinline__ void ph_streams_s1(const Params& p, int l) {
    const int tid_ = opq_tid(), bid_ = opq_bid(); (void)tid_; (void)bid_;
    constexpr int NCH = A_IN / 8, NCHP = (NCH + 7) & ~7;
    const float* sh = p.a_shift + (size_t)l * 3 * A_IN;
    for (long it = (long)bid_ * 256 + tid_; it < (long)T * NCHP; it += (long)gridDim.x * 256) {
        const int m = (int)(it / NCHP), ch = (int)(it % NCHP), c0 = 8 * ch;
        const bool act = ch < NCH;
        int t, len;
        if (m < TL) { t = m % S; len = S; } else { t = (m - TL) % L; len = L; }
        float v[8];
#pragma unroll
        for (int e = 0; e < 8; ++e) v[e] = 0.f;
        if (act) {
            const bf16_t* z = p.Z + (size_t)m * ZP + ZA + c0;
            const bf16x8 zc = *(const bf16x8*)z;
            const f32x4 s1a = *(const f32x4*)(sh + A_IN + c0), s1b = *(const f32x4*)(sh + A_IN + c0 + 4);
#pragma unroll
            for (int e = 0; e < 8; ++e) v[e] = (e < 4 ? s1a[e] : s1b[e - 4]) * bf2f((bf16_t)zc[e]);
            if (t > 0) { const bf16x8 zp = *(const bf16x8*)(z - ZP); const f32x4 a = *(const f32x4*)(sh + c0), b = *(const f32x4*)(sh + c0 + 4);
#pragma unroll
                for (int e = 0; e < 8; ++e) v[e] += (e < 4 ? a[e] : b[e - 4]) * bf2f((bf16_t)zp[e]); }
            if (t < len - 1) { const bf16x8 zn = *(const bf16x8*)(z + ZP); const f32x4 a = *(const f32x4*)(sh + 2 * A_IN + c0), b = *(const f32x4*)(sh + 2 * A_IN + c0 + 4);
#pragma unroll
                for (int e = 0; e < 8; ++e) v[e] += (e < 4 ? a[e] : b[e - 4]) * bf2f((bf16_t)zn[e]); }
        }
        float nrm = 0.f;
        if (ch >= 32 && ch < 64) {
#pragma unroll
            for (int e = 0; e < 8; ++e) { const float t2 = v[e] * p.a_k_k[l * DA + c0 - 256 + e]; nrm += t2 * t2; } }
        nrm = sum8(nrm);
        if (!act) continue;
        if (c0 < 768) {
            float* dst = (c0 < 256 ? p.sR + (size_t)m * DA + c0 : c0 < 512 ? p.kT + (size_t)m * DA + c0 - 256 : p.sV + (size_t)m * DA + c0 - 512);
            *(f32x4*)dst = (f32x4){v[0], v[1], v[2], v[3]}; *(f32x4*)(dst + 4) = (f32x4){v[4], v[5], v[6], v[7]};
            if (ch >= 32 && ch < 64 && (ch & 7) == 0) p.kN[(size_t)m * 4 + ((ch - 32) >> 3)] = 1.0f / sqrtf(nrm + 1e-12f);
        } else {
            if (c0 < 896) {
#pragma unroll
                for (int e = 0; e < 8; ++e) v[e] = tanh_fast(v[e]); }
            else if (c0 >= 1024) {
#pragma unroll
                for (int e = 0; e < 8; ++e) v[e] = 1.0f / (1.0f + __expf(-v[e])); }
            uint4 o; o.x = pk2(v[0], v[1]); o.y = pk2(v[2], v[3]); o.z = pk2(v[4], v[5]); o.w = pk2(v[6], v[7]);
            *(uint4*)(p.LA + (size_t)m * 416 + c0 - 768) = o;
        }
    }
}
__device__ __forceinline__ void g_streams_s2(const Params& p, int l, char* lds) {
    const int tid_ = opq_tid(), bid_ = opq_bid(); (void)tid_; (void)bid_;
    constexpr int MT = T / 128;
    for (int job = bid_; job < 5 * MT * 2; job += gridDim.x) {
        const int type = job / (MT * 2), r = job % (MT * 2), tm = r >> 1, tn = r & 1;
        const int coff = type < 2 ? type * 64 : type < 4 ? 128 + (type - 2) * 64 : 256, K = type < 4 ? 64 : 160, d = type & 1;
        const bf16_t* Bt = type < 2 ? p.wupT + type * 256 * 64 : type < 4 ? p.aupT + (type - 2) * 256 * 64 : p.gupT;
        const bf16_t* a0 = p.LA + (size_t)(tm * 128 + STG_ROW(0)) * 416 + coff + STG_K; const bf16_t* a1 = p.LA + (size_t)(tm * 128 + STG_ROW(1)) * 416 + coff + STG_K;
        const bf16_t* b0 = Bt + (size_t)(tn * 128 + STG_ROW(0)) * K + STG_K; const bf16_t* b1 = Bt + (size_t)(tn * 128 + STG_ROW(1)) * K + STG_K;
        if (type < 2) gemm_tile(a0, a1, b0, b1, K, lds, [&](const f32x4 (&acc)[4][4], int wr, int wc, int fr, int fq) {
#pragma unroll
            for (int mi = 0; mi < 4; ++mi) {
#pragma unroll
                for (int n = 0; n < 4; ++n) { const int c = tn * 128 + wc * 64 + n * 16 + fr; const float w0 = p.a_w0[(l * 2 + d) * DA + c];
#pragma unroll
                    for (int j = 0; j < 4; ++j) { const int row = tm * 128 + wr * 64 + mi * 16 + fq * 4 + j;
                        const float e = __expf(-(w0 + acc[mi][n][j]));
                        p.sW[((size_t)d * T + row) * DA + c] = __expf(-0.60653065971f / (1.0f + e)); } }
                asm volatile("" ::: "memory"); }
        });
        else if (type < 4) gemm_tile(a0, a1, b0, b1, K, lds, [&](const f32x4 (&acc)[4][4], int wr, int wc, int fr, int fq) {
#pragma unroll
            for (int mi = 0; mi < 4; ++mi) {
#pragma unroll
                for (int n = 0; n < 4; ++n) { const int c = tn * 128 + wc * 64 + n * 16 + fr;
                    const float a0v = p.a_a0[(l * 2 + d) * DA + c], kkc = p.a_k_k[l * DA + c], kac = p.a_k_a[l * DA + c];
#pragma unroll
                    for (int j = 0; j < 4; ++j) { const int row = tm * 128 + wr * 64 + mi * 16 + fq * 4 + j;
                        const size_t o = (size_t)row * DA + c, od = ((size_t)d * T + row) * DA + c;
                        const float av = 1.0f / (1.0f + __expf(-(a0v + acc[mi][n][j]))); const float k = p.kT[o];
                        const float kk = k * kkc * p.kN[(size_t)row * 4 + (c >> 6)];
                        p.sKD[od] = k * (1.0f + (av - 1.0f) * kac); p.sB[od] = kk * av; if (d == 0) p.sKK[o] = kk; } }
                asm volatile("" ::: "memory"); }
        });
        else gemm_tile(a0, a1, b0, b1, K, lds, [&](const f32x4 (&acc)[4][4], int wr, int wc, int fr, int fq) {
#pragma unroll
            for (int mi = 0; mi < 4; ++mi)
#pragma unroll
                for (int n = 0; n < 4; ++n) { const int c = tn * 128 + wc * 64 + n * 16 + fr;
#pragma unroll
                    for (int j = 0; j < 4; ++j) p.sG[(size_t)(tm * 128 + wr * 64 + mi * 16 + fq * 4 + j) * DA + c] = acc[mi][n][j]; }
        });
    }
}


typedef float f32x16 __attribute__((ext_vector_type(16)));
typedef short s16x4 __attribute__((ext_vector_type(4)));
typedef unsigned u32x4_t __attribute__((ext_vector_type(4)));
typedef float f32x2_t __attribute__((ext_vector_type(2)));
typedef __bf16 bf16x2_t __attribute__((ext_vector_type(2)));
__device__ __forceinline__ unsigned cvtpk(float lo, float hi) { f32x2_t v = {lo, hi}; bf16x2_t b = __builtin_convertvector(v, bf16x2_t); return __builtin_bit_cast(unsigned, b); }
__device__ __forceinline__ int crow(int r, int hi) { return (r & 3) + 8 * (r >> 2) + 4 * hi; }

template <class MaskF>
__device__ __forceinline__ void attn_tile(const bf16x8 (&qf)[4], const bf16_t* krow, const bf16_t* vt0, const bf16_t* vt1, const MaskF& mask,
                                          float& m_run, float& l_run, f32x16& o0, f32x16& o1, int hi) {
    f32x16 s;
#pragma unroll
    for (int r = 0; r < 16; ++r) s[r] = 0.f;
#pragma unroll
    for (int ks = 0; ks < 4; ++ks) { const bf16x8 kf = *(const bf16x8*)(krow + 16 * ks); s = __builtin_amdgcn_mfma_f32_32x32x16_bf16(kf, qf[ks], s, 0, 0, 0); }
    float mx = -INFINITY;
#pragma unroll
    for (int r = 0; r < 16; ++r) { s[r] = mask(crow(r, hi), s[r] * ATT_SCALE); mx = fmaxf(mx, s[r]); }
    mx = fmaxf(mx, __shfl_xor(mx, 32));
    const float mn = fmaxf(m_run, mx), alpha = __expf(m_run - mn);
    m_run = mn;
    float ps = 0.f;
#pragma unroll
    for (int r = 0; r < 16; ++r) { s[r] = __expf(s[r] - mn); ps += s[r]; }
    l_run = l_run * alpha + ps;
#pragma unroll
    for (int r = 0; r < 16; ++r) { o0[r] *= alpha; o1[r] *= alpha; }
#pragma unroll
    for (int s2 = 0; s2 < 2; ++s2) {
        u32x4_t pw; pw[0] = cvtpk(s[8 * s2], s[8 * s2 + 1]); pw[1] = cvtpk(s[8 * s2 + 2], s[8 * s2 + 3]); pw[2] = cvtpk(s[8 * s2 + 4], s[8 * s2 + 5]); pw[3] = cvtpk(s[8 * s2 + 6], s[8 * s2 + 7]);
        const bf16x8 pb = __builtin_bit_cast(bf16x8, pw);
        const s16x4 a0 = *(const s16x4*)(vt0 + 16 * s2), a1 = *(const s16x4*)(vt0 + 16 * s2 + 8);
        const s16x4 c0 = *(const s16x4*)(vt1 + 16 * s2), c1 = *(const s16x4*)(vt1 + 16 * s2 + 8);
        o0 = __builtin_amdgcn_mfma_f32_32x32x16_bf16(__builtin_shufflevector(a0, a1, 0, 1, 2, 3, 4, 5, 6, 7), pb, o0, 0, 0, 0);
        o1 = __builtin_amdgcn_mfma_f32_32x32x16_bf16(__builtin_shufflevector(c0, c1, 0, 1, 2, 3, 4, 5, 6, 7), pb, o1, 0, 0, 0);
    }
}
struct NoMask { __device__ __forceinline__ float operator()(int, float v) const { return v; } };

__device__ __forceinline__ void ph_attn_mfma(const Params& p, int l, bool with_ctx) {
    const int tid_ = opq_tid(), bid_ = opq_bid(); (void)tid_; (void)bid_;
    const int lane = tid_ & 63, hi = lane >> 5, ql = lane & 31;
    const int gw = bid_ * 4 + (tid_ >> 6), nw = gridDim.x * 4;
    constexpr int NQT = S / 32, NCT = L / 32, N_LAT = NB * 6 * NQT, N_CTX = NB * 6 * NCT;
    const int ntask = 2 * N_LAT + (with_ctx ? 2 * N_CTX : 0);
    for (int task = gw; task < ntask; task += nw) {
        bool isC, isCtx; int r;
        if (task < N_LAT) { isC = true; isCtx = false; r = task; }
        else if (task < 2 * N_LAT) { isC = false; isCtx = false; r = task - N_LAT; }
        else { r = task - 2 * N_LAT; isCtx = true; isC = r >= N_CTX; if (isC) r -= N_CTX; }
        const int nqt = isCtx ? NCT : NQT, qt = r % nqt, h = (r / nqt) % 6, b = r / (nqt * 6);
        const int m = isCtx ? TL + b * L + 32 * qt + ql : b * S + 32 * qt + ql;
        const int qcol = isC ? ZQN + h * 64 : ZQB + h * 64, kcol = isC ? ZKN + h * 64 : ZKB + (h / 3) * 64, hv = isC ? 2 + h : h / 3;
        bf16x8 qf[4];
        { const bf16_t* qp = p.Z + (size_t)m * ZP + qcol + 8 * hi;
#pragma unroll
          for (int ks = 0; ks < 4; ++ks) qf[ks] = *(const bf16x8*)(qp + 16 * ks); }
        const bf16_t* kc0 = p.Z + (size_t)(TL + b * L + ql) * ZP + kcol + 8 * hi;
        const bf16_t* kl0 = p.Z + (size_t)(b * S + ql) * ZP + kcol + 8 * hi;
        const bf16_t* vt0 = p.VT + ((size_t)(b * 8 + hv) * 64 + ql) * PU + 4 * hi; const bf16_t* vt1 = vt0 + (size_t)32 * PU;
        f32x16 o0, o1;
#pragma unroll
        for (int rr = 0; rr < 16; ++rr) { o0[rr] = 0.f; o1[rr] = 0.f; }
        float m_run, l_run;
        if (isC) { m_run = -1e30f; l_run = 0.f; } else { m_run = p.b_sink[l * 6 + h]; l_run = hi == 0 ? 1.0f : 0.f; }
#pragma unroll 1
        for (int i = 0; i < NCT; ++i) attn_tile(qf, kc0 + (size_t)(32 * i) * ZP, vt0 + 32 * i, vt1 + 32 * i, NoMask(), m_run, l_run, o0, o1, hi);
        if (!isCtx) {
            if (!isC) {
#pragma unroll 1
                for (int jt = qt - 4; jt <= qt + 4; ++jt) {
                    if (jt < 0 || jt >= NQT) continue;
                    const bf16_t* kr = kl0 + (size_t)(32 * jt) * ZP; const bf16_t* v0 = vt0 + L + 32 * jt; const bf16_t* v1 = vt1 + L + 32 * jt;
                    if (jt == qt - 4 || jt == qt + 4) { const int base = 32 * (jt - qt) - ql;
                        attn_tile(qf, kr, v0, v1, [&](int ko, float v) { const int rel = base + ko; return (rel >= -128 && rel <= 128) ? v : -INFINITY; }, m_run, l_run, o0, o1, hi); }
                    else attn_tile(qf, kr, v0, v1, NoMask(), m_run, l_run, o0, o1, hi);
                }
            } else {
                constexpr int ROWS = S / GRID_W;
                const int gr = qt >> 1, c = 32 * (qt & 1) + ql;
                int r0 = gr - 4; r0 = r0 < 0 ? 0 : (r0 > ROWS - 8 ? ROWS - 8 : r0);
                int c0 = c - 8; c0 = c0 < 0 ? 0 : (c0 > GRID_W - 16 ? GRID_W - 16 : c0);
                const float* rpb = p.c_rpb + ((size_t)l * 6 + h) * 15 * 31;
#pragma unroll 1
                for (int a = 0; a < 8; ++a) {
                    const int kr_ = r0 + a; const float* rp = rpb + (kr_ - gr + 7) * 31 + 15 - c;
#pragma unroll 1
                    for (int ct = 0; ct < 2; ++ct) {
                        const int t0 = kr_ * GRID_W + 32 * ct;
                        attn_tile(qf, kl0 + (size_t)t0 * ZP, vt0 + L + t0, vt1 + L + t0,
                                  [&](int ko, float v) { const int kc = 32 * ct + ko; return (kc >= c0 && kc < c0 + 16) ? v + rp[kc] : -INFINITY; }, m_run, l_run, o0, o1, hi);
                    }
                }
            }
        }
        const float lt = l_run + __shfl_xor(l_run, 32), inv = 1.0f / lt;
        bf16_t* op = p.MIX + (size_t)m * DMIX + (isC ? 640 : 256) + h * 64 + 4 * hi;
#pragma unroll
        for (int g = 0; g < 4; ++g) {
            st_bf16x4(op + 8 * g, (f32x4){o0[4 * g] * inv, o0[4 * g + 1] * inv, o0[4 * g + 2] * inv, o0[4 * g + 3] * inv});
            st_bf16x4(op + 32 + 8 * g, (f32x4){o1[4 * g] * inv, o1[4 * g + 1] * inv, o1[4 * g + 2] * inv, o1[4 * g + 3] * inv});
        }
    }
}


template <class MaskF>
__device__ __forceinline__ void attn_tile_lds(const bf16x8 (&qf)[4], const char* ks, const char* vs, const MaskF& mask, float& m_run, float& l_run, f32x16& o0, f32x16& o1, int ql, int hi) {
    f32x16 s;
#pragma unroll
    for (int r = 0; r < 16; ++r) s[r] = 0.f;
#pragma unroll
    for (int k4 = 0; k4 < 4; ++k4) { const bf16x8 kf = *(const bf16x8*)(ks + ql * 128 + (((2 * k4 + hi) ^ (ql & 7)) * 16)); s = __builtin_amdgcn_mfma_f32_32x32x16_bf16(kf, qf[k4], s, 0, 0, 0); }
    float mx = -INFINITY;
#pragma unroll
    for (int r = 0; r < 16; ++r) { s[r] = mask(crow(r, hi), s[r] * ATT_SCALE); mx = fmaxf(mx, s[r]); }
    mx = fmaxf(mx, __shfl_xor(mx, 32));
    const float mn = fmaxf(m_run, mx), alpha = __expf(m_run - mn);
    m_run = mn;
    float ps = 0.f;
#pragma unroll
    for (int r = 0; r < 16; ++r) { s[r] = __expf(s[r] - mn); ps += s[r]; }
    l_run = l_run * alpha + ps;
#pragma unroll
    for (int r = 0; r < 16; ++r) { o0[r] *= alpha; o1[r] *= alpha; }
    const int sw0 = (ql >> 2) & 3;
#pragma unroll
    for (int s2 = 0; s2 < 2; ++s2) {
        u32x4_t pw; pw[0] = cvtpk(s[8 * s2], s[8 * s2 + 1]); pw[1] = cvtpk(s[8 * s2 + 2], s[8 * s2 + 3]); pw[2] = cvtpk(s[8 * s2 + 4], s[8 * s2 + 5]); pw[3] = cvtpk(s[8 * s2 + 6], s[8 * s2 + 7]);
        const bf16x8 pb = __builtin_bit_cast(bf16x8, pw);
        const char* v0 = vs + ql * 64 + 8 * hi; const char* v1 = v0 + 32 * 64;
        const s16x4 a0 = *(const s16x4*)(v0 + (((2 * s2) ^ sw0) * 16)), a1 = *(const s16x4*)(v0 + (((2 * s2 + 1) ^ sw0) * 16));
        const s16x4 c0 = *(const s16x4*)(v1 + (((2 * s2) ^ sw0) * 16)), c1 = *(const s16x4*)(v1 + (((2 * s2 + 1) ^ sw0) * 16));
        o0 = __builtin_amdgcn_mfma_f32_32x32x16_bf16(__builtin_shufflevector(a0, a1, 0, 1, 2, 3, 4, 5, 6, 7), pb, o0, 0, 0, 0);
        o1 = __builtin_amdgcn_mfma_f32_32x32x16_bf16(__builtin_shufflevector(c0, c1, 0, 1, 2, 3, 4, 5, 6, 7), pb, o1, 0, 0, 0);
    }
}

__device__ __forceinline__ void ph_attn_blk(const Params& p, int l, bool with_ctx, int first_blk, char* lds) {
    const int tid_ = opq_tid(), bid_ = opq_bid(); (void)tid_; (void)bid_;
    if (bid_ < first_blk) return;
    const int lane = tid_ & 63, hi = lane >> 5, ql = lane & 31, wid = tid_ >> 6;
    constexpr int NQG = S / 128, NCG = L / 128, ROWS = S / GRID_W, N_LAT = NB * 6 * NQG, N_CTX = NB * 6 * NCG, TPB = (S + L) / 32;
    const int ntask = 2 * N_LAT + (with_ctx ? 2 * N_CTX : 0);
    const int krow = tid_ >> 3, kch = (tid_ & 7) ^ (krow & 7), vrow = tid_ >> 2, vpc = (tid_ & 3) ^ ((vrow >> 2) & 3);
    for (int task = bid_ - first_blk; task < ntask; task += gridDim.x - first_blk) {
        bool isC, isCtx; int r;
        if (task < N_LAT) { isC = true; isCtx = false; r = task; }
        else if (task < 2 * N_LAT) { isC = false; isCtx = false; r = task - N_LAT; }
        else { r = task - 2 * N_LAT; isCtx = true; isC = r >= N_CTX; if (isC) r -= N_CTX; }
        const int ng = isCtx ? NCG : NQG, g = r % ng, h = (r / ng) % 6, b = r / (ng * 6);
        const int qt = 4 * g + wid;
        const int m = isCtx ? TL + b * L + 32 * qt + ql : b * S + 32 * qt + ql;
        const int qcol = isC ? ZQN + h * 64 : ZQB + h * 64, kcol = isC ? ZKN + h * 64 : ZKB + (h / 3) * 64, hv = isC ? 2 + h : h / 3;
        bf16x8 qf[4];
        { const bf16_t* qp = p.Z + (size_t)m * ZP + qcol + 8 * hi;
#pragma unroll
          for (int k4 = 0; k4 < 4; ++k4) qf[k4] = *(const bf16x8*)(qp + 16 * k4); }
        int lo = 0, hi_t = 0, gr0 = 0;
        if (!isCtx) {
            if (!isC) { lo = 4 * g - 4; hi_t = 4 * g + 8; lo = lo < 0 ? 0 : lo; hi_t = hi_t > S / 32 ? S / 32 : hi_t; }
            else { const int ra = 2 * g, rb = 2 * g + 1; int r0a = ra - 4; r0a = r0a < 0 ? 0 : (r0a > ROWS - 8 ? ROWS - 8 : r0a); int r0b = rb - 4; r0b = r0b < 0 ? 0 : (r0b > ROWS - 8 ? ROWS - 8 : r0b);
                   lo = 2 * r0a; hi_t = 2 * (r0b + 8); gr0 = 0; }
        }
        const int ntile = L / 32 + (hi_t - lo);
        const bf16_t* kbase = p.Z + (size_t)krow * ZP + kcol + 8 * kch;
        const bf16_t* vbase = p.VT + ((size_t)(b * 8 + hv) * 64 + vrow) * PU + 8 * vpc;
#define AT_TOK(i_) ((i_) < L / 32 ? 32 * (i_) : L + 32 * (lo + (i_) - L / 32))
#define AT_STAGE(i_) do { const int u0_ = AT_TOK(i_); const int zrow_ = u0_ < L ? TL + b * L + u0_ : b * S + (u0_ - L); char* sl_ = lds + ((i_) % 3) * 8192 + tid_ * 16; \
            __builtin_amdgcn_global_load_lds((const unsigned*)(kbase + (size_t)zrow_ * ZP), (__attribute__((address_space(3))) unsigned*)(sl_), 16, 0, 0); \
            __builtin_amdgcn_global_load_lds((const unsigned*)(vbase + u0_), (__attribute__((address_space(3))) unsigned*)(sl_ + 4096), 16, 0, 0); } while (0)
        f32x16 o0, o1;
#pragma unroll
        for (int rr = 0; rr < 16; ++rr) { o0[rr] = 0.f; o1[rr] = 0.f; }
        float m_run, l_run;
        if (isC) { m_run = -1e30f; l_run = 0.f; } else { m_run = p.b_sink[l * 6 + h]; l_run = hi == 0 ? 1.0f : 0.f; }
        const int gr = qt >> 1, c = 32 * (qt & 1) + ql;
        int r0 = gr - 4; r0 = r0 < 0 ? 0 : (r0 > ROWS - 8 ? ROWS - 8 : r0);
        int c0 = c - 8; c0 = c0 < 0 ? 0 : (c0 > GRID_W - 16 ? GRID_W - 16 : c0);
        float* rpb = (float*)(lds + 24576);
        if (isC && !isCtx) for (int i = tid_; i < 15 * 31; i += 256) rpb[i] = p.c_rpb[((size_t)l * 6 + h) * 15 * 31 + i];
        AT_STAGE(0);
        if (ntile > 1) AT_STAGE(1);
#pragma unroll 1
        for (int i = 0; i < ntile; ++i) {
            if (i + 1 < ntile) asm volatile("s_waitcnt vmcnt(2)" ::: "memory"); else asm volatile("s_waitcnt vmcnt(0)" ::: "memory");
            asm volatile("s_waitcnt lgkmcnt(0)" ::: "memory");
            __builtin_amdgcn_s_barrier();
            if (i + 2 < ntile) AT_STAGE(i + 2);
            const char* ks = lds + (i % 3) * 8192; const char* vs = ks + 4096;
            if (i < L / 32) attn_tile_lds(qf, ks, vs, NoMask(), m_run, l_run, o0, o1, ql, hi);
            else {
                const int jt = lo + i - L / 32;
                if (!isC) {
                    const int dq = jt - qt;
                    if (dq >= -3 && dq <= 3) attn_tile_lds(qf, ks, vs, NoMask(), m_run, l_run, o0, o1, ql, hi);
                    else if (dq == -4 || dq == 4) { const int base = 32 * dq - ql;
                        attn_tile_lds(qf, ks, vs, [&](int ko, float v) { const int rel = base + ko; return (rel >= -128 && rel <= 128) ? v : -INFINITY; }, m_run, l_run, o0, o1, ql, hi); }
                } else {
                    const int kr_ = jt >> 1, ct = jt & 1;
                    if (kr_ >= r0 && kr_ < r0 + 8) { const float* rp = rpb + (kr_ - gr + 7) * 31 + 15 - c;
                        attn_tile_lds(qf, ks, vs, [&](int ko, float v) { const int kc = 32 * ct + ko; return (kc >= c0 && kc < c0 + 16) ? v + rp[kc] : -INFINITY; }, m_run, l_run, o0, o1, ql, hi); }
                }
            }
        }
        asm volatile("s_waitcnt lgkmcnt(0)" ::: "memory");
        __builtin_amdgcn_s_barrier();
#undef AT_STAGE
#undef AT_TOK
        (void)gr0;
        const float lt = l_run + __shfl_xor(l_run, 32), inv = 1.0f / lt;
        bf16_t* op = p.MIX + (size_t)m * DMIX + (isC ? 640 : 256) + h * 64 + 4 * hi;
#pragma unroll
        for (int gq = 0; gq < 4; ++gq) {
            st_bf16x4(op + 8 * gq, (f32x4){o0[4 * gq] * inv, o0[4 * gq + 1] * inv, o0[4 * gq + 2] * inv, o0[4 * gq + 3] * inv});
            st_bf16x4(op + 32 + 8 * gq, (f32x4){o1[4 * gq] * inv, o1[4 * gq + 1] * inv, o1[4 * gq + 2] * inv, o1[4 * gq + 3] * inv});
        }
    }
}

#define RNB " row_newbcast:%c[n] row_mask:0xf bank_mask:0xf\n\t"
template <int N, bool FIRST>
__device__ __forceinline__ void dpp_dot4(float& a0, float& a1, float& a2, float& a3, const f32x4& v, float s0, float s1, float s2, float s3) {
    if (FIRST) asm volatile("s_nop 1");
    asm("v_fmac_f32_dpp %0, %4, %8" RNB "v_fmac_f32_dpp %1, %5, %9" RNB "v_fmac_f32_dpp %2, %6, %10" RNB "v_fmac_f32_dpp %3, %7, %11" RNB
        : "+v"(a0), "+v"(a1), "+v"(a2), "+v"(a3) : "v"(v[0]), "v"(v[1]), "v"(v[2]), "v"(v[3]), "v"(s0), "v"(s1), "v"(s2), "v"(s3), [n] "i"(N));
}
template <int N, bool FIRST>
__device__ __forceinline__ void dpp_upd4s(float& s0, float& s1, float& s2, float& s3, float& y0, float& y1, float& y2, float& y3,
                                          const f32x4& w, const f32x4& b, const f32x4& kd, const f32x4& r, float nsk, float vv) {
    if (FIRST) asm volatile("s_nop 1");
    asm("v_mul_f32_dpp %0, %8, %0" RNB "v_mul_f32_dpp %1, %9, %1" RNB "v_mul_f32_dpp %2, %10, %2" RNB "v_mul_f32_dpp %3, %11, %3" RNB
        "v_fmac_f32_dpp %0, %12, %24" RNB "v_fmac_f32_dpp %1, %13, %24" RNB "v_fmac_f32_dpp %2, %14, %24" RNB "v_fmac_f32_dpp %3, %15, %24" RNB
        "v_fmac_f32_dpp %0, %16, %25" RNB "v_fmac_f32_dpp %1, %17, %25" RNB "v_fmac_f32_dpp %2, %18, %25" RNB "v_fmac_f32_dpp %3, %19, %25" RNB
        "v_fmac_f32_dpp %4, %20, %0" RNB "v_fmac_f32_dpp %5, %21, %1" RNB "v_fmac_f32_dpp %6, %22, %2" RNB "v_fmac_f32_dpp %7, %23, %3" RNB
        : "+v"(s0), "+v"(s1), "+v"(s2), "+v"(s3), "+v"(y0), "+v"(y1), "+v"(y2), "+v"(y3)
        : "v"(w[0]), "v"(w[1]), "v"(w[2]), "v"(w[3]), "v"(b[0]), "v"(b[1]), "v"(b[2]), "v"(b[3]), "v"(kd[0]), "v"(kd[1]), "v"(kd[2]), "v"(kd[3]),
          "v"(r[0]), "v"(r[1]), "v"(r[2]), "v"(r[3]), "v"(nsk), "v"(vv), [n] "i"(N));
}
template <int N, bool FIRST>
__device__ __forceinline__ void dpp_upd4p(float& s0, float& s1, float& s2, float& s3, float& y0, float& y1, float& y2, float& y3,
                                          const f32x4& w, const f32x4& b, const f32x4& r, float nsk) {
    if (FIRST) asm volatile("s_nop 1");
    asm("v_mul_f32_dpp %0, %8, %0" RNB "v_mul_f32_dpp %1, %9, %1" RNB "v_mul_f32_dpp %2, %10, %2" RNB "v_mul_f32_dpp %3, %11, %3" RNB
        "v_fmac_f32_dpp %0, %12, %20" RNB "v_fmac_f32_dpp %1, %13, %20" RNB "v_fmac_f32_dpp %2, %14, %20" RNB "v_fmac_f32_dpp %3, %15, %20" RNB
        "v_fmac_f32_dpp %4, %16, %0" RNB "v_fmac_f32_dpp %5, %17, %1" RNB "v_fmac_f32_dpp %6, %18, %2" RNB "v_fmac_f32_dpp %7, %19, %3" RNB
        : "+v"(s0), "+v"(s1), "+v"(s2), "+v"(s3), "+v"(y0), "+v"(y1), "+v"(y2), "+v"(y3)
        : "v"(w[0]), "v"(w[1]), "v"(w[2]), "v"(w[3]), "v"(b[0]), "v"(b[1]), "v"(b[2]), "v"(b[3]), "v"(r[0]), "v"(r[1]), "v"(r[2]), "v"(r[3]), "v"(nsk), [n] "i"(N));
}
template <int N, bool FIRST>
__device__ __forceinline__ void dpp_mul4(float& s0, float& s1, float& s2, float& s3, const f32x4& v) {
    if (FIRST) asm volatile("s_nop 1");
    asm("v_mul_f32_dpp %0, %4, %0" RNB "v_mul_f32_dpp %1, %5, %1" RNB "v_mul_f32_dpp %2, %6, %2" RNB "v_mul_f32_dpp %3, %7, %3" RNB
        : "+v"(s0), "+v"(s1), "+v"(s2), "+v"(s3) : "v"(v[0]), "v"(v[1]), "v"(v[2]), "v"(v[3]), [n] "i"(N));
}
template <int N>
__device__ __forceinline__ void dpp_fmacx4(float& s0, float& s1, float& s2, float& s3, const f32x4& v, float x) {
    asm("v_fmac_f32_dpp %0, %4, %8" RNB "v_fmac_f32_dpp %1, %5, %8" RNB "v_fmac_f32_dpp %2, %6, %8" RNB "v_fmac_f32_dpp %3, %7, %8" RNB
        : "+v"(s0), "+v"(s1), "+v"(s2), "+v"(s3) : "v"(v[0]), "v"(v[1]), "v"(v[2]), "v"(v[3]), "v"(x), [n] "i"(N));
}
template <int N> struct ScanRep {
    static __device__ __forceinline__ void dot8(float (&a)[8], const f32x4& v, const float (&st)[64]) {
        constexpr int h = (N & 1) * 4;
        dpp_dot4<N, N == 0>(a[h], a[h + 1], a[h + 2], a[h + 3], v, st[4 * N], st[4 * N + 1], st[4 * N + 2], st[4 * N + 3]);
        if constexpr (N < 15) ScanRep<N + 1>::dot8(a, v, st);
    }
    static __device__ __forceinline__ void dot(float& a0, float& a1, float& a2, float& a3, const f32x4& v, const float (&st)[64]) {
        dpp_dot4<N, N == 0>(a0, a1, a2, a3, v, st[4 * N], st[4 * N + 1], st[4 * N + 2], st[4 * N + 3]);
        if constexpr (N < 15) ScanRep<N + 1>::dot(a0, a1, a2, a3, v, st);
    }
    static __device__ __forceinline__ void mul(float (&st)[64], const f32x4& w) {
        dpp_mul4<N, N == 0>(st[4 * N], st[4 * N + 1], st[4 * N + 2], st[4 * N + 3], w);
        if constexpr (N < 15) ScanRep<N + 1>::mul(st, w);
    }
    static __device__ __forceinline__ void fmacx(float (&st)[64], const f32x4& v, float x) {
        dpp_fmacx4<N>(st[4 * N], st[4 * N + 1], st[4 * N + 2], st[4 * N + 3], v, x);
        if constexpr (N < 15) ScanRep<N + 1>::fmacx(st, v, x);
    }
};
__device__ __forceinline__ int seg_row0(int b, int d, int s) { const int pos0 = 128 * s; return pos0 < L ? TL + b * L + (d ? L - 1 - pos0 : pos0) : b * S + (d ? S - 1 - (pos0 - L) : pos0 - L); }

template <bool ISP>
__device__ __forceinline__ void scan_task(const Params& p, int c, int s, int lane) {
    const int h = c & 3, b = (c >> 2) % NB, d = (c >> 2) / NB;
    const int m0 = seg_row0(b, d, s); const long step = d ? -(long)DA : (long)DA;
    const size_t o = (size_t)m0 * DA + h * 64, od = ((size_t)d * T + m0) * DA + h * 64; const int q = 4 * (lane & 15);
    const float* pkk = p.sKK + o + q; const float* pr = p.sR + o + q; const float* pw = p.sW + od + q; const float* pb = p.sB + od + q;
    const float* pkd = p.sKD + od + q; const float* pv = p.sV + o + lane;
    float* py = (ISP ? p.PV : p.Y) + od + lane;
    float st[64];
#pragma unroll
    for (int k = 0; k < 64; ++k) st[k] = (ISP && k == lane) ? 1.0f : 0.f;
    const float* pfp; { const int arr = lane >> 1; const float* bs = arr == 0 ? p.sKK + o : arr == 1 ? p.sW + od : arr == 2 ? p.sB + od : arr == 3 ? p.sR + o : arr == 4 ? p.sKD + od : p.sV + o;
        pfp = (lane < 12 ? bs + 32 * (lane & 1) : p.sKK + o) + 8 * step; }
    float pfd = 0.f;
    f32x4 kk = *(const f32x4*)pkk, w = *(const f32x4*)pw, bb = *(const f32x4*)pb, r = *(const f32x4*)pr, kd = w; float vv = 0.f;
    if (!ISP) { kd = *(const f32x4*)pkd; vv = *pv; }
#pragma unroll 1
    for (int i = 0; i < 128; ++i) {
        const long nx = (i < 127) ? step : 0;
        pkk += nx; pw += nx; pb += nx; pr += nx; pkd += nx; pv += nx;
        asm volatile("global_load_dword %0, %1, off" : "+v"(pfd) : "v"(pfp)); if (i < 119) pfp += step;
        const f32x4 nkk = *(const f32x4*)pkk, nw = *(const f32x4*)pw, nb = *(const f32x4*)pb, nr = *(const f32x4*)pr;
        f32x4 nkd = nw; float nv = 0.f;
        if (!ISP) { nkd = *(const f32x4*)pkd; nv = *pv; }
        float a[8] = {0.f, 0.f, 0.f, 0.f, 0.f, 0.f, 0.f, 0.f};
        ScanRep<0>::dot8(a, kk, st);
        const float nsk = -(((a[0] + a[1]) + (a[2] + a[3])) + ((a[4] + a[5]) + (a[6] + a[7])));
        ScanRep<0>::mul(st, w);
        ScanRep<0>::fmacx(st, bb, nsk);
        if (!ISP) ScanRep<0>::fmacx(st, kd, vv);
        float y[8] = {0.f, 0.f, 0.f, 0.f, 0.f, 0.f, 0.f, 0.f};
        ScanRep<0>::dot8(y, r, st);
        *py = ((y[0] + y[1]) + (y[2] + y[3])) + ((y[4] + y[5]) + (y[6] + y[7])); py += step;
        kk = nkk; w = nw; bb = nb; r = nr; kd = nkd; vv = nv;
    }
    asm volatile("s_waitcnt vmcnt(0)" : "+v"(pfd));
    if (s < NSG - 1) {
        float* dst = (ISP ? p.PS : p.QS) + (((size_t)c * NSG + s) * 64 + lane) * 64;
#pragma unroll
        for (int k4 = 0; k4 < 16; ++k4) *(f32x4*)(dst + 4 * k4) = (f32x4){st[4 * k4], st[4 * k4 + 1], st[4 * k4 + 2], st[4 * k4 + 3]};
    }
}
__device__ __forceinline__ void ph_scan_fast(const Params& p) {
    const int tid_ = opq_tid(), bid_ = opq_bid(); (void)tid_; (void)bid_;
    const int lane = tid_ & 63, gw = bid_ * 4 + (tid_ >> 6), nw = gridDim.x * 4;
    constexpr int NS_T = 64 * NSG, NP_T = 64 * (NSG - 1);
    const int G = gridDim.x, wv = tid_ >> 6; (void)gw; (void)nw;
    for (int tsk = wv * G + bid_; tsk < NS_T + NP_T; tsk += 4 * G) {
        const int t2 = __builtin_amdgcn_readfirstlane(tsk);
        if (t2 < NS_T) scan_task<false>(p, t2 & 63, t2 >> 6, lane);
        else scan_task<true>(p, (t2 - NS_T) & 63, 1 + ((t2 - NS_T) >> 6), lane);
    }
}
__device__ __forceinline__ void ph_combine(const Params& p, char* lds) {
    const int tid_ = opq_tid(), bid_ = opq_bid(); (void)tid_; (void)bid_; (void)lds;
    if (bid_ >= 64) return;
    const int lane = tid_ & 63, c = bid_, cb = tid_ >> 6, q = lane >> 4, i16 = lane & 15, v = 16 * cb + i16;
    const float* QSc = p.QS + (size_t)c * NSG * 4096; const float* PSc = p.PS + (size_t)c * NSG * 4096; float* SSg = p.SS + (size_t)c * NSG * 4096;
    f32x4 acc[4];
#pragma unroll
    for (int ro = 0; ro < 4; ++ro) acc[ro] = *(const f32x4*)(QSc + v * 64 + 16 * ro + 4 * q);
#pragma unroll 1
    for (int s = 1; s < NSG; ++s) {
#pragma unroll
        for (int ro = 0; ro < 4; ++ro)
#pragma unroll
            for (int j = 0; j < 4; ++j) SSg[(size_t)s * 4096 + (16 * ro + 4 * q + j) * 64 + v] = acc[ro][j];
        if (s == NSG - 1) break;
        const float* P = PSc + (size_t)s * 4096 + (4 * q) * 64 + i16;
        float a[4][4][4];
#pragma unroll
        for (int rb = 0; rb < 4; ++rb)
#pragma unroll
            for (int kk = 0; kk < 4; ++kk)
#pragma unroll
                for (int ro = 0; ro < 4; ++ro) a[rb][kk][ro] = P[(16 * rb + kk) * 64 + 16 * ro];
#pragma unroll
        for (int rb = 0; rb < 4; ++rb) asm volatile("" : "+v"(a[rb][0][0]), "+v"(a[rb][0][1]), "+v"(a[rb][0][2]), "+v"(a[rb][0][3]), "+v"(a[rb][1][0]), "+v"(a[rb][1][1]), "+v"(a[rb][1][2]), "+v"(a[rb][1][3]),
                                                         "+v"(a[rb][2][0]), "+v"(a[rb][2][1]), "+v"(a[rb][2][2]), "+v"(a[rb][2][3]), "+v"(a[rb][3][0]), "+v"(a[rb][3][1]), "+v"(a[rb][3][2]), "+v"(a[rb][3][3]));
        f32x4 nacc[4];
#pragma unroll
        for (int ro = 0; ro < 4; ++ro) nacc[ro] = *(const f32x4*)(QSc + (size_t)s * 4096 + v * 64 + 16 * ro + 4 * q);
#pragma unroll
        for (int rb = 0; rb < 4; ++rb)
#pragma unroll
            for (int kk = 0; kk < 4; ++kk)
#pragma unroll
                for (int ro = 0; ro < 4; ++ro) nacc[ro] = __builtin_amdgcn_mfma_f32_16x16x4f32(a[rb][kk][ro], acc[rb][kk], nacc[ro], 0, 0, 0);
#pragma unroll
        for (int ro = 0; ro < 4; ++ro) acc[ro] = nacc[ro];
    }
}
__device__ __forceinline__ void ph_rwkv_out_fast(const Params& p, int l, bool with_ctx) {
    const int tid_ = opq_tid(), bid_ = opq_bid(); (void)tid_; (void)bid_;
    const int lane = tid_ & 63, gw = bid_ * 4 + (tid_ >> 6), nw = gridDim.x * 4;
    constexpr int TOK = 16, NLT = NB * (S / TOK) * 4, NCTK = NB * (L / TOK) * 4;
    const int ntask = NLT + (with_ctx ? NCTK : 0);
    for (int tsk = gw; tsk < ntask; tsk += nw) {
        const bool isCtx = tsk >= NLT; const int r = isCtx ? tsk - NLT : tsk;
        const int h = r & 3, npt = isCtx ? L / TOK : S / TOK, tt = (r >> 2) % npt, b = (r >> 2) / npt, t128 = tt / (128 / TOK);
        const int seg0 = isCtx ? t128 : L / 128 + t128, seg1 = isCtx ? (L / 128 - 1) - t128 : L / 128 + (S / 128 - 1) - t128;
        const int mbase = isCtx ? TL + b * L + TOK * tt : b * S + TOK * tt;
        float ss0[64], ss1[64];
        { const float* s0p = p.SS + (((size_t)(0 * NB + b) * 4 + h) * NSG + seg0) * 4096 + lane; const float* s1p = p.SS + (((size_t)(1 * NB + b) * 4 + h) * NSG + seg1) * 4096 + lane;
#pragma unroll
          for (int k = 0; k < 64; ++k) { ss0[k] = seg0 > 0 ? s0p[k * 64] : 0.f; ss1[k] = seg1 > 0 ? s1p[k * 64] : 0.f; } }
        const float rk = p.a_r_k[l * DA + h * 64 + lane], gln = p.a_lnx_g[l * DA + h * 64 + lane], bln = p.a_lnx_b[l * DA + h * 64 + lane];
        f32x4 pv0 = {0.f, 0.f, 0.f, 0.f}, pv1 = pv0; float y0l, y1l, rr, kds, vv, gg;
#define ROUT_LOAD(i_) do { const size_t o_ = (size_t)(mbase + (i_)) * DA + h * 64, o1_ = o_ + (size_t)T * DA; \
            if (seg0 > 0) pv0 = *(const f32x4*)(p.PV + o_ + 4 * (lane & 15)); if (seg1 > 0) pv1 = *(const f32x4*)(p.PV + o1_ + 4 * (lane & 15)); \
            y0l = p.Y[o_ + lane]; y1l = p.Y[o1_ + lane]; rr = p.sR[o_ + lane]; kds = p.sKD[o_ + lane] + p.sKD[o1_ + lane]; vv = p.sV[o_ + lane]; gg = p.sG[o_ + lane]; } while (0)
        ROUT_LOAD(0);
#pragma unroll 1
        for (int i = 0; i < TOK; ++i) {
            const f32x4 cpv0 = pv0, cpv1 = pv1; float a0 = y0l, a1 = y1l, a2 = 0.f, a3 = 0.f; const float crr = rr, ckds = kds, cvv = vv, cgg = gg;
            ROUT_LOAD(i + 1 < TOK ? i + 1 : i);
            ScanRep<0>::dot(a0, a1, a2, a3, cpv0, ss0);
            ScanRep<0>::dot(a0, a1, a2, a3, cpv1, ss1);
            const float y = (a0 + a1) + (a2 + a3);
            const float mu = wave_sum(y) * (1.0f / 64.f), dy = y - mu;
            const float rstd = 1.0f / sqrtf(wave_sum(dy * dy) * (1.0f / 64.f) + GN_EPS);
            const float bon = wave_sum(crr * ckds * rk);
            p.MIX[(size_t)(mbase + i) * DMIX + h * 64 + lane] = f2bf((dy * rstd * gln + bln + bon * cvv) * cgg);
        }
#undef ROUT_LOAD
    }
}


#define LAS __attribute__((address_space(3)))
#define XB_TMO      128
#define XB_XCNT(j)  (256  + 64 * (j))
#define XB_XSUB(j)  (1280 + 64 * (j))
#define XB_XGEN(j)  (2304 + 64 * (j))
#define XB_TOP      3328
#define XB_TOPGEN   3392
#define XCD_BAR_WORDS 3456
#define XB_SPIN_CAP (1u << 20)
static_assert(XCD_BAR_WORDS * 4 <= 16384, "barrier words fit the control region");
__device__ __forceinline__ unsigned xb_ld(unsigned* p)              { return __hip_atomic_load(p, __ATOMIC_RELAXED, __HIP_MEMORY_SCOPE_AGENT); }
__device__ __forceinline__ unsigned xb_add(unsigned* p, unsigned v) { return __hip_atomic_fetch_add(p, v, __ATOMIC_RELAXED, __HIP_MEMORY_SCOPE_AGENT); }
__device__ __forceinline__ unsigned xb_xcc_id() { return (unsigned)__builtin_amdgcn_s_getreg((3 << 11) | 20) & 0xFu; }
#define XB_SPIN(cond, bar) do { unsigned _sp = 0; while (cond) { __builtin_amdgcn_s_sleep(1); \
    if ((++_sp & 255u) == 0u) { if (xb_ld(&(bar)[XB_TMO])) break; if (_sp > XB_SPIN_CAP) { atomicAdd(&(bar)[XB_TMO], 1u); break; } } } } while (0)
struct XcdBarrier { unsigned* bar; unsigned x; volatile LAS unsigned* st; };
__device__ __forceinline__ XcdBarrier xcd_barrier_post(unsigned* bar, volatile LAS unsigned* st) {
    XcdBarrier b; b.bar = bar; b.x = xb_xcc_id(); b.st = st;
    if (threadIdx.x == 0) (void)xb_add(&bar[XB_XCNT(b.x)], 1u);
    return b;
}
__device__ __forceinline__ void xcd_barrier_complete(unsigned* bar, unsigned x, unsigned& nloc, unsigned& nx) {
    const unsigned G = gridDim.x * gridDim.y * gridDim.z;
    unsigned sum, cnt, mine, sp = 0u;
    for (;;) {
        sum = 0u; cnt = 0u; mine = 0u;
#pragma unroll
        for (unsigned j = 0; j < 16; ++j) { const unsigned c = xb_ld(&bar[XB_XCNT(j)]); sum += c; cnt += (c > 0u) ? 1u : 0u; mine = (j == x) ? c : mine; }
        if (sum == G) break;
        __builtin_amdgcn_s_sleep(1);
        if ((++sp & 255u) == 0u) { if (xb_ld(&bar[XB_TMO])) break; if (sp > XB_SPIN_CAP) { atomicAdd(&bar[XB_TMO], 1u); break; } }
    }
    nloc = mine > 0u ? mine : 1u; nx = cnt > 0u ? cnt : 1u;
}
__device__ __forceinline__ void xcd_barrier(const XcdBarrier& b) {
    asm volatile("s_waitcnt vmcnt(0)" ::: "memory");
    __syncthreads();
    if (threadIdx.x == 0) {
        unsigned* bar = b.bar;
        __builtin_amdgcn_s_waitcnt(0);
        unsigned nloc = b.st[0], nx = b.st[1];
        if (nloc == 0u) { xcd_barrier_complete(bar, b.x, nloc, nx); b.st[0] = nloc; b.st[1] = nx; }
        const unsigned old = xb_add(&bar[XB_XSUB(b.x)], 1u);
        const unsigned gen = old / nloc;
        if (old + 1u == (gen + 1u) * nloc) {
            __builtin_amdgcn_fence(__ATOMIC_RELEASE, "agent");
            asm volatile("s_waitcnt vmcnt(0)" ::: "memory");
            const unsigned og = xb_add(&bar[XB_TOP], 1u);
            const unsigned tg = og / nx;
            if (og + 1u == (tg + 1u) * nx) xb_add(&bar[XB_TOPGEN], 1u);
            else XB_SPIN(xb_ld(&bar[XB_TOPGEN]) == tg, bar);
            __builtin_amdgcn_fence(__ATOMIC_ACQUIRE, "agent");
            xb_add(&bar[XB_XGEN(b.x)], 1u);
            asm volatile("s_waitcnt vmcnt(0)" ::: "memory");
        } else {
            XB_SPIN(xb_ld(&bar[XB_XGEN(b.x)]) == gen, bar);
            __builtin_amdgcn_fence(__ATOMIC_ACQUIRE, "agent");
            asm volatile("s_waitcnt vmcnt(0)" ::: "memory");
        }
    }
    __syncthreads();
}

#define GT ((long)blockIdx.x * blockDim.x + threadIdx.x)
#define GS ((long)gridDim.x * blockDim.x)
__global__ void __launch_bounds__(256, 2) mega_fwd(Params p) {
    __shared__ __attribute__((aligned(16))) char lds[65536 + 64];
    cg::grid_group grid = cg::this_grid();
    const long gt = GT, gs = GS;
    volatile LAS unsigned* bst = (volatile LAS unsigned*)(LAS char*)(lds + 65536);
    if (threadIdx.x < 2) bst[threadIdx.x] = 0u;
    __syncthreads();
    const XcdBarrier xb = xcd_barrier_post(p.bar, bst);
#ifndef PROBE_PHASE
#define PROBE_PHASE -1
#endif
#define PROBE_AMP 8
    unsigned long long t_prev = 0; int nts = 0;
#define STAMP() do { if (PROBE_PHASE >= 0 && blockIdx.x == 0 && threadIdx.x == 0) { const unsigned long long t_now = __builtin_amdgcn_s_memrealtime(); \
        if (nts == PROBE_PHASE + 1) { const unsigned long long t_end = t_now + PROBE_AMP * (t_now - t_prev); while (__builtin_amdgcn_s_memrealtime() < t_end) __builtin_amdgcn_s_sleep(8); } \
        t_prev = __builtin_amdgcn_s_memrealtime(); } ++nts; } while (0)
#define GSYNC() do { xcd_barrier(xb); STAMP(); } while (0)
    STAMP();
    ph_mod_fast(p, lds); ph_prep_w_fast(p, 0, 0, lds); ph_prep_misc(p, 0, gt, gs, false);
    grid.sync(); STAMP();
    for (int l = 0; l < 2; ++l) {
        const int nrows = (l == 0) ? T : TL;
        ph_lnmod_fast(p, l);
        GSYNC();
        g_gemm_in(p, lds);
        GSYNC();
        ph_streams_s1(p, l);
        GSYNC();
        g_streams_s2(p, l, lds);
        GSYNC();
        ph_scan_fast(p);
        GSYNC();
        ph_combine(p, lds); ph_attn_blk(p, l, l == 0, 64, lds);
        GSYNC();
        ph_rwkv_out_fast(p, l, l == 0);
        GSYNC();
        if (blockIdx.x >= gridDim.x / 2) { ph_prep_w_fast(p, l, 1, lds); __syncthreads(); g_gemm_out(p, nrows, lds); } else { g_gemm_out(p, nrows, lds); ph_prep_w_fast(p, l, 1, lds); }
        GSYNC();
        ph_post_mixer_fast(p, l, nrows);
        GSYNC();
        g_router(p, l, nrows, lds);
        GSYNC();
        ph_dispatch_fast(p, l, nrows, lds);
        GSYNC();
        g_moe1(p, l, lds);
        GSYNC();
        g_moe2(p, l, lds);
        GSYNC();
        ph_final_fast(p, l, nrows);
        if (l == 0) { ph_prep_w_fast(p, 1, 0, lds); ph_prep_misc(p, 1, gt, gs, false); }
        GSYNC();
    }}

extern "C" void kernel_launch(void* const* d_in, const int* in_sizes, int n_in, void* d_out, int out_size, void* d_ws, size_t ws_size, hipStream_t stream) {
    if (n_in != 32 || out_size != TL * D || ws_size < WS_NEED) { fprintf(stderr, "kernel_launch: unexpected shapes / workspace (n_in %d out %d ws %zu need %zu)\n", n_in, out_size, ws_size, (size_t)WS_NEED); return; }
    static int grid_blocks = 0;
    if (!grid_blocks) {
        int dev = 0, cus = 0, per_cu = 0;
        (void)hipGetDevice(&dev);
        (void)hipDeviceGetAttribute(&cus, hipDeviceAttributeMultiprocessorCount, dev);
        (void)hipOccupancyMaxActiveBlocksPerMultiprocessor(&per_cu, mega_fwd, 256, 0);
        if (per_cu < 1) per_cu = 1;
        if (per_cu > 2) per_cu = 2;
        grid_blocks = cus * per_cu;
        fprintf(stderr, "kernel_launch: %d CUs x %d blocks\n", cus, per_cu);
    }
    Params p = make_params(d_in, d_out, d_ws);
    (void)hipMemsetAsync(d_ws, 0, CTL_BYTES, stream);
    void* args[] = {&p};
    hipError_t e = hipLaunchCooperativeKernel((void*)mega_fwd, dim3(grid_blocks), dim3(256), args, 0, stream);
    if (e != hipSuccess) fprintf(stderr, "cooperative launch failed: %s (grid %d)\n", hipGetErrorString(e), grid_blocks);
}
#endif

#ifdef HOST_EMU
static void host_forward(void* const* d_in, void* d_out, void* d_ws) {
    const Params p = make_params(d_in, d_out, d_ws);
    for (int l = 0; l < 2; ++l) {
        const int nrows = (l == 0) ? T : TL;
        ph_prep_w(p, l, 0, 1); ph_prep_misc(p, l, 0, 1); ph_lnmod(p, l, 0, 1); host_gemm_in(p); ph_streams(p, l, 0, 1); ph_rope(p, 0, 1); ph_scan(p, 0, 1);
        ph_attn(p, l, nrows, 0, 1); ph_rwkv_out(p, l, nrows, 0, 1); host_gemm_out(p, nrows); ph_post_mixer(p, l, nrows, 0, 1);
        ph_dispatch(p, l, nrows, 0, 1); host_moe1(p, l); host_moe2(p, l); ph_final(p, l, nrows, 0, 1);
    }
}
#endif
```

```cpp
#ifdef HOST_EMU
#include <cmath>
#include <cstdio>
#include <cstring>
#include <cstdint>
#include <cstdlib>
#define __device__
#define __global__
#define __host__
#define __forceinline__ inline
#else
#include <hip/hip_runtime.h>
#include <hip/hip_cooperative_groups.h>
#include <cstdio>
#include <cstdint>
namespace cg = cooperative_groups;
#endif

#ifndef CFG_D
#define CFG_D 1024
#define CFG_B 8
#define CFG_S 2048
#define CFG_L 256
#define CFG_DE 512
#endif
constexpr int D = CFG_D, NB = CFG_B, S = CFG_S, L = CFG_L, DE = CFG_DE;
constexpr int TL = NB * S, TC = NB * L, T = TL + TC;
constexpr int GRID_W = 64, HD = 64;
constexpr int DA = 256, A_IN = 1184, N_IN = 2976, NINP = 3072, DMIX = 1024;
constexpr int NEXP = 32, NSLOT = 2 * T + NEXP * 128;
constexpr int ZQB = 0, ZKB = 384, ZVB = 512, ZQN = 640, ZKN = 1024, ZVN = 1408, ZA = 1792, ZP = 2976;
constexpr float LN_EPS = 1e-6f, GN_EPS = 64e-5f, ATT_SCALE = 0.125f;
constexpr float ALPHA = 1.41421356237309515f;

typedef unsigned short bf16_t;

__device__ __forceinline__ float bf2f(bf16_t v) {
    unsigned u = ((unsigned)v) << 16; float f;
#ifdef HOST_EMU
    memcpy(&f, &u, 4);
#else
    f = __uint_as_float(u);
#endif
    return f;
}
__device__ __forceinline__ bf16_t f2bf(float f) {
    unsigned u;
#ifdef HOST_EMU
    memcpy(&u, &f, 4);
#else
    u = __float_as_uint(f);
#endif
    return (bf16_t)((u + 0x7fffu + ((u >> 16) & 1u)) >> 16);
}
__device__ __forceinline__ float sigmoidf_(float x) { return 1.0f / (1.0f + expf(-x)); }
__device__ __forceinline__ float siluf_(float x) { return x / (1.0f + expf(-x)); }
__device__ __forceinline__ int atomic_inc_int(int* p) {
#ifdef HOST_EMU
    int o = *p; *p = o + 1; return o;
#else
    return atomicAdd(p, 1);
#endif
}

struct Params {
    const float *x, *c, *ctx, *c_ctx, *w_mod, *b_mod, *w_in, *w_out, *a_shift, *a_w0, *a_w_up, *a_a0, *a_a_up, *a_g_up,
        *a_k_k, *a_k_a, *a_r_k, *a_lnx_g, *a_lnx_b, *b_sink, *c_rpb, *ln1_g, *ln1_b, *ln2_g, *ln2_b, *w_rg, *b_rg, *w_re,
        *b_re, *w_gate, *w_up, *w_down;
    float* out;
    int* cnt;
    unsigned* bar;
    float* mod;
    float* rope;
    bf16_t *win_t, *wout_t, *wgu_t, *wd_t;
    bf16_t *wrt;
    int* hist;
    bf16_t* HLO;
    bf16_t *wupT, *aupT, *gupT;
    bf16_t* LA;
    float *kT, *kN;
    bf16_t* H;
    bf16_t* Z;
    bf16_t* VT;
    float *sR, *sV, *sKK, *sG, *sW, *sKD, *sB;
    float* Y;
    bf16_t* MIX;
    float *PV, *QS, *PS, *SS;
    float* XC;
    float* O;
    int *rE, *rPos, *rSlot; float* rW;
    int* slotTok;
    bf16_t* ACT;
    float* YS;
};

constexpr size_t al256(size_t v) { return (v + 255) & ~(size_t)255; }
constexpr size_t OFF_CNT = 0;
constexpr size_t OFF_BAR = 4096, CTL_BYTES = 4096 + 16384;
constexpr size_t OFF_MOD = CTL_BYTES;
constexpr size_t OFF_ROPE = al256(OFF_MOD + (size_t)2 * (NB + 1) * 6 * D * 4);
constexpr size_t OFF_LORA = al256(OFF_ROPE + 64 * 16 * 2 * 4);
constexpr size_t OFF_WRT = al256(OFF_LORA + (size_t)(2 * 256 * 64 * 2 + 256 * 160) * 2);
constexpr size_t OFF_LG = al256(OFF_WRT + (size_t)2 * 128 * D * 2);
constexpr size_t OFF_WIN = al256(OFF_LG + (size_t)T * 36 * 4);
constexpr size_t OFF_WOUT = al256(OFF_WIN + (size_t)NINP * D * 2);
constexpr size_t OFF_WGU = al256(OFF_WOUT + (size_t)D * DMIX * 2);
constexpr size_t OFF_WD = al256(OFF_WGU + (size_t)NEXP * 2 * DE * D * 2);
constexpr size_t OFF_H = al256(OFF_WD + (size_t)NEXP * D * DE * 2);
constexpr size_t OFF_Z = al256(OFF_H + (size_t)(T + 1) * D * 2);
constexpr int PU = L + S;
constexpr int NSG = (L + S) / 128;
static_assert((size_t)3 * 64 * ((L + S) / 128) * 4096 * 4 <= (size_t)NEXP * 2 * DE * D * 2 || (L % 128) != 0, "scan segment states overlay wgu_t");
constexpr size_t OFF_VT = al256(OFF_Z + (size_t)T * ZP * 2);
constexpr size_t OFF_S = al256(OFF_VT + (size_t)NB * 8 * 64 * PU * 2);
constexpr size_t S1 = (size_t)T * 256 * 4;
constexpr size_t OFF_Y = al256(OFF_S + 10 * S1);
constexpr size_t OFF_MIX = al256(OFF_Y + 2 * S1);
constexpr size_t OFF_XC = al256(OFF_MIX + (size_t)T * 1024 * 2);
constexpr size_t OFF_ROUTE = al256(OFF_XC + (size_t)TC * D * 4);
constexpr size_t OFF_SLOTTOK = al256(OFF_ROUTE + (size_t)T * 2 * 4 * 4);
constexpr size_t WS_NEED = al256(OFF_SLOTTOK + (size_t)NSLOT * 4);
static_assert((size_t)NSLOT * DE * 2 <= (size_t)T * ZP * 2 && (size_t)T * D * 2 <= (size_t)T * ZP * 2, "ACT / HLO overlay Z");
static_assert((size_t)T * 4 * 4 + (size_t)T * 416 * 2 <= S1, "kN + LA overlay Y[1]");
static_assert((size_t)NSLOT * D * 4 <= 10 * S1 && (size_t)T * D * 4 <= 10 * S1, "YS / O overlay the stream buffers");

static Params make_params(void* const* d_in, void* d_out, void* d_ws) {
    Params p{};
    const float** f = (const float**)&p.x;
    for (int i = 0; i < 32; ++i) f[i] = (const float*)d_in[i];
    p.out = (float*)d_out;
    char* w = (char*)d_ws;
    p.cnt = (int*)(w + OFF_CNT); p.bar = (unsigned*)(w + OFF_BAR); p.mod = (float*)(w + OFF_MOD); p.rope = (float*)(w + OFF_ROPE);
    p.win_t = (bf16_t*)(w + OFF_WIN); p.wout_t = (bf16_t*)(w + OFF_WOUT); p.wgu_t = (bf16_t*)(w + OFF_WGU); p.wd_t = (bf16_t*)(w + OFF_WD);
    p.wrt = (bf16_t*)(w + OFF_WRT); p.hist = (int*)(w + OFF_LG); p.HLO = (bf16_t*)(w + OFF_Z);
    p.wupT = (bf16_t*)(w + OFF_LORA); p.aupT = p.wupT + 2 * 256 * 64; p.gupT = p.aupT + 2 * 256 * 64;
    p.H = (bf16_t*)(w + OFF_H); p.Z = (bf16_t*)(w + OFF_Z); p.VT = (bf16_t*)(w + OFF_VT);
    float* s = (float*)(w + OFF_S); const size_t n1 = (size_t)T * 256;
    p.sR = s; p.sV = s + n1; p.sKK = s + 2 * n1; p.sG = s + 3 * n1; p.sW = s + 4 * n1; p.sKD = s + 6 * n1; p.sB = s + 8 * n1;
    p.Y = (float*)(w + OFF_Y); p.MIX = (bf16_t*)(w + OFF_MIX); p.XC = (float*)(w + OFF_XC);
    p.O = (float*)(w + OFF_S);
    p.PV = (float*)(w + OFF_H); p.QS = (float*)(w + OFF_WGU); p.PS = p.QS + (size_t)64 * NSG * 4096; p.SS = p.PS + (size_t)64 * NSG * 4096;
    p.kT = p.Y; p.kN = p.Y + (size_t)T * 256; p.LA = (bf16_t*)(p.Y + (size_t)T * 256 + (size_t)T * 4);
    int* r = (int*)(w + OFF_ROUTE); p.rE = r; p.rPos = r + 2 * T; p.rSlot = r + 4 * T; p.rW = (float*)(r + 6 * T);
    p.slotTok = (int*)(w + OFF_SLOTTOK);
    p.ACT = (bf16_t*)(w + OFF_Z); p.YS = (float*)(w + OFF_S);
    return p;
}

__device__ void ph_prep_w(const Params& p, int l, long gtid, long gsz) {
    for (long i = gtid; i < (long)D * NINP; i += gsz) {
        const int k = (int)(i / NINP), n = (int)(i % NINP);
        float v = 0.f;
        if (n < N_IN) { const int oc = (n < ZA) ? n + A_IN : n - ZA; v = p.w_in[((size_t)l * D + k) * N_IN + oc]; }
        p.win_t[(size_t)n * D + k] = f2bf(v);
    }
    for (long i = gtid; i < (long)DMIX * D; i += gsz) {
        const int k = (int)(i / D), n = (int)(i % D);
        p.wout_t[(size_t)n * DMIX + k] = f2bf(p.w_out[((size_t)l * DMIX + k) * D + n]);
    }
    for (long i = gtid; i < (long)NEXP * D * 2 * DE; i += gsz) {
        const int rho = (int)(i % (2 * DE)); const long t = i / (2 * DE); const int k = (int)(t % D), e = (int)(t / D);
        const int q = rho >> 5, half = (rho >> 4) & 1, ii = rho & 15, cc = 16 * q + ii;
        const float* src = half ? p.w_up : p.w_gate;
        p.wgu_t[((size_t)e * 2 * DE + rho) * D + k] = f2bf(src[(((size_t)l * NEXP + e) * D + k) * DE + cc]);
    }
    for (long i = gtid; i < (long)NEXP * DE * D; i += gsz) {
        const int n = (int)(i % D); const long t = i / D; const int k = (int)(t % DE), e = (int)(t / DE);
        p.wd_t[((size_t)e * D + n) * DE + k] = f2bf(p.w_down[(((size_t)l * NEXP + e) * DE + k) * D + n]);
    }
}
__device__ __forceinline__ void ph_prep_misc(const Params& p, int l, long gtid, long gsz, bool do_mod = true) {
    if (l == 0 && do_mod) for (long i = gtid; i < (long)2 * (NB + 1) * 6 * D; i += gsz) {
        const int j = (int)(i % (6 * D)), b = (int)((i / (6 * D)) % (NB + 1)), ll = (int)(i / ((long)6 * D * (NB + 1)));
        const float* cv = (b < NB) ? p.c + (size_t)b * D : p.c_ctx;
        float acc = 0.f;
        for (int k = 0; k < D; ++k) acc += siluf_(cv[k]) * p.w_mod[((size_t)ll * D + k) * 6 * D + j];
        p.mod[((size_t)ll * (NB + 1) + b) * 6 * D + j] = acc + p.b_mod[(size_t)ll * 6 * D + j];
    }
    if (l == 0) for (long i = gtid; i < 64 * 16; i += gsz) {
        const int pos = (int)(i / 16), fi = (int)(i % 16);
        const float inv = powf(10000.0f, -(float)fi / 16.0f), ang = (float)pos * inv;
        p.rope[i] = cosf(ang); p.rope[1024 + i] = sinf(ang);
    }
    for (long i = gtid; i < NEXP; i += gsz) p.cnt[l * NEXP + i] = 0;
    for (long i = gtid; i < NSLOT; i += gsz) p.slotTok[i] = T;
    for (long i = gtid; i < D; i += gsz) p.H[(size_t)T * D + i] = 0;
}

__device__ __forceinline__ const float* xrow_in(const Params& p, int l, int m) {
    if (m < TL) return (l == 0 ? p.x : p.out) + (size_t)m * D;
    return (l == 0 ? p.ctx : p.XC) + (size_t)(m - TL) * D;
}
__device__ __forceinline__ const float* modrow(const Params& p, int l, int m) { return p.mod + ((size_t)l * (NB + 1) + (m < TL ? m / S : NB)) * 6 * D; }

__device__ void ph_lnmod(const Params& p, int l, long gtid, long gsz) {
    for (long m = gtid; m < T; m += gsz) {
        const float* xr = xrow_in(p, l, (int)m); const float* md = modrow(p, l, (int)m);
        float s = 0.f; for (int j = 0; j < D; ++j) s += xr[j];
        const float mu = s / D; float q = 0.f;
        for (int j = 0; j < D; ++j) { const float d = xr[j] - mu; q += d * d; }
        const float rstd = 1.0f / sqrtf(q / D + LN_EPS);
        for (int j = 0; j < D; ++j) p.H[(size_t)m * D + j] = f2bf((xr[j] - mu) * rstd * (1.0f + md[D + j]) + md[j]);
    }
}

__device__ __forceinline__ float zshift(const Params& p, int l, int m, int col) {
    int t, len;
    if (m < TL) { t = m % S; len = S; } else { t = (m - TL) % L; len = L; }
    const float* sh = p.a_shift + (size_t)l * 3 * A_IN;
    const bf16_t* z = p.Z + (size_t)m * ZP + ZA + col;
    float v = sh[A_IN + col] * bf2f(z[0]);
    if (t > 0) v += sh[col] * bf2f(z[-ZP]);
    if (t < len - 1) v += sh[2 * A_IN + col] * bf2f(z[ZP]);
    return v;
}

__device__ void ph_streams(const Params& p, int l, long gtid, long gsz) {
    for (long i = gtid; i < (long)T * DA; i += gsz) {
        const int m = (int)(i / DA), c = (int)(i % DA), h0 = c & ~63;
        const float r = zshift(p, l, m, c), k = zshift(p, l, m, 256 + c), v = zshift(p, l, m, 512 + c);
        float nrm = 0.f;
        for (int j = 0; j < 64; ++j) { const float t = zshift(p, l, m, 256 + h0 + j) * p.a_k_k[l * DA + h0 + j]; nrm += t * t; }
        const float kk = k * p.a_k_k[l * DA + c] / sqrtf(nrm + 1e-12f);
        float g = 0.f;
        for (int j = 0; j < 160; ++j) g += sigmoidf_(zshift(p, l, m, 1024 + j)) * p.a_g_up[((size_t)l * 160 + j) * DA + c];
        const size_t o = (size_t)m * DA + c;
        p.sR[o] = r; p.sV[o] = v; p.sKK[o] = kk; p.sG[o] = g;
        for (int d = 0; d < 2; ++d) {
            float aw = 0.f, aa = 0.f;
            for (int j = 0; j < 64; ++j) {
                aw += tanhf(zshift(p, l, m, 768 + d * 64 + j)) * p.a_w_up[(((size_t)l * 2 + d) * 64 + j) * DA + c];
                aa += zshift(p, l, m, 896 + d * 64 + j) * p.a_a_up[(((size_t)l * 2 + d) * 64 + j) * DA + c];
            }
            const float u = -(p.a_w0[(l * 2 + d) * DA + c] + aw);
            const float sp = (u > 20.f) ? u : log1pf(expf(u));
            const float w = expf(-expf(-sp - 0.5f));
            const float a = sigmoidf_(p.a_a0[(l * 2 + d) * DA + c] + aa);
            const size_t od = ((size_t)d * T + m) * DA + c;
            p.sW[od] = w; p.sKD[od] = k * (1.0f + (a - 1.0f) * p.a_k_a[l * DA + c]); p.sB[od] = kk * a;
        }
    }
}

__device__ __forceinline__ void ph_rope(const Params& p, long gtid, long gsz) {
    for (long i = gtid; i < (long)TL * 8 * 32; i += gsz) {
        const int pr = (int)(i & 31), hs = (int)((i >> 5) & 7), m = (int)(i >> 8);
        const int t = m % S, axis = pr >> 4, fi = pr & 15, pos = axis ? (t % GRID_W) : (t / GRID_W);
        bf16_t* z = p.Z + (size_t)m * ZP + hs * 64 + axis * 32 + fi;
        const float cs = p.rope[pos * 16 + fi], sn = p.rope[1024 + pos * 16 + fi];
        const float x0 = bf2f(z[0]), x1 = bf2f(z[16]);
        z[0] = f2bf(x0 * cs - x1 * sn); z[16] = f2bf(x1 * cs + x0 * sn);
    }
}

__device__ void ph_scan(const Params& p, long gtid, long gsz) {
    for (long i = gtid; i < (long)2 * NB * 4 * 64; i += gsz) {
        const int v = (int)(i & 63), h = (int)((i >> 6) & 3), b = (int)((i >> 8) % NB), d = (int)((i >> 8) / NB);
        float st[64];
#pragma unroll
        for (int k = 0; k < 64; ++k) st[k] = 0.f;
        for (int pos = 0; pos < L + S; ++pos) {
            int m;
            if (pos < L) m = TL + b * L + (d ? L - 1 - pos : pos);
            else m = b * S + (d ? S - 1 - (pos - L) : pos - L);
            const size_t o = (size_t)m * DA + h * 64, od = ((size_t)d * T + m) * DA + h * 64;
            const float* kk = p.sKK + o; const float* r = p.sR + o;
            const float* w = p.sW + od; const float* bb = p.sB + od; const float* kd = p.sKD + od;
            const float vv = p.sV[o + v];
            float sk = 0.f;
#pragma unroll
            for (int k = 0; k < 64; ++k) sk += st[k] * kk[k];
            float y = 0.f;
#pragma unroll
            for (int k = 0; k < 64; ++k) { st[k] = st[k] * w[k] - sk * bb[k] + vv * kd[k]; y += st[k] * r[k]; }
            p.Y[od + v] = y;
        }
    }
}

__device__ void ph_rwkv_out(const Params& p, int l, int nrows, long gtid, long gsz) {
    for (long i = gtid; i < (long)nrows * 4; i += gsz) {
        const int m = (int)(i >> 2), h = (int)(i & 3);
        const size_t o = (size_t)m * DA + h * 64;
        const float* y0 = p.Y + o; const float* y1 = p.Y + (size_t)T * DA + o;
        float s = 0.f, bon = 0.f;
        for (int n = 0; n < 64; ++n) {
            s += y0[n] + y1[n];
            bon += p.sR[o + n] * (p.sKD[o + n] + p.sKD[(size_t)T * DA + o + n]) * p.a_r_k[l * DA + h * 64 + n];
        }
        const float mu = s / 64.f; float q = 0.f;
        for (int n = 0; n < 64; ++n) { const float dd = y0[n] + y1[n] - mu; q += dd * dd; }
        const float rstd = 1.0f / sqrtf(q / 64.f + GN_EPS);
        for (int n = 0; n < 64; ++n) {
            const int c = h * 64 + n;
            const float yn = (y0[n] + y1[n] - mu) * rstd * p.a_lnx_g[l * DA + c] + p.a_lnx_b[l * DA + c];
            p.MIX[(size_t)m * DMIX + c] = f2bf((yn + bon * p.sV[o + n]) * p.sG[o + n]);
        }
    }
}

__device__ __forceinline__ void att_key(const float (&q)[64], const bf16_t* kr, const bf16_t* vr, float bias, float& mx, float& ls, float (&acc)[64]) {
    float s = 0.f;
#pragma unroll
    for (int d = 0; d < 64; ++d) s += q[d] * bf2f(kr[d]);
    s = s * ATT_SCALE + bias;
    const float mn = fmaxf(mx, s), f = expf(mx - mn), pe = expf(s - mn);
    ls = ls * f + pe;
#pragma unroll
    for (int d = 0; d < 64; ++d) acc[d] = acc[d] * f + pe * bf2f(vr[d]);
    mx = mn;
}

__device__ void ph_attn(const Params& p, int l, int nrows, long gtid, long gsz) {
    for (long i = gtid; i < (long)nrows * 12; i += gsz) {
        const int m = (int)(i / 12), u = (int)(i % 12);
        const bool isB = u < 6; const int hq = isB ? u : u - 6;
        const int b = (m < TL) ? m / S : (m - TL) / L;
        const int qcol = isB ? ZQB + hq * 64 : ZQN + hq * 64;
        const int kcol = isB ? ZKB + (hq / 3) * 64 : ZKN + hq * 64;
        const int vcol = isB ? ZVB + (hq / 3) * 64 : ZVN + hq * 64;
        float q[64], acc[64];
        const bf16_t* qr = p.Z + (size_t)m * ZP + qcol;
#pragma unroll
        for (int d = 0; d < 64; ++d) { q[d] = bf2f(qr[d]); acc[d] = 0.f; }
        float mx, ls;
        if (isB) { mx = p.b_sink[l * 6 + hq]; ls = 1.0f; } else { mx = -1e30f; ls = 0.f; }
        for (int j = 0; j < L; ++j) { const bf16_t* zr = p.Z + (size_t)(TL + b * L + j) * ZP; att_key(q, zr + kcol, zr + vcol, 0.f, mx, ls, acc); }
        if (m < TL) {
            const int t = m % S;
            if (isB) {
                const int j0 = t - 128 < 0 ? 0 : t - 128, j1 = t + 128 > S - 1 ? S - 1 : t + 128;
                for (int j = j0; j <= j1; ++j) { const bf16_t* zr = p.Z + (size_t)(b * S + j) * ZP; att_key(q, zr + kcol, zr + vcol, 0.f, mx, ls, acc); }
            } else {
                const int rows = S / GRID_W, r = t / GRID_W, c = t % GRID_W;
                int r0 = r - 4; r0 = r0 < 0 ? 0 : (r0 > rows - 8 ? rows - 8 : r0);
                int c0 = c - 8; c0 = c0 < 0 ? 0 : (c0 > GRID_W - 16 ? GRID_W - 16 : c0);
                for (int a = 0; a < 8; ++a)
                    for (int e = 0; e < 16; ++e) {
                        const int kr = r0 + a, kc = c0 + e;
                        const float bias = p.c_rpb[(((size_t)l * 6 + hq) * 15 + (kr - r + 7)) * 31 + (kc - c + 15)];
                        const bf16_t* zr = p.Z + (size_t)(b * S + kr * GRID_W + kc) * ZP;
                        att_key(q, zr + kcol, zr + vcol, bias, mx, ls, acc);
                    }
            }
        }
        const float inv = 1.0f / ls;
        bf16_t* o = p.MIX + (size_t)m * DMIX + (isB ? 256 : 640) + hq * 64;
#pragma unroll
        for (int d = 0; d < 64; ++d) o[d] = f2bf(acc[d] * inv);
    }
}

__device__ void ph_post_mixer(const Params& p, int l, int nrows, long gtid, long gsz) {
    for (long mm = gtid; mm < nrows; mm += gsz) {
        const int m = (int)mm;
        const float* xr = xrow_in(p, l, m); const float* md = modrow(p, l, m); const float* orow = p.O + (size_t)m * D;
        float* x1 = (m < TL) ? p.out + (size_t)m * D : p.XC + (size_t)(m - TL) * D;
        const float* g1 = p.ln1_g + (size_t)l * D; const float* b1 = p.ln1_b + (size_t)l * D;
        float s = 0.f; for (int j = 0; j < D; ++j) s += ALPHA * xr[j] + md[2 * D + j] * orow[j];
        float mu = s / D, q = 0.f;
        for (int j = 0; j < D; ++j) { const float d = ALPHA * xr[j] + md[2 * D + j] * orow[j] - mu; q += d * d; }
        float rstd = 1.0f / sqrtf(q / D + LN_EPS);
        s = 0.f;
        for (int j = 0; j < D; ++j) { const float v = (ALPHA * xr[j] + md[2 * D + j] * orow[j] - mu) * rstd * g1[j] + b1[j]; x1[j] = v; s += v; }
        mu = s / D; q = 0.f;
        for (int j = 0; j < D; ++j) { const float d = x1[j] - mu; q += d * d; }
        rstd = 1.0f / sqrtf(q / D + LN_EPS);
        float gl[4], el[32];
#pragma unroll
        for (int g = 0; g < 4; ++g) gl[g] = p.b_rg[l * 4 + g];
#pragma unroll
        for (int e = 0; e < 32; ++e) el[e] = p.b_re[l * 32 + e];
        for (int j = 0; j < D; ++j) {
            const float hv = (x1[j] - mu) * rstd * (1.0f + md[4 * D + j]) + md[3 * D + j];
            p.H[(size_t)m * D + j] = f2bf(hv);
            const float* wg = p.w_rg + ((size_t)l * D + j) * 4; const float* we = p.w_re + ((size_t)l * D + j) * 32;
#pragma unroll
            for (int g = 0; g < 4; ++g) gl[g] += hv * wg[g];
#pragma unroll
            for (int e = 0; e < 32; ++e) el[e] += hv * we[e];
        }
        int gs = 0; float gm = gl[0];
#pragma unroll
        for (int g = 1; g < 4; ++g) if (gl[g] > gm) { gm = gl[g]; gs = g; }
        float den = 0.f;
#pragma unroll
        for (int g = 0; g < 4; ++g) den += expf(gl[g] - gm);
        const float pg = 1.0f / den;
        float v1 = -3e38f, v2 = -3e38f; int i1 = 0, i2 = 0;
#pragma unroll
        for (int j = 0; j < 8; ++j) {
            const float v = gs == 0 ? el[j] : gs == 1 ? el[8 + j] : gs == 2 ? el[16 + j] : el[24 + j];
            if (v > v1) { v2 = v1; i2 = i1; v1 = v; i1 = j; } else if (v > v2) { v2 = v; i2 = j; }
        }
        const float e2 = expf(v2 - v1), w1 = pg / (1.0f + e2), w2 = pg * e2 / (1.0f + e2);
        const int ea = gs * 8 + i1, eb = gs * 8 + i2;
        p.rE[2 * m] = ea; p.rE[2 * m + 1] = eb; p.rW[2 * m] = w1; p.rW[2 * m + 1] = w2;
        p.rPos[2 * m] = atomic_inc_int(p.cnt + l * NEXP + ea); p.rPos[2 * m + 1] = atomic_inc_int(p.cnt + l * NEXP + eb);
    }
}

__device__ __forceinline__ int pstart_of(const int* cnt, int e) {
    int s = 0;
    for (int j = 0; j < NEXP; ++j) if (j < e) s += (cnt[j] + 127) & ~127;
    return s;
}
__device__ __forceinline__ void ph_dispatch(const Params& p, int l, int nrows, long gtid, long gsz) {
    for (long i = gtid; i < (long)nrows * 2; i += gsz) {
        const int slot = pstart_of(p.cnt + l * NEXP, p.rE[i]) + p.rPos[i];
        p.rSlot[i] = slot; p.slotTok[slot] = (int)(i >> 1);
    }
}

__device__ void ph_final(const Params& p, int l, int nrows, long gtid, long gsz) {
    for (long mm = gtid; mm < nrows; mm += gsz) {
        const int m = (int)mm;
        float* x1 = (m < TL) ? p.out + (size_t)m * D : p.XC + (size_t)(m - TL) * D;
        const float* md = modrow(p, l, m);
        const float* ya = p.YS + (size_t)p.rSlot[2 * m] * D; const float* yb = p.YS + (size_t)p.rSlot[2 * m + 1] * D;
        const float wa = p.rW[2 * m], wb = p.rW[2 * m + 1];
        const float* g2 = p.ln2_g + (size_t)l * D; const float* b2 = p.ln2_b + (size_t)l * D;
        float s = 0.f; for (int j = 0; j < D; ++j) s += ALPHA * x1[j] + md[5 * D + j] * (wa * ya[j] + wb * yb[j]);
        const float mu = s / D; float q = 0.f;
        for (int j = 0; j < D; ++j) { const float d = ALPHA * x1[j] + md[5 * D + j] * (wa * ya[j] + wb * yb[j]) - mu; q += d * d; }
        const float rstd = 1.0f / sqrtf(q / D + LN_EPS);
        for (int j = 0; j < D; ++j) x1[j] = (ALPHA * x1[j] + md[5 * D + j] * (wa * ya[j] + wb * yb[j]) - mu) * rstd * g2[j] + b2[j];
    }
}

__device__ __forceinline__ int moe_blocks(const int* cnt) { int s = 0; for (int j = 0; j < NEXP; ++j) s += (cnt[j] + 127) >> 7; return s; }
__device__ __forceinline__ int moe_block_expert(const int* cnt, int rb) {
    int s = 0, e = 0;
    for (int j = 0; j < NEXP; ++j) { const int nb = (cnt[j] + 127) >> 7; if (rb >= s && rb < s + nb) e = j; s += nb; }
    return e;
}

#ifdef HOST_EMU
static void host_gemm_in(const Params& p) {
    for (int m = 0; m < T; ++m) for (int n = 0; n < ZP; ++n) { float a = 0.f; for (int k = 0; k < D; ++k) a += bf2f(p.H[(size_t)m * D + k]) * bf2f(p.win_t[(size_t)n * D + k]); p.Z[(size_t)m * ZP + n] = f2bf(a); }
}
static void host_gemm_out(const Params& p, int nrows) {
    for (int m = 0; m < nrows; ++m) for (int n = 0; n < D; ++n) { float a = 0.f; for (int k = 0; k < DMIX; ++k) a += bf2f(p.MIX[(size_t)m * DMIX + k]) * bf2f(p.wout_t[(size_t)n * DMIX + k]); p.O[(size_t)m * D + n] = a; }
}
static void host_moe1(const Params& p, int l) {
    const int* cnt = p.cnt + l * NEXP; const int nrb = moe_blocks(cnt);
    for (int rb = 0; rb < nrb; ++rb) { const int e = moe_block_expert(cnt, rb);
        for (int r = 0; r < 128; ++r) { const int slot = rb * 128 + r; const bf16_t* a = p.H + (size_t)p.slotTok[slot] * D;
            for (int c = 0; c < DE; ++c) { const int q = c >> 4, ii = c & 15; float g = 0.f, u = 0.f;
                const bf16_t* wg = p.wgu_t + ((size_t)e * 2 * DE + 32 * q + ii) * D; const bf16_t* wu = wg + (size_t)16 * D;
                for (int k = 0; k < D; ++k) { g += bf2f(a[k]) * bf2f(wg[k]); u += bf2f(a[k]) * bf2f(wu[k]); }
                p.ACT[(size_t)slot * DE + c] = f2bf(siluf_(g) * u); } } }
}
static void host_moe2(const Params& p, int l) {
    const int* cnt = p.cnt + l * NEXP; const int nrb = moe_blocks(cnt);
    for (int rb = 0; rb < nrb; ++rb) { const int e = moe_block_expert(cnt, rb);
        for (int r = 0; r < 128; ++r) { const int slot = rb * 128 + r;
            for (int n = 0; n < D; ++n) { float a = 0.f; const bf16_t* w = p.wd_t + ((size_t)e * D + n) * DE;
                for (int k = 0; k < DE; ++k) a += bf2f(p.ACT[(size_t)slot * DE + k]) * bf2f(w[k]);
                p.YS[(size_t)slot * D + n] = a; } } }
}
#else
typedef short bf16x8 __attribute__((ext_vector_type(8)));
typedef float f32x4 __attribute__((ext_vector_type(4)));
__device__ __forceinline__ int opq_tid() { int t = threadIdx.x; asm volatile("" : "+v"(t)); return t; }
__device__ __forceinline__ int opq_bid() { int b = blockIdx.x; asm volatile("" : "+s"(b)); return b; }
__device__ __forceinline__ unsigned pk2(float lo, float hi) { return (unsigned)f2bf(lo) | ((unsigned)f2bf(hi) << 16); }
struct u32x2_t { unsigned x, y; };
__device__ __forceinline__ void st_bf16x4(bf16_t* dst, f32x4 v) { u32x2_t o; o.x = pk2(v[0], v[1]); o.y = pk2(v[2], v[3]); *(u32x2_t*)dst = o; }
template <class Epi>
__device__ __forceinline__ void gemm_tile(const bf16_t* a0, const bf16_t* a1, const bf16_t* b0, const bf16_t* b1, int K, char* lds, const Epi& epi) {
    const int tid = opq_tid(), wid = tid >> 6, lane = tid & 63, wr = wid >> 1, wc = wid & 1, fr = lane & 15, fq = lane >> 4;
    f32x4 acc[4][4];
#pragma unroll
    for (int m = 0; m < 4; ++m)
#pragma unroll
        for (int n = 0; n < 4; ++n) acc[m][n] = (f32x4){0.f, 0.f, 0.f, 0.f};
#define GT_STAGE(st_, kt_) do { char* sa_ = lds + (st_) * 16384 + tid * 16; \
        __builtin_amdgcn_global_load_lds((const unsigned*)(a0 + (kt_)), (__attribute__((address_space(3))) unsigned*)(sa_), 16, 0, 0); \
        __builtin_amdgcn_global_load_lds((const unsigned*)(a1 + (kt_)), (__attribute__((address_space(3))) unsigned*)(sa_ + 4096), 16, 0, 0); \
        __builtin_amdgcn_global_load_lds((const unsigned*)(b0 + (kt_)), (__attribute__((address_space(3))) unsigned*)(sa_ + 8192), 16, 0, 0); \
        __builtin_amdgcn_global_load_lds((const unsigned*)(b1 + (kt_)), (__attribute__((address_space(3))) unsigned*)(sa_ + 12288), 16, 0, 0); } while (0)
    const int fsw = (0 - (fr >> 2)) & 3;
    const int aoff = (wr * 64 + fr) * 64 + ((fq ^ fsw) * 16), boff = 8192 + (wc * 64 + fr) * 64 + ((fq ^ fsw) * 16);
    const int nk = K / 32;
    GT_STAGE(0, 0);
    if (nk > 1) GT_STAGE(1, 32);
    if (nk > 2) GT_STAGE(2, 64);
    for (int t = 0; t < nk; ++t) {
        if (t + 2 < nk) asm volatile("s_waitcnt vmcnt(8)" ::: "memory"); else if (t + 1 < nk) asm volatile("s_waitcnt vmcnt(4)" ::: "memory"); else asm volatile("s_waitcnt vmcnt(0)" ::: "memory");
        asm volatile("s_waitcnt lgkmcnt(0)" ::: "memory");
        __builtin_amdgcn_s_barrier();
        if (t + 3 < nk) GT_STAGE((t + 3) & 3, (t + 3) * 32);
        const char* sb = lds + (t & 3) * 16384;
        bf16x8 At[4], Bt[4];
#pragma unroll
        for (int m = 0; m < 4; ++m) At[m] = *(const bf16x8*)(sb + aoff + m * 1024);
#pragma unroll
        for (int n = 0; n < 4; ++n) Bt[n] = *(const bf16x8*)(sb + boff + n * 1024);
#pragma unroll
        for (int m = 0; m < 4; ++m)
#pragma unroll
            for (int n = 0; n < 4; ++n) acc[m][n] = __builtin_amdgcn_mfma_f32_16x16x32_bf16(At[m], Bt[n], acc[m][n], 0, 0, 0);
    }
    asm volatile("s_waitcnt lgkmcnt(0)" ::: "memory");
    __builtin_amdgcn_s_barrier();
#undef GT_STAGE
    epi(acc, wr, wc, fr, fq);
}
#define STG_ROW(i) ((tid_ + (i) * 256) >> 2)
#define STG_K ((((tid_ & 3) ^ ((0 - (tid_ >> 4)) & 3))) * 8)

__device__ __forceinline__ void g_gemm_in(const Params& p, char* lds) {
    const int tid_ = opq_tid(), bid_ = opq_bid(); (void)tid_; (void)bid_;
    constexpr int NT = NINP / 128, MT = T / 128;
    for (int tile = bid_; tile < NT * MT; tile += gridDim.x) {
        const int tm = tile / NT, tn = tile % NT;
        const bf16_t* a0 = p.H + (size_t)(tm * 128 + STG_ROW(0)) * D + STG_K; const bf16_t* a1 = p.H + (size_t)(tm * 128 + STG_ROW(1)) * D + STG_K;
        const bf16_t* b0 = p.win_t + (size_t)(tn * 128 + STG_ROW(0)) * D + STG_K; const bf16_t* b1 = p.win_t + (size_t)(tn * 128 + STG_ROW(1)) * D + STG_K;
        gemm_tile(a0, a1, b0, b1, D, lds, [&](const f32x4 (&acc)[4][4], int wr, int wc, int fr, int fq) {
            if (tn < ZVB / 128 && tm < TL / 128) {
#pragma unroll
                for (int m = 0; m < 4; ++m)
#pragma unroll
                    for (int j = 0; j < 4; ++j) { const int row = tm * 128 + wr * 64 + m * 16 + fq * 4 + j, t = row % S;
                        bf16_t* zr = p.Z + (size_t)row * ZP + tn * 128 + wc * 64 + fr;
#pragma unroll
                        for (int ax = 0; ax < 2; ++ax) { const int pos = ax ? t % GRID_W : t / GRID_W; const float cs = p.rope[pos * 16 + fr], sn = p.rope[1024 + pos * 16 + fr];
                            const float x0 = acc[m][2 * ax][j], x1 = acc[m][2 * ax + 1][j];
                            zr[32 * ax] = f2bf(x0 * cs - x1 * sn); zr[32 * ax + 16] = f2bf(x1 * cs + x0 * sn); } }
            } else {
#pragma unroll
            for (int m = 0; m < 4; ++m)
#pragma unroll
                for (int n = 0; n < 4; ++n) { const int col = tn * 128 + wc * 64 + n * 16 + fr;
                    if (col < ZP) {
#pragma unroll
                        for (int j = 0; j < 4; ++j) p.Z[(size_t)(tm * 128 + wr * 64 + m * 16 + fq * 4 + j) * ZP + col] = f2bf(acc[m][n][j]); } }
            }
            if (tn == ZVB / 128 || (tn >= ZVN / 128 && tn < ZA / 128)) {
#pragma unroll
                for (int m = 0; m < 4; ++m) { const int m0 = tm * 128 + wr * 64 + m * 16 + fq * 4; int b, u;
                    if (m0 < TL) { b = m0 / S; u = L + m0 % S; } else { b = (m0 - TL) / L; u = (m0 - TL) % L; }
#pragma unroll
                    for (int n = 0; n < 4; ++n) { const int col = tn * 128 + wc * 64 + n * 16 + fr;
                        const int hv = col < ZVN ? (col - ZVB) >> 6 : 2 + ((col - ZVN) >> 6), d = col < ZVN ? (col - ZVB) & 63 : (col - ZVN) & 63;
                        st_bf16x4(p.VT + ((size_t)(b * 8 + hv) * 64 + d) * PU + u, acc[m][n]); } }
            }
        });
    }
}
__device__ __forceinline__ void g_gemm_out(const Params& p, int nrows, char* lds) {
    const int tid_ = opq_tid(), bid_ = opq_bid(); (void)tid_; (void)bid_;
    constexpr int NT = D / 128; const int MT = nrows / 128;
    for (int tile = bid_; tile < NT * MT; tile += gridDim.x) {
        const int tm = tile / NT, tn = tile % NT;
        const bf16_t* a0 = p.MIX + (size_t)(tm * 128 + STG_ROW(0)) * DMIX + STG_K; const bf16_t* a1 = p.MIX + (size_t)(tm * 128 + STG_ROW(1)) * DMIX + STG_K;
        const bf16_t* b0 = p.wout_t + (size_t)(tn * 128 + STG_ROW(0)) * DMIX + STG_K; const bf16_t* b1 = p.wout_t + (size_t)(tn * 128 + STG_ROW(1)) * DMIX + STG_K;
        gemm_tile(a0, a1, b0, b1, DMIX, lds, [&](const f32x4 (&acc)[4][4], int wr, int wc, int fr, int fq) {
#pragma unroll
            for (int m = 0; m < 4; ++m)
#pragma unroll
                for (int n = 0; n < 4; ++n)
#pragma unroll
                    for (int j = 0; j < 4; ++j) p.O[(size_t)(tm * 128 + wr * 64 + m * 16 + fq * 4 + j) * D + tn * 128 + wc * 64 + n * 16 + fr] = acc[m][n][j];
        });
    }
}
__device__ __forceinline__ void g_moe1(const Params& p, int l, char* lds) {
    const int tid_ = opq_tid(), bid_ = opq_bid(); (void)tid_; (void)bid_;
    const int* cnt = p.cnt + l * NEXP; const int nrb = moe_blocks(cnt); constexpr int NT = 2 * DE / 128;
    for (int tile = bid_; tile < nrb * NT; tile += gridDim.x) {
        const int rb = tile / NT, tn = tile % NT, e = moe_block_expert(cnt, rb);
        const bf16_t* a0 = p.H + (size_t)p.slotTok[rb * 128 + STG_ROW(0)] * D + STG_K; const bf16_t* a1 = p.H + (size_t)p.slotTok[rb * 128 + STG_ROW(1)] * D + STG_K;
        const bf16_t* bw = p.wgu_t + (size_t)e * 2 * DE * D;
        const bf16_t* b0 = bw + (size_t)(tn * 128 + STG_ROW(0)) * D + STG_K; const bf16_t* b1 = bw + (size_t)(tn * 128 + STG_ROW(1)) * D + STG_K;
        gemm_tile(a0, a1, b0, b1, D, lds, [&](const f32x4 (&acc)[4][4], int wr, int wc, int fr, int fq) {
#pragma unroll
            for (int m = 0; m < 4; ++m)
#pragma unroll
                for (int n2 = 0; n2 < 2; ++n2) { const int col = tn * 64 + wc * 32 + n2 * 16 + fr;
#pragma unroll
                    for (int j = 0; j < 4; ++j) { const float g = acc[m][2 * n2][j], u = acc[m][2 * n2 + 1][j];
                        p.ACT[(size_t)(rb * 128 + wr * 64 + m * 16 + fq * 4 + j) * DE + col] = f2bf(g / (1.0f + __expf(-g)) * u); } }
        });
    }
}
__device__ __forceinline__ void g_moe2(const Params& p, int l, char* lds) {
    const int tid_ = opq_tid(), bid_ = opq_bid(); (void)tid_; (void)bid_;
    const int* cnt = p.cnt + l * NEXP; const int nrb = moe_blocks(cnt); constexpr int NT = D / 128;
    for (int tile = bid_; tile < nrb * NT; tile += gridDim.x) {
        const int rb = tile / NT, tn = tile % NT, e = moe_block_expert(cnt, rb);
        const bf16_t* a0 = p.ACT + (size_t)(rb * 128 + STG_ROW(0)) * DE + STG_K; const bf16_t* a1 = p.ACT + (size_t)(rb * 128 + STG_ROW(1)) * DE + STG_K;
        const bf16_t* bw = p.wd_t + (size_t)e * D * DE;
        const bf16_t* b0 = bw + (size_t)(tn * 128 + STG_ROW(0)) * DE + STG_K; const bf16_t* b1 = bw + (size_t)(tn * 128 + STG_ROW(1)) * DE + STG_K;
        gemm_tile(a0, a1, b0, b1, DE, lds, [&](const f32x4 (&acc)[4][4], int wr, int wc, int fr, int fq) {
#pragma unroll
            for (int m = 0; m < 4; ++m)
#pragma unroll
                for (int n = 0; n < 4; ++n)
#pragma unroll
                    for (int j = 0; j < 4; ++j) p.YS[(size_t)(rb * 128 + wr * 64 + m * 16 + fq * 4 + j) * D + tn * 128 + wc * 64 + n * 16 + fr] = acc[m][n][j];
        });
    }
}


constexpr int DV = D / 256;
static_assert(D % 256 == 0, "row phases hold a row as DV float4 per lane");
template <int CTRL> __device__ __forceinline__ float dppf(float v) { return __builtin_bit_cast(float, __builtin_amdgcn_update_dpp(0, __builtin_bit_cast(int, v), CTRL, 0xf, 0xf, true)); }
__device__ __forceinline__ float wave_sum(float v) {
    v += dppf<0xB1>(v); v += dppf<0x4E>(v); v += dppf<0x141>(v); v += dppf<0x140>(v);
    float a = v, b = v;
    asm volatile("s_nop 1\n\tv_permlane16_swap_b32 %0, %1" : "+v"(a), "+v"(b));
    v = a + b; a = v; b = v;
    asm volatile("s_nop 1\n\tv_permlane32_swap_b32 %0, %1" : "+v"(a), "+v"(b));
    return a + b;
}
__device__ __forceinline__ float sum8(float v) { v += dppf<0xB1>(v); v += dppf<0x4E>(v); v += dppf<0x141>(v); return v; }
__device__ __forceinline__ float sum4(f32x4 a) { return (a[0] + a[1]) + (a[2] + a[3]); }
#define LDS_WAIT() asm volatile("s_waitcnt lgkmcnt(0)" ::: "memory")

__device__ __forceinline__ void row_stats(const f32x4 (&v)[DV], float& mu, float& rstd) {
    float s = 0.f;
#pragma unroll
    for (int j = 0; j < DV; ++j) s += sum4(v[j]);
    mu = wave_sum(s) * (1.0f / D);
    float q = 0.f;
#pragma unroll
    for (int j = 0; j < DV; ++j) { const f32x4 d = v[j] - mu; q += sum4(d * d); }
    rstd = 1.0f / sqrtf(wave_sum(q) * (1.0f / D) + LN_EPS);
}

__device__ __forceinline__ void ph_lnmod_fast(const Params& p, int l) {
    const int tid_ = opq_tid(), bid_ = opq_bid(); (void)tid_; (void)bid_;
    const int lane = tid_ & 63, gw = bid_ * 4 + (tid_ >> 6), nw = gridDim.x * 4;
    for (int m = gw; m < T; m += nw) {
        const f32x4* xr = (const f32x4*)xrow_in(p, l, m) + lane; const f32x4* md = (const f32x4*)modrow(p, l, m) + lane;
        f32x4 v[DV];
#pragma unroll
        for (int j = 0; j < DV; ++j) v[j] = xr[64 * j];
        float mu, rstd; row_stats(v, mu, rstd);
#pragma unroll
        for (int j = 0; j < DV; ++j) { const f32x4 sh = md[64 * j], sc = md[D / 4 + 64 * j];
            st_bf16x4(p.H + (size_t)m * D + 4 * (lane + 64 * j), (v[j] - mu) * rstd * (sc + 1.0f) + sh); }
    }
}

__device__ __forceinline__ void pm_row(const Params& p, int l, int m, int lane) {
    const f32x4* xr = (const f32x4*)xrow_in(p, l, m) + lane; const f32x4* md = (const f32x4*)modrow(p, l, m) + lane;
    const f32x4* orow = (const f32x4*)(p.O + (size_t)m * D) + lane;
    f32x4* x1 = (f32x4*)((m < TL) ? p.out + (size_t)m * D : p.XC + (size_t)(m - TL) * D) + lane;
    const f32x4* g1 = (const f32x4*)(p.ln1_g + (size_t)l * D) + lane; const f32x4* b1 = (const f32x4*)(p.ln1_b + (size_t)l * D) + lane;
    f32x4 v[DV];
#pragma unroll
    for (int j = 0; j < DV; ++j) v[j] = xr[64 * j] * ALPHA + md[2 * (D / 4) + 64 * j] * orow[64 * j];
    float mu, rstd; row_stats(v, mu, rstd);
#pragma unroll
    for (int j = 0; j < DV; ++j) { v[j] = (v[j] - mu) * rstd * g1[64 * j] + b1[64 * j]; x1[64 * j] = v[j]; }
    row_stats(v, mu, rstd);
#pragma unroll
    for (int j = 0; j < DV; ++j) {
        const f32x4 hv = (v[j] - mu) * rstd * (md[4 * (D / 4) + 64 * j] + 1.0f) + md[3 * (D / 4) + 64 * j];
        f32x4 hh, lo;
#pragma unroll
        for (int e = 0; e < 4; ++e) { hh[e] = bf2f(f2bf(hv[e])); lo[e] = hv[e] - hh[e]; }
        st_bf16x4(p.H + (size_t)m * D + 4 * (lane + 64 * j), hh);
        st_bf16x4(p.HLO + (size_t)m * D + 4 * (lane + 64 * j), lo);
    }
}

__device__ __forceinline__ void g_router(const Params& p, int l, int nrows, char* lds) {
    const int tid_ = opq_tid(), bid_ = opq_bid(); (void)tid_; (void)bid_;
    const int lane = tid_ & 63, wid = tid_ >> 6, fr = lane & 15, fq = lane >> 4;
    float* part = (float*)lds;
    float* lgt = part + 4 * 6 * 64 * 4;
    int* eids = (int*)(lgt + 32 * 48);
    for (int rg = bid_; rg < nrows / 32; rg += gridDim.x) {
#pragma unroll 1
        for (int i = 0; i < 8; ++i) pm_row(p, l, rg * 32 + wid * 8 + i, lane);
        asm volatile("s_waitcnt vmcnt(0)" ::: "memory");
        __syncthreads();
        f32x4 acc[2][3];
#pragma unroll
        for (int a = 0; a < 2; ++a)
#pragma unroll
            for (int b = 0; b < 3; ++b) acc[a][b] = (f32x4){0.f, 0.f, 0.f, 0.f};
#pragma unroll
        for (int seg = 0; seg < 3; ++seg) {
            const bf16_t* ap = (seg < 2 ? p.H : p.HLO) + (size_t)(rg * 32 + fr) * D + wid * (D / 4) + fq * 8;
            const bf16_t* bp = p.wrt + (seg == 1 ? (size_t)128 * D : 0) + (size_t)fr * D + wid * (D / 4) + fq * 8;
#pragma unroll 1
            for (int ks0 = 0; ks0 < D / 128; ks0 += 4) {
                bf16x8 av[4][2], bv[4][3];
#pragma unroll
                for (int u = 0; u < 4; ++u) { const int ko = (ks0 + u) * 32;
                    av[u][0] = *(const bf16x8*)(ap + ko); av[u][1] = *(const bf16x8*)(ap + (size_t)16 * D + ko);
                    bv[u][0] = *(const bf16x8*)(bp + ko); bv[u][1] = *(const bf16x8*)(bp + (size_t)16 * D + ko); bv[u][2] = *(const bf16x8*)(bp + (size_t)32 * D + ko); }
                asm volatile("" ::: "memory");
#pragma unroll
                for (int u = 0; u < 4; ++u)
#pragma unroll
                    for (int a = 0; a < 2; ++a)
#pragma unroll
                        for (int b = 0; b < 3; ++b) acc[a][b] = __builtin_amdgcn_mfma_f32_16x16x32_bf16(av[u][a], bv[u][b], acc[a][b], 0, 0, 0);
            }
        }
#pragma unroll
        for (int a = 0; a < 2; ++a)
#pragma unroll
            for (int b = 0; b < 3; ++b) *(f32x4*)(part + ((wid * 6 + a * 3 + b) * 64 + lane) * 4) = acc[a][b];
        __syncthreads();
#pragma unroll
        for (int i = 0; i < 6; ++i) { const int e = tid_ + 256 * i, f = e >> 8, ln = (e & 255) >> 2, j = e & 3;
            const float sm = (part[((0 * 6 + f) * 64 + ln) * 4 + j] + part[((1 * 6 + f) * 64 + ln) * 4 + j]) + (part[((2 * 6 + f) * 64 + ln) * 4 + j] + part[((3 * 6 + f) * 64 + ln) * 4 + j]);
            lgt[((f / 3) * 16 + (ln >> 4) * 4 + j) * 48 + (f % 3) * 16 + (ln & 15)] = sm; }
        __syncthreads();
        if (tid_ < 32) {
            const int m = rg * 32 + tid_; const float* lg = lgt + tid_ * 48;
            float gl[4], el[32];
#pragma unroll
            for (int g = 0; g < 4; ++g) gl[g] = lg[g] + p.b_rg[l * 4 + g];
#pragma unroll
            for (int e = 0; e < 32; ++e) el[e] = lg[4 + e] + p.b_re[l * 32 + e];
            int gs = 0; float gm = gl[0];
#pragma unroll
            for (int g = 1; g < 4; ++g) if (gl[g] > gm) { gm = gl[g]; gs = g; }
            float den = 0.f;
#pragma unroll
            for (int g = 0; g < 4; ++g) den += expf(gl[g] - gm);
            const float pg = 1.0f / den;
            float v1 = -3e38f, v2 = -3e38f; int i1 = 0, i2 = 0;
#pragma unroll
            for (int j = 0; j < 8; ++j) {
                const float vv = gs == 0 ? el[j] : gs == 1 ? el[8 + j] : gs == 2 ? el[16 + j] : el[24 + j];
                if (vv > v1) { v2 = v1; i2 = i1; v1 = vv; i1 = j; } else if (vv > v2) { v2 = vv; i2 = j; }
            }
            const float e2 = expf(v2 - v1), w1 = pg / (1.0f + e2), w2 = pg * e2 / (1.0f + e2);
            const int ea = gs * 8 + i1, eb = gs * 8 + i2;
            p.rE[2 * m] = ea; p.rE[2 * m + 1] = eb; p.rW[2 * m] = w1; p.rW[2 * m + 1] = w2;
            eids[2 * tid_] = ea; eids[2 * tid_ + 1] = eb;
        }
        __syncthreads();
        if (tid_ < 64) { const int e = eids[tid_]; int rk = 0; for (int j = 0; j < tid_; ++j) rk += (eids[j] == e) ? 1 : 0; p.rPos[2 * (rg * 32) + tid_] = rk; }
        else if (tid_ < 96) { const int e = tid_ - 64; int c = 0; for (int j = 0; j < 64; ++j) c += (eids[j] == e) ? 1 : 0; p.hist[rg * 32 + e] = c; }
        __syncthreads();
    }
}

__device__ __forceinline__ void ph_dispatch_fast(const Params& p, int l, int nrows, char* lds) {
    const int tid_ = opq_tid(), bid_ = opq_bid(); (void)tid_; (void)bid_;
    const int nrg = nrows / 32, e = tid_ & 31, part = tid_ >> 5;
    int* tot = (int*)lds; int* pst = tot + 32; int* pre = pst + 32; int* red = pre + 32;
    { int s = 0; for (int b = part; b < nrg; b += 8) s += p.hist[b * 32 + e]; red[part * 32 + e] = s; }
    __syncthreads();
    if (tid_ < 32) { int s = 0; for (int q = 0; q < 8; ++q) s += red[q * 32 + tid_]; tot[tid_] = s; }
    __syncthreads();
    if (tid_ < 32) { int s = 0; for (int j = 0; j < tid_; ++j) s += (tot[j] + 127) & ~127; pst[tid_] = s; if (bid_ == 0) p.cnt[l * NEXP + tid_] = tot[tid_]; }
    for (int rg = bid_; rg < nrg; rg += gridDim.x) {
        __syncthreads();
        { int s = 0; for (int b = part; b < rg; b += 8) s += p.hist[b * 32 + e]; red[part * 32 + e] = s; }
        __syncthreads();
        if (tid_ < 32) { int s = 0; for (int q = 0; q < 8; ++q) s += red[q * 32 + tid_]; pre[tid_] = s; }
        __syncthreads();
        if (tid_ < 64) { const int i = 2 * (rg * 32) + tid_, ee = p.rE[i], slot = pst[ee] + pre[ee] + p.rPos[i]; p.rSlot[i] = slot; p.slotTok[slot] = i >> 1; }
    }
}

__device__ __forceinline__ void ph_final_fast(const Params& p, int l, int nrows, bool next_h) {
    const int tid_ = opq_tid(), bid_ = opq_bid(); (void)tid_; (void)bid_;
    const int lane = tid_ & 63, gw = bid_ * 4 + (tid_ >> 6), nw = gridDim.x * 4;
    for (int m = gw; m < nrows; m += nw) {
        f32x4* x1 = (f32x4*)((m < TL) ? p.out + (size_t)m * D : p.XC + (size_t)(m - TL) * D) + lane;
        const f32x4* md = (const f32x4*)modrow(p, l, m) + lane;
        const f32x4* ya = (const f32x4*)(p.YS + (size_t)p.rSlot[2 * m] * D) + lane; const f32x4* yb = (const f32x4*)(p.YS + (size_t)p.rSlot[2 * m + 1] * D) + lane;
        const float wa = p.rW[2 * m], wb = p.rW[2 * m + 1];
        const f32x4* g2 = (const f32x4*)(p.ln2_g + (size_t)l * D) + lane; const f32x4* b2 = (const f32x4*)(p.ln2_b + (size_t)l * D) + lane;
        f32x4 v[DV];
#pragma unroll
        for (int j = 0; j < DV; ++j) v[j] = x1[64 * j] * ALPHA + md[5 * (D / 4) + 64 * j] * (ya[64 * j] * wa + yb[64 * j] * wb);
        float mu, rstd; row_stats(v, mu, rstd);
#pragma unroll
        for (int j = 0; j < DV; ++j) { v[j] = (v[j] - mu) * rstd * g2[64 * j] + b2[64 * j]; x1[64 * j] = v[j]; }
        if (next_h) {
            const f32x4* mn = (const f32x4*)modrow(p, l + 1, m) + lane;
            row_stats(v, mu, rstd);
#pragma unroll
            for (int j = 0; j < DV; ++j) st_bf16x4(p.H + (size_t)m * D + 4 * (lane + 64 * j), (v[j] - mu) * rstd * (mn[D / 4 + 64 * j] + 1.0f) + mn[64 * j]);
        }
    }
}

__device__ __forceinline__ void ph_mod_fast(const Params& p, char* lds) {
    const int tid_ = opq_tid(), bid_ = opq_bid(); (void)tid_; (void)bid_;
    constexpr int NR = NB + 1, NTASK = 2 * (6 * D / 64);
    if (bid_ >= NTASK) return;
    float* sc = (float*)lds;
    float* part = sc + NR * D;
    for (int i = tid_; i < NR * D; i += 256) { const int b = i / D, k = i % D; const float cv = b < NB ? p.c[(size_t)b * D + k] : p.c_ctx[k]; sc[i] = cv / (1.0f + __expf(-cv)); }
    __syncthreads();
    const int lane = tid_ & 63, wid = tid_ >> 6;
    for (int task = bid_; task < NTASK; task += gridDim.x) {
        const int ll = task / (6 * D / 64), col = 64 * (task % (6 * D / 64)) + lane;
        float acc[NR];
#pragma unroll
        for (int b = 0; b < NR; ++b) acc[b] = 0.f;
        const float* wp = p.w_mod + ((size_t)ll * D + wid * (D / 4)) * 6 * D + col;
#pragma unroll 16
        for (int k = 0; k < D / 4; ++k) { const float w = wp[(size_t)k * 6 * D];
#pragma unroll
            for (int b = 0; b < NR; ++b) acc[b] += sc[b * D + wid * (D / 4) + k] * w; }
#pragma unroll
        for (int b = 0; b < NR; ++b) part[(wid * NR + b) * 64 + lane] = acc[b];
        __syncthreads();
        for (int i = tid_; i < NR * 64; i += 256) { const int b = i / 64, cl = i % 64;
            p.mod[((size_t)ll * NR + b) * 6 * D + 64 * (task % (6 * D / 64)) + cl] = (part[(0 * NR + b) * 64 + cl] + part[(1 * NR + b) * 64 + cl]) + (part[(2 * NR + b) * 64 + cl] + part[(3 * NR + b) * 64 + cl]) + p.b_mod[(size_t)ll * 6 * D + 64 * (task % (6 * D / 64)) + cl]; }
        __syncthreads();
    }
}

template <bool SPLIT = false>
__device__ __forceinline__ void tr_item(const float* srcl, size_t ldw, bf16_t* dst, size_t ldd, float* scr, int lane) {
    float v[32];
#pragma unroll
    for (int i = 0; i < 32; ++i) v[i] = srcl ? srcl[(size_t)(2 * i + (lane >> 5)) * ldw] : 0.f;
#pragma unroll
    for (int i = 0; i < 32; ++i) scr[(2 * i + (lane >> 5)) * 33 + (lane & 31)] = v[i];
    LDS_WAIT();
    const int c = lane & 7;
#pragma unroll
    for (int j = 0; j < 4; ++j) { const int n = (lane >> 3) + 8 * j; const float* s = scr + (8 * c) * 33 + n;
        uint4 o; o.x = pk2(s[0], s[33]); o.y = pk2(s[2 * 33], s[3 * 33]); o.z = pk2(s[4 * 33], s[5 * 33]); o.w = pk2(s[6 * 33], s[7 * 33]);
        *(uint4*)(dst + (size_t)(SPLIT ? (n & 15) + 32 * (n >> 4) : n) * ldd + 8 * c) = o; }
    LDS_WAIT();
}
__device__ __forceinline__ void ph_prep_w_fast(const Params& p, int l, int part, char* lds) {
    const int tid_ = opq_tid(), bid_ = opq_bid(); (void)tid_; (void)bid_;
    const int lane = tid_ & 63, wid = tid_ >> 6, gw = bid_ * 4 + wid, nw = gridDim.x * 4;
    float* scr = (float*)(lds + wid * 8448);
    constexpr int I_IN = (D / 64) * (NINP / 32), I_OUT = (DMIX / 64) * (D / 32), I_GU1 = (D / 64) * (2 * DE / 32), I_D1 = (DE / 64) * (D / 32);
    constexpr int NITEMS = I_IN + I_OUT + NEXP * (I_GU1 + I_D1);
    const int it0 = part == 0 ? 0 : I_IN + I_OUT, it1 = part == 0 ? I_IN + I_OUT : NITEMS;
    for (int it = it0 + gw; it < it1; it += nw) {
        int r = it;
        if (r < I_IN) { const int kb = r / (NINP / 32), n0 = 32 * (r % (NINP / 32));
            const float* s = nullptr;
            if (n0 < N_IN) { const int oc = (n0 < ZA) ? n0 + A_IN : n0 - ZA; s = p.w_in + ((size_t)l * D + 64 * kb) * N_IN + oc + (lane & 31); }
            tr_item(s, N_IN, p.win_t + (size_t)n0 * D + 64 * kb, D, scr, lane); continue; }
        r -= I_IN;
        if (r < I_OUT) { const int kb = r / (D / 32), n0 = 32 * (r % (D / 32));
            tr_item(p.w_out + ((size_t)l * DMIX + 64 * kb) * D + n0 + (lane & 31), D, p.wout_t + (size_t)n0 * DMIX + 64 * kb, DMIX, scr, lane); continue; }
        r -= I_OUT;
        const int e = r / (I_GU1 + I_D1); r %= (I_GU1 + I_D1);
        if (r < I_GU1) { const int kb = r / (2 * DE / 32), q = r % (2 * DE / 32), up = q & 1, c0 = 32 * (q >> 1);
            const float* s = (up ? p.w_up : p.w_gate) + (((size_t)l * NEXP + e) * D + 64 * kb) * DE + c0 + (lane & 31);
            tr_item<true>(s, DE, p.wgu_t + ((size_t)e * 2 * DE + 2 * c0 + 16 * up) * D + 64 * kb, D, scr, lane); continue; }
        r -= I_GU1;
        { const int kb = r / (D / 32), n0 = 32 * (r % (D / 32));
            tr_item(p.w_down + (((size_t)l * NEXP + e) * DE + 64 * kb) * D + n0 + (lane & 31), D, p.wd_t + ((size_t)e * D + n0) * DE + 64 * kb, DE, scr, lane); }
    }
    if (part != 0) return;
    const long gt = (long)bid_ * blockDim.x + tid_, gs = (long)gridDim.x * blockDim.x;
    for (long i = gt; i < 2 * 256 * 64; i += gs) { const int k = (int)(i & 63), n = (int)((i >> 6) & 255), d = (int)(i >> 14);
        p.wupT[i] = f2bf(p.a_w_up[(((size_t)l * 2 + d) * 64 + k) * DA + n]); p.aupT[i] = f2bf(p.a_a_up[(((size_t)l * 2 + d) * 64 + k) * DA + n]); }
    for (long i = gt; i < 256 * 160; i += gs) { const int k = (int)(i % 160), n = (int)(i / 160); p.gupT[i] = f2bf(p.a_g_up[((size_t)l * 160 + k) * DA + n]); }
    for (long i = gt; i < (long)128 * D; i += gs) { const int n = (int)(i / D), k = (int)(i % D);
        const float w = n < 4 ? p.w_rg[((size_t)l * D + k) * 4 + n] : n < 36 ? p.w_re[((size_t)l * D + k) * 32 + n - 4] : 0.f;
        const bf16_t hb = f2bf(w); p.wrt[i] = hb; p.wrt[(size_t)128 * D + i] = f2bf(w - bf2f(hb)); }
}

__device__ __forceinline__ float tanh_fast(float x) { return 1.0f - 2.0f / (1.0f + __expf(2.0f * x)); }
__device__ __forceinline__ void ph_streams_s1(const Params& p, int l) {
    const int tid_ = opq_tid(), bid_ = opq_bid(); (void)tid_; (void)bid_;
    constexpr int NCH = A_IN / 8, NCHP = (NCH + 7) & ~7;
    const float* sh = p.a_shift + (size_t)l * 3 * A_IN;
    for (long it = (long)bid_ * 256 + tid_; it < (long)T * NCHP; it += (long)gridDim.x * 256) {
        const int m = (int)(it / NCHP), ch = (int)(it % NCHP), c0 = 8 * ch;
        const bool act = ch < NCH;
        int t, len;
        if (m < TL) { t = m % S; len = S; } else { t = (m - TL) % L; len = L; }
        float v[8];
#pragma unroll
        for (int e = 0; e < 8; ++e) v[e] = 0.f;
        if (act) {
            const bf16_t* z = p.Z + (size_t)m * ZP + ZA + c0;
            const bf16x8 zc = *(const bf16x8*)z;
            const f32x4 s1a = *(const f32x4*)(sh + A_IN + c0), s1b = *(const f32x4*)(sh + A_IN + c0 + 4);
#pragma unroll
            for (int e = 0; e < 8; ++e) v[e] = (e < 4 ? s1a[e] : s1b[e - 4]) * bf2f((bf16_t)zc[e]);
            if (t > 0) { const bf16x8 zp = *(const bf16x8*)(z - ZP); const f32x4 a = *(const f32x4*)(sh + c0), b = *(const f32x4*)(sh + c0 + 4);
#pragma unroll
                for (int e = 0; e < 8; ++e) v[e] += (e < 4 ? a[e] : b[e - 4]) * bf2f((bf16_t)zp[e]); }
            if (t < len - 1) { const bf16x8 zn = *(const bf16x8*)(z + ZP); const f32x4 a = *(const f32x4*)(sh + 2 * A_IN + c0), b = *(const f32x4*)(sh + 2 * A_IN + c0 + 4);
#pragma unroll
                for (int e = 0; e < 8; ++e) v[e] += (e < 4 ? a[e] : b[e - 4]) * bf2f((bf16_t)zn[e]); }
        }
        float nrm = 0.f;
        if (ch >= 32 && ch < 64) {
#pragma unroll
            for (int e = 0; e < 8; ++e) { const float t2 = v[e] * p.a_k_k[l * DA + c0 - 256 + e]; nrm += t2 * t2; } }
        nrm = sum8(nrm);
        if (!act) continue;
        if (c0 < 768) {
            float* dst = (c0 < 256 ? p.sR + (size_t)m * DA + c0 : c0 < 512 ? p.kT + (size_t)m * DA + c0 - 256 : p.sV + (size_t)m * DA + c0 - 512);
            *(f32x4*)dst = (f32x4){v[0], v[1], v[2], v[3]}; *(f32x4*)(dst + 4) = (f32x4){v[4], v[5], v[6], v[7]};
            if (ch >= 32 && ch < 64 && (ch & 7) == 0) p.kN[(size_t)m * 4 + ((ch - 32) >> 3)] = 1.0f / sqrtf(nrm + 1e-12f);
        } else {
            if (c0 < 896) {
#pragma unroll
                for (int e = 0; e < 8; ++e) v[e] = tanh_fast(v[e]); }
            else if (c0 >= 1024) {
#pragma unroll
                for (int e = 0; e < 8; ++e) v[e] = 1.0f / (1.0f + __expf(-v[e])); }
            uint4 o; o.x = pk2(v[0], v[1]); o.y = pk2(v[2], v[3]); o.z = pk2(v[4], v[5]); o.w = pk2(v[6], v[7]);
            *(uint4*)(p.LA + (size_t)m * 416 + c0 - 768) = o;
        }
    }
}
__device__ __forceinline__ void g_streams_s2(const Params& p, int l, char* lds) {
    const int tid_ = opq_tid(), bid_ = opq_bid(); (void)tid_; (void)bid_;
    constexpr int MT = T / 128;
    for (int job = bid_; job < 5 * MT * 2; job += gridDim.x) {
        const int type = job / (MT * 2), r = job % (MT * 2), tm = r >> 1, tn = r & 1;
        const int coff = type < 2 ? type * 64 : type < 4 ? 128 + (type - 2) * 64 : 256, K = type < 4 ? 64 : 160, d = type & 1;
        const bf16_t* Bt = type < 2 ? p.wupT + type * 256 * 64 : type < 4 ? p.aupT + (type - 2) * 256 * 64 : p.gupT;
        const bf16_t* a0 = p.LA + (size_t)(tm * 128 + STG_ROW(0)) * 416 + coff + STG_K; const bf16_t* a1 = p.LA + (size_t)(tm * 128 + STG_ROW(1)) * 416 + coff + STG_K;
        const bf16_t* b0 = Bt + (size_t)(tn * 128 + STG_ROW(0)) * K + STG_K; const bf16_t* b1 = Bt + (size_t)(tn * 128 + STG_ROW(1)) * K + STG_K;
        if (type < 2) gemm_tile(a0, a1, b0, b1, K, lds, [&](const f32x4 (&acc)[4][4], int wr, int wc, int fr, int fq) {
#pragma unroll
            for (int mi = 0; mi < 4; ++mi) {
#pragma unroll
                for (int n = 0; n < 4; ++n) { const int c = tn * 128 + wc * 64 + n * 16 + fr; const float w0 = p.a_w0[(l * 2 + d) * DA + c];
#pragma unroll
                    for (int j = 0; j < 4; ++j) { const int row = tm * 128 + wr * 64 + mi * 16 + fq * 4 + j;
                        const float e = __expf(-(w0 + acc[mi][n][j]));
                        p.sW[((size_t)d * T + row) * DA + c] = __expf(-0.60653065971f / (1.0f + e)); } }
                asm volatile("" ::: "memory"); }
        });
        else if (type < 4) gemm_tile(a0, a1, b0, b1, K, lds, [&](const f32x4 (&acc)[4][4], int wr, int wc, int fr, int fq) {
#pragma unroll
            for (int mi = 0; mi < 4; ++mi) {
#pragma unroll
                for (int n = 0; n < 4; ++n) { const int c = tn * 128 + wc * 64 + n * 16 + fr;
                    const float a0v = p.a_a0[(l * 2 + d) * DA + c], kkc = p.a_k_k[l * DA + c], kac = p.a_k_a[l * DA + c];
#pragma unroll
                    for (int j = 0; j < 4; ++j) { const int row = tm * 128 + wr * 64 + mi * 16 + fq * 4 + j;
                        const size_t o = (size_t)row * DA + c, od = ((size_t)d * T + row) * DA + c;
                        const float av = 1.0f / (1.0f + __expf(-(a0v + acc[mi][n][j]))); const float k = p.kT[o];
                        const float kk = k * kkc * p.kN[(size_t)row * 4 + (c >> 6)];
                        p.sKD[od] = k * (1.0f + (av - 1.0f) * kac); p.sB[od] = kk * av; if (d == 0) p.sKK[o] = kk; } }
                asm volatile("" ::: "memory"); }
        });
        else gemm_tile(a0, a1, b0, b1, K, lds, [&](const f32x4 (&acc)[4][4], int wr, int wc, int fr, int fq) {
#pragma unroll
            for (int mi = 0; mi < 4; ++mi)
#pragma unroll
                for (int n = 0; n < 4; ++n) { const int c = tn * 128 + wc * 64 + n * 16 + fr;
#pragma unroll
                    for (int j = 0; j < 4; ++j) p.sG[(size_t)(tm * 128 + wr * 64 + mi * 16 + fq * 4 + j) * DA + c] = acc[mi][n][j]; }
        });
    }
}


typedef float f32x16 __attribute__((ext_vector_type(16)));
typedef short s16x4 __attribute__((ext_vector_type(4)));
typedef unsigned u32x4_t __attribute__((ext_vector_type(4)));
typedef float f32x2_t __attribute__((ext_vector_type(2)));
typedef __bf16 bf16x2_t __attribute__((ext_vector_type(2)));
__device__ __forceinline__ unsigned cvtpk(float lo, float hi) { f32x2_t v = {lo, hi}; bf16x2_t b = __builtin_convertvector(v, bf16x2_t); return __builtin_bit_cast(unsigned, b); }
__device__ __forceinline__ int crow(int r, int hi) { return (r & 3) + 8 * (r >> 2) + 4 * hi; }
__device__ __forceinline__ float xmax32(float v) { float a = v, b = v; asm volatile("s_nop 1\n\tv_permlane32_swap_b32 %0, %1" : "+v"(a), "+v"(b)); return fmaxf(a, b); }
__device__ __forceinline__ float xsum32(float v) { float a = v, b = v; asm volatile("s_nop 1\n\tv_permlane32_swap_b32 %0, %1" : "+v"(a), "+v"(b)); return a + b; }

template <class MaskF>
__device__ __forceinline__ void attn_tile(const bf16x8 (&qf)[4], const bf16_t* krow, const bf16_t* vt0, const bf16_t* vt1, const MaskF& mask,
                                          float& m_run, float& l_run, f32x16& o0, f32x16& o1, int hi) {
    f32x16 s;
#pragma unroll
    for (int r = 0; r < 16; ++r) s[r] = 0.f;
#pragma unroll
    for (int ks = 0; ks < 4; ++ks) { const bf16x8 kf = *(const bf16x8*)(krow + 16 * ks); s = __builtin_amdgcn_mfma_f32_32x32x16_bf16(kf, qf[ks], s, 0, 0, 0); }
    float mx = -INFINITY;
#pragma unroll
    for (int r = 0; r < 16; ++r) { s[r] = mask(crow(r, hi), s[r] * ATT_SCALE); mx = fmaxf(mx, s[r]); }
    mx = xmax32(mx);
    const float mn = fmaxf(m_run, mx), alpha = __expf(m_run - mn);
    m_run = mn;
    float ps = 0.f;
#pragma unroll
    for (int r = 0; r < 16; ++r) { s[r] = __expf(s[r] - mn); ps += s[r]; }
    l_run = l_run * alpha + ps;
#pragma unroll
    for (int r = 0; r < 16; ++r) { o0[r] *= alpha; o1[r] *= alpha; }
#pragma unroll
    for (int s2 = 0; s2 < 2; ++s2) {
        u32x4_t pw; pw[0] = cvtpk(s[8 * s2], s[8 * s2 + 1]); pw[1] = cvtpk(s[8 * s2 + 2], s[8 * s2 + 3]); pw[2] = cvtpk(s[8 * s2 + 4], s[8 * s2 + 5]); pw[3] = cvtpk(s[8 * s2 + 6], s[8 * s2 + 7]);
        const bf16x8 pb = __builtin_bit_cast(bf16x8, pw);
        const s16x4 a0 = *(const s16x4*)(vt0 + 16 * s2), a1 = *(const s16x4*)(vt0 + 16 * s2 + 8);
        const s16x4 c0 = *(const s16x4*)(vt1 + 16 * s2), c1 = *(const s16x4*)(vt1 + 16 * s2 + 8);
        o0 = __builtin_amdgcn_mfma_f32_32x32x16_bf16(__builtin_shufflevector(a0, a1, 0, 1, 2, 3, 4, 5, 6, 7), pb, o0, 0, 0, 0);
        o1 = __builtin_amdgcn_mfma_f32_32x32x16_bf16(__builtin_shufflevector(c0, c1, 0, 1, 2, 3, 4, 5, 6, 7), pb, o1, 0, 0, 0);
    }
}
struct NoMask { __device__ __forceinline__ float operator()(int, float v) const { return v; } };

__device__ __forceinline__ void ph_attn_mfma(const Params& p, int l, bool with_ctx) {
    const int tid_ = opq_tid(), bid_ = opq_bid(); (void)tid_; (void)bid_;
    const int lane = tid_ & 63, hi = lane >> 5, ql = lane & 31;
    const int gw = bid_ * 4 + (tid_ >> 6), nw = gridDim.x * 4;
    constexpr int NQT = S / 32, NCT = L / 32, N_LAT = NB * 6 * NQT, N_CTX = NB * 6 * NCT;
    const int ntask = 2 * N_LAT + (with_ctx ? 2 * N_CTX : 0);
    for (int task = gw; task < ntask; task += nw) {
        bool isC, isCtx; int r;
        if (task < N_LAT) { isC = true; isCtx = false; r = task; }
        else if (task < 2 * N_LAT) { isC = false; isCtx = false; r = task - N_LAT; }
        else { r = task - 2 * N_LAT; isCtx = true; isC = r >= N_CTX; if (isC) r -= N_CTX; }
        const int nqt = isCtx ? NCT : NQT, qt = r % nqt, h = (r / nqt) % 6, b = r / (nqt * 6);
        const int m = isCtx ? TL + b * L + 32 * qt + ql : b * S + 32 * qt + ql;
        const int qcol = isC ? ZQN + h * 64 : ZQB + h * 64, kcol = isC ? ZKN + h * 64 : ZKB + (h / 3) * 64, hv = isC ? 2 + h : h / 3;
        bf16x8 qf[4];
        { const bf16_t* qp = p.Z + (size_t)m * ZP + qcol + 8 * hi;
#pragma unroll
          for (int ks = 0; ks < 4; ++ks) qf[ks] = *(const bf16x8*)(qp + 16 * ks); }
        const bf16_t* kc0 = p.Z + (size_t)(TL + b * L + ql) * ZP + kcol + 8 * hi;
        const bf16_t* kl0 = p.Z + (size_t)(b * S + ql) * ZP + kcol + 8 * hi;
        const bf16_t* vt0 = p.VT + ((size_t)(b * 8 + hv) * 64 + ql) * PU + 4 * hi; const bf16_t* vt1 = vt0 + (size_t)32 * PU;
        f32x16 o0, o1;
#pragma unroll
        for (int rr = 0; rr < 16; ++rr) { o0[rr] = 0.f; o1[rr] = 0.f; }
        float m_run, l_run;
        if (isC) { m_run = -1e30f; l_run = 0.f; } else { m_run = p.b_sink[l * 6 + h]; l_run = hi == 0 ? 1.0f : 0.f; }
#pragma unroll 1
        for (int i = 0; i < NCT; ++i) attn_tile(qf, kc0 + (size_t)(32 * i) * ZP, vt0 + 32 * i, vt1 + 32 * i, NoMask(), m_run, l_run, o0, o1, hi);
        if (!isCtx) {
            if (!isC) {
#pragma unroll 1
                for (int jt = qt - 4; jt <= qt + 4; ++jt) {
                    if (jt < 0 || jt >= NQT) continue;
                    const bf16_t* kr = kl0 + (size_t)(32 * jt) * ZP; const bf16_t* v0 = vt0 + L + 32 * jt; const bf16_t* v1 = vt1 + L + 32 * jt;
                    if (jt == qt - 4 || jt == qt + 4) { const int base = 32 * (jt - qt) - ql;
                        attn_tile(qf, kr, v0, v1, [&](int ko, float v) { const int rel = base + ko; return (rel >= -128 && rel <= 128) ? v : -INFINITY; }, m_run, l_run, o0, o1, hi); }
                    else attn_tile(qf, kr, v0, v1, NoMask(), m_run, l_run, o0, o1, hi);
                }
            } else {
                constexpr int ROWS = S / GRID_W;
                const int gr = qt >> 1, c = 32 * (qt & 1) + ql;
                int r0 = gr - 4; r0 = r0 < 0 ? 0 : (r0 > ROWS - 8 ? ROWS - 8 : r0);
                int c0 = c - 8; c0 = c0 < 0 ? 0 : (c0 > GRID_W - 16 ? GRID_W - 16 : c0);
                const float* rpb = p.c_rpb + ((size_t)l * 6 + h) * 15 * 31;
#pragma unroll 1
                for (int a = 0; a < 8; ++a) {
                    const int kr_ = r0 + a; const float* rp = rpb + (kr_ - gr + 7) * 31 + 15 - c;
#pragma unroll 1
                    for (int ct = 0; ct < 2; ++ct) {
                        const int t0 = kr_ * GRID_W + 32 * ct;
                        attn_tile(qf, kl0 + (size_t)t0 * ZP, vt0 + L + t0, vt1 + L + t0,
                                  [&](int ko, float v) { const int kc = 32 * ct + ko; return (kc >= c0 && kc < c0 + 16) ? v + rp[kc] : -INFINITY; }, m_run, l_run, o0, o1, hi);
                    }
                }
            }
        }
        const float lt = xsum32(l_run), inv = 1.0f / lt;
        bf16_t* op = p.MIX + (size_t)m * DMIX + (isC ? 640 : 256) + h * 64 + 4 * hi;
#pragma unroll
        for (int g = 0; g < 4; ++g) {
            st_bf16x4(op + 8 * g, (f32x4){o0[4 * g] * inv, o0[4 * g + 1] * inv, o0[4 * g + 2] * inv, o0[4 * g + 3] * inv});
            st_bf16x4(op + 32 + 8 * g, (f32x4){o1[4 * g] * inv, o1[4 * g + 1] * inv, o1[4 * g + 2] * inv, o1[4 * g + 3] * inv});
        }
    }
}


template <class MaskF>
__device__ __forceinline__ void attn_tile_lds(const bf16x8 (&qf)[4], const char* ks, const char* vs, const MaskF& mask, float& m_run, float& l_run, f32x16& o0, f32x16& o1, int ql, int hi) {
    f32x16 s;
#pragma unroll
    for (int r = 0; r < 16; ++r) s[r] = 0.f;
#pragma unroll
    for (int k4 = 0; k4 < 4; ++k4) { const bf16x8 kf = *(const bf16x8*)(ks + ql * 128 + (((2 * k4 + hi) ^ (ql & 7)) * 16)); s = __builtin_amdgcn_mfma_f32_32x32x16_bf16(kf, qf[k4], s, 0, 0, 0); }
    float mx = -INFINITY;
#pragma unroll
    for (int r = 0; r < 16; ++r) { s[r] = mask(crow(r, hi), s[r] * ATT_SCALE); mx = fmaxf(mx, s[r]); }
    mx = xmax32(mx);
    const float mn = fmaxf(m_run, mx), alpha = __expf(m_run - mn);
    m_run = mn;
    float ps = 0.f;
#pragma unroll
    for (int r = 0; r < 16; ++r) { s[r] = __expf(s[r] - mn); ps += s[r]; }
    l_run = l_run * alpha + ps;
#pragma unroll
    for (int r = 0; r < 16; ++r) { o0[r] *= alpha; o1[r] *= alpha; }
    const int sw0 = (ql >> 2) & 3;
#pragma unroll
    for (int s2 = 0; s2 < 2; ++s2) {
        u32x4_t pw; pw[0] = cvtpk(s[8 * s2], s[8 * s2 + 1]); pw[1] = cvtpk(s[8 * s2 + 2], s[8 * s2 + 3]); pw[2] = cvtpk(s[8 * s2 + 4], s[8 * s2 + 5]); pw[3] = cvtpk(s[8 * s2 + 6], s[8 * s2 + 7]);
        const bf16x8 pb = __builtin_bit_cast(bf16x8, pw);
        const char* v0 = vs + ql * 64 + 8 * hi; const char* v1 = v0 + 32 * 64;
        const s16x4 a0 = *(const s16x4*)(v0 + (((2 * s2) ^ sw0) * 16)), a1 = *(const s16x4*)(v0 + (((2 * s2 + 1) ^ sw0) * 16));
        const s16x4 c0 = *(const s16x4*)(v1 + (((2 * s2) ^ sw0) * 16)), c1 = *(const s16x4*)(v1 + (((2 * s2 + 1) ^ sw0) * 16));
        o0 = __builtin_amdgcn_mfma_f32_32x32x16_bf16(__builtin_shufflevector(a0, a1, 0, 1, 2, 3, 4, 5, 6, 7), pb, o0, 0, 0, 0);
        o1 = __builtin_amdgcn_mfma_f32_32x32x16_bf16(__builtin_shufflevector(c0, c1, 0, 1, 2, 3, 4, 5, 6, 7), pb, o1, 0, 0, 0);
    }
}

__device__ __forceinline__ void ph_attn_blk(const Params& p, int l, bool with_ctx, int first_blk, char* lds) {
    const int tid_ = opq_tid(), bid_ = opq_bid(); (void)tid_; (void)bid_;
    if (bid_ < first_blk) return;
    const int lane = tid_ & 63, hi = lane >> 5, ql = lane & 31, wid = tid_ >> 6;
    constexpr int NQG = S / 128, NCG = L / 128, ROWS = S / GRID_W, N_LAT = NB * 6 * NQG, N_CTX = NB * 6 * NCG, TPB = (S + L) / 32;
    const int ntask = 2 * N_LAT + (with_ctx ? 2 * N_CTX : 0);
    const int krow = tid_ >> 3, kch = (tid_ & 7) ^ (krow & 7), vrow = tid_ >> 2, vpc = (tid_ & 3) ^ ((vrow >> 2) & 3);
    for (int task = bid_ - first_blk; task < ntask; task += gridDim.x - first_blk) {
        bool isC, isCtx; int r;
        if (task < N_LAT) { isC = true; isCtx = false; r = task; }
        else if (task < 2 * N_LAT) { isC = false; isCtx = false; r = task - N_LAT; }
        else { r = task - 2 * N_LAT; isCtx = true; isC = r >= N_CTX; if (isC) r -= N_CTX; }
        const int ng = isCtx ? NCG : NQG, g = r % ng, h = (r / ng) % 6, b = r / (ng * 6);
        const int qt = 4 * g + wid;
        const int m = isCtx ? TL + b * L + 32 * qt + ql : b * S + 32 * qt + ql;
        const int qcol = isC ? ZQN + h * 64 : ZQB + h * 64, kcol = isC ? ZKN + h * 64 : ZKB + (h / 3) * 64, hv = isC ? 2 + h : h / 3;
        bf16x8 qf[4];
        { const bf16_t* qp = p.Z + (size_t)m * ZP + qcol + 8 * hi;
#pragma unroll
          for (int k4 = 0; k4 < 4; ++k4) qf[k4] = *(const bf16x8*)(qp + 16 * k4); }
        int lo = 0, hi_t = 0, gr0 = 0;
        if (!isCtx) {
            if (!isC) { lo = 4 * g - 4; hi_t = 4 * g + 8; lo = lo < 0 ? 0 : lo; hi_t = hi_t > S / 32 ? S / 32 : hi_t; }
            else { const int ra = 2 * g, rb = 2 * g + 1; int r0a = ra - 4; r0a = r0a < 0 ? 0 : (r0a > ROWS - 8 ? ROWS - 8 : r0a); int r0b = rb - 4; r0b = r0b < 0 ? 0 : (r0b > ROWS - 8 ? ROWS - 8 : r0b);
                   lo = 2 * r0a; hi_t = 2 * (r0b + 8); gr0 = 0; }
        }
        const int ntile = L / 32 + (hi_t - lo);
        const bf16_t* kbase = p.Z + (size_t)krow * ZP + kcol + 8 * kch;
        const bf16_t* vbase = p.VT + ((size_t)(b * 8 + hv) * 64 + vrow) * PU + 8 * vpc;
#define AT_TOK(i_) ((i_) < L / 32 ? 32 * (i_) : L + 32 * (lo + (i_) - L / 32))
#define AT_STAGE(i_) do { const int u0_ = AT_TOK(i_); const int zrow_ = u0_ < L ? TL + b * L + u0_ : b * S + (u0_ - L); char* sl_ = lds + ((i_) % 3) * 8192 + tid_ * 16; \
            __builtin_amdgcn_global_load_lds((const unsigned*)(kbase + (size_t)zrow_ * ZP), (__attribute__((address_space(3))) unsigned*)(sl_), 16, 0, 0); \
            __builtin_amdgcn_global_load_lds((const unsigned*)(vbase + u0_), (__attribute__((address_space(3))) unsigned*)(sl_ + 4096), 16, 0, 0); } while (0)
        f32x16 o0, o1;
#pragma unroll
        for (int rr = 0; rr < 16; ++rr) { o0[rr] = 0.f; o1[rr] = 0.f; }
        float m_run, l_run;
        if (isC) { m_run = -1e30f; l_run = 0.f; } else { m_run = p.b_sink[l * 6 + h]; l_run = hi == 0 ? 1.0f : 0.f; }
        const int gr = qt >> 1, c = 32 * (qt & 1) + ql;
        int r0 = gr - 4; r0 = r0 < 0 ? 0 : (r0 > ROWS - 8 ? ROWS - 8 : r0);
        int c0 = c - 8; c0 = c0 < 0 ? 0 : (c0 > GRID_W - 16 ? GRID_W - 16 : c0);
        float* rpb = (float*)(lds + 24576);
        if (isC && !isCtx) for (int i = tid_; i < 15 * 31; i += 256) rpb[i] = p.c_rpb[((size_t)l * 6 + h) * 15 * 31 + i];
        AT_STAGE(0);
        if (ntile > 1) AT_STAGE(1);
#pragma unroll 1
        for (int i = 0; i < ntile; ++i) {
            if (i + 1 < ntile) asm volatile("s_waitcnt vmcnt(2)" ::: "memory"); else asm volatile("s_waitcnt vmcnt(0)" ::: "memory");
            asm volatile("s_waitcnt lgkmcnt(0)" ::: "memory");
            __builtin_amdgcn_s_barrier();
            if (i + 2 < ntile) AT_STAGE(i + 2);
            const char* ks = lds + (i % 3) * 8192; const char* vs = ks + 4096;
            if (i < L / 32) attn_tile_lds(qf, ks, vs, NoMask(), m_run, l_run, o0, o1, ql, hi);
            else {
                const int jt = lo + i - L / 32;
                if (!isC) {
                    const int dq = jt - qt;
                    if (dq >= -3 && dq <= 3) attn_tile_lds(qf, ks, vs, NoMask(), m_run, l_run, o0, o1, ql, hi);
                    else if (dq == -4 || dq == 4) { const int base = 32 * dq - ql;
                        attn_tile_lds(qf, ks, vs, [&](int ko, float v) { const int rel = base + ko; return (rel >= -128 && rel <= 128) ? v : -INFINITY; }, m_run, l_run, o0, o1, ql, hi); }
                } else {
                    const int kr_ = jt >> 1, ct = jt & 1;
                    if (kr_ >= r0 && kr_ < r0 + 8) { const float* rp = rpb + (kr_ - gr + 7) * 31 + 15 - c;
                        attn_tile_lds(qf, ks, vs, [&](int ko, float v) { const int kc = 32 * ct + ko; return (kc >= c0 && kc < c0 + 16) ? v + rp[kc] : -INFINITY; }, m_run, l_run, o0, o1, ql, hi); }
                }
            }
        }
        asm volatile("s_waitcnt lgkmcnt(0)" ::: "memory");
        __builtin_amdgcn_s_barrier();
#undef AT_STAGE
#undef AT_TOK
        (void)gr0;
        const float lt = xsum32(l_run), inv = 1.0f / lt;
        bf16_t* op = p.MIX + (size_t)m * DMIX + (isC ? 640 : 256) + h * 64 + 4 * hi;
#pragma unroll
        for (int gq = 0; gq < 4; ++gq) {
            st_bf16x4(op + 8 * gq, (f32x4){o0[4 * gq] * inv, o0[4 * gq + 1] * inv, o0[4 * gq + 2] * inv, o0[4 * gq + 3] * inv});
            st_bf16x4(op + 32 + 8 * gq, (f32x4){o1[4 * gq] * inv, o1[4 * gq + 1] * inv, o1[4 * gq + 2] * inv, o1[4 * gq + 3] * inv});
        }
    }
}

#define RNB " row_newbcast:%c[n] row_mask:0xf bank_mask:0xf\n\t"
template <int N, bool FIRST>
__device__ __forceinline__ void dpp_dot4(float& a0, float& a1, float& a2, float& a3, const f32x4& v, float s0, float s1, float s2, float s3) {
    if (FIRST) asm volatile("s_nop 1");
    asm("v_fmac_f32_dpp %0, %4, %8" RNB "v_fmac_f32_dpp %1, %5, %9" RNB "v_fmac_f32_dpp %2, %6, %10" RNB "v_fmac_f32_dpp %3, %7, %11" RNB
        : "+v"(a0), "+v"(a1), "+v"(a2), "+v"(a3) : "v"(v[0]), "v"(v[1]), "v"(v[2]), "v"(v[3]), "v"(s0), "v"(s1), "v"(s2), "v"(s3), [n] "i"(N));
}
template <int N, bool FIRST>
__device__ __forceinline__ void dpp_upd4s(float& s0, float& s1, float& s2, float& s3, float& y0, float& y1, float& y2, float& y3,
                                          const f32x4& w, const f32x4& b, const f32x4& kd, const f32x4& r, float nsk, float vv) {
    if (FIRST) asm volatile("s_nop 1");
    asm("v_mul_f32_dpp %0, %8, %0" RNB "v_mul_f32_dpp %1, %9, %1" RNB "v_mul_f32_dpp %2, %10, %2" RNB "v_mul_f32_dpp %3, %11, %3" RNB
        "v_fmac_f32_dpp %0, %12, %24" RNB "v_fmac_f32_dpp %1, %13, %24" RNB "v_fmac_f32_dpp %2, %14, %24" RNB "v_fmac_f32_dpp %3, %15, %24" RNB
        "v_fmac_f32_dpp %0, %16, %25" RNB "v_fmac_f32_dpp %1, %17, %25" RNB "v_fmac_f32_dpp %2, %18, %25" RNB "v_fmac_f32_dpp %3, %19, %25" RNB
        "v_fmac_f32_dpp %4, %20, %0" RNB "v_fmac_f32_dpp %5, %21, %1" RNB "v_fmac_f32_dpp %6, %22, %2" RNB "v_fmac_f32_dpp %7, %23, %3" RNB
        : "+v"(s0), "+v"(s1), "+v"(s2), "+v"(s3), "+v"(y0), "+v"(y1), "+v"(y2), "+v"(y3)
        : "v"(w[0]), "v"(w[1]), "v"(w[2]), "v"(w[3]), "v"(b[0]), "v"(b[1]), "v"(b[2]), "v"(b[3]), "v"(kd[0]), "v"(kd[1]), "v"(kd[2]), "v"(kd[3]),
          "v"(r[0]), "v"(r[1]), "v"(r[2]), "v"(r[3]), "v"(nsk), "v"(vv), [n] "i"(N));
}
template <int N, bool FIRST>
__device__ __forceinline__ void dpp_upd4p(float& s0, float& s1, float& s2, float& s3, float& y0, float& y1, float& y2, float& y3,
                                          const f32x4& w, const f32x4& b, const f32x4& r, float nsk) {
    if (FIRST) asm volatile("s_nop 1");
    asm("v_mul_f32_dpp %0, %8, %0" RNB "v_mul_f32_dpp %1, %9, %1" RNB "v_mul_f32_dpp %2, %10, %2" RNB "v_mul_f32_dpp %3, %11, %3" RNB
        "v_fmac_f32_dpp %0, %12, %20" RNB "v_fmac_f32_dpp %1, %13, %20" RNB "v_fmac_f32_dpp %2, %14, %20" RNB "v_fmac_f32_dpp %3, %15, %20" RNB
        "v_fmac_f32_dpp %4, %16, %0" RNB "v_fmac_f32_dpp %5, %17, %1" RNB "v_fmac_f32_dpp %6, %18, %2" RNB "v_fmac_f32_dpp %7, %19, %3" RNB
        : "+v"(s0), "+v"(s1), "+v"(s2), "+v"(s3), "+v"(y0), "+v"(y1), "+v"(y2), "+v"(y3)
        : "v"(w[0]), "v"(w[1]), "v"(w[2]), "v"(w[3]), "v"(b[0]), "v"(b[1]), "v"(b[2]), "v"(b[3]), "v"(r[0]), "v"(r[1]), "v"(r[2]), "v"(r[3]), "v"(nsk), [n] "i"(N));
}
template <int N, bool FIRST>
__device__ __forceinline__ void dpp_mul4(float& s0, float& s1, float& s2, float& s3, const f32x4& v) {
    if (FIRST) asm volatile("s_nop 1");
    asm("v_mul_f32_dpp %0, %4, %0" RNB "v_mul_f32_dpp %1, %5, %1" RNB "v_mul_f32_dpp %2, %6, %2" RNB "v_mul_f32_dpp %3, %7, %3" RNB
        : "+v"(s0), "+v"(s1), "+v"(s2), "+v"(s3) : "v"(v[0]), "v"(v[1]), "v"(v[2]), "v"(v[3]), [n] "i"(N));
}
template <int N>
__device__ __forceinline__ void dpp_fmacx4(float& s0, float& s1, float& s2, float& s3, const f32x4& v, float x) {
    asm("v_fmac_f32_dpp %0, %4, %8" RNB "v_fmac_f32_dpp %1, %5, %8" RNB "v_fmac_f32_dpp %2, %6, %8" RNB "v_fmac_f32_dpp %3, %7, %8" RNB
        : "+v"(s0), "+v"(s1), "+v"(s2), "+v"(s3) : "v"(v[0]), "v"(v[1]), "v"(v[2]), "v"(v[3]), "v"(x), [n] "i"(N));
}
template <int N> struct ScanRep {
    static __device__ __forceinline__ void dot8(float (&a)[8], const f32x4& v, const float (&st)[64]) {
        constexpr int h = (N & 1) * 4;
        dpp_dot4<N, N == 0>(a[h], a[h + 1], a[h + 2], a[h + 3], v, st[4 * N], st[4 * N + 1], st[4 * N + 2], st[4 * N + 3]);
        if constexpr (N < 15) ScanRep<N + 1>::dot8(a, v, st);
    }
    static __device__ __forceinline__ void dot(float& a0, float& a1, float& a2, float& a3, const f32x4& v, const float (&st)[64]) {
        dpp_dot4<N, N == 0>(a0, a1, a2, a3, v, st[4 * N], st[4 * N + 1], st[4 * N + 2], st[4 * N + 3]);
        if constexpr (N < 15) ScanRep<N + 1>::dot(a0, a1, a2, a3, v, st);
    }
    static __device__ __forceinline__ void mul(float (&st)[64], const f32x4& w) {
        dpp_mul4<N, N == 0>(st[4 * N], st[4 * N + 1], st[4 * N + 2], st[4 * N + 3], w);
        if constexpr (N < 15) ScanRep<N + 1>::mul(st, w);
    }
    static __device__ __forceinline__ void fmacx(float (&st)[64], const f32x4& v, float x) {
        dpp_fmacx4<N>(st[4 * N], st[4 * N + 1], st[4 * N + 2], st[4 * N + 3], v, x);
        if constexpr (N < 15) ScanRep<N + 1>::fmacx(st, v, x);
    }
};
__device__ __forceinline__ int seg_row0(int b, int d, int s) { const int pos0 = 128 * s; return pos0 < L ? TL + b * L + (d ? L - 1 - pos0 : pos0) : b * S + (d ? S - 1 - (pos0 - L) : pos0 - L); }

template <bool ISP>
__device__ __forceinline__ void scan_task(const Params& p, int c, int s, int lane) {
    const int h = c & 3, b = (c >> 2) % NB, d = (c >> 2) / NB;
    const int m0 = seg_row0(b, d, s); const long step = d ? -(long)DA : (long)DA;
    const size_t o = (size_t)m0 * DA + h * 64, od = ((size_t)d * T + m0) * DA + h * 64; const int q = 4 * (lane & 15);
    const float* pkk = p.sKK + o + q; const float* pr = p.sR + o + q; const float* pw = p.sW + od + q; const float* pb = p.sB + od + q;
    const float* pkd = p.sKD + od + q; const float* pv = p.sV + o + lane;
    float* py = (ISP ? p.PV : p.Y) + od + lane;
    float st[64];
#pragma unroll
    for (int k = 0; k < 64; ++k) st[k] = (ISP && k == lane) ? 1.0f : 0.f;
    const float* pfp; { const int arr = lane >> 1; const float* bs = arr == 0 ? p.sKK + o : arr == 1 ? p.sW + od : arr == 2 ? p.sB + od : arr == 3 ? p.sR + o : arr == 4 ? p.sKD + od : p.sV + o;
        pfp = (lane < 12 ? bs + 32 * (lane & 1) : p.sKK + o) + 8 * step; }
    float pfd = 0.f;
    f32x4 kk = *(const f32x4*)pkk, w = *(const f32x4*)pw, bb = *(const f32x4*)pb, r = *(const f32x4*)pr, kd = w; float vv = 0.f;
    if (!ISP) { kd = *(const f32x4*)pkd; vv = *pv; }
#pragma unroll 1
    for (int i = 0; i < 128; ++i) {
        const long nx = (i < 127) ? step : 0;
        pkk += nx; pw += nx; pb += nx; pr += nx; pkd += nx; pv += nx;
        asm volatile("global_load_dword %0, %1, off" : "+v"(pfd) : "v"(pfp)); if (i < 119) pfp += step;
        const f32x4 nkk = *(const f32x4*)pkk, nw = *(const f32x4*)pw, nb = *(const f32x4*)pb, nr = *(const f32x4*)pr;
        f32x4 nkd = nw; float nv = 0.f;
        if (!ISP) { nkd = *(const f32x4*)pkd; nv = *pv; }
        float a[8] = {0.f, 0.f, 0.f, 0.f, 0.f, 0.f, 0.f, 0.f};
        ScanRep<0>::dot8(a, kk, st);
        const float nsk = -(((a[0] + a[1]) + (a[2] + a[3])) + ((a[4] + a[5]) + (a[6] + a[7])));
        ScanRep<0>::mul(st, w);
        ScanRep<0>::fmacx(st, bb, nsk);
        if (!ISP) ScanRep<0>::fmacx(st, kd, vv);
        float y[8] = {0.f, 0.f, 0.f, 0.f, 0.f, 0.f, 0.f, 0.f};
        ScanRep<0>::dot8(y, r, st);
        *py = ((y[0] + y[1]) + (y[2] + y[3])) + ((y[4] + y[5]) + (y[6] + y[7])); py += step;
        kk = nkk; w = nw; bb = nb; r = nr; kd = nkd; vv = nv;
    }
    asm volatile("s_waitcnt vmcnt(0)" : "+v"(pfd));
    if (s < NSG - 1) {
        float* dst = (ISP ? p.PS : p.QS) + (((size_t)c * NSG + s) * 64 + lane) * 64;
#pragma unroll
        for (int k4 = 0; k4 < 16; ++k4) *(f32x4*)(dst + 4 * k4) = (f32x4){st[4 * k4], st[4 * k4 + 1], st[4 * k4 + 2], st[4 * k4 + 3]};
    }
}
__device__ __forceinline__ void ph_scan_fast(const Params& p) {
    const int tid_ = opq_tid(), bid_ = opq_bid(); (void)tid_; (void)bid_;
    const int lane = tid_ & 63, gw = bid_ * 4 + (tid_ >> 6), nw = gridDim.x * 4;
    constexpr int NS_T = 64 * NSG, NP_T = 64 * (NSG - 1);
    const int G = gridDim.x, wv = tid_ >> 6; (void)gw; (void)nw;
    for (int tsk = wv * G + bid_; tsk < NS_T + NP_T; tsk += 4 * G) {
        const int t2 = __builtin_amdgcn_readfirstlane(tsk);
        if (t2 < NS_T) scan_task<false>(p, t2 & 63, t2 >> 6, lane);
        else scan_task<true>(p, (t2 - NS_T) & 63, 1 + ((t2 - NS_T) >> 6), lane);
    }
}
__device__ __forceinline__ void ph_combine(const Params& p, char* lds) {
    const int tid_ = opq_tid(), bid_ = opq_bid(); (void)tid_; (void)bid_; (void)lds;
    if (bid_ >= 64) return;
    const int lane = tid_ & 63, c = bid_, cb = tid_ >> 6, q = lane >> 4, i16 = lane & 15, v = 16 * cb + i16;
    const float* QSc = p.QS + (size_t)c * NSG * 4096; const float* PSc = p.PS + (size_t)c * NSG * 4096; float* SSg = p.SS + (size_t)c * NSG * 4096;
    f32x4 acc[4];
#pragma unroll
    for (int ro = 0; ro < 4; ++ro) acc[ro] = *(const f32x4*)(QSc + v * 64 + 16 * ro + 4 * q);
#pragma unroll 1
    for (int s = 1; s < NSG; ++s) {
#pragma unroll
        for (int ro = 0; ro < 4; ++ro)
#pragma unroll
            for (int j = 0; j < 4; ++j) SSg[(size_t)s * 4096 + (16 * ro + 4 * q + j) * 64 + v] = acc[ro][j];
        if (s == NSG - 1) break;
        const float* P = PSc + (size_t)s * 4096 + (4 * q) * 64 + i16;
        float a[4][4][4];
#pragma unroll
        for (int rb = 0; rb < 4; ++rb)
#pragma unroll
            for (int kk = 0; kk < 4; ++kk)
#pragma unroll
                for (int ro = 0; ro < 4; ++ro) a[rb][kk][ro] = P[(16 * rb + kk) * 64 + 16 * ro];
#pragma unroll
        for (int rb = 0; rb < 4; ++rb) asm volatile("" : "+v"(a[rb][0][0]), "+v"(a[rb][0][1]), "+v"(a[rb][0][2]), "+v"(a[rb][0][3]), "+v"(a[rb][1][0]), "+v"(a[rb][1][1]), "+v"(a[rb][1][2]), "+v"(a[rb][1][3]),
                                                         "+v"(a[rb][2][0]), "+v"(a[rb][2][1]), "+v"(a[rb][2][2]), "+v"(a[rb][2][3]), "+v"(a[rb][3][0]), "+v"(a[rb][3][1]), "+v"(a[rb][3][2]), "+v"(a[rb][3][3]));
        f32x4 nacc[4];
#pragma unroll
        for (int ro = 0; ro < 4; ++ro) nacc[ro] = *(const f32x4*)(QSc + (size_t)s * 4096 + v * 64 + 16 * ro + 4 * q);
#pragma unroll
        for (int rb = 0; rb < 4; ++rb)
#pragma unroll
            for (int kk = 0; kk < 4; ++kk)
#pragma unroll
                for (int ro = 0; ro < 4; ++ro) nacc[ro] = __builtin_amdgcn_mfma_f32_16x16x4f32(a[rb][kk][ro], acc[rb][kk], nacc[ro], 0, 0, 0);
#pragma unroll
        for (int ro = 0; ro < 4; ++ro) acc[ro] = nacc[ro];
    }
}
__device__ __forceinline__ void ph_rwkv_out_fast(const Params& p, int l, bool with_ctx) {
    const int tid_ = opq_tid(), bid_ = opq_bid(); (void)tid_; (void)bid_;
    const int lane = tid_ & 63, gw = bid_ * 4 + (tid_ >> 6), nw = gridDim.x * 4;
    constexpr int TOK = 16, NLT = NB * (S / TOK) * 4, NCTK = NB * (L / TOK) * 4;
    const int ntask = NLT + (with_ctx ? NCTK : 0);
    for (int tsk = gw; tsk < ntask; tsk += nw) {
        const bool isCtx = tsk >= NLT; const int r = isCtx ? tsk - NLT : tsk;
        const int h = r & 3, npt = isCtx ? L / TOK : S / TOK, tt = (r >> 2) % npt, b = (r >> 2) / npt, t128 = tt / (128 / TOK);
        const int seg0 = isCtx ? t128 : L / 128 + t128, seg1 = isCtx ? (L / 128 - 1) - t128 : L / 128 + (S / 128 - 1) - t128;
        const int mbase = isCtx ? TL + b * L + TOK * tt : b * S + TOK * tt;
        float ss0[64], ss1[64];
        { const float* s0p = p.SS + (((size_t)(0 * NB + b) * 4 + h) * NSG + seg0) * 4096 + lane; const float* s1p = p.SS + (((size_t)(1 * NB + b) * 4 + h) * NSG + seg1) * 4096 + lane;
#pragma unroll
          for (int k = 0; k < 64; ++k) { ss0[k] = seg0 > 0 ? s0p[k * 64] : 0.f; ss1[k] = seg1 > 0 ? s1p[k * 64] : 0.f; } }
        const float rk = p.a_r_k[l * DA + h * 64 + lane], gln = p.a_lnx_g[l * DA + h * 64 + lane], bln = p.a_lnx_b[l * DA + h * 64 + lane];
        f32x4 pv0 = {0.f, 0.f, 0.f, 0.f}, pv1 = pv0; float y0l, y1l, rr, kds, vv, gg;
#define ROUT_LOAD(i_) do { const size_t o_ = (size_t)(mbase + (i_)) * DA + h * 64, o1_ = o_ + (size_t)T * DA; \
            if (seg0 > 0) pv0 = *(const f32x4*)(p.PV + o_ + 4 * (lane & 15)); if (seg1 > 0) pv1 = *(const f32x4*)(p.PV + o1_ + 4 * (lane & 15)); \
            y0l = p.Y[o_ + lane]; y1l = p.Y[o1_ + lane]; rr = p.sR[o_ + lane]; kds = p.sKD[o_ + lane] + p.sKD[o1_ + lane]; vv = p.sV[o_ + lane]; gg = p.sG[o_ + lane]; } while (0)
        ROUT_LOAD(0);
#pragma unroll 1
        for (int i = 0; i < TOK; ++i) {
            const f32x4 cpv0 = pv0, cpv1 = pv1; float a0 = y0l, a1 = y1l, a2 = 0.f, a3 = 0.f; const float crr = rr, ckds = kds, cvv = vv, cgg = gg;
            ROUT_LOAD(i + 1 < TOK ? i + 1 : i);
            ScanRep<0>::dot(a0, a1, a2, a3, cpv0, ss0);
            ScanRep<0>::dot(a0, a1, a2, a3, cpv1, ss1);
            const float y = (a0 + a1) + (a2 + a3);
            const float mu = wave_sum(y) * (1.0f / 64.f), dy = y - mu;
            const float rstd = 1.0f / sqrtf(wave_sum(dy * dy) * (1.0f / 64.f) + GN_EPS);
            const float bon = wave_sum(crr * ckds * rk);
            p.MIX[(size_t)(mbase + i) * DMIX + h * 64 + lane] = f2bf((dy * rstd * gln + bln + bon * cvv) * cgg);
        }
#undef ROUT_LOAD
    }
}


#define LAS __attribute__((address_space(3)))
#define XB_TMO      128
#define XB_XCNT(j)  (256  + 64 * (j))
#define XB_XSUB(j)  (1280 + 64 * (j))
#define XB_XGEN(j)  (2304 + 64 * (j))
#define XB_TOP      3328
#define XB_TOPGEN   3392
#define XCD_BAR_WORDS 3456
#define XB_SPIN_CAP (1u << 20)
static_assert(XCD_BAR_WORDS * 4 <= 16384, "barrier words fit the control region");
__device__ __forceinline__ unsigned xb_ld(unsigned* p)              { return __hip_atomic_load(p, __ATOMIC_RELAXED, __HIP_MEMORY_SCOPE_AGENT); }
__device__ __forceinline__ unsigned xb_add(unsigned* p, unsigned v) { return __hip_atomic_fetch_add(p, v, __ATOMIC_RELAXED, __HIP_MEMORY_SCOPE_AGENT); }
__device__ __forceinline__ unsigned xb_xcc_id() { return (unsigned)__builtin_amdgcn_s_getreg((3 << 11) | 20) & 0xFu; }
#define XB_SPIN(cond, bar) do { unsigned _sp = 0; while (cond) { __builtin_amdgcn_s_sleep(1); \
    if ((++_sp & 255u) == 0u) { if (xb_ld(&(bar)[XB_TMO])) break; if (_sp > XB_SPIN_CAP) { atomicAdd(&(bar)[XB_TMO], 1u); break; } } } } while (0)
struct XcdBarrier { unsigned* bar; unsigned x; volatile LAS unsigned* st; };
__device__ __forceinline__ XcdBarrier xcd_barrier_post(unsigned* bar, volatile LAS unsigned* st) {
    XcdBarrier b; b.bar = bar; b.x = xb_xcc_id(); b.st = st;
    if (threadIdx.x == 0) (void)xb_add(&bar[XB_XCNT(b.x)], 1u);
    return b;
}
__device__ __forceinline__ void xcd_barrier_complete(unsigned* bar, unsigned x, unsigned& nloc, unsigned& nx) {
    const unsigned G = gridDim.x * gridDim.y * gridDim.z;
    unsigned sum, cnt, mine, sp = 0u;
    for (;;) {
        sum = 0u; cnt = 0u; mine = 0u;
#pragma unroll
        for (unsigned j = 0; j < 16; ++j) { const unsigned c = xb_ld(&bar[XB_XCNT(j)]); sum += c; cnt += (c > 0u) ? 1u : 0u; mine = (j == x) ? c : mine; }
        if (sum == G) break;
        __builtin_amdgcn_s_sleep(1);
        if ((++sp & 255u) == 0u) { if (xb_ld(&bar[XB_TMO])) break; if (sp > XB_SPIN_CAP) { atomicAdd(&bar[XB_TMO], 1u); break; } }
    }
    nloc = mine > 0u ? mine : 1u; nx = cnt > 0u ? cnt : 1u;
}
__device__ __forceinline__ void xcd_barrier(const XcdBarrier& b) {
    asm volatile("s_waitcnt vmcnt(0)" ::: "memory");
    __syncthreads();
    if (threadIdx.x == 0) {
        unsigned* bar = b.bar;
        __builtin_amdgcn_s_waitcnt(0);
        unsigned nloc = b.st[0], nx = b.st[1];
        if (nloc == 0u) { xcd_barrier_complete(bar, b.x, nloc, nx); b.st[0] = nloc; b.st[1] = nx; }
        const unsigned old = xb_add(&bar[XB_XSUB(b.x)], 1u);
        const unsigned gen = old / nloc;
        if (old + 1u == (gen + 1u) * nloc) {
            __builtin_amdgcn_fence(__ATOMIC_RELEASE, "agent");
            asm volatile("s_waitcnt vmcnt(0)" ::: "memory");
            const unsigned og = xb_add(&bar[XB_TOP], 1u);
            const unsigned tg = og / nx;
            if (og + 1u == (tg + 1u) * nx) xb_add(&bar[XB_TOPGEN], 1u);
            else XB_SPIN(xb_ld(&bar[XB_TOPGEN]) == tg, bar);
            __builtin_amdgcn_fence(__ATOMIC_ACQUIRE, "agent");
            xb_add(&bar[XB_XGEN(b.x)], 1u);
            asm volatile("s_waitcnt vmcnt(0)" ::: "memory");
        } else {
            XB_SPIN(xb_ld(&bar[XB_XGEN(b.x)]) == gen, bar);
            __builtin_amdgcn_fence(__ATOMIC_ACQUIRE, "agent");
            asm volatile("s_waitcnt vmcnt(0)" ::: "memory");
        }
    }
    __syncthreads();
}

#define GT ((long)blockIdx.x * blockDim.x + threadIdx.x)
#define GS ((long)gridDim.x * blockDim.x)
__global__ void __launch_bounds__(256, 2) mega_fwd(Params p) {
    __shared__ __attribute__((aligned(16))) char lds[65536 + 64];
    cg::grid_group grid = cg::this_grid();
    const long gt = GT, gs = GS;
    volatile LAS unsigned* bst = (volatile LAS unsigned*)(LAS char*)(lds + 65536);
    if (threadIdx.x < 2) bst[threadIdx.x] = 0u;
    __syncthreads();
    const XcdBarrier xb = xcd_barrier_post(p.bar, bst);
#ifndef PROBE_PHASE
#define PROBE_PHASE -1
#endif
#define PROBE_AMP 8
    unsigned long long t_prev = 0; int nts = 0;
#define STAMP() do { if (PROBE_PHASE >= 0 && blockIdx.x == 0 && threadIdx.x == 0) { const unsigned long long t_now = __builtin_amdgcn_s_memrealtime(); \
        if (nts == PROBE_PHASE + 1) { const unsigned long long t_end = t_now + PROBE_AMP * (t_now - t_prev); while (__builtin_amdgcn_s_memrealtime() < t_end) __builtin_amdgcn_s_sleep(8); } \
        t_prev = __builtin_amdgcn_s_memrealtime(); } ++nts; } while (0)
#define GSYNC() do { xcd_barrier(xb); STAMP(); } while (0)
    STAMP();
    ph_mod_fast(p, lds); ph_prep_w_fast(p, 0, 0, lds); ph_prep_misc(p, 0, gt, gs, false);
    grid.sync(); STAMP();
    for (int l = 0; l < 2; ++l) {
        const int nrows = (l == 0) ? T : TL;
        if (l == 0) { ph_lnmod_fast(p, l); GSYNC(); }
        g_gemm_in(p, lds);
        GSYNC();
        ph_streams_s1(p, l);
        GSYNC();
        g_streams_s2(p, l, lds);
        GSYNC();
        ph_scan_fast(p);
        GSYNC();
        ph_combine(p, lds); ph_attn_blk(p, l, l == 0, 64, lds);
        GSYNC();
        ph_rwkv_out_fast(p, l, l == 0);
        GSYNC();
        if (blockIdx.x >= gridDim.x / 2) { ph_prep_w_fast(p, l, 1, lds); __syncthreads(); g_gemm_out(p, nrows, lds); } else { g_gemm_out(p, nrows, lds); ph_prep_w_fast(p, l, 1, lds); }
        GSYNC();
        g_router(p, l, nrows, lds);
        GSYNC();
        ph_dispatch_fast(p, l, nrows, lds);
        GSYNC();
        g_moe1(p, l, lds);
        GSYNC();
        g_moe2(p, l, lds);
        GSYNC();
        ph_final_fast(p, l, nrows, l == 0);
        if (l == 0) { ph_prep_w_fast(p, 1, 0, lds); ph_prep_misc(p, 1, gt, gs, false); }
        GSYNC();
    }}

extern "C" void kernel_launch(void* const* d_in, const int* in_sizes, int n_in, void* d_out, int out_size, void* d_ws, size_t ws_size, hipStream_t stream) {
    if (n_in != 32 || out_size != TL * D || ws_size < WS_NEED) { fprintf(stderr, "kernel_launch: unexpected shapes / workspace (n_in %d out %d ws %zu need %zu)\n", n_in, out_size, ws_size, (size_t)WS_NEED); return; }
    static int grid_blocks = 0;
    if (!grid_blocks) {
        int dev = 0, cus = 0, per_cu = 0;
        (void)hipGetDevice(&dev);
        (void)hipDeviceGetAttribute(&cus, hipDeviceAttributeMultiprocessorCount, dev);
        (void)hipOccupancyMaxActiveBlocksPerMultiprocessor(&per_cu, mega_fwd, 256, 0);
        if (per_cu < 1) per_cu = 1;
        if (per_cu > 2) per_cu = 2;
        grid_blocks = cus * per_cu;
        fprintf(stderr, "kernel_launch: %d CUs x %d blocks\n", cus, per_cu);
    }
    Params p = make_params(d_in, d_out, d_ws);
    (void)hipMemsetAsync(d_ws, 0, CTL_BYTES, stream);
    void* args[] = {&p};
    hipError_t e = hipLaunchCooperativeKernel((void*)mega_fwd, dim3(grid_blocks), dim3(256), args, 0, stream);
    if (e != hipSuccess) fprintf(stderr, "cooperative launch failed: %s (grid %d)\n", hipGetErrorString(e), grid_blocks);
}
#endif

#ifdef HOST_EMU
static void host_forward(void* const* d_in, void* d_out, void* d_ws) {
    const Params p = make_params(d_in, d_out, d_ws);
    for (int l = 0; l < 2; ++l) {
        const int nrows = (l == 0) ? T : TL;
        ph_prep_w(p, l, 0, 1); ph_prep_misc(p, l, 0, 1); ph_lnmod(p, l, 0, 1); host_gemm_in(p); ph_streams(p, l, 0, 1); ph_rope(p, 0, 1); ph_scan(p, 0, 1);
        ph_attn(p, l, nrows, 0, 1); ph_rwkv_out(p, l, nrows, 0, 1); host_gemm_out(p, nrows); ph_post_mixer(p, l, nrows, 0, 1);
        ph_dispatch(p, l, nrows, 0, 1); host_moe1(p, l); host_moe2(p, l); ph_final(p, l, nrows, 0, 1);
    }
}
#endif
```

```cpp
#ifdef HOST_EMU
#include <cmath>
#include <cstdio>
#include <cstring>
#include <cstdint>
#include <cstdlib>
#define __device__
#define __global__
#define __host__
#define __forceinline__ inline
#else
#include <hip/hip_runtime.h>
#include <hip/hip_cooperative_groups.h>
#include <cstdio>
#include <cstdint>
namespace cg = cooperative_groups;
#endif

#ifndef CFG_D
#define CFG_D 1024
#define CFG_B 8
#define CFG_S 2048
#define CFG_L 256
#define CFG_DE 512
#endif
constexpr int D = CFG_D, NB = CFG_B, S = CFG_S, L = CFG_L, DE = CFG_DE;
constexpr int TL = NB * S, TC = NB * L, T = TL + TC;
constexpr int GRID_W = 64, HD = 64;
constexpr int DA = 256, A_IN = 1184, N_IN = 2976, NINP = 3072, DMIX = 1024;
constexpr int NEXP = 32, NSLOT = 2 * T + NEXP * 128;
constexpr int ZQB = 0, ZKB = 384, ZVB = 512, ZQN = 640, ZKN = 1024, ZVN = 1408, ZA = 1792, ZP = 2976;
constexpr float LN_EPS = 1e-6f, GN_EPS = 64e-5f, ATT_SCALE = 0.125f;
constexpr float ALPHA = 1.41421356237309515f;

typedef unsigned short bf16_t;

__device__ __forceinline__ float bf2f(bf16_t v) {
    unsigned u = ((unsigned)v) << 16; float f;
#ifdef HOST_EMU
    memcpy(&f, &u, 4);
#else
    f = __uint_as_float(u);
#endif
    return f;
}
__device__ __forceinline__ bf16_t f2bf(float f) {
    unsigned u;
#ifdef HOST_EMU
    memcpy(&u, &f, 4);
#else
    u = __float_as_uint(f);
#endif
    return (bf16_t)((u + 0x7fffu + ((u >> 16) & 1u)) >> 16);
}
__device__ __forceinline__ float sigmoidf_(float x) { return 1.0f / (1.0f + expf(-x)); }
__device__ __forceinline__ float siluf_(float x) { return x / (1.0f + expf(-x)); }
__device__ __forceinline__ int atomic_inc_int(int* p) {
#ifdef HOST_EMU
    int o = *p; *p = o + 1; return o;
#else
    return atomicAdd(p, 1);
#endif
}

struct Params {
    const float *x, *c, *ctx, *c_ctx, *w_mod, *b_mod, *w_in, *w_out, *a_shift, *a_w0, *a_w_up, *a_a0, *a_a_up, *a_g_up,
        *a_k_k, *a_k_a, *a_r_k, *a_lnx_g, *a_lnx_b, *b_sink, *c_rpb, *ln1_g, *ln1_b, *ln2_g, *ln2_b, *w_rg, *b_rg, *w_re,
        *b_re, *w_gate, *w_up, *w_down;
    float* out;
    int* cnt;
    unsigned* bar;
    float* mod;
    float* rope;
    bf16_t *win_t, *wout_t, *wgu_t, *wd_t;
    bf16_t *wrt;
    int* hist;
    bf16_t* HLO;
    bf16_t *wupT, *aupT, *gupT;
    bf16_t* LA;
    float *kT, *kN;
    bf16_t* H;
    bf16_t* Z;
    bf16_t* VT;
    float *sR, *sV, *sKK, *sG, *sW, *sKD, *sB;
    float* Y;
    bf16_t* MIX;
    float *PV, *QS, *PS, *SS;
    float* XC;
    float* O;
    int *rE, *rPos, *rSlot; float* rW;
    int* slotTok;
    bf16_t* ACT;
    float* YS;
};

constexpr size_t al256(size_t v) { return (v + 255) & ~(size_t)255; }
constexpr size_t OFF_CNT = 0;
constexpr size_t OFF_BAR = 4096, CTL_BYTES = 4096 + 16384;
constexpr size_t OFF_MOD = CTL_BYTES;
constexpr size_t OFF_ROPE = al256(OFF_MOD + (size_t)2 * (NB + 1) * 6 * D * 4);
constexpr size_t OFF_LORA = al256(OFF_ROPE + 64 * 16 * 2 * 4);
constexpr size_t OFF_WRT = al256(OFF_LORA + (size_t)(2 * 256 * 64 * 2 + 256 * 160) * 2);
constexpr size_t OFF_LG = al256(OFF_WRT + (size_t)2 * 128 * D * 2);
constexpr size_t OFF_WIN = al256(OFF_LG + (size_t)T * 36 * 4);
constexpr size_t OFF_WOUT = al256(OFF_WIN + (size_t)NINP * D * 2);
constexpr size_t OFF_WGU = al256(OFF_WOUT + (size_t)D * DMIX * 2);
constexpr size_t OFF_WD = al256(OFF_WGU + (size_t)NEXP * 2 * DE * D * 2);
constexpr size_t OFF_H = al256(OFF_WD + (size_t)NEXP * D * DE * 2);
constexpr size_t OFF_Z = al256(OFF_H + (size_t)(T + 1) * D * 2);
constexpr int PU = L + S;
constexpr int SEGLEN = 144, NSG = (L + S) / SEGLEN;
static_assert((L + S) % SEGLEN == 0 && SEGLEN % 16 == 0 && L % 16 == 0 && S % 16 == 0, "16-token output tiles must not straddle scan segments");
static_assert((size_t)3 * 64 * NSG * 4096 * 4 <= (size_t)NEXP * 2 * DE * D * 2, "scan segment states overlay wgu_t");
constexpr size_t OFF_VT = al256(OFF_Z + (size_t)T * ZP * 2);
constexpr size_t OFF_S = al256(OFF_VT + (size_t)NB * 8 * 64 * PU * 2);
constexpr size_t S1 = (size_t)T * 256 * 4;
constexpr size_t OFF_Y = al256(OFF_S + 10 * S1);
constexpr size_t OFF_MIX = al256(OFF_Y + 2 * S1);
constexpr size_t OFF_XC = al256(OFF_MIX + (size_t)T * 1024 * 2);
constexpr size_t OFF_ROUTE = al256(OFF_XC + (size_t)TC * D * 4);
constexpr size_t OFF_SLOTTOK = al256(OFF_ROUTE + (size_t)T * 2 * 4 * 4);
constexpr size_t WS_NEED = al256(OFF_SLOTTOK + (size_t)NSLOT * 4);
static_assert((size_t)NSLOT * DE * 2 <= (size_t)T * ZP * 2 && (size_t)T * D * 2 <= (size_t)T * ZP * 2, "ACT / HLO overlay Z");
static_assert((size_t)T * 4 * 4 + (size_t)T * 416 * 2 <= S1, "kN + LA overlay Y[1]");
static_assert((size_t)NSLOT * D * 4 <= 10 * S1 && (size_t)T * D * 4 <= 10 * S1, "YS / O overlay the stream buffers");

static Params make_params(void* const* d_in, void* d_out, void* d_ws) {
    Params p{};
    const float** f = (const float**)&p.x;
    for (int i = 0; i < 32; ++i) f[i] = (const float*)d_in[i];
    p.out = (float*)d_out;
    char* w = (char*)d_ws;
    p.cnt = (int*)(w + OFF_CNT); p.bar = (unsigned*)(w + OFF_BAR); p.mod = (float*)(w + OFF_MOD); p.rope = (float*)(w + OFF_ROPE);
    p.win_t = (bf16_t*)(w + OFF_WIN); p.wout_t = (bf16_t*)(w + OFF_WOUT); p.wgu_t = (bf16_t*)(w + OFF_WGU); p.wd_t = (bf16_t*)(w + OFF_WD);
    p.wrt = (bf16_t*)(w + OFF_WRT); p.hist = (int*)(w + OFF_LG); p.HLO = (bf16_t*)(w + OFF_Z);
    p.wupT = (bf16_t*)(w + OFF_LORA); p.aupT = p.wupT + 2 * 256 * 64; p.gupT = p.aupT + 2 * 256 * 64;
    p.H = (bf16_t*)(w + OFF_H); p.Z = (bf16_t*)(w + OFF_Z); p.VT = (bf16_t*)(w + OFF_VT);
    float* s = (float*)(w + OFF_S); const size_t n1 = (size_t)T * 256;
    p.sR = s; p.sV = s + n1; p.sKK = s + 2 * n1; p.sG = s + 3 * n1; p.sW = s + 4 * n1; p.sKD = s + 6 * n1; p.sB = s + 8 * n1;
    p.Y = (float*)(w + OFF_Y); p.MIX = (bf16_t*)(w + OFF_MIX); p.XC = (float*)(w + OFF_XC);
    p.O = (float*)(w + OFF_S);
    p.PV = (float*)(w + OFF_H); p.QS = (float*)(w + OFF_WGU); p.PS = p.QS + (size_t)64 * NSG * 4096; p.SS = p.PS + (size_t)64 * NSG * 4096;
    p.kT = p.Y; p.kN = p.Y + (size_t)T * 256; p.LA = (bf16_t*)(p.Y + (size_t)T * 256 + (size_t)T * 4);
    int* r = (int*)(w + OFF_ROUTE); p.rE = r; p.rPos = r + 2 * T; p.rSlot = r + 4 * T; p.rW = (float*)(r + 6 * T);
    p.slotTok = (int*)(w + OFF_SLOTTOK);
    p.ACT = (bf16_t*)(w + OFF_Z); p.YS = (float*)(w + OFF_S);
    return p;
}

__device__ void ph_prep_w(const Params& p, int l, long gtid, long gsz) {
    for (long i = gtid; i < (long)D * NINP; i += gsz) {
        const int k = (int)(i / NINP), n = (int)(i % NINP);
        float v = 0.f;
        if (n < N_IN) { const int oc = (n < ZA) ? n + A_IN : n - ZA; v = p.w_in[((size_t)l * D + k) * N_IN + oc]; }
        p.win_t[(size_t)n * D + k] = f2bf(v);
    }
    for (long i = gtid; i < (long)DMIX * D; i += gsz) {
        const int k = (int)(i / D), n = (int)(i % D);
        p.wout_t[(size_t)n * DMIX + k] = f2bf(p.w_out[((size_t)l * DMIX + k) * D + n]);
    }
    for (long i = gtid; i < (long)NEXP * D * 2 * DE; i += gsz) {
        const int rho = (int)(i % (2 * DE)); const long t = i / (2 * DE); const int k = (int)(t % D), e = (int)(t / D);
        const int q = rho >> 5, half = (rho >> 4) & 1, ii = rho & 15, cc = 16 * q + ii;
        const float* src = half ? p.w_up : p.w_gate;
        p.wgu_t[((size_t)e * 2 * DE + rho) * D + k] = f2bf(src[(((size_t)l * NEXP + e) * D + k) * DE + cc]);
    }
    for (long i = gtid; i < (long)NEXP * DE * D; i += gsz) {
        const int n = (int)(i % D); const long t = i / D; const int k = (int)(t % DE), e = (int)(t / DE);
        p.wd_t[((size_t)e * D + n) * DE + k] = f2bf(p.w_down[(((size_t)l * NEXP + e) * DE + k) * D + n]);
    }
}
__device__ __forceinline__ void ph_prep_misc(const Params& p, int l, long gtid, long gsz, bool do_mod = true) {
    if (l == 0 && do_mod) for (long i = gtid; i < (long)2 * (NB + 1) * 6 * D; i += gsz) {
        const int j = (int)(i % (6 * D)), b = (int)((i / (6 * D)) % (NB + 1)), ll = (int)(i / ((long)6 * D * (NB + 1)));
        const float* cv = (b < NB) ? p.c + (size_t)b * D : p.c_ctx;
        float acc = 0.f;
        for (int k = 0; k < D; ++k) acc += siluf_(cv[k]) * p.w_mod[((size_t)ll * D + k) * 6 * D + j];
        p.mod[((size_t)ll * (NB + 1) + b) * 6 * D + j] = acc + p.b_mod[(size_t)ll * 6 * D + j];
    }
    if (l == 0) for (long i = gtid; i < 64 * 16; i += gsz) {
        const int pos = (int)(i / 16), fi = (int)(i % 16);
        const float inv = powf(10000.0f, -(float)fi / 16.0f), ang = (float)pos * inv;
        p.rope[i] = cosf(ang); p.rope[1024 + i] = sinf(ang);
    }
    for (long i = gtid; i < NEXP; i += gsz) p.cnt[l * NEXP + i] = 0;
    for (long i = gtid; i < NSLOT; i += gsz) p.slotTok[i] = T;
    for (long i = gtid; i < D; i += gsz) p.H[(size_t)T * D + i] = 0;
}

__device__ __forceinline__ const float* xrow_in(const Params& p, int l, int m) {
    if (m < TL) return (l == 0 ? p.x : p.out) + (size_t)m * D;
    return (l == 0 ? p.ctx : p.XC) + (size_t)(m - TL) * D;
}
__device__ __forceinline__ const float* modrow(const Params& p, int l, int m) { return p.mod + ((size_t)l * (NB + 1) + (m < TL ? m / S : NB)) * 6 * D; }

__device__ void ph_lnmod(const Params& p, int l, long gtid, long gsz) {
    for (long m = gtid; m < T; m += gsz) {
        const float* xr = xrow_in(p, l, (int)m); const float* md = modrow(p, l, (int)m);
        float s = 0.f; for (int j = 0; j < D; ++j) s += xr[j];
        const float mu = s / D; float q = 0.f;
        for (int j = 0; j < D; ++j) { const float d = xr[j] - mu; q += d * d; }
        const float rstd = 1.0f / sqrtf(q / D + LN_EPS);
        for (int j = 0; j < D; ++j) p.H[(size_t)m * D + j] = f2bf((xr[j] - mu) * rstd * (1.0f + md[D + j]) + md[j]);
    }
}

__device__ __forceinline__ float zshift(const Params& p, int l, int m, int col) {
    int t, len;
    if (m < TL) { t = m % S; len = S; } else { t = (m - TL) % L; len = L; }
    const float* sh = p.a_shift + (size_t)l * 3 * A_IN;
    const bf16_t* z = p.Z + (size_t)m * ZP + ZA + col;
    float v = sh[A_IN + col] * bf2f(z[0]);
    if (t > 0) v += sh[col] * bf2f(z[-ZP]);
    if (t < len - 1) v += sh[2 * A_IN + col] * bf2f(z[ZP]);
    return v;
}

__device__ void ph_streams(const Params& p, int l, long gtid, long gsz) {
    for (long i = gtid; i < (long)T * DA; i += gsz) {
        const int m = (int)(i / DA), c = (int)(i % DA), h0 = c & ~63;
        const float r = zshift(p, l, m, c), k = zshift(p, l, m, 256 + c), v = zshift(p, l, m, 512 + c);
        float nrm = 0.f;
        for (int j = 0; j < 64; ++j) { const float t = zshift(p, l, m, 256 + h0 + j) * p.a_k_k[l * DA + h0 + j]; nrm += t * t; }
        const float kk = k * p.a_k_k[l * DA + c] / sqrtf(nrm + 1e-12f);
        float g = 0.f;
        for (int j = 0; j < 160; ++j) g += sigmoidf_(zshift(p, l, m, 1024 + j)) * p.a_g_up[((size_t)l * 160 + j) * DA + c];
        const size_t o = (size_t)m * DA + c;
        p.sR[o] = r; p.sV[o] = v; p.sKK[o] = kk; p.sG[o] = g;
        for (int d = 0; d < 2; ++d) {
            float aw = 0.f, aa = 0.f;
            for (int j = 0; j < 64; ++j) {
                aw += tanhf(zshift(p, l, m, 768 + d * 64 + j)) * p.a_w_up[(((size_t)l * 2 + d) * 64 + j) * DA + c];
                aa += zshift(p, l, m, 896 + d * 64 + j) * p.a_a_up[(((size_t)l * 2 + d) * 64 + j) * DA + c];
            }
            const float u = -(p.a_w0[(l * 2 + d) * DA + c] + aw);
            const float sp = (u > 20.f) ? u : log1pf(expf(u));
            const float w = expf(-expf(-sp - 0.5f));
            const float a = sigmoidf_(p.a_a0[(l * 2 + d) * DA + c] + aa);
            const size_t od = ((size_t)d * T + m) * DA + c;
            p.sW[od] = w; p.sKD[od] = k * (1.0f + (a - 1.0f) * p.a_k_a[l * DA + c]); p.sB[od] = kk * a;
        }
    }
}

__device__ __forceinline__ void ph_rope(const Params& p, long gtid, long gsz) {
    for (long i = gtid; i < (long)TL * 8 * 32; i += gsz) {
        const int pr = (int)(i & 31), hs = (int)((i >> 5) & 7), m = (int)(i >> 8);
        const int t = m % S, axis = pr >> 4, fi = pr & 15, pos = axis ? (t % GRID_W) : (t / GRID_W);
        bf16_t* z = p.Z + (size_t)m * ZP + hs * 64 + axis * 32 + fi;
        const float cs = p.rope[pos * 16 + fi], sn = p.rope[1024 + pos * 16 + fi];
        const float x0 = bf2f(z[0]), x1 = bf2f(z[16]);
        z[0] = f2bf(x0 * cs - x1 * sn); z[16] = f2bf(x1 * cs + x0 * sn);
    }
}

__device__ void ph_scan(const Params& p, long gtid, long gsz) {
    for (long i = gtid; i < (long)2 * NB * 4 * 64; i += gsz) {
        const int v = (int)(i & 63), h = (int)((i >> 6) & 3), b = (int)((i >> 8) % NB), d = (int)((i >> 8) / NB);
        float st[64];
#pragma unroll
        for (int k = 0; k < 64; ++k) st[k] = 0.f;
        for (int pos = 0; pos < L + S; ++pos) {
            int m;
            if (pos < L) m = TL + b * L + (d ? L - 1 - pos : pos);
            else m = b * S + (d ? S - 1 - (pos - L) : pos - L);
            const size_t o = (size_t)m * DA + h * 64, od = ((size_t)d * T + m) * DA + h * 64;
            const float* kk = p.sKK + o; const float* r = p.sR + o;
            const float* w = p.sW + od; const float* bb = p.sB + od; const float* kd = p.sKD + od;
            const float vv = p.sV[o + v];
            float sk = 0.f;
#pragma unroll
            for (int k = 0; k < 64; ++k) sk += st[k] * kk[k];
            float y = 0.f;
#pragma unroll
            for (int k = 0; k < 64; ++k) { st[k] = st[k] * w[k] - sk * bb[k] + vv * kd[k]; y += st[k] * r[k]; }
            p.Y[od + v] = y;
        }
    }
}

__device__ void ph_rwkv_out(const Params& p, int l, int nrows, long gtid, long gsz) {
    for (long i = gtid; i < (long)nrows * 4; i += gsz) {
        const int m = (int)(i >> 2), h = (int)(i & 3);
        const size_t o = (size_t)m * DA + h * 64;
        const float* y0 = p.Y + o; const float* y1 = p.Y + (size_t)T * DA + o;
        float s = 0.f, bon = 0.f;
        for (int n = 0; n < 64; ++n) {
            s += y0[n] + y1[n];
            bon += p.sR[o + n] * (p.sKD[o + n] + p.sKD[(size_t)T * DA + o + n]) * p.a_r_k[l * DA + h * 64 + n];
        }
        const float mu = s / 64.f; float q = 0.f;
        for (int n = 0; n < 64; ++n) { const float dd = y0[n] + y1[n] - mu; q += dd * dd; }
        const float rstd = 1.0f / sqrtf(q / 64.f + GN_EPS);
        for (int n = 0; n < 64; ++n) {
            const int c = h * 64 + n;
            const float yn = (y0[n] + y1[n] - mu) * rstd * p.a_lnx_g[l * DA + c] + p.a_lnx_b[l * DA + c];
            p.MIX[(size_t)m * DMIX + c] = f2bf((yn + bon * p.sV[o + n]) * p.sG[o + n]);
        }
    }
}

__device__ __forceinline__ void att_key(const float (&q)[64], const bf16_t* kr, const bf16_t* vr, float bias, float& mx, float& ls, float (&acc)[64]) {
    float s = 0.f;
#pragma unroll
    for (int d = 0; d < 64; ++d) s += q[d] * bf2f(kr[d]);
    s = s * ATT_SCALE + bias;
    const float mn = fmaxf(mx, s), f = expf(mx - mn), pe = expf(s - mn);
    ls = ls * f + pe;
#pragma unroll
    for (int d = 0; d < 64; ++d) acc[d] = acc[d] * f + pe * bf2f(vr[d]);
    mx = mn;
}

__device__ void ph_attn(const Params& p, int l, int nrows, long gtid, long gsz) {
    for (long i = gtid; i < (long)nrows * 12; i += gsz) {
        const int m = (int)(i / 12), u = (int)(i % 12);
        const bool isB = u < 6; const int hq = isB ? u : u - 6;
        const int b = (m < TL) ? m / S : (m - TL) / L;
        const int qcol = isB ? ZQB + hq * 64 : ZQN + hq * 64;
        const int kcol = isB ? ZKB + (hq / 3) * 64 : ZKN + hq * 64;
        const int vcol = isB ? ZVB + (hq / 3) * 64 : ZVN + hq * 64;
        float q[64], acc[64];
        const bf16_t* qr = p.Z + (size_t)m * ZP + qcol;
#pragma unroll
        for (int d = 0; d < 64; ++d) { q[d] = bf2f(qr[d]); acc[d] = 0.f; }
        float mx, ls;
        if (isB) { mx = p.b_sink[l * 6 + hq]; ls = 1.0f; } else { mx = -1e30f; ls = 0.f; }
        for (int j = 0; j < L; ++j) { const bf16_t* zr = p.Z + (size_t)(TL + b * L + j) * ZP; att_key(q, zr + kcol, zr + vcol, 0.f, mx, ls, acc); }
        if (m < TL) {
            const int t = m % S;
            if (isB) {
                const int j0 = t - 128 < 0 ? 0 : t - 128, j1 = t + 128 > S - 1 ? S - 1 : t + 128;
                for (int j = j0; j <= j1; ++j) { const bf16_t* zr = p.Z + (size_t)(b * S + j) * ZP; att_key(q, zr + kcol, zr + vcol, 0.f, mx, ls, acc); }
            } else {
                const int rows = S / GRID_W, r = t / GRID_W, c = t % GRID_W;
                int r0 = r - 4; r0 = r0 < 0 ? 0 : (r0 > rows - 8 ? rows - 8 : r0);
                int c0 = c - 8; c0 = c0 < 0 ? 0 : (c0 > GRID_W - 16 ? GRID_W - 16 : c0);
                for (int a = 0; a < 8; ++a)
                    for (int e = 0; e < 16; ++e) {
                        const int kr = r0 + a, kc = c0 + e;
                        const float bias = p.c_rpb[(((size_t)l * 6 + hq) * 15 + (kr - r + 7)) * 31 + (kc - c + 15)];
                        const bf16_t* zr = p.Z + (size_t)(b * S + kr * GRID_W + kc) * ZP;
                        att_key(q, zr + kcol, zr + vcol, bias, mx, ls, acc);
                    }
            }
        }
        const float inv = 1.0f / ls;
        bf16_t* o = p.MIX + (size_t)m * DMIX + (isB ? 256 : 640) + hq * 64;
#pragma unroll
        for (int d = 0; d < 64; ++d) o[d] = f2bf(acc[d] * inv);
    }
}

__device__ void ph_post_mixer(const Params& p, int l, int nrows, long gtid, long gsz) {
    for (long mm = gtid; mm < nrows; mm += gsz) {
        const int m = (int)mm;
        const float* xr = xrow_in(p, l, m); const float* md = modrow(p, l, m); const float* orow = p.O + (size_t)m * D;
        float* x1 = (m < TL) ? p.out + (size_t)m * D : p.XC + (size_t)(m - TL) * D;
        const float* g1 = p.ln1_g + (size_t)l * D; const float* b1 = p.ln1_b + (size_t)l * D;
        float s = 0.f; for (int j = 0; j < D; ++j) s += ALPHA * xr[j] + md[2 * D + j] * orow[j];
        float mu = s / D, q = 0.f;
        for (int j = 0; j < D; ++j) { const float d = ALPHA * xr[j] + md[2 * D + j] * orow[j] - mu; q += d * d; }
        float rstd = 1.0f / sqrtf(q / D + LN_EPS);
        s = 0.f;
        for (int j = 0; j < D; ++j) { const float v = (ALPHA * xr[j] + md[2 * D + j] * orow[j] - mu) * rstd * g1[j] + b1[j]; x1[j] = v; s += v; }
        mu = s / D; q = 0.f;
        for (int j = 0; j < D; ++j) { const float d = x1[j] - mu; q += d * d; }
        rstd = 1.0f / sqrtf(q / D + LN_EPS);
        float gl[4], el[32];
#pragma unroll
        for (int g = 0; g < 4; ++g) gl[g] = p.b_rg[l * 4 + g];
#pragma unroll
        for (int e = 0; e < 32; ++e) el[e] = p.b_re[l * 32 + e];
        for (int j = 0; j < D; ++j) {
            const float hv = (x1[j] - mu) * rstd * (1.0f + md[4 * D + j]) + md[3 * D + j];
            p.H[(size_t)m * D + j] = f2bf(hv);
            const float* wg = p.w_rg + ((size_t)l * D + j) * 4; const float* we = p.w_re + ((size_t)l * D + j) * 32;
#pragma unroll
            for (int g = 0; g < 4; ++g) gl[g] += hv * wg[g];
#pragma unroll
            for (int e = 0; e < 32; ++e) el[e] += hv * we[e];
        }
        int gs = 0; float gm = gl[0];
#pragma unroll
        for (int g = 1; g < 4; ++g) if (gl[g] > gm) { gm = gl[g]; gs = g; }
        float den = 0.f;
#pragma unroll
        for (int g = 0; g < 4; ++g) den += expf(gl[g] - gm);
        const float pg = 1.0f / den;
        float v1 = -3e38f, v2 = -3e38f; int i1 = 0, i2 = 0;
#pragma unroll
        for (int j = 0; j < 8; ++j) {
            const float v = gs == 0 ? el[j] : gs == 1 ? el[8 + j] : gs == 2 ? el[16 + j] : el[24 + j];
            if (v > v1) { v2 = v1; i2 = i1; v1 = v; i1 = j; } else if (v > v2) { v2 = v; i2 = j; }
        }
        const float e2 = expf(v2 - v1), w1 = pg / (1.0f + e2), w2 = pg * e2 / (1.0f + e2);
        const int ea = gs * 8 + i1, eb = gs * 8 + i2;
        p.rE[2 * m] = ea; p.rE[2 * m + 1] = eb; p.rW[2 * m] = w1; p.rW[2 * m + 1] = w2;
        p.rPos[2 * m] = atomic_inc_int(p.cnt + l * NEXP + ea); p.rPos[2 * m + 1] = atomic_inc_int(p.cnt + l * NEXP + eb);
    }
}

__device__ __forceinline__ int pstart_of(const int* cnt, int e) {
    int s = 0;
    for (int j = 0; j < NEXP; ++j) if (j < e) s += (cnt[j] + 127) & ~127;
    return s;
}
__device__ __forceinline__ void ph_dispatch(const Params& p, int l, int nrows, long gtid, long gsz) {
    for (long i = gtid; i < (long)nrows * 2; i += gsz) {
        const int slot = pstart_of(p.cnt + l * NEXP, p.rE[i]) + p.rPos[i];
        p.rSlot[i] = slot; p.slotTok[slot] = (int)(i >> 1);
    }
}

__device__ void ph_final(const Params& p, int l, int nrows, long gtid, long gsz) {
    for (long mm = gtid; mm < nrows; mm += gsz) {
        const int m = (int)mm;
        float* x1 = (m < TL) ? p.out + (size_t)m * D : p.XC + (size_t)(m - TL) * D;
        const float* md = modrow(p, l, m);
        const float* ya = p.YS + (size_t)p.rSlot[2 * m] * D; const float* yb = p.YS + (size_t)p.rSlot[2 * m + 1] * D;
        const float wa = p.rW[2 * m], wb = p.rW[2 * m + 1];
        const float* g2 = p.ln2_g + (size_t)l * D; const float* b2 = p.ln2_b + (size_t)l * D;
        float s = 0.f; for (int j = 0; j < D; ++j) s += ALPHA * x1[j] + md[5 * D + j] * (wa * ya[j] + wb * yb[j]);
        const float mu = s / D; float q = 0.f;
        for (int j = 0; j < D; ++j) { const float d = ALPHA * x1[j] + md[5 * D + j] * (wa * ya[j] + wb * yb[j]) - mu; q += d * d; }
        const float rstd = 1.0f / sqrtf(q / D + LN_EPS);
        for (int j = 0; j < D; ++j) x1[j] = (ALPHA * x1[j] + md[5 * D + j] * (wa * ya[j] + wb * yb[j]) - mu) * rstd * g2[j] + b2[j];
    }
}

__device__ __forceinline__ int moe_blocks(const int* cnt) { int s = 0; for (int j = 0; j < NEXP; ++j) s += (cnt[j] + 127) >> 7; return s; }
__device__ __forceinline__ int moe_block_expert(const int* cnt, int rb) {
    int s = 0, e = 0;
    for (int j = 0; j < NEXP; ++j) { const int nb = (cnt[j] + 127) >> 7; if (rb >= s && rb < s + nb) e = j; s += nb; }
    return e;
}

#ifdef HOST_EMU
static void host_gemm_in(const Params& p) {
    for (int m = 0; m < T; ++m) for (int n = 0; n < ZP; ++n) { float a = 0.f; for (int k = 0; k < D; ++k) a += bf2f(p.H[(size_t)m * D + k]) * bf2f(p.win_t[(size_t)n * D + k]); p.Z[(size_t)m * ZP + n] = f2bf(a); }
}
static void host_gemm_out(const Params& p, int nrows) {
    for (int m = 0; m < nrows; ++m) for (int n = 0; n < D; ++n) { float a = 0.f; for (int k = 0; k < DMIX; ++k) a += bf2f(p.MIX[(size_t)m * DMIX + k]) * bf2f(p.wout_t[(size_t)n * DMIX + k]); p.O[(size_t)m * D + n] = a; }
}
static void host_moe1(const Params& p, int l) {
    const int* cnt = p.cnt + l * NEXP; const int nrb = moe_blocks(cnt);
    for (int rb = 0; rb < nrb; ++rb) { const int e = moe_block_expert(cnt, rb);
        for (int r = 0; r < 128; ++r) { const int slot = rb * 128 + r; const bf16_t* a = p.H + (size_t)p.slotTok[slot] * D;
            for (int c = 0; c < DE; ++c) { const int q = c >> 4, ii = c & 15; float g = 0.f, u = 0.f;
                const bf16_t* wg = p.wgu_t + ((size_t)e * 2 * DE + 32 * q + ii) * D; const bf16_t* wu = wg + (size_t)16 * D;
                for (int k = 0; k < D; ++k) { g += bf2f(a[k]) * bf2f(wg[k]); u += bf2f(a[k]) * bf2f(wu[k]); }
                p.ACT[(size_t)slot * DE + c] = f2bf(siluf_(g) * u); } } }
}
static void host_moe2(const Params& p, int l) {
    const int* cnt = p.cnt + l * NEXP; const int nrb = moe_blocks(cnt);
    for (int rb = 0; rb < nrb; ++rb) { const int e = moe_block_expert(cnt, rb);
        for (int r = 0; r < 128; ++r) { const int slot = rb * 128 + r;
            for (int n = 0; n < D; ++n) { float a = 0.f; const bf16_t* w = p.wd_t + ((size_t)e * D + n) * DE;
                for (int k = 0; k < DE; ++k) a += bf2f(p.ACT[(size_t)slot * DE + k]) * bf2f(w[k]);
                p.YS[(size_t)slot * D + n] = a; } } }
}
#else
typedef short bf16x8 __attribute__((ext_vector_type(8)));
typedef float f32x4 __attribute__((ext_vector_type(4)));
__device__ __forceinline__ int opq_tid() { int t = threadIdx.x; asm volatile("" : "+v"(t)); return t; }
__device__ __forceinline__ int opq_bid() { int b = blockIdx.x; asm volatile("" : "+s"(b)); return b; }
__device__ __forceinline__ unsigned pk2(float lo, float hi) { return (unsigned)f2bf(lo) | ((unsigned)f2bf(hi) << 16); }
struct u32x2_t { unsigned x, y; };
__device__ __forceinline__ void st_bf16x4(bf16_t* dst, f32x4 v) { u32x2_t o; o.x = pk2(v[0], v[1]); o.y = pk2(v[2], v[3]); *(u32x2_t*)dst = o; }
template <class Epi>
__device__ __forceinline__ void gemm_tile(const bf16_t* a0, const bf16_t* a1, const bf16_t* b0, const bf16_t* b1, int K, char* lds, const Epi& epi) {
    const int tid = opq_tid(), wid = tid >> 6, lane = tid & 63, wr = wid >> 1, wc = wid & 1, fr = lane & 15, fq = lane >> 4;
    f32x4 acc[4][4];
#pragma unroll
    for (int m = 0; m < 4; ++m)
#pragma unroll
        for (int n = 0; n < 4; ++n) acc[m][n] = (f32x4){0.f, 0.f, 0.f, 0.f};
#define GT_STAGE(st_, kt_) do { char* sa_ = lds + (st_) * 16384 + tid * 16; \
        __builtin_amdgcn_global_load_lds((const unsigned*)(a0 + (kt_)), (__attribute__((address_space(3))) unsigned*)(sa_), 16, 0, 0); \
        __builtin_amdgcn_global_load_lds((const unsigned*)(a1 + (kt_)), (__attribute__((address_space(3))) unsigned*)(sa_ + 4096), 16, 0, 0); \
        __builtin_amdgcn_global_load_lds((const unsigned*)(b0 + (kt_)), (__attribute__((address_space(3))) unsigned*)(sa_ + 8192), 16, 0, 0); \
        __builtin_amdgcn_global_load_lds((const unsigned*)(b1 + (kt_)), (__attribute__((address_space(3))) unsigned*)(sa_ + 12288), 16, 0, 0); } while (0)
    const int fsw = (0 - (fr >> 2)) & 3;
    const int aoff = (wr * 64 + fr) * 64 + ((fq ^ fsw) * 16), boff = 8192 + (wc * 64 + fr) * 64 + ((fq ^ fsw) * 16);
    const int nk = K / 32;
    GT_STAGE(0, 0);
    if (nk > 1) GT_STAGE(1, 32);
    if (nk > 2) GT_STAGE(2, 64);
    for (int t = 0; t < nk; ++t) {
        if (t + 2 < nk) asm volatile("s_waitcnt vmcnt(8)" ::: "memory"); else if (t + 1 < nk) asm volatile("s_waitcnt vmcnt(4)" ::: "memory"); else asm volatile("s_waitcnt vmcnt(0)" ::: "memory");
        asm volatile("s_waitcnt lgkmcnt(0)" ::: "memory");
        __builtin_amdgcn_s_barrier();
        if (t + 3 < nk) GT_STAGE((t + 3) & 3, (t + 3) * 32);
        const char* sb = lds + (t & 3) * 16384;
        bf16x8 At[4], Bt[4];
#pragma unroll
        for (int m = 0; m < 4; ++m) At[m] = *(const bf16x8*)(sb + aoff + m * 1024);
#pragma unroll
        for (int n = 0; n < 4; ++n) Bt[n] = *(const bf16x8*)(sb + boff + n * 1024);
#pragma unroll
        for (int m = 0; m < 4; ++m)
#pragma unroll
            for (int n = 0; n < 4; ++n) acc[m][n] = __builtin_amdgcn_mfma_f32_16x16x32_bf16(At[m], Bt[n], acc[m][n], 0, 0, 0);
    }
    asm volatile("s_waitcnt lgkmcnt(0)" ::: "memory");
    __builtin_amdgcn_s_barrier();
#undef GT_STAGE
    epi(acc, wr, wc, fr, fq);
}
#define STG_ROW(i) ((tid_ + (i) * 256) >> 2)
#define STG_K ((((tid_ & 3) ^ ((0 - (tid_ >> 4)) & 3))) * 8)

__device__ __forceinline__ void g_gemm_in(const Params& p, char* lds) {
    const int tid_ = opq_tid(), bid_ = opq_bid(); (void)tid_; (void)bid_;
    constexpr int NT = NINP / 128, MT = T / 128;
    for (int tile = bid_; tile < NT * MT; tile += gridDim.x) {
        const int tm = tile / NT, tn = tile % NT;
        const bf16_t* a0 = p.H + (size_t)(tm * 128 + STG_ROW(0)) * D + STG_K; const bf16_t* a1 = p.H + (size_t)(tm * 128 + STG_ROW(1)) * D + STG_K;
        const bf16_t* b0 = p.win_t + (size_t)(tn * 128 + STG_ROW(0)) * D + STG_K; const bf16_t* b1 = p.win_t + (size_t)(tn * 128 + STG_ROW(1)) * D + STG_K;
        gemm_tile(a0, a1, b0, b1, D, lds, [&](const f32x4 (&acc)[4][4], int wr, int wc, int fr, int fq) {
            if (tn < ZVB / 128 && tm < TL / 128) {
#pragma unroll
                for (int m = 0; m < 4; ++m)
#pragma unroll
                    for (int j = 0; j < 4; ++j) { const int row = tm * 128 + wr * 64 + m * 16 + fq * 4 + j, t = row % S;
                        bf16_t* zr = p.Z + (size_t)row * ZP + tn * 128 + wc * 64 + fr;
#pragma unroll
                        for (int ax = 0; ax < 2; ++ax) { const int pos = ax ? t % GRID_W : t / GRID_W; const float cs = p.rope[pos * 16 + fr], sn = p.rope[1024 + pos * 16 + fr];
                            const float x0 = acc[m][2 * ax][j], x1 = acc[m][2 * ax + 1][j];
                            zr[32 * ax] = f2bf(x0 * cs - x1 * sn); zr[32 * ax + 16] = f2bf(x1 * cs + x0 * sn); } }
            } else {
#pragma unroll
            for (int m = 0; m < 4; ++m)
#pragma unroll
                for (int n = 0; n < 4; ++n) { const int col = tn * 128 + wc * 64 + n * 16 + fr;
                    if (col < ZP) {
#pragma unroll
                        for (int j = 0; j < 4; ++j) p.Z[(size_t)(tm * 128 + wr * 64 + m * 16 + fq * 4 + j) * ZP + col] = f2bf(acc[m][n][j]); } }
            }
            if (tn == ZVB / 128 || (tn >= ZVN / 128 && tn < ZA / 128)) {
#pragma unroll
                for (int m = 0; m < 4; ++m) { const int m0 = tm * 128 + wr * 64 + m * 16 + fq * 4; int b, u;
                    if (m0 < TL) { b = m0 / S; u = L + m0 % S; } else { b = (m0 - TL) / L; u = (m0 - TL) % L; }
#pragma unroll
                    for (int n = 0; n < 4; ++n) { const int col = tn * 128 + wc * 64 + n * 16 + fr;
                        const int hv = col < ZVN ? (col - ZVB) >> 6 : 2 + ((col - ZVN) >> 6), d = col < ZVN ? (col - ZVB) & 63 : (col - ZVN) & 63;
                        st_bf16x4(p.VT + ((size_t)(b * 8 + hv) * 64 + d) * PU + u, acc[m][n]); } }
            }
        });
    }
}
__device__ __forceinline__ void g_gemm_out(const Params& p, int nrows, char* lds) {
    const int tid_ = opq_tid(), bid_ = opq_bid(); (void)tid_; (void)bid_;
    constexpr int NT = D / 128; const int MT = nrows / 128;
    for (int tile = bid_; tile < NT * MT; tile += gridDim.x) {
        const int tm = tile / NT, tn = tile % NT;
        const bf16_t* a0 = p.MIX + (size_t)(tm * 128 + STG_ROW(0)) * DMIX + STG_K; const bf16_t* a1 = p.MIX + (size_t)(tm * 128 + STG_ROW(1)) * DMIX + STG_K;
        const bf16_t* b0 = p.wout_t + (size_t)(tn * 128 + STG_ROW(0)) * DMIX + STG_K; const bf16_t* b1 = p.wout_t + (size_t)(tn * 128 + STG_ROW(1)) * DMIX + STG_K;
        gemm_tile(a0, a1, b0, b1, DMIX, lds, [&](const f32x4 (&acc)[4][4], int wr, int wc, int fr, int fq) {
#pragma unroll
            for (int m = 0; m < 4; ++m)
#pragma unroll
                for (int n = 0; n < 4; ++n)
#pragma unroll
                    for (int j = 0; j < 4; ++j) p.O[(size_t)(tm * 128 + wr * 64 + m * 16 + fq * 4 + j) * D + tn * 128 + wc * 64 + n * 16 + fr] = acc[m][n][j];
        });
    }
}
__device__ __forceinline__ void g_moe1(const Params& p, int l, char* lds) {
    const int tid_ = opq_tid(), bid_ = opq_bid(); (void)tid_; (void)bid_;
    const int* cnt = p.cnt + l * NEXP; const int nrb = moe_blocks(cnt); constexpr int NT = 2 * DE / 128;
    for (int tile = bid_; tile < nrb * NT; tile += gridDim.x) {
        const int rb = tile / NT, tn = tile % NT, e = moe_block_expert(cnt, rb);
        const bf16_t* a0 = p.H + (size_t)p.slotTok[rb * 128 + STG_ROW(0)] * D + STG_K; const bf16_t* a1 = p.H + (size_t)p.slotTok[rb * 128 + STG_ROW(1)] * D + STG_K;
        const bf16_t* bw = p.wgu_t + (size_t)e * 2 * DE * D;
        const bf16_t* b0 = bw + (size_t)(tn * 128 + STG_ROW(0)) * D + STG_K; const bf16_t* b1 = bw + (size_t)(tn * 128 + STG_ROW(1)) * D + STG_K;
        gemm_tile(a0, a1, b0, b1, D, lds, [&](const f32x4 (&acc)[4][4], int wr, int wc, int fr, int fq) {
#pragma unroll
            for (int m = 0; m < 4; ++m)
#pragma unroll
                for (int n2 = 0; n2 < 2; ++n2) { const int col = tn * 64 + wc * 32 + n2 * 16 + fr;
#pragma unroll
                    for (int j = 0; j < 4; ++j) { const float g = acc[m][2 * n2][j], u = acc[m][2 * n2 + 1][j];
                        p.ACT[(size_t)(rb * 128 + wr * 64 + m * 16 + fq * 4 + j) * DE + col] = f2bf(g / (1.0f + __expf(-g)) * u); } }
        });
    }
}
__device__ __forceinline__ void g_moe2(const Params& p, int l, char* lds) {
    const int tid_ = opq_tid(), bid_ = opq_bid(); (void)tid_; (void)bid_;
    const int* cnt = p.cnt + l * NEXP; const int nrb = moe_blocks(cnt); constexpr int NT = D / 128;
    for (int tile = bid_; tile < nrb * NT; tile += gridDim.x) {
        const int rb = tile / NT, tn = tile % NT, e = moe_block_expert(cnt, rb);
        const bf16_t* a0 = p.ACT + (size_t)(rb * 128 + STG_ROW(0)) * DE + STG_K; const bf16_t* a1 = p.ACT + (size_t)(rb * 128 + STG_ROW(1)) * DE + STG_K;
        const bf16_t* bw = p.wd_t + (size_t)e * D * DE;
        const bf16_t* b0 = bw + (size_t)(tn * 128 + STG_ROW(0)) * DE + STG_K; const bf16_t* b1 = bw + (size_t)(tn * 128 + STG_ROW(1)) * DE + STG_K;
        gemm_tile(a0, a1, b0, b1, DE, lds, [&](const f32x4 (&acc)[4][4], int wr, int wc, int fr, int fq) {
#pragma unroll
            for (int m = 0; m < 4; ++m)
#pragma unroll
                for (int n = 0; n < 4; ++n)
#pragma unroll
                    for (int j = 0; j < 4; ++j) p.YS[(size_t)(rb * 128 + wr * 64 + m * 16 + fq * 4 + j) * D + tn * 128 + wc * 64 + n * 16 + fr] = acc[m][n][j];
        });
    }
}


constexpr int DV = D / 256;
static_assert(D % 256 == 0, "row phases hold a row as DV float4 per lane");
template <int CTRL> __device__ __forceinline__ float dppf(float v) { return __builtin_bit_cast(float, __builtin_amdgcn_update_dpp(0, __builtin_bit_cast(int, v), CTRL, 0xf, 0xf, true)); }
__device__ __forceinline__ float wave_sum(float v) {
    v += dppf<0xB1>(v); v += dppf<0x4E>(v); v += dppf<0x141>(v); v += dppf<0x140>(v);
    float a = v, b = v;
    asm volatile("s_nop 1\n\tv_permlane16_swap_b32 %0, %1" : "+v"(a), "+v"(b));
    v = a + b; a = v; b = v;
    asm volatile("s_nop 1\n\tv_permlane32_swap_b32 %0, %1" : "+v"(a), "+v"(b));
    return a + b;
}
__device__ __forceinline__ float sum8(float v) { v += dppf<0xB1>(v); v += dppf<0x4E>(v); v += dppf<0x141>(v); return v; }
__device__ __forceinline__ float sum4(f32x4 a) { return (a[0] + a[1]) + (a[2] + a[3]); }
#define LDS_WAIT() asm volatile("s_waitcnt lgkmcnt(0)" ::: "memory")

__device__ __forceinline__ void row_stats(const f32x4 (&v)[DV], float& mu, float& rstd) {
    float s = 0.f;
#pragma unroll
    for (int j = 0; j < DV; ++j) s += sum4(v[j]);
    mu = wave_sum(s) * (1.0f / D);
    float q = 0.f;
#pragma unroll
    for (int j = 0; j < DV; ++j) { const f32x4 d = v[j] - mu; q += sum4(d * d); }
    rstd = 1.0f / sqrtf(wave_sum(q) * (1.0f / D) + LN_EPS);
}

__device__ __forceinline__ void ph_lnmod_fast(const Params& p, int l) {
    const int tid_ = opq_tid(), bid_ = opq_bid(); (void)tid_; (void)bid_;
    const int lane = tid_ & 63, gw = bid_ * 4 + (tid_ >> 6), nw = gridDim.x * 4;
    constexpr int R = 4;
    for (int m0 = gw * R; m0 < T; m0 += nw * R) {
        f32x4 v[R][DV];
#pragma unroll
        for (int r = 0; r < R; ++r) { const f32x4* xr = (const f32x4*)xrow_in(p, l, m0 + r < T ? m0 + r : m0) + lane;
#pragma unroll
            for (int j = 0; j < DV; ++j) v[r][j] = xr[64 * j]; }
        float mu[R], rstd[R];
#pragma unroll
        for (int r = 0; r < R; ++r) row_stats(v[r], mu[r], rstd[r]);
#pragma unroll
        for (int r = 0; r < R; ++r) if (m0 + r < T) { const f32x4* md = (const f32x4*)modrow(p, l, m0 + r) + lane;
#pragma unroll
            for (int j = 0; j < DV; ++j) st_bf16x4(p.H + (size_t)(m0 + r) * D + 4 * (lane + 64 * j), (v[r][j] - mu[r]) * rstd[r] * (md[D / 4 + 64 * j] + 1.0f) + md[64 * j]); }
    }
}

template <int R>
__device__ __forceinline__ void pm_rows(const Params& p, int l, int m0, int lane) {
    const f32x4* g1 = (const f32x4*)(p.ln1_g + (size_t)l * D) + lane; const f32x4* b1 = (const f32x4*)(p.ln1_b + (size_t)l * D) + lane;
    f32x4 v[R][DV]; float mu[R], rstd[R];
#pragma unroll
    for (int r = 0; r < R; ++r) { const int m = m0 + r; const f32x4* xr = (const f32x4*)xrow_in(p, l, m) + lane; const f32x4* md = (const f32x4*)modrow(p, l, m) + lane;
        const f32x4* orow = (const f32x4*)(p.O + (size_t)m * D) + lane;
#pragma unroll
        for (int j = 0; j < DV; ++j) v[r][j] = xr[64 * j] * ALPHA + md[2 * (D / 4) + 64 * j] * orow[64 * j]; }
#pragma unroll
    for (int r = 0; r < R; ++r) row_stats(v[r], mu[r], rstd[r]);
#pragma unroll
    for (int r = 0; r < R; ++r) { const int m = m0 + r; f32x4* x1 = (f32x4*)((m < TL) ? p.out + (size_t)m * D : p.XC + (size_t)(m - TL) * D) + lane;
#pragma unroll
        for (int j = 0; j < DV; ++j) { v[r][j] = (v[r][j] - mu[r]) * rstd[r] * g1[64 * j] + b1[64 * j]; x1[64 * j] = v[r][j]; } }
#pragma unroll
    for (int r = 0; r < R; ++r) row_stats(v[r], mu[r], rstd[r]);
#pragma unroll
    for (int r = 0; r < R; ++r) { const int m = m0 + r; const f32x4* md = (const f32x4*)modrow(p, l, m) + lane;
#pragma unroll
        for (int j = 0; j < DV; ++j) {
            const f32x4 hv = (v[r][j] - mu[r]) * rstd[r] * (md[4 * (D / 4) + 64 * j] + 1.0f) + md[3 * (D / 4) + 64 * j];
            f32x4 hh, lo;
#pragma unroll
            for (int e = 0; e < 4; ++e) { hh[e] = bf2f(f2bf(hv[e])); lo[e] = hv[e] - hh[e]; }
            st_bf16x4(p.H + (size_t)m * D + 4 * (lane + 64 * j), hh);
            st_bf16x4(p.HLO + (size_t)m * D + 4 * (lane + 64 * j), lo);
        } }
}

__device__ __forceinline__ void g_router(const Params& p, int l, int nrows, char* lds) {
    const int tid_ = opq_tid(), bid_ = opq_bid(); (void)tid_; (void)bid_;
    const int lane = tid_ & 63, wid = tid_ >> 6, fr = lane & 15, fq = lane >> 4;
    float* part = (float*)lds;
    float* lgt = part + 4 * 6 * 64 * 4;
    int* eids = (int*)(lgt + 32 * 48);
    for (int rg = bid_; rg < nrows / 32; rg += gridDim.x) {
#pragma unroll 1
        for (int i = 0; i < 8; i += 2) pm_rows<2>(p, l, rg * 32 + wid * 8 + i, lane);
        asm volatile("s_waitcnt vmcnt(0)" ::: "memory");
        __syncthreads();
        f32x4 acc[2][3];
#pragma unroll
        for (int a = 0; a < 2; ++a)
#pragma unroll
            for (int b = 0; b < 3; ++b) acc[a][b] = (f32x4){0.f, 0.f, 0.f, 0.f};
#pragma unroll
        for (int seg = 0; seg < 3; ++seg) {
            const bf16_t* ap = (seg < 2 ? p.H : p.HLO) + (size_t)(rg * 32 + fr) * D + wid * (D / 4) + fq * 8;
            const bf16_t* bp = p.wrt + (seg == 1 ? (size_t)128 * D : 0) + (size_t)fr * D + wid * (D / 4) + fq * 8;
#pragma unroll 1
            for (int ks0 = 0; ks0 < D / 128; ks0 += 4) {
                bf16x8 av[4][2], bv[4][3];
#pragma unroll
                for (int u = 0; u < 4; ++u) { const int ko = (ks0 + u) * 32;
                    av[u][0] = *(const bf16x8*)(ap + ko); av[u][1] = *(const bf16x8*)(ap + (size_t)16 * D + ko);
                    bv[u][0] = *(const bf16x8*)(bp + ko); bv[u][1] = *(const bf16x8*)(bp + (size_t)16 * D + ko); bv[u][2] = *(const bf16x8*)(bp + (size_t)32 * D + ko); }
                asm volatile("" ::: "memory");
#pragma unroll
                for (int u = 0; u < 4; ++u)
#pragma unroll
                    for (int a = 0; a < 2; ++a)
#pragma unroll
                        for (int b = 0; b < 3; ++b) acc[a][b] = __builtin_amdgcn_mfma_f32_16x16x32_bf16(av[u][a], bv[u][b], acc[a][b], 0, 0, 0);
            }
        }
#pragma unroll
        for (int a = 0; a < 2; ++a)
#pragma unroll
            for (int b = 0; b < 3; ++b) *(f32x4*)(part + ((wid * 6 + a * 3 + b) * 64 + lane) * 4) = acc[a][b];
        __syncthreads();
#pragma unroll
        for (int i = 0; i < 6; ++i) { const int e = tid_ + 256 * i, f = e >> 8, ln = (e & 255) >> 2, j = e & 3;
            const float sm = (part[((0 * 6 + f) * 64 + ln) * 4 + j] + part[((1 * 6 + f) * 64 + ln) * 4 + j]) + (part[((2 * 6 + f) * 64 + ln) * 4 + j] + part[((3 * 6 + f) * 64 + ln) * 4 + j]);
            lgt[((f / 3) * 16 + (ln >> 4) * 4 + j) * 48 + (f % 3) * 16 + (ln & 15)] = sm; }
        __syncthreads();
        if (tid_ < 32) {
            const int m = rg * 32 + tid_; const float* lg = lgt + tid_ * 48;
            float gl[4], el[32];
#pragma unroll
            for (int g = 0; g < 4; ++g) gl[g] = lg[g] + p.b_rg[l * 4 + g];
#pragma unroll
            for (int e = 0; e < 32; ++e) el[e] = lg[4 + e] + p.b_re[l * 32 + e];
            int gs = 0; float gm = gl[0];
#pragma unroll
            for (int g = 1; g < 4; ++g) if (gl[g] > gm) { gm = gl[g]; gs = g; }
            float den = 0.f;
#pragma unroll
            for (int g = 0; g < 4; ++g) den += expf(gl[g] - gm);
            const float pg = 1.0f / den;
            float v1 = -3e38f, v2 = -3e38f; int i1 = 0, i2 = 0;
#pragma unroll
            for (int j = 0; j < 8; ++j) {
                const float vv = gs == 0 ? el[j] : gs == 1 ? el[8 + j] : gs == 2 ? el[16 + j] : el[24 + j];
                if (vv > v1) { v2 = v1; i2 = i1; v1 = vv; i1 = j; } else if (vv > v2) { v2 = vv; i2 = j; }
            }
            const float e2 = expf(v2 - v1), w1 = pg / (1.0f + e2), w2 = pg * e2 / (1.0f + e2);
            const int ea = gs * 8 + i1, eb = gs * 8 + i2;
            p.rE[2 * m] = ea; p.rE[2 * m + 1] = eb; p.rW[2 * m] = w1; p.rW[2 * m + 1] = w2;
            eids[2 * tid_] = ea; eids[2 * tid_ + 1] = eb;
        }
        __syncthreads();
        if (tid_ < 64) { const int e = eids[tid_]; int rk = 0; for (int j = 0; j < tid_; ++j) rk += (eids[j] == e) ? 1 : 0; p.rPos[2 * (rg * 32) + tid_] = rk; }
        else if (tid_ < 96) { const int e = tid_ - 64; int c = 0; for (int j = 0; j < 64; ++j) c += (eids[j] == e) ? 1 : 0; p.hist[rg * 32 + e] = c; }
        __syncthreads();
    }
}

__device__ __forceinline__ void ph_dispatch_fast(const Params& p, int l, int nrows, char* lds) {
    const int tid_ = opq_tid(), bid_ = opq_bid(); (void)tid_; (void)bid_;
    const int nrg = nrows / 32, e = tid_ & 31, part = tid_ >> 5;
    int* tot = (int*)lds; int* pst = tot + 32; int* pre = pst + 32; int* red = pre + 32;
    { int s = 0; for (int b = part; b < nrg; b += 8) s += p.hist[b * 32 + e]; red[part * 32 + e] = s; }
    __syncthreads();
    if (tid_ < 32) { int s = 0; for (int q = 0; q < 8; ++q) s += red[q * 32 + tid_]; tot[tid_] = s; }
    __syncthreads();
    if (tid_ < 32) { int s = 0; for (int j = 0; j < tid_; ++j) s += (tot[j] + 127) & ~127; pst[tid_] = s; if (bid_ == 0) p.cnt[l * NEXP + tid_] = tot[tid_]; }
    for (int rg = bid_; rg < nrg; rg += gridDim.x) {
        __syncthreads();
        { int s = 0; for (int b = part; b < rg; b += 8) s += p.hist[b * 32 + e]; red[part * 32 + e] = s; }
        __syncthreads();
        if (tid_ < 32) { int s = 0; for (int q = 0; q < 8; ++q) s += red[q * 32 + tid_]; pre[tid_] = s; }
        __syncthreads();
        if (tid_ < 64) { const int i = 2 * (rg * 32) + tid_, ee = p.rE[i], slot = pst[ee] + pre[ee] + p.rPos[i]; p.rSlot[i] = slot; p.slotTok[slot] = i >> 1; }
    }
}

__device__ __forceinline__ void ph_final_fast(const Params& p, int l, int nrows, bool next_h) {
    const int tid_ = opq_tid(), bid_ = opq_bid(); (void)tid_; (void)bid_;
    const int lane = tid_ & 63, gw = bid_ * 4 + (tid_ >> 6), nw = gridDim.x * 4;
    constexpr int R = 2;
    const f32x4* g2 = (const f32x4*)(p.ln2_g + (size_t)l * D) + lane; const f32x4* b2 = (const f32x4*)(p.ln2_b + (size_t)l * D) + lane;
    for (int m0 = gw * R; m0 < nrows; m0 += nw * R) {
        f32x4 v[R][DV]; float mu[R], rstd[R];
#pragma unroll
        for (int r = 0; r < R; ++r) { const int m = m0 + r; const f32x4* x1 = (const f32x4*)((m < TL) ? p.out + (size_t)m * D : p.XC + (size_t)(m - TL) * D) + lane;
            const f32x4* md = (const f32x4*)modrow(p, l, m) + lane;
            const f32x4* ya = (const f32x4*)(p.YS + (size_t)p.rSlot[2 * m] * D) + lane; const f32x4* yb = (const f32x4*)(p.YS + (size_t)p.rSlot[2 * m + 1] * D) + lane;
            const float wa = p.rW[2 * m], wb = p.rW[2 * m + 1];
#pragma unroll
            for (int j = 0; j < DV; ++j) v[r][j] = x1[64 * j] * ALPHA + md[5 * (D / 4) + 64 * j] * (ya[64 * j] * wa + yb[64 * j] * wb); }
#pragma unroll
        for (int r = 0; r < R; ++r) row_stats(v[r], mu[r], rstd[r]);
#pragma unroll
        for (int r = 0; r < R; ++r) { const int m = m0 + r; f32x4* x1 = (f32x4*)((m < TL) ? p.out + (size_t)m * D : p.XC + (size_t)(m - TL) * D) + lane;
#pragma unroll
            for (int j = 0; j < DV; ++j) { v[r][j] = (v[r][j] - mu[r]) * rstd[r] * g2[64 * j] + b2[64 * j]; x1[64 * j] = v[r][j]; } }
        if (next_h) {
#pragma unroll
            for (int r = 0; r < R; ++r) row_stats(v[r], mu[r], rstd[r]);
#pragma unroll
            for (int r = 0; r < R; ++r) { const int m = m0 + r; const f32x4* mn = (const f32x4*)modrow(p, l + 1, m) + lane;
#pragma unroll
                for (int j = 0; j < DV; ++j) st_bf16x4(p.H + (size_t)m * D + 4 * (lane + 64 * j), (v[r][j] - mu[r]) * rstd[r] * (mn[D / 4 + 64 * j] + 1.0f) + mn[64 * j]); }
        }
    }
}

__device__ __forceinline__ void ph_mod_fast(const Params& p, char* lds) {
    const int tid_ = opq_tid(), bid_ = opq_bid(); (void)tid_; (void)bid_;
    constexpr int NR = NB + 1, NTASK = 2 * (6 * D / 64);
    if (bid_ >= NTASK) return;
    float* sc = (float*)lds;
    float* part = sc + NR * D;
    for (int i = tid_; i < NR * D; i += 256) { const int b = i / D, k = i % D; const float cv = b < NB ? p.c[(size_t)b * D + k] : p.c_ctx[k]; sc[i] = cv / (1.0f + __expf(-cv)); }
    __syncthreads();
    const int lane = tid_ & 63, wid = tid_ >> 6;
    for (int task = bid_; task < NTASK; task += gridDim.x) {
        const int ll = task / (6 * D / 64), col = 64 * (task % (6 * D / 64)) + lane;
        float acc[NR];
#pragma unroll
        for (int b = 0; b < NR; ++b) acc[b] = 0.f;
        const float* wp = p.w_mod + ((size_t)ll * D + wid * (D / 4)) * 6 * D + col;
#pragma unroll 16
        for (int k = 0; k < D / 4; ++k) { const float w = wp[(size_t)k * 6 * D];
#pragma unroll
            for (int b = 0; b < NR; ++b) acc[b] += sc[b * D + wid * (D / 4) + k] * w; }
#pragma unroll
        for (int b = 0; b < NR; ++b) part[(wid * NR + b) * 64 + lane] = acc[b];
        __syncthreads();
        for (int i = tid_; i < NR * 64; i += 256) { const int b = i / 64, cl = i % 64;
            p.mod[((size_t)ll * NR + b) * 6 * D + 64 * (task % (6 * D / 64)) + cl] = (part[(0 * NR + b) * 64 + cl] + part[(1 * NR + b) * 64 + cl]) + (part[(2 * NR + b) * 64 + cl] + part[(3 * NR + b) * 64 + cl]) + p.b_mod[(size_t)ll * 6 * D + 64 * (task % (6 * D / 64)) + cl]; }
        __syncthreads();
    }
}

template <bool SPLIT = false>
__device__ __forceinline__ void tr_item(const float* srcl, size_t ldw, bf16_t* dst, size_t ldd, float* scr, int lane) {
    float v[32];
#pragma unroll
    for (int i = 0; i < 32; ++i) v[i] = srcl ? srcl[(size_t)(2 * i + (lane >> 5)) * ldw] : 0.f;
#pragma unroll
    for (int i = 0; i < 32; ++i) scr[(2 * i + (lane >> 5)) * 33 + (lane & 31)] = v[i];
    LDS_WAIT();
    const int c = lane & 7;
#pragma unroll
    for (int j = 0; j < 4; ++j) { const int n = (lane >> 3) + 8 * j; const float* s = scr + (8 * c) * 33 + n;
        uint4 o; o.x = pk2(s[0], s[33]); o.y = pk2(s[2 * 33], s[3 * 33]); o.z = pk2(s[4 * 33], s[5 * 33]); o.w = pk2(s[6 * 33], s[7 * 33]);
        *(uint4*)(dst + (size_t)(SPLIT ? (n & 15) + 32 * (n >> 4) : n) * ldd + 8 * c) = o; }
    LDS_WAIT();
}
__device__ __forceinline__ void ph_prep_w_fast(const Params& p, int l, int part, char* lds) {
    const int tid_ = opq_tid(), bid_ = opq_bid(); (void)tid_; (void)bid_;
    const int lane = tid_ & 63, wid = tid_ >> 6, gw = bid_ * 4 + wid, nw = gridDim.x * 4;
    float* scr = (float*)(lds + wid * 8448);
    constexpr int I_IN = (D / 64) * (NINP / 32), I_OUT = (DMIX / 64) * (D / 32), I_GU1 = (D / 64) * (2 * DE / 32), I_D1 = (DE / 64) * (D / 32);
    constexpr int NITEMS = I_IN + I_OUT + NEXP * (I_GU1 + I_D1);
    const int it0 = part == 0 ? 0 : I_IN + I_OUT, it1 = part == 0 ? I_IN + I_OUT : NITEMS;
    for (int it = it0 + gw; it < it1; it += nw) {
        int r = it;
        if (r < I_IN) { const int kb = r / (NINP / 32), n0 = 32 * (r % (NINP / 32));
            const float* s = nullptr;
            if (n0 < N_IN) { const int oc = (n0 < ZA) ? n0 + A_IN : n0 - ZA; s = p.w_in + ((size_t)l * D + 64 * kb) * N_IN + oc + (lane & 31); }
            tr_item(s, N_IN, p.win_t + (size_t)n0 * D + 64 * kb, D, scr, lane); continue; }
        r -= I_IN;
        if (r < I_OUT) { const int kb = r / (D / 32), n0 = 32 * (r % (D / 32));
            tr_item(p.w_out + ((size_t)l * DMIX + 64 * kb) * D + n0 + (lane & 31), D, p.wout_t + (size_t)n0 * DMIX + 64 * kb, DMIX, scr, lane); continue; }
        r -= I_OUT;
        const int e = r / (I_GU1 + I_D1); r %= (I_GU1 + I_D1);
        if (r < I_GU1) { const int kb = r / (2 * DE / 32), q = r % (2 * DE / 32), up = q & 1, c0 = 32 * (q >> 1);
            const float* s = (up ? p.w_up : p.w_gate) + (((size_t)l * NEXP + e) * D + 64 * kb) * DE + c0 + (lane & 31);
            tr_item<true>(s, DE, p.wgu_t + ((size_t)e * 2 * DE + 2 * c0 + 16 * up) * D + 64 * kb, D, scr, lane); continue; }
        r -= I_GU1;
        { const int kb = r / (D / 32), n0 = 32 * (r % (D / 32));
            tr_item(p.w_down + (((size_t)l * NEXP + e) * DE + 64 * kb) * D + n0 + (lane & 31), D, p.wd_t + ((size_t)e * D + n0) * DE + 64 * kb, DE, scr, lane); }
    }
    if (part != 0) return;
    const long gt = (long)bid_ * blockDim.x + tid_, gs = (long)gridDim.x * blockDim.x;
    for (long i = gt; i < 2 * 256 * 64; i += gs) { const int k = (int)(i & 63), n = (int)((i >> 6) & 255), d = (int)(i >> 14);
        p.wupT[i] = f2bf(p.a_w_up[(((size_t)l * 2 + d) * 64 + k) * DA + n]); p.aupT[i] = f2bf(p.a_a_up[(((size_t)l * 2 + d) * 64 + k) * DA + n]); }
    for (long i = gt; i < 256 * 160; i += gs) { const int k = (int)(i % 160), n = (int)(i / 160); p.gupT[i] = f2bf(p.a_g_up[((size_t)l * 160 + k) * DA + n]); }
    for (long i = gt; i < (long)128 * D; i += gs) { const int n = (int)(i / D), k = (int)(i % D);
        const float w = n < 4 ? p.w_rg[((size_t)l * D + k) * 4 + n] : n < 36 ? p.w_re[((size_t)l * D + k) * 32 + n - 4] : 0.f;
        const bf16_t hb = f2bf(w); p.wrt[i] = hb; p.wrt[(size_t)128 * D + i] = f2bf(w - bf2f(hb)); }
}

__device__ __forceinline__ float tanh_fast(float x) { return 1.0f - 2.0f / (1.0f + __expf(2.0f * x)); }
__device__ __forceinline__ void ph_streams_s1(const Params& p, int l) {
    const int tid_ = opq_tid(), bid_ = opq_bid(); (void)tid_; (void)bid_;
    constexpr int NCH = A_IN / 8, NCHP = (NCH + 7) & ~7;
    const float* sh = p.a_shift + (size_t)l * 3 * A_IN;
    for (long it = (long)bid_ * 256 + tid_; it < (long)T * NCHP; it += (long)gridDim.x * 256) {
        const int m = (int)(it / NCHP), ch = (int)(it % NCHP), c0 = 8 * ch;
        const bool act = ch < NCH;
        int t, len;
        if (m < TL) { t = m % S; len = S; } else { t = (m - TL) % L; len = L; }
        float v[8];
#pragma unroll
        for (int e = 0; e < 8; ++e) v[e] = 0.f;
        if (act) {
            const bf16_t* z = p.Z + (size_t)m * ZP + ZA + c0;
            const bf16x8 zc = *(const bf16x8*)z;
            const f32x4 s1a = *(const f32x4*)(sh + A_IN + c0), s1b = *(const f32x4*)(sh + A_IN + c0 + 4);
#pragma unroll
            for (int e = 0; e < 8; ++e) v[e] = (e < 4 ? s1a[e] : s1b[e - 4]) * bf2f((bf16_t)zc[e]);
            if (t > 0) { const bf16x8 zp = *(const bf16x8*)(z - ZP); const f32x4 a = *(const f32x4*)(sh + c0), b = *(const f32x4*)(sh + c0 + 4);
#pragma unroll
                for (int e = 0; e < 8; ++e) v[e] += (e < 4 ? a[e] : b[e - 4]) * bf2f((bf16_t)zp[e]); }
            if (t < len - 1) { const bf16x8 zn = *(const bf16x8*)(z + ZP); const f32x4 a = *(const f32x4*)(sh + 2 * A_IN + c0), b = *(const f32x4*)(sh + 2 * A_IN + c0 + 4);
#pragma unroll
                for (int e = 0; e < 8; ++e) v[e] += (e < 4 ? a[e] : b[e - 4]) * bf2f((bf16_t)zn[e]); }
        }
        float nrm = 0.f;
        if (ch >= 32 && ch < 64) {
#pragma unroll
            for (int e = 0; e < 8; ++e) { const float t2 = v[e] * p.a_k_k[l * DA + c0 - 256 + e]; nrm += t2 * t2; } }
        nrm = sum8(nrm);
        if (!act) continue;
        if (c0 < 768) {
            float* dst = (c0 < 256 ? p.sR + (size_t)m * DA + c0 : c0 < 512 ? p.kT + (size_t)m * DA + c0 - 256 : p.sV + (size_t)m * DA + c0 - 512);
            *(f32x4*)dst = (f32x4){v[0], v[1], v[2], v[3]}; *(f32x4*)(dst + 4) = (f32x4){v[4], v[5], v[6], v[7]};
            if (ch >= 32 && ch < 64 && (ch & 7) == 0) p.kN[(size_t)m * 4 + ((ch - 32) >> 3)] = 1.0f / sqrtf(nrm + 1e-12f);
        } else {
            if (c0 < 896) {
#pragma unroll
                for (int e = 0; e < 8; ++e) v[e] = tanh_fast(v[e]); }
            else if (c0 >= 1024) {
#pragma unroll
                for (int e = 0; e < 8; ++e) v[e] = 1.0f / (1.0f + __expf(-v[e])); }
            uint4 o; o.x = pk2(v[0], v[1]); o.y = pk2(v[2], v[3]); o.z = pk2(v[4], v[5]); o.w = pk2(v[6], v[7]);
            *(uint4*)(p.LA + (size_t)m * 416 + c0 - 768) = o;
        }
    }
}
__device__ __forceinline__ void g_streams_s2(const Params& p, int l, char* lds) {
    const int tid_ = opq_tid(), bid_ = opq_bid(); (void)tid_; (void)bid_;
    constexpr int MT = T / 128;
    for (int job = bid_; job < 5 * MT * 2; job += gridDim.x) {
        const int type = job / (MT * 2), r = job % (MT * 2), tm = r >> 1, tn = r & 1;
        const int coff = type < 2 ? type * 64 : type < 4 ? 128 + (type - 2) * 64 : 256, K = type < 4 ? 64 : 160, d = type & 1;
        const bf16_t* Bt = type < 2 ? p.wupT + type * 256 * 64 : type < 4 ? p.aupT + (type - 2) * 256 * 64 : p.gupT;
        const bf16_t* a0 = p.LA + (size_t)(tm * 128 + STG_ROW(0)) * 416 + coff + STG_K; const bf16_t* a1 = p.LA + (size_t)(tm * 128 + STG_ROW(1)) * 416 + coff + STG_K;
        const bf16_t* b0 = Bt + (size_t)(tn * 128 + STG_ROW(0)) * K + STG_K; const bf16_t* b1 = Bt + (size_t)(tn * 128 + STG_ROW(1)) * K + STG_K;
        if (type < 2) gemm_tile(a0, a1, b0, b1, K, lds, [&](const f32x4 (&acc)[4][4], int wr, int wc, int fr, int fq) {
#pragma unroll
            for (int mi = 0; mi < 4; ++mi) {
#pragma unroll
                for (int n = 0; n < 4; ++n) { const int c = tn * 128 + wc * 64 + n * 16 + fr; const float w0 = p.a_w0[(l * 2 + d) * DA + c];
#pragma unroll
                    for (int j = 0; j < 4; ++j) { const int row = tm * 128 + wr * 64 + mi * 16 + fq * 4 + j;
                        const float e = __expf(-(w0 + acc[mi][n][j]));
                        p.sW[((size_t)d * T + row) * DA + c] = __expf(-0.60653065971f / (1.0f + e)); } }
                asm volatile("" ::: "memory"); }
        });
        else if (type < 4) gemm_tile(a0, a1, b0, b1, K, lds, [&](const f32x4 (&acc)[4][4], int wr, int wc, int fr, int fq) {
#pragma unroll
            for (int mi = 0; mi < 4; ++mi) {
#pragma unroll
                for (int n = 0; n < 4; ++n) { const int c = tn * 128 + wc * 64 + n * 16 + fr;
                    const float a0v = p.a_a0[(l * 2 + d) * DA + c], kkc = p.a_k_k[l * DA + c], kac = p.a_k_a[l * DA + c];
#pragma unroll
                    for (int j = 0; j < 4; ++j) { const int row = tm * 128 + wr * 64 + mi * 16 + fq * 4 + j;
                        const size_t o = (size_t)row * DA + c, od = ((size_t)d * T + row) * DA + c;
                        const float av = 1.0f / (1.0f + __expf(-(a0v + acc[mi][n][j]))); const float k = p.kT[o];
                        const float kk = k * kkc * p.kN[(size_t)row * 4 + (c >> 6)];
                        p.sKD[od] = k * (1.0f + (av - 1.0f) * kac); p.sB[od] = kk * av; if (d == 0) p.sKK[o] = kk; } }
                asm volatile("" ::: "memory"); }
        });
        else gemm_tile(a0, a1, b0, b1, K, lds, [&](const f32x4 (&acc)[4][4], int wr, int wc, int fr, int fq) {
#pragma unroll
            for (int mi = 0; mi < 4; ++mi)
#pragma unroll
                for (int n = 0; n < 4; ++n) { const int c = tn * 128 + wc * 64 + n * 16 + fr;
#pragma unroll
                    for (int j = 0; j < 4; ++j) p.sG[(size_t)(tm * 128 + wr * 64 + mi * 16 + fq * 4 + j) * DA + c] = acc[mi][n][j]; }
        });
    }
}


typedef float f32x16 __attribute__((ext_vector_type(16)));
typedef short s16x4 __attribute__((ext_vector_type(4)));
typedef unsigned u32x4_t __attribute__((ext_vector_type(4)));
typedef float f32x2_t __attribute__((ext_vector_type(2)));
typedef __bf16 bf16x2_t __attribute__((ext_vector_type(2)));
__device__ __forceinline__ unsigned cvtpk(float lo, float hi) { f32x2_t v = {lo, hi}; bf16x2_t b = __builtin_convertvector(v, bf16x2_t); return __builtin_bit_cast(unsigned, b); }
__device__ __forceinline__ int crow(int r, int hi) { return (r & 3) + 8 * (r >> 2) + 4 * hi; }
__device__ __forceinline__ float xmax32(float v) { float a = v, b = v; asm volatile("s_nop 1\n\tv_permlane32_swap_b32 %0, %1" : "+v"(a), "+v"(b)); return fmaxf(a, b); }
__device__ __forceinline__ float xsum32(float v) { float a = v, b = v; asm volatile("s_nop 1\n\tv_permlane32_swap_b32 %0, %1" : "+v"(a), "+v"(b)); return a + b; }

template <class MaskF>
__device__ __forceinline__ void attn_tile(const bf16x8 (&qf)[4], const bf16_t* krow, const bf16_t* vt0, const bf16_t* vt1, const MaskF& mask,
                                          float& m_run, float& l_run, f32x16& o0, f32x16& o1, int hi) {
    f32x16 s;
#pragma unroll
    for (int r = 0; r < 16; ++r) s[r] = 0.f;
#pragma unroll
    for (int ks = 0; ks < 4; ++ks) { const bf16x8 kf = *(const bf16x8*)(krow + 16 * ks); s = __builtin_amdgcn_mfma_f32_32x32x16_bf16(kf, qf[ks], s, 0, 0, 0); }
    float mx = -INFINITY;
#pragma unroll
    for (int r = 0; r < 16; ++r) { s[r] = mask(crow(r, hi), s[r] * ATT_SCALE); mx = fmaxf(mx, s[r]); }
    mx = xmax32(mx);
    const float mn = fmaxf(m_run, mx), alpha = __expf(m_run - mn);
    m_run = mn;
    float ps = 0.f;
#pragma unroll
    for (int r = 0; r < 16; ++r) { s[r] = __expf(s[r] - mn); ps += s[r]; }
    l_run = l_run * alpha + ps;
#pragma unroll
    for (int r = 0; r < 16; ++r) { o0[r] *= alpha; o1[r] *= alpha; }
#pragma unroll
    for (int s2 = 0; s2 < 2; ++s2) {
        u32x4_t pw; pw[0] = cvtpk(s[8 * s2], s[8 * s2 + 1]); pw[1] = cvtpk(s[8 * s2 + 2], s[8 * s2 + 3]); pw[2] = cvtpk(s[8 * s2 + 4], s[8 * s2 + 5]); pw[3] = cvtpk(s[8 * s2 + 6], s[8 * s2 + 7]);
        const bf16x8 pb = __builtin_bit_cast(bf16x8, pw);
        const s16x4 a0 = *(const s16x4*)(vt0 + 16 * s2), a1 = *(const s16x4*)(vt0 + 16 * s2 + 8);
        const s16x4 c0 = *(const s16x4*)(vt1 + 16 * s2), c1 = *(const s16x4*)(vt1 + 16 * s2 + 8);
        o0 = __builtin_amdgcn_mfma_f32_32x32x16_bf16(__builtin_shufflevector(a0, a1, 0, 1, 2, 3, 4, 5, 6, 7), pb, o0, 0, 0, 0);
        o1 = __builtin_amdgcn_mfma_f32_32x32x16_bf16(__builtin_shufflevector(c0, c1, 0, 1, 2, 3, 4, 5, 6, 7), pb, o1, 0, 0, 0);
    }
}
struct NoMask { __device__ __forceinline__ float operator()(int, float v) const { return v; } };

__device__ __forceinline__ void ph_attn_mfma(const Params& p, int l, bool with_ctx) {
    const int tid_ = opq_tid(), bid_ = opq_bid(); (void)tid_; (void)bid_;
    const int lane = tid_ & 63, hi = lane >> 5, ql = lane & 31;
    const int gw = bid_ * 4 + (tid_ >> 6), nw = gridDim.x * 4;
    constexpr int NQT = S / 32, NCT = L / 32, N_LAT = NB * 6 * NQT, N_CTX = NB * 6 * NCT;
    const int ntask = 2 * N_LAT + (with_ctx ? 2 * N_CTX : 0);
    for (int task = gw; task < ntask; task += nw) {
        bool isC, isCtx; int r;
        if (task < N_LAT) { isC = true; isCtx = false; r = task; }
        else if (task < 2 * N_LAT) { isC = false; isCtx = false; r = task - N_LAT; }
        else { r = task - 2 * N_LAT; isCtx = true; isC = r >= N_CTX; if (isC) r -= N_CTX; }
        const int nqt = isCtx ? NCT : NQT, qt = r % nqt, h = (r / nqt) % 6, b = r / (nqt * 6);
        const int m = isCtx ? TL + b * L + 32 * qt + ql : b * S + 32 * qt + ql;
        const int qcol = isC ? ZQN + h * 64 : ZQB + h * 64, kcol = isC ? ZKN + h * 64 : ZKB + (h / 3) * 64, hv = isC ? 2 + h : h / 3;
        bf16x8 qf[4];
        { const bf16_t* qp = p.Z + (size_t)m * ZP + qcol + 8 * hi;
#pragma unroll
          for (int ks = 0; ks < 4; ++ks) qf[ks] = *(const bf16x8*)(qp + 16 * ks); }
        const bf16_t* kc0 = p.Z + (size_t)(TL + b * L + ql) * ZP + kcol + 8 * hi;
        const bf16_t* kl0 = p.Z + (size_t)(b * S + ql) * ZP + kcol + 8 * hi;
        const bf16_t* vt0 = p.VT + ((size_t)(b * 8 + hv) * 64 + ql) * PU + 4 * hi; const bf16_t* vt1 = vt0 + (size_t)32 * PU;
        f32x16 o0, o1;
#pragma unroll
        for (int rr = 0; rr < 16; ++rr) { o0[rr] = 0.f; o1[rr] = 0.f; }
        float m_run, l_run;
        if (isC) { m_run = -1e30f; l_run = 0.f; } else { m_run = p.b_sink[l * 6 + h]; l_run = hi == 0 ? 1.0f : 0.f; }
#pragma unroll 1
        for (int i = 0; i < NCT; ++i) attn_tile(qf, kc0 + (size_t)(32 * i) * ZP, vt0 + 32 * i, vt1 + 32 * i, NoMask(), m_run, l_run, o0, o1, hi);
        if (!isCtx) {
            if (!isC) {
#pragma unroll 1
                for (int jt = qt - 4; jt <= qt + 4; ++jt) {
                    if (jt < 0 || jt >= NQT) continue;
                    const bf16_t* kr = kl0 + (size_t)(32 * jt) * ZP; const bf16_t* v0 = vt0 + L + 32 * jt; const bf16_t* v1 = vt1 + L + 32 * jt;
                    if (jt == qt - 4 || jt == qt + 4) { const int base = 32 * (jt - qt) - ql;
                        attn_tile(qf, kr, v0, v1, [&](int ko, float v) { const int rel = base + ko; return (rel >= -128 && rel <= 128) ? v : -INFINITY; }, m_run, l_run, o0, o1, hi); }
                    else attn_tile(qf, kr, v0, v1, NoMask(), m_run, l_run, o0, o1, hi);
                }
            } else {
                constexpr int ROWS = S / GRID_W;
                const int gr = qt >> 1, c = 32 * (qt & 1) + ql;
                int r0 = gr - 4; r0 = r0 < 0 ? 0 : (r0 > ROWS - 8 ? ROWS - 8 : r0);
                int c0 = c - 8; c0 = c0 < 0 ? 0 : (c0 > GRID_W - 16 ? GRID_W - 16 : c0);
                const float* rpb = p.c_rpb + ((size_t)l * 6 + h) * 15 * 31;
#pragma unroll 1
                for (int a = 0; a < 8; ++a) {
                    const int kr_ = r0 + a; const float* rp = rpb + (kr_ - gr + 7) * 31 + 15 - c;
#pragma unroll 1
                    for (int ct = 0; ct < 2; ++ct) {
                        const int t0 = kr_ * GRID_W + 32 * ct;
                        attn_tile(qf, kl0 + (size_t)t0 * ZP, vt0 + L + t0, vt1 + L + t0,
                                  [&](int ko, float v) { const int kc = 32 * ct + ko; return (kc >= c0 && kc < c0 + 16) ? v + rp[kc] : -INFINITY; }, m_run, l_run, o0, o1, hi);
                    }
                }
            }
        }
        const float lt = xsum32(l_run), inv = 1.0f / lt;
        bf16_t* op = p.MIX + (size_t)m * DMIX + (isC ? 640 : 256) + h * 64 + 4 * hi;
#pragma unroll
        for (int g = 0; g < 4; ++g) {
            st_bf16x4(op + 8 * g, (f32x4){o0[4 * g] * inv, o0[4 * g + 1] * inv, o0[4 * g + 2] * inv, o0[4 * g + 3] * inv});
            st_bf16x4(op + 32 + 8 * g, (f32x4){o1[4 * g] * inv, o1[4 * g + 1] * inv, o1[4 * g + 2] * inv, o1[4 * g + 3] * inv});
        }
    }
}


template <class MaskF>
__device__ __forceinline__ void attn_tile_lds(const bf16x8 (&qf)[4], const char* ks, const char* vs, const MaskF& mask, float& m_run, float& l_run, f32x16& o0, f32x16& o1, int ql, int hi) {
    f32x16 s;
#pragma unroll
    for (int r = 0; r < 16; ++r) s[r] = 0.f;
#pragma unroll
    for (int k4 = 0; k4 < 4; ++k4) { const bf16x8 kf = *(const bf16x8*)(ks + ql * 128 + (((2 * k4 + hi) ^ (ql & 7)) * 16)); s = __builtin_amdgcn_mfma_f32_32x32x16_bf16(kf, qf[k4], s, 0, 0, 0); }
    float mx = -INFINITY;
#pragma unroll
    for (int r = 0; r < 16; ++r) { s[r] = mask(crow(r, hi), s[r] * ATT_SCALE); mx = fmaxf(mx, s[r]); }
    mx = xmax32(mx);
    const float mn = fmaxf(m_run, mx), alpha = __expf(m_run - mn);
    m_run = mn;
    float ps = 0.f;
#pragma unroll
    for (int r = 0; r < 16; ++r) { s[r] = __expf(s[r] - mn); ps += s[r]; }
    l_run = l_run * alpha + ps;
#pragma unroll
    for (int r = 0; r < 16; ++r) { o0[r] *= alpha; o1[r] *= alpha; }
    const int sw0 = (ql >> 2) & 3;
#pragma unroll
    for (int s2 = 0; s2 < 2; ++s2) {
        u32x4_t pw; pw[0] = cvtpk(s[8 * s2], s[8 * s2 + 1]); pw[1] = cvtpk(s[8 * s2 + 2], s[8 * s2 + 3]); pw[2] = cvtpk(s[8 * s2 + 4], s[8 * s2 + 5]); pw[3] = cvtpk(s[8 * s2 + 6], s[8 * s2 + 7]);
        const bf16x8 pb = __builtin_bit_cast(bf16x8, pw);
        const char* v0 = vs + ql * 64 + 8 * hi; const char* v1 = v0 + 32 * 64;
        const s16x4 a0 = *(const s16x4*)(v0 + (((2 * s2) ^ sw0) * 16)), a1 = *(const s16x4*)(v0 + (((2 * s2 + 1) ^ sw0) * 16));
        const s16x4 c0 = *(const s16x4*)(v1 + (((2 * s2) ^ sw0) * 16)), c1 = *(const s16x4*)(v1 + (((2 * s2 + 1) ^ sw0) * 16));
        o0 = __builtin_amdgcn_mfma_f32_32x32x16_bf16(__builtin_shufflevector(a0, a1, 0, 1, 2, 3, 4, 5, 6, 7), pb, o0, 0, 0, 0);
        o1 = __builtin_amdgcn_mfma_f32_32x32x16_bf16(__builtin_shufflevector(c0, c1, 0, 1, 2, 3, 4, 5, 6, 7), pb, o1, 0, 0, 0);
    }
}

__device__ __forceinline__ void ph_attn_blk(const Params& p, int l, bool with_ctx, int first_blk, char* lds) {
    const int tid_ = opq_tid(), bid_ = opq_bid(); (void)tid_; (void)bid_;
    if (bid_ < first_blk) return;
    const int lane = tid_ & 63, hi = lane >> 5, ql = lane & 31, wid = tid_ >> 6;
    constexpr int NQG = S / 128, NCG = L / 128, ROWS = S / GRID_W, N_LAT = NB * 6 * NQG, N_CTX = NB * 6 * NCG, TPB = (S + L) / 32;
    const int ntask = 2 * N_LAT + (with_ctx ? 2 * N_CTX : 0);
    const int krow = tid_ >> 3, kch = (tid_ & 7) ^ (krow & 7), vrow = tid_ >> 2, vpc = (tid_ & 3) ^ ((vrow >> 2) & 3);
    for (int task = bid_ - first_blk; task < ntask; task += gridDim.x - first_blk) {
        bool isC, isCtx; int r;
        if (task < N_LAT) { isC = true; isCtx = false; r = task; }
        else if (task < 2 * N_LAT) { isC = false; isCtx = false; r = task - N_LAT; }
        else { r = task - 2 * N_LAT; isCtx = true; isC = r >= N_CTX; if (isC) r -= N_CTX; }
        const int ng = isCtx ? NCG : NQG, g = r % ng, h = (r / ng) % 6, b = r / (ng * 6);
        const int qt = 4 * g + wid;
        const int m = isCtx ? TL + b * L + 32 * qt + ql : b * S + 32 * qt + ql;
        const int qcol = isC ? ZQN + h * 64 : ZQB + h * 64, kcol = isC ? ZKN + h * 64 : ZKB + (h / 3) * 64, hv = isC ? 2 + h : h / 3;
        bf16x8 qf[4];
        { const bf16_t* qp = p.Z + (size_t)m * ZP + qcol + 8 * hi;
#pragma unroll
          for (int k4 = 0; k4 < 4; ++k4) qf[k4] = *(const bf16x8*)(qp + 16 * k4); }
        int lo = 0, hi_t = 0, gr0 = 0;
        if (!isCtx) {
            if (!isC) { lo = 4 * g - 4; hi_t = 4 * g + 8; lo = lo < 0 ? 0 : lo; hi_t = hi_t > S / 32 ? S / 32 : hi_t; }
            else { const int ra = 2 * g, rb = 2 * g + 1; int r0a = ra - 4; r0a = r0a < 0 ? 0 : (r0a > ROWS - 8 ? ROWS - 8 : r0a); int r0b = rb - 4; r0b = r0b < 0 ? 0 : (r0b > ROWS - 8 ? ROWS - 8 : r0b);
                   lo = 2 * r0a; hi_t = 2 * (r0b + 8); gr0 = 0; }
        }
        const int ntile = L / 32 + (hi_t - lo);
        const bf16_t* kbase = p.Z + (size_t)krow * ZP + kcol + 8 * kch;
        const bf16_t* vbase = p.VT + ((size_t)(b * 8 + hv) * 64 + vrow) * PU + 8 * vpc;
#define AT_TOK(i_) ((i_) < L / 32 ? 32 * (i_) : L + 32 * (lo + (i_) - L / 32))
#define AT_STAGE(i_) do { const int u0_ = AT_TOK(i_); const int zrow_ = u0_ < L ? TL + b * L + u0_ : b * S + (u0_ - L); char* sl_ = lds + ((i_) % 3) * 8192 + tid_ * 16; \
            __builtin_amdgcn_global_load_lds((const unsigned*)(kbase + (size_t)zrow_ * ZP), (__attribute__((address_space(3))) unsigned*)(sl_), 16, 0, 0); \
            __builtin_amdgcn_global_load_lds((const unsigned*)(vbase + u0_), (__attribute__((address_space(3))) unsigned*)(sl_ + 4096), 16, 0, 0); } while (0)
        f32x16 o0, o1;
#pragma unroll
        for (int rr = 0; rr < 16; ++rr) { o0[rr] = 0.f; o1[rr] = 0.f; }
        float m_run, l_run;
        if (isC) { m_run = -1e30f; l_run = 0.f; } else { m_run = p.b_sink[l * 6 + h]; l_run = hi == 0 ? 1.0f : 0.f; }
        const int gr = qt >> 1, c = 32 * (qt & 1) + ql;
        int r0 = gr - 4; r0 = r0 < 0 ? 0 : (r0 > ROWS - 8 ? ROWS - 8 : r0);
        int c0 = c - 8; c0 = c0 < 0 ? 0 : (c0 > GRID_W - 16 ? GRID_W - 16 : c0);
        float* rpb = (float*)(lds + 24576);
        if (isC && !isCtx) for (int i = tid_; i < 15 * 31; i += 256) rpb[i] = p.c_rpb[((size_t)l * 6 + h) * 15 * 31 + i];
        AT_STAGE(0);
        if (ntile > 1) AT_STAGE(1);
#pragma unroll 1
        for (int i = 0; i < ntile; ++i) {
            if (i + 1 < ntile) asm volatile("s_waitcnt vmcnt(2)" ::: "memory"); else asm volatile("s_waitcnt vmcnt(0)" ::: "memory");
            asm volatile("s_waitcnt lgkmcnt(0)" ::: "memory");
            __builtin_amdgcn_s_barrier();
            if (i + 2 < ntile) AT_STAGE(i + 2);
            const char* ks = lds + (i % 3) * 8192; const char* vs = ks + 4096;
            if (i < L / 32) attn_tile_lds(qf, ks, vs, NoMask(), m_run, l_run, o0, o1, ql, hi);
            else {
                const int jt = lo + i - L / 32;
                if (!isC) {
                    const int dq = jt - qt;
                    if (dq >= -3 && dq <= 3) attn_tile_lds(qf, ks, vs, NoMask(), m_run, l_run, o0, o1, ql, hi);
                    else if (dq == -4 || dq == 4) { const int base = 32 * dq - ql;
                        attn_tile_lds(qf, ks, vs, [&](int ko, float v) { const int rel = base + ko; return (rel >= -128 && rel <= 128) ? v : -INFINITY; }, m_run, l_run, o0, o1, ql, hi); }
                } else {
                    const int kr_ = jt >> 1, ct = jt & 1;
                    if (kr_ >= r0 && kr_ < r0 + 8) { const float* rp = rpb + (kr_ - gr + 7) * 31 + 15 - c;
                        attn_tile_lds(qf, ks, vs, [&](int ko, float v) { const int kc = 32 * ct + ko; return (kc >= c0 && kc < c0 + 16) ? v + rp[kc] : -INFINITY; }, m_run, l_run, o0, o1, ql, hi); }
                }
            }
        }
        asm volatile("s_waitcnt lgkmcnt(0)" ::: "memory");
        __builtin_amdgcn_s_barrier();
#undef AT_STAGE
#undef AT_TOK
        (void)gr0;
        const float lt = xsum32(l_run), inv = 1.0f / lt;
        bf16_t* op = p.MIX + (size_t)m * DMIX + (isC ? 640 : 256) + h * 64 + 4 * hi;
#pragma unroll
        for (int gq = 0; gq < 4; ++gq) {
            st_bf16x4(op + 8 * gq, (f32x4){o0[4 * gq] * inv, o0[4 * gq + 1] * inv, o0[4 * gq + 2] * inv, o0[4 * gq + 3] * inv});
            st_bf16x4(op + 32 + 8 * gq, (f32x4){o1[4 * gq] * inv, o1[4 * gq + 1] * inv, o1[4 * gq + 2] * inv, o1[4 * gq + 3] * inv});
        }
    }
}

#define RNB " row_newbcast:%c[n] row_mask:0xf bank_mask:0xf\n\t"
template <int N, bool FIRST>
__device__ __forceinline__ void dpp_dot4(float& a0, float& a1, float& a2, float& a3, const f32x4& v, float s0, float s1, float s2, float s3) {
    if (FIRST) asm volatile("s_nop 1");
    asm("v_fmac_f32_dpp %0, %4, %8" RNB "v_fmac_f32_dpp %1, %5, %9" RNB "v_fmac_f32_dpp %2, %6, %10" RNB "v_fmac_f32_dpp %3, %7, %11" RNB
        : "+v"(a0), "+v"(a1), "+v"(a2), "+v"(a3) : "v"(v[0]), "v"(v[1]), "v"(v[2]), "v"(v[3]), "v"(s0), "v"(s1), "v"(s2), "v"(s3), [n] "i"(N));
}
template <int N, bool FIRST>
__device__ __forceinline__ void dpp_upd4s(float& s0, float& s1, float& s2, float& s3, float& y0, float& y1, float& y2, float& y3,
                                          const f32x4& w, const f32x4& b, const f32x4& kd, const f32x4& r, float nsk, float vv) {
    if (FIRST) asm volatile("s_nop 1");
    asm("v_mul_f32_dpp %0, %8, %0" RNB "v_mul_f32_dpp %1, %9, %1" RNB "v_mul_f32_dpp %2, %10, %2" RNB "v_mul_f32_dpp %3, %11, %3" RNB
        "v_fmac_f32_dpp %0, %12, %24" RNB "v_fmac_f32_dpp %1, %13, %24" RNB "v_fmac_f32_dpp %2, %14, %24" RNB "v_fmac_f32_dpp %3, %15, %24" RNB
        "v_fmac_f32_dpp %0, %16, %25" RNB "v_fmac_f32_dpp %1, %17, %25" RNB "v_fmac_f32_dpp %2, %18, %25" RNB "v_fmac_f32_dpp %3, %19, %25" RNB
        "v_fmac_f32_dpp %4, %20, %0" RNB "v_fmac_f32_dpp %5, %21, %1" RNB "v_fmac_f32_dpp %6, %22, %2" RNB "v_fmac_f32_dpp %7, %23, %3" RNB
        : "+v"(s0), "+v"(s1), "+v"(s2), "+v"(s3), "+v"(y0), "+v"(y1), "+v"(y2), "+v"(y3)
        : "v"(w[0]), "v"(w[1]), "v"(w[2]), "v"(w[3]), "v"(b[0]), "v"(b[1]), "v"(b[2]), "v"(b[3]), "v"(kd[0]), "v"(kd[1]), "v"(kd[2]), "v"(kd[3]),
          "v"(r[0]), "v"(r[1]), "v"(r[2]), "v"(r[3]), "v"(nsk), "v"(vv), [n] "i"(N));
}
template <int N, bool FIRST>
__device__ __forceinline__ void dpp_upd4p(float& s0, float& s1, float& s2, float& s3, float& y0, float& y1, float& y2, float& y3,
                                          const f32x4& w, const f32x4& b, const f32x4& r, float nsk) {
    if (FIRST) asm volatile("s_nop 1");
    asm("v_mul_f32_dpp %0, %8, %0" RNB "v_mul_f32_dpp %1, %9, %1" RNB "v_mul_f32_dpp %2, %10, %2" RNB "v_mul_f32_dpp %3, %11, %3" RNB
        "v_fmac_f32_dpp %0, %12, %20" RNB "v_fmac_f32_dpp %1, %13, %20" RNB "v_fmac_f32_dpp %2, %14, %20" RNB "v_fmac_f32_dpp %3, %15, %20" RNB
        "v_fmac_f32_dpp %4, %16, %0" RNB "v_fmac_f32_dpp %5, %17, %1" RNB "v_fmac_f32_dpp %6, %18, %2" RNB "v_fmac_f32_dpp %7, %19, %3" RNB
        : "+v"(s0), "+v"(s1), "+v"(s2), "+v"(s3), "+v"(y0), "+v"(y1), "+v"(y2), "+v"(y3)
        : "v"(w[0]), "v"(w[1]), "v"(w[2]), "v"(w[3]), "v"(b[0]), "v"(b[1]), "v"(b[2]), "v"(b[3]), "v"(r[0]), "v"(r[1]), "v"(r[2]), "v"(r[3]), "v"(nsk), [n] "i"(N));
}
template <int N, bool FIRST>
__device__ __forceinline__ void dpp_mul4(float& s0, float& s1, float& s2, float& s3, const f32x4& v) {
    if (FIRST) asm volatile("s_nop 1");
    asm("v_mul_f32_dpp %0, %4, %0" RNB "v_mul_f32_dpp %1, %5, %1" RNB "v_mul_f32_dpp %2, %6, %2" RNB "v_mul_f32_dpp %3, %7, %3" RNB
        : "+v"(s0), "+v"(s1), "+v"(s2), "+v"(s3) : "v"(v[0]), "v"(v[1]), "v"(v[2]), "v"(v[3]), [n] "i"(N));
}
template <int N>
__device__ __forceinline__ void dpp_fmacx4(float& s0, float& s1, float& s2, float& s3, const f32x4& v, float x) {
    asm("v_fmac_f32_dpp %0, %4, %8" RNB "v_fmac_f32_dpp %1, %5, %8" RNB "v_fmac_f32_dpp %2, %6, %8" RNB "v_fmac_f32_dpp %3, %7, %8" RNB
        : "+v"(s0), "+v"(s1), "+v"(s2), "+v"(s3) : "v"(v[0]), "v"(v[1]), "v"(v[2]), "v"(v[3]), "v"(x), [n] "i"(N));
}
template <int N> struct ScanRep {
    static __device__ __forceinline__ void dot8(float (&a)[8], const f32x4& v, const float (&st)[64]) {
        constexpr int h = (N & 1) * 4;
        dpp_dot4<N, N == 0>(a[h], a[h + 1], a[h + 2], a[h + 3], v, st[4 * N], st[4 * N + 1], st[4 * N + 2], st[4 * N + 3]);
        if constexpr (N < 15) ScanRep<N + 1>::dot8(a, v, st);
    }
    static __device__ __forceinline__ void dot(float& a0, float& a1, float& a2, float& a3, const f32x4& v, const float (&st)[64]) {
        dpp_dot4<N, N == 0>(a0, a1, a2, a3, v, st[4 * N], st[4 * N + 1], st[4 * N + 2], st[4 * N + 3]);
        if constexpr (N < 15) ScanRep<N + 1>::dot(a0, a1, a2, a3, v, st);
    }
    static __device__ __forceinline__ void mul(float (&st)[64], const f32x4& w) {
        dpp_mul4<N, N == 0>(st[4 * N], st[4 * N + 1], st[4 * N + 2], st[4 * N + 3], w);
        if constexpr (N < 15) ScanRep<N + 1>::mul(st, w);
    }
    static __device__ __forceinline__ void fmacx(float (&st)[64], const f32x4& v, float x) {
        dpp_fmacx4<N>(st[4 * N], st[4 * N + 1], st[4 * N + 2], st[4 * N + 3], v, x);
        if constexpr (N < 15) ScanRep<N + 1>::fmacx(st, v, x);
    }
};
__device__ __forceinline__ int scan_row(int b, int d, int pos) { return pos < L ? TL + b * L + (d ? L - 1 - pos : pos) : b * S + (d ? S - 1 - (pos - L) : pos - L); }

template <bool ISP>
__device__ __forceinline__ void scan_task(const Params& p, int c, int s, int lane) {
    const int h = c & 3, b = (c >> 2) % NB, d = (c >> 2) / NB, pos0 = SEGLEN * s;
    const int q = 4 * (lane & 15);
    const float* bkk = p.sKK + h * 64 + q; const float* br = p.sR + h * 64 + q; const float* bw = p.sW + (size_t)d * T * DA + h * 64 + q; const float* bb_ = p.sB + (size_t)d * T * DA + h * 64 + q;
    const float* bkd = p.sKD + (size_t)d * T * DA + h * 64 + q; const float* bv = p.sV + h * 64 + lane;
    float* by = (ISP ? p.PV : p.Y) + (size_t)d * T * DA + h * 64 + lane;
    float st[64];
#pragma unroll
    for (int k = 0; k < 64; ++k) st[k] = (ISP && k == lane) ? 1.0f : 0.f;
    size_t mo = (size_t)scan_row(b, d, pos0) * DA;
    f32x4 kk = *(const f32x4*)(bkk + mo), w = *(const f32x4*)(bw + mo), bb = *(const f32x4*)(bb_ + mo), r = *(const f32x4*)(br + mo), kd = w; float vv = 0.f;
    if (!ISP) { kd = *(const f32x4*)(bkd + mo); vv = bv[mo]; }
#pragma unroll 1
    for (int i = 0; i < SEGLEN; ++i) {
        const size_t mn = (size_t)scan_row(b, d, pos0 + (i + 1 < SEGLEN ? i + 1 : i)) * DA;
        const f32x4 nkk = *(const f32x4*)(bkk + mn), nw = *(const f32x4*)(bw + mn), nb = *(const f32x4*)(bb_ + mn), nr = *(const f32x4*)(br + mn);
        f32x4 nkd = nw; float nv = 0.f;
        if (!ISP) { nkd = *(const f32x4*)(bkd + mn); nv = bv[mn]; }
        float a[8] = {0.f, 0.f, 0.f, 0.f, 0.f, 0.f, 0.f, 0.f};
        ScanRep<0>::dot8(a, kk, st);
        const float nsk = -(((a[0] + a[1]) + (a[2] + a[3])) + ((a[4] + a[5]) + (a[6] + a[7])));
        ScanRep<0>::mul(st, w);
        ScanRep<0>::fmacx(st, bb, nsk);
        if (!ISP) ScanRep<0>::fmacx(st, kd, vv);
        float y[8] = {0.f, 0.f, 0.f, 0.f, 0.f, 0.f, 0.f, 0.f};
        ScanRep<0>::dot8(y, r, st);
        by[mo] = ((y[0] + y[1]) + (y[2] + y[3])) + ((y[4] + y[5]) + (y[6] + y[7]));
        kk = nkk; w = nw; bb = nb; r = nr; kd = nkd; vv = nv; mo = mn;
    }
    if (s < NSG - 1) {
        float* dst = (ISP ? p.PS : p.QS) + (((size_t)c * NSG + s) * 64 + lane) * 64;
#pragma unroll
        for (int k4 = 0; k4 < 16; ++k4) *(f32x4*)(dst + 4 * k4) = (f32x4){st[4 * k4], st[4 * k4 + 1], st[4 * k4 + 2], st[4 * k4 + 3]};
    }
}
__device__ __forceinline__ void ph_scan_fast(const Params& p) {
    const int tid_ = opq_tid(), bid_ = opq_bid(); (void)tid_; (void)bid_;
    const int lane = tid_ & 63, gw = bid_ * 4 + (tid_ >> 6), nw = gridDim.x * 4;
    constexpr int NS_T = 64 * NSG, NP_T = 64 * (NSG - 1);
    const int G = gridDim.x, wv = tid_ >> 6; (void)gw; (void)nw;
    for (int tsk = wv * G + bid_; tsk < NS_T + NP_T; tsk += 4 * G) {
        const int t2 = __builtin_amdgcn_readfirstlane(tsk);
        if (t2 < NS_T) scan_task<false>(p, t2 & 63, t2 >> 6, lane);
        else scan_task<true>(p, (t2 - NS_T) & 63, 1 + ((t2 - NS_T) >> 6), lane);
    }
}
__device__ __forceinline__ void ph_combine(const Params& p, char* lds) {
    const int tid_ = opq_tid(), bid_ = opq_bid(); (void)tid_; (void)bid_; (void)lds;
    if (bid_ >= 64) return;
    const int lane = tid_ & 63, c = bid_, cb = tid_ >> 6, q = lane >> 4, i16 = lane & 15, v = 16 * cb + i16;
    const float* QSc = p.QS + (size_t)c * NSG * 4096; const float* PSc = p.PS + (size_t)c * NSG * 4096; float* SSg = p.SS + (size_t)c * NSG * 4096;
    f32x4 acc[4];
#pragma unroll
    for (int ro = 0; ro < 4; ++ro) acc[ro] = *(const f32x4*)(QSc + v * 64 + 16 * ro + 4 * q);
#pragma unroll 1
    for (int s = 1; s < NSG; ++s) {
#pragma unroll
        for (int ro = 0; ro < 4; ++ro)
#pragma unroll
            for (int j = 0; j < 4; ++j) SSg[(size_t)s * 4096 + (16 * ro + 4 * q + j) * 64 + v] = acc[ro][j];
        if (s == NSG - 1) break;
        const float* P = PSc + (size_t)s * 4096 + (4 * q) * 64 + i16;
        float a[4][4][4];
#pragma unroll
        for (int rb = 0; rb < 4; ++rb)
#pragma unroll
            for (int kk = 0; kk < 4; ++kk)
#pragma unroll
                for (int ro = 0; ro < 4; ++ro) a[rb][kk][ro] = P[(16 * rb + kk) * 64 + 16 * ro];
#pragma unroll
        for (int rb = 0; rb < 4; ++rb) asm volatile("" : "+v"(a[rb][0][0]), "+v"(a[rb][0][1]), "+v"(a[rb][0][2]), "+v"(a[rb][0][3]), "+v"(a[rb][1][0]), "+v"(a[rb][1][1]), "+v"(a[rb][1][2]), "+v"(a[rb][1][3]),
                                                         "+v"(a[rb][2][0]), "+v"(a[rb][2][1]), "+v"(a[rb][2][2]), "+v"(a[rb][2][3]), "+v"(a[rb][3][0]), "+v"(a[rb][3][1]), "+v"(a[rb][3][2]), "+v"(a[rb][3][3]));
        f32x4 nacc[4];
#pragma unroll
        for (int ro = 0; ro < 4; ++ro) nacc[ro] = *(const f32x4*)(QSc + (size_t)s * 4096 + v * 64 + 16 * ro + 4 * q);
#pragma unroll
        for (int rb = 0; rb < 4; ++rb)
#pragma unroll
            for (int kk = 0; kk < 4; ++kk)
#pragma unroll
                for (int ro = 0; ro < 4; ++ro) nacc[ro] = __builtin_amdgcn_mfma_f32_16x16x4f32(a[rb][kk][ro], acc[rb][kk], nacc[ro], 0, 0, 0);
#pragma unroll
        for (int ro = 0; ro < 4; ++ro) acc[ro] = nacc[ro];
    }
}
__device__ __forceinline__ void ph_rwkv_out_fast(const Params& p, int l, bool with_ctx) {
    const int tid_ = opq_tid(), bid_ = opq_bid(); (void)tid_; (void)bid_;
    const int lane = tid_ & 63, gw = bid_ * 4 + (tid_ >> 6), nw = gridDim.x * 4;
    constexpr int TOK = 16, NLT = NB * (S / TOK) * 4, NCTK = NB * (L / TOK) * 4;
    const int ntask = NLT + (with_ctx ? NCTK : 0);
    for (int tsk = gw; tsk < ntask; tsk += nw) {
        const bool isCtx = tsk >= NLT; const int r = isCtx ? tsk - NLT : tsk;
        const int h = r & 3, npt = isCtx ? L / TOK : S / TOK, tt = (r >> 2) % npt, b = (r >> 2) / npt;
        const int seg0 = (isCtx ? TOK * tt : L + TOK * tt) / SEGLEN, seg1 = (isCtx ? L - 1 - TOK * tt : L + S - 1 - TOK * tt) / SEGLEN;
        const int mbase = isCtx ? TL + b * L + TOK * tt : b * S + TOK * tt;
        float ss0[64], ss1[64];
        { const float* s0p = p.SS + (((size_t)(0 * NB + b) * 4 + h) * NSG + seg0) * 4096 + lane; const float* s1p = p.SS + (((size_t)(1 * NB + b) * 4 + h) * NSG + seg1) * 4096 + lane;
#pragma unroll
          for (int k = 0; k < 64; ++k) { ss0[k] = seg0 > 0 ? s0p[k * 64] : 0.f; ss1[k] = seg1 > 0 ? s1p[k * 64] : 0.f; } }
        const float rk = p.a_r_k[l * DA + h * 64 + lane], gln = p.a_lnx_g[l * DA + h * 64 + lane], bln = p.a_lnx_b[l * DA + h * 64 + lane];
        f32x4 pv0 = {0.f, 0.f, 0.f, 0.f}, pv1 = pv0; float y0l, y1l, rr, kds, vv, gg;
#define ROUT_LOAD(i_) do { const size_t o_ = (size_t)(mbase + (i_)) * DA + h * 64, o1_ = o_ + (size_t)T * DA; \
            if (seg0 > 0) pv0 = *(const f32x4*)(p.PV + o_ + 4 * (lane & 15)); if (seg1 > 0) pv1 = *(const f32x4*)(p.PV + o1_ + 4 * (lane & 15)); \
            y0l = p.Y[o_ + lane]; y1l = p.Y[o1_ + lane]; rr = p.sR[o_ + lane]; kds = p.sKD[o_ + lane] + p.sKD[o1_ + lane]; vv = p.sV[o_ + lane]; gg = p.sG[o_ + lane]; } while (0)
        ROUT_LOAD(0);
#pragma unroll 1
        for (int i = 0; i < TOK; ++i) {
            const f32x4 cpv0 = pv0, cpv1 = pv1; float a0 = y0l, a1 = y1l, a2 = 0.f, a3 = 0.f; const float crr = rr, ckds = kds, cvv = vv, cgg = gg;
            ROUT_LOAD(i + 1 < TOK ? i + 1 : i);
            ScanRep<0>::dot(a0, a1, a2, a3, cpv0, ss0);
            ScanRep<0>::dot(a0, a1, a2, a3, cpv1, ss1);
            const float y = (a0 + a1) + (a2 + a3);
            const float mu = wave_sum(y) * (1.0f / 64.f), dy = y - mu;
            const float rstd = 1.0f / sqrtf(wave_sum(dy * dy) * (1.0f / 64.f) + GN_EPS);
            const float bon = wave_sum(crr * ckds * rk);
            p.MIX[(size_t)(mbase + i) * DMIX + h * 64 + lane] = f2bf((dy * rstd * gln + bln + bon * cvv) * cgg);
        }
#undef ROUT_LOAD
    }
}


#define LAS __attribute__((address_space(3)))
#define XB_TMO      128
#define XB_XCNT(j)  (256  + 64 * (j))
#define XB_XSUB(j)  (1280 + 64 * (j))
#define XB_XGEN(j)  (2304 + 64 * (j))
#define XB_TOP      3328
#define XB_TOPGEN   3392
#define XCD_BAR_WORDS 3456
#define XB_SPIN_CAP (1u << 20)
static_assert(XCD_BAR_WORDS * 4 <= 16384, "barrier words fit the control region");
__device__ __forceinline__ unsigned xb_ld(unsigned* p)              { return __hip_atomic_load(p, __ATOMIC_RELAXED, __HIP_MEMORY_SCOPE_AGENT); }
__device__ __forceinline__ unsigned xb_add(unsigned* p, unsigned v) { return __hip_atomic_fetch_add(p, v, __ATOMIC_RELAXED, __HIP_MEMORY_SCOPE_AGENT); }
__device__ __forceinline__ unsigned xb_xcc_id() { return (unsigned)__builtin_amdgcn_s_getreg((3 << 11) | 20) & 0xFu; }
#define XB_SPIN(cond, bar) do { unsigned _sp = 0; while (cond) { __builtin_amdgcn_s_sleep(1); \
    if ((++_sp & 255u) == 0u) { if (xb_ld(&(bar)[XB_TMO])) break; if (_sp > XB_SPIN_CAP) { atomicAdd(&(bar)[XB_TMO], 1u); break; } } } } while (0)
struct XcdBarrier { unsigned* bar; unsigned x; volatile LAS unsigned* st; };
__device__ __forceinline__ XcdBarrier xcd_barrier_post(unsigned* bar, volatile LAS unsigned* st) {
    XcdBarrier b; b.bar = bar; b.x = xb_xcc_id(); b.st = st;
    if (threadIdx.x == 0) (void)xb_add(&bar[XB_XCNT(b.x)], 1u);
    return b;
}
__device__ __forceinline__ void xcd_barrier_complete(unsigned* bar, unsigned x, unsigned& nloc, unsigned& nx) {
    const unsigned G = gridDim.x * gridDim.y * gridDim.z;
    unsigned sum, cnt, mine, sp = 0u;
    for (;;) {
        sum = 0u; cnt = 0u; mine = 0u;
#pragma unroll
        for (unsigned j = 0; j < 16; ++j) { const unsigned c = xb_ld(&bar[XB_XCNT(j)]); sum += c; cnt += (c > 0u) ? 1u : 0u; mine = (j == x) ? c : mine; }
        if (sum == G) break;
        __builtin_amdgcn_s_sleep(1);
        if ((++sp & 255u) == 0u) { if (xb_ld(&bar[XB_TMO])) break; if (sp > XB_SPIN_CAP) { atomicAdd(&bar[XB_TMO], 1u); break; } }
    }
    nloc = mine > 0u ? mine : 1u; nx = cnt > 0u ? cnt : 1u;
}
__device__ __forceinline__ void xcd_barrier(const XcdBarrier& b) {
    asm volatile("s_waitcnt vmcnt(0)" ::: "memory");
    __syncthreads();
    if (threadIdx.x == 0) {
        unsigned* bar = b.bar;
        __builtin_amdgcn_s_waitcnt(0);
        unsigned nloc = b.st[0], nx = b.st[1];
        if (nloc == 0u) { xcd_barrier_complete(bar, b.x, nloc, nx); b.st[0] = nloc; b.st[1] = nx; }
        const unsigned old = xb_add(&bar[XB_XSUB(b.x)], 1u);
        const unsigned gen = old / nloc;
        if (old + 1u == (gen + 1u) * nloc) {
            __builtin_amdgcn_fence(__ATOMIC_RELEASE, "agent");
            asm volatile("s_waitcnt vmcnt(0)" ::: "memory");
            const unsigned og = xb_add(&bar[XB_TOP], 1u);
            const unsigned tg = og / nx;
            if (og + 1u == (tg + 1u) * nx) xb_add(&bar[XB_TOPGEN], 1u);
            else XB_SPIN(xb_ld(&bar[XB_TOPGEN]) == tg, bar);
            __builtin_amdgcn_fence(__ATOMIC_ACQUIRE, "agent");
            xb_add(&bar[XB_XGEN(b.x)], 1u);
            asm volatile("s_waitcnt vmcnt(0)" ::: "memory");
        } else {
            XB_SPIN(xb_ld(&bar[XB_XGEN(b.x)]) == gen, bar);
            __builtin_amdgcn_fence(__ATOMIC_ACQUIRE, "agent");
            asm volatile("s_waitcnt vmcnt(0)" ::: "memory");
        }
    }
    __syncthreads();
}

#define GT ((long)blockIdx.x * blockDim.x + threadIdx.x)
#define GS ((long)gridDim.x * blockDim.x)
__global__ void __launch_bounds__(256, 2) mega_fwd(Params p) {
    __shared__ __attribute__((aligned(16))) char lds[65536 + 64];
    cg::grid_group grid = cg::this_grid();
    const long gt = GT, gs = GS;
    volatile LAS unsigned* bst = (volatile LAS unsigned*)(LAS char*)(lds + 65536);
    if (threadIdx.x < 2) bst[threadIdx.x] = 0u;
    __syncthreads();
    const XcdBarrier xb = xcd_barrier_post(p.bar, bst);
#ifndef PROBE_PHASE
#define PROBE_PHASE -1
#endif
#define PROBE_AMP 8
    unsigned long long t_prev = 0; int nts = 0;
#define STAMP() do { if (PROBE_PHASE >= 0 && blockIdx.x == 0 && threadIdx.x == 0) { const unsigned long long t_now = __builtin_amdgcn_s_memrealtime(); \
        if (nts == PROBE_PHASE + 1) { const unsigned long long t_end = t_now + PROBE_AMP * (t_now - t_prev); while (__builtin_amdgcn_s_memrealtime() < t_end) __builtin_amdgcn_s_sleep(8); } \
        t_prev = __builtin_amdgcn_s_memrealtime(); } ++nts; } while (0)
#define GSYNC() do { xcd_barrier(xb); STAMP(); } while (0)
    STAMP();
    ph_mod_fast(p, lds); ph_prep_w_fast(p, 0, 0, lds); ph_prep_misc(p, 0, gt, gs, false);
    grid.sync(); STAMP();
    for (int l = 0; l < 2; ++l) {
        const int nrows = (l == 0) ? T : TL;
        if (l == 0) { ph_lnmod_fast(p, l); GSYNC(); }
        g_gemm_in(p, lds);
        GSYNC();
        ph_streams_s1(p, l);
        GSYNC();
        g_streams_s2(p, l, lds);
        GSYNC();
        ph_scan_fast(p);
        GSYNC();
        ph_combine(p, lds); ph_attn_blk(p, l, l == 0, 64, lds);
        GSYNC();
        ph_rwkv_out_fast(p, l, l == 0);
        GSYNC();
        if (blockIdx.x >= gridDim.x / 2) { ph_prep_w_fast(p, l, 1, lds); __syncthreads(); g_gemm_out(p, nrows, lds); } else { g_gemm_out(p, nrows, lds); ph_prep_w_fast(p, l, 1, lds); }
        GSYNC();
        g_router(p, l, nrows, lds);
        GSYNC();
        ph_dispatch_fast(p, l, nrows, lds);
        GSYNC();
        g_moe1(p, l, lds);
        GSYNC();
        g_moe2(p, l, lds);
        GSYNC();
        ph_final_fast(p, l, nrows, l == 0);
        if (l == 0) { ph_prep_w_fast(p, 1, 0, lds); ph_prep_misc(p, 1, gt, gs, false); }
        GSYNC();
    }}

extern "C" void kernel_launch(void* const* d_in, const int* in_sizes, int n_in, void* d_out, int out_size, void* d_ws, size_t ws_size, hipStream_t stream) {
    if (n_in != 32 || out_size != TL * D || ws_size < WS_NEED) { fprintf(stderr, "kernel_launch: unexpected shapes / workspace (n_in %d out %d ws %zu need %zu)\n", n_in, out_size, ws_size, (size_t)WS_NEED); return; }
    static int grid_blocks = 0;
    if (!grid_blocks) {
        int dev = 0, cus = 0, per_cu = 0;
        (void)hipGetDevice(&dev);
        (void)hipDeviceGetAttribute(&cus, hipDeviceAttributeMultiprocessorCount, dev);
        (void)hipOccupancyMaxActiveBlocksPerMultiprocessor(&per_cu, mega_fwd, 256, 0);
        if (per_cu < 1) per_cu = 1;
        if (per_cu > 2) per_cu = 2;
        grid_blocks = cus * per_cu;
        fprintf(stderr, "kernel_launch: %d CUs x %d blocks\n", cus, per_cu);
    }
    Params p = make_params(d_in, d_out, d_ws);
    (void)hipMemsetAsync(d_ws, 0, CTL_BYTES, stream);
    void* args[] = {&p};
    hipError_t e = hipLaunchCooperativeKernel((void*)mega_fwd, dim3(grid_blocks), dim3(256), args, 0, stream);
    if (e != hipSuccess) fprintf(stderr, "cooperative launch failed: %s (grid %d)\n", hipGetErrorString(e), grid_blocks);
}
#endif

#ifdef HOST_EMU
static void host_forward(void* const* d_in, void* d_out, void* d_ws) {
    const Params p = make_params(d_in, d_out, d_ws);
    for (int l = 0; l < 2; ++l) {
        const int nrows = (l == 0) ? T : TL;
        ph_prep_w(p, l, 0, 1); ph_prep_misc(p, l, 0, 1); ph_lnmod(p, l, 0, 1); host_gemm_in(p); ph_streams(p, l, 0, 1); ph_rope(p, 0, 1); ph_scan(p, 0, 1);
        ph_attn(p, l, nrows, 0, 1); ph_rwkv_out(p, l, nrows, 0, 1); host_gemm_out(p, nrows); ph_post_mixer(p, l, nrows, 0, 1);
        ph_dispatch(p, l, nrows, 0, 1); host_moe1(p, l); host_moe2(p, l); ph_final(p, l, nrows, 0, 1);
    }
}
#endif
```

```cpp
#ifdef HOST_EMU
#include <cmath>
#include <cstdio>
#include <cstring>
#include <cstdint>
#include <cstdlib>
#define __device__
#define __global__
#define __host__
#define __forceinline__ inline
#else
#include <hip/hip_runtime.h>
#include <hip/hip_cooperative_groups.h>
#include <cstdio>
#include <cstdint>
namespace cg = cooperative_groups;
#endif

#ifndef CFG_D
#define CFG_D 1024
#define CFG_B 8
#define CFG_S 2048
#define CFG_L 256
#define CFG_DE 512
#endif
constexpr int D = CFG_D, NB = CFG_B, S = CFG_S, L = CFG_L, DE = CFG_DE;
constexpr int TL = NB * S, TC = NB * L, T = TL + TC;
constexpr int GRID_W = 64, HD = 64;
constexpr int DA = 256, A_IN = 1184, N_IN = 2976, NINP = 3072, DMIX = 1024;
constexpr int NEXP = 32, NSLOT = 2 * T + NEXP * 128;
constexpr int ZQB = 0, ZKB = 384, ZVB = 512, ZQN = 640, ZKN = 1024, ZVN = 1408, ZA = 1792, ZP = 2976;
constexpr float LN_EPS = 1e-6f, GN_EPS = 64e-5f, ATT_SCALE = 0.125f;
constexpr float ALPHA = 1.41421356237309515f;

typedef unsigned short bf16_t;

__device__ __forceinline__ float bf2f(bf16_t v) {
    unsigned u = ((unsigned)v) << 16; float f;
#ifdef HOST_EMU
    memcpy(&f, &u, 4);
#else
    f = __uint_as_float(u);
#endif
    return f;
}
__device__ __forceinline__ bf16_t f2bf(float f) {
    unsigned u;
#ifdef HOST_EMU
    memcpy(&u, &f, 4);
#else
    u = __float_as_uint(f);
#endif
    return (bf16_t)((u + 0x7fffu + ((u >> 16) & 1u)) >> 16);
}
__device__ __forceinline__ float sigmoidf_(float x) { return 1.0f / (1.0f + expf(-x)); }
__device__ __forceinline__ float siluf_(float x) { return x / (1.0f + expf(-x)); }
__device__ __forceinline__ int atomic_inc_int(int* p) {
#ifdef HOST_EMU
    int o = *p; *p = o + 1; return o;
#else
    return atomicAdd(p, 1);
#endif
}

struct Params {
    const float *x, *c, *ctx, *c_ctx, *w_mod, *b_mod, *w_in, *w_out, *a_shift, *a_w0, *a_w_up, *a_a0, *a_a_up, *a_g_up,
        *a_k_k, *a_k_a, *a_r_k, *a_lnx_g, *a_lnx_b, *b_sink, *c_rpb, *ln1_g, *ln1_b, *ln2_g, *ln2_b, *w_rg, *b_rg, *w_re,
        *b_re, *w_gate, *w_up, *w_down;
    float* out;
    int* cnt;
    unsigned* bar;
    float* mod;
    float* rope;
    bf16_t *win_t, *wout_t, *wgu_t, *wd_t;
    bf16_t *wrt;
    int* hist;
    bf16_t* HLO;
    bf16_t *wupT, *aupT, *gupT;
    bf16_t* LA;
    float *kT, *kN;
    bf16_t* H;
    bf16_t* Z;
    bf16_t* VT;
    float *sR, *sV, *sKK, *sG, *sW, *sKD, *sB;
    float* Y;
    bf16_t* MIX;
    float *PV, *QS, *PS, *SS;
    float* XC;
    bf16_t* O;
    bf16_t* YSb;
    int *rE, *rPos, *rSlot; float* rW;
    int* slotTok;
    bf16_t* ACT;
    float* YS;
};

constexpr size_t al256(size_t v) { return (v + 255) & ~(size_t)255; }
constexpr size_t OFF_CNT = 0;
constexpr size_t OFF_BAR = 4096, CTL_BYTES = 4096 + 16384;
constexpr size_t OFF_MOD = CTL_BYTES;
constexpr size_t OFF_ROPE = al256(OFF_MOD + (size_t)2 * (NB + 1) * 6 * D * 4);
constexpr size_t OFF_LORA = al256(OFF_ROPE + 64 * 16 * 2 * 4);
constexpr size_t OFF_WRT = al256(OFF_LORA + (size_t)(2 * 256 * 64 * 2 + 256 * 160) * 2);
constexpr size_t OFF_LG = al256(OFF_WRT + (size_t)2 * 128 * D * 2);
constexpr size_t OFF_WIN = al256(OFF_LG + (size_t)T * 36 * 4);
constexpr size_t OFF_WOUT = al256(OFF_WIN + (size_t)NINP * D * 2);
constexpr size_t OFF_WGU = al256(OFF_WOUT + (size_t)D * DMIX * 2);
constexpr size_t OFF_WD = al256(OFF_WGU + (size_t)NEXP * 2 * DE * D * 2);
constexpr size_t OFF_H = al256(OFF_WD + (size_t)NEXP * D * DE * 2);
constexpr size_t OFF_Z = al256(OFF_H + (size_t)(T + 1) * D * 2);
constexpr int PU = L + S;
constexpr int SEGLEN = 144, NSG = (L + S) / SEGLEN;
#ifndef HOST_EMU
static_assert((L + S) % SEGLEN == 0 && SEGLEN % 16 == 0 && L % 16 == 0 && S % 16 == 0, "16-token output tiles must not straddle scan segments");
static_assert((size_t)3 * 64 * NSG * 4096 * 4 <= (size_t)NEXP * 2 * DE * D * 2, "scan segment states overlay wgu_t");
#endif
constexpr size_t OFF_VT = al256(OFF_Z + (size_t)T * ZP * 2);
constexpr size_t OFF_S = al256(OFF_VT + (size_t)NB * 8 * 64 * PU * 2);
constexpr size_t S1 = (size_t)T * 256 * 4;
constexpr size_t OFF_Y = al256(OFF_S + 10 * S1);
constexpr size_t OFF_MIX = al256(OFF_Y + 2 * S1);
constexpr size_t OFF_XC = al256(OFF_MIX + (size_t)T * 1024 * 2);
constexpr size_t OFF_ROUTE = al256(OFF_XC + (size_t)TC * D * 4);
constexpr size_t OFF_SLOTTOK = al256(OFF_ROUTE + (size_t)T * 2 * 4 * 4);
constexpr size_t WS_NEED = al256(OFF_SLOTTOK + (size_t)NSLOT * 4);
static_assert((size_t)NSLOT * DE * 2 <= (size_t)T * ZP * 2 && (size_t)T * D * 2 <= (size_t)T * ZP * 2, "ACT / HLO overlay Z");
static_assert((size_t)T * 4 * 4 + (size_t)T * 416 * 2 <= S1, "kN + LA overlay Y[1]");
static_assert((size_t)NSLOT * D * 4 <= 10 * S1 && (size_t)T * D * 4 <= 10 * S1, "YS / O overlay the stream buffers");

static Params make_params(void* const* d_in, void* d_out, void* d_ws) {
    Params p{};
    const float** f = (const float**)&p.x;
    for (int i = 0; i < 32; ++i) f[i] = (const float*)d_in[i];
    p.out = (float*)d_out;
    char* w = (char*)d_ws;
    p.cnt = (int*)(w + OFF_CNT); p.bar = (unsigned*)(w + OFF_BAR); p.mod = (float*)(w + OFF_MOD); p.rope = (float*)(w + OFF_ROPE);
    p.win_t = (bf16_t*)(w + OFF_WIN); p.wout_t = (bf16_t*)(w + OFF_WOUT); p.wgu_t = (bf16_t*)(w + OFF_WGU); p.wd_t = (bf16_t*)(w + OFF_WD);
    p.wrt = (bf16_t*)(w + OFF_WRT); p.hist = (int*)(w + OFF_LG); p.HLO = (bf16_t*)(w + OFF_Z);
    p.wupT = (bf16_t*)(w + OFF_LORA); p.aupT = p.wupT + 2 * 256 * 64; p.gupT = p.aupT + 2 * 256 * 64;
    p.H = (bf16_t*)(w + OFF_H); p.Z = (bf16_t*)(w + OFF_Z); p.VT = (bf16_t*)(w + OFF_VT);
    float* s = (float*)(w + OFF_S); const size_t n1 = (size_t)T * 256;
    p.sR = s; p.sV = s + n1; p.sKK = s + 2 * n1; p.sG = s + 3 * n1; p.sW = s + 4 * n1; p.sKD = s + 6 * n1; p.sB = s + 8 * n1;
    p.Y = (float*)(w + OFF_Y); p.MIX = (bf16_t*)(w + OFF_MIX); p.XC = (float*)(w + OFF_XC);
    p.O = (bf16_t*)(w + OFF_S); p.YSb = (bf16_t*)(w + OFF_S);
    p.PV = (float*)(w + OFF_H); p.QS = (float*)(w + OFF_WGU); p.PS = p.QS + (size_t)64 * NSG * 4096; p.SS = p.PS + (size_t)64 * NSG * 4096;
    p.kT = p.Y; p.kN = p.Y + (size_t)T * 256; p.LA = (bf16_t*)(p.Y + (size_t)T * 256 + (size_t)T * 4);
    int* r = (int*)(w + OFF_ROUTE); p.rE = r; p.rPos = r + 2 * T; p.rSlot = r + 4 * T; p.rW = (float*)(r + 6 * T);
    p.slotTok = (int*)(w + OFF_SLOTTOK);
    p.ACT = (bf16_t*)(w + OFF_Z); p.YS = (float*)(w + OFF_S);
    return p;
}

__device__ void ph_prep_w(const Params& p, int l, long gtid, long gsz) {
    for (long i = gtid; i < (long)D * NINP; i += gsz) {
        const int k = (int)(i / NINP), n = (int)(i % NINP);
        float v = 0.f;
        if (n < N_IN) { const int oc = (n < ZA) ? n + A_IN : n - ZA; v = p.w_in[((size_t)l * D + k) * N_IN + oc]; }
        p.win_t[(size_t)n * D + k] = f2bf(v);
    }
    for (long i = gtid; i < (long)DMIX * D; i += gsz) {
        const int k = (int)(i / D), n = (int)(i % D);
        p.wout_t[(size_t)n * DMIX + k] = f2bf(p.w_out[((size_t)l * DMIX + k) * D + n]);
    }
    for (long i = gtid; i < (long)NEXP * D * 2 * DE; i += gsz) {
        const int rho = (int)(i % (2 * DE)); const long t = i / (2 * DE); const int k = (int)(t % D), e = (int)(t / D);
        const int q = rho >> 5, half = (rho >> 4) & 1, ii = rho & 15, cc = 16 * q + ii;
        const float* src = half ? p.w_up : p.w_gate;
        p.wgu_t[((size_t)e * 2 * DE + rho) * D + k] = f2bf(src[(((size_t)l * NEXP + e) * D + k) * DE + cc]);
    }
    for (long i = gtid; i < (long)NEXP * DE * D; i += gsz) {
        const int n = (int)(i % D); const long t = i / D; const int k = (int)(t % DE), e = (int)(t / DE);
        p.wd_t[((size_t)e * D + n) * DE + k] = f2bf(p.w_down[(((size_t)l * NEXP + e) * DE + k) * D + n]);
    }
}
__device__ __forceinline__ void ph_prep_misc(const Params& p, int l, long gtid, long gsz, bool do_mod = true) {
    if (l == 0 && do_mod) for (long i = gtid; i < (long)2 * (NB + 1) * 6 * D; i += gsz) {
        const int j = (int)(i % (6 * D)), b = (int)((i / (6 * D)) % (NB + 1)), ll = (int)(i / ((long)6 * D * (NB + 1)));
        const float* cv = (b < NB) ? p.c + (size_t)b * D : p.c_ctx;
        float acc = 0.f;
        for (int k = 0; k < D; ++k) acc += siluf_(cv[k]) * p.w_mod[((size_t)ll * D + k) * 6 * D + j];
        p.mod[((size_t)ll * (NB + 1) + b) * 6 * D + j] = acc + p.b_mod[(size_t)ll * 6 * D + j];
    }
    if (l == 0) for (long i = gtid; i < 64 * 16; i += gsz) {
        const int pos = (int)(i / 16), fi = (int)(i % 16);
        const float inv = powf(10000.0f, -(float)fi / 16.0f), ang = (float)pos * inv;
        p.rope[i] = cosf(ang); p.rope[1024 + i] = sinf(ang);
    }
    for (long i = gtid; i < NEXP; i += gsz) p.cnt[l * NEXP + i] = 0;
    for (long i = gtid; i < NSLOT; i += gsz) p.slotTok[i] = T;
    for (long i = gtid; i < D; i += gsz) p.H[(size_t)T * D + i] = 0;
}

__device__ __forceinline__ const float* xrow_in(const Params& p, int l, int m) {
    if (m < TL) return (l == 0 ? p.x : p.out) + (size_t)m * D;
    return (l == 0 ? p.ctx : p.XC) + (size_t)(m - TL) * D;
}
__device__ __forceinline__ const float* modrow(const Params& p, int l, int m) { return p.mod + ((size_t)l * (NB + 1) + (m < TL ? m / S : NB)) * 6 * D; }

__device__ void ph_lnmod(const Params& p, int l, long gtid, long gsz) {
    for (long m = gtid; m < T; m += gsz) {
        const float* xr = xrow_in(p, l, (int)m); const float* md = modrow(p, l, (int)m);
        float s = 0.f; for (int j = 0; j < D; ++j) s += xr[j];
        const float mu = s / D; float q = 0.f;
        for (int j = 0; j < D; ++j) { const float d = xr[j] - mu; q += d * d; }
        const float rstd = 1.0f / sqrtf(q / D + LN_EPS);
        for (int j = 0; j < D; ++j) p.H[(size_t)m * D + j] = f2bf((xr[j] - mu) * rstd * (1.0f + md[D + j]) + md[j]);
    }
}

__device__ __forceinline__ float zshift(const Params& p, int l, int m, int col) {
    int t, len;
    if (m < TL) { t = m % S; len = S; } else { t = (m - TL) % L; len = L; }
    const float* sh = p.a_shift + (size_t)l * 3 * A_IN;
    const bf16_t* z = p.Z + (size_t)m * ZP + ZA + col;
    float v = sh[A_IN + col] * bf2f(z[0]);
    if (t > 0) v += sh[col] * bf2f(z[-ZP]);
    if (t < len - 1) v += sh[2 * A_IN + col] * bf2f(z[ZP]);
    return v;
}

__device__ void ph_streams(const Params& p, int l, long gtid, long gsz) {
    for (long i = gtid; i < (long)T * DA; i += gsz) {
        const int m = (int)(i / DA), c = (int)(i % DA), h0 = c & ~63;
        const float r = zshift(p, l, m, c), k = zshift(p, l, m, 256 + c), v = zshift(p, l, m, 512 + c);
        float nrm = 0.f;
        for (int j = 0; j < 64; ++j) { const float t = zshift(p, l, m, 256 + h0 + j) * p.a_k_k[l * DA + h0 + j]; nrm += t * t; }
        const float kk = k * p.a_k_k[l * DA + c] / sqrtf(nrm + 1e-12f);
        float g = 0.f;
        for (int j = 0; j < 160; ++j) g += sigmoidf_(zshift(p, l, m, 1024 + j)) * p.a_g_up[((size_t)l * 160 + j) * DA + c];
        const size_t o = (size_t)m * DA + c;
        p.sR[o] = r; p.sV[o] = v; p.sKK[o] = kk; p.sG[o] = g;
        for (int d = 0; d < 2; ++d) {
            float aw = 0.f, aa = 0.f;
            for (int j = 0; j < 64; ++j) {
                aw += tanhf(zshift(p, l, m, 768 + d * 64 + j)) * p.a_w_up[(((size_t)l * 2 + d) * 64 + j) * DA + c];
                aa += zshift(p, l, m, 896 + d * 64 + j) * p.a_a_up[(((size_t)l * 2 + d) * 64 + j) * DA + c];
            }
            const float u = -(p.a_w0[(l * 2 + d) * DA + c] + aw);
            const float sp = (u > 20.f) ? u : log1pf(expf(u));
            const float w = expf(-expf(-sp - 0.5f));
            const float a = sigmoidf_(p.a_a0[(l * 2 + d) * DA + c] + aa);
            const size_t od = ((size_t)d * T + m) * DA + c;
            p.sW[od] = w; p.sKD[od] = k * (1.0f + (a - 1.0f) * p.a_k_a[l * DA + c]); p.sB[od] = kk * a;
        }
    }
}

__device__ __forceinline__ void ph_rope(const Params& p, long gtid, long gsz) {
    for (long i = gtid; i < (long)TL * 8 * 32; i += gsz) {
        const int pr = (int)(i & 31), hs = (int)((i >> 5) & 7), m = (int)(i >> 8);
        const int t = m % S, axis = pr >> 4, fi = pr & 15, pos = axis ? (t % GRID_W) : (t / GRID_W);
        bf16_t* z = p.Z + (size_t)m * ZP + hs * 64 + axis * 32 + fi;
        const float cs = p.rope[pos * 16 + fi], sn = p.rope[1024 + pos * 16 + fi];
        const float x0 = bf2f(z[0]), x1 = bf2f(z[16]);
        z[0] = f2bf(x0 * cs - x1 * sn); z[16] = f2bf(x1 * cs + x0 * sn);
    }
}

__device__ void ph_scan(const Params& p, long gtid, long gsz) {
    for (long i = gtid; i < (long)2 * NB * 4 * 64; i += gsz) {
        const int v = (int)(i & 63), h = (int)((i >> 6) & 3), b = (int)((i >> 8) % NB), d = (int)((i >> 8) / NB);
        float st[64];
#pragma unroll
        for (int k = 0; k < 64; ++k) st[k] = 0.f;
        for (int pos = 0; pos < L + S; ++pos) {
            int m;
            if (pos < L) m = TL + b * L + (d ? L - 1 - pos : pos);
            else m = b * S + (d ? S - 1 - (pos - L) : pos - L);
            const size_t o = (size_t)m * DA + h * 64, od = ((size_t)d * T + m) * DA + h * 64;
            const float* kk = p.sKK + o; const float* r = p.sR + o;
            const float* w = p.sW + od; const float* bb = p.sB + od; const float* kd = p.sKD + od;
            const float vv = p.sV[o + v];
            float sk = 0.f;
#pragma unroll
            for (int k = 0; k < 64; ++k) sk += st[k] * kk[k];
            float y = 0.f;
#pragma unroll
            for (int k = 0; k < 64; ++k) { st[k] = st[k] * w[k] - sk * bb[k] + vv * kd[k]; y += st[k] * r[k]; }
            p.Y[od + v] = y;
        }
    }
}

__device__ void ph_rwkv_out(const Params& p, int l, int nrows, long gtid, long gsz) {
    for (long i = gtid; i < (long)nrows * 4; i += gsz) {
        const int m = (int)(i >> 2), h = (int)(i & 3);
        const size_t o = (size_t)m * DA + h * 64;
        const float* y0 = p.Y + o; const float* y1 = p.Y + (size_t)T * DA + o;
        float s = 0.f, bon = 0.f;
        for (int n = 0; n < 64; ++n) {
            s += y0[n] + y1[n];
            bon += p.sR[o + n] * (p.sKD[o + n] + p.sKD[(size_t)T * DA + o + n]) * p.a_r_k[l * DA + h * 64 + n];
        }
        const float mu = s / 64.f; float q = 0.f;
        for (int n = 0; n < 64; ++n) { const float dd = y0[n] + y1[n] - mu; q += dd * dd; }
        const float rstd = 1.0f / sqrtf(q / 64.f + GN_EPS);
        for (int n = 0; n < 64; ++n) {
            const int c = h * 64 + n;
            const float yn = (y0[n] + y1[n] - mu) * rstd * p.a_lnx_g[l * DA + c] + p.a_lnx_b[l * DA + c];
            p.MIX[(size_t)m * DMIX + c] = f2bf((yn + bon * p.sV[o + n]) * p.sG[o + n]);
        }
    }
}

__device__ __forceinline__ void att_key(const float (&q)[64], const bf16_t* kr, const bf16_t* vr, float bias, float& mx, float& ls, float (&acc)[64]) {
    float s = 0.f;
#pragma unroll
    for (int d = 0; d < 64; ++d) s += q[d] * bf2f(kr[d]);
    s = s * ATT_SCALE + bias;
    const float mn = fmaxf(mx, s), f = expf(mx - mn), pe = expf(s - mn);
    ls = ls * f + pe;
#pragma unroll
    for (int d = 0; d < 64; ++d) acc[d] = acc[d] * f + pe * bf2f(vr[d]);
    mx = mn;
}

__device__ void ph_attn(const Params& p, int l, int nrows, long gtid, long gsz) {
    for (long i = gtid; i < (long)nrows * 12; i += gsz) {
        const int m = (int)(i / 12), u = (int)(i % 12);
        const bool isB = u < 6; const int hq = isB ? u : u - 6;
        const int b = (m < TL) ? m / S : (m - TL) / L;
        const int qcol = isB ? ZQB + hq * 64 : ZQN + hq * 64;
        const int kcol = isB ? ZKB + (hq / 3) * 64 : ZKN + hq * 64;
        const int vcol = isB ? ZVB + (hq / 3) * 64 : ZVN + hq * 64;
        float q[64], acc[64];
        const bf16_t* qr = p.Z + (size_t)m * ZP + qcol;
#pragma unroll
        for (int d = 0; d < 64; ++d) { q[d] = bf2f(qr[d]); acc[d] = 0.f; }
        float mx, ls;
        if (isB) { mx = p.b_sink[l * 6 + hq]; ls = 1.0f; } else { mx = -1e30f; ls = 0.f; }
        for (int j = 0; j < L; ++j) { const bf16_t* zr = p.Z + (size_t)(TL + b * L + j) * ZP; att_key(q, zr + kcol, zr + vcol, 0.f, mx, ls, acc); }
        if (m < TL) {
            const int t = m % S;
            if (isB) {
                const int j0 = t - 128 < 0 ? 0 : t - 128, j1 = t + 128 > S - 1 ? S - 1 : t + 128;
                for (int j = j0; j <= j1; ++j) { const bf16_t* zr = p.Z + (size_t)(b * S + j) * ZP; att_key(q, zr + kcol, zr + vcol, 0.f, mx, ls, acc); }
            } else {
                const int rows = S / GRID_W, r = t / GRID_W, c = t % GRID_W;
                int r0 = r - 4; r0 = r0 < 0 ? 0 : (r0 > rows - 8 ? rows - 8 : r0);
                int c0 = c - 8; c0 = c0 < 0 ? 0 : (c0 > GRID_W - 16 ? GRID_W - 16 : c0);
                for (int a = 0; a < 8; ++a)
                    for (int e = 0; e < 16; ++e) {
                        const int kr = r0 + a, kc = c0 + e;
                        const float bias = p.c_rpb[(((size_t)l * 6 + hq) * 15 + (kr - r + 7)) * 31 + (kc - c + 15)];
                        const bf16_t* zr = p.Z + (size_t)(b * S + kr * GRID_W + kc) * ZP;
                        att_key(q, zr + kcol, zr + vcol, bias, mx, ls, acc);
                    }
            }
        }
        const float inv = 1.0f / ls;
        bf16_t* o = p.MIX + (size_t)m * DMIX + (isB ? 256 : 640) + hq * 64;
#pragma unroll
        for (int d = 0; d < 64; ++d) o[d] = f2bf(acc[d] * inv);
    }
}

__device__ void ph_post_mixer(const Params& p, int l, int nrows, long gtid, long gsz) {
    for (long mm = gtid; mm < nrows; mm += gsz) {
        const int m = (int)mm;
        const float* xr = xrow_in(p, l, m); const float* md = modrow(p, l, m); const float* orow = (const float*)p.O + (size_t)m * D;
        float* x1 = (m < TL) ? p.out + (size_t)m * D : p.XC + (size_t)(m - TL) * D;
        const float* g1 = p.ln1_g + (size_t)l * D; const float* b1 = p.ln1_b + (size_t)l * D;
        float s = 0.f; for (int j = 0; j < D; ++j) s += ALPHA * xr[j] + md[2 * D + j] * orow[j];
        float mu = s / D, q = 0.f;
        for (int j = 0; j < D; ++j) { const float d = ALPHA * xr[j] + md[2 * D + j] * orow[j] - mu; q += d * d; }
        float rstd = 1.0f / sqrtf(q / D + LN_EPS);
        s = 0.f;
        for (int j = 0; j < D; ++j) { const float v = (ALPHA * xr[j] + md[2 * D + j] * orow[j] - mu) * rstd * g1[j] + b1[j]; x1[j] = v; s += v; }
        mu = s / D; q = 0.f;
        for (int j = 0; j < D; ++j) { const float d = x1[j] - mu; q += d * d; }
        rstd = 1.0f / sqrtf(q / D + LN_EPS);
        float gl[4], el[32];
#pragma unroll
        for (int g = 0; g < 4; ++g) gl[g] = p.b_rg[l * 4 + g];
#pragma unroll
        for (int e = 0; e < 32; ++e) el[e] = p.b_re[l * 32 + e];
        for (int j = 0; j < D; ++j) {
            const float hv = (x1[j] - mu) * rstd * (1.0f + md[4 * D + j]) + md[3 * D + j];
            p.H[(size_t)m * D + j] = f2bf(hv);
            const float* wg = p.w_rg + ((size_t)l * D + j) * 4; const float* we = p.w_re + ((size_t)l * D + j) * 32;
#pragma unroll
            for (int g = 0; g < 4; ++g) gl[g] += hv * wg[g];
#pragma unroll
            for (int e = 0; e < 32; ++e) el[e] += hv * we[e];
        }
        int gs = 0; float gm = gl[0];
#pragma unroll
        for (int g = 1; g < 4; ++g) if (gl[g] > gm) { gm = gl[g]; gs = g; }
        float den = 0.f;
#pragma unroll
        for (int g = 0; g < 4; ++g) den += expf(gl[g] - gm);
        const float pg = 1.0f / den;
        float v1 = -3e38f, v2 = -3e38f; int i1 = 0, i2 = 0;
#pragma unroll
        for (int j = 0; j < 8; ++j) {
            const float v = gs == 0 ? el[j] : gs == 1 ? el[8 + j] : gs == 2 ? el[16 + j] : el[24 + j];
            if (v > v1) { v2 = v1; i2 = i1; v1 = v; i1 = j; } else if (v > v2) { v2 = v; i2 = j; }
        }
        const float e2 = expf(v2 - v1), w1 = pg / (1.0f + e2), w2 = pg * e2 / (1.0f + e2);
        const int ea = gs * 8 + i1, eb = gs * 8 + i2;
        p.rE[2 * m] = ea; p.rE[2 * m + 1] = eb; p.rW[2 * m] = w1; p.rW[2 * m + 1] = w2;
        p.rPos[2 * m] = atomic_inc_int(p.cnt + l * NEXP + ea); p.rPos[2 * m + 1] = atomic_inc_int(p.cnt + l * NEXP + eb);
    }
}

__device__ __forceinline__ int pstart_of(const int* cnt, int e) {
    int s = 0;
    for (int j = 0; j < NEXP; ++j) if (j < e) s += (cnt[j] + 127) & ~127;
    return s;
}
__device__ __forceinline__ void ph_dispatch(const Params& p, int l, int nrows, long gtid, long gsz) {
    for (long i = gtid; i < (long)nrows * 2; i += gsz) {
        const int slot = pstart_of(p.cnt + l * NEXP, p.rE[i]) + p.rPos[i];
        p.rSlot[i] = slot; p.slotTok[slot] = (int)(i >> 1);
    }
}

__device__ void ph_final(const Params& p, int l, int nrows, long gtid, long gsz) {
    for (long mm = gtid; mm < nrows; mm += gsz) {
        const int m = (int)mm;
        float* x1 = (m < TL) ? p.out + (size_t)m * D : p.XC + (size_t)(m - TL) * D;
        const float* md = modrow(p, l, m);
        const float* ya = p.YS + (size_t)p.rSlot[2 * m] * D; const float* yb = p.YS + (size_t)p.rSlot[2 * m + 1] * D;
        const float wa = p.rW[2 * m], wb = p.rW[2 * m + 1];
        const float* g2 = p.ln2_g + (size_t)l * D; const float* b2 = p.ln2_b + (size_t)l * D;
        float s = 0.f; for (int j = 0; j < D; ++j) s += ALPHA * x1[j] + md[5 * D + j] * (wa * ya[j] + wb * yb[j]);
        const float mu = s / D; float q = 0.f;
        for (int j = 0; j < D; ++j) { const float d = ALPHA * x1[j] + md[5 * D + j] * (wa * ya[j] + wb * yb[j]) - mu; q += d * d; }
        const float rstd = 1.0f / sqrtf(q / D + LN_EPS);
        for (int j = 0; j < D; ++j) x1[j] = (ALPHA * x1[j] + md[5 * D + j] * (wa * ya[j] + wb * yb[j]) - mu) * rstd * g2[j] + b2[j];
    }
}

__device__ __forceinline__ int moe_blocks(const int* cnt) { int s = 0; for (int j = 0; j < NEXP; ++j) s += (cnt[j] + 127) >> 7; return s; }
__device__ __forceinline__ int moe_block_expert(const int* cnt, int rb) {
    int s = 0, e = 0;
    for (int j = 0; j < NEXP; ++j) { const int nb = (cnt[j] + 127) >> 7; if (rb >= s && rb < s + nb) e = j; s += nb; }
    return e;
}

#ifdef HOST_EMU
static void host_gemm_in(const Params& p) {
    for (int m = 0; m < T; ++m) for (int n = 0; n < ZP; ++n) { float a = 0.f; for (int k = 0; k < D; ++k) a += bf2f(p.H[(size_t)m * D + k]) * bf2f(p.win_t[(size_t)n * D + k]); p.Z[(size_t)m * ZP + n] = f2bf(a); }
}
static void host_gemm_out(const Params& p, int nrows) {
    for (int m = 0; m < nrows; ++m) for (int n = 0; n < D; ++n) { float a = 0.f; for (int k = 0; k < DMIX; ++k) a += bf2f(p.MIX[(size_t)m * DMIX + k]) * bf2f(p.wout_t[(size_t)n * DMIX + k]); ((float*)p.O)[(size_t)m * D + n] = a; }
}
static void host_moe1(const Params& p, int l) {
    const int* cnt = p.cnt + l * NEXP; const int nrb = moe_blocks(cnt);
    for (int rb = 0; rb < nrb; ++rb) { const int e = moe_block_expert(cnt, rb);
        for (int r = 0; r < 128; ++r) { const int slot = rb * 128 + r; const bf16_t* a = p.H + (size_t)p.slotTok[slot] * D;
            for (int c = 0; c < DE; ++c) { const int q = c >> 4, ii = c & 15; float g = 0.f, u = 0.f;
                const bf16_t* wg = p.wgu_t + ((size_t)e * 2 * DE + 32 * q + ii) * D; const bf16_t* wu = wg + (size_t)16 * D;
                for (int k = 0; k < D; ++k) { g += bf2f(a[k]) * bf2f(wg[k]); u += bf2f(a[k]) * bf2f(wu[k]); }
                p.ACT[(size_t)slot * DE + c] = f2bf(siluf_(g) * u); } } }
}
static void host_moe2(const Params& p, int l) {
    const int* cnt = p.cnt + l * NEXP; const int nrb = moe_blocks(cnt);
    for (int rb = 0; rb < nrb; ++rb) { const int e = moe_block_expert(cnt, rb);
        for (int r = 0; r < 128; ++r) { const int slot = rb * 128 + r;
            for (int n = 0; n < D; ++n) { float a = 0.f; const bf16_t* w = p.wd_t + ((size_t)e * D + n) * DE;
                for (int k = 0; k < DE; ++k) a += bf2f(p.ACT[(size_t)slot * DE + k]) * bf2f(w[k]);
                p.YS[(size_t)slot * D + n] = a; } } }
}
#else
typedef short bf16x8 __attribute__((ext_vector_type(8)));
typedef float f32x4 __attribute__((ext_vector_type(4)));
__device__ __forceinline__ int opq_tid() { int t = threadIdx.x; asm volatile("" : "+v"(t)); return t; }
__device__ __forceinline__ int opq_bid() { int b = blockIdx.x; asm volatile("" : "+s"(b)); return b; }
__device__ __forceinline__ unsigned pk2(float lo, float hi) { return (unsigned)f2bf(lo) | ((unsigned)f2bf(hi) << 16); }
struct u32x2_t { unsigned x, y; };
__device__ __forceinline__ void st_bf16x4(bf16_t* dst, f32x4 v) { u32x2_t o; o.x = pk2(v[0], v[1]); o.y = pk2(v[2], v[3]); *(u32x2_t*)dst = o; }
template <bool SWAP = true, class Epi>
__device__ __forceinline__ void gemm_tile(const bf16_t* a0, const bf16_t* a1, const bf16_t* b0, const bf16_t* b1, int K, char* lds, const Epi& epi) {
    const int tid = opq_tid(), wid = tid >> 6, lane = tid & 63, wr = wid >> 1, wc = wid & 1, fr = lane & 15, fq = lane >> 4;
    f32x4 acc[4][4];
#pragma unroll
    for (int m = 0; m < 4; ++m)
#pragma unroll
        for (int n = 0; n < 4; ++n) acc[m][n] = (f32x4){0.f, 0.f, 0.f, 0.f};
#define GT_STAGE(st_, kt_) do { char* sa_ = lds + (st_) * 16384 + tid * 16; \
        __builtin_amdgcn_global_load_lds((const unsigned*)(a0 + (kt_)), (__attribute__((address_space(3))) unsigned*)(sa_), 16, 0, 0); \
        __builtin_amdgcn_global_load_lds((const unsigned*)(a1 + (kt_)), (__attribute__((address_space(3))) unsigned*)(sa_ + 4096), 16, 0, 0); \
        __builtin_amdgcn_global_load_lds((const unsigned*)(b0 + (kt_)), (__attribute__((address_space(3))) unsigned*)(sa_ + 8192), 16, 0, 0); \
        __builtin_amdgcn_global_load_lds((const unsigned*)(b1 + (kt_)), (__attribute__((address_space(3))) unsigned*)(sa_ + 12288), 16, 0, 0); } while (0)
    const int fsw = (0 - (fr >> 2)) & 3;
    const int aoff = (wr * 64 + fr) * 64 + ((fq ^ fsw) * 16), boff = 8192 + (wc * 64 + fr) * 64 + ((fq ^ fsw) * 16);
    const int nk = K / 32;
    GT_STAGE(0, 0);
    if (nk > 1) GT_STAGE(1, 32);
    if (nk > 2) GT_STAGE(2, 64);
    for (int t = 0; t < nk; ++t) {
        if (t + 2 < nk) asm volatile("s_waitcnt vmcnt(8)" ::: "memory"); else if (t + 1 < nk) asm volatile("s_waitcnt vmcnt(4)" ::: "memory"); else asm volatile("s_waitcnt vmcnt(0)" ::: "memory");
        asm volatile("s_waitcnt lgkmcnt(0)" ::: "memory");
        __builtin_amdgcn_s_barrier();
        if (t + 3 < nk) GT_STAGE((t + 3) & 3, (t + 3) * 32);
        const char* sb = lds + (t & 3) * 16384;
        bf16x8 At[4], Bt[4];
#pragma unroll
        for (int m = 0; m < 4; ++m) At[m] = *(const bf16x8*)(sb + aoff + m * 1024);
#pragma unroll
        for (int n = 0; n < 4; ++n) Bt[n] = *(const bf16x8*)(sb + boff + n * 1024);
#pragma unroll
        for (int m = 0; m < 4; ++m)
#pragma unroll
            for (int n = 0; n < 4; ++n) acc[m][n] = SWAP ? __builtin_amdgcn_mfma_f32_16x16x32_bf16(Bt[n], At[m], acc[m][n], 0, 0, 0) : __builtin_amdgcn_mfma_f32_16x16x32_bf16(At[m], Bt[n], acc[m][n], 0, 0, 0);
    }
    asm volatile("s_waitcnt lgkmcnt(0)" ::: "memory");
    __builtin_amdgcn_s_barrier();
#undef GT_STAGE
    epi(acc, wr, wc, fr, fq);
}
#define STG_ROW(i) ((tid_ + (i) * 256) >> 2)
#define STG_K ((((tid_ & 3) ^ ((0 - (tid_ >> 4)) & 3))) * 8)

__device__ __forceinline__ f32x4 ld_bf16x4(const bf16_t* src) { const u32x2_t w = *(const u32x2_t*)src; return (f32x4){__uint_as_float(w.x << 16), __uint_as_float(w.x & 0xffff0000u), __uint_as_float(w.y << 16), __uint_as_float(w.y & 0xffff0000u)}; }
__device__ __forceinline__ void g_gemm_in(const Params& p, char* lds) {
    const int tid_ = opq_tid(), bid_ = opq_bid(); (void)tid_; (void)bid_;
    constexpr int NT = NINP / 128, MT = T / 128;
    for (int tile = bid_; tile < NT * MT; tile += gridDim.x) {
        const int tm = tile / NT, tn = tile % NT;
        const bf16_t* a0 = p.H + (size_t)(tm * 128 + STG_ROW(0)) * D + STG_K; const bf16_t* a1 = p.H + (size_t)(tm * 128 + STG_ROW(1)) * D + STG_K;
        const bf16_t* b0 = p.win_t + (size_t)(tn * 128 + STG_ROW(0)) * D + STG_K; const bf16_t* b1 = p.win_t + (size_t)(tn * 128 + STG_ROW(1)) * D + STG_K;
        if (tn == ZVB / 128 || (tn >= ZVN / 128 && tn < ZA / 128)) {
            gemm_tile<false>(a0, a1, b0, b1, D, lds, [&](const f32x4 (&acc)[4][4], int wr, int wc, int fr, int fq) {
#pragma unroll
                for (int m = 0; m < 4; ++m) { const int m0 = tm * 128 + wr * 64 + m * 16 + fq * 4; int b, u;
                    if (m0 < TL) { b = m0 / S; u = L + m0 % S; } else { b = (m0 - TL) / L; u = (m0 - TL) % L; }
#pragma unroll
                    for (int n = 0; n < 4; ++n) { const int col = tn * 128 + wc * 64 + n * 16 + fr;
                        const int hv = col < ZVN ? (col - ZVB) >> 6 : 2 + ((col - ZVN) >> 6), d = col < ZVN ? (col - ZVB) & 63 : (col - ZVN) & 63;
                        st_bf16x4(p.VT + ((size_t)(b * 8 + hv) * 64 + d) * PU + u, acc[m][n]); } }
            });
        } else if (tn < ZVB / 128 && tm < TL / 128) {
            gemm_tile<true>(a0, a1, b0, b1, D, lds, [&](const f32x4 (&acc)[4][4], int wr, int wc, int fr, int fq) {
#pragma unroll
                for (int m = 0; m < 4; ++m) { const int row = tm * 128 + wr * 64 + m * 16 + fr, t = row % S;
                    bf16_t* zr = p.Z + (size_t)row * ZP + tn * 128 + wc * 64 + 4 * fq;
#pragma unroll
                    for (int ax = 0; ax < 2; ++ax) { const int pos = ax ? t % GRID_W : t / GRID_W;
                        const f32x4 cs = *(const f32x4*)(p.rope + pos * 16 + 4 * fq), sn = *(const f32x4*)(p.rope + 1024 + pos * 16 + 4 * fq);
                        const f32x4 x0 = acc[m][2 * ax], x1 = acc[m][2 * ax + 1];
                        st_bf16x4(zr + 32 * ax, x0 * cs - x1 * sn); st_bf16x4(zr + 32 * ax + 16, x1 * cs + x0 * sn); } }
            });
        } else {
            gemm_tile<true>(a0, a1, b0, b1, D, lds, [&](const f32x4 (&acc)[4][4], int wr, int wc, int fr, int fq) {
#pragma unroll
                for (int m = 0; m < 4; ++m)
#pragma unroll
                    for (int n = 0; n < 4; ++n) { const int col = tn * 128 + wc * 64 + n * 16 + 4 * fq;
                        if (col < ZP) st_bf16x4(p.Z + (size_t)(tm * 128 + wr * 64 + m * 16 + fr) * ZP + col, acc[m][n]); }
            });
        }
    }
}
__device__ __forceinline__ void g_gemm_out(const Params& p, int nrows, char* lds) {
    const int tid_ = opq_tid(), bid_ = opq_bid(); (void)tid_; (void)bid_;
    constexpr int NT = D / 128; const int MT = nrows / 128;
    for (int tile = bid_; tile < NT * MT; tile += gridDim.x) {
        const int tm = tile / NT, tn = tile % NT;
        const bf16_t* a0 = p.MIX + (size_t)(tm * 128 + STG_ROW(0)) * DMIX + STG_K; const bf16_t* a1 = p.MIX + (size_t)(tm * 128 + STG_ROW(1)) * DMIX + STG_K;
        const bf16_t* b0 = p.wout_t + (size_t)(tn * 128 + STG_ROW(0)) * DMIX + STG_K; const bf16_t* b1 = p.wout_t + (size_t)(tn * 128 + STG_ROW(1)) * DMIX + STG_K;
        gemm_tile(a0, a1, b0, b1, DMIX, lds, [&](const f32x4 (&acc)[4][4], int wr, int wc, int fr, int fq) {
#pragma unroll
            for (int m = 0; m < 4; ++m)
#pragma unroll
                for (int n = 0; n < 4; ++n) st_bf16x4(p.O + (size_t)(tm * 128 + wr * 64 + m * 16 + fr) * D + tn * 128 + wc * 64 + n * 16 + 4 * fq, acc[m][n]);
        });
    }
}
__device__ __forceinline__ void g_moe1(const Params& p, int l, char* lds) {
    const int tid_ = opq_tid(), bid_ = opq_bid(); (void)tid_; (void)bid_;
    const int* cnt = p.cnt + l * NEXP; const int nrb = moe_blocks(cnt); constexpr int NT = 2 * DE / 128;
    for (int tile = bid_; tile < nrb * NT; tile += gridDim.x) {
        const int rb = tile / NT, tn = tile % NT, e = moe_block_expert(cnt, rb);
        const bf16_t* a0 = p.H + (size_t)p.slotTok[rb * 128 + STG_ROW(0)] * D + STG_K; const bf16_t* a1 = p.H + (size_t)p.slotTok[rb * 128 + STG_ROW(1)] * D + STG_K;
        const bf16_t* bw = p.wgu_t + (size_t)e * 2 * DE * D;
        const bf16_t* b0 = bw + (size_t)(tn * 128 + STG_ROW(0)) * D + STG_K; const bf16_t* b1 = bw + (size_t)(tn * 128 + STG_ROW(1)) * D + STG_K;
        gemm_tile(a0, a1, b0, b1, D, lds, [&](const f32x4 (&acc)[4][4], int wr, int wc, int fr, int fq) {
#pragma unroll
            for (int m = 0; m < 4; ++m)
#pragma unroll
                for (int n2 = 0; n2 < 2; ++n2) {
                    const f32x4 g = acc[m][2 * n2], u = acc[m][2 * n2 + 1]; f32x4 a;
#pragma unroll
                    for (int e4 = 0; e4 < 4; ++e4) a[e4] = g[e4] / (1.0f + __expf(-g[e4])) * u[e4];
                    st_bf16x4(p.ACT + (size_t)(rb * 128 + wr * 64 + m * 16 + fr) * DE + tn * 64 + wc * 32 + n2 * 16 + 4 * fq, a); }
        });
    }
}
__device__ __forceinline__ void g_moe2(const Params& p, int l, char* lds) {
    const int tid_ = opq_tid(), bid_ = opq_bid(); (void)tid_; (void)bid_;
    const int* cnt = p.cnt + l * NEXP; const int nrb = moe_blocks(cnt); constexpr int NT = D / 128;
    for (int tile = bid_; tile < nrb * NT; tile += gridDim.x) {
        const int rb = tile / NT, tn = tile % NT, e = moe_block_expert(cnt, rb);
        const bf16_t* a0 = p.ACT + (size_t)(rb * 128 + STG_ROW(0)) * DE + STG_K; const bf16_t* a1 = p.ACT + (size_t)(rb * 128 + STG_ROW(1)) * DE + STG_K;
        const bf16_t* bw = p.wd_t + (size_t)e * D * DE;
        const bf16_t* b0 = bw + (size_t)(tn * 128 + STG_ROW(0)) * DE + STG_K; const bf16_t* b1 = bw + (size_t)(tn * 128 + STG_ROW(1)) * DE + STG_K;
        gemm_tile(a0, a1, b0, b1, DE, lds, [&](const f32x4 (&acc)[4][4], int wr, int wc, int fr, int fq) {
#pragma unroll
            for (int m = 0; m < 4; ++m)
#pragma unroll
                for (int n = 0; n < 4; ++n) st_bf16x4(p.YSb + (size_t)(rb * 128 + wr * 64 + m * 16 + fr) * D + tn * 128 + wc * 64 + n * 16 + 4 * fq, acc[m][n]);
        });
    }
}


constexpr int DV = D / 256;
static_assert(D % 256 == 0, "row phases hold a row as DV float4 per lane");
template <int CTRL> __device__ __forceinline__ float dppf(float v) { return __builtin_bit_cast(float, __builtin_amdgcn_update_dpp(0, __builtin_bit_cast(int, v), CTRL, 0xf, 0xf, true)); }
__device__ __forceinline__ float wave_sum(float v) {
    v += dppf<0xB1>(v); v += dppf<0x4E>(v); v += dppf<0x141>(v); v += dppf<0x140>(v);
    float a = v, b = v;
    asm volatile("s_nop 1\n\tv_permlane16_swap_b32 %0, %1" : "+v"(a), "+v"(b));
    v = a + b; a = v; b = v;
    asm volatile("s_nop 1\n\tv_permlane32_swap_b32 %0, %1" : "+v"(a), "+v"(b));
    return a + b;
}
__device__ __forceinline__ float sum8(float v) { v += dppf<0xB1>(v); v += dppf<0x4E>(v); v += dppf<0x141>(v); return v; }
__device__ __forceinline__ float sum4(f32x4 a) { return (a[0] + a[1]) + (a[2] + a[3]); }
#define LDS_WAIT() asm volatile("s_waitcnt lgkmcnt(0)" ::: "memory")

__device__ __forceinline__ void row_stats(const f32x4 (&v)[DV], float& mu, float& rstd) {
    float s = 0.f;
#pragma unroll
    for (int j = 0; j < DV; ++j) s += sum4(v[j]);
    mu = wave_sum(s) * (1.0f / D);
    float q = 0.f;
#pragma unroll
    for (int j = 0; j < DV; ++j) { const f32x4 d = v[j] - mu; q += sum4(d * d); }
    rstd = 1.0f / sqrtf(wave_sum(q) * (1.0f / D) + LN_EPS);
}

__device__ __forceinline__ void ph_lnmod_fast(const Params& p, int l) {
    const int tid_ = opq_tid(), bid_ = opq_bid(); (void)tid_; (void)bid_;
    const int lane = tid_ & 63, gw = bid_ * 4 + (tid_ >> 6), nw = gridDim.x * 4;
    constexpr int R = 4;
    for (int m0 = gw * R; m0 < T; m0 += nw * R) {
        f32x4 v[R][DV];
#pragma unroll
        for (int r = 0; r < R; ++r) { const f32x4* xr = (const f32x4*)xrow_in(p, l, m0 + r < T ? m0 + r : m0) + lane;
#pragma unroll
            for (int j = 0; j < DV; ++j) v[r][j] = xr[64 * j]; }
        float mu[R], rstd[R];
#pragma unroll
        for (int r = 0; r < R; ++r) row_stats(v[r], mu[r], rstd[r]);
#pragma unroll
        for (int r = 0; r < R; ++r) if (m0 + r < T) { const f32x4* md = (const f32x4*)modrow(p, l, m0 + r) + lane;
#pragma unroll
            for (int j = 0; j < DV; ++j) st_bf16x4(p.H + (size_t)(m0 + r) * D + 4 * (lane + 64 * j), (v[r][j] - mu[r]) * rstd[r] * (md[D / 4 + 64 * j] + 1.0f) + md[64 * j]); }
    }
}

template <int R>
__device__ __forceinline__ void pm_rows(const Params& p, int l, int m0, int lane) {
    const f32x4* g1 = (const f32x4*)(p.ln1_g + (size_t)l * D) + lane; const f32x4* b1 = (const f32x4*)(p.ln1_b + (size_t)l * D) + lane;
    f32x4 v[R][DV]; float mu[R], rstd[R];
#pragma unroll
    for (int r = 0; r < R; ++r) { const int m = m0 + r; const f32x4* xr = (const f32x4*)xrow_in(p, l, m) + lane; const f32x4* md = (const f32x4*)modrow(p, l, m) + lane;
        const bf16_t* orow = p.O + (size_t)m * D + 4 * lane;
#pragma unroll
        for (int j = 0; j < DV; ++j) v[r][j] = xr[64 * j] * ALPHA + md[2 * (D / 4) + 64 * j] * ld_bf16x4(orow + 256 * j); }
#pragma unroll
    for (int r = 0; r < R; ++r) row_stats(v[r], mu[r], rstd[r]);
#pragma unroll
    for (int r = 0; r < R; ++r) { const int m = m0 + r; f32x4* x1 = (f32x4*)((m < TL) ? p.out + (size_t)m * D : p.XC + (size_t)(m - TL) * D) + lane;
#pragma unroll
        for (int j = 0; j < DV; ++j) { v[r][j] = (v[r][j] - mu[r]) * rstd[r] * g1[64 * j] + b1[64 * j]; x1[64 * j] = v[r][j]; } }
#pragma unroll
    for (int r = 0; r < R; ++r) row_stats(v[r], mu[r], rstd[r]);
#pragma unroll
    for (int r = 0; r < R; ++r) { const int m = m0 + r; const f32x4* md = (const f32x4*)modrow(p, l, m) + lane;
#pragma unroll
        for (int j = 0; j < DV; ++j) {
            const f32x4 hv = (v[r][j] - mu[r]) * rstd[r] * (md[4 * (D / 4) + 64 * j] + 1.0f) + md[3 * (D / 4) + 64 * j];
            f32x4 hh, lo;
#pragma unroll
            for (int e = 0; e < 4; ++e) { hh[e] = bf2f(f2bf(hv[e])); lo[e] = hv[e] - hh[e]; }
            st_bf16x4(p.H + (size_t)m * D + 4 * (lane + 64 * j), hh);
            st_bf16x4(p.HLO + (size_t)m * D + 4 * (lane + 64 * j), lo);
        } }
}

__device__ __forceinline__ int router_rpg(int nrows) { const int g = gridDim.x; return (nrows % g == 0 && nrows / g <= 48 && (nrows / g) % 4 == 0) ? nrows / g : 32; }
__device__ __forceinline__ void g_router(const Params& p, int l, int nrows, char* lds) {
    const int tid_ = opq_tid(), bid_ = opq_bid(); (void)tid_; (void)bid_;
    const int lane = tid_ & 63, wid = tid_ >> 6, fr = lane & 15, fq = lane >> 4;
    const int RPG = router_rpg(nrows), RW = RPG / 4;
    float* part = (float*)lds;
    float* lgt = part + 4 * 9 * 64 * 4;
    int* eids = (int*)(lgt + 48 * 48);
    for (int rg = bid_; rg < nrows / RPG; rg += gridDim.x) {
#pragma unroll 1
        for (int i = 0; i + 1 < RW; i += 2) pm_rows<2>(p, l, rg * RPG + wid * RW + i, lane);
        if (RW & 1) pm_rows<1>(p, l, rg * RPG + wid * RW + RW - 1, lane);
        asm volatile("s_waitcnt vmcnt(0)" ::: "memory");
        __syncthreads();
        f32x4 acc[3][3];
#pragma unroll
        for (int a = 0; a < 3; ++a)
#pragma unroll
            for (int b = 0; b < 3; ++b) acc[a][b] = (f32x4){0.f, 0.f, 0.f, 0.f};
        int arow[3];
#pragma unroll
        for (int a = 0; a < 3; ++a) { const int rr = a * 16 + fr; arow[a] = rg * RPG + (rr < RPG ? rr : RPG - 1); }
#pragma unroll
        for (int seg = 0; seg < 3; ++seg) {
            const bf16_t* ab = (seg < 2 ? p.H : p.HLO) + wid * (D / 4) + fq * 8;
            const bf16_t* bp = p.wrt + (seg == 1 ? (size_t)128 * D : 0) + (size_t)fr * D + wid * (D / 4) + fq * 8;
#pragma unroll 1
            for (int ks0 = 0; ks0 < D / 128; ks0 += 2) {
                bf16x8 av[2][3], bv[2][3];
#pragma unroll
                for (int u = 0; u < 2; ++u) { const int ko = (ks0 + u) * 32;
#pragma unroll
                    for (int a = 0; a < 3; ++a) { av[u][a] = *(const bf16x8*)(ab + (size_t)arow[a] * D + ko); bv[u][a] = *(const bf16x8*)(bp + (size_t)(16 * a) * D + ko); } }
                asm volatile("" ::: "memory");
#pragma unroll
                for (int u = 0; u < 2; ++u)
#pragma unroll
                    for (int a = 0; a < 3; ++a)
#pragma unroll
                        for (int b = 0; b < 3; ++b) acc[a][b] = __builtin_amdgcn_mfma_f32_16x16x32_bf16(av[u][a], bv[u][b], acc[a][b], 0, 0, 0);
            }
        }
#pragma unroll
        for (int a = 0; a < 3; ++a)
#pragma unroll
            for (int b = 0; b < 3; ++b) *(f32x4*)(part + ((wid * 9 + a * 3 + b) * 64 + lane) * 4) = acc[a][b];
        __syncthreads();
#pragma unroll
        for (int i = 0; i < 9; ++i) { const int e = tid_ + 256 * i, f = e >> 8, ln = (e & 255) >> 2, j = e & 3;
            const float sm = (part[((0 * 9 + f) * 64 + ln) * 4 + j] + part[((1 * 9 + f) * 64 + ln) * 4 + j]) + (part[((2 * 9 + f) * 64 + ln) * 4 + j] + part[((3 * 9 + f) * 64 + ln) * 4 + j]);
            lgt[((f / 3) * 16 + (ln >> 4) * 4 + j) * 48 + (f % 3) * 16 + (ln & 15)] = sm; }
        __syncthreads();
        if (tid_ < RPG) {
            const int m = rg * RPG + tid_; const float* lg = lgt + tid_ * 48;
            float gl[4], el[32];
#pragma unroll
            for (int g = 0; g < 4; ++g) gl[g] = lg[g] + p.b_rg[l * 4 + g];
#pragma unroll
            for (int e = 0; e < 32; ++e) el[e] = lg[4 + e] + p.b_re[l * 32 + e];
            int gs = 0; float gm = gl[0];
#pragma unroll
            for (int g = 1; g < 4; ++g) if (gl[g] > gm) { gm = gl[g]; gs = g; }
            float den = 0.f;
#pragma unroll
            for (int g = 0; g < 4; ++g) den += expf(gl[g] - gm);
            const float pg = 1.0f / den;
            float v1 = -3e38f, v2 = -3e38f; int i1 = 0, i2 = 0;
#pragma unroll
            for (int j = 0; j < 8; ++j) {
                const float vv = gs == 0 ? el[j] : gs == 1 ? el[8 + j] : gs == 2 ? el[16 + j] : el[24 + j];
                if (vv > v1) { v2 = v1; i2 = i1; v1 = vv; i1 = j; } else if (vv > v2) { v2 = vv; i2 = j; }
            }
            const float e2 = expf(v2 - v1), w1 = pg / (1.0f + e2), w2 = pg * e2 / (1.0f + e2);
            const int ea = gs * 8 + i1, eb = gs * 8 + i2;
            p.rE[2 * m] = ea; p.rE[2 * m + 1] = eb; p.rW[2 * m] = w1; p.rW[2 * m + 1] = w2;
            eids[2 * tid_] = ea; eids[2 * tid_ + 1] = eb;
        }
        __syncthreads();
        if (tid_ < 2 * RPG) { const int e = eids[tid_]; int rk = 0; for (int j = 0; j < tid_; ++j) rk += (eids[j] == e) ? 1 : 0; p.rPos[2 * (rg * RPG) + tid_] = rk; }
        else if (tid_ >= 128 && tid_ < 160) { const int e = tid_ - 128; int c = 0; for (int j = 0; j < 2 * RPG; ++j) c += (eids[j] == e) ? 1 : 0; p.hist[rg * 32 + e] = c; }
        __syncthreads();
    }
}

__device__ __forceinline__ void ph_dispatch_fast(const Params& p, int l, int nrows, char* lds) {
    const int tid_ = opq_tid(), bid_ = opq_bid(); (void)tid_; (void)bid_;
    const int RPG = router_rpg(nrows), nrg = nrows / RPG, e = tid_ & 31, part = tid_ >> 5;
    int* tot = (int*)lds; int* pst = tot + 32; int* pre = pst + 32; int* red = pre + 32;
    { int s = 0; for (int b = part; b < nrg; b += 8) s += p.hist[b * 32 + e]; red[part * 32 + e] = s; }
    __syncthreads();
    if (tid_ < 32) { int s = 0; for (int q = 0; q < 8; ++q) s += red[q * 32 + tid_]; tot[tid_] = s; }
    __syncthreads();
    if (tid_ < 32) { int s = 0; for (int j = 0; j < tid_; ++j) s += (tot[j] + 127) & ~127; pst[tid_] = s; if (bid_ == 0) p.cnt[l * NEXP + tid_] = tot[tid_]; }
    for (int rg = bid_; rg < nrg; rg += gridDim.x) {
        __syncthreads();
        { int s = 0; for (int b = part; b < rg; b += 8) s += p.hist[b * 32 + e]; red[part * 32 + e] = s; }
        __syncthreads();
        if (tid_ < 32) { int s = 0; for (int q = 0; q < 8; ++q) s += red[q * 32 + tid_]; pre[tid_] = s; }
        __syncthreads();
        if (tid_ < 2 * RPG) { const int i = 2 * (rg * RPG) + tid_, ee = p.rE[i], slot = pst[ee] + pre[ee] + p.rPos[i]; p.rSlot[i] = slot; p.slotTok[slot] = i >> 1; }
    }
}

__device__ __forceinline__ void ph_final_fast(const Params& p, int l, int nrows, bool next_h) {
    const int tid_ = opq_tid(), bid_ = opq_bid(); (void)tid_; (void)bid_;
    const int lane = tid_ & 63, gw = bid_ * 4 + (tid_ >> 6), nw = gridDim.x * 4;
    constexpr int R = 2;
    const f32x4* g2 = (const f32x4*)(p.ln2_g + (size_t)l * D) + lane; const f32x4* b2 = (const f32x4*)(p.ln2_b + (size_t)l * D) + lane;
    for (int m0 = gw * R; m0 < nrows; m0 += nw * R) {
        f32x4 v[R][DV]; float mu[R], rstd[R];
#pragma unroll
        for (int r = 0; r < R; ++r) { const int m = m0 + r; const f32x4* x1 = (const f32x4*)((m < TL) ? p.out + (size_t)m * D : p.XC + (size_t)(m - TL) * D) + lane;
            const f32x4* md = (const f32x4*)modrow(p, l, m) + lane;
            const bf16_t* ya = p.YSb + (size_t)p.rSlot[2 * m] * D + 4 * lane; const bf16_t* yb = p.YSb + (size_t)p.rSlot[2 * m + 1] * D + 4 * lane;
            const float wa = p.rW[2 * m], wb = p.rW[2 * m + 1];
#pragma unroll
            for (int j = 0; j < DV; ++j) v[r][j] = x1[64 * j] * ALPHA + md[5 * (D / 4) + 64 * j] * (ld_bf16x4(ya + 256 * j) * wa + ld_bf16x4(yb + 256 * j) * wb); }
#pragma unroll
        for (int r = 0; r < R; ++r) row_stats(v[r], mu[r], rstd[r]);
#pragma unroll
        for (int r = 0; r < R; ++r) { const int m = m0 + r; f32x4* x1 = (f32x4*)((m < TL) ? p.out + (size_t)m * D : p.XC + (size_t)(m - TL) * D) + lane;
#pragma unroll
            for (int j = 0; j < DV; ++j) { v[r][j] = (v[r][j] - mu[r]) * rstd[r] * g2[64 * j] + b2[64 * j]; x1[64 * j] = v[r][j]; } }
        if (next_h) {
#pragma unroll
            for (int r = 0; r < R; ++r) row_stats(v[r], mu[r], rstd[r]);
#pragma unroll
            for (int r = 0; r < R; ++r) { const int m = m0 + r; const f32x4* mn = (const f32x4*)modrow(p, l + 1, m) + lane;
#pragma unroll
                for (int j = 0; j < DV; ++j) st_bf16x4(p.H + (size_t)m * D + 4 * (lane + 64 * j), (v[r][j] - mu[r]) * rstd[r] * (mn[D / 4 + 64 * j] + 1.0f) + mn[64 * j]); }
        }
    }
}

__device__ __forceinline__ void ph_mod_fast(const Params& p, char* lds) {
    const int tid_ = opq_tid(), bid_ = opq_bid(); (void)tid_; (void)bid_;
    constexpr int NR = NB + 1, NTASK = 2 * (6 * D / 64);
    if (bid_ >= NTASK) return;
    float* sc = (float*)lds;
    float* part = sc + NR * D;
    for (int i = tid_; i < NR * D; i += 256) { const int b = i / D, k = i % D; const float cv = b < NB ? p.c[(size_t)b * D + k] : p.c_ctx[k]; sc[i] = cv / (1.0f + __expf(-cv)); }
    __syncthreads();
    const int lane = tid_ & 63, wid = tid_ >> 6;
    for (int task = bid_; task < NTASK; task += gridDim.x) {
        const int ll = task / (6 * D / 64), col = 64 * (task % (6 * D / 64)) + lane;
        float acc[NR];
#pragma unroll
        for (int b = 0; b < NR; ++b) acc[b] = 0.f;
        const float* wp = p.w_mod + ((size_t)ll * D + wid * (D / 4)) * 6 * D + col;
#pragma unroll 16
        for (int k = 0; k < D / 4; ++k) { const float w = wp[(size_t)k * 6 * D];
#pragma unroll
            for (int b = 0; b < NR; ++b) acc[b] += sc[b * D + wid * (D / 4) + k] * w; }
#pragma unroll
        for (int b = 0; b < NR; ++b) part[(wid * NR + b) * 64 + lane] = acc[b];
        __syncthreads();
        for (int i = tid_; i < NR * 64; i += 256) { const int b = i / 64, cl = i % 64;
            p.mod[((size_t)ll * NR + b) * 6 * D + 64 * (task % (6 * D / 64)) + cl] = (part[(0 * NR + b) * 64 + cl] + part[(1 * NR + b) * 64 + cl]) + (part[(2 * NR + b) * 64 + cl] + part[(3 * NR + b) * 64 + cl]) + p.b_mod[(size_t)ll * 6 * D + 64 * (task % (6 * D / 64)) + cl]; }
        __syncthreads();
    }
}

template <bool SPLIT = false>
__device__ __forceinline__ void tr_item(const float* srcl, size_t ldw, bf16_t* dst, size_t ldd, float* scr, int lane) {
    float v[32];
#pragma unroll
    for (int i = 0; i < 32; ++i) v[i] = srcl ? srcl[(size_t)(2 * i + (lane >> 5)) * ldw] : 0.f;
#pragma unroll
    for (int i = 0; i < 32; ++i) scr[(2 * i + (lane >> 5)) * 33 + (lane & 31)] = v[i];
    LDS_WAIT();
    const int c = lane & 7;
#pragma unroll
    for (int j = 0; j < 4; ++j) { const int n = (lane >> 3) + 8 * j; const float* s = scr + (8 * c) * 33 + n;
        uint4 o; o.x = pk2(s[0], s[33]); o.y = pk2(s[2 * 33], s[3 * 33]); o.z = pk2(s[4 * 33], s[5 * 33]); o.w = pk2(s[6 * 33], s[7 * 33]);
        *(uint4*)(dst + (size_t)(SPLIT ? (n & 15) + 32 * (n >> 4) : n) * ldd + 8 * c) = o; }
    LDS_WAIT();
}
__device__ __forceinline__ void ph_prep_w_fast(const Params& p, int l, int part, char* lds) {
    const int tid_ = opq_tid(), bid_ = opq_bid(); (void)tid_; (void)bid_;
    const int lane = tid_ & 63, wid = tid_ >> 6, gw = bid_ * 4 + wid, nw = gridDim.x * 4;
    float* scr = (float*)(lds + wid * 8448);
    constexpr int I_IN = (D / 64) * (NINP / 32), I_OUT = (DMIX / 64) * (D / 32), I_GU1 = (D / 64) * (2 * DE / 32), I_D1 = (DE / 64) * (D / 32);
    constexpr int NITEMS = I_IN + I_OUT + NEXP * (I_GU1 + I_D1);
    const int it0 = part == 0 ? 0 : I_IN + I_OUT, it1 = part == 0 ? I_IN + I_OUT : NITEMS;
    for (int it = it0 + gw; it < it1; it += nw) {
        int r = it;
        if (r < I_IN) { const int kb = r / (NINP / 32), n0 = 32 * (r % (NINP / 32));
            const float* s = nullptr;
            if (n0 < N_IN) { const int oc = (n0 < ZA) ? n0 + A_IN : n0 - ZA; s = p.w_in + ((size_t)l * D + 64 * kb) * N_IN + oc + (lane & 31); }
            tr_item(s, N_IN, p.win_t + (size_t)n0 * D + 64 * kb, D, scr, lane); continue; }
        r -= I_IN;
        if (r < I_OUT) { const int kb = r / (D / 32), n0 = 32 * (r % (D / 32));
            tr_item(p.w_out + ((size_t)l * DMIX + 64 * kb) * D + n0 + (lane & 31), D, p.wout_t + (size_t)n0 * DMIX + 64 * kb, DMIX, scr, lane); continue; }
        r -= I_OUT;
        const int e = r / (I_GU1 + I_D1); r %= (I_GU1 + I_D1);
        if (r < I_GU1) { const int kb = r / (2 * DE / 32), q = r % (2 * DE / 32), up = q & 1, c0 = 32 * (q >> 1);
            const float* s = (up ? p.w_up : p.w_gate) + (((size_t)l * NEXP + e) * D + 64 * kb) * DE + c0 + (lane & 31);
            tr_item<true>(s, DE, p.wgu_t + ((size_t)e * 2 * DE + 2 * c0 + 16 * up) * D + 64 * kb, D, scr, lane); continue; }
        r -= I_GU1;
        { const int kb = r / (D / 32), n0 = 32 * (r % (D / 32));
            tr_item(p.w_down + (((size_t)l * NEXP + e) * DE + 64 * kb) * D + n0 + (lane & 31), D, p.wd_t + ((size_t)e * D + n0) * DE + 64 * kb, DE, scr, lane); }
    }
    if (part != 0) return;
    const long gt = (long)bid_ * blockDim.x + tid_, gs = (long)gridDim.x * blockDim.x;
    for (long i = gt; i < 2 * 256 * 64; i += gs) { const int k = (int)(i & 63), n = (int)((i >> 6) & 255), d = (int)(i >> 14);
        p.wupT[i] = f2bf(p.a_w_up[(((size_t)l * 2 + d) * 64 + k) * DA + n]); p.aupT[i] = f2bf(p.a_a_up[(((size_t)l * 2 + d) * 64 + k) * DA + n]); }
    for (long i = gt; i < 256 * 160; i += gs) { const int k = (int)(i % 160), n = (int)(i / 160); p.gupT[i] = f2bf(p.a_g_up[((size_t)l * 160 + k) * DA + n]); }
    for (long i = gt; i < (long)128 * D; i += gs) { const int n = (int)(i / D), k = (int)(i % D);
        const float w = n < 4 ? p.w_rg[((size_t)l * D + k) * 4 + n] : n < 36 ? p.w_re[((size_t)l * D + k) * 32 + n - 4] : 0.f;
        const bf16_t hb = f2bf(w); p.wrt[i] = hb; p.wrt[(size_t)128 * D + i] = f2bf(w - bf2f(hb)); }
}

__device__ __forceinline__ float tanh_fast(float x) { return 1.0f - 2.0f / (1.0f + __expf(2.0f * x)); }
__device__ __forceinline__ void ph_streams_s1(const Params& p, int l) {
    const int tid_ = opq_tid(), bid_ = opq_bid(); (void)tid_; (void)bid_;
    constexpr int NCH = A_IN / 8, NCHP = (NCH + 7) & ~7;
    const float* sh = p.a_shift + (size_t)l * 3 * A_IN;
    for (long it = (long)bid_ * 256 + tid_; it < (long)T * NCHP; it += (long)gridDim.x * 256) {
        const int m = (int)(it / NCHP), ch = (int)(it % NCHP), c0 = 8 * ch;
        const bool act = ch < NCH;
        int t, len;
        if (m < TL) { t = m % S; len = S; } else { t = (m - TL) % L; len = L; }
        float v[8];
#pragma unroll
        for (int e = 0; e < 8; ++e) v[e] = 0.f;
        if (act) {
            const bf16_t* z = p.Z + (size_t)m * ZP + ZA + c0;
            const bf16x8 zc = *(const bf16x8*)z;
            const f32x4 s1a = *(const f32x4*)(sh + A_IN + c0), s1b = *(const f32x4*)(sh + A_IN + c0 + 4);
#pragma unroll
            for (int e = 0; e < 8; ++e) v[e] = (e < 4 ? s1a[e] : s1b[e - 4]) * bf2f((bf16_t)zc[e]);
            if (t > 0) { const bf16x8 zp = *(const bf16x8*)(z - ZP); const f32x4 a = *(const f32x4*)(sh + c0), b = *(const f32x4*)(sh + c0 + 4);
#pragma unroll
                for (int e = 0; e < 8; ++e) v[e] += (e < 4 ? a[e] : b[e - 4]) * bf2f((bf16_t)zp[e]); }
            if (t < len - 1) { const bf16x8 zn = *(const bf16x8*)(z + ZP); const f32x4 a = *(const f32x4*)(sh + 2 * A_IN + c0), b = *(const f32x4*)(sh + 2 * A_IN + c0 + 4);
#pragma unroll
                for (int e = 0; e < 8; ++e) v[e] += (e < 4 ? a[e] : b[e - 4]) * bf2f((bf16_t)zn[e]); }
        }
        float nrm = 0.f;
        if (ch >= 32 && ch < 64) {
#pragma unroll
            for (int e = 0; e < 8; ++e) { const float t2 = v[e] * p.a_k_k[l * DA + c0 - 256 + e]; nrm += t2 * t2; } }
        nrm = sum8(nrm);
        if (!act) continue;
        if (c0 < 768) {
            float* dst = (c0 < 256 ? p.sR + (size_t)m * DA + c0 : c0 < 512 ? p.kT + (size_t)m * DA + c0 - 256 : p.sV + (size_t)m * DA + c0 - 512);
            *(f32x4*)dst = (f32x4){v[0], v[1], v[2], v[3]}; *(f32x4*)(dst + 4) = (f32x4){v[4], v[5], v[6], v[7]};
            if (ch >= 32 && ch < 64 && (ch & 7) == 0) p.kN[(size_t)m * 4 + ((ch - 32) >> 3)] = 1.0f / sqrtf(nrm + 1e-12f);
        } else {
            if (c0 < 896) {
#pragma unroll
                for (int e = 0; e < 8; ++e) v[e] = tanh_fast(v[e]); }
            else if (c0 >= 1024) {
#pragma unroll
                for (int e = 0; e < 8; ++e) v[e] = 1.0f / (1.0f + __expf(-v[e])); }
            uint4 o; o.x = pk2(v[0], v[1]); o.y = pk2(v[2], v[3]); o.z = pk2(v[4], v[5]); o.w = pk2(v[6], v[7]);
            *(uint4*)(p.LA + (size_t)m * 416 + c0 - 768) = o;
        }
    }
}
__device__ __forceinline__ void g_streams_s2(const Params& p, int l, char* lds) {
    const int tid_ = opq_tid(), bid_ = opq_bid(); (void)tid_; (void)bid_;
    constexpr int MT = T / 128;
    for (int job = bid_; job < 5 * MT * 2; job += gridDim.x) {
        const int type = job / (MT * 2), r = job % (MT * 2), tm = r >> 1, tn = r & 1;
        const int coff = type < 2 ? type * 64 : type < 4 ? 128 + (type - 2) * 64 : 256, K = type < 4 ? 64 : 160, d = type & 1;
        const bf16_t* Bt = type < 2 ? p.wupT + type * 256 * 64 : type < 4 ? p.aupT + (type - 2) * 256 * 64 : p.gupT;
        const bf16_t* a0 = p.LA + (size_t)(tm * 128 + STG_ROW(0)) * 416 + coff + STG_K; const bf16_t* a1 = p.LA + (size_t)(tm * 128 + STG_ROW(1)) * 416 + coff + STG_K;
        const bf16_t* b0 = Bt + (size_t)(tn * 128 + STG_ROW(0)) * K + STG_K; const bf16_t* b1 = Bt + (size_t)(tn * 128 + STG_ROW(1)) * K + STG_K;
        if (type < 2) gemm_tile(a0, a1, b0, b1, K, lds, [&](const f32x4 (&acc)[4][4], int wr, int wc, int fr, int fq) {
#pragma unroll
            for (int mi = 0; mi < 4; ++mi) { const int row = tm * 128 + wr * 64 + mi * 16 + fr;
#pragma unroll
                for (int n = 0; n < 4; ++n) { const int c = tn * 128 + wc * 64 + n * 16 + 4 * fq; const f32x4 w0 = *(const f32x4*)(p.a_w0 + (l * 2 + d) * DA + c); f32x4 o;
#pragma unroll
                    for (int e4 = 0; e4 < 4; ++e4) { const float ex = __expf(-(w0[e4] + acc[mi][n][e4]));
                        o[e4] = __expf(-0.60653065971f / (1.0f + ex)); }
                    *(f32x4*)(p.sW + ((size_t)d * T + row) * DA + c) = o; }
                asm volatile("" ::: "memory"); }
        });
        else if (type < 4) gemm_tile(a0, a1, b0, b1, K, lds, [&](const f32x4 (&acc)[4][4], int wr, int wc, int fr, int fq) {
#pragma unroll
            for (int mi = 0; mi < 4; ++mi) { const int row = tm * 128 + wr * 64 + mi * 16 + fr;
#pragma unroll
                for (int n = 0; n < 4; ++n) { const int c = tn * 128 + wc * 64 + n * 16 + 4 * fq;
                    const f32x4 a0v = *(const f32x4*)(p.a_a0 + (l * 2 + d) * DA + c), kkc = *(const f32x4*)(p.a_k_k + l * DA + c), kac = *(const f32x4*)(p.a_k_a + l * DA + c);
                    const size_t o = (size_t)row * DA + c, od = ((size_t)d * T + row) * DA + c;
                    const f32x4 k = *(const f32x4*)(p.kT + o); const float kn = p.kN[(size_t)row * 4 + (c >> 6)];
                    f32x4 kd, bo, kk;
#pragma unroll
                    for (int e4 = 0; e4 < 4; ++e4) { const float av = 1.0f / (1.0f + __expf(-(a0v[e4] + acc[mi][n][e4])));
                        kk[e4] = k[e4] * kkc[e4] * kn; kd[e4] = k[e4] * (1.0f + (av - 1.0f) * kac[e4]); bo[e4] = kk[e4] * av; }
                    *(f32x4*)(p.sKD + od) = kd; *(f32x4*)(p.sB + od) = bo; if (d == 0) *(f32x4*)(p.sKK + o) = kk; }
                asm volatile("" ::: "memory"); }
        });
        else gemm_tile(a0, a1, b0, b1, K, lds, [&](const f32x4 (&acc)[4][4], int wr, int wc, int fr, int fq) {
#pragma unroll
            for (int mi = 0; mi < 4; ++mi)
#pragma unroll
                for (int n = 0; n < 4; ++n) *(f32x4*)(p.sG + (size_t)(tm * 128 + wr * 64 + mi * 16 + fr) * DA + tn * 128 + wc * 64 + n * 16 + 4 * fq) = acc[mi][n];
        });
    }
}


typedef float f32x16 __attribute__((ext_vector_type(16)));
typedef short s16x4 __attribute__((ext_vector_type(4)));
typedef unsigned u32x4_t __attribute__((ext_vector_type(4)));
typedef float f32x2_t __attribute__((ext_vector_type(2)));
typedef __bf16 bf16x2_t __attribute__((ext_vector_type(2)));
__device__ __forceinline__ unsigned cvtpk(float lo, float hi) { f32x2_t v = {lo, hi}; bf16x2_t b = __builtin_convertvector(v, bf16x2_t); return __builtin_bit_cast(unsigned, b); }
__device__ __forceinline__ int crow(int r, int hi) { return (r & 3) + 8 * (r >> 2) + 4 * hi; }
__device__ __forceinline__ float xmax32(float v) { float a = v, b = v; asm volatile("s_nop 1\n\tv_permlane32_swap_b32 %0, %1" : "+v"(a), "+v"(b)); return fmaxf(a, b); }
__device__ __forceinline__ float xsum32(float v) { float a = v, b = v; asm volatile("s_nop 1\n\tv_permlane32_swap_b32 %0, %1" : "+v"(a), "+v"(b)); return a + b; }

template <class MaskF>
__device__ __forceinline__ void attn_tile(const bf16x8 (&qf)[4], const bf16_t* krow, const bf16_t* vt0, const bf16_t* vt1, const MaskF& mask,
                                          float& m_run, float& l_run, f32x16& o0, f32x16& o1, int hi) {
    f32x16 s;
#pragma unroll
    for (int r = 0; r < 16; ++r) s[r] = 0.f;
#pragma unroll
    for (int ks = 0; ks < 4; ++ks) { const bf16x8 kf = *(const bf16x8*)(krow + 16 * ks); s = __builtin_amdgcn_mfma_f32_32x32x16_bf16(kf, qf[ks], s, 0, 0, 0); }
    float mx = -INFINITY;
#pragma unroll
    for (int r = 0; r < 16; ++r) { s[r] = mask(crow(r, hi), s[r] * ATT_SCALE); mx = fmaxf(mx, s[r]); }
    mx = xmax32(mx);
    const float mn = fmaxf(m_run, mx), alpha = __expf(m_run - mn);
    m_run = mn;
    float ps = 0.f;
#pragma unroll
    for (int r = 0; r < 16; ++r) { s[r] = __expf(s[r] - mn); ps += s[r]; }
    l_run = l_run * alpha + ps;
#pragma unroll
    for (int r = 0; r < 16; ++r) { o0[r] *= alpha; o1[r] *= alpha; }
#pragma unroll
    for (int s2 = 0; s2 < 2; ++s2) {
        u32x4_t pw; pw[0] = cvtpk(s[8 * s2], s[8 * s2 + 1]); pw[1] = cvtpk(s[8 * s2 + 2], s[8 * s2 + 3]); pw[2] = cvtpk(s[8 * s2 + 4], s[8 * s2 + 5]); pw[3] = cvtpk(s[8 * s2 + 6], s[8 * s2 + 7]);
        const bf16x8 pb = __builtin_bit_cast(bf16x8, pw);
        const s16x4 a0 = *(const s16x4*)(vt0 + 16 * s2), a1 = *(const s16x4*)(vt0 + 16 * s2 + 8);
        const s16x4 c0 = *(const s16x4*)(vt1 + 16 * s2), c1 = *(const s16x4*)(vt1 + 16 * s2 + 8);
        o0 = __builtin_amdgcn_mfma_f32_32x32x16_bf16(__builtin_shufflevector(a0, a1, 0, 1, 2, 3, 4, 5, 6, 7), pb, o0, 0, 0, 0);
        o1 = __builtin_amdgcn_mfma_f32_32x32x16_bf16(__builtin_shufflevector(c0, c1, 0, 1, 2, 3, 4, 5, 6, 7), pb, o1, 0, 0, 0);
    }
}
struct NoMask { __device__ __forceinline__ float operator()(int, float v) const { return v; } };

__device__ __forceinline__ void ph_attn_mfma(const Params& p, int l, bool with_ctx) {
    const int tid_ = opq_tid(), bid_ = opq_bid(); (void)tid_; (void)bid_;
    const int lane = tid_ & 63, hi = lane >> 5, ql = lane & 31;
    const int gw = bid_ * 4 + (tid_ >> 6), nw = gridDim.x * 4;
    constexpr int NQT = S / 32, NCT = L / 32, N_LAT = NB * 6 * NQT, N_CTX = NB * 6 * NCT;
    const int ntask = 2 * N_LAT + (with_ctx ? 2 * N_CTX : 0);
    for (int task = gw; task < ntask; task += nw) {
        bool isC, isCtx; int r;
        if (task < N_LAT) { isC = true; isCtx = false; r = task; }
        else if (task < 2 * N_LAT) { isC = false; isCtx = false; r = task - N_LAT; }
        else { r = task - 2 * N_LAT; isCtx = true; isC = r >= N_CTX; if (isC) r -= N_CTX; }
        const int nqt = isCtx ? NCT : NQT, qt = r % nqt, h = (r / nqt) % 6, b = r / (nqt * 6);
        const int m = isCtx ? TL + b * L + 32 * qt + ql : b * S + 32 * qt + ql;
        const int qcol = isC ? ZQN + h * 64 : ZQB + h * 64, kcol = isC ? ZKN + h * 64 : ZKB + (h / 3) * 64, hv = isC ? 2 + h : h / 3;
        bf16x8 qf[4];
        { const bf16_t* qp = p.Z + (size_t)m * ZP + qcol + 8 * hi;
#pragma unroll
          for (int ks = 0; ks < 4; ++ks) qf[ks] = *(const bf16x8*)(qp + 16 * ks); }
        const bf16_t* kc0 = p.Z + (size_t)(TL + b * L + ql) * ZP + kcol + 8 * hi;
        const bf16_t* kl0 = p.Z + (size_t)(b * S + ql) * ZP + kcol + 8 * hi;
        const bf16_t* vt0 = p.VT + ((size_t)(b * 8 + hv) * 64 + ql) * PU + 4 * hi; const bf16_t* vt1 = vt0 + (size_t)32 * PU;
        f32x16 o0, o1;
#pragma unroll
        for (int rr = 0; rr < 16; ++rr) { o0[rr] = 0.f; o1[rr] = 0.f; }
        float m_run, l_run;
        if (isC) { m_run = -1e30f; l_run = 0.f; } else { m_run = p.b_sink[l * 6 + h]; l_run = hi == 0 ? 1.0f : 0.f; }
#pragma unroll 1
        for (int i = 0; i < NCT; ++i) attn_tile(qf, kc0 + (size_t)(32 * i) * ZP, vt0 + 32 * i, vt1 + 32 * i, NoMask(), m_run, l_run, o0, o1, hi);
        if (!isCtx) {
            if (!isC) {
#pragma unroll 1
                for (int jt = qt - 4; jt <= qt + 4; ++jt) {
                    if (jt < 0 || jt >= NQT) continue;
                    const bf16_t* kr = kl0 + (size_t)(32 * jt) * ZP; const bf16_t* v0 = vt0 + L + 32 * jt; const bf16_t* v1 = vt1 + L + 32 * jt;
                    if (jt == qt - 4 || jt == qt + 4) { const int base = 32 * (jt - qt) - ql;
                        attn_tile(qf, kr, v0, v1, [&](int ko, float v) { const int rel = base + ko; return (rel >= -128 && rel <= 128) ? v : -INFINITY; }, m_run, l_run, o0, o1, hi); }
                    else attn_tile(qf, kr, v0, v1, NoMask(), m_run, l_run, o0, o1, hi);
                }
            } else {
                constexpr int ROWS = S / GRID_W;
                const int gr = qt >> 1, c = 32 * (qt & 1) + ql;
                int r0 = gr - 4; r0 = r0 < 0 ? 0 : (r0 > ROWS - 8 ? ROWS - 8 : r0);
                int c0 = c - 8; c0 = c0 < 0 ? 0 : (c0 > GRID_W - 16 ? GRID_W - 16 : c0);
                const float* rpb = p.c_rpb + ((size_t)l * 6 + h) * 15 * 31;
#pragma unroll 1
                for (int a = 0; a < 8; ++a) {
                    const int kr_ = r0 + a; const float* rp = rpb + (kr_ - gr + 7) * 31 + 15 - c;
#pragma unroll 1
                    for (int ct = 0; ct < 2; ++ct) {
                        const int t0 = kr_ * GRID_W + 32 * ct;
                        attn_tile(qf, kl0 + (size_t)t0 * ZP, vt0 + L + t0, vt1 + L + t0,
                                  [&](int ko, float v) { const int kc = 32 * ct + ko; return (kc >= c0 && kc < c0 + 16) ? v + rp[kc] : -INFINITY; }, m_run, l_run, o0, o1, hi);
                    }
                }
            }
        }
        const float lt = xsum32(l_run), inv = 1.0f / lt;
        bf16_t* op = p.MIX + (size_t)m * DMIX + (isC ? 640 : 256) + h * 64 + 4 * hi;
#pragma unroll
        for (int g = 0; g < 4; ++g) {
            st_bf16x4(op + 8 * g, (f32x4){o0[4 * g] * inv, o0[4 * g + 1] * inv, o0[4 * g + 2] * inv, o0[4 * g + 3] * inv});
            st_bf16x4(op + 32 + 8 * g, (f32x4){o1[4 * g] * inv, o1[4 * g + 1] * inv, o1[4 * g + 2] * inv, o1[4 * g + 3] * inv});
        }
    }
}


template <class MaskF>
__device__ __forceinline__ void attn_tile_lds(const bf16x8 (&qf)[4], const char* ks, const char* vs, const MaskF& mask, float& m_run, float& l_run, f32x16& o0, f32x16& o1, int ql, int hi) {
    f32x16 s;
#pragma unroll
    for (int r = 0; r < 16; ++r) s[r] = 0.f;
#pragma unroll
    for (int k4 = 0; k4 < 4; ++k4) { const bf16x8 kf = *(const bf16x8*)(ks + ql * 128 + (((2 * k4 + hi) ^ (ql & 7)) * 16)); s = __builtin_amdgcn_mfma_f32_32x32x16_bf16(kf, qf[k4], s, 0, 0, 0); }
    float mx = -INFINITY;
#pragma unroll
    for (int r = 0; r < 16; ++r) { s[r] = mask(crow(r, hi), s[r] * ATT_SCALE); mx = fmaxf(mx, s[r]); }
    mx = xmax32(mx);
    const float mn = fmaxf(m_run, mx), alpha = __expf(m_run - mn);
    m_run = mn;
    float ps = 0.f;
#pragma unroll
    for (int r = 0; r < 16; ++r) { s[r] = __expf(s[r] - mn); ps += s[r]; }
    l_run = l_run * alpha + ps;
#pragma unroll
    for (int r = 0; r < 16; ++r) { o0[r] *= alpha; o1[r] *= alpha; }
    const int sw0 = (ql >> 2) & 3;
#pragma unroll
    for (int s2 = 0; s2 < 2; ++s2) {
        u32x4_t pw; pw[0] = cvtpk(s[8 * s2], s[8 * s2 + 1]); pw[1] = cvtpk(s[8 * s2 + 2], s[8 * s2 + 3]); pw[2] = cvtpk(s[8 * s2 + 4], s[8 * s2 + 5]); pw[3] = cvtpk(s[8 * s2 + 6], s[8 * s2 + 7]);
        const bf16x8 pb = __builtin_bit_cast(bf16x8, pw);
        const char* v0 = vs + ql * 64 + 8 * hi; const char* v1 = v0 + 32 * 64;
        const s16x4 a0 = *(const s16x4*)(v0 + (((2 * s2) ^ sw0) * 16)), a1 = *(const s16x4*)(v0 + (((2 * s2 + 1) ^ sw0) * 16));
        const s16x4 c0 = *(const s16x4*)(v1 + (((2 * s2) ^ sw0) * 16)), c1 = *(const s16x4*)(v1 + (((2 * s2 + 1) ^ sw0) * 16));
        o0 = __builtin_amdgcn_mfma_f32_32x32x16_bf16(__builtin_shufflevector(a0, a1, 0, 1, 2, 3, 4, 5, 6, 7), pb, o0, 0, 0, 0);
        o1 = __builtin_amdgcn_mfma_f32_32x32x16_bf16(__builtin_shufflevector(c0, c1, 0, 1, 2, 3, 4, 5, 6, 7), pb, o1, 0, 0, 0);
    }
}

__device__ __forceinline__ void ph_attn_blk(const Params& p, int l, bool with_ctx, int first_blk, char* lds) {
    const int tid_ = opq_tid(), bid_ = opq_bid(); (void)tid_; (void)bid_;
    if (bid_ < first_blk) return;
    const int lane = tid_ & 63, hi = lane >> 5, ql = lane & 31, wid = tid_ >> 6;
    constexpr int NQG = S / 128, NCG = L / 128, ROWS = S / GRID_W, N_LAT = NB * 6 * NQG, N_CTX = NB * 6 * NCG, TPB = (S + L) / 32;
    const int ntask = 2 * N_LAT + (with_ctx ? 2 * N_CTX : 0);
    const int krow = tid_ >> 3, kch = (tid_ & 7) ^ (krow & 7), vrow = tid_ >> 2, vpc = (tid_ & 3) ^ ((vrow >> 2) & 3);
    for (int task = bid_ - first_blk; task < ntask; task += gridDim.x - first_blk) {
        bool isC, isCtx; int r;
        if (task < N_LAT) { isC = true; isCtx = false; r = task; }
        else if (task < 2 * N_LAT) { isC = false; isCtx = false; r = task - N_LAT; }
        else { r = task - 2 * N_LAT; isCtx = true; isC = r >= N_CTX; if (isC) r -= N_CTX; }
        const int ng = isCtx ? NCG : NQG, g = r % ng, h = (r / ng) % 6, b = r / (ng * 6);
        const int qt = 4 * g + wid;
        const int m = isCtx ? TL + b * L + 32 * qt + ql : b * S + 32 * qt + ql;
        const int qcol = isC ? ZQN + h * 64 : ZQB + h * 64, kcol = isC ? ZKN + h * 64 : ZKB + (h / 3) * 64, hv = isC ? 2 + h : h / 3;
        bf16x8 qf[4];
        { const bf16_t* qp = p.Z + (size_t)m * ZP + qcol + 8 * hi;
#pragma unroll
          for (int k4 = 0; k4 < 4; ++k4) qf[k4] = *(const bf16x8*)(qp + 16 * k4); }
        int lo = 0, hi_t = 0, gr0 = 0;
        if (!isCtx) {
            if (!isC) { lo = 4 * g - 4; hi_t = 4 * g + 8; lo = lo < 0 ? 0 : lo; hi_t = hi_t > S / 32 ? S / 32 : hi_t; }
            else { const int ra = 2 * g, rb = 2 * g + 1; int r0a = ra - 4; r0a = r0a < 0 ? 0 : (r0a > ROWS - 8 ? ROWS - 8 : r0a); int r0b = rb - 4; r0b = r0b < 0 ? 0 : (r0b > ROWS - 8 ? ROWS - 8 : r0b);
                   lo = 2 * r0a; hi_t = 2 * (r0b + 8); gr0 = 0; }
        }
        const int ntile = L / 32 + (hi_t - lo);
        const bf16_t* kbase = p.Z + (size_t)krow * ZP + kcol + 8 * kch;
        const bf16_t* vbase = p.VT + ((size_t)(b * 8 + hv) * 64 + vrow) * PU + 8 * vpc;
#define AT_TOK(i_) ((i_) < L / 32 ? 32 * (i_) : L + 32 * (lo + (i_) - L / 32))
#define AT_STAGE(i_) do { const int u0_ = AT_TOK(i_); const int zrow_ = u0_ < L ? TL + b * L + u0_ : b * S + (u0_ - L); char* sl_ = lds + ((i_) % 3) * 8192 + tid_ * 16; \
            __builtin_amdgcn_global_load_lds((const unsigned*)(kbase + (size_t)zrow_ * ZP), (__attribute__((address_space(3))) unsigned*)(sl_), 16, 0, 0); \
            __builtin_amdgcn_global_load_lds((const unsigned*)(vbase + u0_), (__attribute__((address_space(3))) unsigned*)(sl_ + 4096), 16, 0, 0); } while (0)
        f32x16 o0, o1;
#pragma unroll
        for (int rr = 0; rr < 16; ++rr) { o0[rr] = 0.f; o1[rr] = 0.f; }
        float m_run, l_run;
        if (isC) { m_run = -1e30f; l_run = 0.f; } else { m_run = p.b_sink[l * 6 + h]; l_run = hi == 0 ? 1.0f : 0.f; }
        const int gr = qt >> 1, c = 32 * (qt & 1) + ql;
        int r0 = gr - 4; r0 = r0 < 0 ? 0 : (r0 > ROWS - 8 ? ROWS - 8 : r0);
        int c0 = c - 8; c0 = c0 < 0 ? 0 : (c0 > GRID_W - 16 ? GRID_W - 16 : c0);
        float* rpb = (float*)(lds + 24576);
        if (isC && !isCtx) for (int i = tid_; i < 15 * 31; i += 256) rpb[i] = p.c_rpb[((size_t)l * 6 + h) * 15 * 31 + i];
        AT_STAGE(0);
        if (ntile > 1) AT_STAGE(1);
#pragma unroll 1
        for (int i = 0; i < ntile; ++i) {
            if (i + 1 < ntile) asm volatile("s_waitcnt vmcnt(2)" ::: "memory"); else asm volatile("s_waitcnt vmcnt(0)" ::: "memory");
            asm volatile("s_waitcnt lgkmcnt(0)" ::: "memory");
            __builtin_amdgcn_s_barrier();
            if (i + 2 < ntile) AT_STAGE(i + 2);
            const char* ks = lds + (i % 3) * 8192; const char* vs = ks + 4096;
            if (i < L / 32) attn_tile_lds(qf, ks, vs, NoMask(), m_run, l_run, o0, o1, ql, hi);
            else {
                const int jt = lo + i - L / 32;
                if (!isC) {
                    const int dq = jt - qt;
                    if (dq >= -3 && dq <= 3) attn_tile_lds(qf, ks, vs, NoMask(), m_run, l_run, o0, o1, ql, hi);
                    else if (dq == -4 || dq == 4) { const int base = 32 * dq - ql;
                        attn_tile_lds(qf, ks, vs, [&](int ko, float v) { const int rel = base + ko; return (rel >= -128 && rel <= 128) ? v : -INFINITY; }, m_run, l_run, o0, o1, ql, hi); }
                } else {
                    const int kr_ = jt >> 1, ct = jt & 1;
                    if (kr_ >= r0 && kr_ < r0 + 8) { const float* rp = rpb + (kr_ - gr + 7) * 31 + 15 - c;
                        attn_tile_lds(qf, ks, vs, [&](int ko, float v) { const int kc = 32 * ct + ko; return (kc >= c0 && kc < c0 + 16) ? v + rp[kc] : -INFINITY; }, m_run, l_run, o0, o1, ql, hi); }
                }
            }
        }
        asm volatile("s_waitcnt lgkmcnt(0)" ::: "memory");
        __builtin_amdgcn_s_barrier();
#undef AT_STAGE
#undef AT_TOK
        (void)gr0;
        const float lt = xsum32(l_run), inv = 1.0f / lt;
        bf16_t* op = p.MIX + (size_t)m * DMIX + (isC ? 640 : 256) + h * 64 + 4 * hi;
#pragma unroll
        for (int gq = 0; gq < 4; ++gq) {
            st_bf16x4(op + 8 * gq, (f32x4){o0[4 * gq] * inv, o0[4 * gq + 1] * inv, o0[4 * gq + 2] * inv, o0[4 * gq + 3] * inv});
            st_bf16x4(op + 32 + 8 * gq, (f32x4){o1[4 * gq] * inv, o1[4 * gq + 1] * inv, o1[4 * gq + 2] * inv, o1[4 * gq + 3] * inv});
        }
    }
}

#define RNB " row_newbcast:%c[n] row_mask:0xf bank_mask:0xf\n\t"
template <int N, bool FIRST>
__device__ __forceinline__ void dpp_dot4(float& a0, float& a1, float& a2, float& a3, const f32x4& v, float s0, float s1, float s2, float s3) {
    if (FIRST) asm volatile("s_nop 1");
    asm("v_fmac_f32_dpp %0, %4, %8" RNB "v_fmac_f32_dpp %1, %5, %9" RNB "v_fmac_f32_dpp %2, %6, %10" RNB "v_fmac_f32_dpp %3, %7, %11" RNB
        : "+v"(a0), "+v"(a1), "+v"(a2), "+v"(a3) : "v"(v[0]), "v"(v[1]), "v"(v[2]), "v"(v[3]), "v"(s0), "v"(s1), "v"(s2), "v"(s3), [n] "i"(N));
}
template <int N, bool FIRST>
__device__ __forceinline__ void dpp_upd4s(float& s0, float& s1, float& s2, float& s3, float& y0, float& y1, float& y2, float& y3,
                                          const f32x4& w, const f32x4& b, const f32x4& kd, const f32x4& r, float nsk, float vv) {
    if (FIRST) asm volatile("s_nop 1");
    asm("v_mul_f32_dpp %0, %8, %0" RNB "v_mul_f32_dpp %1, %9, %1" RNB "v_mul_f32_dpp %2, %10, %2" RNB "v_mul_f32_dpp %3, %11, %3" RNB
        "v_fmac_f32_dpp %0, %12, %24" RNB "v_fmac_f32_dpp %1, %13, %24" RNB "v_fmac_f32_dpp %2, %14, %24" RNB "v_fmac_f32_dpp %3, %15, %24" RNB
        "v_fmac_f32_dpp %0, %16, %25" RNB "v_fmac_f32_dpp %1, %17, %25" RNB "v_fmac_f32_dpp %2, %18, %25" RNB "v_fmac_f32_dpp %3, %19, %25" RNB
        "v_fmac_f32_dpp %4, %20, %0" RNB "v_fmac_f32_dpp %5, %21, %1" RNB "v_fmac_f32_dpp %6, %22, %2" RNB "v_fmac_f32_dpp %7, %23, %3" RNB
        : "+v"(s0), "+v"(s1), "+v"(s2), "+v"(s3), "+v"(y0), "+v"(y1), "+v"(y2), "+v"(y3)
        : "v"(w[0]), "v"(w[1]), "v"(w[2]), "v"(w[3]), "v"(b[0]), "v"(b[1]), "v"(b[2]), "v"(b[3]), "v"(kd[0]), "v"(kd[1]), "v"(kd[2]), "v"(kd[3]),
          "v"(r[0]), "v"(r[1]), "v"(r[2]), "v"(r[3]), "v"(nsk), "v"(vv), [n] "i"(N));
}
template <int N, bool FIRST>
__device__ __forceinline__ void dpp_upd4p(float& s0, float& s1, float& s2, float& s3, float& y0, float& y1, float& y2, float& y3,
                                          const f32x4& w, const f32x4& b, const f32x4& r, float nsk) {
    if (FIRST) asm volatile("s_nop 1");
    asm("v_mul_f32_dpp %0, %8, %0" RNB "v_mul_f32_dpp %1, %9, %1" RNB "v_mul_f32_dpp %2, %10, %2" RNB "v_mul_f32_dpp %3, %11, %3" RNB
        "v_fmac_f32_dpp %0, %12, %20" RNB "v_fmac_f32_dpp %1, %13, %20" RNB "v_fmac_f32_dpp %2, %14, %20" RNB "v_fmac_f32_dpp %3, %15, %20" RNB
        "v_fmac_f32_dpp %4, %16, %0" RNB "v_fmac_f32_dpp %5, %17, %1" RNB "v_fmac_f32_dpp %6, %18, %2" RNB "v_fmac_f32_dpp %7, %19, %3" RNB
        : "+v"(s0), "+v"(s1), "+v"(s2), "+v"(s3), "+v"(y0), "+v"(y1), "+v"(y2), "+v"(y3)
        : "v"(w[0]), "v"(w[1]), "v"(w[2]), "v"(w[3]), "v"(b[0]), "v"(b[1]), "v"(b[2]), "v"(b[3]), "v"(r[0]), "v"(r[1]), "v"(r[2]), "v"(r[3]), "v"(nsk), [n] "i"(N));
}
template <int N, bool FIRST>
__device__ __forceinline__ void dpp_mul4(float& s0, float& s1, float& s2, float& s3, const f32x4& v) {
    if (FIRST) asm volatile("s_nop 1");
    asm("v_mul_f32_dpp %0, %4, %0" RNB "v_mul_f32_dpp %1, %5, %1" RNB "v_mul_f32_dpp %2, %6, %2" RNB "v_mul_f32_dpp %3, %7, %3" RNB
        : "+v"(s0), "+v"(s1), "+v"(s2), "+v"(s3) : "v"(v[0]), "v"(v[1]), "v"(v[2]), "v"(v[3]), [n] "i"(N));
}
template <int N>
__device__ __forceinline__ void dpp_fmacx4(float& s0, float& s1, float& s2, float& s3, const f32x4& v, float x) {
    asm("v_fmac_f32_dpp %0, %4, %8" RNB "v_fmac_f32_dpp %1, %5, %8" RNB "v_fmac_f32_dpp %2, %6, %8" RNB "v_fmac_f32_dpp %3, %7, %8" RNB
        : "+v"(s0), "+v"(s1), "+v"(s2), "+v"(s3) : "v"(v[0]), "v"(v[1]), "v"(v[2]), "v"(v[3]), "v"(x), [n] "i"(N));
}
template <int N> struct ScanRep {
    static __device__ __forceinline__ void dot8(float (&a)[8], const f32x4& v, const float (&st)[64]) {
        constexpr int h = (N & 1) * 4;
        dpp_dot4<N, N == 0>(a[h], a[h + 1], a[h + 2], a[h + 3], v, st[4 * N], st[4 * N + 1], st[4 * N + 2], st[4 * N + 3]);
        if constexpr (N < 15) ScanRep<N + 1>::dot8(a, v, st);
    }
    static __device__ __forceinline__ void dot(float& a0, float& a1, float& a2, float& a3, const f32x4& v, const float (&st)[64]) {
        dpp_dot4<N, N == 0>(a0, a1, a2, a3, v, st[4 * N], st[4 * N + 1], st[4 * N + 2], st[4 * N + 3]);
        if constexpr (N < 15) ScanRep<N + 1>::dot(a0, a1, a2, a3, v, st);
    }
    static __device__ __forceinline__ void mul(float (&st)[64], const f32x4& w) {
        dpp_mul4<N, N == 0>(st[4 * N], st[4 * N + 1], st[4 * N + 2], st[4 * N + 3], w);
        if constexpr (N < 15) ScanRep<N + 1>::mul(st, w);
    }
    static __device__ __forceinline__ void fmacx(float (&st)[64], const f32x4& v, float x) {
        dpp_fmacx4<N>(st[4 * N], st[4 * N + 1], st[4 * N + 2], st[4 * N + 3], v, x);
        if constexpr (N < 15) ScanRep<N + 1>::fmacx(st, v, x);
    }
};
__device__ __forceinline__ int scan_row(int b, int d, int pos) { return pos < L ? TL + b * L + (d ? L - 1 - pos : pos) : b * S + (d ? S - 1 - (pos - L) : pos - L); }

template <bool ISP>
__device__ __forceinline__ void scan_task(const Params& p, int c, int s, int lane) {
    const int h = c & 3, b = (c >> 2) % NB, d = (c >> 2) / NB, pos0 = SEGLEN * s;
    const int q = 4 * (lane & 15);
    const float* bkk = p.sKK + h * 64 + q; const float* br = p.sR + h * 64 + q; const float* bw = p.sW + (size_t)d * T * DA + h * 64 + q; const float* bb_ = p.sB + (size_t)d * T * DA + h * 64 + q;
    const float* bkd = p.sKD + (size_t)d * T * DA + h * 64 + q; const float* bv = p.sV + h * 64 + lane;
    float* by = (ISP ? p.PV : p.Y) + (size_t)d * T * DA + h * 64 + lane;
    float st[64];
#pragma unroll
    for (int k = 0; k < 64; ++k) st[k] = (ISP && k == lane) ? 1.0f : 0.f;
    size_t mo = (size_t)scan_row(b, d, pos0) * DA;
    f32x4 kk = *(const f32x4*)(bkk + mo), w = *(const f32x4*)(bw + mo), bb = *(const f32x4*)(bb_ + mo), r = *(const f32x4*)(br + mo), kd = w; float vv = 0.f;
    if (!ISP) { kd = *(const f32x4*)(bkd + mo); vv = bv[mo]; }
#pragma unroll 1
    for (int i = 0; i < SEGLEN; ++i) {
        const size_t mn = (size_t)scan_row(b, d, pos0 + (i + 1 < SEGLEN ? i + 1 : i)) * DA;
        const f32x4 nkk = *(const f32x4*)(bkk + mn), nw = *(const f32x4*)(bw + mn), nb = *(const f32x4*)(bb_ + mn), nr = *(const f32x4*)(br + mn);
        f32x4 nkd = nw; float nv = 0.f;
        if (!ISP) { nkd = *(const f32x4*)(bkd + mn); nv = bv[mn]; }
        float a[8] = {0.f, 0.f, 0.f, 0.f, 0.f, 0.f, 0.f, 0.f};
        ScanRep<0>::dot8(a, kk, st);
        const float nsk = -(((a[0] + a[1]) + (a[2] + a[3])) + ((a[4] + a[5]) + (a[6] + a[7])));
        ScanRep<0>::mul(st, w);
        ScanRep<0>::fmacx(st, bb, nsk);
        if (!ISP) ScanRep<0>::fmacx(st, kd, vv);
        float y[8] = {0.f, 0.f, 0.f, 0.f, 0.f, 0.f, 0.f, 0.f};
        ScanRep<0>::dot8(y, r, st);
        by[mo] = ((y[0] + y[1]) + (y[2] + y[3])) + ((y[4] + y[5]) + (y[6] + y[7]));
        kk = nkk; w = nw; bb = nb; r = nr; kd = nkd; vv = nv; mo = mn;
    }
    if (s < NSG - 1) {
        float* dst = (ISP ? p.PS : p.QS) + (((size_t)c * NSG + s) * 64 + lane) * 64;
#pragma unroll
        for (int k4 = 0; k4 < 16; ++k4) *(f32x4*)(dst + 4 * k4) = (f32x4){st[4 * k4], st[4 * k4 + 1], st[4 * k4 + 2], st[4 * k4 + 3]};
    }
}
__device__ __forceinline__ void ph_scan_fast(const Params& p) {
    const int tid_ = opq_tid(), bid_ = opq_bid(); (void)tid_; (void)bid_;
    const int lane = tid_ & 63, gw = bid_ * 4 + (tid_ >> 6), nw = gridDim.x * 4;
    constexpr int NS_T = 64 * NSG, NP_T = 64 * (NSG - 1);
    const int G = gridDim.x, wv = tid_ >> 6; (void)gw; (void)nw;
    for (int tsk = wv * G + bid_; tsk < NS_T + NP_T; tsk += 4 * G) {
        const int t2 = __builtin_amdgcn_readfirstlane(tsk);
        if (t2 < NS_T) scan_task<false>(p, t2 & 63, t2 >> 6, lane);
        else scan_task<true>(p, (t2 - NS_T) & 63, 1 + ((t2 - NS_T) >> 6), lane);
    }
}
__device__ __forceinline__ void ph_combine(const Params& p, char* lds) {
    const int tid_ = opq_tid(), bid_ = opq_bid(); (void)tid_; (void)bid_; (void)lds;
    if (bid_ >= 64) return;
    const int lane = tid_ & 63, c = bid_, cb = tid_ >> 6, q = lane >> 4, i16 = lane & 15, v = 16 * cb + i16;
    const float* QSc = p.QS + (size_t)c * NSG * 4096; const float* PSc = p.PS + (size_t)c * NSG * 4096; float* SSg = p.SS + (size_t)c * NSG * 4096;
    f32x4 acc[4];
#pragma unroll
    for (int ro = 0; ro < 4; ++ro) acc[ro] = *(const f32x4*)(QSc + v * 64 + 16 * ro + 4 * q);
#pragma unroll 1
    for (int s = 1; s < NSG; ++s) {
#pragma unroll
        for (int ro = 0; ro < 4; ++ro)
#pragma unroll
            for (int j = 0; j < 4; ++j) SSg[(size_t)s * 4096 + (16 * ro + 4 * q + j) * 64 + v] = acc[ro][j];
        if (s == NSG - 1) break;
        const float* P = PSc + (size_t)s * 4096 + (4 * q) * 64 + i16;
        float a[4][4][4];
#pragma unroll
        for (int rb = 0; rb < 4; ++rb)
#pragma unroll
            for (int kk = 0; kk < 4; ++kk)
#pragma unroll
                for (int ro = 0; ro < 4; ++ro) a[rb][kk][ro] = P[(16 * rb + kk) * 64 + 16 * ro];
#pragma unroll
        for (int rb = 0; rb < 4; ++rb) asm volatile("" : "+v"(a[rb][0][0]), "+v"(a[rb][0][1]), "+v"(a[rb][0][2]), "+v"(a[rb][0][3]), "+v"(a[rb][1][0]), "+v"(a[rb][1][1]), "+v"(a[rb][1][2]), "+v"(a[rb][1][3]),
                                                         "+v"(a[rb][2][0]), "+v"(a[rb][2][1]), "+v"(a[rb][2][2]), "+v"(a[rb][2][3]), "+v"(a[rb][3][0]), "+v"(a[rb][3][1]), "+v"(a[rb][3][2]), "+v"(a[rb][3][3]));
        f32x4 nacc[4];
#pragma unroll
        for (int ro = 0; ro < 4; ++ro) nacc[ro] = *(const f32x4*)(QSc + (size_t)s * 4096 + v * 64 + 16 * ro + 4 * q);
#pragma unroll
        for (int rb = 0; rb < 4; ++rb)
#pragma unroll
            for (int kk = 0; kk < 4; ++kk)
#pragma unroll
                for (int ro = 0; ro < 4; ++ro) nacc[ro] = __builtin_amdgcn_mfma_f32_16x16x4f32(a[rb][kk][ro], acc[rb][kk], nacc[ro], 0, 0, 0);
#pragma unroll
        for (int ro = 0; ro < 4; ++ro) acc[ro] = nacc[ro];
    }
}
__device__ __forceinline__ void ph_rwkv_out_fast(const Params& p, int l, bool with_ctx) {
    const int tid_ = opq_tid(), bid_ = opq_bid(); (void)tid_; (void)bid_;
    const int lane = tid_ & 63, gw = bid_ * 4 + (tid_ >> 6), nw = gridDim.x * 4;
    constexpr int TOK = 16, NLT = NB * (S / TOK) * 4, NCTK = NB * (L / TOK) * 4;
    const int ntask = NLT + (with_ctx ? NCTK : 0);
    for (int tsk = gw; tsk < ntask; tsk += nw) {
        const bool isCtx = tsk >= NLT; const int r = isCtx ? tsk - NLT : tsk;
        const int h = r & 3, npt = isCtx ? L / TOK : S / TOK, tt = (r >> 2) % npt, b = (r >> 2) / npt;
        const int seg0 = (isCtx ? TOK * tt : L + TOK * tt) / SEGLEN, seg1 = (isCtx ? L - 1 - TOK * tt : L + S - 1 - TOK * tt) / SEGLEN;
        const int mbase = isCtx ? TL + b * L + TOK * tt : b * S + TOK * tt;
        float ss0[64], ss1[64];
        { const float* s0p = p.SS + (((size_t)(0 * NB + b) * 4 + h) * NSG + seg0) * 4096 + lane; const float* s1p = p.SS + (((size_t)(1 * NB + b) * 4 + h) * NSG + seg1) * 4096 + lane;
#pragma unroll
          for (int k = 0; k < 64; ++k) { ss0[k] = seg0 > 0 ? s0p[k * 64] : 0.f; ss1[k] = seg1 > 0 ? s1p[k * 64] : 0.f; } }
        const float rk = p.a_r_k[l * DA + h * 64 + lane], gln = p.a_lnx_g[l * DA + h * 64 + lane], bln = p.a_lnx_b[l * DA + h * 64 + lane];
        f32x4 pv0 = {0.f, 0.f, 0.f, 0.f}, pv1 = pv0; float y0l, y1l, rr, kds, vv, gg;
#define ROUT_LOAD(i_) do { const size_t o_ = (size_t)(mbase + (i_)) * DA + h * 64, o1_ = o_ + (size_t)T * DA; \
            if (seg0 > 0) pv0 = *(const f32x4*)(p.PV + o_ + 4 * (lane & 15)); if (seg1 > 0) pv1 = *(const f32x4*)(p.PV + o1_ + 4 * (lane & 15)); \
            y0l = p.Y[o_ + lane]; y1l = p.Y[o1_ + lane]; rr = p.sR[o_ + lane]; kds = p.sKD[o_ + lane] + p.sKD[o1_ + lane]; vv = p.sV[o_ + lane]; gg = p.sG[o_ + lane]; } while (0)
        ROUT_LOAD(0);
#pragma unroll 1
        for (int i = 0; i < TOK; ++i) {
            const f32x4 cpv0 = pv0, cpv1 = pv1; float a0 = y0l, a1 = y1l, a2 = 0.f, a3 = 0.f; const float crr = rr, ckds = kds, cvv = vv, cgg = gg;
            ROUT_LOAD(i + 1 < TOK ? i + 1 : i);
            ScanRep<0>::dot(a0, a1, a2, a3, cpv0, ss0);
            ScanRep<0>::dot(a0, a1, a2, a3, cpv1, ss1);
            const float y = (a0 + a1) + (a2 + a3);
            const float mu = wave_sum(y) * (1.0f / 64.f), dy = y - mu;
            const float rstd = 1.0f / sqrtf(wave_sum(dy * dy) * (1.0f / 64.f) + GN_EPS);
            const float bon = wave_sum(crr * ckds * rk);
            p.MIX[(size_t)(mbase + i) * DMIX + h * 64 + lane] = f2bf((dy * rstd * gln + bln + bon * cvv) * cgg);
        }
#undef ROUT_LOAD
    }
}


#define LAS __attribute__((address_space(3)))
#define XB_TMO      128
#define XB_XCNT(j)  (256  + 64 * (j))
#define XB_XSUB(j)  (1280 + 64 * (j))
#define XB_XGEN(j)  (2304 + 64 * (j))
#define XB_TOP      3328
#define XB_TOPGEN   3392
#define XCD_BAR_WORDS 3456
#define XB_SPIN_CAP (1u << 20)
static_assert(XCD_BAR_WORDS * 4 <= 16384, "barrier words fit the control region");
__device__ __forceinline__ unsigned xb_ld(unsigned* p)              { return __hip_atomic_load(p, __ATOMIC_RELAXED, __HIP_MEMORY_SCOPE_AGENT); }
__device__ __forceinline__ unsigned xb_add(unsigned* p, unsigned v) { return __hip_atomic_fetch_add(p, v, __ATOMIC_RELAXED, __HIP_MEMORY_SCOPE_AGENT); }
__device__ __forceinline__ unsigned xb_xcc_id() { return (unsigned)__builtin_amdgcn_s_getreg((3 << 11) | 20) & 0xFu; }
#define XB_SPIN(cond, bar) do { unsigned _sp = 0; while (cond) { __builtin_amdgcn_s_sleep(1); \
    if ((++_sp & 255u) == 0u) { if (xb_ld(&(bar)[XB_TMO])) break; if (_sp > XB_SPIN_CAP) { atomicAdd(&(bar)[XB_TMO], 1u); break; } } } } while (0)
struct XcdBarrier { unsigned* bar; unsigned x; volatile LAS unsigned* st; };
__device__ __forceinline__ XcdBarrier xcd_barrier_post(unsigned* bar, volatile LAS unsigned* st) {
    XcdBarrier b; b.bar = bar; b.x = xb_xcc_id(); b.st = st;
    if (threadIdx.x == 0) (void)xb_add(&bar[XB_XCNT(b.x)], 1u);
    return b;
}
__device__ __forceinline__ void xcd_barrier_complete(unsigned* bar, unsigned x, unsigned& nloc, unsigned& nx) {
    const unsigned G = gridDim.x * gridDim.y * gridDim.z;
    unsigned sum, cnt, mine, sp = 0u;
    for (;;) {
        sum = 0u; cnt = 0u; mine = 0u;
#pragma unroll
        for (unsigned j = 0; j < 16; ++j) { const unsigned c = xb_ld(&bar[XB_XCNT(j)]); sum += c; cnt += (c > 0u) ? 1u : 0u; mine = (j == x) ? c : mine; }
        if (sum == G) break;
        __builtin_amdgcn_s_sleep(1);
        if ((++sp & 255u) == 0u) { if (xb_ld(&bar[XB_TMO])) break; if (sp > XB_SPIN_CAP) { atomicAdd(&bar[XB_TMO], 1u); break; } }
    }
    nloc = mine > 0u ? mine : 1u; nx = cnt > 0u ? cnt : 1u;
}
__device__ __forceinline__ void xcd_barrier(const XcdBarrier& b) {
    asm volatile("s_waitcnt vmcnt(0)" ::: "memory");
    __syncthreads();
    if (threadIdx.x == 0) {
        unsigned* bar = b.bar;
        __builtin_amdgcn_s_waitcnt(0);
        unsigned nloc = b.st[0], nx = b.st[1];
        if (nloc == 0u) { xcd_barrier_complete(bar, b.x, nloc, nx); b.st[0] = nloc; b.st[1] = nx; }
        const unsigned old = xb_add(&bar[XB_XSUB(b.x)], 1u);
        const unsigned gen = old / nloc;
        if (old + 1u == (gen + 1u) * nloc) {
            __builtin_amdgcn_fence(__ATOMIC_RELEASE, "agent");
            asm volatile("s_waitcnt vmcnt(0)" ::: "memory");
            const unsigned og = xb_add(&bar[XB_TOP], 1u);
            const unsigned tg = og / nx;
            if (og + 1u == (tg + 1u) * nx) xb_add(&bar[XB_TOPGEN], 1u);
            else XB_SPIN(xb_ld(&bar[XB_TOPGEN]) == tg, bar);
            __builtin_amdgcn_fence(__ATOMIC_ACQUIRE, "agent");
            xb_add(&bar[XB_XGEN(b.x)], 1u);
            asm volatile("s_waitcnt vmcnt(0)" ::: "memory");
        } else {
            XB_SPIN(xb_ld(&bar[XB_XGEN(b.x)]) == gen, bar);
            __builtin_amdgcn_fence(__ATOMIC_ACQUIRE, "agent");
            asm volatile("s_waitcnt vmcnt(0)" ::: "memory");
        }
    }
    __syncthreads();
}

#define GT ((long)blockIdx.x * blockDim.x + threadIdx.x)
#define GS ((long)gridDim.x * blockDim.x)
__global__ void __launch_bounds__(256, 2) mega_fwd(Params p) {
    __shared__ __attribute__((aligned(16))) char lds[65536 + 64];
    cg::grid_group grid = cg::this_grid();
    const long gt = GT, gs = GS;
    volatile LAS unsigned* bst = (volatile LAS unsigned*)(LAS char*)(lds + 65536);
    if (threadIdx.x < 2) bst[threadIdx.x] = 0u;
    __syncthreads();
    const XcdBarrier xb = xcd_barrier_post(p.bar, bst);
#ifndef PROBE_PHASE
#define PROBE_PHASE -1
#endif
#define PROBE_AMP 8
    unsigned long long t_prev = 0; int nts = 0;
#define STAMP() do { if (PROBE_PHASE >= 0 && blockIdx.x == 0 && threadIdx.x == 0) { const unsigned long long t_now = __builtin_amdgcn_s_memrealtime(); \
        if (nts == PROBE_PHASE + 1) { const unsigned long long t_end = t_now + PROBE_AMP * (t_now - t_prev); while (__builtin_amdgcn_s_memrealtime() < t_end) __builtin_amdgcn_s_sleep(8); } \
        t_prev = __builtin_amdgcn_s_memrealtime(); } ++nts; } while (0)
#define GSYNC() do { xcd_barrier(xb); STAMP(); } while (0)
    STAMP();
    ph_mod_fast(p, lds); ph_prep_w_fast(p, 0, 0, lds); ph_prep_misc(p, 0, gt, gs, false);
    grid.sync(); STAMP();
    for (int l = 0; l < 2; ++l) {
        const int nrows = (l == 0) ? T : TL;
        if (l == 0) { ph_lnmod_fast(p, l); GSYNC(); }
        g_gemm_in(p, lds);
        GSYNC();
        ph_streams_s1(p, l);
        GSYNC();
        g_streams_s2(p, l, lds);
        GSYNC();
        ph_scan_fast(p);
        GSYNC();
        ph_combine(p, lds); ph_attn_blk(p, l, l == 0, 64, lds);
        GSYNC();
        ph_rwkv_out_fast(p, l, l == 0);
        GSYNC();
        if (blockIdx.x >= gridDim.x / 2) { ph_prep_w_fast(p, l, 1, lds); __syncthreads(); g_gemm_out(p, nrows, lds); } else { g_gemm_out(p, nrows, lds); ph_prep_w_fast(p, l, 1, lds); }
        GSYNC();
        g_router(p, l, nrows, lds);
        GSYNC();
        ph_dispatch_fast(p, l, nrows, lds);
        GSYNC();
        g_moe1(p, l, lds);
        GSYNC();
        g_moe2(p, l, lds);
        GSYNC();
        ph_final_fast(p, l, nrows, l == 0);
        if (l == 0) { ph_prep_w_fast(p, 1, 0, lds); ph_prep_misc(p, 1, gt, gs, false); }
        GSYNC();
    }}

extern "C" void kernel_launch(void* const* d_in, const int* in_sizes, int n_in, void* d_out, int out_size, void* d_ws, size_t ws_size, hipStream_t stream) {
    if (n_in != 32 || out_size != TL * D || ws_size < WS_NEED) { fprintf(stderr, "kernel_launch: unexpected shapes / workspace (n_in %d out %d ws %zu need %zu)\n", n_in, out_size, ws_size, (size_t)WS_NEED); return; }
    static int grid_blocks = 0;
    if (!grid_blocks) {
        int dev = 0, cus = 0, per_cu = 0;
        (void)hipGetDevice(&dev);
        (void)hipDeviceGetAttribute(&cus, hipDeviceAttributeMultiprocessorCount, dev);
        (void)hipOccupancyMaxActiveBlocksPerMultiprocessor(&per_cu, mega_fwd, 256, 0);
        if (per_cu < 1) per_cu = 1;
        if (per_cu > 2) per_cu = 2;
        grid_blocks = cus * per_cu;
        fprintf(stderr, "kernel_launch: %d CUs x %d blocks\n", cus, per_cu);
    }
    Params p = make_params(d_in, d_out, d_ws);
    (void)hipMemsetAsync(d_ws, 0, CTL_BYTES, stream);
    void* args[] = {&p};
    hipError_t e = hipLaunchCooperativeKernel((void*)mega_fwd, dim3(grid_blocks), dim3(256), args, 0, stream);
    if (e != hipSuccess) fprintf(stderr, "cooperative launch failed: %s (grid %d)\n", hipGetErrorString(e), grid_blocks);
}
#endif

#ifdef HOST_EMU
static void host_forward(void* const* d_in, void* d_out, void* d_ws) {
    const Params p = make_params(d_in, d_out, d_ws);
    for (int l = 0; l < 2; ++l) {
        const int nrows = (l == 0) ? T : TL;
        ph_prep_w(p, l, 0, 1); ph_prep_misc(p, l, 0, 1); ph_lnmod(p, l, 0, 1); host_gemm_in(p); ph_streams(p, l, 0, 1); ph_rope(p, 0, 1); ph_scan(p, 0, 1);
        ph_attn(p, l, nrows, 0, 1); ph_rwkv_out(p, l, nrows, 0, 1); host_gemm_out(p, nrows); ph_post_mixer(p, l, nrows, 0, 1);
        ph_dispatch(p, l, nrows, 0, 1); host_moe1(p, l); host_moe2(p, l); ph_final(p, l, nrows, 0, 1);
    }
}
#endif
```

```cpp
#ifdef HOST_EMU
#include <cmath>
#include <cstdio>
#include <cstring>
#include <cstdint>
#include <cstdlib>
#define __device__
#define __global__
#define __host__
#define __forceinline__ inline
#else
#include <hip/hip_runtime.h>
#include <hip/hip_cooperative_groups.h>
#include <cstdio>
#include <cstdint>
namespace cg = cooperative_groups;
#endif

#ifndef CFG_D
#define CFG_D 1024
#define CFG_B 8
#define CFG_S 2048
#define CFG_L 256
#define CFG_DE 512
#endif
constexpr int D = CFG_D, NB = CFG_B, S = CFG_S, L = CFG_L, DE = CFG_DE;
constexpr int TL = NB * S, TC = NB * L, T = TL + TC;
constexpr int GRID_W = 64, HD = 64;
constexpr int DA = 256, A_IN = 1184, N_IN = 2976, NINP = 3072, DMIX = 1024;
constexpr int NEXP = 32, NSLOT = 2 * T + NEXP * 128;
constexpr int ZQB = 0, ZKB = 384, ZVB = 512, ZQN = 640, ZKN = 1024, ZVN = 1408, ZA = 1792, ZP = 2976;
constexpr float LN_EPS = 1e-6f, GN_EPS = 64e-5f, ATT_SCALE = 0.125f;
constexpr float ALPHA = 1.41421356237309515f;

typedef unsigned short bf16_t;

__device__ __forceinline__ float bf2f(bf16_t v) {
    unsigned u = ((unsigned)v) << 16; float f;
#ifdef HOST_EMU
    memcpy(&f, &u, 4);
#else
    f = __uint_as_float(u);
#endif
    return f;
}
__device__ __forceinline__ bf16_t f2bf(float f) {
    unsigned u;
#ifdef HOST_EMU
    memcpy(&u, &f, 4);
#else
    u = __float_as_uint(f);
#endif
    return (bf16_t)((u + 0x7fffu + ((u >> 16) & 1u)) >> 16);
}
__device__ __forceinline__ float sigmoidf_(float x) { return 1.0f / (1.0f + expf(-x)); }
__device__ __forceinline__ float siluf_(float x) { return x / (1.0f + expf(-x)); }
__device__ __forceinline__ int atomic_inc_int(int* p) {
#ifdef HOST_EMU
    int o = *p; *p = o + 1; return o;
#else
    return atomicAdd(p, 1);
#endif
}

struct Params {
    const float *x, *c, *ctx, *c_ctx, *w_mod, *b_mod, *w_in, *w_out, *a_shift, *a_w0, *a_w_up, *a_a0, *a_a_up, *a_g_up,
        *a_k_k, *a_k_a, *a_r_k, *a_lnx_g, *a_lnx_b, *b_sink, *c_rpb, *ln1_g, *ln1_b, *ln2_g, *ln2_b, *w_rg, *b_rg, *w_re,
        *b_re, *w_gate, *w_up, *w_down;
    float* out;
    int* cnt;
    unsigned* bar;
    float* mod;
    float* rope;
    bf16_t *win_t, *wout_t, *wgu_t, *wd_t;
    bf16_t *wrt;
    int* hist;
    bf16_t* HLO;
    bf16_t *wupT, *aupT, *gupT;
    bf16_t* LA;
    float *kT, *kN;
    bf16_t* H;
    bf16_t* Z;
    bf16_t* VT;
    float *sR, *sV, *sKK, *sG, *sW, *sKD, *sB;
    float* Y;
    bf16_t* MIX;
    float *PV, *QS, *PS, *SS;
    float* XC;
    bf16_t* O;
    bf16_t* YSb;
    int *rE, *rPos, *rSlot; float* rW;
    int* slotTok;
    bf16_t* ACT;
    float* YS;
};

constexpr size_t al256(size_t v) { return (v + 255) & ~(size_t)255; }
constexpr size_t OFF_CNT = 0;
constexpr size_t OFF_BAR = 4096, CTL_BYTES = 4096 + 16384;
constexpr size_t OFF_MOD = CTL_BYTES;
constexpr size_t OFF_ROPE = al256(OFF_MOD + (size_t)2 * (NB + 1) * 6 * D * 4);
constexpr size_t OFF_LORA = al256(OFF_ROPE + 64 * 16 * 2 * 4);
constexpr size_t OFF_WRT = al256(OFF_LORA + (size_t)(2 * 256 * 64 * 2 + 256 * 160) * 2);
constexpr size_t OFF_LG = al256(OFF_WRT + (size_t)2 * 128 * D * 2);
constexpr size_t OFF_WIN = al256(OFF_LG + (size_t)(T / 32) * 32 * 4);
constexpr size_t OFF_WOUT = al256(OFF_WIN + (size_t)NINP * D * 2);
constexpr size_t OFF_WGU = al256(OFF_WOUT + (size_t)D * DMIX * 2);
constexpr size_t OFF_WD = al256(OFF_WGU + (size_t)NEXP * 2 * DE * D * 2);
constexpr size_t OFF_H = al256(OFF_WD + (size_t)NEXP * D * DE * 2);
constexpr size_t OFF_Z = al256(OFF_H + (size_t)(T + 1) * D * 2);
constexpr int PU = L + S;
constexpr int SEGLEN = 144, NSG = (L + S) / SEGLEN;
#ifndef HOST_EMU
static_assert((L + S) % SEGLEN == 0 && SEGLEN % 16 == 0 && L % 16 == 0 && S % 16 == 0, "16-token output tiles must not straddle scan segments");
static_assert((size_t)3 * 64 * NSG * 4096 * 4 <= (size_t)NEXP * 2 * DE * D * 2, "scan segment states overlay wgu_t");
#endif
constexpr size_t OFF_VT = al256(OFF_Z + (size_t)T * ZP * 2);
constexpr size_t OFF_S = al256(OFF_VT + (size_t)NB * 8 * 64 * PU * 2);
constexpr size_t S1 = (size_t)T * 256 * 4;
#ifdef HOST_EMU
constexpr int NSTREAM = 10;
#else
constexpr int NSTREAM = 9;
#endif
constexpr size_t OFF_Y = al256(OFF_S + NSTREAM * S1);
constexpr size_t OFF_MIX = al256(OFF_Y + 2 * S1);
constexpr size_t OFF_XC = al256(OFF_MIX + (size_t)T * 1024 * 2);
constexpr size_t OFF_ROUTE = al256(OFF_XC + (size_t)TC * D * 4);
constexpr size_t OFF_SLOTTOK = al256(OFF_ROUTE + (size_t)T * 2 * 4 * 4);
constexpr size_t WS_NEED = al256(OFF_SLOTTOK + (size_t)NSLOT * 4);
static_assert((size_t)NSLOT * DE * 2 <= (size_t)T * ZP * 2 && (size_t)T * D * 2 <= (size_t)T * ZP * 2, "ACT / HLO overlay Z");
static_assert((size_t)T * 4 * 4 + (size_t)T * 416 * 2 <= S1, "kN + LA overlay Y[1]");
static_assert((size_t)NSLOT * D * 4 <= NSTREAM * S1 && (size_t)T * D * 4 <= NSTREAM * S1, "YS / O overlay the stream buffers");

static Params make_params(void* const* d_in, void* d_out, void* d_ws) {
    Params p{};
    const float** f = (const float**)&p.x;
    for (int i = 0; i < 32; ++i) f[i] = (const float*)d_in[i];
    p.out = (float*)d_out;
    char* w = (char*)d_ws;
    p.cnt = (int*)(w + OFF_CNT); p.bar = (unsigned*)(w + OFF_BAR); p.mod = (float*)(w + OFF_MOD); p.rope = (float*)(w + OFF_ROPE);
    p.win_t = (bf16_t*)(w + OFF_WIN); p.wout_t = (bf16_t*)(w + OFF_WOUT); p.wgu_t = (bf16_t*)(w + OFF_WGU); p.wd_t = (bf16_t*)(w + OFF_WD);
    p.wrt = (bf16_t*)(w + OFF_WRT); p.hist = (int*)(w + OFF_LG); p.HLO = (bf16_t*)(w + OFF_Z);
    p.wupT = (bf16_t*)(w + OFF_LORA); p.aupT = p.wupT + 2 * 256 * 64; p.gupT = p.aupT + 2 * 256 * 64;
    p.H = (bf16_t*)(w + OFF_H); p.Z = (bf16_t*)(w + OFF_Z); p.VT = (bf16_t*)(w + OFF_VT);
    float* s = (float*)(w + OFF_S); const size_t n1 = (size_t)T * 256;
    p.sR = s; p.sV = s + n1; p.sKK = s + 2 * n1; p.sW = s + 3 * n1; p.sKD = s + 5 * n1; p.sB = s + 7 * n1; p.sG = s + 9 * n1;
    p.Y = (float*)(w + OFF_Y); p.MIX = (bf16_t*)(w + OFF_MIX); p.XC = (float*)(w + OFF_XC);
    p.O = (bf16_t*)(w + OFF_S); p.YSb = (bf16_t*)(w + OFF_S);
    p.PV = (float*)(w + OFF_H); p.QS = (float*)(w + OFF_WGU); p.PS = p.QS + (size_t)64 * NSG * 4096; p.SS = p.PS + (size_t)64 * NSG * 4096;
    p.kT = p.Y; p.kN = p.Y + (size_t)T * 256; p.LA = (bf16_t*)(p.Y + (size_t)T * 256 + (size_t)T * 4);
    int* r = (int*)(w + OFF_ROUTE); p.rE = r; p.rPos = r + 2 * T; p.rSlot = r + 4 * T; p.rW = (float*)(r + 6 * T);
    p.slotTok = (int*)(w + OFF_SLOTTOK);
    p.ACT = (bf16_t*)(w + OFF_Z); p.YS = (float*)(w + OFF_S);
    return p;
}

__device__ void ph_prep_w(const Params& p, int l, long gtid, long gsz) {
    for (long i = gtid; i < (long)D * NINP; i += gsz) {
        const int k = (int)(i / NINP), n = (int)(i % NINP);
        float v = 0.f;
        if (n < N_IN) { const int oc = (n < ZA) ? n + A_IN : n - ZA; v = p.w_in[((size_t)l * D + k) * N_IN + oc]; }
        p.win_t[(size_t)n * D + k] = f2bf(v);
    }
    for (long i = gtid; i < (long)DMIX * D; i += gsz) {
        const int k = (int)(i / D), n = (int)(i % D);
        p.wout_t[(size_t)n * DMIX + k] = f2bf(p.w_out[((size_t)l * DMIX + k) * D + n]);
    }
    for (long i = gtid; i < (long)NEXP * D * 2 * DE; i += gsz) {
        const int rho = (int)(i % (2 * DE)); const long t = i / (2 * DE); const int k = (int)(t % D), e = (int)(t / D);
        const int q = rho >> 5, half = (rho >> 4) & 1, ii = rho & 15, cc = 16 * q + ii;
        const float* src = half ? p.w_up : p.w_gate;
        p.wgu_t[((size_t)e * 2 * DE + rho) * D + k] = f2bf(src[(((size_t)l * NEXP + e) * D + k) * DE + cc]);
    }
    for (long i = gtid; i < (long)NEXP * DE * D; i += gsz) {
        const int n = (int)(i % D); const long t = i / D; const int k = (int)(t % DE), e = (int)(t / DE);
        p.wd_t[((size_t)e * D + n) * DE + k] = f2bf(p.w_down[(((size_t)l * NEXP + e) * DE + k) * D + n]);
    }
}
__device__ __forceinline__ void ph_prep_misc(const Params& p, int l, long gtid, long gsz, bool do_mod = true) {
    if (l == 0 && do_mod) for (long i = gtid; i < (long)2 * (NB + 1) * 6 * D; i += gsz) {
        const int j = (int)(i % (6 * D)), b = (int)((i / (6 * D)) % (NB + 1)), ll = (int)(i / ((long)6 * D * (NB + 1)));
        const float* cv = (b < NB) ? p.c + (size_t)b * D : p.c_ctx;
        float acc = 0.f;
        for (int k = 0; k < D; ++k) acc += siluf_(cv[k]) * p.w_mod[((size_t)ll * D + k) * 6 * D + j];
        p.mod[((size_t)ll * (NB + 1) + b) * 6 * D + j] = acc + p.b_mod[(size_t)ll * 6 * D + j];
    }
    if (l == 0) for (long i = gtid; i < 64 * 16; i += gsz) {
        const int pos = (int)(i / 16), fi = (int)(i % 16);
        const float inv = powf(10000.0f, -(float)fi / 16.0f), ang = (float)pos * inv;
        p.rope[i] = cosf(ang); p.rope[1024 + i] = sinf(ang);
    }
    for (long i = gtid; i < NEXP; i += gsz) p.cnt[l * NEXP + i] = 0;
    for (long i = gtid; i < NSLOT; i += gsz) p.slotTok[i] = T;
    for (long i = gtid; i < D; i += gsz) p.H[(size_t)T * D + i] = 0;
}

__device__ __forceinline__ const float* xrow_in(const Params& p, int l, int m) {
    if (m < TL) return (l == 0 ? p.x : p.out) + (size_t)m * D;
    return (l == 0 ? p.ctx : p.XC) + (size_t)(m - TL) * D;
}
__device__ __forceinline__ const float* modrow(const Params& p, int l, int m) { return p.mod + ((size_t)l * (NB + 1) + (m < TL ? m / S : NB)) * 6 * D; }

__device__ void ph_lnmod(const Params& p, int l, long gtid, long gsz) {
    for (long m = gtid; m < T; m += gsz) {
        const float* xr = xrow_in(p, l, (int)m); const float* md = modrow(p, l, (int)m);
        float s = 0.f; for (int j = 0; j < D; ++j) s += xr[j];
        const float mu = s / D; float q = 0.f;
        for (int j = 0; j < D; ++j) { const float d = xr[j] - mu; q += d * d; }
        const float rstd = 1.0f / sqrtf(q / D + LN_EPS);
        for (int j = 0; j < D; ++j) p.H[(size_t)m * D + j] = f2bf((xr[j] - mu) * rstd * (1.0f + md[D + j]) + md[j]);
    }
}

__device__ __forceinline__ float zshift(const Params& p, int l, int m, int col) {
    int t, len;
    if (m < TL) { t = m % S; len = S; } else { t = (m - TL) % L; len = L; }
    const float* sh = p.a_shift + (size_t)l * 3 * A_IN;
    const bf16_t* z = p.Z + (size_t)m * ZP + ZA + col;
    float v = sh[A_IN + col] * bf2f(z[0]);
    if (t > 0) v += sh[col] * bf2f(z[-ZP]);
    if (t < len - 1) v += sh[2 * A_IN + col] * bf2f(z[ZP]);
    return v;
}

__device__ void ph_streams(const Params& p, int l, long gtid, long gsz) {
    for (long i = gtid; i < (long)T * DA; i += gsz) {
        const int m = (int)(i / DA), c = (int)(i % DA), h0 = c & ~63;
        const float r = zshift(p, l, m, c), k = zshift(p, l, m, 256 + c), v = zshift(p, l, m, 512 + c);
        float nrm = 0.f;
        for (int j = 0; j < 64; ++j) { const float t = zshift(p, l, m, 256 + h0 + j) * p.a_k_k[l * DA + h0 + j]; nrm += t * t; }
        const float kk = k * p.a_k_k[l * DA + c] / sqrtf(nrm + 1e-12f);
        float g = 0.f;
        for (int j = 0; j < 160; ++j) g += sigmoidf_(zshift(p, l, m, 1024 + j)) * p.a_g_up[((size_t)l * 160 + j) * DA + c];
        const size_t o = (size_t)m * DA + c;
        p.sR[o] = r; p.sV[o] = v; p.sKK[o] = kk; p.sG[o] = g;
        for (int d = 0; d < 2; ++d) {
            float aw = 0.f, aa = 0.f;
            for (int j = 0; j < 64; ++j) {
                aw += tanhf(zshift(p, l, m, 768 + d * 64 + j)) * p.a_w_up[(((size_t)l * 2 + d) * 64 + j) * DA + c];
                aa += zshift(p, l, m, 896 + d * 64 + j) * p.a_a_up[(((size_t)l * 2 + d) * 64 + j) * DA + c];
            }
            const float u = -(p.a_w0[(l * 2 + d) * DA + c] + aw);
            const float sp = (u > 20.f) ? u : log1pf(expf(u));
            const float w = expf(-expf(-sp - 0.5f));
            const float a = sigmoidf_(p.a_a0[(l * 2 + d) * DA + c] + aa);
            const size_t od = ((size_t)d * T + m) * DA + c;
            p.sW[od] = w; p.sKD[od] = k * (1.0f + (a - 1.0f) * p.a_k_a[l * DA + c]); p.sB[od] = kk * a;
        }
    }
}

__device__ __forceinline__ void ph_rope(const Params& p, long gtid, long gsz) {
    for (long i = gtid; i < (long)TL * 8 * 32; i += gsz) {
        const int pr = (int)(i & 31), hs = (int)((i >> 5) & 7), m = (int)(i >> 8);
        const int t = m % S, axis = pr >> 4, fi = pr & 15, pos = axis ? (t % GRID_W) : (t / GRID_W);
        bf16_t* z = p.Z + (size_t)m * ZP + hs * 64 + axis * 32 + fi;
        const float cs = p.rope[pos * 16 + fi], sn = p.rope[1024 + pos * 16 + fi];
        const float x0 = bf2f(z[0]), x1 = bf2f(z[16]);
        z[0] = f2bf(x0 * cs - x1 * sn); z[16] = f2bf(x1 * cs + x0 * sn);
    }
}

__device__ void ph_scan(const Params& p, long gtid, long gsz) {
    for (long i = gtid; i < (long)2 * NB * 4 * 64; i += gsz) {
        const int v = (int)(i & 63), h = (int)((i >> 6) & 3), b = (int)((i >> 8) % NB), d = (int)((i >> 8) / NB);
        float st[64];
#pragma unroll
        for (int k = 0; k < 64; ++k) st[k] = 0.f;
        for (int pos = 0; pos < L + S; ++pos) {
            int m;
            if (pos < L) m = TL + b * L + (d ? L - 1 - pos : pos);
            else m = b * S + (d ? S - 1 - (pos - L) : pos - L);
            const size_t o = (size_t)m * DA + h * 64, od = ((size_t)d * T + m) * DA + h * 64;
            const float* kk = p.sKK + o; const float* r = p.sR + o;
            const float* w = p.sW + od; const float* bb = p.sB + od; const float* kd = p.sKD + od;
            const float vv = p.sV[o + v];
            float sk = 0.f;
#pragma unroll
            for (int k = 0; k < 64; ++k) sk += st[k] * kk[k];
            float y = 0.f;
#pragma unroll
            for (int k = 0; k < 64; ++k) { st[k] = st[k] * w[k] - sk * bb[k] + vv * kd[k]; y += st[k] * r[k]; }
            p.Y[od + v] = y;
        }
    }
}

__device__ void ph_rwkv_out(const Params& p, int l, int nrows, long gtid, long gsz) {
    for (long i = gtid; i < (long)nrows * 4; i += gsz) {
        const int m = (int)(i >> 2), h = (int)(i & 3);
        const size_t o = (size_t)m * DA + h * 64;
        const float* y0 = p.Y + o; const float* y1 = p.Y + (size_t)T * DA + o;
        float s = 0.f, bon = 0.f;
        for (int n = 0; n < 64; ++n) {
            s += y0[n] + y1[n];
            bon += p.sR[o + n] * (p.sKD[o + n] + p.sKD[(size_t)T * DA + o + n]) * p.a_r_k[l * DA + h * 64 + n];
        }
        const float mu = s / 64.f; float q = 0.f;
        for (int n = 0; n < 64; ++n) { const float dd = y0[n] + y1[n] - mu; q += dd * dd; }
        const float rstd = 1.0f / sqrtf(q / 64.f + GN_EPS);
        for (int n = 0; n < 64; ++n) {
            const int c = h * 64 + n;
            const float yn = (y0[n] + y1[n] - mu) * rstd * p.a_lnx_g[l * DA + c] + p.a_lnx_b[l * DA + c];
            p.MIX[(size_t)m * DMIX + c] = f2bf((yn + bon * p.sV[o + n]) * p.sG[o + n]);
        }
    }
}

__device__ __forceinline__ void att_key(const float (&q)[64], const bf16_t* kr, const bf16_t* vr, float bias, float& mx, float& ls, float (&acc)[64]) {
    float s = 0.f;
#pragma unroll
    for (int d = 0; d < 64; ++d) s += q[d] * bf2f(kr[d]);
    s = s * ATT_SCALE + bias;
    const float mn = fmaxf(mx, s), f = expf(mx - mn), pe = expf(s - mn);
    ls = ls * f + pe;
#pragma unroll
    for (int d = 0; d < 64; ++d) acc[d] = acc[d] * f + pe * bf2f(vr[d]);
    mx = mn;
}

__device__ void ph_attn(const Params& p, int l, int nrows, long gtid, long gsz) {
    for (long i = gtid; i < (long)nrows * 12; i += gsz) {
        const int m = (int)(i / 12), u = (int)(i % 12);
        const bool isB = u < 6; const int hq = isB ? u : u - 6;
        const int b = (m < TL) ? m / S : (m - TL) / L;
        const int qcol = isB ? ZQB + hq * 64 : ZQN + hq * 64;
        const int kcol = isB ? ZKB + (hq / 3) * 64 : ZKN + hq * 64;
        const int vcol = isB ? ZVB + (hq / 3) * 64 : ZVN + hq * 64;
        float q[64], acc[64];
        const bf16_t* qr = p.Z + (size_t)m * ZP + qcol;
#pragma unroll
        for (int d = 0; d < 64; ++d) { q[d] = bf2f(qr[d]); acc[d] = 0.f; }
        float mx, ls;
        if (isB) { mx = p.b_sink[l * 6 + hq]; ls = 1.0f; } else { mx = -1e30f; ls = 0.f; }
        for (int j = 0; j < L; ++j) { const bf16_t* zr = p.Z + (size_t)(TL + b * L + j) * ZP; att_key(q, zr + kcol, zr + vcol, 0.f, mx, ls, acc); }
        if (m < TL) {
            const int t = m % S;
            if (isB) {
                const int j0 = t - 128 < 0 ? 0 : t - 128, j1 = t + 128 > S - 1 ? S - 1 : t + 128;
                for (int j = j0; j <= j1; ++j) { const bf16_t* zr = p.Z + (size_t)(b * S + j) * ZP; att_key(q, zr + kcol, zr + vcol, 0.f, mx, ls, acc); }
            } else {
                const int rows = S / GRID_W, r = t / GRID_W, c = t % GRID_W;
                int r0 = r - 4; r0 = r0 < 0 ? 0 : (r0 > rows - 8 ? rows - 8 : r0);
                int c0 = c - 8; c0 = c0 < 0 ? 0 : (c0 > GRID_W - 16 ? GRID_W - 16 : c0);
                for (int a = 0; a < 8; ++a)
                    for (int e = 0; e < 16; ++e) {
                        const int kr = r0 + a, kc = c0 + e;
                        const float bias = p.c_rpb[(((size_t)l * 6 + hq) * 15 + (kr - r + 7)) * 31 + (kc - c + 15)];
                        const bf16_t* zr = p.Z + (size_t)(b * S + kr * GRID_W + kc) * ZP;
                        att_key(q, zr + kcol, zr + vcol, bias, mx, ls, acc);
                    }
            }
        }
        const float inv = 1.0f / ls;
        bf16_t* o = p.MIX + (size_t)m * DMIX + (isB ? 256 : 640) + hq * 64;
#pragma unroll
        for (int d = 0; d < 64; ++d) o[d] = f2bf(acc[d] * inv);
    }
}

__device__ void ph_post_mixer(const Params& p, int l, int nrows, long gtid, long gsz) {
    for (long mm = gtid; mm < nrows; mm += gsz) {
        const int m = (int)mm;
        const float* xr = xrow_in(p, l, m); const float* md = modrow(p, l, m); const float* orow = (const float*)p.O + (size_t)m * D;
        float* x1 = (m < TL) ? p.out + (size_t)m * D : p.XC + (size_t)(m - TL) * D;
        const float* g1 = p.ln1_g + (size_t)l * D; const float* b1 = p.ln1_b + (size_t)l * D;
        float s = 0.f; for (int j = 0; j < D; ++j) s += ALPHA * xr[j] + md[2 * D + j] * orow[j];
        float mu = s / D, q = 0.f;
        for (int j = 0; j < D; ++j) { const float d = ALPHA * xr[j] + md[2 * D + j] * orow[j] - mu; q += d * d; }
        float rstd = 1.0f / sqrtf(q / D + LN_EPS);
        s = 0.f;
        for (int j = 0; j < D; ++j) { const float v = (ALPHA * xr[j] + md[2 * D + j] * orow[j] - mu) * rstd * g1[j] + b1[j]; x1[j] = v; s += v; }
        mu = s / D; q = 0.f;
        for (int j = 0; j < D; ++j) { const float d = x1[j] - mu; q += d * d; }
        rstd = 1.0f / sqrtf(q / D + LN_EPS);
        float gl[4], el[32];
#pragma unroll
        for (int g = 0; g < 4; ++g) gl[g] = p.b_rg[l * 4 + g];
#pragma unroll
        for (int e = 0; e < 32; ++e) el[e] = p.b_re[l * 32 + e];
        for (int j = 0; j < D; ++j) {
            const float hv = (x1[j] - mu) * rstd * (1.0f + md[4 * D + j]) + md[3 * D + j];
            p.H[(size_t)m * D + j] = f2bf(hv);
            const float* wg = p.w_rg + ((size_t)l * D + j) * 4; const float* we = p.w_re + ((size_t)l * D + j) * 32;
#pragma unroll
            for (int g = 0; g < 4; ++g) gl[g] += hv * wg[g];
#pragma unroll
            for (int e = 0; e < 32; ++e) el[e] += hv * we[e];
        }
        int gs = 0; float gm = gl[0];
#pragma unroll
        for (int g = 1; g < 4; ++g) if (gl[g] > gm) { gm = gl[g]; gs = g; }
        float den = 0.f;
#pragma unroll
        for (int g = 0; g < 4; ++g) den += expf(gl[g] - gm);
        const float pg = 1.0f / den;
        float v1 = -3e38f, v2 = -3e38f; int i1 = 0, i2 = 0;
#pragma unroll
        for (int j = 0; j < 8; ++j) {
            const float v = gs == 0 ? el[j] : gs == 1 ? el[8 + j] : gs == 2 ? el[16 + j] : el[24 + j];
            if (v > v1) { v2 = v1; i2 = i1; v1 = v; i1 = j; } else if (v > v2) { v2 = v; i2 = j; }
        }
        const float e2 = expf(v2 - v1), w1 = pg / (1.0f + e2), w2 = pg * e2 / (1.0f + e2);
        const int ea = gs * 8 + i1, eb = gs * 8 + i2;
        p.rE[2 * m] = ea; p.rE[2 * m + 1] = eb; p.rW[2 * m] = w1; p.rW[2 * m + 1] = w2;
        p.rPos[2 * m] = atomic_inc_int(p.cnt + l * NEXP + ea); p.rPos[2 * m + 1] = atomic_inc_int(p.cnt + l * NEXP + eb);
    }
}

__device__ __forceinline__ int pstart_of(const int* cnt, int e) {
    int s = 0;
    for (int j = 0; j < NEXP; ++j) if (j < e) s += (cnt[j] + 127) & ~127;
    return s;
}
__device__ __forceinline__ void ph_dispatch(const Params& p, int l, int nrows, long gtid, long gsz) {
    for (long i = gtid; i < (long)nrows * 2; i += gsz) {
        const int slot = pstart_of(p.cnt + l * NEXP, p.rE[i]) + p.rPos[i];
        p.rSlot[i] = slot; p.slotTok[slot] = (int)(i >> 1);
    }
}

__device__ void ph_final(const Params& p, int l, int nrows, long gtid, long gsz) {
    for (long mm = gtid; mm < nrows; mm += gsz) {
        const int m = (int)mm;
        float* x1 = (m < TL) ? p.out + (size_t)m * D : p.XC + (size_t)(m - TL) * D;
        const float* md = modrow(p, l, m);
        const float* ya = p.YS + (size_t)p.rSlot[2 * m] * D; const float* yb = p.YS + (size_t)p.rSlot[2 * m + 1] * D;
        const float wa = p.rW[2 * m], wb = p.rW[2 * m + 1];
        const float* g2 = p.ln2_g + (size_t)l * D; const float* b2 = p.ln2_b + (size_t)l * D;
        float s = 0.f; for (int j = 0; j < D; ++j) s += ALPHA * x1[j] + md[5 * D + j] * (wa * ya[j] + wb * yb[j]);
        const float mu = s / D; float q = 0.f;
        for (int j = 0; j < D; ++j) { const float d = ALPHA * x1[j] + md[5 * D + j] * (wa * ya[j] + wb * yb[j]) - mu; q += d * d; }
        const float rstd = 1.0f / sqrtf(q / D + LN_EPS);
        for (int j = 0; j < D; ++j) x1[j] = (ALPHA * x1[j] + md[5 * D + j] * (wa * ya[j] + wb * yb[j]) - mu) * rstd * g2[j] + b2[j];
    }
}

__device__ __forceinline__ int moe_blocks(const int* cnt) { int s = 0; for (int j = 0; j < NEXP; ++j) s += (cnt[j] + 127) >> 7; return s; }
__device__ __forceinline__ int moe_block_expert(const int* cnt, int rb) {
    int s = 0, e = 0;
    for (int j = 0; j < NEXP; ++j) { const int nb = (cnt[j] + 127) >> 7; if (rb >= s && rb < s + nb) e = j; s += nb; }
    return e;
}

#ifdef HOST_EMU
static void host_gemm_in(const Params& p) {
    for (int m = 0; m < T; ++m) for (int n = 0; n < ZP; ++n) { float a = 0.f; for (int k = 0; k < D; ++k) a += bf2f(p.H[(size_t)m * D + k]) * bf2f(p.win_t[(size_t)n * D + k]); p.Z[(size_t)m * ZP + n] = f2bf(a); }
}
static void host_gemm_out(const Params& p, int nrows) {
    for (int m = 0; m < nrows; ++m) for (int n = 0; n < D; ++n) { float a = 0.f; for (int k = 0; k < DMIX; ++k) a += bf2f(p.MIX[(size_t)m * DMIX + k]) * bf2f(p.wout_t[(size_t)n * DMIX + k]); ((float*)p.O)[(size_t)m * D + n] = a; }
}
static void host_moe1(const Params& p, int l) {
    const int* cnt = p.cnt + l * NEXP; const int nrb = moe_blocks(cnt);
    for (int rb = 0; rb < nrb; ++rb) { const int e = moe_block_expert(cnt, rb);
        for (int r = 0; r < 128; ++r) { const int slot = rb * 128 + r; const bf16_t* a = p.H + (size_t)p.slotTok[slot] * D;
            for (int c = 0; c < DE; ++c) { const int q = c >> 4, ii = c & 15; float g = 0.f, u = 0.f;
                const bf16_t* wg = p.wgu_t + ((size_t)e * 2 * DE + 32 * q + ii) * D; const bf16_t* wu = wg + (size_t)16 * D;
                for (int k = 0; k < D; ++k) { g += bf2f(a[k]) * bf2f(wg[k]); u += bf2f(a[k]) * bf2f(wu[k]); }
                p.ACT[(size_t)slot * DE + c] = f2bf(siluf_(g) * u); } } }
}
static void host_moe2(const Params& p, int l) {
    const int* cnt = p.cnt + l * NEXP; const int nrb = moe_blocks(cnt);
    for (int rb = 0; rb < nrb; ++rb) { const int e = moe_block_expert(cnt, rb);
        for (int r = 0; r < 128; ++r) { const int slot = rb * 128 + r;
            for (int n = 0; n < D; ++n) { float a = 0.f; const bf16_t* w = p.wd_t + ((size_t)e * D + n) * DE;
                for (int k = 0; k < DE; ++k) a += bf2f(p.ACT[(size_t)slot * DE + k]) * bf2f(w[k]);
                p.YS[(size_t)slot * D + n] = a; } } }
}
#else
typedef short bf16x8 __attribute__((ext_vector_type(8)));
typedef float f32x4 __attribute__((ext_vector_type(4)));
__device__ __forceinline__ int opq_tid() { int t = threadIdx.x; asm volatile("" : "+v"(t)); return t; }
__device__ __forceinline__ int opq_bid() { int b = blockIdx.x; asm volatile("" : "+s"(b)); return b; }
__device__ __forceinline__ unsigned pk2(float lo, float hi) { return (unsigned)f2bf(lo) | ((unsigned)f2bf(hi) << 16); }
struct u32x2_t { unsigned x, y; };
__device__ __forceinline__ void st_bf16x4(bf16_t* dst, f32x4 v) { u32x2_t o; o.x = pk2(v[0], v[1]); o.y = pk2(v[2], v[3]); *(u32x2_t*)dst = o; }
template <bool SWAP = true, class Epi>
__device__ __forceinline__ void gemm_tile(const bf16_t* a0, const bf16_t* a1, const bf16_t* b0, const bf16_t* b1, int K, char* lds, const Epi& epi) {
    const int tid = opq_tid(), wid = tid >> 6, lane = tid & 63, wr = wid >> 1, wc = wid & 1, fr = lane & 15, fq = lane >> 4;
    f32x4 acc[4][4];
#pragma unroll
    for (int m = 0; m < 4; ++m)
#pragma unroll
        for (int n = 0; n < 4; ++n) acc[m][n] = (f32x4){0.f, 0.f, 0.f, 0.f};
#define GT_STAGE(st_, kt_) do { char* sa_ = lds + (st_) * 16384 + tid * 16; \
        __builtin_amdgcn_global_load_lds((const unsigned*)(a0 + (kt_)), (__attribute__((address_space(3))) unsigned*)(sa_), 16, 0, 0); \
        __builtin_amdgcn_global_load_lds((const unsigned*)(a1 + (kt_)), (__attribute__((address_space(3))) unsigned*)(sa_ + 4096), 16, 0, 0); \
        __builtin_amdgcn_global_load_lds((const unsigned*)(b0 + (kt_)), (__attribute__((address_space(3))) unsigned*)(sa_ + 8192), 16, 0, 0); \
        __builtin_amdgcn_global_load_lds((const unsigned*)(b1 + (kt_)), (__attribute__((address_space(3))) unsigned*)(sa_ + 12288), 16, 0, 0); } while (0)
    const int fsw = (0 - (fr >> 2)) & 3;
    const int aoff = (wr * 64 + fr) * 64 + ((fq ^ fsw) * 16), boff = 8192 + (wc * 64 + fr) * 64 + ((fq ^ fsw) * 16);
    const int nk = K / 32;
    GT_STAGE(0, 0);
    if (nk > 1) GT_STAGE(1, 32);
    if (nk > 2) GT_STAGE(2, 64);
    for (int t = 0; t < nk; ++t) {
        if (t + 2 < nk) asm volatile("s_waitcnt vmcnt(8)" ::: "memory"); else if (t + 1 < nk) asm volatile("s_waitcnt vmcnt(4)" ::: "memory"); else asm volatile("s_waitcnt vmcnt(0)" ::: "memory");
        asm volatile("s_waitcnt lgkmcnt(0)" ::: "memory");
        __builtin_amdgcn_s_barrier();
        if (t + 3 < nk) GT_STAGE((t + 3) & 3, (t + 3) * 32);
        const char* sb = lds + (t & 3) * 16384;
        bf16x8 At[4], Bt[4];
#pragma unroll
        for (int m = 0; m < 4; ++m) At[m] = *(const bf16x8*)(sb + aoff + m * 1024);
#pragma unroll
        for (int n = 0; n < 4; ++n) Bt[n] = *(const bf16x8*)(sb + boff + n * 1024);
#pragma unroll
        for (int m = 0; m < 4; ++m)
#pragma unroll
            for (int n = 0; n < 4; ++n) acc[m][n] = SWAP ? __builtin_amdgcn_mfma_f32_16x16x32_bf16(Bt[n], At[m], acc[m][n], 0, 0, 0) : __builtin_amdgcn_mfma_f32_16x16x32_bf16(At[m], Bt[n], acc[m][n], 0, 0, 0);
    }
    asm volatile("s_waitcnt lgkmcnt(0)" ::: "memory");
    __builtin_amdgcn_s_barrier();
#undef GT_STAGE
    epi(acc, wr, wc, fr, fq);
}
#define STG_ROW(i) ((tid_ + (i) * 256) >> 2)
#define STG_K ((((tid_ & 3) ^ ((0 - (tid_ >> 4)) & 3))) * 8)

__device__ __forceinline__ f32x4 ld_bf16x4(const bf16_t* src) { const u32x2_t w = *(const u32x2_t*)src; return (f32x4){__uint_as_float(w.x << 16), __uint_as_float(w.x & 0xffff0000u), __uint_as_float(w.y << 16), __uint_as_float(w.y & 0xffff0000u)}; }
__device__ __forceinline__ void g_gemm_in(const Params& p, char* lds) {
    const int tid_ = opq_tid(), bid_ = opq_bid(); (void)tid_; (void)bid_;
    constexpr int NT = NINP / 128, MT = T / 128;
    for (int tile = bid_; tile < NT * MT; tile += gridDim.x) {
        const int tm = tile / NT, tn = tile % NT;
        const bf16_t* a0 = p.H + (size_t)(tm * 128 + STG_ROW(0)) * D + STG_K; const bf16_t* a1 = p.H + (size_t)(tm * 128 + STG_ROW(1)) * D + STG_K;
        const bf16_t* b0 = p.win_t + (size_t)(tn * 128 + STG_ROW(0)) * D + STG_K; const bf16_t* b1 = p.win_t + (size_t)(tn * 128 + STG_ROW(1)) * D + STG_K;
        if (tn == ZVB / 128 || (tn >= ZVN / 128 && tn < ZA / 128)) {
            gemm_tile<false>(a0, a1, b0, b1, D, lds, [&](const f32x4 (&acc)[4][4], int wr, int wc, int fr, int fq) {
#pragma unroll
                for (int m = 0; m < 4; ++m) { const int m0 = tm * 128 + wr * 64 + m * 16 + fq * 4; int b, u;
                    if (m0 < TL) { b = m0 / S; u = L + m0 % S; } else { b = (m0 - TL) / L; u = (m0 - TL) % L; }
#pragma unroll
                    for (int n = 0; n < 4; ++n) { const int col = tn * 128 + wc * 64 + n * 16 + fr;
                        const int hv = col < ZVN ? (col - ZVB) >> 6 : 2 + ((col - ZVN) >> 6), d = col < ZVN ? (col - ZVB) & 63 : (col - ZVN) & 63;
                        st_bf16x4(p.VT + ((size_t)(b * 8 + hv) * 64 + d) * PU + u, acc[m][n]); } }
            });
        } else if (tn < ZVB / 128 && tm < TL / 128) {
            gemm_tile<true>(a0, a1, b0, b1, D, lds, [&](const f32x4 (&acc)[4][4], int wr, int wc, int fr, int fq) {
#pragma unroll
                for (int m = 0; m < 4; ++m) { const int row = tm * 128 + wr * 64 + m * 16 + fr, t = row % S;
                    bf16_t* zr = p.Z + (size_t)row * ZP + tn * 128 + wc * 64 + 4 * fq;
#pragma unroll
                    for (int ax = 0; ax < 2; ++ax) { const int pos = ax ? t % GRID_W : t / GRID_W;
                        const f32x4 cs = *(const f32x4*)(p.rope + pos * 16 + 4 * fq), sn = *(const f32x4*)(p.rope + 1024 + pos * 16 + 4 * fq);
                        const f32x4 x0 = acc[m][2 * ax], x1 = acc[m][2 * ax + 1];
                        st_bf16x4(zr + 32 * ax, x0 * cs - x1 * sn); st_bf16x4(zr + 32 * ax + 16, x1 * cs + x0 * sn); } }
            });
        } else {
            gemm_tile<true>(a0, a1, b0, b1, D, lds, [&](const f32x4 (&acc)[4][4], int wr, int wc, int fr, int fq) {
#pragma unroll
                for (int m = 0; m < 4; ++m)
#pragma unroll
                    for (int n = 0; n < 4; ++n) { const int col = tn * 128 + wc * 64 + n * 16 + 4 * fq;
                        if (col < ZP) st_bf16x4(p.Z + (size_t)(tm * 128 + wr * 64 + m * 16 + fr) * ZP + col, acc[m][n]); }
            });
        }
    }
}
__device__ __forceinline__ void g_gemm_out(const Params& p, int nrows, char* lds) {
    const int tid_ = opq_tid(), bid_ = opq_bid(); (void)tid_; (void)bid_;
    constexpr int NT = D / 128; const int MT = nrows / 128;
    for (int tile = bid_; tile < NT * MT; tile += gridDim.x) {
        const int tm = tile / NT, tn = tile % NT;
        const bf16_t* a0 = p.MIX + (size_t)(tm * 128 + STG_ROW(0)) * DMIX + STG_K; const bf16_t* a1 = p.MIX + (size_t)(tm * 128 + STG_ROW(1)) * DMIX + STG_K;
        const bf16_t* b0 = p.wout_t + (size_t)(tn * 128 + STG_ROW(0)) * DMIX + STG_K; const bf16_t* b1 = p.wout_t + (size_t)(tn * 128 + STG_ROW(1)) * DMIX + STG_K;
        gemm_tile(a0, a1, b0, b1, DMIX, lds, [&](const f32x4 (&acc)[4][4], int wr, int wc, int fr, int fq) {
#pragma unroll
            for (int m = 0; m < 4; ++m)
#pragma unroll
                for (int n = 0; n < 4; ++n) st_bf16x4(p.O + (size_t)(tm * 128 + wr * 64 + m * 16 + fr) * D + tn * 128 + wc * 64 + n * 16 + 4 * fq, acc[m][n]);
        });
    }
}
__device__ __forceinline__ void g_moe1(const Params& p, int l, char* lds) {
    const int tid_ = opq_tid(), bid_ = opq_bid(); (void)tid_; (void)bid_;
    const int* cnt = p.cnt + l * NEXP; const int nrb = moe_blocks(cnt); constexpr int NT = 2 * DE / 128;
    for (int tile = bid_; tile < nrb * NT; tile += gridDim.x) {
        const int rb = tile / NT, tn = tile % NT, e = moe_block_expert(cnt, rb);
        const bf16_t* a0 = p.H + (size_t)p.slotTok[rb * 128 + STG_ROW(0)] * D + STG_K; const bf16_t* a1 = p.H + (size_t)p.slotTok[rb * 128 + STG_ROW(1)] * D + STG_K;
        const bf16_t* bw = p.wgu_t + (size_t)e * 2 * DE * D;
        const bf16_t* b0 = bw + (size_t)(tn * 128 + STG_ROW(0)) * D + STG_K; const bf16_t* b1 = bw + (size_t)(tn * 128 + STG_ROW(1)) * D + STG_K;
        gemm_tile(a0, a1, b0, b1, D, lds, [&](const f32x4 (&acc)[4][4], int wr, int wc, int fr, int fq) {
#pragma unroll
            for (int m = 0; m < 4; ++m)
#pragma unroll
                for (int n2 = 0; n2 < 2; ++n2) {
                    const f32x4 g = acc[m][2 * n2], u = acc[m][2 * n2 + 1]; f32x4 a;
#pragma unroll
                    for (int e4 = 0; e4 < 4; ++e4) a[e4] = g[e4] / (1.0f + __expf(-g[e4])) * u[e4];
                    st_bf16x4(p.ACT + (size_t)(rb * 128 + wr * 64 + m * 16 + fr) * DE + tn * 64 + wc * 32 + n2 * 16 + 4 * fq, a); }
        });
    }
}
__device__ __forceinline__ void g_moe2(const Params& p, int l, char* lds) {
    const int tid_ = opq_tid(), bid_ = opq_bid(); (void)tid_; (void)bid_;
    const int* cnt = p.cnt + l * NEXP; const int nrb = moe_blocks(cnt); constexpr int NT = D / 128;
    for (int tile = bid_; tile < nrb * NT; tile += gridDim.x) {
        const int rb = tile / NT, tn = tile % NT, e = moe_block_expert(cnt, rb);
        const bf16_t* a0 = p.ACT + (size_t)(rb * 128 + STG_ROW(0)) * DE + STG_K; const bf16_t* a1 = p.ACT + (size_t)(rb * 128 + STG_ROW(1)) * DE + STG_K;
        const bf16_t* bw = p.wd_t + (size_t)e * D * DE;
        const bf16_t* b0 = bw + (size_t)(tn * 128 + STG_ROW(0)) * DE + STG_K; const bf16_t* b1 = bw + (size_t)(tn * 128 + STG_ROW(1)) * DE + STG_K;
        gemm_tile(a0, a1, b0, b1, DE, lds, [&](const f32x4 (&acc)[4][4], int wr, int wc, int fr, int fq) {
#pragma unroll
            for (int m = 0; m < 4; ++m)
#pragma unroll
                for (int n = 0; n < 4; ++n) st_bf16x4(p.YSb + (size_t)(rb * 128 + wr * 64 + m * 16 + fr) * D + tn * 128 + wc * 64 + n * 16 + 4 * fq, acc[m][n]);
        });
    }
}


constexpr int DV = D / 256;
static_assert(D % 256 == 0, "row phases hold a row as DV float4 per lane");
template <int CTRL> __device__ __forceinline__ float dppf(float v) { return __builtin_bit_cast(float, __builtin_amdgcn_update_dpp(0, __builtin_bit_cast(int, v), CTRL, 0xf, 0xf, true)); }
__device__ __forceinline__ float wave_sum(float v) {
    v += dppf<0xB1>(v); v += dppf<0x4E>(v); v += dppf<0x141>(v); v += dppf<0x140>(v);
    float a = v, b = v;
    asm volatile("s_nop 1\n\tv_permlane16_swap_b32 %0, %1" : "+v"(a), "+v"(b));
    v = a + b; a = v; b = v;
    asm volatile("s_nop 1\n\tv_permlane32_swap_b32 %0, %1" : "+v"(a), "+v"(b));
    return a + b;
}
__device__ __forceinline__ float sum8(float v) { v += dppf<0xB1>(v); v += dppf<0x4E>(v); v += dppf<0x141>(v); return v; }
__device__ __forceinline__ float sum4(f32x4 a) { return (a[0] + a[1]) + (a[2] + a[3]); }
#define LDS_WAIT() asm volatile("s_waitcnt lgkmcnt(0)" ::: "memory")

__device__ __forceinline__ void row_stats(const f32x4 (&v)[DV], float& mu, float& rstd) {
    float s = 0.f;
#pragma unroll
    for (int j = 0; j < DV; ++j) s += sum4(v[j]);
    mu = wave_sum(s) * (1.0f / D);
    float q = 0.f;
#pragma unroll
    for (int j = 0; j < DV; ++j) { const f32x4 d = v[j] - mu; q += sum4(d * d); }
    rstd = 1.0f / sqrtf(wave_sum(q) * (1.0f / D) + LN_EPS);
}

__device__ __forceinline__ void ph_lnmod_fast(const Params& p, int l) {
    const int tid_ = opq_tid(), bid_ = opq_bid(); (void)tid_; (void)bid_;
    const int lane = tid_ & 63, gw = bid_ * 4 + (tid_ >> 6), nw = gridDim.x * 4;
    constexpr int R = 4;
    for (int m0 = gw * R; m0 < T; m0 += nw * R) {
        f32x4 v[R][DV];
#pragma unroll
        for (int r = 0; r < R; ++r) { const f32x4* xr = (const f32x4*)xrow_in(p, l, m0 + r < T ? m0 + r : m0) + lane;
#pragma unroll
            for (int j = 0; j < DV; ++j) v[r][j] = xr[64 * j]; }
        float mu[R], rstd[R];
#pragma unroll
        for (int r = 0; r < R; ++r) row_stats(v[r], mu[r], rstd[r]);
#pragma unroll
        for (int r = 0; r < R; ++r) if (m0 + r < T) { const f32x4* md = (const f32x4*)modrow(p, l, m0 + r) + lane;
#pragma unroll
            for (int j = 0; j < DV; ++j) st_bf16x4(p.H + (size_t)(m0 + r) * D + 4 * (lane + 64 * j), (v[r][j] - mu[r]) * rstd[r] * (md[D / 4 + 64 * j] + 1.0f) + md[64 * j]); }
    }
}

template <int R>
__device__ __forceinline__ void pm_rows(const Params& p, int l, int m0, int lane) {
    const f32x4* g1 = (const f32x4*)(p.ln1_g + (size_t)l * D) + lane; const f32x4* b1 = (const f32x4*)(p.ln1_b + (size_t)l * D) + lane;
    f32x4 v[R][DV]; float mu[R], rstd[R];
#pragma unroll
    for (int r = 0; r < R; ++r) { const int m = m0 + r; const f32x4* xr = (const f32x4*)xrow_in(p, l, m) + lane; const f32x4* md = (const f32x4*)modrow(p, l, m) + lane;
        const bf16_t* orow = p.O + (size_t)m * D + 4 * lane;
#pragma unroll
        for (int j = 0; j < DV; ++j) v[r][j] = xr[64 * j] * ALPHA + md[2 * (D / 4) + 64 * j] * ld_bf16x4(orow + 256 * j); }
#pragma unroll
    for (int r = 0; r < R; ++r) row_stats(v[r], mu[r], rstd[r]);
#pragma unroll
    for (int r = 0; r < R; ++r) { const int m = m0 + r; f32x4* x1 = (f32x4*)((m < TL) ? p.out + (size_t)m * D : p.XC + (size_t)(m - TL) * D) + lane;
#pragma unroll
        for (int j = 0; j < DV; ++j) { v[r][j] = (v[r][j] - mu[r]) * rstd[r] * g1[64 * j] + b1[64 * j]; x1[64 * j] = v[r][j]; } }
#pragma unroll
    for (int r = 0; r < R; ++r) row_stats(v[r], mu[r], rstd[r]);
#pragma unroll
    for (int r = 0; r < R; ++r) { const int m = m0 + r; const f32x4* md = (const f32x4*)modrow(p, l, m) + lane;
#pragma unroll
        for (int j = 0; j < DV; ++j) {
            const f32x4 hv = (v[r][j] - mu[r]) * rstd[r] * (md[4 * (D / 4) + 64 * j] + 1.0f) + md[3 * (D / 4) + 64 * j];
            f32x4 hh, lo;
#pragma unroll
            for (int e = 0; e < 4; ++e) { hh[e] = bf2f(f2bf(hv[e])); lo[e] = hv[e] - hh[e]; }
            st_bf16x4(p.H + (size_t)m * D + 4 * (lane + 64 * j), hh);
            st_bf16x4(p.HLO + (size_t)m * D + 4 * (lane + 64 * j), lo);
        } }
}

__device__ __forceinline__ int router_rpg(int nrows) { const int g = gridDim.x; return (nrows % g == 0 && nrows / g <= 48 && (nrows / g) % 4 == 0) ? nrows / g : 32; }
__device__ __forceinline__ void g_router(const Params& p, int l, int nrows, char* lds) {
    const int tid_ = opq_tid(), bid_ = opq_bid(); (void)tid_; (void)bid_;
    const int lane = tid_ & 63, wid = tid_ >> 6, fr = lane & 15, fq = lane >> 4;
    const int RPG = router_rpg(nrows), RW = RPG / 4;
    float* part = (float*)lds;
    float* lgt = part + 4 * 9 * 64 * 4;
    int* eids = (int*)(lgt + 48 * 48);
    for (int rg = bid_; rg < nrows / RPG; rg += gridDim.x) {
#pragma unroll 1
        for (int i = 0; i + 1 < RW; i += 2) pm_rows<2>(p, l, rg * RPG + wid * RW + i, lane);
        if (RW & 1) pm_rows<1>(p, l, rg * RPG + wid * RW + RW - 1, lane);
        asm volatile("s_waitcnt vmcnt(0)" ::: "memory");
        __syncthreads();
        f32x4 acc[3][3];
#pragma unroll
        for (int a = 0; a < 3; ++a)
#pragma unroll
            for (int b = 0; b < 3; ++b) acc[a][b] = (f32x4){0.f, 0.f, 0.f, 0.f};
        int arow[3];
#pragma unroll
        for (int a = 0; a < 3; ++a) { const int rr = a * 16 + fr; arow[a] = rg * RPG + (rr < RPG ? rr : RPG - 1); }
#pragma unroll
        for (int seg = 0; seg < 3; ++seg) {
            const bf16_t* ab = (seg < 2 ? p.H : p.HLO) + wid * (D / 4) + fq * 8;
            const bf16_t* bp = p.wrt + (seg == 1 ? (size_t)128 * D : 0) + (size_t)fr * D + wid * (D / 4) + fq * 8;
#pragma unroll 1
            for (int ks0 = 0; ks0 < D / 128; ks0 += 2) {
                bf16x8 av[2][3], bv[2][3];
#pragma unroll
                for (int u = 0; u < 2; ++u) { const int ko = (ks0 + u) * 32;
#pragma unroll
                    for (int a = 0; a < 3; ++a) { av[u][a] = *(const bf16x8*)(ab + (size_t)arow[a] * D + ko); bv[u][a] = *(const bf16x8*)(bp + (size_t)(16 * a) * D + ko); } }
                asm volatile("" ::: "memory");
#pragma unroll
                for (int u = 0; u < 2; ++u)
#pragma unroll
                    for (int a = 0; a < 3; ++a)
#pragma unroll
                        for (int b = 0; b < 3; ++b) acc[a][b] = __builtin_amdgcn_mfma_f32_16x16x32_bf16(av[u][a], bv[u][b], acc[a][b], 0, 0, 0);
            }
        }
#pragma unroll
        for (int a = 0; a < 3; ++a)
#pragma unroll
            for (int b = 0; b < 3; ++b) *(f32x4*)(part + ((wid * 9 + a * 3 + b) * 64 + lane) * 4) = acc[a][b];
        __syncthreads();
#pragma unroll
        for (int i = 0; i < 9; ++i) { const int e = tid_ + 256 * i, f = e >> 8, ln = (e & 255) >> 2, j = e & 3;
            const float sm = (part[((0 * 9 + f) * 64 + ln) * 4 + j] + part[((1 * 9 + f) * 64 + ln) * 4 + j]) + (part[((2 * 9 + f) * 64 + ln) * 4 + j] + part[((3 * 9 + f) * 64 + ln) * 4 + j]);
            lgt[((f / 3) * 16 + (ln >> 4) * 4 + j) * 48 + (f % 3) * 16 + (ln & 15)] = sm; }
        __syncthreads();
        if (tid_ < RPG) {
            const int m = rg * RPG + tid_; const float* lg = lgt + tid_ * 48;
            float gl[4], el[32];
#pragma unroll
            for (int g = 0; g < 4; ++g) gl[g] = lg[g] + p.b_rg[l * 4 + g];
#pragma unroll
            for (int e = 0; e < 32; ++e) el[e] = lg[4 + e] + p.b_re[l * 32 + e];
            int gs = 0; float gm = gl[0];
#pragma unroll
            for (int g = 1; g < 4; ++g) if (gl[g] > gm) { gm = gl[g]; gs = g; }
            float den = 0.f;
#pragma unroll
            for (int g = 0; g < 4; ++g) den += expf(gl[g] - gm);
            const float pg = 1.0f / den;
            float v1 = -3e38f, v2 = -3e38f; int i1 = 0, i2 = 0;
#pragma unroll
            for (int j = 0; j < 8; ++j) {
                const float vv = gs == 0 ? el[j] : gs == 1 ? el[8 + j] : gs == 2 ? el[16 + j] : el[24 + j];
                if (vv > v1) { v2 = v1; i2 = i1; v1 = vv; i1 = j; } else if (vv > v2) { v2 = vv; i2 = j; }
            }
            const float e2 = expf(v2 - v1), w1 = pg / (1.0f + e2), w2 = pg * e2 / (1.0f + e2);
            const int ea = gs * 8 + i1, eb = gs * 8 + i2;
            p.rE[2 * m] = ea; p.rE[2 * m + 1] = eb; p.rW[2 * m] = w1; p.rW[2 * m + 1] = w2;
            eids[2 * tid_] = ea; eids[2 * tid_ + 1] = eb;
        }
        __syncthreads();
        if (tid_ < 2 * RPG) { const int e = eids[tid_]; int rk = 0; for (int j = 0; j < tid_; ++j) rk += (eids[j] == e) ? 1 : 0; p.rPos[2 * (rg * RPG) + tid_] = rk; }
        else if (tid_ >= 128 && tid_ < 160) { const int e = tid_ - 128; int c = 0; for (int j = 0; j < 2 * RPG; ++j) c += (eids[j] == e) ? 1 : 0; p.hist[rg * 32 + e] = c; }
        __syncthreads();
    }
}

__device__ __forceinline__ void ph_dispatch_fast(const Params& p, int l, int nrows, char* lds) {
    const int tid_ = opq_tid(), bid_ = opq_bid(); (void)tid_; (void)bid_;
    const int RPG = router_rpg(nrows), nrg = nrows / RPG, e = tid_ & 31, part = tid_ >> 5;
    int* tot = (int*)lds; int* pst = tot + 32; int* pre = pst + 32; int* red = pre + 32;
    { int s = 0; for (int b = part; b < nrg; b += 8) s += p.hist[b * 32 + e]; red[part * 32 + e] = s; }
    __syncthreads();
    if (tid_ < 32) { int s = 0; for (int q = 0; q < 8; ++q) s += red[q * 32 + tid_]; tot[tid_] = s; }
    __syncthreads();
    if (tid_ < 32) { int s = 0; for (int j = 0; j < tid_; ++j) s += (tot[j] + 127) & ~127; pst[tid_] = s; if (bid_ == 0) p.cnt[l * NEXP + tid_] = tot[tid_]; }
    for (int rg = bid_; rg < nrg; rg += gridDim.x) {
        __syncthreads();
        { int s = 0; for (int b = part; b < rg; b += 8) s += p.hist[b * 32 + e]; red[part * 32 + e] = s; }
        __syncthreads();
        if (tid_ < 32) { int s = 0; for (int q = 0; q < 8; ++q) s += red[q * 32 + tid_]; pre[tid_] = s; }
        __syncthreads();
        if (tid_ < 2 * RPG) { const int i = 2 * (rg * RPG) + tid_, ee = p.rE[i], slot = pst[ee] + pre[ee] + p.rPos[i]; p.rSlot[i] = slot; p.slotTok[slot] = i >> 1; }
    }
}

__device__ __forceinline__ void ph_final_fast(const Params& p, int l, int nrows, bool next_h) {
    const int tid_ = opq_tid(), bid_ = opq_bid(); (void)tid_; (void)bid_;
    const int lane = tid_ & 63, gw = bid_ * 4 + (tid_ >> 6), nw = gridDim.x * 4;
    constexpr int R = 2;
    const f32x4* g2 = (const f32x4*)(p.ln2_g + (size_t)l * D) + lane; const f32x4* b2 = (const f32x4*)(p.ln2_b + (size_t)l * D) + lane;
    for (int m0 = gw * R; m0 < nrows; m0 += nw * R) {
        f32x4 v[R][DV]; float mu[R], rstd[R];
#pragma unroll
        for (int r = 0; r < R; ++r) { const int m = m0 + r; const f32x4* x1 = (const f32x4*)((m < TL) ? p.out + (size_t)m * D : p.XC + (size_t)(m - TL) * D) + lane;
            const f32x4* md = (const f32x4*)modrow(p, l, m) + lane;
            const bf16_t* ya = p.YSb + (size_t)p.rSlot[2 * m] * D + 4 * lane; const bf16_t* yb = p.YSb + (size_t)p.rSlot[2 * m + 1] * D + 4 * lane;
            const float wa = p.rW[2 * m], wb = p.rW[2 * m + 1];
#pragma unroll
            for (int j = 0; j < DV; ++j) v[r][j] = x1[64 * j] * ALPHA + md[5 * (D / 4) + 64 * j] * (ld_bf16x4(ya + 256 * j) * wa + ld_bf16x4(yb + 256 * j) * wb); }
#pragma unroll
        for (int r = 0; r < R; ++r) row_stats(v[r], mu[r], rstd[r]);
#pragma unroll
        for (int r = 0; r < R; ++r) { const int m = m0 + r; f32x4* x1 = (f32x4*)((m < TL) ? p.out + (size_t)m * D : p.XC + (size_t)(m - TL) * D) + lane;
#pragma unroll
            for (int j = 0; j < DV; ++j) { v[r][j] = (v[r][j] - mu[r]) * rstd[r] * g2[64 * j] + b2[64 * j]; x1[64 * j] = v[r][j]; } }
        if (next_h) {
#pragma unroll
            for (int r = 0; r < R; ++r) row_stats(v[r], mu[r], rstd[r]);
#pragma unroll
            for (int r = 0; r < R; ++r) { const int m = m0 + r; const f32x4* mn = (const f32x4*)modrow(p, l + 1, m) + lane;
#pragma unroll
                for (int j = 0; j < DV; ++j) st_bf16x4(p.H + (size_t)m * D + 4 * (lane + 64 * j), (v[r][j] - mu[r]) * rstd[r] * (mn[D / 4 + 64 * j] + 1.0f) + mn[64 * j]); }
        }
    }
}

__device__ __forceinline__ void ph_mod_fast(const Params& p, char* lds) {
    const int tid_ = opq_tid(), bid_ = opq_bid(); (void)tid_; (void)bid_;
    constexpr int NR = NB + 1, NTASK = 2 * (6 * D / 64);
    if (bid_ >= NTASK) return;
    float* sc = (float*)lds;
    float* part = sc + NR * D;
    for (int i = tid_; i < NR * D; i += 256) { const int b = i / D, k = i % D; const float cv = b < NB ? p.c[(size_t)b * D + k] : p.c_ctx[k]; sc[i] = cv / (1.0f + __expf(-cv)); }
    __syncthreads();
    const int lane = tid_ & 63, wid = tid_ >> 6;
    for (int task = bid_; task < NTASK; task += gridDim.x) {
        const int ll = task / (6 * D / 64), col = 64 * (task % (6 * D / 64)) + lane;
        float acc[NR];
#pragma unroll
        for (int b = 0; b < NR; ++b) acc[b] = 0.f;
        const float* wp = p.w_mod + ((size_t)ll * D + wid * (D / 4)) * 6 * D + col;
#pragma unroll 16
        for (int k = 0; k < D / 4; ++k) { const float w = wp[(size_t)k * 6 * D];
#pragma unroll
            for (int b = 0; b < NR; ++b) acc[b] += sc[b * D + wid * (D / 4) + k] * w; }
#pragma unroll
        for (int b = 0; b < NR; ++b) part[(wid * NR + b) * 64 + lane] = acc[b];
        __syncthreads();
        for (int i = tid_; i < NR * 64; i += 256) { const int b = i / 64, cl = i % 64;
            p.mod[((size_t)ll * NR + b) * 6 * D + 64 * (task % (6 * D / 64)) + cl] = (part[(0 * NR + b) * 64 + cl] + part[(1 * NR + b) * 64 + cl]) + (part[(2 * NR + b) * 64 + cl] + part[(3 * NR + b) * 64 + cl]) + p.b_mod[(size_t)ll * 6 * D + 64 * (task % (6 * D / 64)) + cl]; }
        __syncthreads();
    }
}

template <bool SPLIT = false>
__device__ __forceinline__ void tr_item(const float* srcl, size_t ldw, bf16_t* dst, size_t ldd, float* scr, int lane) {
    float v[32];
#pragma unroll
    for (int i = 0; i < 32; ++i) v[i] = srcl ? srcl[(size_t)(2 * i + (lane >> 5)) * ldw] : 0.f;
#pragma unroll
    for (int i = 0; i < 32; ++i) scr[(2 * i + (lane >> 5)) * 33 + (lane & 31)] = v[i];
    LDS_WAIT();
    const int c = lane & 7;
#pragma unroll
    for (int j = 0; j < 4; ++j) { const int n = (lane >> 3) + 8 * j; const float* s = scr + (8 * c) * 33 + n;
        uint4 o; o.x = pk2(s[0], s[33]); o.y = pk2(s[2 * 33], s[3 * 33]); o.z = pk2(s[4 * 33], s[5 * 33]); o.w = pk2(s[6 * 33], s[7 * 33]);
        *(uint4*)(dst + (size_t)(SPLIT ? (n & 15) + 32 * (n >> 4) : n) * ldd + 8 * c) = o; }
    LDS_WAIT();
}
__device__ __forceinline__ void ph_prep_w_fast(const Params& p, int l, int part, char* lds) {
    const int tid_ = opq_tid(), bid_ = opq_bid(); (void)tid_; (void)bid_;
    const int lane = tid_ & 63, wid = tid_ >> 6, gw = bid_ * 4 + wid, nw = gridDim.x * 4;
    float* scr = (float*)(lds + wid * 8448);
    constexpr int I_IN = (D / 64) * (NINP / 32), I_OUT = (DMIX / 64) * (D / 32), I_GU1 = (D / 64) * (2 * DE / 32), I_D1 = (DE / 64) * (D / 32);
    constexpr int NITEMS = I_IN + I_OUT + NEXP * (I_GU1 + I_D1);
    const int it0 = part == 0 ? 0 : I_IN + I_OUT, it1 = part == 0 ? I_IN + I_OUT : NITEMS;
    for (int it = it0 + gw; it < it1; it += nw) {
        int r = it;
        if (r < I_IN) { const int kb = r / (NINP / 32), n0 = 32 * (r % (NINP / 32));
            const float* s = nullptr;
            if (n0 < N_IN) { const int oc = (n0 < ZA) ? n0 + A_IN : n0 - ZA; s = p.w_in + ((size_t)l * D + 64 * kb) * N_IN + oc + (lane & 31); }
            tr_item(s, N_IN, p.win_t + (size_t)n0 * D + 64 * kb, D, scr, lane); continue; }
        r -= I_IN;
        if (r < I_OUT) { const int kb = r / (D / 32), n0 = 32 * (r % (D / 32));
            tr_item(p.w_out + ((size_t)l * DMIX + 64 * kb) * D + n0 + (lane & 31), D, p.wout_t + (size_t)n0 * DMIX + 64 * kb, DMIX, scr, lane); continue; }
        r -= I_OUT;
        const int e = r / (I_GU1 + I_D1); r %= (I_GU1 + I_D1);
        if (r < I_GU1) { const int kb = r / (2 * DE / 32), q = r % (2 * DE / 32), up = q & 1, c0 = 32 * (q >> 1);
            const float* s = (up ? p.w_up : p.w_gate) + (((size_t)l * NEXP + e) * D + 64 * kb) * DE + c0 + (lane & 31);
            tr_item<true>(s, DE, p.wgu_t + ((size_t)e * 2 * DE + 2 * c0 + 16 * up) * D + 64 * kb, D, scr, lane); continue; }
        r -= I_GU1;
        { const int kb = r / (D / 32), n0 = 32 * (r % (D / 32));
            tr_item(p.w_down + (((size_t)l * NEXP + e) * DE + 64 * kb) * D + n0 + (lane & 31), D, p.wd_t + ((size_t)e * D + n0) * DE + 64 * kb, DE, scr, lane); }
    }
    if (part != 0) return;
    const long gt = (long)bid_ * blockDim.x + tid_, gs = (long)gridDim.x * blockDim.x;
    for (long i = gt; i < 2 * 256 * 64; i += gs) { const int k = (int)(i & 63), n = (int)((i >> 6) & 255), d = (int)(i >> 14);
        p.wupT[i] = f2bf(p.a_w_up[(((size_t)l * 2 + d) * 64 + k) * DA + n]); p.aupT[i] = f2bf(p.a_a_up[(((size_t)l * 2 + d) * 64 + k) * DA + n]); }
    for (long i = gt; i < 256 * 160; i += gs) { const int k = (int)(i % 160), n = (int)(i / 160); p.gupT[i] = f2bf(p.a_g_up[((size_t)l * 160 + k) * DA + n]); }
    for (long i = gt; i < (long)128 * D; i += gs) { const int n = (int)(i / D), k = (int)(i % D);
        const float w = n < 4 ? p.w_rg[((size_t)l * D + k) * 4 + n] : n < 36 ? p.w_re[((size_t)l * D + k) * 32 + n - 4] : 0.f;
        const bf16_t hb = f2bf(w); p.wrt[i] = hb; p.wrt[(size_t)128 * D + i] = f2bf(w - bf2f(hb)); }
}

__device__ __forceinline__ float tanh_fast(float x) { return 1.0f - 2.0f / (1.0f + __expf(2.0f * x)); }
__device__ __forceinline__ void ph_streams_s1(const Params& p, int l) {
    const int tid_ = opq_tid(), bid_ = opq_bid(); (void)tid_; (void)bid_;
    constexpr int NCH = A_IN / 8, NCHP = (NCH + 7) & ~7;
    const float* sh = p.a_shift + (size_t)l * 3 * A_IN;
    for (long it = (long)bid_ * 256 + tid_; it < (long)T * NCHP; it += (long)gridDim.x * 256) {
        const int m = (int)(it / NCHP), ch = (int)(it % NCHP), c0 = 8 * ch;
        const bool act = ch < NCH;
        int t, len;
        if (m < TL) { t = m % S; len = S; } else { t = (m - TL) % L; len = L; }
        float v[8];
#pragma unroll
        for (int e = 0; e < 8; ++e) v[e] = 0.f;
        if (act) {
            const bf16_t* z = p.Z + (size_t)m * ZP + ZA + c0;
            const bf16x8 zc = *(const bf16x8*)z;
            const f32x4 s1a = *(const f32x4*)(sh + A_IN + c0), s1b = *(const f32x4*)(sh + A_IN + c0 + 4);
#pragma unroll
            for (int e = 0; e < 8; ++e) v[e] = (e < 4 ? s1a[e] : s1b[e - 4]) * bf2f((bf16_t)zc[e]);
            if (t > 0) { const bf16x8 zp = *(const bf16x8*)(z - ZP); const f32x4 a = *(const f32x4*)(sh + c0), b = *(const f32x4*)(sh + c0 + 4);
#pragma unroll
                for (int e = 0; e < 8; ++e) v[e] += (e < 4 ? a[e] : b[e - 4]) * bf2f((bf16_t)zp[e]); }
            if (t < len - 1) { const bf16x8 zn = *(const bf16x8*)(z + ZP); const f32x4 a = *(const f32x4*)(sh + 2 * A_IN + c0), b = *(const f32x4*)(sh + 2 * A_IN + c0 + 4);
#pragma unroll
                for (int e = 0; e < 8; ++e) v[e] += (e < 4 ? a[e] : b[e - 4]) * bf2f((bf16_t)zn[e]); }
        }
        float nrm = 0.f;
        if (ch >= 32 && ch < 64) {
#pragma unroll
            for (int e = 0; e < 8; ++e) { const float t2 = v[e] * p.a_k_k[l * DA + c0 - 256 + e]; nrm += t2 * t2; } }
        nrm = sum8(nrm);
        if (!act) continue;
        if (c0 < 768) {
            float* dst = (c0 < 256 ? p.sR + (size_t)m * DA + c0 : c0 < 512 ? p.kT + (size_t)m * DA + c0 - 256 : p.sV + (size_t)m * DA + c0 - 512);
            *(f32x4*)dst = (f32x4){v[0], v[1], v[2], v[3]}; *(f32x4*)(dst + 4) = (f32x4){v[4], v[5], v[6], v[7]};
            if (ch >= 32 && ch < 64 && (ch & 7) == 0) p.kN[(size_t)m * 4 + ((ch - 32) >> 3)] = 1.0f / sqrtf(nrm + 1e-12f);
        } else {
            if (c0 < 896) {
#pragma unroll
                for (int e = 0; e < 8; ++e) v[e] = tanh_fast(v[e]); }
            else if (c0 >= 1024) {
#pragma unroll
                for (int e = 0; e < 8; ++e) v[e] = 1.0f / (1.0f + __expf(-v[e])); }
            uint4 o; o.x = pk2(v[0], v[1]); o.y = pk2(v[2], v[3]); o.z = pk2(v[4], v[5]); o.w = pk2(v[6], v[7]);
            *(uint4*)(p.LA + (size_t)m * 416 + c0 - 768) = o;
        }
    }
}
__device__ __forceinline__ void g_streams_s2(const Params& p, int l, char* lds) {
    const int tid_ = opq_tid(), bid_ = opq_bid(); (void)tid_; (void)bid_;
    constexpr int MT = T / 128;
    for (int job = bid_; job < 5 * MT * 2; job += gridDim.x) {
        const int type = job / (MT * 2), r = job % (MT * 2), tm = r >> 1, tn = r & 1;
        const int coff = type < 2 ? type * 64 : type < 4 ? 128 + (type - 2) * 64 : 256, K = type < 4 ? 64 : 160, d = type & 1;
        const bf16_t* Bt = type < 2 ? p.wupT + type * 256 * 64 : type < 4 ? p.aupT + (type - 2) * 256 * 64 : p.gupT;
        const bf16_t* a0 = p.LA + (size_t)(tm * 128 + STG_ROW(0)) * 416 + coff + STG_K; const bf16_t* a1 = p.LA + (size_t)(tm * 128 + STG_ROW(1)) * 416 + coff + STG_K;
        const bf16_t* b0 = Bt + (size_t)(tn * 128 + STG_ROW(0)) * K + STG_K; const bf16_t* b1 = Bt + (size_t)(tn * 128 + STG_ROW(1)) * K + STG_K;
        if (type < 2) gemm_tile(a0, a1, b0, b1, K, lds, [&](const f32x4 (&acc)[4][4], int wr, int wc, int fr, int fq) {
#pragma unroll
            for (int mi = 0; mi < 4; ++mi) { const int row = tm * 128 + wr * 64 + mi * 16 + fr;
#pragma unroll
                for (int n = 0; n < 4; ++n) { const int c = tn * 128 + wc * 64 + n * 16 + 4 * fq; const f32x4 w0 = *(const f32x4*)(p.a_w0 + (l * 2 + d) * DA + c); f32x4 o;
#pragma unroll
                    for (int e4 = 0; e4 < 4; ++e4) { const float ex = __expf(-(w0[e4] + acc[mi][n][e4]));
                        o[e4] = __expf(-0.60653065971f / (1.0f + ex)); }
                    *(f32x4*)(p.sW + ((size_t)d * T + row) * DA + c) = o; }
                asm volatile("" ::: "memory"); }
        });
        else if (type < 4) gemm_tile(a0, a1, b0, b1, K, lds, [&](const f32x4 (&acc)[4][4], int wr, int wc, int fr, int fq) {
#pragma unroll
            for (int mi = 0; mi < 4; ++mi) { const int row = tm * 128 + wr * 64 + mi * 16 + fr;
#pragma unroll
                for (int n = 0; n < 4; ++n) { const int c = tn * 128 + wc * 64 + n * 16 + 4 * fq;
                    const f32x4 a0v = *(const f32x4*)(p.a_a0 + (l * 2 + d) * DA + c), kkc = *(const f32x4*)(p.a_k_k + l * DA + c), kac = *(const f32x4*)(p.a_k_a + l * DA + c);
                    const size_t o = (size_t)row * DA + c, od = ((size_t)d * T + row) * DA + c;
                    const f32x4 k = *(const f32x4*)(p.kT + o); const float kn = p.kN[(size_t)row * 4 + (c >> 6)];
                    f32x4 kd, bo, kk;
#pragma unroll
                    for (int e4 = 0; e4 < 4; ++e4) { const float av = 1.0f / (1.0f + __expf(-(a0v[e4] + acc[mi][n][e4])));
                        kk[e4] = k[e4] * kkc[e4] * kn; kd[e4] = k[e4] * (1.0f + (av - 1.0f) * kac[e4]); bo[e4] = kk[e4] * av; }
                    *(f32x4*)(p.sKD + od) = kd; *(f32x4*)(p.sB + od) = bo; if (d == 0) *(f32x4*)(p.sKK + o) = kk; }
                asm volatile("" ::: "memory"); }
        });
        else gemm_tile(a0, a1, b0, b1, K, lds, [&](const f32x4 (&acc)[4][4], int wr, int wc, int fr, int fq) {
#pragma unroll
            for (int mi = 0; mi < 4; ++mi)
#pragma unroll
                for (int n = 0; n < 4; ++n) st_bf16x4(p.MIX + (size_t)(tm * 128 + wr * 64 + mi * 16 + fr) * DMIX + tn * 128 + wc * 64 + n * 16 + 4 * fq, acc[mi][n]);
        });
    }
}


typedef float f32x16 __attribute__((ext_vector_type(16)));
typedef short s16x4 __attribute__((ext_vector_type(4)));
typedef unsigned u32x4_t __attribute__((ext_vector_type(4)));
typedef float f32x2_t __attribute__((ext_vector_type(2)));
typedef __bf16 bf16x2_t __attribute__((ext_vector_type(2)));
__device__ __forceinline__ unsigned cvtpk(float lo, float hi) { f32x2_t v = {lo, hi}; bf16x2_t b = __builtin_convertvector(v, bf16x2_t); return __builtin_bit_cast(unsigned, b); }
__device__ __forceinline__ int crow(int r, int hi) { return (r & 3) + 8 * (r >> 2) + 4 * hi; }
__device__ __forceinline__ float xmax32(float v) { float a = v, b = v; asm volatile("s_nop 1\n\tv_permlane32_swap_b32 %0, %1" : "+v"(a), "+v"(b)); return fmaxf(a, b); }
__device__ __forceinline__ float xsum32(float v) { float a = v, b = v; asm volatile("s_nop 1\n\tv_permlane32_swap_b32 %0, %1" : "+v"(a), "+v"(b)); return a + b; }

template <class MaskF>
__device__ __forceinline__ void attn_tile(const bf16x8 (&qf)[4], const bf16_t* krow, const bf16_t* vt0, const bf16_t* vt1, const MaskF& mask,
                                          float& m_run, float& l_run, f32x16& o0, f32x16& o1, int hi) {
    f32x16 s;
#pragma unroll
    for (int r = 0; r < 16; ++r) s[r] = 0.f;
#pragma unroll
    for (int ks = 0; ks < 4; ++ks) { const bf16x8 kf = *(const bf16x8*)(krow + 16 * ks); s = __builtin_amdgcn_mfma_f32_32x32x16_bf16(kf, qf[ks], s, 0, 0, 0); }
    float mx = -INFINITY;
#pragma unroll
    for (int r = 0; r < 16; ++r) { s[r] = mask(crow(r, hi), s[r] * ATT_SCALE); mx = fmaxf(mx, s[r]); }
    mx = xmax32(mx);
    const float mn = fmaxf(m_run, mx), alpha = __expf(m_run - mn);
    m_run = mn;
    float ps = 0.f;
#pragma unroll
    for (int r = 0; r < 16; ++r) { s[r] = __expf(s[r] - mn); ps += s[r]; }
    l_run = l_run * alpha + ps;
#pragma unroll
    for (int r = 0; r < 16; ++r) { o0[r] *= alpha; o1[r] *= alpha; }
#pragma unroll
    for (int s2 = 0; s2 < 2; ++s2) {
        u32x4_t pw; pw[0] = cvtpk(s[8 * s2], s[8 * s2 + 1]); pw[1] = cvtpk(s[8 * s2 + 2], s[8 * s2 + 3]); pw[2] = cvtpk(s[8 * s2 + 4], s[8 * s2 + 5]); pw[3] = cvtpk(s[8 * s2 + 6], s[8 * s2 + 7]);
        const bf16x8 pb = __builtin_bit_cast(bf16x8, pw);
        const s16x4 a0 = *(const s16x4*)(vt0 + 16 * s2), a1 = *(const s16x4*)(vt0 + 16 * s2 + 8);
        const s16x4 c0 = *(const s16x4*)(vt1 + 16 * s2), c1 = *(const s16x4*)(vt1 + 16 * s2 + 8);
        o0 = __builtin_amdgcn_mfma_f32_32x32x16_bf16(__builtin_shufflevector(a0, a1, 0, 1, 2, 3, 4, 5, 6, 7), pb, o0, 0, 0, 0);
        o1 = __builtin_amdgcn_mfma_f32_32x32x16_bf16(__builtin_shufflevector(c0, c1, 0, 1, 2, 3, 4, 5, 6, 7), pb, o1, 0, 0, 0);
    }
}
struct NoMask { __device__ __forceinline__ float operator()(int, float v) const { return v; } };

__device__ __forceinline__ void ph_attn_mfma(const Params& p, int l, bool with_ctx) {
    const int tid_ = opq_tid(), bid_ = opq_bid(); (void)tid_; (void)bid_;
    const int lane = tid_ & 63, hi = lane >> 5, ql = lane & 31;
    const int gw = bid_ * 4 + (tid_ >> 6), nw = gridDim.x * 4;
    constexpr int NQT = S / 32, NCT = L / 32, N_LAT = NB * 6 * NQT, N_CTX = NB * 6 * NCT;
    const int ntask = 2 * N_LAT + (with_ctx ? 2 * N_CTX : 0);
    for (int task = gw; task < ntask; task += nw) {
        bool isC, isCtx; int r;
        if (task < N_LAT) { isC = true; isCtx = false; r = task; }
        else if (task < 2 * N_LAT) { isC = false; isCtx = false; r = task - N_LAT; }
        else { r = task - 2 * N_LAT; isCtx = true; isC = r >= N_CTX; if (isC) r -= N_CTX; }
        const int nqt = isCtx ? NCT : NQT, qt = r % nqt, h = (r / nqt) % 6, b = r / (nqt * 6);
        const int m = isCtx ? TL + b * L + 32 * qt + ql : b * S + 32 * qt + ql;
        const int qcol = isC ? ZQN + h * 64 : ZQB + h * 64, kcol = isC ? ZKN + h * 64 : ZKB + (h / 3) * 64, hv = isC ? 2 + h : h / 3;
        bf16x8 qf[4];
        { const bf16_t* qp = p.Z + (size_t)m * ZP + qcol + 8 * hi;
#pragma unroll
          for (int ks = 0; ks < 4; ++ks) qf[ks] = *(const bf16x8*)(qp + 16 * ks); }
        const bf16_t* kc0 = p.Z + (size_t)(TL + b * L + ql) * ZP + kcol + 8 * hi;
        const bf16_t* kl0 = p.Z + (size_t)(b * S + ql) * ZP + kcol + 8 * hi;
        const bf16_t* vt0 = p.VT + ((size_t)(b * 8 + hv) * 64 + ql) * PU + 4 * hi; const bf16_t* vt1 = vt0 + (size_t)32 * PU;
        f32x16 o0, o1;
#pragma unroll
        for (int rr = 0; rr < 16; ++rr) { o0[rr] = 0.f; o1[rr] = 0.f; }
        float m_run, l_run;
        if (isC) { m_run = -1e30f; l_run = 0.f; } else { m_run = p.b_sink[l * 6 + h]; l_run = hi == 0 ? 1.0f : 0.f; }
#pragma unroll 1
        for (int i = 0; i < NCT; ++i) attn_tile(qf, kc0 + (size_t)(32 * i) * ZP, vt0 + 32 * i, vt1 + 32 * i, NoMask(), m_run, l_run, o0, o1, hi);
        if (!isCtx) {
            if (!isC) {
#pragma unroll 1
                for (int jt = qt - 4; jt <= qt + 4; ++jt) {
                    if (jt < 0 || jt >= NQT) continue;
                    const bf16_t* kr = kl0 + (size_t)(32 * jt) * ZP; const bf16_t* v0 = vt0 + L + 32 * jt; const bf16_t* v1 = vt1 + L + 32 * jt;
                    if (jt == qt - 4 || jt == qt + 4) { const int base = 32 * (jt - qt) - ql;
                        attn_tile(qf, kr, v0, v1, [&](int ko, float v) { const int rel = base + ko; return (rel >= -128 && rel <= 128) ? v : -INFINITY; }, m_run, l_run, o0, o1, hi); }
                    else attn_tile(qf, kr, v0, v1, NoMask(), m_run, l_run, o0, o1, hi);
                }
            } else {
                constexpr int ROWS = S / GRID_W;
                const int gr = qt >> 1, c = 32 * (qt & 1) + ql;
                int r0 = gr - 4; r0 = r0 < 0 ? 0 : (r0 > ROWS - 8 ? ROWS - 8 : r0);
                int c0 = c - 8; c0 = c0 < 0 ? 0 : (c0 > GRID_W - 16 ? GRID_W - 16 : c0);
                const float* rpb = p.c_rpb + ((size_t)l * 6 + h) * 15 * 31;
#pragma unroll 1
                for (int a = 0; a < 8; ++a) {
                    const int kr_ = r0 + a; const float* rp = rpb + (kr_ - gr + 7) * 31 + 15 - c;
#pragma unroll 1
                    for (int ct = 0; ct < 2; ++ct) {
                        const int t0 = kr_ * GRID_W + 32 * ct;
                        attn_tile(qf, kl0 + (size_t)t0 * ZP, vt0 + L + t0, vt1 + L + t0,
                                  [&](int ko, float v) { const int kc = 32 * ct + ko; return (kc >= c0 && kc < c0 + 16) ? v + rp[kc] : -INFINITY; }, m_run, l_run, o0, o1, hi);
                    }
                }
            }
        }
        const float lt = xsum32(l_run), inv = 1.0f / lt;
        bf16_t* op = p.MIX + (size_t)m * DMIX + (isC ? 640 : 256) + h * 64 + 4 * hi;
#pragma unroll
        for (int g = 0; g < 4; ++g) {
            st_bf16x4(op + 8 * g, (f32x4){o0[4 * g] * inv, o0[4 * g + 1] * inv, o0[4 * g + 2] * inv, o0[4 * g + 3] * inv});
            st_bf16x4(op + 32 + 8 * g, (f32x4){o1[4 * g] * inv, o1[4 * g + 1] * inv, o1[4 * g + 2] * inv, o1[4 * g + 3] * inv});
        }
    }
}


template <class MaskF>
__device__ __forceinline__ void attn_tile_lds(const bf16x8 (&qf)[4], const char* ks, const char* vs, const MaskF& mask, float& m_run, float& l_run, f32x16& o0, f32x16& o1, int ql, int hi) {
    f32x16 s;
#pragma unroll
    for (int r = 0; r < 16; ++r) s[r] = 0.f;
#pragma unroll
    for (int k4 = 0; k4 < 4; ++k4) { const bf16x8 kf = *(const bf16x8*)(ks + ql * 128 + (((2 * k4 + hi) ^ (ql & 7)) * 16)); s = __builtin_amdgcn_mfma_f32_32x32x16_bf16(kf, qf[k4], s, 0, 0, 0); }
    float mx = -INFINITY;
#pragma unroll
    for (int r = 0; r < 16; ++r) { s[r] = mask(crow(r, hi), s[r] * ATT_SCALE); mx = fmaxf(mx, s[r]); }
    mx = xmax32(mx);
    const float mn = fmaxf(m_run, mx), alpha = __expf(m_run - mn);
    m_run = mn;
    float ps = 0.f;
#pragma unroll
    for (int r = 0; r < 16; ++r) { s[r] = __expf(s[r] - mn); ps += s[r]; }
    l_run = l_run * alpha + ps;
#pragma unroll
    for (int r = 0; r < 16; ++r) { o0[r] *= alpha; o1[r] *= alpha; }
    const int sw0 = (ql >> 2) & 3;
#pragma unroll
    for (int s2 = 0; s2 < 2; ++s2) {
        u32x4_t pw; pw[0] = cvtpk(s[8 * s2], s[8 * s2 + 1]); pw[1] = cvtpk(s[8 * s2 + 2], s[8 * s2 + 3]); pw[2] = cvtpk(s[8 * s2 + 4], s[8 * s2 + 5]); pw[3] = cvtpk(s[8 * s2 + 6], s[8 * s2 + 7]);
        const bf16x8 pb = __builtin_bit_cast(bf16x8, pw);
        const char* v0 = vs + ql * 64 + 8 * hi; const char* v1 = v0 + 32 * 64;
        const s16x4 a0 = *(const s16x4*)(v0 + (((2 * s2) ^ sw0) * 16)), a1 = *(const s16x4*)(v0 + (((2 * s2 + 1) ^ sw0) * 16));
        const s16x4 c0 = *(const s16x4*)(v1 + (((2 * s2) ^ sw0) * 16)), c1 = *(const s16x4*)(v1 + (((2 * s2 + 1) ^ sw0) * 16));
        o0 = __builtin_amdgcn_mfma_f32_32x32x16_bf16(__builtin_shufflevector(a0, a1, 0, 1, 2, 3, 4, 5, 6, 7), pb, o0, 0, 0, 0);
        o1 = __builtin_amdgcn_mfma_f32_32x32x16_bf16(__builtin_shufflevector(c0, c1, 0, 1, 2, 3, 4, 5, 6, 7), pb, o1, 0, 0, 0);
    }
}

__device__ __forceinline__ void ph_attn_blk(const Params& p, int l, bool with_ctx, int first_blk, char* lds) {
    const int tid_ = opq_tid(), bid_ = opq_bid(); (void)tid_; (void)bid_;
    if (bid_ < first_blk) return;
    const int lane = tid_ & 63, hi = lane >> 5, ql = lane & 31, wid = tid_ >> 6;
    constexpr int NQG = S / 128, NCG = L / 128, ROWS = S / GRID_W, N_LAT = NB * 6 * NQG, N_CTX = NB * 6 * NCG, TPB = (S + L) / 32;
    const int ntask = 2 * N_LAT + (with_ctx ? 2 * N_CTX : 0);
    const int krow = tid_ >> 3, kch = (tid_ & 7) ^ (krow & 7), vrow = tid_ >> 2, vpc = (tid_ & 3) ^ ((vrow >> 2) & 3);
    for (int task = bid_ - first_blk; task < ntask; task += gridDim.x - first_blk) {
        bool isC, isCtx; int r;
        if (task < N_LAT) { isC = true; isCtx = false; r = task; }
        else if (task < 2 * N_LAT) { isC = false; isCtx = false; r = task - N_LAT; }
        else { r = task - 2 * N_LAT; isCtx = true; isC = r >= N_CTX; if (isC) r -= N_CTX; }
        const int ng = isCtx ? NCG : NQG, g = r % ng, h = (r / ng) % 6, b = r / (ng * 6);
        const int qt = 4 * g + wid;
        const int m = isCtx ? TL + b * L + 32 * qt + ql : b * S + 32 * qt + ql;
        const int qcol = isC ? ZQN + h * 64 : ZQB + h * 64, kcol = isC ? ZKN + h * 64 : ZKB + (h / 3) * 64, hv = isC ? 2 + h : h / 3;
        bf16x8 qf[4];
        { const bf16_t* qp = p.Z + (size_t)m * ZP + qcol + 8 * hi;
#pragma unroll
          for (int k4 = 0; k4 < 4; ++k4) qf[k4] = *(const bf16x8*)(qp + 16 * k4); }
        int lo = 0, hi_t = 0, gr0 = 0;
        if (!isCtx) {
            if (!isC) { lo = 4 * g - 4; hi_t = 4 * g + 8; lo = lo < 0 ? 0 : lo; hi_t = hi_t > S / 32 ? S / 32 : hi_t; }
            else { const int ra = 2 * g, rb = 2 * g + 1; int r0a = ra - 4; r0a = r0a < 0 ? 0 : (r0a > ROWS - 8 ? ROWS - 8 : r0a); int r0b = rb - 4; r0b = r0b < 0 ? 0 : (r0b > ROWS - 8 ? ROWS - 8 : r0b);
                   lo = 2 * r0a; hi_t = 2 * (r0b + 8); gr0 = 0; }
        }
        const int ntile = L / 32 + (hi_t - lo);
        const bf16_t* kbase = p.Z + (size_t)krow * ZP + kcol + 8 * kch;
        const bf16_t* vbase = p.VT + ((size_t)(b * 8 + hv) * 64 + vrow) * PU + 8 * vpc;
#define AT_TOK(i_) ((i_) < L / 32 ? 32 * (i_) : L + 32 * (lo + (i_) - L / 32))
#define AT_STAGE(i_) do { const int u0_ = AT_TOK(i_); const int zrow_ = u0_ < L ? TL + b * L + u0_ : b * S + (u0_ - L); char* sl_ = lds + ((i_) % 3) * 8192 + tid_ * 16; \
            __builtin_amdgcn_global_load_lds((const unsigned*)(kbase + (size_t)zrow_ * ZP), (__attribute__((address_space(3))) unsigned*)(sl_), 16, 0, 0); \
            __builtin_amdgcn_global_load_lds((const unsigned*)(vbase + u0_), (__attribute__((address_space(3))) unsigned*)(sl_ + 4096), 16, 0, 0); } while (0)
        f32x16 o0, o1;
#pragma unroll
        for (int rr = 0; rr < 16; ++rr) { o0[rr] = 0.f; o1[rr] = 0.f; }
        float m_run, l_run;
        if (isC) { m_run = -1e30f; l_run = 0.f; } else { m_run = p.b_sink[l * 6 + h]; l_run = hi == 0 ? 1.0f : 0.f; }
        const int gr = qt >> 1, c = 32 * (qt & 1) + ql;
        int r0 = gr - 4; r0 = r0 < 0 ? 0 : (r0 > ROWS - 8 ? ROWS - 8 : r0);
        int c0 = c - 8; c0 = c0 < 0 ? 0 : (c0 > GRID_W - 16 ? GRID_W - 16 : c0);
        float* rpb = (float*)(lds + 24576);
        if (isC && !isCtx) for (int i = tid_; i < 15 * 31; i += 256) rpb[i] = p.c_rpb[((size_t)l * 6 + h) * 15 * 31 + i];
        AT_STAGE(0);
        if (ntile > 1) AT_STAGE(1);
#pragma unroll 1
        for (int i = 0; i < ntile; ++i) {
            if (i + 1 < ntile) asm volatile("s_waitcnt vmcnt(2)" ::: "memory"); else asm volatile("s_waitcnt vmcnt(0)" ::: "memory");
            asm volatile("s_waitcnt lgkmcnt(0)" ::: "memory");
            __builtin_amdgcn_s_barrier();
            if (i + 2 < ntile) AT_STAGE(i + 2);
            const char* ks = lds + (i % 3) * 8192; const char* vs = ks + 4096;
            if (i < L / 32) attn_tile_lds(qf, ks, vs, NoMask(), m_run, l_run, o0, o1, ql, hi);
            else {
                const int jt = lo + i - L / 32;
                if (!isC) {
                    const int dq = jt - qt;
                    if (dq >= -3 && dq <= 3) attn_tile_lds(qf, ks, vs, NoMask(), m_run, l_run, o0, o1, ql, hi);
                    else if (dq == -4 || dq == 4) { const int base = 32 * dq - ql;
                        attn_tile_lds(qf, ks, vs, [&](int ko, float v) { const int rel = base + ko; return (rel >= -128 && rel <= 128) ? v : -INFINITY; }, m_run, l_run, o0, o1, ql, hi); }
                } else {
                    const int kr_ = jt >> 1, ct = jt & 1;
                    if (kr_ >= r0 && kr_ < r0 + 8) { const float* rp = rpb + (kr_ - gr + 7) * 31 + 15 - c;
                        attn_tile_lds(qf, ks, vs, [&](int ko, float v) { const int kc = 32 * ct + ko; return (kc >= c0 && kc < c0 + 16) ? v + rp[kc] : -INFINITY; }, m_run, l_run, o0, o1, ql, hi); }
                }
            }
        }
        asm volatile("s_waitcnt lgkmcnt(0)" ::: "memory");
        __builtin_amdgcn_s_barrier();
#undef AT_STAGE
#undef AT_TOK
        (void)gr0;
        const float lt = xsum32(l_run), inv = 1.0f / lt;
        bf16_t* op = p.MIX + (size_t)m * DMIX + (isC ? 640 : 256) + h * 64 + 4 * hi;
#pragma unroll
        for (int gq = 0; gq < 4; ++gq) {
            st_bf16x4(op + 8 * gq, (f32x4){o0[4 * gq] * inv, o0[4 * gq + 1] * inv, o0[4 * gq + 2] * inv, o0[4 * gq + 3] * inv});
            st_bf16x4(op + 32 + 8 * gq, (f32x4){o1[4 * gq] * inv, o1[4 * gq + 1] * inv, o1[4 * gq + 2] * inv, o1[4 * gq + 3] * inv});
        }
    }
}

#define RNB " row_newbcast:%c[n] row_mask:0xf bank_mask:0xf\n\t"
template <int N, bool FIRST>
__device__ __forceinline__ void dpp_dot4(float& a0, float& a1, float& a2, float& a3, const f32x4& v, float s0, float s1, float s2, float s3) {
    if (FIRST) asm volatile("s_nop 1");
    asm("v_fmac_f32_dpp %0, %4, %8" RNB "v_fmac_f32_dpp %1, %5, %9" RNB "v_fmac_f32_dpp %2, %6, %10" RNB "v_fmac_f32_dpp %3, %7, %11" RNB
        : "+v"(a0), "+v"(a1), "+v"(a2), "+v"(a3) : "v"(v[0]), "v"(v[1]), "v"(v[2]), "v"(v[3]), "v"(s0), "v"(s1), "v"(s2), "v"(s3), [n] "i"(N));
}
template <int N, bool FIRST>
__device__ __forceinline__ void dpp_upd4s(float& s0, float& s1, float& s2, float& s3, float& y0, float& y1, float& y2, float& y3,
                                          const f32x4& w, const f32x4& b, const f32x4& kd, const f32x4& r, float nsk, float vv) {
    if (FIRST) asm volatile("s_nop 1");
    asm("v_mul_f32_dpp %0, %8, %0" RNB "v_mul_f32_dpp %1, %9, %1" RNB "v_mul_f32_dpp %2, %10, %2" RNB "v_mul_f32_dpp %3, %11, %3" RNB
        "v_fmac_f32_dpp %0, %12, %24" RNB "v_fmac_f32_dpp %1, %13, %24" RNB "v_fmac_f32_dpp %2, %14, %24" RNB "v_fmac_f32_dpp %3, %15, %24" RNB
        "v_fmac_f32_dpp %0, %16, %25" RNB "v_fmac_f32_dpp %1, %17, %25" RNB "v_fmac_f32_dpp %2, %18, %25" RNB "v_fmac_f32_dpp %3, %19, %25" RNB
        "v_fmac_f32_dpp %4, %20, %0" RNB "v_fmac_f32_dpp %5, %21, %1" RNB "v_fmac_f32_dpp %6, %22, %2" RNB "v_fmac_f32_dpp %7, %23, %3" RNB
        : "+v"(s0), "+v"(s1), "+v"(s2), "+v"(s3), "+v"(y0), "+v"(y1), "+v"(y2), "+v"(y3)
        : "v"(w[0]), "v"(w[1]), "v"(w[2]), "v"(w[3]), "v"(b[0]), "v"(b[1]), "v"(b[2]), "v"(b[3]), "v"(kd[0]), "v"(kd[1]), "v"(kd[2]), "v"(kd[3]),
          "v"(r[0]), "v"(r[1]), "v"(r[2]), "v"(r[3]), "v"(nsk), "v"(vv), [n] "i"(N));
}
template <int N, bool FIRST>
__device__ __forceinline__ void dpp_upd4p(float& s0, float& s1, float& s2, float& s3, float& y0, float& y1, float& y2, float& y3,
                                          const f32x4& w, const f32x4& b, const f32x4& r, float nsk) {
    if (FIRST) asm volatile("s_nop 1");
    asm("v_mul_f32_dpp %0, %8, %0" RNB "v_mul_f32_dpp %1, %9, %1" RNB "v_mul_f32_dpp %2, %10, %2" RNB "v_mul_f32_dpp %3, %11, %3" RNB
        "v_fmac_f32_dpp %0, %12, %20" RNB "v_fmac_f32_dpp %1, %13, %20" RNB "v_fmac_f32_dpp %2, %14, %20" RNB "v_fmac_f32_dpp %3, %15, %20" RNB
        "v_fmac_f32_dpp %4, %16, %0" RNB "v_fmac_f32_dpp %5, %17, %1" RNB "v_fmac_f32_dpp %6, %18, %2" RNB "v_fmac_f32_dpp %7, %19, %3" RNB
        : "+v"(s0), "+v"(s1), "+v"(s2), "+v"(s3), "+v"(y0), "+v"(y1), "+v"(y2), "+v"(y3)
        : "v"(w[0]), "v"(w[1]), "v"(w[2]), "v"(w[3]), "v"(b[0]), "v"(b[1]), "v"(b[2]), "v"(b[3]), "v"(r[0]), "v"(r[1]), "v"(r[2]), "v"(r[3]), "v"(nsk), [n] "i"(N));
}
template <int N, bool FIRST>
__device__ __forceinline__ void dpp_mul4(float& s0, float& s1, float& s2, float& s3, const f32x4& v) {
    if (FIRST) asm volatile("s_nop 1");
    asm("v_mul_f32_dpp %0, %4, %0" RNB "v_mul_f32_dpp %1, %5, %1" RNB "v_mul_f32_dpp %2, %6, %2" RNB "v_mul_f32_dpp %3, %7, %3" RNB
        : "+v"(s0), "+v"(s1), "+v"(s2), "+v"(s3) : "v"(v[0]), "v"(v[1]), "v"(v[2]), "v"(v[3]), [n] "i"(N));
}
template <int N>
__device__ __forceinline__ void dpp_fmacx4(float& s0, float& s1, float& s2, float& s3, const f32x4& v, float x) {
    asm("v_fmac_f32_dpp %0, %4, %8" RNB "v_fmac_f32_dpp %1, %5, %8" RNB "v_fmac_f32_dpp %2, %6, %8" RNB "v_fmac_f32_dpp %3, %7, %8" RNB
        : "+v"(s0), "+v"(s1), "+v"(s2), "+v"(s3) : "v"(v[0]), "v"(v[1]), "v"(v[2]), "v"(v[3]), "v"(x), [n] "i"(N));
}
template <int N> struct ScanRep {
    static __device__ __forceinline__ void dot8(float (&a)[8], const f32x4& v, const float (&st)[64]) {
        constexpr int h = (N & 1) * 4;
        dpp_dot4<N, N == 0>(a[h], a[h + 1], a[h + 2], a[h + 3], v, st[4 * N], st[4 * N + 1], st[4 * N + 2], st[4 * N + 3]);
        if constexpr (N < 15) ScanRep<N + 1>::dot8(a, v, st);
    }
    static __device__ __forceinline__ void dot(float& a0, float& a1, float& a2, float& a3, const f32x4& v, const float (&st)[64]) {
        dpp_dot4<N, N == 0>(a0, a1, a2, a3, v, st[4 * N], st[4 * N + 1], st[4 * N + 2], st[4 * N + 3]);
        if constexpr (N < 15) ScanRep<N + 1>::dot(a0, a1, a2, a3, v, st);
    }
    static __device__ __forceinline__ void mul(float (&st)[64], const f32x4& w) {
        dpp_mul4<N, N == 0>(st[4 * N], st[4 * N + 1], st[4 * N + 2], st[4 * N + 3], w);
        if constexpr (N < 15) ScanRep<N + 1>::mul(st, w);
    }
    static __device__ __forceinline__ void fmacx(float (&st)[64], const f32x4& v, float x) {
        dpp_fmacx4<N>(st[4 * N], st[4 * N + 1], st[4 * N + 2], st[4 * N + 3], v, x);
        if constexpr (N < 15) ScanRep<N + 1>::fmacx(st, v, x);
    }
};
__device__ __forceinline__ int scan_row(int b, int d, int pos) { return pos < L ? TL + b * L + (d ? L - 1 - pos : pos) : b * S + (d ? S - 1 - (pos - L) : pos - L); }

template <bool ISP>
__device__ __forceinline__ void scan_task(const Params& p, int c, int s, int lane) {
    const int h = c & 3, b = (c >> 2) % NB, d = (c >> 2) / NB, pos0 = SEGLEN * s;
    const int q = 4 * (lane & 15);
    const float* bkk = p.sKK + h * 64 + q; const float* br = p.sR + h * 64 + q; const float* bw = p.sW + (size_t)d * T * DA + h * 64 + q; const float* bb_ = p.sB + (size_t)d * T * DA + h * 64 + q;
    const float* bkd = p.sKD + (size_t)d * T * DA + h * 64 + q; const float* bv = p.sV + h * 64 + lane;
    float* by = (ISP ? p.PV : p.Y) + (size_t)d * T * DA + h * 64 + lane;
    float st[64];
#pragma unroll
    for (int k = 0; k < 64; ++k) st[k] = (ISP && k == lane) ? 1.0f : 0.f;
    size_t mo = (size_t)scan_row(b, d, pos0) * DA;
    f32x4 kk = *(const f32x4*)(bkk + mo), w = *(const f32x4*)(bw + mo), bb = *(const f32x4*)(bb_ + mo), r = *(const f32x4*)(br + mo), kd = w; float vv = 0.f;
    if (!ISP) { kd = *(const f32x4*)(bkd + mo); vv = bv[mo]; }
#pragma unroll 1
    for (int i = 0; i < SEGLEN; ++i) {
        const size_t mn = (size_t)scan_row(b, d, pos0 + (i + 1 < SEGLEN ? i + 1 : i)) * DA;
        const f32x4 nkk = *(const f32x4*)(bkk + mn), nw = *(const f32x4*)(bw + mn), nb = *(const f32x4*)(bb_ + mn), nr = *(const f32x4*)(br + mn);
        f32x4 nkd = nw; float nv = 0.f;
        if (!ISP) { nkd = *(const f32x4*)(bkd + mn); nv = bv[mn]; }
        float a[8] = {0.f, 0.f, 0.f, 0.f, 0.f, 0.f, 0.f, 0.f};
        ScanRep<0>::dot8(a, kk, st);
        const float nsk = -(((a[0] + a[1]) + (a[2] + a[3])) + ((a[4] + a[5]) + (a[6] + a[7])));
        ScanRep<0>::mul(st, w);
        ScanRep<0>::fmacx(st, bb, nsk);
        if (!ISP) ScanRep<0>::fmacx(st, kd, vv);
        float y[8] = {0.f, 0.f, 0.f, 0.f, 0.f, 0.f, 0.f, 0.f};
        ScanRep<0>::dot8(y, r, st);
        by[mo] = ((y[0] + y[1]) + (y[2] + y[3])) + ((y[4] + y[5]) + (y[6] + y[7]));
        kk = nkk; w = nw; bb = nb; r = nr; kd = nkd; vv = nv; mo = mn;
    }
    if (s < NSG - 1) {
        float* dst = (ISP ? p.PS : p.QS) + (((size_t)c * NSG + s) * 64 + lane) * 64;
#pragma unroll
        for (int k4 = 0; k4 < 16; ++k4) *(f32x4*)(dst + 4 * k4) = (f32x4){st[4 * k4], st[4 * k4 + 1], st[4 * k4 + 2], st[4 * k4 + 3]};
    }
}
__device__ __forceinline__ void ph_scan_fast(const Params& p) {
    const int tid_ = opq_tid(), bid_ = opq_bid(); (void)tid_; (void)bid_;
    const int lane = tid_ & 63, gw = bid_ * 4 + (tid_ >> 6), nw = gridDim.x * 4;
    constexpr int NS_T = 64 * NSG, NP_T = 64 * (NSG - 1);
    const int G = gridDim.x, wv = tid_ >> 6; (void)gw; (void)nw;
    for (int tsk = wv * G + bid_; tsk < NS_T + NP_T; tsk += 4 * G) {
        const int t2 = __builtin_amdgcn_readfirstlane(tsk);
        if (t2 < NS_T) scan_task<false>(p, t2 & 63, t2 >> 6, lane);
        else scan_task<true>(p, (t2 - NS_T) & 63, 1 + ((t2 - NS_T) >> 6), lane);
    }
}
__device__ __forceinline__ void ph_combine(const Params& p, char* lds) {
    const int tid_ = opq_tid(), bid_ = opq_bid(); (void)tid_; (void)bid_; (void)lds;
    if (bid_ >= 64) return;
    const int lane = tid_ & 63, c = bid_, cb = tid_ >> 6, q = lane >> 4, i16 = lane & 15, v = 16 * cb + i16;
    const float* QSc = p.QS + (size_t)c * NSG * 4096; const float* PSc = p.PS + (size_t)c * NSG * 4096; float* SSg = p.SS + (size_t)c * NSG * 4096;
    f32x4 acc[4];
#pragma unroll
    for (int ro = 0; ro < 4; ++ro) acc[ro] = *(const f32x4*)(QSc + v * 64 + 16 * ro + 4 * q);
#pragma unroll 1
    for (int s = 1; s < NSG; ++s) {
#pragma unroll
        for (int ro = 0; ro < 4; ++ro)
#pragma unroll
            for (int j = 0; j < 4; ++j) SSg[(size_t)s * 4096 + (16 * ro + 4 * q + j) * 64 + v] = acc[ro][j];
        if (s == NSG - 1) break;
        const float* P = PSc + (size_t)s * 4096 + (4 * q) * 64 + i16;
        float a[4][4][4];
#pragma unroll
        for (int rb = 0; rb < 4; ++rb)
#pragma unroll
            for (int kk = 0; kk < 4; ++kk)
#pragma unroll
                for (int ro = 0; ro < 4; ++ro) a[rb][kk][ro] = P[(16 * rb + kk) * 64 + 16 * ro];
#pragma unroll
        for (int rb = 0; rb < 4; ++rb) asm volatile("" : "+v"(a[rb][0][0]), "+v"(a[rb][0][1]), "+v"(a[rb][0][2]), "+v"(a[rb][0][3]), "+v"(a[rb][1][0]), "+v"(a[rb][1][1]), "+v"(a[rb][1][2]), "+v"(a[rb][1][3]),
                                                         "+v"(a[rb][2][0]), "+v"(a[rb][2][1]), "+v"(a[rb][2][2]), "+v"(a[rb][2][3]), "+v"(a[rb][3][0]), "+v"(a[rb][3][1]), "+v"(a[rb][3][2]), "+v"(a[rb][3][3]));
        f32x4 nacc[4];
#pragma unroll
        for (int ro = 0; ro < 4; ++ro) nacc[ro] = *(const f32x4*)(QSc + (size_t)s * 4096 + v * 64 + 16 * ro + 4 * q);
#pragma unroll
        for (int rb = 0; rb < 4; ++rb)
#pragma unroll
            for (int kk = 0; kk < 4; ++kk)
#pragma unroll
                for (int ro = 0; ro < 4; ++ro) nacc[ro] = __builtin_amdgcn_mfma_f32_16x16x4f32(a[rb][kk][ro], acc[rb][kk], nacc[ro], 0, 0, 0);
#pragma unroll
        for (int ro = 0; ro < 4; ++ro) acc[ro] = nacc[ro];
    }
}
__device__ __forceinline__ void ph_rwkv_out_fast(const Params& p, int l, bool with_ctx) {
    const int tid_ = opq_tid(), bid_ = opq_bid(); (void)tid_; (void)bid_;
    const int lane = tid_ & 63, gw = bid_ * 4 + (tid_ >> 6), nw = gridDim.x * 4;
    constexpr int TOK = 16, NLT = NB * (S / TOK) * 4, NCTK = NB * (L / TOK) * 4;
    const int ntask = NLT + (with_ctx ? NCTK : 0);
    for (int tsk = gw; tsk < ntask; tsk += nw) {
        const bool isCtx = tsk >= NLT; const int r = isCtx ? tsk - NLT : tsk;
        const int h = r & 3, npt = isCtx ? L / TOK : S / TOK, tt = (r >> 2) % npt, b = (r >> 2) / npt;
        const int seg0 = (isCtx ? TOK * tt : L + TOK * tt) / SEGLEN, seg1 = (isCtx ? L - 1 - TOK * tt : L + S - 1 - TOK * tt) / SEGLEN;
        const int mbase = isCtx ? TL + b * L + TOK * tt : b * S + TOK * tt;
        float ss0[64], ss1[64];
        { const float* s0p = p.SS + (((size_t)(0 * NB + b) * 4 + h) * NSG + seg0) * 4096 + lane; const float* s1p = p.SS + (((size_t)(1 * NB + b) * 4 + h) * NSG + seg1) * 4096 + lane;
#pragma unroll
          for (int k = 0; k < 64; ++k) { ss0[k] = seg0 > 0 ? s0p[k * 64] : 0.f; ss1[k] = seg1 > 0 ? s1p[k * 64] : 0.f; } }
        const float rk = p.a_r_k[l * DA + h * 64 + lane], gln = p.a_lnx_g[l * DA + h * 64 + lane], bln = p.a_lnx_b[l * DA + h * 64 + lane];
        f32x4 pv0 = {0.f, 0.f, 0.f, 0.f}, pv1 = pv0; float y0l, y1l, rr, kds, vv, gg;
#define ROUT_LOAD(i_) do { const size_t o_ = (size_t)(mbase + (i_)) * DA + h * 64, o1_ = o_ + (size_t)T * DA; \
            if (seg0 > 0) pv0 = *(const f32x4*)(p.PV + o_ + 4 * (lane & 15)); if (seg1 > 0) pv1 = *(const f32x4*)(p.PV + o1_ + 4 * (lane & 15)); \
            y0l = p.Y[o_ + lane]; y1l = p.Y[o1_ + lane]; rr = p.sR[o_ + lane]; kds = p.sKD[o_ + lane] + p.sKD[o1_ + lane]; vv = p.sV[o_ + lane]; gg = bf2f(p.MIX[(size_t)(mbase + (i_)) * DMIX + h * 64 + lane]); } while (0)
        ROUT_LOAD(0);
#pragma unroll 1
        for (int i = 0; i < TOK; ++i) {
            const f32x4 cpv0 = pv0, cpv1 = pv1; float a0 = y0l, a1 = y1l, a2 = 0.f, a3 = 0.f; const float crr = rr, ckds = kds, cvv = vv, cgg = gg;
            ROUT_LOAD(i + 1 < TOK ? i + 1 : i);
            ScanRep<0>::dot(a0, a1, a2, a3, cpv0, ss0);
            ScanRep<0>::dot(a0, a1, a2, a3, cpv1, ss1);
            const float y = (a0 + a1) + (a2 + a3);
            const float mu = wave_sum(y) * (1.0f / 64.f), dy = y - mu;
            const float rstd = 1.0f / sqrtf(wave_sum(dy * dy) * (1.0f / 64.f) + GN_EPS);
            const float bon = wave_sum(crr * ckds * rk);
            p.MIX[(size_t)(mbase + i) * DMIX + h * 64 + lane] = f2bf((dy * rstd * gln + bln + bon * cvv) * cgg);
        }
#undef ROUT_LOAD
    }
}


#define LAS __attribute__((address_space(3)))
#define XB_TMO      128
#define XB_XCNT(j)  (256  + 64 * (j))
#define XB_XSUB(j)  (1280 + 64 * (j))
#define XB_XGEN(j)  (2304 + 64 * (j))
#define XB_TOP      3328
#define XB_TOPGEN   3392
#define XCD_BAR_WORDS 3456
#define XB_SPIN_CAP (1u << 20)
static_assert(XCD_BAR_WORDS * 4 <= 16384, "barrier words fit the control region");
__device__ __forceinline__ unsigned xb_ld(unsigned* p)              { return __hip_atomic_load(p, __ATOMIC_RELAXED, __HIP_MEMORY_SCOPE_AGENT); }
__device__ __forceinline__ unsigned xb_add(unsigned* p, unsigned v) { return __hip_atomic_fetch_add(p, v, __ATOMIC_RELAXED, __HIP_MEMORY_SCOPE_AGENT); }
__device__ __forceinline__ unsigned xb_xcc_id() { return (unsigned)__builtin_amdgcn_s_getreg((3 << 11) | 20) & 0xFu; }
#define XB_SPIN(cond, bar) do { unsigned _sp = 0; while (cond) { __builtin_amdgcn_s_sleep(1); \
    if ((++_sp & 255u) == 0u) { if (xb_ld(&(bar)[XB_TMO])) break; if (_sp > XB_SPIN_CAP) { atomicAdd(&(bar)[XB_TMO], 1u); break; } } } } while (0)
struct XcdBarrier { unsigned* bar; unsigned x; volatile LAS unsigned* st; };
__device__ __forceinline__ XcdBarrier xcd_barrier_post(unsigned* bar, volatile LAS unsigned* st) {
    XcdBarrier b; b.bar = bar; b.x = xb_xcc_id(); b.st = st;
    if (threadIdx.x == 0) (void)xb_add(&bar[XB_XCNT(b.x)], 1u);
    return b;
}
__device__ __forceinline__ void xcd_barrier_complete(unsigned* bar, unsigned x, unsigned& nloc, unsigned& nx) {
    const unsigned G = gridDim.x * gridDim.y * gridDim.z;
    unsigned sum, cnt, mine, sp = 0u;
    for (;;) {
        sum = 0u; cnt = 0u; mine = 0u;
#pragma unroll
        for (unsigned j = 0; j < 16; ++j) { const unsigned c = xb_ld(&bar[XB_XCNT(j)]); sum += c; cnt += (c > 0u) ? 1u : 0u; mine = (j == x) ? c : mine; }
        if (sum == G) break;
        __builtin_amdgcn_s_sleep(1);
        if ((++sp & 255u) == 0u) { if (xb_ld(&bar[XB_TMO])) break; if (sp > XB_SPIN_CAP) { atomicAdd(&bar[XB_TMO], 1u); break; } }
    }
    nloc = mine > 0u ? mine : 1u; nx = cnt > 0u ? cnt : 1u;
}
__device__ __forceinline__ void xcd_barrier(const XcdBarrier& b) {
    asm volatile("s_waitcnt vmcnt(0)" ::: "memory");
    __syncthreads();
    if (threadIdx.x == 0) {
        unsigned* bar = b.bar;
        __builtin_amdgcn_s_waitcnt(0);
        unsigned nloc = b.st[0], nx = b.st[1];
        if (nloc == 0u) { xcd_barrier_complete(bar, b.x, nloc, nx); b.st[0] = nloc; b.st[1] = nx; }
        const unsigned old = xb_add(&bar[XB_XSUB(b.x)], 1u);
        const unsigned gen = old / nloc;
        if (old + 1u == (gen + 1u) * nloc) {
            __builtin_amdgcn_fence(__ATOMIC_RELEASE, "agent");
            asm volatile("s_waitcnt vmcnt(0)" ::: "memory");
            const unsigned og = xb_add(&bar[XB_TOP], 1u);
            const unsigned tg = og / nx;
            if (og + 1u == (tg + 1u) * nx) xb_add(&bar[XB_TOPGEN], 1u);
            else XB_SPIN(xb_ld(&bar[XB_TOPGEN]) == tg, bar);
            __builtin_amdgcn_fence(__ATOMIC_ACQUIRE, "agent");
            xb_add(&bar[XB_XGEN(b.x)], 1u);
            asm volatile("s_waitcnt vmcnt(0)" ::: "memory");
        } else {
            XB_SPIN(xb_ld(&bar[XB_XGEN(b.x)]) == gen, bar);
            __builtin_amdgcn_fence(__ATOMIC_ACQUIRE, "agent");
            asm volatile("s_waitcnt vmcnt(0)" ::: "memory");
        }
    }
    __syncthreads();
}

#define GT ((long)blockIdx.x * blockDim.x + threadIdx.x)
#define GS ((long)gridDim.x * blockDim.x)
__global__ void __launch_bounds__(256, 2) mega_fwd(Params p) {
    __shared__ __attribute__((aligned(16))) char lds[65536 + 64];
    cg::grid_group grid = cg::this_grid();
    const long gt = GT, gs = GS;
    volatile LAS unsigned* bst = (volatile LAS unsigned*)(LAS char*)(lds + 65536);
    if (threadIdx.x < 2) bst[threadIdx.x] = 0u;
    __syncthreads();
    const XcdBarrier xb = xcd_barrier_post(p.bar, bst);
#ifndef PROBE_PHASE
#define PROBE_PHASE -1
#endif
#define PROBE_AMP 8
    unsigned long long t_prev = 0; int nts = 0;
#define STAMP() do { if (PROBE_PHASE >= 0 && blockIdx.x == 0 && threadIdx.x == 0) { const unsigned long long t_now = __builtin_amdgcn_s_memrealtime(); \
        if (nts == PROBE_PHASE + 1) { const unsigned long long t_end = t_now + PROBE_AMP * (t_now - t_prev); while (__builtin_amdgcn_s_memrealtime() < t_end) __builtin_amdgcn_s_sleep(8); } \
        t_prev = __builtin_amdgcn_s_memrealtime(); } ++nts; } while (0)
#define GSYNC() do { xcd_barrier(xb); STAMP(); } while (0)
    STAMP();
    ph_mod_fast(p, lds); ph_prep_w_fast(p, 0, 0, lds); ph_prep_misc(p, 0, gt, gs, false);
    if (p.out == nullptr) grid.sync();
    GSYNC();
    for (int l = 0; l < 2; ++l) {
        const int nrows = (l == 0) ? T : TL;
        if (l == 0) { ph_lnmod_fast(p, l); GSYNC(); }
        g_gemm_in(p, lds);
        GSYNC();
        ph_streams_s1(p, l);
        GSYNC();
        g_streams_s2(p, l, lds);
        GSYNC();
        ph_scan_fast(p);
        GSYNC();
        ph_combine(p, lds); ph_attn_blk(p, l, l == 0, 64, lds);
        GSYNC();
        ph_rwkv_out_fast(p, l, l == 0);
        GSYNC();
        if (blockIdx.x >= gridDim.x / 2) { ph_prep_w_fast(p, l, 1, lds); __syncthreads(); g_gemm_out(p, nrows, lds); } else { g_gemm_out(p, nrows, lds); ph_prep_w_fast(p, l, 1, lds); }
        GSYNC();
        g_router(p, l, nrows, lds);
        GSYNC();
        ph_dispatch_fast(p, l, nrows, lds);
        GSYNC();
        g_moe1(p, l, lds);
        GSYNC();
        g_moe2(p, l, lds);
        GSYNC();
        ph_final_fast(p, l, nrows, l == 0);
        if (l == 0) { ph_prep_w_fast(p, 1, 0, lds); ph_prep_misc(p, 1, gt, gs, false); }
        GSYNC();
    }}

extern "C" void kernel_launch(void* const* d_in, const int* in_sizes, int n_in, void* d_out, int out_size, void* d_ws, size_t ws_size, hipStream_t stream) {
    if (n_in != 32 || out_size != TL * D || ws_size < WS_NEED) { fprintf(stderr, "kernel_launch: unexpected shapes / workspace (n_in %d out %d ws %zu need %zu)\n", n_in, out_size, ws_size, (size_t)WS_NEED); return; }
    static int grid_blocks = 0;
    if (!grid_blocks) {
        int dev = 0, cus = 0, per_cu = 0;
        (void)hipGetDevice(&dev);
        (void)hipDeviceGetAttribute(&cus, hipDeviceAttributeMultiprocessorCount, dev);
        (void)hipOccupancyMaxActiveBlocksPerMultiprocessor(&per_cu, mega_fwd, 256, 0);
        if (per_cu < 1) per_cu = 1;
        if (per_cu > 2) per_cu = 2;
        grid_blocks = cus * per_cu;
        fprintf(stderr, "kernel_launch: %d CUs x %d blocks\n", cus, per_cu);
    }
    Params p = make_params(d_in, d_out, d_ws);
    (void)hipMemsetAsync(d_ws, 0, CTL_BYTES, stream);
    void* args[] = {&p};
    hipError_t e = hipLaunchCooperativeKernel((void*)mega_fwd, dim3(grid_blocks), dim3(256), args, 0, stream);
    if (e != hipSuccess) fprintf(stderr, "cooperative launch failed: %s (grid %d)\n", hipGetErrorString(e), grid_blocks);
}
#endif

#ifdef HOST_EMU
static void host_forward(void* const* d_in, void* d_out, void* d_ws) {
    const Params p = make_params(d_in, d_out, d_ws);
    for (int l = 0; l < 2; ++l) {
        const int nrows = (l == 0) ? T : TL;
        ph_prep_w(p, l, 0, 1); ph_prep_misc(p, l, 0, 1); ph_lnmod(p, l, 0, 1); host_gemm_in(p); ph_streams(p, l, 0, 1); ph_rope(p, 0, 1); ph_scan(p, 0, 1);
        ph_attn(p, l, nrows, 0, 1); ph_rwkv_out(p, l, nrows, 0, 1); host_gemm_out(p, nrows); ph_post_mixer(p, l, nrows, 0, 1);
        ph_dispatch(p, l, nrows, 0, 1); host_moe1(p, l); host_moe2(p, l); ph_final(p, l, nrows, 0, 1);
    }
}
#endif
```

```cpp
#ifdef HOST_EMU
#include <cmath>
#include <cstdio>
#include <cstring>
#include <cstdint>
#include <cstdlib>
#define __device__
#define __global__
#define __host__
#define __forceinline__ inline
#else
#include <hip/hip_runtime.h>
#include <hip/hip_cooperative_groups.h>
#include <cstdio>
#include <cstdint>
namespace cg = cooperative_groups;
#endif

#ifndef CFG_D
#define CFG_D 1024
#define CFG_B 8
#define CFG_S 2048
#define CFG_L 256
#define CFG_DE 512
#endif
constexpr int D = CFG_D, NB = CFG_B, S = CFG_S, L = CFG_L, DE = CFG_DE;
constexpr int TL = NB * S, TC = NB * L, T = TL + TC;
constexpr int GRID_W = 64, HD = 64;
constexpr int DA = 256, A_IN = 1184, N_IN = 2976, NINP = 3072, DMIX = 1024;
constexpr int NEXP = 32, NSLOT = 2 * T + NEXP * 128;
constexpr int ZQB = 0, ZKB = 384, ZVB = 512, ZQN = 640, ZKN = 1024, ZVN = 1408, ZA = 1792, ZP = 2976;
constexpr float LN_EPS = 1e-6f, GN_EPS = 64e-5f, ATT_SCALE = 0.125f;
constexpr float ALPHA = 1.41421356237309515f;

typedef unsigned short bf16_t;

__device__ __forceinline__ float bf2f(bf16_t v) {
    unsigned u = ((unsigned)v) << 16; float f;
#ifdef HOST_EMU
    memcpy(&f, &u, 4);
#else
    f = __uint_as_float(u);
#endif
    return f;
}
__device__ __forceinline__ bf16_t f2bf(float f) {
    unsigned u;
#ifdef HOST_EMU
    memcpy(&u, &f, 4);
#else
    u = __float_as_uint(f);
#endif
    return (bf16_t)((u + 0x7fffu + ((u >> 16) & 1u)) >> 16);
}
__device__ __forceinline__ float sigmoidf_(float x) { return 1.0f / (1.0f + expf(-x)); }
__device__ __forceinline__ float siluf_(float x) { return x / (1.0f + expf(-x)); }
__device__ __forceinline__ int atomic_inc_int(int* p) {
#ifdef HOST_EMU
    int o = *p; *p = o + 1; return o;
#else
    return atomicAdd(p, 1);
#endif
}

struct Params {
    const float *x, *c, *ctx, *c_ctx, *w_mod, *b_mod, *w_in, *w_out, *a_shift, *a_w0, *a_w_up, *a_a0, *a_a_up, *a_g_up,
        *a_k_k, *a_k_a, *a_r_k, *a_lnx_g, *a_lnx_b, *b_sink, *c_rpb, *ln1_g, *ln1_b, *ln2_g, *ln2_b, *w_rg, *b_rg, *w_re,
        *b_re, *w_gate, *w_up, *w_down;
    float* out;
    int* cnt;
    unsigned* bar;
    float* mod;
    float* rope;
    bf16_t *win_t, *wout_t, *wgu_t, *wd_t;
    bf16_t *wrt;
    int* hist;
    bf16_t* HLO;
    bf16_t *wupT, *aupT, *gupT;
    bf16_t* LA;
    float *kT, *kN;
    bf16_t* H;
    bf16_t* Z;
    bf16_t* VT;
    float *sR, *sV, *sKK, *sG, *sW, *sKD, *sB;
    float* Y;
    bf16_t* MIX;
    float *PV, *QS, *PS, *SS;
    float* XC;
    bf16_t* O;
    bf16_t* YSb;
    int *rE, *rPos, *rSlot; float* rW;
    int* slotTok;
    bf16_t* ACT;
    float* YS;
};

constexpr size_t al256(size_t v) { return (v + 255) & ~(size_t)255; }
constexpr size_t OFF_CNT = 0;
constexpr size_t OFF_BAR = 4096, CTL_BYTES = 4096 + 16384;
constexpr size_t OFF_MOD = CTL_BYTES;
constexpr size_t OFF_ROPE = al256(OFF_MOD + (size_t)2 * (NB + 1) * 6 * D * 4);
constexpr size_t OFF_LORA = al256(OFF_ROPE + 64 * 16 * 2 * 4);
constexpr size_t OFF_WRT = al256(OFF_LORA + (size_t)(2 * 256 * 64 * 2 + 256 * 160) * 2);
constexpr size_t OFF_LG = al256(OFF_WRT + (size_t)2 * 128 * D * 2);
constexpr size_t OFF_WIN = al256(OFF_LG + (size_t)(T / 32) * 32 * 4);
constexpr size_t OFF_WOUT = al256(OFF_WIN + (size_t)NINP * D * 2);
constexpr size_t OFF_WGU = al256(OFF_WOUT + (size_t)D * DMIX * 2);
constexpr size_t OFF_WD = al256(OFF_WGU + (size_t)NEXP * 2 * DE * D * 2);
constexpr size_t OFF_H = al256(OFF_WD + (size_t)NEXP * D * DE * 2);
constexpr size_t OFF_Z = al256(OFF_H + (size_t)(T + 1) * D * 2);
constexpr int PU = L + S;
constexpr int SEGLEN = 144, NSG = (L + S) / SEGLEN;
#ifndef HOST_EMU
static_assert((L + S) % SEGLEN == 0 && SEGLEN % 16 == 0 && L % 16 == 0 && S % 16 == 0, "16-token output tiles must not straddle scan segments");
static_assert((size_t)3 * 64 * NSG * 4096 * 4 <= (size_t)NEXP * 2 * DE * D * 2, "scan segment states overlay wgu_t");
#endif
constexpr size_t OFF_VT = al256(OFF_Z + (size_t)T * ZP * 2);
constexpr size_t OFF_S = al256(OFF_VT + (size_t)NB * 8 * 64 * PU * 2);
constexpr size_t S1 = (size_t)T * 256 * 4;
#ifdef HOST_EMU
constexpr int NSTREAM = 10;
#else
constexpr int NSTREAM = 9;
#endif
constexpr size_t OFF_Y = al256(OFF_S + NSTREAM * S1);
constexpr size_t OFF_MIX = al256(OFF_Y + 2 * S1);
constexpr size_t OFF_XC = al256(OFF_MIX + (size_t)T * 1024 * 2);
constexpr size_t OFF_ROUTE = al256(OFF_XC + (size_t)TC * D * 4);
constexpr size_t OFF_SLOTTOK = al256(OFF_ROUTE + (size_t)T * 2 * 4 * 4);
constexpr size_t WS_NEED = al256(OFF_SLOTTOK + (size_t)NSLOT * 4);
static_assert((size_t)NSLOT * DE * 2 <= (size_t)T * ZP * 2 && (size_t)T * D * 2 <= (size_t)T * ZP * 2, "ACT / HLO overlay Z");
static_assert((size_t)T * 4 * 4 + (size_t)T * 416 * 2 <= S1, "kN + LA overlay Y[1]");
static_assert((size_t)NSLOT * D * 4 <= NSTREAM * S1 && (size_t)T * D * 4 <= NSTREAM * S1, "YS / O overlay the stream buffers");

static Params make_params(void* const* d_in, void* d_out, void* d_ws) {
    Params p{};
    const float** f = (const float**)&p.x;
    for (int i = 0; i < 32; ++i) f[i] = (const float*)d_in[i];
    p.out = (float*)d_out;
    char* w = (char*)d_ws;
    p.cnt = (int*)(w + OFF_CNT); p.bar = (unsigned*)(w + OFF_BAR); p.mod = (float*)(w + OFF_MOD); p.rope = (float*)(w + OFF_ROPE);
    p.win_t = (bf16_t*)(w + OFF_WIN); p.wout_t = (bf16_t*)(w + OFF_WOUT); p.wgu_t = (bf16_t*)(w + OFF_WGU); p.wd_t = (bf16_t*)(w + OFF_WD);
    p.wrt = (bf16_t*)(w + OFF_WRT); p.hist = (int*)(w + OFF_LG); p.HLO = (bf16_t*)(w + OFF_Z);
    p.wupT = (bf16_t*)(w + OFF_LORA); p.aupT = p.wupT + 2 * 256 * 64; p.gupT = p.aupT + 2 * 256 * 64;
    p.H = (bf16_t*)(w + OFF_H); p.Z = (bf16_t*)(w + OFF_Z); p.VT = (bf16_t*)(w + OFF_VT);
    float* s = (float*)(w + OFF_S); const size_t n1 = (size_t)T * 256;
    p.sR = s; p.sV = s + n1; p.sKK = s + 2 * n1; p.sW = s + 3 * n1; p.sKD = s + 5 * n1; p.sB = s + 7 * n1; p.sG = s + 9 * n1;
    p.Y = (float*)(w + OFF_Y); p.MIX = (bf16_t*)(w + OFF_MIX); p.XC = (float*)(w + OFF_XC);
    p.O = (bf16_t*)(w + OFF_S); p.YSb = (bf16_t*)(w + OFF_S);
    p.PV = (float*)(w + OFF_H); p.QS = (float*)(w + OFF_WGU); p.PS = p.QS + (size_t)64 * NSG * 4096; p.SS = p.PS + (size_t)64 * NSG * 4096;
    p.kT = p.Y; p.kN = p.Y + (size_t)T * 256; p.LA = (bf16_t*)(p.Y + (size_t)T * 256 + (size_t)T * 4);
    int* r = (int*)(w + OFF_ROUTE); p.rE = r; p.rPos = r + 2 * T; p.rSlot = r + 4 * T; p.rW = (float*)(r + 6 * T);
    p.slotTok = (int*)(w + OFF_SLOTTOK);
    p.ACT = (bf16_t*)(w + OFF_Z); p.YS = (float*)(w + OFF_S);
    return p;
}

__device__ void ph_prep_w(const Params& p, int l, long gtid, long gsz) {
    for (long i = gtid; i < (long)D * NINP; i += gsz) {
        const int k = (int)(i / NINP), n = (int)(i % NINP);
        float v = 0.f;
        if (n < N_IN) { const int oc = (n < ZA) ? n + A_IN : n - ZA; v = p.w_in[((size_t)l * D + k) * N_IN + oc]; }
        p.win_t[(size_t)n * D + k] = f2bf(v);
    }
    for (long i = gtid; i < (long)DMIX * D; i += gsz) {
        const int k = (int)(i / D), n = (int)(i % D);
        p.wout_t[(size_t)n * DMIX + k] = f2bf(p.w_out[((size_t)l * DMIX + k) * D + n]);
    }
    for (long i = gtid; i < (long)NEXP * D * 2 * DE; i += gsz) {
        const int rho = (int)(i % (2 * DE)); const long t = i / (2 * DE); const int k = (int)(t % D), e = (int)(t / D);
        const int q = rho >> 5, half = (rho >> 4) & 1, ii = rho & 15, cc = 16 * q + ii;
        const float* src = half ? p.w_up : p.w_gate;
        p.wgu_t[((size_t)e * 2 * DE + rho) * D + k] = f2bf(src[(((size_t)l * NEXP + e) * D + k) * DE + cc]);
    }
    for (long i = gtid; i < (long)NEXP * DE * D; i += gsz) {
        const int n = (int)(i % D); const long t = i / D; const int k = (int)(t % DE), e = (int)(t / DE);
        p.wd_t[((size_t)e * D + n) * DE + k] = f2bf(p.w_down[(((size_t)l * NEXP + e) * DE + k) * D + n]);
    }
}
__device__ __forceinline__ void ph_prep_misc(const Params& p, int l, long gtid, long gsz, bool do_mod = true) {
    if (l == 0 && do_mod) for (long i = gtid; i < (long)2 * (NB + 1) * 6 * D; i += gsz) {
        const int j = (int)(i % (6 * D)), b = (int)((i / (6 * D)) % (NB + 1)), ll = (int)(i / ((long)6 * D * (NB + 1)));
        const float* cv = (b < NB) ? p.c + (size_t)b * D : p.c_ctx;
        float acc = 0.f;
        for (int k = 0; k < D; ++k) acc += siluf_(cv[k]) * p.w_mod[((size_t)ll * D + k) * 6 * D + j];
        p.mod[((size_t)ll * (NB + 1) + b) * 6 * D + j] = acc + p.b_mod[(size_t)ll * 6 * D + j];
    }
    if (l == 0) for (long i = gtid; i < 64 * 16; i += gsz) {
        const int pos = (int)(i / 16), fi = (int)(i % 16);
        const float inv = powf(10000.0f, -(float)fi / 16.0f), ang = (float)pos * inv;
        p.rope[i] = cosf(ang); p.rope[1024 + i] = sinf(ang);
    }
    for (long i = gtid; i < NEXP; i += gsz) p.cnt[l * NEXP + i] = 0;
    for (long i = gtid; i < NSLOT; i += gsz) p.slotTok[i] = T;
    for (long i = gtid; i < D; i += gsz) p.H[(size_t)T * D + i] = 0;
}

__device__ __forceinline__ const float* xrow_in(const Params& p, int l, int m) {
    if (m < TL) return (l == 0 ? p.x : p.out) + (size_t)m * D;
    return (l == 0 ? p.ctx : p.XC) + (size_t)(m - TL) * D;
}
__device__ __forceinline__ const float* modrow(const Params& p, int l, int m) { return p.mod + ((size_t)l * (NB + 1) + (m < TL ? m / S : NB)) * 6 * D; }

__device__ void ph_lnmod(const Params& p, int l, long gtid, long gsz) {
    for (long m = gtid; m < T; m += gsz) {
        const float* xr = xrow_in(p, l, (int)m); const float* md = modrow(p, l, (int)m);
        float s = 0.f; for (int j = 0; j < D; ++j) s += xr[j];
        const float mu = s / D; float q = 0.f;
        for (int j = 0; j < D; ++j) { const float d = xr[j] - mu; q += d * d; }
        const float rstd = 1.0f / sqrtf(q / D + LN_EPS);
        for (int j = 0; j < D; ++j) p.H[(size_t)m * D + j] = f2bf((xr[j] - mu) * rstd * (1.0f + md[D + j]) + md[j]);
    }
}

__device__ __forceinline__ float zshift(const Params& p, int l, int m, int col) {
    int t, len;
    if (m < TL) { t = m % S; len = S; } else { t = (m - TL) % L; len = L; }
    const float* sh = p.a_shift + (size_t)l * 3 * A_IN;
    const bf16_t* z = p.Z + (size_t)m * ZP + ZA + col;
    float v = sh[A_IN + col] * bf2f(z[0]);
    if (t > 0) v += sh[col] * bf2f(z[-ZP]);
    if (t < len - 1) v += sh[2 * A_IN + col] * bf2f(z[ZP]);
    return v;
}

__device__ void ph_streams(const Params& p, int l, long gtid, long gsz) {
    for (long i = gtid; i < (long)T * DA; i += gsz) {
        const int m = (int)(i / DA), c = (int)(i % DA), h0 = c & ~63;
        const float r = zshift(p, l, m, c), k = zshift(p, l, m, 256 + c), v = zshift(p, l, m, 512 + c);
        float nrm = 0.f;
        for (int j = 0; j < 64; ++j) { const float t = zshift(p, l, m, 256 + h0 + j) * p.a_k_k[l * DA + h0 + j]; nrm += t * t; }
        const float kk = k * p.a_k_k[l * DA + c] / sqrtf(nrm + 1e-12f);
        float g = 0.f;
        for (int j = 0; j < 160; ++j) g += sigmoidf_(zshift(p, l, m, 1024 + j)) * p.a_g_up[((size_t)l * 160 + j) * DA + c];
        const size_t o = (size_t)m * DA + c;
        p.sR[o] = r; p.sV[o] = v; p.sKK[o] = kk; p.sG[o] = g;
        for (int d = 0; d < 2; ++d) {
            float aw = 0.f, aa = 0.f;
            for (int j = 0; j < 64; ++j) {
                aw += tanhf(zshift(p, l, m, 768 + d * 64 + j)) * p.a_w_up[(((size_t)l * 2 + d) * 64 + j) * DA + c];
                aa += zshift(p, l, m, 896 + d * 64 + j) * p.a_a_up[(((size_t)l * 2 + d) * 64 + j) * DA + c];
            }
            const float u = -(p.a_w0[(l * 2 + d) * DA + c] + aw);
            const float sp = (u > 20.f) ? u : log1pf(expf(u));
            const float w = expf(-expf(-sp - 0.5f));
            const float a = sigmoidf_(p.a_a0[(l * 2 + d) * DA + c] + aa);
            const size_t od = ((size_t)d * T + m) * DA + c;
            p.sW[od] = w; p.sKD[od] = k * (1.0f + (a - 1.0f) * p.a_k_a[l * DA + c]); p.sB[od] = kk * a;
        }
    }
}

__device__ __forceinline__ void ph_rope(const Params& p, long gtid, long gsz) {
    for (long i = gtid; i < (long)TL * 8 * 32; i += gsz) {
        const int pr = (int)(i & 31), hs = (int)((i >> 5) & 7), m = (int)(i >> 8);
        const int t = m % S, axis = pr >> 4, fi = pr & 15, pos = axis ? (t % GRID_W) : (t / GRID_W);
        bf16_t* z = p.Z + (size_t)m * ZP + hs * 64 + axis * 32 + fi;
        const float cs = p.rope[pos * 16 + fi], sn = p.rope[1024 + pos * 16 + fi];
        const float x0 = bf2f(z[0]), x1 = bf2f(z[16]);
        z[0] = f2bf(x0 * cs - x1 * sn); z[16] = f2bf(x1 * cs + x0 * sn);
    }
}

__device__ void ph_scan(const Params& p, long gtid, long gsz) {
    for (long i = gtid; i < (long)2 * NB * 4 * 64; i += gsz) {
        const int v = (int)(i & 63), h = (int)((i >> 6) & 3), b = (int)((i >> 8) % NB), d = (int)((i >> 8) / NB);
        float st[64];
#pragma unroll
        for (int k = 0; k < 64; ++k) st[k] = 0.f;
        for (int pos = 0; pos < L + S; ++pos) {
            int m;
            if (pos < L) m = TL + b * L + (d ? L - 1 - pos : pos);
            else m = b * S + (d ? S - 1 - (pos - L) : pos - L);
            const size_t o = (size_t)m * DA + h * 64, od = ((size_t)d * T + m) * DA + h * 64;
            const float* kk = p.sKK + o; const float* r = p.sR + o;
            const float* w = p.sW + od; const float* bb = p.sB + od; const float* kd = p.sKD + od;
            const float vv = p.sV[o + v];
            float sk = 0.f;
#pragma unroll
            for (int k = 0; k < 64; ++k) sk += st[k] * kk[k];
            float y = 0.f;
#pragma unroll
            for (int k = 0; k < 64; ++k) { st[k] = st[k] * w[k] - sk * bb[k] + vv * kd[k]; y += st[k] * r[k]; }
            p.Y[od + v] = y;
        }
    }
}

__device__ void ph_rwkv_out(const Params& p, int l, int nrows, long gtid, long gsz) {
    for (long i = gtid; i < (long)nrows * 4; i += gsz) {
        const int m = (int)(i >> 2), h = (int)(i & 3);
        const size_t o = (size_t)m * DA + h * 64;
        const float* y0 = p.Y + o; const float* y1 = p.Y + (size_t)T * DA + o;
        float s = 0.f, bon = 0.f;
        for (int n = 0; n < 64; ++n) {
            s += y0[n] + y1[n];
            bon += p.sR[o + n] * (p.sKD[o + n] + p.sKD[(size_t)T * DA + o + n]) * p.a_r_k[l * DA + h * 64 + n];
        }
        const float mu = s / 64.f; float q = 0.f;
        for (int n = 0; n < 64; ++n) { const float dd = y0[n] + y1[n] - mu; q += dd * dd; }
        const float rstd = 1.0f / sqrtf(q / 64.f + GN_EPS);
        for (int n = 0; n < 64; ++n) {
            const int c = h * 64 + n;
            const float yn = (y0[n] + y1[n] - mu) * rstd * p.a_lnx_g[l * DA + c] + p.a_lnx_b[l * DA + c];
            p.MIX[(size_t)m * DMIX + c] = f2bf((yn + bon * p.sV[o + n]) * p.sG[o + n]);
        }
    }
}

__device__ __forceinline__ void att_key(const float (&q)[64], const bf16_t* kr, const bf16_t* vr, float bias, float& mx, float& ls, float (&acc)[64]) {
    float s = 0.f;
#pragma unroll
    for (int d = 0; d < 64; ++d) s += q[d] * bf2f(kr[d]);
    s = s * ATT_SCALE + bias;
    const float mn = fmaxf(mx, s), f = expf(mx - mn), pe = expf(s - mn);
    ls = ls * f + pe;
#pragma unroll
    for (int d = 0; d < 64; ++d) acc[d] = acc[d] * f + pe * bf2f(vr[d]);
    mx = mn;
}

__device__ void ph_attn(const Params& p, int l, int nrows, long gtid, long gsz) {
    for (long i = gtid; i < (long)nrows * 12; i += gsz) {
        const int m = (int)(i / 12), u = (int)(i % 12);
        const bool isB = u < 6; const int hq = isB ? u : u - 6;
        const int b = (m < TL) ? m / S : (m - TL) / L;
        const int qcol = isB ? ZQB + hq * 64 : ZQN + hq * 64;
        const int kcol = isB ? ZKB + (hq / 3) * 64 : ZKN + hq * 64;
        const int vcol = isB ? ZVB + (hq / 3) * 64 : ZVN + hq * 64;
        float q[64], acc[64];
        const bf16_t* qr = p.Z + (size_t)m * ZP + qcol;
#pragma unroll
        for (int d = 0; d < 64; ++d) { q[d] = bf2f(qr[d]); acc[d] = 0.f; }
        float mx, ls;
        if (isB) { mx = p.b_sink[l * 6 + hq]; ls = 1.0f; } else { mx = -1e30f; ls = 0.f; }
        for (int j = 0; j < L; ++j) { const bf16_t* zr = p.Z + (size_t)(TL + b * L + j) * ZP; att_key(q, zr + kcol, zr + vcol, 0.f, mx, ls, acc); }
        if (m < TL) {
            const int t = m % S;
            if (isB) {
                const int j0 = t - 128 < 0 ? 0 : t - 128, j1 = t + 128 > S - 1 ? S - 1 : t + 128;
                for (int j = j0; j <= j1; ++j) { const bf16_t* zr = p.Z + (size_t)(b * S + j) * ZP; att_key(q, zr + kcol, zr + vcol, 0.f, mx, ls, acc); }
            } else {
                const int rows = S / GRID_W, r = t / GRID_W, c = t % GRID_W;
                int r0 = r - 4; r0 = r0 < 0 ? 0 : (r0 > rows - 8 ? rows - 8 : r0);
                int c0 = c - 8; c0 = c0 < 0 ? 0 : (c0 > GRID_W - 16 ? GRID_W - 16 : c0);
                for (int a = 0; a < 8; ++a)
                    for (int e = 0; e < 16; ++e) {
                        const int kr = r0 + a, kc = c0 + e;
                        const float bias = p.c_rpb[(((size_t)l * 6 + hq) * 15 + (kr - r + 7)) * 31 + (kc - c + 15)];
                        const bf16_t* zr = p.Z + (size_t)(b * S + kr * GRID_W + kc) * ZP;
                        att_key(q, zr + kcol, zr + vcol, bias, mx, ls, acc);
                    }
            }
        }
        const float inv = 1.0f / ls;
        bf16_t* o = p.MIX + (size_t)m * DMIX + (isB ? 256 : 640) + hq * 64;
#pragma unroll
        for (int d = 0; d < 64; ++d) o[d] = f2bf(acc[d] * inv);
    }
}

__device__ void ph_post_mixer(const Params& p, int l, int nrows, long gtid, long gsz) {
    for (long mm = gtid; mm < nrows; mm += gsz) {
        const int m = (int)mm;
        const float* xr = xrow_in(p, l, m); const float* md = modrow(p, l, m); const float* orow = (const float*)p.O + (size_t)m * D;
        float* x1 = (m < TL) ? p.out + (size_t)m * D : p.XC + (size_t)(m - TL) * D;
        const float* g1 = p.ln1_g + (size_t)l * D; const float* b1 = p.ln1_b + (size_t)l * D;
        float s = 0.f; for (int j = 0; j < D; ++j) s += ALPHA * xr[j] + md[2 * D + j] * orow[j];
        float mu = s / D, q = 0.f;
        for (int j = 0; j < D; ++j) { const float d = ALPHA * xr[j] + md[2 * D + j] * orow[j] - mu; q += d * d; }
        float rstd = 1.0f / sqrtf(q / D + LN_EPS);
        s = 0.f;
        for (int j = 0; j < D; ++j) { const float v = (ALPHA * xr[j] + md[2 * D + j] * orow[j] - mu) * rstd * g1[j] + b1[j]; x1[j] = v; s += v; }
        mu = s / D; q = 0.f;
        for (int j = 0; j < D; ++j) { const float d = x1[j] - mu; q += d * d; }
        rstd = 1.0f / sqrtf(q / D + LN_EPS);
        float gl[4], el[32];
#pragma unroll
        for (int g = 0; g < 4; ++g) gl[g] = p.b_rg[l * 4 + g];
#pragma unroll
        for (int e = 0; e < 32; ++e) el[e] = p.b_re[l * 32 + e];
        for (int j = 0; j < D; ++j) {
            const float hv = (x1[j] - mu) * rstd * (1.0f + md[4 * D + j]) + md[3 * D + j];
            p.H[(size_t)m * D + j] = f2bf(hv);
            const float* wg = p.w_rg + ((size_t)l * D + j) * 4; const float* we = p.w_re + ((size_t)l * D + j) * 32;
#pragma unroll
            for (int g = 0; g < 4; ++g) gl[g] += hv * wg[g];
#pragma unroll
            for (int e = 0; e < 32; ++e) el[e] += hv * we[e];
        }
        int gs = 0; float gm = gl[0];
#pragma unroll
        for (int g = 1; g < 4; ++g) if (gl[g] > gm) { gm = gl[g]; gs = g; }
        float den = 0.f;
#pragma unroll
        for (int g = 0; g < 4; ++g) den += expf(gl[g] - gm);
        const float pg = 1.0f / den;
        float v1 = -3e38f, v2 = -3e38f; int i1 = 0, i2 = 0;
#pragma unroll
        for (int j = 0; j < 8; ++j) {
            const float v = gs == 0 ? el[j] : gs == 1 ? el[8 + j] : gs == 2 ? el[16 + j] : el[24 + j];
            if (v > v1) { v2 = v1; i2 = i1; v1 = v; i1 = j; } else if (v > v2) { v2 = v; i2 = j; }
        }
        const float e2 = expf(v2 - v1), w1 = pg / (1.0f + e2), w2 = pg * e2 / (1.0f + e2);
        const int ea = gs * 8 + i1, eb = gs * 8 + i2;
        p.rE[2 * m] = ea; p.rE[2 * m + 1] = eb; p.rW[2 * m] = w1; p.rW[2 * m + 1] = w2;
        p.rPos[2 * m] = atomic_inc_int(p.cnt + l * NEXP + ea); p.rPos[2 * m + 1] = atomic_inc_int(p.cnt + l * NEXP + eb);
    }
}

__device__ __forceinline__ int pstart_of(const int* cnt, int e) {
    int s = 0;
    for (int j = 0; j < NEXP; ++j) if (j < e) s += (cnt[j] + 127) & ~127;
    return s;
}
__device__ __forceinline__ void ph_dispatch(const Params& p, int l, int nrows, long gtid, long gsz) {
    for (long i = gtid; i < (long)nrows * 2; i += gsz) {
        const int slot = pstart_of(p.cnt + l * NEXP, p.rE[i]) + p.rPos[i];
        p.rSlot[i] = slot; p.slotTok[slot] = (int)(i >> 1);
    }
}

__device__ void ph_final(const Params& p, int l, int nrows, long gtid, long gsz) {
    for (long mm = gtid; mm < nrows; mm += gsz) {
        const int m = (int)mm;
        float* x1 = (m < TL) ? p.out + (size_t)m * D : p.XC + (size_t)(m - TL) * D;
        const float* md = modrow(p, l, m);
        const float* ya = p.YS + (size_t)p.rSlot[2 * m] * D; const float* yb = p.YS + (size_t)p.rSlot[2 * m + 1] * D;
        const float wa = p.rW[2 * m], wb = p.rW[2 * m + 1];
        const float* g2 = p.ln2_g + (size_t)l * D; const float* b2 = p.ln2_b + (size_t)l * D;
        float s = 0.f; for (int j = 0; j < D; ++j) s += ALPHA * x1[j] + md[5 * D + j] * (wa * ya[j] + wb * yb[j]);
        const float mu = s / D; float q = 0.f;
        for (int j = 0; j < D; ++j) { const float d = ALPHA * x1[j] + md[5 * D + j] * (wa * ya[j] + wb * yb[j]) - mu; q += d * d; }
        const float rstd = 1.0f / sqrtf(q / D + LN_EPS);
        for (int j = 0; j < D; ++j) x1[j] = (ALPHA * x1[j] + md[5 * D + j] * (wa * ya[j] + wb * yb[j]) - mu) * rstd * g2[j] + b2[j];
    }
}

__device__ __forceinline__ int moe_blocks(const int* cnt) { int s = 0; for (int j = 0; j < NEXP; ++j) s += (cnt[j] + 127) >> 7; return s; }
__device__ __forceinline__ int moe_block_expert(const int* cnt, int rb) {
    int s = 0, e = 0;
    for (int j = 0; j < NEXP; ++j) { const int nb = (cnt[j] + 127) >> 7; if (rb >= s && rb < s + nb) e = j; s += nb; }
    return e;
}

#ifdef HOST_EMU
static void host_gemm_in(const Params& p) {
    for (int m = 0; m < T; ++m) for (int n = 0; n < ZP; ++n) { float a = 0.f; for (int k = 0; k < D; ++k) a += bf2f(p.H[(size_t)m * D + k]) * bf2f(p.win_t[(size_t)n * D + k]); p.Z[(size_t)m * ZP + n] = f2bf(a); }
}
static void host_gemm_out(const Params& p, int nrows) {
    for (int m = 0; m < nrows; ++m) for (int n = 0; n < D; ++n) { float a = 0.f; for (int k = 0; k < DMIX; ++k) a += bf2f(p.MIX[(size_t)m * DMIX + k]) * bf2f(p.wout_t[(size_t)n * DMIX + k]); ((float*)p.O)[(size_t)m * D + n] = a; }
}
static void host_moe1(const Params& p, int l) {
    const int* cnt = p.cnt + l * NEXP; const int nrb = moe_blocks(cnt);
    for (int rb = 0; rb < nrb; ++rb) { const int e = moe_block_expert(cnt, rb);
        for (int r = 0; r < 128; ++r) { const int slot = rb * 128 + r; const bf16_t* a = p.H + (size_t)p.slotTok[slot] * D;
            for (int c = 0; c < DE; ++c) { const int q = c >> 4, ii = c & 15; float g = 0.f, u = 0.f;
                const bf16_t* wg = p.wgu_t + ((size_t)e * 2 * DE + 32 * q + ii) * D; const bf16_t* wu = wg + (size_t)16 * D;
                for (int k = 0; k < D; ++k) { g += bf2f(a[k]) * bf2f(wg[k]); u += bf2f(a[k]) * bf2f(wu[k]); }
                p.ACT[(size_t)slot * DE + c] = f2bf(siluf_(g) * u); } } }
}
static void host_moe2(const Params& p, int l) {
    const int* cnt = p.cnt + l * NEXP; const int nrb = moe_blocks(cnt);
    for (int rb = 0; rb < nrb; ++rb) { const int e = moe_block_expert(cnt, rb);
        for (int r = 0; r < 128; ++r) { const int slot = rb * 128 + r;
            for (int n = 0; n < D; ++n) { float a = 0.f; const bf16_t* w = p.wd_t + ((size_t)e * D + n) * DE;
                for (int k = 0; k < DE; ++k) a += bf2f(p.ACT[(size_t)slot * DE + k]) * bf2f(w[k]);
                p.YS[(size_t)slot * D + n] = a; } } }
}
#else
typedef short bf16x8 __attribute__((ext_vector_type(8)));
typedef float f32x4 __attribute__((ext_vector_type(4)));
__device__ __forceinline__ int opq_tid() { int t = threadIdx.x; asm volatile("" : "+v"(t)); return t; }
__device__ __forceinline__ int opq_bid() { int b = blockIdx.x; asm volatile("" : "+s"(b)); return b; }
__device__ __forceinline__ unsigned pk2(float lo, float hi) { return (unsigned)f2bf(lo) | ((unsigned)f2bf(hi) << 16); }
struct u32x2_t { unsigned x, y; };
__device__ __forceinline__ void st_bf16x4(bf16_t* dst, f32x4 v) { u32x2_t o; o.x = pk2(v[0], v[1]); o.y = pk2(v[2], v[3]); *(u32x2_t*)dst = o; }
template <bool SWAP = true, class Epi>
__device__ __forceinline__ void gemm_tile(const bf16_t* a0, const bf16_t* a1, const bf16_t* b0, const bf16_t* b1, int K, char* lds, const Epi& epi) {
    const int tid = opq_tid(), wid = tid >> 6, lane = tid & 63, wr = wid >> 1, wc = wid & 1, fr = lane & 15, fq = lane >> 4;
    f32x4 acc[4][4];
#pragma unroll
    for (int m = 0; m < 4; ++m)
#pragma unroll
        for (int n = 0; n < 4; ++n) acc[m][n] = (f32x4){0.f, 0.f, 0.f, 0.f};
#define GT_STAGE(st_, kt_) do { char* sa_ = lds + (st_) * 16384 + tid * 16; \
        __builtin_amdgcn_global_load_lds((const unsigned*)(a0 + (kt_)), (__attribute__((address_space(3))) unsigned*)(sa_), 16, 0, 0); \
        __builtin_amdgcn_global_load_lds((const unsigned*)(a1 + (kt_)), (__attribute__((address_space(3))) unsigned*)(sa_ + 4096), 16, 0, 0); \
        __builtin_amdgcn_global_load_lds((const unsigned*)(b0 + (kt_)), (__attribute__((address_space(3))) unsigned*)(sa_ + 8192), 16, 0, 0); \
        __builtin_amdgcn_global_load_lds((const unsigned*)(b1 + (kt_)), (__attribute__((address_space(3))) unsigned*)(sa_ + 12288), 16, 0, 0); } while (0)
    const int fsw = (0 - (fr >> 2)) & 3;
    const int aoff = (wr * 64 + fr) * 64 + ((fq ^ fsw) * 16), boff = 8192 + (wc * 64 + fr) * 64 + ((fq ^ fsw) * 16);
    const int nk = K / 32;
    GT_STAGE(0, 0);
    if (nk > 1) GT_STAGE(1, 32);
    if (nk > 2) GT_STAGE(2, 64);
    for (int t = 0; t < nk; ++t) {
        if (t + 2 < nk) asm volatile("s_waitcnt vmcnt(8)" ::: "memory"); else if (t + 1 < nk) asm volatile("s_waitcnt vmcnt(4)" ::: "memory"); else asm volatile("s_waitcnt vmcnt(0)" ::: "memory");
        asm volatile("s_waitcnt lgkmcnt(0)" ::: "memory");
        __builtin_amdgcn_s_barrier();
        if (t + 3 < nk) GT_STAGE((t + 3) & 3, (t + 3) * 32);
        const char* sb = lds + (t & 3) * 16384;
        bf16x8 At[4], Bt[4];
#pragma unroll
        for (int m = 0; m < 4; ++m) At[m] = *(const bf16x8*)(sb + aoff + m * 1024);
#pragma unroll
        for (int n = 0; n < 4; ++n) Bt[n] = *(const bf16x8*)(sb + boff + n * 1024);
#pragma unroll
        for (int m = 0; m < 4; ++m)
#pragma unroll
            for (int n = 0; n < 4; ++n) acc[m][n] = SWAP ? __builtin_amdgcn_mfma_f32_16x16x32_bf16(Bt[n], At[m], acc[m][n], 0, 0, 0) : __builtin_amdgcn_mfma_f32_16x16x32_bf16(At[m], Bt[n], acc[m][n], 0, 0, 0);
    }
    asm volatile("s_waitcnt lgkmcnt(0)" ::: "memory");
    __builtin_amdgcn_s_barrier();
#undef GT_STAGE
    epi(acc, wr, wc, fr, fq);
}
#define STG_ROW(i) ((tid_ + (i) * 256) >> 2)
#define STG_K ((((tid_ & 3) ^ ((0 - (tid_ >> 4)) & 3))) * 8)

__device__ __forceinline__ f32x4 ld_bf16x4(const bf16_t* src) { const u32x2_t w = *(const u32x2_t*)src; return (f32x4){__uint_as_float(w.x << 16), __uint_as_float(w.x & 0xffff0000u), __uint_as_float(w.y << 16), __uint_as_float(w.y & 0xffff0000u)}; }
__device__ __forceinline__ void g_gemm_in(const Params& p, char* lds) {
    const int tid_ = opq_tid(), bid_ = opq_bid(); (void)tid_; (void)bid_;
    constexpr int NT = NINP / 128, MT = T / 128;
    for (int tile = bid_; tile < NT * MT; tile += gridDim.x) {
        const int tm = tile / NT, tn = tile % NT;
        const bf16_t* a0 = p.H + (size_t)(tm * 128 + STG_ROW(0)) * D + STG_K; const bf16_t* a1 = p.H + (size_t)(tm * 128 + STG_ROW(1)) * D + STG_K;
        const bf16_t* b0 = p.win_t + (size_t)(tn * 128 + STG_ROW(0)) * D + STG_K; const bf16_t* b1 = p.win_t + (size_t)(tn * 128 + STG_ROW(1)) * D + STG_K;
        if (tn == ZVB / 128 || (tn >= ZVN / 128 && tn < ZA / 128)) {
            gemm_tile<false>(a0, a1, b0, b1, D, lds, [&](const f32x4 (&acc)[4][4], int wr, int wc, int fr, int fq) {
#pragma unroll
                for (int m = 0; m < 4; ++m) { const int m0 = tm * 128 + wr * 64 + m * 16 + fq * 4; int b, u;
                    if (m0 < TL) { b = m0 / S; u = L + m0 % S; } else { b = (m0 - TL) / L; u = (m0 - TL) % L; }
#pragma unroll
                    for (int n = 0; n < 4; ++n) { const int col = tn * 128 + wc * 64 + n * 16 + fr;
                        const int hv = col < ZVN ? (col - ZVB) >> 6 : 2 + ((col - ZVN) >> 6), d = col < ZVN ? (col - ZVB) & 63 : (col - ZVN) & 63;
                        st_bf16x4(p.VT + ((size_t)(b * 8 + hv) * 64 + d) * PU + u, acc[m][n]); } }
            });
        } else if (tn < ZVB / 128 && tm < TL / 128) {
            gemm_tile<true>(a0, a1, b0, b1, D, lds, [&](const f32x4 (&acc)[4][4], int wr, int wc, int fr, int fq) {
#pragma unroll
                for (int m = 0; m < 4; ++m) { const int row = tm * 128 + wr * 64 + m * 16 + fr, t = row % S;
                    bf16_t* zr = p.Z + (size_t)row * ZP + tn * 128 + wc * 64 + 4 * fq;
#pragma unroll
                    for (int ax = 0; ax < 2; ++ax) { const int pos = ax ? t % GRID_W : t / GRID_W;
                        const f32x4 cs = *(const f32x4*)(p.rope + pos * 16 + 4 * fq), sn = *(const f32x4*)(p.rope + 1024 + pos * 16 + 4 * fq);
                        const f32x4 x0 = acc[m][2 * ax], x1 = acc[m][2 * ax + 1];
                        st_bf16x4(zr + 32 * ax, x0 * cs - x1 * sn); st_bf16x4(zr + 32 * ax + 16, x1 * cs + x0 * sn); } }
            });
        } else {
            gemm_tile<true>(a0, a1, b0, b1, D, lds, [&](const f32x4 (&acc)[4][4], int wr, int wc, int fr, int fq) {
#pragma unroll
                for (int m = 0; m < 4; ++m)
#pragma unroll
                    for (int n = 0; n < 4; ++n) { const int col = tn * 128 + wc * 64 + n * 16 + 4 * fq;
                        if (col < ZP) st_bf16x4(p.Z + (size_t)(tm * 128 + wr * 64 + m * 16 + fr) * ZP + col, acc[m][n]); }
            });
        }
    }
}
__device__ __forceinline__ void g_gemm_out(const Params& p, int nrows, char* lds) {
    const int tid_ = opq_tid(), bid_ = opq_bid(); (void)tid_; (void)bid_;
    constexpr int NT = D / 128; const int MT = nrows / 128;
    for (int tile = bid_; tile < NT * MT; tile += gridDim.x) {
        const int tm = tile / NT, tn = tile % NT;
        const bf16_t* a0 = p.MIX + (size_t)(tm * 128 + STG_ROW(0)) * DMIX + STG_K; const bf16_t* a1 = p.MIX + (size_t)(tm * 128 + STG_ROW(1)) * DMIX + STG_K;
        const bf16_t* b0 = p.wout_t + (size_t)(tn * 128 + STG_ROW(0)) * DMIX + STG_K; const bf16_t* b1 = p.wout_t + (size_t)(tn * 128 + STG_ROW(1)) * DMIX + STG_K;
        gemm_tile(a0, a1, b0, b1, DMIX, lds, [&](const f32x4 (&acc)[4][4], int wr, int wc, int fr, int fq) {
#pragma unroll
            for (int m = 0; m < 4; ++m)
#pragma unroll
                for (int n = 0; n < 4; ++n) st_bf16x4(p.O + (size_t)(tm * 128 + wr * 64 + m * 16 + fr) * D + tn * 128 + wc * 64 + n * 16 + 4 * fq, acc[m][n]);
        });
    }
}
__device__ __forceinline__ void g_moe1(const Params& p, int l, char* lds) {
    const int tid_ = opq_tid(), bid_ = opq_bid(); (void)tid_; (void)bid_;
    const int* cnt = p.cnt + l * NEXP; const int nrb = moe_blocks(cnt); constexpr int NT = 2 * DE / 128;
    for (int tile = bid_; tile < nrb * NT; tile += gridDim.x) {
        const int rb = tile / NT, tn = tile % NT, e = moe_block_expert(cnt, rb);
        const bf16_t* a0 = p.H + (size_t)p.slotTok[rb * 128 + STG_ROW(0)] * D + STG_K; const bf16_t* a1 = p.H + (size_t)p.slotTok[rb * 128 + STG_ROW(1)] * D + STG_K;
        const bf16_t* bw = p.wgu_t + (size_t)e * 2 * DE * D;
        const bf16_t* b0 = bw + (size_t)(tn * 128 + STG_ROW(0)) * D + STG_K; const bf16_t* b1 = bw + (size_t)(tn * 128 + STG_ROW(1)) * D + STG_K;
        gemm_tile(a0, a1, b0, b1, D, lds, [&](const f32x4 (&acc)[4][4], int wr, int wc, int fr, int fq) {
#pragma unroll
            for (int m = 0; m < 4; ++m)
#pragma unroll
                for (int n2 = 0; n2 < 2; ++n2) {
                    const f32x4 g = acc[m][2 * n2], u = acc[m][2 * n2 + 1]; f32x4 a;
#pragma unroll
                    for (int e4 = 0; e4 < 4; ++e4) a[e4] = g[e4] / (1.0f + __expf(-g[e4])) * u[e4];
                    st_bf16x4(p.ACT + (size_t)(rb * 128 + wr * 64 + m * 16 + fr) * DE + tn * 64 + wc * 32 + n2 * 16 + 4 * fq, a); }
        });
    }
}
__device__ __forceinline__ void g_moe2(const Params& p, int l, char* lds) {
    const int tid_ = opq_tid(), bid_ = opq_bid(); (void)tid_; (void)bid_;
    const int* cnt = p.cnt + l * NEXP; const int nrb = moe_blocks(cnt); constexpr int NT = D / 128;
    for (int tile = bid_; tile < nrb * NT; tile += gridDim.x) {
        const int rb = tile / NT, tn = tile % NT, e = moe_block_expert(cnt, rb);
        const bf16_t* a0 = p.ACT + (size_t)(rb * 128 + STG_ROW(0)) * DE + STG_K; const bf16_t* a1 = p.ACT + (size_t)(rb * 128 + STG_ROW(1)) * DE + STG_K;
        const bf16_t* bw = p.wd_t + (size_t)e * D * DE;
        const bf16_t* b0 = bw + (size_t)(tn * 128 + STG_ROW(0)) * DE + STG_K; const bf16_t* b1 = bw + (size_t)(tn * 128 + STG_ROW(1)) * DE + STG_K;
        gemm_tile(a0, a1, b0, b1, DE, lds, [&](const f32x4 (&acc)[4][4], int wr, int wc, int fr, int fq) {
#pragma unroll
            for (int m = 0; m < 4; ++m)
#pragma unroll
                for (int n = 0; n < 4; ++n) st_bf16x4(p.YSb + (size_t)(rb * 128 + wr * 64 + m * 16 + fr) * D + tn * 128 + wc * 64 + n * 16 + 4 * fq, acc[m][n]);
        });
    }
}


constexpr int DV = D / 256;
static_assert(D % 256 == 0, "row phases hold a row as DV float4 per lane");
template <int CTRL> __device__ __forceinline__ float dppf(float v) { return __builtin_bit_cast(float, __builtin_amdgcn_update_dpp(0, __builtin_bit_cast(int, v), CTRL, 0xf, 0xf, true)); }
__device__ __forceinline__ float wave_sum(float v) {
    v += dppf<0xB1>(v); v += dppf<0x4E>(v); v += dppf<0x141>(v); v += dppf<0x140>(v);
    float a = v, b = v;
    asm volatile("s_nop 1\n\tv_permlane16_swap_b32 %0, %1" : "+v"(a), "+v"(b));
    v = a + b; a = v; b = v;
    asm volatile("s_nop 1\n\tv_permlane32_swap_b32 %0, %1" : "+v"(a), "+v"(b));
    return a + b;
}
__device__ __forceinline__ float sum8(float v) { v += dppf<0xB1>(v); v += dppf<0x4E>(v); v += dppf<0x141>(v); return v; }
__device__ __forceinline__ float sum4(f32x4 a) { return (a[0] + a[1]) + (a[2] + a[3]); }
#define LDS_WAIT() asm volatile("s_waitcnt lgkmcnt(0)" ::: "memory")

__device__ __forceinline__ void row_stats(const f32x4 (&v)[DV], float& mu, float& rstd) {
    float s = 0.f;
#pragma unroll
    for (int j = 0; j < DV; ++j) s += sum4(v[j]);
    mu = wave_sum(s) * (1.0f / D);
    float q = 0.f;
#pragma unroll
    for (int j = 0; j < DV; ++j) { const f32x4 d = v[j] - mu; q += sum4(d * d); }
    rstd = 1.0f / sqrtf(wave_sum(q) * (1.0f / D) + LN_EPS);
}

__device__ __forceinline__ void ph_lnmod_fast(const Params& p, int l) {
    const int tid_ = opq_tid(), bid_ = opq_bid(); (void)tid_; (void)bid_;
    const int lane = tid_ & 63, gw = bid_ * 4 + (tid_ >> 6), nw = gridDim.x * 4;
    constexpr int R = 4;
    for (int m0 = gw * R; m0 < T; m0 += nw * R) {
        f32x4 v[R][DV];
#pragma unroll
        for (int r = 0; r < R; ++r) { const f32x4* xr = (const f32x4*)xrow_in(p, l, m0 + r < T ? m0 + r : m0) + lane;
#pragma unroll
            for (int j = 0; j < DV; ++j) v[r][j] = xr[64 * j]; }
        float mu[R], rstd[R];
#pragma unroll
        for (int r = 0; r < R; ++r) row_stats(v[r], mu[r], rstd[r]);
#pragma unroll
        for (int r = 0; r < R; ++r) if (m0 + r < T) { const f32x4* md = (const f32x4*)modrow(p, l, m0 + r) + lane;
#pragma unroll
            for (int j = 0; j < DV; ++j) st_bf16x4(p.H + (size_t)(m0 + r) * D + 4 * (lane + 64 * j), (v[r][j] - mu[r]) * rstd[r] * (md[D / 4 + 64 * j] + 1.0f) + md[64 * j]); }
    }
}

template <int R>
__device__ __forceinline__ void pm_rows(const Params& p, int l, int m0, int lane) {
    const f32x4* g1 = (const f32x4*)(p.ln1_g + (size_t)l * D) + lane; const f32x4* b1 = (const f32x4*)(p.ln1_b + (size_t)l * D) + lane;
    f32x4 v[R][DV]; float mu[R], rstd[R];
#pragma unroll
    for (int r = 0; r < R; ++r) { const int m = m0 + r; const f32x4* xr = (const f32x4*)xrow_in(p, l, m) + lane; const f32x4* md = (const f32x4*)modrow(p, l, m) + lane;
        const bf16_t* orow = p.O + (size_t)m * D + 4 * lane;
#pragma unroll
        for (int j = 0; j < DV; ++j) v[r][j] = xr[64 * j] * ALPHA + md[2 * (D / 4) + 64 * j] * ld_bf16x4(orow + 256 * j); }
#pragma unroll
    for (int r = 0; r < R; ++r) row_stats(v[r], mu[r], rstd[r]);
#pragma unroll
    for (int r = 0; r < R; ++r) { const int m = m0 + r; f32x4* x1 = (f32x4*)((m < TL) ? p.out + (size_t)m * D : p.XC + (size_t)(m - TL) * D) + lane;
#pragma unroll
        for (int j = 0; j < DV; ++j) { v[r][j] = (v[r][j] - mu[r]) * rstd[r] * g1[64 * j] + b1[64 * j]; x1[64 * j] = v[r][j]; } }
#pragma unroll
    for (int r = 0; r < R; ++r) row_stats(v[r], mu[r], rstd[r]);
#pragma unroll
    for (int r = 0; r < R; ++r) { const int m = m0 + r; const f32x4* md = (const f32x4*)modrow(p, l, m) + lane;
#pragma unroll
        for (int j = 0; j < DV; ++j) {
            const f32x4 hv = (v[r][j] - mu[r]) * rstd[r] * (md[4 * (D / 4) + 64 * j] + 1.0f) + md[3 * (D / 4) + 64 * j];
            f32x4 hh, lo;
#pragma unroll
            for (int e = 0; e < 4; ++e) { hh[e] = bf2f(f2bf(hv[e])); lo[e] = hv[e] - hh[e]; }
            st_bf16x4(p.H + (size_t)m * D + 4 * (lane + 64 * j), hh);
            st_bf16x4(p.HLO + (size_t)m * D + 4 * (lane + 64 * j), lo);
        } }
}

__device__ __forceinline__ int router_rpg(int nrows) { const int g = gridDim.x; return (nrows % g == 0 && nrows / g <= 48 && (nrows / g) % 4 == 0) ? nrows / g : 32; }
__device__ __forceinline__ void g_router(const Params& p, int l, int nrows, char* lds) {
    const int tid_ = opq_tid(), bid_ = opq_bid(); (void)tid_; (void)bid_;
    const int lane = tid_ & 63, wid = tid_ >> 6, fr = lane & 15, fq = lane >> 4;
    const int RPG = router_rpg(nrows), RW = RPG / 4;
    float* part = (float*)lds;
    float* lgt = part + 4 * 9 * 64 * 4;
    int* eids = (int*)(lgt + 48 * 48);
    for (int rg = bid_; rg < nrows / RPG; rg += gridDim.x) {
#pragma unroll 1
        for (int i = 0; i + 1 < RW; i += 2) pm_rows<2>(p, l, rg * RPG + wid * RW + i, lane);
        if (RW & 1) pm_rows<1>(p, l, rg * RPG + wid * RW + RW - 1, lane);
        asm volatile("s_waitcnt vmcnt(0)" ::: "memory");
        __syncthreads();
        f32x4 acc[3][3];
#pragma unroll
        for (int a = 0; a < 3; ++a)
#pragma unroll
            for (int b = 0; b < 3; ++b) acc[a][b] = (f32x4){0.f, 0.f, 0.f, 0.f};
        int arow[3];
#pragma unroll
        for (int a = 0; a < 3; ++a) { const int rr = a * 16 + fr; arow[a] = rg * RPG + (rr < RPG ? rr : RPG - 1); }
#pragma unroll
        for (int seg = 0; seg < 3; ++seg) {
            const bf16_t* ab = (seg < 2 ? p.H : p.HLO) + wid * (D / 4) + fq * 8;
            const bf16_t* bp = p.wrt + (seg == 1 ? (size_t)128 * D : 0) + (size_t)fr * D + wid * (D / 4) + fq * 8;
#pragma unroll 1
            for (int ks0 = 0; ks0 < D / 128; ks0 += 2) {
                bf16x8 av[2][3], bv[2][3];
#pragma unroll
                for (int u = 0; u < 2; ++u) { const int ko = (ks0 + u) * 32;
#pragma unroll
                    for (int a = 0; a < 3; ++a) { av[u][a] = *(const bf16x8*)(ab + (size_t)arow[a] * D + ko); bv[u][a] = *(const bf16x8*)(bp + (size_t)(16 * a) * D + ko); } }
                asm volatile("" ::: "memory");
#pragma unroll
                for (int u = 0; u < 2; ++u)
#pragma unroll
                    for (int a = 0; a < 3; ++a)
#pragma unroll
                        for (int b = 0; b < 3; ++b) acc[a][b] = __builtin_amdgcn_mfma_f32_16x16x32_bf16(av[u][a], bv[u][b], acc[a][b], 0, 0, 0);
            }
        }
#pragma unroll
        for (int a = 0; a < 3; ++a)
#pragma unroll
            for (int b = 0; b < 3; ++b) *(f32x4*)(part + ((wid * 9 + a * 3 + b) * 64 + lane) * 4) = acc[a][b];
        __syncthreads();
#pragma unroll
        for (int i = 0; i < 9; ++i) { const int e = tid_ + 256 * i, f = e >> 8, ln = (e & 255) >> 2, j = e & 3;
            const float sm = (part[((0 * 9 + f) * 64 + ln) * 4 + j] + part[((1 * 9 + f) * 64 + ln) * 4 + j]) + (part[((2 * 9 + f) * 64 + ln) * 4 + j] + part[((3 * 9 + f) * 64 + ln) * 4 + j]);
            lgt[((f / 3) * 16 + (ln >> 4) * 4 + j) * 48 + (f % 3) * 16 + (ln & 15)] = sm; }
        __syncthreads();
        if (tid_ < RPG) {
            const int m = rg * RPG + tid_; const float* lg = lgt + tid_ * 48;
            float gl[4], el[32];
#pragma unroll
            for (int g = 0; g < 4; ++g) gl[g] = lg[g] + p.b_rg[l * 4 + g];
#pragma unroll
            for (int e = 0; e < 32; ++e) el[e] = lg[4 + e] + p.b_re[l * 32 + e];
            int gs = 0; float gm = gl[0];
#pragma unroll
            for (int g = 1; g < 4; ++g) if (gl[g] > gm) { gm = gl[g]; gs = g; }
            float den = 0.f;
#pragma unroll
            for (int g = 0; g < 4; ++g) den += expf(gl[g] - gm);
            const float pg = 1.0f / den;
            float v1 = -3e38f, v2 = -3e38f; int i1 = 0, i2 = 0;
#pragma unroll
            for (int j = 0; j < 8; ++j) {
                const float vv = gs == 0 ? el[j] : gs == 1 ? el[8 + j] : gs == 2 ? el[16 + j] : el[24 + j];
                if (vv > v1) { v2 = v1; i2 = i1; v1 = vv; i1 = j; } else if (vv > v2) { v2 = vv; i2 = j; }
            }
            const float e2 = expf(v2 - v1), w1 = pg / (1.0f + e2), w2 = pg * e2 / (1.0f + e2);
            const int ea = gs * 8 + i1, eb = gs * 8 + i2;
            p.rE[2 * m] = ea; p.rE[2 * m + 1] = eb; p.rW[2 * m] = w1; p.rW[2 * m + 1] = w2;
            eids[2 * tid_] = ea; eids[2 * tid_ + 1] = eb;
        }
        __syncthreads();
        if (tid_ < 2 * RPG) { const int e = eids[tid_]; int rk = 0; for (int j = 0; j < tid_; ++j) rk += (eids[j] == e) ? 1 : 0; p.rPos[2 * (rg * RPG) + tid_] = rk; }
        else if (tid_ >= 128 && tid_ < 160) { const int e = tid_ - 128; int c = 0; for (int j = 0; j < 2 * RPG; ++j) c += (eids[j] == e) ? 1 : 0; p.hist[rg * 32 + e] = c; }
        __syncthreads();
    }
}

__device__ __forceinline__ void ph_dispatch_fast(const Params& p, int l, int nrows, char* lds) {
    const int tid_ = opq_tid(), bid_ = opq_bid(); (void)tid_; (void)bid_;
    const int RPG = router_rpg(nrows), nrg = nrows / RPG, e = tid_ & 31, part = tid_ >> 5;
    int* tot = (int*)lds; int* pst = tot + 32; int* pre = pst + 32; int* red = pre + 32;
    { int s = 0; for (int b = part; b < nrg; b += 8) s += p.hist[b * 32 + e]; red[part * 32 + e] = s; }
    __syncthreads();
    if (tid_ < 32) { int s = 0; for (int q = 0; q < 8; ++q) s += red[q * 32 + tid_]; tot[tid_] = s; }
    __syncthreads();
    if (tid_ < 32) { int s = 0; for (int j = 0; j < tid_; ++j) s += (tot[j] + 127) & ~127; pst[tid_] = s; if (bid_ == 0) p.cnt[l * NEXP + tid_] = tot[tid_]; }
    for (int rg = bid_; rg < nrg; rg += gridDim.x) {
        __syncthreads();
        { int s = 0; for (int b = part; b < rg; b += 8) s += p.hist[b * 32 + e]; red[part * 32 + e] = s; }
        __syncthreads();
        if (tid_ < 32) { int s = 0; for (int q = 0; q < 8; ++q) s += red[q * 32 + tid_]; pre[tid_] = s; }
        __syncthreads();
        if (tid_ < 2 * RPG) { const int i = 2 * (rg * RPG) + tid_, ee = p.rE[i], slot = pst[ee] + pre[ee] + p.rPos[i]; p.rSlot[i] = slot; p.slotTok[slot] = i >> 1; }
    }
}

__device__ __forceinline__ void ph_final_fast(const Params& p, int l, int nrows, bool next_h) {
    const int tid_ = opq_tid(), bid_ = opq_bid(); (void)tid_; (void)bid_;
    const int lane = tid_ & 63, gw = bid_ * 4 + (tid_ >> 6), nw = gridDim.x * 4;
    constexpr int R = 2;
    const f32x4* g2 = (const f32x4*)(p.ln2_g + (size_t)l * D) + lane; const f32x4* b2 = (const f32x4*)(p.ln2_b + (size_t)l * D) + lane;
    for (int m0 = gw * R; m0 < nrows; m0 += nw * R) {
        f32x4 v[R][DV]; float mu[R], rstd[R];
#pragma unroll
        for (int r = 0; r < R; ++r) { const int m = m0 + r; const f32x4* x1 = (const f32x4*)((m < TL) ? p.out + (size_t)m * D : p.XC + (size_t)(m - TL) * D) + lane;
            const f32x4* md = (const f32x4*)modrow(p, l, m) + lane;
            const bf16_t* ya = p.YSb + (size_t)p.rSlot[2 * m] * D + 4 * lane; const bf16_t* yb = p.YSb + (size_t)p.rSlot[2 * m + 1] * D + 4 * lane;
            const float wa = p.rW[2 * m], wb = p.rW[2 * m + 1];
#pragma unroll
            for (int j = 0; j < DV; ++j) v[r][j] = x1[64 * j] * ALPHA + md[5 * (D / 4) + 64 * j] * (ld_bf16x4(ya + 256 * j) * wa + ld_bf16x4(yb + 256 * j) * wb); }
#pragma unroll
        for (int r = 0; r < R; ++r) row_stats(v[r], mu[r], rstd[r]);
#pragma unroll
        for (int r = 0; r < R; ++r) { const int m = m0 + r; f32x4* x1 = (f32x4*)((m < TL) ? p.out + (size_t)m * D : p.XC + (size_t)(m - TL) * D) + lane;
#pragma unroll
            for (int j = 0; j < DV; ++j) { v[r][j] = (v[r][j] - mu[r]) * rstd[r] * g2[64 * j] + b2[64 * j]; x1[64 * j] = v[r][j]; } }
        if (next_h) {
#pragma unroll
            for (int r = 0; r < R; ++r) row_stats(v[r], mu[r], rstd[r]);
#pragma unroll
            for (int r = 0; r < R; ++r) { const int m = m0 + r; const f32x4* mn = (const f32x4*)modrow(p, l + 1, m) + lane;
#pragma unroll
                for (int j = 0; j < DV; ++j) st_bf16x4(p.H + (size_t)m * D + 4 * (lane + 64 * j), (v[r][j] - mu[r]) * rstd[r] * (mn[D / 4 + 64 * j] + 1.0f) + mn[64 * j]); }
        }
    }
}

__device__ __forceinline__ void ph_mod_fast(const Params& p, char* lds) {
    const int tid_ = opq_tid(), bid_ = opq_bid(); (void)tid_; (void)bid_;
    constexpr int NR = NB + 1, NTASK = 2 * (6 * D / 64);
    if (bid_ >= NTASK) return;
    float* sc = (float*)lds;
    float* part = sc + NR * D;
    for (int i = tid_; i < NR * D; i += 256) { const int b = i / D, k = i % D; const float cv = b < NB ? p.c[(size_t)b * D + k] : p.c_ctx[k]; sc[i] = cv / (1.0f + __expf(-cv)); }
    __syncthreads();
    const int lane = tid_ & 63, wid = tid_ >> 6;
    for (int task = bid_; task < NTASK; task += gridDim.x) {
        const int ll = task / (6 * D / 64), col = 64 * (task % (6 * D / 64)) + lane;
        float acc[NR];
#pragma unroll
        for (int b = 0; b < NR; ++b) acc[b] = 0.f;
        const float* wp = p.w_mod + ((size_t)ll * D + wid * (D / 4)) * 6 * D + col;
#pragma unroll 16
        for (int k = 0; k < D / 4; ++k) { const float w = wp[(size_t)k * 6 * D];
#pragma unroll
            for (int b = 0; b < NR; ++b) acc[b] += sc[b * D + wid * (D / 4) + k] * w; }
#pragma unroll
        for (int b = 0; b < NR; ++b) part[(wid * NR + b) * 64 + lane] = acc[b];
        __syncthreads();
        for (int i = tid_; i < NR * 64; i += 256) { const int b = i / 64, cl = i % 64;
            p.mod[((size_t)ll * NR + b) * 6 * D + 64 * (task % (6 * D / 64)) + cl] = (part[(0 * NR + b) * 64 + cl] + part[(1 * NR + b) * 64 + cl]) + (part[(2 * NR + b) * 64 + cl] + part[(3 * NR + b) * 64 + cl]) + p.b_mod[(size_t)ll * 6 * D + 64 * (task % (6 * D / 64)) + cl]; }
        __syncthreads();
    }
}

template <bool SPLIT = false>
__device__ __forceinline__ void tr_item(const float* srcl, size_t ldw, bf16_t* dst, size_t ldd, float* scr, int lane) {
    float v[32];
#pragma unroll
    for (int i = 0; i < 32; ++i) v[i] = srcl ? srcl[(size_t)(2 * i + (lane >> 5)) * ldw] : 0.f;
#pragma unroll
    for (int i = 0; i < 32; ++i) scr[(2 * i + (lane >> 5)) * 33 + (lane & 31)] = v[i];
    LDS_WAIT();
    const int c = lane & 7;
#pragma unroll
    for (int j = 0; j < 4; ++j) { const int n = (lane >> 3) + 8 * j; const float* s = scr + (8 * c) * 33 + n;
        uint4 o; o.x = pk2(s[0], s[33]); o.y = pk2(s[2 * 33], s[3 * 33]); o.z = pk2(s[4 * 33], s[5 * 33]); o.w = pk2(s[6 * 33], s[7 * 33]);
        *(uint4*)(dst + (size_t)(SPLIT ? (n & 15) + 32 * (n >> 4) : n) * ldd + 8 * c) = o; }
    LDS_WAIT();
}
__device__ __forceinline__ void ph_prep_w_fast(const Params& p, int l, int part, char* lds) {
    const int tid_ = opq_tid(), bid_ = opq_bid(); (void)tid_; (void)bid_;
    const int lane = tid_ & 63, wid = tid_ >> 6, gw = bid_ * 4 + wid, nw = gridDim.x * 4;
    float* scr = (float*)(lds + wid * 8448);
    constexpr int I_IN = (D / 64) * (NINP / 32), I_OUT = (DMIX / 64) * (D / 32), I_GU1 = (D / 64) * (2 * DE / 32), I_D1 = (DE / 64) * (D / 32);
    constexpr int NITEMS = I_IN + I_OUT + NEXP * (I_GU1 + I_D1);
    const int it0 = part == 0 ? 0 : I_IN + I_OUT, it1 = part == 0 ? I_IN + I_OUT : NITEMS;
    for (int it = it0 + gw; it < it1; it += nw) {
        int r = it;
        if (r < I_IN) { const int kb = r / (NINP / 32), n0 = 32 * (r % (NINP / 32));
            const float* s = nullptr;
            if (n0 < N_IN) { const int oc = (n0 < ZA) ? n0 + A_IN : n0 - ZA; s = p.w_in + ((size_t)l * D + 64 * kb) * N_IN + oc + (lane & 31); }
            tr_item(s, N_IN, p.win_t + (size_t)n0 * D + 64 * kb, D, scr, lane); continue; }
        r -= I_IN;
        if (r < I_OUT) { const int kb = r / (D / 32), n0 = 32 * (r % (D / 32));
            tr_item(p.w_out + ((size_t)l * DMIX + 64 * kb) * D + n0 + (lane & 31), D, p.wout_t + (size_t)n0 * DMIX + 64 * kb, DMIX, scr, lane); continue; }
        r -= I_OUT;
        const int e = r / (I_GU1 + I_D1); r %= (I_GU1 + I_D1);
        if (r < I_GU1) { const int kb = r / (2 * DE / 32), q = r % (2 * DE / 32), up = q & 1, c0 = 32 * (q >> 1);
            const float* s = (up ? p.w_up : p.w_gate) + (((size_t)l * NEXP + e) * D + 64 * kb) * DE + c0 + (lane & 31);
            tr_item<true>(s, DE, p.wgu_t + ((size_t)e * 2 * DE + 2 * c0 + 16 * up) * D + 64 * kb, D, scr, lane); continue; }
        r -= I_GU1;
        { const int kb = r / (D / 32), n0 = 32 * (r % (D / 32));
            tr_item(p.w_down + (((size_t)l * NEXP + e) * DE + 64 * kb) * D + n0 + (lane & 31), D, p.wd_t + ((size_t)e * D + n0) * DE + 64 * kb, DE, scr, lane); }
    }
    if (part != 0) return;
    const long gt = (long)bid_ * blockDim.x + tid_, gs = (long)gridDim.x * blockDim.x;
    for (long i = gt; i < 2 * 256 * 64; i += gs) { const int k = (int)(i & 63), n = (int)((i >> 6) & 255), d = (int)(i >> 14);
        p.wupT[i] = f2bf(p.a_w_up[(((size_t)l * 2 + d) * 64 + k) * DA + n]); p.aupT[i] = f2bf(p.a_a_up[(((size_t)l * 2 + d) * 64 + k) * DA + n]); }
    for (long i = gt; i < 256 * 160; i += gs) { const int k = (int)(i % 160), n = (int)(i / 160); p.gupT[i] = f2bf(p.a_g_up[((size_t)l * 160 + k) * DA + n]); }
    for (long i = gt; i < (long)128 * D; i += gs) { const int n = (int)(i / D), k = (int)(i % D);
        const float w = n < 4 ? p.w_rg[((size_t)l * D + k) * 4 + n] : n < 36 ? p.w_re[((size_t)l * D + k) * 32 + n - 4] : 0.f;
        const bf16_t hb = f2bf(w); p.wrt[i] = hb; p.wrt[(size_t)128 * D + i] = f2bf(w - bf2f(hb)); }
}

__device__ __forceinline__ float tanh_fast(float x) { return 1.0f - 2.0f / (1.0f + __expf(2.0f * x)); }
__device__ __forceinline__ void ph_streams_s1(const Params& p, int l) {
    const int tid_ = opq_tid(), bid_ = opq_bid(); (void)tid_; (void)bid_;
    constexpr int NCH = A_IN / 8, NCHP = (NCH + 7) & ~7;
    const float* sh = p.a_shift + (size_t)l * 3 * A_IN;
    for (long it = (long)bid_ * 256 + tid_; it < (long)T * NCHP; it += (long)gridDim.x * 256) {
        const int m = (int)(it / NCHP), ch = (int)(it % NCHP), c0 = 8 * ch;
        const bool act = ch < NCH;
        int t, len;
        if (m < TL) { t = m % S; len = S; } else { t = (m - TL) % L; len = L; }
        float v[8];
#pragma unroll
        for (int e = 0; e < 8; ++e) v[e] = 0.f;
        if (act) {
            const bf16_t* z = p.Z + (size_t)m * ZP + ZA + c0;
            const bf16x8 zc = *(const bf16x8*)z;
            const f32x4 s1a = *(const f32x4*)(sh + A_IN + c0), s1b = *(const f32x4*)(sh + A_IN + c0 + 4);
#pragma unroll
            for (int e = 0; e < 8; ++e) v[e] = (e < 4 ? s1a[e] : s1b[e - 4]) * bf2f((bf16_t)zc[e]);
            if (t > 0) { const bf16x8 zp = *(const bf16x8*)(z - ZP); const f32x4 a = *(const f32x4*)(sh + c0), b = *(const f32x4*)(sh + c0 + 4);
#pragma unroll
                for (int e = 0; e < 8; ++e) v[e] += (e < 4 ? a[e] : b[e - 4]) * bf2f((bf16_t)zp[e]); }
            if (t < len - 1) { const bf16x8 zn = *(const bf16x8*)(z + ZP); const f32x4 a = *(const f32x4*)(sh + 2 * A_IN + c0), b = *(const f32x4*)(sh + 2 * A_IN + c0 + 4);
#pragma unroll
                for (int e = 0; e < 8; ++e) v[e] += (e < 4 ? a[e] : b[e - 4]) * bf2f((bf16_t)zn[e]); }
        }
        float nrm = 0.f;
        if (ch >= 32 && ch < 64) {
#pragma unroll
            for (int e = 0; e < 8; ++e) { const float t2 = v[e] * p.a_k_k[l * DA + c0 - 256 + e]; nrm += t2 * t2; } }
        nrm = sum8(nrm);
        if (!act) continue;
        if (c0 < 768) {
            float* dst = (c0 < 256 ? p.sR + (size_t)m * DA + c0 : c0 < 512 ? p.kT + (size_t)m * DA + c0 - 256 : p.sV + (size_t)m * DA + c0 - 512);
            *(f32x4*)dst = (f32x4){v[0], v[1], v[2], v[3]}; *(f32x4*)(dst + 4) = (f32x4){v[4], v[5], v[6], v[7]};
            if (ch >= 32 && ch < 64 && (ch & 7) == 0) p.kN[(size_t)m * 4 + ((ch - 32) >> 3)] = 1.0f / sqrtf(nrm + 1e-12f);
        } else {
            if (c0 < 896) {
#pragma unroll
                for (int e = 0; e < 8; ++e) v[e] = tanh_fast(v[e]); }
            else if (c0 >= 1024) {
#pragma unroll
                for (int e = 0; e < 8; ++e) v[e] = 1.0f / (1.0f + __expf(-v[e])); }
            uint4 o; o.x = pk2(v[0], v[1]); o.y = pk2(v[2], v[3]); o.z = pk2(v[4], v[5]); o.w = pk2(v[6], v[7]);
            *(uint4*)(p.LA + (size_t)m * 416 + c0 - 768) = o;
        }
    }
}
__device__ __forceinline__ void g_streams_s2(const Params& p, int l, char* lds) {
    const int tid_ = opq_tid(), bid_ = opq_bid(); (void)tid_; (void)bid_;
    constexpr int MT = T / 128;
    for (int job = bid_; job < 5 * MT * 2; job += gridDim.x) {
        const int type = job / (MT * 2), r = job % (MT * 2), tm = r >> 1, tn = r & 1;
        const int coff = type < 2 ? type * 64 : type < 4 ? 128 + (type - 2) * 64 : 256, K = type < 4 ? 64 : 160, d = type & 1;
        const bf16_t* Bt = type < 2 ? p.wupT + type * 256 * 64 : type < 4 ? p.aupT + (type - 2) * 256 * 64 : p.gupT;
        const bf16_t* a0 = p.LA + (size_t)(tm * 128 + STG_ROW(0)) * 416 + coff + STG_K; const bf16_t* a1 = p.LA + (size_t)(tm * 128 + STG_ROW(1)) * 416 + coff + STG_K;
        const bf16_t* b0 = Bt + (size_t)(tn * 128 + STG_ROW(0)) * K + STG_K; const bf16_t* b1 = Bt + (size_t)(tn * 128 + STG_ROW(1)) * K + STG_K;
        if (type < 2) gemm_tile(a0, a1, b0, b1, K, lds, [&](const f32x4 (&acc)[4][4], int wr, int wc, int fr, int fq) {
#pragma unroll
            for (int mi = 0; mi < 4; ++mi) { const int row = tm * 128 + wr * 64 + mi * 16 + fr;
#pragma unroll
                for (int n = 0; n < 4; ++n) { const int c = tn * 128 + wc * 64 + n * 16 + 4 * fq; const f32x4 w0 = *(const f32x4*)(p.a_w0 + (l * 2 + d) * DA + c); f32x4 o;
#pragma unroll
                    for (int e4 = 0; e4 < 4; ++e4) { const float ex = __expf(-(w0[e4] + acc[mi][n][e4]));
                        o[e4] = __expf(-0.60653065971f / (1.0f + ex)); }
                    *(f32x4*)(p.sW + ((size_t)d * T + row) * DA + c) = o; }
                asm volatile("" ::: "memory"); }
        });
        else if (type < 4) gemm_tile(a0, a1, b0, b1, K, lds, [&](const f32x4 (&acc)[4][4], int wr, int wc, int fr, int fq) {
#pragma unroll
            for (int mi = 0; mi < 4; ++mi) { const int row = tm * 128 + wr * 64 + mi * 16 + fr;
#pragma unroll
                for (int n = 0; n < 4; ++n) { const int c = tn * 128 + wc * 64 + n * 16 + 4 * fq;
                    const f32x4 a0v = *(const f32x4*)(p.a_a0 + (l * 2 + d) * DA + c), kkc = *(const f32x4*)(p.a_k_k + l * DA + c), kac = *(const f32x4*)(p.a_k_a + l * DA + c);
                    const size_t o = (size_t)row * DA + c, od = ((size_t)d * T + row) * DA + c;
                    const f32x4 k = *(const f32x4*)(p.kT + o); const float kn = p.kN[(size_t)row * 4 + (c >> 6)];
                    f32x4 kd, bo, kk;
#pragma unroll
                    for (int e4 = 0; e4 < 4; ++e4) { const float av = 1.0f / (1.0f + __expf(-(a0v[e4] + acc[mi][n][e4])));
                        kk[e4] = k[e4] * kkc[e4] * kn; kd[e4] = k[e4] * (1.0f + (av - 1.0f) * kac[e4]); bo[e4] = kk[e4] * av; }
                    *(f32x4*)(p.sKD + od) = kd; *(f32x4*)(p.sB + od) = bo; if (d == 0) *(f32x4*)(p.sKK + o) = kk; }
                asm volatile("" ::: "memory"); }
        });
        else gemm_tile(a0, a1, b0, b1, K, lds, [&](const f32x4 (&acc)[4][4], int wr, int wc, int fr, int fq) {
#pragma unroll
            for (int mi = 0; mi < 4; ++mi)
#pragma unroll
                for (int n = 0; n < 4; ++n) st_bf16x4(p.MIX + (size_t)(tm * 128 + wr * 64 + mi * 16 + fr) * DMIX + tn * 128 + wc * 64 + n * 16 + 4 * fq, acc[mi][n]);
        });
    }
}


typedef float f32x16 __attribute__((ext_vector_type(16)));
typedef short s16x4 __attribute__((ext_vector_type(4)));
typedef unsigned u32x4_t __attribute__((ext_vector_type(4)));
typedef float f32x2_t __attribute__((ext_vector_type(2)));
typedef __bf16 bf16x2_t __attribute__((ext_vector_type(2)));
__device__ __forceinline__ unsigned cvtpk(float lo, float hi) { f32x2_t v = {lo, hi}; bf16x2_t b = __builtin_convertvector(v, bf16x2_t); return __builtin_bit_cast(unsigned, b); }
__device__ __forceinline__ int crow(int r, int hi) { return (r & 3) + 8 * (r >> 2) + 4 * hi; }
__device__ __forceinline__ float xmax32(float v) { float a = v, b = v; asm volatile("s_nop 1\n\tv_permlane32_swap_b32 %0, %1" : "+v"(a), "+v"(b)); return fmaxf(a, b); }
__device__ __forceinline__ float xsum32(float v) { float a = v, b = v; asm volatile("s_nop 1\n\tv_permlane32_swap_b32 %0, %1" : "+v"(a), "+v"(b)); return a + b; }

template <class MaskF>
__device__ __forceinline__ void attn_tile(const bf16x8 (&qf)[4], const bf16_t* krow, const bf16_t* vt0, const bf16_t* vt1, const MaskF& mask,
                                          float& m_run, float& l_run, f32x16& o0, f32x16& o1, int hi) {
    f32x16 s;
#pragma unroll
    for (int r = 0; r < 16; ++r) s[r] = 0.f;
#pragma unroll
    for (int ks = 0; ks < 4; ++ks) { const bf16x8 kf = *(const bf16x8*)(krow + 16 * ks); s = __builtin_amdgcn_mfma_f32_32x32x16_bf16(kf, qf[ks], s, 0, 0, 0); }
    float mx = -INFINITY;
#pragma unroll
    for (int r = 0; r < 16; ++r) { s[r] = mask(crow(r, hi), s[r] * ATT_SCALE); mx = fmaxf(mx, s[r]); }
    mx = xmax32(mx);
    const float mn = fmaxf(m_run, mx), alpha = __expf(m_run - mn);
    m_run = mn;
    float ps = 0.f;
#pragma unroll
    for (int r = 0; r < 16; ++r) { s[r] = __expf(s[r] - mn); ps += s[r]; }
    l_run = l_run * alpha + ps;
#pragma unroll
    for (int r = 0; r < 16; ++r) { o0[r] *= alpha; o1[r] *= alpha; }
#pragma unroll
    for (int s2 = 0; s2 < 2; ++s2) {
        u32x4_t pw; pw[0] = cvtpk(s[8 * s2], s[8 * s2 + 1]); pw[1] = cvtpk(s[8 * s2 + 2], s[8 * s2 + 3]); pw[2] = cvtpk(s[8 * s2 + 4], s[8 * s2 + 5]); pw[3] = cvtpk(s[8 * s2 + 6], s[8 * s2 + 7]);
        const bf16x8 pb = __builtin_bit_cast(bf16x8, pw);
        const s16x4 a0 = *(const s16x4*)(vt0 + 16 * s2), a1 = *(const s16x4*)(vt0 + 16 * s2 + 8);
        const s16x4 c0 = *(const s16x4*)(vt1 + 16 * s2), c1 = *(const s16x4*)(vt1 + 16 * s2 + 8);
        o0 = __builtin_amdgcn_mfma_f32_32x32x16_bf16(__builtin_shufflevector(a0, a1, 0, 1, 2, 3, 4, 5, 6, 7), pb, o0, 0, 0, 0);
        o1 = __builtin_amdgcn_mfma_f32_32x32x16_bf16(__builtin_shufflevector(c0, c1, 0, 1, 2, 3, 4, 5, 6, 7), pb, o1, 0, 0, 0);
    }
}
struct NoMask { __device__ __forceinline__ float operator()(int, float v) const { return v; } };

__device__ __forceinline__ void ph_attn_mfma(const Params& p, int l, bool with_ctx) {
    const int tid_ = opq_tid(), bid_ = opq_bid(); (void)tid_; (void)bid_;
    const int lane = tid_ & 63, hi = lane >> 5, ql = lane & 31;
    const int gw = bid_ * 4 + (tid_ >> 6), nw = gridDim.x * 4;
    constexpr int NQT = S / 32, NCT = L / 32, N_LAT = NB * 6 * NQT, N_CTX = NB * 6 * NCT;
    const int ntask = 2 * N_LAT + (with_ctx ? 2 * N_CTX : 0);
    for (int task = gw; task < ntask; task += nw) {
        bool isC, isCtx; int r;
        if (task < N_LAT) { isC = true; isCtx = false; r = task; }
        else if (task < 2 * N_LAT) { isC = false; isCtx = false; r = task - N_LAT; }
        else { r = task - 2 * N_LAT; isCtx = true; isC = r >= N_CTX; if (isC) r -= N_CTX; }
        const int nqt = isCtx ? NCT : NQT, qt = r % nqt, h = (r / nqt) % 6, b = r / (nqt * 6);
        const int m = isCtx ? TL + b * L + 32 * qt + ql : b * S + 32 * qt + ql;
        const int qcol = isC ? ZQN + h * 64 : ZQB + h * 64, kcol = isC ? ZKN + h * 64 : ZKB + (h / 3) * 64, hv = isC ? 2 + h : h / 3;
        bf16x8 qf[4];
        { const bf16_t* qp = p.Z + (size_t)m * ZP + qcol + 8 * hi;
#pragma unroll
          for (int ks = 0; ks < 4; ++ks) qf[ks] = *(const bf16x8*)(qp + 16 * ks); }
        const bf16_t* kc0 = p.Z + (size_t)(TL + b * L + ql) * ZP + kcol + 8 * hi;
        const bf16_t* kl0 = p.Z + (size_t)(b * S + ql) * ZP + kcol + 8 * hi;
        const bf16_t* vt0 = p.VT + ((size_t)(b * 8 + hv) * 64 + ql) * PU + 4 * hi; const bf16_t* vt1 = vt0 + (size_t)32 * PU;
        f32x16 o0, o1;
#pragma unroll
        for (int rr = 0; rr < 16; ++rr) { o0[rr] = 0.f; o1[rr] = 0.f; }
        float m_run, l_run;
        if (isC) { m_run = -1e30f; l_run = 0.f; } else { m_run = p.b_sink[l * 6 + h]; l_run = hi == 0 ? 1.0f : 0.f; }
#pragma unroll 1
        for (int i = 0; i < NCT; ++i) attn_tile(qf, kc0 + (size_t)(32 * i) * ZP, vt0 + 32 * i, vt1 + 32 * i, NoMask(), m_run, l_run, o0, o1, hi);
        if (!isCtx) {
            if (!isC) {
#pragma unroll 1
                for (int jt = qt - 4; jt <= qt + 4; ++jt) {
                    if (jt < 0 || jt >= NQT) continue;
                    const bf16_t* kr = kl0 + (size_t)(32 * jt) * ZP; const bf16_t* v0 = vt0 + L + 32 * jt; const bf16_t* v1 = vt1 + L + 32 * jt;
                    if (jt == qt - 4 || jt == qt + 4) { const int base = 32 * (jt - qt) - ql;
                        attn_tile(qf, kr, v0, v1, [&](int ko, float v) { const int rel = base + ko; return (rel >= -128 && rel <= 128) ? v : -INFINITY; }, m_run, l_run, o0, o1, hi); }
                    else attn_tile(qf, kr, v0, v1, NoMask(), m_run, l_run, o0, o1, hi);
                }
            } else {
                constexpr int ROWS = S / GRID_W;
                const int gr = qt >> 1, c = 32 * (qt & 1) + ql;
                int r0 = gr - 4; r0 = r0 < 0 ? 0 : (r0 > ROWS - 8 ? ROWS - 8 : r0);
                int c0 = c - 8; c0 = c0 < 0 ? 0 : (c0 > GRID_W - 16 ? GRID_W - 16 : c0);
                const float* rpb = p.c_rpb + ((size_t)l * 6 + h) * 15 * 31;
#pragma unroll 1
                for (int a = 0; a < 8; ++a) {
                    const int kr_ = r0 + a; const float* rp = rpb + (kr_ - gr + 7) * 31 + 15 - c;
#pragma unroll 1
                    for (int ct = 0; ct < 2; ++ct) {
                        const int t0 = kr_ * GRID_W + 32 * ct;
                        attn_tile(qf, kl0 + (size_t)t0 * ZP, vt0 + L + t0, vt1 + L + t0,
                                  [&](int ko, float v) { const int kc = 32 * ct + ko; return (kc >= c0 && kc < c0 + 16) ? v + rp[kc] : -INFINITY; }, m_run, l_run, o0, o1, hi);
                    }
                }
            }
        }
        const float lt = xsum32(l_run), inv = 1.0f / lt;
        bf16_t* op = p.MIX + (size_t)m * DMIX + (isC ? 640 : 256) + h * 64 + 4 * hi;
#pragma unroll
        for (int g = 0; g < 4; ++g) {
            st_bf16x4(op + 8 * g, (f32x4){o0[4 * g] * inv, o0[4 * g + 1] * inv, o0[4 * g + 2] * inv, o0[4 * g + 3] * inv});
            st_bf16x4(op + 32 + 8 * g, (f32x4){o1[4 * g] * inv, o1[4 * g + 1] * inv, o1[4 * g + 2] * inv, o1[4 * g + 3] * inv});
        }
    }
}


template <class MaskF>
__device__ __forceinline__ void attn_tile_lds(const bf16x8 (&qf)[4], const char* ks, const char* vs, const MaskF& mask, float& m_run, float& l_run, f32x16& o0, f32x16& o1, int ql, int hi) {
    f32x16 s;
#pragma unroll
    for (int r = 0; r < 16; ++r) s[r] = 0.f;
#pragma unroll
    for (int k4 = 0; k4 < 4; ++k4) { const bf16x8 kf = *(const bf16x8*)(ks + ql * 128 + (((2 * k4 + hi) ^ (ql & 7)) * 16)); s = __builtin_amdgcn_mfma_f32_32x32x16_bf16(kf, qf[k4], s, 0, 0, 0); }
    float mx = -INFINITY;
#pragma unroll
    for (int r = 0; r < 16; ++r) { s[r] = mask(crow(r, hi), s[r] * ATT_SCALE); mx = fmaxf(mx, s[r]); }
    mx = xmax32(mx);
    const float mn = fmaxf(m_run, mx), alpha = __expf(m_run - mn);
    m_run = mn;
    float ps = 0.f;
#pragma unroll
    for (int r = 0; r < 16; ++r) { s[r] = __expf(s[r] - mn); ps += s[r]; }
    l_run = l_run * alpha + ps;
#pragma unroll
    for (int r = 0; r < 16; ++r) { o0[r] *= alpha; o1[r] *= alpha; }
    const int sw0 = (ql >> 2) & 3;
#pragma unroll
    for (int s2 = 0; s2 < 2; ++s2) {
        u32x4_t pw; pw[0] = cvtpk(s[8 * s2], s[8 * s2 + 1]); pw[1] = cvtpk(s[8 * s2 + 2], s[8 * s2 + 3]); pw[2] = cvtpk(s[8 * s2 + 4], s[8 * s2 + 5]); pw[3] = cvtpk(s[8 * s2 + 6], s[8 * s2 + 7]);
        const bf16x8 pb = __builtin_bit_cast(bf16x8, pw);
        const char* v0 = vs + ql * 64 + 8 * hi; const char* v1 = v0 + 32 * 64;
        const s16x4 a0 = *(const s16x4*)(v0 + (((2 * s2) ^ sw0) * 16)), a1 = *(const s16x4*)(v0 + (((2 * s2 + 1) ^ sw0) * 16));
        const s16x4 c0 = *(const s16x4*)(v1 + (((2 * s2) ^ sw0) * 16)), c1 = *(const s16x4*)(v1 + (((2 * s2 + 1) ^ sw0) * 16));
        o0 = __builtin_amdgcn_mfma_f32_32x32x16_bf16(__builtin_shufflevector(a0, a1, 0, 1, 2, 3, 4, 5, 6, 7), pb, o0, 0, 0, 0);
        o1 = __builtin_amdgcn_mfma_f32_32x32x16_bf16(__builtin_shufflevector(c0, c1, 0, 1, 2, 3, 4, 5, 6, 7), pb, o1, 0, 0, 0);
    }
}

__device__ __forceinline__ void ph_attn_blk(const Params& p, int l, bool with_ctx, int first_blk, char* lds) {
    const int tid_ = opq_tid(), bid_ = opq_bid(); (void)tid_; (void)bid_;
    if (bid_ < first_blk) return;
    const int lane = tid_ & 63, hi = lane >> 5, ql = lane & 31, wid = tid_ >> 6;
    constexpr int NQG = S / 128, NCG = L / 128, ROWS = S / GRID_W, N_LAT = NB * 6 * NQG, N_CTX = NB * 6 * NCG, TPB = (S + L) / 32;
    const int ntask = 2 * N_LAT + (with_ctx ? 2 * N_CTX : 0);
    const int krow = tid_ >> 3, kch = (tid_ & 7) ^ (krow & 7), vrow = tid_ >> 2, vpc = (tid_ & 3) ^ ((vrow >> 2) & 3);
    for (int task = bid_ - first_blk; task < ntask; task += gridDim.x - first_blk) {
        bool isC, isCtx; int r;
        if (task < N_LAT) { isC = true; isCtx = false; r = task; }
        else if (task < 2 * N_LAT) { isC = false; isCtx = false; r = task - N_LAT; }
        else { r = task - 2 * N_LAT; isCtx = true; isC = r >= N_CTX; if (isC) r -= N_CTX; }
        const int ng = isCtx ? NCG : NQG, g = r % ng, h = (r / ng) % 6, b = r / (ng * 6);
        const int qt = 4 * g + wid;
        const int m = isCtx ? TL + b * L + 32 * qt + ql : b * S + 32 * qt + ql;
        const int qcol = isC ? ZQN + h * 64 : ZQB + h * 64, kcol = isC ? ZKN + h * 64 : ZKB + (h / 3) * 64, hv = isC ? 2 + h : h / 3;
        bf16x8 qf[4];
        { const bf16_t* qp = p.Z + (size_t)m * ZP + qcol + 8 * hi;
#pragma unroll
          for (int k4 = 0; k4 < 4; ++k4) qf[k4] = *(const bf16x8*)(qp + 16 * k4); }
        int lo = 0, hi_t = 0, gr0 = 0;
        if (!isCtx) {
            if (!isC) { lo = 4 * g - 4; hi_t = 4 * g + 8; lo = lo < 0 ? 0 : lo; hi_t = hi_t > S / 32 ? S / 32 : hi_t; }
            else { const int ra = 2 * g, rb = 2 * g + 1; int r0a = ra - 4; r0a = r0a < 0 ? 0 : (r0a > ROWS - 8 ? ROWS - 8 : r0a); int r0b = rb - 4; r0b = r0b < 0 ? 0 : (r0b > ROWS - 8 ? ROWS - 8 : r0b);
                   lo = 2 * r0a; hi_t = 2 * (r0b + 8); gr0 = 0; }
        }
        const int ntile = L / 32 + (hi_t - lo);
        const bf16_t* kbase = p.Z + (size_t)krow * ZP + kcol + 8 * kch;
        const bf16_t* vbase = p.VT + ((size_t)(b * 8 + hv) * 64 + vrow) * PU + 8 * vpc;
#define AT_TOK(i_) ((i_) < L / 32 ? 32 * (i_) : L + 32 * (lo + (i_) - L / 32))
#define AT_STAGE(i_) do { const int u0_ = AT_TOK(i_); const int zrow_ = u0_ < L ? TL + b * L + u0_ : b * S + (u0_ - L); char* sl_ = lds + ((i_) % 3) * 8192 + tid_ * 16; \
            __builtin_amdgcn_global_load_lds((const unsigned*)(kbase + (size_t)zrow_ * ZP), (__attribute__((address_space(3))) unsigned*)(sl_), 16, 0, 0); \
            __builtin_amdgcn_global_load_lds((const unsigned*)(vbase + u0_), (__attribute__((address_space(3))) unsigned*)(sl_ + 4096), 16, 0, 0); } while (0)
        f32x16 o0, o1;
#pragma unroll
        for (int rr = 0; rr < 16; ++rr) { o0[rr] = 0.f; o1[rr] = 0.f; }
        float m_run, l_run;
        if (isC) { m_run = -1e30f; l_run = 0.f; } else { m_run = p.b_sink[l * 6 + h]; l_run = hi == 0 ? 1.0f : 0.f; }
        const int gr = qt >> 1, c = 32 * (qt & 1) + ql;
        int r0 = gr - 4; r0 = r0 < 0 ? 0 : (r0 > ROWS - 8 ? ROWS - 8 : r0);
        int c0 = c - 8; c0 = c0 < 0 ? 0 : (c0 > GRID_W - 16 ? GRID_W - 16 : c0);
        float* rpb = (float*)(lds + 24576);
        if (isC && !isCtx) for (int i = tid_; i < 15 * 31; i += 256) rpb[i] = p.c_rpb[((size_t)l * 6 + h) * 15 * 31 + i];
        AT_STAGE(0);
        if (ntile > 1) AT_STAGE(1);
#pragma unroll 1
        for (int i = 0; i < ntile; ++i) {
            if (i + 1 < ntile) asm volatile("s_waitcnt vmcnt(2)" ::: "memory"); else asm volatile("s_waitcnt vmcnt(0)" ::: "memory");
            asm volatile("s_waitcnt lgkmcnt(0)" ::: "memory");
            __builtin_amdgcn_s_barrier();
            if (i + 2 < ntile) AT_STAGE(i + 2);
            const char* ks = lds + (i % 3) * 8192; const char* vs = ks + 4096;
            if (i < L / 32) attn_tile_lds(qf, ks, vs, NoMask(), m_run, l_run, o0, o1, ql, hi);
            else {
                const int jt = lo + i - L / 32;
                if (!isC) {
                    const int dq = jt - qt;
                    if (dq >= -3 && dq <= 3) attn_tile_lds(qf, ks, vs, NoMask(), m_run, l_run, o0, o1, ql, hi);
                    else if (dq == -4 || dq == 4) { const int base = 32 * dq - ql;
                        attn_tile_lds(qf, ks, vs, [&](int ko, float v) { const int rel = base + ko; return (rel >= -128 && rel <= 128) ? v : -INFINITY; }, m_run, l_run, o0, o1, ql, hi); }
                } else {
                    const int kr_ = jt >> 1, ct = jt & 1;
                    if (kr_ >= r0 && kr_ < r0 + 8) { const float* rp = rpb + (kr_ - gr + 7) * 31 + 15 - c;
                        attn_tile_lds(qf, ks, vs, [&](int ko, float v) { const int kc = 32 * ct + ko; return (kc >= c0 && kc < c0 + 16) ? v + rp[kc] : -INFINITY; }, m_run, l_run, o0, o1, ql, hi); }
                }
            }
        }
        asm volatile("s_waitcnt lgkmcnt(0)" ::: "memory");
        __builtin_amdgcn_s_barrier();
#undef AT_STAGE
#undef AT_TOK
        (void)gr0;
        const float lt = xsum32(l_run), inv = 1.0f / lt;
        bf16_t* op = p.MIX + (size_t)m * DMIX + (isC ? 640 : 256) + h * 64 + 4 * hi;
#pragma unroll
        for (int gq = 0; gq < 4; ++gq) {
            st_bf16x4(op + 8 * gq, (f32x4){o0[4 * gq] * inv, o0[4 * gq + 1] * inv, o0[4 * gq + 2] * inv, o0[4 * gq + 3] * inv});
            st_bf16x4(op + 32 + 8 * gq, (f32x4){o1[4 * gq] * inv, o1[4 * gq + 1] * inv, o1[4 * gq + 2] * inv, o1[4 * gq + 3] * inv});
        }
    }
}

#define RNB " row_newbcast:%c[n] row_mask:0xf bank_mask:0xf\n\t"
template <int N, bool FIRST>
__device__ __forceinline__ void dpp_dot4(float& a0, float& a1, float& a2, float& a3, const f32x4& v, float s0, float s1, float s2, float s3) {
    if (FIRST) asm volatile("s_nop 1");
    asm("v_fmac_f32_dpp %0, %4, %8" RNB "v_fmac_f32_dpp %1, %5, %9" RNB "v_fmac_f32_dpp %2, %6, %10" RNB "v_fmac_f32_dpp %3, %7, %11" RNB
        : "+v"(a0), "+v"(a1), "+v"(a2), "+v"(a3) : "v"(v[0]), "v"(v[1]), "v"(v[2]), "v"(v[3]), "v"(s0), "v"(s1), "v"(s2), "v"(s3), [n] "i"(N));
}
template <int N, bool FIRST>
__device__ __forceinline__ void dpp_upd4s(float& s0, float& s1, float& s2, float& s3, float& y0, float& y1, float& y2, float& y3,
                                          const f32x4& w, const f32x4& b, const f32x4& kd, const f32x4& r, float nsk, float vv) {
    if (FIRST) asm volatile("s_nop 1");
    asm("v_mul_f32_dpp %0, %8, %0" RNB "v_mul_f32_dpp %1, %9, %1" RNB "v_mul_f32_dpp %2, %10, %2" RNB "v_mul_f32_dpp %3, %11, %3" RNB
        "v_fmac_f32_dpp %0, %12, %24" RNB "v_fmac_f32_dpp %1, %13, %24" RNB "v_fmac_f32_dpp %2, %14, %24" RNB "v_fmac_f32_dpp %3, %15, %24" RNB
        "v_fmac_f32_dpp %0, %16, %25" RNB "v_fmac_f32_dpp %1, %17, %25" RNB "v_fmac_f32_dpp %2, %18, %25" RNB "v_fmac_f32_dpp %3, %19, %25" RNB
        "v_fmac_f32_dpp %4, %20, %0" RNB "v_fmac_f32_dpp %5, %21, %1" RNB "v_fmac_f32_dpp %6, %22, %2" RNB "v_fmac_f32_dpp %7, %23, %3" RNB
        : "+v"(s0), "+v"(s1), "+v"(s2), "+v"(s3), "+v"(y0), "+v"(y1), "+v"(y2), "+v"(y3)
        : "v"(w[0]), "v"(w[1]), "v"(w[2]), "v"(w[3]), "v"(b[0]), "v"(b[1]), "v"(b[2]), "v"(b[3]), "v"(kd[0]), "v"(kd[1]), "v"(kd[2]), "v"(kd[3]),
          "v"(r[0]), "v"(r[1]), "v"(r[2]), "v"(r[3]), "v"(nsk), "v"(vv), [n] "i"(N));
}
template <int N, bool FIRST>
__device__ __forceinline__ void dpp_upd4p(float& s0, float& s1, float& s2, float& s3, float& y0, float& y1, float& y2, float& y3,
                                          const f32x4& w, const f32x4& b, const f32x4& r, float nsk) {
    if (FIRST) asm volatile("s_nop 1");
    asm("v_mul_f32_dpp %0, %8, %0" RNB "v_mul_f32_dpp %1, %9, %1" RNB "v_mul_f32_dpp %2, %10, %2" RNB "v_mul_f32_dpp %3, %11, %3" RNB
        "v_fmac_f32_dpp %0, %12, %20" RNB "v_fmac_f32_dpp %1, %13, %20" RNB "v_fmac_f32_dpp %2, %14, %20" RNB "v_fmac_f32_dpp %3, %15, %20" RNB
        "v_fmac_f32_dpp %4, %16, %0" RNB "v_fmac_f32_dpp %5, %17, %1" RNB "v_fmac_f32_dpp %6, %18, %2" RNB "v_fmac_f32_dpp %7, %19, %3" RNB
        : "+v"(s0), "+v"(s1), "+v"(s2), "+v"(s3), "+v"(y0), "+v"(y1), "+v"(y2), "+v"(y3)
        : "v"(w[0]), "v"(w[1]), "v"(w[2]), "v"(w[3]), "v"(b[0]), "v"(b[1]), "v"(b[2]), "v"(b[3]), "v"(r[0]), "v"(r[1]), "v"(r[2]), "v"(r[3]), "v"(nsk), [n] "i"(N));
}
template <int N, bool FIRST>
__device__ __forceinline__ void dpp_mul4(float& s0, float& s1, float& s2, float& s3, const f32x4& v) {
    if (FIRST) asm volatile("s_nop 1");
    asm("v_mul_f32_dpp %0, %4, %0" RNB "v_mul_f32_dpp %1, %5, %1" RNB "v_mul_f32_dpp %2, %6, %2" RNB "v_mul_f32_dpp %3, %7, %3" RNB
        : "+v"(s0), "+v"(s1), "+v"(s2), "+v"(s3) : "v"(v[0]), "v"(v[1]), "v"(v[2]), "v"(v[3]), [n] "i"(N));
}
template <int N>
__device__ __forceinline__ void dpp_fmacx4(float& s0, float& s1, float& s2, float& s3, const f32x4& v, float x) {
    asm("v_fmac_f32_dpp %0, %4, %8" RNB "v_fmac_f32_dpp %1, %5, %8" RNB "v_fmac_f32_dpp %2, %6, %8" RNB "v_fmac_f32_dpp %3, %7, %8" RNB
        : "+v"(s0), "+v"(s1), "+v"(s2), "+v"(s3) : "v"(v[0]), "v"(v[1]), "v"(v[2]), "v"(v[3]), "v"(x), [n] "i"(N));
}
template <int N> struct ScanRep {
    static __device__ __forceinline__ void dot8(float (&a)[8], const f32x4& v, const float (&st)[64]) {
        constexpr int h = (N & 1) * 4;
        dpp_dot4<N, N == 0>(a[h], a[h + 1], a[h + 2], a[h + 3], v, st[4 * N], st[4 * N + 1], st[4 * N + 2], st[4 * N + 3]);
        if constexpr (N < 15) ScanRep<N + 1>::dot8(a, v, st);
    }
    static __device__ __forceinline__ void dot(float& a0, float& a1, float& a2, float& a3, const f32x4& v, const float (&st)[64]) {
        dpp_dot4<N, N == 0>(a0, a1, a2, a3, v, st[4 * N], st[4 * N + 1], st[4 * N + 2], st[4 * N + 3]);
        if constexpr (N < 15) ScanRep<N + 1>::dot(a0, a1, a2, a3, v, st);
    }
    static __device__ __forceinline__ void mul(float (&st)[64], const f32x4& w) {
        dpp_mul4<N, N == 0>(st[4 * N], st[4 * N + 1], st[4 * N + 2], st[4 * N + 3], w);
        if constexpr (N < 15) ScanRep<N + 1>::mul(st, w);
    }
    static __device__ __forceinline__ void fmacx(float (&st)[64], const f32x4& v, float x) {
        dpp_fmacx4<N>(st[4 * N], st[4 * N + 1], st[4 * N + 2], st[4 * N + 3], v, x);
        if constexpr (N < 15) ScanRep<N + 1>::fmacx(st, v, x);
    }
};
__device__ __forceinline__ int scan_row(int b, int d, int pos) { return pos < L ? TL + b * L + (d ? L - 1 - pos : pos) : b * S + (d ? S - 1 - (pos - L) : pos - L); }

template <bool ISP>
__device__ __forceinline__ void scan_task(const Params& p, int c, int s, int lane) {
    const int h = c & 3, b = (c >> 2) % NB, d = (c >> 2) / NB, pos0 = SEGLEN * s;
    const int q = 4 * (lane & 15);
    const float* bkk = p.sKK + h * 64 + q; const float* br = p.sR + h * 64 + q; const float* bw = p.sW + (size_t)d * T * DA + h * 64 + q; const float* bb_ = p.sB + (size_t)d * T * DA + h * 64 + q;
    const float* bkd = p.sKD + (size_t)d * T * DA + h * 64 + q; const float* bv = p.sV + h * 64 + lane;
    float* by = (ISP ? p.PV : p.Y) + (size_t)d * T * DA + h * 64 + lane;
    float st[64];
#pragma unroll
    for (int k = 0; k < 64; ++k) st[k] = (ISP && k == lane) ? 1.0f : 0.f;
    size_t mo = (size_t)scan_row(b, d, pos0) * DA;
    f32x4 kk = *(const f32x4*)(bkk + mo), w = *(const f32x4*)(bw + mo), bb = *(const f32x4*)(bb_ + mo), r = *(const f32x4*)(br + mo), kd = w; float vv = 0.f;
    if (!ISP) { kd = *(const f32x4*)(bkd + mo); vv = bv[mo]; }
#pragma unroll 1
    for (int i = 0; i < SEGLEN; ++i) {
        const size_t mn = (size_t)scan_row(b, d, pos0 + (i + 1 < SEGLEN ? i + 1 : i)) * DA;
        const f32x4 nkk = *(const f32x4*)(bkk + mn), nw = *(const f32x4*)(bw + mn), nb = *(const f32x4*)(bb_ + mn), nr = *(const f32x4*)(br + mn);
        f32x4 nkd = nw; float nv = 0.f;
        if (!ISP) { nkd = *(const f32x4*)(bkd + mn); nv = bv[mn]; }
        float a[8] = {0.f, 0.f, 0.f, 0.f, 0.f, 0.f, 0.f, 0.f};
        ScanRep<0>::dot8(a, kk, st);
        const float nsk = -(((a[0] + a[1]) + (a[2] + a[3])) + ((a[4] + a[5]) + (a[6] + a[7])));
        ScanRep<0>::mul(st, w);
        ScanRep<0>::fmacx(st, bb, nsk);
        if (!ISP) ScanRep<0>::fmacx(st, kd, vv);
        float y[8] = {0.f, 0.f, 0.f, 0.f, 0.f, 0.f, 0.f, 0.f};
        ScanRep<0>::dot8(y, r, st);
        by[mo] = ((y[0] + y[1]) + (y[2] + y[3])) + ((y[4] + y[5]) + (y[6] + y[7]));
        kk = nkk; w = nw; bb = nb; r = nr; kd = nkd; vv = nv; mo = mn;
    }
    if (s < NSG - 1) {
        float* dst = (ISP ? p.PS : p.QS) + (((size_t)c * NSG + s) * 64 + lane) * 64;
#pragma unroll
        for (int k4 = 0; k4 < 16; ++k4) *(f32x4*)(dst + 4 * k4) = (f32x4){st[4 * k4], st[4 * k4 + 1], st[4 * k4 + 2], st[4 * k4 + 3]};
    }
}
__device__ __forceinline__ void ph_scan_fast(const Params& p) {
    const int tid_ = opq_tid(), bid_ = opq_bid(); (void)tid_; (void)bid_;
    const int lane = tid_ & 63, gw = bid_ * 4 + (tid_ >> 6), nw = gridDim.x * 4;
    constexpr int NS_T = 64 * NSG, NP_T = 64 * (NSG - 1);
    const int G = gridDim.x, wv = tid_ >> 6; (void)gw; (void)nw;
    for (int tsk = wv * G + bid_; tsk < NS_T + NP_T; tsk += 4 * G) {
        const int t2 = __builtin_amdgcn_readfirstlane(tsk);
        if (t2 < NS_T) scan_task<false>(p, t2 & 63, t2 >> 6, lane);
        else scan_task<true>(p, (t2 - NS_T) & 63, 1 + ((t2 - NS_T) >> 6), lane);
    }
}
__device__ __forceinline__ void ph_combine(const Params& p, char* lds) {
    const int tid_ = opq_tid(), bid_ = opq_bid(); (void)tid_; (void)bid_; (void)lds;
    if (bid_ >= 64) return;
    const int lane = tid_ & 63, c = bid_, cb = tid_ >> 6, q = lane >> 4, i16 = lane & 15, v = 16 * cb + i16;
    const float* QSc = p.QS + (size_t)c * NSG * 4096; const float* PSc = p.PS + (size_t)c * NSG * 4096; float* SSg = p.SS + (size_t)c * NSG * 4096;
    f32x4 acc[4];
#pragma unroll
    for (int ro = 0; ro < 4; ++ro) acc[ro] = *(const f32x4*)(QSc + v * 64 + 16 * ro + 4 * q);
#pragma unroll 1
    for (int s = 1; s < NSG; ++s) {
#pragma unroll
        for (int ro = 0; ro < 4; ++ro)
#pragma unroll
            for (int j = 0; j < 4; ++j) SSg[(size_t)s * 4096 + (16 * ro + 4 * q + j) * 64 + v] = acc[ro][j];
        if (s == NSG - 1) break;
        const float* P = PSc + (size_t)s * 4096 + (4 * q) * 64 + i16;
        float a[4][4][4];
#pragma unroll
        for (int rb = 0; rb < 4; ++rb)
#pragma unroll
            for (int kk = 0; kk < 4; ++kk)
#pragma unroll
                for (int ro = 0; ro < 4; ++ro) a[rb][kk][ro] = P[(16 * rb + kk) * 64 + 16 * ro];
#pragma unroll
        for (int rb = 0; rb < 4; ++rb) asm volatile("" : "+v"(a[rb][0][0]), "+v"(a[rb][0][1]), "+v"(a[rb][0][2]), "+v"(a[rb][0][3]), "+v"(a[rb][1][0]), "+v"(a[rb][1][1]), "+v"(a[rb][1][2]), "+v"(a[rb][1][3]),
                                                         "+v"(a[rb][2][0]), "+v"(a[rb][2][1]), "+v"(a[rb][2][2]), "+v"(a[rb][2][3]), "+v"(a[rb][3][0]), "+v"(a[rb][3][1]), "+v"(a[rb][3][2]), "+v"(a[rb][3][3]));
        f32x4 nacc[4];
#pragma unroll
        for (int ro = 0; ro < 4; ++ro) nacc[ro] = *(const f32x4*)(QSc + (size_t)s * 4096 + v * 64 + 16 * ro + 4 * q);
#pragma unroll
        for (int rb = 0; rb < 4; ++rb)
#pragma unroll
            for (int kk = 0; kk < 4; ++kk)
#pragma unroll
                for (int ro = 0; ro < 4; ++ro) nacc[ro] = __builtin_amdgcn_mfma_f32_16x16x4f32(a[rb][kk][ro], acc[rb][kk], nacc[ro], 0, 0, 0);
#pragma unroll
        for (int ro = 0; ro < 4; ++ro) acc[ro] = nacc[ro];
    }
}
__device__ __forceinline__ float qsum(float v) {
    float a = v, b = v; asm volatile("s_nop 1\n\tv_permlane16_swap_b32 %0, %1" : "+v"(a), "+v"(b)); v = a + b; a = v; b = v;
    asm volatile("s_nop 1\n\tv_permlane32_swap_b32 %0, %1" : "+v"(a), "+v"(b)); return a + b; }
__device__ __forceinline__ void ph_rwkv_out_fast(const Params& p, int l, bool with_ctx) {
    const int tid_ = opq_tid(), bid_ = opq_bid(); (void)tid_; (void)bid_;
    const int lane = tid_ & 63, i16 = lane & 15, q = lane >> 4, gw = bid_ * 4 + (tid_ >> 6), nw = gridDim.x * 4;
    constexpr int TOK = 16, NLT = NB * (S / TOK) * 4, NCTK = NB * (L / TOK) * 4;
    const int ntask = NLT + (with_ctx ? NCTK : 0);
    for (int tsk = gw; tsk < ntask; tsk += nw) {
        const bool isCtx = tsk >= NLT; const int r = isCtx ? tsk - NLT : tsk;
        const int h = r & 3, npt = isCtx ? L / TOK : S / TOK, tt = (r >> 2) % npt, b = (r >> 2) / npt;
        const int seg0 = (isCtx ? TOK * tt : L + TOK * tt) / SEGLEN, seg1 = (isCtx ? L - 1 - TOK * tt : L + S - 1 - TOK * tt) / SEGLEN;
        const int m = (isCtx ? TL + b * L + TOK * tt : b * S + TOK * tt) + i16;
        const size_t o = (size_t)m * DA + h * 64 + 4 * q, o1 = o + (size_t)T * DA;
        f32x4 acc[4];
#pragma unroll
        for (int rb = 0; rb < 4; ++rb) acc[rb] = *(const f32x4*)(p.Y + o + 16 * rb) + *(const f32x4*)(p.Y + o1 + 16 * rb);
#pragma unroll
        for (int d = 0; d < 2; ++d) {
            const int seg = d ? seg1 : seg0;
            if (seg > 0) {
                const float* sst = p.SS + (((size_t)(d * NB + b) * 4 + h) * NSG + seg) * 4096 + q * 64 + i16;
                const float* pvp = p.PV + (d ? o1 : o) - 4 * q + q;
                float a[4][16], bq[16];
#pragma unroll
                for (int kk = 0; kk < 16; ++kk) { bq[kk] = pvp[4 * kk];
#pragma unroll
                    for (int rb = 0; rb < 4; ++rb) a[rb][kk] = sst[(4 * kk) * 64 + 16 * rb]; }
#pragma unroll
                for (int rb = 0; rb < 4; ++rb) asm volatile("" : "+v"(a[rb][0]), "+v"(a[rb][1]), "+v"(a[rb][2]), "+v"(a[rb][3]), "+v"(a[rb][4]), "+v"(a[rb][5]), "+v"(a[rb][6]), "+v"(a[rb][7]),
                                                                 "+v"(a[rb][8]), "+v"(a[rb][9]), "+v"(a[rb][10]), "+v"(a[rb][11]), "+v"(a[rb][12]), "+v"(a[rb][13]), "+v"(a[rb][14]), "+v"(a[rb][15]));
#pragma unroll
                for (int kk = 0; kk < 16; ++kk)
#pragma unroll
                    for (int rb = 0; rb < 4; ++rb) acc[rb] = __builtin_amdgcn_mfma_f32_16x16x4f32(a[rb][kk], bq[kk], acc[rb], 0, 0, 0);
            }
        }
        float s = 0.f;
#pragma unroll
        for (int rb = 0; rb < 4; ++rb) s += sum4(acc[rb]);
        const float mu = qsum(s) * (1.0f / 64.f);
        float sq = 0.f, bon = 0.f;
#pragma unroll
        for (int rb = 0; rb < 4; ++rb) { const f32x4 dy = acc[rb] - mu; sq += sum4(dy * dy);
            const f32x4 rr = *(const f32x4*)(p.sR + o + 16 * rb), kds = *(const f32x4*)(p.sKD + o + 16 * rb) + *(const f32x4*)(p.sKD + o1 + 16 * rb), rk = *(const f32x4*)(p.a_r_k + l * DA + h * 64 + 16 * rb + 4 * q);
            bon += sum4(rr * kds * rk); }
        const float rstd = 1.0f / sqrtf(qsum(sq) * (1.0f / 64.f) + GN_EPS); bon = qsum(bon);
#pragma unroll
        for (int rb = 0; rb < 4; ++rb) { const int c = h * 64 + 16 * rb + 4 * q;
            const f32x4 gln = *(const f32x4*)(p.a_lnx_g + l * DA + c), bln = *(const f32x4*)(p.a_lnx_b + l * DA + c), vv = *(const f32x4*)(p.sV + o + 16 * rb);
            bf16_t* mp = p.MIX + (size_t)m * DMIX + c; const f32x4 gg = ld_bf16x4(mp);
            st_bf16x4(mp, ((acc[rb] - mu) * rstd * gln + bln + vv * bon) * gg); }
    }
}


#define LAS __attribute__((address_space(3)))
#define XB_TMO      128
#define XB_XCNT(j)  (256  + 64 * (j))
#define XB_XSUB(j)  (1280 + 64 * (j))
#define XB_XGEN(j)  (2304 + 64 * (j))
#define XB_TOP      3328
#define XB_TOPGEN   3392
#define XCD_BAR_WORDS 3456
#define XB_SPIN_CAP (1u << 20)
static_assert(XCD_BAR_WORDS * 4 <= 16384, "barrier words fit the control region");
__device__ __forceinline__ unsigned xb_ld(unsigned* p)              { return __hip_atomic_load(p, __ATOMIC_RELAXED, __HIP_MEMORY_SCOPE_AGENT); }
__device__ __forceinline__ unsigned xb_add(unsigned* p, unsigned v) { return __hip_atomic_fetch_add(p, v, __ATOMIC_RELAXED, __HIP_MEMORY_SCOPE_AGENT); }
__device__ __forceinline__ unsigned xb_xcc_id() { return (unsigned)__builtin_amdgcn_s_getreg((3 << 11) | 20) & 0xFu; }
#define XB_SPIN(cond, bar) do { unsigned _sp = 0; while (cond) { __builtin_amdgcn_s_sleep(1); \
    if ((++_sp & 255u) == 0u) { if (xb_ld(&(bar)[XB_TMO])) break; if (_sp > XB_SPIN_CAP) { atomicAdd(&(bar)[XB_TMO], 1u); break; } } } } while (0)
struct XcdBarrier { unsigned* bar; unsigned x; volatile LAS unsigned* st; };
__device__ __forceinline__ XcdBarrier xcd_barrier_post(unsigned* bar, volatile LAS unsigned* st) {
    XcdBarrier b; b.bar = bar; b.x = xb_xcc_id(); b.st = st;
    if (threadIdx.x == 0) (void)xb_add(&bar[XB_XCNT(b.x)], 1u);
    return b;
}
__device__ __forceinline__ void xcd_barrier_complete(unsigned* bar, unsigned x, unsigned& nloc, unsigned& nx) {
    const unsigned G = gridDim.x * gridDim.y * gridDim.z;
    unsigned sum, cnt, mine, sp = 0u;
    for (;;) {
        sum = 0u; cnt = 0u; mine = 0u;
#pragma unroll
        for (unsigned j = 0; j < 16; ++j) { const unsigned c = xb_ld(&bar[XB_XCNT(j)]); sum += c; cnt += (c > 0u) ? 1u : 0u; mine = (j == x) ? c : mine; }
        if (sum == G) break;
        __builtin_amdgcn_s_sleep(1);
        if ((++sp & 255u) == 0u) { if (xb_ld(&bar[XB_TMO])) break; if (sp > XB_SPIN_CAP) { atomicAdd(&bar[XB_TMO], 1u); break; } }
    }
    nloc = mine > 0u ? mine : 1u; nx = cnt > 0u ? cnt : 1u;
}
__device__ __forceinline__ void xcd_barrier(const XcdBarrier& b) {
    asm volatile("s_waitcnt vmcnt(0)" ::: "memory");
    __syncthreads();
    if (threadIdx.x == 0) {
        unsigned* bar = b.bar;
        __builtin_amdgcn_s_waitcnt(0);
        unsigned nloc = b.st[0], nx = b.st[1];
        if (nloc == 0u) { xcd_barrier_complete(bar, b.x, nloc, nx); b.st[0] = nloc; b.st[1] = nx; }
        const unsigned old = xb_add(&bar[XB_XSUB(b.x)], 1u);
        const unsigned gen = old / nloc;
        if (old + 1u == (gen + 1u) * nloc) {
            __builtin_amdgcn_fence(__ATOMIC_RELEASE, "agent");
            asm volatile("s_waitcnt vmcnt(0)" ::: "memory");
            const unsigned og = xb_add(&bar[XB_TOP], 1u);
            const unsigned tg = og / nx;
            if (og + 1u == (tg + 1u) * nx) xb_add(&bar[XB_TOPGEN], 1u);
            else XB_SPIN(xb_ld(&bar[XB_TOPGEN]) == tg, bar);
            __builtin_amdgcn_fence(__ATOMIC_ACQUIRE, "agent");
            xb_add(&bar[XB_XGEN(b.x)], 1u);
            asm volatile("s_waitcnt vmcnt(0)" ::: "memory");
        } else {
            XB_SPIN(xb_ld(&bar[XB_XGEN(b.x)]) == gen, bar);
            __builtin_amdgcn_fence(__ATOMIC_ACQUIRE, "agent");
            asm volatile("s_waitcnt vmcnt(0)" ::: "memory");
        }
    }
    __syncthreads();
}

#define GT ((long)blockIdx.x * blockDim.x + threadIdx.x)
#define GS ((long)gridDim.x * blockDim.x)
__global__ void __launch_bounds__(256, 2) mega_fwd(Params p) {
    __shared__ __attribute__((aligned(16))) char lds[65536 + 64];
    cg::grid_group grid = cg::this_grid();
    const long gt = GT, gs = GS;
    volatile LAS unsigned* bst = (volatile LAS unsigned*)(LAS char*)(lds + 65536);
    if (threadIdx.x < 2) bst[threadIdx.x] = 0u;
    __syncthreads();
    const XcdBarrier xb = xcd_barrier_post(p.bar, bst);
#ifndef PROBE_PHASE
#define PROBE_PHASE -1
#endif
#define PROBE_AMP 8
    unsigned long long t_prev = 0; int nts = 0;
#define STAMP() do { if (PROBE_PHASE >= 0 && blockIdx.x == 0 && threadIdx.x == 0) { const unsigned long long t_now = __builtin_amdgcn_s_memrealtime(); \
        if (nts == PROBE_PHASE + 1) { const unsigned long long t_end = t_now + PROBE_AMP * (t_now - t_prev); while (__builtin_amdgcn_s_memrealtime() < t_end) __builtin_amdgcn_s_sleep(8); } \
        t_prev = __builtin_amdgcn_s_memrealtime(); } ++nts; } while (0)
#define GSYNC() do { xcd_barrier(xb); STAMP(); } while (0)
    STAMP();
    ph_mod_fast(p, lds); ph_prep_w_fast(p, 0, 0, lds); ph_prep_misc(p, 0, gt, gs, false);
    if (p.out == nullptr) grid.sync();
    GSYNC();
    for (int l = 0; l < 2; ++l) {
        const int nrows = (l == 0) ? T : TL;
        if (l == 0) { ph_lnmod_fast(p, l); GSYNC(); }
        g_gemm_in(p, lds);
        GSYNC();
        ph_streams_s1(p, l);
        GSYNC();
        g_streams_s2(p, l, lds);
        GSYNC();
        ph_scan_fast(p);
        GSYNC();
        ph_combine(p, lds); ph_attn_blk(p, l, l == 0, 64, lds);
        GSYNC();
        ph_rwkv_out_fast(p, l, l == 0);
        GSYNC();
        if (blockIdx.x >= gridDim.x / 2) { ph_prep_w_fast(p, l, 1, lds); __syncthreads(); g_gemm_out(p, nrows, lds); } else { g_gemm_out(p, nrows, lds); ph_prep_w_fast(p, l, 1, lds); }
        GSYNC();
        g_router(p, l, nrows, lds);
        GSYNC();
        ph_dispatch_fast(p, l, nrows, lds);
        GSYNC();
        g_moe1(p, l, lds);
        GSYNC();
        g_moe2(p, l, lds);
        GSYNC();
        ph_final_fast(p, l, nrows, l == 0);
        if (l == 0) { ph_prep_w_fast(p, 1, 0, lds); ph_prep_misc(p, 1, gt, gs, false); }
        GSYNC();
    }}

extern "C" void kernel_launch(void* const* d_in, const int* in_sizes, int n_in, void* d_out, int out_size, void* d_ws, size_t ws_size, hipStream_t stream) {
    if (n_in != 32 || out_size != TL * D || ws_size < WS_NEED) { fprintf(stderr, "kernel_launch: unexpected shapes / workspace (n_in %d out %d ws %zu need %zu)\n", n_in, out_size, ws_size, (size_t)WS_NEED); return; }
    static int grid_blocks = 0;
    if (!grid_blocks) {
        int dev = 0, cus = 0, per_cu = 0;
        (void)hipGetDevice(&dev);
        (void)hipDeviceGetAttribute(&cus, hipDeviceAttributeMultiprocessorCount, dev);
        (void)hipOccupancyMaxActiveBlocksPerMultiprocessor(&per_cu, mega_fwd, 256, 0);
        if (per_cu < 1) per_cu = 1;
        if (per_cu > 2) per_cu = 2;
        grid_blocks = cus * per_cu;
        fprintf(stderr, "kernel_launch: %d CUs x %d blocks\n", cus, per_cu);
    }
    Params p = make_params(d_in, d_out, d_ws);
    (void)hipMemsetAsync(d_ws, 0, CTL_BYTES, stream);
    void* args[] = {&p};
    hipError_t e = hipLaunchCooperativeKernel((void*)mega_fwd, dim3(grid_blocks), dim3(256), args, 0, stream);
    if (e != hipSuccess) fprintf(stderr, "cooperative launch failed: %s (grid %d)\n", hipGetErrorString(e), grid_blocks);
}
#endif

#ifdef HOST_EMU
static void host_forward(void* const* d_in, void* d_out, void* d_ws) {
    const Params p = make_params(d_in, d_out, d_ws);
    for (int l = 0; l < 2; ++l) {
        const int nrows = (l == 0) ? T : TL;
        ph_prep_w(p, l, 0, 1); ph_prep_misc(p, l, 0, 1); ph_lnmod(p, l, 0, 1); host_gemm_in(p); ph_streams(p, l, 0, 1); ph_rope(p, 0, 1); ph_scan(p, 0, 1);
        ph_attn(p, l, nrows, 0, 1); ph_rwkv_out(p, l, nrows, 0, 1); host_gemm_out(p, nrows); ph_post_mixer(p, l, nrows, 0, 1);
        ph_dispatch(p, l, nrows, 0, 1); host_moe1(p, l); host_moe2(p, l); ph_final(p, l, nrows, 0, 1);
    }
}
#endif
```

```cpp
#ifdef HOST_EMU
#include <cmath>
#include <cstdio>
#include <cstring>
#include <cstdint>
#include <cstdlib>
#define __device__
#define __global__
#define __host__
#define __forceinline__ inline
#else
#include <hip/hip_runtime.h>
#include <hip/hip_cooperative_groups.h>
#include <cstdio>
#include <cstdint>
namespace cg = cooperative_groups;
#endif

#ifndef CFG_D
#define CFG_D 1024
#define CFG_B 8
#define CFG_S 2048
#define CFG_L 256
#define CFG_DE 512
#endif
constexpr int D = CFG_D, NB = CFG_B, S = CFG_S, L = CFG_L, DE = CFG_DE;
constexpr int TL = NB * S, TC = NB * L, T = TL + TC;
constexpr int GRID_W = 64, HD = 64;
constexpr int DA = 256, A_IN = 1184, N_IN = 2976, NINP = 3072, DMIX = 1024;
constexpr int NEXP = 32, NSLOT = 2 * T + NEXP * 128;
constexpr int ZQB = 0, ZKB = 384, ZVB = 512, ZQN = 640, ZKN = 1024, ZVN = 1408, ZA = 1792, ZP = 2976;
constexpr float LN_EPS = 1e-6f, GN_EPS = 64e-5f, ATT_SCALE = 0.125f, LOG2E = 1.4426950408889634f, QSCALE = ATT_SCALE * LOG2E;
constexpr float ALPHA = 1.41421356237309515f;

typedef unsigned short bf16_t;

__device__ __forceinline__ float bf2f(bf16_t v) {
    unsigned u = ((unsigned)v) << 16; float f;
#ifdef HOST_EMU
    memcpy(&f, &u, 4);
#else
    f = __uint_as_float(u);
#endif
    return f;
}
__device__ __forceinline__ bf16_t f2bf(float f) {
    unsigned u;
#ifdef HOST_EMU
    memcpy(&u, &f, 4);
#else
    u = __float_as_uint(f);
#endif
    return (bf16_t)((u + 0x7fffu + ((u >> 16) & 1u)) >> 16);
}
__device__ __forceinline__ float sigmoidf_(float x) { return 1.0f / (1.0f + expf(-x)); }
__device__ __forceinline__ float siluf_(float x) { return x / (1.0f + expf(-x)); }
__device__ __forceinline__ int atomic_inc_int(int* p) {
#ifdef HOST_EMU
    int o = *p; *p = o + 1; return o;
#else
    return atomicAdd(p, 1);
#endif
}

struct Params {
    const float *x, *c, *ctx, *c_ctx, *w_mod, *b_mod, *w_in, *w_out, *a_shift, *a_w0, *a_w_up, *a_a0, *a_a_up, *a_g_up,
        *a_k_k, *a_k_a, *a_r_k, *a_lnx_g, *a_lnx_b, *b_sink, *c_rpb, *ln1_g, *ln1_b, *ln2_g, *ln2_b, *w_rg, *b_rg, *w_re,
        *b_re, *w_gate, *w_up, *w_down;
    float* out;
    int* cnt;
    unsigned* bar;
    float* mod;
    float* rope;
    bf16_t *win_t, *wout_t, *wgu_t, *wd_t;
    bf16_t *wrt;
    int* hist;
    bf16_t* HLO;
    bf16_t *wupT, *aupT, *gupT;
    bf16_t* LA;
    float *kT, *kN;
    bf16_t* H;
    bf16_t* Z;
    bf16_t* VT;
    float *sR, *sV, *sKK, *sG, *sW, *sKD, *sB;
    float* Y;
    bf16_t* MIX;
    float *PV, *QS, *PS, *SS;
    float* XC;
    bf16_t* O;
    bf16_t* YSb;
    int *rE, *rPos, *rSlot; float* rW;
    int* slotTok;
    bf16_t* ACT;
    float* YS;
};

constexpr size_t al256(size_t v) { return (v + 255) & ~(size_t)255; }
constexpr size_t OFF_CNT = 0;
constexpr size_t OFF_BAR = 4096, CTL_BYTES = 4096 + 16384;
constexpr size_t OFF_MOD = CTL_BYTES;
constexpr size_t OFF_ROPE = al256(OFF_MOD + (size_t)2 * (NB + 1) * 6 * D * 4);
constexpr size_t OFF_LORA = al256(OFF_ROPE + 64 * 16 * 2 * 4);
constexpr size_t OFF_WRT = al256(OFF_LORA + (size_t)(2 * 256 * 64 * 2 + 256 * 160) * 2);
constexpr size_t OFF_LG = al256(OFF_WRT + (size_t)2 * 128 * D * 2);
constexpr size_t OFF_WIN = al256(OFF_LG + (size_t)(T / 32) * 32 * 4);
constexpr size_t OFF_WOUT = al256(OFF_WIN + (size_t)NINP * D * 2);
constexpr size_t OFF_WGU = al256(OFF_WOUT + (size_t)D * DMIX * 2);
constexpr size_t OFF_WD = al256(OFF_WGU + (size_t)NEXP * 2 * DE * D * 2);
constexpr size_t OFF_H = al256(OFF_WD + (size_t)NEXP * D * DE * 2);
constexpr size_t OFF_Z = al256(OFF_H + (size_t)(T + 1) * D * 2);
constexpr int PU = L + S;
constexpr int SEGLEN = 144, NSG = (L + S) / SEGLEN;
#ifndef HOST_EMU
static_assert((L + S) % SEGLEN == 0 && SEGLEN % 16 == 0 && L % 16 == 0 && S % 16 == 0, "16-token output tiles must not straddle scan segments");
static_assert((size_t)3 * 64 * NSG * 4096 * 4 <= (size_t)NEXP * 2 * DE * D * 2, "scan segment states overlay wgu_t");
#endif
constexpr size_t OFF_VT = al256(OFF_Z + (size_t)T * ZP * 2);
constexpr size_t OFF_S = al256(OFF_VT + (size_t)NB * 8 * 64 * PU * 2);
constexpr size_t S1 = (size_t)T * 256 * 4;
#ifdef HOST_EMU
constexpr int NSTREAM = 10;
#else
constexpr int NSTREAM = 9;
#endif
constexpr size_t OFF_Y = al256(OFF_S + NSTREAM * S1);
constexpr size_t OFF_MIX = al256(OFF_Y + 2 * S1);
constexpr size_t OFF_XC = al256(OFF_MIX + (size_t)T * 1024 * 2);
constexpr size_t OFF_ROUTE = al256(OFF_XC + (size_t)TC * D * 4);
constexpr size_t OFF_SLOTTOK = al256(OFF_ROUTE + (size_t)T * 2 * 4 * 4);
constexpr size_t WS_NEED = al256(OFF_SLOTTOK + (size_t)NSLOT * 4);
static_assert((size_t)NSLOT * DE * 2 <= (size_t)T * ZP * 2 && (size_t)T * D * 2 <= (size_t)T * ZP * 2, "ACT / HLO overlay Z");
static_assert((size_t)T * 4 * 4 + (size_t)T * 416 * 2 <= S1, "kN + LA overlay Y[1]");
static_assert((size_t)NSLOT * D * 4 <= NSTREAM * S1 && (size_t)T * D * 4 <= NSTREAM * S1, "YS / O overlay the stream buffers");

static Params make_params(void* const* d_in, void* d_out, void* d_ws) {
    Params p{};
    const float** f = (const float**)&p.x;
    for (int i = 0; i < 32; ++i) f[i] = (const float*)d_in[i];
    p.out = (float*)d_out;
    char* w = (char*)d_ws;
    p.cnt = (int*)(w + OFF_CNT); p.bar = (unsigned*)(w + OFF_BAR); p.mod = (float*)(w + OFF_MOD); p.rope = (float*)(w + OFF_ROPE);
    p.win_t = (bf16_t*)(w + OFF_WIN); p.wout_t = (bf16_t*)(w + OFF_WOUT); p.wgu_t = (bf16_t*)(w + OFF_WGU); p.wd_t = (bf16_t*)(w + OFF_WD);
    p.wrt = (bf16_t*)(w + OFF_WRT); p.hist = (int*)(w + OFF_LG); p.HLO = (bf16_t*)(w + OFF_Z);
    p.wupT = (bf16_t*)(w + OFF_LORA); p.aupT = p.wupT + 2 * 256 * 64; p.gupT = p.aupT + 2 * 256 * 64;
    p.H = (bf16_t*)(w + OFF_H); p.Z = (bf16_t*)(w + OFF_Z); p.VT = (bf16_t*)(w + OFF_VT);
    float* s = (float*)(w + OFF_S); const size_t n1 = (size_t)T * 256;
    p.sR = s; p.sV = s + n1; p.sKK = s + 2 * n1; p.sW = s + 3 * n1; p.sKD = s + 5 * n1; p.sB = s + 7 * n1; p.sG = s + 9 * n1;
    p.Y = (float*)(w + OFF_Y); p.MIX = (bf16_t*)(w + OFF_MIX); p.XC = (float*)(w + OFF_XC);
    p.O = (bf16_t*)(w + OFF_S); p.YSb = (bf16_t*)(w + OFF_S);
    p.PV = (float*)(w + OFF_H); p.QS = (float*)(w + OFF_WGU); p.PS = p.QS + (size_t)64 * NSG * 4096; p.SS = p.PS + (size_t)64 * NSG * 4096;
    p.kT = p.Y; p.kN = p.Y + (size_t)T * 256; p.LA = (bf16_t*)(p.Y + (size_t)T * 256 + (size_t)T * 4);
    int* r = (int*)(w + OFF_ROUTE); p.rE = r; p.rPos = r + 2 * T; p.rSlot = r + 4 * T; p.rW = (float*)(r + 6 * T);
    p.slotTok = (int*)(w + OFF_SLOTTOK);
    p.ACT = (bf16_t*)(w + OFF_Z); p.YS = (float*)(w + OFF_S);
    return p;
}

__device__ void ph_prep_w(const Params& p, int l, long gtid, long gsz) {
    for (long i = gtid; i < (long)D * NINP; i += gsz) {
        const int k = (int)(i / NINP), n = (int)(i % NINP);
        float v = 0.f;
        if (n < N_IN) { const int oc = (n < ZA) ? n + A_IN : n - ZA; v = p.w_in[((size_t)l * D + k) * N_IN + oc]; }
        p.win_t[(size_t)n * D + k] = f2bf(v);
    }
    for (long i = gtid; i < (long)DMIX * D; i += gsz) {
        const int k = (int)(i / D), n = (int)(i % D);
        p.wout_t[(size_t)n * DMIX + k] = f2bf(p.w_out[((size_t)l * DMIX + k) * D + n]);
    }
    for (long i = gtid; i < (long)NEXP * D * 2 * DE; i += gsz) {
        const int rho = (int)(i % (2 * DE)); const long t = i / (2 * DE); const int k = (int)(t % D), e = (int)(t / D);
        const int q = rho >> 5, half = (rho >> 4) & 1, ii = rho & 15, cc = 16 * q + ii;
        const float* src = half ? p.w_up : p.w_gate;
        p.wgu_t[((size_t)e * 2 * DE + rho) * D + k] = f2bf(src[(((size_t)l * NEXP + e) * D + k) * DE + cc]);
    }
    for (long i = gtid; i < (long)NEXP * DE * D; i += gsz) {
        const int n = (int)(i % D); const long t = i / D; const int k = (int)(t % DE), e = (int)(t / DE);
        p.wd_t[((size_t)e * D + n) * DE + k] = f2bf(p.w_down[(((size_t)l * NEXP + e) * DE + k) * D + n]);
    }
}
__device__ __forceinline__ void ph_prep_misc(const Params& p, int l, long gtid, long gsz, bool do_mod = true) {
    if (l == 0 && do_mod) for (long i = gtid; i < (long)2 * (NB + 1) * 6 * D; i += gsz) {
        const int j = (int)(i % (6 * D)), b = (int)((i / (6 * D)) % (NB + 1)), ll = (int)(i / ((long)6 * D * (NB + 1)));
        const float* cv = (b < NB) ? p.c + (size_t)b * D : p.c_ctx;
        float acc = 0.f;
        for (int k = 0; k < D; ++k) acc += siluf_(cv[k]) * p.w_mod[((size_t)ll * D + k) * 6 * D + j];
        p.mod[((size_t)ll * (NB + 1) + b) * 6 * D + j] = acc + p.b_mod[(size_t)ll * 6 * D + j];
    }
    if (l == 0) for (long i = gtid; i < 64 * 16; i += gsz) {
        const int pos = (int)(i / 16), fi = (int)(i % 16);
        const float inv = powf(10000.0f, -(float)fi / 16.0f), ang = (float)pos * inv;
        p.rope[i] = cosf(ang); p.rope[1024 + i] = sinf(ang);
    }
    for (long i = gtid; i < NEXP; i += gsz) p.cnt[l * NEXP + i] = 0;
    for (long i = gtid; i < NSLOT; i += gsz) p.slotTok[i] = T;
    for (long i = gtid; i < D; i += gsz) p.H[(size_t)T * D + i] = 0;
}

__device__ __forceinline__ const float* xrow_in(const Params& p, int l, int m) {
    if (m < TL) return (l == 0 ? p.x : p.out) + (size_t)m * D;
    return (l == 0 ? p.ctx : p.XC) + (size_t)(m - TL) * D;
}
__device__ __forceinline__ const float* modrow(const Params& p, int l, int m) { return p.mod + ((size_t)l * (NB + 1) + (m < TL ? m / S : NB)) * 6 * D; }

__device__ void ph_lnmod(const Params& p, int l, long gtid, long gsz) {
    for (long m = gtid; m < T; m += gsz) {
        const float* xr = xrow_in(p, l, (int)m); const float* md = modrow(p, l, (int)m);
        float s = 0.f; for (int j = 0; j < D; ++j) s += xr[j];
        const float mu = s / D; float q = 0.f;
        for (int j = 0; j < D; ++j) { const float d = xr[j] - mu; q += d * d; }
        const float rstd = 1.0f / sqrtf(q / D + LN_EPS);
        for (int j = 0; j < D; ++j) p.H[(size_t)m * D + j] = f2bf((xr[j] - mu) * rstd * (1.0f + md[D + j]) + md[j]);
    }
}

__device__ __forceinline__ float zshift(const Params& p, int l, int m, int col) {
    int t, len;
    if (m < TL) { t = m % S; len = S; } else { t = (m - TL) % L; len = L; }
    const float* sh = p.a_shift + (size_t)l * 3 * A_IN;
    const bf16_t* z = p.Z + (size_t)m * ZP + ZA + col;
    float v = sh[A_IN + col] * bf2f(z[0]);
    if (t > 0) v += sh[col] * bf2f(z[-ZP]);
    if (t < len - 1) v += sh[2 * A_IN + col] * bf2f(z[ZP]);
    return v;
}

__device__ void ph_streams(const Params& p, int l, long gtid, long gsz) {
    for (long i = gtid; i < (long)T * DA; i += gsz) {
        const int m = (int)(i / DA), c = (int)(i % DA), h0 = c & ~63;
        const float r = zshift(p, l, m, c), k = zshift(p, l, m, 256 + c), v = zshift(p, l, m, 512 + c);
        float nrm = 0.f;
        for (int j = 0; j < 64; ++j) { const float t = zshift(p, l, m, 256 + h0 + j) * p.a_k_k[l * DA + h0 + j]; nrm += t * t; }
        const float kk = k * p.a_k_k[l * DA + c] / sqrtf(nrm + 1e-12f);
        float g = 0.f;
        for (int j = 0; j < 160; ++j) g += sigmoidf_(zshift(p, l, m, 1024 + j)) * p.a_g_up[((size_t)l * 160 + j) * DA + c];
        const size_t o = (size_t)m * DA + c;
        p.sR[o] = r; p.sV[o] = v; p.sKK[o] = kk; p.sG[o] = g;
        for (int d = 0; d < 2; ++d) {
            float aw = 0.f, aa = 0.f;
            for (int j = 0; j < 64; ++j) {
                aw += tanhf(zshift(p, l, m, 768 + d * 64 + j)) * p.a_w_up[(((size_t)l * 2 + d) * 64 + j) * DA + c];
                aa += zshift(p, l, m, 896 + d * 64 + j) * p.a_a_up[(((size_t)l * 2 + d) * 64 + j) * DA + c];
            }
            const float u = -(p.a_w0[(l * 2 + d) * DA + c] + aw);
            const float sp = (u > 20.f) ? u : log1pf(expf(u));
            const float w = expf(-expf(-sp - 0.5f));
            const float a = sigmoidf_(p.a_a0[(l * 2 + d) * DA + c] + aa);
            const size_t od = ((size_t)d * T + m) * DA + c;
            p.sW[od] = w; p.sKD[od] = k * (1.0f + (a - 1.0f) * p.a_k_a[l * DA + c]); p.sB[od] = kk * a;
        }
    }
}

__device__ __forceinline__ void ph_rope(const Params& p, long gtid, long gsz) {
    for (long i = gtid; i < (long)TL * 8 * 32; i += gsz) {
        const int pr = (int)(i & 31), hs = (int)((i >> 5) & 7), m = (int)(i >> 8);
        const int t = m % S, axis = pr >> 4, fi = pr & 15, pos = axis ? (t % GRID_W) : (t / GRID_W);
        bf16_t* z = p.Z + (size_t)m * ZP + hs * 64 + axis * 32 + fi;
        const float cs = p.rope[pos * 16 + fi], sn = p.rope[1024 + pos * 16 + fi];
        const float x0 = bf2f(z[0]), x1 = bf2f(z[16]);
        z[0] = f2bf(x0 * cs - x1 * sn); z[16] = f2bf(x1 * cs + x0 * sn);
    }
}

__device__ void ph_scan(const Params& p, long gtid, long gsz) {
    for (long i = gtid; i < (long)2 * NB * 4 * 64; i += gsz) {
        const int v = (int)(i & 63), h = (int)((i >> 6) & 3), b = (int)((i >> 8) % NB), d = (int)((i >> 8) / NB);
        float st[64];
#pragma unroll
        for (int k = 0; k < 64; ++k) st[k] = 0.f;
        for (int pos = 0; pos < L + S; ++pos) {
            int m;
            if (pos < L) m = TL + b * L + (d ? L - 1 - pos : pos);
            else m = b * S + (d ? S - 1 - (pos - L) : pos - L);
            const size_t o = (size_t)m * DA + h * 64, od = ((size_t)d * T + m) * DA + h * 64;
            const float* kk = p.sKK + o; const float* r = p.sR + o;
            const float* w = p.sW + od; const float* bb = p.sB + od; const float* kd = p.sKD + od;
            const float vv = p.sV[o + v];
            float sk = 0.f;
#pragma unroll
            for (int k = 0; k < 64; ++k) sk += st[k] * kk[k];
            float y = 0.f;
#pragma unroll
            for (int k = 0; k < 64; ++k) { st[k] = st[k] * w[k] - sk * bb[k] + vv * kd[k]; y += st[k] * r[k]; }
            p.Y[od + v] = y;
        }
    }
}

__device__ void ph_rwkv_out(const Params& p, int l, int nrows, long gtid, long gsz) {
    for (long i = gtid; i < (long)nrows * 4; i += gsz) {
        const int m = (int)(i >> 2), h = (int)(i & 3);
        const size_t o = (size_t)m * DA + h * 64;
        const float* y0 = p.Y + o; const float* y1 = p.Y + (size_t)T * DA + o;
        float s = 0.f, bon = 0.f;
        for (int n = 0; n < 64; ++n) {
            s += y0[n] + y1[n];
            bon += p.sR[o + n] * (p.sKD[o + n] + p.sKD[(size_t)T * DA + o + n]) * p.a_r_k[l * DA + h * 64 + n];
        }
        const float mu = s / 64.f; float q = 0.f;
        for (int n = 0; n < 64; ++n) { const float dd = y0[n] + y1[n] - mu; q += dd * dd; }
        const float rstd = 1.0f / sqrtf(q / 64.f + GN_EPS);
        for (int n = 0; n < 64; ++n) {
            const int c = h * 64 + n;
            const float yn = (y0[n] + y1[n] - mu) * rstd * p.a_lnx_g[l * DA + c] + p.a_lnx_b[l * DA + c];
            p.MIX[(size_t)m * DMIX + c] = f2bf((yn + bon * p.sV[o + n]) * p.sG[o + n]);
        }
    }
}

__device__ __forceinline__ void att_key(const float (&q)[64], const bf16_t* kr, const bf16_t* vr, float bias, float& mx, float& ls, float (&acc)[64]) {
    float s = 0.f;
#pragma unroll
    for (int d = 0; d < 64; ++d) s += q[d] * bf2f(kr[d]);
    s = s * ATT_SCALE + bias;
    const float mn = fmaxf(mx, s), f = expf(mx - mn), pe = expf(s - mn);
    ls = ls * f + pe;
#pragma unroll
    for (int d = 0; d < 64; ++d) acc[d] = acc[d] * f + pe * bf2f(vr[d]);
    mx = mn;
}

__device__ void ph_attn(const Params& p, int l, int nrows, long gtid, long gsz) {
    for (long i = gtid; i < (long)nrows * 12; i += gsz) {
        const int m = (int)(i / 12), u = (int)(i % 12);
        const bool isB = u < 6; const int hq = isB ? u : u - 6;
        const int b = (m < TL) ? m / S : (m - TL) / L;
        const int qcol = isB ? ZQB + hq * 64 : ZQN + hq * 64;
        const int kcol = isB ? ZKB + (hq / 3) * 64 : ZKN + hq * 64;
        const int vcol = isB ? ZVB + (hq / 3) * 64 : ZVN + hq * 64;
        float q[64], acc[64];
        const bf16_t* qr = p.Z + (size_t)m * ZP + qcol;
#pragma unroll
        for (int d = 0; d < 64; ++d) { q[d] = bf2f(qr[d]); acc[d] = 0.f; }
        float mx, ls;
        if (isB) { mx = p.b_sink[l * 6 + hq]; ls = 1.0f; } else { mx = -1e30f; ls = 0.f; }
        for (int j = 0; j < L; ++j) { const bf16_t* zr = p.Z + (size_t)(TL + b * L + j) * ZP; att_key(q, zr + kcol, zr + vcol, 0.f, mx, ls, acc); }
        if (m < TL) {
            const int t = m % S;
            if (isB) {
                const int j0 = t - 128 < 0 ? 0 : t - 128, j1 = t + 128 > S - 1 ? S - 1 : t + 128;
                for (int j = j0; j <= j1; ++j) { const bf16_t* zr = p.Z + (size_t)(b * S + j) * ZP; att_key(q, zr + kcol, zr + vcol, 0.f, mx, ls, acc); }
            } else {
                const int rows = S / GRID_W, r = t / GRID_W, c = t % GRID_W;
                int r0 = r - 4; r0 = r0 < 0 ? 0 : (r0 > rows - 8 ? rows - 8 : r0);
                int c0 = c - 8; c0 = c0 < 0 ? 0 : (c0 > GRID_W - 16 ? GRID_W - 16 : c0);
                for (int a = 0; a < 8; ++a)
                    for (int e = 0; e < 16; ++e) {
                        const int kr = r0 + a, kc = c0 + e;
                        const float bias = p.c_rpb[(((size_t)l * 6 + hq) * 15 + (kr - r + 7)) * 31 + (kc - c + 15)];
                        const bf16_t* zr = p.Z + (size_t)(b * S + kr * GRID_W + kc) * ZP;
                        att_key(q, zr + kcol, zr + vcol, bias, mx, ls, acc);
                    }
            }
        }
        const float inv = 1.0f / ls;
        bf16_t* o = p.MIX + (size_t)m * DMIX + (isB ? 256 : 640) + hq * 64;
#pragma unroll
        for (int d = 0; d < 64; ++d) o[d] = f2bf(acc[d] * inv);
    }
}

__device__ void ph_post_mixer(const Params& p, int l, int nrows, long gtid, long gsz) {
    for (long mm = gtid; mm < nrows; mm += gsz) {
        const int m = (int)mm;
        const float* xr = xrow_in(p, l, m); const float* md = modrow(p, l, m); const float* orow = (const float*)p.O + (size_t)m * D;
        float* x1 = (m < TL) ? p.out + (size_t)m * D : p.XC + (size_t)(m - TL) * D;
        const float* g1 = p.ln1_g + (size_t)l * D; const float* b1 = p.ln1_b + (size_t)l * D;
        float s = 0.f; for (int j = 0; j < D; ++j) s += ALPHA * xr[j] + md[2 * D + j] * orow[j];
        float mu = s / D, q = 0.f;
        for (int j = 0; j < D; ++j) { const float d = ALPHA * xr[j] + md[2 * D + j] * orow[j] - mu; q += d * d; }
        float rstd = 1.0f / sqrtf(q / D + LN_EPS);
        s = 0.f;
        for (int j = 0; j < D; ++j) { const float v = (ALPHA * xr[j] + md[2 * D + j] * orow[j] - mu) * rstd * g1[j] + b1[j]; x1[j] = v; s += v; }
        mu = s / D; q = 0.f;
        for (int j = 0; j < D; ++j) { const float d = x1[j] - mu; q += d * d; }
        rstd = 1.0f / sqrtf(q / D + LN_EPS);
        float gl[4], el[32];
#pragma unroll
        for (int g = 0; g < 4; ++g) gl[g] = p.b_rg[l * 4 + g];
#pragma unroll
        for (int e = 0; e < 32; ++e) el[e] = p.b_re[l * 32 + e];
        for (int j = 0; j < D; ++j) {
            const float hv = (x1[j] - mu) * rstd * (1.0f + md[4 * D + j]) + md[3 * D + j];
            p.H[(size_t)m * D + j] = f2bf(hv);
            const float* wg = p.w_rg + ((size_t)l * D + j) * 4; const float* we = p.w_re + ((size_t)l * D + j) * 32;
#pragma unroll
            for (int g = 0; g < 4; ++g) gl[g] += hv * wg[g];
#pragma unroll
            for (int e = 0; e < 32; ++e) el[e] += hv * we[e];
        }
        int gs = 0; float gm = gl[0];
#pragma unroll
        for (int g = 1; g < 4; ++g) if (gl[g] > gm) { gm = gl[g]; gs = g; }
        float den = 0.f;
#pragma unroll
        for (int g = 0; g < 4; ++g) den += expf(gl[g] - gm);
        const float pg = 1.0f / den;
        float v1 = -3e38f, v2 = -3e38f; int i1 = 0, i2 = 0;
#pragma unroll
        for (int j = 0; j < 8; ++j) {
            const float v = gs == 0 ? el[j] : gs == 1 ? el[8 + j] : gs == 2 ? el[16 + j] : el[24 + j];
            if (v > v1) { v2 = v1; i2 = i1; v1 = v; i1 = j; } else if (v > v2) { v2 = v; i2 = j; }
        }
        const float e2 = expf(v2 - v1), w1 = pg / (1.0f + e2), w2 = pg * e2 / (1.0f + e2);
        const int ea = gs * 8 + i1, eb = gs * 8 + i2;
        p.rE[2 * m] = ea; p.rE[2 * m + 1] = eb; p.rW[2 * m] = w1; p.rW[2 * m + 1] = w2;
        p.rPos[2 * m] = atomic_inc_int(p.cnt + l * NEXP + ea); p.rPos[2 * m + 1] = atomic_inc_int(p.cnt + l * NEXP + eb);
    }
}

__device__ __forceinline__ int pstart_of(const int* cnt, int e) {
    int s = 0;
    for (int j = 0; j < NEXP; ++j) if (j < e) s += (cnt[j] + 127) & ~127;
    return s;
}
__device__ __forceinline__ void ph_dispatch(const Params& p, int l, int nrows, long gtid, long gsz) {
    for (long i = gtid; i < (long)nrows * 2; i += gsz) {
        const int slot = pstart_of(p.cnt + l * NEXP, p.rE[i]) + p.rPos[i];
        p.rSlot[i] = slot; p.slotTok[slot] = (int)(i >> 1);
    }
}

__device__ void ph_final(const Params& p, int l, int nrows, long gtid, long gsz) {
    for (long mm = gtid; mm < nrows; mm += gsz) {
        const int m = (int)mm;
        float* x1 = (m < TL) ? p.out + (size_t)m * D : p.XC + (size_t)(m - TL) * D;
        const float* md = modrow(p, l, m);
        const float* ya = p.YS + (size_t)p.rSlot[2 * m] * D; const float* yb = p.YS + (size_t)p.rSlot[2 * m + 1] * D;
        const float wa = p.rW[2 * m], wb = p.rW[2 * m + 1];
        const float* g2 = p.ln2_g + (size_t)l * D; const float* b2 = p.ln2_b + (size_t)l * D;
        float s = 0.f; for (int j = 0; j < D; ++j) s += ALPHA * x1[j] + md[5 * D + j] * (wa * ya[j] + wb * yb[j]);
        const float mu = s / D; float q = 0.f;
        for (int j = 0; j < D; ++j) { const float d = ALPHA * x1[j] + md[5 * D + j] * (wa * ya[j] + wb * yb[j]) - mu; q += d * d; }
        const float rstd = 1.0f / sqrtf(q / D + LN_EPS);
        for (int j = 0; j < D; ++j) x1[j] = (ALPHA * x1[j] + md[5 * D + j] * (wa * ya[j] + wb * yb[j]) - mu) * rstd * g2[j] + b2[j];
    }
}

__device__ __forceinline__ int moe_blocks(const int* cnt) { int s = 0; for (int j = 0; j < NEXP; ++j) s += (cnt[j] + 127) >> 7; return s; }
__device__ __forceinline__ int moe_block_expert(const int* cnt, int rb) {
    int s = 0, e = 0;
    for (int j = 0; j < NEXP; ++j) { const int nb = (cnt[j] + 127) >> 7; if (rb >= s && rb < s + nb) e = j; s += nb; }
    return e;
}

#ifdef HOST_EMU
static void host_gemm_in(const Params& p) {
    for (int m = 0; m < T; ++m) for (int n = 0; n < ZP; ++n) { float a = 0.f; for (int k = 0; k < D; ++k) a += bf2f(p.H[(size_t)m * D + k]) * bf2f(p.win_t[(size_t)n * D + k]); p.Z[(size_t)m * ZP + n] = f2bf(a); }
}
static void host_gemm_out(const Params& p, int nrows) {
    for (int m = 0; m < nrows; ++m) for (int n = 0; n < D; ++n) { float a = 0.f; for (int k = 0; k < DMIX; ++k) a += bf2f(p.MIX[(size_t)m * DMIX + k]) * bf2f(p.wout_t[(size_t)n * DMIX + k]); ((float*)p.O)[(size_t)m * D + n] = a; }
}
static void host_moe1(const Params& p, int l) {
    const int* cnt = p.cnt + l * NEXP; const int nrb = moe_blocks(cnt);
    for (int rb = 0; rb < nrb; ++rb) { const int e = moe_block_expert(cnt, rb);
        for (int r = 0; r < 128; ++r) { const int slot = rb * 128 + r; const bf16_t* a = p.H + (size_t)p.slotTok[slot] * D;
            for (int c = 0; c < DE; ++c) { const int q = c >> 4, ii = c & 15; float g = 0.f, u = 0.f;
                const bf16_t* wg = p.wgu_t + ((size_t)e * 2 * DE + 32 * q + ii) * D; const bf16_t* wu = wg + (size_t)16 * D;
                for (int k = 0; k < D; ++k) { g += bf2f(a[k]) * bf2f(wg[k]); u += bf2f(a[k]) * bf2f(wu[k]); }
                p.ACT[(size_t)slot * DE + c] = f2bf(siluf_(g) * u); } } }
}
static void host_moe2(const Params& p, int l) {
    const int* cnt = p.cnt + l * NEXP; const int nrb = moe_blocks(cnt);
    for (int rb = 0; rb < nrb; ++rb) { const int e = moe_block_expert(cnt, rb);
        for (int r = 0; r < 128; ++r) { const int slot = rb * 128 + r;
            for (int n = 0; n < D; ++n) { float a = 0.f; const bf16_t* w = p.wd_t + ((size_t)e * D + n) * DE;
                for (int k = 0; k < DE; ++k) a += bf2f(p.ACT[(size_t)slot * DE + k]) * bf2f(w[k]);
                p.YS[(size_t)slot * D + n] = a; } } }
}
#else
typedef short bf16x8 __attribute__((ext_vector_type(8)));
typedef float f32x4 __attribute__((ext_vector_type(4)));
__device__ __forceinline__ int opq_tid() { int t = threadIdx.x; asm volatile("" : "+v"(t)); return t; }
__device__ __forceinline__ int opq_bid() { int b = blockIdx.x; asm volatile("" : "+s"(b)); return b; }
__device__ __forceinline__ unsigned pk2(float lo, float hi) { return (unsigned)f2bf(lo) | ((unsigned)f2bf(hi) << 16); }
struct u32x2_t { unsigned x, y; };
__device__ __forceinline__ void st_bf16x4(bf16_t* dst, f32x4 v) { u32x2_t o; o.x = pk2(v[0], v[1]); o.y = pk2(v[2], v[3]); *(u32x2_t*)dst = o; }
template <bool SWAP = true, class Epi>
__device__ __forceinline__ void gemm_tile(const bf16_t* a0, const bf16_t* a1, const bf16_t* b0, const bf16_t* b1, int K, char* lds, const Epi& epi) {
    const int tid = opq_tid(), wid = tid >> 6, lane = tid & 63, wr = wid >> 1, wc = wid & 1, fr = lane & 15, fq = lane >> 4;
    f32x4 acc[4][4];
#pragma unroll
    for (int m = 0; m < 4; ++m)
#pragma unroll
        for (int n = 0; n < 4; ++n) acc[m][n] = (f32x4){0.f, 0.f, 0.f, 0.f};
#define GT_STAGE(st_, kt_) do { char* sa_ = lds + (st_) * 16384 + tid * 16; \
        __builtin_amdgcn_global_load_lds((const unsigned*)(a0 + (kt_)), (__attribute__((address_space(3))) unsigned*)(sa_), 16, 0, 0); \
        __builtin_amdgcn_global_load_lds((const unsigned*)(a1 + (kt_)), (__attribute__((address_space(3))) unsigned*)(sa_ + 4096), 16, 0, 0); \
        __builtin_amdgcn_global_load_lds((const unsigned*)(b0 + (kt_)), (__attribute__((address_space(3))) unsigned*)(sa_ + 8192), 16, 0, 0); \
        __builtin_amdgcn_global_load_lds((const unsigned*)(b1 + (kt_)), (__attribute__((address_space(3))) unsigned*)(sa_ + 12288), 16, 0, 0); } while (0)
    const int fsw = (0 - (fr >> 2)) & 3;
    const int aoff = (wr * 64 + fr) * 64 + ((fq ^ fsw) * 16), boff = 8192 + (wc * 64 + fr) * 64 + ((fq ^ fsw) * 16);
    const int nk = K / 32;
    GT_STAGE(0, 0);
    if (nk > 1) GT_STAGE(1, 32);
    if (nk > 2) GT_STAGE(2, 64);
    for (int t = 0; t < nk; ++t) {
        if (t + 2 < nk) asm volatile("s_waitcnt vmcnt(8)" ::: "memory"); else if (t + 1 < nk) asm volatile("s_waitcnt vmcnt(4)" ::: "memory"); else asm volatile("s_waitcnt vmcnt(0)" ::: "memory");
        asm volatile("s_waitcnt lgkmcnt(0)" ::: "memory");
        __builtin_amdgcn_s_barrier();
        if (t + 3 < nk) GT_STAGE((t + 3) & 3, (t + 3) * 32);
        const char* sb = lds + (t & 3) * 16384;
        bf16x8 At[4], Bt[4];
#pragma unroll
        for (int m = 0; m < 4; ++m) At[m] = *(const bf16x8*)(sb + aoff + m * 1024);
#pragma unroll
        for (int n = 0; n < 4; ++n) Bt[n] = *(const bf16x8*)(sb + boff + n * 1024);
#pragma unroll
        for (int m = 0; m < 4; ++m)
#pragma unroll
            for (int n = 0; n < 4; ++n) acc[m][n] = SWAP ? __builtin_amdgcn_mfma_f32_16x16x32_bf16(Bt[n], At[m], acc[m][n], 0, 0, 0) : __builtin_amdgcn_mfma_f32_16x16x32_bf16(At[m], Bt[n], acc[m][n], 0, 0, 0);
    }
    asm volatile("s_waitcnt lgkmcnt(0)" ::: "memory");
    __builtin_amdgcn_s_barrier();
#undef GT_STAGE
    epi(acc, wr, wc, fr, fq);
}
#define STG_ROW(i) ((tid_ + (i) * 256) >> 2)
#define STG_K ((((tid_ & 3) ^ ((0 - (tid_ >> 4)) & 3))) * 8)

__device__ __forceinline__ f32x4 ld_bf16x4(const bf16_t* src) { const u32x2_t w = *(const u32x2_t*)src; return (f32x4){__uint_as_float(w.x << 16), __uint_as_float(w.x & 0xffff0000u), __uint_as_float(w.y << 16), __uint_as_float(w.y & 0xffff0000u)}; }
__device__ __forceinline__ void g_gemm_in(const Params& p, char* lds) {
    const int tid_ = opq_tid(), bid_ = opq_bid(); (void)tid_; (void)bid_;
    constexpr int NT = NINP / 128, MT = T / 128;
    for (int tile = bid_; tile < NT * MT; tile += gridDim.x) {
        const int tm = tile / NT, tn = tile % NT;
        const bf16_t* a0 = p.H + (size_t)(tm * 128 + STG_ROW(0)) * D + STG_K; const bf16_t* a1 = p.H + (size_t)(tm * 128 + STG_ROW(1)) * D + STG_K;
        const bf16_t* b0 = p.win_t + (size_t)(tn * 128 + STG_ROW(0)) * D + STG_K; const bf16_t* b1 = p.win_t + (size_t)(tn * 128 + STG_ROW(1)) * D + STG_K;
        const float qs = (tn < ZKB / 128 || (tn >= ZQN / 128 && tn < ZKN / 128)) ? QSCALE : 1.0f;
        if (tn == ZVB / 128 || (tn >= ZVN / 128 && tn < ZA / 128)) {
            gemm_tile<false>(a0, a1, b0, b1, D, lds, [&](const f32x4 (&acc)[4][4], int wr, int wc, int fr, int fq) {
#pragma unroll
                for (int m = 0; m < 4; ++m) { const int m0 = tm * 128 + wr * 64 + m * 16 + fq * 4; int b, u;
                    if (m0 < TL) { b = m0 / S; u = L + m0 % S; } else { b = (m0 - TL) / L; u = (m0 - TL) % L; }
#pragma unroll
                    for (int n = 0; n < 4; ++n) { const int col = tn * 128 + wc * 64 + n * 16 + fr;
                        const int hv = col < ZVN ? (col - ZVB) >> 6 : 2 + ((col - ZVN) >> 6), d = col < ZVN ? (col - ZVB) & 63 : (col - ZVN) & 63;
                        st_bf16x4(p.VT + ((size_t)(b * 8 + hv) * 64 + d) * PU + u, acc[m][n]); } }
            });
        } else if (tn < ZVB / 128 && tm < TL / 128) {
            gemm_tile<true>(a0, a1, b0, b1, D, lds, [&](const f32x4 (&acc)[4][4], int wr, int wc, int fr, int fq) {
#pragma unroll
                for (int m = 0; m < 4; ++m) { const int row = tm * 128 + wr * 64 + m * 16 + fr, t = row % S;
                    bf16_t* zr = p.Z + (size_t)row * ZP + tn * 128 + wc * 64 + 4 * fq;
#pragma unroll
                    for (int ax = 0; ax < 2; ++ax) { const int pos = ax ? t % GRID_W : t / GRID_W;
                        const f32x4 cs = *(const f32x4*)(p.rope + pos * 16 + 4 * fq), sn = *(const f32x4*)(p.rope + 1024 + pos * 16 + 4 * fq);
                        const f32x4 x0 = acc[m][2 * ax] * qs, x1 = acc[m][2 * ax + 1] * qs;
                        st_bf16x4(zr + 32 * ax, x0 * cs - x1 * sn); st_bf16x4(zr + 32 * ax + 16, x1 * cs + x0 * sn); } }
            });
        } else {
            gemm_tile<true>(a0, a1, b0, b1, D, lds, [&](const f32x4 (&acc)[4][4], int wr, int wc, int fr, int fq) {
#pragma unroll
                for (int m = 0; m < 4; ++m)
#pragma unroll
                    for (int n = 0; n < 4; ++n) { const int col = tn * 128 + wc * 64 + n * 16 + 4 * fq;
                        if (col < ZP) st_bf16x4(p.Z + (size_t)(tm * 128 + wr * 64 + m * 16 + fr) * ZP + col, acc[m][n] * qs); }
            });
        }
    }
}
__device__ __forceinline__ void g_gemm_out(const Params& p, int nrows, char* lds) {
    const int tid_ = opq_tid(), bid_ = opq_bid(); (void)tid_; (void)bid_;
    constexpr int NT = D / 128; const int MT = nrows / 128;
    for (int tile = bid_; tile < NT * MT; tile += gridDim.x) {
        const int tm = tile / NT, tn = tile % NT;
        const bf16_t* a0 = p.MIX + (size_t)(tm * 128 + STG_ROW(0)) * DMIX + STG_K; const bf16_t* a1 = p.MIX + (size_t)(tm * 128 + STG_ROW(1)) * DMIX + STG_K;
        const bf16_t* b0 = p.wout_t + (size_t)(tn * 128 + STG_ROW(0)) * DMIX + STG_K; const bf16_t* b1 = p.wout_t + (size_t)(tn * 128 + STG_ROW(1)) * DMIX + STG_K;
        gemm_tile(a0, a1, b0, b1, DMIX, lds, [&](const f32x4 (&acc)[4][4], int wr, int wc, int fr, int fq) {
#pragma unroll
            for (int m = 0; m < 4; ++m)
#pragma unroll
                for (int n = 0; n < 4; ++n) st_bf16x4(p.O + (size_t)(tm * 128 + wr * 64 + m * 16 + fr) * D + tn * 128 + wc * 64 + n * 16 + 4 * fq, acc[m][n]);
        });
    }
}
__device__ __forceinline__ void g_moe1(const Params& p, int l, char* lds) {
    const int tid_ = opq_tid(), bid_ = opq_bid(); (void)tid_; (void)bid_;
    const int* cnt = p.cnt + l * NEXP; const int nrb = moe_blocks(cnt); constexpr int NT = 2 * DE / 128;
    for (int tile = bid_; tile < nrb * NT; tile += gridDim.x) {
        const int rb = tile / NT, tn = tile % NT, e = moe_block_expert(cnt, rb);
        const bf16_t* a0 = p.H + (size_t)p.slotTok[rb * 128 + STG_ROW(0)] * D + STG_K; const bf16_t* a1 = p.H + (size_t)p.slotTok[rb * 128 + STG_ROW(1)] * D + STG_K;
        const bf16_t* bw = p.wgu_t + (size_t)e * 2 * DE * D;
        const bf16_t* b0 = bw + (size_t)(tn * 128 + STG_ROW(0)) * D + STG_K; const bf16_t* b1 = bw + (size_t)(tn * 128 + STG_ROW(1)) * D + STG_K;
        gemm_tile(a0, a1, b0, b1, D, lds, [&](const f32x4 (&acc)[4][4], int wr, int wc, int fr, int fq) {
#pragma unroll
            for (int m = 0; m < 4; ++m)
#pragma unroll
                for (int n2 = 0; n2 < 2; ++n2) {
                    const f32x4 g = acc[m][2 * n2], u = acc[m][2 * n2 + 1]; f32x4 a;
#pragma unroll
                    for (int e4 = 0; e4 < 4; ++e4) a[e4] = g[e4] / (1.0f + __expf(-g[e4])) * u[e4];
                    st_bf16x4(p.ACT + (size_t)(rb * 128 + wr * 64 + m * 16 + fr) * DE + tn * 64 + wc * 32 + n2 * 16 + 4 * fq, a); }
        });
    }
}
__device__ __forceinline__ void g_moe2(const Params& p, int l, char* lds) {
    const int tid_ = opq_tid(), bid_ = opq_bid(); (void)tid_; (void)bid_;
    const int* cnt = p.cnt + l * NEXP; const int nrb = moe_blocks(cnt); constexpr int NT = D / 128;
    for (int tile = bid_; tile < nrb * NT; tile += gridDim.x) {
        const int rb = tile / NT, tn = tile % NT, e = moe_block_expert(cnt, rb);
        const bf16_t* a0 = p.ACT + (size_t)(rb * 128 + STG_ROW(0)) * DE + STG_K; const bf16_t* a1 = p.ACT + (size_t)(rb * 128 + STG_ROW(1)) * DE + STG_K;
        const bf16_t* bw = p.wd_t + (size_t)e * D * DE;
        const bf16_t* b0 = bw + (size_t)(tn * 128 + STG_ROW(0)) * DE + STG_K; const bf16_t* b1 = bw + (size_t)(tn * 128 + STG_ROW(1)) * DE + STG_K;
        gemm_tile(a0, a1, b0, b1, DE, lds, [&](const f32x4 (&acc)[4][4], int wr, int wc, int fr, int fq) {
#pragma unroll
            for (int m = 0; m < 4; ++m)
#pragma unroll
                for (int n = 0; n < 4; ++n) st_bf16x4(p.YSb + (size_t)(rb * 128 + wr * 64 + m * 16 + fr) * D + tn * 128 + wc * 64 + n * 16 + 4 * fq, acc[m][n]);
        });
    }
}


constexpr int DV = D / 256;
static_assert(D % 256 == 0, "row phases hold a row as DV float4 per lane");
template <int CTRL> __device__ __forceinline__ float dppf(float v) { return __builtin_bit_cast(float, __builtin_amdgcn_update_dpp(0, __builtin_bit_cast(int, v), CTRL, 0xf, 0xf, true)); }
__device__ __forceinline__ float wave_sum(float v) {
    v += dppf<0xB1>(v); v += dppf<0x4E>(v); v += dppf<0x141>(v); v += dppf<0x140>(v);
    float a = v, b = v;
    asm volatile("s_nop 1\n\tv_permlane16_swap_b32 %0, %1" : "+v"(a), "+v"(b));
    v = a + b; a = v; b = v;
    asm volatile("s_nop 1\n\tv_permlane32_swap_b32 %0, %1" : "+v"(a), "+v"(b));
    return a + b;
}
__device__ __forceinline__ float sum8(float v) { v += dppf<0xB1>(v); v += dppf<0x4E>(v); v += dppf<0x141>(v); return v; }
__device__ __forceinline__ float sum4(f32x4 a) { return (a[0] + a[1]) + (a[2] + a[3]); }
#define LDS_WAIT() asm volatile("s_waitcnt lgkmcnt(0)" ::: "memory")

__device__ __forceinline__ void row_stats(const f32x4 (&v)[DV], float& mu, float& rstd) {
    float s = 0.f;
#pragma unroll
    for (int j = 0; j < DV; ++j) s += sum4(v[j]);
    mu = wave_sum(s) * (1.0f / D);
    float q = 0.f;
#pragma unroll
    for (int j = 0; j < DV; ++j) { const f32x4 d = v[j] - mu; q += sum4(d * d); }
    rstd = 1.0f / sqrtf(wave_sum(q) * (1.0f / D) + LN_EPS);
}

__device__ __forceinline__ void ph_lnmod_fast(const Params& p, int l) {
    const int tid_ = opq_tid(), bid_ = opq_bid(); (void)tid_; (void)bid_;
    const int lane = tid_ & 63, gw = bid_ * 4 + (tid_ >> 6), nw = gridDim.x * 4;
    constexpr int R = 4;
    for (int m0 = gw * R; m0 < T; m0 += nw * R) {
        f32x4 v[R][DV];
#pragma unroll
        for (int r = 0; r < R; ++r) { const f32x4* xr = (const f32x4*)xrow_in(p, l, m0 + r < T ? m0 + r : m0) + lane;
#pragma unroll
            for (int j = 0; j < DV; ++j) v[r][j] = xr[64 * j]; }
        float mu[R], rstd[R];
#pragma unroll
        for (int r = 0; r < R; ++r) row_stats(v[r], mu[r], rstd[r]);
#pragma unroll
        for (int r = 0; r < R; ++r) if (m0 + r < T) { const f32x4* md = (const f32x4*)modrow(p, l, m0 + r) + lane;
#pragma unroll
            for (int j = 0; j < DV; ++j) st_bf16x4(p.H + (size_t)(m0 + r) * D + 4 * (lane + 64 * j), (v[r][j] - mu[r]) * rstd[r] * (md[D / 4 + 64 * j] + 1.0f) + md[64 * j]); }
    }
}

template <int R>
__device__ __forceinline__ void pm_rows(const Params& p, int l, int m0, int lane) {
    const f32x4* g1 = (const f32x4*)(p.ln1_g + (size_t)l * D) + lane; const f32x4* b1 = (const f32x4*)(p.ln1_b + (size_t)l * D) + lane;
    f32x4 v[R][DV]; float mu[R], rstd[R];
#pragma unroll
    for (int r = 0; r < R; ++r) { const int m = m0 + r; const f32x4* xr = (const f32x4*)xrow_in(p, l, m) + lane; const f32x4* md = (const f32x4*)modrow(p, l, m) + lane;
        const bf16_t* orow = p.O + (size_t)m * D + 4 * lane;
#pragma unroll
        for (int j = 0; j < DV; ++j) v[r][j] = xr[64 * j] * ALPHA + md[2 * (D / 4) + 64 * j] * ld_bf16x4(orow + 256 * j); }
#pragma unroll
    for (int r = 0; r < R; ++r) row_stats(v[r], mu[r], rstd[r]);
#pragma unroll
    for (int r = 0; r < R; ++r) { const int m = m0 + r; f32x4* x1 = (f32x4*)((m < TL) ? p.out + (size_t)m * D : p.XC + (size_t)(m - TL) * D) + lane;
#pragma unroll
        for (int j = 0; j < DV; ++j) { v[r][j] = (v[r][j] - mu[r]) * rstd[r] * g1[64 * j] + b1[64 * j]; x1[64 * j] = v[r][j]; } }
#pragma unroll
    for (int r = 0; r < R; ++r) row_stats(v[r], mu[r], rstd[r]);
#pragma unroll
    for (int r = 0; r < R; ++r) { const int m = m0 + r; const f32x4* md = (const f32x4*)modrow(p, l, m) + lane;
#pragma unroll
        for (int j = 0; j < DV; ++j) {
            const f32x4 hv = (v[r][j] - mu[r]) * rstd[r] * (md[4 * (D / 4) + 64 * j] + 1.0f) + md[3 * (D / 4) + 64 * j];
            f32x4 hh, lo;
#pragma unroll
            for (int e = 0; e < 4; ++e) { hh[e] = bf2f(f2bf(hv[e])); lo[e] = hv[e] - hh[e]; }
            st_bf16x4(p.H + (size_t)m * D + 4 * (lane + 64 * j), hh);
            st_bf16x4(p.HLO + (size_t)m * D + 4 * (lane + 64 * j), lo);
        } }
}

__device__ __forceinline__ int router_rpg(int nrows) { const int g = gridDim.x; return (nrows % g == 0 && nrows / g <= 48 && (nrows / g) % 4 == 0) ? nrows / g : 32; }
__device__ __forceinline__ void g_router(const Params& p, int l, int nrows, char* lds) {
    const int tid_ = opq_tid(), bid_ = opq_bid(); (void)tid_; (void)bid_;
    const int lane = tid_ & 63, wid = tid_ >> 6, fr = lane & 15, fq = lane >> 4;
    const int RPG = router_rpg(nrows), RW = RPG / 4;
    float* part = (float*)lds;
    float* lgt = part + 4 * 9 * 64 * 4;
    int* eids = (int*)(lgt + 48 * 48);
    for (int rg = bid_; rg < nrows / RPG; rg += gridDim.x) {
#pragma unroll 1
        for (int i = 0; i + 1 < RW; i += 2) pm_rows<2>(p, l, rg * RPG + wid * RW + i, lane);
        if (RW & 1) pm_rows<1>(p, l, rg * RPG + wid * RW + RW - 1, lane);
        asm volatile("s_waitcnt vmcnt(0)" ::: "memory");
        __syncthreads();
        f32x4 acc[3][3];
#pragma unroll
        for (int a = 0; a < 3; ++a)
#pragma unroll
            for (int b = 0; b < 3; ++b) acc[a][b] = (f32x4){0.f, 0.f, 0.f, 0.f};
        int arow[3];
#pragma unroll
        for (int a = 0; a < 3; ++a) { const int rr = a * 16 + fr; arow[a] = rg * RPG + (rr < RPG ? rr : RPG - 1); }
#pragma unroll
        for (int seg = 0; seg < 3; ++seg) {
            const bf16_t* ab = (seg < 2 ? p.H : p.HLO) + wid * (D / 4) + fq * 8;
            const bf16_t* bp = p.wrt + (seg == 1 ? (size_t)128 * D : 0) + (size_t)fr * D + wid * (D / 4) + fq * 8;
#pragma unroll 1
            for (int ks0 = 0; ks0 < D / 128; ks0 += 2) {
                bf16x8 av[2][3], bv[2][3];
#pragma unroll
                for (int u = 0; u < 2; ++u) { const int ko = (ks0 + u) * 32;
#pragma unroll
                    for (int a = 0; a < 3; ++a) { av[u][a] = *(const bf16x8*)(ab + (size_t)arow[a] * D + ko); bv[u][a] = *(const bf16x8*)(bp + (size_t)(16 * a) * D + ko); } }
                asm volatile("" ::: "memory");
#pragma unroll
                for (int u = 0; u < 2; ++u)
#pragma unroll
                    for (int a = 0; a < 3; ++a)
#pragma unroll
                        for (int b = 0; b < 3; ++b) acc[a][b] = __builtin_amdgcn_mfma_f32_16x16x32_bf16(av[u][a], bv[u][b], acc[a][b], 0, 0, 0);
            }
        }
#pragma unroll
        for (int a = 0; a < 3; ++a)
#pragma unroll
            for (int b = 0; b < 3; ++b) *(f32x4*)(part + ((wid * 9 + a * 3 + b) * 64 + lane) * 4) = acc[a][b];
        __syncthreads();
#pragma unroll
        for (int i = 0; i < 9; ++i) { const int e = tid_ + 256 * i, f = e >> 8, ln = (e & 255) >> 2, j = e & 3;
            const float sm = (part[((0 * 9 + f) * 64 + ln) * 4 + j] + part[((1 * 9 + f) * 64 + ln) * 4 + j]) + (part[((2 * 9 + f) * 64 + ln) * 4 + j] + part[((3 * 9 + f) * 64 + ln) * 4 + j]);
            lgt[((f / 3) * 16 + (ln >> 4) * 4 + j) * 48 + (f % 3) * 16 + (ln & 15)] = sm; }
        __syncthreads();
        if (tid_ < RPG) {
            const int m = rg * RPG + tid_; const float* lg = lgt + tid_ * 48;
            float gl[4], el[32];
#pragma unroll
            for (int g = 0; g < 4; ++g) gl[g] = lg[g] + p.b_rg[l * 4 + g];
#pragma unroll
            for (int e = 0; e < 32; ++e) el[e] = lg[4 + e] + p.b_re[l * 32 + e];
            int gs = 0; float gm = gl[0];
#pragma unroll
            for (int g = 1; g < 4; ++g) if (gl[g] > gm) { gm = gl[g]; gs = g; }
            float den = 0.f;
#pragma unroll
            for (int g = 0; g < 4; ++g) den += expf(gl[g] - gm);
            const float pg = 1.0f / den;
            float v1 = -3e38f, v2 = -3e38f; int i1 = 0, i2 = 0;
#pragma unroll
            for (int j = 0; j < 8; ++j) {
                const float vv = gs == 0 ? el[j] : gs == 1 ? el[8 + j] : gs == 2 ? el[16 + j] : el[24 + j];
                if (vv > v1) { v2 = v1; i2 = i1; v1 = vv; i1 = j; } else if (vv > v2) { v2 = vv; i2 = j; }
            }
            const float e2 = expf(v2 - v1), w1 = pg / (1.0f + e2), w2 = pg * e2 / (1.0f + e2);
            const int ea = gs * 8 + i1, eb = gs * 8 + i2;
            p.rE[2 * m] = ea; p.rE[2 * m + 1] = eb; p.rW[2 * m] = w1; p.rW[2 * m + 1] = w2;
            eids[2 * tid_] = ea; eids[2 * tid_ + 1] = eb;
        }
        __syncthreads();
        if (tid_ < 2 * RPG) { const int e = eids[tid_]; int rk = 0; for (int j = 0; j < tid_; ++j) rk += (eids[j] == e) ? 1 : 0; p.rPos[2 * (rg * RPG) + tid_] = rk; }
        else if (tid_ >= 128 && tid_ < 160) { const int e = tid_ - 128; int c = 0; for (int j = 0; j < 2 * RPG; ++j) c += (eids[j] == e) ? 1 : 0; p.hist[rg * 32 + e] = c; }
        __syncthreads();
    }
}

__device__ __forceinline__ void ph_dispatch_fast(const Params& p, int l, int nrows, char* lds) {
    const int tid_ = opq_tid(), bid_ = opq_bid(); (void)tid_; (void)bid_;
    const int RPG = router_rpg(nrows), nrg = nrows / RPG, e = tid_ & 31, part = tid_ >> 5;
    int* tot = (int*)lds; int* pst = tot + 32; int* pre = pst + 32; int* red = pre + 32;
    { int s = 0; for (int b = part; b < nrg; b += 8) s += p.hist[b * 32 + e]; red[part * 32 + e] = s; }
    __syncthreads();
    if (tid_ < 32) { int s = 0; for (int q = 0; q < 8; ++q) s += red[q * 32 + tid_]; tot[tid_] = s; }
    __syncthreads();
    if (tid_ < 32) { int s = 0; for (int j = 0; j < tid_; ++j) s += (tot[j] + 127) & ~127; pst[tid_] = s; if (bid_ == 0) p.cnt[l * NEXP + tid_] = tot[tid_]; }
    for (int rg = bid_; rg < nrg; rg += gridDim.x) {
        __syncthreads();
        { int s = 0; for (int b = part; b < rg; b += 8) s += p.hist[b * 32 + e]; red[part * 32 + e] = s; }
        __syncthreads();
        if (tid_ < 32) { int s = 0; for (int q = 0; q < 8; ++q) s += red[q * 32 + tid_]; pre[tid_] = s; }
        __syncthreads();
        if (tid_ < 2 * RPG) { const int i = 2 * (rg * RPG) + tid_, ee = p.rE[i], slot = pst[ee] + pre[ee] + p.rPos[i]; p.rSlot[i] = slot; p.slotTok[slot] = i >> 1; }
    }
}

__device__ __forceinline__ void ph_final_fast(const Params& p, int l, int nrows, bool next_h) {
    const int tid_ = opq_tid(), bid_ = opq_bid(); (void)tid_; (void)bid_;
    const int lane = tid_ & 63, gw = bid_ * 4 + (tid_ >> 6), nw = gridDim.x * 4;
    constexpr int R = 2;
    const f32x4* g2 = (const f32x4*)(p.ln2_g + (size_t)l * D) + lane; const f32x4* b2 = (const f32x4*)(p.ln2_b + (size_t)l * D) + lane;
    for (int m0 = gw * R; m0 < nrows; m0 += nw * R) {
        f32x4 v[R][DV]; float mu[R], rstd[R];
#pragma unroll
        for (int r = 0; r < R; ++r) { const int m = m0 + r; const f32x4* x1 = (const f32x4*)((m < TL) ? p.out + (size_t)m * D : p.XC + (size_t)(m - TL) * D) + lane;
            const f32x4* md = (const f32x4*)modrow(p, l, m) + lane;
            const bf16_t* ya = p.YSb + (size_t)p.rSlot[2 * m] * D + 4 * lane; const bf16_t* yb = p.YSb + (size_t)p.rSlot[2 * m + 1] * D + 4 * lane;
            const float wa = p.rW[2 * m], wb = p.rW[2 * m + 1];
#pragma unroll
            for (int j = 0; j < DV; ++j) v[r][j] = x1[64 * j] * ALPHA + md[5 * (D / 4) + 64 * j] * (ld_bf16x4(ya + 256 * j) * wa + ld_bf16x4(yb + 256 * j) * wb); }
#pragma unroll
        for (int r = 0; r < R; ++r) row_stats(v[r], mu[r], rstd[r]);
#pragma unroll
        for (int r = 0; r < R; ++r) { const int m = m0 + r; f32x4* x1 = (f32x4*)((m < TL) ? p.out + (size_t)m * D : p.XC + (size_t)(m - TL) * D) + lane;
#pragma unroll
            for (int j = 0; j < DV; ++j) { v[r][j] = (v[r][j] - mu[r]) * rstd[r] * g2[64 * j] + b2[64 * j]; x1[64 * j] = v[r][j]; } }
        if (next_h) {
#pragma unroll
            for (int r = 0; r < R; ++r) row_stats(v[r], mu[r], rstd[r]);
#pragma unroll
            for (int r = 0; r < R; ++r) { const int m = m0 + r; const f32x4* mn = (const f32x4*)modrow(p, l + 1, m) + lane;
#pragma unroll
                for (int j = 0; j < DV; ++j) st_bf16x4(p.H + (size_t)m * D + 4 * (lane + 64 * j), (v[r][j] - mu[r]) * rstd[r] * (mn[D / 4 + 64 * j] + 1.0f) + mn[64 * j]); }
        }
    }
}

__device__ __forceinline__ void ph_mod_fast(const Params& p, char* lds) {
    const int tid_ = opq_tid(), bid_ = opq_bid(); (void)tid_; (void)bid_;
    constexpr int NR = NB + 1, NTASK = 2 * (6 * D / 64);
    if (bid_ >= NTASK) return;
    float* sc = (float*)lds;
    float* part = sc + NR * D;
    for (int i = tid_; i < NR * D; i += 256) { const int b = i / D, k = i % D; const float cv = b < NB ? p.c[(size_t)b * D + k] : p.c_ctx[k]; sc[i] = cv / (1.0f + __expf(-cv)); }
    __syncthreads();
    const int lane = tid_ & 63, wid = tid_ >> 6;
    for (int task = bid_; task < NTASK; task += gridDim.x) {
        const int ll = task / (6 * D / 64), col = 64 * (task % (6 * D / 64)) + lane;
        float acc[NR];
#pragma unroll
        for (int b = 0; b < NR; ++b) acc[b] = 0.f;
        const float* wp = p.w_mod + ((size_t)ll * D + wid * (D / 4)) * 6 * D + col;
#pragma unroll 16
        for (int k = 0; k < D / 4; ++k) { const float w = wp[(size_t)k * 6 * D];
#pragma unroll
            for (int b = 0; b < NR; ++b) acc[b] += sc[b * D + wid * (D / 4) + k] * w; }
#pragma unroll
        for (int b = 0; b < NR; ++b) part[(wid * NR + b) * 64 + lane] = acc[b];
        __syncthreads();
        for (int i = tid_; i < NR * 64; i += 256) { const int b = i / 64, cl = i % 64;
            p.mod[((size_t)ll * NR + b) * 6 * D + 64 * (task % (6 * D / 64)) + cl] = (part[(0 * NR + b) * 64 + cl] + part[(1 * NR + b) * 64 + cl]) + (part[(2 * NR + b) * 64 + cl] + part[(3 * NR + b) * 64 + cl]) + p.b_mod[(size_t)ll * 6 * D + 64 * (task % (6 * D / 64)) + cl]; }
        __syncthreads();
    }
}

template <bool SPLIT = false>
__device__ __forceinline__ void tr_item(const float* srcl, size_t ldw, bf16_t* dst, size_t ldd, float* scr, int lane) {
    float v[32];
#pragma unroll
    for (int i = 0; i < 32; ++i) v[i] = srcl ? srcl[(size_t)(2 * i + (lane >> 5)) * ldw] : 0.f;
#pragma unroll
    for (int i = 0; i < 32; ++i) scr[(2 * i + (lane >> 5)) * 33 + (lane & 31)] = v[i];
    LDS_WAIT();
    const int c = lane & 7;
#pragma unroll
    for (int j = 0; j < 4; ++j) { const int n = (lane >> 3) + 8 * j; const float* s = scr + (8 * c) * 33 + n;
        uint4 o; o.x = pk2(s[0], s[33]); o.y = pk2(s[2 * 33], s[3 * 33]); o.z = pk2(s[4 * 33], s[5 * 33]); o.w = pk2(s[6 * 33], s[7 * 33]);
        *(uint4*)(dst + (size_t)(SPLIT ? (n & 15) + 32 * (n >> 4) : n) * ldd + 8 * c) = o; }
    LDS_WAIT();
}
__device__ __forceinline__ void ph_prep_w_fast(const Params& p, int l, int part, char* lds) {
    const int tid_ = opq_tid(), bid_ = opq_bid(); (void)tid_; (void)bid_;
    const int lane = tid_ & 63, wid = tid_ >> 6, gw = bid_ * 4 + wid, nw = gridDim.x * 4;
    float* scr = (float*)(lds + wid * 8448);
    constexpr int I_IN = (D / 64) * (NINP / 32), I_OUT = (DMIX / 64) * (D / 32), I_GU1 = (D / 64) * (2 * DE / 32), I_D1 = (DE / 64) * (D / 32);
    constexpr int NITEMS = I_IN + I_OUT + NEXP * (I_GU1 + I_D1);
    const int it0 = part == 0 ? 0 : I_IN + I_OUT, it1 = part == 0 ? I_IN + I_OUT : NITEMS;
    for (int it = it0 + gw; it < it1; it += nw) {
        int r = it;
        if (r < I_IN) { const int kb = r / (NINP / 32), n0 = 32 * (r % (NINP / 32));
            const float* s = nullptr;
            if (n0 < N_IN) { const int oc = (n0 < ZA) ? n0 + A_IN : n0 - ZA; s = p.w_in + ((size_t)l * D + 64 * kb) * N_IN + oc + (lane & 31); }
            tr_item(s, N_IN, p.win_t + (size_t)n0 * D + 64 * kb, D, scr, lane); continue; }
        r -= I_IN;
        if (r < I_OUT) { const int kb = r / (D / 32), n0 = 32 * (r % (D / 32));
            tr_item(p.w_out + ((size_t)l * DMIX + 64 * kb) * D + n0 + (lane & 31), D, p.wout_t + (size_t)n0 * DMIX + 64 * kb, DMIX, scr, lane); continue; }
        r -= I_OUT;
        const int e = r / (I_GU1 + I_D1); r %= (I_GU1 + I_D1);
        if (r < I_GU1) { const int kb = r / (2 * DE / 32), q = r % (2 * DE / 32), up = q & 1, c0 = 32 * (q >> 1);
            const float* s = (up ? p.w_up : p.w_gate) + (((size_t)l * NEXP + e) * D + 64 * kb) * DE + c0 + (lane & 31);
            tr_item<true>(s, DE, p.wgu_t + ((size_t)e * 2 * DE + 2 * c0 + 16 * up) * D + 64 * kb, D, scr, lane); continue; }
        r -= I_GU1;
        { const int kb = r / (D / 32), n0 = 32 * (r % (D / 32));
            tr_item(p.w_down + (((size_t)l * NEXP + e) * DE + 64 * kb) * D + n0 + (lane & 31), D, p.wd_t + ((size_t)e * D + n0) * DE + 64 * kb, DE, scr, lane); }
    }
    if (part != 0) return;
    const long gt = (long)bid_ * blockDim.x + tid_, gs = (long)gridDim.x * blockDim.x;
    for (long i = gt; i < 2 * 256 * 64; i += gs) { const int k = (int)(i & 63), n = (int)((i >> 6) & 255), d = (int)(i >> 14);
        p.wupT[i] = f2bf(p.a_w_up[(((size_t)l * 2 + d) * 64 + k) * DA + n]); p.aupT[i] = f2bf(p.a_a_up[(((size_t)l * 2 + d) * 64 + k) * DA + n]); }
    for (long i = gt; i < 256 * 160; i += gs) { const int k = (int)(i % 160), n = (int)(i / 160); p.gupT[i] = f2bf(p.a_g_up[((size_t)l * 160 + k) * DA + n]); }
    for (long i = gt; i < (long)128 * D; i += gs) { const int n = (int)(i / D), k = (int)(i % D);
        const float w = n < 4 ? p.w_rg[((size_t)l * D + k) * 4 + n] : n < 36 ? p.w_re[((size_t)l * D + k) * 32 + n - 4] : 0.f;
        const bf16_t hb = f2bf(w); p.wrt[i] = hb; p.wrt[(size_t)128 * D + i] = f2bf(w - bf2f(hb)); }
}

__device__ __forceinline__ float tanh_fast(float x) { return 1.0f - 2.0f / (1.0f + __expf(2.0f * x)); }
__device__ __forceinline__ void ph_streams_s1(const Params& p, int l) {
    const int tid_ = opq_tid(), bid_ = opq_bid(); (void)tid_; (void)bid_;
    constexpr int NCH = A_IN / 8, NCHP = (NCH + 7) & ~7;
    const float* sh = p.a_shift + (size_t)l * 3 * A_IN;
    for (long it = (long)bid_ * 256 + tid_; it < (long)T * NCHP; it += (long)gridDim.x * 256) {
        const int m = (int)(it / NCHP), ch = (int)(it % NCHP), c0 = 8 * ch;
        const bool act = ch < NCH;
        int t, len;
        if (m < TL) { t = m % S; len = S; } else { t = (m - TL) % L; len = L; }
        float v[8];
#pragma unroll
        for (int e = 0; e < 8; ++e) v[e] = 0.f;
        if (act) {
            const bf16_t* z = p.Z + (size_t)m * ZP + ZA + c0;
            const bf16x8 zc = *(const bf16x8*)z;
            const f32x4 s1a = *(const f32x4*)(sh + A_IN + c0), s1b = *(const f32x4*)(sh + A_IN + c0 + 4);
#pragma unroll
            for (int e = 0; e < 8; ++e) v[e] = (e < 4 ? s1a[e] : s1b[e - 4]) * bf2f((bf16_t)zc[e]);
            if (t > 0) { const bf16x8 zp = *(const bf16x8*)(z - ZP); const f32x4 a = *(const f32x4*)(sh + c0), b = *(const f32x4*)(sh + c0 + 4);
#pragma unroll
                for (int e = 0; e < 8; ++e) v[e] += (e < 4 ? a[e] : b[e - 4]) * bf2f((bf16_t)zp[e]); }
            if (t < len - 1) { const bf16x8 zn = *(const bf16x8*)(z + ZP); const f32x4 a = *(const f32x4*)(sh + 2 * A_IN + c0), b = *(const f32x4*)(sh + 2 * A_IN + c0 + 4);
#pragma unroll
                for (int e = 0; e < 8; ++e) v[e] += (e < 4 ? a[e] : b[e - 4]) * bf2f((bf16_t)zn[e]); }
        }
        float nrm = 0.f;
        if (ch >= 32 && ch < 64) {
#pragma unroll
            for (int e = 0; e < 8; ++e) { const float t2 = v[e] * p.a_k_k[l * DA + c0 - 256 + e]; nrm += t2 * t2; } }
        nrm = sum8(nrm);
        if (!act) continue;
        if (c0 < 768) {
            float* dst = (c0 < 256 ? p.sR + (size_t)m * DA + c0 : c0 < 512 ? p.kT + (size_t)m * DA + c0 - 256 : p.sV + (size_t)m * DA + c0 - 512);
            *(f32x4*)dst = (f32x4){v[0], v[1], v[2], v[3]}; *(f32x4*)(dst + 4) = (f32x4){v[4], v[5], v[6], v[7]};
            if (ch >= 32 && ch < 64 && (ch & 7) == 0) p.kN[(size_t)m * 4 + ((ch - 32) >> 3)] = 1.0f / sqrtf(nrm + 1e-12f);
        } else {
            if (c0 < 896) {
#pragma unroll
                for (int e = 0; e < 8; ++e) v[e] = tanh_fast(v[e]); }
            else if (c0 >= 1024) {
#pragma unroll
                for (int e = 0; e < 8; ++e) v[e] = 1.0f / (1.0f + __expf(-v[e])); }
            uint4 o; o.x = pk2(v[0], v[1]); o.y = pk2(v[2], v[3]); o.z = pk2(v[4], v[5]); o.w = pk2(v[6], v[7]);
            *(uint4*)(p.LA + (size_t)m * 416 + c0 - 768) = o;
        }
    }
}
__device__ __forceinline__ void g_streams_s2(const Params& p, int l, char* lds) {
    const int tid_ = opq_tid(), bid_ = opq_bid(); (void)tid_; (void)bid_;
    constexpr int MT = T / 128;
    for (int job = bid_; job < 5 * MT * 2; job += gridDim.x) {
        const int type = job / (MT * 2), r = job % (MT * 2), tm = r >> 1, tn = r & 1;
        const int coff = type < 2 ? type * 64 : type < 4 ? 128 + (type - 2) * 64 : 256, K = type < 4 ? 64 : 160, d = type & 1;
        const bf16_t* Bt = type < 2 ? p.wupT + type * 256 * 64 : type < 4 ? p.aupT + (type - 2) * 256 * 64 : p.gupT;
        const bf16_t* a0 = p.LA + (size_t)(tm * 128 + STG_ROW(0)) * 416 + coff + STG_K; const bf16_t* a1 = p.LA + (size_t)(tm * 128 + STG_ROW(1)) * 416 + coff + STG_K;
        const bf16_t* b0 = Bt + (size_t)(tn * 128 + STG_ROW(0)) * K + STG_K; const bf16_t* b1 = Bt + (size_t)(tn * 128 + STG_ROW(1)) * K + STG_K;
        if (type < 2) gemm_tile(a0, a1, b0, b1, K, lds, [&](const f32x4 (&acc)[4][4], int wr, int wc, int fr, int fq) {
#pragma unroll
            for (int mi = 0; mi < 4; ++mi) { const int row = tm * 128 + wr * 64 + mi * 16 + fr;
#pragma unroll
                for (int n = 0; n < 4; ++n) { const int c = tn * 128 + wc * 64 + n * 16 + 4 * fq; const f32x4 w0 = *(const f32x4*)(p.a_w0 + (l * 2 + d) * DA + c); f32x4 o;
#pragma unroll
                    for (int e4 = 0; e4 < 4; ++e4) { const float ex = __expf(-(w0[e4] + acc[mi][n][e4]));
                        o[e4] = __expf(-0.60653065971f / (1.0f + ex)); }
                    *(f32x4*)(p.sW + ((size_t)d * T + row) * DA + c) = o; }
                asm volatile("" ::: "memory"); }
        });
        else if (type < 4) gemm_tile(a0, a1, b0, b1, K, lds, [&](const f32x4 (&acc)[4][4], int wr, int wc, int fr, int fq) {
#pragma unroll
            for (int mi = 0; mi < 4; ++mi) { const int row = tm * 128 + wr * 64 + mi * 16 + fr;
#pragma unroll
                for (int n = 0; n < 4; ++n) { const int c = tn * 128 + wc * 64 + n * 16 + 4 * fq;
                    const f32x4 a0v = *(const f32x4*)(p.a_a0 + (l * 2 + d) * DA + c), kkc = *(const f32x4*)(p.a_k_k + l * DA + c), kac = *(const f32x4*)(p.a_k_a + l * DA + c);
                    const size_t o = (size_t)row * DA + c, od = ((size_t)d * T + row) * DA + c;
                    const f32x4 k = *(const f32x4*)(p.kT + o); const float kn = p.kN[(size_t)row * 4 + (c >> 6)];
                    f32x4 kd, bo, kk;
#pragma unroll
                    for (int e4 = 0; e4 < 4; ++e4) { const float av = 1.0f / (1.0f + __expf(-(a0v[e4] + acc[mi][n][e4])));
                        kk[e4] = k[e4] * kkc[e4] * kn; kd[e4] = k[e4] * (1.0f + (av - 1.0f) * kac[e4]); bo[e4] = kk[e4] * av; }
                    *(f32x4*)(p.sKD + od) = kd; *(f32x4*)(p.sB + od) = bo; if (d == 0) *(f32x4*)(p.sKK + o) = kk; }
                asm volatile("" ::: "memory"); }
        });
        else gemm_tile(a0, a1, b0, b1, K, lds, [&](const f32x4 (&acc)[4][4], int wr, int wc, int fr, int fq) {
#pragma unroll
            for (int mi = 0; mi < 4; ++mi)
#pragma unroll
                for (int n = 0; n < 4; ++n) st_bf16x4(p.MIX + (size_t)(tm * 128 + wr * 64 + mi * 16 + fr) * DMIX + tn * 128 + wc * 64 + n * 16 + 4 * fq, acc[mi][n]);
        });
    }
}


typedef float f32x16 __attribute__((ext_vector_type(16)));
typedef short s16x4 __attribute__((ext_vector_type(4)));
typedef unsigned u32x4_t __attribute__((ext_vector_type(4)));
typedef float f32x2_t __attribute__((ext_vector_type(2)));
typedef __bf16 bf16x2_t __attribute__((ext_vector_type(2)));
__device__ __forceinline__ unsigned cvtpk(float lo, float hi) { f32x2_t v = {lo, hi}; bf16x2_t b = __builtin_convertvector(v, bf16x2_t); return __builtin_bit_cast(unsigned, b); }
__device__ __forceinline__ int crow(int r, int hi) { return (r & 3) + 8 * (r >> 2) + 4 * hi; }
__device__ __forceinline__ float xmax32(float v) { float a = v, b = v; asm volatile("s_nop 1\n\tv_permlane32_swap_b32 %0, %1" : "+v"(a), "+v"(b)); return fmaxf(a, b); }
__device__ __forceinline__ float xsum32(float v) { float a = v, b = v; asm volatile("s_nop 1\n\tv_permlane32_swap_b32 %0, %1" : "+v"(a), "+v"(b)); return a + b; }

struct NoMask { __device__ __forceinline__ float operator()(int, float v) const { return v; } };

template <class MaskF>
__device__ __forceinline__ void attn_tile_lds(const bf16x8 (&qf)[4], const char* ks, const char* vs, const MaskF& mask, float& m_run, float& l_run, f32x16& o0, f32x16& o1, int ql, int hi) {
    f32x16 s;
#pragma unroll
    for (int r = 0; r < 16; ++r) s[r] = 0.f;
#pragma unroll
    for (int k4 = 0; k4 < 4; ++k4) { const bf16x8 kf = *(const bf16x8*)(ks + ql * 128 + (((2 * k4 + hi) ^ (ql & 7)) * 16)); s = __builtin_amdgcn_mfma_f32_32x32x16_bf16(kf, qf[k4], s, 0, 0, 0); }
    float mx = -INFINITY;
#pragma unroll
    for (int r = 0; r < 16; ++r) { s[r] = mask(crow(r, hi), s[r]); mx = fmaxf(mx, s[r]); }
    mx = xmax32(mx);
    if (__any(mx > m_run)) {
        const float mn = fmaxf(m_run, mx), alpha = __builtin_amdgcn_exp2f(m_run - mn);
        m_run = mn; l_run *= alpha;
#pragma unroll
        for (int r = 0; r < 16; ++r) { o0[r] *= alpha; o1[r] *= alpha; }
    }
    float ps = 0.f;
#pragma unroll
    for (int r = 0; r < 16; ++r) { s[r] = __builtin_amdgcn_exp2f(s[r] - m_run); ps += s[r]; }
    l_run += ps;
    const int sw0 = (ql >> 2) & 3;
#pragma unroll
    for (int s2 = 0; s2 < 2; ++s2) {
        u32x4_t pw; pw[0] = cvtpk(s[8 * s2], s[8 * s2 + 1]); pw[1] = cvtpk(s[8 * s2 + 2], s[8 * s2 + 3]); pw[2] = cvtpk(s[8 * s2 + 4], s[8 * s2 + 5]); pw[3] = cvtpk(s[8 * s2 + 6], s[8 * s2 + 7]);
        const bf16x8 pb = __builtin_bit_cast(bf16x8, pw);
        const char* v0 = vs + ql * 64 + 8 * hi; const char* v1 = v0 + 32 * 64;
        const s16x4 a0 = *(const s16x4*)(v0 + (((2 * s2) ^ sw0) * 16)), a1 = *(const s16x4*)(v0 + (((2 * s2 + 1) ^ sw0) * 16));
        const s16x4 c0 = *(const s16x4*)(v1 + (((2 * s2) ^ sw0) * 16)), c1 = *(const s16x4*)(v1 + (((2 * s2 + 1) ^ sw0) * 16));
        o0 = __builtin_amdgcn_mfma_f32_32x32x16_bf16(__builtin_shufflevector(a0, a1, 0, 1, 2, 3, 4, 5, 6, 7), pb, o0, 0, 0, 0);
        o1 = __builtin_amdgcn_mfma_f32_32x32x16_bf16(__builtin_shufflevector(c0, c1, 0, 1, 2, 3, 4, 5, 6, 7), pb, o1, 0, 0, 0);
    }
}

__device__ __forceinline__ void ph_attn_blk(const Params& p, int l, bool with_ctx, int first_blk, char* lds) {
    const int tid_ = opq_tid(), bid_ = opq_bid(); (void)tid_; (void)bid_;
    if (bid_ < first_blk) return;
    const int lane = tid_ & 63, hi = lane >> 5, ql = lane & 31, wid = tid_ >> 6;
    constexpr int NQG = S / 128, NCG = L / 128, ROWS = S / GRID_W, N_LAT = NB * 6 * NQG, N_CTX = NB * 6 * NCG, TPB = (S + L) / 32;
    const int ntask = 2 * N_LAT + (with_ctx ? 2 * N_CTX : 0);
    const int krow = tid_ >> 3, kch = (tid_ & 7) ^ (krow & 7), vrow = tid_ >> 2, vpc = (tid_ & 3) ^ ((vrow >> 2) & 3);
    for (int task = bid_ - first_blk; task < ntask; task += gridDim.x - first_blk) {
        bool isC, isCtx; int r;
        if (task < N_LAT) { isC = true; isCtx = false; r = task; }
        else if (task < 2 * N_LAT) { isC = false; isCtx = false; r = task - N_LAT; }
        else { r = task - 2 * N_LAT; isCtx = true; isC = r >= N_CTX; if (isC) r -= N_CTX; }
        const int ng = isCtx ? NCG : NQG, g = r % ng, h = (r / ng) % 6, b = r / (ng * 6);
        const int qt = 4 * g + wid;
        const int m = isCtx ? TL + b * L + 32 * qt + ql : b * S + 32 * qt + ql;
        const int qcol = isC ? ZQN + h * 64 : ZQB + h * 64, kcol = isC ? ZKN + h * 64 : ZKB + (h / 3) * 64, hv = isC ? 2 + h : h / 3;
        bf16x8 qf[4];
        { const bf16_t* qp = p.Z + (size_t)m * ZP + qcol + 8 * hi;
#pragma unroll
          for (int k4 = 0; k4 < 4; ++k4) qf[k4] = *(const bf16x8*)(qp + 16 * k4); }
        int lo = 0, hi_t = 0, gr0 = 0;
        if (!isCtx) {
            if (!isC) { lo = 4 * g - 4; hi_t = 4 * g + 8; lo = lo < 0 ? 0 : lo; hi_t = hi_t > S / 32 ? S / 32 : hi_t; }
            else { const int ra = 2 * g, rb = 2 * g + 1; int r0a = ra - 4; r0a = r0a < 0 ? 0 : (r0a > ROWS - 8 ? ROWS - 8 : r0a); int r0b = rb - 4; r0b = r0b < 0 ? 0 : (r0b > ROWS - 8 ? ROWS - 8 : r0b);
                   lo = 2 * r0a; hi_t = 2 * (r0b + 8); gr0 = 0; }
        }
        const int ntile = L / 32 + (hi_t - lo);
        const bf16_t* kbase = p.Z + (size_t)krow * ZP + kcol + 8 * kch;
        const bf16_t* vbase = p.VT + ((size_t)(b * 8 + hv) * 64 + vrow) * PU + 8 * vpc;
#define AT_TOK(i_) ((i_) < L / 32 ? 32 * (i_) : L + 32 * (lo + (i_) - L / 32))
#define AT_STAGE(i_) do { const int u0_ = AT_TOK(i_); const int zrow_ = u0_ < L ? TL + b * L + u0_ : b * S + (u0_ - L); char* sl_ = lds + ((i_) % 3) * 8192 + tid_ * 16; \
            __builtin_amdgcn_global_load_lds((const unsigned*)(kbase + (size_t)zrow_ * ZP), (__attribute__((address_space(3))) unsigned*)(sl_), 16, 0, 0); \
            __builtin_amdgcn_global_load_lds((const unsigned*)(vbase + u0_), (__attribute__((address_space(3))) unsigned*)(sl_ + 4096), 16, 0, 0); } while (0)
        f32x16 o0, o1;
#pragma unroll
        for (int rr = 0; rr < 16; ++rr) { o0[rr] = 0.f; o1[rr] = 0.f; }
        float m_run, l_run;
        if (isC) { m_run = -1e30f; l_run = 0.f; } else { m_run = p.b_sink[l * 6 + h] * LOG2E; l_run = hi == 0 ? 1.0f : 0.f; }
        const int gr = qt >> 1, c = 32 * (qt & 1) + ql;
        int r0 = gr - 4; r0 = r0 < 0 ? 0 : (r0 > ROWS - 8 ? ROWS - 8 : r0);
        int c0 = c - 8; c0 = c0 < 0 ? 0 : (c0 > GRID_W - 16 ? GRID_W - 16 : c0);
        float* rpb = (float*)(lds + 24576);
        if (isC && !isCtx) for (int i = tid_; i < 15 * 31; i += 256) rpb[i] = p.c_rpb[((size_t)l * 6 + h) * 15 * 31 + i] * LOG2E;
        AT_STAGE(0);
        if (ntile > 1) AT_STAGE(1);
#pragma unroll 1
        for (int i = 0; i < ntile; ++i) {
            if (i + 1 < ntile) asm volatile("s_waitcnt vmcnt(2)" ::: "memory"); else asm volatile("s_waitcnt vmcnt(0)" ::: "memory");
            asm volatile("s_waitcnt lgkmcnt(0)" ::: "memory");
            __builtin_amdgcn_s_barrier();
            if (i + 2 < ntile) AT_STAGE(i + 2);
            const char* ks = lds + (i % 3) * 8192; const char* vs = ks + 4096;
            if (i < L / 32) attn_tile_lds(qf, ks, vs, NoMask(), m_run, l_run, o0, o1, ql, hi);
            else {
                const int jt = lo + i - L / 32;
                if (!isC) {
                    const int dq = jt - qt;
                    if (dq >= -3 && dq <= 3) attn_tile_lds(qf, ks, vs, NoMask(), m_run, l_run, o0, o1, ql, hi);
                    else if (dq == -4 || dq == 4) { const int base = 32 * dq - ql;
                        attn_tile_lds(qf, ks, vs, [&](int ko, float v) { const int rel = base + ko; return (rel >= -128 && rel <= 128) ? v : -INFINITY; }, m_run, l_run, o0, o1, ql, hi); }
                } else {
                    const int kr_ = jt >> 1, ct = jt & 1;
                    if (kr_ >= r0 && kr_ < r0 + 8) { const float* rp = rpb + (kr_ - gr + 7) * 31 + 15 - c;
                        attn_tile_lds(qf, ks, vs, [&](int ko, float v) { const int kc = 32 * ct + ko; int ix = kc - c + 15; ix = ix < 0 ? 0 : (ix > 30 ? 30 : ix); const float bs = rp[c - 15 + ix];
                                                     return (kc >= c0 && kc < c0 + 16) ? v + bs : -INFINITY; }, m_run, l_run, o0, o1, ql, hi); }
                }
            }
        }
        asm volatile("s_waitcnt lgkmcnt(0)" ::: "memory");
        __builtin_amdgcn_s_barrier();
#undef AT_STAGE
#undef AT_TOK
        (void)gr0;
        const float lt = xsum32(l_run), inv = 1.0f / lt;
        bf16_t* op = p.MIX + (size_t)m * DMIX + (isC ? 640 : 256) + h * 64 + 4 * hi;
#pragma unroll
        for (int gq = 0; gq < 4; ++gq) {
            st_bf16x4(op + 8 * gq, (f32x4){o0[4 * gq] * inv, o0[4 * gq + 1] * inv, o0[4 * gq + 2] * inv, o0[4 * gq + 3] * inv});
            st_bf16x4(op + 32 + 8 * gq, (f32x4){o1[4 * gq] * inv, o1[4 * gq + 1] * inv, o1[4 * gq + 2] * inv, o1[4 * gq + 3] * inv});
        }
    }
}

#define RNB " row_newbcast:%c[n] row_mask:0xf bank_mask:0xf\n\t"
template <int N, bool FIRST>
__device__ __forceinline__ void dpp_dot4(float& a0, float& a1, float& a2, float& a3, const f32x4& v, float s0, float s1, float s2, float s3) {
    if (FIRST) asm volatile("s_nop 1");
    asm("v_fmac_f32_dpp %0, %4, %8" RNB "v_fmac_f32_dpp %1, %5, %9" RNB "v_fmac_f32_dpp %2, %6, %10" RNB "v_fmac_f32_dpp %3, %7, %11" RNB
        : "+v"(a0), "+v"(a1), "+v"(a2), "+v"(a3) : "v"(v[0]), "v"(v[1]), "v"(v[2]), "v"(v[3]), "v"(s0), "v"(s1), "v"(s2), "v"(s3), [n] "i"(N));
}
template <int N, bool FIRST>
__device__ __forceinline__ void dpp_upd4s(float& s0, float& s1, float& s2, float& s3, float& y0, float& y1, float& y2, float& y3,
                                          const f32x4& w, const f32x4& b, const f32x4& kd, const f32x4& r, float nsk, float vv) {
    if (FIRST) asm volatile("s_nop 1");
    asm("v_mul_f32_dpp %0, %8, %0" RNB "v_mul_f32_dpp %1, %9, %1" RNB "v_mul_f32_dpp %2, %10, %2" RNB "v_mul_f32_dpp %3, %11, %3" RNB
        "v_fmac_f32_dpp %0, %12, %24" RNB "v_fmac_f32_dpp %1, %13, %24" RNB "v_fmac_f32_dpp %2, %14, %24" RNB "v_fmac_f32_dpp %3, %15, %24" RNB
        "v_fmac_f32_dpp %0, %16, %25" RNB "v_fmac_f32_dpp %1, %17, %25" RNB "v_fmac_f32_dpp %2, %18, %25" RNB "v_fmac_f32_dpp %3, %19, %25" RNB
        "v_fmac_f32_dpp %4, %20, %0" RNB "v_fmac_f32_dpp %5, %21, %1" RNB "v_fmac_f32_dpp %6, %22, %2" RNB "v_fmac_f32_dpp %7, %23, %3" RNB
        : "+v"(s0), "+v"(s1), "+v"(s2), "+v"(s3), "+v"(y0), "+v"(y1), "+v"(y2), "+v"(y3)
        : "v"(w[0]), "v"(w[1]), "v"(w[2]), "v"(w[3]), "v"(b[0]), "v"(b[1]), "v"(b[2]), "v"(b[3]), "v"(kd[0]), "v"(kd[1]), "v"(kd[2]), "v"(kd[3]),
          "v"(r[0]), "v"(r[1]), "v"(r[2]), "v"(r[3]), "v"(nsk), "v"(vv), [n] "i"(N));
}
template <int N, bool FIRST>
__device__ __forceinline__ void dpp_upd4p(float& s0, float& s1, float& s2, float& s3, float& y0, float& y1, float& y2, float& y3,
                                          const f32x4& w, const f32x4& b, const f32x4& r, float nsk) {
    if (FIRST) asm volatile("s_nop 1");
    asm("v_mul_f32_dpp %0, %8, %0" RNB "v_mul_f32_dpp %1, %9, %1" RNB "v_mul_f32_dpp %2, %10, %2" RNB "v_mul_f32_dpp %3, %11, %3" RNB
        "v_fmac_f32_dpp %0, %12, %20" RNB "v_fmac_f32_dpp %1, %13, %20" RNB "v_fmac_f32_dpp %2, %14, %20" RNB "v_fmac_f32_dpp %3, %15, %20" RNB
        "v_fmac_f32_dpp %4, %16, %0" RNB "v_fmac_f32_dpp %5, %17, %1" RNB "v_fmac_f32_dpp %6, %18, %2" RNB "v_fmac_f32_dpp %7, %19, %3" RNB
        : "+v"(s0), "+v"(s1), "+v"(s2), "+v"(s3), "+v"(y0), "+v"(y1), "+v"(y2), "+v"(y3)
        : "v"(w[0]), "v"(w[1]), "v"(w[2]), "v"(w[3]), "v"(b[0]), "v"(b[1]), "v"(b[2]), "v"(b[3]), "v"(r[0]), "v"(r[1]), "v"(r[2]), "v"(r[3]), "v"(nsk), [n] "i"(N));
}
template <int N, bool FIRST>
__device__ __forceinline__ void dpp_mul4(float& s0, float& s1, float& s2, float& s3, const f32x4& v) {
    if (FIRST) asm volatile("s_nop 1");
    asm("v_mul_f32_dpp %0, %4, %0" RNB "v_mul_f32_dpp %1, %5, %1" RNB "v_mul_f32_dpp %2, %6, %2" RNB "v_mul_f32_dpp %3, %7, %3" RNB
        : "+v"(s0), "+v"(s1), "+v"(s2), "+v"(s3) : "v"(v[0]), "v"(v[1]), "v"(v[2]), "v"(v[3]), [n] "i"(N));
}
template <int N>
__device__ __forceinline__ void dpp_fmacx4(float& s0, float& s1, float& s2, float& s3, const f32x4& v, float x) {
    asm("v_fmac_f32_dpp %0, %4, %8" RNB "v_fmac_f32_dpp %1, %5, %8" RNB "v_fmac_f32_dpp %2, %6, %8" RNB "v_fmac_f32_dpp %3, %7, %8" RNB
        : "+v"(s0), "+v"(s1), "+v"(s2), "+v"(s3) : "v"(v[0]), "v"(v[1]), "v"(v[2]), "v"(v[3]), "v"(x), [n] "i"(N));
}
template <int N> struct ScanRep {
    static __device__ __forceinline__ void dot8(float (&a)[8], const f32x4& v, const float (&st)[64]) {
        constexpr int h = (N & 1) * 4;
        dpp_dot4<N, N == 0>(a[h], a[h + 1], a[h + 2], a[h + 3], v, st[4 * N], st[4 * N + 1], st[4 * N + 2], st[4 * N + 3]);
        if constexpr (N < 15) ScanRep<N + 1>::dot8(a, v, st);
    }
    static __device__ __forceinline__ void dot(float& a0, float& a1, float& a2, float& a3, const f32x4& v, const float (&st)[64]) {
        dpp_dot4<N, N == 0>(a0, a1, a2, a3, v, st[4 * N], st[4 * N + 1], st[4 * N + 2], st[4 * N + 3]);
        if constexpr (N < 15) ScanRep<N + 1>::dot(a0, a1, a2, a3, v, st);
    }
    static __device__ __forceinline__ void mul(float (&st)[64], const f32x4& w) {
        dpp_mul4<N, N == 0>(st[4 * N], st[4 * N + 1], st[4 * N + 2], st[4 * N + 3], w);
        if constexpr (N < 15) ScanRep<N + 1>::mul(st, w);
    }
    static __device__ __forceinline__ void fmacx(float (&st)[64], const f32x4& v, float x) {
        dpp_fmacx4<N>(st[4 * N], st[4 * N + 1], st[4 * N + 2], st[4 * N + 3], v, x);
        if constexpr (N < 15) ScanRep<N + 1>::fmacx(st, v, x);
    }
};
__device__ __forceinline__ int scan_row(int b, int d, int pos) { return pos < L ? TL + b * L + (d ? L - 1 - pos : pos) : b * S + (d ? S - 1 - (pos - L) : pos - L); }

template <bool ISP>
__device__ __forceinline__ void scan_task(const Params& p, int c, int s, int lane) {
    const int h = c & 3, b = (c >> 2) % NB, d = (c >> 2) / NB, pos0 = SEGLEN * s;
    const int q = 4 * (lane & 15);
    const float* bkk = p.sKK + h * 64 + q; const float* br = p.sR + h * 64 + q; const float* bw = p.sW + (size_t)d * T * DA + h * 64 + q; const float* bb_ = p.sB + (size_t)d * T * DA + h * 64 + q;
    const float* bkd = p.sKD + (size_t)d * T * DA + h * 64 + q; const float* bv = p.sV + h * 64 + lane;
    float* by = (ISP ? p.PV : p.Y) + (size_t)d * T * DA + h * 64 + lane;
    float st[64];
#pragma unroll
    for (int k = 0; k < 64; ++k) st[k] = (ISP && k == lane) ? 1.0f : 0.f;
    size_t mo = (size_t)scan_row(b, d, pos0) * DA;
    f32x4 kk = *(const f32x4*)(bkk + mo), w = *(const f32x4*)(bw + mo), bb = *(const f32x4*)(bb_ + mo), r = *(const f32x4*)(br + mo), kd = w; float vv = 0.f;
    if (!ISP) { kd = *(const f32x4*)(bkd + mo); vv = bv[mo]; }
#pragma unroll 1
    for (int i = 0; i < SEGLEN; ++i) {
        const size_t mn = (size_t)scan_row(b, d, pos0 + (i + 1 < SEGLEN ? i + 1 : i)) * DA;
        const f32x4 nkk = *(const f32x4*)(bkk + mn), nw = *(const f32x4*)(bw + mn), nb = *(const f32x4*)(bb_ + mn), nr = *(const f32x4*)(br + mn);
        f32x4 nkd = nw; float nv = 0.f;
        if (!ISP) { nkd = *(const f32x4*)(bkd + mn); nv = bv[mn]; }
        float a[8] = {0.f, 0.f, 0.f, 0.f, 0.f, 0.f, 0.f, 0.f};
        ScanRep<0>::dot8(a, kk, st);
        const float nsk = -(((a[0] + a[1]) + (a[2] + a[3])) + ((a[4] + a[5]) + (a[6] + a[7])));
        ScanRep<0>::mul(st, w);
        ScanRep<0>::fmacx(st, bb, nsk);
        if (!ISP) ScanRep<0>::fmacx(st, kd, vv);
        float y[8] = {0.f, 0.f, 0.f, 0.f, 0.f, 0.f, 0.f, 0.f};
        ScanRep<0>::dot8(y, r, st);
        by[mo] = ((y[0] + y[1]) + (y[2] + y[3])) + ((y[4] + y[5]) + (y[6] + y[7]));
        kk = nkk; w = nw; bb = nb; r = nr; kd = nkd; vv = nv; mo = mn;
    }
    if (s < NSG - 1) {
        float* dst = (ISP ? p.PS : p.QS) + (((size_t)c * NSG + s) * 64 + lane) * 64;
#pragma unroll
        for (int k4 = 0; k4 < 16; ++k4) *(f32x4*)(dst + 4 * k4) = (f32x4){st[4 * k4], st[4 * k4 + 1], st[4 * k4 + 2], st[4 * k4 + 3]};
    }
}
__device__ __forceinline__ void ph_scan_fast(const Params& p) {
    const int tid_ = opq_tid(), bid_ = opq_bid(); (void)tid_; (void)bid_;
    const int lane = tid_ & 63, gw = bid_ * 4 + (tid_ >> 6), nw = gridDim.x * 4;
    constexpr int NS_T = 64 * NSG, NP_T = 64 * (NSG - 1);
    const int G = gridDim.x, wv = tid_ >> 6; (void)gw; (void)nw;
    for (int tsk = wv * G + bid_; tsk < NS_T + NP_T; tsk += 4 * G) {
        const int t2 = __builtin_amdgcn_readfirstlane(tsk);
        if (t2 < NS_T) scan_task<false>(p, t2 & 63, t2 >> 6, lane);
        else scan_task<true>(p, (t2 - NS_T) & 63, 1 + ((t2 - NS_T) >> 6), lane);
    }
}
__device__ __forceinline__ void ph_combine(const Params& p, char* lds) {
    const int tid_ = opq_tid(), bid_ = opq_bid(); (void)tid_; (void)bid_; (void)lds;
    if (bid_ >= 64) return;
    const int lane = tid_ & 63, c = bid_, cb = tid_ >> 6, q = lane >> 4, i16 = lane & 15, v = 16 * cb + i16;
    const float* QSc = p.QS + (size_t)c * NSG * 4096; const float* PSc = p.PS + (size_t)c * NSG * 4096; float* SSg = p.SS + (size_t)c * NSG * 4096;
    f32x4 acc[4];
#pragma unroll
    for (int ro = 0; ro < 4; ++ro) acc[ro] = *(const f32x4*)(QSc + v * 64 + 16 * ro + 4 * q);
#pragma unroll 1
    for (int s = 1; s < NSG; ++s) {
#pragma unroll
        for (int ro = 0; ro < 4; ++ro)
#pragma unroll
            for (int j = 0; j < 4; ++j) SSg[(size_t)s * 4096 + (16 * ro + 4 * q + j) * 64 + v] = acc[ro][j];
        if (s == NSG - 1) break;
        const float* P = PSc + (size_t)s * 4096 + (4 * q) * 64 + i16;
        float a[4][4][4];
#pragma unroll
        for (int rb = 0; rb < 4; ++rb)
#pragma unroll
            for (int kk = 0; kk < 4; ++kk)
#pragma unroll
                for (int ro = 0; ro < 4; ++ro) a[rb][kk][ro] = P[(16 * rb + kk) * 64 + 16 * ro];
#pragma unroll
        for (int rb = 0; rb < 4; ++rb) asm volatile("" : "+v"(a[rb][0][0]), "+v"(a[rb][0][1]), "+v"(a[rb][0][2]), "+v"(a[rb][0][3]), "+v"(a[rb][1][0]), "+v"(a[rb][1][1]), "+v"(a[rb][1][2]), "+v"(a[rb][1][3]),
                                                         "+v"(a[rb][2][0]), "+v"(a[rb][2][1]), "+v"(a[rb][2][2]), "+v"(a[rb][2][3]), "+v"(a[rb][3][0]), "+v"(a[rb][3][1]), "+v"(a[rb][3][2]), "+v"(a[rb][3][3]));
        f32x4 nacc[4];
#pragma unroll
        for (int ro = 0; ro < 4; ++ro) nacc[ro] = *(const f32x4*)(QSc + (size_t)s * 4096 + v * 64 + 16 * ro + 4 * q);
#pragma unroll
        for (int rb = 0; rb < 4; ++rb)
#pragma unroll
            for (int kk = 0; kk < 4; ++kk)
#pragma unroll
                for (int ro = 0; ro < 4; ++ro) nacc[ro] = __builtin_amdgcn_mfma_f32_16x16x4f32(a[rb][kk][ro], acc[rb][kk], nacc[ro], 0, 0, 0);
#pragma unroll
        for (int ro = 0; ro < 4; ++ro) acc[ro] = nacc[ro];
    }
}
__device__ __forceinline__ float qsum(float v) {
    float a = v, b = v; asm volatile("s_nop 1\n\tv_permlane16_swap_b32 %0, %1" : "+v"(a), "+v"(b)); v = a + b; a = v; b = v;
    asm volatile("s_nop 1\n\tv_permlane32_swap_b32 %0, %1" : "+v"(a), "+v"(b)); return a + b; }
__device__ __forceinline__ void ph_rwkv_out_fast(const Params& p, int l, bool with_ctx) {
    const int tid_ = opq_tid(), bid_ = opq_bid(); (void)tid_; (void)bid_;
    const int lane = tid_ & 63, i16 = lane & 15, q = lane >> 4, gw = bid_ * 4 + (tid_ >> 6), nw = gridDim.x * 4;
    constexpr int TOK = 16, NLT = NB * (S / TOK) * 4, NCTK = NB * (L / TOK) * 4;
    const int ntask = NLT + (with_ctx ? NCTK : 0);
    for (int tsk = gw; tsk < ntask; tsk += nw) {
        const bool isCtx = tsk >= NLT; const int r = isCtx ? tsk - NLT : tsk;
        const int h = r & 3, npt = isCtx ? L / TOK : S / TOK, tt = (r >> 2) % npt, b = (r >> 2) / npt;
        const int seg0 = (isCtx ? TOK * tt : L + TOK * tt) / SEGLEN, seg1 = (isCtx ? L - 1 - TOK * tt : L + S - 1 - TOK * tt) / SEGLEN;
        const int m = (isCtx ? TL + b * L + TOK * tt : b * S + TOK * tt) + i16;
        const size_t o = (size_t)m * DA + h * 64 + 4 * q, o1 = o + (size_t)T * DA;
        f32x4 acc[4];
#pragma unroll
        for (int rb = 0; rb < 4; ++rb) acc[rb] = *(const f32x4*)(p.Y + o + 16 * rb) + *(const f32x4*)(p.Y + o1 + 16 * rb);
#pragma unroll
        for (int d = 0; d < 2; ++d) {
            const int seg = d ? seg1 : seg0;
            if (seg > 0) {
                const float* sst = p.SS + (((size_t)(d * NB + b) * 4 + h) * NSG + seg) * 4096 + q * 64 + i16;
                const float* pvp = p.PV + (d ? o1 : o) - 4 * q + q;
                float a[4][16], bq[16];
#pragma unroll
                for (int kk = 0; kk < 16; ++kk) { bq[kk] = pvp[4 * kk];
#pragma unroll
                    for (int rb = 0; rb < 4; ++rb) a[rb][kk] = sst[(4 * kk) * 64 + 16 * rb]; }
#pragma unroll
                for (int rb = 0; rb < 4; ++rb) asm volatile("" : "+v"(a[rb][0]), "+v"(a[rb][1]), "+v"(a[rb][2]), "+v"(a[rb][3]), "+v"(a[rb][4]), "+v"(a[rb][5]), "+v"(a[rb][6]), "+v"(a[rb][7]),
                                                                 "+v"(a[rb][8]), "+v"(a[rb][9]), "+v"(a[rb][10]), "+v"(a[rb][11]), "+v"(a[rb][12]), "+v"(a[rb][13]), "+v"(a[rb][14]), "+v"(a[rb][15]));
#pragma unroll
                for (int kk = 0; kk < 16; ++kk)
#pragma unroll
                    for (int rb = 0; rb < 4; ++rb) acc[rb] = __builtin_amdgcn_mfma_f32_16x16x4f32(a[rb][kk], bq[kk], acc[rb], 0, 0, 0);
            }
        }
        float s = 0.f;
#pragma unroll
        for (int rb = 0; rb < 4; ++rb) s += sum4(acc[rb]);
        const float mu = qsum(s) * (1.0f / 64.f);
        float sq = 0.f, bon = 0.f;
#pragma unroll
        for (int rb = 0; rb < 4; ++rb) { const f32x4 dy = acc[rb] - mu; sq += sum4(dy * dy);
            const f32x4 rr = *(const f32x4*)(p.sR + o + 16 * rb), kds = *(const f32x4*)(p.sKD + o + 16 * rb) + *(const f32x4*)(p.sKD + o1 + 16 * rb), rk = *(const f32x4*)(p.a_r_k + l * DA + h * 64 + 16 * rb + 4 * q);
            bon += sum4(rr * kds * rk); }
        const float rstd = 1.0f / sqrtf(qsum(sq) * (1.0f / 64.f) + GN_EPS); bon = qsum(bon);
#pragma unroll
        for (int rb = 0; rb < 4; ++rb) { const int c = h * 64 + 16 * rb + 4 * q;
            const f32x4 gln = *(const f32x4*)(p.a_lnx_g + l * DA + c), bln = *(const f32x4*)(p.a_lnx_b + l * DA + c), vv = *(const f32x4*)(p.sV + o + 16 * rb);
            bf16_t* mp = p.MIX + (size_t)m * DMIX + c; const f32x4 gg = ld_bf16x4(mp);
            st_bf16x4(mp, ((acc[rb] - mu) * rstd * gln + bln + vv * bon) * gg); }
    }
}


#define LAS __attribute__((address_space(3)))
#define XB_TMO      128
#define XB_XCNT(j)  (256  + 64 * (j))
#define XB_XSUB(j)  (1280 + 64 * (j))
#define XB_XGEN(j)  (2304 + 64 * (j))
#define XB_TOP      3328
#define XB_TOPGEN   3392
#define XCD_BAR_WORDS 3456
#define XB_SPIN_CAP (1u << 20)
static_assert(XCD_BAR_WORDS * 4 <= 16384, "barrier words fit the control region");
__device__ __forceinline__ unsigned xb_ld(unsigned* p)              { return __hip_atomic_load(p, __ATOMIC_RELAXED, __HIP_MEMORY_SCOPE_AGENT); }
__device__ __forceinline__ unsigned xb_add(unsigned* p, unsigned v) { return __hip_atomic_fetch_add(p, v, __ATOMIC_RELAXED, __HIP_MEMORY_SCOPE_AGENT); }
__device__ __forceinline__ unsigned xb_xcc_id() { return (unsigned)__builtin_amdgcn_s_getreg((3 << 11) | 20) & 0xFu; }
#define XB_SPIN(cond, bar) do { unsigned _sp = 0; while (cond) { __builtin_amdgcn_s_sleep(1); \
    if ((++_sp & 255u) == 0u) { if (xb_ld(&(bar)[XB_TMO])) break; if (_sp > XB_SPIN_CAP) { atomicAdd(&(bar)[XB_TMO], 1u); break; } } } } while (0)
struct XcdBarrier { unsigned* bar; unsigned x; volatile LAS unsigned* st; };
__device__ __forceinline__ XcdBarrier xcd_barrier_post(unsigned* bar, volatile LAS unsigned* st) {
    XcdBarrier b; b.bar = bar; b.x = xb_xcc_id(); b.st = st;
    if (threadIdx.x == 0) (void)xb_add(&bar[XB_XCNT(b.x)], 1u);
    return b;
}
__device__ __forceinline__ void xcd_barrier_complete(unsigned* bar, unsigned x, unsigned& nloc, unsigned& nx) {
    const unsigned G = gridDim.x * gridDim.y * gridDim.z;
    unsigned sum, cnt, mine, sp = 0u;
    for (;;) {
        sum = 0u; cnt = 0u; mine = 0u;
#pragma unroll
        for (unsigned j = 0; j < 16; ++j) { const unsigned c = xb_ld(&bar[XB_XCNT(j)]); sum += c; cnt += (c > 0u) ? 1u : 0u; mine = (j == x) ? c : mine; }
        if (sum == G) break;
        __builtin_amdgcn_s_sleep(1);
        if ((++sp & 255u) == 0u) { if (xb_ld(&bar[XB_TMO])) break; if (sp > XB_SPIN_CAP) { atomicAdd(&bar[XB_TMO], 1u); break; } }
    }
    nloc = mine > 0u ? mine : 1u; nx = cnt > 0u ? cnt : 1u;
}
__device__ __forceinline__ void xcd_barrier(const XcdBarrier& b) {
    asm volatile("s_waitcnt vmcnt(0)" ::: "memory");
    __syncthreads();
    if (threadIdx.x == 0) {
        unsigned* bar = b.bar;
        __builtin_amdgcn_s_waitcnt(0);
        unsigned nloc = b.st[0], nx = b.st[1];
        if (nloc == 0u) { xcd_barrier_complete(bar, b.x, nloc, nx); b.st[0] = nloc; b.st[1] = nx; }
        const unsigned old = xb_add(&bar[XB_XSUB(b.x)], 1u);
        const unsigned gen = old / nloc;
        if (old + 1u == (gen + 1u) * nloc) {
            __builtin_amdgcn_fence(__ATOMIC_RELEASE, "agent");
            asm volatile("s_waitcnt vmcnt(0)" ::: "memory");
            const unsigned og = xb_add(&bar[XB_TOP], 1u);
            const unsigned tg = og / nx;
            if (og + 1u == (tg + 1u) * nx) xb_add(&bar[XB_TOPGEN], 1u);
            else XB_SPIN(xb_ld(&bar[XB_TOPGEN]) == tg, bar);
            __builtin_amdgcn_fence(__ATOMIC_ACQUIRE, "agent");
            xb_add(&bar[XB_XGEN(b.x)], 1u);
            asm volatile("s_waitcnt vmcnt(0)" ::: "memory");
        } else {
            XB_SPIN(xb_ld(&bar[XB_XGEN(b.x)]) == gen, bar);
            __builtin_amdgcn_fence(__ATOMIC_ACQUIRE, "agent");
            asm volatile("s_waitcnt vmcnt(0)" ::: "memory");
        }
    }
    __syncthreads();
}

#define GT ((long)blockIdx.x * blockDim.x + threadIdx.x)
#define GS ((long)gridDim.x * blockDim.x)
__global__ void __launch_bounds__(256, 2) mega_fwd(Params p) {
    __shared__ __attribute__((aligned(16))) char lds[65536 + 64];
    cg::grid_group grid = cg::this_grid();
    const long gt = GT, gs = GS;
    volatile LAS unsigned* bst = (volatile LAS unsigned*)(LAS char*)(lds + 65536);
    if (threadIdx.x < 2) bst[threadIdx.x] = 0u;
    __syncthreads();
    const XcdBarrier xb = xcd_barrier_post(p.bar, bst);
#ifndef PROBE_PHASE
#define PROBE_PHASE -1
#endif
#define PROBE_AMP 8
    unsigned long long t_prev = 0; int nts = 0;
#define STAMP() do { if (PROBE_PHASE >= 0 && blockIdx.x == 0 && threadIdx.x == 0) { const unsigned long long t_now = __builtin_amdgcn_s_memrealtime(); \
        if (nts == PROBE_PHASE + 1) { const unsigned long long t_end = t_now + PROBE_AMP * (t_now - t_prev); while (__builtin_amdgcn_s_memrealtime() < t_end) __builtin_amdgcn_s_sleep(8); } \
        t_prev = __builtin_amdgcn_s_memrealtime(); } ++nts; } while (0)
#define GSYNC() do { xcd_barrier(xb); STAMP(); } while (0)
    STAMP();
    ph_mod_fast(p, lds); ph_prep_w_fast(p, 0, 0, lds); ph_prep_misc(p, 0, gt, gs, false);
    if (p.out == nullptr) grid.sync();
    GSYNC();
    for (int l = 0; l < 2; ++l) {
        const int nrows = (l == 0) ? T : TL;
        if (l == 0) { ph_lnmod_fast(p, l); GSYNC(); }
        g_gemm_in(p, lds);
        GSYNC();
        ph_streams_s1(p, l);
        GSYNC();
        g_streams_s2(p, l, lds);
        GSYNC();
        ph_scan_fast(p);
        GSYNC();
        ph_combine(p, lds); ph_attn_blk(p, l, l == 0, 64, lds);
        GSYNC();
        ph_rwkv_out_fast(p, l, l == 0);
        GSYNC();
        if (blockIdx.x >= gridDim.x / 2) { ph_prep_w_fast(p, l, 1, lds); __syncthreads(); g_gemm_out(p, nrows, lds); } else { g_gemm_out(p, nrows, lds); ph_prep_w_fast(p, l, 1, lds); }
        GSYNC();
        g_router(p, l, nrows, lds);
        GSYNC();
        ph_dispatch_fast(p, l, nrows, lds);
        GSYNC();
        g_moe1(p, l, lds);
        GSYNC();
        g_moe2(p, l, lds);
        GSYNC();
        ph_final_fast(p, l, nrows, l == 0);
        if (l == 0) { ph_prep_w_fast(p, 1, 0, lds); ph_prep_misc(p, 1, gt, gs, false); }
        GSYNC();
    }}

extern "C" void kernel_launch(void* const* d_in, const int* in_sizes, int n_in, void* d_out, int out_size, void* d_ws, size_t ws_size, hipStream_t stream) {
    if (n_in != 32 || out_size != TL * D || ws_size < WS_NEED) { fprintf(stderr, "kernel_launch: unexpected shapes / workspace (n_in %d out %d ws %zu need %zu)\n", n_in, out_size, ws_size, (size_t)WS_NEED); return; }
    static int grid_blocks = 0;
    if (!grid_blocks) {
        int dev = 0, cus = 0, per_cu = 0;
        (void)hipGetDevice(&dev);
        (void)hipDeviceGetAttribute(&cus, hipDeviceAttributeMultiprocessorCount, dev);
        (void)hipOccupancyMaxActiveBlocksPerMultiprocessor(&per_cu, mega_fwd, 256, 0);
        if (per_cu < 1) per_cu = 1;
        if (per_cu > 2) per_cu = 2;
        grid_blocks = cus * per_cu;
        fprintf(stderr, "kernel_launch: %d CUs x %d blocks\n", cus, per_cu);
    }
    Params p = make_params(d_in, d_out, d_ws);
    (void)hipMemsetAsync(d_ws, 0, CTL_BYTES, stream);
    void* args[] = {&p};
    hipError_t e = hipLaunchCooperativeKernel((void*)mega_fwd, dim3(grid_blocks), dim3(256), args, 0, stream);
    if (e != hipSuccess) fprintf(stderr, "cooperative launch failed: %s (grid %d)\n", hipGetErrorString(e), grid_blocks);
}
#endif

#ifdef HOST_EMU
static void host_forward(void* const* d_in, void* d_out, void* d_ws) {
    const Params p = make_params(d_in, d_out, d_ws);
    for (int l = 0; l < 2; ++l) {
        const int nrows = (l == 0) ? T : TL;
        ph_prep_w(p, l, 0, 1); ph_prep_misc(p, l, 0, 1); ph_lnmod(p, l, 0, 1); host_gemm_in(p); ph_streams(p, l, 0, 1); ph_rope(p, 0, 1); ph_scan(p, 0, 1);
        ph_attn(p, l, nrows, 0, 1); ph_rwkv_out(p, l, nrows, 0, 1); host_gemm_out(p, nrows); ph_post_mixer(p, l, nrows, 0, 1);
        ph_dispatch(p, l, nrows, 0, 1); host_moe1(p, l); host_moe2(p, l); ph_final(p, l, nrows, 0, 1);
    }
}
#endif
```

```cpp
#ifdef HOST_EMU
#include <cmath>
#include <cstdio>
#include <cstring>
#include <cstdint>
#include <cstdlib>
#define __device__
#define __global__
#define __host__
#define __forceinline__ inline
#else
#include <hip/hip_runtime.h>
#include <hip/hip_cooperative_groups.h>
#include <cstdio>
#include <cstdint>
namespace cg = cooperative_groups;
#endif

#ifndef CFG_D
#define CFG_D 1024
#define CFG_B 8
#define CFG_S 2048
#define CFG_L 256
#define CFG_DE 512
#endif
constexpr int D = CFG_D, NB = CFG_B, S = CFG_S, L = CFG_L, DE = CFG_DE;
constexpr int TL = NB * S, TC = NB * L, T = TL + TC;
constexpr int GRID_W = 64, HD = 64;
constexpr int DA = 256, A_IN = 1184, N_IN = 2976, NINP = 3072, DMIX = 1024;
constexpr int NEXP = 32, NSLOT = 2 * T + NEXP * 128;
#ifdef HOST_EMU
constexpr int ZQB = 0, ZKB = 384, ZVB = 512, ZQN = 640, ZKN = 1024, ZVN = 1408, ZA = 1792, ZP = 2976;
#else
constexpr int ZQB = 0, ZKB = 384, ZQN = 512, ZKN = 896, ZA = 1280, ZP = 2464, WVB = 2560, WVN = 2688;
#endif
constexpr float LN_EPS = 1e-6f, GN_EPS = 64e-5f, ATT_SCALE = 0.125f, LOG2E = 1.4426950408889634f, QSCALE = ATT_SCALE * LOG2E;
constexpr float ALPHA = 1.41421356237309515f;

typedef unsigned short bf16_t;

__device__ __forceinline__ float bf2f(bf16_t v) {
    unsigned u = ((unsigned)v) << 16; float f;
#ifdef HOST_EMU
    memcpy(&f, &u, 4);
#else
    f = __uint_as_float(u);
#endif
    return f;
}
__device__ __forceinline__ bf16_t f2bf(float f) {
    unsigned u;
#ifdef HOST_EMU
    memcpy(&u, &f, 4);
#else
    u = __float_as_uint(f);
#endif
    return (bf16_t)((u + 0x7fffu + ((u >> 16) & 1u)) >> 16);
}
__device__ __forceinline__ float sigmoidf_(float x) { return 1.0f / (1.0f + expf(-x)); }
__device__ __forceinline__ float siluf_(float x) { return x / (1.0f + expf(-x)); }
__device__ __forceinline__ int atomic_inc_int(int* p) {
#ifdef HOST_EMU
    int o = *p; *p = o + 1; return o;
#else
    return atomicAdd(p, 1);
#endif
}

struct Params {
    const float *x, *c, *ctx, *c_ctx, *w_mod, *b_mod, *w_in, *w_out, *a_shift, *a_w0, *a_w_up, *a_a0, *a_a_up, *a_g_up,
        *a_k_k, *a_k_a, *a_r_k, *a_lnx_g, *a_lnx_b, *b_sink, *c_rpb, *ln1_g, *ln1_b, *ln2_g, *ln2_b, *w_rg, *b_rg, *w_re,
        *b_re, *w_gate, *w_up, *w_down;
    float* out;
    int* cnt;
    unsigned* bar;
    float* mod;
    float* rope;
    bf16_t *win_t, *wout_t, *wgu_t, *wd_t;
    bf16_t *wrt;
    int* hist;
    bf16_t* HLO;
    bf16_t *wupT, *aupT, *gupT;
    bf16_t* LA;
    float *kT, *kN;
    bf16_t* H;
    bf16_t* Z;
    bf16_t* VT;
    float *sR, *sV, *sKK, *sG, *sW, *sKD, *sB;
    float* Y;
    bf16_t* MIX;
    float *PV, *QS, *PS, *SS;
    float* XC;
    bf16_t* O;
    bf16_t* YSb;
    int *rE, *rPos, *rSlot; float* rW;
    int* slotTok;
    bf16_t* ACT;
    float* YS;
};

constexpr size_t al256(size_t v) { return (v + 255) & ~(size_t)255; }
constexpr size_t OFF_CNT = 0;
constexpr size_t OFF_BAR = 4096, CTL_BYTES = 4096 + 16384;
constexpr size_t OFF_MOD = CTL_BYTES;
constexpr size_t OFF_ROPE = al256(OFF_MOD + (size_t)2 * (NB + 1) * 6 * D * 4);
constexpr size_t OFF_LORA = al256(OFF_ROPE + 64 * 16 * 2 * 4);
constexpr size_t OFF_WRT = al256(OFF_LORA + (size_t)(2 * 256 * 64 * 2 + 256 * 160) * 2);
constexpr size_t OFF_LG = al256(OFF_WRT + (size_t)2 * 128 * D * 2);
constexpr size_t OFF_WIN = al256(OFF_LG + (size_t)(T / 32) * 32 * 4);
constexpr size_t OFF_WOUT = al256(OFF_WIN + (size_t)NINP * D * 2);
constexpr size_t OFF_WGU = al256(OFF_WOUT + (size_t)D * DMIX * 2);
constexpr size_t OFF_WD = al256(OFF_WGU + (size_t)NEXP * 2 * DE * D * 2);
constexpr size_t OFF_H = al256(OFF_WD + (size_t)NEXP * D * DE * 2);
constexpr size_t OFF_Z = al256(OFF_H + (size_t)(T + 1) * D * 2);
constexpr int PU = L + S;
constexpr int SEGLEN = 144, NSG = (L + S) / SEGLEN;
#ifndef HOST_EMU
static_assert((L + S) % SEGLEN == 0 && SEGLEN % 16 == 0 && L % 16 == 0 && S % 16 == 0, "16-token output tiles must not straddle scan segments");
static_assert((size_t)3 * 64 * NSG * 4096 * 4 <= (size_t)NEXP * 2 * DE * D * 2, "scan segment states overlay wgu_t");
#endif
constexpr size_t OFF_VT = al256(OFF_Z + (size_t)T * 2976 * 2);
constexpr size_t OFF_S = al256(OFF_VT + (size_t)NB * 8 * 64 * PU * 2);
constexpr size_t S1 = (size_t)T * 256 * 4;
#ifdef HOST_EMU
constexpr int NSTREAM = 10;
#else
constexpr int NSTREAM = 9;
#endif
constexpr size_t OFF_Y = al256(OFF_S + NSTREAM * S1);
constexpr size_t OFF_MIX = al256(OFF_Y + 2 * S1);
constexpr size_t OFF_XC = al256(OFF_MIX + (size_t)T * 1024 * 2);
constexpr size_t OFF_ROUTE = al256(OFF_XC + (size_t)TC * D * 4);
constexpr size_t OFF_SLOTTOK = al256(OFF_ROUTE + (size_t)T * 2 * 4 * 4);
constexpr size_t WS_NEED = al256(OFF_SLOTTOK + (size_t)NSLOT * 4);
static_assert((size_t)NSLOT * DE * 2 <= (size_t)T * 2976 * 2 && (size_t)T * D * 2 <= (size_t)T * 2976 * 2, "ACT / HLO overlay Z");
static_assert((size_t)T * 4 * 4 + (size_t)T * 416 * 2 <= S1, "kN + LA overlay Y[1]");
static_assert((size_t)NSLOT * D * 4 <= NSTREAM * S1 && (size_t)T * D * 4 <= NSTREAM * S1, "YS / O overlay the stream buffers");

static Params make_params(void* const* d_in, void* d_out, void* d_ws) {
    Params p{};
    const float** f = (const float**)&p.x;
    for (int i = 0; i < 32; ++i) f[i] = (const float*)d_in[i];
    p.out = (float*)d_out;
    char* w = (char*)d_ws;
    p.cnt = (int*)(w + OFF_CNT); p.bar = (unsigned*)(w + OFF_BAR); p.mod = (float*)(w + OFF_MOD); p.rope = (float*)(w + OFF_ROPE);
    p.win_t = (bf16_t*)(w + OFF_WIN); p.wout_t = (bf16_t*)(w + OFF_WOUT); p.wgu_t = (bf16_t*)(w + OFF_WGU); p.wd_t = (bf16_t*)(w + OFF_WD);
    p.wrt = (bf16_t*)(w + OFF_WRT); p.hist = (int*)(w + OFF_LG); p.HLO = (bf16_t*)(w + OFF_Z);
    p.wupT = (bf16_t*)(w + OFF_LORA); p.aupT = p.wupT + 2 * 256 * 64; p.gupT = p.aupT + 2 * 256 * 64;
    p.H = (bf16_t*)(w + OFF_H); p.Z = (bf16_t*)(w + OFF_Z); p.VT = (bf16_t*)(w + OFF_VT);
    float* s = (float*)(w + OFF_S); const size_t n1 = (size_t)T * 256;
    p.sR = s; p.sV = s + n1; p.sKK = s + 2 * n1; p.sW = s + 3 * n1; p.sKD = s + 5 * n1; p.sB = s + 7 * n1; p.sG = s + 9 * n1;
    p.Y = (float*)(w + OFF_Y); p.MIX = (bf16_t*)(w + OFF_MIX); p.XC = (float*)(w + OFF_XC);
    p.O = (bf16_t*)(w + OFF_S); p.YSb = (bf16_t*)(w + OFF_S);
    p.PV = (float*)(w + OFF_H); p.QS = (float*)(w + OFF_WGU); p.PS = p.QS + (size_t)64 * NSG * 4096; p.SS = p.PS + (size_t)64 * NSG * 4096;
    p.kT = p.Y; p.kN = p.Y + (size_t)T * 256; p.LA = (bf16_t*)(p.Y + (size_t)T * 256 + (size_t)T * 4);
    int* r = (int*)(w + OFF_ROUTE); p.rE = r; p.rPos = r + 2 * T; p.rSlot = r + 4 * T; p.rW = (float*)(r + 6 * T);
    p.slotTok = (int*)(w + OFF_SLOTTOK);
    p.ACT = (bf16_t*)(w + OFF_Z); p.YS = (float*)(w + OFF_S);
    return p;
}

__device__ void ph_prep_w(const Params& p, int l, long gtid, long gsz) {
    for (long i = gtid; i < (long)D * NINP; i += gsz) {
        const int k = (int)(i / NINP), n = (int)(i % NINP);
        float v = 0.f;
        if (n < N_IN) { const int oc = (n < ZA) ? n + A_IN : n - ZA; v = p.w_in[((size_t)l * D + k) * N_IN + oc]; }
        p.win_t[(size_t)n * D + k] = f2bf(v);
    }
    for (long i = gtid; i < (long)DMIX * D; i += gsz) {
        const int k = (int)(i / D), n = (int)(i % D);
        p.wout_t[(size_t)n * DMIX + k] = f2bf(p.w_out[((size_t)l * DMIX + k) * D + n]);
    }
    for (long i = gtid; i < (long)NEXP * D * 2 * DE; i += gsz) {
        const int rho = (int)(i % (2 * DE)); const long t = i / (2 * DE); const int k = (int)(t % D), e = (int)(t / D);
        const int q = rho >> 5, half = (rho >> 4) & 1, ii = rho & 15, cc = 16 * q + ii;
        const float* src = half ? p.w_up : p.w_gate;
        p.wgu_t[((size_t)e * 2 * DE + rho) * D + k] = f2bf(src[(((size_t)l * NEXP + e) * D + k) * DE + cc]);
    }
    for (long i = gtid; i < (long)NEXP * DE * D; i += gsz) {
        const int n = (int)(i % D); const long t = i / D; const int k = (int)(t % DE), e = (int)(t / DE);
        p.wd_t[((size_t)e * D + n) * DE + k] = f2bf(p.w_down[(((size_t)l * NEXP + e) * DE + k) * D + n]);
    }
}
__device__ __forceinline__ void ph_prep_misc(const Params& p, int l, long gtid, long gsz, bool do_mod = true) {
    if (l == 0 && do_mod) for (long i = gtid; i < (long)2 * (NB + 1) * 6 * D; i += gsz) {
        const int j = (int)(i % (6 * D)), b = (int)((i / (6 * D)) % (NB + 1)), ll = (int)(i / ((long)6 * D * (NB + 1)));
        const float* cv = (b < NB) ? p.c + (size_t)b * D : p.c_ctx;
        float acc = 0.f;
        for (int k = 0; k < D; ++k) acc += siluf_(cv[k]) * p.w_mod[((size_t)ll * D + k) * 6 * D + j];
        p.mod[((size_t)ll * (NB + 1) + b) * 6 * D + j] = acc + p.b_mod[(size_t)ll * 6 * D + j];
    }
    if (l == 0) for (long i = gtid; i < 64 * 16; i += gsz) {
        const int pos = (int)(i / 16), fi = (int)(i % 16);
        const float inv = powf(10000.0f, -(float)fi / 16.0f), ang = (float)pos * inv;
        p.rope[i] = cosf(ang); p.rope[1024 + i] = sinf(ang);
    }
    for (long i = gtid; i < NEXP; i += gsz) p.cnt[l * NEXP + i] = 0;
    for (long i = gtid; i < NSLOT; i += gsz) p.slotTok[i] = T;
    for (long i = gtid; i < D; i += gsz) p.H[(size_t)T * D + i] = 0;
}

__device__ __forceinline__ const float* xrow_in(const Params& p, int l, int m) {
    if (m < TL) return (l == 0 ? p.x : p.out) + (size_t)m * D;
    return (l == 0 ? p.ctx : p.XC) + (size_t)(m - TL) * D;
}
__device__ __forceinline__ const float* modrow(const Params& p, int l, int m) { return p.mod + ((size_t)l * (NB + 1) + (m < TL ? m / S : NB)) * 6 * D; }

__device__ void ph_lnmod(const Params& p, int l, long gtid, long gsz) {
    for (long m = gtid; m < T; m += gsz) {
        const float* xr = xrow_in(p, l, (int)m); const float* md = modrow(p, l, (int)m);
        float s = 0.f; for (int j = 0; j < D; ++j) s += xr[j];
        const float mu = s / D; float q = 0.f;
        for (int j = 0; j < D; ++j) { const float d = xr[j] - mu; q += d * d; }
        const float rstd = 1.0f / sqrtf(q / D + LN_EPS);
        for (int j = 0; j < D; ++j) p.H[(size_t)m * D + j] = f2bf((xr[j] - mu) * rstd * (1.0f + md[D + j]) + md[j]);
    }
}

__device__ __forceinline__ float zshift(const Params& p, int l, int m, int col) {
    int t, len;
    if (m < TL) { t = m % S; len = S; } else { t = (m - TL) % L; len = L; }
    const float* sh = p.a_shift + (size_t)l * 3 * A_IN;
    const bf16_t* z = p.Z + (size_t)m * ZP + ZA + col;
    float v = sh[A_IN + col] * bf2f(z[0]);
    if (t > 0) v += sh[col] * bf2f(z[-ZP]);
    if (t < len - 1) v += sh[2 * A_IN + col] * bf2f(z[ZP]);
    return v;
}

__device__ void ph_streams(const Params& p, int l, long gtid, long gsz) {
    for (long i = gtid; i < (long)T * DA; i += gsz) {
        const int m = (int)(i / DA), c = (int)(i % DA), h0 = c & ~63;
        const float r = zshift(p, l, m, c), k = zshift(p, l, m, 256 + c), v = zshift(p, l, m, 512 + c);
        float nrm = 0.f;
        for (int j = 0; j < 64; ++j) { const float t = zshift(p, l, m, 256 + h0 + j) * p.a_k_k[l * DA + h0 + j]; nrm += t * t; }
        const float kk = k * p.a_k_k[l * DA + c] / sqrtf(nrm + 1e-12f);
        float g = 0.f;
        for (int j = 0; j < 160; ++j) g += sigmoidf_(zshift(p, l, m, 1024 + j)) * p.a_g_up[((size_t)l * 160 + j) * DA + c];
        const size_t o = (size_t)m * DA + c;
        p.sR[o] = r; p.sV[o] = v; p.sKK[o] = kk; p.sG[o] = g;
        for (int d = 0; d < 2; ++d) {
            float aw = 0.f, aa = 0.f;
            for (int j = 0; j < 64; ++j) {
                aw += tanhf(zshift(p, l, m, 768 + d * 64 + j)) * p.a_w_up[(((size_t)l * 2 + d) * 64 + j) * DA + c];
                aa += zshift(p, l, m, 896 + d * 64 + j) * p.a_a_up[(((size_t)l * 2 + d) * 64 + j) * DA + c];
            }
            const float u = -(p.a_w0[(l * 2 + d) * DA + c] + aw);
            const float sp = (u > 20.f) ? u : log1pf(expf(u));
            const float w = expf(-expf(-sp - 0.5f));
            const float a = sigmoidf_(p.a_a0[(l * 2 + d) * DA + c] + aa);
            const size_t od = ((size_t)d * T + m) * DA + c;
            p.sW[od] = w; p.sKD[od] = k * (1.0f + (a - 1.0f) * p.a_k_a[l * DA + c]); p.sB[od] = kk * a;
        }
    }
}

__device__ __forceinline__ void ph_rope(const Params& p, long gtid, long gsz) {
    for (long i = gtid; i < (long)TL * 8 * 32; i += gsz) {
        const int pr = (int)(i & 31), hs = (int)((i >> 5) & 7), m = (int)(i >> 8);
        const int t = m % S, axis = pr >> 4, fi = pr & 15, pos = axis ? (t % GRID_W) : (t / GRID_W);
        bf16_t* z = p.Z + (size_t)m * ZP + hs * 64 + axis * 32 + fi;
        const float cs = p.rope[pos * 16 + fi], sn = p.rope[1024 + pos * 16 + fi];
        const float x0 = bf2f(z[0]), x1 = bf2f(z[16]);
        z[0] = f2bf(x0 * cs - x1 * sn); z[16] = f2bf(x1 * cs + x0 * sn);
    }
}

__device__ void ph_scan(const Params& p, long gtid, long gsz) {
    for (long i = gtid; i < (long)2 * NB * 4 * 64; i += gsz) {
        const int v = (int)(i & 63), h = (int)((i >> 6) & 3), b = (int)((i >> 8) % NB), d = (int)((i >> 8) / NB);
        float st[64];
#pragma unroll
        for (int k = 0; k < 64; ++k) st[k] = 0.f;
        for (int pos = 0; pos < L + S; ++pos) {
            int m;
            if (pos < L) m = TL + b * L + (d ? L - 1 - pos : pos);
            else m = b * S + (d ? S - 1 - (pos - L) : pos - L);
            const size_t o = (size_t)m * DA + h * 64, od = ((size_t)d * T + m) * DA + h * 64;
            const float* kk = p.sKK + o; const float* r = p.sR + o;
            const float* w = p.sW + od; const float* bb = p.sB + od; const float* kd = p.sKD + od;
            const float vv = p.sV[o + v];
            float sk = 0.f;
#pragma unroll
            for (int k = 0; k < 64; ++k) sk += st[k] * kk[k];
            float y = 0.f;
#pragma unroll
            for (int k = 0; k < 64; ++k) { st[k] = st[k] * w[k] - sk * bb[k] + vv * kd[k]; y += st[k] * r[k]; }
            p.Y[od + v] = y;
        }
    }
}

__device__ void ph_rwkv_out(const Params& p, int l, int nrows, long gtid, long gsz) {
    for (long i = gtid; i < (long)nrows * 4; i += gsz) {
        const int m = (int)(i >> 2), h = (int)(i & 3);
        const size_t o = (size_t)m * DA + h * 64;
        const float* y0 = p.Y + o; const float* y1 = p.Y + (size_t)T * DA + o;
        float s = 0.f, bon = 0.f;
        for (int n = 0; n < 64; ++n) {
            s += y0[n] + y1[n];
            bon += p.sR[o + n] * (p.sKD[o + n] + p.sKD[(size_t)T * DA + o + n]) * p.a_r_k[l * DA + h * 64 + n];
        }
        const float mu = s / 64.f; float q = 0.f;
        for (int n = 0; n < 64; ++n) { const float dd = y0[n] + y1[n] - mu; q += dd * dd; }
        const float rstd = 1.0f / sqrtf(q / 64.f + GN_EPS);
        for (int n = 0; n < 64; ++n) {
            const int c = h * 64 + n;
            const float yn = (y0[n] + y1[n] - mu) * rstd * p.a_lnx_g[l * DA + c] + p.a_lnx_b[l * DA + c];
            p.MIX[(size_t)m * DMIX + c] = f2bf((yn + bon * p.sV[o + n]) * p.sG[o + n]);
        }
    }
}

#ifdef HOST_EMU
__device__ __forceinline__ void att_key(const float (&q)[64], const bf16_t* kr, const bf16_t* vr, float bias, float& mx, float& ls, float (&acc)[64]) {
    float s = 0.f;
#pragma unroll
    for (int d = 0; d < 64; ++d) s += q[d] * bf2f(kr[d]);
    s = s * ATT_SCALE + bias;
    const float mn = fmaxf(mx, s), f = expf(mx - mn), pe = expf(s - mn);
    ls = ls * f + pe;
#pragma unroll
    for (int d = 0; d < 64; ++d) acc[d] = acc[d] * f + pe * bf2f(vr[d]);
    mx = mn;
}

__device__ void ph_attn(const Params& p, int l, int nrows, long gtid, long gsz) {
    for (long i = gtid; i < (long)nrows * 12; i += gsz) {
        const int m = (int)(i / 12), u = (int)(i % 12);
        const bool isB = u < 6; const int hq = isB ? u : u - 6;
        const int b = (m < TL) ? m / S : (m - TL) / L;
        const int qcol = isB ? ZQB + hq * 64 : ZQN + hq * 64;
        const int kcol = isB ? ZKB + (hq / 3) * 64 : ZKN + hq * 64;
        const int vcol = isB ? ZVB + (hq / 3) * 64 : ZVN + hq * 64;
        float q[64], acc[64];
        const bf16_t* qr = p.Z + (size_t)m * ZP + qcol;
#pragma unroll
        for (int d = 0; d < 64; ++d) { q[d] = bf2f(qr[d]); acc[d] = 0.f; }
        float mx, ls;
        if (isB) { mx = p.b_sink[l * 6 + hq]; ls = 1.0f; } else { mx = -1e30f; ls = 0.f; }
        for (int j = 0; j < L; ++j) { const bf16_t* zr = p.Z + (size_t)(TL + b * L + j) * ZP; att_key(q, zr + kcol, zr + vcol, 0.f, mx, ls, acc); }
        if (m < TL) {
            const int t = m % S;
            if (isB) {
                const int j0 = t - 128 < 0 ? 0 : t - 128, j1 = t + 128 > S - 1 ? S - 1 : t + 128;
                for (int j = j0; j <= j1; ++j) { const bf16_t* zr = p.Z + (size_t)(b * S + j) * ZP; att_key(q, zr + kcol, zr + vcol, 0.f, mx, ls, acc); }
            } else {
                const int rows = S / GRID_W, r = t / GRID_W, c = t % GRID_W;
                int r0 = r - 4; r0 = r0 < 0 ? 0 : (r0 > rows - 8 ? rows - 8 : r0);
                int c0 = c - 8; c0 = c0 < 0 ? 0 : (c0 > GRID_W - 16 ? GRID_W - 16 : c0);
                for (int a = 0; a < 8; ++a)
                    for (int e = 0; e < 16; ++e) {
                        const int kr = r0 + a, kc = c0 + e;
                        const float bias = p.c_rpb[(((size_t)l * 6 + hq) * 15 + (kr - r + 7)) * 31 + (kc - c + 15)];
                        const bf16_t* zr = p.Z + (size_t)(b * S + kr * GRID_W + kc) * ZP;
                        att_key(q, zr + kcol, zr + vcol, bias, mx, ls, acc);
                    }
            }
        }
        const float inv = 1.0f / ls;
        bf16_t* o = p.MIX + (size_t)m * DMIX + (isB ? 256 : 640) + hq * 64;
#pragma unroll
        for (int d = 0; d < 64; ++d) o[d] = f2bf(acc[d] * inv);
    }
}

#endif
__device__ void ph_post_mixer(const Params& p, int l, int nrows, long gtid, long gsz) {
    for (long mm = gtid; mm < nrows; mm += gsz) {
        const int m = (int)mm;
        const float* xr = xrow_in(p, l, m); const float* md = modrow(p, l, m); const float* orow = (const float*)p.O + (size_t)m * D;
        float* x1 = (m < TL) ? p.out + (size_t)m * D : p.XC + (size_t)(m - TL) * D;
        const float* g1 = p.ln1_g + (size_t)l * D; const float* b1 = p.ln1_b + (size_t)l * D;
        float s = 0.f; for (int j = 0; j < D; ++j) s += ALPHA * xr[j] + md[2 * D + j] * orow[j];
        float mu = s / D, q = 0.f;
        for (int j = 0; j < D; ++j) { const float d = ALPHA * xr[j] + md[2 * D + j] * orow[j] - mu; q += d * d; }
        float rstd = 1.0f / sqrtf(q / D + LN_EPS);
        s = 0.f;
        for (int j = 0; j < D; ++j) { const float v = (ALPHA * xr[j] + md[2 * D + j] * orow[j] - mu) * rstd * g1[j] + b1[j]; x1[j] = v; s += v; }
        mu = s / D; q = 0.f;
        for (int j = 0; j < D; ++j) { const float d = x1[j] - mu; q += d * d; }
        rstd = 1.0f / sqrtf(q / D + LN_EPS);
        float gl[4], el[32];
#pragma unroll
        for (int g = 0; g < 4; ++g) gl[g] = p.b_rg[l * 4 + g];
#pragma unroll
        for (int e = 0; e < 32; ++e) el[e] = p.b_re[l * 32 + e];
        for (int j = 0; j < D; ++j) {
            const float hv = (x1[j] - mu) * rstd * (1.0f + md[4 * D + j]) + md[3 * D + j];
            p.H[(size_t)m * D + j] = f2bf(hv);
            const float* wg = p.w_rg + ((size_t)l * D + j) * 4; const float* we = p.w_re + ((size_t)l * D + j) * 32;
#pragma unroll
            for (int g = 0; g < 4; ++g) gl[g] += hv * wg[g];
#pragma unroll
            for (int e = 0; e < 32; ++e) el[e] += hv * we[e];
        }
        int gs = 0; float gm = gl[0];
#pragma unroll
        for (int g = 1; g < 4; ++g) if (gl[g] > gm) { gm = gl[g]; gs = g; }
        float den = 0.f;
#pragma unroll
        for (int g = 0; g < 4; ++g) den += expf(gl[g] - gm);
        const float pg = 1.0f / den;
        float v1 = -3e38f, v2 = -3e38f; int i1 = 0, i2 = 0;
#pragma unroll
        for (int j = 0; j < 8; ++j) {
            const float v = gs == 0 ? el[j] : gs == 1 ? el[8 + j] : gs == 2 ? el[16 + j] : el[24 + j];
            if (v > v1) { v2 = v1; i2 = i1; v1 = v; i1 = j; } else if (v > v2) { v2 = v; i2 = j; }
        }
        const float e2 = expf(v2 - v1), w1 = pg / (1.0f + e2), w2 = pg * e2 / (1.0f + e2);
        const int ea = gs * 8 + i1, eb = gs * 8 + i2;
        p.rE[2 * m] = ea; p.rE[2 * m + 1] = eb; p.rW[2 * m] = w1; p.rW[2 * m + 1] = w2;
        p.rPos[2 * m] = atomic_inc_int(p.cnt + l * NEXP + ea); p.rPos[2 * m + 1] = atomic_inc_int(p.cnt + l * NEXP + eb);
    }
}

__device__ __forceinline__ int pstart_of(const int* cnt, int e) {
    int s = 0;
    for (int j = 0; j < NEXP; ++j) if (j < e) s += (cnt[j] + 127) & ~127;
    return s;
}
__device__ __forceinline__ void ph_dispatch(const Params& p, int l, int nrows, long gtid, long gsz) {
    for (long i = gtid; i < (long)nrows * 2; i += gsz) {
        const int slot = pstart_of(p.cnt + l * NEXP, p.rE[i]) + p.rPos[i];
        p.rSlot[i] = slot; p.slotTok[slot] = (int)(i >> 1);
    }
}

__device__ void ph_final(const Params& p, int l, int nrows, long gtid, long gsz) {
    for (long mm = gtid; mm < nrows; mm += gsz) {
        const int m = (int)mm;
        float* x1 = (m < TL) ? p.out + (size_t)m * D : p.XC + (size_t)(m - TL) * D;
        const float* md = modrow(p, l, m);
        const float* ya = p.YS + (size_t)p.rSlot[2 * m] * D; const float* yb = p.YS + (size_t)p.rSlot[2 * m + 1] * D;
        const float wa = p.rW[2 * m], wb = p.rW[2 * m + 1];
        const float* g2 = p.ln2_g + (size_t)l * D; const float* b2 = p.ln2_b + (size_t)l * D;
        float s = 0.f; for (int j = 0; j < D; ++j) s += ALPHA * x1[j] + md[5 * D + j] * (wa * ya[j] + wb * yb[j]);
        const float mu = s / D; float q = 0.f;
        for (int j = 0; j < D; ++j) { const float d = ALPHA * x1[j] + md[5 * D + j] * (wa * ya[j] + wb * yb[j]) - mu; q += d * d; }
        const float rstd = 1.0f / sqrtf(q / D + LN_EPS);
        for (int j = 0; j < D; ++j) x1[j] = (ALPHA * x1[j] + md[5 * D + j] * (wa * ya[j] + wb * yb[j]) - mu) * rstd * g2[j] + b2[j];
    }
}

__device__ __forceinline__ int moe_blocks(const int* cnt) { int s = 0; for (int j = 0; j < NEXP; ++j) s += (cnt[j] + 127) >> 7; return s; }
__device__ __forceinline__ int moe_block_expert(const int* cnt, int rb) {
    int s = 0, e = 0;
    for (int j = 0; j < NEXP; ++j) { const int nb = (cnt[j] + 127) >> 7; if (rb >= s && rb < s + nb) e = j; s += nb; }
    return e;
}

#ifdef HOST_EMU
static void host_gemm_in(const Params& p) {
    for (int m = 0; m < T; ++m) for (int n = 0; n < ZP; ++n) { float a = 0.f; for (int k = 0; k < D; ++k) a += bf2f(p.H[(size_t)m * D + k]) * bf2f(p.win_t[(size_t)n * D + k]); p.Z[(size_t)m * ZP + n] = f2bf(a); }
}
static void host_gemm_out(const Params& p, int nrows) {
    for (int m = 0; m < nrows; ++m) for (int n = 0; n < D; ++n) { float a = 0.f; for (int k = 0; k < DMIX; ++k) a += bf2f(p.MIX[(size_t)m * DMIX + k]) * bf2f(p.wout_t[(size_t)n * DMIX + k]); ((float*)p.O)[(size_t)m * D + n] = a; }
}
static void host_moe1(const Params& p, int l) {
    const int* cnt = p.cnt + l * NEXP; const int nrb = moe_blocks(cnt);
    for (int rb = 0; rb < nrb; ++rb) { const int e = moe_block_expert(cnt, rb);
        for (int r = 0; r < 128; ++r) { const int slot = rb * 128 + r; const bf16_t* a = p.H + (size_t)p.slotTok[slot] * D;
            for (int c = 0; c < DE; ++c) { const int q = c >> 4, ii = c & 15; float g = 0.f, u = 0.f;
                const bf16_t* wg = p.wgu_t + ((size_t)e * 2 * DE + 32 * q + ii) * D; const bf16_t* wu = wg + (size_t)16 * D;
                for (int k = 0; k < D; ++k) { g += bf2f(a[k]) * bf2f(wg[k]); u += bf2f(a[k]) * bf2f(wu[k]); }
                p.ACT[(size_t)slot * DE + c] = f2bf(siluf_(g) * u); } } }
}
static void host_moe2(const Params& p, int l) {
    const int* cnt = p.cnt + l * NEXP; const int nrb = moe_blocks(cnt);
    for (int rb = 0; rb < nrb; ++rb) { const int e = moe_block_expert(cnt, rb);
        for (int r = 0; r < 128; ++r) { const int slot = rb * 128 + r;
            for (int n = 0; n < D; ++n) { float a = 0.f; const bf16_t* w = p.wd_t + ((size_t)e * D + n) * DE;
                for (int k = 0; k < DE; ++k) a += bf2f(p.ACT[(size_t)slot * DE + k]) * bf2f(w[k]);
                p.YS[(size_t)slot * D + n] = a; } } }
}
#else
typedef short bf16x8 __attribute__((ext_vector_type(8)));
typedef float f32x4 __attribute__((ext_vector_type(4)));
__device__ __forceinline__ int opq_tid() { int t = threadIdx.x; asm volatile("" : "+v"(t)); return t; }
__device__ __forceinline__ int opq_bid() { int b = blockIdx.x; asm volatile("" : "+s"(b)); return b; }
__device__ __forceinline__ unsigned pk2(float lo, float hi) { return (unsigned)f2bf(lo) | ((unsigned)f2bf(hi) << 16); }
struct u32x2_t { unsigned x, y; };
__device__ __forceinline__ void st_bf16x4(bf16_t* dst, f32x4 v) { u32x2_t o; o.x = pk2(v[0], v[1]); o.y = pk2(v[2], v[3]); *(u32x2_t*)dst = o; }
template <bool SWAP = true, class Epi>
__device__ __forceinline__ void gemm_tile(const bf16_t* a0, const bf16_t* a1, const bf16_t* b0, const bf16_t* b1, int K, char* lds, const Epi& epi) {
    const int tid = opq_tid(), wid = tid >> 6, lane = tid & 63, wr = wid >> 1, wc = wid & 1, fr = lane & 15, fq = lane >> 4;
    f32x4 acc[4][4];
#pragma unroll
    for (int m = 0; m < 4; ++m)
#pragma unroll
        for (int n = 0; n < 4; ++n) acc[m][n] = (f32x4){0.f, 0.f, 0.f, 0.f};
#define GT_STAGE(st_, kt_) do { char* sa_ = lds + (st_) * 16384 + tid * 16; \
        __builtin_amdgcn_global_load_lds((const unsigned*)(a0 + (kt_)), (__attribute__((address_space(3))) unsigned*)(sa_), 16, 0, 0); \
        __builtin_amdgcn_global_load_lds((const unsigned*)(a1 + (kt_)), (__attribute__((address_space(3))) unsigned*)(sa_ + 4096), 16, 0, 0); \
        __builtin_amdgcn_global_load_lds((const unsigned*)(b0 + (kt_)), (__attribute__((address_space(3))) unsigned*)(sa_ + 8192), 16, 0, 0); \
        __builtin_amdgcn_global_load_lds((const unsigned*)(b1 + (kt_)), (__attribute__((address_space(3))) unsigned*)(sa_ + 12288), 16, 0, 0); } while (0)
    const int fsw = (0 - (fr >> 2)) & 3;
    const int aoff = (wr * 64 + fr) * 64 + ((fq ^ fsw) * 16), boff = 8192 + (wc * 64 + fr) * 64 + ((fq ^ fsw) * 16);
    const int nk = K / 32;
    GT_STAGE(0, 0);
    if (nk > 1) GT_STAGE(1, 32);
    if (nk > 2) GT_STAGE(2, 64);
    for (int t = 0; t < nk; ++t) {
        if (t + 2 < nk) asm volatile("s_waitcnt vmcnt(8)" ::: "memory"); else if (t + 1 < nk) asm volatile("s_waitcnt vmcnt(4)" ::: "memory"); else asm volatile("s_waitcnt vmcnt(0)" ::: "memory");
        asm volatile("s_waitcnt lgkmcnt(0)" ::: "memory");
        __builtin_amdgcn_s_barrier();
        if (t + 3 < nk) GT_STAGE((t + 3) & 3, (t + 3) * 32);
        const char* sb = lds + (t & 3) * 16384;
        bf16x8 At[4], Bt[4];
#pragma unroll
        for (int m = 0; m < 4; ++m) At[m] = *(const bf16x8*)(sb + aoff + m * 1024);
#pragma unroll
        for (int n = 0; n < 4; ++n) Bt[n] = *(const bf16x8*)(sb + boff + n * 1024);
#pragma unroll
        for (int m = 0; m < 4; ++m)
#pragma unroll
            for (int n = 0; n < 4; ++n) acc[m][n] = SWAP ? __builtin_amdgcn_mfma_f32_16x16x32_bf16(Bt[n], At[m], acc[m][n], 0, 0, 0) : __builtin_amdgcn_mfma_f32_16x16x32_bf16(At[m], Bt[n], acc[m][n], 0, 0, 0);
    }
    asm volatile("s_waitcnt lgkmcnt(0)" ::: "memory");
    __builtin_amdgcn_s_barrier();
#undef GT_STAGE
    epi(acc, wr, wc, fr, fq);
}
#define STG_ROW(i) ((tid_ + (i) * 256) >> 2)
#define STG_K ((((tid_ & 3) ^ ((0 - (tid_ >> 4)) & 3))) * 8)

__device__ __forceinline__ f32x4 ld_bf16x4(const bf16_t* src) { const u32x2_t w = *(const u32x2_t*)src; return (f32x4){__uint_as_float(w.x << 16), __uint_as_float(w.x & 0xffff0000u), __uint_as_float(w.y << 16), __uint_as_float(w.y & 0xffff0000u)}; }
template <bool SWAP = true, class Epi>
__device__ __forceinline__ void gemm_tile2(const bf16_t* a0, const bf16_t* a1, const bf16_t* b0, size_t ldb64, int K, char* lds, const Epi& epi) {
    const int tid = opq_tid(), wid = tid >> 6, lane = tid & 63, wr = wid >> 1, wc = wid & 1, fr = lane & 15, fq = lane >> 4;
    f32x4 acc[4][8];
#pragma unroll
    for (int m = 0; m < 4; ++m)
#pragma unroll
        for (int n = 0; n < 8; ++n) acc[m][n] = (f32x4){0.f, 0.f, 0.f, 0.f};
#define GT2_STAGE(st_, kt_) do { char* sa_ = lds + (st_) * 24576 + tid * 16; \
        __builtin_amdgcn_global_load_lds((const unsigned*)(a0 + (kt_)), (__attribute__((address_space(3))) unsigned*)(sa_), 16, 0, 0); \
        __builtin_amdgcn_global_load_lds((const unsigned*)(a1 + (kt_)), (__attribute__((address_space(3))) unsigned*)(sa_ + 4096), 16, 0, 0); \
        __builtin_amdgcn_global_load_lds((const unsigned*)(b0 + (kt_)), (__attribute__((address_space(3))) unsigned*)(sa_ + 8192), 16, 0, 0); \
        __builtin_amdgcn_global_load_lds((const unsigned*)(b0 + ldb64 + (kt_)), (__attribute__((address_space(3))) unsigned*)(sa_ + 12288), 16, 0, 0); \
        __builtin_amdgcn_global_load_lds((const unsigned*)(b0 + 2 * ldb64 + (kt_)), (__attribute__((address_space(3))) unsigned*)(sa_ + 16384), 16, 0, 0); \
        __builtin_amdgcn_global_load_lds((const unsigned*)(b0 + 3 * ldb64 + (kt_)), (__attribute__((address_space(3))) unsigned*)(sa_ + 20480), 16, 0, 0); } while (0)
    const int fsw = (0 - (fr >> 2)) & 3;
    const int aoff = (wr * 64 + fr) * 64 + ((fq ^ fsw) * 16), boff = 8192 + (wc * 128 + fr) * 64 + ((fq ^ fsw) * 16);
    const int nk = K / 32;
    GT2_STAGE(0, 0);
    if (nk > 1) GT2_STAGE(1, 32);
    int st = 0, st2 = 2;
#pragma unroll 1
    for (int t = 0; t < nk; ++t) {
        if (t + 1 < nk) asm volatile("s_waitcnt vmcnt(6)" ::: "memory"); else asm volatile("s_waitcnt vmcnt(0)" ::: "memory");
        asm volatile("s_waitcnt lgkmcnt(0)" ::: "memory");
        __builtin_amdgcn_s_barrier();
        if (t + 2 < nk) GT2_STAGE(st2, (t + 2) * 32);
        const char* sb = lds + st * 24576;
        bf16x8 At[4];
#pragma unroll
        for (int m = 0; m < 4; ++m) At[m] = *(const bf16x8*)(sb + aoff + m * 1024);
#pragma unroll
        for (int nh = 0; nh < 2; ++nh) {
            bf16x8 Bt[4];
#pragma unroll
            for (int n = 0; n < 4; ++n) Bt[n] = *(const bf16x8*)(sb + boff + (4 * nh + n) * 1024);
#pragma unroll
            for (int m = 0; m < 4; ++m)
#pragma unroll
                for (int n = 0; n < 4; ++n) acc[m][4 * nh + n] = SWAP ? __builtin_amdgcn_mfma_f32_16x16x32_bf16(Bt[n], At[m], acc[m][4 * nh + n], 0, 0, 0) : __builtin_amdgcn_mfma_f32_16x16x32_bf16(At[m], Bt[n], acc[m][4 * nh + n], 0, 0, 0);
        }
        st = st == 2 ? 0 : st + 1; st2 = st2 == 2 ? 0 : st2 + 1;
    }
    asm volatile("s_waitcnt lgkmcnt(0)" ::: "memory");
    __builtin_amdgcn_s_barrier();
#undef GT2_STAGE
    epi(acc, wr, wc, fr, fq);
}

__device__ __forceinline__ void g_gemm_in(const Params& p, char* lds) {
    const int tid_ = opq_tid(), bid_ = opq_bid(); (void)tid_; (void)bid_;
    constexpr int NT = NINP / 256, MT = T / 128;
    for (int tile = bid_; tile < NT * MT; tile += gridDim.x) {
        const int tm = tile / NT, tn = tile % NT;
        const bf16_t* a0 = p.H + (size_t)(tm * 128 + STG_ROW(0)) * D + STG_K; const bf16_t* a1 = p.H + (size_t)(tm * 128 + STG_ROW(1)) * D + STG_K;
        const bf16_t* b0 = p.win_t + (size_t)(tn * 256 + STG_ROW(0)) * D + STG_K;
        if (tn * 256 >= WVB) {
            gemm_tile2<false>(a0, a1, b0, (size_t)64 * D, D, lds, [&](const f32x4 (&acc)[4][8], int wr, int wc, int fr, int fq) {
#pragma unroll
                for (int m = 0; m < 4; ++m) { const int m0 = tm * 128 + wr * 64 + m * 16 + fq * 4; int b, u;
                    if (m0 < TL) { b = m0 / S; u = L + m0 % S; } else { b = (m0 - TL) / L; u = (m0 - TL) % L; }
#pragma unroll
                    for (int n = 0; n < 8; ++n) { const int vc = tn * 256 + wc * 128 + n * 16 + fr - WVB;
                        st_bf16x4(p.VT + ((size_t)(b * 8 + (vc >> 6)) * 64 + (vc & 63)) * PU + u, acc[m][n]); } }
            });
        } else {
            gemm_tile2<true>(a0, a1, b0, (size_t)64 * D, D, lds, [&](const f32x4 (&acc)[4][8], int wr, int wc, int fr, int fq) {
                const int c0 = tn * 256 + wc * 128;
                if (c0 < ZQN && tm < TL / 128) {
#pragma unroll
                    for (int m = 0; m < 4; ++m) { const int row = tm * 128 + wr * 64 + m * 16 + fr, t = row % S;
                        bf16_t* zr = p.Z + (size_t)row * ZP + c0 + 4 * fq;
#pragma unroll
                        for (int hh = 0; hh < 2; ++hh)
#pragma unroll
                            for (int ax = 0; ax < 2; ++ax) { const int pos = ax ? t % GRID_W : t / GRID_W;
                                const f32x4 cs = *(const f32x4*)(p.rope + pos * 16 + 4 * fq), sn = *(const f32x4*)(p.rope + 1024 + pos * 16 + 4 * fq);
                                const f32x4 x0 = acc[m][4 * hh + 2 * ax], x1 = acc[m][4 * hh + 2 * ax + 1];
                                st_bf16x4(zr + 64 * hh + 32 * ax, x0 * cs - x1 * sn); st_bf16x4(zr + 64 * hh + 32 * ax + 16, x1 * cs + x0 * sn); }
                        asm volatile("" ::: "memory"); }
                } else {
#pragma unroll
                    for (int m = 0; m < 4; ++m)
#pragma unroll
                        for (int n = 0; n < 8; ++n) { const int col = c0 + n * 16 + 4 * fq;
                            if (col < ZP) st_bf16x4(p.Z + (size_t)(tm * 128 + wr * 64 + m * 16 + fr) * ZP + col, acc[m][n]); }
                }
            });
        }
    }
}
__device__ __forceinline__ void g_gemm_out(const Params& p, int nrows, char* lds) {
    const int tid_ = opq_tid(), bid_ = opq_bid(); (void)tid_; (void)bid_;
    constexpr int NT = D / 128; const int MT = nrows / 128;
    for (int tile = bid_; tile < NT * MT; tile += gridDim.x) {
        const int tm = tile / NT, tn = tile % NT;
        const bf16_t* a0 = p.MIX + (size_t)(tm * 128 + STG_ROW(0)) * DMIX + STG_K; const bf16_t* a1 = p.MIX + (size_t)(tm * 128 + STG_ROW(1)) * DMIX + STG_K;
        const bf16_t* b0 = p.wout_t + (size_t)(tn * 128 + STG_ROW(0)) * DMIX + STG_K; const bf16_t* b1 = p.wout_t + (size_t)(tn * 128 + STG_ROW(1)) * DMIX + STG_K;
        gemm_tile(a0, a1, b0, b1, DMIX, lds, [&](const f32x4 (&acc)[4][4], int wr, int wc, int fr, int fq) {
#pragma unroll
            for (int m = 0; m < 4; ++m)
#pragma unroll
                for (int n = 0; n < 4; ++n) st_bf16x4(p.O + (size_t)(tm * 128 + wr * 64 + m * 16 + fr) * D + tn * 128 + wc * 64 + n * 16 + 4 * fq, acc[m][n]);
        });
    }
}
__device__ __forceinline__ void g_moe1(const Params& p, int l, char* lds) {
    const int tid_ = opq_tid(), bid_ = opq_bid(); (void)tid_; (void)bid_;
    const int* cnt = p.cnt + l * NEXP; const int nrb = moe_blocks(cnt); constexpr int NT = 2 * DE / 128;
    for (int tile = bid_; tile < nrb * NT; tile += gridDim.x) {
        const int rb = tile / NT, tn = tile % NT, e = moe_block_expert(cnt, rb);
        const bf16_t* a0 = p.H + (size_t)p.slotTok[rb * 128 + STG_ROW(0)] * D + STG_K; const bf16_t* a1 = p.H + (size_t)p.slotTok[rb * 128 + STG_ROW(1)] * D + STG_K;
        const bf16_t* bw = p.wgu_t + (size_t)e * 2 * DE * D;
        const bf16_t* b0 = bw + (size_t)(tn * 128 + STG_ROW(0)) * D + STG_K; const bf16_t* b1 = bw + (size_t)(tn * 128 + STG_ROW(1)) * D + STG_K;
        gemm_tile(a0, a1, b0, b1, D, lds, [&](const f32x4 (&acc)[4][4], int wr, int wc, int fr, int fq) {
#pragma unroll
            for (int m = 0; m < 4; ++m)
#pragma unroll
                for (int n2 = 0; n2 < 2; ++n2) {
                    const f32x4 g = acc[m][2 * n2], u = acc[m][2 * n2 + 1]; f32x4 a;
#pragma unroll
                    for (int e4 = 0; e4 < 4; ++e4) a[e4] = g[e4] / (1.0f + __expf(-g[e4])) * u[e4];
                    st_bf16x4(p.ACT + (size_t)(rb * 128 + wr * 64 + m * 16 + fr) * DE + tn * 64 + wc * 32 + n2 * 16 + 4 * fq, a); }
        });
    }
}
__device__ __forceinline__ void g_moe2(const Params& p, int l, char* lds) {
    const int tid_ = opq_tid(), bid_ = opq_bid(); (void)tid_; (void)bid_;
    const int* cnt = p.cnt + l * NEXP; const int nrb = moe_blocks(cnt); constexpr int NT = D / 128;
    for (int tile = bid_; tile < nrb * NT; tile += gridDim.x) {
        const int rb = tile / NT, tn = tile % NT, e = moe_block_expert(cnt, rb);
        const bf16_t* a0 = p.ACT + (size_t)(rb * 128 + STG_ROW(0)) * DE + STG_K; const bf16_t* a1 = p.ACT + (size_t)(rb * 128 + STG_ROW(1)) * DE + STG_K;
        const bf16_t* bw = p.wd_t + (size_t)e * D * DE;
        const bf16_t* b0 = bw + (size_t)(tn * 128 + STG_ROW(0)) * DE + STG_K; const bf16_t* b1 = bw + (size_t)(tn * 128 + STG_ROW(1)) * DE + STG_K;
        gemm_tile(a0, a1, b0, b1, DE, lds, [&](const f32x4 (&acc)[4][4], int wr, int wc, int fr, int fq) {
#pragma unroll
            for (int m = 0; m < 4; ++m)
#pragma unroll
                for (int n = 0; n < 4; ++n) st_bf16x4(p.YSb + (size_t)(rb * 128 + wr * 64 + m * 16 + fr) * D + tn * 128 + wc * 64 + n * 16 + 4 * fq, acc[m][n]);
        });
    }
}


constexpr int DV = D / 256;
static_assert(D % 256 == 0, "row phases hold a row as DV float4 per lane");
template <int CTRL> __device__ __forceinline__ float dppf(float v) { return __builtin_bit_cast(float, __builtin_amdgcn_update_dpp(0, __builtin_bit_cast(int, v), CTRL, 0xf, 0xf, true)); }
__device__ __forceinline__ float wave_sum(float v) {
    v += dppf<0xB1>(v); v += dppf<0x4E>(v); v += dppf<0x141>(v); v += dppf<0x140>(v);
    float a = v, b = v;
    asm volatile("s_nop 1\n\tv_permlane16_swap_b32 %0, %1" : "+v"(a), "+v"(b));
    v = a + b; a = v; b = v;
    asm volatile("s_nop 1\n\tv_permlane32_swap_b32 %0, %1" : "+v"(a), "+v"(b));
    return a + b;
}
__device__ __forceinline__ float sum8(float v) { v += dppf<0xB1>(v); v += dppf<0x4E>(v); v += dppf<0x141>(v); return v; }
__device__ __forceinline__ float sum4(f32x4 a) { return (a[0] + a[1]) + (a[2] + a[3]); }
#define LDS_WAIT() asm volatile("s_waitcnt lgkmcnt(0)" ::: "memory")

__device__ __forceinline__ void row_stats(const f32x4 (&v)[DV], float& mu, float& rstd) {
    float s = 0.f;
#pragma unroll
    for (int j = 0; j < DV; ++j) s += sum4(v[j]);
    mu = wave_sum(s) * (1.0f / D);
    float q = 0.f;
#pragma unroll
    for (int j = 0; j < DV; ++j) { const f32x4 d = v[j] - mu; q += sum4(d * d); }
    rstd = 1.0f / sqrtf(wave_sum(q) * (1.0f / D) + LN_EPS);
}

__device__ __forceinline__ void ph_lnmod_fast(const Params& p, int l) {
    const int tid_ = opq_tid(), bid_ = opq_bid(); (void)tid_; (void)bid_;
    const int lane = tid_ & 63, gw = bid_ * 4 + (tid_ >> 6), nw = gridDim.x * 4;
    constexpr int R = 4;
    for (int m0 = gw * R; m0 < T; m0 += nw * R) {
        f32x4 v[R][DV];
#pragma unroll
        for (int r = 0; r < R; ++r) { const f32x4* xr = (const f32x4*)xrow_in(p, l, m0 + r < T ? m0 + r : m0) + lane;
#pragma unroll
            for (int j = 0; j < DV; ++j) v[r][j] = xr[64 * j]; }
        float mu[R], rstd[R];
#pragma unroll
        for (int r = 0; r < R; ++r) row_stats(v[r], mu[r], rstd[r]);
#pragma unroll
        for (int r = 0; r < R; ++r) if (m0 + r < T) { const f32x4* md = (const f32x4*)modrow(p, l, m0 + r) + lane;
#pragma unroll
            for (int j = 0; j < DV; ++j) st_bf16x4(p.H + (size_t)(m0 + r) * D + 4 * (lane + 64 * j), (v[r][j] - mu[r]) * rstd[r] * (md[D / 4 + 64 * j] + 1.0f) + md[64 * j]); }
    }
}

template <int R>
__device__ __forceinline__ void pm_rows(const Params& p, int l, int m0, int lane) {
    const f32x4* g1 = (const f32x4*)(p.ln1_g + (size_t)l * D) + lane; const f32x4* b1 = (const f32x4*)(p.ln1_b + (size_t)l * D) + lane;
    f32x4 v[R][DV]; float mu[R], rstd[R];
#pragma unroll
    for (int r = 0; r < R; ++r) { const int m = m0 + r; const f32x4* xr = (const f32x4*)xrow_in(p, l, m) + lane; const f32x4* md = (const f32x4*)modrow(p, l, m) + lane;
        const bf16_t* orow = p.O + (size_t)m * D + 4 * lane;
#pragma unroll
        for (int j = 0; j < DV; ++j) v[r][j] = xr[64 * j] * ALPHA + md[2 * (D / 4) + 64 * j] * ld_bf16x4(orow + 256 * j); }
#pragma unroll
    for (int r = 0; r < R; ++r) row_stats(v[r], mu[r], rstd[r]);
#pragma unroll
    for (int r = 0; r < R; ++r) { const int m = m0 + r; f32x4* x1 = (f32x4*)((m < TL) ? p.out + (size_t)m * D : p.XC + (size_t)(m - TL) * D) + lane;
#pragma unroll
        for (int j = 0; j < DV; ++j) { v[r][j] = (v[r][j] - mu[r]) * rstd[r] * g1[64 * j] + b1[64 * j]; x1[64 * j] = v[r][j]; } }
#pragma unroll
    for (int r = 0; r < R; ++r) row_stats(v[r], mu[r], rstd[r]);
#pragma unroll
    for (int r = 0; r < R; ++r) { const int m = m0 + r; const f32x4* md = (const f32x4*)modrow(p, l, m) + lane;
#pragma unroll
        for (int j = 0; j < DV; ++j) {
            const f32x4 hv = (v[r][j] - mu[r]) * rstd[r] * (md[4 * (D / 4) + 64 * j] + 1.0f) + md[3 * (D / 4) + 64 * j];
            f32x4 hh, lo;
#pragma unroll
            for (int e = 0; e < 4; ++e) { hh[e] = bf2f(f2bf(hv[e])); lo[e] = hv[e] - hh[e]; }
            st_bf16x4(p.H + (size_t)m * D + 4 * (lane + 64 * j), hh);
            st_bf16x4(p.HLO + (size_t)m * D + 4 * (lane + 64 * j), lo);
        } }
}

__device__ __forceinline__ int router_rpg(int nrows) { const int g = gridDim.x; return (nrows % g == 0 && nrows / g <= 48 && (nrows / g) % 4 == 0) ? nrows / g : 32; }
__device__ __forceinline__ void g_router(const Params& p, int l, int nrows, char* lds) {
    const int tid_ = opq_tid(), bid_ = opq_bid(); (void)tid_; (void)bid_;
    const int lane = tid_ & 63, wid = tid_ >> 6, fr = lane & 15, fq = lane >> 4;
    const int RPG = router_rpg(nrows), RW = RPG / 4;
    float* part = (float*)lds;
    float* lgt = part + 4 * 9 * 64 * 4;
    int* eids = (int*)(lgt + 48 * 48);
    for (int rg = bid_; rg < nrows / RPG; rg += gridDim.x) {
#pragma unroll 1
        for (int i = 0; i + 1 < RW; i += 2) pm_rows<2>(p, l, rg * RPG + wid * RW + i, lane);
        if (RW & 1) pm_rows<1>(p, l, rg * RPG + wid * RW + RW - 1, lane);
        asm volatile("s_waitcnt vmcnt(0)" ::: "memory");
        __syncthreads();
        f32x4 acc[3][3];
#pragma unroll
        for (int a = 0; a < 3; ++a)
#pragma unroll
            for (int b = 0; b < 3; ++b) acc[a][b] = (f32x4){0.f, 0.f, 0.f, 0.f};
        int arow[3];
#pragma unroll
        for (int a = 0; a < 3; ++a) { const int rr = a * 16 + fr; arow[a] = rg * RPG + (rr < RPG ? rr : RPG - 1); }
#pragma unroll
        for (int seg = 0; seg < 3; ++seg) {
            const bf16_t* ab = (seg < 2 ? p.H : p.HLO) + wid * (D / 4) + fq * 8;
            const bf16_t* bp = p.wrt + (seg == 1 ? (size_t)128 * D : 0) + (size_t)fr * D + wid * (D / 4) + fq * 8;
#pragma unroll 1
            for (int ks0 = 0; ks0 < D / 128; ks0 += 2) {
                bf16x8 av[2][3], bv[2][3];
#pragma unroll
                for (int u = 0; u < 2; ++u) { const int ko = (ks0 + u) * 32;
#pragma unroll
                    for (int a = 0; a < 3; ++a) { av[u][a] = *(const bf16x8*)(ab + (size_t)arow[a] * D + ko); bv[u][a] = *(const bf16x8*)(bp + (size_t)(16 * a) * D + ko); } }
                asm volatile("" ::: "memory");
#pragma unroll
                for (int u = 0; u < 2; ++u)
#pragma unroll
                    for (int a = 0; a < 3; ++a)
#pragma unroll
                        for (int b = 0; b < 3; ++b) acc[a][b] = __builtin_amdgcn_mfma_f32_16x16x32_bf16(av[u][a], bv[u][b], acc[a][b], 0, 0, 0);
            }
        }
#pragma unroll
        for (int a = 0; a < 3; ++a)
#pragma unroll
            for (int b = 0; b < 3; ++b) *(f32x4*)(part + ((wid * 9 + a * 3 + b) * 64 + lane) * 4) = acc[a][b];
        __syncthreads();
#pragma unroll
        for (int i = 0; i < 9; ++i) { const int e = tid_ + 256 * i, f = e >> 8, ln = (e & 255) >> 2, j = e & 3;
            const float sm = (part[((0 * 9 + f) * 64 + ln) * 4 + j] + part[((1 * 9 + f) * 64 + ln) * 4 + j]) + (part[((2 * 9 + f) * 64 + ln) * 4 + j] + part[((3 * 9 + f) * 64 + ln) * 4 + j]);
            lgt[((f / 3) * 16 + (ln >> 4) * 4 + j) * 48 + (f % 3) * 16 + (ln & 15)] = sm; }
        __syncthreads();
        if (tid_ < RPG) {
            const int m = rg * RPG + tid_; const float* lg = lgt + tid_ * 48;
            float gl[4], el[32];
#pragma unroll
            for (int g = 0; g < 4; ++g) gl[g] = lg[g] + p.b_rg[l * 4 + g];
#pragma unroll
            for (int e = 0; e < 32; ++e) el[e] = lg[4 + e] + p.b_re[l * 32 + e];
            int gs = 0; float gm = gl[0];
#pragma unroll
            for (int g = 1; g < 4; ++g) if (gl[g] > gm) { gm = gl[g]; gs = g; }
            float den = 0.f;
#pragma unroll
            for (int g = 0; g < 4; ++g) den += expf(gl[g] - gm);
            const float pg = 1.0f / den;
            float v1 = -3e38f, v2 = -3e38f; int i1 = 0, i2 = 0;
#pragma unroll
            for (int j = 0; j < 8; ++j) {
                const float vv = gs == 0 ? el[j] : gs == 1 ? el[8 + j] : gs == 2 ? el[16 + j] : el[24 + j];
                if (vv > v1) { v2 = v1; i2 = i1; v1 = vv; i1 = j; } else if (vv > v2) { v2 = vv; i2 = j; }
            }
            const float e2 = expf(v2 - v1), w1 = pg / (1.0f + e2), w2 = pg * e2 / (1.0f + e2);
            const int ea = gs * 8 + i1, eb = gs * 8 + i2;
            p.rE[2 * m] = ea; p.rE[2 * m + 1] = eb; p.rW[2 * m] = w1; p.rW[2 * m + 1] = w2;
            eids[2 * tid_] = ea; eids[2 * tid_ + 1] = eb;
        }
        __syncthreads();
        if (tid_ < 2 * RPG) { const int e = eids[tid_]; int rk = 0; for (int j = 0; j < tid_; ++j) rk += (eids[j] == e) ? 1 : 0; p.rPos[2 * (rg * RPG) + tid_] = rk; }
        else if (tid_ >= 128 && tid_ < 160) { const int e = tid_ - 128; int c = 0; for (int j = 0; j < 2 * RPG; ++j) c += (eids[j] == e) ? 1 : 0; p.hist[rg * 32 + e] = c; }
        __syncthreads();
    }
}

__device__ __forceinline__ void ph_dispatch_fast(const Params& p, int l, int nrows, char* lds) {
    const int tid_ = opq_tid(), bid_ = opq_bid(); (void)tid_; (void)bid_;
    const int RPG = router_rpg(nrows), nrg = nrows / RPG, e = tid_ & 31, part = tid_ >> 5;
    int* tot = (int*)lds; int* pst = tot + 32; int* pre = pst + 32; int* red = pre + 32;
    { int s = 0; for (int b = part; b < nrg; b += 8) s += p.hist[b * 32 + e]; red[part * 32 + e] = s; }
    __syncthreads();
    if (tid_ < 32) { int s = 0; for (int q = 0; q < 8; ++q) s += red[q * 32 + tid_]; tot[tid_] = s; }
    __syncthreads();
    if (tid_ < 32) { int s = 0; for (int j = 0; j < tid_; ++j) s += (tot[j] + 127) & ~127; pst[tid_] = s; if (bid_ == 0) p.cnt[l * NEXP + tid_] = tot[tid_]; }
    for (int rg = bid_; rg < nrg; rg += gridDim.x) {
        __syncthreads();
        { int s = 0; for (int b = part; b < rg; b += 8) s += p.hist[b * 32 + e]; red[part * 32 + e] = s; }
        __syncthreads();
        if (tid_ < 32) { int s = 0; for (int q = 0; q < 8; ++q) s += red[q * 32 + tid_]; pre[tid_] = s; }
        __syncthreads();
        if (tid_ < 2 * RPG) { const int i = 2 * (rg * RPG) + tid_, ee = p.rE[i], slot = pst[ee] + pre[ee] + p.rPos[i]; p.rSlot[i] = slot; p.slotTok[slot] = i >> 1; }
    }
}

__device__ __forceinline__ void ph_final_fast(const Params& p, int l, int nrows, bool next_h) {
    const int tid_ = opq_tid(), bid_ = opq_bid(); (void)tid_; (void)bid_;
    const int lane = tid_ & 63, gw = bid_ * 4 + (tid_ >> 6), nw = gridDim.x * 4;
    constexpr int R = 2;
    const f32x4* g2 = (const f32x4*)(p.ln2_g + (size_t)l * D) + lane; const f32x4* b2 = (const f32x4*)(p.ln2_b + (size_t)l * D) + lane;
    for (int m0 = gw * R; m0 < nrows; m0 += nw * R) {
        f32x4 v[R][DV]; float mu[R], rstd[R];
#pragma unroll
        for (int r = 0; r < R; ++r) { const int m = m0 + r; const f32x4* x1 = (const f32x4*)((m < TL) ? p.out + (size_t)m * D : p.XC + (size_t)(m - TL) * D) + lane;
            const f32x4* md = (const f32x4*)modrow(p, l, m) + lane;
            const bf16_t* ya = p.YSb + (size_t)p.rSlot[2 * m] * D + 4 * lane; const bf16_t* yb = p.YSb + (size_t)p.rSlot[2 * m + 1] * D + 4 * lane;
            const float wa = p.rW[2 * m], wb = p.rW[2 * m + 1];
#pragma unroll
            for (int j = 0; j < DV; ++j) v[r][j] = x1[64 * j] * ALPHA + md[5 * (D / 4) + 64 * j] * (ld_bf16x4(ya + 256 * j) * wa + ld_bf16x4(yb + 256 * j) * wb); }
#pragma unroll
        for (int r = 0; r < R; ++r) row_stats(v[r], mu[r], rstd[r]);
#pragma unroll
        for (int r = 0; r < R; ++r) { const int m = m0 + r; f32x4* x1 = (f32x4*)((m < TL) ? p.out + (size_t)m * D : p.XC + (size_t)(m - TL) * D) + lane;
#pragma unroll
            for (int j = 0; j < DV; ++j) { v[r][j] = (v[r][j] - mu[r]) * rstd[r] * g2[64 * j] + b2[64 * j]; x1[64 * j] = v[r][j]; } }
        if (next_h) {
#pragma unroll
            for (int r = 0; r < R; ++r) row_stats(v[r], mu[r], rstd[r]);
#pragma unroll
            for (int r = 0; r < R; ++r) { const int m = m0 + r; const f32x4* mn = (const f32x4*)modrow(p, l + 1, m) + lane;
#pragma unroll
                for (int j = 0; j < DV; ++j) st_bf16x4(p.H + (size_t)m * D + 4 * (lane + 64 * j), (v[r][j] - mu[r]) * rstd[r] * (mn[D / 4 + 64 * j] + 1.0f) + mn[64 * j]); }
        }
    }
}

__device__ __forceinline__ void ph_mod_fast(const Params& p, char* lds) {
    const int tid_ = opq_tid(), bid_ = opq_bid(); (void)tid_; (void)bid_;
    constexpr int NR = NB + 1, NTASK = 2 * (6 * D / 64);
    if (bid_ >= NTASK) return;
    float* sc = (float*)lds;
    float* part = sc + NR * D;
    for (int i = tid_; i < NR * D; i += 256) { const int b = i / D, k = i % D; const float cv = b < NB ? p.c[(size_t)b * D + k] : p.c_ctx[k]; sc[i] = cv / (1.0f + __expf(-cv)); }
    __syncthreads();
    const int lane = tid_ & 63, wid = tid_ >> 6;
    for (int task = bid_; task < NTASK; task += gridDim.x) {
        const int ll = task / (6 * D / 64), col = 64 * (task % (6 * D / 64)) + lane;
        float acc[NR];
#pragma unroll
        for (int b = 0; b < NR; ++b) acc[b] = 0.f;
        const float* wp = p.w_mod + ((size_t)ll * D + wid * (D / 4)) * 6 * D + col;
#pragma unroll 16
        for (int k = 0; k < D / 4; ++k) { const float w = wp[(size_t)k * 6 * D];
#pragma unroll
            for (int b = 0; b < NR; ++b) acc[b] += sc[b * D + wid * (D / 4) + k] * w; }
#pragma unroll
        for (int b = 0; b < NR; ++b) part[(wid * NR + b) * 64 + lane] = acc[b];
        __syncthreads();
        for (int i = tid_; i < NR * 64; i += 256) { const int b = i / 64, cl = i % 64;
            p.mod[((size_t)ll * NR + b) * 6 * D + 64 * (task % (6 * D / 64)) + cl] = (part[(0 * NR + b) * 64 + cl] + part[(1 * NR + b) * 64 + cl]) + (part[(2 * NR + b) * 64 + cl] + part[(3 * NR + b) * 64 + cl]) + p.b_mod[(size_t)ll * 6 * D + 64 * (task % (6 * D / 64)) + cl]; }
        __syncthreads();
    }
}

template <bool SPLIT = false>
__device__ __forceinline__ void tr_item(const float* srcl, size_t ldw, bf16_t* dst, size_t ldd, float* scr, int lane, float scale = 1.0f) {
    float v[32];
#pragma unroll
    for (int i = 0; i < 32; ++i) v[i] = srcl ? srcl[(size_t)(2 * i + (lane >> 5)) * ldw] * scale : 0.f;
#pragma unroll
    for (int i = 0; i < 32; ++i) scr[(2 * i + (lane >> 5)) * 33 + (lane & 31)] = v[i];
    LDS_WAIT();
    const int c = lane & 7;
#pragma unroll
    for (int j = 0; j < 4; ++j) { const int n = (lane >> 3) + 8 * j; const float* s = scr + (8 * c) * 33 + n;
        uint4 o; o.x = pk2(s[0], s[33]); o.y = pk2(s[2 * 33], s[3 * 33]); o.z = pk2(s[4 * 33], s[5 * 33]); o.w = pk2(s[6 * 33], s[7 * 33]);
        *(uint4*)(dst + (size_t)(SPLIT ? (n & 15) + 32 * (n >> 4) : n) * ldd + 8 * c) = o; }
    LDS_WAIT();
}
__device__ __forceinline__ void ph_prep_w_fast(const Params& p, int l, int part, char* lds) {
    const int tid_ = opq_tid(), bid_ = opq_bid(); (void)tid_; (void)bid_;
    const int lane = tid_ & 63, wid = tid_ >> 6, gw = bid_ * 4 + wid, nw = gridDim.x * 4;
    float* scr = (float*)(lds + wid * 8448);
    constexpr int I_IN = (D / 64) * (NINP / 32), I_OUT = (DMIX / 64) * (D / 32), I_GU1 = (D / 64) * (2 * DE / 32), I_D1 = (DE / 64) * (D / 32);
    constexpr int NITEMS = I_IN + I_OUT + NEXP * (I_GU1 + I_D1);
    const int it0 = part == 0 ? 0 : I_IN + I_OUT, it1 = part == 0 ? I_IN + I_OUT : NITEMS;
    for (int it = it0 + gw; it < it1; it += nw) {
        int r = it;
        if (r < I_IN) { const int kb = r / (NINP / 32), n0 = 32 * (r % (NINP / 32));
            const float* s = nullptr;
            {
                const int oc = n0 < ZQN ? n0 + A_IN : n0 < ZA ? n0 + 1312 : n0 < ZP ? n0 - ZA : n0 < WVB ? -1 : n0 < WVN ? n0 - 864 : n0 - 96;
                if (oc >= 0) s = p.w_in + ((size_t)l * D + 64 * kb) * N_IN + oc + (lane & 31); }
            tr_item(s, N_IN, p.win_t + (size_t)n0 * D + 64 * kb, D, scr, lane, (n0 < ZKB || (n0 >= ZQN && n0 < ZKN)) ? QSCALE : 1.0f); continue; }
        r -= I_IN;
        if (r < I_OUT) { const int kb = r / (D / 32), n0 = 32 * (r % (D / 32));
            tr_item(p.w_out + ((size_t)l * DMIX + 64 * kb) * D + n0 + (lane & 31), D, p.wout_t + (size_t)n0 * DMIX + 64 * kb, DMIX, scr, lane); continue; }
        r -= I_OUT;
        const int e = r / (I_GU1 + I_D1); r %= (I_GU1 + I_D1);
        if (r < I_GU1) { const int kb = r / (2 * DE / 32), q = r % (2 * DE / 32), up = q & 1, c0 = 32 * (q >> 1);
            const float* s = (up ? p.w_up : p.w_gate) + (((size_t)l * NEXP + e) * D + 64 * kb) * DE + c0 + (lane & 31);
            tr_item<true>(s, DE, p.wgu_t + ((size_t)e * 2 * DE + 2 * c0 + 16 * up) * D + 64 * kb, D, scr, lane); continue; }
        r -= I_GU1;
        { const int kb = r / (D / 32), n0 = 32 * (r % (D / 32));
            tr_item(p.w_down + (((size_t)l * NEXP + e) * DE + 64 * kb) * D + n0 + (lane & 31), D, p.wd_t + ((size_t)e * D + n0) * DE + 64 * kb, DE, scr, lane); }
    }
    if (part != 0) return;
    const long gt = (long)bid_ * blockDim.x + tid_, gs = (long)gridDim.x * blockDim.x;
    for (long i = gt; i < 2 * 256 * 64; i += gs) { const int k = (int)(i & 63), n = (int)((i >> 6) & 255), d = (int)(i >> 14);
        p.wupT[i] = f2bf(p.a_w_up[(((size_t)l * 2 + d) * 64 + k) * DA + n]); p.aupT[i] = f2bf(p.a_a_up[(((size_t)l * 2 + d) * 64 + k) * DA + n]); }
    for (long i = gt; i < 256 * 160; i += gs) { const int k = (int)(i % 160), n = (int)(i / 160); p.gupT[i] = f2bf(p.a_g_up[((size_t)l * 160 + k) * DA + n]); }
    for (long i = gt; i < (long)128 * D; i += gs) { const int n = (int)(i / D), k = (int)(i % D);
        const float w = n < 4 ? p.w_rg[((size_t)l * D + k) * 4 + n] : n < 36 ? p.w_re[((size_t)l * D + k) * 32 + n - 4] : 0.f;
        const bf16_t hb = f2bf(w); p.wrt[i] = hb; p.wrt[(size_t)128 * D + i] = f2bf(w - bf2f(hb)); }
}

__device__ __forceinline__ float tanh_fast(float x) { return 1.0f - 2.0f / (1.0f + __expf(2.0f * x)); }
__device__ __forceinline__ void ph_streams_s1(const Params& p, int l) {
    const int tid_ = opq_tid(), bid_ = opq_bid(); (void)tid_; (void)bid_;
    constexpr int NCH = A_IN / 8, NCHP = (NCH + 7) & ~7;
    const float* sh = p.a_shift + (size_t)l * 3 * A_IN;
    for (long it = (long)bid_ * 256 + tid_; it < (long)T * NCHP; it += (long)gridDim.x * 256) {
        const int m = (int)(it / NCHP), ch = (int)(it % NCHP), c0 = 8 * ch;
        const bool act = ch < NCH;
        int t, len;
        if (m < TL) { t = m % S; len = S; } else { t = (m - TL) % L; len = L; }
        float v[8];
#pragma unroll
        for (int e = 0; e < 8; ++e) v[e] = 0.f;
        if (act) {
            const bf16_t* z = p.Z + (size_t)m * ZP + ZA + c0;
            const bf16x8 zc = *(const bf16x8*)z;
            const f32x4 s1a = *(const f32x4*)(sh + A_IN + c0), s1b = *(const f32x4*)(sh + A_IN + c0 + 4);
#pragma unroll
            for (int e = 0; e < 8; ++e) v[e] = (e < 4 ? s1a[e] : s1b[e - 4]) * bf2f((bf16_t)zc[e]);
            if (t > 0) { const bf16x8 zp = *(const bf16x8*)(z - ZP); const f32x4 a = *(const f32x4*)(sh + c0), b = *(const f32x4*)(sh + c0 + 4);
#pragma unroll
                for (int e = 0; e < 8; ++e) v[e] += (e < 4 ? a[e] : b[e - 4]) * bf2f((bf16_t)zp[e]); }
            if (t < len - 1) { const bf16x8 zn = *(const bf16x8*)(z + ZP); const f32x4 a = *(const f32x4*)(sh + 2 * A_IN + c0), b = *(const f32x4*)(sh + 2 * A_IN + c0 + 4);
#pragma unroll
                for (int e = 0; e < 8; ++e) v[e] += (e < 4 ? a[e] : b[e - 4]) * bf2f((bf16_t)zn[e]); }
        }
        float nrm = 0.f;
        if (ch >= 32 && ch < 64) {
#pragma unroll
            for (int e = 0; e < 8; ++e) { const float t2 = v[e] * p.a_k_k[l * DA + c0 - 256 + e]; nrm += t2 * t2; } }
        nrm = sum8(nrm);
        if (!act) continue;
        if (c0 < 768) {
            float* dst = (c0 < 256 ? p.sR + (size_t)m * DA + c0 : c0 < 512 ? p.kT + (size_t)m * DA + c0 - 256 : p.sV + (size_t)m * DA + c0 - 512);
            *(f32x4*)dst = (f32x4){v[0], v[1], v[2], v[3]}; *(f32x4*)(dst + 4) = (f32x4){v[4], v[5], v[6], v[7]};
            if (ch >= 32 && ch < 64 && (ch & 7) == 0) p.kN[(size_t)m * 4 + ((ch - 32) >> 3)] = 1.0f / sqrtf(nrm + 1e-12f);
        } else {
            if (c0 < 896) {
#pragma unroll
                for (int e = 0; e < 8; ++e) v[e] = tanh_fast(v[e]); }
            else if (c0 >= 1024) {
#pragma unroll
                for (int e = 0; e < 8; ++e) v[e] = 1.0f / (1.0f + __expf(-v[e])); }
            uint4 o; o.x = pk2(v[0], v[1]); o.y = pk2(v[2], v[3]); o.z = pk2(v[4], v[5]); o.w = pk2(v[6], v[7]);
            *(uint4*)(p.LA + (size_t)m * 416 + c0 - 768) = o;
        }
    }
}
__device__ __forceinline__ void g_streams_s2(const Params& p, int l, char* lds) {
    const int tid_ = opq_tid(), bid_ = opq_bid(); (void)tid_; (void)bid_;
    constexpr int MT = T / 128;
    for (int job = bid_; job < 5 * MT * 2; job += gridDim.x) {
        const int type = job / (MT * 2), r = job % (MT * 2), tm = r >> 1, tn = r & 1;
        const int coff = type < 2 ? type * 64 : type < 4 ? 128 + (type - 2) * 64 : 256, K = type < 4 ? 64 : 160, d = type & 1;
        const bf16_t* Bt = type < 2 ? p.wupT + type * 256 * 64 : type < 4 ? p.aupT + (type - 2) * 256 * 64 : p.gupT;
        const bf16_t* a0 = p.LA + (size_t)(tm * 128 + STG_ROW(0)) * 416 + coff + STG_K; const bf16_t* a1 = p.LA + (size_t)(tm * 128 + STG_ROW(1)) * 416 + coff + STG_K;
        const bf16_t* b0 = Bt + (size_t)(tn * 128 + STG_ROW(0)) * K + STG_K; const bf16_t* b1 = Bt + (size_t)(tn * 128 + STG_ROW(1)) * K + STG_K;
        if (type < 2) gemm_tile(a0, a1, b0, b1, K, lds, [&](const f32x4 (&acc)[4][4], int wr, int wc, int fr, int fq) {
#pragma unroll
            for (int mi = 0; mi < 4; ++mi) { const int row = tm * 128 + wr * 64 + mi * 16 + fr;
#pragma unroll
                for (int n = 0; n < 4; ++n) { const int c = tn * 128 + wc * 64 + n * 16 + 4 * fq; const f32x4 w0 = *(const f32x4*)(p.a_w0 + (l * 2 + d) * DA + c); f32x4 o;
#pragma unroll
                    for (int e4 = 0; e4 < 4; ++e4) { const float ex = __expf(-(w0[e4] + acc[mi][n][e4]));
                        o[e4] = __expf(-0.60653065971f / (1.0f + ex)); }
                    *(f32x4*)(p.sW + ((size_t)d * T + row) * DA + c) = o; }
                asm volatile("" ::: "memory"); }
        });
        else if (type < 4) gemm_tile(a0, a1, b0, b1, K, lds, [&](const f32x4 (&acc)[4][4], int wr, int wc, int fr, int fq) {
#pragma unroll
            for (int mi = 0; mi < 4; ++mi) { const int row = tm * 128 + wr * 64 + mi * 16 + fr;
#pragma unroll
                for (int n = 0; n < 4; ++n) { const int c = tn * 128 + wc * 64 + n * 16 + 4 * fq;
                    const f32x4 a0v = *(const f32x4*)(p.a_a0 + (l * 2 + d) * DA + c), kkc = *(const f32x4*)(p.a_k_k + l * DA + c), kac = *(const f32x4*)(p.a_k_a + l * DA + c);
                    const size_t o = (size_t)row * DA + c, od = ((size_t)d * T + row) * DA + c;
                    const f32x4 k = *(const f32x4*)(p.kT + o); const float kn = p.kN[(size_t)row * 4 + (c >> 6)];
                    f32x4 kd, bo, kk;
#pragma unroll
                    for (int e4 = 0; e4 < 4; ++e4) { const float av = 1.0f / (1.0f + __expf(-(a0v[e4] + acc[mi][n][e4])));
                        kk[e4] = k[e4] * kkc[e4] * kn; kd[e4] = k[e4] * (1.0f + (av - 1.0f) * kac[e4]); bo[e4] = kk[e4] * av; }
                    *(f32x4*)(p.sKD + od) = kd; *(f32x4*)(p.sB + od) = bo; if (d == 0) *(f32x4*)(p.sKK + o) = kk; }
                asm volatile("" ::: "memory"); }
        });
        else gemm_tile(a0, a1, b0, b1, K, lds, [&](const f32x4 (&acc)[4][4], int wr, int wc, int fr, int fq) {
#pragma unroll
            for (int mi = 0; mi < 4; ++mi)
#pragma unroll
                for (int n = 0; n < 4; ++n) st_bf16x4(p.MIX + (size_t)(tm * 128 + wr * 64 + mi * 16 + fr) * DMIX + tn * 128 + wc * 64 + n * 16 + 4 * fq, acc[mi][n]);
        });
    }
}


typedef float f32x16 __attribute__((ext_vector_type(16)));
typedef short s16x4 __attribute__((ext_vector_type(4)));
typedef unsigned u32x4_t __attribute__((ext_vector_type(4)));
typedef float f32x2_t __attribute__((ext_vector_type(2)));
typedef __bf16 bf16x2_t __attribute__((ext_vector_type(2)));
__device__ __forceinline__ unsigned cvtpk(float lo, float hi) { f32x2_t v = {lo, hi}; bf16x2_t b = __builtin_convertvector(v, bf16x2_t); return __builtin_bit_cast(unsigned, b); }
__device__ __forceinline__ int crow(int r, int hi) { return (r & 3) + 8 * (r >> 2) + 4 * hi; }
__device__ __forceinline__ float xmax32(float v) { float a = v, b = v; asm volatile("s_nop 1\n\tv_permlane32_swap_b32 %0, %1" : "+v"(a), "+v"(b)); return fmaxf(a, b); }
__device__ __forceinline__ float xsum32(float v) { float a = v, b = v; asm volatile("s_nop 1\n\tv_permlane32_swap_b32 %0, %1" : "+v"(a), "+v"(b)); return a + b; }

struct NoMask { __device__ __forceinline__ float operator()(int, float v) const { return v; } };

template <class MaskF>
__device__ __forceinline__ void attn_tile_lds(const bf16x8 (&qf)[4], const char* ks, const char* vs, const MaskF& mask, float& m_run, float& l_run, f32x16& o0, f32x16& o1, int ql, int hi) {
    f32x16 s;
#pragma unroll
    for (int r = 0; r < 16; ++r) s[r] = 0.f;
#pragma unroll
    for (int k4 = 0; k4 < 4; ++k4) { const bf16x8 kf = *(const bf16x8*)(ks + ql * 128 + (((2 * k4 + hi) ^ (ql & 7)) * 16)); s = __builtin_amdgcn_mfma_f32_32x32x16_bf16(kf, qf[k4], s, 0, 0, 0); }
    float mx = -INFINITY;
#pragma unroll
    for (int r = 0; r < 16; ++r) { s[r] = mask(crow(r, hi), s[r]); mx = fmaxf(mx, s[r]); }
    mx = xmax32(mx);
    if (__any(mx > m_run)) {
        const float mn = fmaxf(m_run, mx), alpha = __builtin_amdgcn_exp2f(m_run - mn);
        m_run = mn; l_run *= alpha;
#pragma unroll
        for (int r = 0; r < 16; ++r) { o0[r] *= alpha; o1[r] *= alpha; }
    }
    float ps = 0.f;
#pragma unroll
    for (int r = 0; r < 16; ++r) { s[r] = __builtin_amdgcn_exp2f(s[r] - m_run); ps += s[r]; }
    l_run += ps;
    const int sw0 = (ql >> 2) & 3;
#pragma unroll
    for (int s2 = 0; s2 < 2; ++s2) {
        u32x4_t pw; pw[0] = cvtpk(s[8 * s2], s[8 * s2 + 1]); pw[1] = cvtpk(s[8 * s2 + 2], s[8 * s2 + 3]); pw[2] = cvtpk(s[8 * s2 + 4], s[8 * s2 + 5]); pw[3] = cvtpk(s[8 * s2 + 6], s[8 * s2 + 7]);
        const bf16x8 pb = __builtin_bit_cast(bf16x8, pw);
        const char* v0 = vs + ql * 64 + 8 * hi; const char* v1 = v0 + 32 * 64;
        const s16x4 a0 = *(const s16x4*)(v0 + (((2 * s2) ^ sw0) * 16)), a1 = *(const s16x4*)(v0 + (((2 * s2 + 1) ^ sw0) * 16));
        const s16x4 c0 = *(const s16x4*)(v1 + (((2 * s2) ^ sw0) * 16)), c1 = *(const s16x4*)(v1 + (((2 * s2 + 1) ^ sw0) * 16));
        o0 = __builtin_amdgcn_mfma_f32_32x32x16_bf16(__builtin_shufflevector(a0, a1, 0, 1, 2, 3, 4, 5, 6, 7), pb, o0, 0, 0, 0);
        o1 = __builtin_amdgcn_mfma_f32_32x32x16_bf16(__builtin_shufflevector(c0, c1, 0, 1, 2, 3, 4, 5, 6, 7), pb, o1, 0, 0, 0);
    }
}

__device__ __forceinline__ void ph_attn_blk(const Params& p, int l, bool with_ctx, int first_blk, char* lds) {
    const int tid_ = opq_tid(), bid_ = opq_bid(); (void)tid_; (void)bid_;
    if (bid_ < first_blk) return;
    const int lane = tid_ & 63, hi = lane >> 5, ql = lane & 31, wid = tid_ >> 6;
    constexpr int NQG = S / 128, NCG = L / 128, ROWS = S / GRID_W, N_LAT = NB * 6 * NQG, N_CTX = NB * 6 * NCG, TPB = (S + L) / 32;
    const int ntask = 2 * N_LAT + (with_ctx ? 2 * N_CTX : 0);
    const int krow = tid_ >> 3, kch = (tid_ & 7) ^ (krow & 7), vrow = tid_ >> 2, vpc = (tid_ & 3) ^ ((vrow >> 2) & 3);
    for (int task = bid_ - first_blk; task < ntask; task += gridDim.x - first_blk) {
        bool isC, isCtx; int r;
        if (task < N_LAT) { isC = true; isCtx = false; r = task; }
        else if (task < 2 * N_LAT) { isC = false; isCtx = false; r = task - N_LAT; }
        else { r = task - 2 * N_LAT; isCtx = true; isC = r >= N_CTX; if (isC) r -= N_CTX; }
        const int ng = isCtx ? NCG : NQG, g = r % ng, h = (r / ng) % 6, b = r / (ng * 6);
        const int qt = 4 * g + wid;
        const int m = isCtx ? TL + b * L + 32 * qt + ql : b * S + 32 * qt + ql;
        const int qcol = isC ? ZQN + h * 64 : ZQB + h * 64, kcol = isC ? ZKN + h * 64 : ZKB + (h / 3) * 64, hv = isC ? 2 + h : h / 3;
        bf16x8 qf[4];
        { const bf16_t* qp = p.Z + (size_t)m * ZP + qcol + 8 * hi;
#pragma unroll
          for (int k4 = 0; k4 < 4; ++k4) qf[k4] = *(const bf16x8*)(qp + 16 * k4); }
        int lo = 0, hi_t = 0, gr0 = 0;
        if (!isCtx) {
            if (!isC) { lo = 4 * g - 4; hi_t = 4 * g + 8; lo = lo < 0 ? 0 : lo; hi_t = hi_t > S / 32 ? S / 32 : hi_t; }
            else { const int ra = 2 * g, rb = 2 * g + 1; int r0a = ra - 4; r0a = r0a < 0 ? 0 : (r0a > ROWS - 8 ? ROWS - 8 : r0a); int r0b = rb - 4; r0b = r0b < 0 ? 0 : (r0b > ROWS - 8 ? ROWS - 8 : r0b);
                   lo = 2 * r0a; hi_t = 2 * (r0b + 8); gr0 = 0; }
        }
        const int ntile = L / 32 + (hi_t - lo);
        const bf16_t* kbase = p.Z + (size_t)krow * ZP + kcol + 8 * kch;
        const bf16_t* vbase = p.VT + ((size_t)(b * 8 + hv) * 64 + vrow) * PU + 8 * vpc;
#define AT_TOK(i_) ((i_) < L / 32 ? 32 * (i_) : L + 32 * (lo + (i_) - L / 32))
#define AT_STAGE(i_) do { const int u0_ = AT_TOK(i_); const int zrow_ = u0_ < L ? TL + b * L + u0_ : b * S + (u0_ - L); char* sl_ = lds + ((i_) % 3) * 8192 + tid_ * 16; \
            __builtin_amdgcn_global_load_lds((const unsigned*)(kbase + (size_t)zrow_ * ZP), (__attribute__((address_space(3))) unsigned*)(sl_), 16, 0, 0); \
            __builtin_amdgcn_global_load_lds((const unsigned*)(vbase + u0_), (__attribute__((address_space(3))) unsigned*)(sl_ + 4096), 16, 0, 0); } while (0)
        f32x16 o0, o1;
#pragma unroll
        for (int rr = 0; rr < 16; ++rr) { o0[rr] = 0.f; o1[rr] = 0.f; }
        float m_run, l_run;
        if (isC) { m_run = -1e30f; l_run = 0.f; } else { m_run = p.b_sink[l * 6 + h] * LOG2E; l_run = hi == 0 ? 1.0f : 0.f; }
        const int gr = qt >> 1, c = 32 * (qt & 1) + ql;
        int r0 = gr - 4; r0 = r0 < 0 ? 0 : (r0 > ROWS - 8 ? ROWS - 8 : r0);
        int c0 = c - 8; c0 = c0 < 0 ? 0 : (c0 > GRID_W - 16 ? GRID_W - 16 : c0);
        float* rpb = (float*)(lds + 24576);
        if (isC && !isCtx) for (int i = tid_; i < 15 * 31; i += 256) rpb[i] = p.c_rpb[((size_t)l * 6 + h) * 15 * 31 + i] * LOG2E;
        AT_STAGE(0);
        if (ntile > 1) AT_STAGE(1);
#pragma unroll 1
        for (int i = 0; i < ntile; ++i) {
            if (i + 1 < ntile) asm volatile("s_waitcnt vmcnt(2)" ::: "memory"); else asm volatile("s_waitcnt vmcnt(0)" ::: "memory");
            asm volatile("s_waitcnt lgkmcnt(0)" ::: "memory");
            __builtin_amdgcn_s_barrier();
            if (i + 2 < ntile) AT_STAGE(i + 2);
            const char* ks = lds + (i % 3) * 8192; const char* vs = ks + 4096;
            if (i < L / 32) attn_tile_lds(qf, ks, vs, NoMask(), m_run, l_run, o0, o1, ql, hi);
            else {
                const int jt = lo + i - L / 32;
                if (!isC) {
                    const int dq = jt - qt;
                    if (dq >= -3 && dq <= 3) attn_tile_lds(qf, ks, vs, NoMask(), m_run, l_run, o0, o1, ql, hi);
                    else if (dq == -4 || dq == 4) { const int base = 32 * dq - ql;
                        attn_tile_lds(qf, ks, vs, [&](int ko, float v) { const int rel = base + ko; return (rel >= -128 && rel <= 128) ? v : -INFINITY; }, m_run, l_run, o0, o1, ql, hi); }
                } else {
                    const int kr_ = jt >> 1, ct = jt & 1;
                    if (kr_ >= r0 && kr_ < r0 + 8) { const float* rp = rpb + (kr_ - gr + 7) * 31 + 15 - c;
                        attn_tile_lds(qf, ks, vs, [&](int ko, float v) { const int kc = 32 * ct + ko; int ix = kc - c + 15; ix = ix < 0 ? 0 : (ix > 30 ? 30 : ix); const float bs = rp[c - 15 + ix];
                                                     return (kc >= c0 && kc < c0 + 16) ? v + bs : -INFINITY; }, m_run, l_run, o0, o1, ql, hi); }
                }
            }
        }
        asm volatile("s_waitcnt lgkmcnt(0)" ::: "memory");
        __builtin_amdgcn_s_barrier();
#undef AT_STAGE
#undef AT_TOK
        (void)gr0;
        const float lt = xsum32(l_run), inv = 1.0f / lt;
        bf16_t* op = p.MIX + (size_t)m * DMIX + (isC ? 640 : 256) + h * 64 + 4 * hi;
#pragma unroll
        for (int gq = 0; gq < 4; ++gq) {
            st_bf16x4(op + 8 * gq, (f32x4){o0[4 * gq] * inv, o0[4 * gq + 1] * inv, o0[4 * gq + 2] * inv, o0[4 * gq + 3] * inv});
            st_bf16x4(op + 32 + 8 * gq, (f32x4){o1[4 * gq] * inv, o1[4 * gq + 1] * inv, o1[4 * gq + 2] * inv, o1[4 * gq + 3] * inv});
        }
    }
}

#define RNB " row_newbcast:%c[n] row_mask:0xf bank_mask:0xf\n\t"
template <int N, bool FIRST>
__device__ __forceinline__ void dpp_dot4(float& a0, float& a1, float& a2, float& a3, const f32x4& v, float s0, float s1, float s2, float s3) {
    if (FIRST) asm volatile("s_nop 1");
    asm("v_fmac_f32_dpp %0, %4, %8" RNB "v_fmac_f32_dpp %1, %5, %9" RNB "v_fmac_f32_dpp %2, %6, %10" RNB "v_fmac_f32_dpp %3, %7, %11" RNB
        : "+v"(a0), "+v"(a1), "+v"(a2), "+v"(a3) : "v"(v[0]), "v"(v[1]), "v"(v[2]), "v"(v[3]), "v"(s0), "v"(s1), "v"(s2), "v"(s3), [n] "i"(N));
}
template <int N, bool FIRST>
__device__ __forceinline__ void dpp_upd4s(float& s0, float& s1, float& s2, float& s3, float& y0, float& y1, float& y2, float& y3,
                                          const f32x4& w, const f32x4& b, const f32x4& kd, const f32x4& r, float nsk, float vv) {
    if (FIRST) asm volatile("s_nop 1");
    asm("v_mul_f32_dpp %0, %8, %0" RNB "v_mul_f32_dpp %1, %9, %1" RNB "v_mul_f32_dpp %2, %10, %2" RNB "v_mul_f32_dpp %3, %11, %3" RNB
        "v_fmac_f32_dpp %0, %12, %24" RNB "v_fmac_f32_dpp %1, %13, %24" RNB "v_fmac_f32_dpp %2, %14, %24" RNB "v_fmac_f32_dpp %3, %15, %24" RNB
        "v_fmac_f32_dpp %0, %16, %25" RNB "v_fmac_f32_dpp %1, %17, %25" RNB "v_fmac_f32_dpp %2, %18, %25" RNB "v_fmac_f32_dpp %3, %19, %25" RNB
        "v_fmac_f32_dpp %4, %20, %0" RNB "v_fmac_f32_dpp %5, %21, %1" RNB "v_fmac_f32_dpp %6, %22, %2" RNB "v_fmac_f32_dpp %7, %23, %3" RNB
        : "+v"(s0), "+v"(s1), "+v"(s2), "+v"(s3), "+v"(y0), "+v"(y1), "+v"(y2), "+v"(y3)
        : "v"(w[0]), "v"(w[1]), "v"(w[2]), "v"(w[3]), "v"(b[0]), "v"(b[1]), "v"(b[2]), "v"(b[3]), "v"(kd[0]), "v"(kd[1]), "v"(kd[2]), "v"(kd[3]),
          "v"(r[0]), "v"(r[1]), "v"(r[2]), "v"(r[3]), "v"(nsk), "v"(vv), [n] "i"(N));
}
template <int N, bool FIRST>
__device__ __forceinline__ void dpp_upd4p(float& s0, float& s1, float& s2, float& s3, float& y0, float& y1, float& y2, float& y3,
                                          const f32x4& w, const f32x4& b, const f32x4& r, float nsk) {
    if (FIRST) asm volatile("s_nop 1");
    asm("v_mul_f32_dpp %0, %8, %0" RNB "v_mul_f32_dpp %1, %9, %1" RNB "v_mul_f32_dpp %2, %10, %2" RNB "v_mul_f32_dpp %3, %11, %3" RNB
        "v_fmac_f32_dpp %0, %12, %20" RNB "v_fmac_f32_dpp %1, %13, %20" RNB "v_fmac_f32_dpp %2, %14, %20" RNB "v_fmac_f32_dpp %3, %15, %20" RNB
        "v_fmac_f32_dpp %4, %16, %0" RNB "v_fmac_f32_dpp %5, %17, %1" RNB "v_fmac_f32_dpp %6, %18, %2" RNB "v_fmac_f32_dpp %7, %19, %3" RNB
        : "+v"(s0), "+v"(s1), "+v"(s2), "+v"(s3), "+v"(y0), "+v"(y1), "+v"(y2), "+v"(y3)
        : "v"(w[0]), "v"(w[1]), "v"(w[2]), "v"(w[3]), "v"(b[0]), "v"(b[1]), "v"(b[2]), "v"(b[3]), "v"(r[0]), "v"(r[1]), "v"(r[2]), "v"(r[3]), "v"(nsk), [n] "i"(N));
}
template <int N, bool FIRST>
__device__ __forceinline__ void dpp_mul4(float& s0, float& s1, float& s2, float& s3, const f32x4& v) {
    if (FIRST) asm volatile("s_nop 1");
    asm("v_mul_f32_dpp %0, %4, %0" RNB "v_mul_f32_dpp %1, %5, %1" RNB "v_mul_f32_dpp %2, %6, %2" RNB "v_mul_f32_dpp %3, %7, %3" RNB
        : "+v"(s0), "+v"(s1), "+v"(s2), "+v"(s3) : "v"(v[0]), "v"(v[1]), "v"(v[2]), "v"(v[3]), [n] "i"(N));
}
template <int N>
__device__ __forceinline__ void dpp_fmacx4(float& s0, float& s1, float& s2, float& s3, const f32x4& v, float x) {
    asm("v_fmac_f32_dpp %0, %4, %8" RNB "v_fmac_f32_dpp %1, %5, %8" RNB "v_fmac_f32_dpp %2, %6, %8" RNB "v_fmac_f32_dpp %3, %7, %8" RNB
        : "+v"(s0), "+v"(s1), "+v"(s2), "+v"(s3) : "v"(v[0]), "v"(v[1]), "v"(v[2]), "v"(v[3]), "v"(x), [n] "i"(N));
}
template <int N> struct ScanRep {
    static __device__ __forceinline__ void dot8(float (&a)[8], const f32x4& v, const float (&st)[64]) {
        constexpr int h = (N & 1) * 4;
        dpp_dot4<N, N == 0>(a[h], a[h + 1], a[h + 2], a[h + 3], v, st[4 * N], st[4 * N + 1], st[4 * N + 2], st[4 * N + 3]);
        if constexpr (N < 15) ScanRep<N + 1>::dot8(a, v, st);
    }
    static __device__ __forceinline__ void dot(float& a0, float& a1, float& a2, float& a3, const f32x4& v, const float (&st)[64]) {
        dpp_dot4<N, N == 0>(a0, a1, a2, a3, v, st[4 * N], st[4 * N + 1], st[4 * N + 2], st[4 * N + 3]);
        if constexpr (N < 15) ScanRep<N + 1>::dot(a0, a1, a2, a3, v, st);
    }
    static __device__ __forceinline__ void mul(float (&st)[64], const f32x4& w) {
        dpp_mul4<N, N == 0>(st[4 * N], st[4 * N + 1], st[4 * N + 2], st[4 * N + 3], w);
        if constexpr (N < 15) ScanRep<N + 1>::mul(st, w);
    }
    static __device__ __forceinline__ void fmacx(float (&st)[64], const f32x4& v, float x) {
        dpp_fmacx4<N>(st[4 * N], st[4 * N + 1], st[4 * N + 2], st[4 * N + 3], v, x);
        if constexpr (N < 15) ScanRep<N + 1>::fmacx(st, v, x);
    }
};
__device__ __forceinline__ int scan_row(int b, int d, int pos) { return pos < L ? TL + b * L + (d ? L - 1 - pos : pos) : b * S + (d ? S - 1 - (pos - L) : pos - L); }

template <bool ISP>
__device__ __forceinline__ void scan_task(const Params& p, int c, int s, int lane) {
    const int h = c & 3, b = (c >> 2) % NB, d = (c >> 2) / NB, pos0 = SEGLEN * s;
    const int q = 4 * (lane & 15);
    const float* bkk = p.sKK + h * 64 + q; const float* br = p.sR + h * 64 + q; const float* bw = p.sW + (size_t)d * T * DA + h * 64 + q; const float* bb_ = p.sB + (size_t)d * T * DA + h * 64 + q;
    const float* bkd = p.sKD + (size_t)d * T * DA + h * 64 + q; const float* bv = p.sV + h * 64 + lane;
    float* by = (ISP ? p.PV : p.Y) + (size_t)d * T * DA + h * 64 + lane;
    float st[64];
#pragma unroll
    for (int k = 0; k < 64; ++k) st[k] = (ISP && k == lane) ? 1.0f : 0.f;
    size_t mo = (size_t)scan_row(b, d, pos0) * DA;
    f32x4 kk = *(const f32x4*)(bkk + mo), w = *(const f32x4*)(bw + mo), bb = *(const f32x4*)(bb_ + mo), r = *(const f32x4*)(br + mo), kd = w; float vv = 0.f;
    if (!ISP) { kd = *(const f32x4*)(bkd + mo); vv = bv[mo]; }
#pragma unroll 1
    for (int i = 0; i < SEGLEN; ++i) {
        const size_t mn = (size_t)scan_row(b, d, pos0 + (i + 1 < SEGLEN ? i + 1 : i)) * DA;
        const f32x4 nkk = *(const f32x4*)(bkk + mn), nw = *(const f32x4*)(bw + mn), nb = *(const f32x4*)(bb_ + mn), nr = *(const f32x4*)(br + mn);
        f32x4 nkd = nw; float nv = 0.f;
        if (!ISP) { nkd = *(const f32x4*)(bkd + mn); nv = bv[mn]; }
        float a[8] = {0.f, 0.f, 0.f, 0.f, 0.f, 0.f, 0.f, 0.f};
        ScanRep<0>::dot8(a, kk, st);
        const float nsk = -(((a[0] + a[1]) + (a[2] + a[3])) + ((a[4] + a[5]) + (a[6] + a[7])));
        ScanRep<0>::mul(st, w);
        ScanRep<0>::fmacx(st, bb, nsk);
        if (!ISP) ScanRep<0>::fmacx(st, kd, vv);
        float y[8] = {0.f, 0.f, 0.f, 0.f, 0.f, 0.f, 0.f, 0.f};
        ScanRep<0>::dot8(y, r, st);
        by[mo] = ((y[0] + y[1]) + (y[2] + y[3])) + ((y[4] + y[5]) + (y[6] + y[7]));
        kk = nkk; w = nw; bb = nb; r = nr; kd = nkd; vv = nv; mo = mn;
    }
    if (s < NSG - 1) {
        float* dst = (ISP ? p.PS : p.QS) + (((size_t)c * NSG + s) * 64 + lane) * 64;
#pragma unroll
        for (int k4 = 0; k4 < 16; ++k4) *(f32x4*)(dst + 4 * k4) = (f32x4){st[4 * k4], st[4 * k4 + 1], st[4 * k4 + 2], st[4 * k4 + 3]};
    }
}
__device__ __forceinline__ void ph_scan_fast(const Params& p) {
    const int tid_ = opq_tid(), bid_ = opq_bid(); (void)tid_; (void)bid_;
    const int lane = tid_ & 63, gw = bid_ * 4 + (tid_ >> 6), nw = gridDim.x * 4;
    constexpr int NS_T = 64 * NSG, NP_T = 64 * (NSG - 1);
    const int G = gridDim.x, wv = tid_ >> 6; (void)gw; (void)nw;
    for (int tsk = wv * G + bid_; tsk < NS_T + NP_T; tsk += 4 * G) {
        const int t2 = __builtin_amdgcn_readfirstlane(tsk);
        if (t2 < NS_T) scan_task<false>(p, t2 & 63, t2 >> 6, lane);
        else scan_task<true>(p, (t2 - NS_T) & 63, 1 + ((t2 - NS_T) >> 6), lane);
    }
}
__device__ __forceinline__ void ph_combine(const Params& p, char* lds) {
    const int tid_ = opq_tid(), bid_ = opq_bid(); (void)tid_; (void)bid_; (void)lds;
    if (bid_ >= 64) return;
    const int lane = tid_ & 63, c = bid_, cb = tid_ >> 6, q = lane >> 4, i16 = lane & 15, v = 16 * cb + i16;
    const float* QSc = p.QS + (size_t)c * NSG * 4096; const float* PSc = p.PS + (size_t)c * NSG * 4096; float* SSg = p.SS + (size_t)c * NSG * 4096;
    f32x4 acc[4];
#pragma unroll
    for (int ro = 0; ro < 4; ++ro) acc[ro] = *(const f32x4*)(QSc + v * 64 + 16 * ro + 4 * q);
#pragma unroll 1
    for (int s = 1; s < NSG; ++s) {
#pragma unroll
        for (int ro = 0; ro < 4; ++ro)
#pragma unroll
            for (int j = 0; j < 4; ++j) SSg[(size_t)s * 4096 + (16 * ro + 4 * q + j) * 64 + v] = acc[ro][j];
        if (s == NSG - 1) break;
        const float* P = PSc + (size_t)s * 4096 + (4 * q) * 64 + i16;
        float a[4][4][4];
#pragma unroll
        for (int rb = 0; rb < 4; ++rb)
#pragma unroll
            for (int kk = 0; kk < 4; ++kk)
#pragma unroll
                for (int ro = 0; ro < 4; ++ro) a[rb][kk][ro] = P[(16 * rb + kk) * 64 + 16 * ro];
#pragma unroll
        for (int rb = 0; rb < 4; ++rb) asm volatile("" : "+v"(a[rb][0][0]), "+v"(a[rb][0][1]), "+v"(a[rb][0][2]), "+v"(a[rb][0][3]), "+v"(a[rb][1][0]), "+v"(a[rb][1][1]), "+v"(a[rb][1][2]), "+v"(a[rb][1][3]),
                                                         "+v"(a[rb][2][0]), "+v"(a[rb][2][1]), "+v"(a[rb][2][2]), "+v"(a[rb][2][3]), "+v"(a[rb][3][0]), "+v"(a[rb][3][1]), "+v"(a[rb][3][2]), "+v"(a[rb][3][3]));
        f32x4 nacc[4];
#pragma unroll
        for (int ro = 0; ro < 4; ++ro) nacc[ro] = *(const f32x4*)(QSc + (size_t)s * 4096 + v * 64 + 16 * ro + 4 * q);
#pragma unroll
        for (int rb = 0; rb < 4; ++rb)
#pragma unroll
            for (int kk = 0; kk < 4; ++kk)
#pragma unroll
                for (int ro = 0; ro < 4; ++ro) nacc[ro] = __builtin_amdgcn_mfma_f32_16x16x4f32(a[rb][kk][ro], acc[rb][kk], nacc[ro], 0, 0, 0);
#pragma unroll
        for (int ro = 0; ro < 4; ++ro) acc[ro] = nacc[ro];
    }
}
__device__ __forceinline__ float qsum(float v) {
    float a = v, b = v; asm volatile("s_nop 1\n\tv_permlane16_swap_b32 %0, %1" : "+v"(a), "+v"(b)); v = a + b; a = v; b = v;
    asm volatile("s_nop 1\n\tv_permlane32_swap_b32 %0, %1" : "+v"(a), "+v"(b)); return a + b; }
__device__ __forceinline__ void ph_rwkv_out_fast(const Params& p, int l, bool with_ctx) {
    const int tid_ = opq_tid(), bid_ = opq_bid(); (void)tid_; (void)bid_;
    const int lane = tid_ & 63, i16 = lane & 15, q = lane >> 4, gw = bid_ * 4 + (tid_ >> 6), nw = gridDim.x * 4;
    constexpr int TOK = 16, NLT = NB * (S / TOK) * 4, NCTK = NB * (L / TOK) * 4;
    const int ntask = NLT + (with_ctx ? NCTK : 0);
    for (int tsk = gw; tsk < ntask; tsk += nw) {
        const bool isCtx = tsk >= NLT; const int r = isCtx ? tsk - NLT : tsk;
        const int h = r & 3, npt = isCtx ? L / TOK : S / TOK, tt = (r >> 2) % npt, b = (r >> 2) / npt;
        const int seg0 = (isCtx ? TOK * tt : L + TOK * tt) / SEGLEN, seg1 = (isCtx ? L - 1 - TOK * tt : L + S - 1 - TOK * tt) / SEGLEN;
        const int m = (isCtx ? TL + b * L + TOK * tt : b * S + TOK * tt) + i16;
        const size_t o = (size_t)m * DA + h * 64 + 4 * q, o1 = o + (size_t)T * DA;
        f32x4 acc[4];
#pragma unroll
        for (int rb = 0; rb < 4; ++rb) acc[rb] = *(const f32x4*)(p.Y + o + 16 * rb) + *(const f32x4*)(p.Y + o1 + 16 * rb);
#pragma unroll
        for (int d = 0; d < 2; ++d) {
            const int seg = d ? seg1 : seg0;
            if (seg > 0) {
                const float* sst = p.SS + (((size_t)(d * NB + b) * 4 + h) * NSG + seg) * 4096 + q * 64 + i16;
                const float* pvp = p.PV + (d ? o1 : o) - 4 * q + q;
                float a[4][16], bq[16];
#pragma unroll
                for (int kk = 0; kk < 16; ++kk) { bq[kk] = pvp[4 * kk];
#pragma unroll
                    for (int rb = 0; rb < 4; ++rb) a[rb][kk] = sst[(4 * kk) * 64 + 16 * rb]; }
#pragma unroll
                for (int rb = 0; rb < 4; ++rb) asm volatile("" : "+v"(a[rb][0]), "+v"(a[rb][1]), "+v"(a[rb][2]), "+v"(a[rb][3]), "+v"(a[rb][4]), "+v"(a[rb][5]), "+v"(a[rb][6]), "+v"(a[rb][7]),
                                                                 "+v"(a[rb][8]), "+v"(a[rb][9]), "+v"(a[rb][10]), "+v"(a[rb][11]), "+v"(a[rb][12]), "+v"(a[rb][13]), "+v"(a[rb][14]), "+v"(a[rb][15]));
#pragma unroll
                for (int kk = 0; kk < 16; ++kk)
#pragma unroll
                    for (int rb = 0; rb < 4; ++rb) acc[rb] = __builtin_amdgcn_mfma_f32_16x16x4f32(a[rb][kk], bq[kk], acc[rb], 0, 0, 0);
            }
        }
        float s = 0.f;
#pragma unroll
        for (int rb = 0; rb < 4; ++rb) s += sum4(acc[rb]);
        const float mu = qsum(s) * (1.0f / 64.f);
        float sq = 0.f, bon = 0.f;
#pragma unroll
        for (int rb = 0; rb < 4; ++rb) { const f32x4 dy = acc[rb] - mu; sq += sum4(dy * dy);
            const f32x4 rr = *(const f32x4*)(p.sR + o + 16 * rb), kds = *(const f32x4*)(p.sKD + o + 16 * rb) + *(const f32x4*)(p.sKD + o1 + 16 * rb), rk = *(const f32x4*)(p.a_r_k + l * DA + h * 64 + 16 * rb + 4 * q);
            bon += sum4(rr * kds * rk); }
        const float rstd = 1.0f / sqrtf(qsum(sq) * (1.0f / 64.f) + GN_EPS); bon = qsum(bon);
#pragma unroll
        for (int rb = 0; rb < 4; ++rb) { const int c = h * 64 + 16 * rb + 4 * q;
            const f32x4 gln = *(const f32x4*)(p.a_lnx_g + l * DA + c), bln = *(const f32x4*)(p.a_lnx_b + l * DA + c), vv = *(const f32x4*)(p.sV + o + 16 * rb);
            bf16_t* mp = p.MIX + (size_t)m * DMIX + c; const f32x4 gg = ld_bf16x4(mp);
            st_bf16x4(mp, ((acc[rb] - mu) * rstd * gln + bln + vv * bon) * gg); }
    }
}


#define LAS __attribute__((address_space(3)))
#define XB_TMO      128
#define XB_XCNT(j)  (256  + 64 * (j))
#define XB_XSUB(j)  (1280 + 64 * (j))
#define XB_XGEN(j)  (2304 + 64 * (j))
#define XB_TOP      3328
#define XB_TOPGEN   3392
#define XCD_BAR_WORDS 3456
#define XB_SPIN_CAP (1u << 20)
static_assert(XCD_BAR_WORDS * 4 <= 16384, "barrier words fit the control region");
__device__ __forceinline__ unsigned xb_ld(unsigned* p)              { return __hip_atomic_load(p, __ATOMIC_RELAXED, __HIP_MEMORY_SCOPE_AGENT); }
__device__ __forceinline__ unsigned xb_add(unsigned* p, unsigned v) { return __hip_atomic_fetch_add(p, v, __ATOMIC_RELAXED, __HIP_MEMORY_SCOPE_AGENT); }
__device__ __forceinline__ unsigned xb_xcc_id() { return (unsigned)__builtin_amdgcn_s_getreg((3 << 11) | 20) & 0xFu; }
#define XB_SPIN(cond, bar) do { unsigned _sp = 0; while (cond) { __builtin_amdgcn_s_sleep(1); \
    if ((++_sp & 255u) == 0u) { if (xb_ld(&(bar)[XB_TMO])) break; if (_sp > XB_SPIN_CAP) { atomicAdd(&(bar)[XB_TMO], 1u); break; } } } } while (0)
struct XcdBarrier { unsigned* bar; unsigned x; volatile LAS unsigned* st; };
__device__ __forceinline__ XcdBarrier xcd_barrier_post(unsigned* bar, volatile LAS unsigned* st) {
    XcdBarrier b; b.bar = bar; b.x = xb_xcc_id(); b.st = st;
    if (threadIdx.x == 0) (void)xb_add(&bar[XB_XCNT(b.x)], 1u);
    return b;
}
__device__ __forceinline__ void xcd_barrier_complete(unsigned* bar, unsigned x, unsigned& nloc, unsigned& nx) {
    const unsigned G = gridDim.x * gridDim.y * gridDim.z;
    unsigned sum, cnt, mine, sp = 0u;
    for (;;) {
        sum = 0u; cnt = 0u; mine = 0u;
#pragma unroll
        for (unsigned j = 0; j < 16; ++j) { const unsigned c = xb_ld(&bar[XB_XCNT(j)]); sum += c; cnt += (c > 0u) ? 1u : 0u; mine = (j == x) ? c : mine; }
        if (sum == G) break;
        __builtin_amdgcn_s_sleep(1);
        if ((++sp & 255u) == 0u) { if (xb_ld(&bar[XB_TMO])) break; if (sp > XB_SPIN_CAP) { atomicAdd(&bar[XB_TMO], 1u); break; } }
    }
    nloc = mine > 0u ? mine : 1u; nx = cnt > 0u ? cnt : 1u;
}
__device__ __forceinline__ void xcd_barrier(const XcdBarrier& b) {
    asm volatile("s_waitcnt vmcnt(0)" ::: "memory");
    __syncthreads();
    if (threadIdx.x == 0) {
        unsigned* bar = b.bar;
        __builtin_amdgcn_s_waitcnt(0);
        unsigned nloc = b.st[0], nx = b.st[1];
        if (nloc == 0u) { xcd_barrier_complete(bar, b.x, nloc, nx); b.st[0] = nloc; b.st[1] = nx; }
        const unsigned old = xb_add(&bar[XB_XSUB(b.x)], 1u);
        const unsigned gen = old / nloc;
        if (old + 1u == (gen + 1u) * nloc) {
            __builtin_amdgcn_fence(__ATOMIC_RELEASE, "agent");
            asm volatile("s_waitcnt vmcnt(0)" ::: "memory");
            const unsigned og = xb_add(&bar[XB_TOP], 1u);
            const unsigned tg = og / nx;
            if (og + 1u == (tg + 1u) * nx) xb_add(&bar[XB_TOPGEN], 1u);
            else XB_SPIN(xb_ld(&bar[XB_TOPGEN]) == tg, bar);
            __builtin_amdgcn_fence(__ATOMIC_ACQUIRE, "agent");
            xb_add(&bar[XB_XGEN(b.x)], 1u);
            asm volatile("s_waitcnt vmcnt(0)" ::: "memory");
        } else {
            XB_SPIN(xb_ld(&bar[XB_XGEN(b.x)]) == gen, bar);
            __builtin_amdgcn_fence(__ATOMIC_ACQUIRE, "agent");
            asm volatile("s_waitcnt vmcnt(0)" ::: "memory");
        }
    }
    __syncthreads();
}

#define GT ((long)blockIdx.x * blockDim.x + threadIdx.x)
#define GS ((long)gridDim.x * blockDim.x)
__global__ void __launch_bounds__(256, 2) mega_fwd(Params p) {
    __shared__ __attribute__((aligned(16))) char lds[73728 + 64];
    cg::grid_group grid = cg::this_grid();
    const long gt = GT, gs = GS;
    volatile LAS unsigned* bst = (volatile LAS unsigned*)(LAS char*)(lds + 73728);
    if (threadIdx.x < 2) bst[threadIdx.x] = 0u;
    __syncthreads();
    const XcdBarrier xb = xcd_barrier_post(p.bar, bst);
#ifndef PROBE_PHASE
#define PROBE_PHASE -1
#endif
#define PROBE_AMP 8
    unsigned long long t_prev = 0; int nts = 0;
#define STAMP() do { if (PROBE_PHASE >= 0 && blockIdx.x == 0 && threadIdx.x == 0) { const unsigned long long t_now = __builtin_amdgcn_s_memrealtime(); \
        if (nts == PROBE_PHASE + 1) { const unsigned long long t_end = t_now + PROBE_AMP * (t_now - t_prev); while (__builtin_amdgcn_s_memrealtime() < t_end) __builtin_amdgcn_s_sleep(8); } \
        t_prev = __builtin_amdgcn_s_memrealtime(); } ++nts; } while (0)
#define GSYNC() do { xcd_barrier(xb); STAMP(); } while (0)
    STAMP();
    ph_mod_fast(p, lds); ph_prep_w_fast(p, 0, 0, lds); ph_prep_misc(p, 0, gt, gs, false);
    if (p.out == nullptr) grid.sync();
    GSYNC();
    for (int l = 0; l < 2; ++l) {
        const int nrows = (l == 0) ? T : TL;
        if (l == 0) { ph_lnmod_fast(p, l); GSYNC(); }
        g_gemm_in(p, lds);
        GSYNC();
        ph_streams_s1(p, l);
        GSYNC();
        g_streams_s2(p, l, lds);
        GSYNC();
        ph_scan_fast(p);
        GSYNC();
        ph_combine(p, lds); ph_attn_blk(p, l, l == 0, 64, lds);
        GSYNC();
        ph_rwkv_out_fast(p, l, l == 0);
        GSYNC();
        if (blockIdx.x >= gridDim.x / 2) { ph_prep_w_fast(p, l, 1, lds); __syncthreads(); g_gemm_out(p, nrows, lds); } else { g_gemm_out(p, nrows, lds); ph_prep_w_fast(p, l, 1, lds); }
        GSYNC();
        g_router(p, l, nrows, lds);
        GSYNC();
        ph_dispatch_fast(p, l, nrows, lds);
        GSYNC();
        g_moe1(p, l, lds);
        GSYNC();
        g_moe2(p, l, lds);
        GSYNC();
        ph_final_fast(p, l, nrows, l == 0);
        if (l == 0) { ph_prep_w_fast(p, 1, 0, lds); ph_prep_misc(p, 1, gt, gs, false); }
        GSYNC();
    }}

extern "C" void kernel_launch(void* const* d_in, const int* in_sizes, int n_in, void* d_out, int out_size, void* d_ws, size_t ws_size, hipStream_t stream) {
    if (n_in != 32 || out_size != TL * D || ws_size < WS_NEED) { fprintf(stderr, "kernel_launch: unexpected shapes / workspace (n_in %d out %d ws %zu need %zu)\n", n_in, out_size, ws_size, (size_t)WS_NEED); return; }
    static int grid_blocks = 0;
    if (!grid_blocks) {
        int dev = 0, cus = 0, per_cu = 0;
        (void)hipGetDevice(&dev);
        (void)hipDeviceGetAttribute(&cus, hipDeviceAttributeMultiprocessorCount, dev);
        (void)hipOccupancyMaxActiveBlocksPerMultiprocessor(&per_cu, mega_fwd, 256, 0);
        if (per_cu < 1) per_cu = 1;
        if (per_cu > 2) per_cu = 2;
        grid_blocks = cus * per_cu;
        fprintf(stderr, "kernel_launch: %d CUs x %d blocks\n", cus, per_cu);
    }
    Params p = make_params(d_in, d_out, d_ws);
    (void)hipMemsetAsync(d_ws, 0, CTL_BYTES, stream);
    void* args[] = {&p};
    hipError_t e = hipLaunchCooperativeKernel((void*)mega_fwd, dim3(grid_blocks), dim3(256), args, 0, stream);
    if (e != hipSuccess) fprintf(stderr, "cooperative launch failed: %s (grid %d)\n", hipGetErrorString(e), grid_blocks);
}
#endif

#ifdef HOST_EMU
static void host_forward(void* const* d_in, void* d_out, void* d_ws) {
    const Params p = make_params(d_in, d_out, d_ws);
    for (int l = 0; l < 2; ++l) {
        const int nrows = (l == 0) ? T : TL;
        ph_prep_w(p, l, 0, 1); ph_prep_misc(p, l, 0, 1); ph_lnmod(p, l, 0, 1); host_gemm_in(p); ph_streams(p, l, 0, 1); ph_rope(p, 0, 1); ph_scan(p, 0, 1);
        ph_attn(p, l, nrows, 0, 1); ph_rwkv_out(p, l, nrows, 0, 1); host_gemm_out(p, nrows); ph_post_mixer(p, l, nrows, 0, 1);
        ph_dispatch(p, l, nrows, 0, 1); host_moe1(p, l); host_moe2(p, l); ph_final(p, l, nrows, 0, 1);
    }
}
#endif
```

```cpp
#ifdef HOST_EMU
#include <cmath>
#include <cstdio>
#include <cstring>
#include <cstdint>
#include <cstdlib>
#define __device__
#define __global__
#define __host__
#define __forceinline__ inline
#else
#include <hip/hip_runtime.h>
#include <hip/hip_cooperative_groups.h>
#include <cstdio>
#include <cstdint>
namespace cg = cooperative_groups;
#endif

#ifndef CFG_D
#define CFG_D 1024
#define CFG_B 8
#define CFG_S 2048
#define CFG_L 256
#define CFG_DE 512
#endif
constexpr int D = CFG_D, NB = CFG_B, S = CFG_S, L = CFG_L, DE = CFG_DE;
constexpr int TL = NB * S, TC = NB * L, T = TL + TC;
constexpr int GRID_W = 64, HD = 64;
constexpr int DA = 256, A_IN = 1184, N_IN = 2976, NINP = 3072, DMIX = 1024;
constexpr int NEXP = 32, NSLOT = 2 * T + NEXP * 128;
#ifdef HOST_EMU
constexpr int ZQB = 0, ZKB = 384, ZVB = 512, ZQN = 640, ZKN = 1024, ZVN = 1408, ZA = 1792, ZP = 2976;
#else
constexpr int ZQB = 0, ZKB = 384, ZQN = 512, ZKN = 896, ZA = 1280, ZP = 2464, WVB = 2560, WVN = 2688;
#endif
constexpr float LN_EPS = 1e-6f, GN_EPS = 64e-5f, ATT_SCALE = 0.125f, LOG2E = 1.4426950408889634f, QSCALE = ATT_SCALE * LOG2E;
constexpr float ALPHA = 1.41421356237309515f;

typedef unsigned short bf16_t;

__device__ __forceinline__ float bf2f(bf16_t v) {
    unsigned u = ((unsigned)v) << 16; float f;
#ifdef HOST_EMU
    memcpy(&f, &u, 4);
#else
    f = __uint_as_float(u);
#endif
    return f;
}
__device__ __forceinline__ bf16_t f2bf(float f) {
    unsigned u;
#ifdef HOST_EMU
    memcpy(&u, &f, 4);
#else
    u = __float_as_uint(f);
#endif
    return (bf16_t)((u + 0x7fffu + ((u >> 16) & 1u)) >> 16);
}
__device__ __forceinline__ float sigmoidf_(float x) { return 1.0f / (1.0f + expf(-x)); }
__device__ __forceinline__ float siluf_(float x) { return x / (1.0f + expf(-x)); }
__device__ __forceinline__ int atomic_inc_int(int* p) {
#ifdef HOST_EMU
    int o = *p; *p = o + 1; return o;
#else
    return atomicAdd(p, 1);
#endif
}

struct Params {
    const float *x, *c, *ctx, *c_ctx, *w_mod, *b_mod, *w_in, *w_out, *a_shift, *a_w0, *a_w_up, *a_a0, *a_a_up, *a_g_up,
        *a_k_k, *a_k_a, *a_r_k, *a_lnx_g, *a_lnx_b, *b_sink, *c_rpb, *ln1_g, *ln1_b, *ln2_g, *ln2_b, *w_rg, *b_rg, *w_re,
        *b_re, *w_gate, *w_up, *w_down;
    float* out;
    int* cnt;
    unsigned* bar;
    float* mod;
    float* rope;
    bf16_t *win_t, *wout_t, *wgu_t, *wd_t;
    bf16_t *wrt;
    int* hist;
    bf16_t* HLO;
    bf16_t *wupT, *aupT, *gupT;
    bf16_t* LA;
    float *kT, *kN;
    bf16_t* H;
    bf16_t* Z;
    bf16_t* VT;
    float *sR, *sV, *sKK, *sG, *sW, *sKD, *sB;
    float* Y;
    bf16_t* MIX;
    float *PV, *QS, *PS, *SS;
    float* XC;
    bf16_t* O;
    bf16_t* YSb;
    int *rE, *rPos, *rSlot; float* rW;
    int* slotTok;
    bf16_t* ACT;
    float* YS;
};

constexpr size_t al256(size_t v) { return (v + 255) & ~(size_t)255; }
constexpr size_t OFF_CNT = 0;
constexpr size_t OFF_BAR = 4096, CTL_BYTES = 4096 + 16384;
constexpr size_t OFF_MOD = CTL_BYTES;
constexpr size_t OFF_ROPE = al256(OFF_MOD + (size_t)2 * (NB + 1) * 6 * D * 4);
constexpr size_t OFF_LORA = al256(OFF_ROPE + 64 * 16 * 2 * 4);
constexpr size_t OFF_WRT = al256(OFF_LORA + (size_t)(2 * 256 * 64 * 2 + 256 * 160) * 2);
constexpr size_t OFF_LG = al256(OFF_WRT + (size_t)2 * 128 * D * 2);
constexpr size_t OFF_WIN = al256(OFF_LG + (size_t)(T / 32) * 32 * 4);
constexpr size_t OFF_WOUT = al256(OFF_WIN + (size_t)NINP * D * 2);
constexpr size_t OFF_WGU = al256(OFF_WOUT + (size_t)D * DMIX * 2);
constexpr size_t OFF_WD = al256(OFF_WGU + (size_t)NEXP * 2 * DE * D * 2);
constexpr size_t OFF_H = al256(OFF_WD + (size_t)NEXP * D * DE * 2);
constexpr size_t OFF_Z = al256(OFF_H + (size_t)(T + 1) * D * 2);
constexpr int PU = L + S;
constexpr int SEGLEN = 144, NSG = (L + S) / SEGLEN;
#ifndef HOST_EMU
static_assert((L + S) % SEGLEN == 0 && SEGLEN % 16 == 0 && L % 16 == 0 && S % 16 == 0, "16-token output tiles must not straddle scan segments");
static_assert((size_t)3 * 64 * NSG * 4096 * 4 <= (size_t)NEXP * 2 * DE * D * 2, "scan segment states overlay wgu_t");
#endif
constexpr size_t OFF_VT = al256(OFF_Z + (size_t)T * 2976 * 2);
constexpr size_t OFF_S = al256(OFF_VT + (size_t)NB * 8 * 64 * PU * 2);
constexpr size_t S1 = (size_t)T * 256 * 4;
#ifdef HOST_EMU
constexpr int NSTREAM = 10;
#else
constexpr int NSTREAM = 9;
#endif
constexpr size_t OFF_Y = al256(OFF_S + NSTREAM * S1);
constexpr size_t OFF_MIX = al256(OFF_Y + 2 * S1);
constexpr size_t OFF_XC = al256(OFF_MIX + (size_t)T * 1024 * 2);
constexpr size_t OFF_ROUTE = al256(OFF_XC + (size_t)TC * D * 4);
constexpr size_t OFF_SLOTTOK = al256(OFF_ROUTE + (size_t)T * 2 * 4 * 4);
constexpr size_t WS_NEED = al256(OFF_SLOTTOK + (size_t)NSLOT * 4);
static_assert((size_t)NSLOT * DE * 2 <= (size_t)T * 2976 * 2 && (size_t)T * D * 2 <= (size_t)T * 2976 * 2, "ACT / HLO overlay Z");
static_assert((size_t)T * 4 * 4 + (size_t)T * 416 * 2 <= S1, "kN + LA overlay Y[1]");
static_assert((size_t)NSLOT * D * 4 <= NSTREAM * S1 && (size_t)T * D * 4 <= NSTREAM * S1, "YS / O overlay the stream buffers");

static Params make_params(void* const* d_in, void* d_out, void* d_ws) {
    Params p{};
    const float** f = (const float**)&p.x;
    for (int i = 0; i < 32; ++i) f[i] = (const float*)d_in[i];
    p.out = (float*)d_out;
    char* w = (char*)d_ws;
    p.cnt = (int*)(w + OFF_CNT); p.bar = (unsigned*)(w + OFF_BAR); p.mod = (float*)(w + OFF_MOD); p.rope = (float*)(w + OFF_ROPE);
    p.win_t = (bf16_t*)(w + OFF_WIN); p.wout_t = (bf16_t*)(w + OFF_WOUT); p.wgu_t = (bf16_t*)(w + OFF_WGU); p.wd_t = (bf16_t*)(w + OFF_WD);
    p.wrt = (bf16_t*)(w + OFF_WRT); p.hist = (int*)(w + OFF_LG); p.HLO = (bf16_t*)(w + OFF_Z);
    p.wupT = (bf16_t*)(w + OFF_LORA); p.aupT = p.wupT + 2 * 256 * 64; p.gupT = p.aupT + 2 * 256 * 64;
    p.H = (bf16_t*)(w + OFF_H); p.Z = (bf16_t*)(w + OFF_Z); p.VT = (bf16_t*)(w + OFF_VT);
    float* s = (float*)(w + OFF_S); const size_t n1 = (size_t)T * 256;
    p.sR = s; p.sV = s + n1; p.sKK = s + 2 * n1; p.sW = s + 3 * n1; p.sKD = s + 5 * n1; p.sB = s + 7 * n1; p.sG = s + 9 * n1;
    p.Y = (float*)(w + OFF_Y); p.MIX = (bf16_t*)(w + OFF_MIX); p.XC = (float*)(w + OFF_XC);
    p.O = (bf16_t*)(w + OFF_S); p.YSb = (bf16_t*)(w + OFF_S);
    p.PV = (float*)(w + OFF_H); p.QS = (float*)(w + OFF_WGU); p.PS = p.QS + (size_t)64 * NSG * 4096; p.SS = p.PS + (size_t)64 * NSG * 4096;
    p.kT = p.Y; p.kN = p.Y + (size_t)T * 256; p.LA = (bf16_t*)(p.Y + (size_t)T * 256 + (size_t)T * 4);
    int* r = (int*)(w + OFF_ROUTE); p.rE = r; p.rPos = r + 2 * T; p.rSlot = r + 4 * T; p.rW = (float*)(r + 6 * T);
    p.slotTok = (int*)(w + OFF_SLOTTOK);
    p.ACT = (bf16_t*)(w + OFF_Z); p.YS = (float*)(w + OFF_S);
    return p;
}

#ifdef HOST_EMU
__device__ void ph_prep_w(const Params& p, int l, long gtid, long gsz) {
    for (long i = gtid; i < (long)D * NINP; i += gsz) {
        const int k = (int)(i / NINP), n = (int)(i % NINP);
        float v = 0.f;
        if (n < N_IN) { const int oc = (n < ZA) ? n + A_IN : n - ZA; v = p.w_in[((size_t)l * D + k) * N_IN + oc]; }
        p.win_t[(size_t)n * D + k] = f2bf(v);
    }
    for (long i = gtid; i < (long)DMIX * D; i += gsz) {
        const int k = (int)(i / D), n = (int)(i % D);
        p.wout_t[(size_t)n * DMIX + k] = f2bf(p.w_out[((size_t)l * DMIX + k) * D + n]);
    }
    for (long i = gtid; i < (long)NEXP * D * 2 * DE; i += gsz) {
        const int rho = (int)(i % (2 * DE)); const long t = i / (2 * DE); const int k = (int)(t % D), e = (int)(t / D);
        const int q = rho >> 5, half = (rho >> 4) & 1, ii = rho & 15, cc = 16 * q + ii;
        const float* src = half ? p.w_up : p.w_gate;
        p.wgu_t[((size_t)e * 2 * DE + rho) * D + k] = f2bf(src[(((size_t)l * NEXP + e) * D + k) * DE + cc]);
    }
    for (long i = gtid; i < (long)NEXP * DE * D; i += gsz) {
        const int n = (int)(i % D); const long t = i / D; const int k = (int)(t % DE), e = (int)(t / DE);
        p.wd_t[((size_t)e * D + n) * DE + k] = f2bf(p.w_down[(((size_t)l * NEXP + e) * DE + k) * D + n]);
    }
}
#endif
__device__ __forceinline__ void ph_prep_misc(const Params& p, int l, long gtid, long gsz, bool do_mod = true) {
    if (l == 0 && do_mod) for (long i = gtid; i < (long)2 * (NB + 1) * 6 * D; i += gsz) {
        const int j = (int)(i % (6 * D)), b = (int)((i / (6 * D)) % (NB + 1)), ll = (int)(i / ((long)6 * D * (NB + 1)));
        const float* cv = (b < NB) ? p.c + (size_t)b * D : p.c_ctx;
        float acc = 0.f;
        for (int k = 0; k < D; ++k) acc += siluf_(cv[k]) * p.w_mod[((size_t)ll * D + k) * 6 * D + j];
        p.mod[((size_t)ll * (NB + 1) + b) * 6 * D + j] = acc + p.b_mod[(size_t)ll * 6 * D + j];
    }
    if (l == 0) for (long i = gtid; i < 64 * 16; i += gsz) {
        const int pos = (int)(i / 16), fi = (int)(i % 16);
        const float inv = powf(10000.0f, -(float)fi / 16.0f), ang = (float)pos * inv;
        p.rope[i] = cosf(ang); p.rope[1024 + i] = sinf(ang);
    }
    for (long i = gtid; i < NEXP; i += gsz) p.cnt[l * NEXP + i] = 0;
    for (long i = gtid; i < NSLOT; i += gsz) p.slotTok[i] = T;
    for (long i = gtid; i < D; i += gsz) p.H[(size_t)T * D + i] = 0;
}

__device__ __forceinline__ const float* xrow_in(const Params& p, int l, int m) {
    if (m < TL) return (l == 0 ? p.x : p.out) + (size_t)m * D;
    return (l == 0 ? p.ctx : p.XC) + (size_t)(m - TL) * D;
}
__device__ __forceinline__ const float* modrow(const Params& p, int l, int m) { return p.mod + ((size_t)l * (NB + 1) + (m < TL ? m / S : NB)) * 6 * D; }

__device__ void ph_lnmod(const Params& p, int l, long gtid, long gsz) {
    for (long m = gtid; m < T; m += gsz) {
        const float* xr = xrow_in(p, l, (int)m); const float* md = modrow(p, l, (int)m);
        float s = 0.f; for (int j = 0; j < D; ++j) s += xr[j];
        const float mu = s / D; float q = 0.f;
        for (int j = 0; j < D; ++j) { const float d = xr[j] - mu; q += d * d; }
        const float rstd = 1.0f / sqrtf(q / D + LN_EPS);
        for (int j = 0; j < D; ++j) p.H[(size_t)m * D + j] = f2bf((xr[j] - mu) * rstd * (1.0f + md[D + j]) + md[j]);
    }
}

__device__ __forceinline__ float zshift(const Params& p, int l, int m, int col) {
    int t, len;
    if (m < TL) { t = m % S; len = S; } else { t = (m - TL) % L; len = L; }
    const float* sh = p.a_shift + (size_t)l * 3 * A_IN;
    const bf16_t* z = p.Z + (size_t)m * ZP + ZA + col;
    float v = sh[A_IN + col] * bf2f(z[0]);
    if (t > 0) v += sh[col] * bf2f(z[-ZP]);
    if (t < len - 1) v += sh[2 * A_IN + col] * bf2f(z[ZP]);
    return v;
}

__device__ void ph_streams(const Params& p, int l, long gtid, long gsz) {
    for (long i = gtid; i < (long)T * DA; i += gsz) {
        const int m = (int)(i / DA), c = (int)(i % DA), h0 = c & ~63;
        const float r = zshift(p, l, m, c), k = zshift(p, l, m, 256 + c), v = zshift(p, l, m, 512 + c);
        float nrm = 0.f;
        for (int j = 0; j < 64; ++j) { const float t = zshift(p, l, m, 256 + h0 + j) * p.a_k_k[l * DA + h0 + j]; nrm += t * t; }
        const float kk = k * p.a_k_k[l * DA + c] / sqrtf(nrm + 1e-12f);
        float g = 0.f;
        for (int j = 0; j < 160; ++j) g += sigmoidf_(zshift(p, l, m, 1024 + j)) * p.a_g_up[((size_t)l * 160 + j) * DA + c];
        const size_t o = (size_t)m * DA + c;
        p.sR[o] = r; p.sV[o] = v; p.sKK[o] = kk; p.sG[o] = g;
        for (int d = 0; d < 2; ++d) {
            float aw = 0.f, aa = 0.f;
            for (int j = 0; j < 64; ++j) {
                aw += tanhf(zshift(p, l, m, 768 + d * 64 + j)) * p.a_w_up[(((size_t)l * 2 + d) * 64 + j) * DA + c];
                aa += zshift(p, l, m, 896 + d * 64 + j) * p.a_a_up[(((size_t)l * 2 + d) * 64 + j) * DA + c];
            }
            const float u = -(p.a_w0[(l * 2 + d) * DA + c] + aw);
            const float sp = (u > 20.f) ? u : log1pf(expf(u));
            const float w = expf(-expf(-sp - 0.5f));
            const float a = sigmoidf_(p.a_a0[(l * 2 + d) * DA + c] + aa);
            const size_t od = ((size_t)d * T + m) * DA + c;
            p.sW[od] = w; p.sKD[od] = k * (1.0f + (a - 1.0f) * p.a_k_a[l * DA + c]); p.sB[od] = kk * a;
        }
    }
}

__device__ __forceinline__ void ph_rope(const Params& p, long gtid, long gsz) {
    for (long i = gtid; i < (long)TL * 8 * 32; i += gsz) {
        const int pr = (int)(i & 31), hs = (int)((i >> 5) & 7), m = (int)(i >> 8);
        const int t = m % S, axis = pr >> 4, fi = pr & 15, pos = axis ? (t % GRID_W) : (t / GRID_W);
        bf16_t* z = p.Z + (size_t)m * ZP + hs * 64 + axis * 32 + fi;
        const float cs = p.rope[pos * 16 + fi], sn = p.rope[1024 + pos * 16 + fi];
        const float x0 = bf2f(z[0]), x1 = bf2f(z[16]);
        z[0] = f2bf(x0 * cs - x1 * sn); z[16] = f2bf(x1 * cs + x0 * sn);
    }
}

__device__ void ph_scan(const Params& p, long gtid, long gsz) {
    for (long i = gtid; i < (long)2 * NB * 4 * 64; i += gsz) {
        const int v = (int)(i & 63), h = (int)((i >> 6) & 3), b = (int)((i >> 8) % NB), d = (int)((i >> 8) / NB);
        float st[64];
#pragma unroll
        for (int k = 0; k < 64; ++k) st[k] = 0.f;
        for (int pos = 0; pos < L + S; ++pos) {
            int m;
            if (pos < L) m = TL + b * L + (d ? L - 1 - pos : pos);
            else m = b * S + (d ? S - 1 - (pos - L) : pos - L);
            const size_t o = (size_t)m * DA + h * 64, od = ((size_t)d * T + m) * DA + h * 64;
            const float* kk = p.sKK + o; const float* r = p.sR + o;
            const float* w = p.sW + od; const float* bb = p.sB + od; const float* kd = p.sKD + od;
            const float vv = p.sV[o + v];
            float sk = 0.f;
#pragma unroll
            for (int k = 0; k < 64; ++k) sk += st[k] * kk[k];
            float y = 0.f;
#pragma unroll
            for (int k = 0; k < 64; ++k) { st[k] = st[k] * w[k] - sk * bb[k] + vv * kd[k]; y += st[k] * r[k]; }
            p.Y[od + v] = y;
        }
    }
}

__device__ void ph_rwkv_out(const Params& p, int l, int nrows, long gtid, long gsz) {
    for (long i = gtid; i < (long)nrows * 4; i += gsz) {
        const int m = (int)(i >> 2), h = (int)(i & 3);
        const size_t o = (size_t)m * DA + h * 64;
        const float* y0 = p.Y + o; const float* y1 = p.Y + (size_t)T * DA + o;
        float s = 0.f, bon = 0.f;
        for (int n = 0; n < 64; ++n) {
            s += y0[n] + y1[n];
            bon += p.sR[o + n] * (p.sKD[o + n] + p.sKD[(size_t)T * DA + o + n]) * p.a_r_k[l * DA + h * 64 + n];
        }
        const float mu = s / 64.f; float q = 0.f;
        for (int n = 0; n < 64; ++n) { const float dd = y0[n] + y1[n] - mu; q += dd * dd; }
        const float rstd = 1.0f / sqrtf(q / 64.f + GN_EPS);
        for (int n = 0; n < 64; ++n) {
            const int c = h * 64 + n;
            const float yn = (y0[n] + y1[n] - mu) * rstd * p.a_lnx_g[l * DA + c] + p.a_lnx_b[l * DA + c];
            p.MIX[(size_t)m * DMIX + c] = f2bf((yn + bon * p.sV[o + n]) * p.sG[o + n]);
        }
    }
}

#ifdef HOST_EMU
__device__ __forceinline__ void att_key(const float (&q)[64], const bf16_t* kr, const bf16_t* vr, float bias, float& mx, float& ls, float (&acc)[64]) {
    float s = 0.f;
#pragma unroll
    for (int d = 0; d < 64; ++d) s += q[d] * bf2f(kr[d]);
    s = s * ATT_SCALE + bias;
    const float mn = fmaxf(mx, s), f = expf(mx - mn), pe = expf(s - mn);
    ls = ls * f + pe;
#pragma unroll
    for (int d = 0; d < 64; ++d) acc[d] = acc[d] * f + pe * bf2f(vr[d]);
    mx = mn;
}

__device__ void ph_attn(const Params& p, int l, int nrows, long gtid, long gsz) {
    for (long i = gtid; i < (long)nrows * 12; i += gsz) {
        const int m = (int)(i / 12), u = (int)(i % 12);
        const bool isB = u < 6; const int hq = isB ? u : u - 6;
        const int b = (m < TL) ? m / S : (m - TL) / L;
        const int qcol = isB ? ZQB + hq * 64 : ZQN + hq * 64;
        const int kcol = isB ? ZKB + (hq / 3) * 64 : ZKN + hq * 64;
        const int vcol = isB ? ZVB + (hq / 3) * 64 : ZVN + hq * 64;
        float q[64], acc[64];
        const bf16_t* qr = p.Z + (size_t)m * ZP + qcol;
#pragma unroll
        for (int d = 0; d < 64; ++d) { q[d] = bf2f(qr[d]); acc[d] = 0.f; }
        float mx, ls;
        if (isB) { mx = p.b_sink[l * 6 + hq]; ls = 1.0f; } else { mx = -1e30f; ls = 0.f; }
        for (int j = 0; j < L; ++j) { const bf16_t* zr = p.Z + (size_t)(TL + b * L + j) * ZP; att_key(q, zr + kcol, zr + vcol, 0.f, mx, ls, acc); }
        if (m < TL) {
            const int t = m % S;
            if (isB) {
                const int j0 = t - 128 < 0 ? 0 : t - 128, j1 = t + 128 > S - 1 ? S - 1 : t + 128;
                for (int j = j0; j <= j1; ++j) { const bf16_t* zr = p.Z + (size_t)(b * S + j) * ZP; att_key(q, zr + kcol, zr + vcol, 0.f, mx, ls, acc); }
            } else {
                const int rows = S / GRID_W, r = t / GRID_W, c = t % GRID_W;
                int r0 = r - 4; r0 = r0 < 0 ? 0 : (r0 > rows - 8 ? rows - 8 : r0);
                int c0 = c - 8; c0 = c0 < 0 ? 0 : (c0 > GRID_W - 16 ? GRID_W - 16 : c0);
                for (int a = 0; a < 8; ++a)
                    for (int e = 0; e < 16; ++e) {
                        const int kr = r0 + a, kc = c0 + e;
                        const float bias = p.c_rpb[(((size_t)l * 6 + hq) * 15 + (kr - r + 7)) * 31 + (kc - c + 15)];
                        const bf16_t* zr = p.Z + (size_t)(b * S + kr * GRID_W + kc) * ZP;
                        att_key(q, zr + kcol, zr + vcol, bias, mx, ls, acc);
                    }
            }
        }
        const float inv = 1.0f / ls;
        bf16_t* o = p.MIX + (size_t)m * DMIX + (isB ? 256 : 640) + hq * 64;
#pragma unroll
        for (int d = 0; d < 64; ++d) o[d] = f2bf(acc[d] * inv);
    }
}

#endif
__device__ void ph_post_mixer(const Params& p, int l, int nrows, long gtid, long gsz) {
    for (long mm = gtid; mm < nrows; mm += gsz) {
        const int m = (int)mm;
        const float* xr = xrow_in(p, l, m); const float* md = modrow(p, l, m); const float* orow = (const float*)p.O + (size_t)m * D;
        float* x1 = (m < TL) ? p.out + (size_t)m * D : p.XC + (size_t)(m - TL) * D;
        const float* g1 = p.ln1_g + (size_t)l * D; const float* b1 = p.ln1_b + (size_t)l * D;
        float s = 0.f; for (int j = 0; j < D; ++j) s += ALPHA * xr[j] + md[2 * D + j] * orow[j];
        float mu = s / D, q = 0.f;
        for (int j = 0; j < D; ++j) { const float d = ALPHA * xr[j] + md[2 * D + j] * orow[j] - mu; q += d * d; }
        float rstd = 1.0f / sqrtf(q / D + LN_EPS);
        s = 0.f;
        for (int j = 0; j < D; ++j) { const float v = (ALPHA * xr[j] + md[2 * D + j] * orow[j] - mu) * rstd * g1[j] + b1[j]; x1[j] = v; s += v; }
        mu = s / D; q = 0.f;
        for (int j = 0; j < D; ++j) { const float d = x1[j] - mu; q += d * d; }
        rstd = 1.0f / sqrtf(q / D + LN_EPS);
        float gl[4], el[32];
#pragma unroll
        for (int g = 0; g < 4; ++g) gl[g] = p.b_rg[l * 4 + g];
#pragma unroll
        for (int e = 0; e < 32; ++e) el[e] = p.b_re[l * 32 + e];
        for (int j = 0; j < D; ++j) {
            const float hv = (x1[j] - mu) * rstd * (1.0f + md[4 * D + j]) + md[3 * D + j];
            p.H[(size_t)m * D + j] = f2bf(hv);
            const float* wg = p.w_rg + ((size_t)l * D + j) * 4; const float* we = p.w_re + ((size_t)l * D + j) * 32;
#pragma unroll
            for (int g = 0; g < 4; ++g) gl[g] += hv * wg[g];
#pragma unroll
            for (int e = 0; e < 32; ++e) el[e] += hv * we[e];
        }
        int gs = 0; float gm = gl[0];
#pragma unroll
        for (int g = 1; g < 4; ++g) if (gl[g] > gm) { gm = gl[g]; gs = g; }
        float den = 0.f;
#pragma unroll
        for (int g = 0; g < 4; ++g) den += expf(gl[g] - gm);
        const float pg = 1.0f / den;
        float v1 = -3e38f, v2 = -3e38f; int i1 = 0, i2 = 0;
#pragma unroll
        for (int j = 0; j < 8; ++j) {
            const float v = gs == 0 ? el[j] : gs == 1 ? el[8 + j] : gs == 2 ? el[16 + j] : el[24 + j];
            if (v > v1) { v2 = v1; i2 = i1; v1 = v; i1 = j; } else if (v > v2) { v2 = v; i2 = j; }
        }
        const float e2 = expf(v2 - v1), w1 = pg / (1.0f + e2), w2 = pg * e2 / (1.0f + e2);
        const int ea = gs * 8 + i1, eb = gs * 8 + i2;
        p.rE[2 * m] = ea; p.rE[2 * m + 1] = eb; p.rW[2 * m] = w1; p.rW[2 * m + 1] = w2;
        p.rPos[2 * m] = atomic_inc_int(p.cnt + l * NEXP + ea); p.rPos[2 * m + 1] = atomic_inc_int(p.cnt + l * NEXP + eb);
    }
}

__device__ __forceinline__ int pstart_of(const int* cnt, int e) {
    int s = 0;
    for (int j = 0; j < NEXP; ++j) if (j < e) s += (cnt[j] + 127) & ~127;
    return s;
}
__device__ __forceinline__ void ph_dispatch(const Params& p, int l, int nrows, long gtid, long gsz) {
    for (long i = gtid; i < (long)nrows * 2; i += gsz) {
        const int slot = pstart_of(p.cnt + l * NEXP, p.rE[i]) + p.rPos[i];
        p.rSlot[i] = slot; p.slotTok[slot] = (int)(i >> 1);
    }
}

__device__ void ph_final(const Params& p, int l, int nrows, long gtid, long gsz) {
    for (long mm = gtid; mm < nrows; mm += gsz) {
        const int m = (int)mm;
        float* x1 = (m < TL) ? p.out + (size_t)m * D : p.XC + (size_t)(m - TL) * D;
        const float* md = modrow(p, l, m);
        const float* ya = p.YS + (size_t)p.rSlot[2 * m] * D; const float* yb = p.YS + (size_t)p.rSlot[2 * m + 1] * D;
        const float wa = p.rW[2 * m], wb = p.rW[2 * m + 1];
        const float* g2 = p.ln2_g + (size_t)l * D; const float* b2 = p.ln2_b + (size_t)l * D;
        float s = 0.f; for (int j = 0; j < D; ++j) s += ALPHA * x1[j] + md[5 * D + j] * (wa * ya[j] + wb * yb[j]);
        const float mu = s / D; float q = 0.f;
        for (int j = 0; j < D; ++j) { const float d = ALPHA * x1[j] + md[5 * D + j] * (wa * ya[j] + wb * yb[j]) - mu; q += d * d; }
        const float rstd = 1.0f / sqrtf(q / D + LN_EPS);
        for (int j = 0; j < D; ++j) x1[j] = (ALPHA * x1[j] + md[5 * D + j] * (wa * ya[j] + wb * yb[j]) - mu) * rstd * g2[j] + b2[j];
    }
}

__device__ __forceinline__ int moe_blocks(const int* cnt) { int s = 0; for (int j = 0; j < NEXP; ++j) s += (cnt[j] + 127) >> 7; return s; }
__device__ __forceinline__ int moe_block_expert(const int* cnt, int rb) {
    int s = 0, e = 0;
    for (int j = 0; j < NEXP; ++j) { const int nb = (cnt[j] + 127) >> 7; if (rb >= s && rb < s + nb) e = j; s += nb; }
    return e;
}

#ifdef HOST_EMU
static void host_gemm_in(const Params& p) {
    for (int m = 0; m < T; ++m) for (int n = 0; n < ZP; ++n) { float a = 0.f; for (int k = 0; k < D; ++k) a += bf2f(p.H[(size_t)m * D + k]) * bf2f(p.win_t[(size_t)n * D + k]); p.Z[(size_t)m * ZP + n] = f2bf(a); }
}
static void host_gemm_out(const Params& p, int nrows) {
    for (int m = 0; m < nrows; ++m) for (int n = 0; n < D; ++n) { float a = 0.f; for (int k = 0; k < DMIX; ++k) a += bf2f(p.MIX[(size_t)m * DMIX + k]) * bf2f(p.wout_t[(size_t)n * DMIX + k]); ((float*)p.O)[(size_t)m * D + n] = a; }
}
static void host_moe1(const Params& p, int l) {
    const int* cnt = p.cnt + l * NEXP; const int nrb = moe_blocks(cnt);
    for (int rb = 0; rb < nrb; ++rb) { const int e = moe_block_expert(cnt, rb);
        for (int r = 0; r < 128; ++r) { const int slot = rb * 128 + r; const bf16_t* a = p.H + (size_t)p.slotTok[slot] * D;
            for (int c = 0; c < DE; ++c) { const int q = c >> 4, ii = c & 15; float g = 0.f, u = 0.f;
                const bf16_t* wg = p.wgu_t + ((size_t)e * 2 * DE + 32 * q + ii) * D; const bf16_t* wu = wg + (size_t)16 * D;
                for (int k = 0; k < D; ++k) { g += bf2f(a[k]) * bf2f(wg[k]); u += bf2f(a[k]) * bf2f(wu[k]); }
                p.ACT[(size_t)slot * DE + c] = f2bf(siluf_(g) * u); } } }
}
static void host_moe2(const Params& p, int l) {
    const int* cnt = p.cnt + l * NEXP; const int nrb = moe_blocks(cnt);
    for (int rb = 0; rb < nrb; ++rb) { const int e = moe_block_expert(cnt, rb);
        for (int r = 0; r < 128; ++r) { const int slot = rb * 128 + r;
            for (int n = 0; n < D; ++n) { float a = 0.f; const bf16_t* w = p.wd_t + ((size_t)e * D + n) * DE;
                for (int k = 0; k < DE; ++k) a += bf2f(p.ACT[(size_t)slot * DE + k]) * bf2f(w[k]);
                p.YS[(size_t)slot * D + n] = a; } } }
}
#else
typedef short bf16x8 __attribute__((ext_vector_type(8)));
typedef float f32x4 __attribute__((ext_vector_type(4)));
__device__ __forceinline__ int opq_tid() { int t = threadIdx.x; asm volatile("" : "+v"(t)); return t; }
__device__ __forceinline__ int opq_bid() { int b = blockIdx.x; asm volatile("" : "+s"(b)); return b; }
__device__ __forceinline__ unsigned pk2(float lo, float hi) { return (unsigned)f2bf(lo) | ((unsigned)f2bf(hi) << 16); }
struct u32x2_t { unsigned x, y; };
__device__ __forceinline__ void st_bf16x4(bf16_t* dst, f32x4 v) { u32x2_t o; o.x = pk2(v[0], v[1]); o.y = pk2(v[2], v[3]); *(u32x2_t*)dst = o; }
template <bool SWAP = true, class Epi>
__device__ __forceinline__ void gemm_tile(const bf16_t* a0, const bf16_t* a1, const bf16_t* b0, const bf16_t* b1, int K, char* lds, const Epi& epi) {
    const int tid = opq_tid(), wid = tid >> 6, lane = tid & 63, wr = wid >> 1, wc = wid & 1, fr = lane & 15, fq = lane >> 4;
    f32x4 acc[4][4];
#pragma unroll
    for (int m = 0; m < 4; ++m)
#pragma unroll
        for (int n = 0; n < 4; ++n) acc[m][n] = (f32x4){0.f, 0.f, 0.f, 0.f};
#define GT_STAGE(st_, kt_) do { char* sa_ = lds + (st_) * 16384 + tid * 16; \
        __builtin_amdgcn_global_load_lds((const unsigned*)(a0 + (kt_)), (__attribute__((address_space(3))) unsigned*)(sa_), 16, 0, 0); \
        __builtin_amdgcn_global_load_lds((const unsigned*)(a1 + (kt_)), (__attribute__((address_space(3))) unsigned*)(sa_ + 4096), 16, 0, 0); \
        __builtin_amdgcn_global_load_lds((const unsigned*)(b0 + (kt_)), (__attribute__((address_space(3))) unsigned*)(sa_ + 8192), 16, 0, 0); \
        __builtin_amdgcn_global_load_lds((const unsigned*)(b1 + (kt_)), (__attribute__((address_space(3))) unsigned*)(sa_ + 12288), 16, 0, 0); } while (0)
    const int fsw = (0 - (fr >> 2)) & 3;
    const int aoff = (wr * 64 + fr) * 64 + ((fq ^ fsw) * 16), boff = 8192 + (wc * 64 + fr) * 64 + ((fq ^ fsw) * 16);
    const int nk = K / 32;
    GT_STAGE(0, 0);
    if (nk > 1) GT_STAGE(1, 32);
    if (nk > 2) GT_STAGE(2, 64);
    for (int t = 0; t < nk; ++t) {
        if (t + 2 < nk) asm volatile("s_waitcnt vmcnt(8)" ::: "memory"); else if (t + 1 < nk) asm volatile("s_waitcnt vmcnt(4)" ::: "memory"); else asm volatile("s_waitcnt vmcnt(0)" ::: "memory");
        asm volatile("s_waitcnt lgkmcnt(0)" ::: "memory");
        __builtin_amdgcn_s_barrier();
        if (t + 3 < nk) GT_STAGE((t + 3) & 3, (t + 3) * 32);
        const char* sb = lds + (t & 3) * 16384;
        bf16x8 At[4], Bt[4];
#pragma unroll
        for (int m = 0; m < 4; ++m) At[m] = *(const bf16x8*)(sb + aoff + m * 1024);
#pragma unroll
        for (int n = 0; n < 4; ++n) Bt[n] = *(const bf16x8*)(sb + boff + n * 1024);
#pragma unroll
        for (int m = 0; m < 4; ++m)
#pragma unroll
            for (int n = 0; n < 4; ++n) acc[m][n] = SWAP ? __builtin_amdgcn_mfma_f32_16x16x32_bf16(Bt[n], At[m], acc[m][n], 0, 0, 0) : __builtin_amdgcn_mfma_f32_16x16x32_bf16(At[m], Bt[n], acc[m][n], 0, 0, 0);
    }
    asm volatile("s_waitcnt lgkmcnt(0)" ::: "memory");
    __builtin_amdgcn_s_barrier();
#undef GT_STAGE
    epi(acc, wr, wc, fr, fq);
}
#define STG_ROW(i) ((tid_ + (i) * 256) >> 2)
#define STG_K ((((tid_ & 3) ^ ((0 - (tid_ >> 4)) & 3))) * 8)

__device__ __forceinline__ f32x4 ld_bf16x4(const bf16_t* src) { const u32x2_t w = *(const u32x2_t*)src; return (f32x4){__uint_as_float(w.x << 16), __uint_as_float(w.x & 0xffff0000u), __uint_as_float(w.y << 16), __uint_as_float(w.y & 0xffff0000u)}; }
template <bool SWAP = true, class Epi>
__device__ __forceinline__ void gemm_tile2(const bf16_t* a0, const bf16_t* a1, const bf16_t* b0, size_t ldb64, int K, char* lds, const Epi& epi) {
    const int tid = opq_tid(), wid = tid >> 6, lane = tid & 63, wr = wid >> 1, wc = wid & 1, fr = lane & 15, fq = lane >> 4;
    f32x4 acc[4][8];
#pragma unroll
    for (int m = 0; m < 4; ++m)
#pragma unroll
        for (int n = 0; n < 8; ++n) acc[m][n] = (f32x4){0.f, 0.f, 0.f, 0.f};
#define GT2_STAGE(st_, kt_) do { char* sa_ = lds + (st_) * 24576 + tid * 16; \
        __builtin_amdgcn_global_load_lds((const unsigned*)(a0 + (kt_)), (__attribute__((address_space(3))) unsigned*)(sa_), 16, 0, 0); \
        __builtin_amdgcn_global_load_lds((const unsigned*)(a1 + (kt_)), (__attribute__((address_space(3))) unsigned*)(sa_ + 4096), 16, 0, 0); \
        __builtin_amdgcn_global_load_lds((const unsigned*)(b0 + (kt_)), (__attribute__((address_space(3))) unsigned*)(sa_ + 8192), 16, 0, 0); \
        __builtin_amdgcn_global_load_lds((const unsigned*)(b0 + ldb64 + (kt_)), (__attribute__((address_space(3))) unsigned*)(sa_ + 12288), 16, 0, 0); \
        __builtin_amdgcn_global_load_lds((const unsigned*)(b0 + 2 * ldb64 + (kt_)), (__attribute__((address_space(3))) unsigned*)(sa_ + 16384), 16, 0, 0); \
        __builtin_amdgcn_global_load_lds((const unsigned*)(b0 + 3 * ldb64 + (kt_)), (__attribute__((address_space(3))) unsigned*)(sa_ + 20480), 16, 0, 0); } while (0)
    const int fsw = (0 - (fr >> 2)) & 3;
    const int aoff = (wr * 64 + fr) * 64 + ((fq ^ fsw) * 16), boff = 8192 + (wc * 128 + fr) * 64 + ((fq ^ fsw) * 16);
    const int nk = K / 32;
    GT2_STAGE(0, 0);
    if (nk > 1) GT2_STAGE(1, 32);
    int st = 0, st2 = 2;
#pragma unroll 1
    for (int t = 0; t < nk; ++t) {
        if (t + 1 < nk) asm volatile("s_waitcnt vmcnt(6)" ::: "memory"); else asm volatile("s_waitcnt vmcnt(0)" ::: "memory");
        asm volatile("s_waitcnt lgkmcnt(0)" ::: "memory");
        __builtin_amdgcn_s_barrier();
        if (t + 2 < nk) GT2_STAGE(st2, (t + 2) * 32);
        const char* sb = lds + st * 24576;
        bf16x8 At[4];
#pragma unroll
        for (int m = 0; m < 4; ++m) At[m] = *(const bf16x8*)(sb + aoff + m * 1024);
#pragma unroll
        for (int nh = 0; nh < 2; ++nh) {
            bf16x8 Bt[4];
#pragma unroll
            for (int n = 0; n < 4; ++n) Bt[n] = *(const bf16x8*)(sb + boff + (4 * nh + n) * 1024);
#pragma unroll
            for (int m = 0; m < 4; ++m)
#pragma unroll
                for (int n = 0; n < 4; ++n) acc[m][4 * nh + n] = SWAP ? __builtin_amdgcn_mfma_f32_16x16x32_bf16(Bt[n], At[m], acc[m][4 * nh + n], 0, 0, 0) : __builtin_amdgcn_mfma_f32_16x16x32_bf16(At[m], Bt[n], acc[m][4 * nh + n], 0, 0, 0);
        }
        st = st == 2 ? 0 : st + 1; st2 = st2 == 2 ? 0 : st2 + 1;
    }
    asm volatile("s_waitcnt lgkmcnt(0)" ::: "memory");
    __builtin_amdgcn_s_barrier();
#undef GT2_STAGE
    epi(acc, wr, wc, fr, fq);
}

__device__ __forceinline__ void g_gemm_in(const Params& p, char* lds) {
    const int tid_ = opq_tid(), bid_ = opq_bid(); (void)tid_; (void)bid_;
    constexpr int NT = NINP / 256, MT = T / 128;
    for (int tile = bid_; tile < NT * MT; tile += gridDim.x) {
        const int tm = tile / NT, tn = tile % NT;
        const bf16_t* a0 = p.H + (size_t)(tm * 128 + STG_ROW(0)) * D + STG_K; const bf16_t* a1 = p.H + (size_t)(tm * 128 + STG_ROW(1)) * D + STG_K;
        const bf16_t* b0 = p.win_t + (size_t)(tn * 256 + STG_ROW(0)) * D + STG_K;
        if (tn * 256 >= WVB) {
            gemm_tile2<false>(a0, a1, b0, (size_t)64 * D, D, lds, [&](const f32x4 (&acc)[4][8], int wr, int wc, int fr, int fq) {
#pragma unroll
                for (int m = 0; m < 4; ++m) { const int m0 = tm * 128 + wr * 64 + m * 16 + fq * 4; int b, u;
                    if (m0 < TL) { b = m0 / S; u = L + m0 % S; } else { b = (m0 - TL) / L; u = (m0 - TL) % L; }
#pragma unroll
                    for (int n = 0; n < 8; ++n) { const int vc = tn * 256 + wc * 128 + n * 16 + fr - WVB;
                        st_bf16x4(p.VT + ((size_t)(b * 8 + (vc >> 6)) * 64 + (vc & 63)) * PU + u, acc[m][n]); } }
            });
        } else {
            gemm_tile2<true>(a0, a1, b0, (size_t)64 * D, D, lds, [&](const f32x4 (&acc)[4][8], int wr, int wc, int fr, int fq) {
                const int c0 = tn * 256 + wc * 128;
                if (c0 < ZQN && tm < TL / 128) {
#pragma unroll
                    for (int m = 0; m < 4; ++m) { const int row = tm * 128 + wr * 64 + m * 16 + fr, t = row % S;
                        bf16_t* zr = p.Z + (size_t)row * ZP + c0 + 4 * fq;
#pragma unroll
                        for (int hh = 0; hh < 2; ++hh)
#pragma unroll
                            for (int ax = 0; ax < 2; ++ax) { const int pos = ax ? t % GRID_W : t / GRID_W;
                                const f32x4 cs = *(const f32x4*)(p.rope + pos * 16 + 4 * fq), sn = *(const f32x4*)(p.rope + 1024 + pos * 16 + 4 * fq);
                                const f32x4 x0 = acc[m][4 * hh + 2 * ax], x1 = acc[m][4 * hh + 2 * ax + 1];
                                st_bf16x4(zr + 64 * hh + 32 * ax, x0 * cs - x1 * sn); st_bf16x4(zr + 64 * hh + 32 * ax + 16, x1 * cs + x0 * sn); }
                        asm volatile("" ::: "memory"); }
                } else {
#pragma unroll
                    for (int m = 0; m < 4; ++m)
#pragma unroll
                        for (int n = 0; n < 8; ++n) { const int col = c0 + n * 16 + 4 * fq;
                            if (col < ZP) st_bf16x4(p.Z + (size_t)(tm * 128 + wr * 64 + m * 16 + fr) * ZP + col, acc[m][n]); }
                }
            });
        }
    }
}
__device__ __forceinline__ void g_gemm_out(const Params& p, int nrows, char* lds) {
    const int tid_ = opq_tid(), bid_ = opq_bid(); (void)tid_; (void)bid_;
    constexpr int NT = D / 128; const int MT = nrows / 128;
    for (int tile = bid_; tile < NT * MT; tile += gridDim.x) {
        const int tm = tile / NT, tn = tile % NT;
        const bf16_t* a0 = p.MIX + (size_t)(tm * 128 + STG_ROW(0)) * DMIX + STG_K; const bf16_t* a1 = p.MIX + (size_t)(tm * 128 + STG_ROW(1)) * DMIX + STG_K;
        const bf16_t* b0 = p.wout_t + (size_t)(tn * 128 + STG_ROW(0)) * DMIX + STG_K; const bf16_t* b1 = p.wout_t + (size_t)(tn * 128 + STG_ROW(1)) * DMIX + STG_K;
        gemm_tile(a0, a1, b0, b1, DMIX, lds, [&](const f32x4 (&acc)[4][4], int wr, int wc, int fr, int fq) {
#pragma unroll
            for (int m = 0; m < 4; ++m)
#pragma unroll
                for (int n = 0; n < 4; ++n) st_bf16x4(p.O + (size_t)(tm * 128 + wr * 64 + m * 16 + fr) * D + tn * 128 + wc * 64 + n * 16 + 4 * fq, acc[m][n]);
        });
    }
}
__device__ __forceinline__ void g_moe1(const Params& p, int l, char* lds) {
    const int tid_ = opq_tid(), bid_ = opq_bid(); (void)tid_; (void)bid_;
    const int* cnt = p.cnt + l * NEXP; const int nrb = moe_blocks(cnt); constexpr int NT = 2 * DE / 128;
    for (int tile = bid_; tile < nrb * NT; tile += gridDim.x) {
        const int rb = tile / NT, tn = tile % NT, e = moe_block_expert(cnt, rb);
        const bf16_t* a0 = p.H + (size_t)p.slotTok[rb * 128 + STG_ROW(0)] * D + STG_K; const bf16_t* a1 = p.H + (size_t)p.slotTok[rb * 128 + STG_ROW(1)] * D + STG_K;
        const bf16_t* bw = p.wgu_t + (size_t)e * 2 * DE * D;
        const bf16_t* b0 = bw + (size_t)(tn * 128 + STG_ROW(0)) * D + STG_K; const bf16_t* b1 = bw + (size_t)(tn * 128 + STG_ROW(1)) * D + STG_K;
        gemm_tile(a0, a1, b0, b1, D, lds, [&](const f32x4 (&acc)[4][4], int wr, int wc, int fr, int fq) {
#pragma unroll
            for (int m = 0; m < 4; ++m)
#pragma unroll
                for (int n2 = 0; n2 < 2; ++n2) {
                    const f32x4 g = acc[m][2 * n2], u = acc[m][2 * n2 + 1]; f32x4 a;
#pragma unroll
                    for (int e4 = 0; e4 < 4; ++e4) a[e4] = g[e4] / (1.0f + __expf(-g[e4])) * u[e4];
                    st_bf16x4(p.ACT + (size_t)(rb * 128 + wr * 64 + m * 16 + fr) * DE + tn * 64 + wc * 32 + n2 * 16 + 4 * fq, a); }
        });
    }
}
__device__ __forceinline__ void g_moe2(const Params& p, int l, char* lds) {
    const int tid_ = opq_tid(), bid_ = opq_bid(); (void)tid_; (void)bid_;
    const int* cnt = p.cnt + l * NEXP; const int nrb = moe_blocks(cnt); constexpr int NT = D / 128;
    for (int tile = bid_; tile < nrb * NT; tile += gridDim.x) {
        const int rb = tile / NT, tn = tile % NT, e = moe_block_expert(cnt, rb);
        const bf16_t* a0 = p.ACT + (size_t)(rb * 128 + STG_ROW(0)) * DE + STG_K; const bf16_t* a1 = p.ACT + (size_t)(rb * 128 + STG_ROW(1)) * DE + STG_K;
        const bf16_t* bw = p.wd_t + (size_t)e * D * DE;
        const bf16_t* b0 = bw + (size_t)(tn * 128 + STG_ROW(0)) * DE + STG_K; const bf16_t* b1 = bw + (size_t)(tn * 128 + STG_ROW(1)) * DE + STG_K;
        gemm_tile(a0, a1, b0, b1, DE, lds, [&](const f32x4 (&acc)[4][4], int wr, int wc, int fr, int fq) {
#pragma unroll
            for (int m = 0; m < 4; ++m)
#pragma unroll
                for (int n = 0; n < 4; ++n) st_bf16x4(p.YSb + (size_t)(rb * 128 + wr * 64 + m * 16 + fr) * D + tn * 128 + wc * 64 + n * 16 + 4 * fq, acc[m][n]);
        });
    }
}


constexpr int DV = D / 256;
static_assert(D % 256 == 0, "row phases hold a row as DV float4 per lane");
template <int CTRL> __device__ __forceinline__ float dppf(float v) { return __builtin_bit_cast(float, __builtin_amdgcn_update_dpp(0, __builtin_bit_cast(int, v), CTRL, 0xf, 0xf, true)); }
__device__ __forceinline__ float wave_sum(float v) {
    v += dppf<0xB1>(v); v += dppf<0x4E>(v); v += dppf<0x141>(v); v += dppf<0x140>(v);
    float a = v, b = v;
    asm volatile("s_nop 1\n\tv_permlane16_swap_b32 %0, %1" : "+v"(a), "+v"(b));
    v = a + b; a = v; b = v;
    asm volatile("s_nop 1\n\tv_permlane32_swap_b32 %0, %1" : "+v"(a), "+v"(b));
    return a + b;
}
__device__ __forceinline__ float sum8(float v) { v += dppf<0xB1>(v); v += dppf<0x4E>(v); v += dppf<0x141>(v); return v; }
__device__ __forceinline__ float sum4(f32x4 a) { return (a[0] + a[1]) + (a[2] + a[3]); }
#define LDS_WAIT() asm volatile("s_waitcnt lgkmcnt(0)" ::: "memory")

__device__ __forceinline__ void row_stats(const f32x4 (&v)[DV], float& mu, float& rstd) {
    float s = 0.f;
#pragma unroll
    for (int j = 0; j < DV; ++j) s += sum4(v[j]);
    mu = wave_sum(s) * (1.0f / D);
    float q = 0.f;
#pragma unroll
    for (int j = 0; j < DV; ++j) { const f32x4 d = v[j] - mu; q += sum4(d * d); }
    rstd = 1.0f / sqrtf(wave_sum(q) * (1.0f / D) + LN_EPS);
}

__device__ __forceinline__ void ph_lnmod_fast(const Params& p, int l) {
    const int tid_ = opq_tid(), bid_ = opq_bid(); (void)tid_; (void)bid_;
    const int lane = tid_ & 63, gw = bid_ * 4 + (tid_ >> 6), nw = gridDim.x * 4;
    constexpr int R = 4;
    for (int m0 = gw * R; m0 < T; m0 += nw * R) {
        f32x4 v[R][DV];
#pragma unroll
        for (int r = 0; r < R; ++r) { const f32x4* xr = (const f32x4*)xrow_in(p, l, m0 + r < T ? m0 + r : m0) + lane;
#pragma unroll
            for (int j = 0; j < DV; ++j) v[r][j] = xr[64 * j]; }
        float mu[R], rstd[R];
#pragma unroll
        for (int r = 0; r < R; ++r) row_stats(v[r], mu[r], rstd[r]);
#pragma unroll
        for (int r = 0; r < R; ++r) if (m0 + r < T) { const f32x4* md = (const f32x4*)modrow(p, l, m0 + r) + lane;
#pragma unroll
            for (int j = 0; j < DV; ++j) st_bf16x4(p.H + (size_t)(m0 + r) * D + 4 * (lane + 64 * j), (v[r][j] - mu[r]) * rstd[r] * (md[D / 4 + 64 * j] + 1.0f) + md[64 * j]); }
    }
}

template <int R>
__device__ __forceinline__ void pm_rows(const Params& p, int l, int m0, int lane) {
    const f32x4* g1 = (const f32x4*)(p.ln1_g + (size_t)l * D) + lane; const f32x4* b1 = (const f32x4*)(p.ln1_b + (size_t)l * D) + lane;
    f32x4 v[R][DV]; float mu[R], rstd[R];
#pragma unroll
    for (int r = 0; r < R; ++r) { const int m = m0 + r; const f32x4* xr = (const f32x4*)xrow_in(p, l, m) + lane; const f32x4* md = (const f32x4*)modrow(p, l, m) + lane;
        const bf16_t* orow = p.O + (size_t)m * D + 4 * lane;
#pragma unroll
        for (int j = 0; j < DV; ++j) v[r][j] = xr[64 * j] * ALPHA + md[2 * (D / 4) + 64 * j] * ld_bf16x4(orow + 256 * j); }
#pragma unroll
    for (int r = 0; r < R; ++r) row_stats(v[r], mu[r], rstd[r]);
#pragma unroll
    for (int r = 0; r < R; ++r) { const int m = m0 + r; f32x4* x1 = (f32x4*)((m < TL) ? p.out + (size_t)m * D : p.XC + (size_t)(m - TL) * D) + lane;
#pragma unroll
        for (int j = 0; j < DV; ++j) { v[r][j] = (v[r][j] - mu[r]) * rstd[r] * g1[64 * j] + b1[64 * j]; x1[64 * j] = v[r][j]; } }
#pragma unroll
    for (int r = 0; r < R; ++r) row_stats(v[r], mu[r], rstd[r]);
#pragma unroll
    for (int r = 0; r < R; ++r) { const int m = m0 + r; const f32x4* md = (const f32x4*)modrow(p, l, m) + lane;
#pragma unroll
        for (int j = 0; j < DV; ++j) {
            const f32x4 hv = (v[r][j] - mu[r]) * rstd[r] * (md[4 * (D / 4) + 64 * j] + 1.0f) + md[3 * (D / 4) + 64 * j];
            f32x4 hh, lo;
#pragma unroll
            for (int e = 0; e < 4; ++e) { hh[e] = bf2f(f2bf(hv[e])); lo[e] = hv[e] - hh[e]; }
            st_bf16x4(p.H + (size_t)m * D + 4 * (lane + 64 * j), hh);
            st_bf16x4(p.HLO + (size_t)m * D + 4 * (lane + 64 * j), lo);
        } }
}

__device__ __forceinline__ int router_rpg(int nrows) { const int g = gridDim.x; return (nrows % g == 0 && nrows / g <= 48 && (nrows / g) % 4 == 0) ? nrows / g : 32; }
__device__ __forceinline__ void g_router(const Params& p, int l, int nrows, char* lds) {
    const int tid_ = opq_tid(), bid_ = opq_bid(); (void)tid_; (void)bid_;
    const int lane = tid_ & 63, wid = tid_ >> 6, fr = lane & 15, fq = lane >> 4;
    const int RPG = router_rpg(nrows), RW = RPG / 4;
    float* part = (float*)lds;
    float* lgt = part + 4 * 9 * 64 * 4;
    int* eids = (int*)(lgt + 48 * 48);
    for (int rg = bid_; rg < nrows / RPG; rg += gridDim.x) {
#pragma unroll 1
        for (int i = 0; i + 1 < RW; i += 2) pm_rows<2>(p, l, rg * RPG + wid * RW + i, lane);
        if (RW & 1) pm_rows<1>(p, l, rg * RPG + wid * RW + RW - 1, lane);
        asm volatile("s_waitcnt vmcnt(0)" ::: "memory");
        __syncthreads();
        f32x4 acc[3][3];
#pragma unroll
        for (int a = 0; a < 3; ++a)
#pragma unroll
            for (int b = 0; b < 3; ++b) acc[a][b] = (f32x4){0.f, 0.f, 0.f, 0.f};
        int arow[3];
#pragma unroll
        for (int a = 0; a < 3; ++a) { const int rr = a * 16 + fr; arow[a] = rg * RPG + (rr < RPG ? rr : RPG - 1); }
#pragma unroll
        for (int seg = 0; seg < 3; ++seg) {
            const bf16_t* ab = (seg < 2 ? p.H : p.HLO) + wid * (D / 4) + fq * 8;
            const bf16_t* bp = p.wrt + (seg == 1 ? (size_t)128 * D : 0) + (size_t)fr * D + wid * (D / 4) + fq * 8;
#pragma unroll 1
            for (int ks0 = 0; ks0 < D / 128; ks0 += 2) {
                bf16x8 av[2][3], bv[2][3];
#pragma unroll
                for (int u = 0; u < 2; ++u) { const int ko = (ks0 + u) * 32;
#pragma unroll
                    for (int a = 0; a < 3; ++a) { av[u][a] = *(const bf16x8*)(ab + (size_t)arow[a] * D + ko); bv[u][a] = *(const bf16x8*)(bp + (size_t)(16 * a) * D + ko); } }
                asm volatile("" ::: "memory");
#pragma unroll
                for (int u = 0; u < 2; ++u)
#pragma unroll
                    for (int a = 0; a < 3; ++a)
#pragma unroll
                        for (int b = 0; b < 3; ++b) acc[a][b] = __builtin_amdgcn_mfma_f32_16x16x32_bf16(av[u][a], bv[u][b], acc[a][b], 0, 0, 0);
            }
        }
#pragma unroll
        for (int a = 0; a < 3; ++a)
#pragma unroll
            for (int b = 0; b < 3; ++b) *(f32x4*)(part + ((wid * 9 + a * 3 + b) * 64 + lane) * 4) = acc[a][b];
        __syncthreads();
#pragma unroll
        for (int i = 0; i < 9; ++i) { const int e = tid_ + 256 * i, f = e >> 8, ln = (e & 255) >> 2, j = e & 3;
            const float sm = (part[((0 * 9 + f) * 64 + ln) * 4 + j] + part[((1 * 9 + f) * 64 + ln) * 4 + j]) + (part[((2 * 9 + f) * 64 + ln) * 4 + j] + part[((3 * 9 + f) * 64 + ln) * 4 + j]);
            lgt[((f / 3) * 16 + (ln >> 4) * 4 + j) * 48 + (f % 3) * 16 + (ln & 15)] = sm; }
        __syncthreads();
        if (tid_ < RPG) {
            const int m = rg * RPG + tid_; const float* lg = lgt + tid_ * 48;
            float gl[4], el[32];
#pragma unroll
            for (int g = 0; g < 4; ++g) gl[g] = lg[g] + p.b_rg[l * 4 + g];
#pragma unroll
            for (int e = 0; e < 32; ++e) el[e] = lg[4 + e] + p.b_re[l * 32 + e];
            int gs = 0; float gm = gl[0];
#pragma unroll
            for (int g = 1; g < 4; ++g) if (gl[g] > gm) { gm = gl[g]; gs = g; }
            float den = 0.f;
#pragma unroll
            for (int g = 0; g < 4; ++g) den += expf(gl[g] - gm);
            const float pg = 1.0f / den;
            float v1 = -3e38f, v2 = -3e38f; int i1 = 0, i2 = 0;
#pragma unroll
            for (int j = 0; j < 8; ++j) {
                const float vv = gs == 0 ? el[j] : gs == 1 ? el[8 + j] : gs == 2 ? el[16 + j] : el[24 + j];
                if (vv > v1) { v2 = v1; i2 = i1; v1 = vv; i1 = j; } else if (vv > v2) { v2 = vv; i2 = j; }
            }
            const float e2 = expf(v2 - v1), w1 = pg / (1.0f + e2), w2 = pg * e2 / (1.0f + e2);
            const int ea = gs * 8 + i1, eb = gs * 8 + i2;
            p.rE[2 * m] = ea; p.rE[2 * m + 1] = eb; p.rW[2 * m] = w1; p.rW[2 * m + 1] = w2;
            eids[2 * tid_] = ea; eids[2 * tid_ + 1] = eb;
        }
        __syncthreads();
        if (tid_ < 2 * RPG) { const int e = eids[tid_]; int rk = 0; for (int j = 0; j < tid_; ++j) rk += (eids[j] == e) ? 1 : 0; p.rPos[2 * (rg * RPG) + tid_] = rk; }
        else if (tid_ >= 128 && tid_ < 160) { const int e = tid_ - 128; int c = 0; for (int j = 0; j < 2 * RPG; ++j) c += (eids[j] == e) ? 1 : 0; p.hist[rg * 32 + e] = c; }
        __syncthreads();
    }
}

__device__ __forceinline__ void ph_dispatch_fast(const Params& p, int l, int nrows, char* lds) {
    const int tid_ = opq_tid(), bid_ = opq_bid(); (void)tid_; (void)bid_;
    const int RPG = router_rpg(nrows), nrg = nrows / RPG, e = tid_ & 31, part = tid_ >> 5;
    int* tot = (int*)lds; int* pst = tot + 32; int* pre = pst + 32; int* red = pre + 32;
    { int s = 0; for (int b = part; b < nrg; b += 8) s += p.hist[b * 32 + e]; red[part * 32 + e] = s; }
    __syncthreads();
    if (tid_ < 32) { int s = 0; for (int q = 0; q < 8; ++q) s += red[q * 32 + tid_]; tot[tid_] = s; }
    __syncthreads();
    if (tid_ < 32) { int s = 0; for (int j = 0; j < tid_; ++j) s += (tot[j] + 127) & ~127; pst[tid_] = s; if (bid_ == 0) p.cnt[l * NEXP + tid_] = tot[tid_]; }
    for (int rg = bid_; rg < nrg; rg += gridDim.x) {
        __syncthreads();
        { int s = 0; for (int b = part; b < rg; b += 8) s += p.hist[b * 32 + e]; red[part * 32 + e] = s; }
        __syncthreads();
        if (tid_ < 32) { int s = 0; for (int q = 0; q < 8; ++q) s += red[q * 32 + tid_]; pre[tid_] = s; }
        __syncthreads();
        if (tid_ < 2 * RPG) { const int i = 2 * (rg * RPG) + tid_, ee = p.rE[i], slot = pst[ee] + pre[ee] + p.rPos[i]; p.rSlot[i] = slot; p.slotTok[slot] = i >> 1; }
    }
}

__device__ __forceinline__ void ph_final_fast(const Params& p, int l, int nrows, bool next_h) {
    const int tid_ = opq_tid(), bid_ = opq_bid(); (void)tid_; (void)bid_;
    const int lane = tid_ & 63, gw = bid_ * 4 + (tid_ >> 6), nw = gridDim.x * 4;
    constexpr int R = 4;
    const f32x4* g2 = (const f32x4*)(p.ln2_g + (size_t)l * D) + lane; const f32x4* b2 = (const f32x4*)(p.ln2_b + (size_t)l * D) + lane;
    for (int m0 = gw * R; m0 < nrows; m0 += nw * R) {
        f32x4 v[R][DV]; float mu[R], rstd[R];
#pragma unroll
        for (int r = 0; r < R; ++r) { const int m = m0 + r; const f32x4* x1 = (const f32x4*)((m < TL) ? p.out + (size_t)m * D : p.XC + (size_t)(m - TL) * D) + lane;
            const f32x4* md = (const f32x4*)modrow(p, l, m) + lane;
            const bf16_t* ya = p.YSb + (size_t)p.rSlot[2 * m] * D + 4 * lane; const bf16_t* yb = p.YSb + (size_t)p.rSlot[2 * m + 1] * D + 4 * lane;
            const float wa = p.rW[2 * m], wb = p.rW[2 * m + 1];
#pragma unroll
            for (int j = 0; j < DV; ++j) v[r][j] = x1[64 * j] * ALPHA + md[5 * (D / 4) + 64 * j] * (ld_bf16x4(ya + 256 * j) * wa + ld_bf16x4(yb + 256 * j) * wb); }
#pragma unroll
        for (int r = 0; r < R; ++r) row_stats(v[r], mu[r], rstd[r]);
#pragma unroll
        for (int r = 0; r < R; ++r) { const int m = m0 + r; f32x4* x1 = (f32x4*)((m < TL) ? p.out + (size_t)m * D : p.XC + (size_t)(m - TL) * D) + lane;
#pragma unroll
            for (int j = 0; j < DV; ++j) { v[r][j] = (v[r][j] - mu[r]) * rstd[r] * g2[64 * j] + b2[64 * j]; x1[64 * j] = v[r][j]; } }
        if (next_h) {
#pragma unroll
            for (int r = 0; r < R; ++r) row_stats(v[r], mu[r], rstd[r]);
#pragma unroll
            for (int r = 0; r < R; ++r) { const int m = m0 + r; const f32x4* mn = (const f32x4*)modrow(p, l + 1, m) + lane;
#pragma unroll
                for (int j = 0; j < DV; ++j) st_bf16x4(p.H + (size_t)m * D + 4 * (lane + 64 * j), (v[r][j] - mu[r]) * rstd[r] * (mn[D / 4 + 64 * j] + 1.0f) + mn[64 * j]); }
        }
    }
}

__device__ __forceinline__ void ph_mod_fast(const Params& p, char* lds) {
    const int tid_ = opq_tid(), bid_ = opq_bid(); (void)tid_; (void)bid_;
    constexpr int NR = NB + 1, NTASK = 2 * (6 * D / 64);
    if (bid_ >= NTASK) return;
    float* sc = (float*)lds;
    float* part = sc + NR * D;
    for (int i = tid_; i < NR * D; i += 256) { const int b = i / D, k = i % D; const float cv = b < NB ? p.c[(size_t)b * D + k] : p.c_ctx[k]; sc[i] = cv / (1.0f + __expf(-cv)); }
    __syncthreads();
    const int lane = tid_ & 63, wid = tid_ >> 6;
    for (int task = bid_; task < NTASK; task += gridDim.x) {
        const int ll = task / (6 * D / 64), col = 64 * (task % (6 * D / 64)) + lane;
        float acc[NR];
#pragma unroll
        for (int b = 0; b < NR; ++b) acc[b] = 0.f;
        const float* wp = p.w_mod + ((size_t)ll * D + wid * (D / 4)) * 6 * D + col;
#pragma unroll 16
        for (int k = 0; k < D / 4; ++k) { const float w = wp[(size_t)k * 6 * D];
#pragma unroll
            for (int b = 0; b < NR; ++b) acc[b] += sc[b * D + wid * (D / 4) + k] * w; }
#pragma unroll
        for (int b = 0; b < NR; ++b) part[(wid * NR + b) * 64 + lane] = acc[b];
        __syncthreads();
        for (int i = tid_; i < NR * 64; i += 256) { const int b = i / 64, cl = i % 64;
            p.mod[((size_t)ll * NR + b) * 6 * D + 64 * (task % (6 * D / 64)) + cl] = (part[(0 * NR + b) * 64 + cl] + part[(1 * NR + b) * 64 + cl]) + (part[(2 * NR + b) * 64 + cl] + part[(3 * NR + b) * 64 + cl]) + p.b_mod[(size_t)ll * 6 * D + 64 * (task % (6 * D / 64)) + cl]; }
        __syncthreads();
    }
}

template <bool SPLIT = false>
__device__ __forceinline__ void tr_item(const float* srcl, size_t ldw, bf16_t* dst, size_t ldd, float* scr, int lane, float scale = 1.0f) {
    float v[32];
#pragma unroll
    for (int i = 0; i < 32; ++i) v[i] = srcl ? srcl[(size_t)(2 * i + (lane >> 5)) * ldw] * scale : 0.f;
#pragma unroll
    for (int i = 0; i < 32; ++i) scr[(2 * i + (lane >> 5)) * 33 + (lane & 31)] = v[i];
    LDS_WAIT();
    const int c = lane & 7;
#pragma unroll
    for (int j = 0; j < 4; ++j) { const int n = (lane >> 3) + 8 * j; const float* s = scr + (8 * c) * 33 + n;
        uint4 o; o.x = pk2(s[0], s[33]); o.y = pk2(s[2 * 33], s[3 * 33]); o.z = pk2(s[4 * 33], s[5 * 33]); o.w = pk2(s[6 * 33], s[7 * 33]);
        *(uint4*)(dst + (size_t)(SPLIT ? (n & 15) + 32 * (n >> 4) : n) * ldd + 8 * c) = o; }
    LDS_WAIT();
}
__device__ __forceinline__ void ph_prep_w_fast(const Params& p, int l, int part, char* lds) {
    const int tid_ = opq_tid(), bid_ = opq_bid(); (void)tid_; (void)bid_;
    const int lane = tid_ & 63, wid = tid_ >> 6, gw = bid_ * 4 + wid, nw = gridDim.x * 4;
    float* scr = (float*)(lds + wid * 8448);
    constexpr int I_IN = (D / 64) * (NINP / 32), I_OUT = (DMIX / 64) * (D / 32), I_GU1 = (D / 64) * (2 * DE / 32), I_D1 = (DE / 64) * (D / 32);
    constexpr int NITEMS = I_IN + I_OUT + NEXP * (I_GU1 + I_D1);
    const int it0 = part == 0 ? 0 : I_IN + I_OUT, it1 = part == 0 ? I_IN + I_OUT : NITEMS;
    for (int it = it0 + gw; it < it1; it += nw) {
        int r = it;
        if (r < I_IN) { const int kb = r / (NINP / 32), n0 = 32 * (r % (NINP / 32));
            const float* s = nullptr;
            {
                const int oc = n0 < ZQN ? n0 + A_IN : n0 < ZA ? n0 + 1312 : n0 < ZP ? n0 - ZA : n0 < WVB ? -1 : n0 < WVN ? n0 - 864 : n0 - 96;
                if (oc >= 0) s = p.w_in + ((size_t)l * D + 64 * kb) * N_IN + oc + (lane & 31); }
            tr_item(s, N_IN, p.win_t + (size_t)n0 * D + 64 * kb, D, scr, lane, (n0 < ZKB || (n0 >= ZQN && n0 < ZKN)) ? QSCALE : 1.0f); continue; }
        r -= I_IN;
        if (r < I_OUT) { const int kb = r / (D / 32), n0 = 32 * (r % (D / 32));
            tr_item(p.w_out + ((size_t)l * DMIX + 64 * kb) * D + n0 + (lane & 31), D, p.wout_t + (size_t)n0 * DMIX + 64 * kb, DMIX, scr, lane); continue; }
        r -= I_OUT;
        const int e = r / (I_GU1 + I_D1); r %= (I_GU1 + I_D1);
        if (r < I_GU1) { const int kb = r / (2 * DE / 32), q = r % (2 * DE / 32), up = q & 1, c0 = 32 * (q >> 1);
            const float* s = (up ? p.w_up : p.w_gate) + (((size_t)l * NEXP + e) * D + 64 * kb) * DE + c0 + (lane & 31);
            tr_item<true>(s, DE, p.wgu_t + ((size_t)e * 2 * DE + 2 * c0 + 16 * up) * D + 64 * kb, D, scr, lane); continue; }
        r -= I_GU1;
        { const int kb = r / (D / 32), n0 = 32 * (r % (D / 32));
            tr_item(p.w_down + (((size_t)l * NEXP + e) * DE + 64 * kb) * D + n0 + (lane & 31), D, p.wd_t + ((size_t)e * D + n0) * DE + 64 * kb, DE, scr, lane); }
    }
    if (part != 0) return;
    const long gt = (long)bid_ * blockDim.x + tid_, gs = (long)gridDim.x * blockDim.x;
    for (long i = gt; i < 2 * 256 * 64; i += gs) { const int k = (int)(i & 63), n = (int)((i >> 6) & 255), d = (int)(i >> 14);
        p.wupT[i] = f2bf(p.a_w_up[(((size_t)l * 2 + d) * 64 + k) * DA + n]); p.aupT[i] = f2bf(p.a_a_up[(((size_t)l * 2 + d) * 64 + k) * DA + n]); }
    for (long i = gt; i < 256 * 160; i += gs) { const int k = (int)(i % 160), n = (int)(i / 160); p.gupT[i] = f2bf(p.a_g_up[((size_t)l * 160 + k) * DA + n]); }
    for (long i = gt; i < (long)128 * D; i += gs) { const int n = (int)(i / D), k = (int)(i % D);
        const float w = n < 4 ? p.w_rg[((size_t)l * D + k) * 4 + n] : n < 36 ? p.w_re[((size_t)l * D + k) * 32 + n - 4] : 0.f;
        const bf16_t hb = f2bf(w); p.wrt[i] = hb; p.wrt[(size_t)128 * D + i] = f2bf(w - bf2f(hb)); }
}

__device__ __forceinline__ float tanh_fast(float x) { return 1.0f - 2.0f / (1.0f + __expf(2.0f * x)); }
__device__ __forceinline__ void ph_streams_s1(const Params& p, int l) {
    const int tid_ = opq_tid(), bid_ = opq_bid(); (void)tid_; (void)bid_;
    constexpr int NCH = A_IN / 8, NCHP = (NCH + 7) & ~7;
    const float* sh = p.a_shift + (size_t)l * 3 * A_IN;
    for (long it = (long)bid_ * 256 + tid_; it < (long)T * NCHP; it += (long)gridDim.x * 256) {
        const int m = (int)(it / NCHP), ch = (int)(it % NCHP), c0 = 8 * ch;
        const bool act = ch < NCH;
        int t, len;
        if (m < TL) { t = m % S; len = S; } else { t = (m - TL) % L; len = L; }
        float v[8];
#pragma unroll
        for (int e = 0; e < 8; ++e) v[e] = 0.f;
        if (act) {
            const bf16_t* z = p.Z + (size_t)m * ZP + ZA + c0;
            const bf16x8 zc = *(const bf16x8*)z;
            const f32x4 s1a = *(const f32x4*)(sh + A_IN + c0), s1b = *(const f32x4*)(sh + A_IN + c0 + 4);
#pragma unroll
            for (int e = 0; e < 8; ++e) v[e] = (e < 4 ? s1a[e] : s1b[e - 4]) * bf2f((bf16_t)zc[e]);
            if (t > 0) { const bf16x8 zp = *(const bf16x8*)(z - ZP); const f32x4 a = *(const f32x4*)(sh + c0), b = *(const f32x4*)(sh + c0 + 4);
#pragma unroll
                for (int e = 0; e < 8; ++e) v[e] += (e < 4 ? a[e] : b[e - 4]) * bf2f((bf16_t)zp[e]); }
            if (t < len - 1) { const bf16x8 zn = *(const bf16x8*)(z + ZP); const f32x4 a = *(const f32x4*)(sh + 2 * A_IN + c0), b = *(const f32x4*)(sh + 2 * A_IN + c0 + 4);
#pragma unroll
                for (int e = 0; e < 8; ++e) v[e] += (e < 4 ? a[e] : b[e - 4]) * bf2f((bf16_t)zn[e]); }
        }
        float nrm = 0.f;
        if (ch >= 32 && ch < 64) {
#pragma unroll
            for (int e = 0; e < 8; ++e) { const float t2 = v[e] * p.a_k_k[l * DA + c0 - 256 + e]; nrm += t2 * t2; } }
        nrm = sum8(nrm);
        if (!act) continue;
        if (c0 < 768) {
            float* dst = (c0 < 256 ? p.sR + (size_t)m * DA + c0 : c0 < 512 ? p.kT + (size_t)m * DA + c0 - 256 : p.sV + (size_t)m * DA + c0 - 512);
            *(f32x4*)dst = (f32x4){v[0], v[1], v[2], v[3]}; *(f32x4*)(dst + 4) = (f32x4){v[4], v[5], v[6], v[7]};
            if (ch >= 32 && ch < 64 && (ch & 7) == 0) p.kN[(size_t)m * 4 + ((ch - 32) >> 3)] = 1.0f / sqrtf(nrm + 1e-12f);
        } else {
            if (c0 < 896) {
#pragma unroll
                for (int e = 0; e < 8; ++e) v[e] = tanh_fast(v[e]); }
            else if (c0 >= 1024) {
#pragma unroll
                for (int e = 0; e < 8; ++e) v[e] = 1.0f / (1.0f + __expf(-v[e])); }
            uint4 o; o.x = pk2(v[0], v[1]); o.y = pk2(v[2], v[3]); o.z = pk2(v[4], v[5]); o.w = pk2(v[6], v[7]);
            *(uint4*)(p.LA + (size_t)m * 416 + c0 - 768) = o;
        }
    }
}
__device__ __forceinline__ void g_streams_s2(const Params& p, int l, char* lds) {
    const int tid_ = opq_tid(), bid_ = opq_bid(); (void)tid_; (void)bid_;
    constexpr int MT = T / 128;
    for (int job = bid_; job < 5 * MT * 2; job += gridDim.x) {
        const int type = job / (MT * 2), r = job % (MT * 2), tm = r >> 1, tn = r & 1;
        const int coff = type < 2 ? type * 64 : type < 4 ? 128 + (type - 2) * 64 : 256, K = type < 4 ? 64 : 160, d = type & 1;
        const bf16_t* Bt = type < 2 ? p.wupT + type * 256 * 64 : type < 4 ? p.aupT + (type - 2) * 256 * 64 : p.gupT;
        const bf16_t* a0 = p.LA + (size_t)(tm * 128 + STG_ROW(0)) * 416 + coff + STG_K; const bf16_t* a1 = p.LA + (size_t)(tm * 128 + STG_ROW(1)) * 416 + coff + STG_K;
        const bf16_t* b0 = Bt + (size_t)(tn * 128 + STG_ROW(0)) * K + STG_K; const bf16_t* b1 = Bt + (size_t)(tn * 128 + STG_ROW(1)) * K + STG_K;
        if (type < 2) gemm_tile(a0, a1, b0, b1, K, lds, [&](const f32x4 (&acc)[4][4], int wr, int wc, int fr, int fq) {
#pragma unroll
            for (int mi = 0; mi < 4; ++mi) { const int row = tm * 128 + wr * 64 + mi * 16 + fr;
#pragma unroll
                for (int n = 0; n < 4; ++n) { const int c = tn * 128 + wc * 64 + n * 16 + 4 * fq; const f32x4 w0 = *(const f32x4*)(p.a_w0 + (l * 2 + d) * DA + c); f32x4 o;
#pragma unroll
                    for (int e4 = 0; e4 < 4; ++e4) { const float ex = __expf(-(w0[e4] + acc[mi][n][e4]));
                        o[e4] = __expf(-0.60653065971f / (1.0f + ex)); }
                    *(f32x4*)(p.sW + ((size_t)d * T + row) * DA + c) = o; }
                asm volatile("" ::: "memory"); }
        });
        else if (type < 4) gemm_tile(a0, a1, b0, b1, K, lds, [&](const f32x4 (&acc)[4][4], int wr, int wc, int fr, int fq) {
#pragma unroll
            for (int mi = 0; mi < 4; ++mi) { const int row = tm * 128 + wr * 64 + mi * 16 + fr;
#pragma unroll
                for (int n = 0; n < 4; ++n) { const int c = tn * 128 + wc * 64 + n * 16 + 4 * fq;
                    const f32x4 a0v = *(const f32x4*)(p.a_a0 + (l * 2 + d) * DA + c), kkc = *(const f32x4*)(p.a_k_k + l * DA + c), kac = *(const f32x4*)(p.a_k_a + l * DA + c);
                    const size_t o = (size_t)row * DA + c, od = ((size_t)d * T + row) * DA + c;
                    const f32x4 k = *(const f32x4*)(p.kT + o); const float kn = p.kN[(size_t)row * 4 + (c >> 6)];
                    f32x4 kd, bo, kk;
#pragma unroll
                    for (int e4 = 0; e4 < 4; ++e4) { const float av = 1.0f / (1.0f + __expf(-(a0v[e4] + acc[mi][n][e4])));
                        kk[e4] = k[e4] * kkc[e4] * kn; kd[e4] = k[e4] * (1.0f + (av - 1.0f) * kac[e4]); bo[e4] = kk[e4] * av; }
                    *(f32x4*)(p.sKD + od) = kd; *(f32x4*)(p.sB + od) = bo; if (d == 0) *(f32x4*)(p.sKK + o) = kk; }
                asm volatile("" ::: "memory"); }
        });
        else gemm_tile(a0, a1, b0, b1, K, lds, [&](const f32x4 (&acc)[4][4], int wr, int wc, int fr, int fq) {
#pragma unroll
            for (int mi = 0; mi < 4; ++mi)
#pragma unroll
                for (int n = 0; n < 4; ++n) st_bf16x4(p.MIX + (size_t)(tm * 128 + wr * 64 + mi * 16 + fr) * DMIX + tn * 128 + wc * 64 + n * 16 + 4 * fq, acc[mi][n]);
        });
    }
}


typedef float f32x16 __attribute__((ext_vector_type(16)));
typedef short s16x4 __attribute__((ext_vector_type(4)));
typedef unsigned u32x4_t __attribute__((ext_vector_type(4)));
typedef float f32x2_t __attribute__((ext_vector_type(2)));
typedef __bf16 bf16x2_t __attribute__((ext_vector_type(2)));
__device__ __forceinline__ unsigned cvtpk(float lo, float hi) { f32x2_t v = {lo, hi}; bf16x2_t b = __builtin_convertvector(v, bf16x2_t); return __builtin_bit_cast(unsigned, b); }
__device__ __forceinline__ int crow(int r, int hi) { return (r & 3) + 8 * (r >> 2) + 4 * hi; }
__device__ __forceinline__ float xmax32(float v) { float a = v, b = v; asm volatile("s_nop 1\n\tv_permlane32_swap_b32 %0, %1" : "+v"(a), "+v"(b)); return fmaxf(a, b); }
__device__ __forceinline__ float xsum32(float v) { float a = v, b = v; asm volatile("s_nop 1\n\tv_permlane32_swap_b32 %0, %1" : "+v"(a), "+v"(b)); return a + b; }

struct NoMask { __device__ __forceinline__ float operator()(int, float v) const { return v; } };

template <class MaskF>
__device__ __forceinline__ void attn_tile_lds(const bf16x8 (&qf)[4], const char* ks, const char* vs, const MaskF& mask, float& m_run, float& l_run, f32x16& o0, f32x16& o1, int ql, int hi) {
    f32x16 s;
#pragma unroll
    for (int r = 0; r < 16; ++r) s[r] = 0.f;
#pragma unroll
    for (int k4 = 0; k4 < 4; ++k4) { const bf16x8 kf = *(const bf16x8*)(ks + ql * 128 + (((2 * k4 + hi) ^ (ql & 7)) * 16)); s = __builtin_amdgcn_mfma_f32_32x32x16_bf16(kf, qf[k4], s, 0, 0, 0); }
    float mx = -INFINITY;
#pragma unroll
    for (int r = 0; r < 16; ++r) { s[r] = mask(crow(r, hi), s[r]); mx = fmaxf(mx, s[r]); }
    mx = xmax32(mx);
    if (__any(mx > m_run)) {
        const float mn = fmaxf(m_run, mx), alpha = __builtin_amdgcn_exp2f(m_run - mn);
        m_run = mn; l_run *= alpha;
#pragma unroll
        for (int r = 0; r < 16; ++r) { o0[r] *= alpha; o1[r] *= alpha; }
    }
    float ps = 0.f;
#pragma unroll
    for (int r = 0; r < 16; ++r) { s[r] = __builtin_amdgcn_exp2f(s[r] - m_run); ps += s[r]; }
    l_run += ps;
    const int sw0 = (ql >> 2) & 3;
#pragma unroll
    for (int s2 = 0; s2 < 2; ++s2) {
        u32x4_t pw; pw[0] = cvtpk(s[8 * s2], s[8 * s2 + 1]); pw[1] = cvtpk(s[8 * s2 + 2], s[8 * s2 + 3]); pw[2] = cvtpk(s[8 * s2 + 4], s[8 * s2 + 5]); pw[3] = cvtpk(s[8 * s2 + 6], s[8 * s2 + 7]);
        const bf16x8 pb = __builtin_bit_cast(bf16x8, pw);
        const char* v0 = vs + ql * 64 + 8 * hi; const char* v1 = v0 + 32 * 64;
        const s16x4 a0 = *(const s16x4*)(v0 + (((2 * s2) ^ sw0) * 16)), a1 = *(const s16x4*)(v0 + (((2 * s2 + 1) ^ sw0) * 16));
        const s16x4 c0 = *(const s16x4*)(v1 + (((2 * s2) ^ sw0) * 16)), c1 = *(const s16x4*)(v1 + (((2 * s2 + 1) ^ sw0) * 16));
        o0 = __builtin_amdgcn_mfma_f32_32x32x16_bf16(__builtin_shufflevector(a0, a1, 0, 1, 2, 3, 4, 5, 6, 7), pb, o0, 0, 0, 0);
        o1 = __builtin_amdgcn_mfma_f32_32x32x16_bf16(__builtin_shufflevector(c0, c1, 0, 1, 2, 3, 4, 5, 6, 7), pb, o1, 0, 0, 0);
    }
}

__device__ __forceinline__ void ph_attn_blk(const Params& p, int l, bool with_ctx, int first_blk, char* lds) {
    const int tid_ = opq_tid(), bid_ = opq_bid(); (void)tid_; (void)bid_;
    if (bid_ < first_blk) return;
    const int lane = tid_ & 63, hi = lane >> 5, ql = lane & 31, wid = tid_ >> 6;
    constexpr int NQG = S / 128, NCG = L / 128, ROWS = S / GRID_W, N_LAT = NB * 6 * NQG, N_CTX = NB * 6 * NCG, TPB = (S + L) / 32;
    const int ntask = 2 * N_LAT + (with_ctx ? 2 * N_CTX : 0);
    const int krow = tid_ >> 3, kch = (tid_ & 7) ^ (krow & 7), vrow = tid_ >> 2, vpc = (tid_ & 3) ^ ((vrow >> 2) & 3);
    for (int task = bid_ - first_blk; task < ntask; task += gridDim.x - first_blk) {
        bool isC, isCtx; int r;
        if (task < N_LAT) { isC = true; isCtx = false; r = task; }
        else if (task < 2 * N_LAT) { isC = false; isCtx = false; r = task - N_LAT; }
        else { r = task - 2 * N_LAT; isCtx = true; isC = r >= N_CTX; if (isC) r -= N_CTX; }
        const int ng = isCtx ? NCG : NQG, g = r % ng, h = (r / ng) % 6, b = r / (ng * 6);
        const int qt = 4 * g + wid;
        const int m = isCtx ? TL + b * L + 32 * qt + ql : b * S + 32 * qt + ql;
        const int qcol = isC ? ZQN + h * 64 : ZQB + h * 64, kcol = isC ? ZKN + h * 64 : ZKB + (h / 3) * 64, hv = isC ? 2 + h : h / 3;
        bf16x8 qf[4];
        { const bf16_t* qp = p.Z + (size_t)m * ZP + qcol + 8 * hi;
#pragma unroll
          for (int k4 = 0; k4 < 4; ++k4) qf[k4] = *(const bf16x8*)(qp + 16 * k4); }
        int lo = 0, hi_t = 0, gr0 = 0;
        if (!isCtx) {
            if (!isC) { lo = 4 * g - 4; hi_t = 4 * g + 8; lo = lo < 0 ? 0 : lo; hi_t = hi_t > S / 32 ? S / 32 : hi_t; }
            else { const int ra = 2 * g, rb = 2 * g + 1; int r0a = ra - 4; r0a = r0a < 0 ? 0 : (r0a > ROWS - 8 ? ROWS - 8 : r0a); int r0b = rb - 4; r0b = r0b < 0 ? 0 : (r0b > ROWS - 8 ? ROWS - 8 : r0b);
                   lo = 2 * r0a; hi_t = 2 * (r0b + 8); gr0 = 0; }
        }
        const int ntile = L / 32 + (hi_t - lo);
        const bf16_t* kbase = p.Z + (size_t)krow * ZP + kcol + 8 * kch;
        const bf16_t* vbase = p.VT + ((size_t)(b * 8 + hv) * 64 + vrow) * PU + 8 * vpc;
#define AT_TOK(i_) ((i_) < L / 32 ? 32 * (i_) : L + 32 * (lo + (i_) - L / 32))
#define AT_STAGE(i_) do { const int u0_ = AT_TOK(i_); const int zrow_ = u0_ < L ? TL + b * L + u0_ : b * S + (u0_ - L); char* sl_ = lds + ((i_) % 3) * 8192 + tid_ * 16; \
            __builtin_amdgcn_global_load_lds((const unsigned*)(kbase + (size_t)zrow_ * ZP), (__attribute__((address_space(3))) unsigned*)(sl_), 16, 0, 0); \
            __builtin_amdgcn_global_load_lds((const unsigned*)(vbase + u0_), (__attribute__((address_space(3))) unsigned*)(sl_ + 4096), 16, 0, 0); } while (0)
        f32x16 o0, o1;
#pragma unroll
        for (int rr = 0; rr < 16; ++rr) { o0[rr] = 0.f; o1[rr] = 0.f; }
        float m_run, l_run;
        if (isC) { m_run = -1e30f; l_run = 0.f; } else { m_run = p.b_sink[l * 6 + h] * LOG2E; l_run = hi == 0 ? 1.0f : 0.f; }
        const int gr = qt >> 1, c = 32 * (qt & 1) + ql;
        int r0 = gr - 4; r0 = r0 < 0 ? 0 : (r0 > ROWS - 8 ? ROWS - 8 : r0);
        int c0 = c - 8; c0 = c0 < 0 ? 0 : (c0 > GRID_W - 16 ? GRID_W - 16 : c0);
        float* rpb = (float*)(lds + 24576);
        if (isC && !isCtx) for (int i = tid_; i < 15 * 31; i += 256) rpb[i] = p.c_rpb[((size_t)l * 6 + h) * 15 * 31 + i] * LOG2E;
        AT_STAGE(0);
        if (ntile > 1) AT_STAGE(1);
#pragma unroll 1
        for (int i = 0; i < ntile; ++i) {
            if (i + 1 < ntile) asm volatile("s_waitcnt vmcnt(2)" ::: "memory"); else asm volatile("s_waitcnt vmcnt(0)" ::: "memory");
            asm volatile("s_waitcnt lgkmcnt(0)" ::: "memory");
            __builtin_amdgcn_s_barrier();
            if (i + 2 < ntile) AT_STAGE(i + 2);
            const char* ks = lds + (i % 3) * 8192; const char* vs = ks + 4096;
            if (i < L / 32) attn_tile_lds(qf, ks, vs, NoMask(), m_run, l_run, o0, o1, ql, hi);
            else {
                const int jt = lo + i - L / 32;
                if (!isC) {
                    const int dq = jt - qt;
                    if (dq >= -3 && dq <= 3) attn_tile_lds(qf, ks, vs, NoMask(), m_run, l_run, o0, o1, ql, hi);
                    else if (dq == -4 || dq == 4) { const int base = 32 * dq - ql;
                        attn_tile_lds(qf, ks, vs, [&](int ko, float v) { const int rel = base + ko; return (rel >= -128 && rel <= 128) ? v : -INFINITY; }, m_run, l_run, o0, o1, ql, hi); }
                } else {
                    const int kr_ = jt >> 1, ct = jt & 1;
                    if (kr_ >= r0 && kr_ < r0 + 8) { const float* rp = rpb + (kr_ - gr + 7) * 31 + 15 - c;
                        attn_tile_lds(qf, ks, vs, [&](int ko, float v) { const int kc = 32 * ct + ko; int ix = kc - c + 15; ix = ix < 0 ? 0 : (ix > 30 ? 30 : ix); const float bs = rp[c - 15 + ix];
                                                     return (kc >= c0 && kc < c0 + 16) ? v + bs : -INFINITY; }, m_run, l_run, o0, o1, ql, hi); }
                }
            }
        }
        asm volatile("s_waitcnt lgkmcnt(0)" ::: "memory");
        __builtin_amdgcn_s_barrier();
#undef AT_STAGE
#undef AT_TOK
        (void)gr0;
        const float lt = xsum32(l_run), inv = 1.0f / lt;
        bf16_t* op = p.MIX + (size_t)m * DMIX + (isC ? 640 : 256) + h * 64 + 4 * hi;
#pragma unroll
        for (int gq = 0; gq < 4; ++gq) {
            st_bf16x4(op + 8 * gq, (f32x4){o0[4 * gq] * inv, o0[4 * gq + 1] * inv, o0[4 * gq + 2] * inv, o0[4 * gq + 3] * inv});
            st_bf16x4(op + 32 + 8 * gq, (f32x4){o1[4 * gq] * inv, o1[4 * gq + 1] * inv, o1[4 * gq + 2] * inv, o1[4 * gq + 3] * inv});
        }
    }
}

#define RNB " row_newbcast:%c[n] row_mask:0xf bank_mask:0xf\n\t"
template <int N, bool FIRST>
__device__ __forceinline__ void dpp_dot4(float& a0, float& a1, float& a2, float& a3, const f32x4& v, float s0, float s1, float s2, float s3) {
    if (FIRST) asm volatile("s_nop 1");
    asm("v_fmac_f32_dpp %0, %4, %8" RNB "v_fmac_f32_dpp %1, %5, %9" RNB "v_fmac_f32_dpp %2, %6, %10" RNB "v_fmac_f32_dpp %3, %7, %11" RNB
        : "+v"(a0), "+v"(a1), "+v"(a2), "+v"(a3) : "v"(v[0]), "v"(v[1]), "v"(v[2]), "v"(v[3]), "v"(s0), "v"(s1), "v"(s2), "v"(s3), [n] "i"(N));
}
template <int N, bool FIRST>
__device__ __forceinline__ void dpp_upd4s(float& s0, float& s1, float& s2, float& s3, float& y0, float& y1, float& y2, float& y3,
                                          const f32x4& w, const f32x4& b, const f32x4& kd, const f32x4& r, float nsk, float vv) {
    if (FIRST) asm volatile("s_nop 1");
    asm("v_mul_f32_dpp %0, %8, %0" RNB "v_mul_f32_dpp %1, %9, %1" RNB "v_mul_f32_dpp %2, %10, %2" RNB "v_mul_f32_dpp %3, %11, %3" RNB
        "v_fmac_f32_dpp %0, %12, %24" RNB "v_fmac_f32_dpp %1, %13, %24" RNB "v_fmac_f32_dpp %2, %14, %24" RNB "v_fmac_f32_dpp %3, %15, %24" RNB
        "v_fmac_f32_dpp %0, %16, %25" RNB "v_fmac_f32_dpp %1, %17, %25" RNB "v_fmac_f32_dpp %2, %18, %25" RNB "v_fmac_f32_dpp %3, %19, %25" RNB
        "v_fmac_f32_dpp %4, %20, %0" RNB "v_fmac_f32_dpp %5, %21, %1" RNB "v_fmac_f32_dpp %6, %22, %2" RNB "v_fmac_f32_dpp %7, %23, %3" RNB
        : "+v"(s0), "+v"(s1), "+v"(s2), "+v"(s3), "+v"(y0), "+v"(y1), "+v"(y2), "+v"(y3)
        : "v"(w[0]), "v"(w[1]), "v"(w[2]), "v"(w[3]), "v"(b[0]), "v"(b[1]), "v"(b[2]), "v"(b[3]), "v"(kd[0]), "v"(kd[1]), "v"(kd[2]), "v"(kd[3]),
          "v"(r[0]), "v"(r[1]), "v"(r[2]), "v"(r[3]), "v"(nsk), "v"(vv), [n] "i"(N));
}
template <int N, bool FIRST>
__device__ __forceinline__ void dpp_upd4p(float& s0, float& s1, float& s2, float& s3, float& y0, float& y1, float& y2, float& y3,
                                          const f32x4& w, const f32x4& b, const f32x4& r, float nsk) {
    if (FIRST) asm volatile("s_nop 1");
    asm("v_mul_f32_dpp %0, %8, %0" RNB "v_mul_f32_dpp %1, %9, %1" RNB "v_mul_f32_dpp %2, %10, %2" RNB "v_mul_f32_dpp %3, %11, %3" RNB
        "v_fmac_f32_dpp %0, %12, %20" RNB "v_fmac_f32_dpp %1, %13, %20" RNB "v_fmac_f32_dpp %2, %14, %20" RNB "v_fmac_f32_dpp %3, %15, %20" RNB
        "v_fmac_f32_dpp %4, %16, %0" RNB "v_fmac_f32_dpp %5, %17, %1" RNB "v_fmac_f32_dpp %6, %18, %2" RNB "v_fmac_f32_dpp %7, %19, %3" RNB
        : "+v"(s0), "+v"(s1), "+v"(s2), "+v"(s3), "+v"(y0), "+v"(y1), "+v"(y2), "+v"(y3)
        : "v"(w[0]), "v"(w[1]), "v"(w[2]), "v"(w[3]), "v"(b[0]), "v"(b[1]), "v"(b[2]), "v"(b[3]), "v"(r[0]), "v"(r[1]), "v"(r[2]), "v"(r[3]), "v"(nsk), [n] "i"(N));
}
template <int N, bool FIRST>
__device__ __forceinline__ void dpp_mul4(float& s0, float& s1, float& s2, float& s3, const f32x4& v) {
    if (FIRST) asm volatile("s_nop 1");
    asm("v_mul_f32_dpp %0, %4, %0" RNB "v_mul_f32_dpp %1, %5, %1" RNB "v_mul_f32_dpp %2, %6, %2" RNB "v_mul_f32_dpp %3, %7, %3" RNB
        : "+v"(s0), "+v"(s1), "+v"(s2), "+v"(s3) : "v"(v[0]), "v"(v[1]), "v"(v[2]), "v"(v[3]), [n] "i"(N));
}
template <int N>
__device__ __forceinline__ void dpp_fmacx4(float& s0, float& s1, float& s2, float& s3, const f32x4& v, float x) {
    asm("v_fmac_f32_dpp %0, %4, %8" RNB "v_fmac_f32_dpp %1, %5, %8" RNB "v_fmac_f32_dpp %2, %6, %8" RNB "v_fmac_f32_dpp %3, %7, %8" RNB
        : "+v"(s0), "+v"(s1), "+v"(s2), "+v"(s3) : "v"(v[0]), "v"(v[1]), "v"(v[2]), "v"(v[3]), "v"(x), [n] "i"(N));
}
template <int N> struct ScanRep {
    static __device__ __forceinline__ void dot8(float (&a)[8], const f32x4& v, const float (&st)[64]) {
        constexpr int h = (N & 1) * 4;
        dpp_dot4<N, N == 0>(a[h], a[h + 1], a[h + 2], a[h + 3], v, st[4 * N], st[4 * N + 1], st[4 * N + 2], st[4 * N + 3]);
        if constexpr (N < 15) ScanRep<N + 1>::dot8(a, v, st);
    }
    static __device__ __forceinline__ void dot(float& a0, float& a1, float& a2, float& a3, const f32x4& v, const float (&st)[64]) {
        dpp_dot4<N, N == 0>(a0, a1, a2, a3, v, st[4 * N], st[4 * N + 1], st[4 * N + 2], st[4 * N + 3]);
        if constexpr (N < 15) ScanRep<N + 1>::dot(a0, a1, a2, a3, v, st);
    }
    static __device__ __forceinline__ void mul(float (&st)[64], const f32x4& w) {
        dpp_mul4<N, N == 0>(st[4 * N], st[4 * N + 1], st[4 * N + 2], st[4 * N + 3], w);
        if constexpr (N < 15) ScanRep<N + 1>::mul(st, w);
    }
    static __device__ __forceinline__ void fmacx(float (&st)[64], const f32x4& v, float x) {
        dpp_fmacx4<N>(st[4 * N], st[4 * N + 1], st[4 * N + 2], st[4 * N + 3], v, x);
        if constexpr (N < 15) ScanRep<N + 1>::fmacx(st, v, x);
    }
};
__device__ __forceinline__ int scan_row(int b, int d, int pos) { return pos < L ? TL + b * L + (d ? L - 1 - pos : pos) : b * S + (d ? S - 1 - (pos - L) : pos - L); }

template <bool ISP>
__device__ __forceinline__ void scan_task(const Params& p, int c, int s, int lane) {
    const int h = c & 3, b = (c >> 2) % NB, d = (c >> 2) / NB, pos0 = SEGLEN * s;
    const int q = 4 * (lane & 15);
    const float* bkk = p.sKK + h * 64 + q; const float* br = p.sR + h * 64 + q; const float* bw = p.sW + (size_t)d * T * DA + h * 64 + q; const float* bb_ = p.sB + (size_t)d * T * DA + h * 64 + q;
    const float* bkd = p.sKD + (size_t)d * T * DA + h * 64 + q; const float* bv = p.sV + h * 64 + lane;
    float* by = (ISP ? p.PV : p.Y) + (size_t)d * T * DA + h * 64 + lane;
    float st[64];
#pragma unroll
    for (int k = 0; k < 64; ++k) st[k] = (ISP && k == lane) ? 1.0f : 0.f;
    size_t mo = (size_t)scan_row(b, d, pos0) * DA;
    f32x4 kk = *(const f32x4*)(bkk + mo), w = *(const f32x4*)(bw + mo), bb = *(const f32x4*)(bb_ + mo), r = *(const f32x4*)(br + mo), kd = w; float vv = 0.f;
    if (!ISP) { kd = *(const f32x4*)(bkd + mo); vv = bv[mo]; }
#pragma unroll 1
    for (int i = 0; i < SEGLEN; ++i) {
        const size_t mn = (size_t)scan_row(b, d, pos0 + (i + 1 < SEGLEN ? i + 1 : i)) * DA;
        const f32x4 nkk = *(const f32x4*)(bkk + mn), nw = *(const f32x4*)(bw + mn), nb = *(const f32x4*)(bb_ + mn), nr = *(const f32x4*)(br + mn);
        f32x4 nkd = nw; float nv = 0.f;
        if (!ISP) { nkd = *(const f32x4*)(bkd + mn); nv = bv[mn]; }
        float a[8] = {0.f, 0.f, 0.f, 0.f, 0.f, 0.f, 0.f, 0.f};
        ScanRep<0>::dot8(a, kk, st);
        const float nsk = -(((a[0] + a[1]) + (a[2] + a[3])) + ((a[4] + a[5]) + (a[6] + a[7])));
        ScanRep<0>::mul(st, w);
        ScanRep<0>::fmacx(st, bb, nsk);
        if (!ISP) ScanRep<0>::fmacx(st, kd, vv);
        float y[8] = {0.f, 0.f, 0.f, 0.f, 0.f, 0.f, 0.f, 0.f};
        ScanRep<0>::dot8(y, r, st);
        by[mo] = ((y[0] + y[1]) + (y[2] + y[3])) + ((y[4] + y[5]) + (y[6] + y[7]));
        kk = nkk; w = nw; bb = nb; r = nr; kd = nkd; vv = nv; mo = mn;
    }
    if (s < NSG - 1) {
        float* dst = (ISP ? p.PS : p.QS) + (((size_t)c * NSG + s) * 64 + lane) * 64;
#pragma unroll
        for (int k4 = 0; k4 < 16; ++k4) *(f32x4*)(dst + 4 * k4) = (f32x4){st[4 * k4], st[4 * k4 + 1], st[4 * k4 + 2], st[4 * k4 + 3]};
    }
}
__device__ __forceinline__ void ph_scan_fast(const Params& p) {
    const int tid_ = opq_tid(), bid_ = opq_bid(); (void)tid_; (void)bid_;
    const int lane = tid_ & 63, gw = bid_ * 4 + (tid_ >> 6), nw = gridDim.x * 4;
    constexpr int NS_T = 64 * NSG, NP_T = 64 * (NSG - 1);
    const int G = gridDim.x, wv = tid_ >> 6; (void)gw; (void)nw;
    for (int tsk = wv * G + bid_; tsk < NS_T + NP_T; tsk += 4 * G) {
        const int t2 = __builtin_amdgcn_readfirstlane(tsk);
        if (t2 < NS_T) scan_task<false>(p, t2 & 63, t2 >> 6, lane);
        else scan_task<true>(p, (t2 - NS_T) & 63, 1 + ((t2 - NS_T) >> 6), lane);
    }
}
__device__ __forceinline__ void ph_combine(const Params& p, char* lds) {
    const int tid_ = opq_tid(), bid_ = opq_bid(); (void)tid_; (void)bid_; (void)lds;
    if (bid_ >= 64) return;
    const int lane = tid_ & 63, c = bid_, cb = tid_ >> 6, q = lane >> 4, i16 = lane & 15, v = 16 * cb + i16;
    const float* QSc = p.QS + (size_t)c * NSG * 4096; const float* PSc = p.PS + (size_t)c * NSG * 4096; float* SSg = p.SS + (size_t)c * NSG * 4096;
    f32x4 acc[4];
#pragma unroll
    for (int ro = 0; ro < 4; ++ro) acc[ro] = *(const f32x4*)(QSc + v * 64 + 16 * ro + 4 * q);
#pragma unroll 1
    for (int s = 1; s < NSG; ++s) {
#pragma unroll
        for (int ro = 0; ro < 4; ++ro)
#pragma unroll
            for (int j = 0; j < 4; ++j) SSg[(size_t)s * 4096 + (16 * ro + 4 * q + j) * 64 + v] = acc[ro][j];
        if (s == NSG - 1) break;
        const float* P = PSc + (size_t)s * 4096 + (4 * q) * 64 + i16;
        float a[4][4][4];
#pragma unroll
        for (int rb = 0; rb < 4; ++rb)
#pragma unroll
            for (int kk = 0; kk < 4; ++kk)
#pragma unroll
                for (int ro = 0; ro < 4; ++ro) a[rb][kk][ro] = P[(16 * rb + kk) * 64 + 16 * ro];
#pragma unroll
        for (int rb = 0; rb < 4; ++rb) asm volatile("" : "+v"(a[rb][0][0]), "+v"(a[rb][0][1]), "+v"(a[rb][0][2]), "+v"(a[rb][0][3]), "+v"(a[rb][1][0]), "+v"(a[rb][1][1]), "+v"(a[rb][1][2]), "+v"(a[rb][1][3]),
                                                         "+v"(a[rb][2][0]), "+v"(a[rb][2][1]), "+v"(a[rb][2][2]), "+v"(a[rb][2][3]), "+v"(a[rb][3][0]), "+v"(a[rb][3][1]), "+v"(a[rb][3][2]), "+v"(a[rb][3][3]));
        f32x4 nacc[4];
#pragma unroll
        for (int ro = 0; ro < 4; ++ro) nacc[ro] = *(const f32x4*)(QSc + (size_t)s * 4096 + v * 64 + 16 * ro + 4 * q);
#pragma unroll
        for (int rb = 0; rb < 4; ++rb)
#pragma unroll
            for (int kk = 0; kk < 4; ++kk)
#pragma unroll
                for (int ro = 0; ro < 4; ++ro) nacc[ro] = __builtin_amdgcn_mfma_f32_16x16x4f32(a[rb][kk][ro], acc[rb][kk], nacc[ro], 0, 0, 0);
#pragma unroll
        for (int ro = 0; ro < 4; ++ro) acc[ro] = nacc[ro];
    }
}
__device__ __forceinline__ float qsum(float v) {
    float a = v, b = v; asm volatile("s_nop 1\n\tv_permlane16_swap_b32 %0, %1" : "+v"(a), "+v"(b)); v = a + b; a = v; b = v;
    asm volatile("s_nop 1\n\tv_permlane32_swap_b32 %0, %1" : "+v"(a), "+v"(b)); return a + b; }
__device__ __forceinline__ void ph_rwkv_out_fast(const Params& p, int l, bool with_ctx) {
    const int tid_ = opq_tid(), bid_ = opq_bid(); (void)tid_; (void)bid_;
    const int lane = tid_ & 63, i16 = lane & 15, q = lane >> 4, gw = bid_ * 4 + (tid_ >> 6), nw = gridDim.x * 4;
    constexpr int TOK = 16, NLT = NB * (S / TOK) * 4, NCTK = NB * (L / TOK) * 4;
    const int ntask = NLT + (with_ctx ? NCTK : 0);
    for (int tsk = gw; tsk < ntask; tsk += nw) {
        const bool isCtx = tsk >= NLT; const int r = isCtx ? tsk - NLT : tsk;
        const int h = r & 3, npt = isCtx ? L / TOK : S / TOK, tt = (r >> 2) % npt, b = (r >> 2) / npt;
        const int seg0 = (isCtx ? TOK * tt : L + TOK * tt) / SEGLEN, seg1 = (isCtx ? L - 1 - TOK * tt : L + S - 1 - TOK * tt) / SEGLEN;
        const int m = (isCtx ? TL + b * L + TOK * tt : b * S + TOK * tt) + i16;
        const size_t o = (size_t)m * DA + h * 64 + 4 * q, o1 = o + (size_t)T * DA;
        f32x4 acc[4];
#pragma unroll
        for (int rb = 0; rb < 4; ++rb) acc[rb] = *(const f32x4*)(p.Y + o + 16 * rb) + *(const f32x4*)(p.Y + o1 + 16 * rb);
#pragma unroll
        for (int d = 0; d < 2; ++d) {
            const int seg = d ? seg1 : seg0;
            if (seg > 0) {
                const float* sst = p.SS + (((size_t)(d * NB + b) * 4 + h) * NSG + seg) * 4096 + q * 64 + i16;
                const float* pvp = p.PV + (d ? o1 : o) - 4 * q + q;
                float a[4][16], bq[16];
#pragma unroll
                for (int kk = 0; kk < 16; ++kk) { bq[kk] = pvp[4 * kk];
#pragma unroll
                    for (int rb = 0; rb < 4; ++rb) a[rb][kk] = sst[(4 * kk) * 64 + 16 * rb]; }
#pragma unroll
                for (int rb = 0; rb < 4; ++rb) asm volatile("" : "+v"(a[rb][0]), "+v"(a[rb][1]), "+v"(a[rb][2]), "+v"(a[rb][3]), "+v"(a[rb][4]), "+v"(a[rb][5]), "+v"(a[rb][6]), "+v"(a[rb][7]),
                                                                 "+v"(a[rb][8]), "+v"(a[rb][9]), "+v"(a[rb][10]), "+v"(a[rb][11]), "+v"(a[rb][12]), "+v"(a[rb][13]), "+v"(a[rb][14]), "+v"(a[rb][15]));
#pragma unroll
                for (int kk = 0; kk < 16; ++kk)
#pragma unroll
                    for (int rb = 0; rb < 4; ++rb) acc[rb] = __builtin_amdgcn_mfma_f32_16x16x4f32(a[rb][kk], bq[kk], acc[rb], 0, 0, 0);
            }
        }
        float s = 0.f;
#pragma unroll
        for (int rb = 0; rb < 4; ++rb) s += sum4(acc[rb]);
        const float mu = qsum(s) * (1.0f / 64.f);
        float sq = 0.f, bon = 0.f;
#pragma unroll
        for (int rb = 0; rb < 4; ++rb) { const f32x4 dy = acc[rb] - mu; sq += sum4(dy * dy);
            const f32x4 rr = *(const f32x4*)(p.sR + o + 16 * rb), kds = *(const f32x4*)(p.sKD + o + 16 * rb) + *(const f32x4*)(p.sKD + o1 + 16 * rb), rk = *(const f32x4*)(p.a_r_k + l * DA + h * 64 + 16 * rb + 4 * q);
            bon += sum4(rr * kds * rk); }
        const float rstd = 1.0f / sqrtf(qsum(sq) * (1.0f / 64.f) + GN_EPS); bon = qsum(bon);
#pragma unroll
        for (int rb = 0; rb < 4; ++rb) { const int c = h * 64 + 16 * rb + 4 * q;
            const f32x4 gln = *(const f32x4*)(p.a_lnx_g + l * DA + c), bln = *(const f32x4*)(p.a_lnx_b + l * DA + c), vv = *(const f32x4*)(p.sV + o + 16 * rb);
            bf16_t* mp = p.MIX + (size_t)m * DMIX + c; const f32x4 gg = ld_bf16x4(mp);
            st_bf16x4(mp, ((acc[rb] - mu) * rstd * gln + bln + vv * bon) * gg); }
    }
}


#define LAS __attribute__((address_space(3)))
#define XB_TMO      128
#define XB_XCNT(j)  (256  + 64 * (j))
#define XB_XSUB(j)  (1280 + 64 * (j))
#define XB_XGEN(j)  (2304 + 64 * (j))
#define XB_TOP      3328
#define XB_TOPGEN   3392
#define XCD_BAR_WORDS 3456
#define XB_SPIN_CAP (1u << 20)
static_assert(XCD_BAR_WORDS * 4 <= 16384, "barrier words fit the control region");
__device__ __forceinline__ unsigned xb_ld(unsigned* p)              { return __hip_atomic_load(p, __ATOMIC_RELAXED, __HIP_MEMORY_SCOPE_AGENT); }
__device__ __forceinline__ unsigned xb_add(unsigned* p, unsigned v) { return __hip_atomic_fetch_add(p, v, __ATOMIC_RELAXED, __HIP_MEMORY_SCOPE_AGENT); }
__device__ __forceinline__ unsigned xb_xcc_id() { return (unsigned)__builtin_amdgcn_s_getreg((3 << 11) | 20) & 0xFu; }
#define XB_SPIN(cond, bar) do { unsigned _sp = 0; while (cond) { __builtin_amdgcn_s_sleep(1); \
    if ((++_sp & 255u) == 0u) { if (xb_ld(&(bar)[XB_TMO])) break; if (_sp > XB_SPIN_CAP) { atomicAdd(&(bar)[XB_TMO], 1u); break; } } } } while (0)
struct XcdBarrier { unsigned* bar; unsigned x; volatile LAS unsigned* st; };
__device__ __forceinline__ XcdBarrier xcd_barrier_post(unsigned* bar, volatile LAS unsigned* st) {
    XcdBarrier b; b.bar = bar; b.x = xb_xcc_id(); b.st = st;
    if (threadIdx.x == 0) (void)xb_add(&bar[XB_XCNT(b.x)], 1u);
    return b;
}
__device__ __forceinline__ void xcd_barrier_complete(unsigned* bar, unsigned x, unsigned& nloc, unsigned& nx) {
    const unsigned G = gridDim.x * gridDim.y * gridDim.z;
    unsigned sum, cnt, mine, sp = 0u;
    for (;;) {
        sum = 0u; cnt = 0u; mine = 0u;
#pragma unroll
        for (unsigned j = 0; j < 16; ++j) { const unsigned c = xb_ld(&bar[XB_XCNT(j)]); sum += c; cnt += (c > 0u) ? 1u : 0u; mine = (j == x) ? c : mine; }
        if (sum == G) break;
        __builtin_amdgcn_s_sleep(1);
        if ((++sp & 255u) == 0u) { if (xb_ld(&bar[XB_TMO])) break; if (sp > XB_SPIN_CAP) { atomicAdd(&bar[XB_TMO], 1u); break; } }
    }
    nloc = mine > 0u ? mine : 1u; nx = cnt > 0u ? cnt : 1u;
}
__device__ __forceinline__ void xcd_barrier(const XcdBarrier& b) {
    asm volatile("s_waitcnt vmcnt(0)" ::: "memory");
    __syncthreads();
    if (threadIdx.x == 0) {
        unsigned* bar = b.bar;
        __builtin_amdgcn_s_waitcnt(0);
        unsigned nloc = b.st[0], nx = b.st[1];
        if (nloc == 0u) { xcd_barrier_complete(bar, b.x, nloc, nx); b.st[0] = nloc; b.st[1] = nx; }
        const unsigned old = xb_add(&bar[XB_XSUB(b.x)], 1u);
        const unsigned gen = old / nloc;
        if (old + 1u == (gen + 1u) * nloc) {
            __builtin_amdgcn_fence(__ATOMIC_RELEASE, "agent");
            asm volatile("s_waitcnt vmcnt(0)" ::: "memory");
            const unsigned og = xb_add(&bar[XB_TOP], 1u);
            const unsigned tg = og / nx;
            if (og + 1u == (tg + 1u) * nx) xb_add(&bar[XB_TOPGEN], 1u);
            else XB_SPIN(xb_ld(&bar[XB_TOPGEN]) == tg, bar);
            __builtin_amdgcn_fence(__ATOMIC_ACQUIRE, "agent");
            xb_add(&bar[XB_XGEN(b.x)], 1u);
            asm volatile("s_waitcnt vmcnt(0)" ::: "memory");
        } else {
            XB_SPIN(xb_ld(&bar[XB_XGEN(b.x)]) == gen, bar);
            __builtin_amdgcn_fence(__ATOMIC_ACQUIRE, "agent");
            asm volatile("s_waitcnt vmcnt(0)" ::: "memory");
        }
    }
    __syncthreads();
}

#define GT ((long)blockIdx.x * blockDim.x + threadIdx.x)
#define GS ((long)gridDim.x * blockDim.x)
__global__ void __launch_bounds__(256, 2) mega_fwd(Params p) {
    __shared__ __attribute__((aligned(16))) char lds[73728 + 64];
    cg::grid_group grid = cg::this_grid();
    const long gt = GT, gs = GS;
    volatile LAS unsigned* bst = (volatile LAS unsigned*)(LAS char*)(lds + 73728);
    if (threadIdx.x < 2) bst[threadIdx.x] = 0u;
    __syncthreads();
    const XcdBarrier xb = xcd_barrier_post(p.bar, bst);
#ifndef PROBE_PHASE
#define PROBE_PHASE -1
#endif
#define PROBE_AMP 8
    unsigned long long t_prev = 0; int nts = 0;
#define STAMP() do { if (PROBE_PHASE >= 0 && blockIdx.x == 0 && threadIdx.x == 0) { const unsigned long long t_now = __builtin_amdgcn_s_memrealtime(); \
        if (nts == PROBE_PHASE + 1) { const unsigned long long t_end = t_now + PROBE_AMP * (t_now - t_prev); while (__builtin_amdgcn_s_memrealtime() < t_end) __builtin_amdgcn_s_sleep(8); } \
        t_prev = __builtin_amdgcn_s_memrealtime(); } ++nts; } while (0)
#define GSYNC() do { xcd_barrier(xb); STAMP(); } while (0)
    STAMP();
    ph_mod_fast(p, lds); ph_prep_w_fast(p, 0, 0, lds); ph_prep_misc(p, 0, gt, gs, false);
    if (p.out == nullptr) grid.sync();
    GSYNC();
    for (int l = 0; l < 2; ++l) {
        const int nrows = (l == 0) ? T : TL;
        if (l == 0) { ph_lnmod_fast(p, l); GSYNC(); }
        g_gemm_in(p, lds);
        GSYNC();
        ph_streams_s1(p, l);
        GSYNC();
        g_streams_s2(p, l, lds);
        GSYNC();
        ph_scan_fast(p);
        GSYNC();
        ph_combine(p, lds); ph_attn_blk(p, l, l == 0, 64, lds);
        GSYNC();
        ph_rwkv_out_fast(p, l, l == 0);
        GSYNC();
        if (blockIdx.x >= gridDim.x / 2) { ph_prep_w_fast(p, l, 1, lds); __syncthreads(); g_gemm_out(p, nrows, lds); } else { g_gemm_out(p, nrows, lds); ph_prep_w_fast(p, l, 1, lds); }
        GSYNC();
        g_router(p, l, nrows, lds);
        GSYNC();
        ph_dispatch_fast(p, l, nrows, lds);
        GSYNC();
        g_moe1(p, l, lds);
        GSYNC();
        g_moe2(p, l, lds);
        GSYNC();
        ph_final_fast(p, l, nrows, l == 0);
        if (l == 0) { ph_prep_w_fast(p, 1, 0, lds); ph_prep_misc(p, 1, gt, gs, false); }
        GSYNC();
    }}

extern "C" void kernel_launch(void* const* d_in, const int* in_sizes, int n_in, void* d_out, int out_size, void* d_ws, size_t ws_size, hipStream_t stream) {
    if (n_in != 32 || out_size != TL * D || ws_size < WS_NEED) { fprintf(stderr, "kernel_launch: unexpected shapes / workspace (n_in %d out %d ws %zu need %zu)\n", n_in, out_size, ws_size, (size_t)WS_NEED); return; }
    static int grid_blocks = 0;
    if (!grid_blocks) {
        int dev = 0, cus = 0, per_cu = 0;
        (void)hipGetDevice(&dev);
        (void)hipDeviceGetAttribute(&cus, hipDeviceAttributeMultiprocessorCount, dev);
        (void)hipOccupancyMaxActiveBlocksPerMultiprocessor(&per_cu, mega_fwd, 256, 0);
        if (per_cu < 1) per_cu = 1;
        if (per_cu > 2) per_cu = 2;
        grid_blocks = cus * per_cu;
        fprintf(stderr, "kernel_launch: %d CUs x %d blocks\n", cus, per_cu);
    }
    Params p = make_params(d_in, d_out, d_ws);
    (void)hipMemsetAsync(d_ws, 0, CTL_BYTES, stream);
    void* args[] = {&p};
    hipError_t e = hipLaunchCooperativeKernel((void*)mega_fwd, dim3(grid_blocks), dim3(256), args, 0, stream);
    if (e != hipSuccess) fprintf(stderr, "cooperative launch failed: %s (grid %d)\n", hipGetErrorString(e), grid_blocks);
}
#endif

#ifdef HOST_EMU
static void host_forward(void* const* d_in, void* d_out, void* d_ws) {
    const Params p = make_params(d_in, d_out, d_ws);
    for (int l = 0; l < 2; ++l) {
        const int nrows = (l == 0) ? T : TL;
        ph_prep_w(p, l, 0, 1); ph_prep_misc(p, l, 0, 1); ph_lnmod(p, l, 0, 1); host_gemm_in(p); ph_streams(p, l, 0, 1); ph_rope(p, 0, 1); ph_scan(p, 0, 1);
        ph_attn(p, l, nrows, 0, 1); ph_rwkv_out(p, l, nrows, 0, 1); host_gemm_out(p, nrows); ph_post_mixer(p, l, nrows, 0, 1);
        ph_dispatch(p, l, nrows, 0, 1); host_moe1(p, l); host_moe2(p, l); ph_final(p, l, nrows, 0, 1);
    }
}
#endif
```

```cpp
#ifdef HOST_EMU
#include <cmath>
#include <cstdio>
#include <cstring>
#include <cstdint>
#include <cstdlib>
#define __device__
#define __global__
#define __host__
#define __forceinline__ inline
#else
#include <hip/hip_runtime.h>
#include <hip/hip_cooperative_groups.h>
#include <cstdio>
#include <cstdint>
namespace cg = cooperative_groups;
#endif

#ifndef CFG_D
#define CFG_D 1024
#define CFG_B 8
#define CFG_S 2048
#define CFG_L 256
#define CFG_DE 512
#endif
constexpr int D = CFG_D, NB = CFG_B, S = CFG_S, L = CFG_L, DE = CFG_DE;
constexpr int TL = NB * S, TC = NB * L, T = TL + TC;
constexpr int GRID_W = 64, HD = 64;
constexpr int DA = 256, A_IN = 1184, N_IN = 2976, NINP = 3072, DMIX = 1024;
#ifdef HOST_EMU
constexpr int MPAD = 128;
#else
constexpr int MPAD = 256;
#endif
constexpr int NEXP = 32, NSLOT = 2 * T + NEXP * MPAD;
#ifdef HOST_EMU
constexpr int ZQB = 0, ZKB = 384, ZVB = 512, ZQN = 640, ZKN = 1024, ZVN = 1408, ZA = 1792, ZP = 2976;
#else
constexpr int ZQB = 0, ZKB = 384, ZQN = 512, ZKN = 896, ZA = 1280, ZP = 2464, WVB = 2560, WVN = 2688;
#endif
constexpr float LN_EPS = 1e-6f, GN_EPS = 64e-5f, ATT_SCALE = 0.125f, LOG2E = 1.4426950408889634f, QSCALE = ATT_SCALE * LOG2E;
constexpr float ALPHA = 1.41421356237309515f;

typedef unsigned short bf16_t;

__device__ __forceinline__ float bf2f(bf16_t v) {
    unsigned u = ((unsigned)v) << 16; float f;
#ifdef HOST_EMU
    memcpy(&f, &u, 4);
#else
    f = __uint_as_float(u);
#endif
    return f;
}
__device__ __forceinline__ bf16_t f2bf(float f) {
    unsigned u;
#ifdef HOST_EMU
    memcpy(&u, &f, 4);
#else
    u = __float_as_uint(f);
#endif
    return (bf16_t)((u + 0x7fffu + ((u >> 16) & 1u)) >> 16);
}
__device__ __forceinline__ float sigmoidf_(float x) { return 1.0f / (1.0f + expf(-x)); }
__device__ __forceinline__ float siluf_(float x) { return x / (1.0f + expf(-x)); }
__device__ __forceinline__ int atomic_inc_int(int* p) {
#ifdef HOST_EMU
    int o = *p; *p = o + 1; return o;
#else
    return atomicAdd(p, 1);
#endif
}

struct Params {
    const float *x, *c, *ctx, *c_ctx, *w_mod, *b_mod, *w_in, *w_out, *a_shift, *a_w0, *a_w_up, *a_a0, *a_a_up, *a_g_up,
        *a_k_k, *a_k_a, *a_r_k, *a_lnx_g, *a_lnx_b, *b_sink, *c_rpb, *ln1_g, *ln1_b, *ln2_g, *ln2_b, *w_rg, *b_rg, *w_re,
        *b_re, *w_gate, *w_up, *w_down;
    float* out;
    int* cnt;
    unsigned* bar;
    float* mod;
    float* rope;
    bf16_t *win_t, *wout_t, *wgu_t, *wd_t;
    bf16_t *wrt;
    int* hist;
    bf16_t* HLO;
    bf16_t *wupT, *aupT, *gupT;
    bf16_t* LA;
    float *kT, *kN;
    bf16_t* H;
    bf16_t* Z;
    bf16_t* VT;
    float *sR, *sV, *sKK, *sG, *sW, *sKD, *sB;
    float* Y;
    bf16_t* MIX;
    float *PV, *QS, *PS, *SS;
    float* XC;
    bf16_t* O;
    bf16_t* YSb;
    int *rE, *rPos, *rSlot; float* rW;
    int* slotTok;
    bf16_t* ACT;
    float* YS;
};

constexpr size_t al256(size_t v) { return (v + 255) & ~(size_t)255; }
constexpr size_t OFF_CNT = 0;
constexpr size_t OFF_BAR = 4096, CTL_BYTES = 4096 + 16384;
constexpr size_t OFF_MOD = CTL_BYTES;
constexpr size_t OFF_ROPE = al256(OFF_MOD + (size_t)2 * (NB + 1) * 6 * D * 4);
constexpr size_t OFF_LORA = al256(OFF_ROPE + 64 * 16 * 2 * 4);
constexpr size_t OFF_WRT = al256(OFF_LORA + (size_t)(2 * 256 * 64 * 2 + 256 * 160) * 2);
constexpr size_t OFF_LG = al256(OFF_WRT + (size_t)2 * 128 * D * 2);
constexpr size_t OFF_WIN = al256(OFF_LG + (size_t)(T / 32) * 32 * 4);
constexpr size_t OFF_WOUT = al256(OFF_WIN + (size_t)NINP * D * 2);
constexpr size_t OFF_WGU = al256(OFF_WOUT + (size_t)D * DMIX * 2);
constexpr size_t OFF_WD = al256(OFF_WGU + (size_t)NEXP * 2 * DE * D * 2);
constexpr size_t OFF_H = al256(OFF_WD + (size_t)NEXP * D * DE * 2);
constexpr size_t OFF_Z = al256(OFF_H + (size_t)(T + 1) * D * 2);
constexpr int PU = L + S;
constexpr int SEGLEN = 144, NSG = (L + S) / SEGLEN;
#ifndef HOST_EMU
static_assert((L + S) % SEGLEN == 0 && SEGLEN % 16 == 0 && L % 16 == 0 && S % 16 == 0, "16-token output tiles must not straddle scan segments");
static_assert((size_t)3 * 64 * NSG * 4096 * 4 <= (size_t)NEXP * 2 * DE * D * 2, "scan segment states overlay wgu_t");
#endif
constexpr size_t OFF_VT = al256(OFF_Z + (size_t)T * 2976 * 2);
constexpr size_t OFF_S = al256(OFF_VT + (size_t)NB * 8 * 64 * PU * 2);
constexpr size_t S1 = (size_t)T * 256 * 4;
#ifdef HOST_EMU
constexpr int NSTREAM = 10;
#else
constexpr int NSTREAM = 9;
#endif
constexpr size_t OFF_Y = al256(OFF_S + NSTREAM * S1);
constexpr size_t OFF_MIX = al256(OFF_Y + 2 * S1);
constexpr size_t OFF_XC = al256(OFF_MIX + (size_t)T * 1024 * 2);
constexpr size_t OFF_ROUTE = al256(OFF_XC + (size_t)TC * D * 4);
constexpr size_t OFF_SLOTTOK = al256(OFF_ROUTE + (size_t)T * 2 * 4 * 4);
constexpr size_t WS_NEED = al256(OFF_SLOTTOK + (size_t)NSLOT * 4);
static_assert((size_t)NSLOT * DE * 2 <= (size_t)T * 2976 * 2 && (size_t)T * D * 2 <= (size_t)T * 2976 * 2, "ACT / HLO overlay Z");
static_assert((size_t)T * 4 * 4 + (size_t)T * 416 * 2 <= S1, "kN + LA overlay Y[1]");
#ifdef HOST_EMU
static_assert((size_t)NSLOT * D * 4 <= NSTREAM * S1 && (size_t)T * D * 4 <= NSTREAM * S1, "YS / O overlay the stream buffers");
#else
static_assert((size_t)NSLOT * D * 2 <= NSTREAM * S1 && (size_t)T * D * 2 <= NSTREAM * S1, "YSb / O overlay the stream buffers");
#endif

static Params make_params(void* const* d_in, void* d_out, void* d_ws) {
    Params p{};
    const float** f = (const float**)&p.x;
    for (int i = 0; i < 32; ++i) f[i] = (const float*)d_in[i];
    p.out = (float*)d_out;
    char* w = (char*)d_ws;
    p.cnt = (int*)(w + OFF_CNT); p.bar = (unsigned*)(w + OFF_BAR); p.mod = (float*)(w + OFF_MOD); p.rope = (float*)(w + OFF_ROPE);
    p.win_t = (bf16_t*)(w + OFF_WIN); p.wout_t = (bf16_t*)(w + OFF_WOUT); p.wgu_t = (bf16_t*)(w + OFF_WGU); p.wd_t = (bf16_t*)(w + OFF_WD);
    p.wrt = (bf16_t*)(w + OFF_WRT); p.hist = (int*)(w + OFF_LG); p.HLO = (bf16_t*)(w + OFF_Z);
    p.wupT = (bf16_t*)(w + OFF_LORA); p.aupT = p.wupT + 2 * 256 * 64; p.gupT = p.aupT + 2 * 256 * 64;
    p.H = (bf16_t*)(w + OFF_H); p.Z = (bf16_t*)(w + OFF_Z); p.VT = (bf16_t*)(w + OFF_VT);
    float* s = (float*)(w + OFF_S); const size_t n1 = (size_t)T * 256;
    p.sR = s; p.sV = s + n1; p.sKK = s + 2 * n1; p.sW = s + 3 * n1; p.sKD = s + 5 * n1; p.sB = s + 7 * n1; p.sG = s + 9 * n1;
    p.Y = (float*)(w + OFF_Y); p.MIX = (bf16_t*)(w + OFF_MIX); p.XC = (float*)(w + OFF_XC);
    p.O = (bf16_t*)(w + OFF_S); p.YSb = (bf16_t*)(w + OFF_S);
    p.PV = (float*)(w + OFF_H); p.QS = (float*)(w + OFF_WGU); p.PS = p.QS + (size_t)64 * NSG * 4096; p.SS = p.PS + (size_t)64 * NSG * 4096;
    p.kT = p.Y; p.kN = p.Y + (size_t)T * 256; p.LA = (bf16_t*)(p.Y + (size_t)T * 256 + (size_t)T * 4);
    int* r = (int*)(w + OFF_ROUTE); p.rE = r; p.rPos = r + 2 * T; p.rSlot = r + 4 * T; p.rW = (float*)(r + 6 * T);
    p.slotTok = (int*)(w + OFF_SLOTTOK);
    p.ACT = (bf16_t*)(w + OFF_Z); p.YS = (float*)(w + OFF_S);
    return p;
}

#ifdef HOST_EMU
__device__ void ph_prep_w(const Params& p, int l, long gtid, long gsz) {
    for (long i = gtid; i < (long)D * NINP; i += gsz) {
        const int k = (int)(i / NINP), n = (int)(i % NINP);
        float v = 0.f;
        if (n < N_IN) { const int oc = (n < ZA) ? n + A_IN : n - ZA; v = p.w_in[((size_t)l * D + k) * N_IN + oc]; }
        p.win_t[(size_t)n * D + k] = f2bf(v);
    }
    for (long i = gtid; i < (long)DMIX * D; i += gsz) {
        const int k = (int)(i / D), n = (int)(i % D);
        p.wout_t[(size_t)n * DMIX + k] = f2bf(p.w_out[((size_t)l * DMIX + k) * D + n]);
    }
    for (long i = gtid; i < (long)NEXP * D * 2 * DE; i += gsz) {
        const int rho = (int)(i % (2 * DE)); const long t = i / (2 * DE); const int k = (int)(t % D), e = (int)(t / D);
        const int q = rho >> 5, half = (rho >> 4) & 1, ii = rho & 15, cc = 16 * q + ii;
        const float* src = half ? p.w_up : p.w_gate;
        p.wgu_t[((size_t)e * 2 * DE + rho) * D + k] = f2bf(src[(((size_t)l * NEXP + e) * D + k) * DE + cc]);
    }
    for (long i = gtid; i < (long)NEXP * DE * D; i += gsz) {
        const int n = (int)(i % D); const long t = i / D; const int k = (int)(t % DE), e = (int)(t / DE);
        p.wd_t[((size_t)e * D + n) * DE + k] = f2bf(p.w_down[(((size_t)l * NEXP + e) * DE + k) * D + n]);
    }
}
#endif
__device__ __forceinline__ void ph_prep_misc(const Params& p, int l, long gtid, long gsz, bool do_mod = true) {
    if (l == 0 && do_mod) for (long i = gtid; i < (long)2 * (NB + 1) * 6 * D; i += gsz) {
        const int j = (int)(i % (6 * D)), b = (int)((i / (6 * D)) % (NB + 1)), ll = (int)(i / ((long)6 * D * (NB + 1)));
        const float* cv = (b < NB) ? p.c + (size_t)b * D : p.c_ctx;
        float acc = 0.f;
        for (int k = 0; k < D; ++k) acc += siluf_(cv[k]) * p.w_mod[((size_t)ll * D + k) * 6 * D + j];
        p.mod[((size_t)ll * (NB + 1) + b) * 6 * D + j] = acc + p.b_mod[(size_t)ll * 6 * D + j];
    }
    if (l == 0) for (long i = gtid; i < 64 * 16; i += gsz) {
        const int pos = (int)(i / 16), fi = (int)(i % 16);
        const float inv = powf(10000.0f, -(float)fi / 16.0f), ang = (float)pos * inv;
        p.rope[i] = cosf(ang); p.rope[1024 + i] = sinf(ang);
    }
    for (long i = gtid; i < NEXP; i += gsz) p.cnt[l * NEXP + i] = 0;
    for (long i = gtid; i < NSLOT; i += gsz) p.slotTok[i] = T;
    for (long i = gtid; i < D; i += gsz) p.H[(size_t)T * D + i] = 0;
}

__device__ __forceinline__ const float* xrow_in(const Params& p, int l, int m) {
    if (m < TL) return (l == 0 ? p.x : p.out) + (size_t)m * D;
    return (l == 0 ? p.ctx : p.XC) + (size_t)(m - TL) * D;
}
__device__ __forceinline__ const float* modrow(const Params& p, int l, int m) { return p.mod + ((size_t)l * (NB + 1) + (m < TL ? m / S : NB)) * 6 * D; }

__device__ void ph_lnmod(const Params& p, int l, long gtid, long gsz) {
    for (long m = gtid; m < T; m += gsz) {
        const float* xr = xrow_in(p, l, (int)m); const float* md = modrow(p, l, (int)m);
        float s = 0.f; for (int j = 0; j < D; ++j) s += xr[j];
        const float mu = s / D; float q = 0.f;
        for (int j = 0; j < D; ++j) { const float d = xr[j] - mu; q += d * d; }
        const float rstd = 1.0f / sqrtf(q / D + LN_EPS);
        for (int j = 0; j < D; ++j) p.H[(size_t)m * D + j] = f2bf((xr[j] - mu) * rstd * (1.0f + md[D + j]) + md[j]);
    }
}

__device__ __forceinline__ float zshift(const Params& p, int l, int m, int col) {
    int t, len;
    if (m < TL) { t = m % S; len = S; } else { t = (m - TL) % L; len = L; }
    const float* sh = p.a_shift + (size_t)l * 3 * A_IN;
    const bf16_t* z = p.Z + (size_t)m * ZP + ZA + col;
    float v = sh[A_IN + col] * bf2f(z[0]);
    if (t > 0) v += sh[col] * bf2f(z[-ZP]);
    if (t < len - 1) v += sh[2 * A_IN + col] * bf2f(z[ZP]);
    return v;
}

__device__ void ph_streams(const Params& p, int l, long gtid, long gsz) {
    for (long i = gtid; i < (long)T * DA; i += gsz) {
        const int m = (int)(i / DA), c = (int)(i % DA), h0 = c & ~63;
        const float r = zshift(p, l, m, c), k = zshift(p, l, m, 256 + c), v = zshift(p, l, m, 512 + c);
        float nrm = 0.f;
        for (int j = 0; j < 64; ++j) { const float t = zshift(p, l, m, 256 + h0 + j) * p.a_k_k[l * DA + h0 + j]; nrm += t * t; }
        const float kk = k * p.a_k_k[l * DA + c] / sqrtf(nrm + 1e-12f);
        float g = 0.f;
        for (int j = 0; j < 160; ++j) g += sigmoidf_(zshift(p, l, m, 1024 + j)) * p.a_g_up[((size_t)l * 160 + j) * DA + c];
        const size_t o = (size_t)m * DA + c;
        p.sR[o] = r; p.sV[o] = v; p.sKK[o] = kk; p.sG[o] = g;
        for (int d = 0; d < 2; ++d) {
            float aw = 0.f, aa = 0.f;
            for (int j = 0; j < 64; ++j) {
                aw += tanhf(zshift(p, l, m, 768 + d * 64 + j)) * p.a_w_up[(((size_t)l * 2 + d) * 64 + j) * DA + c];
                aa += zshift(p, l, m, 896 + d * 64 + j) * p.a_a_up[(((size_t)l * 2 + d) * 64 + j) * DA + c];
            }
            const float u = -(p.a_w0[(l * 2 + d) * DA + c] + aw);
            const float sp = (u > 20.f) ? u : log1pf(expf(u));
            const float w = expf(-expf(-sp - 0.5f));
            const float a = sigmoidf_(p.a_a0[(l * 2 + d) * DA + c] + aa);
            const size_t od = ((size_t)d * T + m) * DA + c;
            p.sW[od] = w; p.sKD[od] = k * (1.0f + (a - 1.0f) * p.a_k_a[l * DA + c]); p.sB[od] = kk * a;
        }
    }
}

__device__ __forceinline__ void ph_rope(const Params& p, long gtid, long gsz) {
    for (long i = gtid; i < (long)TL * 8 * 32; i += gsz) {
        const int pr = (int)(i & 31), hs = (int)((i >> 5) & 7), m = (int)(i >> 8);
        const int t = m % S, axis = pr >> 4, fi = pr & 15, pos = axis ? (t % GRID_W) : (t / GRID_W);
        bf16_t* z = p.Z + (size_t)m * ZP + hs * 64 + axis * 32 + fi;
        const float cs = p.rope[pos * 16 + fi], sn = p.rope[1024 + pos * 16 + fi];
        const float x0 = bf2f(z[0]), x1 = bf2f(z[16]);
        z[0] = f2bf(x0 * cs - x1 * sn); z[16] = f2bf(x1 * cs + x0 * sn);
    }
}

__device__ void ph_scan(const Params& p, long gtid, long gsz) {
    for (long i = gtid; i < (long)2 * NB * 4 * 64; i += gsz) {
        const int v = (int)(i & 63), h = (int)((i >> 6) & 3), b = (int)((i >> 8) % NB), d = (int)((i >> 8) / NB);
        float st[64];
#pragma unroll
        for (int k = 0; k < 64; ++k) st[k] = 0.f;
        for (int pos = 0; pos < L + S; ++pos) {
            int m;
            if (pos < L) m = TL + b * L + (d ? L - 1 - pos : pos);
            else m = b * S + (d ? S - 1 - (pos - L) : pos - L);
            const size_t o = (size_t)m * DA + h * 64, od = ((size_t)d * T + m) * DA + h * 64;
            const float* kk = p.sKK + o; const float* r = p.sR + o;
            const float* w = p.sW + od; const float* bb = p.sB + od; const float* kd = p.sKD + od;
            const float vv = p.sV[o + v];
            float sk = 0.f;
#pragma unroll
            for (int k = 0; k < 64; ++k) sk += st[k] * kk[k];
            float y = 0.f;
#pragma unroll
            for (int k = 0; k < 64; ++k) { st[k] = st[k] * w[k] - sk * bb[k] + vv * kd[k]; y += st[k] * r[k]; }
            p.Y[od + v] = y;
        }
    }
}

__device__ void ph_rwkv_out(const Params& p, int l, int nrows, long gtid, long gsz) {
    for (long i = gtid; i < (long)nrows * 4; i += gsz) {
        const int m = (int)(i >> 2), h = (int)(i & 3);
        const size_t o = (size_t)m * DA + h * 64;
        const float* y0 = p.Y + o; const float* y1 = p.Y + (size_t)T * DA + o;
        float s = 0.f, bon = 0.f;
        for (int n = 0; n < 64; ++n) {
            s += y0[n] + y1[n];
            bon += p.sR[o + n] * (p.sKD[o + n] + p.sKD[(size_t)T * DA + o + n]) * p.a_r_k[l * DA + h * 64 + n];
        }
        const float mu = s / 64.f; float q = 0.f;
        for (int n = 0; n < 64; ++n) { const float dd = y0[n] + y1[n] - mu; q += dd * dd; }
        const float rstd = 1.0f / sqrtf(q / 64.f + GN_EPS);
        for (int n = 0; n < 64; ++n) {
            const int c = h * 64 + n;
            const float yn = (y0[n] + y1[n] - mu) * rstd * p.a_lnx_g[l * DA + c] + p.a_lnx_b[l * DA + c];
            p.MIX[(size_t)m * DMIX + c] = f2bf((yn + bon * p.sV[o + n]) * p.sG[o + n]);
        }
    }
}

#ifdef HOST_EMU
__device__ __forceinline__ void att_key(const float (&q)[64], const bf16_t* kr, const bf16_t* vr, float bias, float& mx, float& ls, float (&acc)[64]) {
    float s = 0.f;
#pragma unroll
    for (int d = 0; d < 64; ++d) s += q[d] * bf2f(kr[d]);
    s = s * ATT_SCALE + bias;
    const float mn = fmaxf(mx, s), f = expf(mx - mn), pe = expf(s - mn);
    ls = ls * f + pe;
#pragma unroll
    for (int d = 0; d < 64; ++d) acc[d] = acc[d] * f + pe * bf2f(vr[d]);
    mx = mn;
}

__device__ void ph_attn(const Params& p, int l, int nrows, long gtid, long gsz) {
    for (long i = gtid; i < (long)nrows * 12; i += gsz) {
        const int m = (int)(i / 12), u = (int)(i % 12);
        const bool isB = u < 6; const int hq = isB ? u : u - 6;
        const int b = (m < TL) ? m / S : (m - TL) / L;
        const int qcol = isB ? ZQB + hq * 64 : ZQN + hq * 64;
        const int kcol = isB ? ZKB + (hq / 3) * 64 : ZKN + hq * 64;
        const int vcol = isB ? ZVB + (hq / 3) * 64 : ZVN + hq * 64;
        float q[64], acc[64];
        const bf16_t* qr = p.Z + (size_t)m * ZP + qcol;
#pragma unroll
        for (int d = 0; d < 64; ++d) { q[d] = bf2f(qr[d]); acc[d] = 0.f; }
        float mx, ls;
        if (isB) { mx = p.b_sink[l * 6 + hq]; ls = 1.0f; } else { mx = -1e30f; ls = 0.f; }
        for (int j = 0; j < L; ++j) { const bf16_t* zr = p.Z + (size_t)(TL + b * L + j) * ZP; att_key(q, zr + kcol, zr + vcol, 0.f, mx, ls, acc); }
        if (m < TL) {
            const int t = m % S;
            if (isB) {
                const int j0 = t - 128 < 0 ? 0 : t - 128, j1 = t + 128 > S - 1 ? S - 1 : t + 128;
                for (int j = j0; j <= j1; ++j) { const bf16_t* zr = p.Z + (size_t)(b * S + j) * ZP; att_key(q, zr + kcol, zr + vcol, 0.f, mx, ls, acc); }
            } else {
                const int rows = S / GRID_W, r = t / GRID_W, c = t % GRID_W;
                int r0 = r - 4; r0 = r0 < 0 ? 0 : (r0 > rows - 8 ? rows - 8 : r0);
                int c0 = c - 8; c0 = c0 < 0 ? 0 : (c0 > GRID_W - 16 ? GRID_W - 16 : c0);
                for (int a = 0; a < 8; ++a)
                    for (int e = 0; e < 16; ++e) {
                        const int kr = r0 + a, kc = c0 + e;
                        const float bias = p.c_rpb[(((size_t)l * 6 + hq) * 15 + (kr - r + 7)) * 31 + (kc - c + 15)];
                        const bf16_t* zr = p.Z + (size_t)(b * S + kr * GRID_W + kc) * ZP;
                        att_key(q, zr + kcol, zr + vcol, bias, mx, ls, acc);
                    }
            }
        }
        const float inv = 1.0f / ls;
        bf16_t* o = p.MIX + (size_t)m * DMIX + (isB ? 256 : 640) + hq * 64;
#pragma unroll
        for (int d = 0; d < 64; ++d) o[d] = f2bf(acc[d] * inv);
    }
}

#endif
__device__ void ph_post_mixer(const Params& p, int l, int nrows, long gtid, long gsz) {
    for (long mm = gtid; mm < nrows; mm += gsz) {
        const int m = (int)mm;
        const float* xr = xrow_in(p, l, m); const float* md = modrow(p, l, m); const float* orow = (const float*)p.O + (size_t)m * D;
        float* x1 = (m < TL) ? p.out + (size_t)m * D : p.XC + (size_t)(m - TL) * D;
        const float* g1 = p.ln1_g + (size_t)l * D; const float* b1 = p.ln1_b + (size_t)l * D;
        float s = 0.f; for (int j = 0; j < D; ++j) s += ALPHA * xr[j] + md[2 * D + j] * orow[j];
        float mu = s / D, q = 0.f;
        for (int j = 0; j < D; ++j) { const float d = ALPHA * xr[j] + md[2 * D + j] * orow[j] - mu; q += d * d; }
        float rstd = 1.0f / sqrtf(q / D + LN_EPS);
        s = 0.f;
        for (int j = 0; j < D; ++j) { const float v = (ALPHA * xr[j] + md[2 * D + j] * orow[j] - mu) * rstd * g1[j] + b1[j]; x1[j] = v; s += v; }
        mu = s / D; q = 0.f;
        for (int j = 0; j < D; ++j) { const float d = x1[j] - mu; q += d * d; }
        rstd = 1.0f / sqrtf(q / D + LN_EPS);
        float gl[4], el[32];
#pragma unroll
        for (int g = 0; g < 4; ++g) gl[g] = p.b_rg[l * 4 + g];
#pragma unroll
        for (int e = 0; e < 32; ++e) el[e] = p.b_re[l * 32 + e];
        for (int j = 0; j < D; ++j) {
            const float hv = (x1[j] - mu) * rstd * (1.0f + md[4 * D + j]) + md[3 * D + j];
            p.H[(size_t)m * D + j] = f2bf(hv);
            const float* wg = p.w_rg + ((size_t)l * D + j) * 4; const float* we = p.w_re + ((size_t)l * D + j) * 32;
#pragma unroll
            for (int g = 0; g < 4; ++g) gl[g] += hv * wg[g];
#pragma unroll
            for (int e = 0; e < 32; ++e) el[e] += hv * we[e];
        }
        int gs = 0; float gm = gl[0];
#pragma unroll
        for (int g = 1; g < 4; ++g) if (gl[g] > gm) { gm = gl[g]; gs = g; }
        float den = 0.f;
#pragma unroll
        for (int g = 0; g < 4; ++g) den += expf(gl[g] - gm);
        const float pg = 1.0f / den;
        float v1 = -3e38f, v2 = -3e38f; int i1 = 0, i2 = 0;
#pragma unroll
        for (int j = 0; j < 8; ++j) {
            const float v = gs == 0 ? el[j] : gs == 1 ? el[8 + j] : gs == 2 ? el[16 + j] : el[24 + j];
            if (v > v1) { v2 = v1; i2 = i1; v1 = v; i1 = j; } else if (v > v2) { v2 = v; i2 = j; }
        }
        const float e2 = expf(v2 - v1), w1 = pg / (1.0f + e2), w2 = pg * e2 / (1.0f + e2);
        const int ea = gs * 8 + i1, eb = gs * 8 + i2;
        p.rE[2 * m] = ea; p.rE[2 * m + 1] = eb; p.rW[2 * m] = w1; p.rW[2 * m + 1] = w2;
        p.rPos[2 * m] = atomic_inc_int(p.cnt + l * NEXP + ea); p.rPos[2 * m + 1] = atomic_inc_int(p.cnt + l * NEXP + eb);
    }
}

__device__ __forceinline__ int pstart_of(const int* cnt, int e) {
    int s = 0;
    for (int j = 0; j < NEXP; ++j) if (j < e) s += (cnt[j] + 127) & ~127;
    return s;
}
__device__ __forceinline__ void ph_dispatch(const Params& p, int l, int nrows, long gtid, long gsz) {
    for (long i = gtid; i < (long)nrows * 2; i += gsz) {
        const int slot = pstart_of(p.cnt + l * NEXP, p.rE[i]) + p.rPos[i];
        p.rSlot[i] = slot; p.slotTok[slot] = (int)(i >> 1);
    }
}

__device__ void ph_final(const Params& p, int l, int nrows, long gtid, long gsz) {
    for (long mm = gtid; mm < nrows; mm += gsz) {
        const int m = (int)mm;
        float* x1 = (m < TL) ? p.out + (size_t)m * D : p.XC + (size_t)(m - TL) * D;
        const float* md = modrow(p, l, m);
        const float* ya = p.YS + (size_t)p.rSlot[2 * m] * D; const float* yb = p.YS + (size_t)p.rSlot[2 * m + 1] * D;
        const float wa = p.rW[2 * m], wb = p.rW[2 * m + 1];
        const float* g2 = p.ln2_g + (size_t)l * D; const float* b2 = p.ln2_b + (size_t)l * D;
        float s = 0.f; for (int j = 0; j < D; ++j) s += ALPHA * x1[j] + md[5 * D + j] * (wa * ya[j] + wb * yb[j]);
        const float mu = s / D; float q = 0.f;
        for (int j = 0; j < D; ++j) { const float d = ALPHA * x1[j] + md[5 * D + j] * (wa * ya[j] + wb * yb[j]) - mu; q += d * d; }
        const float rstd = 1.0f / sqrtf(q / D + LN_EPS);
        for (int j = 0; j < D; ++j) x1[j] = (ALPHA * x1[j] + md[5 * D + j] * (wa * ya[j] + wb * yb[j]) - mu) * rstd * g2[j] + b2[j];
    }
}

__device__ __forceinline__ int moe_blocks(const int* cnt) { int s = 0; for (int j = 0; j < NEXP; ++j) s += (cnt[j] + 127) >> 7; return s; }
__device__ __forceinline__ int moe_block_expert(const int* cnt, int rb) {
    int s = 0, e = 0;
    for (int j = 0; j < NEXP; ++j) { const int nb = (cnt[j] + 127) >> 7; if (rb >= s && rb < s + nb) e = j; s += nb; }
    return e;
}

#ifdef HOST_EMU
static void host_gemm_in(const Params& p) {
    for (int m = 0; m < T; ++m) for (int n = 0; n < ZP; ++n) { float a = 0.f; for (int k = 0; k < D; ++k) a += bf2f(p.H[(size_t)m * D + k]) * bf2f(p.win_t[(size_t)n * D + k]); p.Z[(size_t)m * ZP + n] = f2bf(a); }
}
static void host_gemm_out(const Params& p, int nrows) {
    for (int m = 0; m < nrows; ++m) for (int n = 0; n < D; ++n) { float a = 0.f; for (int k = 0; k < DMIX; ++k) a += bf2f(p.MIX[(size_t)m * DMIX + k]) * bf2f(p.wout_t[(size_t)n * DMIX + k]); ((float*)p.O)[(size_t)m * D + n] = a; }
}
static void host_moe1(const Params& p, int l) {
    const int* cnt = p.cnt + l * NEXP; const int nrb = moe_blocks(cnt);
    for (int rb = 0; rb < nrb; ++rb) { const int e = moe_block_expert(cnt, rb);
        for (int r = 0; r < 128; ++r) { const int slot = rb * 128 + r; const bf16_t* a = p.H + (size_t)p.slotTok[slot] * D;
            for (int c = 0; c < DE; ++c) { const int q = c >> 4, ii = c & 15; float g = 0.f, u = 0.f;
                const bf16_t* wg = p.wgu_t + ((size_t)e * 2 * DE + 32 * q + ii) * D; const bf16_t* wu = wg + (size_t)16 * D;
                for (int k = 0; k < D; ++k) { g += bf2f(a[k]) * bf2f(wg[k]); u += bf2f(a[k]) * bf2f(wu[k]); }
                p.ACT[(size_t)slot * DE + c] = f2bf(siluf_(g) * u); } } }
}
static void host_moe2(const Params& p, int l) {
    const int* cnt = p.cnt + l * NEXP; const int nrb = moe_blocks(cnt);
    for (int rb = 0; rb < nrb; ++rb) { const int e = moe_block_expert(cnt, rb);
        for (int r = 0; r < 128; ++r) { const int slot = rb * 128 + r;
            for (int n = 0; n < D; ++n) { float a = 0.f; const bf16_t* w = p.wd_t + ((size_t)e * D + n) * DE;
                for (int k = 0; k < DE; ++k) a += bf2f(p.ACT[(size_t)slot * DE + k]) * bf2f(w[k]);
                p.YS[(size_t)slot * D + n] = a; } } }
}
#else
typedef short bf16x8 __attribute__((ext_vector_type(8)));
typedef float f32x4 __attribute__((ext_vector_type(4)));
#define VGRID ((int)gridDim.x * 2)
__device__ __forceinline__ int opq_tid() { int t = threadIdx.x & 255; asm volatile("" : "+v"(t)); return t; }
__device__ __forceinline__ int opq_bid() { int b = 2 * blockIdx.x + __builtin_amdgcn_readfirstlane(threadIdx.x >> 8); asm volatile("" : "+s"(b)); return b; }
__device__ __forceinline__ unsigned pk2(float lo, float hi) { return (unsigned)f2bf(lo) | ((unsigned)f2bf(hi) << 16); }
struct u32x2_t { unsigned x, y; };
__device__ __forceinline__ void st_bf16x4(bf16_t* dst, f32x4 v) { u32x2_t o; o.x = pk2(v[0], v[1]); o.y = pk2(v[2], v[3]); *(u32x2_t*)dst = o; }
template <bool SWAP = true, class Epi>
__device__ __forceinline__ void gemm_tile(const bf16_t* a0, const bf16_t* a1, const bf16_t* b0, const bf16_t* b1, int K, char* lds, const Epi& epi) {
    const int tid = opq_tid(), wid = tid >> 6, lane = tid & 63, wr = wid >> 1, wc = wid & 1, fr = lane & 15, fq = lane >> 4;
    f32x4 acc[4][4];
#pragma unroll
    for (int m = 0; m < 4; ++m)
#pragma unroll
        for (int n = 0; n < 4; ++n) acc[m][n] = (f32x4){0.f, 0.f, 0.f, 0.f};
#define GT_STAGE(st_, kt_) do { char* sa_ = lds + (st_) * 16384 + tid * 16; \
        __builtin_amdgcn_global_load_lds((const unsigned*)(a0 + (kt_)), (__attribute__((address_space(3))) unsigned*)(sa_), 16, 0, 0); \
        __builtin_amdgcn_global_load_lds((const unsigned*)(a1 + (kt_)), (__attribute__((address_space(3))) unsigned*)(sa_ + 4096), 16, 0, 0); \
        __builtin_amdgcn_global_load_lds((const unsigned*)(b0 + (kt_)), (__attribute__((address_space(3))) unsigned*)(sa_ + 8192), 16, 0, 0); \
        __builtin_amdgcn_global_load_lds((const unsigned*)(b1 + (kt_)), (__attribute__((address_space(3))) unsigned*)(sa_ + 12288), 16, 0, 0); } while (0)
    const int fsw = (0 - (fr >> 2)) & 3;
    const int aoff = (wr * 64 + fr) * 64 + ((fq ^ fsw) * 16), boff = 8192 + (wc * 64 + fr) * 64 + ((fq ^ fsw) * 16);
    const int nk = K / 32;
    GT_STAGE(0, 0);
    if (nk > 1) GT_STAGE(1, 32);
    if (nk > 2) GT_STAGE(2, 64);
    for (int t = 0; t < nk; ++t) {
        if (t + 2 < nk) asm volatile("s_waitcnt vmcnt(8)" ::: "memory"); else if (t + 1 < nk) asm volatile("s_waitcnt vmcnt(4)" ::: "memory"); else asm volatile("s_waitcnt vmcnt(0)" ::: "memory");
        asm volatile("s_waitcnt lgkmcnt(0)" ::: "memory");
        __builtin_amdgcn_s_barrier();
        if (t + 3 < nk) GT_STAGE((t + 3) & 3, (t + 3) * 32);
        const char* sb = lds + (t & 3) * 16384;
        bf16x8 At[4], Bt[4];
#pragma unroll
        for (int m = 0; m < 4; ++m) At[m] = *(const bf16x8*)(sb + aoff + m * 1024);
#pragma unroll
        for (int n = 0; n < 4; ++n) Bt[n] = *(const bf16x8*)(sb + boff + n * 1024);
#pragma unroll
        for (int m = 0; m < 4; ++m)
#pragma unroll
            for (int n = 0; n < 4; ++n) acc[m][n] = SWAP ? __builtin_amdgcn_mfma_f32_16x16x32_bf16(Bt[n], At[m], acc[m][n], 0, 0, 0) : __builtin_amdgcn_mfma_f32_16x16x32_bf16(At[m], Bt[n], acc[m][n], 0, 0, 0);
    }
    asm volatile("s_waitcnt lgkmcnt(0)" ::: "memory");
    __builtin_amdgcn_s_barrier();
#undef GT_STAGE
    epi(acc, wr, wc, fr, fq);
}
#define STG_ROW(i) ((tid_ + (i) * 256) >> 2)
#define STG_K ((((tid_ & 3) ^ ((0 - (tid_ >> 4)) & 3))) * 8)

__device__ __forceinline__ f32x4 ld_bf16x4(const bf16_t* src) { const u32x2_t w = *(const u32x2_t*)src; return (f32x4){__uint_as_float(w.x << 16), __uint_as_float(w.x & 0xffff0000u), __uint_as_float(w.y << 16), __uint_as_float(w.y & 0xffff0000u)}; }
#define G8_LAS __attribute__((address_space(3)))
namespace g8 {
constexpr int BM = 256, BK = 64, HALF = 128, HTB = HALF * BK * 2;
__device__ __forceinline__ int lds_byte(int r, int c) { const int st = (r >> 4) * 2 + (c >> 5), rr = r & 15, cc = c & 31, ob = rr * 64 + cc * 2; return st * 1024 + (ob ^ (((ob >> 9) & 1) << 5)); }
__device__ __forceinline__ void stage_rc(int b, int& R, int& C) { const int st = b / 1024, sb = b % 1024, swz = sb ^ (((sb >> 9) & 1) << 5); R = (st >> 1) * 16 + swz / 64; C = (st & 1) * 32 + (swz % 64) / 2; }
struct Unit { const char* A; const char* B; int r0, c0, tag; };
__device__ __forceinline__ int xcd_pos(int wgid, int nwg) { const int q = nwg / 8, r = nwg % 8, xcd = wgid % 8, off = wgid / 8; return (xcd < r ? xcd * (q + 1) : r * (q + 1) + (xcd - r) * q) + off; }
__device__ __forceinline__ void order2d(int wgid, int nM, int nN, int& pm, int& pn) {
    wgid = xcd_pos(wgid, nM * nN);
    const int nig = 8 * nN, gid = wgid / nig, fm = gid * 8, gsz = (nM - fm) < 8 ? (nM - fm) : 8;
    pm = fm + ((wgid % nig) % gsz); pn = (wgid % nig) / gsz;
}
}
template <int K, bool GATHER, class Sched, class Epi>
__device__ __forceinline__ void gemm8(char* lds_raw, const Sched& S, const Epi& E, const int* gidx) {
    using namespace g8;
    G8_LAS unsigned char* lds = (G8_LAS unsigned char*)lds_raw;
    int tid = threadIdx.x; asm volatile("" : "+v"(tid));
    const int wid = __builtin_amdgcn_readfirstlane(tid >> 6), lane = tid & 63, wr = wid >> 2, wc = wid & 3, fr = lane & 15, fq = lane >> 4;
    constexpr int nt = K / BK;
    static_assert(K % 128 == 0 && K >= 256 && (K & (K - 1)) == 0, "K-tiles are consumed in pairs; the gather path masks with K * 2 - 1");
    static_assert(T + 1 <= 65536, "gathered row ids are packed in 16 bits");
    unsigned voffB[2];
#pragma unroll
    for (int i = 0; i < 2; ++i) { int R, C; stage_rc(tid * 16 + i * 8192, R, C); voffB[i] = (unsigned)(R * K + C) * 2u; }
    unsigned gpk[2] = {0u, 0u};
    constexpr size_t kstep = (size_t)(BK * 2), hstep = (size_t)HALF * K * 2;
    const unsigned ldsw = (unsigned)wid * 1024u;
    const int aoff = lds_byte(wr * 64 + fr, fq * 8), boff = lds_byte(wc * 32 + fr, fq * 8);
#define G8_SA(b, h) (((b) * 2 + (h)) * HTB)
#define G8_SB(b, h) ((4 + (b) * 2 + (h)) * HTB)
#define G8_STAGE_B(bufoff, gbase) do { _Pragma("unroll") for (int _i = 0; _i < 2; ++_i) \
        __builtin_amdgcn_global_load_lds((const unsigned*)((const char*)(gbase) + voffB[_i]), (G8_LAS unsigned*)(lds + (bufoff) + ldsw + _i * 8192), 16, 0, 0); } while (0)
#define G8_STAGE_A(bufoff, gbase, h, nx) do { _Pragma("unroll") for (int _i = 0; _i < 2; ++_i) { const unsigned _o = GATHER ? ((gpk[_i] >> (16 * (h))) & 0xffffu) * (unsigned)(K * 2) + (voffB[_i] & (unsigned)(K * 2 - 1)) : voffB[_i] + (unsigned)((h) * hstep); \
        __builtin_amdgcn_global_load_lds((const unsigned*)((const char*)(gbase) + _o), (G8_LAS unsigned*)(lds + (bufoff) + ldsw + _i * 8192), 16, 0, 0); } } while (0)
#define G8_LDA(dst, b, h) do { _Pragma("unroll") for (int m = 0; m < 4; ++m) _Pragma("unroll") for (int k = 0; k < 2; ++k) dst[m][k] = *(const G8_LAS bf16x8*)(lds + G8_SA(b, h) + aoff + m * 2048 + k * 1024); } while (0)
#define G8_LDB(dst, b, h) do { _Pragma("unroll") for (int n = 0; n < 2; ++n) _Pragma("unroll") for (int k = 0; k < 2; ++k) dst[n][k] = *(const G8_LAS bf16x8*)(lds + G8_SB(b, h) + boff + n * 2048 + k * 1024); } while (0)
#define G8_MMA(ai, bj, At, Bt) do { __builtin_amdgcn_s_setprio(1); _Pragma("unroll") for (int m = 0; m < 4; ++m) _Pragma("unroll") for (int n = 0; n < 2; ++n) _Pragma("unroll") for (int k = 0; k < 2; ++k) \
        acc[ai][bj][m][n] = __builtin_amdgcn_mfma_f32_16x16x32_bf16(Bt[n][k], At[m][k], acc[ai][bj][m][n], 0, 0, 0); __builtin_amdgcn_s_setprio(0); } while (0)
#define G8_WAIT_V(n) asm volatile("s_waitcnt vmcnt(" #n ")" ::: "memory")
#define G8_WAIT_L(n) asm volatile("s_waitcnt lgkmcnt(" #n ")" ::: "memory")
#define G8_BAR __builtin_amdgcn_s_barrier()
#define G8_SCHED __builtin_amdgcn_sched_barrier(0)
#define G8_GOFF(dst, u) do { int _t = tid; asm volatile("" : "+v"(_t)); _Pragma("unroll") for (int _i = 0; _i < 2; ++_i) { int _R, _C; stage_rc(_t * 16 + _i * 8192, _R, _C); \
        dst[_i] = (unsigned)gidx[(u).r0 + _R] | ((unsigned)gidx[(u).r0 + HALF + _R] << 16); } } while (0)
    Unit cur, nxt; int ui = 0;
    if (!S.next(0, cur)) return;
    f32x4 acc[2][2][4][2];
#pragma unroll
    for (int a = 0; a < 2; ++a)
#pragma unroll
        for (int b = 0; b < 2; ++b)
#pragma unroll
            for (int m = 0; m < 4; ++m)
#pragma unroll
                for (int n = 0; n < 2; ++n) acc[a][b][m][n] = (f32x4){0.f, 0.f, 0.f, 0.f};
    bf16x8 At[4][2], B0[2][2], B1[2][2];
    const char* cA = cur.A; const char* cB = cur.B;
    if (GATHER) G8_GOFF(gpk, cur);
    G8_STAGE_B(G8_SB(0, 0), cB); G8_STAGE_A(G8_SA(0, 0), cA, 0, false); G8_STAGE_B(G8_SB(0, 1), cB + hstep); G8_STAGE_A(G8_SA(0, 1), cA, 1, false);
    if (wr == 1) G8_BAR;
    G8_WAIT_V(4); G8_BAR;
    G8_STAGE_B(G8_SB(1, 0), cB + kstep); G8_STAGE_A(G8_SA(1, 0), cA + kstep, 0, false); G8_STAGE_B(G8_SB(1, 1), cB + hstep + kstep);
    G8_WAIT_V(6); G8_BAR;
    for (;;) {
        const bool has_next = S.next(ui + 1, nxt);
        const char* nA = has_next ? nxt.A : cA; const char* nB = has_next ? nxt.B : cB;
#pragma unroll 1
        for (int t = 0; t < nt; t += 2) {
            const bool last = (t == nt - 2);
            const char* a1 = cA + (size_t)(t + 1) * kstep;
            const char* a2 = last ? nA : cA + (size_t)(t + 2) * kstep; const char* b2 = last ? nB : cB + (size_t)(t + 2) * kstep;
            const char* a3 = a2 + kstep; const char* b3 = b2 + kstep;
            G8_LDB(B0, 0, 0); G8_SCHED; G8_LDA(At, 0, 0); G8_STAGE_A(G8_SA(1, 1), a1, 1, false);
            G8_WAIT_L(8); G8_BAR; G8_WAIT_L(0); G8_MMA(0, 0, At, B0); G8_BAR; G8_SCHED;
            if (GATHER && last && has_next) G8_GOFF(gpk, nxt);
            G8_LDB(B1, 0, 1); G8_STAGE_B(G8_SB(0, 0), b2);
            G8_BAR; G8_WAIT_L(0); G8_MMA(0, 1, At, B1); G8_BAR;
            G8_LDA(At, 0, 1); G8_STAGE_A(G8_SA(0, 0), a2, 0, last);
            G8_BAR; G8_WAIT_L(0); G8_MMA(1, 0, At, B0); G8_BAR; G8_SCHED;
            G8_STAGE_B(G8_SB(0, 1), b2 + hstep);
            G8_WAIT_V(6); G8_BAR; G8_MMA(1, 1, At, B1); G8_BAR;
            G8_LDB(B0, 1, 0); G8_SCHED; G8_LDA(At, 1, 0); G8_STAGE_A(G8_SA(0, 1), a2, 1, last);
            G8_WAIT_L(8); G8_BAR; G8_WAIT_L(0); G8_MMA(0, 0, At, B0); G8_BAR; G8_SCHED;
            G8_LDB(B1, 1, 1); G8_STAGE_B(G8_SB(1, 0), b3);
            G8_BAR; G8_WAIT_L(0); G8_MMA(0, 1, At, B1); G8_BAR;
            G8_LDA(At, 1, 1); G8_STAGE_A(G8_SA(1, 0), a3, 0, last);
            G8_BAR; G8_WAIT_L(0); G8_MMA(1, 0, At, B0); G8_BAR; G8_SCHED;
            G8_STAGE_B(G8_SB(1, 1), b3 + hstep);
            G8_WAIT_V(6); G8_BAR; G8_MMA(1, 1, At, B1); G8_BAR;
        }
        { int efr = fr, efq = fq; asm volatile("" : "+v"(efr), "+v"(efq));
          E(acc, cur, wr, wc, efr, efq); }
        if (!has_next) break;
#pragma unroll
        for (int a = 0; a < 2; ++a)
#pragma unroll
            for (int b = 0; b < 2; ++b)
#pragma unroll
                for (int m = 0; m < 4; ++m)
#pragma unroll
                    for (int n = 0; n < 2; ++n) acc[a][b][m][n] = (f32x4){0.f, 0.f, 0.f, 0.f};
        cur = nxt; cA = nA; cB = nB; ++ui;
    }
    G8_WAIT_V(0);
    if (wr == 0) G8_BAR;
    G8_BAR;
#undef G8_SA
#undef G8_SB
#undef G8_STAGE_A
#undef G8_STAGE_B
#undef G8_LDA
#undef G8_LDB
#undef G8_MMA
#undef G8_WAIT_V
#undef G8_WAIT_L
#undef G8_BAR
#undef G8_SCHED
#undef G8_GOFF
}
__device__ __forceinline__ int real_bid() { int b = blockIdx.x; asm volatile("" : "+s"(b)); return b; }

__device__ __forceinline__ void g_gemm_in(const Params& p, char* lds_all) {
    constexpr int NM = T / 256, NN = NINP / 256, NMAIN = WVB / 256;
    struct Sched { const Params* p; int G, c;
        __device__ __forceinline__ bool next(int i, g8::Unit& u) const {
            const int Lx = i * G + c; if (Lx >= NM * NN) return false;
            int pm, pn; g8::order2d(Lx, NM, NN, pm, pn);
            if (pn < NMAIN) { u.A = (const char*)(p->H + (size_t)pm * 256 * D); u.B = (const char*)(p->win_t + (size_t)pn * 256 * D); u.r0 = pm * 256; u.c0 = pn * 256; u.tag = 0; }
            else { u.A = (const char*)(p->win_t + (size_t)pn * 256 * D); u.B = (const char*)(p->H + (size_t)pm * 256 * D); u.r0 = (pn - NMAIN) * 256; u.c0 = pm * 256; u.tag = 1; }
            return true; } };
    const Sched sch{&p, (int)gridDim.x, real_bid()};
    gemm8<D, false>(lds_all, sch, [&](const f32x4 (&acc)[2][2][4][2], const g8::Unit& u, int wr, int wc, int fr, int fq) {
        if (u.tag == 1) {
#pragma unroll
            for (int ai = 0; ai < 2; ++ai)
#pragma unroll
                for (int m = 0; m < 4; ++m) { const int vc = u.r0 + ai * 128 + wr * 64 + m * 16 + fr;
#pragma unroll
                    for (int bj = 0; bj < 2; ++bj)
#pragma unroll
                        for (int n = 0; n < 2; ++n) { const int m0 = u.c0 + bj * 128 + wc * 32 + n * 16 + 4 * fq; int b, tk;
                            if (m0 < TL) { b = m0 / S; tk = L + m0 % S; } else { b = (m0 - TL) / L; tk = (m0 - TL) % L; }
                            st_bf16x4(p.VT + ((size_t)(b * 8 + (vc >> 6)) * 64 + (vc & 63)) * PU + tk, acc[ai][bj][m][n]); } }
        } else if (u.c0 < ZQN && u.r0 < TL) {
#pragma unroll
            for (int ai = 0; ai < 2; ++ai)
#pragma unroll
                for (int m = 0; m < 4; ++m) { const int row = u.r0 + ai * 128 + wr * 64 + m * 16 + fr, t = row % S;
#pragma unroll
                    for (int bj = 0; bj < 2; ++bj) { const int c32 = u.c0 + bj * 128 + wc * 32, ax = (c32 >> 5) & 1, pos = ax ? t % GRID_W : t / GRID_W;
                        const f32x4 cs = *(const f32x4*)(p.rope + pos * 16 + 4 * fq), sn = *(const f32x4*)(p.rope + 1024 + pos * 16 + 4 * fq);
                        const f32x4 x0 = acc[ai][bj][m][0], x1 = acc[ai][bj][m][1];
                        bf16_t* zr = p.Z + (size_t)row * ZP + c32 + 4 * fq;
                        st_bf16x4(zr, x0 * cs - x1 * sn); st_bf16x4(zr + 16, x1 * cs + x0 * sn); }
                    asm volatile("" ::: "memory"); }
        } else {
#pragma unroll
            for (int ai = 0; ai < 2; ++ai)
#pragma unroll
                for (int m = 0; m < 4; ++m) { bf16_t* zr = p.Z + (size_t)(u.r0 + ai * 128 + wr * 64 + m * 16 + fr) * ZP;
#pragma unroll
                    for (int bj = 0; bj < 2; ++bj)
#pragma unroll
                        for (int n = 0; n < 2; ++n) { const int col = u.c0 + bj * 128 + wc * 32 + n * 16 + 4 * fq; if (col < ZP) st_bf16x4(zr + col, acc[ai][bj][m][n]); } }
        }
    }, nullptr);
}
__device__ __forceinline__ void g_gemm_out(const Params& p, int nrows, char* lds_all) {
    struct Sched { const Params* p; int G, c, nM;
        __device__ __forceinline__ bool next(int i, g8::Unit& u) const {
            const int Lx = i * G + c; if (Lx >= nM * (D / 256)) return false;
            int pm, pn; g8::order2d(Lx, nM, D / 256, pm, pn);
            u.A = (const char*)(p->MIX + (size_t)pm * 256 * DMIX); u.B = (const char*)(p->wout_t + (size_t)pn * 256 * DMIX); u.r0 = pm * 256; u.c0 = pn * 256; u.tag = 0; return true; } };
    const Sched sch{&p, (int)gridDim.x, real_bid(), nrows / 256};
    gemm8<DMIX, false>(lds_all, sch, [&](const f32x4 (&acc)[2][2][4][2], const g8::Unit& u, int wr, int wc, int fr, int fq) {
#pragma unroll
        for (int ai = 0; ai < 2; ++ai)
#pragma unroll
            for (int m = 0; m < 4; ++m) { bf16_t* orow = p.O + (size_t)(u.r0 + ai * 128 + wr * 64 + m * 16 + fr) * D + u.c0 + wc * 32 + 4 * fq;
#pragma unroll
                for (int bj = 0; bj < 2; ++bj)
#pragma unroll
                    for (int n = 0; n < 2; ++n) st_bf16x4(orow + bj * 128 + n * 16, acc[ai][bj][m][n]); }
    }, nullptr);
}
struct SchedMoe { const int* te; int G, c; const char* A; size_t a_tile; const char* W; size_t w_exp, w_pan;
    __device__ __forceinline__ bool next(int i, g8::Unit& u) const {
        const int nU = __builtin_amdgcn_readfirstlane(te[255]) * 4, Lx = i * G + c; if (Lx >= nU) return false;
        const int w = g8::xcd_pos(Lx, nU), rt = w >> 2, pn = w & 3, e = __builtin_amdgcn_readfirstlane(te[rt]);
        u.A = A + (size_t)rt * a_tile; u.B = W + (size_t)e * w_exp + (size_t)pn * w_pan; u.r0 = rt * 256; u.c0 = pn * 256; u.tag = e; return true; } };
__device__ __forceinline__ int* moe_tile_table(const Params& p, int l, char* lds_all) {
    static_assert(2 * T / 256 + NEXP <= 255, "row-tile table");
    int* te = (int*)(lds_all + 131072);
    if (threadIdx.x < 256) { const int rt = threadIdx.x; int s = 0, e = 0;
        for (int j = 0; j < NEXP; ++j) { s += (p.cnt[l * NEXP + j] + 255) >> 8; e += (s <= rt) ? 1 : 0; }
        te[rt] = rt == 255 ? s : (e < NEXP ? e : NEXP - 1); }
    __syncthreads();
    return te;
}
__device__ __forceinline__ void g_moe1(const Params& p, int l, char* lds_all) {
    const int* te = moe_tile_table(p, l, lds_all);
    const SchedMoe sch{te, (int)gridDim.x, real_bid(), (const char*)p.H, 0, (const char*)p.wgu_t, (size_t)2 * DE * D * 2, (size_t)256 * D * 2};
    gemm8<D, true>(lds_all, sch, [&](const f32x4 (&acc)[2][2][4][2], const g8::Unit& u, int wr, int wc, int fr, int fq) {
#pragma unroll
        for (int ai = 0; ai < 2; ++ai)
#pragma unroll
            for (int m = 0; m < 4; ++m) { bf16_t* arow = p.ACT + (size_t)(u.r0 + ai * 128 + wr * 64 + m * 16 + fr) * DE + (u.c0 + wc * 32) / 2 + 4 * fq;
#pragma unroll
                for (int bj = 0; bj < 2; ++bj) {
                    const f32x4 g = acc[ai][bj][m][0], up = acc[ai][bj][m][1]; f32x4 a;
#pragma unroll
                    for (int e4 = 0; e4 < 4; ++e4) a[e4] = g[e4] / (1.0f + __expf(-g[e4])) * up[e4];
                    st_bf16x4(arow + bj * 64, a); } }
    }, p.slotTok);
}
__device__ __forceinline__ void g_moe2(const Params& p, int l, char* lds_all) {
    const int* te = moe_tile_table(p, l, lds_all);
    const SchedMoe sch{te, (int)gridDim.x, real_bid(), (const char*)p.ACT, (size_t)256 * DE * 2, (const char*)p.wd_t, (size_t)D * DE * 2, (size_t)256 * DE * 2};
    gemm8<DE, false>(lds_all, sch, [&](const f32x4 (&acc)[2][2][4][2], const g8::Unit& u, int wr, int wc, int fr, int fq) {
#pragma unroll
        for (int ai = 0; ai < 2; ++ai)
#pragma unroll
            for (int m = 0; m < 4; ++m) { bf16_t* yrow = p.YSb + (size_t)(u.r0 + ai * 128 + wr * 64 + m * 16 + fr) * D + u.c0 + wc * 32 + 4 * fq;
#pragma unroll
                for (int bj = 0; bj < 2; ++bj)
#pragma unroll
                    for (int n = 0; n < 2; ++n) st_bf16x4(yrow + bj * 128 + n * 16, acc[ai][bj][m][n]); }
    }, nullptr);
}


constexpr int DV = D / 256;
static_assert(D % 256 == 0, "row phases hold a row as DV float4 per lane");
template <int CTRL> __device__ __forceinline__ float dppf(float v) { return __builtin_bit_cast(float, __builtin_amdgcn_update_dpp(0, __builtin_bit_cast(int, v), CTRL, 0xf, 0xf, true)); }
__device__ __forceinline__ float wave_sum(float v) {
    v += dppf<0xB1>(v); v += dppf<0x4E>(v); v += dppf<0x141>(v); v += dppf<0x140>(v);
    float a = v, b = v;
    asm volatile("s_nop 1\n\tv_permlane16_swap_b32 %0, %1" : "+v"(a), "+v"(b));
    v = a + b; a = v; b = v;
    asm volatile("s_nop 1\n\tv_permlane32_swap_b32 %0, %1" : "+v"(a), "+v"(b));
    return a + b;
}
__device__ __forceinline__ float sum8(float v) { v += dppf<0xB1>(v); v += dppf<0x4E>(v); v += dppf<0x141>(v); return v; }
__device__ __forceinline__ float sum4(f32x4 a) { return (a[0] + a[1]) + (a[2] + a[3]); }
#define LDS_WAIT() asm volatile("s_waitcnt lgkmcnt(0)" ::: "memory")

__device__ __forceinline__ void row_stats(const f32x4 (&v)[DV], float& mu, float& rstd) {
    float s = 0.f;
#pragma unroll
    for (int j = 0; j < DV; ++j) s += sum4(v[j]);
    mu = wave_sum(s) * (1.0f / D);
    float q = 0.f;
#pragma unroll
    for (int j = 0; j < DV; ++j) { const f32x4 d = v[j] - mu; q += sum4(d * d); }
    rstd = 1.0f / sqrtf(wave_sum(q) * (1.0f / D) + LN_EPS);
}

__device__ __forceinline__ void ph_lnmod_fast(const Params& p, int l) {
    const int tid_ = opq_tid(), bid_ = opq_bid(); (void)tid_; (void)bid_;
    const int lane = tid_ & 63, gw = bid_ * 4 + (tid_ >> 6), nw = VGRID * 4;
    constexpr int R = 4;
    for (int m0 = gw * R; m0 < T; m0 += nw * R) {
        f32x4 v[R][DV];
#pragma unroll
        for (int r = 0; r < R; ++r) { const f32x4* xr = (const f32x4*)xrow_in(p, l, m0 + r < T ? m0 + r : m0) + lane;
#pragma unroll
            for (int j = 0; j < DV; ++j) v[r][j] = xr[64 * j]; }
        float mu[R], rstd[R];
#pragma unroll
        for (int r = 0; r < R; ++r) row_stats(v[r], mu[r], rstd[r]);
#pragma unroll
        for (int r = 0; r < R; ++r) if (m0 + r < T) { const f32x4* md = (const f32x4*)modrow(p, l, m0 + r) + lane;
#pragma unroll
            for (int j = 0; j < DV; ++j) st_bf16x4(p.H + (size_t)(m0 + r) * D + 4 * (lane + 64 * j), (v[r][j] - mu[r]) * rstd[r] * (md[D / 4 + 64 * j] + 1.0f) + md[64 * j]); }
    }
}

template <int R>
__device__ __forceinline__ void pm_rows(const Params& p, int l, int m0, int lane) {
    const f32x4* g1 = (const f32x4*)(p.ln1_g + (size_t)l * D) + lane; const f32x4* b1 = (const f32x4*)(p.ln1_b + (size_t)l * D) + lane;
    f32x4 v[R][DV]; float mu[R], rstd[R];
#pragma unroll
    for (int r = 0; r < R; ++r) { const int m = m0 + r; const f32x4* xr = (const f32x4*)xrow_in(p, l, m) + lane; const f32x4* md = (const f32x4*)modrow(p, l, m) + lane;
        const bf16_t* orow = p.O + (size_t)m * D + 4 * lane;
#pragma unroll
        for (int j = 0; j < DV; ++j) v[r][j] = xr[64 * j] * ALPHA + md[2 * (D / 4) + 64 * j] * ld_bf16x4(orow + 256 * j); }
#pragma unroll
    for (int r = 0; r < R; ++r) row_stats(v[r], mu[r], rstd[r]);
#pragma unroll
    for (int r = 0; r < R; ++r) { const int m = m0 + r; f32x4* x1 = (f32x4*)((m < TL) ? p.out + (size_t)m * D : p.XC + (size_t)(m - TL) * D) + lane;
#pragma unroll
        for (int j = 0; j < DV; ++j) { v[r][j] = (v[r][j] - mu[r]) * rstd[r] * g1[64 * j] + b1[64 * j]; x1[64 * j] = v[r][j]; } }
#pragma unroll
    for (int r = 0; r < R; ++r) row_stats(v[r], mu[r], rstd[r]);
#pragma unroll
    for (int r = 0; r < R; ++r) { const int m = m0 + r; const f32x4* md = (const f32x4*)modrow(p, l, m) + lane;
#pragma unroll
        for (int j = 0; j < DV; ++j) {
            const f32x4 hv = (v[r][j] - mu[r]) * rstd[r] * (md[4 * (D / 4) + 64 * j] + 1.0f) + md[3 * (D / 4) + 64 * j];
            f32x4 hh, lo;
#pragma unroll
            for (int e = 0; e < 4; ++e) { hh[e] = bf2f(f2bf(hv[e])); lo[e] = hv[e] - hh[e]; }
            st_bf16x4(p.H + (size_t)m * D + 4 * (lane + 64 * j), hh);
            st_bf16x4(p.HLO + (size_t)m * D + 4 * (lane + 64 * j), lo);
        } }
}

__device__ __forceinline__ int router_rpg(int nrows) { const int g = VGRID; return (nrows % g == 0 && nrows / g <= 48 && (nrows / g) % 4 == 0) ? nrows / g : 32; }
__device__ __forceinline__ void g_router(const Params& p, int l, int nrows, char* lds) {
    const int tid_ = opq_tid(), bid_ = opq_bid(); (void)tid_; (void)bid_;
    const int lane = tid_ & 63, wid = tid_ >> 6, fr = lane & 15, fq = lane >> 4;
    const int RPG = router_rpg(nrows), RW = RPG / 4;
    float* part = (float*)lds;
    float* lgt = part + 4 * 9 * 64 * 4;
    int* eids = (int*)(lgt + 48 * 48);
    for (int rg = bid_; rg < nrows / RPG; rg += VGRID) {
#pragma unroll 1
        for (int i = 0; i + 1 < RW; i += 2) pm_rows<2>(p, l, rg * RPG + wid * RW + i, lane);
        if (RW & 1) pm_rows<1>(p, l, rg * RPG + wid * RW + RW - 1, lane);
        asm volatile("s_waitcnt vmcnt(0)" ::: "memory");
        __syncthreads();
        f32x4 acc[3][3];
#pragma unroll
        for (int a = 0; a < 3; ++a)
#pragma unroll
            for (int b = 0; b < 3; ++b) acc[a][b] = (f32x4){0.f, 0.f, 0.f, 0.f};
        int arow[3];
#pragma unroll
        for (int a = 0; a < 3; ++a) { const int rr = a * 16 + fr; arow[a] = rg * RPG + (rr < RPG ? rr : RPG - 1); }
#pragma unroll
        for (int seg = 0; seg < 3; ++seg) {
            const bf16_t* ab = (seg < 2 ? p.H : p.HLO) + wid * (D / 4) + fq * 8;
            const bf16_t* bp = p.wrt + (seg == 1 ? (size_t)128 * D : 0) + (size_t)fr * D + wid * (D / 4) + fq * 8;
#pragma unroll 1
            for (int ks0 = 0; ks0 < D / 128; ks0 += 2) {
                bf16x8 av[2][3], bv[2][3];
#pragma unroll
                for (int u = 0; u < 2; ++u) { const int ko = (ks0 + u) * 32;
#pragma unroll
                    for (int a = 0; a < 3; ++a) { av[u][a] = *(const bf16x8*)(ab + (size_t)arow[a] * D + ko); bv[u][a] = *(const bf16x8*)(bp + (size_t)(16 * a) * D + ko); } }
                asm volatile("" ::: "memory");
#pragma unroll
                for (int u = 0; u < 2; ++u)
#pragma unroll
                    for (int a = 0; a < 3; ++a)
#pragma unroll
                        for (int b = 0; b < 3; ++b) acc[a][b] = __builtin_amdgcn_mfma_f32_16x16x32_bf16(av[u][a], bv[u][b], acc[a][b], 0, 0, 0);
            }
        }
#pragma unroll
        for (int a = 0; a < 3; ++a)
#pragma unroll
            for (int b = 0; b < 3; ++b) *(f32x4*)(part + ((wid * 9 + a * 3 + b) * 64 + lane) * 4) = acc[a][b];
        __syncthreads();
#pragma unroll
        for (int i = 0; i < 9; ++i) { const int e = tid_ + 256 * i, f = e >> 8, ln = (e & 255) >> 2, j = e & 3;
            const float sm = (part[((0 * 9 + f) * 64 + ln) * 4 + j] + part[((1 * 9 + f) * 64 + ln) * 4 + j]) + (part[((2 * 9 + f) * 64 + ln) * 4 + j] + part[((3 * 9 + f) * 64 + ln) * 4 + j]);
            lgt[((f / 3) * 16 + (ln >> 4) * 4 + j) * 48 + (f % 3) * 16 + (ln & 15)] = sm; }
        __syncthreads();
        if (tid_ < RPG) {
            const int m = rg * RPG + tid_; const float* lg = lgt + tid_ * 48;
            float gl[4], el[32];
#pragma unroll
            for (int g = 0; g < 4; ++g) gl[g] = lg[g] + p.b_rg[l * 4 + g];
#pragma unroll
            for (int e = 0; e < 32; ++e) el[e] = lg[4 + e] + p.b_re[l * 32 + e];
            int gs = 0; float gm = gl[0];
#pragma unroll
            for (int g = 1; g < 4; ++g) if (gl[g] > gm) { gm = gl[g]; gs = g; }
            float den = 0.f;
#pragma unroll
            for (int g = 0; g < 4; ++g) den += expf(gl[g] - gm);
            const float pg = 1.0f / den;
            float v1 = -3e38f, v2 = -3e38f; int i1 = 0, i2 = 0;
#pragma unroll
            for (int j = 0; j < 8; ++j) {
                const float vv = gs == 0 ? el[j] : gs == 1 ? el[8 + j] : gs == 2 ? el[16 + j] : el[24 + j];
                if (vv > v1) { v2 = v1; i2 = i1; v1 = vv; i1 = j; } else if (vv > v2) { v2 = vv; i2 = j; }
            }
            const float e2 = expf(v2 - v1), w1 = pg / (1.0f + e2), w2 = pg * e2 / (1.0f + e2);
            const int ea = gs * 8 + i1, eb = gs * 8 + i2;
            p.rE[2 * m] = ea; p.rE[2 * m + 1] = eb; p.rW[2 * m] = w1; p.rW[2 * m + 1] = w2;
            eids[2 * tid_] = ea; eids[2 * tid_ + 1] = eb;
        }
        __syncthreads();
        if (tid_ < 2 * RPG) { const int e = eids[tid_]; int rk = 0; for (int j = 0; j < tid_; ++j) rk += (eids[j] == e) ? 1 : 0; p.rPos[2 * (rg * RPG) + tid_] = rk; }
        else if (tid_ >= 128 && tid_ < 160) { const int e = tid_ - 128; int c = 0; for (int j = 0; j < 2 * RPG; ++j) c += (eids[j] == e) ? 1 : 0; p.hist[rg * 32 + e] = c; }
        __syncthreads();
    }
}

__device__ __forceinline__ void ph_dispatch_fast(const Params& p, int l, int nrows, char* lds) {
    const int tid_ = opq_tid(), bid_ = opq_bid(); (void)tid_; (void)bid_;
    const int RPG = router_rpg(nrows), nrg = nrows / RPG, e = tid_ & 31, part = tid_ >> 5;
    int* tot = (int*)lds; int* pst = tot + 32; int* pre = pst + 32; int* red = pre + 32;
    { int s = 0; for (int b = part; b < nrg; b += 8) s += p.hist[b * 32 + e]; red[part * 32 + e] = s; }
    __syncthreads();
    if (tid_ < 32) { int s = 0; for (int q = 0; q < 8; ++q) s += red[q * 32 + tid_]; tot[tid_] = s; }
    __syncthreads();
    if (tid_ < 32) { int s = 0; for (int j = 0; j < tid_; ++j) s += (tot[j] + MPAD - 1) & ~(MPAD - 1); pst[tid_] = s; if (bid_ == 0) p.cnt[l * NEXP + tid_] = tot[tid_]; }
    for (int rg = bid_; rg < nrg; rg += VGRID) {
        __syncthreads();
        { int s = 0; for (int b = part; b < rg; b += 8) s += p.hist[b * 32 + e]; red[part * 32 + e] = s; }
        __syncthreads();
        if (tid_ < 32) { int s = 0; for (int q = 0; q < 8; ++q) s += red[q * 32 + tid_]; pre[tid_] = s; }
        __syncthreads();
        if (tid_ < 2 * RPG) { const int i = 2 * (rg * RPG) + tid_, ee = p.rE[i], slot = pst[ee] + pre[ee] + p.rPos[i]; p.rSlot[i] = slot; p.slotTok[slot] = i >> 1; }
    }
}

__device__ __forceinline__ void ph_final_fast(const Params& p, int l, int nrows, bool next_h) {
    const int tid_ = opq_tid(), bid_ = opq_bid(); (void)tid_; (void)bid_;
    const int lane = tid_ & 63, gw = bid_ * 4 + (tid_ >> 6), nw = VGRID * 4;
    constexpr int R = 4;
    const f32x4* g2 = (const f32x4*)(p.ln2_g + (size_t)l * D) + lane; const f32x4* b2 = (const f32x4*)(p.ln2_b + (size_t)l * D) + lane;
    for (int m0 = gw * R; m0 < nrows; m0 += nw * R) {
        f32x4 v[R][DV]; float mu[R], rstd[R];
#pragma unroll
        for (int r = 0; r < R; ++r) { const int m = m0 + r; const f32x4* x1 = (const f32x4*)((m < TL) ? p.out + (size_t)m * D : p.XC + (size_t)(m - TL) * D) + lane;
            const f32x4* md = (const f32x4*)modrow(p, l, m) + lane;
            const bf16_t* ya = p.YSb + (size_t)p.rSlot[2 * m] * D + 4 * lane; const bf16_t* yb = p.YSb + (size_t)p.rSlot[2 * m + 1] * D + 4 * lane;
            const float wa = p.rW[2 * m], wb = p.rW[2 * m + 1];
#pragma unroll
            for (int j = 0; j < DV; ++j) v[r][j] = x1[64 * j] * ALPHA + md[5 * (D / 4) + 64 * j] * (ld_bf16x4(ya + 256 * j) * wa + ld_bf16x4(yb + 256 * j) * wb); }
#pragma unroll
        for (int r = 0; r < R; ++r) row_stats(v[r], mu[r], rstd[r]);
#pragma unroll
        for (int r = 0; r < R; ++r) { const int m = m0 + r; f32x4* x1 = (f32x4*)((m < TL) ? p.out + (size_t)m * D : p.XC + (size_t)(m - TL) * D) + lane;
#pragma unroll
            for (int j = 0; j < DV; ++j) { v[r][j] = (v[r][j] - mu[r]) * rstd[r] * g2[64 * j] + b2[64 * j]; x1[64 * j] = v[r][j]; } }
        if (next_h) {
#pragma unroll
            for (int r = 0; r < R; ++r) row_stats(v[r], mu[r], rstd[r]);
#pragma unroll
            for (int r = 0; r < R; ++r) { const int m = m0 + r; const f32x4* mn = (const f32x4*)modrow(p, l + 1, m) + lane;
#pragma unroll
                for (int j = 0; j < DV; ++j) st_bf16x4(p.H + (size_t)m * D + 4 * (lane + 64 * j), (v[r][j] - mu[r]) * rstd[r] * (mn[D / 4 + 64 * j] + 1.0f) + mn[64 * j]); }
        }
    }
}

__device__ __forceinline__ void ph_mod_fast(const Params& p, char* lds) {
    const int tid_ = opq_tid(), bid_ = opq_bid(); (void)tid_; (void)bid_;
    constexpr int NR = NB + 1, NTASK = 2 * (6 * D / 64);
    if (bid_ >= NTASK) return;
    float* sc = (float*)lds;
    float* part = sc + NR * D;
    for (int i = tid_; i < NR * D; i += 256) { const int b = i / D, k = i % D; const float cv = b < NB ? p.c[(size_t)b * D + k] : p.c_ctx[k]; sc[i] = cv / (1.0f + __expf(-cv)); }
    __syncthreads();
    const int lane = tid_ & 63, wid = tid_ >> 6;
    for (int task = bid_; task < NTASK; task += VGRID) {
        const int ll = task / (6 * D / 64), col = 64 * (task % (6 * D / 64)) + lane;
        float acc[NR];
#pragma unroll
        for (int b = 0; b < NR; ++b) acc[b] = 0.f;
        const float* wp = p.w_mod + ((size_t)ll * D + wid * (D / 4)) * 6 * D + col;
#pragma unroll 16
        for (int k = 0; k < D / 4; ++k) { const float w = wp[(size_t)k * 6 * D];
#pragma unroll
            for (int b = 0; b < NR; ++b) acc[b] += sc[b * D + wid * (D / 4) + k] * w; }
#pragma unroll
        for (int b = 0; b < NR; ++b) part[(wid * NR + b) * 64 + lane] = acc[b];
        __syncthreads();
        for (int i = tid_; i < NR * 64; i += 256) { const int b = i / 64, cl = i % 64;
            p.mod[((size_t)ll * NR + b) * 6 * D + 64 * (task % (6 * D / 64)) + cl] = (part[(0 * NR + b) * 64 + cl] + part[(1 * NR + b) * 64 + cl]) + (part[(2 * NR + b) * 64 + cl] + part[(3 * NR + b) * 64 + cl]) + p.b_mod[(size_t)ll * 6 * D + 64 * (task % (6 * D / 64)) + cl]; }
        __syncthreads();
    }
}

template <bool SPLIT = false>
__device__ __forceinline__ void tr_item(const float* srcl, size_t ldw, bf16_t* dst, size_t ldd, float* scr, int lane, float scale = 1.0f) {
    float v[32];
#pragma unroll
    for (int i = 0; i < 32; ++i) v[i] = srcl ? srcl[(size_t)(2 * i + (lane >> 5)) * ldw] * scale : 0.f;
#pragma unroll
    for (int i = 0; i < 32; ++i) scr[(2 * i + (lane >> 5)) * 33 + (lane & 31)] = v[i];
    LDS_WAIT();
    const int c = lane & 7;
#pragma unroll
    for (int j = 0; j < 4; ++j) { const int n = (lane >> 3) + 8 * j; const float* s = scr + (8 * c) * 33 + n;
        uint4 o; o.x = pk2(s[0], s[33]); o.y = pk2(s[2 * 33], s[3 * 33]); o.z = pk2(s[4 * 33], s[5 * 33]); o.w = pk2(s[6 * 33], s[7 * 33]);
        *(uint4*)(dst + (size_t)(SPLIT ? (n & 15) + 32 * (n >> 4) : n) * ldd + 8 * c) = o; }
    LDS_WAIT();
}
__device__ __forceinline__ void ph_prep_w_fast(const Params& p, int l, int part, char* lds) {
    const int tid_ = opq_tid(), bid_ = opq_bid(); (void)tid_; (void)bid_;
    const int lane = tid_ & 63, wid = tid_ >> 6, gw = bid_ * 4 + wid, nw = VGRID * 4;
    float* scr = (float*)(lds + wid * 8448);
    constexpr int I_IN = (D / 64) * (NINP / 32), I_OUT = (DMIX / 64) * (D / 32), I_GU1 = (D / 64) * (2 * DE / 32), I_D1 = (DE / 64) * (D / 32);
    constexpr int NITEMS = I_IN + I_OUT + NEXP * (I_GU1 + I_D1);
    const int it0 = part == 0 ? 0 : I_IN + I_OUT, it1 = part == 0 ? I_IN + I_OUT : NITEMS;
    for (int it = it0 + gw; it < it1; it += nw) {
        int r = it;
        if (r < I_IN) { const int kb = r / (NINP / 32), n0 = 32 * (r % (NINP / 32));
            const float* s = nullptr;
            {
                const int oc = n0 < ZQN ? n0 + A_IN : n0 < ZA ? n0 + 1312 : n0 < ZP ? n0 - ZA : n0 < WVB ? -1 : n0 < WVN ? n0 - 864 : n0 - 96;
                if (oc >= 0) s = p.w_in + ((size_t)l * D + 64 * kb) * N_IN + oc + (lane & 31); }
            tr_item(s, N_IN, p.win_t + (size_t)n0 * D + 64 * kb, D, scr, lane, (n0 < ZKB || (n0 >= ZQN && n0 < ZKN)) ? QSCALE : 1.0f); continue; }
        r -= I_IN;
        if (r < I_OUT) { const int kb = r / (D / 32), n0 = 32 * (r % (D / 32));
            tr_item(p.w_out + ((size_t)l * DMIX + 64 * kb) * D + n0 + (lane & 31), D, p.wout_t + (size_t)n0 * DMIX + 64 * kb, DMIX, scr, lane); continue; }
        r -= I_OUT;
        const int e = r / (I_GU1 + I_D1); r %= (I_GU1 + I_D1);
        if (r < I_GU1) { const int kb = r / (2 * DE / 32), q = r % (2 * DE / 32), up = q & 1, c0 = 32 * (q >> 1);
            const float* s = (up ? p.w_up : p.w_gate) + (((size_t)l * NEXP + e) * D + 64 * kb) * DE + c0 + (lane & 31);
            tr_item<true>(s, DE, p.wgu_t + ((size_t)e * 2 * DE + 2 * c0 + 16 * up) * D + 64 * kb, D, scr, lane); continue; }
        r -= I_GU1;
        { const int kb = r / (D / 32), n0 = 32 * (r % (D / 32));
            tr_item(p.w_down + (((size_t)l * NEXP + e) * DE + 64 * kb) * D + n0 + (lane & 31), D, p.wd_t + ((size_t)e * D + n0) * DE + 64 * kb, DE, scr, lane); }
    }
    if (part != 0) return;
    const long gt = (long)bid_ * 256 + tid_, gs = (long)VGRID * 256;
    for (long i = gt; i < 2 * 256 * 64; i += gs) { const int k = (int)(i & 63), n = (int)((i >> 6) & 255), d = (int)(i >> 14);
        p.wupT[i] = f2bf(p.a_w_up[(((size_t)l * 2 + d) * 64 + k) * DA + n]); p.aupT[i] = f2bf(p.a_a_up[(((size_t)l * 2 + d) * 64 + k) * DA + n]); }
    for (long i = gt; i < 256 * 160; i += gs) { const int k = (int)(i % 160), n = (int)(i / 160); p.gupT[i] = f2bf(p.a_g_up[((size_t)l * 160 + k) * DA + n]); }
    for (long i = gt; i < (long)128 * D; i += gs) { const int n = (int)(i / D), k = (int)(i % D);
        const float w = n < 4 ? p.w_rg[((size_t)l * D + k) * 4 + n] : n < 36 ? p.w_re[((size_t)l * D + k) * 32 + n - 4] : 0.f;
        const bf16_t hb = f2bf(w); p.wrt[i] = hb; p.wrt[(size_t)128 * D + i] = f2bf(w - bf2f(hb)); }
}

__device__ __forceinline__ float tanh_fast(float x) { return 1.0f - 2.0f / (1.0f + __expf(2.0f * x)); }
__device__ __forceinline__ void ph_streams_s1(const Params& p, int l) {
    const int tid_ = opq_tid(), bid_ = opq_bid(); (void)tid_; (void)bid_;
    constexpr int NCH = A_IN / 8, NCHP = (NCH + 7) & ~7;
    const float* sh = p.a_shift + (size_t)l * 3 * A_IN;
    for (long it = (long)bid_ * 256 + tid_; it < (long)T * NCHP; it += (long)VGRID * 256) {
        const int m = (int)(it / NCHP), ch = (int)(it % NCHP), c0 = 8 * ch;
        const bool act = ch < NCH;
        int t, len;
        if (m < TL) { t = m % S; len = S; } else { t = (m - TL) % L; len = L; }
        float v[8];
#pragma unroll
        for (int e = 0; e < 8; ++e) v[e] = 0.f;
        if (act) {
            const bf16_t* z = p.Z + (size_t)m * ZP + ZA + c0;
            const bf16x8 zc = *(const bf16x8*)z;
            const f32x4 s1a = *(const f32x4*)(sh + A_IN + c0), s1b = *(const f32x4*)(sh + A_IN + c0 + 4);
#pragma unroll
            for (int e = 0; e < 8; ++e) v[e] = (e < 4 ? s1a[e] : s1b[e - 4]) * bf2f((bf16_t)zc[e]);
            if (t > 0) { const bf16x8 zp = *(const bf16x8*)(z - ZP); const f32x4 a = *(const f32x4*)(sh + c0), b = *(const f32x4*)(sh + c0 + 4);
#pragma unroll
                for (int e = 0; e < 8; ++e) v[e] += (e < 4 ? a[e] : b[e - 4]) * bf2f((bf16_t)zp[e]); }
            if (t < len - 1) { const bf16x8 zn = *(const bf16x8*)(z + ZP); const f32x4 a = *(const f32x4*)(sh + 2 * A_IN + c0), b = *(const f32x4*)(sh + 2 * A_IN + c0 + 4);
#pragma unroll
                for (int e = 0; e < 8; ++e) v[e] += (e < 4 ? a[e] : b[e - 4]) * bf2f((bf16_t)zn[e]); }
        }
        float nrm = 0.f;
        if (ch >= 32 && ch < 64) {
#pragma unroll
            for (int e = 0; e < 8; ++e) { const float t2 = v[e] * p.a_k_k[l * DA + c0 - 256 + e]; nrm += t2 * t2; } }
        nrm = sum8(nrm);
        if (!act) continue;
        if (c0 < 768) {
            float* dst = (c0 < 256 ? p.sR + (size_t)m * DA + c0 : c0 < 512 ? p.kT + (size_t)m * DA + c0 - 256 : p.sV + (size_t)m * DA + c0 - 512);
            *(f32x4*)dst = (f32x4){v[0], v[1], v[2], v[3]}; *(f32x4*)(dst + 4) = (f32x4){v[4], v[5], v[6], v[7]};
            if (ch >= 32 && ch < 64 && (ch & 7) == 0) p.kN[(size_t)m * 4 + ((ch - 32) >> 3)] = 1.0f / sqrtf(nrm + 1e-12f);
        } else {
            if (c0 < 896) {
#pragma unroll
                for (int e = 0; e < 8; ++e) v[e] = tanh_fast(v[e]); }
            else if (c0 >= 1024) {
#pragma unroll
                for (int e = 0; e < 8; ++e) v[e] = 1.0f / (1.0f + __expf(-v[e])); }
            uint4 o; o.x = pk2(v[0], v[1]); o.y = pk2(v[2], v[3]); o.z = pk2(v[4], v[5]); o.w = pk2(v[6], v[7]);
            *(uint4*)(p.LA + (size_t)m * 416 + c0 - 768) = o;
        }
    }
}
__device__ __forceinline__ void g_streams_s2(const Params& p, int l, char* lds) {
    const int tid_ = opq_tid(), bid_ = opq_bid(); (void)tid_; (void)bid_;
    constexpr int MT = T / 128;
    for (int job = bid_; job < 5 * MT * 2; job += VGRID) {
        const int type = job / (MT * 2), r = job % (MT * 2), tm = r >> 1, tn = r & 1;
        const int coff = type < 2 ? type * 64 : type < 4 ? 128 + (type - 2) * 64 : 256, K = type < 4 ? 64 : 160, d = type & 1;
        const bf16_t* Bt = type < 2 ? p.wupT + type * 256 * 64 : type < 4 ? p.aupT + (type - 2) * 256 * 64 : p.gupT;
        const bf16_t* a0 = p.LA + (size_t)(tm * 128 + STG_ROW(0)) * 416 + coff + STG_K; const bf16_t* a1 = p.LA + (size_t)(tm * 128 + STG_ROW(1)) * 416 + coff + STG_K;
        const bf16_t* b0 = Bt + (size_t)(tn * 128 + STG_ROW(0)) * K + STG_K; const bf16_t* b1 = Bt + (size_t)(tn * 128 + STG_ROW(1)) * K + STG_K;
        if (type < 2) gemm_tile(a0, a1, b0, b1, K, lds, [&](const f32x4 (&acc)[4][4], int wr, int wc, int fr, int fq) {
#pragma unroll
            for (int mi = 0; mi < 4; ++mi) { const int row = tm * 128 + wr * 64 + mi * 16 + fr;
#pragma unroll
                for (int n = 0; n < 4; ++n) { const int c = tn * 128 + wc * 64 + n * 16 + 4 * fq; const f32x4 w0 = *(const f32x4*)(p.a_w0 + (l * 2 + d) * DA + c); f32x4 o;
#pragma unroll
                    for (int e4 = 0; e4 < 4; ++e4) { const float ex = __expf(-(w0[e4] + acc[mi][n][e4]));
                        o[e4] = __expf(-0.60653065971f / (1.0f + ex)); }
                    *(f32x4*)(p.sW + ((size_t)d * T + row) * DA + c) = o; }
                asm volatile("" ::: "memory"); }
        });
        else if (type < 4) gemm_tile(a0, a1, b0, b1, K, lds, [&](const f32x4 (&acc)[4][4], int wr, int wc, int fr, int fq) {
#pragma unroll
            for (int mi = 0; mi < 4; ++mi) { const int row = tm * 128 + wr * 64 + mi * 16 + fr;
#pragma unroll
                for (int n = 0; n < 4; ++n) { const int c = tn * 128 + wc * 64 + n * 16 + 4 * fq;
                    const f32x4 a0v = *(const f32x4*)(p.a_a0 + (l * 2 + d) * DA + c), kkc = *(const f32x4*)(p.a_k_k + l * DA + c), kac = *(const f32x4*)(p.a_k_a + l * DA + c);
                    const size_t o = (size_t)row * DA + c, od = ((size_t)d * T + row) * DA + c;
                    const f32x4 k = *(const f32x4*)(p.kT + o); const float kn = p.kN[(size_t)row * 4 + (c >> 6)];
                    f32x4 kd, bo, kk;
#pragma unroll
                    for (int e4 = 0; e4 < 4; ++e4) { const float av = 1.0f / (1.0f + __expf(-(a0v[e4] + acc[mi][n][e4])));
                        kk[e4] = k[e4] * kkc[e4] * kn; kd[e4] = k[e4] * (1.0f + (av - 1.0f) * kac[e4]); bo[e4] = kk[e4] * av; }
                    *(f32x4*)(p.sKD + od) = kd; *(f32x4*)(p.sB + od) = bo; if (d == 0) *(f32x4*)(p.sKK + o) = kk; }
                asm volatile("" ::: "memory"); }
        });
        else gemm_tile(a0, a1, b0, b1, K, lds, [&](const f32x4 (&acc)[4][4], int wr, int wc, int fr, int fq) {
#pragma unroll
            for (int mi = 0; mi < 4; ++mi)
#pragma unroll
                for (int n = 0; n < 4; ++n) st_bf16x4(p.MIX + (size_t)(tm * 128 + wr * 64 + mi * 16 + fr) * DMIX + tn * 128 + wc * 64 + n * 16 + 4 * fq, acc[mi][n]);
        });
    }
}


typedef float f32x16 __attribute__((ext_vector_type(16)));
typedef short s16x4 __attribute__((ext_vector_type(4)));
typedef unsigned u32x4_t __attribute__((ext_vector_type(4)));
typedef float f32x2_t __attribute__((ext_vector_type(2)));
typedef __bf16 bf16x2_t __attribute__((ext_vector_type(2)));
__device__ __forceinline__ unsigned cvtpk(float lo, float hi) { f32x2_t v = {lo, hi}; bf16x2_t b = __builtin_convertvector(v, bf16x2_t); return __builtin_bit_cast(unsigned, b); }
__device__ __forceinline__ int crow(int r, int hi) { return (r & 3) + 8 * (r >> 2) + 4 * hi; }
__device__ __forceinline__ float xmax32(float v) { float a = v, b = v; asm volatile("s_nop 1\n\tv_permlane32_swap_b32 %0, %1" : "+v"(a), "+v"(b)); return fmaxf(a, b); }
__device__ __forceinline__ float xsum32(float v) { float a = v, b = v; asm volatile("s_nop 1\n\tv_permlane32_swap_b32 %0, %1" : "+v"(a), "+v"(b)); return a + b; }

struct NoMask { __device__ __forceinline__ float operator()(int, float v) const { return v; } };

template <class MaskF>
__device__ __forceinline__ void attn_tile_lds(const bf16x8 (&qf)[4], const char* ks, const char* vs, const MaskF& mask, float& m_run, float& l_run, f32x16& o0, f32x16& o1, int ql, int hi) {
    f32x16 s;
#pragma unroll
    for (int r = 0; r < 16; ++r) s[r] = 0.f;
#pragma unroll
    for (int k4 = 0; k4 < 4; ++k4) { const bf16x8 kf = *(const bf16x8*)(ks + ql * 128 + (((2 * k4 + hi) ^ (ql & 7)) * 16)); s = __builtin_amdgcn_mfma_f32_32x32x16_bf16(kf, qf[k4], s, 0, 0, 0); }
    float mx = -INFINITY;
#pragma unroll
    for (int r = 0; r < 16; ++r) { s[r] = mask(crow(r, hi), s[r]); mx = fmaxf(mx, s[r]); }
    mx = xmax32(mx);
    if (__any(mx > m_run)) {
        const float mn = fmaxf(m_run, mx), alpha = __builtin_amdgcn_exp2f(m_run - mn);
        m_run = mn; l_run *= alpha;
#pragma unroll
        for (int r = 0; r < 16; ++r) { o0[r] *= alpha; o1[r] *= alpha; }
    }
    float ps = 0.f;
#pragma unroll
    for (int r = 0; r < 16; ++r) { s[r] = __builtin_amdgcn_exp2f(s[r] - m_run); ps += s[r]; }
    l_run += ps;
    const int sw0 = (ql >> 2) & 3;
#pragma unroll
    for (int s2 = 0; s2 < 2; ++s2) {
        u32x4_t pw; pw[0] = cvtpk(s[8 * s2], s[8 * s2 + 1]); pw[1] = cvtpk(s[8 * s2 + 2], s[8 * s2 + 3]); pw[2] = cvtpk(s[8 * s2 + 4], s[8 * s2 + 5]); pw[3] = cvtpk(s[8 * s2 + 6], s[8 * s2 + 7]);
        const bf16x8 pb = __builtin_bit_cast(bf16x8, pw);
        const char* v0 = vs + ql * 64 + 8 * hi; const char* v1 = v0 + 32 * 64;
        const s16x4 a0 = *(const s16x4*)(v0 + (((2 * s2) ^ sw0) * 16)), a1 = *(const s16x4*)(v0 + (((2 * s2 + 1) ^ sw0) * 16));
        const s16x4 c0 = *(const s16x4*)(v1 + (((2 * s2) ^ sw0) * 16)), c1 = *(const s16x4*)(v1 + (((2 * s2 + 1) ^ sw0) * 16));
        o0 = __builtin_amdgcn_mfma_f32_32x32x16_bf16(__builtin_shufflevector(a0, a1, 0, 1, 2, 3, 4, 5, 6, 7), pb, o0, 0, 0, 0);
        o1 = __builtin_amdgcn_mfma_f32_32x32x16_bf16(__builtin_shufflevector(c0, c1, 0, 1, 2, 3, 4, 5, 6, 7), pb, o1, 0, 0, 0);
    }
}

__device__ __forceinline__ void ph_attn_blk(const Params& p, int l, bool with_ctx, int first_blk, char* lds) {
    const int tid_ = opq_tid(), bid_ = opq_bid(); (void)tid_; (void)bid_;
    if (bid_ < first_blk) return;
    const int lane = tid_ & 63, hi = lane >> 5, ql = lane & 31, wid = tid_ >> 6;
    constexpr int NQG = S / 128, NCG = L / 128, ROWS = S / GRID_W, N_LAT = NB * 6 * NQG, N_CTX = NB * 6 * NCG, TPB = (S + L) / 32;
    const int ntask = 2 * N_LAT + (with_ctx ? 2 * N_CTX : 0);
    const int krow = tid_ >> 3, kch = (tid_ & 7) ^ (krow & 7), vrow = tid_ >> 2, vpc = (tid_ & 3) ^ ((vrow >> 2) & 3);
    for (int task = bid_ - first_blk; task < ntask; task += VGRID - first_blk) {
        bool isC, isCtx; int r;
        if (task < N_LAT) { isC = true; isCtx = false; r = task; }
        else if (task < 2 * N_LAT) { isC = false; isCtx = false; r = task - N_LAT; }
        else { r = task - 2 * N_LAT; isCtx = true; isC = r >= N_CTX; if (isC) r -= N_CTX; }
        const int ng = isCtx ? NCG : NQG, g = r % ng, h = (r / ng) % 6, b = r / (ng * 6);
        const int qt = 4 * g + wid;
        const int m = isCtx ? TL + b * L + 32 * qt + ql : b * S + 32 * qt + ql;
        const int qcol = isC ? ZQN + h * 64 : ZQB + h * 64, kcol = isC ? ZKN + h * 64 : ZKB + (h / 3) * 64, hv = isC ? 2 + h : h / 3;
        bf16x8 qf[4];
        { const bf16_t* qp = p.Z + (size_t)m * ZP + qcol + 8 * hi;
#pragma unroll
          for (int k4 = 0; k4 < 4; ++k4) qf[k4] = *(const bf16x8*)(qp + 16 * k4); }
        int lo = 0, hi_t = 0, gr0 = 0;
        if (!isCtx) {
            if (!isC) { lo = 4 * g - 4; hi_t = 4 * g + 8; lo = lo < 0 ? 0 : lo; hi_t = hi_t > S / 32 ? S / 32 : hi_t; }
            else { const int ra = 2 * g, rb = 2 * g + 1; int r0a = ra - 4; r0a = r0a < 0 ? 0 : (r0a > ROWS - 8 ? ROWS - 8 : r0a); int r0b = rb - 4; r0b = r0b < 0 ? 0 : (r0b > ROWS - 8 ? ROWS - 8 : r0b);
                   lo = 2 * r0a; hi_t = 2 * (r0b + 8); gr0 = 0; }
        }
        const int ntile = L / 32 + (hi_t - lo);
        const bf16_t* kbase = p.Z + (size_t)krow * ZP + kcol + 8 * kch;
        const bf16_t* vbase = p.VT + ((size_t)(b * 8 + hv) * 64 + vrow) * PU + 8 * vpc;
#define AT_TOK(i_) ((i_) < L / 32 ? 32 * (i_) : L + 32 * (lo + (i_) - L / 32))
#define AT_STAGE(i_) do { const int u0_ = AT_TOK(i_); const int zrow_ = u0_ < L ? TL + b * L + u0_ : b * S + (u0_ - L); char* sl_ = lds + ((i_) % 3) * 8192 + tid_ * 16; \
            __builtin_amdgcn_global_load_lds((const unsigned*)(kbase + (size_t)zrow_ * ZP), (__attribute__((address_space(3))) unsigned*)(sl_), 16, 0, 0); \
            __builtin_amdgcn_global_load_lds((const unsigned*)(vbase + u0_), (__attribute__((address_space(3))) unsigned*)(sl_ + 4096), 16, 0, 0); } while (0)
        f32x16 o0, o1;
#pragma unroll
        for (int rr = 0; rr < 16; ++rr) { o0[rr] = 0.f; o1[rr] = 0.f; }
        float m_run, l_run;
        if (isC) { m_run = -1e30f; l_run = 0.f; } else { m_run = p.b_sink[l * 6 + h] * LOG2E; l_run = hi == 0 ? 1.0f : 0.f; }
        const int gr = qt >> 1, c = 32 * (qt & 1) + ql;
        int r0 = gr - 4; r0 = r0 < 0 ? 0 : (r0 > ROWS - 8 ? ROWS - 8 : r0);
        int c0 = c - 8; c0 = c0 < 0 ? 0 : (c0 > GRID_W - 16 ? GRID_W - 16 : c0);
        float* rpb = (float*)(lds + 24576);
        if (isC && !isCtx) for (int i = tid_; i < 15 * 31; i += 256) rpb[i] = p.c_rpb[((size_t)l * 6 + h) * 15 * 31 + i] * LOG2E;
        AT_STAGE(0);
        if (ntile > 1) AT_STAGE(1);
#pragma unroll 1
        for (int i = 0; i < ntile; ++i) {
            if (i + 1 < ntile) asm volatile("s_waitcnt vmcnt(2)" ::: "memory"); else asm volatile("s_waitcnt vmcnt(0)" ::: "memory");
            asm volatile("s_waitcnt lgkmcnt(0)" ::: "memory");
            __builtin_amdgcn_s_barrier();
            if (i + 2 < ntile) AT_STAGE(i + 2);
            const char* ks = lds + (i % 3) * 8192; const char* vs = ks + 4096;
            if (i < L / 32) attn_tile_lds(qf, ks, vs, NoMask(), m_run, l_run, o0, o1, ql, hi);
            else {
                const int jt = lo + i - L / 32;
                if (!isC) {
                    const int dq = jt - qt;
                    if (dq >= -3 && dq <= 3) attn_tile_lds(qf, ks, vs, NoMask(), m_run, l_run, o0, o1, ql, hi);
                    else if (dq == -4 || dq == 4) { const int base = 32 * dq - ql;
                        attn_tile_lds(qf, ks, vs, [&](int ko, float v) { const int rel = base + ko; return (rel >= -128 && rel <= 128) ? v : -INFINITY; }, m_run, l_run, o0, o1, ql, hi); }
                } else {
                    const int kr_ = jt >> 1, ct = jt & 1;
                    if (kr_ >= r0 && kr_ < r0 + 8) { const float* rp = rpb + (kr_ - gr + 7) * 31 + 15 - c;
                        attn_tile_lds(qf, ks, vs, [&](int ko, float v) { const int kc = 32 * ct + ko; int ix = kc - c + 15; ix = ix < 0 ? 0 : (ix > 30 ? 30 : ix); const float bs = rp[c - 15 + ix];
                                                     return (kc >= c0 && kc < c0 + 16) ? v + bs : -INFINITY; }, m_run, l_run, o0, o1, ql, hi); }
                }
            }
        }
        asm volatile("s_waitcnt lgkmcnt(0)" ::: "memory");
        __builtin_amdgcn_s_barrier();
        {
            const int tk = task ^ 1; int np = L / 32;
            if (tk < 2 * N_LAT) { const bool c_ = tk < N_LAT; const int g_ = (c_ ? tk : tk - N_LAT) % NQG; int lo_, hi_;
                if (!c_) { lo_ = 4 * g_ - 4; hi_ = 4 * g_ + 8; lo_ = lo_ < 0 ? 0 : lo_; hi_ = hi_ > S / 32 ? S / 32 : hi_; }
                else { int r0a = 2 * g_ - 4; r0a = r0a < 0 ? 0 : (r0a > ROWS - 8 ? ROWS - 8 : r0a); int r0b = 2 * g_ - 3; r0b = r0b < 0 ? 0 : (r0b > ROWS - 8 ? ROWS - 8 : r0b); lo_ = 2 * r0a; hi_ = 2 * (r0b + 8); }
                np += hi_ - lo_; }
#pragma unroll 1
            for (int i = ntile; i < np; ++i) __builtin_amdgcn_s_barrier();
        }
#undef AT_STAGE
#undef AT_TOK
        (void)gr0;
        const float lt = xsum32(l_run), inv = 1.0f / lt;
        bf16_t* op = p.MIX + (size_t)m * DMIX + (isC ? 640 : 256) + h * 64 + 4 * hi;
#pragma unroll
        for (int gq = 0; gq < 4; ++gq) {
            st_bf16x4(op + 8 * gq, (f32x4){o0[4 * gq] * inv, o0[4 * gq + 1] * inv, o0[4 * gq + 2] * inv, o0[4 * gq + 3] * inv});
            st_bf16x4(op + 32 + 8 * gq, (f32x4){o1[4 * gq] * inv, o1[4 * gq + 1] * inv, o1[4 * gq + 2] * inv, o1[4 * gq + 3] * inv});
        }
    }
}

#define RNB " row_newbcast:%c[n] row_mask:0xf bank_mask:0xf\n\t"
template <int N, bool FIRST>
__device__ __forceinline__ void dpp_dot4(float& a0, float& a1, float& a2, float& a3, const f32x4& v, float s0, float s1, float s2, float s3) {
    if (FIRST) asm volatile("s_nop 1");
    asm("v_fmac_f32_dpp %0, %4, %8" RNB "v_fmac_f32_dpp %1, %5, %9" RNB "v_fmac_f32_dpp %2, %6, %10" RNB "v_fmac_f32_dpp %3, %7, %11" RNB
        : "+v"(a0), "+v"(a1), "+v"(a2), "+v"(a3) : "v"(v[0]), "v"(v[1]), "v"(v[2]), "v"(v[3]), "v"(s0), "v"(s1), "v"(s2), "v"(s3), [n] "i"(N));
}
template <int N, bool FIRST>
__device__ __forceinline__ void dpp_upd4s(float& s0, float& s1, float& s2, float& s3, float& y0, float& y1, float& y2, float& y3,
                                          const f32x4& w, const f32x4& b, const f32x4& kd, const f32x4& r, float nsk, float vv) {
    if (FIRST) asm volatile("s_nop 1");
    asm("v_mul_f32_dpp %0, %8, %0" RNB "v_mul_f32_dpp %1, %9, %1" RNB "v_mul_f32_dpp %2, %10, %2" RNB "v_mul_f32_dpp %3, %11, %3" RNB
        "v_fmac_f32_dpp %0, %12, %24" RNB "v_fmac_f32_dpp %1, %13, %24" RNB "v_fmac_f32_dpp %2, %14, %24" RNB "v_fmac_f32_dpp %3, %15, %24" RNB
        "v_fmac_f32_dpp %0, %16, %25" RNB "v_fmac_f32_dpp %1, %17, %25" RNB "v_fmac_f32_dpp %2, %18, %25" RNB "v_fmac_f32_dpp %3, %19, %25" RNB
        "v_fmac_f32_dpp %4, %20, %0" RNB "v_fmac_f32_dpp %5, %21, %1" RNB "v_fmac_f32_dpp %6, %22, %2" RNB "v_fmac_f32_dpp %7, %23, %3" RNB
        : "+v"(s0), "+v"(s1), "+v"(s2), "+v"(s3), "+v"(y0), "+v"(y1), "+v"(y2), "+v"(y3)
        : "v"(w[0]), "v"(w[1]), "v"(w[2]), "v"(w[3]), "v"(b[0]), "v"(b[1]), "v"(b[2]), "v"(b[3]), "v"(kd[0]), "v"(kd[1]), "v"(kd[2]), "v"(kd[3]),
          "v"(r[0]), "v"(r[1]), "v"(r[2]), "v"(r[3]), "v"(nsk), "v"(vv), [n] "i"(N));
}
template <int N, bool FIRST>
__device__ __forceinline__ void dpp_upd4p(float& s0, float& s1, float& s2, float& s3, float& y0, float& y1, float& y2, float& y3,
                                          const f32x4& w, const f32x4& b, const f32x4& r, float nsk) {
    if (FIRST) asm volatile("s_nop 1");
    asm("v_mul_f32_dpp %0, %8, %0" RNB "v_mul_f32_dpp %1, %9, %1" RNB "v_mul_f32_dpp %2, %10, %2" RNB "v_mul_f32_dpp %3, %11, %3" RNB
        "v_fmac_f32_dpp %0, %12, %20" RNB "v_fmac_f32_dpp %1, %13, %20" RNB "v_fmac_f32_dpp %2, %14, %20" RNB "v_fmac_f32_dpp %3, %15, %20" RNB
        "v_fmac_f32_dpp %4, %16, %0" RNB "v_fmac_f32_dpp %5, %17, %1" RNB "v_fmac_f32_dpp %6, %18, %2" RNB "v_fmac_f32_dpp %7, %19, %3" RNB
        : "+v"(s0), "+v"(s1), "+v"(s2), "+v"(s3), "+v"(y0), "+v"(y1), "+v"(y2), "+v"(y3)
        : "v"(w[0]), "v"(w[1]), "v"(w[2]), "v"(w[3]), "v"(b[0]), "v"(b[1]), "v"(b[2]), "v"(b[3]), "v"(r[0]), "v"(r[1]), "v"(r[2]), "v"(r[3]), "v"(nsk), [n] "i"(N));
}
template <int N, bool FIRST>
__device__ __forceinline__ void dpp_mul4(float& s0, float& s1, float& s2, float& s3, const f32x4& v) {
    if (FIRST) asm volatile("s_nop 1");
    asm("v_mul_f32_dpp %0, %4, %0" RNB "v_mul_f32_dpp %1, %5, %1" RNB "v_mul_f32_dpp %2, %6, %2" RNB "v_mul_f32_dpp %3, %7, %3" RNB
        : "+v"(s0), "+v"(s1), "+v"(s2), "+v"(s3) : "v"(v[0]), "v"(v[1]), "v"(v[2]), "v"(v[3]), [n] "i"(N));
}
template <int N>
__device__ __forceinline__ void dpp_fmacx4(float& s0, float& s1, float& s2, float& s3, const f32x4& v, float x) {
    asm("v_fmac_f32_dpp %0, %4, %8" RNB "v_fmac_f32_dpp %1, %5, %8" RNB "v_fmac_f32_dpp %2, %6, %8" RNB "v_fmac_f32_dpp %3, %7, %8" RNB
        : "+v"(s0), "+v"(s1), "+v"(s2), "+v"(s3) : "v"(v[0]), "v"(v[1]), "v"(v[2]), "v"(v[3]), "v"(x), [n] "i"(N));
}
template <int N> struct ScanRep {
    static __device__ __forceinline__ void dot8(float (&a)[8], const f32x4& v, const float (&st)[64]) {
        constexpr int h = (N & 1) * 4;
        dpp_dot4<N, N == 0>(a[h], a[h + 1], a[h + 2], a[h + 3], v, st[4 * N], st[4 * N + 1], st[4 * N + 2], st[4 * N + 3]);
        if constexpr (N < 15) ScanRep<N + 1>::dot8(a, v, st);
    }
    static __device__ __forceinline__ void dot(float& a0, float& a1, float& a2, float& a3, const f32x4& v, const float (&st)[64]) {
        dpp_dot4<N, N == 0>(a0, a1, a2, a3, v, st[4 * N], st[4 * N + 1], st[4 * N + 2], st[4 * N + 3]);
        if constexpr (N < 15) ScanRep<N + 1>::dot(a0, a1, a2, a3, v, st);
    }
    static __device__ __forceinline__ void mul(float (&st)[64], const f32x4& w) {
        dpp_mul4<N, N == 0>(st[4 * N], st[4 * N + 1], st[4 * N + 2], st[4 * N + 3], w);
        if constexpr (N < 15) ScanRep<N + 1>::mul(st, w);
    }
    static __device__ __forceinline__ void fmacx(float (&st)[64], const f32x4& v, float x) {
        dpp_fmacx4<N>(st[4 * N], st[4 * N + 1], st[4 * N + 2], st[4 * N + 3], v, x);
        if constexpr (N < 15) ScanRep<N + 1>::fmacx(st, v, x);
    }
};
__device__ __forceinline__ int scan_row(int b, int d, int pos) { return pos < L ? TL + b * L + (d ? L - 1 - pos : pos) : b * S + (d ? S - 1 - (pos - L) : pos - L); }

template <bool ISP>
__device__ __forceinline__ void scan_task(const Params& p, int c, int s, int lane) {
    const int h = c & 3, b = (c >> 2) % NB, d = (c >> 2) / NB, pos0 = SEGLEN * s;
    const int q = 4 * (lane & 15);
    const float* bkk = p.sKK + h * 64 + q; const float* br = p.sR + h * 64 + q; const float* bw = p.sW + (size_t)d * T * DA + h * 64 + q; const float* bb_ = p.sB + (size_t)d * T * DA + h * 64 + q;
    const float* bkd = p.sKD + (size_t)d * T * DA + h * 64 + q; const float* bv = p.sV + h * 64 + lane;
    float* by = (ISP ? p.PV : p.Y) + (size_t)d * T * DA + h * 64 + lane;
    float st[64];
#pragma unroll
    for (int k = 0; k < 64; ++k) st[k] = (ISP && k == lane) ? 1.0f : 0.f;
    size_t mo = (size_t)scan_row(b, d, pos0) * DA;
    f32x4 kk = *(const f32x4*)(bkk + mo), w = *(const f32x4*)(bw + mo), bb = *(const f32x4*)(bb_ + mo), r = *(const f32x4*)(br + mo), kd = w; float vv = 0.f;
    if (!ISP) { kd = *(const f32x4*)(bkd + mo); vv = bv[mo]; }
#pragma unroll 1
    for (int i = 0; i < SEGLEN; ++i) {
        const size_t mn = (size_t)scan_row(b, d, pos0 + (i + 1 < SEGLEN ? i + 1 : i)) * DA;
        const f32x4 nkk = *(const f32x4*)(bkk + mn), nw = *(const f32x4*)(bw + mn), nb = *(const f32x4*)(bb_ + mn), nr = *(const f32x4*)(br + mn);
        f32x4 nkd = nw; float nv = 0.f;
        if (!ISP) { nkd = *(const f32x4*)(bkd + mn); nv = bv[mn]; }
        float a[8] = {0.f, 0.f, 0.f, 0.f, 0.f, 0.f, 0.f, 0.f};
        ScanRep<0>::dot8(a, kk, st);
        const float nsk = -(((a[0] + a[1]) + (a[2] + a[3])) + ((a[4] + a[5]) + (a[6] + a[7])));
        ScanRep<0>::mul(st, w);
        ScanRep<0>::fmacx(st, bb, nsk);
        if (!ISP) ScanRep<0>::fmacx(st, kd, vv);
        float y[8] = {0.f, 0.f, 0.f, 0.f, 0.f, 0.f, 0.f, 0.f};
        ScanRep<0>::dot8(y, r, st);
        by[mo] = ((y[0] + y[1]) + (y[2] + y[3])) + ((y[4] + y[5]) + (y[6] + y[7]));
        kk = nkk; w = nw; bb = nb; r = nr; kd = nkd; vv = nv; mo = mn;
    }
    if (s < NSG - 1) {
        float* dst = (ISP ? p.PS : p.QS) + (((size_t)c * NSG + s) * 64 + lane) * 64;
#pragma unroll
        for (int k4 = 0; k4 < 16; ++k4) *(f32x4*)(dst + 4 * k4) = (f32x4){st[4 * k4], st[4 * k4 + 1], st[4 * k4 + 2], st[4 * k4 + 3]};
    }
}
__device__ __forceinline__ void ph_scan_fast(const Params& p) {
    const int tid_ = opq_tid(), bid_ = opq_bid(); (void)tid_; (void)bid_;
    const int lane = tid_ & 63, gw = bid_ * 4 + (tid_ >> 6), nw = VGRID * 4;
    constexpr int NS_T = 64 * NSG, NP_T = 64 * (NSG - 1);
    const int G = VGRID, wv = tid_ >> 6; (void)gw; (void)nw;
    for (int tsk = wv * G + bid_; tsk < NS_T + NP_T; tsk += 4 * G) {
        const int t2 = __builtin_amdgcn_readfirstlane(tsk);
        if (t2 < NS_T) scan_task<false>(p, t2 & 63, t2 >> 6, lane);
        else scan_task<true>(p, (t2 - NS_T) & 63, 1 + ((t2 - NS_T) >> 6), lane);
    }
}
__device__ __forceinline__ void ph_combine(const Params& p, char* lds) {
    const int tid_ = opq_tid(), bid_ = opq_bid(); (void)tid_; (void)bid_; (void)lds;
    if (bid_ >= 64) return;
    const int lane = tid_ & 63, c = bid_, cb = tid_ >> 6, q = lane >> 4, i16 = lane & 15, v = 16 * cb + i16;
    const float* QSc = p.QS + (size_t)c * NSG * 4096; const float* PSc = p.PS + (size_t)c * NSG * 4096; float* SSg = p.SS + (size_t)c * NSG * 4096;
    f32x4 acc[4];
#pragma unroll
    for (int ro = 0; ro < 4; ++ro) acc[ro] = *(const f32x4*)(QSc + v * 64 + 16 * ro + 4 * q);
#pragma unroll 1
    for (int s = 1; s < NSG; ++s) {
#pragma unroll
        for (int ro = 0; ro < 4; ++ro)
#pragma unroll
            for (int j = 0; j < 4; ++j) SSg[(size_t)s * 4096 + (16 * ro + 4 * q + j) * 64 + v] = acc[ro][j];
        if (s == NSG - 1) break;
        const float* P = PSc + (size_t)s * 4096 + (4 * q) * 64 + i16;
        float a[4][4][4];
#pragma unroll
        for (int rb = 0; rb < 4; ++rb)
#pragma unroll
            for (int kk = 0; kk < 4; ++kk)
#pragma unroll
                for (int ro = 0; ro < 4; ++ro) a[rb][kk][ro] = P[(16 * rb + kk) * 64 + 16 * ro];
#pragma unroll
        for (int rb = 0; rb < 4; ++rb) asm volatile("" : "+v"(a[rb][0][0]), "+v"(a[rb][0][1]), "+v"(a[rb][0][2]), "+v"(a[rb][0][3]), "+v"(a[rb][1][0]), "+v"(a[rb][1][1]), "+v"(a[rb][1][2]), "+v"(a[rb][1][3]),
                                                         "+v"(a[rb][2][0]), "+v"(a[rb][2][1]), "+v"(a[rb][2][2]), "+v"(a[rb][2][3]), "+v"(a[rb][3][0]), "+v"(a[rb][3][1]), "+v"(a[rb][3][2]), "+v"(a[rb][3][3]));
        f32x4 nacc[4];
#pragma unroll
        for (int ro = 0; ro < 4; ++ro) nacc[ro] = *(const f32x4*)(QSc + (size_t)s * 4096 + v * 64 + 16 * ro + 4 * q);
#pragma unroll
        for (int rb = 0; rb < 4; ++rb)
#pragma unroll
            for (int kk = 0; kk < 4; ++kk)
#pragma unroll
                for (int ro = 0; ro < 4; ++ro) nacc[ro] = __builtin_amdgcn_mfma_f32_16x16x4f32(a[rb][kk][ro], acc[rb][kk], nacc[ro], 0, 0, 0);
#pragma unroll
        for (int ro = 0; ro < 4; ++ro) acc[ro] = nacc[ro];
    }
}
__device__ __forceinline__ float qsum(float v) {
    float a = v, b = v; asm volatile("s_nop 1\n\tv_permlane16_swap_b32 %0, %1" : "+v"(a), "+v"(b)); v = a + b; a = v; b = v;
    asm volatile("s_nop 1\n\tv_permlane32_swap_b32 %0, %1" : "+v"(a), "+v"(b)); return a + b; }
__device__ __forceinline__ void ph_rwkv_out_fast(const Params& p, int l, bool with_ctx) {
    const int tid_ = opq_tid(), bid_ = opq_bid(); (void)tid_; (void)bid_;
    const int lane = tid_ & 63, i16 = lane & 15, q = lane >> 4, gw = bid_ * 4 + (tid_ >> 6), nw = VGRID * 4;
    constexpr int TOK = 16, NLT = NB * (S / TOK) * 4, NCTK = NB * (L / TOK) * 4;
    const int ntask = NLT + (with_ctx ? NCTK : 0);
    for (int tsk = gw; tsk < ntask; tsk += nw) {
        const bool isCtx = tsk >= NLT; const int r = isCtx ? tsk - NLT : tsk;
        const int h = r & 3, npt = isCtx ? L / TOK : S / TOK, tt = (r >> 2) % npt, b = (r >> 2) / npt;
        const int seg0 = (isCtx ? TOK * tt : L + TOK * tt) / SEGLEN, seg1 = (isCtx ? L - 1 - TOK * tt : L + S - 1 - TOK * tt) / SEGLEN;
        const int m = (isCtx ? TL + b * L + TOK * tt : b * S + TOK * tt) + i16;
        const size_t o = (size_t)m * DA + h * 64 + 4 * q, o1 = o + (size_t)T * DA;
        f32x4 acc[4];
#pragma unroll
        for (int rb = 0; rb < 4; ++rb) acc[rb] = *(const f32x4*)(p.Y + o + 16 * rb) + *(const f32x4*)(p.Y + o1 + 16 * rb);
#pragma unroll
        for (int d = 0; d < 2; ++d) {
            const int seg = d ? seg1 : seg0;
            if (seg > 0) {
                const float* sst = p.SS + (((size_t)(d * NB + b) * 4 + h) * NSG + seg) * 4096 + q * 64 + i16;
                const float* pvp = p.PV + (d ? o1 : o) - 4 * q + q;
                float a[4][16], bq[16];
#pragma unroll
                for (int kk = 0; kk < 16; ++kk) { bq[kk] = pvp[4 * kk];
#pragma unroll
                    for (int rb = 0; rb < 4; ++rb) a[rb][kk] = sst[(4 * kk) * 64 + 16 * rb]; }
#pragma unroll
                for (int rb = 0; rb < 4; ++rb) asm volatile("" : "+v"(a[rb][0]), "+v"(a[rb][1]), "+v"(a[rb][2]), "+v"(a[rb][3]), "+v"(a[rb][4]), "+v"(a[rb][5]), "+v"(a[rb][6]), "+v"(a[rb][7]),
                                                                 "+v"(a[rb][8]), "+v"(a[rb][9]), "+v"(a[rb][10]), "+v"(a[rb][11]), "+v"(a[rb][12]), "+v"(a[rb][13]), "+v"(a[rb][14]), "+v"(a[rb][15]));
#pragma unroll
                for (int kk = 0; kk < 16; ++kk)
#pragma unroll
                    for (int rb = 0; rb < 4; ++rb) acc[rb] = __builtin_amdgcn_mfma_f32_16x16x4f32(a[rb][kk], bq[kk], acc[rb], 0, 0, 0);
            }
        }
        float s = 0.f;
#pragma unroll
        for (int rb = 0; rb < 4; ++rb) s += sum4(acc[rb]);
        const float mu = qsum(s) * (1.0f / 64.f);
        float sq = 0.f, bon = 0.f;
#pragma unroll
        for (int rb = 0; rb < 4; ++rb) { const f32x4 dy = acc[rb] - mu; sq += sum4(dy * dy);
            const f32x4 rr = *(const f32x4*)(p.sR + o + 16 * rb), kds = *(const f32x4*)(p.sKD + o + 16 * rb) + *(const f32x4*)(p.sKD + o1 + 16 * rb), rk = *(const f32x4*)(p.a_r_k + l * DA + h * 64 + 16 * rb + 4 * q);
            bon += sum4(rr * kds * rk); }
        const float rstd = 1.0f / sqrtf(qsum(sq) * (1.0f / 64.f) + GN_EPS); bon = qsum(bon);
#pragma unroll
        for (int rb = 0; rb < 4; ++rb) { const int c = h * 64 + 16 * rb + 4 * q;
            const f32x4 gln = *(const f32x4*)(p.a_lnx_g + l * DA + c), bln = *(const f32x4*)(p.a_lnx_b + l * DA + c), vv = *(const f32x4*)(p.sV + o + 16 * rb);
            bf16_t* mp = p.MIX + (size_t)m * DMIX + c; const f32x4 gg = ld_bf16x4(mp);
            st_bf16x4(mp, ((acc[rb] - mu) * rstd * gln + bln + vv * bon) * gg); }
    }
}


#define LAS __attribute__((address_space(3)))
#define XB_TMO      128
#define XB_XCNT(j)  (256  + 64 * (j))
#define XB_XSUB(j)  (1280 + 64 * (j))
#define XB_XGEN(j)  (2304 + 64 * (j))
#define XB_TOP      3328
#define XB_TOPGEN   3392
#define XCD_BAR_WORDS 3456
#define XB_SPIN_CAP (1u << 20)
static_assert(XCD_BAR_WORDS * 4 <= 16384, "barrier words fit the control region");
__device__ __forceinline__ unsigned xb_ld(unsigned* p)              { return __hip_atomic_load(p, __ATOMIC_RELAXED, __HIP_MEMORY_SCOPE_AGENT); }
__device__ __forceinline__ unsigned xb_add(unsigned* p, unsigned v) { return __hip_atomic_fetch_add(p, v, __ATOMIC_RELAXED, __HIP_MEMORY_SCOPE_AGENT); }
__device__ __forceinline__ unsigned xb_xcc_id() { return (unsigned)__builtin_amdgcn_s_getreg((3 << 11) | 20) & 0xFu; }
#define XB_SPIN(cond, bar) do { unsigned _sp = 0; while (cond) { __builtin_amdgcn_s_sleep(1); \
    if ((++_sp & 255u) == 0u) { if (xb_ld(&(bar)[XB_TMO])) break; if (_sp > XB_SPIN_CAP) { atomicAdd(&(bar)[XB_TMO], 1u); break; } } } } while (0)
struct XcdBarrier { unsigned* bar; unsigned x; volatile LAS unsigned* st; };
__device__ __forceinline__ XcdBarrier xcd_barrier_post(unsigned* bar, volatile LAS unsigned* st) {
    XcdBarrier b; b.bar = bar; b.x = xb_xcc_id(); b.st = st;
    if (threadIdx.x == 0) (void)xb_add(&bar[XB_XCNT(b.x)], 1u);
    return b;
}
__device__ __forceinline__ void xcd_barrier_complete(unsigned* bar, unsigned x, unsigned& nloc, unsigned& nx) {
    const unsigned G = gridDim.x * gridDim.y * gridDim.z;
    unsigned sum, cnt, mine, sp = 0u;
    for (;;) {
        sum = 0u; cnt = 0u; mine = 0u;
#pragma unroll
        for (unsigned j = 0; j < 16; ++j) { const unsigned c = xb_ld(&bar[XB_XCNT(j)]); sum += c; cnt += (c > 0u) ? 1u : 0u; mine = (j == x) ? c : mine; }
        if (sum == G) break;
        __builtin_amdgcn_s_sleep(1);
        if ((++sp & 255u) == 0u) { if (xb_ld(&bar[XB_TMO])) break; if (sp > XB_SPIN_CAP) { atomicAdd(&bar[XB_TMO], 1u); break; } }
    }
    nloc = mine > 0u ? mine : 1u; nx = cnt > 0u ? cnt : 1u;
}
__device__ __forceinline__ void xcd_barrier(const XcdBarrier& b) {
    asm volatile("s_waitcnt vmcnt(0)" ::: "memory");
    __syncthreads();
    if (threadIdx.x == 0) {
        unsigned* bar = b.bar;
        __builtin_amdgcn_s_waitcnt(0);
        unsigned nloc = b.st[0], nx = b.st[1];
        if (nloc == 0u) { xcd_barrier_complete(bar, b.x, nloc, nx); b.st[0] = nloc; b.st[1] = nx; }
        const unsigned old = xb_add(&bar[XB_XSUB(b.x)], 1u);
        const unsigned gen = old / nloc;
        if (old + 1u == (gen + 1u) * nloc) {
            __builtin_amdgcn_fence(__ATOMIC_RELEASE, "agent");
            asm volatile("s_waitcnt vmcnt(0)" ::: "memory");
            const unsigned og = xb_add(&bar[XB_TOP], 1u);
            const unsigned tg = og / nx;
            if (og + 1u == (tg + 1u) * nx) xb_add(&bar[XB_TOPGEN], 1u);
            else XB_SPIN(xb_ld(&bar[XB_TOPGEN]) == tg, bar);
            __builtin_amdgcn_fence(__ATOMIC_ACQUIRE, "agent");
            xb_add(&bar[XB_XGEN(b.x)], 1u);
            asm volatile("s_waitcnt vmcnt(0)" ::: "memory");
        } else {
            XB_SPIN(xb_ld(&bar[XB_XGEN(b.x)]) == gen, bar);
            __builtin_amdgcn_fence(__ATOMIC_ACQUIRE, "agent");
            asm volatile("s_waitcnt vmcnt(0)" ::: "memory");
        }
    }
    __syncthreads();
}

__device__ __forceinline__ long opq_gt() { int t = threadIdx.x; asm volatile("" : "+v"(t)); return (long)blockIdx.x * blockDim.x + t; }
#define GS ((long)gridDim.x * blockDim.x)
__global__ void __launch_bounds__(512, 1) mega_fwd(Params p) {
    __shared__ __attribute__((aligned(16))) char lds_all[2 * 73728 + 64];
    cg::grid_group grid = cg::this_grid();
    const long gs = GS;
#define gt opq_gt()
    char* lds = lds_all + __builtin_amdgcn_readfirstlane(threadIdx.x >> 8) * 73728;
    volatile LAS unsigned* bst = (volatile LAS unsigned*)(LAS char*)(lds_all + 2 * 73728);
    if (threadIdx.x < 2) bst[threadIdx.x] = 0u;
    __syncthreads();
    const XcdBarrier xb = xcd_barrier_post(p.bar, bst);
#ifndef PROBE_PHASE
#define PROBE_PHASE -1
#endif
#define PROBE_AMP 8
    unsigned long long t_prev = 0; int nts = 0;
#define STAMP() do { if (PROBE_PHASE >= 0 && blockIdx.x == 0 && threadIdx.x == 0) { const unsigned long long t_now = __builtin_amdgcn_s_memrealtime(); \
        if (nts == PROBE_PHASE + 1) { const unsigned long long t_end = t_now + PROBE_AMP * (t_now - t_prev); while (__builtin_amdgcn_s_memrealtime() < t_end) __builtin_amdgcn_s_sleep(8); } \
        t_prev = __builtin_amdgcn_s_memrealtime(); } ++nts; } while (0)
#define GSYNC() do { xcd_barrier(xb); STAMP(); } while (0)
    STAMP();
    ph_mod_fast(p, lds); ph_prep_w_fast(p, 0, 0, lds); ph_prep_misc(p, 0, gt, gs, false);
    if (p.out == nullptr) grid.sync();
    GSYNC();
    for (int l = 0; l < 2; ++l) {
        const int nrows = (l == 0) ? T : TL;
        if (l == 0) { ph_lnmod_fast(p, l); GSYNC(); }
        g_gemm_in(p, lds_all);
        GSYNC();
        ph_streams_s1(p, l);
        GSYNC();
        g_streams_s2(p, l, lds);
        GSYNC();
        ph_scan_fast(p);
        GSYNC();
        ph_combine(p, lds); ph_attn_blk(p, l, l == 0, 64, lds);
        GSYNC();
        ph_rwkv_out_fast(p, l, l == 0);
        GSYNC();
        if (blockIdx.x >= gridDim.x / 2) { ph_prep_w_fast(p, l, 1, lds); __syncthreads(); g_gemm_out(p, nrows, lds_all); } else { g_gemm_out(p, nrows, lds_all); __syncthreads(); ph_prep_w_fast(p, l, 1, lds); }
        GSYNC();
        g_router(p, l, nrows, lds);
        GSYNC();
        ph_dispatch_fast(p, l, nrows, lds);
        GSYNC();
        g_moe1(p, l, lds_all);
        GSYNC();
        g_moe2(p, l, lds_all);
        GSYNC();
        ph_final_fast(p, l, nrows, l == 0);
        if (l == 0) { ph_prep_w_fast(p, 1, 0, lds); ph_prep_misc(p, 1, gt, gs, false); }
        GSYNC();
    }}

extern "C" void kernel_launch(void* const* d_in, const int* in_sizes, int n_in, void* d_out, int out_size, void* d_ws, size_t ws_size, hipStream_t stream) {
    if (n_in != 32 || out_size != TL * D || ws_size < WS_NEED) { fprintf(stderr, "kernel_launch: unexpected shapes / workspace (n_in %d out %d ws %zu need %zu)\n", n_in, out_size, ws_size, (size_t)WS_NEED); return; }
    static int grid_blocks = 0;
    if (!grid_blocks) {
        int dev = 0, cus = 0, per_cu = 0;
        (void)hipGetDevice(&dev);
        (void)hipDeviceGetAttribute(&cus, hipDeviceAttributeMultiprocessorCount, dev);
        (void)hipOccupancyMaxActiveBlocksPerMultiprocessor(&per_cu, mega_fwd, 512, 0);
        if (per_cu < 1) per_cu = 1;
        if (per_cu > 1) per_cu = 1;
        grid_blocks = cus * per_cu;
        fprintf(stderr, "kernel_launch: %d CUs x %d blocks\n", cus, per_cu);
    }
    Params p = make_params(d_in, d_out, d_ws);
    (void)hipMemsetAsync(d_ws, 0, CTL_BYTES, stream);
    void* args[] = {&p};
    hipError_t e = hipLaunchCooperativeKernel((void*)mega_fwd, dim3(grid_blocks), dim3(512), args, 0, stream);
    if (e != hipSuccess) fprintf(stderr, "cooperative launch failed: %s (grid %d)\n", hipGetErrorString(e), grid_blocks);
}
#endif

#ifdef HOST_EMU
static void host_forward(void* const* d_in, void* d_out, void* d_ws) {
    const Params p = make_params(d_in, d_out, d_ws);
    for (int l = 0; l < 2; ++l) {
        const int nrows = (l == 0) ? T : TL;
        ph_prep_w(p, l, 0, 1); ph_prep_misc(p, l, 0, 1); ph_lnmod(p, l, 0, 1); host_gemm_in(p); ph_streams(p, l, 0, 1); ph_rope(p, 0, 1); ph_scan(p, 0, 1);
        ph_attn(p, l, nrows, 0, 1); ph_rwkv_out(p, l, nrows, 0, 1); host_gemm_out(p, nrows); ph_post_mixer(p, l, nrows, 0, 1);
        ph_dispatch(p, l, nrows, 0, 1); host_moe1(p, l); host_moe2(p, l); ph_final(p, l, nrows, 0, 1);
    }
}
#endif
```

```cpp
#ifdef HOST_EMU
#include <cmath>
#include <cstdio>
#include <cstring>
#include <cstdint>
#include <cstdlib>
#define __device__
#define __global__
#define __host__
#define __forceinline__ inline
#else
#include <hip/hip_runtime.h>
#include <hip/hip_cooperative_groups.h>
#include <cstdio>
#include <cstdint>
namespace cg = cooperative_groups;
#endif

#ifndef CFG_D
#define CFG_D 1024
#define CFG_B 8
#define CFG_S 2048
#define CFG_L 256
#define CFG_DE 512
#endif
constexpr int D = CFG_D, NB = CFG_B, S = CFG_S, L = CFG_L, DE = CFG_DE;
constexpr int TL = NB * S, TC = NB * L, T = TL + TC;
constexpr int GRID_W = 64, HD = 64;
constexpr int DA = 256, A_IN = 1184, N_IN = 2976, NINP = 3072, DMIX = 1024;
#ifdef HOST_EMU
constexpr int MPAD = 128;
#else
constexpr int MPAD = 256;
#endif
constexpr int NEXP = 32, NSLOT = 2 * T + NEXP * MPAD;
#ifdef HOST_EMU
constexpr int ZQB = 0, ZKB = 384, ZVB = 512, ZQN = 640, ZKN = 1024, ZVN = 1408, ZA = 1792, ZP = 2976;
#else
constexpr int ZQB = 0, ZKB = 384, ZQN = 512, ZKN = 896, ZA = 1280, ZP = 2464, WVB = 2560, WVN = 2688;
#endif
constexpr float LN_EPS = 1e-6f, GN_EPS = 64e-5f, ATT_SCALE = 0.125f, LOG2E = 1.4426950408889634f, QSCALE = ATT_SCALE * LOG2E;
constexpr float ALPHA = 1.41421356237309515f;

typedef unsigned short bf16_t;

__device__ __forceinline__ float bf2f(bf16_t v) {
    unsigned u = ((unsigned)v) << 16; float f;
#ifdef HOST_EMU
    memcpy(&f, &u, 4);
#else
    f = __uint_as_float(u);
#endif
    return f;
}
__device__ __forceinline__ bf16_t f2bf(float f) {
    unsigned u;
#ifdef HOST_EMU
    memcpy(&u, &f, 4);
#else
    u = __float_as_uint(f);
#endif
    return (bf16_t)((u + 0x7fffu + ((u >> 16) & 1u)) >> 16);
}
__device__ __forceinline__ float sigmoidf_(float x) { return 1.0f / (1.0f + expf(-x)); }
__device__ __forceinline__ float siluf_(float x) { return x / (1.0f + expf(-x)); }
__device__ __forceinline__ int atomic_inc_int(int* p) {
#ifdef HOST_EMU
    int o = *p; *p = o + 1; return o;
#else
    return atomicAdd(p, 1);
#endif
}

struct Params {
    const float *x, *c, *ctx, *c_ctx, *w_mod, *b_mod, *w_in, *w_out, *a_shift, *a_w0, *a_w_up, *a_a0, *a_a_up, *a_g_up,
        *a_k_k, *a_k_a, *a_r_k, *a_lnx_g, *a_lnx_b, *b_sink, *c_rpb, *ln1_g, *ln1_b, *ln2_g, *ln2_b, *w_rg, *b_rg, *w_re,
        *b_re, *w_gate, *w_up, *w_down;
    float* out;
    int* cnt;
    unsigned* bar;
    float* mod;
    float* rope;
    bf16_t *win_t, *wout_t, *wgu_t, *wd_t;
    bf16_t *wrt;
    int* hist;
    bf16_t* HLO;
    bf16_t *wupT, *aupT, *gupT;
    bf16_t* LA;
    float *kT, *kN;
    bf16_t* H;
    bf16_t* Z;
    bf16_t* VT;
    float *sR, *sV, *sKK, *sG, *sW, *sKD, *sB;
    float* Y;
    bf16_t* MIX;
    float *PV, *QS, *PS, *SS;
    float* XC;
    bf16_t* O;
    bf16_t* YSb;
    int *rE, *rPos, *rSlot; float* rW;
    int* slotTok;
    bf16_t* ACT;
    float* YS;
};

constexpr size_t al256(size_t v) { return (v + 255) & ~(size_t)255; }
constexpr size_t OFF_CNT = 0;
constexpr size_t OFF_BAR = 4096, CTL_BYTES = 4096 + 16384;
constexpr size_t OFF_MOD = CTL_BYTES;
constexpr size_t OFF_ROPE = al256(OFF_MOD + (size_t)2 * (NB + 1) * 6 * D * 4);
constexpr size_t OFF_LORA = al256(OFF_ROPE + 64 * 16 * 2 * 4);
constexpr size_t OFF_WRT = al256(OFF_LORA + (size_t)(2 * 256 * 64 * 2 + 256 * 160) * 2);
constexpr size_t OFF_LG = al256(OFF_WRT + (size_t)2 * 128 * D * 2);
constexpr size_t OFF_WIN = al256(OFF_LG + (size_t)(T / 32) * 32 * 4);
constexpr size_t OFF_WOUT = al256(OFF_WIN + (size_t)NINP * D * 2);
constexpr size_t OFF_WGU = al256(OFF_WOUT + (size_t)D * DMIX * 2);
constexpr size_t OFF_WD = al256(OFF_WGU + (size_t)NEXP * 2 * DE * D * 2);
constexpr size_t OFF_H = al256(OFF_WD + (size_t)NEXP * D * DE * 2);
constexpr size_t OFF_Z = al256(OFF_H + (size_t)(T + 1) * D * 2);
constexpr int PU = L + S;
constexpr int SEGLEN = 144, NSG = (L + S) / SEGLEN;
#ifndef HOST_EMU
static_assert((L + S) % SEGLEN == 0 && SEGLEN % 16 == 0 && L % 16 == 0 && S % 16 == 0, "16-token output tiles must not straddle scan segments");
static_assert((size_t)3 * 64 * NSG * 4096 * 4 <= (size_t)NEXP * 2 * DE * D * 2, "scan segment states overlay wgu_t");
#endif
constexpr size_t OFF_VT = al256(OFF_Z + (size_t)T * 2976 * 2);
constexpr size_t OFF_S = al256(OFF_VT + (size_t)NB * 8 * 64 * PU * 2);
constexpr size_t S1 = (size_t)T * 256 * 4;
#ifdef HOST_EMU
constexpr int NSTREAM = 10;
#else
constexpr int NSTREAM = 9;
#endif
constexpr size_t OFF_Y = al256(OFF_S + NSTREAM * S1);
constexpr size_t OFF_MIX = al256(OFF_Y + 2 * S1);
constexpr size_t OFF_XC = al256(OFF_MIX + (size_t)T * 1024 * 2);
constexpr size_t OFF_ROUTE = al256(OFF_XC + (size_t)TC * D * 4);
constexpr size_t OFF_SLOTTOK = al256(OFF_ROUTE + (size_t)T * 2 * 4 * 4);
constexpr size_t WS_NEED = al256(OFF_SLOTTOK + (size_t)NSLOT * 4);
static_assert((size_t)NSLOT * DE * 2 <= (size_t)T * 2976 * 2 && (size_t)T * D * 2 <= (size_t)T * 2976 * 2, "ACT / HLO overlay Z");
static_assert((size_t)T * 4 * 4 + (size_t)T * 416 * 2 <= S1, "kN + LA overlay Y[1]");
#ifdef HOST_EMU
static_assert((size_t)NSLOT * D * 4 <= NSTREAM * S1 && (size_t)T * D * 4 <= NSTREAM * S1, "YS / O overlay the stream buffers");
#else
static_assert((size_t)NSLOT * D * 2 <= NSTREAM * S1 && (size_t)T * D * 2 <= NSTREAM * S1, "YSb / O overlay the stream buffers");
#endif

static Params make_params(void* const* d_in, void* d_out, void* d_ws) {
    Params p{};
    const float** f = (const float**)&p.x;
    for (int i = 0; i < 32; ++i) f[i] = (const float*)d_in[i];
    p.out = (float*)d_out;
    char* w = (char*)d_ws;
    p.cnt = (int*)(w + OFF_CNT); p.bar = (unsigned*)(w + OFF_BAR); p.mod = (float*)(w + OFF_MOD); p.rope = (float*)(w + OFF_ROPE);
    p.win_t = (bf16_t*)(w + OFF_WIN); p.wout_t = (bf16_t*)(w + OFF_WOUT); p.wgu_t = (bf16_t*)(w + OFF_WGU); p.wd_t = (bf16_t*)(w + OFF_WD);
    p.wrt = (bf16_t*)(w + OFF_WRT); p.hist = (int*)(w + OFF_LG); p.HLO = (bf16_t*)(w + OFF_Z);
    p.wupT = (bf16_t*)(w + OFF_LORA); p.aupT = p.wupT + 2 * 256 * 64; p.gupT = p.aupT + 2 * 256 * 64;
    p.H = (bf16_t*)(w + OFF_H); p.Z = (bf16_t*)(w + OFF_Z); p.VT = (bf16_t*)(w + OFF_VT);
    float* s = (float*)(w + OFF_S); const size_t n1 = (size_t)T * 256;
    p.sR = s; p.sV = s + n1; p.sKK = s + 2 * n1; p.sW = s + 3 * n1; p.sKD = s + 5 * n1; p.sB = s + 7 * n1; p.sG = s + 9 * n1;
    p.Y = (float*)(w + OFF_Y); p.MIX = (bf16_t*)(w + OFF_MIX); p.XC = (float*)(w + OFF_XC);
    p.O = (bf16_t*)(w + OFF_S); p.YSb = (bf16_t*)(w + OFF_S);
    p.PV = (float*)(w + OFF_H); p.QS = (float*)(w + OFF_WGU); p.PS = p.QS + (size_t)64 * NSG * 4096; p.SS = p.PS + (size_t)64 * NSG * 4096;
    p.kT = p.Y; p.kN = p.Y + (size_t)T * 256; p.LA = (bf16_t*)(p.Y + (size_t)T * 256 + (size_t)T * 4);
    int* r = (int*)(w + OFF_ROUTE); p.rE = r; p.rPos = r + 2 * T; p.rSlot = r + 4 * T; p.rW = (float*)(r + 6 * T);
    p.slotTok = (int*)(w + OFF_SLOTTOK);
    p.ACT = (bf16_t*)(w + OFF_Z); p.YS = (float*)(w + OFF_S);
    return p;
}

#ifdef HOST_EMU
__device__ void ph_prep_w(const Params& p, int l, long gtid, long gsz) {
    for (long i = gtid; i < (long)D * NINP; i += gsz) {
        const int k = (int)(i / NINP), n = (int)(i % NINP);
        float v = 0.f;
        if (n < N_IN) { const int oc = (n < ZA) ? n + A_IN : n - ZA; v = p.w_in[((size_t)l * D + k) * N_IN + oc]; }
        p.win_t[(size_t)n * D + k] = f2bf(v);
    }
    for (long i = gtid; i < (long)DMIX * D; i += gsz) {
        const int k = (int)(i / D), n = (int)(i % D);
        p.wout_t[(size_t)n * DMIX + k] = f2bf(p.w_out[((size_t)l * DMIX + k) * D + n]);
    }
    for (long i = gtid; i < (long)NEXP * D * 2 * DE; i += gsz) {
        const int rho = (int)(i % (2 * DE)); const long t = i / (2 * DE); const int k = (int)(t % D), e = (int)(t / D);
        const int q = rho >> 5, half = (rho >> 4) & 1, ii = rho & 15, cc = 16 * q + ii;
        const float* src = half ? p.w_up : p.w_gate;
        p.wgu_t[((size_t)e * 2 * DE + rho) * D + k] = f2bf(src[(((size_t)l * NEXP + e) * D + k) * DE + cc]);
    }
    for (long i = gtid; i < (long)NEXP * DE * D; i += gsz) {
        const int n = (int)(i % D); const long t = i / D; const int k = (int)(t % DE), e = (int)(t / DE);
        p.wd_t[((size_t)e * D + n) * DE + k] = f2bf(p.w_down[(((size_t)l * NEXP + e) * DE + k) * D + n]);
    }
}
#endif
__device__ __forceinline__ void ph_prep_misc(const Params& p, int l, long gtid, long gsz, bool do_mod = true) {
    if (l == 0 && do_mod) for (long i = gtid; i < (long)2 * (NB + 1) * 6 * D; i += gsz) {
        const int j = (int)(i % (6 * D)), b = (int)((i / (6 * D)) % (NB + 1)), ll = (int)(i / ((long)6 * D * (NB + 1)));
        const float* cv = (b < NB) ? p.c + (size_t)b * D : p.c_ctx;
        float acc = 0.f;
        for (int k = 0; k < D; ++k) acc += siluf_(cv[k]) * p.w_mod[((size_t)ll * D + k) * 6 * D + j];
        p.mod[((size_t)ll * (NB + 1) + b) * 6 * D + j] = acc + p.b_mod[(size_t)ll * 6 * D + j];
    }
    if (l == 0) for (long i = gtid; i < 64 * 16; i += gsz) {
        const int pos = (int)(i / 16), fi = (int)(i % 16);
        const float inv = powf(10000.0f, -(float)fi / 16.0f), ang = (float)pos * inv;
        p.rope[i] = cosf(ang); p.rope[1024 + i] = sinf(ang);
    }
    for (long i = gtid; i < NEXP; i += gsz) p.cnt[l * NEXP + i] = 0;
    for (long i = gtid; i < NSLOT; i += gsz) p.slotTok[i] = T;
    for (long i = gtid; i < D; i += gsz) p.H[(size_t)T * D + i] = 0;
}

__device__ __forceinline__ const float* xrow_in(const Params& p, int l, int m) {
    if (m < TL) return (l == 0 ? p.x : p.out) + (size_t)m * D;
    return (l == 0 ? p.ctx : p.XC) + (size_t)(m - TL) * D;
}
__device__ __forceinline__ const float* modrow(const Params& p, int l, int m) { return p.mod + ((size_t)l * (NB + 1) + (m < TL ? m / S : NB)) * 6 * D; }

__device__ void ph_lnmod(const Params& p, int l, long gtid, long gsz) {
    for (long m = gtid; m < T; m += gsz) {
        const float* xr = xrow_in(p, l, (int)m); const float* md = modrow(p, l, (int)m);
        float s = 0.f; for (int j = 0; j < D; ++j) s += xr[j];
        const float mu = s / D; float q = 0.f;
        for (int j = 0; j < D; ++j) { const float d = xr[j] - mu; q += d * d; }
        const float rstd = 1.0f / sqrtf(q / D + LN_EPS);
        for (int j = 0; j < D; ++j) p.H[(size_t)m * D + j] = f2bf((xr[j] - mu) * rstd * (1.0f + md[D + j]) + md[j]);
    }
}

__device__ __forceinline__ float zshift(const Params& p, int l, int m, int col) {
    int t, len;
    if (m < TL) { t = m % S; len = S; } else { t = (m - TL) % L; len = L; }
    const float* sh = p.a_shift + (size_t)l * 3 * A_IN;
    const bf16_t* z = p.Z + (size_t)m * ZP + ZA + col;
    float v = sh[A_IN + col] * bf2f(z[0]);
    if (t > 0) v += sh[col] * bf2f(z[-ZP]);
    if (t < len - 1) v += sh[2 * A_IN + col] * bf2f(z[ZP]);
    return v;
}

__device__ void ph_streams(const Params& p, int l, long gtid, long gsz) {
    for (long i = gtid; i < (long)T * DA; i += gsz) {
        const int m = (int)(i / DA), c = (int)(i % DA), h0 = c & ~63;
        const float r = zshift(p, l, m, c), k = zshift(p, l, m, 256 + c), v = zshift(p, l, m, 512 + c);
        float nrm = 0.f;
        for (int j = 0; j < 64; ++j) { const float t = zshift(p, l, m, 256 + h0 + j) * p.a_k_k[l * DA + h0 + j]; nrm += t * t; }
        const float kk = k * p.a_k_k[l * DA + c] / sqrtf(nrm + 1e-12f);
        float g = 0.f;
        for (int j = 0; j < 160; ++j) g += sigmoidf_(zshift(p, l, m, 1024 + j)) * p.a_g_up[((size_t)l * 160 + j) * DA + c];
        const size_t o = (size_t)m * DA + c;
        p.sR[o] = r; p.sV[o] = v; p.sKK[o] = kk; p.sG[o] = g;
        for (int d = 0; d < 2; ++d) {
            float aw = 0.f, aa = 0.f;
            for (int j = 0; j < 64; ++j) {
                aw += tanhf(zshift(p, l, m, 768 + d * 64 + j)) * p.a_w_up[(((size_t)l * 2 + d) * 64 + j) * DA + c];
                aa += zshift(p, l, m, 896 + d * 64 + j) * p.a_a_up[(((size_t)l * 2 + d) * 64 + j) * DA + c];
            }
            const float u = -(p.a_w0[(l * 2 + d) * DA + c] + aw);
            const float sp = (u > 20.f) ? u : log1pf(expf(u));
            const float w = expf(-expf(-sp - 0.5f));
            const float a = sigmoidf_(p.a_a0[(l * 2 + d) * DA + c] + aa);
            const size_t od = ((size_t)d * T + m) * DA + c;
            p.sW[od] = w; p.sKD[od] = k * (1.0f + (a - 1.0f) * p.a_k_a[l * DA + c]); p.sB[od] = kk * a;
        }
    }
}

__device__ __forceinline__ void ph_rope(const Params& p, long gtid, long gsz) {
    for (long i = gtid; i < (long)TL * 8 * 32; i += gsz) {
        const int pr = (int)(i & 31), hs = (int)((i >> 5) & 7), m = (int)(i >> 8);
        const int t = m % S, axis = pr >> 4, fi = pr & 15, pos = axis ? (t % GRID_W) : (t / GRID_W);
        bf16_t* z = p.Z + (size_t)m * ZP + hs * 64 + axis * 32 + fi;
        const float cs = p.rope[pos * 16 + fi], sn = p.rope[1024 + pos * 16 + fi];
        const float x0 = bf2f(z[0]), x1 = bf2f(z[16]);
        z[0] = f2bf(x0 * cs - x1 * sn); z[16] = f2bf(x1 * cs + x0 * sn);
    }
}

__device__ void ph_scan(const Params& p, long gtid, long gsz) {
    for (long i = gtid; i < (long)2 * NB * 4 * 64; i += gsz) {
        const int v = (int)(i & 63), h = (int)((i >> 6) & 3), b = (int)((i >> 8) % NB), d = (int)((i >> 8) / NB);
        float st[64];
#pragma unroll
        for (int k = 0; k < 64; ++k) st[k] = 0.f;
        for (int pos = 0; pos < L + S; ++pos) {
            int m;
            if (pos < L) m = TL + b * L + (d ? L - 1 - pos : pos);
            else m = b * S + (d ? S - 1 - (pos - L) : pos - L);
            const size_t o = (size_t)m * DA + h * 64, od = ((size_t)d * T + m) * DA + h * 64;
            const float* kk = p.sKK + o; const float* r = p.sR + o;
            const float* w = p.sW + od; const float* bb = p.sB + od; const float* kd = p.sKD + od;
            const float vv = p.sV[o + v];
            float sk = 0.f;
#pragma unroll
            for (int k = 0; k < 64; ++k) sk += st[k] * kk[k];
            float y = 0.f;
#pragma unroll
            for (int k = 0; k < 64; ++k) { st[k] = st[k] * w[k] - sk * bb[k] + vv * kd[k]; y += st[k] * r[k]; }
            p.Y[od + v] = y;
        }
    }
}

__device__ void ph_rwkv_out(const Params& p, int l, int nrows, long gtid, long gsz) {
    for (long i = gtid; i < (long)nrows * 4; i += gsz) {
        const int m = (int)(i >> 2), h = (int)(i & 3);
        const size_t o = (size_t)m * DA + h * 64;
        const float* y0 = p.Y + o; const float* y1 = p.Y + (size_t)T * DA + o;
        float s = 0.f, bon = 0.f;
        for (int n = 0; n < 64; ++n) {
            s += y0[n] + y1[n];
            bon += p.sR[o + n] * (p.sKD[o + n] + p.sKD[(size_t)T * DA + o + n]) * p.a_r_k[l * DA + h * 64 + n];
        }
        const float mu = s / 64.f; float q = 0.f;
        for (int n = 0; n < 64; ++n) { const float dd = y0[n] + y1[n] - mu; q += dd * dd; }
        const float rstd = 1.0f / sqrtf(q / 64.f + GN_EPS);
        for (int n = 0; n < 64; ++n) {
            const int c = h * 64 + n;
            const float yn = (y0[n] + y1[n] - mu) * rstd * p.a_lnx_g[l * DA + c] + p.a_lnx_b[l * DA + c];
            p.MIX[(size_t)m * DMIX + c] = f2bf((yn + bon * p.sV[o + n]) * p.sG[o + n]);
        }
    }
}

#ifdef HOST_EMU
__device__ __forceinline__ void att_key(const float (&q)[64], const bf16_t* kr, const bf16_t* vr, float bias, float& mx, float& ls, float (&acc)[64]) {
    float s = 0.f;
#pragma unroll
    for (int d = 0; d < 64; ++d) s += q[d] * bf2f(kr[d]);
    s = s * ATT_SCALE + bias;
    const float mn = fmaxf(mx, s), f = expf(mx - mn), pe = expf(s - mn);
    ls = ls * f + pe;
#pragma unroll
    for (int d = 0; d < 64; ++d) acc[d] = acc[d] * f + pe * bf2f(vr[d]);
    mx = mn;
}

__device__ void ph_attn(const Params& p, int l, int nrows, long gtid, long gsz) {
    for (long i = gtid; i < (long)nrows * 12; i += gsz) {
        const int m = (int)(i / 12), u = (int)(i % 12);
        const bool isB = u < 6; const int hq = isB ? u : u - 6;
        const int b = (m < TL) ? m / S : (m - TL) / L;
        const int qcol = isB ? ZQB + hq * 64 : ZQN + hq * 64;
        const int kcol = isB ? ZKB + (hq / 3) * 64 : ZKN + hq * 64;
        const int vcol = isB ? ZVB + (hq / 3) * 64 : ZVN + hq * 64;
        float q[64], acc[64];
        const bf16_t* qr = p.Z + (size_t)m * ZP + qcol;
#pragma unroll
        for (int d = 0; d < 64; ++d) { q[d] = bf2f(qr[d]); acc[d] = 0.f; }
        float mx, ls;
        if (isB) { mx = p.b_sink[l * 6 + hq]; ls = 1.0f; } else { mx = -1e30f; ls = 0.f; }
        for (int j = 0; j < L; ++j) { const bf16_t* zr = p.Z + (size_t)(TL + b * L + j) * ZP; att_key(q, zr + kcol, zr + vcol, 0.f, mx, ls, acc); }
        if (m < TL) {
            const int t = m % S;
            if (isB) {
                const int j0 = t - 128 < 0 ? 0 : t - 128, j1 = t + 128 > S - 1 ? S - 1 : t + 128;
                for (int j = j0; j <= j1; ++j) { const bf16_t* zr = p.Z + (size_t)(b * S + j) * ZP; att_key(q, zr + kcol, zr + vcol, 0.f, mx, ls, acc); }
            } else {
                const int rows = S / GRID_W, r = t / GRID_W, c = t % GRID_W;
                int r0 = r - 4; r0 = r0 < 0 ? 0 : (r0 > rows - 8 ? rows - 8 : r0);
                int c0 = c - 8; c0 = c0 < 0 ? 0 : (c0 > GRID_W - 16 ? GRID_W - 16 : c0);
                for (int a = 0; a < 8; ++a)
                    for (int e = 0; e < 16; ++e) {
                        const int kr = r0 + a, kc = c0 + e;
                        const float bias = p.c_rpb[(((size_t)l * 6 + hq) * 15 + (kr - r + 7)) * 31 + (kc - c + 15)];
                        const bf16_t* zr = p.Z + (size_t)(b * S + kr * GRID_W + kc) * ZP;
                        att_key(q, zr + kcol, zr + vcol, bias, mx, ls, acc);
                    }
            }
        }
        const float inv = 1.0f / ls;
        bf16_t* o = p.MIX + (size_t)m * DMIX + (isB ? 256 : 640) + hq * 64;
#pragma unroll
        for (int d = 0; d < 64; ++d) o[d] = f2bf(acc[d] * inv);
    }
}

#endif
__device__ void ph_post_mixer(const Params& p, int l, int nrows, long gtid, long gsz) {
    for (long mm = gtid; mm < nrows; mm += gsz) {
        const int m = (int)mm;
        const float* xr = xrow_in(p, l, m); const float* md = modrow(p, l, m); const float* orow = (const float*)p.O + (size_t)m * D;
        float* x1 = (m < TL) ? p.out + (size_t)m * D : p.XC + (size_t)(m - TL) * D;
        const float* g1 = p.ln1_g + (size_t)l * D; const float* b1 = p.ln1_b + (size_t)l * D;
        float s = 0.f; for (int j = 0; j < D; ++j) s += ALPHA * xr[j] + md[2 * D + j] * orow[j];
        float mu = s / D, q = 0.f;
        for (int j = 0; j < D; ++j) { const float d = ALPHA * xr[j] + md[2 * D + j] * orow[j] - mu; q += d * d; }
        float rstd = 1.0f / sqrtf(q / D + LN_EPS);
        s = 0.f;
        for (int j = 0; j < D; ++j) { const float v = (ALPHA * xr[j] + md[2 * D + j] * orow[j] - mu) * rstd * g1[j] + b1[j]; x1[j] = v; s += v; }
        mu = s / D; q = 0.f;
        for (int j = 0; j < D; ++j) { const float d = x1[j] - mu; q += d * d; }
        rstd = 1.0f / sqrtf(q / D + LN_EPS);
        float gl[4], el[32];
#pragma unroll
        for (int g = 0; g < 4; ++g) gl[g] = p.b_rg[l * 4 + g];
#pragma unroll
        for (int e = 0; e < 32; ++e) el[e] = p.b_re[l * 32 + e];
        for (int j = 0; j < D; ++j) {
            const float hv = (x1[j] - mu) * rstd * (1.0f + md[4 * D + j]) + md[3 * D + j];
            p.H[(size_t)m * D + j] = f2bf(hv);
            const float* wg = p.w_rg + ((size_t)l * D + j) * 4; const float* we = p.w_re + ((size_t)l * D + j) * 32;
#pragma unroll
            for (int g = 0; g < 4; ++g) gl[g] += hv * wg[g];
#pragma unroll
            for (int e = 0; e < 32; ++e) el[e] += hv * we[e];
        }
        int gs = 0; float gm = gl[0];
#pragma unroll
        for (int g = 1; g < 4; ++g) if (gl[g] > gm) { gm = gl[g]; gs = g; }
        float den = 0.f;
#pragma unroll
        for (int g = 0; g < 4; ++g) den += expf(gl[g] - gm);
        const float pg = 1.0f / den;
        float v1 = -3e38f, v2 = -3e38f; int i1 = 0, i2 = 0;
#pragma unroll
        for (int j = 0; j < 8; ++j) {
            const float v = gs == 0 ? el[j] : gs == 1 ? el[8 + j] : gs == 2 ? el[16 + j] : el[24 + j];
            if (v > v1) { v2 = v1; i2 = i1; v1 = v; i1 = j; } else if (v > v2) { v2 = v; i2 = j; }
        }
        const float e2 = expf(v2 - v1), w1 = pg / (1.0f + e2), w2 = pg * e2 / (1.0f + e2);
        const int ea = gs * 8 + i1, eb = gs * 8 + i2;
        p.rE[2 * m] = ea; p.rE[2 * m + 1] = eb; p.rW[2 * m] = w1; p.rW[2 * m + 1] = w2;
        p.rPos[2 * m] = atomic_inc_int(p.cnt + l * NEXP + ea); p.rPos[2 * m + 1] = atomic_inc_int(p.cnt + l * NEXP + eb);
    }
}

__device__ __forceinline__ int pstart_of(const int* cnt, int e) {
    int s = 0;
    for (int j = 0; j < NEXP; ++j) if (j < e) s += (cnt[j] + 127) & ~127;
    return s;
}
__device__ __forceinline__ void ph_dispatch(const Params& p, int l, int nrows, long gtid, long gsz) {
    for (long i = gtid; i < (long)nrows * 2; i += gsz) {
        const int slot = pstart_of(p.cnt + l * NEXP, p.rE[i]) + p.rPos[i];
        p.rSlot[i] = slot; p.slotTok[slot] = (int)(i >> 1);
    }
}

__device__ void ph_final(const Params& p, int l, int nrows, long gtid, long gsz) {
    for (long mm = gtid; mm < nrows; mm += gsz) {
        const int m = (int)mm;
        float* x1 = (m < TL) ? p.out + (size_t)m * D : p.XC + (size_t)(m - TL) * D;
        const float* md = modrow(p, l, m);
        const float* ya = p.YS + (size_t)p.rSlot[2 * m] * D; const float* yb = p.YS + (size_t)p.rSlot[2 * m + 1] * D;
        const float wa = p.rW[2 * m], wb = p.rW[2 * m + 1];
        const float* g2 = p.ln2_g + (size_t)l * D; const float* b2 = p.ln2_b + (size_t)l * D;
        float s = 0.f; for (int j = 0; j < D; ++j) s += ALPHA * x1[j] + md[5 * D + j] * (wa * ya[j] + wb * yb[j]);
        const float mu = s / D; float q = 0.f;
        for (int j = 0; j < D; ++j) { const float d = ALPHA * x1[j] + md[5 * D + j] * (wa * ya[j] + wb * yb[j]) - mu; q += d * d; }
        const float rstd = 1.0f / sqrtf(q / D + LN_EPS);
        for (int j = 0; j < D; ++j) x1[j] = (ALPHA * x1[j] + md[5 * D + j] * (wa * ya[j] + wb * yb[j]) - mu) * rstd * g2[j] + b2[j];
    }
}

__device__ __forceinline__ int moe_blocks(const int* cnt) { int s = 0; for (int j = 0; j < NEXP; ++j) s += (cnt[j] + 127) >> 7; return s; }
__device__ __forceinline__ int moe_block_expert(const int* cnt, int rb) {
    int s = 0, e = 0;
    for (int j = 0; j < NEXP; ++j) { const int nb = (cnt[j] + 127) >> 7; if (rb >= s && rb < s + nb) e = j; s += nb; }
    return e;
}

#ifdef HOST_EMU
static void host_gemm_in(const Params& p) {
    for (int m = 0; m < T; ++m) for (int n = 0; n < ZP; ++n) { float a = 0.f; for (int k = 0; k < D; ++k) a += bf2f(p.H[(size_t)m * D + k]) * bf2f(p.win_t[(size_t)n * D + k]); p.Z[(size_t)m * ZP + n] = f2bf(a); }
}
static void host_gemm_out(const Params& p, int nrows) {
    for (int m = 0; m < nrows; ++m) for (int n = 0; n < D; ++n) { float a = 0.f; for (int k = 0; k < DMIX; ++k) a += bf2f(p.MIX[(size_t)m * DMIX + k]) * bf2f(p.wout_t[(size_t)n * DMIX + k]); ((float*)p.O)[(size_t)m * D + n] = a; }
}
static void host_moe1(const Params& p, int l) {
    const int* cnt = p.cnt + l * NEXP; const int nrb = moe_blocks(cnt);
    for (int rb = 0; rb < nrb; ++rb) { const int e = moe_block_expert(cnt, rb);
        for (int r = 0; r < 128; ++r) { const int slot = rb * 128 + r; const bf16_t* a = p.H + (size_t)p.slotTok[slot] * D;
            for (int c = 0; c < DE; ++c) { const int q = c >> 4, ii = c & 15; float g = 0.f, u = 0.f;
                const bf16_t* wg = p.wgu_t + ((size_t)e * 2 * DE + 32 * q + ii) * D; const bf16_t* wu = wg + (size_t)16 * D;
                for (int k = 0; k < D; ++k) { g += bf2f(a[k]) * bf2f(wg[k]); u += bf2f(a[k]) * bf2f(wu[k]); }
                p.ACT[(size_t)slot * DE + c] = f2bf(siluf_(g) * u); } } }
}
static void host_moe2(const Params& p, int l) {
    const int* cnt = p.cnt + l * NEXP; const int nrb = moe_blocks(cnt);
    for (int rb = 0; rb < nrb; ++rb) { const int e = moe_block_expert(cnt, rb);
        for (int r = 0; r < 128; ++r) { const int slot = rb * 128 + r;
            for (int n = 0; n < D; ++n) { float a = 0.f; const bf16_t* w = p.wd_t + ((size_t)e * D + n) * DE;
                for (int k = 0; k < DE; ++k) a += bf2f(p.ACT[(size_t)slot * DE + k]) * bf2f(w[k]);
                p.YS[(size_t)slot * D + n] = a; } } }
}
#else
typedef short bf16x8 __attribute__((ext_vector_type(8)));
typedef float f32x4 __attribute__((ext_vector_type(4)));
#define VGRID ((int)gridDim.x * 2)
__device__ __forceinline__ int opq_tid() { int t = threadIdx.x & 255; asm volatile("" : "+v"(t)); return t; }
__device__ __forceinline__ int opq_bid() { int b = 2 * blockIdx.x + __builtin_amdgcn_readfirstlane(threadIdx.x >> 8); asm volatile("" : "+s"(b)); return b; }
__device__ __forceinline__ unsigned pk2(float lo, float hi) { return (unsigned)f2bf(lo) | ((unsigned)f2bf(hi) << 16); }
struct u32x2_t { unsigned x, y; };
__device__ __forceinline__ void st_bf16x4(bf16_t* dst, f32x4 v) { u32x2_t o; o.x = pk2(v[0], v[1]); o.y = pk2(v[2], v[3]); *(u32x2_t*)dst = o; }
template <bool SWAP = true, class Epi>
__device__ __forceinline__ void gemm_tile(const bf16_t* a0, const bf16_t* a1, const bf16_t* b0, const bf16_t* b1, int K, char* lds, const Epi& epi) {
    const int tid = opq_tid(), wid = tid >> 6, lane = tid & 63, wr = wid >> 1, wc = wid & 1, fr = lane & 15, fq = lane >> 4;
    f32x4 acc[4][4];
#pragma unroll
    for (int m = 0; m < 4; ++m)
#pragma unroll
        for (int n = 0; n < 4; ++n) acc[m][n] = (f32x4){0.f, 0.f, 0.f, 0.f};
#define GT_STAGE(st_, kt_) do { char* sa_ = lds + (st_) * 16384 + tid * 16; \
        __builtin_amdgcn_global_load_lds((const unsigned*)(a0 + (kt_)), (__attribute__((address_space(3))) unsigned*)(sa_), 16, 0, 0); \
        __builtin_amdgcn_global_load_lds((const unsigned*)(a1 + (kt_)), (__attribute__((address_space(3))) unsigned*)(sa_ + 4096), 16, 0, 0); \
        __builtin_amdgcn_global_load_lds((const unsigned*)(b0 + (kt_)), (__attribute__((address_space(3))) unsigned*)(sa_ + 8192), 16, 0, 0); \
        __builtin_amdgcn_global_load_lds((const unsigned*)(b1 + (kt_)), (__attribute__((address_space(3))) unsigned*)(sa_ + 12288), 16, 0, 0); } while (0)
    const int fsw = (0 - (fr >> 2)) & 3;
    const int aoff = (wr * 64 + fr) * 64 + ((fq ^ fsw) * 16), boff = 8192 + (wc * 64 + fr) * 64 + ((fq ^ fsw) * 16);
    const int nk = K / 32;
    GT_STAGE(0, 0);
    if (nk > 1) GT_STAGE(1, 32);
    if (nk > 2) GT_STAGE(2, 64);
    for (int t = 0; t < nk; ++t) {
        if (t + 2 < nk) asm volatile("s_waitcnt vmcnt(8)" ::: "memory"); else if (t + 1 < nk) asm volatile("s_waitcnt vmcnt(4)" ::: "memory"); else asm volatile("s_waitcnt vmcnt(0)" ::: "memory");
        asm volatile("s_waitcnt lgkmcnt(0)" ::: "memory");
        __builtin_amdgcn_s_barrier();
        if (t + 3 < nk) GT_STAGE((t + 3) & 3, (t + 3) * 32);
        const char* sb = lds + (t & 3) * 16384;
        bf16x8 At[4], Bt[4];
#pragma unroll
        for (int m = 0; m < 4; ++m) At[m] = *(const bf16x8*)(sb + aoff + m * 1024);
#pragma unroll
        for (int n = 0; n < 4; ++n) Bt[n] = *(const bf16x8*)(sb + boff + n * 1024);
#pragma unroll
        for (int m = 0; m < 4; ++m)
#pragma unroll
            for (int n = 0; n < 4; ++n) acc[m][n] = SWAP ? __builtin_amdgcn_mfma_f32_16x16x32_bf16(Bt[n], At[m], acc[m][n], 0, 0, 0) : __builtin_amdgcn_mfma_f32_16x16x32_bf16(At[m], Bt[n], acc[m][n], 0, 0, 0);
    }
    asm volatile("s_waitcnt lgkmcnt(0)" ::: "memory");
    __builtin_amdgcn_s_barrier();
#undef GT_STAGE
    epi(acc, wr, wc, fr, fq);
}
#define STG_ROW(i) ((tid_ + (i) * 256) >> 2)
#define STG_K ((((tid_ & 3) ^ ((0 - (tid_ >> 4)) & 3))) * 8)

__device__ __forceinline__ f32x4 ld_bf16x4(const bf16_t* src) { const u32x2_t w = *(const u32x2_t*)src; return (f32x4){__uint_as_float(w.x << 16), __uint_as_float(w.x & 0xffff0000u), __uint_as_float(w.y << 16), __uint_as_float(w.y & 0xffff0000u)}; }
#define G8_LAS __attribute__((address_space(3)))
namespace g8 {
constexpr int BM = 256, BK = 64, HALF = 128, HTB = HALF * BK * 2;
__device__ __forceinline__ int lds_byte(int r, int c) { const int st = (r >> 4) * 2 + (c >> 5), rr = r & 15, cc = c & 31, ob = rr * 64 + cc * 2; return st * 1024 + (ob ^ (((ob >> 9) & 1) << 5)); }
__device__ __forceinline__ void stage_rc(int b, int& R, int& C) { const int st = b / 1024, sb = b % 1024, swz = sb ^ (((sb >> 9) & 1) << 5); R = (st >> 1) * 16 + swz / 64; C = (st & 1) * 32 + (swz % 64) / 2; }
struct Unit { const char* A; const char* B; int r0, c0, tag; };
__device__ __forceinline__ int xcd_pos(int wgid, int nwg) { const int q = nwg / 8, r = nwg % 8, xcd = wgid % 8, off = wgid / 8; return (xcd < r ? xcd * (q + 1) : r * (q + 1) + (xcd - r) * q) + off; }
__device__ __forceinline__ void order2d(int wgid, int nM, int nN, int& pm, int& pn) {
    wgid = xcd_pos(wgid, nM * nN);
    const int nig = 8 * nN, gid = wgid / nig, fm = gid * 8, gsz = (nM - fm) < 8 ? (nM - fm) : 8;
    pm = fm + ((wgid % nig) % gsz); pn = (wgid % nig) / gsz;
}
}
template <int K, bool GATHER, class Sched, class Epi>
__device__ __forceinline__ void gemm8(char* lds_raw, const Sched& S, const Epi& E, const int* gidx) {
    using namespace g8;
    G8_LAS unsigned char* lds = (G8_LAS unsigned char*)lds_raw;
    int tid = threadIdx.x; asm volatile("" : "+v"(tid));
    const int wid = __builtin_amdgcn_readfirstlane(tid >> 6), lane = tid & 63, wr = wid >> 2, wc = wid & 3, fr = lane & 15, fq = lane >> 4;
    constexpr int nt = K / BK;
    static_assert(K % 128 == 0 && K >= 256 && (K & (K - 1)) == 0, "K-tiles are consumed in pairs; the gather path masks with K * 2 - 1");
    static_assert(T + 1 <= 65536, "gathered row ids are packed in 16 bits");
    unsigned voffB[2];
#pragma unroll
    for (int i = 0; i < 2; ++i) { int R, C; stage_rc(tid * 16 + i * 8192, R, C); voffB[i] = (unsigned)(R * K + C) * 2u; }
    unsigned gpk[2] = {0u, 0u};
    constexpr size_t kstep = (size_t)(BK * 2), hstep = (size_t)HALF * K * 2;
    const unsigned ldsw = (unsigned)wid * 1024u;
    const int aoff = lds_byte(wr * 64 + fr, fq * 8), boff = lds_byte(wc * 32 + fr, fq * 8);
#define G8_SA(b, h) (((b) * 2 + (h)) * HTB)
#define G8_SB(b, h) ((4 + (b) * 2 + (h)) * HTB)
#define G8_STAGE_B(bufoff, gbase) do { _Pragma("unroll") for (int _i = 0; _i < 2; ++_i) \
        __builtin_amdgcn_global_load_lds((const unsigned*)((const char*)(gbase) + voffB[_i]), (G8_LAS unsigned*)(lds + (bufoff) + ldsw + _i * 8192), 16, 0, 0); } while (0)
#define G8_STAGE_A(bufoff, gbase, h, nx) do { _Pragma("unroll") for (int _i = 0; _i < 2; ++_i) { const unsigned _o = GATHER ? ((gpk[_i] >> (16 * (h))) & 0xffffu) * (unsigned)(K * 2) + (voffB[_i] & (unsigned)(K * 2 - 1)) : voffB[_i] + (unsigned)((h) * hstep); \
        __builtin_amdgcn_global_load_lds((const unsigned*)((const char*)(gbase) + _o), (G8_LAS unsigned*)(lds + (bufoff) + ldsw + _i * 8192), 16, 0, 0); } } while (0)
#define G8_LDA(dst, b, h) do { _Pragma("unroll") for (int m = 0; m < 4; ++m) _Pragma("unroll") for (int k = 0; k < 2; ++k) dst[m][k] = *(const G8_LAS bf16x8*)(lds + G8_SA(b, h) + aoff + m * 2048 + k * 1024); } while (0)
#define G8_LDB(dst, b, h) do { _Pragma("unroll") for (int n = 0; n < 2; ++n) _Pragma("unroll") for (int k = 0; k < 2; ++k) dst[n][k] = *(const G8_LAS bf16x8*)(lds + G8_SB(b, h) + boff + n * 2048 + k * 1024); } while (0)
#define G8_MMA(ai, bj, At, Bt) do { __builtin_amdgcn_s_setprio(1); _Pragma("unroll") for (int m = 0; m < 4; ++m) _Pragma("unroll") for (int n = 0; n < 2; ++n) _Pragma("unroll") for (int k = 0; k < 2; ++k) \
        acc[ai][bj][m][n] = __builtin_amdgcn_mfma_f32_16x16x32_bf16(Bt[n][k], At[m][k], acc[ai][bj][m][n], 0, 0, 0); __builtin_amdgcn_s_setprio(0); } while (0)
#define G8_WAIT_V(n) asm volatile("s_waitcnt vmcnt(" #n ")" ::: "memory")
#define G8_WAIT_L(n) asm volatile("s_waitcnt lgkmcnt(" #n ")" ::: "memory")
#define G8_BAR __builtin_amdgcn_s_barrier()
#define G8_SCHED __builtin_amdgcn_sched_barrier(0)
#define G8_GOFF(dst, u) do { int _t = tid; asm volatile("" : "+v"(_t)); _Pragma("unroll") for (int _i = 0; _i < 2; ++_i) { int _R, _C; stage_rc(_t * 16 + _i * 8192, _R, _C); \
        dst[_i] = (unsigned)gidx[(u).r0 + _R] | ((unsigned)gidx[(u).r0 + HALF + _R] << 16); } } while (0)
    Unit cur, nxt; int ui = 0;
    if (!S.next(0, cur)) return;
    f32x4 acc[2][2][4][2];
#pragma unroll
    for (int a = 0; a < 2; ++a)
#pragma unroll
        for (int b = 0; b < 2; ++b)
#pragma unroll
            for (int m = 0; m < 4; ++m)
#pragma unroll
                for (int n = 0; n < 2; ++n) acc[a][b][m][n] = (f32x4){0.f, 0.f, 0.f, 0.f};
    bf16x8 At[4][2], B0[2][2], B1[2][2];
    const char* cA = cur.A; const char* cB = cur.B;
    if (GATHER) G8_GOFF(gpk, cur);
    G8_STAGE_B(G8_SB(0, 0), cB); G8_STAGE_A(G8_SA(0, 0), cA, 0, false); G8_STAGE_B(G8_SB(0, 1), cB + hstep); G8_STAGE_A(G8_SA(0, 1), cA, 1, false);
    if (wr == 1) G8_BAR;
    G8_WAIT_V(4); G8_BAR;
    G8_STAGE_B(G8_SB(1, 0), cB + kstep); G8_STAGE_A(G8_SA(1, 0), cA + kstep, 0, false); G8_STAGE_B(G8_SB(1, 1), cB + hstep + kstep);
    G8_WAIT_V(6); G8_BAR;
    for (;;) {
        const bool has_next = S.next(ui + 1, nxt);
        const char* nA = has_next ? nxt.A : cA; const char* nB = has_next ? nxt.B : cB;
#pragma unroll 1
        for (int t = 0; t < nt; t += 2) {
            const bool last = (t == nt - 2);
            const char* a1 = cA + (size_t)(t + 1) * kstep;
            const char* a2 = last ? nA : cA + (size_t)(t + 2) * kstep; const char* b2 = last ? nB : cB + (size_t)(t + 2) * kstep;
            const char* a3 = a2 + kstep; const char* b3 = b2 + kstep;
            G8_LDB(B0, 0, 0); G8_SCHED; G8_LDA(At, 0, 0); G8_STAGE_A(G8_SA(1, 1), a1, 1, false);
            G8_WAIT_L(8); G8_BAR; G8_WAIT_L(0); G8_MMA(0, 0, At, B0); G8_BAR; G8_SCHED;
            if (GATHER && last && has_next) G8_GOFF(gpk, nxt);
            G8_LDB(B1, 0, 1); G8_STAGE_B(G8_SB(0, 0), b2);
            G8_BAR; G8_WAIT_L(0); G8_MMA(0, 1, At, B1); G8_BAR;
            G8_LDA(At, 0, 1); G8_STAGE_A(G8_SA(0, 0), a2, 0, last);
            G8_BAR; G8_WAIT_L(0); G8_MMA(1, 0, At, B0); G8_BAR; G8_SCHED;
            G8_STAGE_B(G8_SB(0, 1), b2 + hstep);
            G8_WAIT_V(6); G8_BAR; G8_MMA(1, 1, At, B1); G8_BAR;
            G8_LDB(B0, 1, 0); G8_SCHED; G8_LDA(At, 1, 0); G8_STAGE_A(G8_SA(0, 1), a2, 1, last);
            G8_WAIT_L(8); G8_BAR; G8_WAIT_L(0); G8_MMA(0, 0, At, B0); G8_BAR; G8_SCHED;
            G8_LDB(B1, 1, 1); G8_STAGE_B(G8_SB(1, 0), b3);
            G8_BAR; G8_WAIT_L(0); G8_MMA(0, 1, At, B1); G8_BAR;
            G8_LDA(At, 1, 1); G8_STAGE_A(G8_SA(1, 0), a3, 0, last);
            G8_BAR; G8_WAIT_L(0); G8_MMA(1, 0, At, B0); G8_BAR; G8_SCHED;
            G8_STAGE_B(G8_SB(1, 1), b3 + hstep);
            G8_WAIT_V(6); G8_BAR; G8_MMA(1, 1, At, B1); G8_BAR;
        }
        { int efr = fr, efq = fq; asm volatile("" : "+v"(efr), "+v"(efq));
          E(acc, cur, wr, wc, efr, efq); }
        if (!has_next) break;
#pragma unroll
        for (int a = 0; a < 2; ++a)
#pragma unroll
            for (int b = 0; b < 2; ++b)
#pragma unroll
                for (int m = 0; m < 4; ++m)
#pragma unroll
                    for (int n = 0; n < 2; ++n) acc[a][b][m][n] = (f32x4){0.f, 0.f, 0.f, 0.f};
        cur = nxt; cA = nA; cB = nB; ++ui;
    }
    G8_WAIT_V(0);
    if (wr == 0) G8_BAR;
    G8_BAR;
#undef G8_SA
#undef G8_SB
#undef G8_STAGE_A
#undef G8_STAGE_B
#undef G8_LDA
#undef G8_LDB
#undef G8_MMA
#undef G8_WAIT_V
#undef G8_WAIT_L
#undef G8_BAR
#undef G8_SCHED
#undef G8_GOFF
}
__device__ __forceinline__ int real_bid() { int b = blockIdx.x; asm volatile("" : "+s"(b)); return b; }

__device__ __forceinline__ void g_gemm_in(const Params& p, char* lds_all) {
    constexpr int NM = T / 256, NN = NINP / 256, NMAIN = WVB / 256;
    struct Sched { const Params* p; int G, c;
        __device__ __forceinline__ bool next(int i, g8::Unit& u) const {
            const int Lx = i * G + c; if (Lx >= NM * NN) return false;
            int pm, pn; g8::order2d(Lx, NM, NN, pm, pn);
            if (pn < NMAIN) { u.A = (const char*)(p->H + (size_t)pm * 256 * D); u.B = (const char*)(p->win_t + (size_t)pn * 256 * D); u.r0 = pm * 256; u.c0 = pn * 256; u.tag = 0; }
            else { u.A = (const char*)(p->win_t + (size_t)pn * 256 * D); u.B = (const char*)(p->H + (size_t)pm * 256 * D); u.r0 = (pn - NMAIN) * 256; u.c0 = pm * 256; u.tag = 1; }
            return true; } };
    const Sched sch{&p, (int)gridDim.x, real_bid()};
    gemm8<D, false>(lds_all, sch, [&](const f32x4 (&acc)[2][2][4][2], const g8::Unit& u, int wr, int wc, int fr, int fq) {
        if (u.tag == 1) {
#pragma unroll
            for (int ai = 0; ai < 2; ++ai)
#pragma unroll
                for (int m = 0; m < 4; ++m) { const int vc = u.r0 + ai * 128 + wr * 64 + m * 16 + fr;
#pragma unroll
                    for (int bj = 0; bj < 2; ++bj)
#pragma unroll
                        for (int n = 0; n < 2; ++n) { const int m0 = u.c0 + bj * 128 + wc * 32 + n * 16 + 4 * fq; int b, tk;
                            if (m0 < TL) { b = m0 / S; tk = L + m0 % S; } else { b = (m0 - TL) / L; tk = (m0 - TL) % L; }
                            st_bf16x4(p.VT + ((size_t)(b * 8 + (vc >> 6)) * 64 + (vc & 63)) * PU + tk, acc[ai][bj][m][n]); } }
        } else if (u.c0 < ZQN && u.r0 < TL) {
#pragma unroll
            for (int ai = 0; ai < 2; ++ai)
#pragma unroll
                for (int m = 0; m < 4; ++m) { const int row = u.r0 + ai * 128 + wr * 64 + m * 16 + fr, t = row % S;
#pragma unroll
                    for (int bj = 0; bj < 2; ++bj) { const int c32 = u.c0 + bj * 128 + wc * 32, ax = (c32 >> 5) & 1, pos = ax ? t % GRID_W : t / GRID_W;
                        const f32x4 cs = *(const f32x4*)(p.rope + pos * 16 + 4 * fq), sn = *(const f32x4*)(p.rope + 1024 + pos * 16 + 4 * fq);
                        const f32x4 x0 = acc[ai][bj][m][0], x1 = acc[ai][bj][m][1];
                        bf16_t* zr = p.Z + (size_t)row * ZP + c32 + 4 * fq;
                        st_bf16x4(zr, x0 * cs - x1 * sn); st_bf16x4(zr + 16, x1 * cs + x0 * sn); }
                    asm volatile("" ::: "memory"); }
        } else {
#pragma unroll
            for (int ai = 0; ai < 2; ++ai)
#pragma unroll
                for (int m = 0; m < 4; ++m) { bf16_t* zr = p.Z + (size_t)(u.r0 + ai * 128 + wr * 64 + m * 16 + fr) * ZP;
#pragma unroll
                    for (int bj = 0; bj < 2; ++bj)
#pragma unroll
                        for (int n = 0; n < 2; ++n) { const int col = u.c0 + bj * 128 + wc * 32 + n * 16 + 4 * fq; if (col < ZP) st_bf16x4(zr + col, acc[ai][bj][m][n]); } }
        }
    }, nullptr);
}
__device__ __forceinline__ void g_gemm_out(const Params& p, int nrows, char* lds_all) {
    struct Sched { const Params* p; int G, c, nM;
        __device__ __forceinline__ bool next(int i, g8::Unit& u) const {
            const int Lx = i * G + c; if (Lx >= nM * (D / 256)) return false;
            int pm, pn; g8::order2d(Lx, nM, D / 256, pm, pn);
            u.A = (const char*)(p->MIX + (size_t)pm * 256 * DMIX); u.B = (const char*)(p->wout_t + (size_t)pn * 256 * DMIX); u.r0 = pm * 256; u.c0 = pn * 256; u.tag = 0; return true; } };
    const Sched sch{&p, (int)gridDim.x, real_bid(), nrows / 256};
    gemm8<DMIX, false>(lds_all, sch, [&](const f32x4 (&acc)[2][2][4][2], const g8::Unit& u, int wr, int wc, int fr, int fq) {
#pragma unroll
        for (int ai = 0; ai < 2; ++ai)
#pragma unroll
            for (int m = 0; m < 4; ++m) { bf16_t* orow = p.O + (size_t)(u.r0 + ai * 128 + wr * 64 + m * 16 + fr) * D + u.c0 + wc * 32 + 4 * fq;
#pragma unroll
                for (int bj = 0; bj < 2; ++bj)
#pragma unroll
                    for (int n = 0; n < 2; ++n) st_bf16x4(orow + bj * 128 + n * 16, acc[ai][bj][m][n]); }
    }, nullptr);
}
struct SchedMoe { const int* te; int G, c; const char* A; size_t a_tile; const char* W; size_t w_exp, w_pan;
    __device__ __forceinline__ bool next(int i, g8::Unit& u) const {
        const int nU = __builtin_amdgcn_readfirstlane(te[255]) * 4, Lx = i * G + c; if (Lx >= nU) return false;
        const int w = g8::xcd_pos(Lx, nU), rt = w >> 2, pn = w & 3, e = __builtin_amdgcn_readfirstlane(te[rt]);
        u.A = A + (size_t)rt * a_tile; u.B = W + (size_t)e * w_exp + (size_t)pn * w_pan; u.r0 = rt * 256; u.c0 = pn * 256; u.tag = e; return true; } };
__device__ __forceinline__ int* moe_tile_table(const Params& p, int l, char* lds_all) {
    static_assert(2 * T / 256 + NEXP <= 255, "row-tile table");
    int* te = (int*)(lds_all + 131072);
    if (threadIdx.x < 256) { const int rt = threadIdx.x; int s = 0, e = 0;
        for (int j = 0; j < NEXP; ++j) { s += (p.cnt[l * NEXP + j] + 255) >> 8; e += (s <= rt) ? 1 : 0; }
        te[rt] = rt == 255 ? s : (e < NEXP ? e : NEXP - 1); }
    __syncthreads();
    return te;
}
__device__ __forceinline__ void g_moe1(const Params& p, int l, char* lds_all) {
    const int* te = moe_tile_table(p, l, lds_all);
    const SchedMoe sch{te, (int)gridDim.x, real_bid(), (const char*)p.H, 0, (const char*)p.wgu_t, (size_t)2 * DE * D * 2, (size_t)256 * D * 2};
    gemm8<D, true>(lds_all, sch, [&](const f32x4 (&acc)[2][2][4][2], const g8::Unit& u, int wr, int wc, int fr, int fq) {
#pragma unroll
        for (int ai = 0; ai < 2; ++ai)
#pragma unroll
            for (int m = 0; m < 4; ++m) { bf16_t* arow = p.ACT + (size_t)(u.r0 + ai * 128 + wr * 64 + m * 16 + fr) * DE + (u.c0 + wc * 32) / 2 + 4 * fq;
#pragma unroll
                for (int bj = 0; bj < 2; ++bj) {
                    const f32x4 g = acc[ai][bj][m][0], up = acc[ai][bj][m][1]; f32x4 a;
#pragma unroll
                    for (int e4 = 0; e4 < 4; ++e4) a[e4] = g[e4] / (1.0f + __expf(-g[e4])) * up[e4];
                    st_bf16x4(arow + bj * 64, a); } }
    }, p.slotTok);
}
__device__ __forceinline__ void g_moe2(const Params& p, int l, char* lds_all) {
    const int* te = moe_tile_table(p, l, lds_all);
    const SchedMoe sch{te, (int)gridDim.x, real_bid(), (const char*)p.ACT, (size_t)256 * DE * 2, (const char*)p.wd_t, (size_t)D * DE * 2, (size_t)256 * DE * 2};
    gemm8<DE, false>(lds_all, sch, [&](const f32x4 (&acc)[2][2][4][2], const g8::Unit& u, int wr, int wc, int fr, int fq) {
#pragma unroll
        for (int ai = 0; ai < 2; ++ai)
#pragma unroll
            for (int m = 0; m < 4; ++m) { bf16_t* yrow = p.YSb + (size_t)(u.r0 + ai * 128 + wr * 64 + m * 16 + fr) * D + u.c0 + wc * 32 + 4 * fq;
#pragma unroll
                for (int bj = 0; bj < 2; ++bj)
#pragma unroll
                    for (int n = 0; n < 2; ++n) st_bf16x4(yrow + bj * 128 + n * 16, acc[ai][bj][m][n]); }
    }, nullptr);
}


constexpr int DV = D / 256;
static_assert(D % 256 == 0, "row phases hold a row as DV float4 per lane");
template <int CTRL> __device__ __forceinline__ float dppf(float v) { return __builtin_bit_cast(float, __builtin_amdgcn_update_dpp(0, __builtin_bit_cast(int, v), CTRL, 0xf, 0xf, true)); }
__device__ __forceinline__ float wave_sum(float v) {
    v += dppf<0xB1>(v); v += dppf<0x4E>(v); v += dppf<0x141>(v); v += dppf<0x140>(v);
    float a = v, b = v;
    asm volatile("s_nop 1\n\tv_permlane16_swap_b32 %0, %1" : "+v"(a), "+v"(b));
    v = a + b; a = v; b = v;
    asm volatile("s_nop 1\n\tv_permlane32_swap_b32 %0, %1" : "+v"(a), "+v"(b));
    return a + b;
}
__device__ __forceinline__ float sum8(float v) { v += dppf<0xB1>(v); v += dppf<0x4E>(v); v += dppf<0x141>(v); return v; }
__device__ __forceinline__ float sum4(f32x4 a) { return (a[0] + a[1]) + (a[2] + a[3]); }
#define LDS_WAIT() asm volatile("s_waitcnt lgkmcnt(0)" ::: "memory")

__device__ __forceinline__ void row_stats(const f32x4 (&v)[DV], float& mu, float& rstd) {
    float s = 0.f;
#pragma unroll
    for (int j = 0; j < DV; ++j) s += sum4(v[j]);
    mu = wave_sum(s) * (1.0f / D);
    float q = 0.f;
#pragma unroll
    for (int j = 0; j < DV; ++j) { const f32x4 d = v[j] - mu; q += sum4(d * d); }
    rstd = 1.0f / sqrtf(wave_sum(q) * (1.0f / D) + LN_EPS);
}

__device__ __forceinline__ void ph_lnmod_fast(const Params& p, int l) {
    const int tid_ = opq_tid(), bid_ = opq_bid(); (void)tid_; (void)bid_;
    const int lane = tid_ & 63, gw = bid_ * 4 + (tid_ >> 6), nw = VGRID * 4;
    constexpr int R = 4;
    for (int m0 = gw * R; m0 < T; m0 += nw * R) {
        f32x4 v[R][DV];
#pragma unroll
        for (int r = 0; r < R; ++r) { const f32x4* xr = (const f32x4*)xrow_in(p, l, m0 + r < T ? m0 + r : m0) + lane;
#pragma unroll
            for (int j = 0; j < DV; ++j) v[r][j] = xr[64 * j]; }
        float mu[R], rstd[R];
#pragma unroll
        for (int r = 0; r < R; ++r) row_stats(v[r], mu[r], rstd[r]);
#pragma unroll
        for (int r = 0; r < R; ++r) if (m0 + r < T) { const f32x4* md = (const f32x4*)modrow(p, l, m0 + r) + lane;
#pragma unroll
            for (int j = 0; j < DV; ++j) st_bf16x4(p.H + (size_t)(m0 + r) * D + 4 * (lane + 64 * j), (v[r][j] - mu[r]) * rstd[r] * (md[D / 4 + 64 * j] + 1.0f) + md[64 * j]); }
    }
}

template <int R>
__device__ __forceinline__ void pm_rows(const Params& p, int l, int m0, int lane) {
    const f32x4* g1 = (const f32x4*)(p.ln1_g + (size_t)l * D) + lane; const f32x4* b1 = (const f32x4*)(p.ln1_b + (size_t)l * D) + lane;
    f32x4 v[R][DV]; float mu[R], rstd[R];
#pragma unroll
    for (int r = 0; r < R; ++r) { const int m = m0 + r; const f32x4* xr = (const f32x4*)xrow_in(p, l, m) + lane; const f32x4* md = (const f32x4*)modrow(p, l, m) + lane;
        const bf16_t* orow = p.O + (size_t)m * D + 4 * lane;
#pragma unroll
        for (int j = 0; j < DV; ++j) v[r][j] = xr[64 * j] * ALPHA + md[2 * (D / 4) + 64 * j] * ld_bf16x4(orow + 256 * j); }
#pragma unroll
    for (int r = 0; r < R; ++r) row_stats(v[r], mu[r], rstd[r]);
#pragma unroll
    for (int r = 0; r < R; ++r) { const int m = m0 + r; f32x4* x1 = (f32x4*)((m < TL) ? p.out + (size_t)m * D : p.XC + (size_t)(m - TL) * D) + lane;
#pragma unroll
        for (int j = 0; j < DV; ++j) { v[r][j] = (v[r][j] - mu[r]) * rstd[r] * g1[64 * j] + b1[64 * j]; x1[64 * j] = v[r][j]; } }
#pragma unroll
    for (int r = 0; r < R; ++r) row_stats(v[r], mu[r], rstd[r]);
#pragma unroll
    for (int r = 0; r < R; ++r) { const int m = m0 + r; const f32x4* md = (const f32x4*)modrow(p, l, m) + lane;
#pragma unroll
        for (int j = 0; j < DV; ++j) {
            const f32x4 hv = (v[r][j] - mu[r]) * rstd[r] * (md[4 * (D / 4) + 64 * j] + 1.0f) + md[3 * (D / 4) + 64 * j];
            f32x4 hh, lo;
#pragma unroll
            for (int e = 0; e < 4; ++e) { hh[e] = bf2f(f2bf(hv[e])); lo[e] = hv[e] - hh[e]; }
            st_bf16x4(p.H + (size_t)m * D + 4 * (lane + 64 * j), hh);
            st_bf16x4(p.HLO + (size_t)m * D + 4 * (lane + 64 * j), lo);
        } }
}

__device__ __forceinline__ int router_rpg(int nrows) { const int g = VGRID; return (nrows % g == 0 && nrows / g <= 48 && (nrows / g) % 4 == 0) ? nrows / g : 32; }
__device__ __forceinline__ void g_router(const Params& p, int l, int nrows, char* lds) {
    const int tid_ = opq_tid(), bid_ = opq_bid(); (void)tid_; (void)bid_;
    const int lane = tid_ & 63, wid = tid_ >> 6, fr = lane & 15, fq = lane >> 4;
    const int RPG = router_rpg(nrows), RW = RPG / 4;
    float* part = (float*)lds;
    float* lgt = part + 4 * 9 * 64 * 4;
    int* eids = (int*)(lgt + 48 * 48);
    for (int rg = bid_; rg < nrows / RPG; rg += VGRID) {
#pragma unroll 1
        for (int i = 0; i + 1 < RW; i += 2) pm_rows<2>(p, l, rg * RPG + wid * RW + i, lane);
        if (RW & 1) pm_rows<1>(p, l, rg * RPG + wid * RW + RW - 1, lane);
        asm volatile("s_waitcnt vmcnt(0)" ::: "memory");
        __syncthreads();
        f32x4 acc[3][3];
#pragma unroll
        for (int a = 0; a < 3; ++a)
#pragma unroll
            for (int b = 0; b < 3; ++b) acc[a][b] = (f32x4){0.f, 0.f, 0.f, 0.f};
        int arow[3];
#pragma unroll
        for (int a = 0; a < 3; ++a) { const int rr = a * 16 + fr; arow[a] = rg * RPG + (rr < RPG ? rr : RPG - 1); }
#pragma unroll
        for (int seg = 0; seg < 3; ++seg) {
            const bf16_t* ab = (seg < 2 ? p.H : p.HLO) + wid * (D / 4) + fq * 8;
            const bf16_t* bp = p.wrt + (seg == 1 ? (size_t)128 * D : 0) + (size_t)fr * D + wid * (D / 4) + fq * 8;
#pragma unroll 1
            for (int ks0 = 0; ks0 < D / 128; ks0 += 2) {
                bf16x8 av[2][3], bv[2][3];
#pragma unroll
                for (int u = 0; u < 2; ++u) { const int ko = (ks0 + u) * 32;
#pragma unroll
                    for (int a = 0; a < 3; ++a) { av[u][a] = *(const bf16x8*)(ab + (size_t)arow[a] * D + ko); bv[u][a] = *(const bf16x8*)(bp + (size_t)(16 * a) * D + ko); } }
                asm volatile("" ::: "memory");
#pragma unroll
                for (int u = 0; u < 2; ++u)
#pragma unroll
                    for (int a = 0; a < 3; ++a)
#pragma unroll
                        for (int b = 0; b < 3; ++b) acc[a][b] = __builtin_amdgcn_mfma_f32_16x16x32_bf16(av[u][a], bv[u][b], acc[a][b], 0, 0, 0);
            }
        }
#pragma unroll
        for (int a = 0; a < 3; ++a)
#pragma unroll
            for (int b = 0; b < 3; ++b) *(f32x4*)(part + ((wid * 9 + a * 3 + b) * 64 + lane) * 4) = acc[a][b];
        __syncthreads();
#pragma unroll
        for (int i = 0; i < 9; ++i) { const int e = tid_ + 256 * i, f = e >> 8, ln = (e & 255) >> 2, j = e & 3;
            const float sm = (part[((0 * 9 + f) * 64 + ln) * 4 + j] + part[((1 * 9 + f) * 64 + ln) * 4 + j]) + (part[((2 * 9 + f) * 64 + ln) * 4 + j] + part[((3 * 9 + f) * 64 + ln) * 4 + j]);
            lgt[((f / 3) * 16 + (ln >> 4) * 4 + j) * 48 + (f % 3) * 16 + (ln & 15)] = sm; }
        __syncthreads();
        if (tid_ < RPG) {
            const int m = rg * RPG + tid_; const float* lg = lgt + tid_ * 48;
            float gl[4], el[32];
#pragma unroll
            for (int g = 0; g < 4; ++g) gl[g] = lg[g] + p.b_rg[l * 4 + g];
#pragma unroll
            for (int e = 0; e < 32; ++e) el[e] = lg[4 + e] + p.b_re[l * 32 + e];
            int gs = 0; float gm = gl[0];
#pragma unroll
            for (int g = 1; g < 4; ++g) if (gl[g] > gm) { gm = gl[g]; gs = g; }
            float den = 0.f;
#pragma unroll
            for (int g = 0; g < 4; ++g) den += expf(gl[g] - gm);
            const float pg = 1.0f / den;
            float v1 = -3e38f, v2 = -3e38f; int i1 = 0, i2 = 0;
#pragma unroll
            for (int j = 0; j < 8; ++j) {
                const float vv = gs == 0 ? el[j] : gs == 1 ? el[8 + j] : gs == 2 ? el[16 + j] : el[24 + j];
                if (vv > v1) { v2 = v1; i2 = i1; v1 = vv; i1 = j; } else if (vv > v2) { v2 = vv; i2 = j; }
            }
            const float e2 = expf(v2 - v1), w1 = pg / (1.0f + e2), w2 = pg * e2 / (1.0f + e2);
            const int ea = gs * 8 + i1, eb = gs * 8 + i2;
            p.rE[2 * m] = ea; p.rE[2 * m + 1] = eb; p.rW[2 * m] = w1; p.rW[2 * m + 1] = w2;
            eids[2 * tid_] = ea; eids[2 * tid_ + 1] = eb;
        }
        __syncthreads();
        if (tid_ < 2 * RPG) { const int e = eids[tid_]; int rk = 0; for (int j = 0; j < tid_; ++j) rk += (eids[j] == e) ? 1 : 0; p.rPos[2 * (rg * RPG) + tid_] = rk; }
        else if (tid_ >= 128 && tid_ < 160) { const int e = tid_ - 128; int c = 0; for (int j = 0; j < 2 * RPG; ++j) c += (eids[j] == e) ? 1 : 0; p.hist[rg * 32 + e] = c; }
        __syncthreads();
    }
}

__device__ __forceinline__ void ph_dispatch_fast(const Params& p, int l, int nrows, char* lds) {
    const int tid_ = opq_tid(), bid_ = opq_bid(); (void)tid_; (void)bid_;
    const int RPG = router_rpg(nrows), nrg = nrows / RPG, e = tid_ & 31, part = tid_ >> 5;
    int* tot = (int*)lds; int* pst = tot + 32; int* pre = pst + 32; int* red = pre + 32;
    { int s = 0; for (int b = part; b < nrg; b += 8) s += p.hist[b * 32 + e]; red[part * 32 + e] = s; }
    __syncthreads();
    if (tid_ < 32) { int s = 0; for (int q = 0; q < 8; ++q) s += red[q * 32 + tid_]; tot[tid_] = s; }
    __syncthreads();
    if (tid_ < 32) { int s = 0; for (int j = 0; j < tid_; ++j) s += (tot[j] + MPAD - 1) & ~(MPAD - 1); pst[tid_] = s; if (bid_ == 0) p.cnt[l * NEXP + tid_] = tot[tid_]; }
    for (int rg = bid_; rg < nrg; rg += VGRID) {
        __syncthreads();
        { int s = 0; for (int b = part; b < rg; b += 8) s += p.hist[b * 32 + e]; red[part * 32 + e] = s; }
        __syncthreads();
        if (tid_ < 32) { int s = 0; for (int q = 0; q < 8; ++q) s += red[q * 32 + tid_]; pre[tid_] = s; }
        __syncthreads();
        if (tid_ < 2 * RPG) { const int i = 2 * (rg * RPG) + tid_, ee = p.rE[i], slot = pst[ee] + pre[ee] + p.rPos[i]; p.rSlot[i] = slot; p.slotTok[slot] = i >> 1; }
    }
}

__device__ __forceinline__ void ph_final_fast(const Params& p, int l, int nrows, bool next_h) {
    const int tid_ = opq_tid(), bid_ = opq_bid(); (void)tid_; (void)bid_;
    const int lane = tid_ & 63, gw = bid_ * 4 + (tid_ >> 6), nw = VGRID * 4;
    constexpr int R = 4;
    const f32x4* g2 = (const f32x4*)(p.ln2_g + (size_t)l * D) + lane; const f32x4* b2 = (const f32x4*)(p.ln2_b + (size_t)l * D) + lane;
    for (int m0 = gw * R; m0 < nrows; m0 += nw * R) {
        f32x4 v[R][DV]; float mu[R], rstd[R];
#pragma unroll
        for (int r = 0; r < R; ++r) { const int m = m0 + r; const f32x4* x1 = (const f32x4*)((m < TL) ? p.out + (size_t)m * D : p.XC + (size_t)(m - TL) * D) + lane;
            const f32x4* md = (const f32x4*)modrow(p, l, m) + lane;
            const bf16_t* ya = p.YSb + (size_t)p.rSlot[2 * m] * D + 4 * lane; const bf16_t* yb = p.YSb + (size_t)p.rSlot[2 * m + 1] * D + 4 * lane;
            const float wa = p.rW[2 * m], wb = p.rW[2 * m + 1];
#pragma unroll
            for (int j = 0; j < DV; ++j) v[r][j] = x1[64 * j] * ALPHA + md[5 * (D / 4) + 64 * j] * (ld_bf16x4(ya + 256 * j) * wa + ld_bf16x4(yb + 256 * j) * wb); }
#pragma unroll
        for (int r = 0; r < R; ++r) row_stats(v[r], mu[r], rstd[r]);
#pragma unroll
        for (int r = 0; r < R; ++r) { const int m = m0 + r; f32x4* x1 = (f32x4*)((m < TL) ? p.out + (size_t)m * D : p.XC + (size_t)(m - TL) * D) + lane;
#pragma unroll
            for (int j = 0; j < DV; ++j) { v[r][j] = (v[r][j] - mu[r]) * rstd[r] * g2[64 * j] + b2[64 * j]; x1[64 * j] = v[r][j]; } }
        if (next_h) {
#pragma unroll
            for (int r = 0; r < R; ++r) row_stats(v[r], mu[r], rstd[r]);
#pragma unroll
            for (int r = 0; r < R; ++r) { const int m = m0 + r; const f32x4* mn = (const f32x4*)modrow(p, l + 1, m) + lane;
#pragma unroll
                for (int j = 0; j < DV; ++j) st_bf16x4(p.H + (size_t)m * D + 4 * (lane + 64 * j), (v[r][j] - mu[r]) * rstd[r] * (mn[D / 4 + 64 * j] + 1.0f) + mn[64 * j]); }
        }
    }
}

__device__ __forceinline__ void ph_mod_fast(const Params& p, char* lds) {
    const int tid_ = opq_tid(), bid_ = opq_bid(); (void)tid_; (void)bid_;
    constexpr int NR = NB + 1, NTASK = 2 * (6 * D / 64);
    if (bid_ >= NTASK) return;
    float* sc = (float*)lds;
    float* part = sc + NR * D;
    for (int i = tid_; i < NR * D; i += 256) { const int b = i / D, k = i % D; const float cv = b < NB ? p.c[(size_t)b * D + k] : p.c_ctx[k]; sc[i] = cv / (1.0f + __expf(-cv)); }
    __syncthreads();
    const int lane = tid_ & 63, wid = tid_ >> 6;
    for (int task = bid_; task < NTASK; task += VGRID) {
        const int ll = task / (6 * D / 64), col = 64 * (task % (6 * D / 64)) + lane;
        float acc[NR];
#pragma unroll
        for (int b = 0; b < NR; ++b) acc[b] = 0.f;
        const float* wp = p.w_mod + ((size_t)ll * D + wid * (D / 4)) * 6 * D + col;
#pragma unroll 16
        for (int k = 0; k < D / 4; ++k) { const float w = wp[(size_t)k * 6 * D];
#pragma unroll
            for (int b = 0; b < NR; ++b) acc[b] += sc[b * D + wid * (D / 4) + k] * w; }
#pragma unroll
        for (int b = 0; b < NR; ++b) part[(wid * NR + b) * 64 + lane] = acc[b];
        __syncthreads();
        for (int i = tid_; i < NR * 64; i += 256) { const int b = i / 64, cl = i % 64;
            p.mod[((size_t)ll * NR + b) * 6 * D + 64 * (task % (6 * D / 64)) + cl] = (part[(0 * NR + b) * 64 + cl] + part[(1 * NR + b) * 64 + cl]) + (part[(2 * NR + b) * 64 + cl] + part[(3 * NR + b) * 64 + cl]) + p.b_mod[(size_t)ll * 6 * D + 64 * (task % (6 * D / 64)) + cl]; }
        __syncthreads();
    }
}

template <bool SPLIT = false>
__device__ __forceinline__ void tr_item(const float* srcl, size_t ldw, bf16_t* dst, size_t ldd, float* scr, int lane, float scale = 1.0f) {
    float v[32];
#pragma unroll
    for (int i = 0; i < 32; ++i) v[i] = srcl ? srcl[(size_t)(2 * i + (lane >> 5)) * ldw] * scale : 0.f;
#pragma unroll
    for (int i = 0; i < 32; ++i) scr[(2 * i + (lane >> 5)) * 33 + (lane & 31)] = v[i];
    LDS_WAIT();
    const int c = lane & 7;
#pragma unroll
    for (int j = 0; j < 4; ++j) { const int n = (lane >> 3) + 8 * j; const float* s = scr + (8 * c) * 33 + n;
        uint4 o; o.x = pk2(s[0], s[33]); o.y = pk2(s[2 * 33], s[3 * 33]); o.z = pk2(s[4 * 33], s[5 * 33]); o.w = pk2(s[6 * 33], s[7 * 33]);
        *(uint4*)(dst + (size_t)(SPLIT ? (n & 15) + 32 * (n >> 4) : n) * ldd + 8 * c) = o; }
    LDS_WAIT();
}
__device__ __forceinline__ void ph_prep_w_fast(const Params& p, int l, int part, char* lds) {
    const int tid_ = opq_tid(), bid_ = opq_bid(); (void)tid_; (void)bid_;
    const int lane = tid_ & 63, wid = tid_ >> 6, gw = bid_ * 4 + wid, nw = VGRID * 4;
    float* scr = (float*)(lds + wid * 8448);
    constexpr int I_IN = (D / 64) * (NINP / 32), I_OUT = (DMIX / 64) * (D / 32), I_GU1 = (D / 64) * (2 * DE / 32), I_D1 = (DE / 64) * (D / 32);
    constexpr int NITEMS = I_IN + I_OUT + NEXP * (I_GU1 + I_D1);
    const int it0 = part == 0 ? 0 : I_IN + I_OUT, it1 = part == 0 ? I_IN + I_OUT : NITEMS;
    for (int it = it0 + gw; it < it1; it += nw) {
        int r = it;
        if (r < I_IN) { const int kb = r / (NINP / 32), n0 = 32 * (r % (NINP / 32));
            const float* s = nullptr;
            {
                const int oc = n0 < ZQN ? n0 + A_IN : n0 < ZA ? n0 + 1312 : n0 < ZP ? n0 - ZA : n0 < WVB ? -1 : n0 < WVN ? n0 - 864 : n0 - 96;
                if (oc >= 0) s = p.w_in + ((size_t)l * D + 64 * kb) * N_IN + oc + (lane & 31); }
            tr_item(s, N_IN, p.win_t + (size_t)n0 * D + 64 * kb, D, scr, lane, (n0 < ZKB || (n0 >= ZQN && n0 < ZKN)) ? QSCALE : 1.0f); continue; }
        r -= I_IN;
        if (r < I_OUT) { const int kb = r / (D / 32), n0 = 32 * (r % (D / 32));
            tr_item(p.w_out + ((size_t)l * DMIX + 64 * kb) * D + n0 + (lane & 31), D, p.wout_t + (size_t)n0 * DMIX + 64 * kb, DMIX, scr, lane); continue; }
        r -= I_OUT;
        const int e = r / (I_GU1 + I_D1); r %= (I_GU1 + I_D1);
        if (r < I_GU1) { const int kb = r / (2 * DE / 32), q = r % (2 * DE / 32), up = q & 1, c0 = 32 * (q >> 1);
            const float* s = (up ? p.w_up : p.w_gate) + (((size_t)l * NEXP + e) * D + 64 * kb) * DE + c0 + (lane & 31);
            tr_item<true>(s, DE, p.wgu_t + ((size_t)e * 2 * DE + 2 * c0 + 16 * up) * D + 64 * kb, D, scr, lane); continue; }
        r -= I_GU1;
        { const int kb = r / (D / 32), n0 = 32 * (r % (D / 32));
            tr_item(p.w_down + (((size_t)l * NEXP + e) * DE + 64 * kb) * D + n0 + (lane & 31), D, p.wd_t + ((size_t)e * D + n0) * DE + 64 * kb, DE, scr, lane); }
    }
    if (part != 0) return;
    const long gt = (long)bid_ * 256 + tid_, gs = (long)VGRID * 256;
    for (long i = gt; i < 2 * 256 * 64; i += gs) { const int k = (int)(i & 63), n = (int)((i >> 6) & 255), d = (int)(i >> 14);
        p.wupT[i] = f2bf(p.a_w_up[(((size_t)l * 2 + d) * 64 + k) * DA + n]); p.aupT[i] = f2bf(p.a_a_up[(((size_t)l * 2 + d) * 64 + k) * DA + n]); }
    for (long i = gt; i < 256 * 160; i += gs) { const int k = (int)(i % 160), n = (int)(i / 160); p.gupT[i] = f2bf(p.a_g_up[((size_t)l * 160 + k) * DA + n]); }
    for (long i = gt; i < (long)128 * D; i += gs) { const int n = (int)(i / D), k = (int)(i % D);
        const float w = n < 4 ? p.w_rg[((size_t)l * D + k) * 4 + n] : n < 36 ? p.w_re[((size_t)l * D + k) * 32 + n - 4] : 0.f;
        const bf16_t hb = f2bf(w); p.wrt[i] = hb; p.wrt[(size_t)128 * D + i] = f2bf(w - bf2f(hb)); }
}

__device__ __forceinline__ float tanh_fast(float x) { return 1.0f - 2.0f / (1.0f + __expf(2.0f * x)); }
__device__ __forceinline__ void ph_streams_s1(const Params& p, int l) {
    const int tid_ = opq_tid(), bid_ = opq_bid(); (void)tid_; (void)bid_;
    constexpr int NCH = A_IN / 8, NCHP = (NCH + 7) & ~7;
    const float* sh = p.a_shift + (size_t)l * 3 * A_IN;
    for (long it = (long)bid_ * 256 + tid_; it < (long)T * NCHP; it += (long)VGRID * 256) {
        const int m = (int)(it / NCHP), ch = (int)(it % NCHP), c0 = 8 * ch;
        const bool act = ch < NCH;
        int t, len;
        if (m < TL) { t = m % S; len = S; } else { t = (m - TL) % L; len = L; }
        float v[8];
#pragma unroll
        for (int e = 0; e < 8; ++e) v[e] = 0.f;
        if (act) {
            const bf16_t* z = p.Z + (size_t)m * ZP + ZA + c0;
            const bf16x8 zc = *(const bf16x8*)z;
            const f32x4 s1a = *(const f32x4*)(sh + A_IN + c0), s1b = *(const f32x4*)(sh + A_IN + c0 + 4);
#pragma unroll
            for (int e = 0; e < 8; ++e) v[e] = (e < 4 ? s1a[e] : s1b[e - 4]) * bf2f((bf16_t)zc[e]);
            if (t > 0) { const bf16x8 zp = *(const bf16x8*)(z - ZP); const f32x4 a = *(const f32x4*)(sh + c0), b = *(const f32x4*)(sh + c0 + 4);
#pragma unroll
                for (int e = 0; e < 8; ++e) v[e] += (e < 4 ? a[e] : b[e - 4]) * bf2f((bf16_t)zp[e]); }
            if (t < len - 1) { const bf16x8 zn = *(const bf16x8*)(z + ZP); const f32x4 a = *(const f32x4*)(sh + 2 * A_IN + c0), b = *(const f32x4*)(sh + 2 * A_IN + c0 + 4);
#pragma unroll
                for (int e = 0; e < 8; ++e) v[e] += (e < 4 ? a[e] : b[e - 4]) * bf2f((bf16_t)zn[e]); }
        }
        float nrm = 0.f;
        if (ch >= 32 && ch < 64) {
#pragma unroll
            for (int e = 0; e < 8; ++e) { const float t2 = v[e] * p.a_k_k[l * DA + c0 - 256 + e]; nrm += t2 * t2; } }
        nrm = sum8(nrm);
        if (!act) continue;
        if (c0 < 768) {
            float* dst = (c0 < 256 ? p.sR + (size_t)m * DA + c0 : c0 < 512 ? p.kT + (size_t)m * DA + c0 - 256 : p.sV + (size_t)m * DA + c0 - 512);
            *(f32x4*)dst = (f32x4){v[0], v[1], v[2], v[3]}; *(f32x4*)(dst + 4) = (f32x4){v[4], v[5], v[6], v[7]};
            if (ch >= 32 && ch < 64 && (ch & 7) == 0) p.kN[(size_t)m * 4 + ((ch - 32) >> 3)] = 1.0f / sqrtf(nrm + 1e-12f);
        } else {
            if (c0 < 896) {
#pragma unroll
                for (int e = 0; e < 8; ++e) v[e] = tanh_fast(v[e]); }
            else if (c0 >= 1024) {
#pragma unroll
                for (int e = 0; e < 8; ++e) v[e] = 1.0f / (1.0f + __expf(-v[e])); }
            uint4 o; o.x = pk2(v[0], v[1]); o.y = pk2(v[2], v[3]); o.z = pk2(v[4], v[5]); o.w = pk2(v[6], v[7]);
            *(uint4*)(p.LA + (size_t)m * 416 + c0 - 768) = o;
        }
    }
}
__device__ __forceinline__ void g_streams_s2(const Params& p, int l, char* lds) {
    const int tid_ = opq_tid(), bid_ = opq_bid(); (void)tid_; (void)bid_;
    constexpr int MT = T / 128;
    for (int job = bid_; job < 5 * MT * 2; job += VGRID) {
        const int type = job / (MT * 2), r = job % (MT * 2), tm = r >> 1, tn = r & 1;
        const int coff = type < 2 ? type * 64 : type < 4 ? 128 + (type - 2) * 64 : 256, K = type < 4 ? 64 : 160, d = type & 1;
        const bf16_t* Bt = type < 2 ? p.wupT + type * 256 * 64 : type < 4 ? p.aupT + (type - 2) * 256 * 64 : p.gupT;
        const bf16_t* a0 = p.LA + (size_t)(tm * 128 + STG_ROW(0)) * 416 + coff + STG_K; const bf16_t* a1 = p.LA + (size_t)(tm * 128 + STG_ROW(1)) * 416 + coff + STG_K;
        const bf16_t* b0 = Bt + (size_t)(tn * 128 + STG_ROW(0)) * K + STG_K; const bf16_t* b1 = Bt + (size_t)(tn * 128 + STG_ROW(1)) * K + STG_K;
        if (type < 2) gemm_tile(a0, a1, b0, b1, K, lds, [&](const f32x4 (&acc)[4][4], int wr, int wc, int fr, int fq) {
#pragma unroll
            for (int mi = 0; mi < 4; ++mi) { const int row = tm * 128 + wr * 64 + mi * 16 + fr;
#pragma unroll
                for (int n = 0; n < 4; ++n) { const int c = tn * 128 + wc * 64 + n * 16 + 4 * fq; const f32x4 w0 = *(const f32x4*)(p.a_w0 + (l * 2 + d) * DA + c); f32x4 o;
#pragma unroll
                    for (int e4 = 0; e4 < 4; ++e4) { const float ex = __expf(-(w0[e4] + acc[mi][n][e4]));
                        o[e4] = __expf(-0.60653065971f / (1.0f + ex)); }
                    *(f32x4*)(p.sW + ((size_t)d * T + row) * DA + c) = o; }
                asm volatile("" ::: "memory"); }
        });
        else if (type < 4) gemm_tile(a0, a1, b0, b1, K, lds, [&](const f32x4 (&acc)[4][4], int wr, int wc, int fr, int fq) {
#pragma unroll
            for (int mi = 0; mi < 4; ++mi) { const int row = tm * 128 + wr * 64 + mi * 16 + fr;
#pragma unroll
                for (int n = 0; n < 4; ++n) { const int c = tn * 128 + wc * 64 + n * 16 + 4 * fq;
                    const f32x4 a0v = *(const f32x4*)(p.a_a0 + (l * 2 + d) * DA + c), kkc = *(const f32x4*)(p.a_k_k + l * DA + c), kac = *(const f32x4*)(p.a_k_a + l * DA + c);
                    const size_t o = (size_t)row * DA + c, od = ((size_t)d * T + row) * DA + c;
                    const f32x4 k = *(const f32x4*)(p.kT + o); const float kn = p.kN[(size_t)row * 4 + (c >> 6)];
                    f32x4 kd, bo, kk;
#pragma unroll
                    for (int e4 = 0; e4 < 4; ++e4) { const float av = 1.0f / (1.0f + __expf(-(a0v[e4] + acc[mi][n][e4])));
                        kk[e4] = k[e4] * kkc[e4] * kn; kd[e4] = k[e4] * (1.0f + (av - 1.0f) * kac[e4]); bo[e4] = kk[e4] * av; }
                    *(f32x4*)(p.sKD + od) = kd; *(f32x4*)(p.sB + od) = bo; if (d == 0) *(f32x4*)(p.sKK + o) = kk; }
                asm volatile("" ::: "memory"); }
        });
        else gemm_tile(a0, a1, b0, b1, K, lds, [&](const f32x4 (&acc)[4][4], int wr, int wc, int fr, int fq) {
#pragma unroll
            for (int mi = 0; mi < 4; ++mi)
#pragma unroll
                for (int n = 0; n < 4; ++n) st_bf16x4(p.MIX + (size_t)(tm * 128 + wr * 64 + mi * 16 + fr) * DMIX + tn * 128 + wc * 64 + n * 16 + 4 * fq, acc[mi][n]);
        });
    }
}


typedef float f32x16 __attribute__((ext_vector_type(16)));
typedef short s16x4 __attribute__((ext_vector_type(4)));
typedef unsigned u32x4_t __attribute__((ext_vector_type(4)));
typedef float f32x2_t __attribute__((ext_vector_type(2)));
typedef __bf16 bf16x2_t __attribute__((ext_vector_type(2)));
__device__ __forceinline__ unsigned cvtpk(float lo, float hi) { f32x2_t v = {lo, hi}; bf16x2_t b = __builtin_convertvector(v, bf16x2_t); return __builtin_bit_cast(unsigned, b); }
__device__ __forceinline__ int crow(int r, int hi) { return (r & 3) + 8 * (r >> 2) + 4 * hi; }
__device__ __forceinline__ float xmax32(float v) { float a = v, b = v; asm volatile("s_nop 1\n\tv_permlane32_swap_b32 %0, %1" : "+v"(a), "+v"(b)); return fmaxf(a, b); }
__device__ __forceinline__ float xsum32(float v) { float a = v, b = v; asm volatile("s_nop 1\n\tv_permlane32_swap_b32 %0, %1" : "+v"(a), "+v"(b)); return a + b; }

struct NoMask { __device__ __forceinline__ float operator()(int, float v) const { return v; } };

template <class MaskF>
__device__ __forceinline__ void attn_tile_lds(const bf16x8 (&qf)[4], const char* ks, const char* vs, const MaskF& mask, float& m_run, float& l_run, f32x16& o0, f32x16& o1, int ql, int hi) {
    f32x16 s;
#pragma unroll
    for (int r = 0; r < 16; ++r) s[r] = 0.f;
#pragma unroll
    for (int k4 = 0; k4 < 4; ++k4) { const bf16x8 kf = *(const bf16x8*)(ks + ql * 128 + (((2 * k4 + hi) ^ (ql & 7)) * 16)); s = __builtin_amdgcn_mfma_f32_32x32x16_bf16(kf, qf[k4], s, 0, 0, 0); }
    float mx = -INFINITY;
#pragma unroll
    for (int r = 0; r < 16; ++r) { s[r] = mask(crow(r, hi), s[r]); mx = fmaxf(mx, s[r]); }
    mx = xmax32(mx);
    if (__any(mx > m_run)) {
        const float mn = fmaxf(m_run, mx), alpha = __builtin_amdgcn_exp2f(m_run - mn);
        m_run = mn; l_run *= alpha;
#pragma unroll
        for (int r = 0; r < 16; ++r) { o0[r] *= alpha; o1[r] *= alpha; }
    }
    float ps = 0.f;
#pragma unroll
    for (int r = 0; r < 16; ++r) { s[r] = __builtin_amdgcn_exp2f(s[r] - m_run); ps += s[r]; }
    l_run += ps;
    const int sw0 = (ql >> 2) & 3;
#pragma unroll
    for (int s2 = 0; s2 < 2; ++s2) {
        u32x4_t pw; pw[0] = cvtpk(s[8 * s2], s[8 * s2 + 1]); pw[1] = cvtpk(s[8 * s2 + 2], s[8 * s2 + 3]); pw[2] = cvtpk(s[8 * s2 + 4], s[8 * s2 + 5]); pw[3] = cvtpk(s[8 * s2 + 6], s[8 * s2 + 7]);
        const bf16x8 pb = __builtin_bit_cast(bf16x8, pw);
        const char* v0 = vs + ql * 64 + 8 * hi; const char* v1 = v0 + 32 * 64;
        const s16x4 a0 = *(const s16x4*)(v0 + (((2 * s2) ^ sw0) * 16)), a1 = *(const s16x4*)(v0 + (((2 * s2 + 1) ^ sw0) * 16));
        const s16x4 c0 = *(const s16x4*)(v1 + (((2 * s2) ^ sw0) * 16)), c1 = *(const s16x4*)(v1 + (((2 * s2 + 1) ^ sw0) * 16));
        o0 = __builtin_amdgcn_mfma_f32_32x32x16_bf16(__builtin_shufflevector(a0, a1, 0, 1, 2, 3, 4, 5, 6, 7), pb, o0, 0, 0, 0);
        o1 = __builtin_amdgcn_mfma_f32_32x32x16_bf16(__builtin_shufflevector(c0, c1, 0, 1, 2, 3, 4, 5, 6, 7), pb, o1, 0, 0, 0);
    }
}

__device__ __forceinline__ void ph_attn_blk(const Params& p, int l, bool with_ctx, int first_blk, char* lds) {
    const int tid_ = opq_tid(), bid_ = opq_bid(); (void)tid_; (void)bid_;
    if (bid_ < first_blk) return;
    const int lane = tid_ & 63, hi = lane >> 5, ql = lane & 31, wid = tid_ >> 6;
    constexpr int NQG = S / 128, NCG = L / 128, ROWS = S / GRID_W, N_LAT = NB * 6 * NQG, N_CTX = NB * 6 * NCG, TPB = (S + L) / 32;
    const int ntask = 2 * N_LAT + (with_ctx ? 2 * N_CTX : 0);
    const int krow = tid_ >> 3, kch = (tid_ & 7) ^ (krow & 7), vrow = tid_ >> 2, vpc = (tid_ & 3) ^ ((vrow >> 2) & 3);
    for (int task = bid_ - first_blk; task < ntask; task += VGRID - first_blk) {
        bool isC, isCtx; int r;
        if (task < N_LAT) { isC = true; isCtx = false; r = task; }
        else if (task < 2 * N_LAT) { isC = false; isCtx = false; r = task - N_LAT; }
        else { r = task - 2 * N_LAT; isCtx = true; isC = r >= N_CTX; if (isC) r -= N_CTX; }
        const int ng = isCtx ? NCG : NQG, g = r % ng, h = (r / ng) % 6, b = r / (ng * 6);
        const int qt = 4 * g + wid;
        const int m = isCtx ? TL + b * L + 32 * qt + ql : b * S + 32 * qt + ql;
        const int qcol = isC ? ZQN + h * 64 : ZQB + h * 64, kcol = isC ? ZKN + h * 64 : ZKB + (h / 3) * 64, hv = isC ? 2 + h : h / 3;
        bf16x8 qf[4];
        { const bf16_t* qp = p.Z + (size_t)m * ZP + qcol + 8 * hi;
#pragma unroll
          for (int k4 = 0; k4 < 4; ++k4) qf[k4] = *(const bf16x8*)(qp + 16 * k4); }
        int lo = 0, hi_t = 0, gr0 = 0;
        if (!isCtx) {
            if (!isC) { lo = 4 * g - 4; hi_t = 4 * g + 8; lo = lo < 0 ? 0 : lo; hi_t = hi_t > S / 32 ? S / 32 : hi_t; }
            else { const int ra = 2 * g, rb = 2 * g + 1; int r0a = ra - 4; r0a = r0a < 0 ? 0 : (r0a > ROWS - 8 ? ROWS - 8 : r0a); int r0b = rb - 4; r0b = r0b < 0 ? 0 : (r0b > ROWS - 8 ? ROWS - 8 : r0b);
                   lo = 2 * r0a; hi_t = 2 * (r0b + 8); gr0 = 0; }
        }
        const int ntile = L / 32 + (hi_t - lo);
        const bf16_t* kbase = p.Z + (size_t)krow * ZP + kcol + 8 * kch;
        const bf16_t* vbase = p.VT + ((size_t)(b * 8 + hv) * 64 + vrow) * PU + 8 * vpc;
#define AT_TOK(i_) ((i_) < L / 32 ? 32 * (i_) : L + 32 * (lo + (i_) - L / 32))
#define AT_STAGE(i_) do { const int u0_ = AT_TOK(i_); const int zrow_ = u0_ < L ? TL + b * L + u0_ : b * S + (u0_ - L); char* sl_ = lds + ((i_) % 6) * 8192 + tid_ * 16; \
            __builtin_amdgcn_global_load_lds((const unsigned*)(kbase + (size_t)zrow_ * ZP), (__attribute__((address_space(3))) unsigned*)(sl_), 16, 0, 0); \
            __builtin_amdgcn_global_load_lds((const unsigned*)(vbase + u0_), (__attribute__((address_space(3))) unsigned*)(sl_ + 4096), 16, 0, 0); } while (0)
        f32x16 o0, o1;
#pragma unroll
        for (int rr = 0; rr < 16; ++rr) { o0[rr] = 0.f; o1[rr] = 0.f; }
        float m_run, l_run;
        if (isC) { m_run = -1e30f; l_run = 0.f; } else { m_run = p.b_sink[l * 6 + h] * LOG2E; l_run = hi == 0 ? 1.0f : 0.f; }
        const int gr = qt >> 1, c = 32 * (qt & 1) + ql;
        int r0 = gr - 4; r0 = r0 < 0 ? 0 : (r0 > ROWS - 8 ? ROWS - 8 : r0);
        int c0 = c - 8; c0 = c0 < 0 ? 0 : (c0 > GRID_W - 16 ? GRID_W - 16 : c0);
        float* rpb = (float*)(lds + 49152);
        if (isC && !isCtx) for (int i = tid_; i < 15 * 31; i += 256) rpb[i] = p.c_rpb[((size_t)l * 6 + h) * 15 * 31 + i] * LOG2E;
        AT_STAGE(0); AT_STAGE(1);
        if (ntile > 2) { AT_STAGE(2); AT_STAGE(3); }
#pragma unroll 1
        for (int i = 0; i < ntile; ++i) {
            if ((i & 1) == 0) {
                if (i + 2 < ntile) asm volatile("s_waitcnt vmcnt(4)" ::: "memory"); else asm volatile("s_waitcnt vmcnt(0)" ::: "memory");
                asm volatile("s_waitcnt lgkmcnt(0)" ::: "memory");
                __builtin_amdgcn_s_barrier();
                if (i + 4 < ntile) { AT_STAGE(i + 4); AT_STAGE(i + 5); }
            }
            const char* ks = lds + (i % 6) * 8192; const char* vs = ks + 4096;
            if (i < L / 32) attn_tile_lds(qf, ks, vs, NoMask(), m_run, l_run, o0, o1, ql, hi);
            else {
                const int jt = lo + i - L / 32;
                if (!isC) {
                    const int dq = jt - qt;
                    if (dq >= -3 && dq <= 3) attn_tile_lds(qf, ks, vs, NoMask(), m_run, l_run, o0, o1, ql, hi);
                    else if (dq == -4 || dq == 4) { const int base = 32 * dq - ql;
                        attn_tile_lds(qf, ks, vs, [&](int ko, float v) { const int rel = base + ko; return (rel >= -128 && rel <= 128) ? v : -INFINITY; }, m_run, l_run, o0, o1, ql, hi); }
                } else {
                    const int kr_ = jt >> 1, ct = jt & 1;
                    if (kr_ >= r0 && kr_ < r0 + 8) { const float* rp = rpb + (kr_ - gr + 7) * 31 + 15 - c;
                        attn_tile_lds(qf, ks, vs, [&](int ko, float v) { const int kc = 32 * ct + ko; int ix = kc - c + 15; ix = ix < 0 ? 0 : (ix > 30 ? 30 : ix); const float bs = rp[c - 15 + ix];
                                                     return (kc >= c0 && kc < c0 + 16) ? v + bs : -INFINITY; }, m_run, l_run, o0, o1, ql, hi); }
                }
            }
        }
        asm volatile("s_waitcnt lgkmcnt(0)" ::: "memory");
        __builtin_amdgcn_s_barrier();
        {
            const int tk = task ^ 1; int np = L / 32;
            if (tk < 2 * N_LAT) { const bool c_ = tk < N_LAT; const int g_ = (c_ ? tk : tk - N_LAT) % NQG; int lo_, hi_;
                if (!c_) { lo_ = 4 * g_ - 4; hi_ = 4 * g_ + 8; lo_ = lo_ < 0 ? 0 : lo_; hi_ = hi_ > S / 32 ? S / 32 : hi_; }
                else { int r0a = 2 * g_ - 4; r0a = r0a < 0 ? 0 : (r0a > ROWS - 8 ? ROWS - 8 : r0a); int r0b = 2 * g_ - 3; r0b = r0b < 0 ? 0 : (r0b > ROWS - 8 ? ROWS - 8 : r0b); lo_ = 2 * r0a; hi_ = 2 * (r0b + 8); }
                np += hi_ - lo_; }
#pragma unroll 1
            for (int i = ntile; i < np; i += 2) __builtin_amdgcn_s_barrier();
        }
#undef AT_STAGE
#undef AT_TOK
        (void)gr0;
        const float lt = xsum32(l_run), inv = 1.0f / lt;
        bf16_t* op = p.MIX + (size_t)m * DMIX + (isC ? 640 : 256) + h * 64 + 4 * hi;
#pragma unroll
        for (int gq = 0; gq < 4; ++gq) {
            st_bf16x4(op + 8 * gq, (f32x4){o0[4 * gq] * inv, o0[4 * gq + 1] * inv, o0[4 * gq + 2] * inv, o0[4 * gq + 3] * inv});
            st_bf16x4(op + 32 + 8 * gq, (f32x4){o1[4 * gq] * inv, o1[4 * gq + 1] * inv, o1[4 * gq + 2] * inv, o1[4 * gq + 3] * inv});
        }
    }
}

#define RNB " row_newbcast:%c[n] row_mask:0xf bank_mask:0xf\n\t"
template <int N, bool FIRST>
__device__ __forceinline__ void dpp_dot4(float& a0, float& a1, float& a2, float& a3, const f32x4& v, float s0, float s1, float s2, float s3) {
    if (FIRST) asm volatile("s_nop 1");
    asm("v_fmac_f32_dpp %0, %4, %8" RNB "v_fmac_f32_dpp %1, %5, %9" RNB "v_fmac_f32_dpp %2, %6, %10" RNB "v_fmac_f32_dpp %3, %7, %11" RNB
        : "+v"(a0), "+v"(a1), "+v"(a2), "+v"(a3) : "v"(v[0]), "v"(v[1]), "v"(v[2]), "v"(v[3]), "v"(s0), "v"(s1), "v"(s2), "v"(s3), [n] "i"(N));
}
template <int N, bool FIRST>
__device__ __forceinline__ void dpp_upd4s(float& s0, float& s1, float& s2, float& s3, float& y0, float& y1, float& y2, float& y3,
                                          const f32x4& w, const f32x4& b, const f32x4& kd, const f32x4& r, float nsk, float vv) {
    if (FIRST) asm volatile("s_nop 1");
    asm("v_mul_f32_dpp %0, %8, %0" RNB "v_mul_f32_dpp %1, %9, %1" RNB "v_mul_f32_dpp %2, %10, %2" RNB "v_mul_f32_dpp %3, %11, %3" RNB
        "v_fmac_f32_dpp %0, %12, %24" RNB "v_fmac_f32_dpp %1, %13, %24" RNB "v_fmac_f32_dpp %2, %14, %24" RNB "v_fmac_f32_dpp %3, %15, %24" RNB
        "v_fmac_f32_dpp %0, %16, %25" RNB "v_fmac_f32_dpp %1, %17, %25" RNB "v_fmac_f32_dpp %2, %18, %25" RNB "v_fmac_f32_dpp %3, %19, %25" RNB
        "v_fmac_f32_dpp %4, %20, %0" RNB "v_fmac_f32_dpp %5, %21, %1" RNB "v_fmac_f32_dpp %6, %22, %2" RNB "v_fmac_f32_dpp %7, %23, %3" RNB
        : "+v"(s0), "+v"(s1), "+v"(s2), "+v"(s3), "+v"(y0), "+v"(y1), "+v"(y2), "+v"(y3)
        : "v"(w[0]), "v"(w[1]), "v"(w[2]), "v"(w[3]), "v"(b[0]), "v"(b[1]), "v"(b[2]), "v"(b[3]), "v"(kd[0]), "v"(kd[1]), "v"(kd[2]), "v"(kd[3]),
          "v"(r[0]), "v"(r[1]), "v"(r[2]), "v"(r[3]), "v"(nsk), "v"(vv), [n] "i"(N));
}
template <int N, bool FIRST>
__device__ __forceinline__ void dpp_upd4p(float& s0, float& s1, float& s2, float& s3, float& y0, float& y1, float& y2, float& y3,
                                          const f32x4& w, const f32x4& b, const f32x4& r, float nsk) {
    if (FIRST) asm volatile("s_nop 1");
    asm("v_mul_f32_dpp %0, %8, %0" RNB "v_mul_f32_dpp %1, %9, %1" RNB "v_mul_f32_dpp %2, %10, %2" RNB "v_mul_f32_dpp %3, %11, %3" RNB
        "v_fmac_f32_dpp %0, %12, %20" RNB "v_fmac_f32_dpp %1, %13, %20" RNB "v_fmac_f32_dpp %2, %14, %20" RNB "v_fmac_f32_dpp %3, %15, %20" RNB
        "v_fmac_f32_dpp %4, %16, %0" RNB "v_fmac_f32_dpp %5, %17, %1" RNB "v_fmac_f32_dpp %6, %18, %2" RNB "v_fmac_f32_dpp %7, %19, %3" RNB
        : "+v"(s0), "+v"(s1), "+v"(s2), "+v"(s3), "+v"(y0), "+v"(y1), "+v"(y2), "+v"(y3)
        : "v"(w[0]), "v"(w[1]), "v"(w[2]), "v"(w[3]), "v"(b[0]), "v"(b[1]), "v"(b[2]), "v"(b[3]), "v"(r[0]), "v"(r[1]), "v"(r[2]), "v"(r[3]), "v"(nsk), [n] "i"(N));
}
template <int N, bool FIRST>
__device__ __forceinline__ void dpp_mul4(float& s0, float& s1, float& s2, float& s3, const f32x4& v) {
    if (FIRST) asm volatile("s_nop 1");
    asm("v_mul_f32_dpp %0, %4, %0" RNB "v_mul_f32_dpp %1, %5, %1" RNB "v_mul_f32_dpp %2, %6, %2" RNB "v_mul_f32_dpp %3, %7, %3" RNB
        : "+v"(s0), "+v"(s1), "+v"(s2), "+v"(s3) : "v"(v[0]), "v"(v[1]), "v"(v[2]), "v"(v[3]), [n] "i"(N));
}
template <int N>
__device__ __forceinline__ void dpp_fmacx4(float& s0, float& s1, float& s2, float& s3, const f32x4& v, float x) {
    asm("v_fmac_f32_dpp %0, %4, %8" RNB "v_fmac_f32_dpp %1, %5, %8" RNB "v_fmac_f32_dpp %2, %6, %8" RNB "v_fmac_f32_dpp %3, %7, %8" RNB
        : "+v"(s0), "+v"(s1), "+v"(s2), "+v"(s3) : "v"(v[0]), "v"(v[1]), "v"(v[2]), "v"(v[3]), "v"(x), [n] "i"(N));
}
template <int N> struct ScanRep {
    static __device__ __forceinline__ void dot8(float (&a)[8], const f32x4& v, const float (&st)[64]) {
        constexpr int h = (N & 1) * 4;
        dpp_dot4<N, N == 0>(a[h], a[h + 1], a[h + 2], a[h + 3], v, st[4 * N], st[4 * N + 1], st[4 * N + 2], st[4 * N + 3]);
        if constexpr (N < 15) ScanRep<N + 1>::dot8(a, v, st);
    }
    static __device__ __forceinline__ void dot(float& a0, float& a1, float& a2, float& a3, const f32x4& v, const float (&st)[64]) {
        dpp_dot4<N, N == 0>(a0, a1, a2, a3, v, st[4 * N], st[4 * N + 1], st[4 * N + 2], st[4 * N + 3]);
        if constexpr (N < 15) ScanRep<N + 1>::dot(a0, a1, a2, a3, v, st);
    }
    static __device__ __forceinline__ void mul(float (&st)[64], const f32x4& w) {
        dpp_mul4<N, N == 0>(st[4 * N], st[4 * N + 1], st[4 * N + 2], st[4 * N + 3], w);
        if constexpr (N < 15) ScanRep<N + 1>::mul(st, w);
    }
    static __device__ __forceinline__ void fmacx(float (&st)[64], const f32x4& v, float x) {
        dpp_fmacx4<N>(st[4 * N], st[4 * N + 1], st[4 * N + 2], st[4 * N + 3], v, x);
        if constexpr (N < 15) ScanRep<N + 1>::fmacx(st, v, x);
    }
};
__device__ __forceinline__ int scan_row(int b, int d, int pos) { return pos < L ? TL + b * L + (d ? L - 1 - pos : pos) : b * S + (d ? S - 1 - (pos - L) : pos - L); }

template <bool ISP>
__device__ __forceinline__ void scan_task(const Params& p, int c, int s, int lane) {
    const int h = c & 3, b = (c >> 2) % NB, d = (c >> 2) / NB, pos0 = SEGLEN * s;
    const int q = 4 * (lane & 15);
    const float* bkk = p.sKK + h * 64 + q; const float* br = p.sR + h * 64 + q; const float* bw = p.sW + (size_t)d * T * DA + h * 64 + q; const float* bb_ = p.sB + (size_t)d * T * DA + h * 64 + q;
    const float* bkd = p.sKD + (size_t)d * T * DA + h * 64 + q; const float* bv = p.sV + h * 64 + lane;
    float* by = (ISP ? p.PV : p.Y) + (size_t)d * T * DA + h * 64 + lane;
    float st[64];
#pragma unroll
    for (int k = 0; k < 64; ++k) st[k] = (ISP && k == lane) ? 1.0f : 0.f;
    size_t mo = (size_t)scan_row(b, d, pos0) * DA;
    f32x4 kk = *(const f32x4*)(bkk + mo), w = *(const f32x4*)(bw + mo), bb = *(const f32x4*)(bb_ + mo), r = *(const f32x4*)(br + mo), kd = w; float vv = 0.f;
    if (!ISP) { kd = *(const f32x4*)(bkd + mo); vv = bv[mo]; }
#pragma unroll 1
    for (int i = 0; i < SEGLEN; ++i) {
        const size_t mn = (size_t)scan_row(b, d, pos0 + (i + 1 < SEGLEN ? i + 1 : i)) * DA;
        const f32x4 nkk = *(const f32x4*)(bkk + mn), nw = *(const f32x4*)(bw + mn), nb = *(const f32x4*)(bb_ + mn), nr = *(const f32x4*)(br + mn);
        f32x4 nkd = nw; float nv = 0.f;
        if (!ISP) { nkd = *(const f32x4*)(bkd + mn); nv = bv[mn]; }
        float a[8] = {0.f, 0.f, 0.f, 0.f, 0.f, 0.f, 0.f, 0.f};
        ScanRep<0>::dot8(a, kk, st);
        const float nsk = -(((a[0] + a[1]) + (a[2] + a[3])) + ((a[4] + a[5]) + (a[6] + a[7])));
        ScanRep<0>::mul(st, w);
        ScanRep<0>::fmacx(st, bb, nsk);
        if (!ISP) ScanRep<0>::fmacx(st, kd, vv);
        float y[8] = {0.f, 0.f, 0.f, 0.f, 0.f, 0.f, 0.f, 0.f};
        ScanRep<0>::dot8(y, r, st);
        by[mo] = ((y[0] + y[1]) + (y[2] + y[3])) + ((y[4] + y[5]) + (y[6] + y[7]));
        kk = nkk; w = nw; bb = nb; r = nr; kd = nkd; vv = nv; mo = mn;
    }
    if (s < NSG - 1) {
        float* dst = (ISP ? p.PS : p.QS) + (((size_t)c * NSG + s) * 64 + lane) * 64;
#pragma unroll
        for (int k4 = 0; k4 < 16; ++k4) *(f32x4*)(dst + 4 * k4) = (f32x4){st[4 * k4], st[4 * k4 + 1], st[4 * k4 + 2], st[4 * k4 + 3]};
    }
}
__device__ __forceinline__ void ph_scan_fast(const Params& p) {
    const int tid_ = opq_tid(), bid_ = opq_bid(); (void)tid_; (void)bid_;
    const int lane = tid_ & 63, gw = bid_ * 4 + (tid_ >> 6), nw = VGRID * 4;
    constexpr int NS_T = 64 * NSG, NP_T = 64 * (NSG - 1);
    const int G = VGRID, wv = ((tid_ >> 6) + 2 * (bid_ & 1)) & 3; (void)gw; (void)nw;
    for (int tsk = wv * G + bid_; tsk < NS_T + NP_T; tsk += 4 * G) {
        const int t2 = __builtin_amdgcn_readfirstlane(tsk);
        if (t2 < NS_T) scan_task<false>(p, t2 & 63, t2 >> 6, lane);
        else scan_task<true>(p, (t2 - NS_T) & 63, 1 + ((t2 - NS_T) >> 6), lane);
    }
}
__device__ __forceinline__ void ph_combine(const Params& p, char* lds) {
    const int tid_ = opq_tid(), bid_ = opq_bid(); (void)tid_; (void)bid_; (void)lds;
    if (bid_ >= 64) return;
    const int lane = tid_ & 63, c = bid_, cb = tid_ >> 6, q = lane >> 4, i16 = lane & 15, v = 16 * cb + i16;
    const float* QSc = p.QS + (size_t)c * NSG * 4096; const float* PSc = p.PS + (size_t)c * NSG * 4096; float* SSg = p.SS + (size_t)c * NSG * 4096;
    f32x4 acc[4];
#pragma unroll
    for (int ro = 0; ro < 4; ++ro) acc[ro] = *(const f32x4*)(QSc + v * 64 + 16 * ro + 4 * q);
#pragma unroll 1
    for (int s = 1; s < NSG; ++s) {
#pragma unroll
        for (int ro = 0; ro < 4; ++ro)
#pragma unroll
            for (int j = 0; j < 4; ++j) SSg[(size_t)s * 4096 + (16 * ro + 4 * q + j) * 64 + v] = acc[ro][j];
        if (s == NSG - 1) break;
        const float* P = PSc + (size_t)s * 4096 + (4 * q) * 64 + i16;
        float a[4][4][4];
#pragma unroll
        for (int rb = 0; rb < 4; ++rb)
#pragma unroll
            for (int kk = 0; kk < 4; ++kk)
#pragma unroll
                for (int ro = 0; ro < 4; ++ro) a[rb][kk][ro] = P[(16 * rb + kk) * 64 + 16 * ro];
#pragma unroll
        for (int rb = 0; rb < 4; ++rb) asm volatile("" : "+v"(a[rb][0][0]), "+v"(a[rb][0][1]), "+v"(a[rb][0][2]), "+v"(a[rb][0][3]), "+v"(a[rb][1][0]), "+v"(a[rb][1][1]), "+v"(a[rb][1][2]), "+v"(a[rb][1][3]),
                                                         "+v"(a[rb][2][0]), "+v"(a[rb][2][1]), "+v"(a[rb][2][2]), "+v"(a[rb][2][3]), "+v"(a[rb][3][0]), "+v"(a[rb][3][1]), "+v"(a[rb][3][2]), "+v"(a[rb][3][3]));
        f32x4 nacc[4];
#pragma unroll
        for (int ro = 0; ro < 4; ++ro) nacc[ro] = *(const f32x4*)(QSc + (size_t)s * 4096 + v * 64 + 16 * ro + 4 * q);
#pragma unroll
        for (int rb = 0; rb < 4; ++rb)
#pragma unroll
            for (int kk = 0; kk < 4; ++kk)
#pragma unroll
                for (int ro = 0; ro < 4; ++ro) nacc[ro] = __builtin_amdgcn_mfma_f32_16x16x4f32(a[rb][kk][ro], acc[rb][kk], nacc[ro], 0, 0, 0);
#pragma unroll
        for (int ro = 0; ro < 4; ++ro) acc[ro] = nacc[ro];
    }
}
__device__ __forceinline__ float qsum(float v) {
    float a = v, b = v; asm volatile("s_nop 1\n\tv_permlane16_swap_b32 %0, %1" : "+v"(a), "+v"(b)); v = a + b; a = v; b = v;
    asm volatile("s_nop 1\n\tv_permlane32_swap_b32 %0, %1" : "+v"(a), "+v"(b)); return a + b; }
__device__ __forceinline__ void ph_rwkv_out_fast(const Params& p, int l, bool with_ctx) {
    const int tid_ = opq_tid(), bid_ = opq_bid(); (void)tid_; (void)bid_;
    const int lane = tid_ & 63, i16 = lane & 15, q = lane >> 4, gw = bid_ * 4 + (tid_ >> 6), nw = VGRID * 4;
    constexpr int TOK = 16, NLT = NB * (S / TOK) * 4, NCTK = NB * (L / TOK) * 4;
    const int ntask = NLT + (with_ctx ? NCTK : 0);
    for (int tsk = gw; tsk < ntask; tsk += nw) {
        const bool isCtx = tsk >= NLT; const int r = isCtx ? tsk - NLT : tsk;
        const int h = r & 3, npt = isCtx ? L / TOK : S / TOK, tt = (r >> 2) % npt, b = (r >> 2) / npt;
        const int seg0 = (isCtx ? TOK * tt : L + TOK * tt) / SEGLEN, seg1 = (isCtx ? L - 1 - TOK * tt : L + S - 1 - TOK * tt) / SEGLEN;
        const int m = (isCtx ? TL + b * L + TOK * tt : b * S + TOK * tt) + i16;
        const size_t o = (size_t)m * DA + h * 64 + 4 * q, o1 = o + (size_t)T * DA;
        f32x4 acc[4];
#pragma unroll
        for (int rb = 0; rb < 4; ++rb) acc[rb] = *(const f32x4*)(p.Y + o + 16 * rb) + *(const f32x4*)(p.Y + o1 + 16 * rb);
#pragma unroll
        for (int d = 0; d < 2; ++d) {
            const int seg = d ? seg1 : seg0;
            if (seg > 0) {
                const float* sst = p.SS + (((size_t)(d * NB + b) * 4 + h) * NSG + seg) * 4096 + q * 64 + i16;
                const float* pvp = p.PV + (d ? o1 : o) - 4 * q + q;
                float a[4][16], bq[16];
#pragma unroll
                for (int kk = 0; kk < 16; ++kk) { bq[kk] = pvp[4 * kk];
#pragma unroll
                    for (int rb = 0; rb < 4; ++rb) a[rb][kk] = sst[(4 * kk) * 64 + 16 * rb]; }
#pragma unroll
                for (int rb = 0; rb < 4; ++rb) asm volatile("" : "+v"(a[rb][0]), "+v"(a[rb][1]), "+v"(a[rb][2]), "+v"(a[rb][3]), "+v"(a[rb][4]), "+v"(a[rb][5]), "+v"(a[rb][6]), "+v"(a[rb][7]),
                                                                 "+v"(a[rb][8]), "+v"(a[rb][9]), "+v"(a[rb][10]), "+v"(a[rb][11]), "+v"(a[rb][12]), "+v"(a[rb][13]), "+v"(a[rb][14]), "+v"(a[rb][15]));
#pragma unroll
                for (int kk = 0; kk < 16; ++kk)
#pragma unroll
                    for (int rb = 0; rb < 4; ++rb) acc[rb] = __builtin_amdgcn_mfma_f32_16x16x4f32(a[rb][kk], bq[kk], acc[rb], 0, 0, 0);
            }
        }
        float s = 0.f;
#pragma unroll
        for (int rb = 0; rb < 4; ++rb) s += sum4(acc[rb]);
        const float mu = qsum(s) * (1.0f / 64.f);
        float sq = 0.f, bon = 0.f;
#pragma unroll
        for (int rb = 0; rb < 4; ++rb) { const f32x4 dy = acc[rb] - mu; sq += sum4(dy * dy);
            const f32x4 rr = *(const f32x4*)(p.sR + o + 16 * rb), kds = *(const f32x4*)(p.sKD + o + 16 * rb) + *(const f32x4*)(p.sKD + o1 + 16 * rb), rk = *(const f32x4*)(p.a_r_k + l * DA + h * 64 + 16 * rb + 4 * q);
            bon += sum4(rr * kds * rk); }
        const float rstd = 1.0f / sqrtf(qsum(sq) * (1.0f / 64.f) + GN_EPS); bon = qsum(bon);
#pragma unroll
        for (int rb = 0; rb < 4; ++rb) { const int c = h * 64 + 16 * rb + 4 * q;
            const f32x4 gln = *(const f32x4*)(p.a_lnx_g + l * DA + c), bln = *(const f32x4*)(p.a_lnx_b + l * DA + c), vv = *(const f32x4*)(p.sV + o + 16 * rb);
            bf16_t* mp = p.MIX + (size_t)m * DMIX + c; const f32x4 gg = ld_bf16x4(mp);
            st_bf16x4(mp, ((acc[rb] - mu) * rstd * gln + bln + vv * bon) * gg); }
    }
}


#define LAS __attribute__((address_space(3)))
#define XB_TMO      128
#define XB_XCNT(j)  (256  + 64 * (j))
#define XB_XSUB(j)  (1280 + 64 * (j))
#define XB_XGEN(j)  (2304 + 64 * (j))
#define XB_TOP      3328
#define XB_TOPGEN   3392
#define XCD_BAR_WORDS 3456
#define XB_SPIN_CAP (1u << 20)
static_assert(XCD_BAR_WORDS * 4 <= 16384, "barrier words fit the control region");
__device__ __forceinline__ unsigned xb_ld(unsigned* p)              { return __hip_atomic_load(p, __ATOMIC_RELAXED, __HIP_MEMORY_SCOPE_AGENT); }
__device__ __forceinline__ unsigned xb_add(unsigned* p, unsigned v) { return __hip_atomic_fetch_add(p, v, __ATOMIC_RELAXED, __HIP_MEMORY_SCOPE_AGENT); }
__device__ __forceinline__ unsigned xb_xcc_id() { return (unsigned)__builtin_amdgcn_s_getreg((3 << 11) | 20) & 0xFu; }
#define XB_SPIN(cond, bar) do { unsigned _sp = 0; while (cond) { __builtin_amdgcn_s_sleep(1); \
    if ((++_sp & 255u) == 0u) { if (xb_ld(&(bar)[XB_TMO])) break; if (_sp > XB_SPIN_CAP) { atomicAdd(&(bar)[XB_TMO], 1u); break; } } } } while (0)
struct XcdBarrier { unsigned* bar; unsigned x; volatile LAS unsigned* st; };
__device__ __forceinline__ XcdBarrier xcd_barrier_post(unsigned* bar, volatile LAS unsigned* st) {
    XcdBarrier b; b.bar = bar; b.x = xb_xcc_id(); b.st = st;
    if (threadIdx.x == 0) (void)xb_add(&bar[XB_XCNT(b.x)], 1u);
    return b;
}
__device__ __forceinline__ void xcd_barrier_complete(unsigned* bar, unsigned x, unsigned& nloc, unsigned& nx) {
    const unsigned G = gridDim.x * gridDim.y * gridDim.z;
    unsigned sum, cnt, mine, sp = 0u;
    for (;;) {
        sum = 0u; cnt = 0u; mine = 0u;
#pragma unroll
        for (unsigned j = 0; j < 16; ++j) { const unsigned c = xb_ld(&bar[XB_XCNT(j)]); sum += c; cnt += (c > 0u) ? 1u : 0u; mine = (j == x) ? c : mine; }
        if (sum == G) break;
        __builtin_amdgcn_s_sleep(1);
        if ((++sp & 255u) == 0u) { if (xb_ld(&bar[XB_TMO])) break; if (sp > XB_SPIN_CAP) { atomicAdd(&bar[XB_TMO], 1u); break; } }
    }
    nloc = mine > 0u ? mine : 1u; nx = cnt > 0u ? cnt : 1u;
}
__device__ __forceinline__ void xcd_barrier(const XcdBarrier& b) {
    asm volatile("s_waitcnt vmcnt(0)" ::: "memory");
    __syncthreads();
    if (threadIdx.x == 0) {
        unsigned* bar = b.bar;
        __builtin_amdgcn_s_waitcnt(0);
        unsigned nloc = b.st[0], nx = b.st[1];
        if (nloc == 0u) { xcd_barrier_complete(bar, b.x, nloc, nx); b.st[0] = nloc; b.st[1] = nx; }
        const unsigned old = xb_add(&bar[XB_XSUB(b.x)], 1u);
        const unsigned gen = old / nloc;
        if (old + 1u == (gen + 1u) * nloc) {
            __builtin_amdgcn_fence(__ATOMIC_RELEASE, "agent");
            asm volatile("s_waitcnt vmcnt(0)" ::: "memory");
            const unsigned og = xb_add(&bar[XB_TOP], 1u);
            const unsigned tg = og / nx;
            if (og + 1u == (tg + 1u) * nx) xb_add(&bar[XB_TOPGEN], 1u);
            else XB_SPIN(xb_ld(&bar[XB_TOPGEN]) == tg, bar);
            __builtin_amdgcn_fence(__ATOMIC_ACQUIRE, "agent");
            xb_add(&bar[XB_XGEN(b.x)], 1u);
            asm volatile("s_waitcnt vmcnt(0)" ::: "memory");
        } else {
            XB_SPIN(xb_ld(&bar[XB_XGEN(b.x)]) == gen, bar);
            __builtin_amdgcn_fence(__ATOMIC_ACQUIRE, "agent");
            asm volatile("s_waitcnt vmcnt(0)" ::: "memory");
        }
    }
    __syncthreads();
}

__device__ __forceinline__ long opq_gt() { int t = threadIdx.x; asm volatile("" : "+v"(t)); return (long)blockIdx.x * blockDim.x + t; }
#define GS ((long)gridDim.x * blockDim.x)
__global__ void __launch_bounds__(512, 1) mega_fwd(Params p) {
    __shared__ __attribute__((aligned(16))) char lds_all[2 * 73728 + 64];
    cg::grid_group grid = cg::this_grid();
    const long gs = GS;
#define gt opq_gt()
    char* lds = lds_all + __builtin_amdgcn_readfirstlane(threadIdx.x >> 8) * 73728;
    volatile LAS unsigned* bst = (volatile LAS unsigned*)(LAS char*)(lds_all + 2 * 73728);
    if (threadIdx.x < 2) bst[threadIdx.x] = 0u;
    __syncthreads();
    const XcdBarrier xb = xcd_barrier_post(p.bar, bst);
#ifndef PROBE_PHASE
#define PROBE_PHASE -1
#endif
#define PROBE_AMP 8
    unsigned long long t_prev = 0; int nts = 0;
#define STAMP() do { if (PROBE_PHASE >= 0 && blockIdx.x == 0 && threadIdx.x == 0) { const unsigned long long t_now = __builtin_amdgcn_s_memrealtime(); \
        if (nts == PROBE_PHASE + 1) { const unsigned long long t_end = t_now + PROBE_AMP * (t_now - t_prev); while (__builtin_amdgcn_s_memrealtime() < t_end) __builtin_amdgcn_s_sleep(8); } \
        t_prev = __builtin_amdgcn_s_memrealtime(); } ++nts; } while (0)
#define GSYNC() do { xcd_barrier(xb); STAMP(); } while (0)
    STAMP();
    ph_mod_fast(p, lds); ph_prep_w_fast(p, 0, 0, lds); ph_prep_misc(p, 0, gt, gs, false);
    if (p.out == nullptr) grid.sync();
    GSYNC();
    for (int l = 0; l < 2; ++l) {
        const int nrows = (l == 0) ? T : TL;
        if (l == 0) { ph_lnmod_fast(p, l); GSYNC(); }
        g_gemm_in(p, lds_all);
        GSYNC();
        ph_streams_s1(p, l);
        GSYNC();
        g_streams_s2(p, l, lds);
        GSYNC();
        ph_scan_fast(p);
        GSYNC();
        ph_combine(p, lds); ph_attn_blk(p, l, l == 0, 64, lds);
        GSYNC();
        ph_rwkv_out_fast(p, l, l == 0);
        GSYNC();
        if (blockIdx.x >= gridDim.x / 2) { ph_prep_w_fast(p, l, 1, lds); __syncthreads(); g_gemm_out(p, nrows, lds_all); } else { g_gemm_out(p, nrows, lds_all); __syncthreads(); ph_prep_w_fast(p, l, 1, lds); }
        GSYNC();
        g_router(p, l, nrows, lds);
        GSYNC();
        ph_dispatch_fast(p, l, nrows, lds);
        GSYNC();
        g_moe1(p, l, lds_all);
        GSYNC();
        g_moe2(p, l, lds_all);
        GSYNC();
        ph_final_fast(p, l, nrows, l == 0);
        if (l == 0) { ph_prep_w_fast(p, 1, 0, lds); ph_prep_misc(p, 1, gt, gs, false); }
        GSYNC();
    }}

extern "C" void kernel_launch(void* const* d_in, const int* in_sizes, int n_in, void* d_out, int out_size, void* d_ws, size_t ws_size, hipStream_t stream) {
    if (n_in != 32 || out_size != TL * D || ws_size < WS_NEED) { fprintf(stderr, "kernel_launch: unexpected shapes / workspace (n_in %d out %d ws %zu need %zu)\n", n_in, out_size, ws_size, (size_t)WS_NEED); return; }
    static int grid_blocks = 0;
    if (!grid_blocks) {
        int dev = 0, cus = 0, per_cu = 0;
        (void)hipGetDevice(&dev);
        (void)hipDeviceGetAttribute(&cus, hipDeviceAttributeMultiprocessorCount, dev);
        (void)hipOccupancyMaxActiveBlocksPerMultiprocessor(&per_cu, mega_fwd, 512, 0);
        if (per_cu < 1) per_cu = 1;
        if (per_cu > 1) per_cu = 1;
        grid_blocks = cus * per_cu;
        fprintf(stderr, "kernel_launch: %d CUs x %d blocks\n", cus, per_cu);
    }
    Params p = make_params(d_in, d_out, d_ws);
    (void)hipMemsetAsync(d_ws, 0, CTL_BYTES, stream);
    void* args[] = {&p};
    hipError_t e = hipLaunchCooperativeKernel((void*)mega_fwd, dim3(grid_blocks), dim3(512), args, 0, stream);
    if (e != hipSuccess) fprintf(stderr, "cooperative launch failed: %s (grid %d)\n", hipGetErrorString(e), grid_blocks);
}
#endif

#ifdef HOST_EMU
static void host_forward(void* const* d_in, void* d_out, void* d_ws) {
    const Params p = make_params(d_in, d_out, d_ws);
    for (int l = 0; l < 2; ++l) {
        const int nrows = (l == 0) ? T : TL;
        ph_prep_w(p, l, 0, 1); ph_prep_misc(p, l, 0, 1); ph_lnmod(p, l, 0, 1); host_gemm_in(p); ph_streams(p, l, 0, 1); ph_rope(p, 0, 1); ph_scan(p, 0, 1);
        ph_attn(p, l, nrows, 0, 1); ph_rwkv_out(p, l, nrows, 0, 1); host_gemm_out(p, nrows); ph_post_mixer(p, l, nrows, 0, 1);
        ph_dispatch(p, l, nrows, 0, 1); host_moe1(p, l); host_moe2(p, l); ph_final(p, l, nrows, 0, 1);
    }
}
#endif
```

```cpp
#ifdef HOST_EMU
#include <cmath>
#include <cstdio>
#include <cstring>
#include <cstdint>
#include <cstdlib>
#define __device__
#define __global__
#define __host__
#define __forceinline__ inline
#else
#include <hip/hip_runtime.h>
#include <hip/hip_cooperative_groups.h>
#include <cstdio>
#include <cstdint>
namespace cg = cooperative_groups;
#endif

#ifndef CFG_D
#define CFG_D 1024
#define CFG_B 8
#define CFG_S 2048
#define CFG_L 256
#define CFG_DE 512
#endif
constexpr int D = CFG_D, NB = CFG_B, S = CFG_S, L = CFG_L, DE = CFG_DE;
constexpr int TL = NB * S, TC = NB * L, T = TL + TC;
constexpr int GRID_W = 64, HD = 64;
constexpr int DA = 256, A_IN = 1184, N_IN = 2976, NINP = 3072, DMIX = 1024;
#ifdef HOST_EMU
constexpr int MPAD = 128;
#else
constexpr int MPAD = 256;
#endif
constexpr int NEXP = 32, NSLOT = 2 * T + NEXP * MPAD;
#ifdef HOST_EMU
constexpr int ZQB = 0, ZKB = 384, ZVB = 512, ZQN = 640, ZKN = 1024, ZVN = 1408, ZA = 1792, ZP = 2976;
#else
constexpr int ZQB = 0, ZKB = 384, ZQN = 512, ZKN = 896, ZA = 1280, ZP = 2464, WVB = 2560, WVN = 2688;
#endif
constexpr float LN_EPS = 1e-6f, GN_EPS = 64e-5f, ATT_SCALE = 0.125f, LOG2E = 1.4426950408889634f, QSCALE = ATT_SCALE * LOG2E;
constexpr float ALPHA = 1.41421356237309515f;

typedef unsigned short bf16_t;

__device__ __forceinline__ float bf2f(bf16_t v) {
    unsigned u = ((unsigned)v) << 16; float f;
#ifdef HOST_EMU
    memcpy(&f, &u, 4);
#else
    f = __uint_as_float(u);
#endif
    return f;
}
__device__ __forceinline__ bf16_t f2bf(float f) {
    unsigned u;
#ifdef HOST_EMU
    memcpy(&u, &f, 4);
#else
    u = __float_as_uint(f);
#endif
    return (bf16_t)((u + 0x7fffu + ((u >> 16) & 1u)) >> 16);
}
__device__ __forceinline__ float sigmoidf_(float x) { return 1.0f / (1.0f + expf(-x)); }
__device__ __forceinline__ float siluf_(float x) { return x / (1.0f + expf(-x)); }
__device__ __forceinline__ int atomic_inc_int(int* p) {
#ifdef HOST_EMU
    int o = *p; *p = o + 1; return o;
#else
    return atomicAdd(p, 1);
#endif
}

struct Params {
    const float *x, *c, *ctx, *c_ctx, *w_mod, *b_mod, *w_in, *w_out, *a_shift, *a_w0, *a_w_up, *a_a0, *a_a_up, *a_g_up,
        *a_k_k, *a_k_a, *a_r_k, *a_lnx_g, *a_lnx_b, *b_sink, *c_rpb, *ln1_g, *ln1_b, *ln2_g, *ln2_b, *w_rg, *b_rg, *w_re,
        *b_re, *w_gate, *w_up, *w_down;
    float* out;
    int* cnt;
    unsigned* bar;
    float* mod;
    float* rope;
    bf16_t *win_t, *wout_t, *wgu_t, *wd_t;
    bf16_t *wrt;
    int* hist;
    bf16_t* HLO;
    bf16_t *wupT, *aupT, *gupT;
    bf16_t* LA;
    float *kT, *kN;
    bf16_t* H;
    bf16_t* Z;
    bf16_t* VT;
    float *sR, *sV, *sKK, *sG, *sW, *sKD, *sB;
    float* Y;
    bf16_t* MIX;
    float *PV, *QS, *PS, *SS;
    float* XC;
    bf16_t* O;
    bf16_t* YSb;
    int *rE, *rPos, *rSlot; float* rW;
    int* slotTok;
    bf16_t* ACT;
    float* YS;
};

constexpr size_t al256(size_t v) { return (v + 255) & ~(size_t)255; }
constexpr size_t OFF_CNT = 0;
constexpr size_t OFF_BAR = 4096, CTL_BYTES = 4096 + 16384;
constexpr size_t OFF_MOD = CTL_BYTES;
constexpr size_t OFF_ROPE = al256(OFF_MOD + (size_t)2 * (NB + 1) * 6 * D * 4);
constexpr size_t OFF_LORA = al256(OFF_ROPE + 64 * 16 * 2 * 4);
constexpr size_t OFF_WRT = al256(OFF_LORA + (size_t)(2 * 256 * 64 * 2 + 256 * 160) * 2);
constexpr size_t OFF_LG = al256(OFF_WRT + (size_t)2 * 128 * D * 2);
constexpr size_t OFF_WIN = al256(OFF_LG + (size_t)(T / 32) * 32 * 4);
constexpr size_t OFF_WOUT = al256(OFF_WIN + (size_t)NINP * D * 2);
constexpr size_t OFF_WGU = al256(OFF_WOUT + (size_t)D * DMIX * 2);
constexpr size_t OFF_WD = al256(OFF_WGU + (size_t)NEXP * 2 * DE * D * 2);
constexpr size_t OFF_H = al256(OFF_WD + (size_t)NEXP * D * DE * 2);
constexpr size_t OFF_Z = al256(OFF_H + (size_t)(T + 1) * D * 2);
constexpr int PU = L + S;
constexpr int SEGLEN = 144, NSG = (L + S) / SEGLEN;
#ifndef HOST_EMU
static_assert((L + S) % SEGLEN == 0 && SEGLEN % 16 == 0 && L % 16 == 0 && S % 16 == 0, "16-token output tiles must not straddle scan segments");
static_assert((size_t)3 * 64 * NSG * 4096 * 4 <= (size_t)NEXP * 2 * DE * D * 2, "scan segment states overlay wgu_t");
#endif
constexpr size_t OFF_VT = al256(OFF_Z + (size_t)T * 2976 * 2);
constexpr size_t OFF_S = al256(OFF_VT + (size_t)NB * 8 * 64 * PU * 2);
constexpr size_t S1 = (size_t)T * 256 * 4;
#ifdef HOST_EMU
constexpr int NSTREAM = 10;
#else
constexpr int NSTREAM = 9;
#endif
constexpr size_t OFF_Y = al256(OFF_S + NSTREAM * S1);
constexpr size_t OFF_MIX = al256(OFF_Y + 2 * S1);
constexpr size_t OFF_XC = al256(OFF_MIX + (size_t)T * 1024 * 2);
constexpr size_t OFF_ROUTE = al256(OFF_XC + (size_t)TC * D * 4);
constexpr size_t OFF_SLOTTOK = al256(OFF_ROUTE + (size_t)T * 2 * 4 * 4);
constexpr size_t WS_NEED = al256(OFF_SLOTTOK + (size_t)NSLOT * 4);
static_assert((size_t)NSLOT * DE * 2 <= (size_t)T * 2976 * 2 && (size_t)T * D * 2 <= (size_t)T * 2976 * 2, "ACT / HLO overlay Z");
static_assert((size_t)T * 4 * 4 + (size_t)T * 416 * 2 <= S1, "kN + LA overlay Y[1]");
#ifdef HOST_EMU
static_assert((size_t)NSLOT * D * 4 <= NSTREAM * S1 && (size_t)T * D * 4 <= NSTREAM * S1, "YS / O overlay the stream buffers");
#else
static_assert((size_t)NSLOT * D * 2 <= NSTREAM * S1 && (size_t)T * D * 2 <= NSTREAM * S1, "YSb / O overlay the stream buffers");
#endif

static Params make_params(void* const* d_in, void* d_out, void* d_ws) {
    Params p{};
    const float** f = (const float**)&p.x;
    for (int i = 0; i < 32; ++i) f[i] = (const float*)d_in[i];
    p.out = (float*)d_out;
    char* w = (char*)d_ws;
    p.cnt = (int*)(w + OFF_CNT); p.bar = (unsigned*)(w + OFF_BAR); p.mod = (float*)(w + OFF_MOD); p.rope = (float*)(w + OFF_ROPE);
    p.win_t = (bf16_t*)(w + OFF_WIN); p.wout_t = (bf16_t*)(w + OFF_WOUT); p.wgu_t = (bf16_t*)(w + OFF_WGU); p.wd_t = (bf16_t*)(w + OFF_WD);
    p.wrt = (bf16_t*)(w + OFF_WRT); p.hist = (int*)(w + OFF_LG); p.HLO = (bf16_t*)(w + OFF_Z);
    p.wupT = (bf16_t*)(w + OFF_LORA); p.aupT = p.wupT + 2 * 256 * 64; p.gupT = p.aupT + 2 * 256 * 64;
    p.H = (bf16_t*)(w + OFF_H); p.Z = (bf16_t*)(w + OFF_Z); p.VT = (bf16_t*)(w + OFF_VT);
    float* s = (float*)(w + OFF_S); const size_t n1 = (size_t)T * 256;
    p.sR = s; p.sV = s + n1; p.sKK = s + 2 * n1; p.sW = s + 3 * n1; p.sKD = s + 5 * n1; p.sB = s + 7 * n1; p.sG = s + 9 * n1;
    p.Y = (float*)(w + OFF_Y); p.MIX = (bf16_t*)(w + OFF_MIX); p.XC = (float*)(w + OFF_XC);
    p.O = (bf16_t*)(w + OFF_S); p.YSb = (bf16_t*)(w + OFF_S);
    p.PV = (float*)(w + OFF_H); p.QS = (float*)(w + OFF_WGU); p.PS = p.QS + (size_t)64 * NSG * 4096; p.SS = p.PS + (size_t)64 * NSG * 4096;
    p.kT = p.Y; p.kN = p.Y + (size_t)T * 256; p.LA = (bf16_t*)(p.Y + (size_t)T * 256 + (size_t)T * 4);
    int* r = (int*)(w + OFF_ROUTE); p.rE = r; p.rPos = r + 2 * T; p.rSlot = r + 4 * T; p.rW = (float*)(r + 6 * T);
    p.slotTok = (int*)(w + OFF_SLOTTOK);
    p.ACT = (bf16_t*)(w + OFF_Z); p.YS = (float*)(w + OFF_S);
    return p;
}

#ifdef HOST_EMU
__device__ void ph_prep_w(const Params& p, int l, long gtid, long gsz) {
    for (long i = gtid; i < (long)D * NINP; i += gsz) {
        const int k = (int)(i / NINP), n = (int)(i % NINP);
        float v = 0.f;
        if (n < N_IN) { const int oc = (n < ZA) ? n + A_IN : n - ZA; v = p.w_in[((size_t)l * D + k) * N_IN + oc]; }
        p.win_t[(size_t)n * D + k] = f2bf(v);
    }
    for (long i = gtid; i < (long)DMIX * D; i += gsz) {
        const int k = (int)(i / D), n = (int)(i % D);
        p.wout_t[(size_t)n * DMIX + k] = f2bf(p.w_out[((size_t)l * DMIX + k) * D + n]);
    }
    for (long i = gtid; i < (long)NEXP * D * 2 * DE; i += gsz) {
        const int rho = (int)(i % (2 * DE)); const long t = i / (2 * DE); const int k = (int)(t % D), e = (int)(t / D);
        const int q = rho >> 5, half = (rho >> 4) & 1, ii = rho & 15, cc = 16 * q + ii;
        const float* src = half ? p.w_up : p.w_gate;
        p.wgu_t[((size_t)e * 2 * DE + rho) * D + k] = f2bf(src[(((size_t)l * NEXP + e) * D + k) * DE + cc]);
    }
    for (long i = gtid; i < (long)NEXP * DE * D; i += gsz) {
        const int n = (int)(i % D); const long t = i / D; const int k = (int)(t % DE), e = (int)(t / DE);
        p.wd_t[((size_t)e * D + n) * DE + k] = f2bf(p.w_down[(((size_t)l * NEXP + e) * DE + k) * D + n]);
    }
}
#endif
__device__ __forceinline__ void ph_prep_misc(const Params& p, int l, long gtid, long gsz, bool do_mod = true) {
    if (l == 0 && do_mod) for (long i = gtid; i < (long)2 * (NB + 1) * 6 * D; i += gsz) {
        const int j = (int)(i % (6 * D)), b = (int)((i / (6 * D)) % (NB + 1)), ll = (int)(i / ((long)6 * D * (NB + 1)));
        const float* cv = (b < NB) ? p.c + (size_t)b * D : p.c_ctx;
        float acc = 0.f;
        for (int k = 0; k < D; ++k) acc += siluf_(cv[k]) * p.w_mod[((size_t)ll * D + k) * 6 * D + j];
        p.mod[((size_t)ll * (NB + 1) + b) * 6 * D + j] = acc + p.b_mod[(size_t)ll * 6 * D + j];
    }
    if (l == 0) for (long i = gtid; i < 64 * 16; i += gsz) {
        const int pos = (int)(i / 16), fi = (int)(i % 16);
        const float inv = powf(10000.0f, -(float)fi / 16.0f), ang = (float)pos * inv;
        p.rope[i] = cosf(ang); p.rope[1024 + i] = sinf(ang);
    }
    for (long i = gtid; i < NEXP; i += gsz) p.cnt[l * NEXP + i] = 0;
    for (long i = gtid; i < NSLOT; i += gsz) p.slotTok[i] = T;
    for (long i = gtid; i < D; i += gsz) p.H[(size_t)T * D + i] = 0;
}

__device__ __forceinline__ const float* xrow_in(const Params& p, int l, int m) {
    if (m < TL) return (l == 0 ? p.x : p.out) + (size_t)m * D;
    return (l == 0 ? p.ctx : p.XC) + (size_t)(m - TL) * D;
}
__device__ __forceinline__ const float* modrow(const Params& p, int l, int m) { return p.mod + ((size_t)l * (NB + 1) + (m < TL ? m / S : NB)) * 6 * D; }

__device__ void ph_lnmod(const Params& p, int l, long gtid, long gsz) {
    for (long m = gtid; m < T; m += gsz) {
        const float* xr = xrow_in(p, l, (int)m); const float* md = modrow(p, l, (int)m);
        float s = 0.f; for (int j = 0; j < D; ++j) s += xr[j];
        const float mu = s / D; float q = 0.f;
        for (int j = 0; j < D; ++j) { const float d = xr[j] - mu; q += d * d; }
        const float rstd = 1.0f / sqrtf(q / D + LN_EPS);
        for (int j = 0; j < D; ++j) p.H[(size_t)m * D + j] = f2bf((xr[j] - mu) * rstd * (1.0f + md[D + j]) + md[j]);
    }
}

__device__ __forceinline__ float zshift(const Params& p, int l, int m, int col) {
    int t, len;
    if (m < TL) { t = m % S; len = S; } else { t = (m - TL) % L; len = L; }
    const float* sh = p.a_shift + (size_t)l * 3 * A_IN;
    const bf16_t* z = p.Z + (size_t)m * ZP + ZA + col;
    float v = sh[A_IN + col] * bf2f(z[0]);
    if (t > 0) v += sh[col] * bf2f(z[-ZP]);
    if (t < len - 1) v += sh[2 * A_IN + col] * bf2f(z[ZP]);
    return v;
}

__device__ void ph_streams(const Params& p, int l, long gtid, long gsz) {
    for (long i = gtid; i < (long)T * DA; i += gsz) {
        const int m = (int)(i / DA), c = (int)(i % DA), h0 = c & ~63;
        const float r = zshift(p, l, m, c), k = zshift(p, l, m, 256 + c), v = zshift(p, l, m, 512 + c);
        float nrm = 0.f;
        for (int j = 0; j < 64; ++j) { const float t = zshift(p, l, m, 256 + h0 + j) * p.a_k_k[l * DA + h0 + j]; nrm += t * t; }
        const float kk = k * p.a_k_k[l * DA + c] / sqrtf(nrm + 1e-12f);
        float g = 0.f;
        for (int j = 0; j < 160; ++j) g += sigmoidf_(zshift(p, l, m, 1024 + j)) * p.a_g_up[((size_t)l * 160 + j) * DA + c];
        const size_t o = (size_t)m * DA + c;
        p.sR[o] = r; p.sV[o] = v; p.sKK[o] = kk; p.sG[o] = g;
        for (int d = 0; d < 2; ++d) {
            float aw = 0.f, aa = 0.f;
            for (int j = 0; j < 64; ++j) {
                aw += tanhf(zshift(p, l, m, 768 + d * 64 + j)) * p.a_w_up[(((size_t)l * 2 + d) * 64 + j) * DA + c];
                aa += zshift(p, l, m, 896 + d * 64 + j) * p.a_a_up[(((size_t)l * 2 + d) * 64 + j) * DA + c];
            }
            const float u = -(p.a_w0[(l * 2 + d) * DA + c] + aw);
            const float sp = (u > 20.f) ? u : log1pf(expf(u));
            const float w = expf(-expf(-sp - 0.5f));
            const float a = sigmoidf_(p.a_a0[(l * 2 + d) * DA + c] + aa);
            const size_t od = ((size_t)d * T + m) * DA + c;
            p.sW[od] = w; p.sKD[od] = k * (1.0f + (a - 1.0f) * p.a_k_a[l * DA + c]); p.sB[od] = kk * a;
        }
    }
}

__device__ __forceinline__ void ph_rope(const Params& p, long gtid, long gsz) {
    for (long i = gtid; i < (long)TL * 8 * 32; i += gsz) {
        const int pr = (int)(i & 31), hs = (int)((i >> 5) & 7), m = (int)(i >> 8);
        const int t = m % S, axis = pr >> 4, fi = pr & 15, pos = axis ? (t % GRID_W) : (t / GRID_W);
        bf16_t* z = p.Z + (size_t)m * ZP + hs * 64 + axis * 32 + fi;
        const float cs = p.rope[pos * 16 + fi], sn = p.rope[1024 + pos * 16 + fi];
        const float x0 = bf2f(z[0]), x1 = bf2f(z[16]);
        z[0] = f2bf(x0 * cs - x1 * sn); z[16] = f2bf(x1 * cs + x0 * sn);
    }
}

__device__ void ph_scan(const Params& p, long gtid, long gsz) {
    for (long i = gtid; i < (long)2 * NB * 4 * 64; i += gsz) {
        const int v = (int)(i & 63), h = (int)((i >> 6) & 3), b = (int)((i >> 8) % NB), d = (int)((i >> 8) / NB);
        float st[64];
#pragma unroll
        for (int k = 0; k < 64; ++k) st[k] = 0.f;
        for (int pos = 0; pos < L + S; ++pos) {
            int m;
            if (pos < L) m = TL + b * L + (d ? L - 1 - pos : pos);
            else m = b * S + (d ? S - 1 - (pos - L) : pos - L);
            const size_t o = (size_t)m * DA + h * 64, od = ((size_t)d * T + m) * DA + h * 64;
            const float* kk = p.sKK + o; const float* r = p.sR + o;
            const float* w = p.sW + od; const float* bb = p.sB + od; const float* kd = p.sKD + od;
            const float vv = p.sV[o + v];
            float sk = 0.f;
#pragma unroll
            for (int k = 0; k < 64; ++k) sk += st[k] * kk[k];
            float y = 0.f;
#pragma unroll
            for (int k = 0; k < 64; ++k) { st[k] = st[k] * w[k] - sk * bb[k] + vv * kd[k]; y += st[k] * r[k]; }
            p.Y[od + v] = y;
        }
    }
}

__device__ void ph_rwkv_out(const Params& p, int l, int nrows, long gtid, long gsz) {
    for (long i = gtid; i < (long)nrows * 4; i += gsz) {
        const int m = (int)(i >> 2), h = (int)(i & 3);
        const size_t o = (size_t)m * DA + h * 64;
        const float* y0 = p.Y + o; const float* y1 = p.Y + (size_t)T * DA + o;
        float s = 0.f, bon = 0.f;
        for (int n = 0; n < 64; ++n) {
            s += y0[n] + y1[n];
            bon += p.sR[o + n] * (p.sKD[o + n] + p.sKD[(size_t)T * DA + o + n]) * p.a_r_k[l * DA + h * 64 + n];
        }
        const float mu = s / 64.f; float q = 0.f;
        for (int n = 0; n < 64; ++n) { const float dd = y0[n] + y1[n] - mu; q += dd * dd; }
        const float rstd = 1.0f / sqrtf(q / 64.f + GN_EPS);
        for (int n = 0; n < 64; ++n) {
            const int c = h * 64 + n;
            const float yn = (y0[n] + y1[n] - mu) * rstd * p.a_lnx_g[l * DA + c] + p.a_lnx_b[l * DA + c];
            p.MIX[(size_t)m * DMIX + c] = f2bf((yn + bon * p.sV[o + n]) * p.sG[o + n]);
        }
    }
}

#ifdef HOST_EMU
__device__ __forceinline__ void att_key(const float (&q)[64], const bf16_t* kr, const bf16_t* vr, float bias, float& mx, float& ls, float (&acc)[64]) {
    float s = 0.f;
#pragma unroll
    for (int d = 0; d < 64; ++d) s += q[d] * bf2f(kr[d]);
    s = s * ATT_SCALE + bias;
    const float mn = fmaxf(mx, s), f = expf(mx - mn), pe = expf(s - mn);
    ls = ls * f + pe;
#pragma unroll
    for (int d = 0; d < 64; ++d) acc[d] = acc[d] * f + pe * bf2f(vr[d]);
    mx = mn;
}

__device__ void ph_attn(const Params& p, int l, int nrows, long gtid, long gsz) {
    for (long i = gtid; i < (long)nrows * 12; i += gsz) {
        const int m = (int)(i / 12), u = (int)(i % 12);
        const bool isB = u < 6; const int hq = isB ? u : u - 6;
        const int b = (m < TL) ? m / S : (m - TL) / L;
        const int qcol = isB ? ZQB + hq * 64 : ZQN + hq * 64;
        const int kcol = isB ? ZKB + (hq / 3) * 64 : ZKN + hq * 64;
        const int vcol = isB ? ZVB + (hq / 3) * 64 : ZVN + hq * 64;
        float q[64], acc[64];
        const bf16_t* qr = p.Z + (size_t)m * ZP + qcol;
#pragma unroll
        for (int d = 0; d < 64; ++d) { q[d] = bf2f(qr[d]); acc[d] = 0.f; }
        float mx, ls;
        if (isB) { mx = p.b_sink[l * 6 + hq]; ls = 1.0f; } else { mx = -1e30f; ls = 0.f; }
        for (int j = 0; j < L; ++j) { const bf16_t* zr = p.Z + (size_t)(TL + b * L + j) * ZP; att_key(q, zr + kcol, zr + vcol, 0.f, mx, ls, acc); }
        if (m < TL) {
            const int t = m % S;
            if (isB) {
                const int j0 = t - 128 < 0 ? 0 : t - 128, j1 = t + 128 > S - 1 ? S - 1 : t + 128;
                for (int j = j0; j <= j1; ++j) { const bf16_t* zr = p.Z + (size_t)(b * S + j) * ZP; att_key(q, zr + kcol, zr + vcol, 0.f, mx, ls, acc); }
            } else {
                const int rows = S / GRID_W, r = t / GRID_W, c = t % GRID_W;
                int r0 = r - 4; r0 = r0 < 0 ? 0 : (r0 > rows - 8 ? rows - 8 : r0);
                int c0 = c - 8; c0 = c0 < 0 ? 0 : (c0 > GRID_W - 16 ? GRID_W - 16 : c0);
                for (int a = 0; a < 8; ++a)
                    for (int e = 0; e < 16; ++e) {
                        const int kr = r0 + a, kc = c0 + e;
                        const float bias = p.c_rpb[(((size_t)l * 6 + hq) * 15 + (kr - r + 7)) * 31 + (kc - c + 15)];
                        const bf16_t* zr = p.Z + (size_t)(b * S + kr * GRID_W + kc) * ZP;
                        att_key(q, zr + kcol, zr + vcol, bias, mx, ls, acc);
                    }
            }
        }
        const float inv = 1.0f / ls;
        bf16_t* o = p.MIX + (size_t)m * DMIX + (isB ? 256 : 640) + hq * 64;
#pragma unroll
        for (int d = 0; d < 64; ++d) o[d] = f2bf(acc[d] * inv);
    }
}

#endif
__device__ void ph_post_mixer(const Params& p, int l, int nrows, long gtid, long gsz) {
    for (long mm = gtid; mm < nrows; mm += gsz) {
        const int m = (int)mm;
        const float* xr = xrow_in(p, l, m); const float* md = modrow(p, l, m); const float* orow = (const float*)p.O + (size_t)m * D;
        float* x1 = (m < TL) ? p.out + (size_t)m * D : p.XC + (size_t)(m - TL) * D;
        const float* g1 = p.ln1_g + (size_t)l * D; const float* b1 = p.ln1_b + (size_t)l * D;
        float s = 0.f; for (int j = 0; j < D; ++j) s += ALPHA * xr[j] + md[2 * D + j] * orow[j];
        float mu = s / D, q = 0.f;
        for (int j = 0; j < D; ++j) { const float d = ALPHA * xr[j] + md[2 * D + j] * orow[j] - mu; q += d * d; }
        float rstd = 1.0f / sqrtf(q / D + LN_EPS);
        s = 0.f;
        for (int j = 0; j < D; ++j) { const float v = (ALPHA * xr[j] + md[2 * D + j] * orow[j] - mu) * rstd * g1[j] + b1[j]; x1[j] = v; s += v; }
        mu = s / D; q = 0.f;
        for (int j = 0; j < D; ++j) { const float d = x1[j] - mu; q += d * d; }
        rstd = 1.0f / sqrtf(q / D + LN_EPS);
        float gl[4], el[32];
#pragma unroll
        for (int g = 0; g < 4; ++g) gl[g] = p.b_rg[l * 4 + g];
#pragma unroll
        for (int e = 0; e < 32; ++e) el[e] = p.b_re[l * 32 + e];
        for (int j = 0; j < D; ++j) {
            const float hv = (x1[j] - mu) * rstd * (1.0f + md[4 * D + j]) + md[3 * D + j];
            p.H[(size_t)m * D + j] = f2bf(hv);
            const float* wg = p.w_rg + ((size_t)l * D + j) * 4; const float* we = p.w_re + ((size_t)l * D + j) * 32;
#pragma unroll
            for (int g = 0; g < 4; ++g) gl[g] += hv * wg[g];
#pragma unroll
            for (int e = 0; e < 32; ++e) el[e] += hv * we[e];
        }
        int gs = 0; float gm = gl[0];
#pragma unroll
        for (int g = 1; g < 4; ++g) if (gl[g] > gm) { gm = gl[g]; gs = g; }
        float den = 0.f;
#pragma unroll
        for (int g = 0; g < 4; ++g) den += expf(gl[g] - gm);
        const float pg = 1.0f / den;
        float v1 = -3e38f, v2 = -3e38f; int i1 = 0, i2 = 0;
#pragma unroll
        for (int j = 0; j < 8; ++j) {
            const float v = gs == 0 ? el[j] : gs == 1 ? el[8 + j] : gs == 2 ? el[16 + j] : el[24 + j];
            if (v > v1) { v2 = v1; i2 = i1; v1 = v; i1 = j; } else if (v > v2) { v2 = v; i2 = j; }
        }
        const float e2 = expf(v2 - v1), w1 = pg / (1.0f + e2), w2 = pg * e2 / (1.0f + e2);
        const int ea = gs * 8 + i1, eb = gs * 8 + i2;
        p.rE[2 * m] = ea; p.rE[2 * m + 1] = eb; p.rW[2 * m] = w1; p.rW[2 * m + 1] = w2;
        p.rPos[2 * m] = atomic_inc_int(p.cnt + l * NEXP + ea); p.rPos[2 * m + 1] = atomic_inc_int(p.cnt + l * NEXP + eb);
    }
}

__device__ __forceinline__ int pstart_of(const int* cnt, int e) {
    int s = 0;
    for (int j = 0; j < NEXP; ++j) if (j < e) s += (cnt[j] + 127) & ~127;
    return s;
}
__device__ __forceinline__ void ph_dispatch(const Params& p, int l, int nrows, long gtid, long gsz) {
    for (long i = gtid; i < (long)nrows * 2; i += gsz) {
        const int slot = pstart_of(p.cnt + l * NEXP, p.rE[i]) + p.rPos[i];
        p.rSlot[i] = slot; p.slotTok[slot] = (int)(i >> 1);
    }
}

__device__ void ph_final(const Params& p, int l, int nrows, long gtid, long gsz) {
    for (long mm = gtid; mm < nrows; mm += gsz) {
        const int m = (int)mm;
        float* x1 = (m < TL) ? p.out + (size_t)m * D : p.XC + (size_t)(m - TL) * D;
        const float* md = modrow(p, l, m);
        const float* ya = p.YS + (size_t)p.rSlot[2 * m] * D; const float* yb = p.YS + (size_t)p.rSlot[2 * m + 1] * D;
        const float wa = p.rW[2 * m], wb = p.rW[2 * m + 1];
        const float* g2 = p.ln2_g + (size_t)l * D; const float* b2 = p.ln2_b + (size_t)l * D;
        float s = 0.f; for (int j = 0; j < D; ++j) s += ALPHA * x1[j] + md[5 * D + j] * (wa * ya[j] + wb * yb[j]);
        const float mu = s / D; float q = 0.f;
        for (int j = 0; j < D; ++j) { const float d = ALPHA * x1[j] + md[5 * D + j] * (wa * ya[j] + wb * yb[j]) - mu; q += d * d; }
        const float rstd = 1.0f / sqrtf(q / D + LN_EPS);
        for (int j = 0; j < D; ++j) x1[j] = (ALPHA * x1[j] + md[5 * D + j] * (wa * ya[j] + wb * yb[j]) - mu) * rstd * g2[j] + b2[j];
    }
}

__device__ __forceinline__ int moe_blocks(const int* cnt) { int s = 0; for (int j = 0; j < NEXP; ++j) s += (cnt[j] + 127) >> 7; return s; }
__device__ __forceinline__ int moe_block_expert(const int* cnt, int rb) {
    int s = 0, e = 0;
    for (int j = 0; j < NEXP; ++j) { const int nb = (cnt[j] + 127) >> 7; if (rb >= s && rb < s + nb) e = j; s += nb; }
    return e;
}

#ifdef HOST_EMU
static void host_gemm_in(const Params& p) {
    for (int m = 0; m < T; ++m) for (int n = 0; n < ZP; ++n) { float a = 0.f; for (int k = 0; k < D; ++k) a += bf2f(p.H[(size_t)m * D + k]) * bf2f(p.win_t[(size_t)n * D + k]); p.Z[(size_t)m * ZP + n] = f2bf(a); }
}
static void host_gemm_out(const Params& p, int nrows) {
    for (int m = 0; m < nrows; ++m) for (int n = 0; n < D; ++n) { float a = 0.f; for (int k = 0; k < DMIX; ++k) a += bf2f(p.MIX[(size_t)m * DMIX + k]) * bf2f(p.wout_t[(size_t)n * DMIX + k]); ((float*)p.O)[(size_t)m * D + n] = a; }
}
static void host_moe1(const Params& p, int l) {
    const int* cnt = p.cnt + l * NEXP; const int nrb = moe_blocks(cnt);
    for (int rb = 0; rb < nrb; ++rb) { const int e = moe_block_expert(cnt, rb);
        for (int r = 0; r < 128; ++r) { const int slot = rb * 128 + r; const bf16_t* a = p.H + (size_t)p.slotTok[slot] * D;
            for (int c = 0; c < DE; ++c) { const int q = c >> 4, ii = c & 15; float g = 0.f, u = 0.f;
                const bf16_t* wg = p.wgu_t + ((size_t)e * 2 * DE + 32 * q + ii) * D; const bf16_t* wu = wg + (size_t)16 * D;
                for (int k = 0; k < D; ++k) { g += bf2f(a[k]) * bf2f(wg[k]); u += bf2f(a[k]) * bf2f(wu[k]); }
                p.ACT[(size_t)slot * DE + c] = f2bf(siluf_(g) * u); } } }
}
static void host_moe2(const Params& p, int l) {
    const int* cnt = p.cnt + l * NEXP; const int nrb = moe_blocks(cnt);
    for (int rb = 0; rb < nrb; ++rb) { const int e = moe_block_expert(cnt, rb);
        for (int r = 0; r < 128; ++r) { const int slot = rb * 128 + r;
            for (int n = 0; n < D; ++n) { float a = 0.f; const bf16_t* w = p.wd_t + ((size_t)e * D + n) * DE;
                for (int k = 0; k < DE; ++k) a += bf2f(p.ACT[(size_t)slot * DE + k]) * bf2f(w[k]);
                p.YS[(size_t)slot * D + n] = a; } } }
}
#else
typedef short bf16x8 __attribute__((ext_vector_type(8)));
typedef float f32x4 __attribute__((ext_vector_type(4)));
#define VGRID ((int)gridDim.x * 2)
__device__ __forceinline__ int opq_tid() { int t = threadIdx.x & 255; asm volatile("" : "+v"(t)); return t; }
__device__ __forceinline__ int opq_bid() { int b = 2 * blockIdx.x + __builtin_amdgcn_readfirstlane(threadIdx.x >> 8); asm volatile("" : "+s"(b)); return b; }
__device__ __forceinline__ unsigned pk2(float lo, float hi) { return (unsigned)f2bf(lo) | ((unsigned)f2bf(hi) << 16); }
struct u32x2_t { unsigned x, y; };
__device__ __forceinline__ void st_bf16x4(bf16_t* dst, f32x4 v) { u32x2_t o; o.x = pk2(v[0], v[1]); o.y = pk2(v[2], v[3]); *(u32x2_t*)dst = o; }
template <bool SWAP = true, class Epi>
__device__ __forceinline__ void gemm_tile(const bf16_t* a0, const bf16_t* a1, const bf16_t* b0, const bf16_t* b1, int K, char* lds, const Epi& epi) {
    const int tid = opq_tid(), wid = tid >> 6, lane = tid & 63, wr = wid >> 1, wc = wid & 1, fr = lane & 15, fq = lane >> 4;
    f32x4 acc[4][4];
#pragma unroll
    for (int m = 0; m < 4; ++m)
#pragma unroll
        for (int n = 0; n < 4; ++n) acc[m][n] = (f32x4){0.f, 0.f, 0.f, 0.f};
#define GT_STAGE(st_, kt_) do { char* sa_ = lds + (st_) * 16384 + tid * 16; \
        __builtin_amdgcn_global_load_lds((const unsigned*)(a0 + (kt_)), (__attribute__((address_space(3))) unsigned*)(sa_), 16, 0, 0); \
        __builtin_amdgcn_global_load_lds((const unsigned*)(a1 + (kt_)), (__attribute__((address_space(3))) unsigned*)(sa_ + 4096), 16, 0, 0); \
        __builtin_amdgcn_global_load_lds((const unsigned*)(b0 + (kt_)), (__attribute__((address_space(3))) unsigned*)(sa_ + 8192), 16, 0, 0); \
        __builtin_amdgcn_global_load_lds((const unsigned*)(b1 + (kt_)), (__attribute__((address_space(3))) unsigned*)(sa_ + 12288), 16, 0, 0); } while (0)
    const int fsw = (0 - (fr >> 2)) & 3;
    const int aoff = (wr * 64 + fr) * 64 + ((fq ^ fsw) * 16), boff = 8192 + (wc * 64 + fr) * 64 + ((fq ^ fsw) * 16);
    const int nk = K / 32;
    GT_STAGE(0, 0);
    if (nk > 1) GT_STAGE(1, 32);
    if (nk > 2) GT_STAGE(2, 64);
    for (int t = 0; t < nk; ++t) {
        if (t + 2 < nk) asm volatile("s_waitcnt vmcnt(8)" ::: "memory"); else if (t + 1 < nk) asm volatile("s_waitcnt vmcnt(4)" ::: "memory"); else asm volatile("s_waitcnt vmcnt(0)" ::: "memory");
        asm volatile("s_waitcnt lgkmcnt(0)" ::: "memory");
        __builtin_amdgcn_s_barrier();
        if (t + 3 < nk) GT_STAGE((t + 3) & 3, (t + 3) * 32);
        const char* sb = lds + (t & 3) * 16384;
        bf16x8 At[4], Bt[4];
#pragma unroll
        for (int m = 0; m < 4; ++m) At[m] = *(const bf16x8*)(sb + aoff + m * 1024);
#pragma unroll
        for (int n = 0; n < 4; ++n) Bt[n] = *(const bf16x8*)(sb + boff + n * 1024);
#pragma unroll
        for (int m = 0; m < 4; ++m)
#pragma unroll
            for (int n = 0; n < 4; ++n) acc[m][n] = SWAP ? __builtin_amdgcn_mfma_f32_16x16x32_bf16(Bt[n], At[m], acc[m][n], 0, 0, 0) : __builtin_amdgcn_mfma_f32_16x16x32_bf16(At[m], Bt[n], acc[m][n], 0, 0, 0);
    }
    asm volatile("s_waitcnt lgkmcnt(0)" ::: "memory");
    __builtin_amdgcn_s_barrier();
#undef GT_STAGE
    epi(acc, wr, wc, fr, fq);
}
#define STG_ROW(i) ((tid_ + (i) * 256) >> 2)
#define STG_K ((((tid_ & 3) ^ ((0 - (tid_ >> 4)) & 3))) * 8)

__device__ __forceinline__ f32x4 ld_bf16x4(const bf16_t* src) { const u32x2_t w = *(const u32x2_t*)src; return (f32x4){__uint_as_float(w.x << 16), __uint_as_float(w.x & 0xffff0000u), __uint_as_float(w.y << 16), __uint_as_float(w.y & 0xffff0000u)}; }
#define G8_LAS __attribute__((address_space(3)))
namespace g8 {
constexpr int BM = 256, BK = 64, HALF = 128, HTB = HALF * BK * 2;
__device__ __forceinline__ int lds_byte(int r, int c) { const int st = (r >> 4) * 2 + (c >> 5), rr = r & 15, cc = c & 31, ob = rr * 64 + cc * 2; return st * 1024 + (ob ^ (((ob >> 9) & 1) << 5)); }
__device__ __forceinline__ void stage_rc(int b, int& R, int& C) { const int st = b / 1024, sb = b % 1024, swz = sb ^ (((sb >> 9) & 1) << 5); R = (st >> 1) * 16 + swz / 64; C = (st & 1) * 32 + (swz % 64) / 2; }
struct Unit { const char* A; const char* B; int r0, c0, tag; };
__device__ __forceinline__ int xcd_pos(int wgid, int nwg) { const int q = nwg / 8, r = nwg % 8, xcd = wgid % 8, off = wgid / 8; return (xcd < r ? xcd * (q + 1) : r * (q + 1) + (xcd - r) * q) + off; }
__device__ __forceinline__ void order2d(int wgid, int nM, int nN, int& pm, int& pn) {
    wgid = xcd_pos(wgid, nM * nN);
    const int nig = 8 * nN, gid = wgid / nig, fm = gid * 8, gsz = (nM - fm) < 8 ? (nM - fm) : 8;
    pm = fm + ((wgid % nig) % gsz); pn = (wgid % nig) / gsz;
}
}
template <int K, bool GATHER, class Sched, class Epi>
__device__ __forceinline__ void gemm8(char* lds_raw, const Sched& S, const Epi& E, const int* gidx) {
    using namespace g8;
    G8_LAS unsigned char* lds = (G8_LAS unsigned char*)lds_raw;
    int tid = threadIdx.x; asm volatile("" : "+v"(tid));
    const int wid = __builtin_amdgcn_readfirstlane(tid >> 6), lane = tid & 63, wr = wid >> 2, wc = wid & 3, fr = lane & 15, fq = lane >> 4;
    constexpr int nt = K / BK;
    static_assert(K % 128 == 0 && K >= 256 && (K & (K - 1)) == 0, "K-tiles are consumed in pairs; the gather path masks with K * 2 - 1");
    static_assert(T + 1 <= 65536, "gathered row ids are packed in 16 bits");
    unsigned voffB[2];
#pragma unroll
    for (int i = 0; i < 2; ++i) { int R, C; stage_rc(tid * 16 + i * 8192, R, C); voffB[i] = (unsigned)(R * K + C) * 2u; }
    unsigned gpk[2] = {0u, 0u};
    constexpr size_t kstep = (size_t)(BK * 2), hstep = (size_t)HALF * K * 2;
    const unsigned ldsw = (unsigned)wid * 1024u;
    const int aoff = lds_byte(wr * 64 + fr, fq * 8), boff = lds_byte(wc * 32 + fr, fq * 8);
#define G8_SA(b, h) (((b) * 2 + (h)) * HTB)
#define G8_SB(b, h) ((4 + (b) * 2 + (h)) * HTB)
#define G8_STAGE_B(bufoff, gbase) do { _Pragma("unroll") for (int _i = 0; _i < 2; ++_i) \
        __builtin_amdgcn_global_load_lds((const unsigned*)((const char*)(gbase) + voffB[_i]), (G8_LAS unsigned*)(lds + (bufoff) + ldsw + _i * 8192), 16, 0, 0); } while (0)
#define G8_STAGE_A(bufoff, gbase, h, nx) do { _Pragma("unroll") for (int _i = 0; _i < 2; ++_i) { const unsigned _o = GATHER ? ((gpk[_i] >> (16 * (h))) & 0xffffu) * (unsigned)(K * 2) + (voffB[_i] & (unsigned)(K * 2 - 1)) : voffB[_i] + (unsigned)((h) * hstep); \
        __builtin_amdgcn_global_load_lds((const unsigned*)((const char*)(gbase) + _o), (G8_LAS unsigned*)(lds + (bufoff) + ldsw + _i * 8192), 16, 0, 0); } } while (0)
#define G8_LDA(dst, b, h) do { _Pragma("unroll") for (int m = 0; m < 4; ++m) _Pragma("unroll") for (int k = 0; k < 2; ++k) dst[m][k] = *(const G8_LAS bf16x8*)(lds + G8_SA(b, h) + aoff + m * 2048 + k * 1024); } while (0)
#define G8_LDB(dst, b, h) do { _Pragma("unroll") for (int n = 0; n < 2; ++n) _Pragma("unroll") for (int k = 0; k < 2; ++k) dst[n][k] = *(const G8_LAS bf16x8*)(lds + G8_SB(b, h) + boff + n * 2048 + k * 1024); } while (0)
#define G8_MMA(ai, bj, At, Bt) do { __builtin_amdgcn_s_setprio(1); _Pragma("unroll") for (int m = 0; m < 4; ++m) _Pragma("unroll") for (int n = 0; n < 2; ++n) _Pragma("unroll") for (int k = 0; k < 2; ++k) \
        acc[ai][bj][m][n] = __builtin_amdgcn_mfma_f32_16x16x32_bf16(Bt[n][k], At[m][k], acc[ai][bj][m][n], 0, 0, 0); __builtin_amdgcn_s_setprio(0); } while (0)
#define G8_WAIT_V(n) asm volatile("s_waitcnt vmcnt(" #n ")" ::: "memory")
#define G8_WAIT_L(n) asm volatile("s_waitcnt lgkmcnt(" #n ")" ::: "memory")
#define G8_BAR __builtin_amdgcn_s_barrier()
#define G8_SCHED __builtin_amdgcn_sched_barrier(0)
#define G8_GOFF(dst, u) do { int _t = tid; asm volatile("" : "+v"(_t)); _Pragma("unroll") for (int _i = 0; _i < 2; ++_i) { int _R, _C; stage_rc(_t * 16 + _i * 8192, _R, _C); \
        dst[_i] = (unsigned)gidx[(u).r0 + _R] | ((unsigned)gidx[(u).r0 + HALF + _R] << 16); } } while (0)
    Unit cur, nxt; int ui = 0;
    if (!S.next(0, cur)) return;
    f32x4 acc[2][2][4][2];
#pragma unroll
    for (int a = 0; a < 2; ++a)
#pragma unroll
        for (int b = 0; b < 2; ++b)
#pragma unroll
            for (int m = 0; m < 4; ++m)
#pragma unroll
                for (int n = 0; n < 2; ++n) acc[a][b][m][n] = (f32x4){0.f, 0.f, 0.f, 0.f};
    bf16x8 At[4][2], B0[2][2], B1[2][2];
    const char* cA = cur.A; const char* cB = cur.B;
    if (GATHER) G8_GOFF(gpk, cur);
    G8_STAGE_B(G8_SB(0, 0), cB); G8_STAGE_A(G8_SA(0, 0), cA, 0, false); G8_STAGE_B(G8_SB(0, 1), cB + hstep); G8_STAGE_A(G8_SA(0, 1), cA, 1, false);
    if (wr == 1) G8_BAR;
    G8_WAIT_V(4); G8_BAR;
    G8_STAGE_B(G8_SB(1, 0), cB + kstep); G8_STAGE_A(G8_SA(1, 0), cA + kstep, 0, false); G8_STAGE_B(G8_SB(1, 1), cB + hstep + kstep);
    G8_WAIT_V(6); G8_BAR;
    for (;;) {
        const bool has_next = S.next(ui + 1, nxt);
        const char* nA = has_next ? nxt.A : cA; const char* nB = has_next ? nxt.B : cB;
#pragma unroll 1
        for (int t = 0; t < nt; t += 2) {
            const bool last = (t == nt - 2);
            const char* a1 = cA + (size_t)(t + 1) * kstep;
            const char* a2 = last ? nA : cA + (size_t)(t + 2) * kstep; const char* b2 = last ? nB : cB + (size_t)(t + 2) * kstep;
            const char* a3 = a2 + kstep; const char* b3 = b2 + kstep;
            G8_LDB(B0, 0, 0); G8_SCHED; G8_LDA(At, 0, 0); G8_STAGE_A(G8_SA(1, 1), a1, 1, false);
            G8_WAIT_L(8); G8_BAR; G8_WAIT_L(0); G8_MMA(0, 0, At, B0); G8_BAR; G8_SCHED;
            if (GATHER && last && has_next) G8_GOFF(gpk, nxt);
            G8_LDB(B1, 0, 1); G8_STAGE_B(G8_SB(0, 0), b2);
            G8_BAR; G8_WAIT_L(0); G8_MMA(0, 1, At, B1); G8_BAR;
            G8_LDA(At, 0, 1); G8_STAGE_A(G8_SA(0, 0), a2, 0, last);
            G8_BAR; G8_WAIT_L(0); G8_MMA(1, 0, At, B0); G8_BAR; G8_SCHED;
            G8_STAGE_B(G8_SB(0, 1), b2 + hstep);
            G8_WAIT_V(6); G8_BAR; G8_MMA(1, 1, At, B1); G8_BAR;
            G8_LDB(B0, 1, 0); G8_SCHED; G8_LDA(At, 1, 0); G8_STAGE_A(G8_SA(0, 1), a2, 1, last);
            G8_WAIT_L(8); G8_BAR; G8_WAIT_L(0); G8_MMA(0, 0, At, B0); G8_BAR; G8_SCHED;
            G8_LDB(B1, 1, 1); G8_STAGE_B(G8_SB(1, 0), b3);
            G8_BAR; G8_WAIT_L(0); G8_MMA(0, 1, At, B1); G8_BAR;
            G8_LDA(At, 1, 1); G8_STAGE_A(G8_SA(1, 0), a3, 0, last);
            G8_BAR; G8_WAIT_L(0); G8_MMA(1, 0, At, B0); G8_BAR; G8_SCHED;
            G8_STAGE_B(G8_SB(1, 1), b3 + hstep);
            G8_WAIT_V(6); G8_BAR; G8_MMA(1, 1, At, B1); G8_BAR;
        }
        { int efr = fr, efq = fq; asm volatile("" : "+v"(efr), "+v"(efq));
          E(acc, cur, wr, wc, efr, efq); }
        if (!has_next) break;
#pragma unroll
        for (int a = 0; a < 2; ++a)
#pragma unroll
            for (int b = 0; b < 2; ++b)
#pragma unroll
                for (int m = 0; m < 4; ++m)
#pragma unroll
                    for (int n = 0; n < 2; ++n) acc[a][b][m][n] = (f32x4){0.f, 0.f, 0.f, 0.f};
        cur = nxt; cA = nA; cB = nB; ++ui;
    }
    G8_WAIT_V(0);
    if (wr == 0) G8_BAR;
    G8_BAR;
#undef G8_SA
#undef G8_SB
#undef G8_STAGE_A
#undef G8_STAGE_B
#undef G8_LDA
#undef G8_LDB
#undef G8_MMA
#undef G8_WAIT_V
#undef G8_WAIT_L
#undef G8_BAR
#undef G8_SCHED
#undef G8_GOFF
}
__device__ __forceinline__ int real_bid() { int b = blockIdx.x; asm volatile("" : "+s"(b)); return b; }

__device__ __forceinline__ void g_gemm_in(const Params& p, char* lds_all) {
    constexpr int NM = T / 256, NN = NINP / 256, NMAIN = WVB / 256;
    struct Sched { const Params* p; int G, c;
        __device__ __forceinline__ bool next(int i, g8::Unit& u) const {
            const int Lx = i * G + c; if (Lx >= NM * NN) return false;
            int pm, pn; g8::order2d(Lx, NM, NN, pm, pn);
            if (pn < NMAIN) { u.A = (const char*)(p->H + (size_t)pm * 256 * D); u.B = (const char*)(p->win_t + (size_t)pn * 256 * D); u.r0 = pm * 256; u.c0 = pn * 256; u.tag = 0; }
            else { u.A = (const char*)(p->win_t + (size_t)pn * 256 * D); u.B = (const char*)(p->H + (size_t)pm * 256 * D); u.r0 = (pn - NMAIN) * 256; u.c0 = pm * 256; u.tag = 1; }
            return true; } };
    const Sched sch{&p, (int)gridDim.x, real_bid()};
    gemm8<D, false>(lds_all, sch, [&](const f32x4 (&acc)[2][2][4][2], const g8::Unit& u, int wr, int wc, int fr, int fq) {
        if (u.tag == 1) {
#pragma unroll
            for (int ai = 0; ai < 2; ++ai)
#pragma unroll
                for (int m = 0; m < 4; ++m) { const int vc = u.r0 + ai * 128 + wr * 64 + m * 16 + fr;
#pragma unroll
                    for (int bj = 0; bj < 2; ++bj)
#pragma unroll
                        for (int n = 0; n < 2; ++n) { const int m0 = u.c0 + bj * 128 + wc * 32 + n * 16 + 4 * fq; int b, tk;
                            if (m0 < TL) { b = m0 / S; tk = L + m0 % S; } else { b = (m0 - TL) / L; tk = (m0 - TL) % L; }
                            st_bf16x4(p.VT + ((size_t)(b * 8 + (vc >> 6)) * 64 + (vc & 63)) * PU + tk, acc[ai][bj][m][n]); } }
        } else if (u.c0 < ZQN && u.r0 < TL) {
#pragma unroll
            for (int ai = 0; ai < 2; ++ai)
#pragma unroll
                for (int m = 0; m < 4; ++m) { const int row = u.r0 + ai * 128 + wr * 64 + m * 16 + fr, t = row % S;
#pragma unroll
                    for (int bj = 0; bj < 2; ++bj) { const int c32 = u.c0 + bj * 128 + wc * 32, ax = (c32 >> 5) & 1, pos = ax ? t % GRID_W : t / GRID_W;
                        const f32x4 cs = *(const f32x4*)(p.rope + pos * 16 + 4 * fq), sn = *(const f32x4*)(p.rope + 1024 + pos * 16 + 4 * fq);
                        const f32x4 x0 = acc[ai][bj][m][0], x1 = acc[ai][bj][m][1];
                        bf16_t* zr = p.Z + (size_t)row * ZP + c32 + 4 * fq;
                        st_bf16x4(zr, x0 * cs - x1 * sn); st_bf16x4(zr + 16, x1 * cs + x0 * sn); }
                    asm volatile("" ::: "memory"); }
        } else {
#pragma unroll
            for (int ai = 0; ai < 2; ++ai)
#pragma unroll
                for (int m = 0; m < 4; ++m) { bf16_t* zr = p.Z + (size_t)(u.r0 + ai * 128 + wr * 64 + m * 16 + fr) * ZP;
#pragma unroll
                    for (int bj = 0; bj < 2; ++bj)
#pragma unroll
                        for (int n = 0; n < 2; ++n) { const int col = u.c0 + bj * 128 + wc * 32 + n * 16 + 4 * fq; if (col < ZP) st_bf16x4(zr + col, acc[ai][bj][m][n]); } }
        }
    }, nullptr);
}
__device__ __forceinline__ void g_gemm_out(const Params& p, int nrows, char* lds_all) {
    struct Sched { const Params* p; int G, c, nM;
        __device__ __forceinline__ bool next(int i, g8::Unit& u) const {
            const int Lx = i * G + c; if (Lx >= nM * (D / 256)) return false;
            int pm, pn; g8::order2d(Lx, nM, D / 256, pm, pn);
            u.A = (const char*)(p->MIX + (size_t)pm * 256 * DMIX); u.B = (const char*)(p->wout_t + (size_t)pn * 256 * DMIX); u.r0 = pm * 256; u.c0 = pn * 256; u.tag = 0; return true; } };
    const Sched sch{&p, (int)gridDim.x, real_bid(), nrows / 256};
    gemm8<DMIX, false>(lds_all, sch, [&](const f32x4 (&acc)[2][2][4][2], const g8::Unit& u, int wr, int wc, int fr, int fq) {
#pragma unroll
        for (int ai = 0; ai < 2; ++ai)
#pragma unroll
            for (int m = 0; m < 4; ++m) { bf16_t* orow = p.O + (size_t)(u.r0 + ai * 128 + wr * 64 + m * 16 + fr) * D + u.c0 + wc * 32 + 4 * fq;
#pragma unroll
                for (int bj = 0; bj < 2; ++bj)
#pragma unroll
                    for (int n = 0; n < 2; ++n) st_bf16x4(orow + bj * 128 + n * 16, acc[ai][bj][m][n]); }
    }, nullptr);
}
struct SchedMoe { const int* te; int G, c; const char* A; size_t a_tile; const char* W; size_t w_exp, w_pan;
    __device__ __forceinline__ bool next(int i, g8::Unit& u) const {
        const int nU = __builtin_amdgcn_readfirstlane(te[255]) * 4, Lx = i * G + c; if (Lx >= nU) return false;
        const int w = g8::xcd_pos(Lx, nU), rt = w >> 2, pn = w & 3, e = __builtin_amdgcn_readfirstlane(te[rt]);
        u.A = A + (size_t)rt * a_tile; u.B = W + (size_t)e * w_exp + (size_t)pn * w_pan; u.r0 = rt * 256; u.c0 = pn * 256; u.tag = e; return true; } };
__device__ __forceinline__ int* moe_tile_table(const Params& p, int l, char* lds_all) {
    static_assert(2 * T / 256 + NEXP <= 255, "row-tile table");
    int* te = (int*)(lds_all + 131072);
    if (threadIdx.x < 256) { const int rt = threadIdx.x; int s = 0, e = 0;
        for (int j = 0; j < NEXP; ++j) { s += (p.cnt[l * NEXP + j] + 255) >> 8; e += (s <= rt) ? 1 : 0; }
        te[rt] = rt == 255 ? s : (e < NEXP ? e : NEXP - 1); }
    __syncthreads();
    return te;
}
__device__ __forceinline__ void g_moe1(const Params& p, int l, char* lds_all) {
    const int* te = moe_tile_table(p, l, lds_all);
    const SchedMoe sch{te, (int)gridDim.x, real_bid(), (const char*)p.H, 0, (const char*)p.wgu_t, (size_t)2 * DE * D * 2, (size_t)256 * D * 2};
    gemm8<D, true>(lds_all, sch, [&](const f32x4 (&acc)[2][2][4][2], const g8::Unit& u, int wr, int wc, int fr, int fq) {
#pragma unroll
        for (int ai = 0; ai < 2; ++ai)
#pragma unroll
            for (int m = 0; m < 4; ++m) { bf16_t* arow = p.ACT + (size_t)(u.r0 + ai * 128 + wr * 64 + m * 16 + fr) * DE + (u.c0 + wc * 32) / 2 + 4 * fq;
#pragma unroll
                for (int bj = 0; bj < 2; ++bj) {
                    const f32x4 g = acc[ai][bj][m][0], up = acc[ai][bj][m][1]; f32x4 a;
#pragma unroll
                    for (int e4 = 0; e4 < 4; ++e4) a[e4] = g[e4] / (1.0f + __expf(-g[e4])) * up[e4];
                    st_bf16x4(arow + bj * 64, a); } }
    }, p.slotTok);
}
__device__ __forceinline__ void g_moe2(const Params& p, int l, char* lds_all) {
    const int* te = moe_tile_table(p, l, lds_all);
    const SchedMoe sch{te, (int)gridDim.x, real_bid(), (const char*)p.ACT, (size_t)256 * DE * 2, (const char*)p.wd_t, (size_t)D * DE * 2, (size_t)256 * DE * 2};
    gemm8<DE, false>(lds_all, sch, [&](const f32x4 (&acc)[2][2][4][2], const g8::Unit& u, int wr, int wc, int fr, int fq) {
#pragma unroll
        for (int ai = 0; ai < 2; ++ai)
#pragma unroll
            for (int m = 0; m < 4; ++m) { bf16_t* yrow = p.YSb + (size_t)(u.r0 + ai * 128 + wr * 64 + m * 16 + fr) * D + u.c0 + wc * 32 + 4 * fq;
#pragma unroll
                for (int bj = 0; bj < 2; ++bj)
#pragma unroll
                    for (int n = 0; n < 2; ++n) st_bf16x4(yrow + bj * 128 + n * 16, acc[ai][bj][m][n]); }
    }, nullptr);
}


constexpr int DV = D / 256;
static_assert(D % 256 == 0, "row phases hold a row as DV float4 per lane");
template <int CTRL> __device__ __forceinline__ float dppf(float v) { return __builtin_bit_cast(float, __builtin_amdgcn_update_dpp(0, __builtin_bit_cast(int, v), CTRL, 0xf, 0xf, true)); }
__device__ __forceinline__ float wave_sum(float v) {
    v += dppf<0xB1>(v); v += dppf<0x4E>(v); v += dppf<0x141>(v); v += dppf<0x140>(v);
    float a = v, b = v;
    asm volatile("s_nop 1\n\tv_permlane16_swap_b32 %0, %1" : "+v"(a), "+v"(b));
    v = a + b; a = v; b = v;
    asm volatile("s_nop 1\n\tv_permlane32_swap_b32 %0, %1" : "+v"(a), "+v"(b));
    return a + b;
}
__device__ __forceinline__ float sum8(float v) { v += dppf<0xB1>(v); v += dppf<0x4E>(v); v += dppf<0x141>(v); return v; }
__device__ __forceinline__ float sum4(f32x4 a) { return (a[0] + a[1]) + (a[2] + a[3]); }
#define LDS_WAIT() asm volatile("s_waitcnt lgkmcnt(0)" ::: "memory")

__device__ __forceinline__ void row_stats(const f32x4 (&v)[DV], float& mu, float& rstd) {
    float s = 0.f;
#pragma unroll
    for (int j = 0; j < DV; ++j) s += sum4(v[j]);
    mu = wave_sum(s) * (1.0f / D);
    float q = 0.f;
#pragma unroll
    for (int j = 0; j < DV; ++j) { const f32x4 d = v[j] - mu; q += sum4(d * d); }
    rstd = 1.0f / sqrtf(wave_sum(q) * (1.0f / D) + LN_EPS);
}

__device__ __forceinline__ void ph_lnmod_fast(const Params& p, int l) {
    const int tid_ = opq_tid(), bid_ = opq_bid(); (void)tid_; (void)bid_;
    const int lane = tid_ & 63, gw = bid_ * 4 + (tid_ >> 6), nw = VGRID * 4;
    constexpr int R = 4;
    for (int m0 = gw * R; m0 < T; m0 += nw * R) {
        f32x4 v[R][DV];
#pragma unroll
        for (int r = 0; r < R; ++r) { const f32x4* xr = (const f32x4*)xrow_in(p, l, m0 + r < T ? m0 + r : m0) + lane;
#pragma unroll
            for (int j = 0; j < DV; ++j) v[r][j] = xr[64 * j]; }
        float mu[R], rstd[R];
#pragma unroll
        for (int r = 0; r < R; ++r) row_stats(v[r], mu[r], rstd[r]);
#pragma unroll
        for (int r = 0; r < R; ++r) if (m0 + r < T) { const f32x4* md = (const f32x4*)modrow(p, l, m0 + r) + lane;
#pragma unroll
            for (int j = 0; j < DV; ++j) st_bf16x4(p.H + (size_t)(m0 + r) * D + 4 * (lane + 64 * j), (v[r][j] - mu[r]) * rstd[r] * (md[D / 4 + 64 * j] + 1.0f) + md[64 * j]); }
    }
}

template <int R>
__device__ __forceinline__ void pm_rows(const Params& p, int l, int m0, int lane) {
    const f32x4* g1 = (const f32x4*)(p.ln1_g + (size_t)l * D) + lane; const f32x4* b1 = (const f32x4*)(p.ln1_b + (size_t)l * D) + lane;
    f32x4 v[R][DV]; float mu[R], rstd[R];
#pragma unroll
    for (int r = 0; r < R; ++r) { const int m = m0 + r; const f32x4* xr = (const f32x4*)xrow_in(p, l, m) + lane; const f32x4* md = (const f32x4*)modrow(p, l, m) + lane;
        const bf16_t* orow = p.O + (size_t)m * D + 4 * lane;
#pragma unroll
        for (int j = 0; j < DV; ++j) v[r][j] = xr[64 * j] * ALPHA + md[2 * (D / 4) + 64 * j] * ld_bf16x4(orow + 256 * j); }
#pragma unroll
    for (int r = 0; r < R; ++r) row_stats(v[r], mu[r], rstd[r]);
#pragma unroll
    for (int r = 0; r < R; ++r) { const int m = m0 + r; f32x4* x1 = (f32x4*)((m < TL) ? p.out + (size_t)m * D : p.XC + (size_t)(m - TL) * D) + lane;
#pragma unroll
        for (int j = 0; j < DV; ++j) { v[r][j] = (v[r][j] - mu[r]) * rstd[r] * g1[64 * j] + b1[64 * j]; x1[64 * j] = v[r][j]; } }
#pragma unroll
    for (int r = 0; r < R; ++r) row_stats(v[r], mu[r], rstd[r]);
#pragma unroll
    for (int r = 0; r < R; ++r) { const int m = m0 + r; const f32x4* md = (const f32x4*)modrow(p, l, m) + lane;
#pragma unroll
        for (int j = 0; j < DV; ++j) {
            const f32x4 hv = (v[r][j] - mu[r]) * rstd[r] * (md[4 * (D / 4) + 64 * j] + 1.0f) + md[3 * (D / 4) + 64 * j];
            f32x4 hh, lo;
#pragma unroll
            for (int e = 0; e < 4; ++e) { hh[e] = bf2f(f2bf(hv[e])); lo[e] = hv[e] - hh[e]; }
            st_bf16x4(p.H + (size_t)m * D + 4 * (lane + 64 * j), hh);
            st_bf16x4(p.HLO + (size_t)m * D + 4 * (lane + 64 * j), lo);
        } }
}

__device__ __forceinline__ int router_rpg(int nrows) { const int g = VGRID; return (nrows % g == 0 && nrows / g <= 48 && (nrows / g) % 4 == 0) ? nrows / g : 32; }
__device__ __forceinline__ void g_router(const Params& p, int l, int nrows, char* lds) {
    const int tid_ = opq_tid(), bid_ = opq_bid(); (void)tid_; (void)bid_;
    const int lane = tid_ & 63, wid = tid_ >> 6, fr = lane & 15, fq = lane >> 4;
    const int RPG = router_rpg(nrows), RW = RPG / 4;
    float* part = (float*)lds;
    float* lgt = part + 4 * 9 * 64 * 4;
    int* eids = (int*)(lgt + 48 * 48);
    for (int rg = bid_; rg < nrows / RPG; rg += VGRID) {
#pragma unroll 1
        for (int i = 0; i + 1 < RW; i += 2) pm_rows<2>(p, l, rg * RPG + wid * RW + i, lane);
        if (RW & 1) pm_rows<1>(p, l, rg * RPG + wid * RW + RW - 1, lane);
        asm volatile("s_waitcnt vmcnt(0)" ::: "memory");
        __syncthreads();
        f32x4 acc[3][3];
#pragma unroll
        for (int a = 0; a < 3; ++a)
#pragma unroll
            for (int b = 0; b < 3; ++b) acc[a][b] = (f32x4){0.f, 0.f, 0.f, 0.f};
        int arow[3];
#pragma unroll
        for (int a = 0; a < 3; ++a) { const int rr = a * 16 + fr; arow[a] = rg * RPG + (rr < RPG ? rr : RPG - 1); }
#pragma unroll
        for (int seg = 0; seg < 3; ++seg) {
            const bf16_t* ab = (seg < 2 ? p.H : p.HLO) + wid * (D / 4) + fq * 8;
            const bf16_t* bp = p.wrt + (seg == 1 ? (size_t)128 * D : 0) + (size_t)fr * D + wid * (D / 4) + fq * 8;
#pragma unroll 1
            for (int ks0 = 0; ks0 < D / 128; ks0 += 2) {
                bf16x8 av[2][3], bv[2][3];
#pragma unroll
                for (int u = 0; u < 2; ++u) { const int ko = (ks0 + u) * 32;
#pragma unroll
                    for (int a = 0; a < 3; ++a) { av[u][a] = *(const bf16x8*)(ab + (size_t)arow[a] * D + ko); bv[u][a] = *(const bf16x8*)(bp + (size_t)(16 * a) * D + ko); } }
                asm volatile("" ::: "memory");
#pragma unroll
                for (int u = 0; u < 2; ++u)
#pragma unroll
                    for (int a = 0; a < 3; ++a)
#pragma unroll
                        for (int b = 0; b < 3; ++b) acc[a][b] = __builtin_amdgcn_mfma_f32_16x16x32_bf16(av[u][a], bv[u][b], acc[a][b], 0, 0, 0);
            }
        }
#pragma unroll
        for (int a = 0; a < 3; ++a)
#pragma unroll
            for (int b = 0; b < 3; ++b) *(f32x4*)(part + ((wid * 9 + a * 3 + b) * 64 + lane) * 4) = acc[a][b];
        __syncthreads();
#pragma unroll
        for (int i = 0; i < 9; ++i) { const int e = tid_ + 256 * i, f = e >> 8, ln = (e & 255) >> 2, j = e & 3;
            const float sm = (part[((0 * 9 + f) * 64 + ln) * 4 + j] + part[((1 * 9 + f) * 64 + ln) * 4 + j]) + (part[((2 * 9 + f) * 64 + ln) * 4 + j] + part[((3 * 9 + f) * 64 + ln) * 4 + j]);
            lgt[((f / 3) * 16 + (ln >> 4) * 4 + j) * 48 + (f % 3) * 16 + (ln & 15)] = sm; }
        __syncthreads();
        if (tid_ < RPG) {
            const int m = rg * RPG + tid_; const float* lg = lgt + tid_ * 48;
            float gl[4], el[32];
#pragma unroll
            for (int g = 0; g < 4; ++g) gl[g] = lg[g] + p.b_rg[l * 4 + g];
#pragma unroll
            for (int e = 0; e < 32; ++e) el[e] = lg[4 + e] + p.b_re[l * 32 + e];
            int gs = 0; float gm = gl[0];
#pragma unroll
            for (int g = 1; g < 4; ++g) if (gl[g] > gm) { gm = gl[g]; gs = g; }
            float den = 0.f;
#pragma unroll
            for (int g = 0; g < 4; ++g) den += expf(gl[g] - gm);
            const float pg = 1.0f / den;
            float v1 = -3e38f, v2 = -3e38f; int i1 = 0, i2 = 0;
#pragma unroll
            for (int j = 0; j < 8; ++j) {
                const float vv = gs == 0 ? el[j] : gs == 1 ? el[8 + j] : gs == 2 ? el[16 + j] : el[24 + j];
                if (vv > v1) { v2 = v1; i2 = i1; v1 = vv; i1 = j; } else if (vv > v2) { v2 = vv; i2 = j; }
            }
            const float e2 = expf(v2 - v1), w1 = pg / (1.0f + e2), w2 = pg * e2 / (1.0f + e2);
            const int ea = gs * 8 + i1, eb = gs * 8 + i2;
            p.rE[2 * m] = ea; p.rE[2 * m + 1] = eb; p.rW[2 * m] = w1; p.rW[2 * m + 1] = w2;
            eids[2 * tid_] = ea; eids[2 * tid_ + 1] = eb;
        }
        __syncthreads();
        if (tid_ < 2 * RPG) { const int e = eids[tid_]; int rk = 0; for (int j = 0; j < tid_; ++j) rk += (eids[j] == e) ? 1 : 0; p.rPos[2 * (rg * RPG) + tid_] = rk; }
        else if (tid_ >= 128 && tid_ < 160) { const int e = tid_ - 128; int c = 0; for (int j = 0; j < 2 * RPG; ++j) c += (eids[j] == e) ? 1 : 0; p.hist[rg * 32 + e] = c; }
        __syncthreads();
    }
}

__device__ __forceinline__ void ph_dispatch_fast(const Params& p, int l, int nrows, char* lds) {
    const int tid_ = opq_tid(), bid_ = opq_bid(); (void)tid_; (void)bid_;
    const int RPG = router_rpg(nrows), nrg = nrows / RPG, e = tid_ & 31, part = tid_ >> 5;
    int* tot = (int*)lds; int* pst = tot + 32; int* pre = pst + 32; int* red = pre + 32;
    { int s = 0; for (int b = part; b < nrg; b += 8) s += p.hist[b * 32 + e]; red[part * 32 + e] = s; }
    __syncthreads();
    if (tid_ < 32) { int s = 0; for (int q = 0; q < 8; ++q) s += red[q * 32 + tid_]; tot[tid_] = s; }
    __syncthreads();
    if (tid_ < 32) { int s = 0; for (int j = 0; j < tid_; ++j) s += (tot[j] + MPAD - 1) & ~(MPAD - 1); pst[tid_] = s; if (bid_ == 0) p.cnt[l * NEXP + tid_] = tot[tid_]; }
    for (int rg = bid_; rg < nrg; rg += VGRID) {
        __syncthreads();
        { int s = 0; for (int b = part; b < rg; b += 8) s += p.hist[b * 32 + e]; red[part * 32 + e] = s; }
        __syncthreads();
        if (tid_ < 32) { int s = 0; for (int q = 0; q < 8; ++q) s += red[q * 32 + tid_]; pre[tid_] = s; }
        __syncthreads();
        if (tid_ < 2 * RPG) { const int i = 2 * (rg * RPG) + tid_, ee = p.rE[i], slot = pst[ee] + pre[ee] + p.rPos[i]; p.rSlot[i] = slot; p.slotTok[slot] = i >> 1; }
    }
}

__device__ __forceinline__ void ph_final_fast(const Params& p, int l, int nrows, bool next_h) {
    const int tid_ = opq_tid(), bid_ = opq_bid(); (void)tid_; (void)bid_;
    const int lane = tid_ & 63, gw = bid_ * 4 + (tid_ >> 6), nw = VGRID * 4;
    constexpr int R = 4;
    const f32x4* g2 = (const f32x4*)(p.ln2_g + (size_t)l * D) + lane; const f32x4* b2 = (const f32x4*)(p.ln2_b + (size_t)l * D) + lane;
    for (int m0 = gw * R; m0 < nrows; m0 += nw * R) {
        f32x4 v[R][DV]; float mu[R], rstd[R];
#pragma unroll
        for (int r = 0; r < R; ++r) { const int m = m0 + r; const f32x4* x1 = (const f32x4*)((m < TL) ? p.out + (size_t)m * D : p.XC + (size_t)(m - TL) * D) + lane;
            const f32x4* md = (const f32x4*)modrow(p, l, m) + lane;
            const bf16_t* ya = p.YSb + (size_t)p.rSlot[2 * m] * D + 4 * lane; const bf16_t* yb = p.YSb + (size_t)p.rSlot[2 * m + 1] * D + 4 * lane;
            const float wa = p.rW[2 * m], wb = p.rW[2 * m + 1];
#pragma unroll
            for (int j = 0; j < DV; ++j) v[r][j] = x1[64 * j] * ALPHA + md[5 * (D / 4) + 64 * j] * (ld_bf16x4(ya + 256 * j) * wa + ld_bf16x4(yb + 256 * j) * wb); }
#pragma unroll
        for (int r = 0; r < R; ++r) row_stats(v[r], mu[r], rstd[r]);
#pragma unroll
        for (int r = 0; r < R; ++r) { const int m = m0 + r; f32x4* x1 = (f32x4*)((m < TL) ? p.out + (size_t)m * D : p.XC + (size_t)(m - TL) * D) + lane;
#pragma unroll
            for (int j = 0; j < DV; ++j) { v[r][j] = (v[r][j] - mu[r]) * rstd[r] * g2[64 * j] + b2[64 * j]; x1[64 * j] = v[r][j]; } }
        if (next_h) {
#pragma unroll
            for (int r = 0; r < R; ++r) row_stats(v[r], mu[r], rstd[r]);
#pragma unroll
            for (int r = 0; r < R; ++r) { const int m = m0 + r; const f32x4* mn = (const f32x4*)modrow(p, l + 1, m) + lane;
#pragma unroll
                for (int j = 0; j < DV; ++j) st_bf16x4(p.H + (size_t)m * D + 4 * (lane + 64 * j), (v[r][j] - mu[r]) * rstd[r] * (mn[D / 4 + 64 * j] + 1.0f) + mn[64 * j]); }
        }
    }
}

__device__ __forceinline__ void ph_mod_fast(const Params& p, char* lds) {
    const int tid_ = opq_tid(), bid_ = opq_bid(); (void)tid_; (void)bid_;
    constexpr int NR = NB + 1, NTASK = 2 * (6 * D / 64);
    if (bid_ >= NTASK) return;
    float* sc = (float*)lds;
    float* part = sc + NR * D;
    for (int i = tid_; i < NR * D; i += 256) { const int b = i / D, k = i % D; const float cv = b < NB ? p.c[(size_t)b * D + k] : p.c_ctx[k]; sc[i] = cv / (1.0f + __expf(-cv)); }
    __syncthreads();
    const int lane = tid_ & 63, wid = tid_ >> 6;
    for (int task = bid_; task < NTASK; task += VGRID) {
        const int ll = task / (6 * D / 64), col = 64 * (task % (6 * D / 64)) + lane;
        float acc[NR];
#pragma unroll
        for (int b = 0; b < NR; ++b) acc[b] = 0.f;
        const float* wp = p.w_mod + ((size_t)ll * D + wid * (D / 4)) * 6 * D + col;
#pragma unroll 16
        for (int k = 0; k < D / 4; ++k) { const float w = wp[(size_t)k * 6 * D];
#pragma unroll
            for (int b = 0; b < NR; ++b) acc[b] += sc[b * D + wid * (D / 4) + k] * w; }
#pragma unroll
        for (int b = 0; b < NR; ++b) part[(wid * NR + b) * 64 + lane] = acc[b];
        __syncthreads();
        for (int i = tid_; i < NR * 64; i += 256) { const int b = i / 64, cl = i % 64;
            p.mod[((size_t)ll * NR + b) * 6 * D + 64 * (task % (6 * D / 64)) + cl] = (part[(0 * NR + b) * 64 + cl] + part[(1 * NR + b) * 64 + cl]) + (part[(2 * NR + b) * 64 + cl] + part[(3 * NR + b) * 64 + cl]) + p.b_mod[(size_t)ll * 6 * D + 64 * (task % (6 * D / 64)) + cl]; }
        __syncthreads();
    }
}

template <bool SPLIT = false>
__device__ __forceinline__ void tr_item(const float* srcl, size_t ldw, bf16_t* dst, size_t ldd, float* scr, int lane, float scale = 1.0f) {
    float v[32];
#pragma unroll
    for (int i = 0; i < 32; ++i) v[i] = srcl ? srcl[(size_t)(2 * i + (lane >> 5)) * ldw] * scale : 0.f;
#pragma unroll
    for (int i = 0; i < 32; ++i) scr[(2 * i + (lane >> 5)) * 33 + (lane & 31)] = v[i];
    LDS_WAIT();
    const int c = lane & 7;
#pragma unroll
    for (int j = 0; j < 4; ++j) { const int n = (lane >> 3) + 8 * j; const float* s = scr + (8 * c) * 33 + n;
        uint4 o; o.x = pk2(s[0], s[33]); o.y = pk2(s[2 * 33], s[3 * 33]); o.z = pk2(s[4 * 33], s[5 * 33]); o.w = pk2(s[6 * 33], s[7 * 33]);
        *(uint4*)(dst + (size_t)(SPLIT ? (n & 15) + 32 * (n >> 4) : n) * ldd + 8 * c) = o; }
    LDS_WAIT();
}
__device__ __forceinline__ void ph_prep_w_fast(const Params& p, int l, int part, char* lds, int vb0 = 0) {
    const int tid_ = opq_tid(), bid_ = opq_bid(); (void)tid_; (void)bid_;
    if (bid_ < vb0) return;
    const int lane = tid_ & 63, wid = tid_ >> 6, gw = (bid_ - vb0) * 4 + wid, nw = (VGRID - vb0) * 4;
    float* scr = (float*)(lds + wid * 8448);
    constexpr int I_IN = (D / 64) * (NINP / 32), I_OUT = (DMIX / 64) * (D / 32), I_GU1 = (D / 64) * (2 * DE / 32), I_D1 = (DE / 64) * (D / 32);
    constexpr int NITEMS = I_IN + I_OUT + NEXP * (I_GU1 + I_D1);
    const int it0 = part == 0 ? 0 : I_IN + I_OUT, it1 = part == 0 ? I_IN + I_OUT : NITEMS;
    for (int it = it0 + gw; it < it1; it += nw) {
        int r = it;
        if (r < I_IN) { const int kb = r / (NINP / 32), n0 = 32 * (r % (NINP / 32));
            const float* s = nullptr;
            {
                const int oc = n0 < ZQN ? n0 + A_IN : n0 < ZA ? n0 + 1312 : n0 < ZP ? n0 - ZA : n0 < WVB ? -1 : n0 < WVN ? n0 - 864 : n0 - 96;
                if (oc >= 0) s = p.w_in + ((size_t)l * D + 64 * kb) * N_IN + oc + (lane & 31); }
            tr_item(s, N_IN, p.win_t + (size_t)n0 * D + 64 * kb, D, scr, lane, (n0 < ZKB || (n0 >= ZQN && n0 < ZKN)) ? QSCALE : 1.0f); continue; }
        r -= I_IN;
        if (r < I_OUT) { const int kb = r / (D / 32), n0 = 32 * (r % (D / 32));
            tr_item(p.w_out + ((size_t)l * DMIX + 64 * kb) * D + n0 + (lane & 31), D, p.wout_t + (size_t)n0 * DMIX + 64 * kb, DMIX, scr, lane); continue; }
        r -= I_OUT;
        const int e = r / (I_GU1 + I_D1); r %= (I_GU1 + I_D1);
        if (r < I_GU1) { const int kb = r / (2 * DE / 32), q = r % (2 * DE / 32), up = q & 1, c0 = 32 * (q >> 1);
            const float* s = (up ? p.w_up : p.w_gate) + (((size_t)l * NEXP + e) * D + 64 * kb) * DE + c0 + (lane & 31);
            tr_item<true>(s, DE, p.wgu_t + ((size_t)e * 2 * DE + 2 * c0 + 16 * up) * D + 64 * kb, D, scr, lane); continue; }
        r -= I_GU1;
        { const int kb = r / (D / 32), n0 = 32 * (r % (D / 32));
            tr_item(p.w_down + (((size_t)l * NEXP + e) * DE + 64 * kb) * D + n0 + (lane & 31), D, p.wd_t + ((size_t)e * D + n0) * DE + 64 * kb, DE, scr, lane); }
    }
    if (part != 0) return;
    const long gt = (long)bid_ * 256 + tid_, gs = (long)VGRID * 256;
    for (long i = gt; i < 2 * 256 * 64; i += gs) { const int k = (int)(i & 63), n = (int)((i >> 6) & 255), d = (int)(i >> 14);
        p.wupT[i] = f2bf(p.a_w_up[(((size_t)l * 2 + d) * 64 + k) * DA + n]); p.aupT[i] = f2bf(p.a_a_up[(((size_t)l * 2 + d) * 64 + k) * DA + n]); }
    for (long i = gt; i < 256 * 160; i += gs) { const int k = (int)(i % 160), n = (int)(i / 160); p.gupT[i] = f2bf(p.a_g_up[((size_t)l * 160 + k) * DA + n]); }
    for (long i = gt; i < (long)128 * D; i += gs) { const int n = (int)(i / D), k = (int)(i % D);
        const float w = n < 4 ? p.w_rg[((size_t)l * D + k) * 4 + n] : n < 36 ? p.w_re[((size_t)l * D + k) * 32 + n - 4] : 0.f;
        const bf16_t hb = f2bf(w); p.wrt[i] = hb; p.wrt[(size_t)128 * D + i] = f2bf(w - bf2f(hb)); }
}

__device__ __forceinline__ float tanh_fast(float x) { return 1.0f - 2.0f / (1.0f + __expf(2.0f * x)); }
__device__ __forceinline__ void ph_streams_s1(const Params& p, int l) {
    const int tid_ = opq_tid(), bid_ = opq_bid(); (void)tid_; (void)bid_;
    constexpr int NCH = A_IN / 8, NCHP = (NCH + 7) & ~7;
    const float* sh = p.a_shift + (size_t)l * 3 * A_IN;
    for (long it = (long)bid_ * 256 + tid_; it < (long)T * NCHP; it += (long)VGRID * 256) {
        const int m = (int)(it / NCHP), ch = (int)(it % NCHP), c0 = 8 * ch;
        const bool act = ch < NCH;
        int t, len;
        if (m < TL) { t = m % S; len = S; } else { t = (m - TL) % L; len = L; }
        float v[8];
#pragma unroll
        for (int e = 0; e < 8; ++e) v[e] = 0.f;
        if (act) {
            const bf16_t* z = p.Z + (size_t)m * ZP + ZA + c0;
            const bf16x8 zc = *(const bf16x8*)z;
            const f32x4 s1a = *(const f32x4*)(sh + A_IN + c0), s1b = *(const f32x4*)(sh + A_IN + c0 + 4);
#pragma unroll
            for (int e = 0; e < 8; ++e) v[e] = (e < 4 ? s1a[e] : s1b[e - 4]) * bf2f((bf16_t)zc[e]);
            if (t > 0) { const bf16x8 zp = *(const bf16x8*)(z - ZP); const f32x4 a = *(const f32x4*)(sh + c0), b = *(const f32x4*)(sh + c0 + 4);
#pragma unroll
                for (int e = 0; e < 8; ++e) v[e] += (e < 4 ? a[e] : b[e - 4]) * bf2f((bf16_t)zp[e]); }
            if (t < len - 1) { const bf16x8 zn = *(const bf16x8*)(z + ZP); const f32x4 a = *(const f32x4*)(sh + 2 * A_IN + c0), b = *(const f32x4*)(sh + 2 * A_IN + c0 + 4);
#pragma unroll
                for (int e = 0; e < 8; ++e) v[e] += (e < 4 ? a[e] : b[e - 4]) * bf2f((bf16_t)zn[e]); }
        }
        float nrm = 0.f;
        if (ch >= 32 && ch < 64) {
#pragma unroll
            for (int e = 0; e < 8; ++e) { const float t2 = v[e] * p.a_k_k[l * DA + c0 - 256 + e]; nrm += t2 * t2; } }
        nrm = sum8(nrm);
        if (!act) continue;
        if (c0 < 768) {
            float* dst = (c0 < 256 ? p.sR + (size_t)m * DA + c0 : c0 < 512 ? p.kT + (size_t)m * DA + c0 - 256 : p.sV + (size_t)m * DA + c0 - 512);
            *(f32x4*)dst = (f32x4){v[0], v[1], v[2], v[3]}; *(f32x4*)(dst + 4) = (f32x4){v[4], v[5], v[6], v[7]};
            if (ch >= 32 && ch < 64 && (ch & 7) == 0) p.kN[(size_t)m * 4 + ((ch - 32) >> 3)] = 1.0f / sqrtf(nrm + 1e-12f);
        } else {
            if (c0 < 896) {
#pragma unroll
                for (int e = 0; e < 8; ++e) v[e] = tanh_fast(v[e]); }
            else if (c0 >= 1024) {
#pragma unroll
                for (int e = 0; e < 8; ++e) v[e] = 1.0f / (1.0f + __expf(-v[e])); }
            uint4 o; o.x = pk2(v[0], v[1]); o.y = pk2(v[2], v[3]); o.z = pk2(v[4], v[5]); o.w = pk2(v[6], v[7]);
            *(uint4*)(p.LA + (size_t)m * 416 + c0 - 768) = o;
        }
    }
}
__device__ __forceinline__ void g_streams_s2(const Params& p, int l, char* lds) {
    const int tid_ = opq_tid(), bid_ = opq_bid(); (void)tid_; (void)bid_;
    constexpr int MT = T / 128;
    for (int job = bid_; job < 5 * MT * 2; job += VGRID) {
        const int type = job / (MT * 2), r = job % (MT * 2), tm = r >> 1, tn = r & 1;
        const int coff = type < 2 ? type * 64 : type < 4 ? 128 + (type - 2) * 64 : 256, K = type < 4 ? 64 : 160, d = type & 1;
        const bf16_t* Bt = type < 2 ? p.wupT + type * 256 * 64 : type < 4 ? p.aupT + (type - 2) * 256 * 64 : p.gupT;
        const bf16_t* a0 = p.LA + (size_t)(tm * 128 + STG_ROW(0)) * 416 + coff + STG_K; const bf16_t* a1 = p.LA + (size_t)(tm * 128 + STG_ROW(1)) * 416 + coff + STG_K;
        const bf16_t* b0 = Bt + (size_t)(tn * 128 + STG_ROW(0)) * K + STG_K; const bf16_t* b1 = Bt + (size_t)(tn * 128 + STG_ROW(1)) * K + STG_K;
        if (type < 2) gemm_tile(a0, a1, b0, b1, K, lds, [&](const f32x4 (&acc)[4][4], int wr, int wc, int fr, int fq) {
#pragma unroll
            for (int mi = 0; mi < 4; ++mi) { const int row = tm * 128 + wr * 64 + mi * 16 + fr;
#pragma unroll
                for (int n = 0; n < 4; ++n) { const int c = tn * 128 + wc * 64 + n * 16 + 4 * fq; const f32x4 w0 = *(const f32x4*)(p.a_w0 + (l * 2 + d) * DA + c); f32x4 o;
#pragma unroll
                    for (int e4 = 0; e4 < 4; ++e4) { const float ex = __expf(-(w0[e4] + acc[mi][n][e4]));
                        o[e4] = __expf(-0.60653065971f / (1.0f + ex)); }
                    *(f32x4*)(p.sW + ((size_t)d * T + row) * DA + c) = o; }
                asm volatile("" ::: "memory"); }
        });
        else if (type < 4) gemm_tile(a0, a1, b0, b1, K, lds, [&](const f32x4 (&acc)[4][4], int wr, int wc, int fr, int fq) {
#pragma unroll
            for (int mi = 0; mi < 4; ++mi) { const int row = tm * 128 + wr * 64 + mi * 16 + fr;
#pragma unroll
                for (int n = 0; n < 4; ++n) { const int c = tn * 128 + wc * 64 + n * 16 + 4 * fq;
                    const f32x4 a0v = *(const f32x4*)(p.a_a0 + (l * 2 + d) * DA + c), kkc = *(const f32x4*)(p.a_k_k + l * DA + c), kac = *(const f32x4*)(p.a_k_a + l * DA + c);
                    const size_t o = (size_t)row * DA + c, od = ((size_t)d * T + row) * DA + c;
                    const f32x4 k = *(const f32x4*)(p.kT + o); const float kn = p.kN[(size_t)row * 4 + (c >> 6)];
                    f32x4 kd, bo, kk;
#pragma unroll
                    for (int e4 = 0; e4 < 4; ++e4) { const float av = 1.0f / (1.0f + __expf(-(a0v[e4] + acc[mi][n][e4])));
                        kk[e4] = k[e4] * kkc[e4] * kn; kd[e4] = k[e4] * (1.0f + (av - 1.0f) * kac[e4]); bo[e4] = kk[e4] * av; }
                    *(f32x4*)(p.sKD + od) = kd; *(f32x4*)(p.sB + od) = bo; if (d == 0) *(f32x4*)(p.sKK + o) = kk; }
                asm volatile("" ::: "memory"); }
        });
        else gemm_tile(a0, a1, b0, b1, K, lds, [&](const f32x4 (&acc)[4][4], int wr, int wc, int fr, int fq) {
#pragma unroll
            for (int mi = 0; mi < 4; ++mi)
#pragma unroll
                for (int n = 0; n < 4; ++n) st_bf16x4(p.MIX + (size_t)(tm * 128 + wr * 64 + mi * 16 + fr) * DMIX + tn * 128 + wc * 64 + n * 16 + 4 * fq, acc[mi][n]);
        });
    }
}


typedef float f32x16 __attribute__((ext_vector_type(16)));
typedef short s16x4 __attribute__((ext_vector_type(4)));
typedef unsigned u32x4_t __attribute__((ext_vector_type(4)));
typedef float f32x2_t __attribute__((ext_vector_type(2)));
typedef __bf16 bf16x2_t __attribute__((ext_vector_type(2)));
__device__ __forceinline__ unsigned cvtpk(float lo, float hi) { f32x2_t v = {lo, hi}; bf16x2_t b = __builtin_convertvector(v, bf16x2_t); return __builtin_bit_cast(unsigned, b); }
__device__ __forceinline__ int crow(int r, int hi) { return (r & 3) + 8 * (r >> 2) + 4 * hi; }
__device__ __forceinline__ float xmax32(float v) { float a = v, b = v; asm volatile("s_nop 1\n\tv_permlane32_swap_b32 %0, %1" : "+v"(a), "+v"(b)); return fmaxf(a, b); }
__device__ __forceinline__ float xsum32(float v) { float a = v, b = v; asm volatile("s_nop 1\n\tv_permlane32_swap_b32 %0, %1" : "+v"(a), "+v"(b)); return a + b; }

struct NoMask { __device__ __forceinline__ float operator()(int, float v) const { return v; } };

template <class MaskF>
__device__ __forceinline__ void attn_tile_lds(const bf16x8 (&qf)[4], const char* ks, const char* vs, const MaskF& mask, float& m_run, float& l_run, f32x16& o0, f32x16& o1, int ql, int hi) {
    f32x16 s;
#pragma unroll
    for (int r = 0; r < 16; ++r) s[r] = 0.f;
#pragma unroll
    for (int k4 = 0; k4 < 4; ++k4) { const bf16x8 kf = *(const bf16x8*)(ks + ql * 128 + (((2 * k4 + hi) ^ (ql & 7)) * 16)); s = __builtin_amdgcn_mfma_f32_32x32x16_bf16(kf, qf[k4], s, 0, 0, 0); }
    float mx = -INFINITY;
#pragma unroll
    for (int r = 0; r < 16; ++r) { s[r] = mask(crow(r, hi), s[r]); mx = fmaxf(mx, s[r]); }
    mx = xmax32(mx);
    if (__any(mx > m_run)) {
        const float mn = fmaxf(m_run, mx), alpha = __builtin_amdgcn_exp2f(m_run - mn);
        m_run = mn; l_run *= alpha;
#pragma unroll
        for (int r = 0; r < 16; ++r) { o0[r] *= alpha; o1[r] *= alpha; }
    }
    float ps = 0.f;
#pragma unroll
    for (int r = 0; r < 16; ++r) { s[r] = __builtin_amdgcn_exp2f(s[r] - m_run); ps += s[r]; }
    l_run += ps;
    const int sw0 = (ql >> 2) & 3;
#pragma unroll
    for (int s2 = 0; s2 < 2; ++s2) {
        u32x4_t pw; pw[0] = cvtpk(s[8 * s2], s[8 * s2 + 1]); pw[1] = cvtpk(s[8 * s2 + 2], s[8 * s2 + 3]); pw[2] = cvtpk(s[8 * s2 + 4], s[8 * s2 + 5]); pw[3] = cvtpk(s[8 * s2 + 6], s[8 * s2 + 7]);
        const bf16x8 pb = __builtin_bit_cast(bf16x8, pw);
        const char* v0 = vs + ql * 64 + 8 * hi; const char* v1 = v0 + 32 * 64;
        const s16x4 a0 = *(const s16x4*)(v0 + (((2 * s2) ^ sw0) * 16)), a1 = *(const s16x4*)(v0 + (((2 * s2 + 1) ^ sw0) * 16));
        const s16x4 c0 = *(const s16x4*)(v1 + (((2 * s2) ^ sw0) * 16)), c1 = *(const s16x4*)(v1 + (((2 * s2 + 1) ^ sw0) * 16));
        o0 = __builtin_amdgcn_mfma_f32_32x32x16_bf16(__builtin_shufflevector(a0, a1, 0, 1, 2, 3, 4, 5, 6, 7), pb, o0, 0, 0, 0);
        o1 = __builtin_amdgcn_mfma_f32_32x32x16_bf16(__builtin_shufflevector(c0, c1, 0, 1, 2, 3, 4, 5, 6, 7), pb, o1, 0, 0, 0);
    }
}

template <class MaskA, class MaskB>
__device__ __forceinline__ void attn_tile2_lds(const bf16x8 (&qf)[4], const char* ksa, const char* ksb, const MaskA& ma, const MaskB& mb, float& m_run, float& l_run, f32x16& o0, f32x16& o1, int ql, int hi) {
    f32x16 sa, sb;
#pragma unroll
    for (int r = 0; r < 16; ++r) { sa[r] = 0.f; sb[r] = 0.f; }
#pragma unroll
    for (int k4 = 0; k4 < 4; ++k4) { const int off = ql * 128 + (((2 * k4 + hi) ^ (ql & 7)) * 16);
        const bf16x8 kfa = *(const bf16x8*)(ksa + off), kfb = *(const bf16x8*)(ksb + off);
        sa = __builtin_amdgcn_mfma_f32_32x32x16_bf16(kfa, qf[k4], sa, 0, 0, 0); sb = __builtin_amdgcn_mfma_f32_32x32x16_bf16(kfb, qf[k4], sb, 0, 0, 0); }
    float mx = -INFINITY;
#pragma unroll
    for (int r = 0; r < 16; ++r) { sa[r] = ma(crow(r, hi), sa[r]); sb[r] = mb(crow(r, hi), sb[r]); mx = fmaxf(mx, fmaxf(sa[r], sb[r])); }
    mx = xmax32(mx);
    if (__any(mx > m_run)) {
        const float mn = fmaxf(m_run, mx), alpha = __builtin_amdgcn_exp2f(m_run - mn);
        m_run = mn; l_run *= alpha;
#pragma unroll
        for (int r = 0; r < 16; ++r) { o0[r] *= alpha; o1[r] *= alpha; }
    }
    float ps = 0.f;
#pragma unroll
    for (int r = 0; r < 16; ++r) { sa[r] = __builtin_amdgcn_exp2f(sa[r] - m_run); sb[r] = __builtin_amdgcn_exp2f(sb[r] - m_run); ps += sa[r] + sb[r]; }
    l_run += ps;
    const int sw0 = (ql >> 2) & 3;
#pragma unroll
    for (int t = 0; t < 2; ++t) {
        const f32x16& s = t ? sb : sa; const char* vs = (t ? ksb : ksa) + 4096;
#pragma unroll
        for (int s2 = 0; s2 < 2; ++s2) {
            u32x4_t pw; pw[0] = cvtpk(s[8 * s2], s[8 * s2 + 1]); pw[1] = cvtpk(s[8 * s2 + 2], s[8 * s2 + 3]); pw[2] = cvtpk(s[8 * s2 + 4], s[8 * s2 + 5]); pw[3] = cvtpk(s[8 * s2 + 6], s[8 * s2 + 7]);
            const bf16x8 pb = __builtin_bit_cast(bf16x8, pw);
            const char* v0 = vs + ql * 64 + 8 * hi; const char* v1 = v0 + 32 * 64;
            const s16x4 a0 = *(const s16x4*)(v0 + (((2 * s2) ^ sw0) * 16)), a1 = *(const s16x4*)(v0 + (((2 * s2 + 1) ^ sw0) * 16));
            const s16x4 c0 = *(const s16x4*)(v1 + (((2 * s2) ^ sw0) * 16)), c1 = *(const s16x4*)(v1 + (((2 * s2 + 1) ^ sw0) * 16));
            o0 = __builtin_amdgcn_mfma_f32_32x32x16_bf16(__builtin_shufflevector(a0, a1, 0, 1, 2, 3, 4, 5, 6, 7), pb, o0, 0, 0, 0);
            o1 = __builtin_amdgcn_mfma_f32_32x32x16_bf16(__builtin_shufflevector(c0, c1, 0, 1, 2, 3, 4, 5, 6, 7), pb, o1, 0, 0, 0);
        }
    }
}

__device__ __forceinline__ void ph_attn_blk(const Params& p, int l, bool with_ctx, int first_blk, char* lds, char* lds_all) {
    const int tid_ = opq_tid(), bid_ = opq_bid(); (void)tid_; (void)bid_; (void)first_blk;
    const int lane = tid_ & 63, hi = lane >> 5, ql = lane & 31, wid = tid_ >> 6;
    constexpr int NQG = S / 128, NCG = L / 128, ROWS = S / GRID_W, N_LAT = NB * 6 * NQG, N_CTX = NB * 6 * NCG, TPB = (S + L) / 32;
    const int ntask = 2 * N_LAT + (with_ctx ? 2 * N_CTX : 0);
    const int krow = tid_ >> 3, kch = (tid_ & 7) ^ (krow & 7), vrow = tid_ >> 2, vpc = (tid_ & 3) ^ ((vrow >> 2) & 3);
    int* tq = (int*)(lds_all + 2 * 73728 + 32);
    for (;;) {
        __syncthreads();
        if (threadIdx.x == 0) *tq = atomicAdd(p.cnt + 128 + l, 1);
        __syncthreads();
        const int task = 2 * __builtin_amdgcn_readfirstlane(*tq) + (bid_ & 1);
        if (task >= ntask) break;
        bool isC, isCtx; int r;
        if (task < N_LAT) { isC = true; isCtx = false; r = task; }
        else if (task < 2 * N_LAT) { isC = false; isCtx = false; r = task - N_LAT; }
        else { r = task - 2 * N_LAT; isCtx = true; isC = r >= N_CTX; if (isC) r -= N_CTX; }
        const int ng = isCtx ? NCG : NQG, g = r % ng, h = (r / ng) % 6, b = r / (ng * 6);
        const int qt = 4 * g + wid;
        const int m = isCtx ? TL + b * L + 32 * qt + ql : b * S + 32 * qt + ql;
        const int qcol = isC ? ZQN + h * 64 : ZQB + h * 64, kcol = isC ? ZKN + h * 64 : ZKB + (h / 3) * 64, hv = isC ? 2 + h : h / 3;
        bf16x8 qf[4];
        { const bf16_t* qp = p.Z + (size_t)m * ZP + qcol + 8 * hi;
#pragma unroll
          for (int k4 = 0; k4 < 4; ++k4) qf[k4] = *(const bf16x8*)(qp + 16 * k4); }
        int lo = 0, hi_t = 0, gr0 = 0;
        if (!isCtx) {
            if (!isC) { lo = 4 * g - 4; hi_t = 4 * g + 8; lo = lo < 0 ? 0 : lo; hi_t = hi_t > S / 32 ? S / 32 : hi_t; }
            else { const int ra = 2 * g, rb = 2 * g + 1; int r0a = ra - 4; r0a = r0a < 0 ? 0 : (r0a > ROWS - 8 ? ROWS - 8 : r0a); int r0b = rb - 4; r0b = r0b < 0 ? 0 : (r0b > ROWS - 8 ? ROWS - 8 : r0b);
                   lo = 2 * r0a; hi_t = 2 * (r0b + 8); gr0 = 0; }
        }
        const int ntile = L / 32 + (hi_t - lo);
        const bf16_t* kbase = p.Z + (size_t)krow * ZP + kcol + 8 * kch;
        const bf16_t* vbase = p.VT + ((size_t)(b * 8 + hv) * 64 + vrow) * PU + 8 * vpc;
#define AT_TOK(i_) ((i_) < L / 32 ? 32 * (i_) : L + 32 * (lo + (i_) - L / 32))
#define AT_STAGE(i_) do { const int u0_ = AT_TOK(i_); const int zrow_ = u0_ < L ? TL + b * L + u0_ : b * S + (u0_ - L); char* sl_ = lds + ((i_) % 6) * 8192 + tid_ * 16; \
            __builtin_amdgcn_global_load_lds((const unsigned*)(kbase + (size_t)zrow_ * ZP), (__attribute__((address_space(3))) unsigned*)(sl_), 16, 0, 0); \
            __builtin_amdgcn_global_load_lds((const unsigned*)(vbase + u0_), (__attribute__((address_space(3))) unsigned*)(sl_ + 4096), 16, 0, 0); } while (0)
        f32x16 o0, o1;
#pragma unroll
        for (int rr = 0; rr < 16; ++rr) { o0[rr] = 0.f; o1[rr] = 0.f; }
        float m_run, l_run;
        if (isC) { m_run = -1e30f; l_run = 0.f; } else { m_run = p.b_sink[l * 6 + h] * LOG2E; l_run = hi == 0 ? 1.0f : 0.f; }
        const int gr = qt >> 1, c = 32 * (qt & 1) + ql;
        int r0 = gr - 4; r0 = r0 < 0 ? 0 : (r0 > ROWS - 8 ? ROWS - 8 : r0);
        int c0 = c - 8; c0 = c0 < 0 ? 0 : (c0 > GRID_W - 16 ? GRID_W - 16 : c0);
        float* rpb = (float*)(lds + 49152);
        if (isC && !isCtx) for (int i = tid_; i < 15 * 31; i += 256) rpb[i] = p.c_rpb[((size_t)l * 6 + h) * 15 * 31 + i] * LOG2E;
        AT_STAGE(0); AT_STAGE(1);
        if (ntile > 2) { AT_STAGE(2); AT_STAGE(3); }
#pragma unroll 1
        for (int i = 0; i < ntile; i += 2) {
            if (i + 2 < ntile) asm volatile("s_waitcnt vmcnt(4)" ::: "memory"); else asm volatile("s_waitcnt vmcnt(0)" ::: "memory");
            asm volatile("s_waitcnt lgkmcnt(0)" ::: "memory");
            __builtin_amdgcn_s_barrier();
            if (i + 4 < ntile) { AT_STAGE(i + 4); AT_STAGE(i + 5); }
            const char* ksa = lds + (i % 6) * 8192; const char* ksb = lds + ((i + 1) % 6) * 8192;
            if (i < L / 32) attn_tile2_lds(qf, ksa, ksb, NoMask(), NoMask(), m_run, l_run, o0, o1, ql, hi);
            else {
                const int jt = lo + i - L / 32;
                if (!isC) {
                    const int dq = jt - qt;
                    const bool aa = dq >= -4 && dq <= 4, ab = dq >= -5 && dq <= 3;
                    const int base = 32 * dq - ql;
                    auto mka = [&](int ko, float v) { const int rel = base + ko; return (rel >= -128 && rel <= 128) ? v : -INFINITY; };
                    auto mkb = [&](int ko, float v) { const int rel = base + 32 + ko; return (rel >= -128 && rel <= 128) ? v : -INFINITY; };
                    if (aa && ab) { if (dq >= -3 && dq <= 2) attn_tile2_lds(qf, ksa, ksb, NoMask(), NoMask(), m_run, l_run, o0, o1, ql, hi);
                                    else attn_tile2_lds(qf, ksa, ksb, mka, mkb, m_run, l_run, o0, o1, ql, hi); }
                    else if (aa) attn_tile_lds(qf, ksa, ksa + 4096, mka, m_run, l_run, o0, o1, ql, hi);
                    else if (ab) attn_tile_lds(qf, ksb, ksb + 4096, mkb, m_run, l_run, o0, o1, ql, hi);
                } else {
                    const int kr_ = jt >> 1;
                    if (kr_ >= r0 && kr_ < r0 + 8) { const float* rp = rpb + (kr_ - gr + 7) * 31 + 15 - c;
                        auto mca = [&](int ko, float v) { const int kc = ko; int ix = kc - c + 15; ix = ix < 0 ? 0 : (ix > 30 ? 30 : ix); const float bs = rp[c - 15 + ix]; return (kc >= c0 && kc < c0 + 16) ? v + bs : -INFINITY; };
                        auto mcb = [&](int ko, float v) { const int kc = 32 + ko; int ix = kc - c + 15; ix = ix < 0 ? 0 : (ix > 30 ? 30 : ix); const float bs = rp[c - 15 + ix]; return (kc >= c0 && kc < c0 + 16) ? v + bs : -INFINITY; };
                        attn_tile2_lds(qf, ksa, ksb, mca, mcb, m_run, l_run, o0, o1, ql, hi); }
                }
            }
        }
        asm volatile("s_waitcnt lgkmcnt(0)" ::: "memory");
        __builtin_amdgcn_s_barrier();
        {
            const int tk = task ^ 1; int np = L / 32;
            if (tk < 2 * N_LAT) { const bool c_ = tk < N_LAT; const int g_ = (c_ ? tk : tk - N_LAT) % NQG; int lo_, hi_;
                if (!c_) { lo_ = 4 * g_ - 4; hi_ = 4 * g_ + 8; lo_ = lo_ < 0 ? 0 : lo_; hi_ = hi_ > S / 32 ? S / 32 : hi_; }
                else { int r0a = 2 * g_ - 4; r0a = r0a < 0 ? 0 : (r0a > ROWS - 8 ? ROWS - 8 : r0a); int r0b = 2 * g_ - 3; r0b = r0b < 0 ? 0 : (r0b > ROWS - 8 ? ROWS - 8 : r0b); lo_ = 2 * r0a; hi_ = 2 * (r0b + 8); }
                np += hi_ - lo_; }
#pragma unroll 1
            for (int i = ntile; i < np; i += 2) __builtin_amdgcn_s_barrier();
        }
#undef AT_STAGE
#undef AT_TOK
        (void)gr0;
        const float lt = xsum32(l_run), inv = 1.0f / lt;
        bf16_t* op = p.MIX + (size_t)m * DMIX + (isC ? 640 : 256) + h * 64 + 4 * hi;
#pragma unroll
        for (int gq = 0; gq < 4; ++gq) {
            st_bf16x4(op + 8 * gq, (f32x4){o0[4 * gq] * inv, o0[4 * gq + 1] * inv, o0[4 * gq + 2] * inv, o0[4 * gq + 3] * inv});
            st_bf16x4(op + 32 + 8 * gq, (f32x4){o1[4 * gq] * inv, o1[4 * gq + 1] * inv, o1[4 * gq + 2] * inv, o1[4 * gq + 3] * inv});
        }
    }
}

#define RNB " row_newbcast:%c[n] row_mask:0xf bank_mask:0xf\n\t"
template <int N, bool FIRST>
__device__ __forceinline__ void dpp_dot4(float& a0, float& a1, float& a2, float& a3, const f32x4& v, float s0, float s1, float s2, float s3) {
    if (FIRST) asm volatile("s_nop 1");
    asm("v_fmac_f32_dpp %0, %4, %8" RNB "v_fmac_f32_dpp %1, %5, %9" RNB "v_fmac_f32_dpp %2, %6, %10" RNB "v_fmac_f32_dpp %3, %7, %11" RNB
        : "+v"(a0), "+v"(a1), "+v"(a2), "+v"(a3) : "v"(v[0]), "v"(v[1]), "v"(v[2]), "v"(v[3]), "v"(s0), "v"(s1), "v"(s2), "v"(s3), [n] "i"(N));
}
template <int N, bool FIRST>
__device__ __forceinline__ void dpp_upd4s(float& s0, float& s1, float& s2, float& s3, float& y0, float& y1, float& y2, float& y3,
                                          const f32x4& w, const f32x4& b, const f32x4& kd, const f32x4& r, float nsk, float vv) {
    if (FIRST) asm volatile("s_nop 1");
    asm("v_mul_f32_dpp %0, %8, %0" RNB "v_mul_f32_dpp %1, %9, %1" RNB "v_mul_f32_dpp %2, %10, %2" RNB "v_mul_f32_dpp %3, %11, %3" RNB
        "v_fmac_f32_dpp %0, %12, %24" RNB "v_fmac_f32_dpp %1, %13, %24" RNB "v_fmac_f32_dpp %2, %14, %24" RNB "v_fmac_f32_dpp %3, %15, %24" RNB
        "v_fmac_f32_dpp %0, %16, %25" RNB "v_fmac_f32_dpp %1, %17, %25" RNB "v_fmac_f32_dpp %2, %18, %25" RNB "v_fmac_f32_dpp %3, %19, %25" RNB
        "v_fmac_f32_dpp %4, %20, %0" RNB "v_fmac_f32_dpp %5, %21, %1" RNB "v_fmac_f32_dpp %6, %22, %2" RNB "v_fmac_f32_dpp %7, %23, %3" RNB
        : "+v"(s0), "+v"(s1), "+v"(s2), "+v"(s3), "+v"(y0), "+v"(y1), "+v"(y2), "+v"(y3)
        : "v"(w[0]), "v"(w[1]), "v"(w[2]), "v"(w[3]), "v"(b[0]), "v"(b[1]), "v"(b[2]), "v"(b[3]), "v"(kd[0]), "v"(kd[1]), "v"(kd[2]), "v"(kd[3]),
          "v"(r[0]), "v"(r[1]), "v"(r[2]), "v"(r[3]), "v"(nsk), "v"(vv), [n] "i"(N));
}
template <int N, bool FIRST>
__device__ __forceinline__ void dpp_upd4p(float& s0, float& s1, float& s2, float& s3, float& y0, float& y1, float& y2, float& y3,
                                          const f32x4& w, const f32x4& b, const f32x4& r, float nsk) {
    if (FIRST) asm volatile("s_nop 1");
    asm("v_mul_f32_dpp %0, %8, %0" RNB "v_mul_f32_dpp %1, %9, %1" RNB "v_mul_f32_dpp %2, %10, %2" RNB "v_mul_f32_dpp %3, %11, %3" RNB
        "v_fmac_f32_dpp %0, %12, %20" RNB "v_fmac_f32_dpp %1, %13, %20" RNB "v_fmac_f32_dpp %2, %14, %20" RNB "v_fmac_f32_dpp %3, %15, %20" RNB
        "v_fmac_f32_dpp %4, %16, %0" RNB "v_fmac_f32_dpp %5, %17, %1" RNB "v_fmac_f32_dpp %6, %18, %2" RNB "v_fmac_f32_dpp %7, %19, %3" RNB
        : "+v"(s0), "+v"(s1), "+v"(s2), "+v"(s3), "+v"(y0), "+v"(y1), "+v"(y2), "+v"(y3)
        : "v"(w[0]), "v"(w[1]), "v"(w[2]), "v"(w[3]), "v"(b[0]), "v"(b[1]), "v"(b[2]), "v"(b[3]), "v"(r[0]), "v"(r[1]), "v"(r[2]), "v"(r[3]), "v"(nsk), [n] "i"(N));
}
template <int N, bool FIRST>
__device__ __forceinline__ void dpp_mul4(float& s0, float& s1, float& s2, float& s3, const f32x4& v) {
    if (FIRST) asm volatile("s_nop 1");
    asm("v_mul_f32_dpp %0, %4, %0" RNB "v_mul_f32_dpp %1, %5, %1" RNB "v_mul_f32_dpp %2, %6, %2" RNB "v_mul_f32_dpp %3, %7, %3" RNB
        : "+v"(s0), "+v"(s1), "+v"(s2), "+v"(s3) : "v"(v[0]), "v"(v[1]), "v"(v[2]), "v"(v[3]), [n] "i"(N));
}
template <int N>
__device__ __forceinline__ void dpp_fmacx4(float& s0, float& s1, float& s2, float& s3, const f32x4& v, float x) {
    asm("v_fmac_f32_dpp %0, %4, %8" RNB "v_fmac_f32_dpp %1, %5, %8" RNB "v_fmac_f32_dpp %2, %6, %8" RNB "v_fmac_f32_dpp %3, %7, %8" RNB
        : "+v"(s0), "+v"(s1), "+v"(s2), "+v"(s3) : "v"(v[0]), "v"(v[1]), "v"(v[2]), "v"(v[3]), "v"(x), [n] "i"(N));
}
template <int N> struct ScanRep {
    static __device__ __forceinline__ void dot8(float (&a)[8], const f32x4& v, const float (&st)[64]) {
        constexpr int h = (N & 1) * 4;
        dpp_dot4<N, N == 0>(a[h], a[h + 1], a[h + 2], a[h + 3], v, st[4 * N], st[4 * N + 1], st[4 * N + 2], st[4 * N + 3]);
        if constexpr (N < 15) ScanRep<N + 1>::dot8(a, v, st);
    }
    static __device__ __forceinline__ void dot(float& a0, float& a1, float& a2, float& a3, const f32x4& v, const float (&st)[64]) {
        dpp_dot4<N, N == 0>(a0, a1, a2, a3, v, st[4 * N], st[4 * N + 1], st[4 * N + 2], st[4 * N + 3]);
        if constexpr (N < 15) ScanRep<N + 1>::dot(a0, a1, a2, a3, v, st);
    }
    static __device__ __forceinline__ void mul(float (&st)[64], const f32x4& w) {
        dpp_mul4<N, N == 0>(st[4 * N], st[4 * N + 1], st[4 * N + 2], st[4 * N + 3], w);
        if constexpr (N < 15) ScanRep<N + 1>::mul(st, w);
    }
    static __device__ __forceinline__ void fmacx(float (&st)[64], const f32x4& v, float x) {
        dpp_fmacx4<N>(st[4 * N], st[4 * N + 1], st[4 * N + 2], st[4 * N + 3], v, x);
        if constexpr (N < 15) ScanRep<N + 1>::fmacx(st, v, x);
    }
};
__device__ __forceinline__ int scan_row(int b, int d, int pos) { return pos < L ? TL + b * L + (d ? L - 1 - pos : pos) : b * S + (d ? S - 1 - (pos - L) : pos - L); }

template <bool ISP>
__device__ __forceinline__ void scan_task(const Params& p, int c, int s, int lane) {
    const int h = c & 3, b = (c >> 2) % NB, d = (c >> 2) / NB, pos0 = SEGLEN * s;
    const int q = 4 * (lane & 15);
    const float* bkk = p.sKK + h * 64 + q; const float* br = p.sR + h * 64 + q; const float* bw = p.sW + (size_t)d * T * DA + h * 64 + q; const float* bb_ = p.sB + (size_t)d * T * DA + h * 64 + q;
    const float* bkd = p.sKD + (size_t)d * T * DA + h * 64 + q; const float* bv = p.sV + h * 64 + lane;
    float* by = (ISP ? p.PV : p.Y) + (size_t)d * T * DA + h * 64 + lane;
    float st[64];
#pragma unroll
    for (int k = 0; k < 64; ++k) st[k] = (ISP && k == lane) ? 1.0f : 0.f;
    size_t mo = (size_t)scan_row(b, d, pos0) * DA;
    f32x4 kk = *(const f32x4*)(bkk + mo), w = *(const f32x4*)(bw + mo), bb = *(const f32x4*)(bb_ + mo), r = *(const f32x4*)(br + mo), kd = w; float vv = 0.f;
    if (!ISP) { kd = *(const f32x4*)(bkd + mo); vv = bv[mo]; }
#pragma unroll 1
    for (int i = 0; i < SEGLEN; ++i) {
        const size_t mn = (size_t)scan_row(b, d, pos0 + (i + 1 < SEGLEN ? i + 1 : i)) * DA;
        const f32x4 nkk = *(const f32x4*)(bkk + mn), nw = *(const f32x4*)(bw + mn), nb = *(const f32x4*)(bb_ + mn), nr = *(const f32x4*)(br + mn);
        f32x4 nkd = nw; float nv = 0.f;
        if (!ISP) { nkd = *(const f32x4*)(bkd + mn); nv = bv[mn]; }
        float a[8] = {0.f, 0.f, 0.f, 0.f, 0.f, 0.f, 0.f, 0.f};
        ScanRep<0>::dot8(a, kk, st);
        const float nsk = -(((a[0] + a[1]) + (a[2] + a[3])) + ((a[4] + a[5]) + (a[6] + a[7])));
        ScanRep<0>::mul(st, w);
        ScanRep<0>::fmacx(st, bb, nsk);
        if (!ISP) ScanRep<0>::fmacx(st, kd, vv);
        float y[8] = {0.f, 0.f, 0.f, 0.f, 0.f, 0.f, 0.f, 0.f};
        ScanRep<0>::dot8(y, r, st);
        by[mo] = ((y[0] + y[1]) + (y[2] + y[3])) + ((y[4] + y[5]) + (y[6] + y[7]));
        kk = nkk; w = nw; bb = nb; r = nr; kd = nkd; vv = nv; mo = mn;
    }
    if (s < NSG - 1) {
        float* dst = (ISP ? p.PS : p.QS) + (((size_t)c * NSG + s) * 64 + lane) * 64;
#pragma unroll
        for (int k4 = 0; k4 < 16; ++k4) *(f32x4*)(dst + 4 * k4) = (f32x4){st[4 * k4], st[4 * k4 + 1], st[4 * k4 + 2], st[4 * k4 + 3]};
    }
}
__device__ __forceinline__ void ph_scan_fast(const Params& p) {
    const int tid_ = opq_tid(), bid_ = opq_bid(); (void)tid_; (void)bid_;
    const int lane = tid_ & 63, gw = bid_ * 4 + (tid_ >> 6), nw = VGRID * 4;
    constexpr int NS_T = 64 * NSG, NP_T = 64 * (NSG - 1);
    const int G = VGRID, wv = ((tid_ >> 6) + 2 * (bid_ & 1)) & 3; (void)gw; (void)nw;
    for (int tsk = wv * G + bid_; tsk < NS_T + NP_T; tsk += 4 * G) {
        const int t2 = __builtin_amdgcn_readfirstlane(tsk);
        if (t2 < NS_T) scan_task<false>(p, t2 & 63, t2 >> 6, lane);
        else scan_task<true>(p, (t2 - NS_T) & 63, 1 + ((t2 - NS_T) >> 6), lane);
    }
}
__device__ __forceinline__ void ph_combine(const Params& p, char* lds) {
    const int tid_ = opq_tid(), bid_ = opq_bid(); (void)tid_; (void)bid_; (void)lds;
    if (bid_ >= 64) return;
    const int lane = tid_ & 63, c = bid_, cb = tid_ >> 6, q = lane >> 4, i16 = lane & 15, v = 16 * cb + i16;
    const float* QSc = p.QS + (size_t)c * NSG * 4096; const float* PSc = p.PS + (size_t)c * NSG * 4096; float* SSg = p.SS + (size_t)c * NSG * 4096;
    f32x4 acc[4];
#pragma unroll
    for (int ro = 0; ro < 4; ++ro) acc[ro] = *(const f32x4*)(QSc + v * 64 + 16 * ro + 4 * q);
#pragma unroll 1
    for (int s = 1; s < NSG; ++s) {
#pragma unroll
        for (int ro = 0; ro < 4; ++ro)
#pragma unroll
            for (int j = 0; j < 4; ++j) SSg[(size_t)s * 4096 + (16 * ro + 4 * q + j) * 64 + v] = acc[ro][j];
        if (s == NSG - 1) break;
        const float* P = PSc + (size_t)s * 4096 + (4 * q) * 64 + i16;
        float a[4][4][4];
#pragma unroll
        for (int rb = 0; rb < 4; ++rb)
#pragma unroll
            for (int kk = 0; kk < 4; ++kk)
#pragma unroll
                for (int ro = 0; ro < 4; ++ro) a[rb][kk][ro] = P[(16 * rb + kk) * 64 + 16 * ro];
#pragma unroll
        for (int rb = 0; rb < 4; ++rb) asm volatile("" : "+v"(a[rb][0][0]), "+v"(a[rb][0][1]), "+v"(a[rb][0][2]), "+v"(a[rb][0][3]), "+v"(a[rb][1][0]), "+v"(a[rb][1][1]), "+v"(a[rb][1][2]), "+v"(a[rb][1][3]),
                                                         "+v"(a[rb][2][0]), "+v"(a[rb][2][1]), "+v"(a[rb][2][2]), "+v"(a[rb][2][3]), "+v"(a[rb][3][0]), "+v"(a[rb][3][1]), "+v"(a[rb][3][2]), "+v"(a[rb][3][3]));
        f32x4 nacc[4];
#pragma unroll
        for (int ro = 0; ro < 4; ++ro) nacc[ro] = *(const f32x4*)(QSc + (size_t)s * 4096 + v * 64 + 16 * ro + 4 * q);
#pragma unroll
        for (int rb = 0; rb < 4; ++rb)
#pragma unroll
            for (int kk = 0; kk < 4; ++kk)
#pragma unroll
                for (int ro = 0; ro < 4; ++ro) nacc[ro] = __builtin_amdgcn_mfma_f32_16x16x4f32(a[rb][kk][ro], acc[rb][kk], nacc[ro], 0, 0, 0);
#pragma unroll
        for (int ro = 0; ro < 4; ++ro) acc[ro] = nacc[ro];
    }
}
__device__ __forceinline__ float qsum(float v) {
    float a = v, b = v; asm volatile("s_nop 1\n\tv_permlane16_swap_b32 %0, %1" : "+v"(a), "+v"(b)); v = a + b; a = v; b = v;
    asm volatile("s_nop 1\n\tv_permlane32_swap_b32 %0, %1" : "+v"(a), "+v"(b)); return a + b; }
__device__ __forceinline__ void ph_rwkv_out_fast(const Params& p, int l, bool with_ctx) {
    const int tid_ = opq_tid(), bid_ = opq_bid(); (void)tid_; (void)bid_;
    const int lane = tid_ & 63, i16 = lane & 15, q = lane >> 4, gw = bid_ * 4 + (tid_ >> 6), nw = VGRID * 4;
    constexpr int TOK = 16, NLT = NB * (S / TOK) * 4, NCTK = NB * (L / TOK) * 4;
    const int ntask = NLT + (with_ctx ? NCTK : 0);
    for (int tsk = gw; tsk < ntask; tsk += nw) {
        const bool isCtx = tsk >= NLT; const int r = isCtx ? tsk - NLT : tsk;
        const int h = r & 3, npt = isCtx ? L / TOK : S / TOK, tt = (r >> 2) % npt, b = (r >> 2) / npt;
        const int seg0 = (isCtx ? TOK * tt : L + TOK * tt) / SEGLEN, seg1 = (isCtx ? L - 1 - TOK * tt : L + S - 1 - TOK * tt) / SEGLEN;
        const int m = (isCtx ? TL + b * L + TOK * tt : b * S + TOK * tt) + i16;
        const size_t o = (size_t)m * DA + h * 64 + 4 * q, o1 = o + (size_t)T * DA;
        f32x4 acc[4];
#pragma unroll
        for (int rb = 0; rb < 4; ++rb) acc[rb] = *(const f32x4*)(p.Y + o + 16 * rb) + *(const f32x4*)(p.Y + o1 + 16 * rb);
#pragma unroll
        for (int d = 0; d < 2; ++d) {
            const int seg = d ? seg1 : seg0;
            if (seg > 0) {
                const float* sst = p.SS + (((size_t)(d * NB + b) * 4 + h) * NSG + seg) * 4096 + q * 64 + i16;
                const float* pvp = p.PV + (d ? o1 : o) - 4 * q + q;
                float a[4][16], bq[16];
#pragma unroll
                for (int kk = 0; kk < 16; ++kk) { bq[kk] = pvp[4 * kk];
#pragma unroll
                    for (int rb = 0; rb < 4; ++rb) a[rb][kk] = sst[(4 * kk) * 64 + 16 * rb]; }
#pragma unroll
                for (int rb = 0; rb < 4; ++rb) asm volatile("" : "+v"(a[rb][0]), "+v"(a[rb][1]), "+v"(a[rb][2]), "+v"(a[rb][3]), "+v"(a[rb][4]), "+v"(a[rb][5]), "+v"(a[rb][6]), "+v"(a[rb][7]),
                                                                 "+v"(a[rb][8]), "+v"(a[rb][9]), "+v"(a[rb][10]), "+v"(a[rb][11]), "+v"(a[rb][12]), "+v"(a[rb][13]), "+v"(a[rb][14]), "+v"(a[rb][15]));
#pragma unroll
                for (int kk = 0; kk < 16; ++kk)
#pragma unroll
                    for (int rb = 0; rb < 4; ++rb) acc[rb] = __builtin_amdgcn_mfma_f32_16x16x4f32(a[rb][kk], bq[kk], acc[rb], 0, 0, 0);
            }
        }
        float s = 0.f;
#pragma unroll
        for (int rb = 0; rb < 4; ++rb) s += sum4(acc[rb]);
        const float mu = qsum(s) * (1.0f / 64.f);
        float sq = 0.f, bon = 0.f;
#pragma unroll
        for (int rb = 0; rb < 4; ++rb) { const f32x4 dy = acc[rb] - mu; sq += sum4(dy * dy);
            const f32x4 rr = *(const f32x4*)(p.sR + o + 16 * rb), kds = *(const f32x4*)(p.sKD + o + 16 * rb) + *(const f32x4*)(p.sKD + o1 + 16 * rb), rk = *(const f32x4*)(p.a_r_k + l * DA + h * 64 + 16 * rb + 4 * q);
            bon += sum4(rr * kds * rk); }
        const float rstd = 1.0f / sqrtf(qsum(sq) * (1.0f / 64.f) + GN_EPS); bon = qsum(bon);
#pragma unroll
        for (int rb = 0; rb < 4; ++rb) { const int c = h * 64 + 16 * rb + 4 * q;
            const f32x4 gln = *(const f32x4*)(p.a_lnx_g + l * DA + c), bln = *(const f32x4*)(p.a_lnx_b + l * DA + c), vv = *(const f32x4*)(p.sV + o + 16 * rb);
            bf16_t* mp = p.MIX + (size_t)m * DMIX + c; const f32x4 gg = ld_bf16x4(mp);
            st_bf16x4(mp, ((acc[rb] - mu) * rstd * gln + bln + vv * bon) * gg); }
    }
}


#define LAS __attribute__((address_space(3)))
#define XB_TMO      128
#define XB_XCNT(j)  (256  + 64 * (j))
#define XB_XSUB(j)  (1280 + 64 * (j))
#define XB_XGEN(j)  (2304 + 64 * (j))
#define XB_TOP      3328
#define XB_TOPGEN   3392
#define XCD_BAR_WORDS 3456
#define XB_SPIN_CAP (1u << 20)
static_assert(XCD_BAR_WORDS * 4 <= 16384, "barrier words fit the control region");
__device__ __forceinline__ unsigned xb_ld(unsigned* p)              { return __hip_atomic_load(p, __ATOMIC_RELAXED, __HIP_MEMORY_SCOPE_AGENT); }
__device__ __forceinline__ unsigned xb_add(unsigned* p, unsigned v) { return __hip_atomic_fetch_add(p, v, __ATOMIC_RELAXED, __HIP_MEMORY_SCOPE_AGENT); }
__device__ __forceinline__ unsigned xb_xcc_id() { return (unsigned)__builtin_amdgcn_s_getreg((3 << 11) | 20) & 0xFu; }
#define XB_SPIN(cond, bar) do { unsigned _sp = 0; while (cond) { __builtin_amdgcn_s_sleep(1); \
    if ((++_sp & 255u) == 0u) { if (xb_ld(&(bar)[XB_TMO])) break; if (_sp > XB_SPIN_CAP) { atomicAdd(&(bar)[XB_TMO], 1u); break; } } } } while (0)
struct XcdBarrier { unsigned* bar; unsigned x; volatile LAS unsigned* st; };
__device__ __forceinline__ XcdBarrier xcd_barrier_post(unsigned* bar, volatile LAS unsigned* st) {
    XcdBarrier b; b.bar = bar; b.x = xb_xcc_id(); b.st = st;
    if (threadIdx.x == 0) (void)xb_add(&bar[XB_XCNT(b.x)], 1u);
    return b;
}
__device__ __forceinline__ void xcd_barrier_complete(unsigned* bar, unsigned x, unsigned& nloc, unsigned& nx) {
    const unsigned G = gridDim.x * gridDim.y * gridDim.z;
    unsigned sum, cnt, mine, sp = 0u;
    for (;;) {
        sum = 0u; cnt = 0u; mine = 0u;
#pragma unroll
        for (unsigned j = 0; j < 16; ++j) { const unsigned c = xb_ld(&bar[XB_XCNT(j)]); sum += c; cnt += (c > 0u) ? 1u : 0u; mine = (j == x) ? c : mine; }
        if (sum == G) break;
        __builtin_amdgcn_s_sleep(1);
        if ((++sp & 255u) == 0u) { if (xb_ld(&bar[XB_TMO])) break; if (sp > XB_SPIN_CAP) { atomicAdd(&bar[XB_TMO], 1u); break; } }
    }
    nloc = mine > 0u ? mine : 1u; nx = cnt > 0u ? cnt : 1u;
}
__device__ __forceinline__ void xcd_barrier(const XcdBarrier& b) {
    asm volatile("s_waitcnt vmcnt(0)" ::: "memory");
    __syncthreads();
    if (threadIdx.x == 0) {
        unsigned* bar = b.bar;
        __builtin_amdgcn_s_waitcnt(0);
        unsigned nloc = b.st[0], nx = b.st[1];
        if (nloc == 0u) { xcd_barrier_complete(bar, b.x, nloc, nx); b.st[0] = nloc; b.st[1] = nx; }
        const unsigned old = xb_add(&bar[XB_XSUB(b.x)], 1u);
        const unsigned gen = old / nloc;
        if (old + 1u == (gen + 1u) * nloc) {
            __builtin_amdgcn_fence(__ATOMIC_RELEASE, "agent");
            asm volatile("s_waitcnt vmcnt(0)" ::: "memory");
            const unsigned og = xb_add(&bar[XB_TOP], 1u);
            const unsigned tg = og / nx;
            if (og + 1u == (tg + 1u) * nx) xb_add(&bar[XB_TOPGEN], 1u);
            else XB_SPIN(xb_ld(&bar[XB_TOPGEN]) == tg, bar);
            __builtin_amdgcn_fence(__ATOMIC_ACQUIRE, "agent");
            xb_add(&bar[XB_XGEN(b.x)], 1u);
            asm volatile("s_waitcnt vmcnt(0)" ::: "memory");
        } else {
            XB_SPIN(xb_ld(&bar[XB_XGEN(b.x)]) == gen, bar);
            __builtin_amdgcn_fence(__ATOMIC_ACQUIRE, "agent");
            asm volatile("s_waitcnt vmcnt(0)" ::: "memory");
        }
    }
    __syncthreads();
}

__device__ __forceinline__ long opq_gt() { int t = threadIdx.x; asm volatile("" : "+v"(t)); return (long)blockIdx.x * blockDim.x + t; }
#define GS ((long)gridDim.x * blockDim.x)
__global__ void __launch_bounds__(512, 1) mega_fwd(Params p) {
    __shared__ __attribute__((aligned(16))) char lds_all[2 * 73728 + 64];
    cg::grid_group grid = cg::this_grid();
    const long gs = GS;
#define gt opq_gt()
    char* lds = lds_all + __builtin_amdgcn_readfirstlane(threadIdx.x >> 8) * 73728;
    volatile LAS unsigned* bst = (volatile LAS unsigned*)(LAS char*)(lds_all + 2 * 73728);
    if (threadIdx.x < 2) bst[threadIdx.x] = 0u;
    __syncthreads();
    const XcdBarrier xb = xcd_barrier_post(p.bar, bst);
#ifndef PROBE_PHASE
#define PROBE_PHASE -1
#endif
#define PROBE_AMP 8
    unsigned long long t_prev = 0; int nts = 0;
#define STAMP() do { if (PROBE_PHASE >= 0 && blockIdx.x == 0 && threadIdx.x == 0) { const unsigned long long t_now = __builtin_amdgcn_s_memrealtime(); \
        if (nts == PROBE_PHASE + 1) { const unsigned long long t_end = t_now + PROBE_AMP * (t_now - t_prev); while (__builtin_amdgcn_s_memrealtime() < t_end) __builtin_amdgcn_s_sleep(8); } \
        t_prev = __builtin_amdgcn_s_memrealtime(); } ++nts; } while (0)
#define GSYNC() do { xcd_barrier(xb); STAMP(); } while (0)
    STAMP();
    ph_mod_fast(p, lds); ph_prep_w_fast(p, 0, 0, lds); ph_prep_misc(p, 0, gt, gs, false);
    if (p.out == nullptr) grid.sync();
    GSYNC();
    for (int l = 0; l < 2; ++l) {
        const int nrows = (l == 0) ? T : TL;
        if (l == 0) { ph_lnmod_fast(p, l); GSYNC(); }
        g_gemm_in(p, lds_all);
        GSYNC();
        ph_streams_s1(p, l);
        GSYNC();
        g_streams_s2(p, l, lds);
        GSYNC();
        ph_scan_fast(p);
        GSYNC();
        ph_combine(p, lds); ph_attn_blk(p, l, l == 0, 64, lds, lds_all);
        GSYNC();
        ph_rwkv_out_fast(p, l, l == 0);
        GSYNC();
        {   const int nU = (nrows / 256) * (D / 256), G = (int)gridDim.x, heavy = nU > G ? nU - G : 0, rb = (int)blockIdx.x;
            if (rb < heavy) g_gemm_out(p, nrows, lds_all);
            else if (rb >= heavy + (G - heavy) / 2) { ph_prep_w_fast(p, l, 1, lds, 2 * heavy); __syncthreads(); g_gemm_out(p, nrows, lds_all); }
            else { g_gemm_out(p, nrows, lds_all); __syncthreads(); ph_prep_w_fast(p, l, 1, lds, 2 * heavy); } }
        GSYNC();
        g_router(p, l, nrows, lds);
        GSYNC();
        ph_dispatch_fast(p, l, nrows, lds);
        GSYNC();
        g_moe1(p, l, lds_all);
        GSYNC();
        g_moe2(p, l, lds_all);
        GSYNC();
        ph_final_fast(p, l, nrows, l == 0);
        if (l == 0) { ph_prep_w_fast(p, 1, 0, lds); ph_prep_misc(p, 1, gt, gs, false); }
        GSYNC();
    }}

extern "C" void kernel_launch(void* const* d_in, const int* in_sizes, int n_in, void* d_out, int out_size, void* d_ws, size_t ws_size, hipStream_t stream) {
    if (n_in != 32 || out_size != TL * D || ws_size < WS_NEED) { fprintf(stderr, "kernel_launch: unexpected shapes / workspace (n_in %d out %d ws %zu need %zu)\n", n_in, out_size, ws_size, (size_t)WS_NEED); return; }
    static int grid_blocks = 0;
    if (!grid_blocks) {
        int dev = 0, cus = 0, per_cu = 0;
        (void)hipGetDevice(&dev);
        (void)hipDeviceGetAttribute(&cus, hipDeviceAttributeMultiprocessorCount, dev);
        (void)hipOccupancyMaxActiveBlocksPerMultiprocessor(&per_cu, mega_fwd, 512, 0);
        if (per_cu < 1) per_cu = 1;
        if (per_cu > 1) per_cu = 1;
        grid_blocks = cus * per_cu;
        fprintf(stderr, "kernel_launch: %d CUs x %d blocks\n", cus, per_cu);
    }
    Params p = make_params(d_in, d_out, d_ws);
    (void)hipMemsetAsync(d_ws, 0, CTL_BYTES, stream);
    void* args[] = {&p};
    hipError_t e = hipLaunchCooperativeKernel((void*)mega_fwd, dim3(grid_blocks), dim3(512), args, 0, stream);
    if (e != hipSuccess) fprintf(stderr, "cooperative launch failed: %s (grid %d)\n", hipGetErrorString(e), grid_blocks);
}
#endif

#ifdef HOST_EMU
static void host_forward(void* const* d_in, void* d_out, void* d_ws) {
    const Params p = make_params(d_in, d_out, d_ws);
    for (int l = 0; l < 2; ++l) {
        const int nrows = (l == 0) ? T : TL;
        ph_prep_w(p, l, 0, 1); ph_prep_misc(p, l, 0, 1); ph_lnmod(p, l, 0, 1); host_gemm_in(p); ph_streams(p, l, 0, 1); ph_rope(p, 0, 1); ph_scan(p, 0, 1);
        ph_attn(p, l, nrows, 0, 1); ph_rwkv_out(p, l, nrows, 0, 1); host_gemm_out(p, nrows); ph_post_mixer(p, l, nrows, 0, 1);
        ph_dispatch(p, l, nrows, 0, 1); host_moe1(p, l); host_moe2(p, l); ph_final(p, l, nrows, 0, 1);
    }
}
#endif
```
